# Optimizing an MI355X kernel written in HIP

```python
import math
import jax, jax.numpy as jnp
from jax import lax
import numpy as np

D_MODEL = 1024
BATCH = 4
SEQ = 4096
DEPTH = 4

CHUNK = 64
Q_BLOCK = 128
D_MIX = D_MODEL
HEAD_DIM = 64
D_FOX = D_MIX // 2
FOX_HEADS = D_FOX // HEAD_DIM
D_S5 = D_MIX // 4
S5_GROUP_CH = 16
S5_GROUPS = D_S5 // S5_GROUP_CH
S5_STATE = 64
D_RET = D_MIX // 4
RET_HEADS = D_RET // HEAD_DIM
ROPE_BASE = 10000.0
EPS = 1e-6
SPLIT_SIZES = (D_FOX, D_FOX, D_FOX, FOX_HEADS, D_S5, D_RET, D_RET, D_RET, D_MIX)
D_IN_PROJ = 3 * D_FOX + FOX_HEADS + D_S5 + 3 * D_RET + D_MIX

kernel_name = 'hybrid_fox_s5_retention_block'


def rms_norm(x, g):
    xf = x.astype(jnp.float32)
    y = xf * lax.rsqrt(jnp.mean(xf * xf, axis=-1, keepdims=True) + EPS)
    return (y * g.astype(jnp.float32)).astype(x.dtype)


def split_cols(proj):
    idx = [int(i) for i in np.cumsum(SPLIT_SIZES)[:-1]]
    return jnp.split(proj, idx, axis=-1)


def rotary(x):
    L, d = x.shape[1], x.shape[3]
    half = d // 2
    freqs = ROPE_BASE ** (-jnp.arange(half, dtype=jnp.float32) / half)
    ang = jnp.arange(L, dtype=jnp.float32)[:, None] * freqs[None, :]
    cos = jnp.cos(ang)[None, :, None, :]
    sin = jnp.sin(ang)[None, :, None, :]
    xf = x.astype(jnp.float32)
    x1, x2 = xf[..., :half], xf[..., half:]
    return jnp.concatenate([x1 * cos - x2 * sin, x1 * sin + x2 * cos], axis=-1)


def forgetting_attention(q, k, v, logf):
    B, L, H, dh = q.shape
    nb = L // Q_BLOCK
    scale = 1.0 / math.sqrt(dh)
    qh = q.transpose(0, 2, 1, 3)
    kh = k.transpose(0, 2, 1, 3)
    vh = v.transpose(0, 2, 1, 3)
    c = jnp.cumsum(logf, axis=1).transpose(0, 2, 1)
    qb = qh.reshape(B, H, nb, Q_BLOCK, dh).transpose(2, 0, 1, 3, 4)
    cb = c.reshape(B, H, nb, Q_BLOCK).transpose(2, 0, 1, 3)
    key_pos = jnp.arange(L)

    def block(args):
        qi, ci, bi = args
        s = jnp.einsum('bhqd,bhkd->bhqk', qi, kh).astype(jnp.float32) * scale
        s = s + ci[..., None] - c[:, :, None, :]
        q_pos = bi * Q_BLOCK + jnp.arange(Q_BLOCK)
        s = jnp.where(key_pos[None, :] <= q_pos[:, None], s, -jnp.inf)
        p = jax.nn.softmax(s, axis=-1)
        return jnp.einsum('bhqk,bhkd->bhqd', p.astype(vh.dtype), vh)

    o = lax.map(block, (qb, cb, jnp.arange(nb)))
    return o.transpose(1, 0, 3, 2, 4).reshape(B, L, H * dh)


def complex_affine_combine(e1, e2):
    a1r, a1i, b1r, b1i = e1
    a2r, a2i, b2r, b2i = e2
    ar = a2r * a1r - a2i * a1i
    ai = a2r * a1i + a2i * a1r
    br = a2r * b1r - a2i * b1i + b2r
    bi = a2r * b1i + a2i * b1r + b2i
    return (ar, ai, br, bi)


def s5_layer(u, a_re, a_im, b_re, b_im, c_re, c_im, d, log_dt, w_glu):
    B, L, _ = u.shape
    uf = u.astype(jnp.float32)
    ug = uf.reshape(B, L, S5_GROUPS, S5_GROUP_CH)
    dt = jnp.exp(log_dt.astype(jnp.float32))[:, None]
    ar = a_re.astype(jnp.float32)
    ai = a_im.astype(jnp.float32)
    mag = jnp.exp(ar * dt)
    lr = mag * jnp.cos(ai * dt)
    li = mag * jnp.sin(ai * dt)
    den = ar * ar + ai * ai
    fr = ((lr - 1.0) * ar + li * ai) / den
    fi = (li * ar - (lr - 1.0) * ai) / den
    br = b_re.astype(jnp.float32)
    bi = b_im.astype(jnp.float32)
    bbr = fr[..., None] * br - fi[..., None] * bi
    bbi = fr[..., None] * bi + fi[..., None] * br
    bu_r = jnp.einsum('gph,blgh->blgp', bbr, ug)
    bu_i = jnp.einsum('gph,blgh->blgp', bbi, ug)
    lr_t = jnp.broadcast_to(lr, bu_r.shape)
    li_t = jnp.broadcast_to(li, bu_r.shape)
    _, _, xr, xi = lax.associative_scan(complex_affine_combine, (lr_t, li_t, bu_r, bu_i), axis=1)
    y = (jnp.einsum('ghp,blgp->blgh', c_re.astype(jnp.float32), xr)
         - jnp.einsum('ghp,blgp->blgh', c_im.astype(jnp.float32), xi))
    y = y.reshape(B, L, D_S5) + d.astype(jnp.float32) * uf
    y = jax.nn.gelu(y)
    y = y * jax.nn.sigmoid(y @ w_glu.astype(jnp.float32))
    return y.astype(u.dtype)


def retention(q, k, v, gn_w):
    B, L, H, dk = q.shape
    dv = v.shape[-1]
    nc = L // CHUNK
    scale = 1.0 / math.sqrt(dk)
    log_gamma = jnp.log1p(-(2.0 ** (-5.0 - jnp.arange(H, dtype=jnp.float32))))

    def chunks(t):
        return t.astype(jnp.float32).reshape(B, nc, CHUNK, H, t.shape[-1]).transpose(1, 0, 3, 2, 4)

    qc, kc, vc = chunks(q), chunks(k), chunks(v)
    pos = jnp.arange(CHUNK, dtype=jnp.float32)
    dmat = jnp.exp(log_gamma[:, None, None] * jnp.abs(pos[:, None] - pos[None, :]))
    scores = jnp.einsum('cbhnd,cbhmd->cbhnm', qc, kc) * scale * dmat
    inner = jnp.einsum('cbhnm,cbhme->cbhne', scores, vc)
    wk = jnp.exp(log_gamma[:, None] * (CHUNK - 1.0 - pos)[None, :])
    wq = jnp.exp(log_gamma[:, None] * (pos + 1.0)[None, :])
    upd = jnp.einsum('cbhmd,cbhme->cbhde', kc * wk[None, None, :, :, None], vc)
    g_chunk = jnp.exp(log_gamma * CHUNK)[:, None, None]

    def step(state, u_i):
        return g_chunk * state + u_i, state

    _, prev_states = lax.scan(step, jnp.zeros((B, H, dk, dv), jnp.float32), upd)
    cross = jnp.einsum('cbhnd,cbhde->cbhne', qc * wq[None, None, :, :, None], prev_states) * scale
    o = (inner + cross).transpose(1, 0, 3, 2, 4).reshape(B, L, H, dv)
    mu = jnp.mean(o, axis=-1, keepdims=True)
    var = jnp.mean(jnp.square(o - mu), axis=-1, keepdims=True)
    o = (o - mu) * lax.rsqrt(var + EPS)
    return (o.reshape(B, L, H * dv) * gn_w.astype(jnp.float32)).astype(v.dtype)


def setup_inputs(seed: int = 0) -> dict:
    key = jax.random.key(seed)
    ks = jax.random.split(key, 17)
    f32 = jnp.float32
    x = jax.random.normal(ks[0], (BATCH, SEQ, D_MODEL), f32)
    norm_w = 1.0 + 0.02 * jax.random.normal(ks[1], (DEPTH, D_MODEL), f32)
    w_in = jax.random.normal(ks[2], (DEPTH, D_MODEL, D_IN_PROJ), f32) * D_MODEL ** -0.5
    fox_b_f = 3.0 + 0.5 * jax.random.normal(ks[3], (DEPTH, FOX_HEADS), f32)
    s5_a_re = -0.5 + 0.01 * jax.random.normal(ks[4], (DEPTH, S5_GROUPS, S5_STATE), f32)
    s5_a_im = (math.pi * jnp.arange(S5_STATE, dtype=f32)[None, None, :]
               + 0.01 * jax.random.normal(ks[5], (DEPTH, S5_GROUPS, S5_STATE), f32))
    s5_b_re = jax.random.normal(ks[6], (DEPTH, S5_GROUPS, S5_STATE, S5_GROUP_CH), f32) * (2 * S5_GROUP_CH) ** -0.5
    s5_b_im = jax.random.normal(ks[7], (DEPTH, S5_GROUPS, S5_STATE, S5_GROUP_CH), f32) * (2 * S5_GROUP_CH) ** -0.5
    s5_c_re = jax.random.normal(ks[8], (DEPTH, S5_GROUPS, S5_GROUP_CH, S5_STATE), f32) * S5_STATE ** -0.5
    s5_c_im = jax.random.normal(ks[9], (DEPTH, S5_GROUPS, S5_GROUP_CH, S5_STATE), f32) * S5_STATE ** -0.5
    s5_d = jax.random.normal(ks[10], (DEPTH, D_S5), f32)
    s5_log_dt = jax.random.uniform(ks[11], (DEPTH, S5_GROUPS), f32, math.log(1e-3), math.log(1e-1))
    s5_w_glu = jax.random.normal(ks[12], (DEPTH, D_S5, D_S5), f32) * D_S5 ** -0.5
    ret_gn_w = 1.0 + 0.02 * jax.random.normal(ks[13], (DEPTH, D_RET), f32)
    w_out = jax.random.normal(ks[14], (DEPTH, D_MIX, D_MODEL), f32) * (0.5 * D_MIX ** -0.5)
    final_norm_w = 1.0 + 0.02 * jax.random.normal(ks[15], (D_MODEL,), f32)
    return {'x': x, 'norm_w': norm_w, 'w_in': w_in, 'fox_b_f': fox_b_f,
            's5_a_re': s5_a_re, 's5_a_im': s5_a_im, 's5_b_re': s5_b_re, 's5_b_im': s5_b_im,
            's5_c_re': s5_c_re, 's5_c_im': s5_c_im, 's5_d': s5_d, 's5_log_dt': s5_log_dt,
            's5_w_glu': s5_w_glu, 'ret_gn_w': ret_gn_w, 'w_out': w_out, 'final_norm_w': final_norm_w}


def reference(x, norm_w, w_in, fox_b_f, s5_a_re, s5_a_im, s5_b_re, s5_b_im,
              s5_c_re, s5_c_im, s5_d, s5_log_dt, s5_w_glu, ret_gn_w, w_out, final_norm_w):
    B, L, _ = x.shape
    for l in range(DEPTH):
        h = rms_norm(x, norm_w[l])
        proj = h @ w_in[l]
        fq, fk, fv, flog, su, rq, rk, rv, gate = split_cols(proj)
        logf = jax.nn.log_sigmoid(flog.astype(jnp.float32) + fox_b_f[l].astype(jnp.float32))
        y_fox = forgetting_attention(fq.reshape(B, L, FOX_HEADS, HEAD_DIM),
                                     fk.reshape(B, L, FOX_HEADS, HEAD_DIM),
                                     fv.reshape(B, L, FOX_HEADS, HEAD_DIM), logf)
        y_s5 = s5_layer(su, s5_a_re[l], s5_a_im[l], s5_b_re[l], s5_b_im[l],
                        s5_c_re[l], s5_c_im[l], s5_d[l], s5_log_dt[l], s5_w_glu[l])
        y_ret = retention(rotary(rq.reshape(B, L, RET_HEADS, HEAD_DIM)),
                          rotary(rk.reshape(B, L, RET_HEADS, HEAD_DIM)),
                          rv.reshape(B, L, RET_HEADS, HEAD_DIM), ret_gn_w[l])
        y = jnp.concatenate([y_fox.astype(x.dtype), y_s5.astype(x.dtype), y_ret.astype(x.dtype)], axis=-1)
        y = y * jax.nn.silu(gate)
        x = x + y @ w_out[l]
    return rms_norm(x, final_norm_w)
```

```cpp
#include <hip/hip_runtime.h>
#include <cstdio>
#include <cstdint>
namespace pg8 {
#define PG8_LAS __attribute__((address_space(3)))
typedef unsigned short bf16_t;
typedef short bf16x8 __attribute__((ext_vector_type(8)));
typedef float f32x4 __attribute__((ext_vector_type(4)));
typedef unsigned u32x4 __attribute__((ext_vector_type(4)));
constexpr int BM = 256, BK = 64, HALF = 128, HTB = HALF * BK * 2  , STAGE_BYTES = 8 * HTB, NXCD = 8, WGM = 8;

__host__ __device__ __forceinline__ int lds_byte(int r, int c) { const int st = (r >> 4) * 2 + (c >> 5), rr = r & 15, cc = c & 31, ob = rr * 64 + cc * 2; return st * 1024 + (ob ^ (((ob >> 9) & 1) << 5)); }
__host__ __device__ __forceinline__ void stage_rc(int b, int& R, int& C) { const int st = b / 1024, sb = b % 1024, swz = sb ^ (((sb >> 9) & 1) << 5); R = (st >> 1) * 16 + swz / 64; C = (st & 1) * 32 + (swz % 64) / 2; }
__host__ __device__ __forceinline__ int perm32(int rho) { const int n = rho >> 4, i = rho & 15; return 8 * (i >> 2) + 4 * n + (i & 3); }

struct Unit { int pm, pn, gz; };
struct Gemm { const bf16_t* A; const bf16_t* Bt; int M, N, K; int lda, ldb; size_t gsA, gsB; };

struct StaticOrder {
    int nM, nN, nwg, G, c;
    __host__ __device__ void init(int M, int N, int G_, int c_) { nM = M / BM; nN = N / BM; nwg = nM * nN; G = G_; c = c_; }
    __host__ __device__ bool next(int i, Unit& u) const {
        const long L = (long)i * G + c; if (L >= nwg) return false;
        int wgid = (int)L; { const int q = nwg / NXCD, r = nwg % NXCD, xcd = wgid % NXCD, off = wgid / NXCD; wgid = (xcd < r ? xcd * (q + 1) : r * (q + 1) + (xcd - r) * q) + off; }
        const int nig = WGM * nN, gid = wgid / nig, fm = gid * WGM, gsz = (nM - fm) < WGM ? (nM - fm) : WGM;
        u.pm = fm + ((wgid % nig) % gsz); u.pn = (wgid % nig) / gsz; u.gz = 0; return true;
    }
    __device__ __forceinline__ void a_ready(const Unit&) const {}
    __device__ __forceinline__ void done(const Unit&) const {}
};

__device__ __forceinline__ unsigned cvt_pk_bf16(float lo, float hi) { unsigned r; asm volatile("v_cvt_pk_bf16_f32 %0, %1, %2" : "=v"(r) : "v"(lo), "v"(hi)); return r; }
typedef float f32x2 __attribute__((ext_vector_type(2)));
__device__ __forceinline__ f32x2 gelu_pk(f32x2 v) {
    const f32x2 av = __builtin_elementwise_abs(v), d = av * 0.2316418882f + 1.0f;
    f32x2 t; t.x = __builtin_amdgcn_rcpf(d.x); t.y = __builtin_amdgcn_rcpf(d.y);
    f32x2 q = t * 0.5307027145f + (-0.7265760135f); q = q * t + 0.7107068705f; q = q * t + (-0.142248368f); q = q * t + 0.127414796f; q = q * t;
    const f32x2 s = (v * v) * (-0.72134752044f);
    f32x2 e; e.x = __builtin_amdgcn_exp2f(s.x); e.y = __builtin_amdgcn_exp2f(s.y);
    const f32x2 m = v * (q * e), r = v - m;
    f32x2 o; o.x = v.x < 0.f ? m.x : r.x; o.y = v.y < 0.f ? m.y : r.y; return o;
}

template <class Epi, class Sched, bool ALIGN_EPI = false, bool SP2 = false>
__device__ __forceinline__ void gemm_phase(PG8_LAS unsigned char* lds, const Gemm g, const Sched& S, const Epi& E) {
    int tid_ = threadIdx.x; asm volatile("" : "+v"(tid_));
    const int tid = tid_, wid = __builtin_amdgcn_readfirstlane(tid >> 6), lane = tid & 63, wr = wid >> 2, wc = wid & 3, fr = lane & 15, fq = lane >> 4;
    const int K = g.K, nt = K / BK;
    unsigned voffA[2], voffB[2];
#pragma unroll
    for (int i = 0; i < 2; ++i) { int R, C; stage_rc(tid * 16 + i * 8192, R, C); const int Rb = Epi::PERM ? ((R & ~31) + perm32(R & 31)) : R;
        voffA[i] = (unsigned)(R * g.lda + C) * 2u; voffB[i] = (unsigned)(Rb * g.ldb + C) * 2u; }
    const size_t kstep = (size_t)(BK * 2);
    const size_t hstepA = (size_t)HALF * g.lda * 2, hstepB = (size_t)HALF * g.ldb * 2;
    const size_t tstepA = 2 * hstepA, tstepB = 2 * hstepB;
    const unsigned ldsw = (unsigned)wid * 1024u;
    const int aoff = lds_byte(wr * 64 + fr, fq * 8), boff = lds_byte(wc * 32 + fr, fq * 8);
#define PG8_SA(b, h) (((b) * 2 + (h)) * HTB)
#define PG8_SB(b, h) ((4 + (b) * 2 + (h)) * HTB)
#define PG8_STAGE(bufoff, gbase, voff) do { _Pragma("unroll") for (int _i = 0; _i < 2; ++_i) \
        __builtin_amdgcn_global_load_lds((const unsigned*)((const char*)(gbase) + (voff)[_i]), (PG8_LAS unsigned*)(lds + (bufoff) + ldsw + _i * 8192), 16, 0, 0); } while (0)
#define PG8_LDA(dst, b, h) do { _Pragma("unroll") for (int m = 0; m < 4; ++m) _Pragma("unroll") for (int k = 0; k < 2; ++k) dst[m][k] = *(const PG8_LAS bf16x8*)(lds + PG8_SA(b, h) + aoff + m * 2048 + k * 1024); } while (0)
#define PG8_LDB(dst, b, h) do { _Pragma("unroll") for (int n = 0; n < 2; ++n) _Pragma("unroll") for (int k = 0; k < 2; ++k) dst[n][k] = *(const PG8_LAS bf16x8*)(lds + PG8_SB(b, h) + boff + n * 2048 + k * 1024); } while (0)
#define PG8_MMA(ai, bj, At, Bt) do { __builtin_amdgcn_s_setprio(1); _Pragma("unroll") for (int m = 0; m < 4; ++m) _Pragma("unroll") for (int n = 0; n < 2; ++n) _Pragma("unroll") for (int k = 0; k < 2; ++k) \
        acc[ai][bj][m][n] = __builtin_amdgcn_mfma_f32_16x16x32_bf16(Bt[n][k], At[m][k], acc[ai][bj][m][n], 0, 0, 0); __builtin_amdgcn_s_setprio(0); } while (0)
#define PG8_WAIT_V(n) asm volatile("s_waitcnt vmcnt(" #n ")" ::: "memory")
#define PG8_WAIT_L(n) asm volatile("s_waitcnt lgkmcnt(" #n ")" ::: "memory")
#define PG8_BAR __builtin_amdgcn_s_barrier()
#define PG8_SCHED __builtin_amdgcn_sched_barrier(0)
    Unit cur, nxt; int ui = 0;
    if (!S.next(0, cur)) return;
    f32x4 acc[2][2][4][2];
#pragma unroll
    for (int a = 0; a < 2; ++a)
#pragma unroll
        for (int b = 0; b < 2; ++b)
#pragma unroll
            for (int m = 0; m < 4; ++m)
#pragma unroll
                for (int n = 0; n < 2; ++n) acc[a][b][m][n] = (f32x4){0.f, 0.f, 0.f, 0.f};
    bf16x8 At[4][2], B0[2][2], B1[2][2];
    const char* cA = (const char*)g.A + (size_t)cur.gz * g.gsA * 2 + (size_t)cur.pm * tstepA; const char* cB = (const char*)g.Bt + (size_t)cur.gz * g.gsB * 2 + (size_t)cur.pn * tstepB;
    S.a_ready(cur);
    if constexpr (SP2) {
        PG8_STAGE(PG8_SB(0, 0), cB, voffB); PG8_STAGE(PG8_SB(0, 1), cB + hstepB, voffB); PG8_STAGE(PG8_SA(0, 0), cA, voffA); PG8_STAGE(PG8_SA(0, 1), cA + hstepA, voffA);
        if (wr == 1) PG8_BAR;
        PG8_WAIT_V(2); PG8_BAR;
        PG8_STAGE(PG8_SB(1, 0), cB + kstep, voffB); PG8_STAGE(PG8_SA(1, 0), cA + kstep, voffA); PG8_STAGE(PG8_SB(1, 1), cB + hstepB + kstep, voffB);
        PG8_WAIT_V(6); PG8_BAR;
    } else {
        PG8_STAGE(PG8_SB(0, 0), cB, voffB); PG8_STAGE(PG8_SA(0, 0), cA, voffA); PG8_STAGE(PG8_SB(0, 1), cB + hstepB, voffB); PG8_STAGE(PG8_SA(0, 1), cA + hstepA, voffA);
        if (wr == 1) PG8_BAR;
        PG8_WAIT_V(4); PG8_BAR;
        PG8_STAGE(PG8_SB(1, 0), cB + kstep, voffB); PG8_STAGE(PG8_SA(1, 0), cA + kstep, voffA); PG8_STAGE(PG8_SB(1, 1), cB + hstepB + kstep, voffB);
        PG8_WAIT_V(6); PG8_BAR;
    }
    for (;;) {
        const bool has_next = S.next(ui + 1, nxt);
        const char* nA = has_next ? (const char*)g.A + (size_t)nxt.gz * g.gsA * 2 + (size_t)nxt.pm * tstepA : cA; const char* nB = has_next ? (const char*)g.Bt + (size_t)nxt.gz * g.gsB * 2 + (size_t)nxt.pn * tstepB : cB;
        for (int t = 0; t < nt; t += 2) {
            const bool last = (t == nt - 2);
            const char* a1 = cA + (size_t)(t + 1) * kstep;
            const char* a2 = last ? nA : cA + (size_t)(t + 2) * kstep; const char* b2 = last ? nB : cB + (size_t)(t + 2) * kstep;
            const char* a3 = a2 + kstep; const char* b3 = b2 + kstep;
            if (last && has_next) S.a_ready(nxt);
            if constexpr (SP2) {
            PG8_LDB(B0, 0, 0); PG8_LDB(B1, 0, 1); PG8_SCHED; PG8_LDA(At, 0, 0); PG8_STAGE(PG8_SA(1, 1), a1 + hstepA, voffA);
            PG8_WAIT_V(8); PG8_WAIT_L(0); PG8_BAR; PG8_MMA(0, 0, At, B0); PG8_MMA(0, 1, At, B1); PG8_BAR; PG8_SCHED;
            PG8_LDA(At, 0, 1); PG8_STAGE(PG8_SB(0, 0), b2, voffB); PG8_STAGE(PG8_SB(0, 1), b2 + hstepB, voffB); PG8_STAGE(PG8_SA(0, 0), a2, voffA);
            PG8_WAIT_V(8); PG8_WAIT_L(0); PG8_BAR; PG8_MMA(1, 0, At, B0); PG8_MMA(1, 1, At, B1); PG8_BAR; PG8_SCHED;
            PG8_LDB(B0, 1, 0); PG8_LDB(B1, 1, 1); PG8_SCHED; PG8_LDA(At, 1, 0); PG8_STAGE(PG8_SA(0, 1), a2 + hstepA, voffA);
            PG8_WAIT_V(8); PG8_WAIT_L(0); PG8_BAR; PG8_MMA(0, 0, At, B0); PG8_MMA(0, 1, At, B1); PG8_BAR; PG8_SCHED;
            PG8_LDA(At, 1, 1); PG8_STAGE(PG8_SB(1, 0), b3, voffB); PG8_STAGE(PG8_SB(1, 1), b3 + hstepB, voffB); PG8_STAGE(PG8_SA(1, 0), a3, voffA);
            PG8_WAIT_V(8); PG8_WAIT_L(0); PG8_BAR; PG8_MMA(1, 0, At, B0); PG8_MMA(1, 1, At, B1); PG8_BAR; PG8_SCHED;
            } else {
            PG8_LDB(B0, 0, 0); PG8_SCHED; PG8_LDA(At, 0, 0); PG8_STAGE(PG8_SA(1, 1), a1 + hstepA, voffA);
            PG8_WAIT_L(8); PG8_BAR; PG8_WAIT_L(0); PG8_MMA(0, 0, At, B0); PG8_BAR; PG8_SCHED;
            PG8_LDB(B1, 0, 1); PG8_STAGE(PG8_SB(0, 0), b2, voffB);
            PG8_BAR; PG8_WAIT_L(0); PG8_MMA(0, 1, At, B1); PG8_BAR;
            PG8_LDA(At, 0, 1); PG8_STAGE(PG8_SA(0, 0), a2, voffA);
            PG8_BAR; PG8_WAIT_L(0); PG8_MMA(1, 0, At, B0); PG8_BAR; PG8_SCHED;
            PG8_STAGE(PG8_SB(0, 1), b2 + hstepB, voffB);
            PG8_WAIT_V(6); PG8_BAR; PG8_MMA(1, 1, At, B1); PG8_BAR;
            PG8_LDB(B0, 1, 0); PG8_SCHED; PG8_LDA(At, 1, 0); PG8_STAGE(PG8_SA(0, 1), a2 + hstepA, voffA);
            PG8_WAIT_L(8); PG8_BAR; PG8_WAIT_L(0); PG8_MMA(0, 0, At, B0); PG8_BAR; PG8_SCHED;
            PG8_LDB(B1, 1, 1); PG8_STAGE(PG8_SB(1, 0), b3, voffB);
            PG8_BAR; PG8_WAIT_L(0); PG8_MMA(0, 1, At, B1); PG8_BAR;
            PG8_LDA(At, 1, 1); PG8_STAGE(PG8_SA(1, 0), a3, voffA);
            PG8_BAR; PG8_WAIT_L(0); PG8_MMA(1, 0, At, B0); PG8_BAR; PG8_SCHED;
            PG8_STAGE(PG8_SB(1, 1), b3 + hstepB, voffB);
            PG8_WAIT_V(6); PG8_BAR; PG8_MMA(1, 1, At, B1); PG8_BAR;
            }
        }
        if constexpr (ALIGN_EPI) { if (wr == 0) PG8_BAR; }
        if constexpr (!Epi::AFTER_DRAIN) { E(acc, cur, wr, wc, fr, fq); S.done(cur); }
        if (!has_next) break;
#pragma unroll
        for (int a = 0; a < 2; ++a)
#pragma unroll
            for (int b = 0; b < 2; ++b)
#pragma unroll
                for (int m = 0; m < 4; ++m)
#pragma unroll
                    for (int n = 0; n < 2; ++n) acc[a][b][m][n] = (f32x4){0.f, 0.f, 0.f, 0.f};
        cur = nxt; cA = nA; cB = nB; ++ui;
        if constexpr (ALIGN_EPI) { if (wr == 1) PG8_BAR; }
    }
    PG8_WAIT_V(0);
    if constexpr (!ALIGN_EPI) { if (wr == 0) PG8_BAR; }
    PG8_BAR;
    if constexpr (Epi::AFTER_DRAIN) { E.fused(acc, cur, wr, wc, fr, fq, lds, wid, lane); S.done(cur); }
#undef PG8_SA
#undef PG8_SB
#undef PG8_STAGE
#undef PG8_LDA
#undef PG8_LDB
#undef PG8_MMA
#undef PG8_WAIT_V
#undef PG8_WAIT_L
#undef PG8_BAR
#undef PG8_SCHED
}
}
#include <hip/hip_bf16.h>
#include <cmath>
namespace attn_body {
using bf16=__hip_bfloat16;
using bf16x8=__attribute__((ext_vector_type(8)))short;
using s16x4=__attribute__((ext_vector_type(4)))short;
using f32x16=__attribute__((ext_vector_type(16)))float;
using u32x4=__attribute__((ext_vector_type(4)))unsigned;
using f32x4=__attribute__((ext_vector_type(4)))float;
constexpr int BATCH=4,NHEAD=8,SEQ=4096,D=64,DM=NHEAD*D,OPITCH=1024;
constexpr int NW=8,QBLK=32,QB=QBLK*NW,KVBLK=64,NQB=SEQ/QB;
constexpr int ATTN_PITCH=DM, ATTN_UNIT_ROWS=QB;
__device__ __forceinline__ int crow(int r,int hi){return (r&3)+8*(r>>2)+4*hi;}
#define SBAR() __builtin_amdgcn_sched_barrier(0)
__device__ __forceinline__ void cmask(f32x16&p0,f32x16&p1,int jb,int qrel,int hi){
  const float NEG=-INFINITY; int kb=64*jb+4*hi;
  #pragma unroll
  for(int r=0;r<16;++r){int kv=kb+(r&3)+8*(r>>2); if(kv>qrel)p0[r]=NEG; if(kv+32>qrel)p1[r]=NEG;}
}

constexpr int NSLOT=3, SLOTB=8192;
constexpr int LDS_K=0, LDS_V=NSLOT*SLOTB, LDS_WS=2*NSLOT*SLOTB, LDS_OST=LDS_WS+NW*64*4, LDS_CB=LDS_OST+NW*4096, LDS_BYTES=LDS_CB+SEQ*4;
constexpr float C2=0.125f*1.4426950408889634f;
__device__ __forceinline__ void glds16(const void*gsrc,unsigned lds_dst){unsigned keep;
  asm volatile("s_mov_b32 %0, m0\n\ts_mov_b32 m0, %2\n\ts_nop 0\n\tglobal_load_lds_dwordx4 %1, off\n\ts_mov_b32 m0, %0":"=&s"(keep):"v"(gsrc),"s"(lds_dst):"memory");}
__device__ __forceinline__ float max3f(float a,float b,float c){float r;asm("v_max3_f32 %0, %1, %2, %3":"=v"(r):"v"(a),"v"(b),"v"(c));return r;}
__device__ __forceinline__ float max2f(float a,float b){float r;asm("v_max_f32_e32 %0, %1, %2":"=v"(r):"v"(a),"v"(b));return r;}
__device__ __forceinline__ float fadd_s(float a,float b){float r;asm("v_add_f32_e32 %0, %1, %2":"=v"(r):"v"(a),"v"(b));return r;}
__device__ __forceinline__ float fsub_s(float a,float b){float r;asm("v_sub_f32_e32 %0, %1, %2":"=v"(r):"v"(a),"v"(b));return r;}
typedef float f32x2_t __attribute__((ext_vector_type(2))); typedef __bf16 bf16x2_t __attribute__((ext_vector_type(2)));
__device__ __forceinline__ unsigned cvtpk_s(float lo,float hi){f32x2_t v={lo,hi};bf16x2_t b=__builtin_convertvector(v,bf16x2_t);return __builtin_bit_cast(unsigned,b);}
#define WAIT_BAR(N) asm volatile("s_waitcnt vmcnt(" #N ") lgkmcnt(0)\n\ts_barrier":::"memory")

__device__ __forceinline__ void qkt(f32x16&p0,f32x16&p1,const char*Kslot,const bf16x8*qr,const char*cbt,int r32,int hi){
  const char*kb=Kslot+hi*1024+r32*16;
  #pragma unroll
  for(int a=0;a<4;++a){ const f32x4 u0=*reinterpret_cast<const f32x4*>(cbt+hi*16+a*32), u1=*reinterpret_cast<const f32x4*>(cbt+128+hi*16+a*32);
    p0[4*a]=u0[0];p0[4*a+1]=u0[1];p0[4*a+2]=u0[2];p0[4*a+3]=u0[3]; p1[4*a]=u1[0];p1[4*a+1]=u1[1];p1[4*a+2]=u1[2];p1[4*a+3]=u1[3]; }
  #pragma unroll
  for(int d0=0;d0<4;++d0){
    const bf16x8 b0=*reinterpret_cast<const bf16x8*>(kb+d0*2048);
    const bf16x8 b1=*reinterpret_cast<const bf16x8*>(kb+d0*2048+512);
    p0=__builtin_amdgcn_mfma_f32_32x32x16_bf16(b0,qr[d0],p0,0,0,0);p1=__builtin_amdgcn_mfma_f32_32x32x16_bf16(b1,qr[d0],p1,0,0,0);}
}
typedef __attribute__((address_space(3))) const char* lds_cptr;
typedef short v4i16_t __attribute__((ext_vector_type(4)));
__device__ __forceinline__ void kload8(bf16x8*kf,lds_cptr kp){
  kf[0]=*(const __attribute__((address_space(3))) bf16x8*)(kp);      kf[1]=*(const __attribute__((address_space(3))) bf16x8*)(kp+512);
  kf[2]=*(const __attribute__((address_space(3))) bf16x8*)(kp+2048); kf[3]=*(const __attribute__((address_space(3))) bf16x8*)(kp+2560);
  kf[4]=*(const __attribute__((address_space(3))) bf16x8*)(kp+4096); kf[5]=*(const __attribute__((address_space(3))) bf16x8*)(kp+4608);
  kf[6]=*(const __attribute__((address_space(3))) bf16x8*)(kp+6144); kf[7]=*(const __attribute__((address_space(3))) bf16x8*)(kp+6656);
}
__device__ __forceinline__ void kload2(bf16x8*kf,lds_cptr kp,int j){ kf[2*j]=*(const __attribute__((address_space(3))) bf16x8*)(kp+j*2048); kf[2*j+1]=*(const __attribute__((address_space(3))) bf16x8*)(kp+j*2048+512); }
__device__ __forceinline__ s16x4 vtr(lds_cptr p){ return __builtin_bit_cast(s16x4,__builtin_amdgcn_ds_read_tr16_b64_v4i16((__attribute__((address_space(3))) v4i16_t*)p)); }
__device__ __forceinline__ float rowmax(const f32x16&p0,const f32x16&p1){
  float a=max3f(p0[0],p0[1],p1[0]),b=max3f(p0[2],p0[3],p1[1]);a=max3f(a,p1[2],p1[3]);
  #pragma unroll
  for(int r=4;r<16;r+=4){a=max3f(a,p0[r],p0[r+1]);b=max3f(b,p0[r+2],p0[r+3]);a=max3f(a,p1[r],p1[r+1]);b=max3f(b,p1[r+2],p1[r+3]);}
  const float m=max2f(a,b);
  auto rr=__builtin_amdgcn_permlane32_swap(__float_as_uint(m),__float_as_uint(m),false,false);
  return max2f(__uint_as_float(rr[0]),__uint_as_float(rr[1]));
}
__device__ __forceinline__ void pv(f32x16*o,int vb,bf16x8 pa0,bf16x8 pa1,bf16x8 pa2,bf16x8 pa3){
  #pragma unroll
  for(int d0=0;d0<2;++d0){s16x4 lo[4],hi[4];
    #pragma unroll
    for(int ks=0;ks<4;++ks){
      asm volatile("ds_read_b64_tr_b16 %0,%1 offset:%c2":"=&v"(lo[ks]):"v"(vb),"i"(d0*4096+ks*1024):"memory");
      asm volatile("ds_read_b64_tr_b16 %0,%1 offset:%c2":"=&v"(hi[ks]):"v"(vb),"i"(d0*4096+ks*1024+512):"memory");}
    asm volatile("s_waitcnt lgkmcnt(0)":::"memory");SBAR();
    #define PK(k) (bf16x8){lo[k][0],lo[k][1],lo[k][2],lo[k][3],hi[k][0],hi[k][1],hi[k][2],hi[k][3]}
    o[d0]=__builtin_amdgcn_mfma_f32_32x32x16_bf16(pa0,PK(0),o[d0],0,0,0);
    o[d0]=__builtin_amdgcn_mfma_f32_32x32x16_bf16(pa1,PK(1),o[d0],0,0,0);
    o[d0]=__builtin_amdgcn_mfma_f32_32x32x16_bf16(pa2,PK(2),o[d0],0,0,0);
    o[d0]=__builtin_amdgcn_mfma_f32_32x32x16_bf16(pa3,PK(3),o[d0],0,0,0);
    #undef PK
  }
}

#ifndef ATTN_STORE16
#define ATTN_STORE16(p,v) (*(u32x4*)(p)=(v))
#endif
template<int THRL> __device__ __forceinline__ void attn_unit(int b,int h,int qb,const bf16*Q,const bf16*__restrict__ K,const bf16*__restrict__ V,bf16*O,const float*__restrict__ CB,char*shm){
  int tid_=threadIdx.x; asm volatile("":"+v"(tid_)); const int tid=tid_,lane=tid&63,r32=lane&31,hi=lane>>5; const int wid=__builtin_amdgcn_readfirstlane(tid>>6);
  const long rowbase=(long)b*SEQ; const int q0=qb*QB;
  const bf16*Qw=Q+(rowbase+q0+wid*QBLK)*DM+h*D;
  const bf16*Kh=K+rowbase*DM+h*D,*Vh=V+rowbase*DM+h*D;
  const unsigned lds0=(unsigned)(uintptr_t)shm;
  float*wsf=(float*)(shm+LDS_WS)+wid*64;
  const bf16*ksrc=Kh+(long)lane*DM+wid*8;
  const bf16*vsrc=Vh+(long)(16*(wid&3)+(lane>>2))*DM+(wid>>2)*32+(lane&3)*8;
  const unsigned kdst=lds0+LDS_K+wid*1024, vdst=lds0+LDS_V+wid*1024;
  #define DMA_K(t,slot) glds16(ksrc+(long)(t)*KVBLK*DM,(unsigned)__builtin_amdgcn_readfirstlane(kdst+(slot)))
  #define DMA_V(t,slot) glds16(vsrc+(long)(t)*KVBLK*DM,(unsigned)__builtin_amdgcn_readfirstlane(vdst+(slot)))
  const int vb0=(int)(lds0+LDS_V)+((lane>>4)&1)*32+(lane&3)*8+(4*hi+((lane&15)>>2))*64;
  const char*Kbase=shm+LDS_K; bf16x8 kf[8];
  const lds_cptr shm3=(lds_cptr)shm; const lds_cptr kp0=shm3+LDS_K+hi*1024+r32*16; const lds_cptr vp0=shm3+LDS_V+((lane>>4)&1)*32+(lane&3)*8+(4*hi+((lane&15)>>2))*64;
  const int NT=(q0+QB)/KVBLK;
  { const f32x4* cbg=reinterpret_cast<const f32x4*>(CB+(long)(b*NHEAD+h)*SEQ); f32x4* cbl=reinterpret_cast<f32x4*>(shm+LDS_CB); const int nv=(q0+QB)/4;
    for(int i=tid;i<nv;i+=NW*64) cbl[i]=cbg[i];
    asm volatile("s_waitcnt vmcnt(0) lgkmcnt(0)\n\ts_barrier":::"memory"); }
  const lds_cptr cb3=(lds_cptr)shm+LDS_CB;
  DMA_K(0,0);DMA_V(0,0);DMA_K(1,SLOTB);
  bf16x8 qr[4];
  #pragma unroll
  for(int d0=0;d0<4;++d0)qr[d0]=*reinterpret_cast<const bf16x8*>(&Qw[(long)r32*DM+d0*16+hi*8]);
  float mhat=0.f,l_reg=0.f;f32x16 o[2];o[0]=f32x16{};o[1]=f32x16{};
  const int qrel=wid*QBLK+r32;
  #define CMASK(P0,P1,t) do{int jb_=(t)-(NT-4); if(jb_>=0)cmask(P0,P1,jb_,qrel,hi);}while(0)
  bool resc=false;
  #define START(P0,P1) do{ const float rm=rowmax(P0,P1); resc=false; \
    { const float dl=rm; mhat=fadd_s(mhat,dl); \
      _Pragma("unroll") for(int r=0;r<16;++r){P0[r]=fsub_s(P0[r],dl);P1[r]=fsub_s(P1[r],dl);} } \
    _Pragma("unroll") for(int r=0;r<16;++r)P0[r]=__builtin_amdgcn_exp2f(P0[r]); }while(0)
  #define RESC() do{ if(resc){ asm volatile("s_waitcnt lgkmcnt(0)":::"memory"); \
      _Pragma("unroll") for(int d_=0;d_<2;++d_) _Pragma("unroll") for(int r=0;r<16;++r)o[d_][r]*=wsf[crow(r,hi)]; } }while(0)
  f32x16 pA0,pA1,pB0,pB1;
  int sl_prev=0,sl_cur=0,sl_next=SLOTB;
  #define ROT() do{sl_prev=sl_cur;sl_cur=sl_next;sl_next=(sl_next==(NSLOT-1)*SLOTB)?0:sl_next+SLOTB;}while(0)
  DMA_K(2,2*SLOTB);
  WAIT_BAR(3);
  qkt(pA0,pA1,Kbase,qr,shm+LDS_CB,r32,hi);asm volatile("s_nop 15\n\ts_nop 7":"+v"(pA0),"+v"(pA1));CMASK(pA0,pA1,0);
  START(pA0,pA1);
  _Pragma("unroll") for(int r=0;r<16;++r)pA1[r]=__builtin_amdgcn_exp2f(pA1[r]);
  WAIT_BAR(0);
  DMA_K(3,0);DMA_V(1,SLOTB);
  ROT();
  kload8(kf,kp0+sl_cur);
  WAIT_BAR(2);
  s16x4 vlo[8],vhi[8]; u32x4 pw0,pw1,pw2,pw3;
  #define PKW(P,B) cvtpk_s(P[B],P[B+1])
  #define PAF(k) __builtin_bit_cast(bf16x8,pw##k)
  #define VFR(i) (bf16x8){vlo[i][0],vlo[i][1],vlo[i][2],vlo[i][3],vhi[i][0],vhi[i][1],vhi[i][2],vhi[i][3]}
  #define PIN(x) asm volatile("":"+v"(x))
  #define MX3(a,b,c) __builtin_fmaxf(__builtin_fmaxf((a),(b)),(c))
  #define GAPA(MF,A0,A1,A2,A3,W0,W1,PW) do{ MF; sacc+=A0; sacc+=A1; sacc+=A2; sacc+=A3; PIN(sacc); W0; W1; PIN(PW); SBAR(); }while(0)
  #define EX(v) __builtin_amdgcn_exp2f(v)
  #define GAPB(MF,X,B) do{ MF; X[B]=EX(X[B]); X[B+1]=EX(X[B+1]); X[B+2]=EX(X[B+2]); X[B+3]=EX(X[B+3]); PIN(X); SBAR(); }while(0)
  #define VRD(i) do{ vlo[i]=vtr(vp_+(((i)>>2)*4096+((i)&3)*1024)); vhi[i]=vtr(vp_+(((i)>>2)*4096+((i)&3)*1024+512)); }while(0)
  #define KRD(G,j) do{ if(G){ kload2(kf,kp0+sl_next,j); SBAR(); } }while(0)
  #define STEP(C0,C1,P0,P1,t,GK,GV,GL) do{ SBAR(); \
    { const __attribute__((address_space(3))) f32x4* cbp_=(const __attribute__((address_space(3))) f32x4*)(cb3+(t)*256+hi*16); \
      _Pragma("unroll") for(int a_=0;a_<4;++a_){ const f32x4 u0_=cbp_[2*a_], u1_=cbp_[8+2*a_]; \
        C0[4*a_]=u0_[0]-mhat;C0[4*a_+1]=u0_[1]-mhat;C0[4*a_+2]=u0_[2]-mhat;C0[4*a_+3]=u0_[3]-mhat; \
        C1[4*a_]=u1_[0]-mhat;C1[4*a_+1]=u1_[1]-mhat;C1[4*a_+2]=u1_[2]-mhat;C1[4*a_+3]=u1_[3]-mhat; } } SBAR(); \
    const lds_cptr vp_=vp0+sl_prev; \
    VRD(0); SBAR(); float sacc=(P0[0]+P0[1]); \
    GAPA(C0=__builtin_amdgcn_mfma_f32_32x32x16_bf16(kf[0],qr[0],C0,0,0,0), P0[2],P0[3],P0[4],P0[5],     pw0[0]=PKW(P0,0), pw0[1]=PKW(P0,2), pw0); \
    VRD(4); SBAR(); GAPA(C1=__builtin_amdgcn_mfma_f32_32x32x16_bf16(kf[1],qr[0],C1,0,0,0), P0[6],P0[7],P0[8],P0[9],     pw0[2]=PKW(P0,4), pw0[3]=PKW(P0,6), pw0); \
    VRD(1); SBAR(); GAPA(C0=__builtin_amdgcn_mfma_f32_32x32x16_bf16(kf[2],qr[1],C0,0,0,0),   P0[10],P0[11],P0[12],P0[13], pw1[0]=PKW(P0,8), pw1[1]=PKW(P0,10), pw1); \
    VRD(5); SBAR(); GAPA(C1=__builtin_amdgcn_mfma_f32_32x32x16_bf16(kf[3],qr[1],C1,0,0,0),   P0[14],P0[15],P1[0],P1[1],   pw1[2]=PKW(P0,12),pw1[3]=PKW(P0,14), pw1); \
    VRD(2); SBAR(); GAPA(C0=__builtin_amdgcn_mfma_f32_32x32x16_bf16(kf[4],qr[2],C0,0,0,0),   P1[2],P1[3],P1[4],P1[5],     pw2[0]=PKW(P1,0), pw2[1]=PKW(P1,2), pw2); \
    VRD(6); SBAR(); GAPA(C1=__builtin_amdgcn_mfma_f32_32x32x16_bf16(kf[5],qr[2],C1,0,0,0),   P1[6],P1[7],P1[8],P1[9],     pw2[2]=PKW(P1,4), pw2[3]=PKW(P1,6), pw2); \
    VRD(3); SBAR(); GAPA(C0=__builtin_amdgcn_mfma_f32_32x32x16_bf16(kf[6],qr[3],C0,0,0,0),   P1[10],P1[11],P1[12],P1[13], pw3[0]=PKW(P1,8), pw3[1]=PKW(P1,10), pw3); \
    VRD(7); SBAR(); GAPA(C1=__builtin_amdgcn_mfma_f32_32x32x16_bf16(kf[7],qr[3],C1,0,0,0),   P1[14],P1[15],0.f,0.f,       pw3[2]=PKW(P1,12),pw3[3]=PKW(P1,14), pw3); \
    l_reg+=sacc; \
    if(GK){DMA_K((t)+3,sl_cur);} if(GV){DMA_V((t)+1,sl_next);} \
    CMASK(C0,C1,t); \
    { float a=MX3(C0[0],C0[1],C1[0]),b=MX3(C0[2],C0[3],C1[1]); a=MX3(a,C1[2],C1[3]); \
      _Pragma("unroll") for(int r=4;r<16;r+=4){a=MX3(a,C0[r],C0[r+1]);b=MX3(b,C0[r+2],C0[r+3]);a=MX3(a,C1[r],C1[r+1]);b=MX3(b,C1[r+2],C1[r+3]);} \
      float rm=__builtin_fmaxf(a,b); { auto rr=__builtin_amdgcn_permlane32_swap(__float_as_uint(rm),__float_as_uint(rm),false,false); rm=__builtin_fmaxf(__uint_as_float(rr[0]),__uint_as_float(rr[1])); } \
      resc=false; \
      if(__builtin_expect(__any(rm>(float)THRL),0)){ const float dl=__builtin_fmaxf(rm,0.f); mhat+=dl; \
        _Pragma("unroll") for(int r=0;r<16;++r){C0[r]-=dl;C1[r]-=dl;} \
        const float f=__builtin_amdgcn_exp2f(-dl); l_reg*=f; if(hi==0)wsf[r32]=f; resc=true; } } \
    SBAR(); \
    GAPB(o[0]=__builtin_amdgcn_mfma_f32_32x32x16_bf16(PAF(0),VFR(0),o[0],0,0,0), C0,0); \
    GAPB(o[1]=__builtin_amdgcn_mfma_f32_32x32x16_bf16(PAF(0),VFR(4),o[1],0,0,0), C0,4); \
    KRD(GL,0); GAPB(o[0]=__builtin_amdgcn_mfma_f32_32x32x16_bf16(PAF(1),VFR(1),o[0],0,0,0), C0,8); \
    KRD(GL,1); GAPB(o[1]=__builtin_amdgcn_mfma_f32_32x32x16_bf16(PAF(1),VFR(5),o[1],0,0,0), C0,12); \
    KRD(GL,2); GAPB(o[0]=__builtin_amdgcn_mfma_f32_32x32x16_bf16(PAF(2),VFR(2),o[0],0,0,0), C1,0); \
    KRD(GL,3); GAPB(o[1]=__builtin_amdgcn_mfma_f32_32x32x16_bf16(PAF(2),VFR(6),o[1],0,0,0), C1,4); \
    GAPB(o[0]=__builtin_amdgcn_mfma_f32_32x32x16_bf16(PAF(3),VFR(3),o[0],0,0,0), C1,8); \
    GAPB(o[1]=__builtin_amdgcn_mfma_f32_32x32x16_bf16(PAF(3),VFR(7),o[1],0,0,0), C1,12); \
    }while(0)
  int t=1;
  #undef CMASK
  #define CMASK(P0,P1,t) do{}while(0)
  for(;t+5<NT;t+=2){
    STEP(pB0,pB1,pA0,pA1,t,true,true,true);     WAIT_BAR(2); RESC(); ROT();
    STEP(pA0,pA1,pB0,pB1,t+1,true,true,true);   WAIT_BAR(2); RESC(); ROT();
  }
  #undef CMASK
  #define CMASK(P0,P1,t) do{int jb_=(t)-(NT-4); if(jb_>=0)cmask(P0,P1,jb_,qrel,hi);}while(0)
  #define ENDW(tt) do{ if((tt)+3<NT){WAIT_BAR(2);} else if((tt)+2<NT){WAIT_BAR(1);} else {WAIT_BAR(0);} }while(0)
  for(;t+1<NT;t+=2){
    STEP(pB0,pB1,pA0,pA1,t,(t+3<NT),(t+1<NT),(t+1<NT));       ENDW(t);   RESC(); ROT();
    STEP(pA0,pA1,pB0,pB1,t+1,(t+4<NT),(t+2<NT),(t+2<NT));     ENDW(t+1); RESC(); ROT();
  }
  STEP(pB0,pB1,pA0,pA1,NT-1,false,false,false); RESC();
  { float sacc=pB0[0]+pB0[1]; _Pragma("unroll") for(int r=2;r<16;++r)sacc+=pB0[r]; _Pragma("unroll") for(int r=0;r<16;++r)sacc+=pB1[r]; l_reg+=sacc;
    pw0=(u32x4){PKW(pB0,0),PKW(pB0,2),PKW(pB0,4),PKW(pB0,6)};pw1=(u32x4){PKW(pB0,8),PKW(pB0,10),PKW(pB0,12),PKW(pB0,14)};pw2=(u32x4){PKW(pB1,0),PKW(pB1,2),PKW(pB1,4),PKW(pB1,6)};pw3=(u32x4){PKW(pB1,8),PKW(pB1,10),PKW(pB1,12),PKW(pB1,14)};
    SBAR(); pv(o,vb0+sl_cur,PAF(0),PAF(1),PAF(2),PAF(3)); }
  #undef PKW
  #undef PAF
  #undef VFR
  #undef PIN
  #undef MX3
  #undef GAPA
  #undef GAPB
  #undef EX
  #undef VRD
  #undef KRD
  #undef STEP
  #undef ENDW
  {auto rr=__builtin_amdgcn_permlane32_swap(__float_as_uint(l_reg),__float_as_uint(l_reg),false,false);l_reg=__uint_as_float(rr[0])+__uint_as_float(rr[1]);}
  if(hi==0)wsf[32+r32]=l_reg;asm volatile("s_waitcnt lgkmcnt(0)":::"memory");
  float rli[16];
  #pragma unroll
  for(int r=0;r<16;++r)rli[r]=__builtin_amdgcn_rcpf(wsf[32+crow(r,hi)]);
  bf16*Ow=O+(rowbase+q0+wid*QBLK)*OPITCH+h*D;
  { bf16*stg=(bf16*)(shm+LDS_OST)+wid*2048;
    #pragma unroll
    for(int r=0;r<16;++r){const int orow=crow(r,hi);
      #pragma unroll
      for(int d0=0;d0<2;++d0)stg[orow*64+d0*32+r32]=__float2bfloat16(o[d0][r]*rli[r]);}
    asm volatile("s_waitcnt lgkmcnt(0)":::"memory");
    #pragma unroll
    for(int i=0;i<4;++i){const int row=i*8+(lane>>3),ch=lane&7; const u32x4 v=*(const u32x4*)(stg+row*64+ch*8); bf16*dst=Ow+(long)row*OPITCH+ch*8; const u32x4 gv=*(const u32x4*)dst; u32x4 w;
      #pragma unroll
      for(int j=0;j<4;++j){ const float a0=__uint_as_float(v[j]<<16)*__uint_as_float(gv[j]<<16), a1=__uint_as_float(v[j]&0xffff0000u)*__uint_as_float(gv[j]&0xffff0000u); w[j]=cvtpk_s(a0,a1); }
      *(u32x4*)dst=w;} }
  asm volatile("s_waitcnt lgkmcnt(0)\n\ts_barrier":::"memory");
  #undef DMA_K
  #undef DMA_V
  #undef CMASK
  #undef START
  #undef RESC
  #undef ROT
}
constexpr int ATTN_LDS_BYTES=LDS_BYTES;
struct AttnTensors { const bf16* Q; const bf16* K; const bf16* V; bf16* O; const float* CB; };
struct AttnUnit { int bh; int qb; };
struct StaticOrder {
  int vcu;
  __device__ __forceinline__ explicit StaticOrder(int grid,int block):vcu((block%8)*(grid/8)+block/8){}
  __device__ __forceinline__ bool next(int i,AttnUnit&u)const{ if(i>=2)return false; const int s=vcu&7; u.bh=vcu>>3; u.qb=(i==0)?15-s:s; return true; }
  __device__ __forceinline__ void a_ready(const AttnUnit&)const{}
  __device__ __forceinline__ void done(const AttnUnit&)const{}
};
template<class Sched,int THRL=8> __device__ __forceinline__ void attn_phase(char*lds,const AttnTensors&T,const Sched&S){
  AttnUnit u;
  for(int i=0;S.next(i,u);++i){ S.a_ready(u); attn_unit<THRL>(u.bh/NHEAD,u.bh%NHEAD,u.qb,T.Q,T.K,T.V,T.O,T.CB,lds); S.done(u); }
}
#undef SBAR
#undef WAIT_BAR
}
#include <hip/hip_cooperative_groups.h>
namespace cg = cooperative_groups;
#define LAS __attribute__((address_space(3)))
typedef unsigned short bf16;
typedef float f32x4 __attribute__((ext_vector_type(4)));
typedef float f32x2 __attribute__((ext_vector_type(2)));
typedef unsigned u32x4 __attribute__((ext_vector_type(4)));
typedef unsigned u32x2 __attribute__((ext_vector_type(2)));
typedef short bf16x8 __attribute__((ext_vector_type(8)));
typedef short bf16x4 __attribute__((ext_vector_type(4)));

constexpr int NWAVES = 8, NTHR = 512;
constexpr int BATCH = 4, SEQ = 4096, DM = 1024, DEPTH = 4, M = BATCH * SEQ;
constexpr int NIN = 3592, NF = 3584;
constexpr int T5 = 32, NCH5 = M / T5, KA5 = 640, NG5 = 16;
constexpr float EPS = 1e-6f;
constexpr float LOG2E = 1.4426950408889634f;

constexpr size_t MiB = 1u << 20;
constexpr size_t WS_WIN = 1 * MiB, WS_WO = 29 * MiB, WS_WGLU = 37 * MiB, WS_ROPE = 38 * MiB, WS_MF = 39 * MiB, WS_WB = 79 * MiB;
constexpr size_t WS_LAM = 88 * MiB, WS_LOGF = 88 * MiB + 65536, WS_CB = WS_LOGF + 524288;
constexpr size_t WS_XN = 90 * MiB, WS_E = WS_XN, WS_UPD = WS_XN + 4 * MiB, WS_STATE = WS_XN + 20 * MiB;
constexpr size_t WS_QO = 122 * MiB, WS_KB = 138 * MiB, WS_VB = 154 * MiB, WS_SUA = 170 * MiB, WS_RQ = 180 * MiB, WS_RK = 188 * MiB, WS_RKT = 196 * MiB, WS_YS5 = WS_RKT;
constexpr size_t WS_RVT = 204 * MiB, WS_GATE = 212 * MiB, WS_END = 244 * MiB;

constexpr int RING_BYTES = 131072, LDS_BYTES = 147456;

struct Args { const float* in[16]; float* out; unsigned char* ws; };

__device__ __forceinline__ float bf2f(unsigned short b) { return __uint_as_float((unsigned)b << 16); }
__device__ __forceinline__ float bflo(unsigned w) { return __uint_as_float(w << 16); }
__device__ __forceinline__ float bfhi(unsigned w) { return __uint_as_float(w & 0xffff0000u); }
__device__ __forceinline__ unsigned pk2(float lo, float hi) { return pg8::cvt_pk_bf16(lo, hi); }
__device__ __forceinline__ unsigned short f2bf(float f) { return (unsigned short)(pg8::cvt_pk_bf16(f, 0.f) & 0xffffu); }
__device__ __forceinline__ float wave_sum(float v) {
#pragma unroll
    for (int o = 1; o < 64; o <<= 1) v += __shfl_xor(v, o);
    return v;
}
__device__ __forceinline__ float lg2_gamma(int hh) { return log2f(1.0f - exp2f(-5.0f - (float)hh)); }

__device__ __forceinline__ int win_col(int n) {
    if (n < 1536) return n;
    if (n < 1792) return n + 8;
    if (n < 2304) { const bool q = n < 2048; const int base = q ? 1792 : 2048; const int hh = (n - base) >> 6, pos = (n - base) & 63; const int d = (pos & 1) ? 32 + (pos >> 1) : (pos >> 1); return (q ? 1800 : 2056) + hh * 64 + d; }
    return n + 8;
}
template <bool MAP> __device__ __forceinline__ void p0_transpose_item(const float* W, int K, int Nsrc, int Ndst, bf16* WT, LAS float* scr, int item, int lane) {
    const int nblk = Ndst / 32, kb = item / nblk, nb = item % nblk, k0 = 64 * kb, n0 = 32 * nb;
    const int sc = MAP ? win_col(n0 + (lane & 31)) : n0 + (lane & 31);
#pragma unroll 8
    for (int i = 0; i < 32; ++i) { const int kk = 2 * i + (lane >> 5); scr[kk * 33 + (lane & 31)] = W[(size_t)(k0 + kk) * Nsrc + sc]; }
    asm volatile("s_waitcnt lgkmcnt(0)" ::: "memory");
    const int c = lane & 7;
#pragma unroll
    for (int j = 0; j < 4; ++j) { const int n = (lane >> 3) + 8 * j; const LAS float* s = scr + (8 * c) * 33 + n;
        u32x4 o; o.x = pk2(s[0 * 33], s[1 * 33]); o.y = pk2(s[2 * 33], s[3 * 33]); o.z = pk2(s[4 * 33], s[5 * 33]); o.w = pk2(s[6 * 33], s[7 * 33]);
        *(u32x4*)(WT + (size_t)(n0 + n) * K + k0 + 8 * c) = o; }
    asm volatile("s_waitcnt lgkmcnt(0)" ::: "memory");
}

__device__ __forceinline__ void s5_prep(const Args& a, int l, int g, LAS float* L, int tid) {
    LAS float* LPr = L;
    LAS float* LPi = L + 33 * 64;
    LAS float* Bbr = L + 66 * 64;
    LAS float* Bbi = Bbr + 1024;
    LAS float* Cr = Bbi + 1024;
    LAS float* Ci = Cr + 1024;
    LAS float* KT = Ci + 1024;
    const float* a_re = a.in[4] + (size_t)(l * 16 + g) * 64; const float* a_im = a.in[5] + (size_t)(l * 16 + g) * 64;
    const float* b_re = a.in[6] + (size_t)(l * 16 + g) * 1024; const float* b_im = a.in[7] + (size_t)(l * 16 + g) * 1024;
    const float* c_re = a.in[8] + (size_t)(l * 16 + g) * 1024; const float* c_im = a.in[9] + (size_t)(l * 16 + g) * 1024;
    const float log_dt = a.in[11][l * 16 + g];
    bf16* MF = (bf16*)(a.ws + WS_MF) + (size_t)(l * 16 + g) * 512 * KA5;
    bf16* WB = (bf16*)(a.ws + WS_WB) + (size_t)(l * 16 + g) * 128 * 512;
    float* LAM = (float*)(a.ws + WS_LAM) + (size_t)(l * 16 + g) * 128;
    if (tid < 64) {
        const int p = tid;
        const double dt = exp((double)log_dt), ar = (double)a_re[p], ai = (double)a_im[p];
        const double mag = exp(ar * dt); double sn, cs; sincos(ai * dt, &sn, &cs);
        const double lr = mag * cs, li = mag * sn, den = ar * ar + ai * ai;
        const double fr = ((lr - 1.0) * ar + li * ai) / den, fi = (li * ar - (lr - 1.0) * ai) / den;
#pragma unroll 4
        for (int h = 0; h < 16; ++h) { const double br = (double)b_re[p * 16 + h], bi = (double)b_im[p * 16 + h]; Bbr[p * 16 + h] = (float)(fr * br - fi * bi); Bbi[p * 16 + h] = (float)(fr * bi + fi * br); }
        double pr = 1.0, pi = 0.0;
        for (int j = 0; j <= 32; ++j) { LPr[j * 64 + p] = (float)pr; LPi[j * 64 + p] = (float)pi; const double nr = pr * lr - pi * li, ni = pr * li + pi * lr; pr = nr; pi = ni; }
        LAM[p] = LPr[32 * 64 + p]; LAM[64 + p] = LPi[32 * 64 + p];
    }
    for (int i = tid; i < 1024; i += NTHR) { Cr[i] = c_re[i]; Ci[i] = c_im[i]; }
    __syncthreads();
    for (int e = tid; e < 8192; e += NTHR) {
        const int j = e >> 8, h = (e >> 4) & 15, hp = e & 15; float s = 0.f;
#pragma unroll 4
        for (int p = 0; p < 64; ++p) { const float cr = Cr[h * 64 + p], ci = Ci[h * 64 + p], lr = LPr[j * 64 + p], li = LPi[j * 64 + p];
            const float clr = cr * lr - ci * li, cli = cr * li + ci * lr; s += clr * Bbr[p * 16 + hp] - cli * Bbi[p * 16 + hp]; }
        KT[e] = s;
    }
    __syncthreads();
    for (int q = tid; q < 512 * 64; q += NTHR) {
        const int row = q >> 6, cp = q & 63, s = cp >> 1, h0 = (cp & 1) * 8, t = row >> 4, h = row & 15;
        u32x4 o = (u32x4){0u, 0u, 0u, 0u};
        if (s <= t) { const LAS float* k = KT + ((t - s) * 16 + h) * 16 + h0; o.x = pk2(k[0], k[1]); o.y = pk2(k[2], k[3]); o.z = pk2(k[4], k[5]); o.w = pk2(k[6], k[7]); }
        *(u32x4*)(MF + (size_t)row * KA5 + cp * 8) = o;
    }
    for (int q = tid; q < 512 * 16; q += NTHR) {
        const int row = q >> 4, cp = q & 15, t = row >> 4, h = row & 15; float v[8];
#pragma unroll
        for (int e = 0; e < 8; ++e) { const int jj = cp * 8 + e, p = jj & 63; const float cr = Cr[h * 64 + p], ci = Ci[h * 64 + p], lr = LPr[(t + 1) * 64 + p], li = LPi[(t + 1) * 64 + p];
            v[e] = (jj < 64) ? (cr * lr - ci * li) : -(cr * li + ci * lr); }
        u32x4 o; o.x = pk2(v[0], v[1]); o.y = pk2(v[2], v[3]); o.z = pk2(v[4], v[5]); o.w = pk2(v[6], v[7]);
        *(u32x4*)(MF + (size_t)row * KA5 + 512 + cp * 8) = o;
    }
    for (int q = tid; q < 128 * 64; q += NTHR) {
        const int j = q >> 6, cp = q & 63, s = cp >> 1, h0 = (cp & 1) * 8, p = j & 63; const float lr = LPr[(31 - s) * 64 + p], li = LPi[(31 - s) * 64 + p]; float v[8];
#pragma unroll
        for (int e = 0; e < 8; ++e) { const float br = Bbr[p * 16 + h0 + e], bi = Bbi[p * 16 + h0 + e]; v[e] = (j < 64) ? (lr * br - li * bi) : (lr * bi + li * br); }
        u32x4 o; o.x = pk2(v[0], v[1]); o.y = pk2(v[2], v[3]); o.z = pk2(v[4], v[5]); o.w = pk2(v[6], v[7]);
        *(u32x4*)(WB + (size_t)j * 512 + cp * 8) = o;
    }
    __syncthreads();
}

__device__ __forceinline__ void norm_phase(const Args& a, int l, const float* X, LAS float* WF, int tid, int lane, int gw, int NGW) {
    const float* win = a.in[2] + (size_t)l * DM * NIN;
    for (int i = tid; i < 2048; i += NTHR) { const int k = i >> 1, hf = i & 1; *(LAS f32x4*)(WF + k * 8 + hf * 4) = *(const f32x4*)(win + (size_t)k * NIN + 1536 + hf * 4); }
    __syncthreads();
    const float* gw_ = a.in[1] + (size_t)l * DM; f32x4 gv[4];
#pragma unroll
    for (int j = 0; j < 4; ++j) gv[j] = *((const f32x4*)gw_ + lane + 64 * j);
    bf16* XN = (bf16*)(a.ws + WS_XN); float* LOGF = (float*)(a.ws + WS_LOGF);
    const float bfj = (lane < 8) ? a.in[3][l * 8 + lane] : 0.f;
    for (int m = gw; m < M; m += NGW) {
        const f32x4* xr = (const f32x4*)(X + (size_t)m * DM) + lane; f32x4 v[4]; float ss = 0.f;
#pragma unroll
        for (int j = 0; j < 4; ++j) { v[j] = xr[64 * j]; ss += (v[j].x * v[j].x + v[j].y * v[j].y) + (v[j].z * v[j].z + v[j].w * v[j].w); }
        const float rstd = rsqrtf(wave_sum(ss) * (1.f / DM) + EPS);
        float acc[8];
#pragma unroll
        for (int e = 0; e < 8; ++e) acc[e] = 0.f;
        unsigned long long* o8 = (unsigned long long*)(XN + (size_t)m * DM) + lane;
#pragma unroll
        for (int j = 0; j < 4; ++j) { v[j] = v[j] * rstd * gv[j];
            o8[64 * j] = (unsigned long long)pk2(v[j].x, v[j].y) | ((unsigned long long)pk2(v[j].z, v[j].w) << 32);
#pragma unroll
            for (int q = 0; q < 4; ++q) { const int k = 256 * j + 4 * lane + q; const f32x4 w0 = *(const LAS f32x4*)(WF + k * 8), w1 = *(const LAS f32x4*)(WF + k * 8 + 4); const float hv = v[j][q];
                acc[0] += hv * w0.x; acc[1] += hv * w0.y; acc[2] += hv * w0.z; acc[3] += hv * w0.w; acc[4] += hv * w1.x; acc[5] += hv * w1.y; acc[6] += hv * w1.z; acc[7] += hv * w1.w; } }
        float mine = 0.f;
#pragma unroll
        for (int e = 0; e < 8; ++e) { const float s = wave_sum(acc[e]); if (lane == e) mine = s; }
        if (lane < 8) { const float z = mine + bfj; const float ls = fminf(z, 0.f) - log1pf(expf(-fabsf(z))); LOGF[(size_t)((m >> 12) * 8 + lane) * SEQ + (m & 4095)] = ls; }
    }
    __syncthreads();
}
__device__ __forceinline__ void final_norm(const Args& a, float* X, int lane, int gw, int NGW) {
    f32x4 gv[4];
#pragma unroll
    for (int j = 0; j < 4; ++j) gv[j] = *((const f32x4*)a.in[15] + lane + 64 * j);
    for (int m = gw; m < M; m += NGW) {
        f32x4* xr = (f32x4*)(X + (size_t)m * DM) + lane; f32x4 v[4]; float ss = 0.f;
#pragma unroll
        for (int j = 0; j < 4; ++j) { v[j] = xr[64 * j]; ss += (v[j].x * v[j].x + v[j].y * v[j].y) + (v[j].z * v[j].z + v[j].w * v[j].w); }
        const float rstd = rsqrtf(wave_sum(ss) * (1.f / DM) + EPS);
#pragma unroll
        for (int j = 0; j < 4; ++j) xr[64 * j] = v[j] * rstd * gv[j];
    }
}

struct FlatOrder {
    int nM, nN, nG, G, c;
    __device__ bool next(int i, pg8::Unit& u) const { const int L = i * G + c; if (L >= nG * nM * nN) return false; u.gz = L / (nM * nN); const int r = L % (nM * nN); u.pm = r % nM; u.pn = r / nM; return true; }
    __device__ __forceinline__ void a_ready(const pg8::Unit&) const {}
    __device__ __forceinline__ void done(const pg8::Unit&) const {}
};
__device__ __forceinline__ float silu_f(float v) { return v / (1.f + __expf(-v)); }
__device__ __forceinline__ float gelu_tanh(float v) { const float u = 0.7978845608028654f * (v + 0.044715f * v * v * v); const float e = __expf(2.f * u); const float th = 1.f - 2.f / (e + 1.f); return 0.5f * v * (1.f + th); }

struct EpiInProj {
    static constexpr bool PERM = true, AFTER_DRAIN = false;
    unsigned char* ws;
    __device__ __forceinline__ void operator()(const pg8::f32x4 (&acc)[2][2][4][2], const pg8::Unit& u, int wr, int wc, int fr, int fq) const {
        const int pn = u.pn; const int row0 = u.pm * 256 + wr * 64 + fr, cl0 = wc * 32 + 8 * fq;
        if (pn < 6) {
            bf16* base = (bf16*)(ws + (pn < 2 ? WS_QO : pn < 4 ? WS_KB : WS_VB)); const float sc = pn < 2 ? 0.125f * LOG2E : 1.f; const int cb = (pn & 1) * 256 + cl0;
#pragma unroll
            for (int ai = 0; ai < 2; ++ai)
#pragma unroll
                for (int m = 0; m < 4; ++m) { bf16* rp = base + (size_t)(row0 + ai * 128 + m * 16) * 512 + cb;
#pragma unroll
                    for (int bj = 0; bj < 2; ++bj) { const pg8::f32x4 v0 = acc[ai][bj][m][0] * sc, v1 = acc[ai][bj][m][1] * sc; u32x4 w; w.x = pk2(v0[0], v0[1]); w.y = pk2(v0[2], v0[3]); w.z = pk2(v1[0], v1[1]); w.w = pk2(v1[2], v1[3]); *(u32x4*)(rp + bj * 128) = w; } }
        } else if (pn == 6) {
            bf16* base = (bf16*)(ws + WS_SUA);
#pragma unroll
            for (int ai = 0; ai < 2; ++ai)
#pragma unroll
                for (int m = 0; m < 4; ++m) { const int row = row0 + ai * 128 + m * 16, chunk = row >> 5, t = row & 31;
#pragma unroll
                    for (int bj = 0; bj < 2; ++bj) { const int c = cl0 + bj * 128, g = c >> 4, h0 = c & 15; const pg8::f32x4 v0 = acc[ai][bj][m][0], v1 = acc[ai][bj][m][1]; u32x4 w; w.x = pk2(v0[0], v0[1]); w.y = pk2(v0[2], v0[3]); w.z = pk2(v1[0], v1[1]); w.w = pk2(v1[2], v1[3]);
                        *(u32x4*)(base + ((size_t)(g * 512 + chunk) * KA5 + t * 16 + h0)) = w; } }
        } else if (pn == 7 || pn == 8) {
            const f32x4* rope = (const f32x4*)(ws + WS_ROPE); bf16* base = (bf16*)(ws + (pn == 7 ? WS_RQ : WS_RK)); bf16* RKT = (bf16*)(ws + WS_RKT);
#pragma unroll
            for (int ai = 0; ai < 2; ++ai)
#pragma unroll
                for (int m = 0; m < 4; ++m) { const int row = row0 + ai * 128 + m * 16, b = row >> 12, t = row & 4095;
#pragma unroll
                    for (int bj = 0; bj < 2; ++bj) { const int c = cl0 + bj * 128, hh = c >> 6, pos0 = c & 63; const pg8::f32x4 v0 = acc[ai][bj][m][0], v1 = acc[ai][bj][m][1];
                        const f32x4 r0 = rope[(t * 32 + (pos0 >> 1)) >> 1], r1 = rope[((t * 32 + (pos0 >> 1)) >> 1) + 1];
                        float o[8];
                        o[0] = v0[0] * r0.x - v0[1] * r0.y; o[1] = v0[0] * r0.y + v0[1] * r0.x; o[2] = v0[2] * r0.z - v0[3] * r0.w; o[3] = v0[2] * r0.w + v0[3] * r0.z;
                        o[4] = v1[0] * r1.x - v1[1] * r1.y; o[5] = v1[0] * r1.y + v1[1] * r1.x; o[6] = v1[2] * r1.z - v1[3] * r1.w; o[7] = v1[2] * r1.w + v1[3] * r1.z;
                        u32x4 w; w.x = pk2(o[0], o[1]); w.y = pk2(o[2], o[3]); w.z = pk2(o[4], o[5]); w.w = pk2(o[6], o[7]);
                        *(u32x4*)(base + (size_t)row * 256 + c) = w;
                        if (pn == 8) { const float wk = exp2f(lg2_gamma(hh) * (float)(63 - (t & 63))); bf16* tp = RKT + ((size_t)((b * 4 + hh) * 64 + pos0)) * SEQ + t;
#pragma unroll
                            for (int e = 0; e < 8; ++e) tp[(size_t)e * SEQ] = f2bf(o[e] * wk); } } }
        } else if (pn == 9) {
            bf16* RVT = (bf16*)(ws + WS_RVT);
#pragma unroll
            for (int ai = 0; ai < 2; ++ai)
#pragma unroll
                for (int m = 0; m < 4; ++m) { const int row = row0 + ai * 128 + m * 16, b = row >> 12, t = row & 4095;
#pragma unroll
                    for (int bj = 0; bj < 2; ++bj) { const int c = cl0 + bj * 128, hh = c >> 6, d0 = c & 63; const pg8::f32x4 v0 = acc[ai][bj][m][0], v1 = acc[ai][bj][m][1]; bf16* tp = RVT + ((size_t)((b * 4 + hh) * 64 + d0)) * SEQ + t;
#pragma unroll
                        for (int e = 0; e < 4; ++e) { tp[(size_t)e * SEQ] = f2bf(v0[e]); tp[(size_t)(4 + e) * SEQ] = f2bf(v1[e]); } } }
        } else {
            bf16* base = (bf16*)(ws + WS_GATE); const int cb = (pn - 10) * 256 + cl0;
#pragma unroll
            for (int ai = 0; ai < 2; ++ai)
#pragma unroll
                for (int m = 0; m < 4; ++m) { bf16* rp = base + (size_t)(row0 + ai * 128 + m * 16) * 1024 + cb;
#pragma unroll
                    for (int bj = 0; bj < 2; ++bj) { const pg8::f32x4 v0 = acc[ai][bj][m][0], v1 = acc[ai][bj][m][1]; u32x4 w; w.x = pk2(silu_f(v0[0]), silu_f(v0[1])); w.y = pk2(silu_f(v0[2]), silu_f(v0[3])); w.z = pk2(silu_f(v1[0]), silu_f(v1[1])); w.w = pk2(silu_f(v1[2]), silu_f(v1[3])); *(u32x4*)(rp + bj * 128) = w; } }
        }
    }
};
struct EpiS5E {
    static constexpr bool PERM = false, AFTER_DRAIN = false;
    float* E;
    __device__ __forceinline__ void operator()(const pg8::f32x4 (&acc)[2][2][4][2], const pg8::Unit& u, int wr, int wc, int fr, int fq) const {
        const int row0 = u.pm * 256 + wr * 64 + fr, col0 = wc * 32 + 4 * fq;
#pragma unroll
        for (int ai = 0; ai < 2; ++ai)
#pragma unroll
            for (int m = 0; m < 4; ++m) { float* rp = E + ((size_t)u.gz * NCH5 + row0 + ai * 128 + m * 16) * 128 + col0;
#pragma unroll
                for (int n = 0; n < 2; ++n) *(pg8::f32x4*)(rp + n * 16) = acc[ai][0][m][n]; }
    }
};
struct EpiS5Y {
    static constexpr bool PERM = true, AFTER_DRAIN = false;
    const bf16* SUA; bf16* YS5; const float* dvec;
    __device__ __forceinline__ void operator()(const pg8::f32x4 (&acc)[2][2][4][2], const pg8::Unit& u, int wr, int wc, int fr, int fq) const {
        const int row0 = u.pm * 256 + wr * 64 + fr, cl0 = u.pn * 256 + wc * 32 + 8 * fq; const int g = u.gz;
#pragma unroll
        for (int bj = 0; bj < 2; ++bj) { const int c = cl0 + bj * 128, tt = c >> 4, h0 = c & 15; const f32x4 d0 = *(const f32x4*)(dvec + g * 16 + h0), d1 = *(const f32x4*)(dvec + g * 16 + h0 + 4);
#pragma unroll
            for (int ai = 0; ai < 2; ++ai)
#pragma unroll
                for (int m = 0; m < 4; ++m) { const int chunk = row0 + ai * 128 + m * 16; const u32x4 uu = *(const u32x4*)(SUA + ((size_t)(g * 512 + chunk) * KA5 + c)); const pg8::f32x4 v0 = acc[ai][bj][m][0], v1 = acc[ai][bj][m][1];
                    float y[8]; y[0] = v0[0] + d0.x * bflo(uu.x); y[1] = v0[1] + d0.y * bfhi(uu.x); y[2] = v0[2] + d0.z * bflo(uu.y); y[3] = v0[3] + d0.w * bfhi(uu.y);
                    y[4] = v1[0] + d1.x * bflo(uu.z); y[5] = v1[1] + d1.y * bfhi(uu.z); y[6] = v1[2] + d1.z * bflo(uu.w); y[7] = v1[3] + d1.w * bfhi(uu.w);
#pragma unroll
                    for (int e = 0; e < 8; ++e) y[e] = gelu_tanh(y[e]);
                    u32x4 w; w.x = pk2(y[0], y[1]); w.y = pk2(y[2], y[3]); w.z = pk2(y[4], y[5]); w.w = pk2(y[6], y[7]);
                    *(u32x4*)(YS5 + (size_t)(chunk * 32 + tt) * 256 + g * 16 + h0) = w; } }
    }
};
struct EpiGlu {
    static constexpr bool PERM = true, AFTER_DRAIN = false;
    const bf16* YS5; bf16* G;
    __device__ __forceinline__ void operator()(const pg8::f32x4 (&acc)[2][2][4][2], const pg8::Unit& u, int wr, int wc, int fr, int fq) const {
        const int row0 = u.pm * 256 + wr * 64 + fr, cl0 = wc * 32 + 8 * fq;
#pragma unroll
        for (int ai = 0; ai < 2; ++ai)
#pragma unroll
            for (int m = 0; m < 4; ++m) { const int row = row0 + ai * 128 + m * 16;
#pragma unroll
                for (int bj = 0; bj < 2; ++bj) { const int c = cl0 + bj * 128; const u32x4 yy = *(const u32x4*)(YS5 + (size_t)row * 256 + c); bf16* gp = G + (size_t)row * 1024 + 512 + c; const u32x4 gg = *(const u32x4*)gp;
                    const pg8::f32x4 v0 = acc[ai][bj][m][0], v1 = acc[ai][bj][m][1]; float s[8];
#pragma unroll
                    for (int e = 0; e < 4; ++e) { s[e] = 1.f / (1.f + __expf(-v0[e])); s[4 + e] = 1.f / (1.f + __expf(-v1[e])); }
                    u32x4 w; w.x = pk2(bflo(yy.x) * s[0] * bflo(gg.x), bfhi(yy.x) * s[1] * bfhi(gg.x)); w.y = pk2(bflo(yy.y) * s[2] * bflo(gg.y), bfhi(yy.y) * s[3] * bfhi(gg.y));
                    w.z = pk2(bflo(yy.z) * s[4] * bflo(gg.z), bfhi(yy.z) * s[5] * bfhi(gg.z)); w.w = pk2(bflo(yy.w) * s[6] * bflo(gg.w), bfhi(yy.w) * s[7] * bfhi(gg.w));
                    *(u32x4*)gp = w; } }
    }
};
struct EpiOut {
    static constexpr bool PERM = false, AFTER_DRAIN = false;
    const float* base; float* out;
    __device__ __forceinline__ void operator()(const pg8::f32x4 (&acc)[2][2][4][2], const pg8::Unit& u, int wr, int wc, int fr, int fq) const {
        const int row0 = u.pm * 256 + wr * 64 + fr, col0 = u.pn * 256 + wc * 32 + 4 * fq;
#pragma unroll
        for (int ai = 0; ai < 2; ++ai)
#pragma unroll
            for (int m = 0; m < 4; ++m) { const size_t off = (size_t)(row0 + ai * 128 + m * 16) * DM + col0;
#pragma unroll
                for (int bj = 0; bj < 2; ++bj)
#pragma unroll
                    for (int n = 0; n < 2; ++n) { const f32x4 bs = *(const f32x4*)(base + off + bj * 128 + n * 16); const pg8::f32x4 v = acc[ai][bj][m][n]; *(f32x4*)(out + off + bj * 128 + n * 16) = (f32x4){bs.x + v[0], bs.y + v[1], bs.z + v[2], bs.w + v[3]}; } }
    }
};

__device__ __forceinline__ void ret_upd_unit(unsigned char* ws, int unit, int lane) {
    const int c = unit & 63, bh = unit >> 6; const int i16 = lane & 15, kq = lane >> 4;
    const bf16* KT = (const bf16*)(ws + WS_RKT) + (size_t)bh * 64 * SEQ + c * 64; const bf16* VT = (const bf16*)(ws + WS_RVT) + (size_t)bh * 64 * SEQ + c * 64;
    float* UPD = (float*)(ws + WS_UPD) + (size_t)unit * 4096;
    bf16x8 af[4][2], bfv[4][2];
#pragma unroll
    for (int ib = 0; ib < 4; ++ib)
#pragma unroll
        for (int ks = 0; ks < 2; ++ks) { af[ib][ks] = *(const bf16x8*)(KT + (size_t)(16 * ib + i16) * SEQ + 32 * ks + 8 * kq); bfv[ib][ks] = *(const bf16x8*)(VT + (size_t)(16 * ib + i16) * SEQ + 32 * ks + 8 * kq); }
#pragma unroll
    for (int ib = 0; ib < 4; ++ib)
#pragma unroll
        for (int jb = 0; jb < 4; ++jb) { pg8::f32x4 d = (pg8::f32x4){0.f, 0.f, 0.f, 0.f};
            d = __builtin_amdgcn_mfma_f32_16x16x32_bf16(af[ib][0], bfv[jb][0], d, 0, 0, 0); d = __builtin_amdgcn_mfma_f32_16x16x32_bf16(af[ib][1], bfv[jb][1], d, 0, 0, 0);
            *(pg8::f32x4*)(UPD + (size_t)(16 * jb + i16) * 64 + 16 * ib + 4 * kq) = d; }
}
__device__ __forceinline__ void ret_out_unit(const Args& a, int l, int unit, int lane) {
    unsigned char* ws = a.ws;
    const int c = unit & 63, bh = unit >> 6, hh = bh & 3, b = bh >> 2; const int fr = lane & 15, fq = lane >> 4;
    const size_t t0 = (size_t)b * SEQ + c * 64;
    const bf16* RQ = (const bf16*)(ws + WS_RQ) + t0 * 256 + hh * 64; const bf16* RK = (const bf16*)(ws + WS_RK) + t0 * 256 + hh * 64;
    const bf16* VT = (const bf16*)(ws + WS_RVT) + (size_t)bh * 64 * SEQ + c * 64; const bf16* ST = (const bf16*)(ws + WS_STATE) + (size_t)unit * 4096;
    const float lg = lg2_gamma(hh);
    bf16x8 qf[4][2]; pg8::f32x4 st[4][4];
#pragma unroll
    for (int nb = 0; nb < 4; ++nb)
#pragma unroll
        for (int ks = 0; ks < 2; ++ks) qf[nb][ks] = *(const bf16x8*)(RQ + (size_t)(16 * nb + fr) * 256 + 32 * ks + 8 * fq);
#pragma unroll
    for (int mb = 0; mb < 4; ++mb) { bf16x8 k0 = *(const bf16x8*)(RK + (size_t)(16 * mb + fr) * 256 + 8 * fq), k1 = *(const bf16x8*)(RK + (size_t)(16 * mb + fr) * 256 + 32 + 8 * fq);
#pragma unroll
        for (int nb = 0; nb < 4; ++nb) { pg8::f32x4 d = (pg8::f32x4){0.f, 0.f, 0.f, 0.f};
            d = __builtin_amdgcn_mfma_f32_16x16x32_bf16(k0, qf[nb][0], d, 0, 0, 0); d = __builtin_amdgcn_mfma_f32_16x16x32_bf16(k1, qf[nb][1], d, 0, 0, 0);
#pragma unroll
            for (int r = 0; r < 4; ++r) { const int mm = 16 * mb + 4 * fq + r, nn = 16 * nb + fr; const int df = mm > nn ? mm - nn : nn - mm; d[r] *= 0.125f * exp2f(lg * (float)df); }
            st[mb][nb] = d; } }
    pg8::f32x4 o[4][4];
#pragma unroll
    for (int nb = 0; nb < 4; ++nb)
#pragma unroll
        for (int dvb = 0; dvb < 4; ++dvb) o[nb][dvb] = (pg8::f32x4){0.f, 0.f, 0.f, 0.f};
#pragma unroll
    for (int dvb = 0; dvb < 4; ++dvb) { const bf16x8 s0 = *(const bf16x8*)(ST + (size_t)(16 * dvb + fr) * 64 + 8 * fq), s1 = *(const bf16x8*)(ST + (size_t)(16 * dvb + fr) * 64 + 32 + 8 * fq);
#pragma unroll
        for (int nb = 0; nb < 4; ++nb) { o[nb][dvb] = __builtin_amdgcn_mfma_f32_16x16x32_bf16(qf[nb][0], s0, o[nb][dvb], 0, 0, 0); o[nb][dvb] = __builtin_amdgcn_mfma_f32_16x16x32_bf16(qf[nb][1], s1, o[nb][dvb], 0, 0, 0); } }
#pragma unroll
    for (int nb = 0; nb < 4; ++nb)
#pragma unroll
        for (int r = 0; r < 4; ++r) { const float wq = 0.125f * exp2f(lg * (float)(16 * nb + 4 * fq + r + 1));
#pragma unroll
            for (int dvb = 0; dvb < 4; ++dvb) o[nb][dvb][r] *= wq; }
#pragma unroll
    for (int s = 0; s < 2; ++s) {
        bf16x8 pa[4];
#pragma unroll
        for (int nb = 0; nb < 4; ++nb) { u32x4 w; w.x = pk2(st[2 * s][nb][0], st[2 * s][nb][1]); w.y = pk2(st[2 * s][nb][2], st[2 * s][nb][3]); w.z = pk2(st[2 * s + 1][nb][0], st[2 * s + 1][nb][1]); w.w = pk2(st[2 * s + 1][nb][2], st[2 * s + 1][nb][3]); pa[nb] = __builtin_bit_cast(bf16x8, w); }
#pragma unroll
        for (int dvb = 0; dvb < 4; ++dvb) { const u32x2 v0 = *(const u32x2*)(VT + (size_t)(16 * dvb + fr) * SEQ + 32 * s + 4 * fq), v1 = *(const u32x2*)(VT + (size_t)(16 * dvb + fr) * SEQ + 32 * s + 16 + 4 * fq);
            const bf16x8 vf = __builtin_bit_cast(bf16x8, (u32x4){v0.x, v0.y, v1.x, v1.y});
#pragma unroll
            for (int nb = 0; nb < 4; ++nb) o[nb][dvb] = __builtin_amdgcn_mfma_f32_16x16x32_bf16(pa[nb], vf, o[nb][dvb], 0, 0, 0); }
    }
    const float* gn = a.in[13] + (size_t)l * 256 + hh * 64; float gnw[4];
#pragma unroll
    for (int dvb = 0; dvb < 4; ++dvb) gnw[dvb] = gn[16 * dvb + fr];
    bf16* Y = (bf16*)(ws + WS_GATE) + t0 * 1024 + 768 + hh * 64;
#pragma unroll
    for (int nb = 0; nb < 4; ++nb)
#pragma unroll
        for (int r = 0; r < 4; ++r) { float s = (o[nb][0][r] + o[nb][1][r]) + (o[nb][2][r] + o[nb][3][r]);
            s += __shfl_xor(s, 1); s += __shfl_xor(s, 2); s += __shfl_xor(s, 4); s += __shfl_xor(s, 8);
            const float mu = s * (1.f / 64.f); float q = 0.f;
#pragma unroll
            for (int dvb = 0; dvb < 4; ++dvb) { const float d = o[nb][dvb][r] - mu; q += d * d; }
            q += __shfl_xor(q, 1); q += __shfl_xor(q, 2); q += __shfl_xor(q, 4); q += __shfl_xor(q, 8);
            const float rstd = rsqrtf(q * (1.f / 64.f) + EPS); bf16* yp = Y + (size_t)(16 * nb + 4 * fq + r) * 1024 + fr;
#pragma unroll
            for (int dvb = 0; dvb < 4; ++dvb) { const float gt = bf2f(yp[16 * dvb]); yp[16 * dvb] = f2bf((o[nb][dvb][r] - mu) * rstd * gnw[dvb] * gt); } }
}

__global__ void __launch_bounds__(NTHR, 2) mega_fwd(Args args) {
    extern __shared__ __attribute__((aligned(16))) unsigned char lds[];
    cg::grid_group grid = cg::this_grid();
    const int tid = threadIdx.x, lane = tid & 63, wave = __builtin_amdgcn_readfirstlane(tid >> 6);
    const int G = gridDim.x, bx = blockIdx.x; const int vcu = (G % 8 == 0) ? (bx % 8) * (G / 8) + bx / 8 : bx;
    const int gw = bx * NWAVES + wave, NGW = G * NWAVES;
    unsigned char* ws = args.ws;
    LAS unsigned char* ldsl = (LAS unsigned char*)lds;
    LAS float* ldsf = (LAS float*)lds;
    float* X = args.out;

    {
#ifndef SKIP_PREP
        if (bx < 64) { s5_prep(args, bx >> 4, bx & 15, ldsf, tid); }
#endif
        LAS float* scr = ldsf + wave * 4096;
        constexpr int I_IN = (DM / 64) * (NF / 32), I_O = (DM / 64) * (DM / 32), I_G = (256 / 64) * (256 / 32), I_L = I_IN + I_O + I_G;
        for (int it = gw; it < DEPTH * I_L; it += NGW) {
            const int l = it / I_L; int r = it % I_L;
            if (r < I_IN) { p0_transpose_item<true>(args.in[2] + (size_t)l * DM * NIN, DM, NIN, NF, (bf16*)(ws + WS_WIN) + (size_t)l * NF * DM, scr, r, lane); continue; } r -= I_IN;
            if (r < I_O) { p0_transpose_item<false>(args.in[14] + (size_t)l * DM * DM, DM, DM, DM, (bf16*)(ws + WS_WO) + (size_t)l * DM * DM, scr, r, lane); continue; } r -= I_O;
            p0_transpose_item<false>(args.in[12] + (size_t)l * 65536, 256, 256, 256, (bf16*)(ws + WS_WGLU) + (size_t)l * 65536, scr, r, lane);
        }
        f32x2* rope = (f32x2*)(ws + WS_ROPE);
        for (int i = bx * NTHR + tid; i < SEQ * 32; i += G * NTHR) { const int pos = i >> 5, fi = i & 31; const float freq = powf(10000.f, -(float)fi / 32.f); const float ang = (float)pos * freq; float sn, cs; sincosf(ang, &sn, &cs); rope[i] = (f32x2){cs, sn}; }
        __syncthreads();
        norm_phase(args, 0, args.in[0], ldsf, tid, lane, gw, NGW);
    }
    grid.sync();

#define PHASE_VARS int tid = threadIdx.x; asm volatile("" : "+v"(tid)); int bxl_ = blockIdx.x; asm volatile("" : "+s"(bxl_)); const int bx = bxl_; const int lane = tid & 63, wave = __builtin_amdgcn_readfirstlane(tid >> 6), gw = bx * NWAVES + wave; __attribute__((address_space(1))) unsigned char* wsg_ = (__attribute__((address_space(1))) unsigned char*)args.ws; asm volatile("" : "+s"(wsg_)); unsigned char* ws = (unsigned char*)wsg_; LAS unsigned char* ldsl = (LAS unsigned char*)lds; LAS float* ldsf = (LAS float*)lds; (void)lane; (void)wave; (void)gw; (void)ldsl; (void)ldsf
    for (int l = 0; l < DEPTH; ++l) {
        {
            PHASE_VARS;
            pg8::Gemm g{(const bf16*)(ws + WS_XN), (const bf16*)(ws + WS_WIN) + (size_t)l * NF * DM, M, NF, DM, DM, DM, 0, 0};
            pg8::StaticOrder S; S.init(M, NF, G, bx);
            EpiInProj E{ws};
#ifndef SKIP_INPROJ
            pg8::gemm_phase<EpiInProj, pg8::StaticOrder, true, true>(ldsl, g, S, E);
#endif
        }
        grid.sync();
        {
            PHASE_VARS;
            if (bx < 32) {
                pg8::Gemm g{(const bf16*)(ws + WS_SUA), (const bf16*)(ws + WS_WB) + (size_t)l * 16 * 128 * 512, NCH5, 256, 512, KA5, 512, (size_t)NCH5 * KA5, (size_t)128 * 512};
                FlatOrder S{2, 1, 16, 32, bx};
                EpiS5E E{(float*)(ws + WS_E)};
#ifndef SKIP_GE
                pg8::gemm_phase<EpiS5E, FlatOrder, true, true>(ldsl, g, S, E);
#endif
            } else if (bx < 160) {
                ret_upd_unit(ws, (bx - 32) * 8 + wave, lane);
            } else if (bx < 192) {
                const int bh = bx - 160; const float* lf = (const float*)(ws + WS_LOGF) + (size_t)bh * SEQ; float* cb = (float*)(ws + WS_CB) + (size_t)bh * SEQ;
                const f32x4 a0 = *(const f32x4*)(lf + tid * 8), a1 = *(const f32x4*)(lf + tid * 8 + 4); float v[8] = {a0.x, a0.y, a0.z, a0.w, a1.x, a1.y, a1.z, a1.w};
#pragma unroll
                for (int e = 1; e < 8; ++e) v[e] += v[e - 1];
                float tot = v[7];
#pragma unroll
                for (int o = 1; o < 64; o <<= 1) { const float t = __shfl_up(tot, o); if (lane >= o) tot += t; }
                if (lane == 63) ldsf[wave] = tot;
                __syncthreads();
                float off = tot - v[7];
                for (int w = 0; w < wave; ++w) off += ldsf[w];
                f32x4 o0, o1; o0.x = -(v[0] + off) * LOG2E; o0.y = -(v[1] + off) * LOG2E; o0.z = -(v[2] + off) * LOG2E; o0.w = -(v[3] + off) * LOG2E; o1.x = -(v[4] + off) * LOG2E; o1.y = -(v[5] + off) * LOG2E; o1.z = -(v[6] + off) * LOG2E; o1.w = -(v[7] + off) * LOG2E;
                *(f32x4*)(cb + tid * 8) = o0; *(f32x4*)(cb + tid * 8 + 4) = o1;
            }
        }
        grid.sync();
        {
            PHASE_VARS;
            if (bx < 64) {
                const int b = bx >> 4, g = bx & 15, p = tid & 63, seg = tid >> 6;
                const float* LAM = (const float*)(ws + WS_LAM) + (size_t)(l * 16 + g) * 128; const float lr = LAM[p], li = LAM[64 + p];
                const float* E = (const float*)(ws + WS_E) + ((size_t)g * NCH5 + b * 128 + seg * 16) * 128 + p;
                bf16* SA = (bf16*)(ws + WS_SUA) + ((size_t)g * NCH5 + b * 128 + seg * 16) * KA5 + 512 + p;
                float er[16], ei[16];
#pragma unroll
                for (int i = 0; i < 16; ++i) { er[i] = E[(size_t)i * 128]; ei[i] = E[(size_t)i * 128 + 64]; }
                float sr = 0.f, si = 0.f;
#pragma unroll
                for (int i = 0; i < 16; ++i) { const float nr = lr * sr - li * si + er[i], ni = lr * si + li * sr + ei[i]; sr = nr; si = ni; }
                LAS float* ends = ldsf;
                ends[(seg * 64 + p) * 2] = sr; ends[(seg * 64 + p) * 2 + 1] = si;
                float pr = lr, pi = li;
#pragma unroll
                for (int i = 0; i < 4; ++i) { const float nr = pr * pr - pi * pi, ni = 2.f * pr * pi; pr = nr; pi = ni; }
                __syncthreads();
                float cr = 0.f, ci = 0.f;
                for (int s2 = 0; s2 < seg; ++s2) { const float xr = ends[(s2 * 64 + p) * 2], xi = ends[(s2 * 64 + p) * 2 + 1]; const float nr = pr * cr - pi * ci + xr, ni = pr * ci + pi * cr + xi; cr = nr; ci = ni; }
#pragma unroll
                for (int i = 0; i < 16; ++i) { SA[(size_t)i * KA5] = f2bf(cr); SA[(size_t)i * KA5 + 64] = f2bf(ci); const float nr = lr * cr - li * ci + er[i], ni = lr * ci + li * cr + ei[i]; cr = nr; ci = ni; }
            } else if (bx < 192) {
                const int idx = (bx - 64) * NTHR + tid, bh = idx >> 12, e = idx & 4095; const float g64 = exp2f(lg2_gamma(bh & 3) * 64.f);
                const float* U = (const float*)(ws + WS_UPD) + (size_t)bh * 64 * 4096 + e; bf16* ST = (bf16*)(ws + WS_STATE) + (size_t)bh * 64 * 4096 + e;
                float st = 0.f;
#pragma unroll 8
                for (int c = 0; c < 64; ++c) { const float u = U[(size_t)c * 4096]; ST[(size_t)c * 4096] = f2bf(st); st = g64 * st + u; }
            }
        }
        grid.sync();
        {
            PHASE_VARS;
#ifndef SKIP_RETOUT
            if (wave < 4) ret_out_unit(args, l, wave * 256 + bx, lane);
#endif
            __syncthreads();
            if (bx < 64) {
                pg8::Gemm g{(const bf16*)(ws + WS_SUA), (const bf16*)(ws + WS_MF) + (size_t)l * 16 * 512 * KA5, NCH5, 512, KA5, KA5, KA5, (size_t)NCH5 * KA5, (size_t)512 * KA5};
                FlatOrder S{2, 2, 16, 64, bx};
                EpiS5Y E{(const bf16*)(ws + WS_SUA), (bf16*)(ws + WS_YS5), args.in[10] + (size_t)l * 256};
#ifndef SKIP_GY
                pg8::gemm_phase<EpiS5Y, FlatOrder, true, true>(ldsl, g, S, E);
#endif
            }
            const attn_body::AttnTensors AT{(const attn_body::bf16*)(ws + WS_QO), (const attn_body::bf16*)(ws + WS_KB), (const attn_body::bf16*)(ws + WS_VB), (attn_body::bf16*)(ws + WS_GATE), (const float*)(ws + WS_CB)};
            const attn_body::StaticOrder S(G, bx);
#ifndef SKIP_ATTN
            attn_body::attn_phase<attn_body::StaticOrder>((char*)lds, AT, S);
#endif
        }
        grid.sync();
        {
            PHASE_VARS;
            if (bx < 64) {
                int Kg = 256; asm volatile("" : "+s"(Kg));
                pg8::Gemm g{(const bf16*)(ws + WS_YS5), (const bf16*)(ws + WS_WGLU) + (size_t)l * 65536, M, 256, Kg, 256, 256, 0, 0};
                FlatOrder S{64, 1, 1, 64, bx};
                EpiGlu E{(const bf16*)(ws + WS_YS5), (bf16*)(ws + WS_GATE)};
#ifndef SKIP_GG
                pg8::gemm_phase<EpiGlu, FlatOrder, true, true>(ldsl, g, S, E);
#endif
            }
        }
        grid.sync();
        {
            PHASE_VARS;
            pg8::Gemm g{(const bf16*)(ws + WS_GATE), (const bf16*)(ws + WS_WO) + (size_t)l * DM * DM, M, DM, DM, DM, DM, 0, 0};
            pg8::StaticOrder S; S.init(M, DM, G, bx);
            EpiOut E{l == 0 ? args.in[0] : X, X};
#ifndef SKIP_GO
            pg8::gemm_phase<EpiOut, pg8::StaticOrder, true, true>(ldsl, g, S, E);
#endif
        }
        grid.sync();
        { PHASE_VARS;
        if (l + 1 < DEPTH) { norm_phase(args, l + 1, X, ldsf, tid, lane, gw, NGW); grid.sync(); }
        else final_norm(args, X, lane, gw, NGW); }
    }
}

extern "C" void kernel_launch(void* const* d_in, const int* in_sizes, int n_in, void* d_out, int out_size, void* d_ws, size_t ws_size, hipStream_t stream) {
    static int grid = 0;
    if (grid == 0) {
        if (n_in != 16 || ws_size < WS_END) { fprintf(stderr, "kernel_launch: unexpected n_in %d / ws %zu\n", n_in, ws_size); grid = -1; return; }
        int dev = 0, cus = 0, per_cu = 0;
        hipGetDevice(&dev); hipDeviceGetAttribute(&cus, hipDeviceAttributeMultiprocessorCount, dev);
        if (hipFuncSetAttribute((const void*)mega_fwd, hipFuncAttributeMaxDynamicSharedMemorySize, LDS_BYTES) != hipSuccess) { fprintf(stderr, "kernel_launch: hipFuncSetAttribute failed\n"); grid = -1; return; }
        if (hipOccupancyMaxActiveBlocksPerMultiprocessor(&per_cu, (const void*)mega_fwd, NTHR, LDS_BYTES) != hipSuccess || per_cu < 1) { fprintf(stderr, "kernel_launch: occupancy query failed (%d)\n", per_cu); grid = -1; return; }
        grid = cus;
        if (grid != 256) fprintf(stderr, "kernel_launch: note: %d CUs\n", grid);
    }
    if (grid < 0) return;
    Args a{};
    for (int i = 0; i < 16; ++i) a.in[i] = (const float*)d_in[i];
    a.out = (float*)d_out; a.ws = (unsigned char*)d_ws;
    void* kargs[] = {&a};
    hipError_t e = hipLaunchCooperativeKernel((const void*)mega_fwd, dim3(grid), dim3(NTHR), kargs, LDS_BYTES, stream);
    if (e != hipSuccess) fprintf(stderr, "kernel_launch: cooperative launch failed: %s\n", hipGetErrorString(e));
}
```

```cpp
#include <hip/hip_runtime.h>
#include <cstdio>
#include <cstdint>
namespace pg8 {
#define PG8_LAS __attribute__((address_space(3)))
typedef unsigned short bf16_t;
typedef short bf16x8 __attribute__((ext_vector_type(8)));
typedef float f32x4 __attribute__((ext_vector_type(4)));
typedef unsigned u32x4 __attribute__((ext_vector_type(4)));
constexpr int BM = 256, BK = 64, HALF = 128, HTB = HALF * BK * 2  , STAGE_BYTES = 8 * HTB, NXCD = 8, WGM = 8;

__host__ __device__ __forceinline__ int lds_byte(int r, int c) { const int st = (r >> 4) * 2 + (c >> 5), rr = r & 15, cc = c & 31, ob = rr * 64 + cc * 2; return st * 1024 + (ob ^ (((ob >> 9) & 1) << 5)); }
__host__ __device__ __forceinline__ void stage_rc(int b, int& R, int& C) { const int st = b / 1024, sb = b % 1024, swz = sb ^ (((sb >> 9) & 1) << 5); R = (st >> 1) * 16 + swz / 64; C = (st & 1) * 32 + (swz % 64) / 2; }
__host__ __device__ __forceinline__ int perm32(int rho) { const int n = rho >> 4, i = rho & 15; return 8 * (i >> 2) + 4 * n + (i & 3); }

struct Unit { int pm, pn, gz; };
struct Gemm { const bf16_t* A; const bf16_t* Bt; int M, N, K; int lda, ldb; size_t gsA, gsB; };

struct StaticOrder {
    int nM, nN, nwg, G, c;
    __host__ __device__ void init(int M, int N, int G_, int c_) { nM = M / BM; nN = N / BM; nwg = nM * nN; G = G_; c = c_; }
    __host__ __device__ bool next(int i, Unit& u) const {
        const long L = (long)i * G + c; if (L >= nwg) return false;
        int wgid = (int)L; { const int q = nwg / NXCD, r = nwg % NXCD, xcd = wgid % NXCD, off = wgid / NXCD; wgid = (xcd < r ? xcd * (q + 1) : r * (q + 1) + (xcd - r) * q) + off; }
        const int nig = WGM * nN, gid = wgid / nig, fm = gid * WGM, gsz = (nM - fm) < WGM ? (nM - fm) : WGM;
        u.pm = fm + ((wgid % nig) % gsz); u.pn = (wgid % nig) / gsz; u.gz = 0; return true;
    }
    __device__ __forceinline__ void a_ready(const Unit&) const {}
    __device__ __forceinline__ void done(const Unit&) const {}
};

__device__ __forceinline__ unsigned cvt_pk_bf16(float lo, float hi) { unsigned r; asm volatile("v_cvt_pk_bf16_f32 %0, %1, %2" : "=v"(r) : "v"(lo), "v"(hi)); return r; }
typedef float f32x2 __attribute__((ext_vector_type(2)));
__device__ __forceinline__ f32x2 gelu_pk(f32x2 v) {
    const f32x2 av = __builtin_elementwise_abs(v), d = av * 0.2316418882f + 1.0f;
    f32x2 t; t.x = __builtin_amdgcn_rcpf(d.x); t.y = __builtin_amdgcn_rcpf(d.y);
    f32x2 q = t * 0.5307027145f + (-0.7265760135f); q = q * t + 0.7107068705f; q = q * t + (-0.142248368f); q = q * t + 0.127414796f; q = q * t;
    const f32x2 s = (v * v) * (-0.72134752044f);
    f32x2 e; e.x = __builtin_amdgcn_exp2f(s.x); e.y = __builtin_amdgcn_exp2f(s.y);
    const f32x2 m = v * (q * e), r = v - m;
    f32x2 o; o.x = v.x < 0.f ? m.x : r.x; o.y = v.y < 0.f ? m.y : r.y; return o;
}

template <class Epi, class Sched, bool ALIGN_EPI = false, bool SP2 = false>
__device__ __forceinline__ void gemm_phase(PG8_LAS unsigned char* lds, const Gemm g, const Sched& S, const Epi& E) {
    int tid_ = threadIdx.x; asm volatile("" : "+v"(tid_));
    const int tid = tid_, wid = __builtin_amdgcn_readfirstlane(tid >> 6), lane = tid & 63, wr = wid >> 2, wc = wid & 3, fr = lane & 15, fq = lane >> 4;
    const int K = g.K, nt = K / BK;
    unsigned voffA[2], voffB[2];
#pragma unroll
    for (int i = 0; i < 2; ++i) { int R, C; stage_rc(tid * 16 + i * 8192, R, C); const int Rb = Epi::PERM ? ((R & ~31) + perm32(R & 31)) : R;
        voffA[i] = (unsigned)(R * g.lda + C) * 2u; voffB[i] = (unsigned)(Rb * g.ldb + C) * 2u; }
    const size_t kstep = (size_t)(BK * 2);
    const size_t hstepA = (size_t)HALF * g.lda * 2, hstepB = (size_t)HALF * g.ldb * 2;
    const size_t tstepA = 2 * hstepA, tstepB = 2 * hstepB;
    const unsigned ldsw = (unsigned)wid * 1024u;
    const int aoff = lds_byte(wr * 64 + fr, fq * 8), boff = lds_byte(wc * 32 + fr, fq * 8);
#define PG8_SA(b, h) (((b) * 2 + (h)) * HTB)
#define PG8_SB(b, h) ((4 + (b) * 2 + (h)) * HTB)
#define PG8_STAGE(bufoff, gbase, voff) do { _Pragma("unroll") for (int _i = 0; _i < 2; ++_i) \
        __builtin_amdgcn_global_load_lds((const unsigned*)((const char*)(gbase) + (voff)[_i]), (PG8_LAS unsigned*)(lds + (bufoff) + ldsw + _i * 8192), 16, 0, 0); } while (0)
#define PG8_LDA(dst, b, h) do { _Pragma("unroll") for (int m = 0; m < 4; ++m) _Pragma("unroll") for (int k = 0; k < 2; ++k) dst[m][k] = *(const PG8_LAS bf16x8*)(lds + PG8_SA(b, h) + aoff + m * 2048 + k * 1024); } while (0)
#define PG8_LDB(dst, b, h) do { _Pragma("unroll") for (int n = 0; n < 2; ++n) _Pragma("unroll") for (int k = 0; k < 2; ++k) dst[n][k] = *(const PG8_LAS bf16x8*)(lds + PG8_SB(b, h) + boff + n * 2048 + k * 1024); } while (0)
#define PG8_MMA(ai, bj, At, Bt) do { __builtin_amdgcn_s_setprio(1); _Pragma("unroll") for (int m = 0; m < 4; ++m) _Pragma("unroll") for (int n = 0; n < 2; ++n) _Pragma("unroll") for (int k = 0; k < 2; ++k) \
        acc[ai][bj][m][n] = __builtin_amdgcn_mfma_f32_16x16x32_bf16(Bt[n][k], At[m][k], acc[ai][bj][m][n], 0, 0, 0); __builtin_amdgcn_s_setprio(0); } while (0)
#define PG8_WAIT_V(n) asm volatile("s_waitcnt vmcnt(" #n ")" ::: "memory")
#define PG8_WAIT_L(n) asm volatile("s_waitcnt lgkmcnt(" #n ")" ::: "memory")
#define PG8_BAR __builtin_amdgcn_s_barrier()
#define PG8_SCHED __builtin_amdgcn_sched_barrier(0)
    Unit cur, nxt; int ui = 0;
    if (!S.next(0, cur)) return;
    f32x4 acc[2][2][4][2];
#pragma unroll
    for (int a = 0; a < 2; ++a)
#pragma unroll
        for (int b = 0; b < 2; ++b)
#pragma unroll
            for (int m = 0; m < 4; ++m)
#pragma unroll
                for (int n = 0; n < 2; ++n) acc[a][b][m][n] = (f32x4){0.f, 0.f, 0.f, 0.f};
    bf16x8 At[4][2], B0[2][2], B1[2][2];
    const char* cA = (const char*)g.A + (size_t)cur.gz * g.gsA * 2 + (size_t)cur.pm * tstepA; const char* cB = (const char*)g.Bt + (size_t)cur.gz * g.gsB * 2 + (size_t)cur.pn * tstepB;
    S.a_ready(cur);
    if constexpr (SP2) {
        PG8_STAGE(PG8_SB(0, 0), cB, voffB); PG8_STAGE(PG8_SB(0, 1), cB + hstepB, voffB); PG8_STAGE(PG8_SA(0, 0), cA, voffA); PG8_STAGE(PG8_SA(0, 1), cA + hstepA, voffA);
        if (wr == 1) PG8_BAR;
        PG8_WAIT_V(2); PG8_BAR;
        PG8_STAGE(PG8_SB(1, 0), cB + kstep, voffB); PG8_STAGE(PG8_SA(1, 0), cA + kstep, voffA); PG8_STAGE(PG8_SB(1, 1), cB + hstepB + kstep, voffB);
        PG8_WAIT_V(6); PG8_BAR;
    } else {
        PG8_STAGE(PG8_SB(0, 0), cB, voffB); PG8_STAGE(PG8_SA(0, 0), cA, voffA); PG8_STAGE(PG8_SB(0, 1), cB + hstepB, voffB); PG8_STAGE(PG8_SA(0, 1), cA + hstepA, voffA);
        if (wr == 1) PG8_BAR;
        PG8_WAIT_V(4); PG8_BAR;
        PG8_STAGE(PG8_SB(1, 0), cB + kstep, voffB); PG8_STAGE(PG8_SA(1, 0), cA + kstep, voffA); PG8_STAGE(PG8_SB(1, 1), cB + hstepB + kstep, voffB);
        PG8_WAIT_V(6); PG8_BAR;
    }
    for (;;) {
        const bool has_next = S.next(ui + 1, nxt);
        const char* nA = has_next ? (const char*)g.A + (size_t)nxt.gz * g.gsA * 2 + (size_t)nxt.pm * tstepA : cA; const char* nB = has_next ? (const char*)g.Bt + (size_t)nxt.gz * g.gsB * 2 + (size_t)nxt.pn * tstepB : cB;
        for (int t = 0; t < nt; t += 2) {
            const bool last = (t == nt - 2);
            const char* a1 = cA + (size_t)(t + 1) * kstep;
            const char* a2 = last ? nA : cA + (size_t)(t + 2) * kstep; const char* b2 = last ? nB : cB + (size_t)(t + 2) * kstep;
            const char* a3 = a2 + kstep; const char* b3 = b2 + kstep;
            if (last && has_next) S.a_ready(nxt);
            if constexpr (SP2) {
            PG8_LDB(B0, 0, 0); PG8_LDB(B1, 0, 1); PG8_SCHED; PG8_LDA(At, 0, 0); PG8_STAGE(PG8_SA(1, 1), a1 + hstepA, voffA);
            PG8_WAIT_V(8); PG8_WAIT_L(0); PG8_BAR; PG8_MMA(0, 0, At, B0); PG8_MMA(0, 1, At, B1); PG8_BAR; PG8_SCHED;
            PG8_LDA(At, 0, 1); PG8_STAGE(PG8_SB(0, 0), b2, voffB); PG8_STAGE(PG8_SB(0, 1), b2 + hstepB, voffB); PG8_STAGE(PG8_SA(0, 0), a2, voffA);
            PG8_WAIT_V(8); PG8_WAIT_L(0); PG8_BAR; PG8_MMA(1, 0, At, B0); PG8_MMA(1, 1, At, B1); PG8_BAR; PG8_SCHED;
            PG8_LDB(B0, 1, 0); PG8_LDB(B1, 1, 1); PG8_SCHED; PG8_LDA(At, 1, 0); PG8_STAGE(PG8_SA(0, 1), a2 + hstepA, voffA);
            PG8_WAIT_V(8); PG8_WAIT_L(0); PG8_BAR; PG8_MMA(0, 0, At, B0); PG8_MMA(0, 1, At, B1); PG8_BAR; PG8_SCHED;
            PG8_LDA(At, 1, 1); PG8_STAGE(PG8_SB(1, 0), b3, voffB); PG8_STAGE(PG8_SB(1, 1), b3 + hstepB, voffB); PG8_STAGE(PG8_SA(1, 0), a3, voffA);
            PG8_WAIT_V(8); PG8_WAIT_L(0); PG8_BAR; PG8_MMA(1, 0, At, B0); PG8_MMA(1, 1, At, B1); PG8_BAR; PG8_SCHED;
            } else {
            PG8_LDB(B0, 0, 0); PG8_SCHED; PG8_LDA(At, 0, 0); PG8_STAGE(PG8_SA(1, 1), a1 + hstepA, voffA);
            PG8_WAIT_L(8); PG8_BAR; PG8_WAIT_L(0); PG8_MMA(0, 0, At, B0); PG8_BAR; PG8_SCHED;
            PG8_LDB(B1, 0, 1); PG8_STAGE(PG8_SB(0, 0), b2, voffB);
            PG8_BAR; PG8_WAIT_L(0); PG8_MMA(0, 1, At, B1); PG8_BAR;
            PG8_LDA(At, 0, 1); PG8_STAGE(PG8_SA(0, 0), a2, voffA);
            PG8_BAR; PG8_WAIT_L(0); PG8_MMA(1, 0, At, B0); PG8_BAR; PG8_SCHED;
            PG8_STAGE(PG8_SB(0, 1), b2 + hstepB, voffB);
            PG8_WAIT_V(6); PG8_BAR; PG8_MMA(1, 1, At, B1); PG8_BAR;
            PG8_LDB(B0, 1, 0); PG8_SCHED; PG8_LDA(At, 1, 0); PG8_STAGE(PG8_SA(0, 1), a2 + hstepA, voffA);
            PG8_WAIT_L(8); PG8_BAR; PG8_WAIT_L(0); PG8_MMA(0, 0, At, B0); PG8_BAR; PG8_SCHED;
            PG8_LDB(B1, 1, 1); PG8_STAGE(PG8_SB(1, 0), b3, voffB);
            PG8_BAR; PG8_WAIT_L(0); PG8_MMA(0, 1, At, B1); PG8_BAR;
            PG8_LDA(At, 1, 1); PG8_STAGE(PG8_SA(1, 0), a3, voffA);
            PG8_BAR; PG8_WAIT_L(0); PG8_MMA(1, 0, At, B0); PG8_BAR; PG8_SCHED;
            PG8_STAGE(PG8_SB(1, 1), b3 + hstepB, voffB);
            PG8_WAIT_V(6); PG8_BAR; PG8_MMA(1, 1, At, B1); PG8_BAR;
            }
        }
        if constexpr (ALIGN_EPI) { if (wr == 0) PG8_BAR; }
        if constexpr (!Epi::AFTER_DRAIN) { E(acc, cur, wr, wc, fr, fq); S.done(cur); }
        if (!has_next) break;
#pragma unroll
        for (int a = 0; a < 2; ++a)
#pragma unroll
            for (int b = 0; b < 2; ++b)
#pragma unroll
                for (int m = 0; m < 4; ++m)
#pragma unroll
                    for (int n = 0; n < 2; ++n) acc[a][b][m][n] = (f32x4){0.f, 0.f, 0.f, 0.f};
        cur = nxt; cA = nA; cB = nB; ++ui;
        if constexpr (ALIGN_EPI) { if (wr == 1) PG8_BAR; }
    }
    PG8_WAIT_V(0);
    if constexpr (!ALIGN_EPI) { if (wr == 0) PG8_BAR; }
    PG8_BAR;
    if constexpr (Epi::AFTER_DRAIN) { E.fused(acc, cur, wr, wc, fr, fq, lds, wid, lane); S.done(cur); }
#undef PG8_SA
#undef PG8_SB
#undef PG8_STAGE
#undef PG8_LDA
#undef PG8_LDB
#undef PG8_MMA
#undef PG8_WAIT_V
#undef PG8_WAIT_L
#undef PG8_BAR
#undef PG8_SCHED
}
}
#include <hip/hip_bf16.h>
#include <cmath>
namespace attn_body {
using bf16=__hip_bfloat16;
using bf16x8=__attribute__((ext_vector_type(8)))short;
using s16x4=__attribute__((ext_vector_type(4)))short;
using f32x16=__attribute__((ext_vector_type(16)))float;
using u32x4=__attribute__((ext_vector_type(4)))unsigned;
using f32x4=__attribute__((ext_vector_type(4)))float;
constexpr int BATCH=4,NHEAD=8,SEQ=4096,D=64,DM=NHEAD*D,OPITCH=1024;
constexpr int NW=8,QBLK=32,QB=QBLK*NW,KVBLK=64,NQB=SEQ/QB;
constexpr int ATTN_PITCH=DM, ATTN_UNIT_ROWS=QB;
__device__ __forceinline__ int crow(int r,int hi){return (r&3)+8*(r>>2)+4*hi;}
#define SBAR() __builtin_amdgcn_sched_barrier(0)
__device__ __forceinline__ void cmask(f32x16&p0,f32x16&p1,int jb,int qrel,int hi){
  const float NEG=-INFINITY; int kb=64*jb+4*hi;
  #pragma unroll
  for(int r=0;r<16;++r){int kv=kb+(r&3)+8*(r>>2); if(kv>qrel)p0[r]=NEG; if(kv+32>qrel)p1[r]=NEG;}
}

constexpr int NSLOT=3, SLOTB=8192;
constexpr int LDS_K=0, LDS_V=NSLOT*SLOTB, LDS_WS=2*NSLOT*SLOTB, LDS_OST=LDS_WS+NW*64*4, LDS_CB=LDS_OST+NW*4096, LDS_BYTES=LDS_CB+SEQ*4;
constexpr float C2=0.125f*1.4426950408889634f;
__device__ __forceinline__ void glds16(const void*gsrc,unsigned lds_dst){unsigned keep;
  asm volatile("s_mov_b32 %0, m0\n\ts_mov_b32 m0, %2\n\ts_nop 0\n\tglobal_load_lds_dwordx4 %1, off\n\ts_mov_b32 m0, %0":"=&s"(keep):"v"(gsrc),"s"(lds_dst):"memory");}
__device__ __forceinline__ float max3f(float a,float b,float c){float r;asm("v_max3_f32 %0, %1, %2, %3":"=v"(r):"v"(a),"v"(b),"v"(c));return r;}
__device__ __forceinline__ float max2f(float a,float b){float r;asm("v_max_f32_e32 %0, %1, %2":"=v"(r):"v"(a),"v"(b));return r;}
__device__ __forceinline__ float fadd_s(float a,float b){float r;asm("v_add_f32_e32 %0, %1, %2":"=v"(r):"v"(a),"v"(b));return r;}
__device__ __forceinline__ float fsub_s(float a,float b){float r;asm("v_sub_f32_e32 %0, %1, %2":"=v"(r):"v"(a),"v"(b));return r;}
typedef float f32x2_t __attribute__((ext_vector_type(2))); typedef __bf16 bf16x2_t __attribute__((ext_vector_type(2)));
__device__ __forceinline__ unsigned cvtpk_s(float lo,float hi){f32x2_t v={lo,hi};bf16x2_t b=__builtin_convertvector(v,bf16x2_t);return __builtin_bit_cast(unsigned,b);}
#define WAIT_BAR(N) asm volatile("s_waitcnt vmcnt(" #N ") lgkmcnt(0)\n\ts_barrier":::"memory")

__device__ __forceinline__ void qkt(f32x16&p0,f32x16&p1,const char*Kslot,const bf16x8*qr,const char*cbt,int r32,int hi){
  const char*kb=Kslot+hi*1024+r32*16;
  #pragma unroll
  for(int a=0;a<4;++a){ const f32x4 u0=*reinterpret_cast<const f32x4*>(cbt+hi*16+a*32), u1=*reinterpret_cast<const f32x4*>(cbt+128+hi*16+a*32);
    p0[4*a]=u0[0];p0[4*a+1]=u0[1];p0[4*a+2]=u0[2];p0[4*a+3]=u0[3]; p1[4*a]=u1[0];p1[4*a+1]=u1[1];p1[4*a+2]=u1[2];p1[4*a+3]=u1[3]; }
  #pragma unroll
  for(int d0=0;d0<4;++d0){
    const bf16x8 b0=*reinterpret_cast<const bf16x8*>(kb+d0*2048);
    const bf16x8 b1=*reinterpret_cast<const bf16x8*>(kb+d0*2048+512);
    p0=__builtin_amdgcn_mfma_f32_32x32x16_bf16(b0,qr[d0],p0,0,0,0);p1=__builtin_amdgcn_mfma_f32_32x32x16_bf16(b1,qr[d0],p1,0,0,0);}
}
typedef __attribute__((address_space(3))) const char* lds_cptr;
typedef short v4i16_t __attribute__((ext_vector_type(4)));
__device__ __forceinline__ void kload8(bf16x8*kf,lds_cptr kp){
  kf[0]=*(const __attribute__((address_space(3))) bf16x8*)(kp);      kf[1]=*(const __attribute__((address_space(3))) bf16x8*)(kp+512);
  kf[2]=*(const __attribute__((address_space(3))) bf16x8*)(kp+2048); kf[3]=*(const __attribute__((address_space(3))) bf16x8*)(kp+2560);
  kf[4]=*(const __attribute__((address_space(3))) bf16x8*)(kp+4096); kf[5]=*(const __attribute__((address_space(3))) bf16x8*)(kp+4608);
  kf[6]=*(const __attribute__((address_space(3))) bf16x8*)(kp+6144); kf[7]=*(const __attribute__((address_space(3))) bf16x8*)(kp+6656);
}
__device__ __forceinline__ void kload2(bf16x8*kf,lds_cptr kp,int j){ kf[2*j]=*(const __attribute__((address_space(3))) bf16x8*)(kp+j*2048); kf[2*j+1]=*(const __attribute__((address_space(3))) bf16x8*)(kp+j*2048+512); }
__device__ __forceinline__ s16x4 vtr(lds_cptr p){ return __builtin_bit_cast(s16x4,__builtin_amdgcn_ds_read_tr16_b64_v4i16((__attribute__((address_space(3))) v4i16_t*)p)); }
__device__ __forceinline__ float rowmax(const f32x16&p0,const f32x16&p1){
  float a=max3f(p0[0],p0[1],p1[0]),b=max3f(p0[2],p0[3],p1[1]);a=max3f(a,p1[2],p1[3]);
  #pragma unroll
  for(int r=4;r<16;r+=4){a=max3f(a,p0[r],p0[r+1]);b=max3f(b,p0[r+2],p0[r+3]);a=max3f(a,p1[r],p1[r+1]);b=max3f(b,p1[r+2],p1[r+3]);}
  const float m=max2f(a,b);
  auto rr=__builtin_amdgcn_permlane32_swap(__float_as_uint(m),__float_as_uint(m),false,false);
  return max2f(__uint_as_float(rr[0]),__uint_as_float(rr[1]));
}
__device__ __forceinline__ void pv(f32x16*o,int vb,bf16x8 pa0,bf16x8 pa1,bf16x8 pa2,bf16x8 pa3){
  #pragma unroll
  for(int d0=0;d0<2;++d0){s16x4 lo[4],hi[4];
    #pragma unroll
    for(int ks=0;ks<4;++ks){
      asm volatile("ds_read_b64_tr_b16 %0,%1 offset:%c2":"=&v"(lo[ks]):"v"(vb),"i"(d0*4096+ks*1024):"memory");
      asm volatile("ds_read_b64_tr_b16 %0,%1 offset:%c2":"=&v"(hi[ks]):"v"(vb),"i"(d0*4096+ks*1024+512):"memory");}
    asm volatile("s_waitcnt lgkmcnt(0)":::"memory");SBAR();
    #define PK(k) (bf16x8){lo[k][0],lo[k][1],lo[k][2],lo[k][3],hi[k][0],hi[k][1],hi[k][2],hi[k][3]}
    o[d0]=__builtin_amdgcn_mfma_f32_32x32x16_bf16(pa0,PK(0),o[d0],0,0,0);
    o[d0]=__builtin_amdgcn_mfma_f32_32x32x16_bf16(pa1,PK(1),o[d0],0,0,0);
    o[d0]=__builtin_amdgcn_mfma_f32_32x32x16_bf16(pa2,PK(2),o[d0],0,0,0);
    o[d0]=__builtin_amdgcn_mfma_f32_32x32x16_bf16(pa3,PK(3),o[d0],0,0,0);
    #undef PK
  }
}

#ifndef ATTN_STORE16
#define ATTN_STORE16(p,v) (*(u32x4*)(p)=(v))
#endif
template<int THRL> __device__ __forceinline__ void attn_unit(int b,int h,int qb,const bf16*Q,const bf16*__restrict__ K,const bf16*__restrict__ V,bf16*O,const float*__restrict__ CB,char*shm){
  int tid_=threadIdx.x; asm volatile("":"+v"(tid_)); const int tid=tid_,lane=tid&63,r32=lane&31,hi=lane>>5; const int wid=__builtin_amdgcn_readfirstlane(tid>>6);
  const long rowbase=(long)b*SEQ; const int q0=qb*QB;
  const bf16*Qw=Q+(rowbase+q0+wid*QBLK)*DM+h*D;
  const bf16*Kh=K+rowbase*DM+h*D,*Vh=V+rowbase*DM+h*D;
  const unsigned lds0=(unsigned)(uintptr_t)shm;
  float*wsf=(float*)(shm+LDS_WS)+wid*64;
  const bf16*ksrc=Kh+(long)lane*DM+wid*8;
  const bf16*vsrc=Vh+(long)(16*(wid&3)+(lane>>2))*DM+(wid>>2)*32+(lane&3)*8;
  const unsigned kdst=lds0+LDS_K+wid*1024, vdst=lds0+LDS_V+wid*1024;
  #define DMA_K(t,slot) glds16(ksrc+(long)(t)*KVBLK*DM,(unsigned)__builtin_amdgcn_readfirstlane(kdst+(slot)))
  #define DMA_V(t,slot) glds16(vsrc+(long)(t)*KVBLK*DM,(unsigned)__builtin_amdgcn_readfirstlane(vdst+(slot)))
  const int vb0=(int)(lds0+LDS_V)+((lane>>4)&1)*32+(lane&3)*8+(4*hi+((lane&15)>>2))*64;
  const char*Kbase=shm+LDS_K; bf16x8 kf[8];
  const lds_cptr shm3=(lds_cptr)shm; const lds_cptr kp0=shm3+LDS_K+hi*1024+r32*16; const lds_cptr vp0=shm3+LDS_V+((lane>>4)&1)*32+(lane&3)*8+(4*hi+((lane&15)>>2))*64;
  const int NT=(q0+QB)/KVBLK;
  { const f32x4* cbg=reinterpret_cast<const f32x4*>(CB+(long)(b*NHEAD+h)*SEQ); f32x4* cbl=reinterpret_cast<f32x4*>(shm+LDS_CB); const int nv=(q0+QB)/4;
    for(int i=tid;i<nv;i+=NW*64) cbl[i]=cbg[i];
    asm volatile("s_waitcnt vmcnt(0) lgkmcnt(0)\n\ts_barrier":::"memory"); }
  const lds_cptr cb3=(lds_cptr)shm+LDS_CB;
  DMA_K(0,0);DMA_V(0,0);DMA_K(1,SLOTB);
  bf16x8 qr[4];
  #pragma unroll
  for(int d0=0;d0<4;++d0)qr[d0]=*reinterpret_cast<const bf16x8*>(&Qw[(long)r32*DM+d0*16+hi*8]);
  float mhat=0.f,l_reg=0.f;f32x16 o[2];o[0]=f32x16{};o[1]=f32x16{};
  const int qrel=wid*QBLK+r32;
  #define CMASK(P0,P1,t) do{int jb_=(t)-(NT-4); if(jb_>=0)cmask(P0,P1,jb_,qrel,hi);}while(0)
  bool resc=false;
  #define START(P0,P1) do{ const float rm=rowmax(P0,P1); resc=false; \
    { const float dl=rm; mhat=fadd_s(mhat,dl); \
      _Pragma("unroll") for(int r=0;r<16;++r){P0[r]=fsub_s(P0[r],dl);P1[r]=fsub_s(P1[r],dl);} } \
    _Pragma("unroll") for(int r=0;r<16;++r)P0[r]=__builtin_amdgcn_exp2f(P0[r]); }while(0)
  #define RESC() do{ if(resc){ asm volatile("s_waitcnt lgkmcnt(0)":::"memory"); \
      _Pragma("unroll") for(int d_=0;d_<2;++d_) _Pragma("unroll") for(int r=0;r<16;++r)o[d_][r]*=wsf[crow(r,hi)]; } }while(0)
  f32x16 pA0,pA1,pB0,pB1;
  int sl_prev=0,sl_cur=0,sl_next=SLOTB;
  #define ROT() do{sl_prev=sl_cur;sl_cur=sl_next;sl_next=(sl_next==(NSLOT-1)*SLOTB)?0:sl_next+SLOTB;}while(0)
  DMA_K(2,2*SLOTB);
  WAIT_BAR(3);
  qkt(pA0,pA1,Kbase,qr,shm+LDS_CB,r32,hi);asm volatile("s_nop 15\n\ts_nop 7":"+v"(pA0),"+v"(pA1));CMASK(pA0,pA1,0);
  START(pA0,pA1);
  _Pragma("unroll") for(int r=0;r<16;++r)pA1[r]=__builtin_amdgcn_exp2f(pA1[r]);
  WAIT_BAR(0);
  DMA_K(3,0);DMA_V(1,SLOTB);
  ROT();
  kload8(kf,kp0+sl_cur);
  WAIT_BAR(2);
  s16x4 vlo[8],vhi[8]; u32x4 pw0,pw1,pw2,pw3;
  #define PKW(P,B) cvtpk_s(P[B],P[B+1])
  #define PAF(k) __builtin_bit_cast(bf16x8,pw##k)
  #define VFR(i) (bf16x8){vlo[i][0],vlo[i][1],vlo[i][2],vlo[i][3],vhi[i][0],vhi[i][1],vhi[i][2],vhi[i][3]}
  #define PIN(x) asm volatile("":"+v"(x))
  #define MX3(a,b,c) __builtin_fmaxf(__builtin_fmaxf((a),(b)),(c))
  #define GAPA(MF,A0,A1,A2,A3,W0,W1,PW) do{ MF; sacc+=A0; sacc+=A1; sacc+=A2; sacc+=A3; PIN(sacc); W0; W1; PIN(PW); SBAR(); }while(0)
  #define EX(v) __builtin_amdgcn_exp2f(v)
  #define GAPB(MF,X,B) do{ MF; X[B]=EX(X[B]); X[B+1]=EX(X[B+1]); X[B+2]=EX(X[B+2]); X[B+3]=EX(X[B+3]); PIN(X); SBAR(); }while(0)
  #define VRD(i) do{ vlo[i]=vtr(vp_+(((i)>>2)*4096+((i)&3)*1024)); vhi[i]=vtr(vp_+(((i)>>2)*4096+((i)&3)*1024+512)); }while(0)
  #define KRD(G,j) do{ if(G){ kload2(kf,kp0+sl_next,j); SBAR(); } }while(0)
  #define STEP(C0,C1,P0,P1,t,GK,GV,GL) do{ SBAR(); \
    { const __attribute__((address_space(3))) f32x4* cbp_=(const __attribute__((address_space(3))) f32x4*)(cb3+(t)*256+hi*16); \
      _Pragma("unroll") for(int a_=0;a_<4;++a_){ const f32x4 u0_=cbp_[2*a_], u1_=cbp_[8+2*a_]; \
        C0[4*a_]=u0_[0]-mhat;C0[4*a_+1]=u0_[1]-mhat;C0[4*a_+2]=u0_[2]-mhat;C0[4*a_+3]=u0_[3]-mhat; \
        C1[4*a_]=u1_[0]-mhat;C1[4*a_+1]=u1_[1]-mhat;C1[4*a_+2]=u1_[2]-mhat;C1[4*a_+3]=u1_[3]-mhat; } } SBAR(); \
    const lds_cptr vp_=vp0+sl_prev; \
    VRD(0); SBAR(); float sacc=(P0[0]+P0[1]); \
    GAPA(C0=__builtin_amdgcn_mfma_f32_32x32x16_bf16(kf[0],qr[0],C0,0,0,0), P0[2],P0[3],P0[4],P0[5],     pw0[0]=PKW(P0,0), pw0[1]=PKW(P0,2), pw0); \
    VRD(4); SBAR(); GAPA(C1=__builtin_amdgcn_mfma_f32_32x32x16_bf16(kf[1],qr[0],C1,0,0,0), P0[6],P0[7],P0[8],P0[9],     pw0[2]=PKW(P0,4), pw0[3]=PKW(P0,6), pw0); \
    VRD(1); SBAR(); GAPA(C0=__builtin_amdgcn_mfma_f32_32x32x16_bf16(kf[2],qr[1],C0,0,0,0),   P0[10],P0[11],P0[12],P0[13], pw1[0]=PKW(P0,8), pw1[1]=PKW(P0,10), pw1); \
    VRD(5); SBAR(); GAPA(C1=__builtin_amdgcn_mfma_f32_32x32x16_bf16(kf[3],qr[1],C1,0,0,0),   P0[14],P0[15],P1[0],P1[1],   pw1[2]=PKW(P0,12),pw1[3]=PKW(P0,14), pw1); \
    VRD(2); SBAR(); GAPA(C0=__builtin_amdgcn_mfma_f32_32x32x16_bf16(kf[4],qr[2],C0,0,0,0),   P1[2],P1[3],P1[4],P1[5],     pw2[0]=PKW(P1,0), pw2[1]=PKW(P1,2), pw2); \
    VRD(6); SBAR(); GAPA(C1=__builtin_amdgcn_mfma_f32_32x32x16_bf16(kf[5],qr[2],C1,0,0,0),   P1[6],P1[7],P1[8],P1[9],     pw2[2]=PKW(P1,4), pw2[3]=PKW(P1,6), pw2); \
    VRD(3); SBAR(); GAPA(C0=__builtin_amdgcn_mfma_f32_32x32x16_bf16(kf[6],qr[3],C0,0,0,0),   P1[10],P1[11],P1[12],P1[13], pw3[0]=PKW(P1,8), pw3[1]=PKW(P1,10), pw3); \
    VRD(7); SBAR(); GAPA(C1=__builtin_amdgcn_mfma_f32_32x32x16_bf16(kf[7],qr[3],C1,0,0,0),   P1[14],P1[15],0.f,0.f,       pw3[2]=PKW(P1,12),pw3[3]=PKW(P1,14), pw3); \
    l_reg+=sacc; \
    if(GK){DMA_K((t)+3,sl_cur);} if(GV){DMA_V((t)+1,sl_next);} \
    CMASK(C0,C1,t); \
    { float a=MX3(C0[0],C0[1],C1[0]),b=MX3(C0[2],C0[3],C1[1]); a=MX3(a,C1[2],C1[3]); \
      _Pragma("unroll") for(int r=4;r<16;r+=4){a=MX3(a,C0[r],C0[r+1]);b=MX3(b,C0[r+2],C0[r+3]);a=MX3(a,C1[r],C1[r+1]);b=MX3(b,C1[r+2],C1[r+3]);} \
      float rm=__builtin_fmaxf(a,b); { auto rr=__builtin_amdgcn_permlane32_swap(__float_as_uint(rm),__float_as_uint(rm),false,false); rm=__builtin_fmaxf(__uint_as_float(rr[0]),__uint_as_float(rr[1])); } \
      resc=false; \
      if(__builtin_expect(__any(rm>(float)THRL),0)){ const float dl=__builtin_fmaxf(rm,0.f); mhat+=dl; \
        _Pragma("unroll") for(int r=0;r<16;++r){C0[r]-=dl;C1[r]-=dl;} \
        const float f=__builtin_amdgcn_exp2f(-dl); l_reg*=f; if(hi==0)wsf[r32]=f; resc=true; } } \
    SBAR(); \
    GAPB(o[0]=__builtin_amdgcn_mfma_f32_32x32x16_bf16(PAF(0),VFR(0),o[0],0,0,0), C0,0); \
    GAPB(o[1]=__builtin_amdgcn_mfma_f32_32x32x16_bf16(PAF(0),VFR(4),o[1],0,0,0), C0,4); \
    KRD(GL,0); GAPB(o[0]=__builtin_amdgcn_mfma_f32_32x32x16_bf16(PAF(1),VFR(1),o[0],0,0,0), C0,8); \
    KRD(GL,1); GAPB(o[1]=__builtin_amdgcn_mfma_f32_32x32x16_bf16(PAF(1),VFR(5),o[1],0,0,0), C0,12); \
    KRD(GL,2); GAPB(o[0]=__builtin_amdgcn_mfma_f32_32x32x16_bf16(PAF(2),VFR(2),o[0],0,0,0), C1,0); \
    KRD(GL,3); GAPB(o[1]=__builtin_amdgcn_mfma_f32_32x32x16_bf16(PAF(2),VFR(6),o[1],0,0,0), C1,4); \
    GAPB(o[0]=__builtin_amdgcn_mfma_f32_32x32x16_bf16(PAF(3),VFR(3),o[0],0,0,0), C1,8); \
    GAPB(o[1]=__builtin_amdgcn_mfma_f32_32x32x16_bf16(PAF(3),VFR(7),o[1],0,0,0), C1,12); \
    }while(0)
  int t=1;
  #undef CMASK
  #define CMASK(P0,P1,t) do{}while(0)
  for(;t+5<NT;t+=2){
    STEP(pB0,pB1,pA0,pA1,t,true,true,true);     WAIT_BAR(2); RESC(); ROT();
    STEP(pA0,pA1,pB0,pB1,t+1,true,true,true);   WAIT_BAR(2); RESC(); ROT();
  }
  #undef CMASK
  #define CMASK(P0,P1,t) do{int jb_=(t)-(NT-4); if(jb_>=0)cmask(P0,P1,jb_,qrel,hi);}while(0)
  #define ENDW(tt) do{ if((tt)+3<NT){WAIT_BAR(2);} else if((tt)+2<NT){WAIT_BAR(1);} else {WAIT_BAR(0);} }while(0)
  for(;t+1<NT;t+=2){
    STEP(pB0,pB1,pA0,pA1,t,(t+3<NT),(t+1<NT),(t+1<NT));       ENDW(t);   RESC(); ROT();
    STEP(pA0,pA1,pB0,pB1,t+1,(t+4<NT),(t+2<NT),(t+2<NT));     ENDW(t+1); RESC(); ROT();
  }
  STEP(pB0,pB1,pA0,pA1,NT-1,false,false,false); RESC();
  { float sacc=pB0[0]+pB0[1]; _Pragma("unroll") for(int r=2;r<16;++r)sacc+=pB0[r]; _Pragma("unroll") for(int r=0;r<16;++r)sacc+=pB1[r]; l_reg+=sacc;
    pw0=(u32x4){PKW(pB0,0),PKW(pB0,2),PKW(pB0,4),PKW(pB0,6)};pw1=(u32x4){PKW(pB0,8),PKW(pB0,10),PKW(pB0,12),PKW(pB0,14)};pw2=(u32x4){PKW(pB1,0),PKW(pB1,2),PKW(pB1,4),PKW(pB1,6)};pw3=(u32x4){PKW(pB1,8),PKW(pB1,10),PKW(pB1,12),PKW(pB1,14)};
    SBAR(); pv(o,vb0+sl_cur,PAF(0),PAF(1),PAF(2),PAF(3)); }
  #undef PKW
  #undef PAF
  #undef VFR
  #undef PIN
  #undef MX3
  #undef GAPA
  #undef GAPB
  #undef EX
  #undef VRD
  #undef KRD
  #undef STEP
  #undef ENDW
  {auto rr=__builtin_amdgcn_permlane32_swap(__float_as_uint(l_reg),__float_as_uint(l_reg),false,false);l_reg=__uint_as_float(rr[0])+__uint_as_float(rr[1]);}
  if(hi==0)wsf[32+r32]=l_reg;asm volatile("s_waitcnt lgkmcnt(0)":::"memory");
  float rli[16];
  #pragma unroll
  for(int r=0;r<16;++r)rli[r]=__builtin_amdgcn_rcpf(wsf[32+crow(r,hi)]);
  bf16*Ow=O+(rowbase+q0+wid*QBLK)*OPITCH+h*D;
  { bf16*stg=(bf16*)(shm+LDS_OST)+wid*2048;
    #pragma unroll
    for(int r=0;r<16;++r){const int orow=crow(r,hi);
      #pragma unroll
      for(int d0=0;d0<2;++d0)stg[orow*64+d0*32+r32]=__float2bfloat16(o[d0][r]*rli[r]);}
    asm volatile("s_waitcnt lgkmcnt(0)":::"memory");
    #pragma unroll
    for(int i=0;i<4;++i){const int row=i*8+(lane>>3),ch=lane&7; const u32x4 v=*(const u32x4*)(stg+row*64+ch*8); bf16*dst=Ow+(long)row*OPITCH+ch*8; const u32x4 gv=*(const u32x4*)dst; u32x4 w;
      #pragma unroll
      for(int j=0;j<4;++j){ const float a0=__uint_as_float(v[j]<<16)*__uint_as_float(gv[j]<<16), a1=__uint_as_float(v[j]&0xffff0000u)*__uint_as_float(gv[j]&0xffff0000u); w[j]=cvtpk_s(a0,a1); }
      *(u32x4*)dst=w;} }
  asm volatile("s_waitcnt lgkmcnt(0)\n\ts_barrier":::"memory");
  #undef DMA_K
  #undef DMA_V
  #undef CMASK
  #undef START
  #undef RESC
  #undef ROT
}
constexpr int ATTN_LDS_BYTES=LDS_BYTES;
struct AttnTensors { const bf16* Q; const bf16* K; const bf16* V; bf16* O; const float* CB; };
struct AttnUnit { int bh; int qb; };
struct StaticOrder {
  int vcu;
  __device__ __forceinline__ explicit StaticOrder(int grid,int block):vcu((block%8)*(grid/8)+block/8){}
  __device__ __forceinline__ bool next(int i,AttnUnit&u)const{ if(i>=2)return false; const int s=vcu&7; u.bh=vcu>>3; u.qb=(i==0)?15-s:s; return true; }
  __device__ __forceinline__ void a_ready(const AttnUnit&)const{}
  __device__ __forceinline__ void done(const AttnUnit&)const{}
};
template<class Sched,int THRL=8> __device__ __forceinline__ void attn_phase(char*lds,const AttnTensors&T,const Sched&S){
  AttnUnit u;
  for(int i=0;S.next(i,u);++i){ S.a_ready(u); attn_unit<THRL>(u.bh/NHEAD,u.bh%NHEAD,u.qb,T.Q,T.K,T.V,T.O,T.CB,lds); S.done(u); }
}
#undef SBAR
#undef WAIT_BAR
}
#include <hip/hip_cooperative_groups.h>
namespace cg = cooperative_groups;
#define LAS __attribute__((address_space(3)))
typedef unsigned short bf16;
typedef float f32x4 __attribute__((ext_vector_type(4)));
typedef float f32x2 __attribute__((ext_vector_type(2)));
typedef unsigned u32x4 __attribute__((ext_vector_type(4)));
typedef unsigned u32x2 __attribute__((ext_vector_type(2)));
typedef short bf16x8 __attribute__((ext_vector_type(8)));
typedef short bf16x4 __attribute__((ext_vector_type(4)));

constexpr int NWAVES = 8, NTHR = 512;
constexpr int BATCH = 4, SEQ = 4096, DM = 1024, DEPTH = 4, M = BATCH * SEQ;
constexpr int NIN = 3592, NF = 3584;
constexpr int T5 = 32, NCH5 = M / T5, KA5 = 640, NG5 = 16;
constexpr float EPS = 1e-6f;
constexpr float LOG2E = 1.4426950408889634f;

constexpr size_t MiB = 1u << 20;
constexpr size_t WS_WIN = 1 * MiB, WS_WO = 29 * MiB, WS_WGLU = 37 * MiB, WS_ROPE = 38 * MiB, WS_MF = 39 * MiB, WS_WB = 79 * MiB;
constexpr size_t WS_LAM = 88 * MiB, WS_LOGF = 88 * MiB + 65536, WS_CB = WS_LOGF + 524288;
constexpr size_t WS_XN = 90 * MiB, WS_E = WS_XN, WS_UPD = WS_XN + 4 * MiB, WS_STATE = WS_XN + 20 * MiB;
constexpr size_t WS_QO = 122 * MiB, WS_KB = 138 * MiB, WS_VB = 154 * MiB, WS_SUA = 170 * MiB, WS_RQ = 180 * MiB, WS_RK = 188 * MiB, WS_RKT = 196 * MiB, WS_YS5 = WS_RKT;
constexpr size_t WS_RVT = 204 * MiB, WS_GATE = 212 * MiB, WS_END = 244 * MiB;

constexpr int RING_BYTES = 131072, LDS_BYTES = 147456;

struct Args { const float* in[16]; float* out; unsigned char* ws; };

__device__ __forceinline__ float bf2f(unsigned short b) { return __uint_as_float((unsigned)b << 16); }
__device__ __forceinline__ float bflo(unsigned w) { return __uint_as_float(w << 16); }
__device__ __forceinline__ float bfhi(unsigned w) { return __uint_as_float(w & 0xffff0000u); }
__device__ __forceinline__ unsigned pk2(float lo, float hi) { return pg8::cvt_pk_bf16(lo, hi); }
__device__ __forceinline__ unsigned short f2bf(float f) { return (unsigned short)(pg8::cvt_pk_bf16(f, 0.f) & 0xffffu); }
__device__ __forceinline__ float wave_sum(float v) {
#pragma unroll
    for (int o = 1; o < 64; o <<= 1) v += __shfl_xor(v, o);
    return v;
}
__device__ __forceinline__ float lg2_gamma(int hh) { return log2f(1.0f - exp2f(-5.0f - (float)hh)); }

__device__ __forceinline__ int win_col(int n) {
    if (n < 1536) return n;
    if (n < 1792) return n + 8;
    if (n < 2304) { const bool q = n < 2048; const int base = q ? 1792 : 2048; const int hh = (n - base) >> 6, pos = (n - base) & 63; const int d = (pos & 1) ? 32 + (pos >> 1) : (pos >> 1); return (q ? 1800 : 2056) + hh * 64 + d; }
    return n + 8;
}
template <bool MAP> __device__ __forceinline__ void p0_transpose_item(const float* W, int K, int Nsrc, int Ndst, bf16* WT, LAS float* scr, int item, int lane) {
    const int nblk = Ndst / 32, kb = item / nblk, nb = item % nblk, k0 = 64 * kb, n0 = 32 * nb;
    const int sc = MAP ? win_col(n0 + (lane & 31)) : n0 + (lane & 31);
#pragma unroll 8
    for (int i = 0; i < 32; ++i) { const int kk = 2 * i + (lane >> 5); scr[kk * 33 + (lane & 31)] = W[(size_t)(k0 + kk) * Nsrc + sc]; }
    asm volatile("s_waitcnt lgkmcnt(0)" ::: "memory");
    const int c = lane & 7;
#pragma unroll
    for (int j = 0; j < 4; ++j) { const int n = (lane >> 3) + 8 * j; const LAS float* s = scr + (8 * c) * 33 + n;
        u32x4 o; o.x = pk2(s[0 * 33], s[1 * 33]); o.y = pk2(s[2 * 33], s[3 * 33]); o.z = pk2(s[4 * 33], s[5 * 33]); o.w = pk2(s[6 * 33], s[7 * 33]);
        *(u32x4*)(WT + (size_t)(n0 + n) * K + k0 + 8 * c) = o; }
    asm volatile("s_waitcnt lgkmcnt(0)" ::: "memory");
}

__device__ __forceinline__ void s5_prep(const Args& a, int l, int g, LAS float* L, int tid) {
    LAS float* LPr = L;
    LAS float* LPi = L + 33 * 64;
    LAS float* Bbr = L + 66 * 64;
    LAS float* Bbi = Bbr + 1024;
    LAS float* Cr = Bbi + 1024;
    LAS float* Ci = Cr + 1024;
    LAS float* KT = Ci + 1024;
    const float* a_re = a.in[4] + (size_t)(l * 16 + g) * 64; const float* a_im = a.in[5] + (size_t)(l * 16 + g) * 64;
    const float* b_re = a.in[6] + (size_t)(l * 16 + g) * 1024; const float* b_im = a.in[7] + (size_t)(l * 16 + g) * 1024;
    const float* c_re = a.in[8] + (size_t)(l * 16 + g) * 1024; const float* c_im = a.in[9] + (size_t)(l * 16 + g) * 1024;
    const float log_dt = a.in[11][l * 16 + g];
    bf16* MF = (bf16*)(a.ws + WS_MF) + (size_t)(l * 16 + g) * 512 * KA5;
    bf16* WB = (bf16*)(a.ws + WS_WB) + (size_t)(l * 16 + g) * 128 * 512;
    float* LAM = (float*)(a.ws + WS_LAM) + (size_t)(l * 16 + g) * 128;
    if (tid < 64) {
        const int p = tid;
        const double dt = exp((double)log_dt), ar = (double)a_re[p], ai = (double)a_im[p];
        const double mag = exp(ar * dt); double sn, cs; sincos(ai * dt, &sn, &cs);
        const double lr = mag * cs, li = mag * sn, den = ar * ar + ai * ai;
        const double fr = ((lr - 1.0) * ar + li * ai) / den, fi = (li * ar - (lr - 1.0) * ai) / den;
#pragma unroll 4
        for (int h = 0; h < 16; ++h) { const double br = (double)b_re[p * 16 + h], bi = (double)b_im[p * 16 + h]; Bbr[p * 16 + h] = (float)(fr * br - fi * bi); Bbi[p * 16 + h] = (float)(fr * bi + fi * br); }
        double pr = 1.0, pi = 0.0;
        for (int j = 0; j <= 32; ++j) { LPr[j * 64 + p] = (float)pr; LPi[j * 64 + p] = (float)pi; const double nr = pr * lr - pi * li, ni = pr * li + pi * lr; pr = nr; pi = ni; }
        LAM[p] = LPr[32 * 64 + p]; LAM[64 + p] = LPi[32 * 64 + p];
    }
    for (int i = tid; i < 1024; i += NTHR) { Cr[i] = c_re[i]; Ci[i] = c_im[i]; }
    __syncthreads();
    for (int e = tid; e < 8192; e += NTHR) {
        const int j = e >> 8, h = (e >> 4) & 15, hp = e & 15; float s = 0.f;
#pragma unroll 4
        for (int p = 0; p < 64; ++p) { const float cr = Cr[h * 64 + p], ci = Ci[h * 64 + p], lr = LPr[j * 64 + p], li = LPi[j * 64 + p];
            const float clr = cr * lr - ci * li, cli = cr * li + ci * lr; s += clr * Bbr[p * 16 + hp] - cli * Bbi[p * 16 + hp]; }
        KT[e] = s;
    }
    __syncthreads();
    for (int q = tid; q < 512 * 64; q += NTHR) {
        const int row = q >> 6, cp = q & 63, s = cp >> 1, h0 = (cp & 1) * 8, t = row >> 4, h = row & 15;
        u32x4 o = (u32x4){0u, 0u, 0u, 0u};
        if (s <= t) { const LAS float* k = KT + ((t - s) * 16 + h) * 16 + h0; o.x = pk2(k[0], k[1]); o.y = pk2(k[2], k[3]); o.z = pk2(k[4], k[5]); o.w = pk2(k[6], k[7]); }
        *(u32x4*)(MF + (size_t)row * KA5 + cp * 8) = o;
    }
    for (int q = tid; q < 512 * 16; q += NTHR) {
        const int row = q >> 4, cp = q & 15, t = row >> 4, h = row & 15; float v[8];
#pragma unroll
        for (int e = 0; e < 8; ++e) { const int jj = cp * 8 + e, p = jj & 63; const float cr = Cr[h * 64 + p], ci = Ci[h * 64 + p], lr = LPr[(t + 1) * 64 + p], li = LPi[(t + 1) * 64 + p];
            v[e] = (jj < 64) ? (cr * lr - ci * li) : -(cr * li + ci * lr); }
        u32x4 o; o.x = pk2(v[0], v[1]); o.y = pk2(v[2], v[3]); o.z = pk2(v[4], v[5]); o.w = pk2(v[6], v[7]);
        *(u32x4*)(MF + (size_t)row * KA5 + 512 + cp * 8) = o;
    }
    for (int q = tid; q < 128 * 64; q += NTHR) {
        const int j = q >> 6, cp = q & 63, s = cp >> 1, h0 = (cp & 1) * 8, p = j & 63; const float lr = LPr[(31 - s) * 64 + p], li = LPi[(31 - s) * 64 + p]; float v[8];
#pragma unroll
        for (int e = 0; e < 8; ++e) { const float br = Bbr[p * 16 + h0 + e], bi = Bbi[p * 16 + h0 + e]; v[e] = (j < 64) ? (lr * br - li * bi) : (lr * bi + li * br); }
        u32x4 o; o.x = pk2(v[0], v[1]); o.y = pk2(v[2], v[3]); o.z = pk2(v[4], v[5]); o.w = pk2(v[6], v[7]);
        *(u32x4*)(WB + (size_t)j * 512 + cp * 8) = o;
    }
    __syncthreads();
}

__device__ __forceinline__ void norm_phase(const Args& a, int l, const float* X, LAS float* WF, int tid, int lane, int gw, int NGW) {
    const float* win = a.in[2] + (size_t)l * DM * NIN;
    for (int i = tid; i < 2048; i += NTHR) { const int k = i >> 1, hf = i & 1; *(LAS f32x4*)(WF + k * 8 + hf * 4) = *(const f32x4*)(win + (size_t)k * NIN + 1536 + hf * 4); }
    __syncthreads();
    const float* gw_ = a.in[1] + (size_t)l * DM; f32x4 gv[4];
#pragma unroll
    for (int j = 0; j < 4; ++j) gv[j] = *((const f32x4*)gw_ + lane + 64 * j);
    bf16* XN = (bf16*)(a.ws + WS_XN); float* LOGF = (float*)(a.ws + WS_LOGF);
    const float bfj = (lane < 8) ? a.in[3][l * 8 + lane] : 0.f;
    for (int m = gw; m < M; m += NGW) {
        const f32x4* xr = (const f32x4*)(X + (size_t)m * DM) + lane; f32x4 v[4]; float ss = 0.f;
#pragma unroll
        for (int j = 0; j < 4; ++j) { v[j] = xr[64 * j]; ss += (v[j].x * v[j].x + v[j].y * v[j].y) + (v[j].z * v[j].z + v[j].w * v[j].w); }
        const float rstd = rsqrtf(wave_sum(ss) * (1.f / DM) + EPS);
        float acc[8];
#pragma unroll
        for (int e = 0; e < 8; ++e) acc[e] = 0.f;
        unsigned long long* o8 = (unsigned long long*)(XN + (size_t)m * DM) + lane;
#pragma unroll
        for (int j = 0; j < 4; ++j) { v[j] = v[j] * rstd * gv[j];
            o8[64 * j] = (unsigned long long)pk2(v[j].x, v[j].y) | ((unsigned long long)pk2(v[j].z, v[j].w) << 32);
#pragma unroll
            for (int q = 0; q < 4; ++q) { const int k = 256 * j + 4 * lane + q; const f32x4 w0 = *(const LAS f32x4*)(WF + k * 8), w1 = *(const LAS f32x4*)(WF + k * 8 + 4); const float hv = v[j][q];
                acc[0] += hv * w0.x; acc[1] += hv * w0.y; acc[2] += hv * w0.z; acc[3] += hv * w0.w; acc[4] += hv * w1.x; acc[5] += hv * w1.y; acc[6] += hv * w1.z; acc[7] += hv * w1.w; } }
        float mine = 0.f;
#pragma unroll
        for (int e = 0; e < 8; ++e) { const float s = wave_sum(acc[e]); if (lane == e) mine = s; }
        if (lane < 8) { const float z = mine + bfj; const float ls = fminf(z, 0.f) - log1pf(expf(-fabsf(z))); LOGF[(size_t)((m >> 12) * 8 + lane) * SEQ + (m & 4095)] = ls; }
    }
    __syncthreads();
}
__device__ __forceinline__ void final_norm(const Args& a, float* X, int lane, int gw, int NGW) {
    f32x4 gv[4];
#pragma unroll
    for (int j = 0; j < 4; ++j) gv[j] = *((const f32x4*)a.in[15] + lane + 64 * j);
    for (int m = gw; m < M; m += NGW) {
        f32x4* xr = (f32x4*)(X + (size_t)m * DM) + lane; f32x4 v[4]; float ss = 0.f;
#pragma unroll
        for (int j = 0; j < 4; ++j) { v[j] = xr[64 * j]; ss += (v[j].x * v[j].x + v[j].y * v[j].y) + (v[j].z * v[j].z + v[j].w * v[j].w); }
        const float rstd = rsqrtf(wave_sum(ss) * (1.f / DM) + EPS);
#pragma unroll
        for (int j = 0; j < 4; ++j) xr[64 * j] = v[j] * rstd * gv[j];
    }
}

struct FlatOrder {
    int nM, nN, nG, G, c;
    __device__ bool next(int i, pg8::Unit& u) const { const int L = i * G + c; if (L >= nG * nM * nN) return false; u.gz = L / (nM * nN); const int r = L % (nM * nN); u.pm = r % nM; u.pn = r / nM; return true; }
    __device__ __forceinline__ void a_ready(const pg8::Unit&) const {}
    __device__ __forceinline__ void done(const pg8::Unit&) const {}
};
__device__ __forceinline__ float silu_f(float v) { return v / (1.f + __expf(-v)); }
__device__ __forceinline__ float gelu_tanh(float v) { const float u = 0.7978845608028654f * (v + 0.044715f * v * v * v); const float e = __expf(2.f * u); const float th = 1.f - 2.f / (e + 1.f); return 0.5f * v * (1.f + th); }

struct EpiInProj {
    static constexpr bool PERM = true, AFTER_DRAIN = false;
    unsigned char* ws;
    __device__ __forceinline__ void operator()(const pg8::f32x4 (&acc)[2][2][4][2], const pg8::Unit& u, int wr, int wc, int fr, int fq) const {
        const int pn = u.pn; const int row0 = u.pm * 256 + wr * 64 + fr, cl0 = wc * 32 + 8 * fq;
        if (pn < 6) {
            bf16* base = (bf16*)(ws + (pn < 2 ? WS_QO : pn < 4 ? WS_KB : WS_VB)); const float sc = pn < 2 ? 0.125f * LOG2E : 1.f; const int cb = (pn & 1) * 256 + cl0;
#pragma unroll
            for (int ai = 0; ai < 2; ++ai)
#pragma unroll
                for (int m = 0; m < 4; ++m) { bf16* rp = base + (size_t)(row0 + ai * 128 + m * 16) * 512 + cb;
#pragma unroll
                    for (int bj = 0; bj < 2; ++bj) { const pg8::f32x4 v0 = acc[ai][bj][m][0] * sc, v1 = acc[ai][bj][m][1] * sc; u32x4 w; w.x = pk2(v0[0], v0[1]); w.y = pk2(v0[2], v0[3]); w.z = pk2(v1[0], v1[1]); w.w = pk2(v1[2], v1[3]); *(u32x4*)(rp + bj * 128) = w; } }
        } else if (pn == 6) {
            bf16* base = (bf16*)(ws + WS_SUA);
#pragma unroll
            for (int ai = 0; ai < 2; ++ai)
#pragma unroll
                for (int m = 0; m < 4; ++m) { const int row = row0 + ai * 128 + m * 16, chunk = row >> 5, t = row & 31;
#pragma unroll
                    for (int bj = 0; bj < 2; ++bj) { const int c = cl0 + bj * 128, g = c >> 4, h0 = c & 15; const pg8::f32x4 v0 = acc[ai][bj][m][0], v1 = acc[ai][bj][m][1]; u32x4 w; w.x = pk2(v0[0], v0[1]); w.y = pk2(v0[2], v0[3]); w.z = pk2(v1[0], v1[1]); w.w = pk2(v1[2], v1[3]);
                        *(u32x4*)(base + ((size_t)(g * 512 + chunk) * KA5 + t * 16 + h0)) = w; } }
        } else if (pn == 7 || pn == 8) {
            const f32x4* rope = (const f32x4*)(ws + WS_ROPE); bf16* base = (bf16*)(ws + (pn == 7 ? WS_RQ : WS_RK)); bf16* RKT = (bf16*)(ws + WS_RKT);
#pragma unroll
            for (int ai = 0; ai < 2; ++ai)
#pragma unroll
                for (int m = 0; m < 4; ++m) { const int row = row0 + ai * 128 + m * 16, b = row >> 12, t = row & 4095;
#pragma unroll
                    for (int bj = 0; bj < 2; ++bj) { const int c = cl0 + bj * 128, hh = c >> 6, pos0 = c & 63; const pg8::f32x4 v0 = acc[ai][bj][m][0], v1 = acc[ai][bj][m][1];
                        const f32x4 r0 = rope[(t * 32 + (pos0 >> 1)) >> 1], r1 = rope[((t * 32 + (pos0 >> 1)) >> 1) + 1];
                        float o[8];
                        o[0] = v0[0] * r0.x - v0[1] * r0.y; o[1] = v0[0] * r0.y + v0[1] * r0.x; o[2] = v0[2] * r0.z - v0[3] * r0.w; o[3] = v0[2] * r0.w + v0[3] * r0.z;
                        o[4] = v1[0] * r1.x - v1[1] * r1.y; o[5] = v1[0] * r1.y + v1[1] * r1.x; o[6] = v1[2] * r1.z - v1[3] * r1.w; o[7] = v1[2] * r1.w + v1[3] * r1.z;
                        u32x4 w; w.x = pk2(o[0], o[1]); w.y = pk2(o[2], o[3]); w.z = pk2(o[4], o[5]); w.w = pk2(o[6], o[7]);
                        *(u32x4*)(base + (size_t)row * 256 + c) = w;
                        if (pn == 8) { const float wk = exp2f(lg2_gamma(hh) * (float)(63 - (t & 63))); bf16* tp = RKT + ((size_t)((b * 4 + hh) * 64 + pos0)) * SEQ + t;
#pragma unroll
                            for (int e = 0; e < 8; ++e) tp[(size_t)e * SEQ] = f2bf(o[e] * wk); } } }
        } else if (pn == 9) {
            bf16* RVT = (bf16*)(ws + WS_RVT);
#pragma unroll
            for (int ai = 0; ai < 2; ++ai)
#pragma unroll
                for (int m = 0; m < 4; ++m) { const int row = row0 + ai * 128 + m * 16, b = row >> 12, t = row & 4095;
#pragma unroll
                    for (int bj = 0; bj < 2; ++bj) { const int c = cl0 + bj * 128, hh = c >> 6, d0 = c & 63; const pg8::f32x4 v0 = acc[ai][bj][m][0], v1 = acc[ai][bj][m][1]; bf16* tp = RVT + ((size_t)((b * 4 + hh) * 64 + d0)) * SEQ + t;
#pragma unroll
                        for (int e = 0; e < 4; ++e) { tp[(size_t)e * SEQ] = f2bf(v0[e]); tp[(size_t)(4 + e) * SEQ] = f2bf(v1[e]); } } }
        } else {
            bf16* base = (bf16*)(ws + WS_GATE); const int cb = (pn - 10) * 256 + cl0;
#pragma unroll
            for (int ai = 0; ai < 2; ++ai)
#pragma unroll
                for (int m = 0; m < 4; ++m) { bf16* rp = base + (size_t)(row0 + ai * 128 + m * 16) * 1024 + cb;
#pragma unroll
                    for (int bj = 0; bj < 2; ++bj) { const pg8::f32x4 v0 = acc[ai][bj][m][0], v1 = acc[ai][bj][m][1]; u32x4 w; w.x = pk2(silu_f(v0[0]), silu_f(v0[1])); w.y = pk2(silu_f(v0[2]), silu_f(v0[3])); w.z = pk2(silu_f(v1[0]), silu_f(v1[1])); w.w = pk2(silu_f(v1[2]), silu_f(v1[3])); *(u32x4*)(rp + bj * 128) = w; } }
        }
    }
};
struct EpiS5E {
    static constexpr bool PERM = false, AFTER_DRAIN = false;
    float* E;
    __device__ __forceinline__ void operator()(const pg8::f32x4 (&acc)[2][2][4][2], const pg8::Unit& u, int wr, int wc, int fr, int fq) const {
        const int row0 = u.pm * 256 + wr * 64 + fr, col0 = wc * 32 + 4 * fq;
#pragma unroll
        for (int ai = 0; ai < 2; ++ai)
#pragma unroll
            for (int m = 0; m < 4; ++m) { float* rp = E + ((size_t)u.gz * NCH5 + row0 + ai * 128 + m * 16) * 128 + col0;
#pragma unroll
                for (int n = 0; n < 2; ++n) *(pg8::f32x4*)(rp + n * 16) = acc[ai][0][m][n]; }
    }
};
struct EpiS5Y {
    static constexpr bool PERM = true, AFTER_DRAIN = false;
    const bf16* SUA; bf16* YS5; const float* dvec;
    __device__ __forceinline__ void operator()(const pg8::f32x4 (&acc)[2][2][4][2], const pg8::Unit& u, int wr, int wc, int fr, int fq) const {
        const int row0 = u.pm * 256 + wr * 64 + fr, cl0 = u.pn * 256 + wc * 32 + 8 * fq; const int g = u.gz;
#pragma unroll
        for (int bj = 0; bj < 2; ++bj) { const int c = cl0 + bj * 128, tt = c >> 4, h0 = c & 15; const f32x4 d0 = *(const f32x4*)(dvec + g * 16 + h0), d1 = *(const f32x4*)(dvec + g * 16 + h0 + 4);
#pragma unroll
            for (int ai = 0; ai < 2; ++ai)
#pragma unroll
                for (int m = 0; m < 4; ++m) { const int chunk = row0 + ai * 128 + m * 16; const u32x4 uu = *(const u32x4*)(SUA + ((size_t)(g * 512 + chunk) * KA5 + c)); const pg8::f32x4 v0 = acc[ai][bj][m][0], v1 = acc[ai][bj][m][1];
                    float y[8]; y[0] = v0[0] + d0.x * bflo(uu.x); y[1] = v0[1] + d0.y * bfhi(uu.x); y[2] = v0[2] + d0.z * bflo(uu.y); y[3] = v0[3] + d0.w * bfhi(uu.y);
                    y[4] = v1[0] + d1.x * bflo(uu.z); y[5] = v1[1] + d1.y * bfhi(uu.z); y[6] = v1[2] + d1.z * bflo(uu.w); y[7] = v1[3] + d1.w * bfhi(uu.w);
#pragma unroll
                    for (int e = 0; e < 8; ++e) y[e] = gelu_tanh(y[e]);
                    u32x4 w; w.x = pk2(y[0], y[1]); w.y = pk2(y[2], y[3]); w.z = pk2(y[4], y[5]); w.w = pk2(y[6], y[7]);
                    *(u32x4*)(YS5 + (size_t)(chunk * 32 + tt) * 256 + g * 16 + h0) = w; } }
    }
};
struct EpiGlu {
    static constexpr bool PERM = true, AFTER_DRAIN = false;
    const bf16* YS5; bf16* G;
    __device__ __forceinline__ void operator()(const pg8::f32x4 (&acc)[2][2][4][2], const pg8::Unit& u, int wr, int wc, int fr, int fq) const {
        const int row0 = u.pm * 256 + wr * 64 + fr, cl0 = wc * 32 + 8 * fq;
#pragma unroll
        for (int ai = 0; ai < 2; ++ai)
#pragma unroll
            for (int m = 0; m < 4; ++m) { const int row = row0 + ai * 128 + m * 16;
#pragma unroll
                for (int bj = 0; bj < 2; ++bj) { const int c = cl0 + bj * 128; const u32x4 yy = *(const u32x4*)(YS5 + (size_t)row * 256 + c); bf16* gp = G + (size_t)row * 1024 + 512 + c; const u32x4 gg = *(const u32x4*)gp;
                    const pg8::f32x4 v0 = acc[ai][bj][m][0], v1 = acc[ai][bj][m][1]; float s[8];
#pragma unroll
                    for (int e = 0; e < 4; ++e) { s[e] = 1.f / (1.f + __expf(-v0[e])); s[4 + e] = 1.f / (1.f + __expf(-v1[e])); }
                    u32x4 w; w.x = pk2(bflo(yy.x) * s[0] * bflo(gg.x), bfhi(yy.x) * s[1] * bfhi(gg.x)); w.y = pk2(bflo(yy.y) * s[2] * bflo(gg.y), bfhi(yy.y) * s[3] * bfhi(gg.y));
                    w.z = pk2(bflo(yy.z) * s[4] * bflo(gg.z), bfhi(yy.z) * s[5] * bfhi(gg.z)); w.w = pk2(bflo(yy.w) * s[6] * bflo(gg.w), bfhi(yy.w) * s[7] * bfhi(gg.w));
                    *(u32x4*)gp = w; } }
    }
};
struct EpiOut {
    static constexpr bool PERM = false, AFTER_DRAIN = false;
    const float* base; float* out;
    __device__ __forceinline__ void operator()(const pg8::f32x4 (&acc)[2][2][4][2], const pg8::Unit& u, int wr, int wc, int fr, int fq) const {
        const int row0 = u.pm * 256 + wr * 64 + fr, col0 = u.pn * 256 + wc * 32 + 4 * fq;
#pragma unroll
        for (int ai = 0; ai < 2; ++ai)
#pragma unroll
            for (int m = 0; m < 4; ++m) { const size_t off = (size_t)(row0 + ai * 128 + m * 16) * DM + col0;
#pragma unroll
                for (int bj = 0; bj < 2; ++bj)
#pragma unroll
                    for (int n = 0; n < 2; ++n) { const f32x4 bs = *(const f32x4*)(base + off + bj * 128 + n * 16); const pg8::f32x4 v = acc[ai][bj][m][n]; *(f32x4*)(out + off + bj * 128 + n * 16) = (f32x4){bs.x + v[0], bs.y + v[1], bs.z + v[2], bs.w + v[3]}; } }
    }
};

__device__ __forceinline__ void ret_upd_unit(unsigned char* ws, int unit, int lane) {
    const int c = unit & 63, bh = unit >> 6; const int i16 = lane & 15, kq = lane >> 4;
    const bf16* KT = (const bf16*)(ws + WS_RKT) + (size_t)bh * 64 * SEQ + c * 64; const bf16* VT = (const bf16*)(ws + WS_RVT) + (size_t)bh * 64 * SEQ + c * 64;
    float* UPD = (float*)(ws + WS_UPD) + (size_t)unit * 4096;
    bf16x8 af[4][2], bfv[4][2];
#pragma unroll
    for (int ib = 0; ib < 4; ++ib)
#pragma unroll
        for (int ks = 0; ks < 2; ++ks) { af[ib][ks] = *(const bf16x8*)(KT + (size_t)(16 * ib + i16) * SEQ + 32 * ks + 8 * kq); bfv[ib][ks] = *(const bf16x8*)(VT + (size_t)(16 * ib + i16) * SEQ + 32 * ks + 8 * kq); }
#pragma unroll
    for (int ib = 0; ib < 4; ++ib)
#pragma unroll
        for (int jb = 0; jb < 4; ++jb) { pg8::f32x4 d = (pg8::f32x4){0.f, 0.f, 0.f, 0.f};
            d = __builtin_amdgcn_mfma_f32_16x16x32_bf16(af[ib][0], bfv[jb][0], d, 0, 0, 0); d = __builtin_amdgcn_mfma_f32_16x16x32_bf16(af[ib][1], bfv[jb][1], d, 0, 0, 0);
            *(pg8::f32x4*)(UPD + (size_t)(16 * jb + i16) * 64 + 16 * ib + 4 * kq) = d; }
}
__device__ __forceinline__ void ret_out_unit(const Args& a, int l, int unit, int lane) {
    unsigned char* ws = a.ws;
    const int c = unit & 63, bh = unit >> 6, hh = bh & 3, b = bh >> 2; const int fr = lane & 15, fq = lane >> 4;
    const size_t t0 = (size_t)b * SEQ + c * 64;
    const bf16* RQ = (const bf16*)(ws + WS_RQ) + t0 * 256 + hh * 64; const bf16* RK = (const bf16*)(ws + WS_RK) + t0 * 256 + hh * 64;
    const bf16* VT = (const bf16*)(ws + WS_RVT) + (size_t)bh * 64 * SEQ + c * 64; const bf16* ST = (const bf16*)(ws + WS_STATE) + (size_t)unit * 4096;
    const float lg = lg2_gamma(hh);
    bf16x8 qf[4][2]; pg8::f32x4 st[4][4];
#pragma unroll
    for (int nb = 0; nb < 4; ++nb)
#pragma unroll
        for (int ks = 0; ks < 2; ++ks) qf[nb][ks] = *(const bf16x8*)(RQ + (size_t)(16 * nb + fr) * 256 + 32 * ks + 8 * fq);
#pragma unroll
    for (int mb = 0; mb < 4; ++mb) { bf16x8 k0 = *(const bf16x8*)(RK + (size_t)(16 * mb + fr) * 256 + 8 * fq), k1 = *(const bf16x8*)(RK + (size_t)(16 * mb + fr) * 256 + 32 + 8 * fq);
#pragma unroll
        for (int nb = 0; nb < 4; ++nb) { pg8::f32x4 d = (pg8::f32x4){0.f, 0.f, 0.f, 0.f};
            d = __builtin_amdgcn_mfma_f32_16x16x32_bf16(k0, qf[nb][0], d, 0, 0, 0); d = __builtin_amdgcn_mfma_f32_16x16x32_bf16(k1, qf[nb][1], d, 0, 0, 0);
#pragma unroll
            for (int r = 0; r < 4; ++r) { const int mm = 16 * mb + 4 * fq + r, nn = 16 * nb + fr; const int df = mm > nn ? mm - nn : nn - mm; d[r] *= 0.125f * exp2f(lg * (float)df); }
            st[mb][nb] = d; } }
    pg8::f32x4 o[4][4];
#pragma unroll
    for (int nb = 0; nb < 4; ++nb)
#pragma unroll
        for (int dvb = 0; dvb < 4; ++dvb) o[nb][dvb] = (pg8::f32x4){0.f, 0.f, 0.f, 0.f};
#pragma unroll
    for (int dvb = 0; dvb < 4; ++dvb) { const bf16x8 s0 = *(const bf16x8*)(ST + (size_t)(16 * dvb + fr) * 64 + 8 * fq), s1 = *(const bf16x8*)(ST + (size_t)(16 * dvb + fr) * 64 + 32 + 8 * fq);
#pragma unroll
        for (int nb = 0; nb < 4; ++nb) { o[nb][dvb] = __builtin_amdgcn_mfma_f32_16x16x32_bf16(qf[nb][0], s0, o[nb][dvb], 0, 0, 0); o[nb][dvb] = __builtin_amdgcn_mfma_f32_16x16x32_bf16(qf[nb][1], s1, o[nb][dvb], 0, 0, 0); } }
#pragma unroll
    for (int nb = 0; nb < 4; ++nb)
#pragma unroll
        for (int r = 0; r < 4; ++r) { const float wq = 0.125f * exp2f(lg * (float)(16 * nb + 4 * fq + r + 1));
#pragma unroll
            for (int dvb = 0; dvb < 4; ++dvb) o[nb][dvb][r] *= wq; }
#pragma unroll
    for (int s = 0; s < 2; ++s) {
        bf16x8 pa[4];
#pragma unroll
        for (int nb = 0; nb < 4; ++nb) { u32x4 w; w.x = pk2(st[2 * s][nb][0], st[2 * s][nb][1]); w.y = pk2(st[2 * s][nb][2], st[2 * s][nb][3]); w.z = pk2(st[2 * s + 1][nb][0], st[2 * s + 1][nb][1]); w.w = pk2(st[2 * s + 1][nb][2], st[2 * s + 1][nb][3]); pa[nb] = __builtin_bit_cast(bf16x8, w); }
#pragma unroll
        for (int dvb = 0; dvb < 4; ++dvb) { const u32x2 v0 = *(const u32x2*)(VT + (size_t)(16 * dvb + fr) * SEQ + 32 * s + 4 * fq), v1 = *(const u32x2*)(VT + (size_t)(16 * dvb + fr) * SEQ + 32 * s + 16 + 4 * fq);
            const bf16x8 vf = __builtin_bit_cast(bf16x8, (u32x4){v0.x, v0.y, v1.x, v1.y});
#pragma unroll
            for (int nb = 0; nb < 4; ++nb) o[nb][dvb] = __builtin_amdgcn_mfma_f32_16x16x32_bf16(pa[nb], vf, o[nb][dvb], 0, 0, 0); }
    }
    const float* gn = a.in[13] + (size_t)l * 256 + hh * 64; float gnw[4];
#pragma unroll
    for (int dvb = 0; dvb < 4; ++dvb) gnw[dvb] = gn[16 * dvb + fr];
    bf16* Y = (bf16*)(ws + WS_GATE) + t0 * 1024 + 768 + hh * 64;
#pragma unroll
    for (int nb = 0; nb < 4; ++nb)
#pragma unroll
        for (int r = 0; r < 4; ++r) { float s = (o[nb][0][r] + o[nb][1][r]) + (o[nb][2][r] + o[nb][3][r]);
            s += __shfl_xor(s, 1); s += __shfl_xor(s, 2); s += __shfl_xor(s, 4); s += __shfl_xor(s, 8);
            const float mu = s * (1.f / 64.f); float q = 0.f;
#pragma unroll
            for (int dvb = 0; dvb < 4; ++dvb) { const float d = o[nb][dvb][r] - mu; q += d * d; }
            q += __shfl_xor(q, 1); q += __shfl_xor(q, 2); q += __shfl_xor(q, 4); q += __shfl_xor(q, 8);
            const float rstd = rsqrtf(q * (1.f / 64.f) + EPS); bf16* yp = Y + (size_t)(16 * nb + 4 * fq + r) * 1024 + fr;
#pragma unroll
            for (int dvb = 0; dvb < 4; ++dvb) { const float gt = bf2f(yp[16 * dvb]); yp[16 * dvb] = f2bf((o[nb][dvb][r] - mu) * rstd * gnw[dvb] * gt); } }
}

#define XB_TMO      128
#define XB_XCNT(j)  (256  + 64 * (j))
#define XB_XSUB(j)  (1280 + 64 * (j))
#define XB_XGEN(j)  (2304 + 64 * (j))
#define XB_TOP      3328
#define XB_TOPGEN   3392
#define XCD_BAR_WORDS 3456
#define XB_SPIN_CAP (1u << 18)

__device__ __forceinline__ unsigned xb_ld(unsigned* p)              { return __hip_atomic_load(p, __ATOMIC_RELAXED, __HIP_MEMORY_SCOPE_AGENT); }
__device__ __forceinline__ unsigned xb_add(unsigned* p, unsigned v) { return __hip_atomic_fetch_add(p, v, __ATOMIC_RELAXED, __HIP_MEMORY_SCOPE_AGENT); }
__device__ __forceinline__ unsigned xb_xcc_id() { return (unsigned)__builtin_amdgcn_s_getreg((3 << 11) | 20) & 0xFu; }
#define XB_SPIN(cond, bar) do { unsigned _sp = 0; while (cond) { __builtin_amdgcn_s_sleep(1); \
    if ((++_sp & 255u) == 0u) { if (xb_ld(&(bar)[XB_TMO])) break; if (_sp > XB_SPIN_CAP) { atomicAdd(&(bar)[XB_TMO], 1u); break; } } } } while (0)

struct XcdBarrier {
    unsigned* bar; unsigned x;
    volatile LAS unsigned* st;
};

__device__ __forceinline__ XcdBarrier xcd_barrier_post(unsigned* bar, volatile LAS unsigned* st) {
    XcdBarrier b; b.bar = bar; b.x = xb_xcc_id(); b.st = st;
    if (threadIdx.x == 0) (void)xb_add(&bar[XB_XCNT(b.x)], 1u);
    return b;
}
__device__ __forceinline__ void xcd_barrier_complete(unsigned* bar, unsigned x, unsigned& nloc, unsigned& nx) {
    const unsigned G = gridDim.x * gridDim.y * gridDim.z;
    unsigned sum, cnt, mine, sp = 0u;
    for (;;) {
        sum = 0u; cnt = 0u; mine = 0u;
#pragma unroll
        for (unsigned j = 0; j < 16; ++j) { const unsigned c = xb_ld(&bar[XB_XCNT(j)]); sum += c; cnt += (c > 0u) ? 1u : 0u; mine = (j == x) ? c : mine; }
        if (sum == G) break;
        __builtin_amdgcn_s_sleep(1);
        if ((++sp & 255u) == 0u) { if (xb_ld(&bar[XB_TMO])) break; if (sp > XB_SPIN_CAP) { atomicAdd(&bar[XB_TMO], 1u); break; } }
    }
    nloc = mine > 0u ? mine : 1u; nx = cnt > 0u ? cnt : 1u;
}

__device__ __forceinline__ void xcd_barrier(const XcdBarrier& b) {
    asm volatile("s_waitcnt vmcnt(0)" ::: "memory");
    __syncthreads();
    if (threadIdx.x == 0) {
        unsigned* bar = b.bar;
        __builtin_amdgcn_s_waitcnt(0);
        unsigned nloc = b.st[0], nx = b.st[1];
        if (nloc == 0u) { xcd_barrier_complete(bar, b.x, nloc, nx); b.st[0] = nloc; b.st[1] = nx; }
        const unsigned old = xb_add(&bar[XB_XSUB(b.x)], 1u);
        const unsigned gen = old / nloc;
        if (old + 1u == (gen + 1u) * nloc) {
            __builtin_amdgcn_fence(__ATOMIC_RELEASE, "agent");
            asm volatile("s_waitcnt vmcnt(0)" ::: "memory");
            const unsigned og = xb_add(&bar[XB_TOP], 1u);
            const unsigned tg = og / nx;
            if (og + 1u == (tg + 1u) * nx) xb_add(&bar[XB_TOPGEN], 1u);
            else XB_SPIN(xb_ld(&bar[XB_TOPGEN]) == tg, bar);
            __builtin_amdgcn_fence(__ATOMIC_ACQUIRE, "agent");
            xb_add(&bar[XB_XGEN(b.x)], 1u);
            asm volatile("s_waitcnt vmcnt(0)" ::: "memory");
        } else {
            XB_SPIN(xb_ld(&bar[XB_XGEN(b.x)]) == gen, bar);
            __builtin_amdgcn_fence(__ATOMIC_ACQUIRE, "agent");
            asm volatile("s_waitcnt vmcnt(0)" ::: "memory");
        }
    }
    __syncthreads();
}

#ifdef REP_SYNC
#define GSYNC() do { xcd_barrier(xbar); xcd_barrier(xbar); } while (0)
#else
#define GSYNC() xcd_barrier(xbar)
#endif
#ifndef REP_P0
#define REP_P0 1
#endif
#ifndef REP_P1
#define REP_P1 1
#endif
#ifndef REP_P23
#define REP_P23 1
#endif
#ifndef REP_NORM
#define REP_NORM 1
#endif
__global__ void __launch_bounds__(NTHR, 2) mega_fwd(Args args) {
    extern __shared__ __attribute__((aligned(16))) unsigned char lds[];
    cg::grid_group grid = cg::this_grid();
    const int tid = threadIdx.x, lane = tid & 63, wave = __builtin_amdgcn_readfirstlane(tid >> 6);
    const int G = gridDim.x, bx = blockIdx.x; const int vcu = (G % 8 == 0) ? (bx % 8) * (G / 8) + bx / 8 : bx;
    const int gw = bx * NWAVES + wave, NGW = G * NWAVES;
    unsigned char* ws = args.ws;
    LAS unsigned char* ldsl = (LAS unsigned char*)lds;
    LAS float* ldsf = (LAS float*)lds;
    float* X = args.out;
    if (bx == 0) { for (int i = tid; i < XCD_BAR_WORDS; i += NTHR) ((unsigned*)ws)[i] = 0u; }
    if (tid < 2) ((volatile LAS unsigned*)(ldsl + RING_BYTES + 352))[tid] = 0u;
    __syncthreads();

    for (int rep_ = 0; rep_ < REP_P0; ++rep_) {
        if (rep_) { __syncthreads(); }
#ifndef SKIP_PREP
        if (bx < 64) { s5_prep(args, bx >> 4, bx & 15, ldsf, tid); }
#endif
        LAS float* scr = ldsf + wave * 4096;
        constexpr int I_IN = (DM / 64) * (NF / 32), I_O = (DM / 64) * (DM / 32), I_G = (256 / 64) * (256 / 32), I_L = I_IN + I_O + I_G;
        for (int it = gw; it < DEPTH * I_L; it += NGW) {
            const int l = it / I_L; int r = it % I_L;
            if (r < I_IN) { p0_transpose_item<true>(args.in[2] + (size_t)l * DM * NIN, DM, NIN, NF, (bf16*)(ws + WS_WIN) + (size_t)l * NF * DM, scr, r, lane); continue; } r -= I_IN;
            if (r < I_O) { p0_transpose_item<false>(args.in[14] + (size_t)l * DM * DM, DM, DM, DM, (bf16*)(ws + WS_WO) + (size_t)l * DM * DM, scr, r, lane); continue; } r -= I_O;
            p0_transpose_item<false>(args.in[12] + (size_t)l * 65536, 256, 256, 256, (bf16*)(ws + WS_WGLU) + (size_t)l * 65536, scr, r, lane);
        }
        f32x2* rope = (f32x2*)(ws + WS_ROPE);
        for (int i = bx * NTHR + tid; i < SEQ * 32; i += G * NTHR) { const int pos = i >> 5, fi = i & 31; const float freq = powf(10000.f, -(float)fi / 32.f); const float ang = (float)pos * freq; float sn, cs; sincosf(ang, &sn, &cs); rope[i] = (f32x2){cs, sn}; }
        __syncthreads();
        norm_phase(args, 0, args.in[0], ldsf, tid, lane, gw, NGW);
    }
    grid.sync();
    XcdBarrier xbar = xcd_barrier_post((unsigned*)ws, (volatile LAS unsigned*)(ldsl + RING_BYTES + 352));

#define PHASE_VARS int tid = threadIdx.x; asm volatile("" : "+v"(tid)); int bxl_ = blockIdx.x; asm volatile("" : "+s"(bxl_)); const int bx = bxl_; const int lane = tid & 63, wave = __builtin_amdgcn_readfirstlane(tid >> 6), gw = bx * NWAVES + wave; __attribute__((address_space(1))) unsigned char* wsg_ = (__attribute__((address_space(1))) unsigned char*)args.ws; asm volatile("" : "+s"(wsg_)); unsigned char* ws = (unsigned char*)wsg_; LAS unsigned char* ldsl = (LAS unsigned char*)lds; LAS float* ldsf = (LAS float*)lds; (void)lane; (void)wave; (void)gw; (void)ldsl; (void)ldsf
    for (int l = 0; l < DEPTH; ++l) {
        for (int rep_ = 0; rep_ < REP_P1; ++rep_) {
            PHASE_VARS;
            pg8::Gemm g{(const bf16*)(ws + WS_XN), (const bf16*)(ws + WS_WIN) + (size_t)l * NF * DM, M, NF, DM, DM, DM, 0, 0};
            pg8::StaticOrder S; S.init(M, NF, G, bx);
            EpiInProj E{ws};
#ifndef SKIP_INPROJ
            pg8::gemm_phase<EpiInProj, pg8::StaticOrder, true, true>(ldsl, g, S, E);
#endif
        }
        GSYNC();
        for (int rep_ = 0; rep_ < REP_P23; ++rep_) {
            if (rep_) __syncthreads();
            PHASE_VARS;
            if (bx < 32) {
                pg8::Gemm g{(const bf16*)(ws + WS_SUA), (const bf16*)(ws + WS_WB) + (size_t)l * 16 * 128 * 512, NCH5, 256, 512, KA5, 512, (size_t)NCH5 * KA5, (size_t)128 * 512};
                FlatOrder S{2, 1, 16, 32, bx};
                EpiS5E E{(float*)(ws + WS_E)};
#ifndef SKIP_GE
                pg8::gemm_phase<EpiS5E, FlatOrder, true, true>(ldsl, g, S, E);
#endif
            } else if (bx < 160) {
                ret_upd_unit(ws, (bx - 32) * 8 + wave, lane);
            } else if (bx < 192) {
                const int bh = bx - 160; const float* lf = (const float*)(ws + WS_LOGF) + (size_t)bh * SEQ; float* cb = (float*)(ws + WS_CB) + (size_t)bh * SEQ;
                const f32x4 a0 = *(const f32x4*)(lf + tid * 8), a1 = *(const f32x4*)(lf + tid * 8 + 4); float v[8] = {a0.x, a0.y, a0.z, a0.w, a1.x, a1.y, a1.z, a1.w};
#pragma unroll
                for (int e = 1; e < 8; ++e) v[e] += v[e - 1];
                float tot = v[7];
#pragma unroll
                for (int o = 1; o < 64; o <<= 1) { const float t = __shfl_up(tot, o); if (lane >= o) tot += t; }
                if (lane == 63) ldsf[wave] = tot;
                __syncthreads();
                float off = tot - v[7];
                for (int w = 0; w < wave; ++w) off += ldsf[w];
                f32x4 o0, o1; o0.x = -(v[0] + off) * LOG2E; o0.y = -(v[1] + off) * LOG2E; o0.z = -(v[2] + off) * LOG2E; o0.w = -(v[3] + off) * LOG2E; o1.x = -(v[4] + off) * LOG2E; o1.y = -(v[5] + off) * LOG2E; o1.z = -(v[6] + off) * LOG2E; o1.w = -(v[7] + off) * LOG2E;
                *(f32x4*)(cb + tid * 8) = o0; *(f32x4*)(cb + tid * 8 + 4) = o1;
            }
        }
        GSYNC();
        for (int rep_ = 0; rep_ < REP_P23; ++rep_) {
            if (rep_) __syncthreads();
            PHASE_VARS;
            if (bx < 64) {
                const int b = bx >> 4, g = bx & 15, p = tid & 63, seg = tid >> 6;
                const float* LAM = (const float*)(ws + WS_LAM) + (size_t)(l * 16 + g) * 128; const float lr = LAM[p], li = LAM[64 + p];
                const float* E = (const float*)(ws + WS_E) + ((size_t)g * NCH5 + b * 128 + seg * 16) * 128 + p;
                bf16* SA = (bf16*)(ws + WS_SUA) + ((size_t)g * NCH5 + b * 128 + seg * 16) * KA5 + 512 + p;
                float er[16], ei[16];
#pragma unroll
                for (int i = 0; i < 16; ++i) { er[i] = E[(size_t)i * 128]; ei[i] = E[(size_t)i * 128 + 64]; }
                float sr = 0.f, si = 0.f;
#pragma unroll
                for (int i = 0; i < 16; ++i) { const float nr = lr * sr - li * si + er[i], ni = lr * si + li * sr + ei[i]; sr = nr; si = ni; }
                LAS float* ends = ldsf;
                ends[(seg * 64 + p) * 2] = sr; ends[(seg * 64 + p) * 2 + 1] = si;
                float pr = lr, pi = li;
#pragma unroll
                for (int i = 0; i < 4; ++i) { const float nr = pr * pr - pi * pi, ni = 2.f * pr * pi; pr = nr; pi = ni; }
                __syncthreads();
                float cr = 0.f, ci = 0.f;
                for (int s2 = 0; s2 < seg; ++s2) { const float xr = ends[(s2 * 64 + p) * 2], xi = ends[(s2 * 64 + p) * 2 + 1]; const float nr = pr * cr - pi * ci + xr, ni = pr * ci + pi * cr + xi; cr = nr; ci = ni; }
#pragma unroll
                for (int i = 0; i < 16; ++i) { SA[(size_t)i * KA5] = f2bf(cr); SA[(size_t)i * KA5 + 64] = f2bf(ci); const float nr = lr * cr - li * ci + er[i], ni = lr * ci + li * cr + ei[i]; cr = nr; ci = ni; }
            } else if (bx < 192) {
                const int idx = (bx - 64) * NTHR + tid, bh = idx >> 12, e = idx & 4095; const float g64 = exp2f(lg2_gamma(bh & 3) * 64.f);
                const float* U = (const float*)(ws + WS_UPD) + (size_t)bh * 64 * 4096 + e; bf16* ST = (bf16*)(ws + WS_STATE) + (size_t)bh * 64 * 4096 + e;
                float st = 0.f;
#pragma unroll 8
                for (int c = 0; c < 64; ++c) { const float u = U[(size_t)c * 4096]; ST[(size_t)c * 4096] = f2bf(st); st = g64 * st + u; }
            }
        }
        GSYNC();
        {
            PHASE_VARS;
#ifndef SKIP_RETOUT
            if (wave < 4) ret_out_unit(args, l, wave * 256 + bx, lane);
#endif
            __syncthreads();
            if (bx < 64) {
                pg8::Gemm g{(const bf16*)(ws + WS_SUA), (const bf16*)(ws + WS_MF) + (size_t)l * 16 * 512 * KA5, NCH5, 512, KA5, KA5, KA5, (size_t)NCH5 * KA5, (size_t)512 * KA5};
                FlatOrder S{2, 2, 16, 64, bx};
                EpiS5Y E{(const bf16*)(ws + WS_SUA), (bf16*)(ws + WS_YS5), args.in[10] + (size_t)l * 256};
#ifndef SKIP_GY
                pg8::gemm_phase<EpiS5Y, FlatOrder, true, true>(ldsl, g, S, E);
#endif
            }
            const attn_body::AttnTensors AT{(const attn_body::bf16*)(ws + WS_QO), (const attn_body::bf16*)(ws + WS_KB), (const attn_body::bf16*)(ws + WS_VB), (attn_body::bf16*)(ws + WS_GATE), (const float*)(ws + WS_CB)};
            const attn_body::StaticOrder S(G, bx);
#ifndef SKIP_ATTN
            attn_body::attn_phase<attn_body::StaticOrder>((char*)lds, AT, S);
#endif
        }
        GSYNC();
        {
            PHASE_VARS;
            if (bx < 64) {
                int Kg = 256; asm volatile("" : "+s"(Kg));
                pg8::Gemm g{(const bf16*)(ws + WS_YS5), (const bf16*)(ws + WS_WGLU) + (size_t)l * 65536, M, 256, Kg, 256, 256, 0, 0};
                FlatOrder S{64, 1, 1, 64, bx};
                EpiGlu E{(const bf16*)(ws + WS_YS5), (bf16*)(ws + WS_GATE)};
#ifndef SKIP_GG
                pg8::gemm_phase<EpiGlu, FlatOrder, true, true>(ldsl, g, S, E);
#endif
            }
        }
        GSYNC();
        {
            PHASE_VARS;
            pg8::Gemm g{(const bf16*)(ws + WS_GATE), (const bf16*)(ws + WS_WO) + (size_t)l * DM * DM, M, DM, DM, DM, DM, 0, 0};
            pg8::StaticOrder S; S.init(M, DM, G, bx);
            EpiOut E{l == 0 ? args.in[0] : X, X};
#ifndef SKIP_GO
            pg8::gemm_phase<EpiOut, pg8::StaticOrder, true, true>(ldsl, g, S, E);
#endif
        }
        GSYNC();
        { PHASE_VARS;
        if (l + 1 < DEPTH) { for (int rep_ = 0; rep_ < REP_NORM; ++rep_) norm_phase(args, l + 1, X, ldsf, tid, lane, gw, NGW); GSYNC(); }
        else final_norm(args, X, lane, gw, NGW); }
    }
}

extern "C" void kernel_launch(void* const* d_in, const int* in_sizes, int n_in, void* d_out, int out_size, void* d_ws, size_t ws_size, hipStream_t stream) {
    static int grid = 0;
    if (grid == 0) {
        if (n_in != 16 || ws_size < WS_END) { fprintf(stderr, "kernel_launch: unexpected n_in %d / ws %zu\n", n_in, ws_size); grid = -1; return; }
        int dev = 0, cus = 0, per_cu = 0;
        hipGetDevice(&dev); hipDeviceGetAttribute(&cus, hipDeviceAttributeMultiprocessorCount, dev);
        if (hipFuncSetAttribute((const void*)mega_fwd, hipFuncAttributeMaxDynamicSharedMemorySize, LDS_BYTES) != hipSuccess) { fprintf(stderr, "kernel_launch: hipFuncSetAttribute failed\n"); grid = -1; return; }
        if (hipOccupancyMaxActiveBlocksPerMultiprocessor(&per_cu, (const void*)mega_fwd, NTHR, LDS_BYTES) != hipSuccess || per_cu < 1) { fprintf(stderr, "kernel_launch: occupancy query failed (%d)\n", per_cu); grid = -1; return; }
        grid = cus;
        if (grid != 256) fprintf(stderr, "kernel_launch: note: %d CUs\n", grid);
    }
    if (grid < 0) return;
    Args a{};
    for (int i = 0; i < 16; ++i) a.in[i] = (const float*)d_in[i];
    a.out = (float*)d_out; a.ws = (unsigned char*)d_ws;
    void* kargs[] = {&a};
    hipError_t e = hipLaunchCooperativeKernel((const void*)mega_fwd, dim3(grid), dim3(NTHR), kargs, LDS_BYTES, stream);
    if (e != hipSuccess) fprintf(stderr, "kernel_launch: cooperative launch failed: %s\n", hipGetErrorString(e));
}
```

```cpp
#include <hip/hip_runtime.h>
#include <cstdio>
#include <cstdint>
namespace pg8 {
#define PG8_LAS __attribute__((address_space(3)))
typedef unsigned short bf16_t;
typedef short bf16x8 __attribute__((ext_vector_type(8)));
typedef float f32x4 __attribute__((ext_vector_type(4)));
typedef unsigned u32x4 __attribute__((ext_vector_type(4)));
constexpr int BM = 256, BK = 64, HALF = 128, HTB = HALF * BK * 2  , STAGE_BYTES = 8 * HTB, NXCD = 8, WGM = 8;

__host__ __device__ __forceinline__ int lds_byte(int r, int c) { const int st = (r >> 4) * 2 + (c >> 5), rr = r & 15, cc = c & 31, ob = rr * 64 + cc * 2; return st * 1024 + (ob ^ (((ob >> 9) & 1) << 5)); }
__host__ __device__ __forceinline__ void stage_rc(int b, int& R, int& C) { const int st = b / 1024, sb = b % 1024, swz = sb ^ (((sb >> 9) & 1) << 5); R = (st >> 1) * 16 + swz / 64; C = (st & 1) * 32 + (swz % 64) / 2; }
__host__ __device__ __forceinline__ int perm32(int rho) { const int n = rho >> 4, i = rho & 15; return 8 * (i >> 2) + 4 * n + (i & 3); }

struct Unit { int pm, pn, gz; };
struct Gemm { const bf16_t* A; const bf16_t* Bt; int M, N, K; int lda, ldb; size_t gsA, gsB; };

struct StaticOrder {
    int nM, nN, nwg, G, c;
    __host__ __device__ void init(int M, int N, int G_, int c_) { nM = M / BM; nN = N / BM; nwg = nM * nN; G = G_; c = c_; }
    __host__ __device__ bool next(int i, Unit& u) const {
        const long L = (long)i * G + c; if (L >= nwg) return false;
        int wgid = (int)L; { const int q = nwg / NXCD, r = nwg % NXCD, xcd = wgid % NXCD, off = wgid / NXCD; wgid = (xcd < r ? xcd * (q + 1) : r * (q + 1) + (xcd - r) * q) + off; }
        const int nig = WGM * nN, gid = wgid / nig, fm = gid * WGM, gsz = (nM - fm) < WGM ? (nM - fm) : WGM;
        u.pm = fm + ((wgid % nig) % gsz); u.pn = (wgid % nig) / gsz; u.gz = 0; return true;
    }
    __device__ __forceinline__ void a_ready(const Unit&) const {}
    __device__ __forceinline__ void done(const Unit&) const {}
};

__device__ __forceinline__ unsigned cvt_pk_bf16(float lo, float hi) { unsigned r; asm volatile("v_cvt_pk_bf16_f32 %0, %1, %2" : "=v"(r) : "v"(lo), "v"(hi)); return r; }
typedef float f32x2 __attribute__((ext_vector_type(2)));
__device__ __forceinline__ f32x2 gelu_pk(f32x2 v) {
    const f32x2 av = __builtin_elementwise_abs(v), d = av * 0.2316418882f + 1.0f;
    f32x2 t; t.x = __builtin_amdgcn_rcpf(d.x); t.y = __builtin_amdgcn_rcpf(d.y);
    f32x2 q = t * 0.5307027145f + (-0.7265760135f); q = q * t + 0.7107068705f; q = q * t + (-0.142248368f); q = q * t + 0.127414796f; q = q * t;
    const f32x2 s = (v * v) * (-0.72134752044f);
    f32x2 e; e.x = __builtin_amdgcn_exp2f(s.x); e.y = __builtin_amdgcn_exp2f(s.y);
    const f32x2 m = v * (q * e), r = v - m;
    f32x2 o; o.x = v.x < 0.f ? m.x : r.x; o.y = v.y < 0.f ? m.y : r.y; return o;
}

template <class Epi, class Sched, bool ALIGN_EPI = false, bool SP2 = false>
__device__ __forceinline__ void gemm_phase(PG8_LAS unsigned char* lds, const Gemm g, const Sched& S, const Epi& E) {
    int tid_ = threadIdx.x; asm volatile("" : "+v"(tid_));
    const int tid = tid_, wid = __builtin_amdgcn_readfirstlane(tid >> 6), lane = tid & 63, wr = wid >> 2, wc = wid & 3, fr = lane & 15, fq = lane >> 4;
    const int K = g.K, nt = K / BK;
    unsigned voffA[2], voffB[2];
#pragma unroll
    for (int i = 0; i < 2; ++i) { int R, C; stage_rc(tid * 16 + i * 8192, R, C); const int Rb = Epi::PERM ? ((R & ~31) + perm32(R & 31)) : R;
        voffA[i] = (unsigned)(R * g.lda + C) * 2u; voffB[i] = (unsigned)(Rb * g.ldb + C) * 2u; }
    const size_t kstep = (size_t)(BK * 2);
    const size_t hstepA = (size_t)HALF * g.lda * 2, hstepB = (size_t)HALF * g.ldb * 2;
    const size_t tstepA = 2 * hstepA, tstepB = 2 * hstepB;
    const unsigned ldsw = (unsigned)wid * 1024u;
    const int aoff = lds_byte(wr * 64 + fr, fq * 8), boff = lds_byte(wc * 32 + fr, fq * 8);
#define PG8_SA(b, h) (((b) * 2 + (h)) * HTB)
#define PG8_SB(b, h) ((4 + (b) * 2 + (h)) * HTB)
#define PG8_STAGE(bufoff, gbase, voff) do { _Pragma("unroll") for (int _i = 0; _i < 2; ++_i) \
        __builtin_amdgcn_global_load_lds((const unsigned*)((const char*)(gbase) + (voff)[_i]), (PG8_LAS unsigned*)(lds + (bufoff) + ldsw + _i * 8192), 16, 0, 0); } while (0)
#define PG8_LDA(dst, b, h) do { _Pragma("unroll") for (int m = 0; m < 4; ++m) _Pragma("unroll") for (int k = 0; k < 2; ++k) dst[m][k] = *(const PG8_LAS bf16x8*)(lds + PG8_SA(b, h) + aoff + m * 2048 + k * 1024); } while (0)
#define PG8_LDB(dst, b, h) do { _Pragma("unroll") for (int n = 0; n < 2; ++n) _Pragma("unroll") for (int k = 0; k < 2; ++k) dst[n][k] = *(const PG8_LAS bf16x8*)(lds + PG8_SB(b, h) + boff + n * 2048 + k * 1024); } while (0)
#define PG8_MMA(ai, bj, At, Bt) do { __builtin_amdgcn_s_setprio(1); _Pragma("unroll") for (int m = 0; m < 4; ++m) _Pragma("unroll") for (int n = 0; n < 2; ++n) _Pragma("unroll") for (int k = 0; k < 2; ++k) \
        acc[ai][bj][m][n] = __builtin_amdgcn_mfma_f32_16x16x32_bf16(Bt[n][k], At[m][k], acc[ai][bj][m][n], 0, 0, 0); __builtin_amdgcn_s_setprio(0); } while (0)
#define PG8_WAIT_V(n) asm volatile("s_waitcnt vmcnt(" #n ")" ::: "memory")
#define PG8_WAIT_L(n) asm volatile("s_waitcnt lgkmcnt(" #n ")" ::: "memory")
#define PG8_BAR __builtin_amdgcn_s_barrier()
#define PG8_SCHED __builtin_amdgcn_sched_barrier(0)
    Unit cur, nxt; int ui = 0;
    if (!S.next(0, cur)) return;
    f32x4 acc[2][2][4][2];
#pragma unroll
    for (int a = 0; a < 2; ++a)
#pragma unroll
        for (int b = 0; b < 2; ++b)
#pragma unroll
            for (int m = 0; m < 4; ++m)
#pragma unroll
                for (int n = 0; n < 2; ++n) acc[a][b][m][n] = (f32x4){0.f, 0.f, 0.f, 0.f};
    bf16x8 At[4][2], B0[2][2], B1[2][2];
    const char* cA = (const char*)g.A + (size_t)cur.gz * g.gsA * 2 + (size_t)cur.pm * tstepA; const char* cB = (const char*)g.Bt + (size_t)cur.gz * g.gsB * 2 + (size_t)cur.pn * tstepB;
    S.a_ready(cur);
    if constexpr (SP2) {
        PG8_STAGE(PG8_SB(0, 0), cB, voffB); PG8_STAGE(PG8_SB(0, 1), cB + hstepB, voffB); PG8_STAGE(PG8_SA(0, 0), cA, voffA); PG8_STAGE(PG8_SA(0, 1), cA + hstepA, voffA);
        if (wr == 1) PG8_BAR;
        PG8_WAIT_V(2); PG8_BAR;
        PG8_STAGE(PG8_SB(1, 0), cB + kstep, voffB); PG8_STAGE(PG8_SA(1, 0), cA + kstep, voffA); PG8_STAGE(PG8_SB(1, 1), cB + hstepB + kstep, voffB);
        PG8_WAIT_V(6); PG8_BAR;
    } else {
        PG8_STAGE(PG8_SB(0, 0), cB, voffB); PG8_STAGE(PG8_SA(0, 0), cA, voffA); PG8_STAGE(PG8_SB(0, 1), cB + hstepB, voffB); PG8_STAGE(PG8_SA(0, 1), cA + hstepA, voffA);
        if (wr == 1) PG8_BAR;
        PG8_WAIT_V(4); PG8_BAR;
        PG8_STAGE(PG8_SB(1, 0), cB + kstep, voffB); PG8_STAGE(PG8_SA(1, 0), cA + kstep, voffA); PG8_STAGE(PG8_SB(1, 1), cB + hstepB + kstep, voffB);
        PG8_WAIT_V(6); PG8_BAR;
    }
    for (;;) {
        const bool has_next = S.next(ui + 1, nxt);
        const char* nA = has_next ? (const char*)g.A + (size_t)nxt.gz * g.gsA * 2 + (size_t)nxt.pm * tstepA : cA; const char* nB = has_next ? (const char*)g.Bt + (size_t)nxt.gz * g.gsB * 2 + (size_t)nxt.pn * tstepB : cB;
        for (int t = 0; t < nt; t += 2) {
            const bool last = (t == nt - 2);
            const char* a1 = cA + (size_t)(t + 1) * kstep;
            const char* a2 = last ? nA : cA + (size_t)(t + 2) * kstep; const char* b2 = last ? nB : cB + (size_t)(t + 2) * kstep;
            const char* a3 = a2 + kstep; const char* b3 = b2 + kstep;
            if (last && has_next) S.a_ready(nxt);
            if constexpr (SP2) {
            PG8_LDB(B0, 0, 0); PG8_LDB(B1, 0, 1); PG8_SCHED; PG8_LDA(At, 0, 0); PG8_STAGE(PG8_SA(1, 1), a1 + hstepA, voffA);
            PG8_WAIT_V(8); PG8_WAIT_L(0); PG8_BAR; PG8_MMA(0, 0, At, B0); PG8_MMA(0, 1, At, B1); PG8_BAR; PG8_SCHED;
            PG8_LDA(At, 0, 1); PG8_STAGE(PG8_SB(0, 0), b2, voffB); PG8_STAGE(PG8_SB(0, 1), b2 + hstepB, voffB); PG8_STAGE(PG8_SA(0, 0), a2, voffA);
            PG8_WAIT_V(8); PG8_WAIT_L(0); PG8_BAR; PG8_MMA(1, 0, At, B0); PG8_MMA(1, 1, At, B1); PG8_BAR; PG8_SCHED;
            PG8_LDB(B0, 1, 0); PG8_LDB(B1, 1, 1); PG8_SCHED; PG8_LDA(At, 1, 0); PG8_STAGE(PG8_SA(0, 1), a2 + hstepA, voffA);
            PG8_WAIT_V(8); PG8_WAIT_L(0); PG8_BAR; PG8_MMA(0, 0, At, B0); PG8_MMA(0, 1, At, B1); PG8_BAR; PG8_SCHED;
            PG8_LDA(At, 1, 1); PG8_STAGE(PG8_SB(1, 0), b3, voffB); PG8_STAGE(PG8_SB(1, 1), b3 + hstepB, voffB); PG8_STAGE(PG8_SA(1, 0), a3, voffA);
            PG8_WAIT_V(8); PG8_WAIT_L(0); PG8_BAR; PG8_MMA(1, 0, At, B0); PG8_MMA(1, 1, At, B1); PG8_BAR; PG8_SCHED;
            } else {
            PG8_LDB(B0, 0, 0); PG8_SCHED; PG8_LDA(At, 0, 0); PG8_STAGE(PG8_SA(1, 1), a1 + hstepA, voffA);
            PG8_WAIT_L(8); PG8_BAR; PG8_WAIT_L(0); PG8_MMA(0, 0, At, B0); PG8_BAR; PG8_SCHED;
            PG8_LDB(B1, 0, 1); PG8_STAGE(PG8_SB(0, 0), b2, voffB);
            PG8_BAR; PG8_WAIT_L(0); PG8_MMA(0, 1, At, B1); PG8_BAR;
            PG8_LDA(At, 0, 1); PG8_STAGE(PG8_SA(0, 0), a2, voffA);
            PG8_BAR; PG8_WAIT_L(0); PG8_MMA(1, 0, At, B0); PG8_BAR; PG8_SCHED;
            PG8_STAGE(PG8_SB(0, 1), b2 + hstepB, voffB);
            PG8_WAIT_V(6); PG8_BAR; PG8_MMA(1, 1, At, B1); PG8_BAR;
            PG8_LDB(B0, 1, 0); PG8_SCHED; PG8_LDA(At, 1, 0); PG8_STAGE(PG8_SA(0, 1), a2 + hstepA, voffA);
            PG8_WAIT_L(8); PG8_BAR; PG8_WAIT_L(0); PG8_MMA(0, 0, At, B0); PG8_BAR; PG8_SCHED;
            PG8_LDB(B1, 1, 1); PG8_STAGE(PG8_SB(1, 0), b3, voffB);
            PG8_BAR; PG8_WAIT_L(0); PG8_MMA(0, 1, At, B1); PG8_BAR;
            PG8_LDA(At, 1, 1); PG8_STAGE(PG8_SA(1, 0), a3, voffA);
            PG8_BAR; PG8_WAIT_L(0); PG8_MMA(1, 0, At, B0); PG8_BAR; PG8_SCHED;
            PG8_STAGE(PG8_SB(1, 1), b3 + hstepB, voffB);
            PG8_WAIT_V(6); PG8_BAR; PG8_MMA(1, 1, At, B1); PG8_BAR;
            }
        }
        if constexpr (ALIGN_EPI) { if (wr == 0) PG8_BAR; }
        if constexpr (!Epi::AFTER_DRAIN) { E(acc, cur, wr, wc, fr, fq); S.done(cur); }
        if (!has_next) break;
#pragma unroll
        for (int a = 0; a < 2; ++a)
#pragma unroll
            for (int b = 0; b < 2; ++b)
#pragma unroll
                for (int m = 0; m < 4; ++m)
#pragma unroll
                    for (int n = 0; n < 2; ++n) acc[a][b][m][n] = (f32x4){0.f, 0.f, 0.f, 0.f};
        cur = nxt; cA = nA; cB = nB; ++ui;
        if constexpr (ALIGN_EPI) { if (wr == 1) PG8_BAR; }
    }
    PG8_WAIT_V(0);
    if constexpr (!ALIGN_EPI) { if (wr == 0) PG8_BAR; }
    PG8_BAR;
    if constexpr (Epi::AFTER_DRAIN) { E.fused(acc, cur, wr, wc, fr, fq, lds, wid, lane); S.done(cur); }
#undef PG8_SA
#undef PG8_SB
#undef PG8_STAGE
#undef PG8_LDA
#undef PG8_LDB
#undef PG8_MMA
#undef PG8_WAIT_V
#undef PG8_WAIT_L
#undef PG8_BAR
#undef PG8_SCHED
}
}
#include <hip/hip_bf16.h>
#include <cmath>
namespace attn_body {
using bf16=__hip_bfloat16;
using bf16x8=__attribute__((ext_vector_type(8)))short;
using s16x4=__attribute__((ext_vector_type(4)))short;
using f32x16=__attribute__((ext_vector_type(16)))float;
using u32x4=__attribute__((ext_vector_type(4)))unsigned;
using f32x4=__attribute__((ext_vector_type(4)))float;
constexpr int BATCH=4,NHEAD=8,SEQ=4096,D=64,DM=NHEAD*D,OPITCH=1024;
constexpr int NW=8,QBLK=32,QB=QBLK*NW,KVBLK=64,NQB=SEQ/QB;
constexpr int ATTN_PITCH=DM, ATTN_UNIT_ROWS=QB;
__device__ __forceinline__ int crow(int r,int hi){return (r&3)+8*(r>>2)+4*hi;}
#define SBAR() __builtin_amdgcn_sched_barrier(0)
__device__ __forceinline__ void cmask(f32x16&p0,f32x16&p1,int jb,int qrel,int hi){
  const float NEG=-INFINITY; int kb=64*jb+4*hi;
  #pragma unroll
  for(int r=0;r<16;++r){int kv=kb+(r&3)+8*(r>>2); if(kv>qrel)p0[r]=NEG; if(kv+32>qrel)p1[r]=NEG;}
}

constexpr int NSLOT=3, SLOTB=8192;
constexpr int LDS_K=0, LDS_V=NSLOT*SLOTB, LDS_WS=2*NSLOT*SLOTB, LDS_OST=LDS_WS+NW*64*4, LDS_CB=LDS_OST+NW*4096, LDS_BYTES=LDS_CB+SEQ*4;
constexpr float C2=0.125f*1.4426950408889634f;
__device__ __forceinline__ void glds16(const void*gsrc,unsigned lds_dst){unsigned keep;
  asm volatile("s_mov_b32 %0, m0\n\ts_mov_b32 m0, %2\n\ts_nop 0\n\tglobal_load_lds_dwordx4 %1, off\n\ts_mov_b32 m0, %0":"=&s"(keep):"v"(gsrc),"s"(lds_dst):"memory");}
__device__ __forceinline__ float max3f(float a,float b,float c){float r;asm("v_max3_f32 %0, %1, %2, %3":"=v"(r):"v"(a),"v"(b),"v"(c));return r;}
__device__ __forceinline__ float max2f(float a,float b){float r;asm("v_max_f32_e32 %0, %1, %2":"=v"(r):"v"(a),"v"(b));return r;}
__device__ __forceinline__ float fadd_s(float a,float b){float r;asm("v_add_f32_e32 %0, %1, %2":"=v"(r):"v"(a),"v"(b));return r;}
__device__ __forceinline__ float fsub_s(float a,float b){float r;asm("v_sub_f32_e32 %0, %1, %2":"=v"(r):"v"(a),"v"(b));return r;}
typedef float f32x2_t __attribute__((ext_vector_type(2))); typedef __bf16 bf16x2_t __attribute__((ext_vector_type(2)));
__device__ __forceinline__ unsigned cvtpk_s(float lo,float hi){f32x2_t v={lo,hi};bf16x2_t b=__builtin_convertvector(v,bf16x2_t);return __builtin_bit_cast(unsigned,b);}
#define WAIT_BAR(N) asm volatile("s_waitcnt vmcnt(" #N ") lgkmcnt(0)\n\ts_barrier":::"memory")

__device__ __forceinline__ void qkt(f32x16&p0,f32x16&p1,const char*Kslot,const bf16x8*qr,const char*cbt,int r32,int hi){
  const char*kb=Kslot+hi*1024+r32*16;
  #pragma unroll
  for(int a=0;a<4;++a){ const f32x4 u0=*reinterpret_cast<const f32x4*>(cbt+hi*16+a*32), u1=*reinterpret_cast<const f32x4*>(cbt+128+hi*16+a*32);
    p0[4*a]=u0[0];p0[4*a+1]=u0[1];p0[4*a+2]=u0[2];p0[4*a+3]=u0[3]; p1[4*a]=u1[0];p1[4*a+1]=u1[1];p1[4*a+2]=u1[2];p1[4*a+3]=u1[3]; }
  #pragma unroll
  for(int d0=0;d0<4;++d0){
    const bf16x8 b0=*reinterpret_cast<const bf16x8*>(kb+d0*2048);
    const bf16x8 b1=*reinterpret_cast<const bf16x8*>(kb+d0*2048+512);
    p0=__builtin_amdgcn_mfma_f32_32x32x16_bf16(b0,qr[d0],p0,0,0,0);p1=__builtin_amdgcn_mfma_f32_32x32x16_bf16(b1,qr[d0],p1,0,0,0);}
}
typedef __attribute__((address_space(3))) const char* lds_cptr;
typedef short v4i16_t __attribute__((ext_vector_type(4)));
__device__ __forceinline__ void kload8(bf16x8*kf,lds_cptr kp){
  kf[0]=*(const __attribute__((address_space(3))) bf16x8*)(kp);      kf[1]=*(const __attribute__((address_space(3))) bf16x8*)(kp+512);
  kf[2]=*(const __attribute__((address_space(3))) bf16x8*)(kp+2048); kf[3]=*(const __attribute__((address_space(3))) bf16x8*)(kp+2560);
  kf[4]=*(const __attribute__((address_space(3))) bf16x8*)(kp+4096); kf[5]=*(const __attribute__((address_space(3))) bf16x8*)(kp+4608);
  kf[6]=*(const __attribute__((address_space(3))) bf16x8*)(kp+6144); kf[7]=*(const __attribute__((address_space(3))) bf16x8*)(kp+6656);
}
__device__ __forceinline__ void kload2(bf16x8*kf,lds_cptr kp,int j){ kf[2*j]=*(const __attribute__((address_space(3))) bf16x8*)(kp+j*2048); kf[2*j+1]=*(const __attribute__((address_space(3))) bf16x8*)(kp+j*2048+512); }
__device__ __forceinline__ s16x4 vtr(lds_cptr p){ return __builtin_bit_cast(s16x4,__builtin_amdgcn_ds_read_tr16_b64_v4i16((__attribute__((address_space(3))) v4i16_t*)p)); }
__device__ __forceinline__ float rowmax(const f32x16&p0,const f32x16&p1){
  float a=max3f(p0[0],p0[1],p1[0]),b=max3f(p0[2],p0[3],p1[1]);a=max3f(a,p1[2],p1[3]);
  #pragma unroll
  for(int r=4;r<16;r+=4){a=max3f(a,p0[r],p0[r+1]);b=max3f(b,p0[r+2],p0[r+3]);a=max3f(a,p1[r],p1[r+1]);b=max3f(b,p1[r+2],p1[r+3]);}
  const float m=max2f(a,b);
  auto rr=__builtin_amdgcn_permlane32_swap(__float_as_uint(m),__float_as_uint(m),false,false);
  return max2f(__uint_as_float(rr[0]),__uint_as_float(rr[1]));
}
__device__ __forceinline__ void pv(f32x16*o,int vb,bf16x8 pa0,bf16x8 pa1,bf16x8 pa2,bf16x8 pa3){
  #pragma unroll
  for(int d0=0;d0<2;++d0){s16x4 lo[4],hi[4];
    #pragma unroll
    for(int ks=0;ks<4;++ks){
      asm volatile("ds_read_b64_tr_b16 %0,%1 offset:%c2":"=&v"(lo[ks]):"v"(vb),"i"(d0*4096+ks*1024):"memory");
      asm volatile("ds_read_b64_tr_b16 %0,%1 offset:%c2":"=&v"(hi[ks]):"v"(vb),"i"(d0*4096+ks*1024+512):"memory");}
    asm volatile("s_waitcnt lgkmcnt(0)":::"memory");SBAR();
    #define PK(k) (bf16x8){lo[k][0],lo[k][1],lo[k][2],lo[k][3],hi[k][0],hi[k][1],hi[k][2],hi[k][3]}
    o[d0]=__builtin_amdgcn_mfma_f32_32x32x16_bf16(pa0,PK(0),o[d0],0,0,0);
    o[d0]=__builtin_amdgcn_mfma_f32_32x32x16_bf16(pa1,PK(1),o[d0],0,0,0);
    o[d0]=__builtin_amdgcn_mfma_f32_32x32x16_bf16(pa2,PK(2),o[d0],0,0,0);
    o[d0]=__builtin_amdgcn_mfma_f32_32x32x16_bf16(pa3,PK(3),o[d0],0,0,0);
    #undef PK
  }
}

#ifndef ATTN_STORE16
#define ATTN_STORE16(p,v) (*(u32x4*)(p)=(v))
#endif
template<int THRL> __device__ __forceinline__ void attn_unit(int b,int h,int qb,const bf16*Q,const bf16*__restrict__ K,const bf16*__restrict__ V,bf16*O,const float*__restrict__ CB,char*shm,bool dry=false){
  int tid_=threadIdx.x; asm volatile("":"+v"(tid_)); const int tid=tid_,lane=tid&63,r32=lane&31,hi=lane>>5; const int wid=__builtin_amdgcn_readfirstlane(tid>>6);
  const long rowbase=(long)b*SEQ; const int q0=qb*QB;
  const bf16*Qw=Q+(rowbase+q0+wid*QBLK)*DM+h*D;
  const bf16*Kh=K+rowbase*DM+h*D,*Vh=V+rowbase*DM+h*D;
  const unsigned lds0=(unsigned)(uintptr_t)shm;
  float*wsf=(float*)(shm+LDS_WS)+wid*64;
  const bf16*ksrc=Kh+(long)lane*DM+wid*8;
  const bf16*vsrc=Vh+(long)(16*(wid&3)+(lane>>2))*DM+(wid>>2)*32+(lane&3)*8;
  const unsigned kdst=lds0+LDS_K+wid*1024, vdst=lds0+LDS_V+wid*1024;
  #define DMA_K(t,slot) glds16(ksrc+(long)(t)*KVBLK*DM,(unsigned)__builtin_amdgcn_readfirstlane(kdst+(slot)))
  #define DMA_V(t,slot) glds16(vsrc+(long)(t)*KVBLK*DM,(unsigned)__builtin_amdgcn_readfirstlane(vdst+(slot)))
  const int vb0=(int)(lds0+LDS_V)+((lane>>4)&1)*32+(lane&3)*8+(4*hi+((lane&15)>>2))*64;
  const char*Kbase=shm+LDS_K; bf16x8 kf[8];
  const lds_cptr shm3=(lds_cptr)shm; const lds_cptr kp0=shm3+LDS_K+hi*1024+r32*16; const lds_cptr vp0=shm3+LDS_V+((lane>>4)&1)*32+(lane&3)*8+(4*hi+((lane&15)>>2))*64;
  const int NT=(q0+QB)/KVBLK;
  { const f32x4* cbg=reinterpret_cast<const f32x4*>(CB+(long)(b*NHEAD+h)*SEQ); f32x4* cbl=reinterpret_cast<f32x4*>(shm+LDS_CB); const int nv=(q0+QB)/4;
    for(int i=tid;i<nv;i+=NW*64) cbl[i]=cbg[i];
    asm volatile("s_waitcnt vmcnt(0) lgkmcnt(0)\n\ts_barrier":::"memory"); }
  const lds_cptr cb3=(lds_cptr)shm+LDS_CB;
  const float cb_own=*(const __attribute__((address_space(3))) float*)(cb3+(q0+wid*QBLK+r32)*4);
  DMA_K(0,0);DMA_V(0,0);DMA_K(1,SLOTB);
  bf16x8 qr[4];
  #pragma unroll
  for(int d0=0;d0<4;++d0)qr[d0]=*reinterpret_cast<const bf16x8*>(&Qw[(long)r32*DM+d0*16+hi*8]);
  float mhat=0.f,l_reg=0.f;f32x16 o[2];o[0]=f32x16{};o[1]=f32x16{};
  const int qrel=wid*QBLK+r32;
  #define CMASK(P0,P1,t) do{int jb_=(t)-(NT-4); if(jb_>=0)cmask(P0,P1,jb_,qrel,hi);}while(0)
  bool resc=false;
  #define START(P0,P1) do{ const float rm=max2f(rowmax(P0,P1),cb_own); resc=false; \
    { const float dl=rm; mhat=fadd_s(mhat,dl); \
      _Pragma("unroll") for(int r=0;r<16;++r){P0[r]=fsub_s(P0[r],dl);P1[r]=fsub_s(P1[r],dl);} } \
    _Pragma("unroll") for(int r=0;r<16;++r)P0[r]=__builtin_amdgcn_exp2f(P0[r]); }while(0)
  #define RESC() do{ if(resc){ asm volatile("s_waitcnt lgkmcnt(0)":::"memory"); \
      _Pragma("unroll") for(int d_=0;d_<2;++d_) _Pragma("unroll") for(int r=0;r<16;++r)o[d_][r]*=wsf[crow(r,hi)]; } }while(0)
  f32x16 pA0,pA1,pB0,pB1;
  int sl_prev=0,sl_cur=0,sl_next=SLOTB;
  #define ROT() do{sl_prev=sl_cur;sl_cur=sl_next;sl_next=(sl_next==(NSLOT-1)*SLOTB)?0:sl_next+SLOTB;}while(0)
  DMA_K(2,2*SLOTB);
  WAIT_BAR(3);
  qkt(pA0,pA1,Kbase,qr,shm+LDS_CB,r32,hi);asm volatile("s_nop 15\n\ts_nop 7":"+v"(pA0),"+v"(pA1));CMASK(pA0,pA1,0);
  START(pA0,pA1);
  _Pragma("unroll") for(int r=0;r<16;++r)pA1[r]=__builtin_amdgcn_exp2f(pA1[r]);
  WAIT_BAR(0);
  DMA_K(3,0);DMA_V(1,SLOTB);
  ROT();
  kload8(kf,kp0+sl_cur);
  WAIT_BAR(2);
  s16x4 vlo[8],vhi[8]; u32x4 pw0,pw1,pw2,pw3;
  #define PKW(P,B) cvtpk_s(P[B],P[B+1])
  #define PAF(k) __builtin_bit_cast(bf16x8,pw##k)
  #define VFR(i) (bf16x8){vlo[i][0],vlo[i][1],vlo[i][2],vlo[i][3],vhi[i][0],vhi[i][1],vhi[i][2],vhi[i][3]}
  #define PIN(x) asm volatile("":"+v"(x))
  #define MX3(a,b,c) __builtin_fmaxf(__builtin_fmaxf((a),(b)),(c))
  #define GAPA(MF,A0,A1,A2,A3,W0,W1,PW) do{ MF; sacc+=A0; sacc+=A1; sacc+=A2; sacc+=A3; PIN(sacc); W0; W1; PIN(PW); SBAR(); }while(0)
  #define EX(v) __builtin_amdgcn_exp2f(v)
  #define GAPB(MF,X,B) do{ MF; X[B]=EX(X[B]); X[B+1]=EX(X[B+1]); X[B+2]=EX(X[B+2]); X[B+3]=EX(X[B+3]); PIN(X); SBAR(); }while(0)
  #define VRD(i) do{ vlo[i]=vtr(vp_+(((i)>>2)*4096+((i)&3)*1024)); vhi[i]=vtr(vp_+(((i)>>2)*4096+((i)&3)*1024+512)); }while(0)
  #define KRD(G,j) do{ if(G){ kload2(kf,kp0+sl_next,j); SBAR(); } }while(0)
  #define STEP(C0,C1,P0,P1,t,GK,GV,GL) do{ SBAR(); \
    { const __attribute__((address_space(3))) f32x4* cbp_=(const __attribute__((address_space(3))) f32x4*)(cb3+(t)*256+hi*16); \
      _Pragma("unroll") for(int a_=0;a_<4;++a_){ const f32x4 u0_=cbp_[2*a_], u1_=cbp_[8+2*a_]; \
        C0[4*a_]=u0_[0]-mhat;C0[4*a_+1]=u0_[1]-mhat;C0[4*a_+2]=u0_[2]-mhat;C0[4*a_+3]=u0_[3]-mhat; \
        C1[4*a_]=u1_[0]-mhat;C1[4*a_+1]=u1_[1]-mhat;C1[4*a_+2]=u1_[2]-mhat;C1[4*a_+3]=u1_[3]-mhat; } } SBAR(); \
    const lds_cptr vp_=vp0+sl_prev; \
    VRD(0); SBAR(); float sacc=(P0[0]+P0[1]); \
    GAPA(C0=__builtin_amdgcn_mfma_f32_32x32x16_bf16(kf[0],qr[0],C0,0,0,0), P0[2],P0[3],P0[4],P0[5],     pw0[0]=PKW(P0,0), pw0[1]=PKW(P0,2), pw0); \
    VRD(4); SBAR(); GAPA(C1=__builtin_amdgcn_mfma_f32_32x32x16_bf16(kf[1],qr[0],C1,0,0,0), P0[6],P0[7],P0[8],P0[9],     pw0[2]=PKW(P0,4), pw0[3]=PKW(P0,6), pw0); \
    VRD(1); SBAR(); GAPA(C0=__builtin_amdgcn_mfma_f32_32x32x16_bf16(kf[2],qr[1],C0,0,0,0),   P0[10],P0[11],P0[12],P0[13], pw1[0]=PKW(P0,8), pw1[1]=PKW(P0,10), pw1); \
    VRD(5); SBAR(); GAPA(C1=__builtin_amdgcn_mfma_f32_32x32x16_bf16(kf[3],qr[1],C1,0,0,0),   P0[14],P0[15],P1[0],P1[1],   pw1[2]=PKW(P0,12),pw1[3]=PKW(P0,14), pw1); \
    VRD(2); SBAR(); GAPA(C0=__builtin_amdgcn_mfma_f32_32x32x16_bf16(kf[4],qr[2],C0,0,0,0),   P1[2],P1[3],P1[4],P1[5],     pw2[0]=PKW(P1,0), pw2[1]=PKW(P1,2), pw2); \
    VRD(6); SBAR(); GAPA(C1=__builtin_amdgcn_mfma_f32_32x32x16_bf16(kf[5],qr[2],C1,0,0,0),   P1[6],P1[7],P1[8],P1[9],     pw2[2]=PKW(P1,4), pw2[3]=PKW(P1,6), pw2); \
    VRD(3); SBAR(); GAPA(C0=__builtin_amdgcn_mfma_f32_32x32x16_bf16(kf[6],qr[3],C0,0,0,0),   P1[10],P1[11],P1[12],P1[13], pw3[0]=PKW(P1,8), pw3[1]=PKW(P1,10), pw3); \
    VRD(7); SBAR(); GAPA(C1=__builtin_amdgcn_mfma_f32_32x32x16_bf16(kf[7],qr[3],C1,0,0,0),   P1[14],P1[15],0.f,0.f,       pw3[2]=PKW(P1,12),pw3[3]=PKW(P1,14), pw3); \
    l_reg+=sacc; \
    if(GK){DMA_K((t)+3,sl_cur);} if(GV){DMA_V((t)+1,sl_next);} \
    CMASK(C0,C1,t); \
    { float a=MX3(C0[0],C0[1],C1[0]),b=MX3(C0[2],C0[3],C1[1]); a=MX3(a,C1[2],C1[3]); \
      _Pragma("unroll") for(int r=4;r<16;r+=4){a=MX3(a,C0[r],C0[r+1]);b=MX3(b,C0[r+2],C0[r+3]);a=MX3(a,C1[r],C1[r+1]);b=MX3(b,C1[r+2],C1[r+3]);} \
      float rm=__builtin_fmaxf(a,b); { auto rr=__builtin_amdgcn_permlane32_swap(__float_as_uint(rm),__float_as_uint(rm),false,false); rm=__builtin_fmaxf(__uint_as_float(rr[0]),__uint_as_float(rr[1])); } \
      resc=false; \
      if(__builtin_expect(__any(rm>(float)THRL),0)){ const float dl=__builtin_fmaxf(rm,0.f); mhat+=dl; \
        _Pragma("unroll") for(int r=0;r<16;++r){C0[r]-=dl;C1[r]-=dl;} \
        const float f=__builtin_amdgcn_exp2f(-dl); l_reg*=f; if(hi==0)wsf[r32]=f; resc=true; } } \
    SBAR(); \
    GAPB(o[0]=__builtin_amdgcn_mfma_f32_32x32x16_bf16(PAF(0),VFR(0),o[0],0,0,0), C0,0); \
    GAPB(o[1]=__builtin_amdgcn_mfma_f32_32x32x16_bf16(PAF(0),VFR(4),o[1],0,0,0), C0,4); \
    KRD(GL,0); GAPB(o[0]=__builtin_amdgcn_mfma_f32_32x32x16_bf16(PAF(1),VFR(1),o[0],0,0,0), C0,8); \
    KRD(GL,1); GAPB(o[1]=__builtin_amdgcn_mfma_f32_32x32x16_bf16(PAF(1),VFR(5),o[1],0,0,0), C0,12); \
    KRD(GL,2); GAPB(o[0]=__builtin_amdgcn_mfma_f32_32x32x16_bf16(PAF(2),VFR(2),o[0],0,0,0), C1,0); \
    KRD(GL,3); GAPB(o[1]=__builtin_amdgcn_mfma_f32_32x32x16_bf16(PAF(2),VFR(6),o[1],0,0,0), C1,4); \
    GAPB(o[0]=__builtin_amdgcn_mfma_f32_32x32x16_bf16(PAF(3),VFR(3),o[0],0,0,0), C1,8); \
    GAPB(o[1]=__builtin_amdgcn_mfma_f32_32x32x16_bf16(PAF(3),VFR(7),o[1],0,0,0), C1,12); \
    }while(0)
  int t=1;
  #undef CMASK
  #define CMASK(P0,P1,t) do{}while(0)
  for(;t+5<NT;t+=2){
    STEP(pB0,pB1,pA0,pA1,t,true,true,true);     WAIT_BAR(2); RESC(); ROT();
    STEP(pA0,pA1,pB0,pB1,t+1,true,true,true);   WAIT_BAR(2); RESC(); ROT();
  }
  #undef CMASK
  #define CMASK(P0,P1,t) do{int jb_=(t)-(NT-4); if(jb_>=0)cmask(P0,P1,jb_,qrel,hi);}while(0)
  #define ENDW(tt) do{ if((tt)+3<NT){WAIT_BAR(2);} else if((tt)+2<NT){WAIT_BAR(1);} else {WAIT_BAR(0);} }while(0)
  for(;t+1<NT;t+=2){
    STEP(pB0,pB1,pA0,pA1,t,(t+3<NT),(t+1<NT),(t+1<NT));       ENDW(t);   RESC(); ROT();
    STEP(pA0,pA1,pB0,pB1,t+1,(t+4<NT),(t+2<NT),(t+2<NT));     ENDW(t+1); RESC(); ROT();
  }
  STEP(pB0,pB1,pA0,pA1,NT-1,false,false,false); RESC();
  { float sacc=pB0[0]+pB0[1]; _Pragma("unroll") for(int r=2;r<16;++r)sacc+=pB0[r]; _Pragma("unroll") for(int r=0;r<16;++r)sacc+=pB1[r]; l_reg+=sacc;
    pw0=(u32x4){PKW(pB0,0),PKW(pB0,2),PKW(pB0,4),PKW(pB0,6)};pw1=(u32x4){PKW(pB0,8),PKW(pB0,10),PKW(pB0,12),PKW(pB0,14)};pw2=(u32x4){PKW(pB1,0),PKW(pB1,2),PKW(pB1,4),PKW(pB1,6)};pw3=(u32x4){PKW(pB1,8),PKW(pB1,10),PKW(pB1,12),PKW(pB1,14)};
    SBAR(); pv(o,vb0+sl_cur,PAF(0),PAF(1),PAF(2),PAF(3)); }
  #undef PKW
  #undef PAF
  #undef VFR
  #undef PIN
  #undef MX3
  #undef GAPA
  #undef GAPB
  #undef EX
  #undef VRD
  #undef KRD
  #undef STEP
  #undef ENDW
  {auto rr=__builtin_amdgcn_permlane32_swap(__float_as_uint(l_reg),__float_as_uint(l_reg),false,false);l_reg=__uint_as_float(rr[0])+__uint_as_float(rr[1]);}
  if(hi==0)wsf[32+r32]=l_reg;asm volatile("s_waitcnt lgkmcnt(0)":::"memory");
  float rli[16];
  #pragma unroll
  for(int r=0;r<16;++r)rli[r]=__builtin_amdgcn_rcpf(wsf[32+crow(r,hi)]);
  bf16*Ow=O+(rowbase+q0+wid*QBLK)*OPITCH+h*D;
  { bf16*stg=(bf16*)(shm+LDS_OST)+wid*2048;
    #pragma unroll
    for(int r=0;r<16;++r){const int orow=crow(r,hi);
      #pragma unroll
      for(int d0=0;d0<2;++d0)stg[orow*64+d0*32+r32]=__float2bfloat16(o[d0][r]*rli[r]);}
    asm volatile("s_waitcnt lgkmcnt(0)":::"memory");
    #pragma unroll
    for(int i=0;i<4;++i){const int row=i*8+(lane>>3),ch=lane&7; const u32x4 v=*(const u32x4*)(stg+row*64+ch*8); bf16*dst=Ow+(long)row*OPITCH+ch*8; const u32x4 gv=*(const u32x4*)dst; u32x4 w;
      #pragma unroll
      for(int j=0;j<4;++j){ const float a0=__uint_as_float(v[j]<<16)*__uint_as_float(gv[j]<<16), a1=__uint_as_float(v[j]&0xffff0000u)*__uint_as_float(gv[j]&0xffff0000u); w[j]=cvtpk_s(a0,a1); }
      if(!dry)*(u32x4*)dst=w;} }
  asm volatile("s_waitcnt lgkmcnt(0)\n\ts_barrier":::"memory");
  #undef DMA_K
  #undef DMA_V
  #undef CMASK
  #undef START
  #undef RESC
  #undef ROT
}
constexpr int ATTN_LDS_BYTES=LDS_BYTES;
struct AttnTensors { const bf16* Q; const bf16* K; const bf16* V; bf16* O; const float* CB; };
struct AttnUnit { int bh; int qb; };
struct StaticOrder {
  int vcu;
  __device__ __forceinline__ explicit StaticOrder(int grid,int block):vcu((block%8)*(grid/8)+block/8){}
  __device__ __forceinline__ bool next(int i,AttnUnit&u)const{ if(i>=2)return false; const int s=vcu&7; u.bh=vcu>>3; u.qb=(i==0)?15-s:s; return true; }
  __device__ __forceinline__ void a_ready(const AttnUnit&)const{}
  __device__ __forceinline__ void done(const AttnUnit&)const{}
};
template<class Sched,int THRL=8> __device__ __forceinline__ void attn_phase(char*lds,const AttnTensors&T,const Sched&S,bool dry=false){
  AttnUnit u;
  for(int i=0;S.next(i,u);++i){ S.a_ready(u); attn_unit<THRL>(u.bh/NHEAD,u.bh%NHEAD,u.qb,T.Q,T.K,T.V,T.O,T.CB,lds,dry); S.done(u); }
}
#undef SBAR
#undef WAIT_BAR
}
#include <hip/hip_cooperative_groups.h>
namespace cg = cooperative_groups;
#define LAS __attribute__((address_space(3)))
typedef unsigned short bf16;
typedef float f32x4 __attribute__((ext_vector_type(4)));
typedef float f32x2 __attribute__((ext_vector_type(2)));
typedef unsigned u32x4 __attribute__((ext_vector_type(4)));
typedef unsigned u32x2 __attribute__((ext_vector_type(2)));
typedef short bf16x8 __attribute__((ext_vector_type(8)));
typedef short bf16x4 __attribute__((ext_vector_type(4)));

constexpr int NWAVES = 8, NTHR = 512;
constexpr int BATCH = 4, SEQ = 4096, DM = 1024, DEPTH = 4, M = BATCH * SEQ;
constexpr int NIN = 3592, NF = 3840;
constexpr int T5 = 32, NCH5 = M / T5, KA5 = 640, NG5 = 16;
constexpr float EPS = 1e-6f;
constexpr float LOG2E = 1.4426950408889634f;

constexpr size_t MiB = 1u << 20;
constexpr size_t WS_WIN = 1 * MiB, WS_WO = 31 * MiB, WS_WGLU = 39 * MiB, WS_ROPE = 40 * MiB, WS_MF = 41 * MiB, WS_WB = 81 * MiB;
constexpr size_t WS_LAM = 90 * MiB, WS_LOGF = 90 * MiB + 65536, WS_CB = WS_LOGF + 524288, WS_SS = WS_CB + 524288;
constexpr size_t WS_XN = 92 * MiB, WS_E = WS_XN, WS_UPD = WS_XN + 4 * MiB, WS_STATE = WS_XN + 20 * MiB;
constexpr size_t WS_QO = 124 * MiB, WS_KB = 140 * MiB, WS_VB = 156 * MiB, WS_SUA = 172 * MiB, WS_RQ = 182 * MiB, WS_RK = 190 * MiB, WS_RKT = 198 * MiB, WS_YS5 = WS_RKT;
constexpr size_t WS_RVT = 206 * MiB, WS_GATE = 214 * MiB, WS_END = 246 * MiB;

constexpr int RING_BYTES = 131072, LDS_BYTES = 147456;

struct Args { const float* in[16]; float* out; unsigned char* ws; };

__device__ __forceinline__ float bf2f(unsigned short b) { return __uint_as_float((unsigned)b << 16); }
__device__ __forceinline__ float bflo(unsigned w) { return __uint_as_float(w << 16); }
__device__ __forceinline__ float bfhi(unsigned w) { return __uint_as_float(w & 0xffff0000u); }
__device__ __forceinline__ unsigned pk2(float lo, float hi) { return pg8::cvt_pk_bf16(lo, hi); }
__device__ __forceinline__ unsigned short f2bf(float f) { return (unsigned short)(pg8::cvt_pk_bf16(f, 0.f) & 0xffffu); }
__device__ __forceinline__ float wave_sum(float v) {
#pragma unroll
    for (int o = 1; o < 64; o <<= 1) v += __shfl_xor(v, o);
    return v;
}
__device__ __forceinline__ float lg2_gamma(int hh) { return log2f(1.0f - exp2f(-5.0f - (float)hh)); }

__device__ __forceinline__ int win_col(int n) {
    if (n < 1536) return n;
    if (n < 1792) return n + 8;
    if (n >= 3584) return (n < 3592) ? 1536 + (n - 3584) : -1;
    if (n < 2304) { const bool q = n < 2048; const int base = q ? 1792 : 2048; const int hh = (n - base) >> 6, pos = (n - base) & 63; const int d = (pos & 1) ? 32 + (pos >> 1) : (pos >> 1); return (q ? 1800 : 2056) + hh * 64 + d; }
    return n + 8;
}
template <bool MAP> __device__ __forceinline__ void p0_transpose_item(const float* W, int K, int Nsrc, int Ndst, bf16* WT, LAS float* scr, int item, int lane) {
    const int nblk = Ndst / 32, kb = item / nblk, nb = item % nblk, k0 = 64 * kb, n0 = 32 * nb;
    const int sc = MAP ? win_col(n0 + (lane & 31)) : n0 + (lane & 31);
#pragma unroll 8
    for (int i = 0; i < 32; ++i) { const int kk = 2 * i + (lane >> 5); scr[kk * 33 + (lane & 31)] = (MAP && sc < 0) ? 0.f : W[(size_t)(k0 + kk) * Nsrc + (sc < 0 ? 0 : sc)]; }
    asm volatile("s_waitcnt lgkmcnt(0)" ::: "memory");
    const int c = lane & 7;
#pragma unroll
    for (int j = 0; j < 4; ++j) { const int n = (lane >> 3) + 8 * j; const LAS float* s = scr + (8 * c) * 33 + n;
        u32x4 o; o.x = pk2(s[0 * 33], s[1 * 33]); o.y = pk2(s[2 * 33], s[3 * 33]); o.z = pk2(s[4 * 33], s[5 * 33]); o.w = pk2(s[6 * 33], s[7 * 33]);
        *(u32x4*)(WT + (size_t)(n0 + n) * K + k0 + 8 * c) = o; }
    asm volatile("s_waitcnt lgkmcnt(0)" ::: "memory");
}

__device__ __forceinline__ void s5_prep(const Args& a, int l, int g, LAS float* L, int tid) {
    LAS float* LPr = L;
    LAS float* LPi = L + 33 * 64;
    LAS float* Bbr = L + 66 * 64;
    LAS float* Bbi = Bbr + 1024;
    LAS float* Cr = Bbi + 1024;
    LAS float* Ci = Cr + 1024;
    LAS float* KT = Ci + 1024;
    const float* a_re = a.in[4] + (size_t)(l * 16 + g) * 64; const float* a_im = a.in[5] + (size_t)(l * 16 + g) * 64;
    const float* b_re = a.in[6] + (size_t)(l * 16 + g) * 1024; const float* b_im = a.in[7] + (size_t)(l * 16 + g) * 1024;
    const float* c_re = a.in[8] + (size_t)(l * 16 + g) * 1024; const float* c_im = a.in[9] + (size_t)(l * 16 + g) * 1024;
    const float log_dt = a.in[11][l * 16 + g];
    bf16* MF = (bf16*)(a.ws + WS_MF) + (size_t)(l * 16 + g) * 512 * KA5;
    bf16* WB = (bf16*)(a.ws + WS_WB) + (size_t)(l * 16 + g) * 128 * 512;
    float* LAM = (float*)(a.ws + WS_LAM) + (size_t)(l * 16 + g) * 128;
    if (tid < 64) {
        const int p = tid;
        const double dt = exp((double)log_dt), ar = (double)a_re[p], ai = (double)a_im[p];
        const double mag = exp(ar * dt); double sn, cs; sincos(ai * dt, &sn, &cs);
        const double lr = mag * cs, li = mag * sn, den = ar * ar + ai * ai;
        const double fr = ((lr - 1.0) * ar + li * ai) / den, fi = (li * ar - (lr - 1.0) * ai) / den;
#pragma unroll 4
        for (int h = 0; h < 16; ++h) { const double br = (double)b_re[p * 16 + h], bi = (double)b_im[p * 16 + h]; Bbr[p * 16 + h] = (float)(fr * br - fi * bi); Bbi[p * 16 + h] = (float)(fr * bi + fi * br); }
        double pr = 1.0, pi = 0.0;
        for (int j = 0; j <= 32; ++j) { LPr[j * 64 + p] = (float)pr; LPi[j * 64 + p] = (float)pi; const double nr = pr * lr - pi * li, ni = pr * li + pi * lr; pr = nr; pi = ni; }
        LAM[p] = LPr[32 * 64 + p]; LAM[64 + p] = LPi[32 * 64 + p];
    }
    for (int i = tid; i < 1024; i += NTHR) { const int h = i >> 6, p = i & 63; Cr[p * 16 + h] = c_re[i]; Ci[p * 16 + h] = c_im[i]; }
    __syncthreads();
    { const int j = tid >> 4, h = tid & 15; float acc[16];
#pragma unroll
      for (int e = 0; e < 16; ++e) acc[e] = 0.f;
      for (int p = 0; p < 64; ++p) { const float cr = Cr[p * 16 + h], ci = Ci[p * 16 + h], lr = LPr[j * 64 + p], li = LPi[j * 64 + p]; const float clr = cr * lr - ci * li, cli = cr * li + ci * lr;
#pragma unroll
          for (int q = 0; q < 4; ++q) { const f32x4 br = *(const LAS f32x4*)(Bbr + p * 16 + 4 * q), bi = *(const LAS f32x4*)(Bbi + p * 16 + 4 * q);
              acc[4 * q] += clr * br.x - cli * bi.x; acc[4 * q + 1] += clr * br.y - cli * bi.y; acc[4 * q + 2] += clr * br.z - cli * bi.z; acc[4 * q + 3] += clr * br.w - cli * bi.w; } }
#pragma unroll
      for (int e = 0; e < 16; ++e) KT[tid * 16 + e] = acc[e]; }
    __syncthreads();
    for (int q = tid; q < 512 * 64; q += NTHR) {
        const int row = q >> 6, cp = q & 63, s = cp >> 1, h0 = (cp & 1) * 8, t = row >> 4, h = row & 15;
        u32x4 o = (u32x4){0u, 0u, 0u, 0u};
        if (s <= t) { const LAS float* k = KT + ((t - s) * 16 + h) * 16 + h0; o.x = pk2(k[0], k[1]); o.y = pk2(k[2], k[3]); o.z = pk2(k[4], k[5]); o.w = pk2(k[6], k[7]); }
        *(u32x4*)(MF + (size_t)row * KA5 + cp * 8) = o;
    }
    for (int q = tid; q < 512 * 16; q += NTHR) {
        const int row = q >> 4, cp = q & 15, t = row >> 4, h = row & 15; float v[8];
#pragma unroll
        for (int e = 0; e < 8; ++e) { const int jj = cp * 8 + e, p = jj & 63; const float cr = Cr[p * 16 + h], ci = Ci[p * 16 + h], lr = LPr[(t + 1) * 64 + p], li = LPi[(t + 1) * 64 + p];
            v[e] = (jj < 64) ? (cr * lr - ci * li) : -(cr * li + ci * lr); }
        u32x4 o; o.x = pk2(v[0], v[1]); o.y = pk2(v[2], v[3]); o.z = pk2(v[4], v[5]); o.w = pk2(v[6], v[7]);
        *(u32x4*)(MF + (size_t)row * KA5 + 512 + cp * 8) = o;
    }
    for (int q = tid; q < 128 * 64; q += NTHR) {
        const int j = q >> 6, cp = q & 63, s = cp >> 1, h0 = (cp & 1) * 8, p = j & 63; const float lr = LPr[(31 - s) * 64 + p], li = LPi[(31 - s) * 64 + p]; float v[8];
#pragma unroll
        for (int e = 0; e < 8; ++e) { const float br = Bbr[p * 16 + h0 + e], bi = Bbi[p * 16 + h0 + e]; v[e] = (j < 64) ? (lr * br - li * bi) : (lr * bi + li * br); }
        u32x4 o; o.x = pk2(v[0], v[1]); o.y = pk2(v[2], v[3]); o.z = pk2(v[4], v[5]); o.w = pk2(v[6], v[7]);
        *(u32x4*)(WB + (size_t)j * 512 + cp * 8) = o;
    }
    __syncthreads();
}

__device__ __forceinline__ void norm0_phase(const Args& a, int lane, int gw, int NGW) {
    const float* X = a.in[0]; f32x4 gv[4];
#pragma unroll
    for (int j = 0; j < 4; ++j) gv[j] = *((const f32x4*)a.in[1] + lane + 64 * j);
    bf16* XN = (bf16*)(a.ws + WS_XN); float* SS = (float*)(a.ws + WS_SS);
    for (int m = gw; m < M; m += 2 * NGW) {
        const int m2 = m + NGW; const bool has2 = m2 < M;
        const f32x4* xr = (const f32x4*)(X + (size_t)m * DM) + lane; const f32x4* xr2 = (const f32x4*)(X + (size_t)(has2 ? m2 : m) * DM) + lane; f32x4 v[4], w[4];
#pragma unroll
        for (int j = 0; j < 4; ++j) { v[j] = xr[64 * j]; w[j] = xr2[64 * j]; }
        float ss = 0.f, ss2 = 0.f;
#pragma unroll
        for (int j = 0; j < 4; ++j) { ss += (v[j].x * v[j].x + v[j].y * v[j].y) + (v[j].z * v[j].z + v[j].w * v[j].w); ss2 += (w[j].x * w[j].x + w[j].y * w[j].y) + (w[j].z * w[j].z + w[j].w * w[j].w); }
        ss = wave_sum(ss); ss2 = wave_sum(ss2);
        unsigned long long* o8 = (unsigned long long*)(XN + (size_t)m * DM) + lane; unsigned long long* o82 = (unsigned long long*)(XN + (size_t)m2 * DM) + lane;
#pragma unroll
        for (int j = 0; j < 4; ++j) { v[j] = v[j] * gv[j]; o8[64 * j] = (unsigned long long)pk2(v[j].x, v[j].y) | ((unsigned long long)pk2(v[j].z, v[j].w) << 32);
            if (has2) { w[j] = w[j] * gv[j]; o82[64 * j] = (unsigned long long)pk2(w[j].x, w[j].y) | ((unsigned long long)pk2(w[j].z, w[j].w) << 32); } }
        if (lane == 0) { SS[m] = ss; if (has2) SS[m2] = ss2; }
    }
}
__device__ __forceinline__ void final_norm(const Args& a, float* X, const float* SS, int lane, int gw, int NGW) {
    f32x4 gv[4];
#pragma unroll
    for (int j = 0; j < 4; ++j) gv[j] = *((const f32x4*)a.in[15] + lane + 64 * j);
    for (int m = gw; m < M; m += 2 * NGW) {
        const int m2 = m + NGW; const bool has2 = m2 < M;
        f32x4* xr = (f32x4*)(X + (size_t)m * DM) + lane; f32x4* xr2 = (f32x4*)(X + (size_t)(has2 ? m2 : m) * DM) + lane; f32x4 v[4], w[4];
#pragma unroll
        for (int j = 0; j < 4; ++j) { v[j] = xr[64 * j]; w[j] = xr2[64 * j]; }
        const float r1 = rsqrtf(SS[m] * (1.f / DM) + EPS), r2 = rsqrtf(SS[has2 ? m2 : m] * (1.f / DM) + EPS);
#pragma unroll
        for (int j = 0; j < 4; ++j) { xr[64 * j] = v[j] * r1 * gv[j]; if (has2) xr2[64 * j] = w[j] * r2 * gv[j]; }
    }
}

__device__ __forceinline__ bool opaque_true() { int d = 1; asm volatile("" : "+s"(d)); return d != 0; }
struct FlatOrder {
    int nM, nN, nG, G, c;
    __device__ bool next(int i, pg8::Unit& u) const { const int L = i * G + c; if (L >= nG * nM * nN) return false; u.gz = L / (nM * nN); const int r = L % (nM * nN); u.pm = r % nM; u.pn = r / nM; return true; }
    __device__ __forceinline__ void a_ready(const pg8::Unit&) const {}
    __device__ __forceinline__ void done(const pg8::Unit&) const {}
};
__device__ __forceinline__ float silu_f(float v) { return v / (1.f + __expf(-v)); }
__device__ __forceinline__ float gelu_tanh(float v) { const float u = 0.7978845608028654f * (v + 0.044715f * v * v * v); const float e = __expf(2.f * u); const float th = 1.f - 2.f / (e + 1.f); return 0.5f * v * (1.f + th); }

struct EpiInProj {
    static constexpr bool PERM = true, AFTER_DRAIN = false;
    unsigned char* ws; const float* SS; const float* bfl;
    __device__ __forceinline__ void operator()(const pg8::f32x4 (&acc)[2][2][4][2], const pg8::Unit& u, int wr, int wc, int fr, int fq) const {
        const int pn = u.pn; const int row0 = u.pm * 256 + wr * 64 + fr, cl0 = wc * 32 + 8 * fq;
        float rs[2][4];
#pragma unroll
        for (int ai = 0; ai < 2; ++ai)
#pragma unroll
            for (int m = 0; m < 4; ++m) rs[ai][m] = rsqrtf(SS[row0 + ai * 128 + m * 16] * (1.f / DM) + EPS);
        if (pn == 14) {
            if (wc == 0 && fq == 0) { float* LOGF = (float*)(ws + WS_LOGF); const f32x4 b0 = *(const f32x4*)bfl, b1 = *(const f32x4*)(bfl + 4);
#pragma unroll
                for (int ai = 0; ai < 2; ++ai)
#pragma unroll
                    for (int m = 0; m < 4; ++m) { const int row = row0 + ai * 128 + m * 16; const float r = rs[ai][m]; const pg8::f32x4 v0 = acc[ai][0][m][0], v1 = acc[ai][0][m][1];
                        float z[8] = {v0[0] * r + b0.x, v0[1] * r + b0.y, v0[2] * r + b0.z, v0[3] * r + b0.w, v1[0] * r + b1.x, v1[1] * r + b1.y, v1[2] * r + b1.z, v1[3] * r + b1.w};
#pragma unroll
                        for (int e = 0; e < 8; ++e) LOGF[(size_t)((row >> 12) * 8 + e) * SEQ + (row & 4095)] = fminf(z[e], 0.f) - log1pf(__expf(-fabsf(z[e]))); } }
            return;
        }
        if (pn < 6) {
            bf16* base = (bf16*)(ws + (pn < 2 ? WS_QO : pn < 4 ? WS_KB : WS_VB)); const float sc = pn < 2 ? 0.125f * LOG2E : 1.f; const int cb = (pn & 1) * 256 + cl0;
#pragma unroll
            for (int ai = 0; ai < 2; ++ai)
#pragma unroll
                for (int m = 0; m < 4; ++m) { bf16* rp = base + (size_t)(row0 + ai * 128 + m * 16) * 512 + cb;
#pragma unroll
                    for (int bj = 0; bj < 2; ++bj) { const float sr = sc * rs[ai][m]; const pg8::f32x4 v0 = acc[ai][bj][m][0] * sr, v1 = acc[ai][bj][m][1] * sr; u32x4 w; w.x = pk2(v0[0], v0[1]); w.y = pk2(v0[2], v0[3]); w.z = pk2(v1[0], v1[1]); w.w = pk2(v1[2], v1[3]); *(u32x4*)(rp + bj * 128) = w; } }
        } else if (pn == 6) {
            bf16* base = (bf16*)(ws + WS_SUA);
#pragma unroll
            for (int ai = 0; ai < 2; ++ai)
#pragma unroll
                for (int m = 0; m < 4; ++m) { const int row = row0 + ai * 128 + m * 16, chunk = row >> 5, t = row & 31;
#pragma unroll
                    for (int bj = 0; bj < 2; ++bj) { const int c = cl0 + bj * 128, g = c >> 4, h0 = c & 15; const pg8::f32x4 v0 = acc[ai][bj][m][0] * rs[ai][m], v1 = acc[ai][bj][m][1] * rs[ai][m]; u32x4 w; w.x = pk2(v0[0], v0[1]); w.y = pk2(v0[2], v0[3]); w.z = pk2(v1[0], v1[1]); w.w = pk2(v1[2], v1[3]);
                        *(u32x4*)(base + ((size_t)(g * 512 + chunk) * KA5 + t * 16 + h0)) = w; } }
        } else if (pn == 7 || pn == 8) {
            const f32x4* rope = (const f32x4*)(ws + WS_ROPE); bf16* base = (bf16*)(ws + (pn == 7 ? WS_RQ : WS_RK)); bf16* RKT = (bf16*)(ws + WS_RKT);
#pragma unroll
            for (int ai = 0; ai < 2; ++ai)
#pragma unroll
                for (int m = 0; m < 4; ++m) { const int row = row0 + ai * 128 + m * 16, b = row >> 12, t = row & 4095;
#pragma unroll
                    for (int bj = 0; bj < 2; ++bj) { const int c = cl0 + bj * 128, hh = c >> 6, pos0 = c & 63; const pg8::f32x4 v0 = acc[ai][bj][m][0] * rs[ai][m], v1 = acc[ai][bj][m][1] * rs[ai][m];
                        const f32x4 r0 = rope[(t * 32 + (pos0 >> 1)) >> 1], r1 = rope[((t * 32 + (pos0 >> 1)) >> 1) + 1];
                        float o[8];
                        o[0] = v0[0] * r0.x - v0[1] * r0.y; o[1] = v0[0] * r0.y + v0[1] * r0.x; o[2] = v0[2] * r0.z - v0[3] * r0.w; o[3] = v0[2] * r0.w + v0[3] * r0.z;
                        o[4] = v1[0] * r1.x - v1[1] * r1.y; o[5] = v1[0] * r1.y + v1[1] * r1.x; o[6] = v1[2] * r1.z - v1[3] * r1.w; o[7] = v1[2] * r1.w + v1[3] * r1.z;
                        u32x4 w; w.x = pk2(o[0], o[1]); w.y = pk2(o[2], o[3]); w.z = pk2(o[4], o[5]); w.w = pk2(o[6], o[7]);
                        *(u32x4*)(base + (size_t)row * 256 + c) = w;
                        if (pn == 8) { const float wk = exp2f(lg2_gamma(hh) * (float)(63 - (t & 63))); bf16* tp = RKT + ((size_t)((b * 4 + hh) * 64 + pos0)) * SEQ + t;
#pragma unroll
                            for (int e = 0; e < 8; ++e) tp[(size_t)e * SEQ] = f2bf(o[e] * wk); } } }
        } else if (pn == 9) {
            bf16* RVT = (bf16*)(ws + WS_RVT);
#pragma unroll
            for (int ai = 0; ai < 2; ++ai)
#pragma unroll
                for (int m = 0; m < 4; ++m) { const int row = row0 + ai * 128 + m * 16, b = row >> 12, t = row & 4095;
#pragma unroll
                    for (int bj = 0; bj < 2; ++bj) { const int c = cl0 + bj * 128, hh = c >> 6, d0 = c & 63; const pg8::f32x4 v0 = acc[ai][bj][m][0] * rs[ai][m], v1 = acc[ai][bj][m][1] * rs[ai][m]; bf16* tp = RVT + ((size_t)((b * 4 + hh) * 64 + d0)) * SEQ + t;
#pragma unroll
                        for (int e = 0; e < 4; ++e) { tp[(size_t)e * SEQ] = f2bf(v0[e]); tp[(size_t)(4 + e) * SEQ] = f2bf(v1[e]); } } }
        } else {
            bf16* base = (bf16*)(ws + WS_GATE); const int cb = (pn - 10) * 256 + cl0;
#pragma unroll
            for (int ai = 0; ai < 2; ++ai)
#pragma unroll
                for (int m = 0; m < 4; ++m) { bf16* rp = base + (size_t)(row0 + ai * 128 + m * 16) * 1024 + cb;
#pragma unroll
                    for (int bj = 0; bj < 2; ++bj) { const pg8::f32x4 v0 = acc[ai][bj][m][0] * rs[ai][m], v1 = acc[ai][bj][m][1] * rs[ai][m]; u32x4 w; w.x = pk2(silu_f(v0[0]), silu_f(v0[1])); w.y = pk2(silu_f(v0[2]), silu_f(v0[3])); w.z = pk2(silu_f(v1[0]), silu_f(v1[1])); w.w = pk2(silu_f(v1[2]), silu_f(v1[3])); *(u32x4*)(rp + bj * 128) = w; } }
        }
    }
};
struct EpiS5E {
    static constexpr bool PERM = false, AFTER_DRAIN = false;
    float* E;
    __device__ __forceinline__ void operator()(const pg8::f32x4 (&acc)[2][2][4][2], const pg8::Unit& u, int wr, int wc, int fr, int fq) const {
        const int row0 = u.pm * 256 + wr * 64 + fr, col0 = wc * 32 + 4 * fq;
#pragma unroll
        for (int ai = 0; ai < 2; ++ai)
#pragma unroll
            for (int m = 0; m < 4; ++m) { float* rp = E + ((size_t)u.gz * NCH5 + row0 + ai * 128 + m * 16) * 128 + col0;
#pragma unroll
                for (int n = 0; n < 2; ++n) *(pg8::f32x4*)(rp + n * 16) = acc[ai][0][m][n]; }
    }
};
struct EpiS5Y {
    static constexpr bool PERM = true, AFTER_DRAIN = false;
    const bf16* SUA; bf16* YS5; const float* dvec;
    __device__ __forceinline__ void operator()(const pg8::f32x4 (&acc)[2][2][4][2], const pg8::Unit& u, int wr, int wc, int fr, int fq) const {
        const int row0 = u.pm * 256 + wr * 64 + fr, cl0 = u.pn * 256 + wc * 32 + 8 * fq; const int g = u.gz;
#pragma unroll
        for (int bj = 0; bj < 2; ++bj) { const int c = cl0 + bj * 128, tt = c >> 4, h0 = c & 15; const f32x4 d0 = *(const f32x4*)(dvec + g * 16 + h0), d1 = *(const f32x4*)(dvec + g * 16 + h0 + 4);
#pragma unroll
            for (int ai = 0; ai < 2; ++ai)
#pragma unroll
                for (int m = 0; m < 4; ++m) { const int chunk = row0 + ai * 128 + m * 16; const u32x4 uu = *(const u32x4*)(SUA + ((size_t)(g * 512 + chunk) * KA5 + c)); const pg8::f32x4 v0 = acc[ai][bj][m][0], v1 = acc[ai][bj][m][1];
                    float y[8]; y[0] = v0[0] + d0.x * bflo(uu.x); y[1] = v0[1] + d0.y * bfhi(uu.x); y[2] = v0[2] + d0.z * bflo(uu.y); y[3] = v0[3] + d0.w * bfhi(uu.y);
                    y[4] = v1[0] + d1.x * bflo(uu.z); y[5] = v1[1] + d1.y * bfhi(uu.z); y[6] = v1[2] + d1.z * bflo(uu.w); y[7] = v1[3] + d1.w * bfhi(uu.w);
#pragma unroll
                    for (int e = 0; e < 8; ++e) y[e] = gelu_tanh(y[e]);
                    u32x4 w; w.x = pk2(y[0], y[1]); w.y = pk2(y[2], y[3]); w.z = pk2(y[4], y[5]); w.w = pk2(y[6], y[7]);
                    *(u32x4*)(YS5 + (size_t)(chunk * 32 + tt) * 256 + g * 16 + h0) = w; } }
    }
};
struct EpiGlu {
    static constexpr bool PERM = true, AFTER_DRAIN = false;
    const bf16* YS5; bf16* G; bool dry;
    __device__ __forceinline__ void operator()(const pg8::f32x4 (&acc)[2][2][4][2], const pg8::Unit& u, int wr, int wc, int fr, int fq) const {
        const int row0 = u.pm * 256 + wr * 64 + fr, cl0 = wc * 32 + 8 * fq;
#pragma unroll
        for (int ai = 0; ai < 2; ++ai)
#pragma unroll
            for (int m = 0; m < 4; ++m) { const int row = row0 + ai * 128 + m * 16;
#pragma unroll
                for (int bj = 0; bj < 2; ++bj) { const int c = cl0 + bj * 128; const u32x4 yy = *(const u32x4*)(YS5 + (size_t)row * 256 + c); bf16* gp = G + (size_t)row * 1024 + 512 + c; const u32x4 gg = *(const u32x4*)gp;
                    const pg8::f32x4 v0 = acc[ai][bj][m][0], v1 = acc[ai][bj][m][1]; float s[8];
#pragma unroll
                    for (int e = 0; e < 4; ++e) { s[e] = 1.f / (1.f + __expf(-v0[e])); s[4 + e] = 1.f / (1.f + __expf(-v1[e])); }
                    u32x4 w; w.x = pk2(bflo(yy.x) * s[0] * bflo(gg.x), bfhi(yy.x) * s[1] * bfhi(gg.x)); w.y = pk2(bflo(yy.y) * s[2] * bflo(gg.y), bfhi(yy.y) * s[3] * bfhi(gg.y));
                    w.z = pk2(bflo(yy.z) * s[4] * bflo(gg.z), bfhi(yy.z) * s[5] * bfhi(gg.z)); w.w = pk2(bflo(yy.w) * s[6] * bflo(gg.w), bfhi(yy.w) * s[7] * bfhi(gg.w));
                    if (!dry) *(u32x4*)gp = w; } }
    }
};
struct EpiOut {
    static constexpr bool PERM = false, AFTER_DRAIN = false;
    const float* base; float* out; float* SSn; bf16* XN; const float* gnext; bool dry;
    __device__ __forceinline__ void operator()(const pg8::f32x4 (&acc)[2][2][4][2], const pg8::Unit& u, int wr, int wc, int fr, int fq) const {
        const int row0 = u.pm * 256 + wr * 64 + fr, col0 = u.pn * 256 + wc * 32 + 4 * fq;
        f32x4 gq[2][2];
#pragma unroll
        for (int bj = 0; bj < 2; ++bj)
#pragma unroll
            for (int n = 0; n < 2; ++n) gq[bj][n] = gnext ? *(const f32x4*)(gnext + col0 + bj * 128 + n * 16) : (f32x4){0.f, 0.f, 0.f, 0.f};
#pragma unroll
        for (int ai = 0; ai < 2; ++ai)
#pragma unroll
            for (int m = 0; m < 4; ++m) { const int row = row0 + ai * 128 + m * 16; const size_t off = (size_t)row * DM + col0; float sq = 0.f;
#pragma unroll
                for (int bj = 0; bj < 2; ++bj)
#pragma unroll
                    for (int n = 0; n < 2; ++n) { const f32x4 bs = *(const f32x4*)(base + off + bj * 128 + n * 16); const pg8::f32x4 v = acc[ai][bj][m][n]; const f32x4 x = (f32x4){bs.x + v[0], bs.y + v[1], bs.z + v[2], bs.w + v[3]};
                        sq += (x.x * x.x + x.y * x.y) + (x.z * x.z + x.w * x.w);
                        if (!dry) { *(f32x4*)(out + off + bj * 128 + n * 16) = x;
                            if (gnext) { const f32x4 g = gq[bj][n]; u32x2 w; w.x = pk2(x.x * g.x, x.y * g.y); w.y = pk2(x.z * g.z, x.w * g.w); *(u32x2*)(XN + off + bj * 128 + n * 16) = w; } } }
                sq += __shfl_xor(sq, 16); sq += __shfl_xor(sq, 32);
                if (fq == 0 && !dry) __hip_atomic_fetch_add(SSn + row, sq, __ATOMIC_RELAXED, __HIP_MEMORY_SCOPE_AGENT); }
    }
};

__device__ __forceinline__ void ret_upd_unit(unsigned char* ws, int unit, int lane) {
    const int c = unit & 63, bh = unit >> 6; const int i16 = lane & 15, kq = lane >> 4;
    const bf16* KT = (const bf16*)(ws + WS_RKT) + (size_t)bh * 64 * SEQ + c * 64; const bf16* VT = (const bf16*)(ws + WS_RVT) + (size_t)bh * 64 * SEQ + c * 64;
    float* UPD = (float*)(ws + WS_UPD) + (size_t)unit * 4096;
    bf16x8 af[4][2], bfv[4][2];
#pragma unroll
    for (int ib = 0; ib < 4; ++ib)
#pragma unroll
        for (int ks = 0; ks < 2; ++ks) { af[ib][ks] = *(const bf16x8*)(KT + (size_t)(16 * ib + i16) * SEQ + 32 * ks + 8 * kq); bfv[ib][ks] = *(const bf16x8*)(VT + (size_t)(16 * ib + i16) * SEQ + 32 * ks + 8 * kq); }
#pragma unroll
    for (int ib = 0; ib < 4; ++ib)
#pragma unroll
        for (int jb = 0; jb < 4; ++jb) { pg8::f32x4 d = (pg8::f32x4){0.f, 0.f, 0.f, 0.f};
            d = __builtin_amdgcn_mfma_f32_16x16x32_bf16(af[ib][0], bfv[jb][0], d, 0, 0, 0); d = __builtin_amdgcn_mfma_f32_16x16x32_bf16(af[ib][1], bfv[jb][1], d, 0, 0, 0);
            *(pg8::f32x4*)(UPD + (size_t)(16 * jb + i16) * 64 + 16 * ib + 4 * kq) = d; }
}
__device__ __forceinline__ void ret_out_unit(const Args& a, int l, int unit, int lane, bool dry = false) {
    unsigned char* ws = a.ws;
    const int c = unit & 63, bh = unit >> 6, hh = bh & 3, b = bh >> 2; const int fr = lane & 15, fq = lane >> 4;
    const size_t t0 = (size_t)b * SEQ + c * 64;
    const bf16* RQ = (const bf16*)(ws + WS_RQ) + t0 * 256 + hh * 64; const bf16* RK = (const bf16*)(ws + WS_RK) + t0 * 256 + hh * 64;
    const bf16* VT = (const bf16*)(ws + WS_RVT) + (size_t)bh * 64 * SEQ + c * 64; const bf16* ST = (const bf16*)(ws + WS_STATE) + (size_t)unit * 4096;
    const float lg = lg2_gamma(hh);
    bf16x8 qf[4][2]; pg8::f32x4 st[4][4];
#pragma unroll
    for (int nb = 0; nb < 4; ++nb)
#pragma unroll
        for (int ks = 0; ks < 2; ++ks) qf[nb][ks] = *(const bf16x8*)(RQ + (size_t)(16 * nb + fr) * 256 + 32 * ks + 8 * fq);
#pragma unroll
    for (int mb = 0; mb < 4; ++mb) { bf16x8 k0 = *(const bf16x8*)(RK + (size_t)(16 * mb + fr) * 256 + 8 * fq), k1 = *(const bf16x8*)(RK + (size_t)(16 * mb + fr) * 256 + 32 + 8 * fq);
#pragma unroll
        for (int nb = 0; nb < 4; ++nb) { pg8::f32x4 d = (pg8::f32x4){0.f, 0.f, 0.f, 0.f};
            d = __builtin_amdgcn_mfma_f32_16x16x32_bf16(k0, qf[nb][0], d, 0, 0, 0); d = __builtin_amdgcn_mfma_f32_16x16x32_bf16(k1, qf[nb][1], d, 0, 0, 0);
#pragma unroll
            for (int r = 0; r < 4; ++r) { const int mm = 16 * mb + 4 * fq + r, nn = 16 * nb + fr; const int df = mm > nn ? mm - nn : nn - mm; d[r] *= 0.125f * exp2f(lg * (float)df); }
            st[mb][nb] = d; } }
    pg8::f32x4 o[4][4];
#pragma unroll
    for (int nb = 0; nb < 4; ++nb)
#pragma unroll
        for (int dvb = 0; dvb < 4; ++dvb) o[nb][dvb] = (pg8::f32x4){0.f, 0.f, 0.f, 0.f};
#pragma unroll
    for (int dvb = 0; dvb < 4; ++dvb) { const bf16x8 s0 = *(const bf16x8*)(ST + (size_t)(16 * dvb + fr) * 64 + 8 * fq), s1 = *(const bf16x8*)(ST + (size_t)(16 * dvb + fr) * 64 + 32 + 8 * fq);
#pragma unroll
        for (int nb = 0; nb < 4; ++nb) { o[nb][dvb] = __builtin_amdgcn_mfma_f32_16x16x32_bf16(qf[nb][0], s0, o[nb][dvb], 0, 0, 0); o[nb][dvb] = __builtin_amdgcn_mfma_f32_16x16x32_bf16(qf[nb][1], s1, o[nb][dvb], 0, 0, 0); } }
#pragma unroll
    for (int nb = 0; nb < 4; ++nb)
#pragma unroll
        for (int r = 0; r < 4; ++r) { const float wq = 0.125f * exp2f(lg * (float)(16 * nb + 4 * fq + r + 1));
#pragma unroll
            for (int dvb = 0; dvb < 4; ++dvb) o[nb][dvb][r] *= wq; }
#pragma unroll
    for (int s = 0; s < 2; ++s) {
        bf16x8 pa[4];
#pragma unroll
        for (int nb = 0; nb < 4; ++nb) { u32x4 w; w.x = pk2(st[2 * s][nb][0], st[2 * s][nb][1]); w.y = pk2(st[2 * s][nb][2], st[2 * s][nb][3]); w.z = pk2(st[2 * s + 1][nb][0], st[2 * s + 1][nb][1]); w.w = pk2(st[2 * s + 1][nb][2], st[2 * s + 1][nb][3]); pa[nb] = __builtin_bit_cast(bf16x8, w); }
#pragma unroll
        for (int dvb = 0; dvb < 4; ++dvb) { const u32x2 v0 = *(const u32x2*)(VT + (size_t)(16 * dvb + fr) * SEQ + 32 * s + 4 * fq), v1 = *(const u32x2*)(VT + (size_t)(16 * dvb + fr) * SEQ + 32 * s + 16 + 4 * fq);
            const bf16x8 vf = __builtin_bit_cast(bf16x8, (u32x4){v0.x, v0.y, v1.x, v1.y});
#pragma unroll
            for (int nb = 0; nb < 4; ++nb) o[nb][dvb] = __builtin_amdgcn_mfma_f32_16x16x32_bf16(pa[nb], vf, o[nb][dvb], 0, 0, 0); }
    }
    const float* gn = a.in[13] + (size_t)l * 256 + hh * 64; float gnw[4];
#pragma unroll
    for (int dvb = 0; dvb < 4; ++dvb) gnw[dvb] = gn[16 * dvb + fr];
    bf16* Y = (bf16*)(ws + WS_GATE) + t0 * 1024 + 768 + hh * 64;
#pragma unroll
    for (int nb = 0; nb < 4; ++nb)
#pragma unroll
        for (int r = 0; r < 4; ++r) { float s = (o[nb][0][r] + o[nb][1][r]) + (o[nb][2][r] + o[nb][3][r]);
            s += __shfl_xor(s, 1); s += __shfl_xor(s, 2); s += __shfl_xor(s, 4); s += __shfl_xor(s, 8);
            const float mu = s * (1.f / 64.f); float q = 0.f;
#pragma unroll
            for (int dvb = 0; dvb < 4; ++dvb) { const float d = o[nb][dvb][r] - mu; q += d * d; }
            q += __shfl_xor(q, 1); q += __shfl_xor(q, 2); q += __shfl_xor(q, 4); q += __shfl_xor(q, 8);
            const float rstd = rsqrtf(q * (1.f / 64.f) + EPS); bf16* yp = Y + (size_t)(16 * nb + 4 * fq + r) * 1024 + fr;
#pragma unroll
            for (int dvb = 0; dvb < 4; ++dvb) { const float gt = bf2f(yp[16 * dvb]); if (!dry) yp[16 * dvb] = f2bf((o[nb][dvb][r] - mu) * rstd * gnw[dvb] * gt); } }
}

#define XB_TMO      128
#define XB_XCNT(j)  (256  + 64 * (j))
#define XB_XSUB(j)  (1280 + 64 * (j))
#define XB_XGEN(j)  (2304 + 64 * (j))
#define XB_TOP      3328
#define XB_TOPGEN   3392
#define XCD_BAR_WORDS 3456
#define XB_SPIN_CAP (1u << 18)

__device__ __forceinline__ unsigned xb_ld(unsigned* p)              { return __hip_atomic_load(p, __ATOMIC_RELAXED, __HIP_MEMORY_SCOPE_AGENT); }
__device__ __forceinline__ unsigned xb_add(unsigned* p, unsigned v) { return __hip_atomic_fetch_add(p, v, __ATOMIC_RELAXED, __HIP_MEMORY_SCOPE_AGENT); }
__device__ __forceinline__ unsigned xb_xcc_id() { return (unsigned)__builtin_amdgcn_s_getreg((3 << 11) | 20) & 0xFu; }
#define XB_SPIN(cond, bar) do { unsigned _sp = 0; while (cond) { __builtin_amdgcn_s_sleep(1); \
    if ((++_sp & 255u) == 0u) { if (xb_ld(&(bar)[XB_TMO])) break; if (_sp > XB_SPIN_CAP) { atomicAdd(&(bar)[XB_TMO], 1u); break; } } } } while (0)

struct XcdBarrier {
    unsigned* bar; unsigned x;
    volatile LAS unsigned* st;
};

__device__ __forceinline__ XcdBarrier xcd_barrier_post(unsigned* bar, volatile LAS unsigned* st) {
    XcdBarrier b; b.bar = bar; b.x = xb_xcc_id(); b.st = st;
    if (threadIdx.x == 0) (void)xb_add(&bar[XB_XCNT(b.x)], 1u);
    return b;
}
__device__ __forceinline__ void xcd_barrier_complete(unsigned* bar, unsigned x, unsigned& nloc, unsigned& nx) {
    const unsigned G = gridDim.x * gridDim.y * gridDim.z;
    unsigned sum, cnt, mine, sp = 0u;
    for (;;) {
        sum = 0u; cnt = 0u; mine = 0u;
#pragma unroll
        for (unsigned j = 0; j < 16; ++j) { const unsigned c = xb_ld(&bar[XB_XCNT(j)]); sum += c; cnt += (c > 0u) ? 1u : 0u; mine = (j == x) ? c : mine; }
        if (sum == G) break;
        __builtin_amdgcn_s_sleep(1);
        if ((++sp & 255u) == 0u) { if (xb_ld(&bar[XB_TMO])) break; if (sp > XB_SPIN_CAP) { atomicAdd(&bar[XB_TMO], 1u); break; } }
    }
    nloc = mine > 0u ? mine : 1u; nx = cnt > 0u ? cnt : 1u;
}

__device__ __forceinline__ void xcd_barrier(const XcdBarrier& b) {
    asm volatile("s_waitcnt vmcnt(0)" ::: "memory");
    __syncthreads();
    if (threadIdx.x == 0) {
        unsigned* bar = b.bar;
        __builtin_amdgcn_s_waitcnt(0);
        unsigned nloc = b.st[0], nx = b.st[1];
        if (nloc == 0u) { xcd_barrier_complete(bar, b.x, nloc, nx); b.st[0] = nloc; b.st[1] = nx; }
        const unsigned old = xb_add(&bar[XB_XSUB(b.x)], 1u);
        const unsigned gen = old / nloc;
        if (old + 1u == (gen + 1u) * nloc) {
            __builtin_amdgcn_fence(__ATOMIC_RELEASE, "agent");
            asm volatile("s_waitcnt vmcnt(0)" ::: "memory");
            const unsigned og = xb_add(&bar[XB_TOP], 1u);
            const unsigned tg = og / nx;
            if (og + 1u == (tg + 1u) * nx) xb_add(&bar[XB_TOPGEN], 1u);
            else XB_SPIN(xb_ld(&bar[XB_TOPGEN]) == tg, bar);
            __builtin_amdgcn_fence(__ATOMIC_ACQUIRE, "agent");
            xb_add(&bar[XB_XGEN(b.x)], 1u);
            asm volatile("s_waitcnt vmcnt(0)" ::: "memory");
        } else {
            XB_SPIN(xb_ld(&bar[XB_XGEN(b.x)]) == gen, bar);
            __builtin_amdgcn_fence(__ATOMIC_ACQUIRE, "agent");
            asm volatile("s_waitcnt vmcnt(0)" ::: "memory");
        }
    }
    __syncthreads();
}

#ifdef REP_SYNC
#define GSYNC() do { xcd_barrier(xbar); xcd_barrier(xbar); } while (0)
#else
#define GSYNC() xcd_barrier(xbar)
#endif
#ifndef REP_P0
#define REP_P0 1
#endif
#ifndef REP_P1
#define REP_P1 1
#endif
#ifndef REP_P23
#define REP_P23 1
#endif
#ifndef REP_NORM
#define REP_NORM 1
#endif
__global__ void __launch_bounds__(NTHR, 2) mega_fwd(Args args) {
    extern __shared__ __attribute__((aligned(16))) unsigned char lds[];
    cg::grid_group grid = cg::this_grid();
    const int tid = threadIdx.x, lane = tid & 63, wave = __builtin_amdgcn_readfirstlane(tid >> 6);
    const int G = gridDim.x, bx = blockIdx.x; const int vcu = (G % 8 == 0) ? (bx % 8) * (G / 8) + bx / 8 : bx;
    const int gw = bx * NWAVES + wave, NGW = G * NWAVES;
    unsigned char* ws = args.ws;
    LAS unsigned char* ldsl = (LAS unsigned char*)lds;
    LAS float* ldsf = (LAS float*)lds;
    float* X = args.out;
    if (bx == 0) { for (int i = tid; i < XCD_BAR_WORDS; i += NTHR) ((unsigned*)ws)[i] = 0u; }
    if (tid < 2) ((volatile LAS unsigned*)(ldsl + RING_BYTES + 352))[tid] = 0u;
    __syncthreads();

    for (int rep_ = 0; rep_ < REP_P0; ++rep_) {
        if (rep_) { __syncthreads(); }
#ifndef SKIP_PREP
        if (bx < 64) { s5_prep(args, bx >> 4, bx & 15, ldsf, tid); }
#endif
        LAS float* scr = ldsf + wave * 4096;
        constexpr int I_IN = (DM / 64) * (NF / 32), I_O = (DM / 64) * (DM / 32), I_G = (256 / 64) * (256 / 32), I_L = I_IN + I_O + I_G;
        for (int it = gw; it < DEPTH * I_L; it += NGW) {
            const int l = it / I_L; int r = it % I_L;
            if (r < I_IN) { p0_transpose_item<true>(args.in[2] + (size_t)l * DM * NIN, DM, NIN, NF, (bf16*)(ws + WS_WIN) + (size_t)l * NF * DM, scr, r, lane); continue; } r -= I_IN;
            if (r < I_O) { p0_transpose_item<false>(args.in[14] + (size_t)l * DM * DM, DM, DM, DM, (bf16*)(ws + WS_WO) + (size_t)l * DM * DM, scr, r, lane); continue; } r -= I_O;
            p0_transpose_item<false>(args.in[12] + (size_t)l * 65536, 256, 256, 256, (bf16*)(ws + WS_WGLU) + (size_t)l * 65536, scr, r, lane);
        }
        f32x2* rope = (f32x2*)(ws + WS_ROPE);
        for (int i = bx * NTHR + tid; i < SEQ * 32; i += G * NTHR) { const int pos = i >> 5, fi = i & 31; const float freq = powf(10000.f, -(float)fi / 32.f); const float ang = (float)pos * freq; float sn, cs; sincosf(ang, &sn, &cs); rope[i] = (f32x2){cs, sn}; }
        __syncthreads();
        norm0_phase(args, lane, gw, NGW);
    }
    grid.sync();
    XcdBarrier xbar = xcd_barrier_post((unsigned*)ws, (volatile LAS unsigned*)(ldsl + RING_BYTES + 352));

#define PHASE_VARS int tid = threadIdx.x; asm volatile("" : "+v"(tid)); int bxl_ = blockIdx.x; asm volatile("" : "+s"(bxl_)); const int bx = bxl_; const int lane = tid & 63, wave = __builtin_amdgcn_readfirstlane(tid >> 6), gw = bx * NWAVES + wave; __attribute__((address_space(1))) unsigned char* wsg_ = (__attribute__((address_space(1))) unsigned char*)args.ws; asm volatile("" : "+s"(wsg_)); unsigned char* ws = (unsigned char*)wsg_; LAS unsigned char* ldsl = (LAS unsigned char*)lds; LAS float* ldsf = (LAS float*)lds; (void)lane; (void)wave; (void)gw; (void)ldsl; (void)ldsf
    for (int l = 0; l < DEPTH; ++l) {
        for (int rep_ = 0; rep_ < REP_P1; ++rep_) {
            PHASE_VARS;
            pg8::Gemm g{(const bf16*)(ws + WS_XN), (const bf16*)(ws + WS_WIN) + (size_t)l * NF * DM, M, NF, DM, DM, DM, 0, 0};
            pg8::StaticOrder S; S.init(M, NF, G, bx);
            EpiInProj E{ws, (const float*)(ws + WS_SS) + (size_t)(l & 1) * M, args.in[3] + (size_t)l * 8};
#ifndef SKIP_INPROJ
            pg8::gemm_phase<EpiInProj, pg8::StaticOrder, true, true>(ldsl, g, S, E);
#endif
        }
        GSYNC();
        for (int rep_ = 0; rep_ < REP_P23; ++rep_) {
            if (rep_) __syncthreads();
            PHASE_VARS;
            if (bx < 32) {
                pg8::Gemm g{(const bf16*)(ws + WS_SUA), (const bf16*)(ws + WS_WB) + (size_t)l * 16 * 128 * 512, NCH5, 256, 512, KA5, 512, (size_t)NCH5 * KA5, (size_t)128 * 512};
                FlatOrder S{2, 1, 16, 32, bx};
                EpiS5E E{(float*)(ws + WS_E)};
#ifndef SKIP_GE
                pg8::gemm_phase<EpiS5E, FlatOrder, true, true>(ldsl, g, S, E);
#endif
            } else if (bx < 160) {
                ret_upd_unit(ws, (bx - 32) * 8 + wave, lane);
            } else if (bx < 192) {
                const int bh = bx - 160; const float* lf = (const float*)(ws + WS_LOGF) + (size_t)bh * SEQ; float* cb = (float*)(ws + WS_CB) + (size_t)bh * SEQ;
                const f32x4 a0 = *(const f32x4*)(lf + tid * 8), a1 = *(const f32x4*)(lf + tid * 8 + 4); float v[8] = {a0.x, a0.y, a0.z, a0.w, a1.x, a1.y, a1.z, a1.w};
#pragma unroll
                for (int e = 1; e < 8; ++e) v[e] += v[e - 1];
                float tot = v[7];
#pragma unroll
                for (int o = 1; o < 64; o <<= 1) { const float t = __shfl_up(tot, o); if (lane >= o) tot += t; }
                if (lane == 63) ldsf[wave] = tot;
                __syncthreads();
                float off = tot - v[7];
                for (int w = 0; w < wave; ++w) off += ldsf[w];
                f32x4 o0, o1; o0.x = -(v[0] + off) * LOG2E; o0.y = -(v[1] + off) * LOG2E; o0.z = -(v[2] + off) * LOG2E; o0.w = -(v[3] + off) * LOG2E; o1.x = -(v[4] + off) * LOG2E; o1.y = -(v[5] + off) * LOG2E; o1.z = -(v[6] + off) * LOG2E; o1.w = -(v[7] + off) * LOG2E;
                *(f32x4*)(cb + tid * 8) = o0; *(f32x4*)(cb + tid * 8 + 4) = o1;
            } else { const int idx = (bx - 192) * NTHR + tid; if (idx < M) ((float*)(ws + WS_SS))[(size_t)((l + 1) & 1) * M + idx] = 0.f; }
        }
        GSYNC();
        for (int rep_ = 0; rep_ < REP_P23; ++rep_) {
            if (rep_) __syncthreads();
            PHASE_VARS;
            if (bx < 64) {
                const int b = bx >> 4, g = bx & 15, p = tid & 63, seg = tid >> 6;
                const float* LAM = (const float*)(ws + WS_LAM) + (size_t)(l * 16 + g) * 128; const float lr = LAM[p], li = LAM[64 + p];
                const float* E = (const float*)(ws + WS_E) + ((size_t)g * NCH5 + b * 128 + seg * 16) * 128 + p;
                bf16* SA = (bf16*)(ws + WS_SUA) + ((size_t)g * NCH5 + b * 128 + seg * 16) * KA5 + 512 + p;
                float er[16], ei[16];
#pragma unroll
                for (int i = 0; i < 16; ++i) { er[i] = E[(size_t)i * 128]; ei[i] = E[(size_t)i * 128 + 64]; }
                float sr = 0.f, si = 0.f;
#pragma unroll
                for (int i = 0; i < 16; ++i) { const float nr = lr * sr - li * si + er[i], ni = lr * si + li * sr + ei[i]; sr = nr; si = ni; }
                LAS float* ends = ldsf;
                ends[(seg * 64 + p) * 2] = sr; ends[(seg * 64 + p) * 2 + 1] = si;
                float pr = lr, pi = li;
#pragma unroll
                for (int i = 0; i < 4; ++i) { const float nr = pr * pr - pi * pi, ni = 2.f * pr * pi; pr = nr; pi = ni; }
                __syncthreads();
                float cr = 0.f, ci = 0.f;
                for (int s2 = 0; s2 < seg; ++s2) { const float xr = ends[(s2 * 64 + p) * 2], xi = ends[(s2 * 64 + p) * 2 + 1]; const float nr = pr * cr - pi * ci + xr, ni = pr * ci + pi * cr + xi; cr = nr; ci = ni; }
#pragma unroll
                for (int i = 0; i < 16; ++i) { SA[(size_t)i * KA5] = f2bf(cr); SA[(size_t)i * KA5 + 64] = f2bf(ci); const float nr = lr * cr - li * ci + er[i], ni = lr * ci + li * cr + ei[i]; cr = nr; ci = ni; }
            } else if (bx < 192) {
                const int idx = (bx - 64) * NTHR + tid, bh = idx >> 12, e = idx & 4095; const float g64 = exp2f(lg2_gamma(bh & 3) * 64.f);
                const float* U = (const float*)(ws + WS_UPD) + (size_t)bh * 64 * 4096 + e; bf16* ST = (bf16*)(ws + WS_STATE) + (size_t)bh * 64 * 4096 + e;
                float st = 0.f;
#pragma unroll 8
                for (int c = 0; c < 64; ++c) { const float u = U[(size_t)c * 4096]; ST[(size_t)c * 4096] = f2bf(st); st = g64 * st + u; }
            }
        }
        GSYNC();
        {
            PHASE_VARS;
#ifdef REP_RET
            if (wave < 4) ret_out_unit(args, l, wave * 256 + bx, lane, opaque_true());
            __syncthreads();
#endif
            if (wave < 4) ret_out_unit(args, l, wave * 256 + bx, lane);
            __syncthreads();
            if (bx < 64) {
                pg8::Gemm g{(const bf16*)(ws + WS_SUA), (const bf16*)(ws + WS_MF) + (size_t)l * 16 * 512 * KA5, NCH5, 512, KA5, KA5, KA5, (size_t)NCH5 * KA5, (size_t)512 * KA5};
                FlatOrder S{2, 2, 16, 64, bx};
                EpiS5Y E{(const bf16*)(ws + WS_SUA), (bf16*)(ws + WS_YS5), args.in[10] + (size_t)l * 256};
#ifdef REP_S5Y
                pg8::gemm_phase<EpiS5Y, FlatOrder, true, true>(ldsl, g, S, E);
#endif
                pg8::gemm_phase<EpiS5Y, FlatOrder, true, true>(ldsl, g, S, E);
            }
            const attn_body::AttnTensors AT{(const attn_body::bf16*)(ws + WS_QO), (const attn_body::bf16*)(ws + WS_KB), (const attn_body::bf16*)(ws + WS_VB), (attn_body::bf16*)(ws + WS_GATE), (const float*)(ws + WS_CB)};
            const attn_body::StaticOrder S(G, bx);
#ifdef REP_ATTN
            attn_body::attn_phase<attn_body::StaticOrder>((char*)lds, AT, S, opaque_true());
#endif
            attn_body::attn_phase<attn_body::StaticOrder>((char*)lds, AT, S);
        }
        GSYNC();
        {
            PHASE_VARS;
            if (bx < 64) {
                int Kg = 256; asm volatile("" : "+s"(Kg));
                pg8::Gemm g{(const bf16*)(ws + WS_YS5), (const bf16*)(ws + WS_WGLU) + (size_t)l * 65536, M, 256, Kg, 256, 256, 0, 0};
                FlatOrder S{64, 1, 1, 64, bx};
#ifdef REP_GLU
                { EpiGlu E0{(const bf16*)(ws + WS_YS5), (bf16*)(ws + WS_GATE), opaque_true()}; pg8::gemm_phase<EpiGlu, FlatOrder, true, true>(ldsl, g, S, E0); }
#endif
                EpiGlu E{(const bf16*)(ws + WS_YS5), (bf16*)(ws + WS_GATE), false};
                pg8::gemm_phase<EpiGlu, FlatOrder, true, true>(ldsl, g, S, E);
            }
        }
        GSYNC();
        {
            PHASE_VARS;
            pg8::Gemm g{(const bf16*)(ws + WS_GATE), (const bf16*)(ws + WS_WO) + (size_t)l * DM * DM, M, DM, DM, DM, DM, 0, 0};
            pg8::StaticOrder S; S.init(M, DM, G, bx);
#ifdef REP_P6
            { EpiOut E0{l == 0 ? args.in[0] : X, X, (float*)(ws + WS_SS) + (size_t)((l + 1) & 1) * M, (bf16*)(ws + WS_XN), (l + 1 < DEPTH) ? args.in[1] + (size_t)(l + 1) * DM : nullptr, opaque_true()}; pg8::gemm_phase<EpiOut, pg8::StaticOrder, true, true>(ldsl, g, S, E0); }
#endif
            EpiOut E{l == 0 ? args.in[0] : X, X, (float*)(ws + WS_SS) + (size_t)((l + 1) & 1) * M, (bf16*)(ws + WS_XN), (l + 1 < DEPTH) ? args.in[1] + (size_t)(l + 1) * DM : nullptr, false};
            pg8::gemm_phase<EpiOut, pg8::StaticOrder, true, true>(ldsl, g, S, E);
        }
        GSYNC();
        if (l + 1 == DEPTH) { PHASE_VARS; final_norm(args, X, (const float*)(ws + WS_SS) + (size_t)((l + 1) & 1) * M, lane, gw, NGW); }
    }
}

extern "C" void kernel_launch(void* const* d_in, const int* in_sizes, int n_in, void* d_out, int out_size, void* d_ws, size_t ws_size, hipStream_t stream) {
    static int grid = 0;
    if (grid == 0) {
        if (n_in != 16 || ws_size < WS_END) { fprintf(stderr, "kernel_launch: unexpected n_in %d / ws %zu\n", n_in, ws_size); grid = -1; return; }
        int dev = 0, cus = 0, per_cu = 0;
        hipGetDevice(&dev); hipDeviceGetAttribute(&cus, hipDeviceAttributeMultiprocessorCount, dev);
        if (hipFuncSetAttribute((const void*)mega_fwd, hipFuncAttributeMaxDynamicSharedMemorySize, LDS_BYTES) != hipSuccess) { fprintf(stderr, "kernel_launch: hipFuncSetAttribute failed\n"); grid = -1; return; }
        if (hipOccupancyMaxActiveBlocksPerMultiprocessor(&per_cu, (const void*)mega_fwd, NTHR, LDS_BYTES) != hipSuccess || per_cu < 1) { fprintf(stderr, "kernel_launch: occupancy query failed (%d)\n", per_cu); grid = -1; return; }
        grid = cus;
        if (grid != 256) fprintf(stderr, "kernel_launch: note: %d CUs\n", grid);
    }
    if (grid < 0) return;
    Args a{};
    for (int i = 0; i < 16; ++i) a.in[i] = (const float*)d_in[i];
    a.out = (float*)d_out; a.ws = (unsigned char*)d_ws;
    void* kargs[] = {&a};
    hipError_t e = hipLaunchCooperativeKernel((const void*)mega_fwd, dim3(grid), dim3(NTHR), kargs, LDS_BYTES, stream);
    if (e != hipSuccess) fprintf(stderr, "kernel_launch: cooperative launch failed: %s\n", hipGetErrorString(e));
}
```

```cpp
#include <hip/hip_runtime.h>
#include <cstdio>
#include <cstdint>
namespace pg8 {
#define PG8_LAS __attribute__((address_space(3)))
typedef unsigned short bf16_t;
typedef short bf16x8 __attribute__((ext_vector_type(8)));
typedef float f32x4 __attribute__((ext_vector_type(4)));
typedef unsigned u32x4 __attribute__((ext_vector_type(4)));
constexpr int BM = 256, BK = 64, HALF = 128, HTB = HALF * BK * 2  , STAGE_BYTES = 8 * HTB, NXCD = 8, WGM = 8;

__host__ __device__ __forceinline__ int lds_byte(int r, int c) { const int st = (r >> 4) * 2 + (c >> 5), rr = r & 15, cc = c & 31, ob = rr * 64 + cc * 2; return st * 1024 + (ob ^ (((ob >> 9) & 1) << 5)); }
__host__ __device__ __forceinline__ void stage_rc(int b, int& R, int& C) { const int st = b / 1024, sb = b % 1024, swz = sb ^ (((sb >> 9) & 1) << 5); R = (st >> 1) * 16 + swz / 64; C = (st & 1) * 32 + (swz % 64) / 2; }
__host__ __device__ __forceinline__ int perm32(int rho) { const int n = rho >> 4, i = rho & 15; return 8 * (i >> 2) + 4 * n + (i & 3); }

struct Unit { int pm, pn, gz; };
struct Gemm { const bf16_t* A; const bf16_t* Bt; int M, N, K; int lda, ldb; size_t gsA, gsB; };

struct StaticOrder {
    int nM, nN, nwg, G, c;
    __host__ __device__ void init(int M, int N, int G_, int c_) { nM = M / BM; nN = N / BM; nwg = nM * nN; G = G_; c = c_; }
    __host__ __device__ bool next(int i, Unit& u) const {
        const long L = (long)i * G + c; if (L >= nwg) return false;
        int wgid = (int)L; { const int q = nwg / NXCD, r = nwg % NXCD, xcd = wgid % NXCD, off = wgid / NXCD; wgid = (xcd < r ? xcd * (q + 1) : r * (q + 1) + (xcd - r) * q) + off; }
        const int nig = WGM * nN, gid = wgid / nig, fm = gid * WGM, gsz = (nM - fm) < WGM ? (nM - fm) : WGM;
        u.pm = fm + ((wgid % nig) % gsz); u.pn = (wgid % nig) / gsz; u.gz = 0; return true;
    }
    __device__ __forceinline__ void a_ready(const Unit&) const {}
    __device__ __forceinline__ void done(const Unit&) const {}
};

__device__ __forceinline__ unsigned cvt_pk_bf16(float lo, float hi) { unsigned r; asm volatile("v_cvt_pk_bf16_f32 %0, %1, %2" : "=v"(r) : "v"(lo), "v"(hi)); return r; }
typedef float f32x2 __attribute__((ext_vector_type(2)));
__device__ __forceinline__ f32x2 gelu_pk(f32x2 v) {
    const f32x2 av = __builtin_elementwise_abs(v), d = av * 0.2316418882f + 1.0f;
    f32x2 t; t.x = __builtin_amdgcn_rcpf(d.x); t.y = __builtin_amdgcn_rcpf(d.y);
    f32x2 q = t * 0.5307027145f + (-0.7265760135f); q = q * t + 0.7107068705f; q = q * t + (-0.142248368f); q = q * t + 0.127414796f; q = q * t;
    const f32x2 s = (v * v) * (-0.72134752044f);
    f32x2 e; e.x = __builtin_amdgcn_exp2f(s.x); e.y = __builtin_amdgcn_exp2f(s.y);
    const f32x2 m = v * (q * e), r = v - m;
    f32x2 o; o.x = v.x < 0.f ? m.x : r.x; o.y = v.y < 0.f ? m.y : r.y; return o;
}

template <class Epi, class Sched, bool ALIGN_EPI = false, bool SP2 = false>
__device__ __forceinline__ void gemm_phase(PG8_LAS unsigned char* lds, const Gemm g, const Sched& S, const Epi& E) {
    int tid_ = threadIdx.x; asm volatile("" : "+v"(tid_));
    const int tid = tid_, wid = __builtin_amdgcn_readfirstlane(tid >> 6), lane = tid & 63, wr = wid >> 2, wc = wid & 3, fr = lane & 15, fq = lane >> 4;
    const int K = g.K, nt = K / BK;
    unsigned voffA[2], voffB[2];
#pragma unroll
    for (int i = 0; i < 2; ++i) { int R, C; stage_rc(tid * 16 + i * 8192, R, C); const int Rb = Epi::PERM ? ((R & ~31) + perm32(R & 31)) : R;
        voffA[i] = (unsigned)(R * g.lda + C) * 2u; voffB[i] = (unsigned)(Rb * g.ldb + C) * 2u; }
    const size_t kstep = (size_t)(BK * 2);
    const size_t hstepA = (size_t)HALF * g.lda * 2, hstepB = (size_t)HALF * g.ldb * 2;
    const size_t tstepA = 2 * hstepA, tstepB = 2 * hstepB;
    const unsigned ldsw = (unsigned)wid * 1024u;
    const int aoff = lds_byte(wr * 64 + fr, fq * 8), boff = lds_byte(wc * 32 + fr, fq * 8);
#define PG8_SA(b, h) (((b) * 2 + (h)) * HTB)
#define PG8_SB(b, h) ((4 + (b) * 2 + (h)) * HTB)
#define PG8_STAGE(bufoff, gbase, voff) do { _Pragma("unroll") for (int _i = 0; _i < 2; ++_i) \
        __builtin_amdgcn_global_load_lds((const unsigned*)((const char*)(gbase) + (voff)[_i]), (PG8_LAS unsigned*)(lds + (bufoff) + ldsw + _i * 8192), 16, 0, 0); } while (0)
#define PG8_LDA(dst, b, h) do { _Pragma("unroll") for (int m = 0; m < 4; ++m) _Pragma("unroll") for (int k = 0; k < 2; ++k) dst[m][k] = *(const PG8_LAS bf16x8*)(lds + PG8_SA(b, h) + aoff + m * 2048 + k * 1024); } while (0)
#define PG8_LDB(dst, b, h) do { _Pragma("unroll") for (int n = 0; n < 2; ++n) _Pragma("unroll") for (int k = 0; k < 2; ++k) dst[n][k] = *(const PG8_LAS bf16x8*)(lds + PG8_SB(b, h) + boff + n * 2048 + k * 1024); } while (0)
#define PG8_MMA(ai, bj, At, Bt) do { __builtin_amdgcn_s_setprio(1); _Pragma("unroll") for (int m = 0; m < 4; ++m) _Pragma("unroll") for (int n = 0; n < 2; ++n) _Pragma("unroll") for (int k = 0; k < 2; ++k) \
        acc[ai][bj][m][n] = __builtin_amdgcn_mfma_f32_16x16x32_bf16(Bt[n][k], At[m][k], acc[ai][bj][m][n], 0, 0, 0); __builtin_amdgcn_s_setprio(0); } while (0)
#define PG8_WAIT_V(n) asm volatile("s_waitcnt vmcnt(" #n ")" ::: "memory")
#define PG8_WAIT_L(n) asm volatile("s_waitcnt lgkmcnt(" #n ")" ::: "memory")
#define PG8_BAR __builtin_amdgcn_s_barrier()
#define PG8_SCHED __builtin_amdgcn_sched_barrier(0)
    Unit cur, nxt; int ui = 0;
    if (!S.next(0, cur)) return;
    f32x4 acc[2][2][4][2];
#pragma unroll
    for (int a = 0; a < 2; ++a)
#pragma unroll
        for (int b = 0; b < 2; ++b)
#pragma unroll
            for (int m = 0; m < 4; ++m)
#pragma unroll
                for (int n = 0; n < 2; ++n) acc[a][b][m][n] = (f32x4){0.f, 0.f, 0.f, 0.f};
    bf16x8 At[4][2], B0[2][2], B1[2][2];
    const char* cA = (const char*)g.A + (size_t)cur.gz * g.gsA * 2 + (size_t)cur.pm * tstepA; const char* cB = (const char*)g.Bt + (size_t)cur.gz * g.gsB * 2 + (size_t)cur.pn * tstepB;
    S.a_ready(cur);
    if constexpr (SP2) {
        PG8_STAGE(PG8_SB(0, 0), cB, voffB); PG8_STAGE(PG8_SB(0, 1), cB + hstepB, voffB); PG8_STAGE(PG8_SA(0, 0), cA, voffA); PG8_STAGE(PG8_SA(0, 1), cA + hstepA, voffA);
        if (wr == 1) PG8_BAR;
        PG8_WAIT_V(2); PG8_BAR;
        PG8_STAGE(PG8_SB(1, 0), cB + kstep, voffB); PG8_STAGE(PG8_SA(1, 0), cA + kstep, voffA); PG8_STAGE(PG8_SB(1, 1), cB + hstepB + kstep, voffB);
        PG8_WAIT_V(6); PG8_BAR;
    } else {
        PG8_STAGE(PG8_SB(0, 0), cB, voffB); PG8_STAGE(PG8_SA(0, 0), cA, voffA); PG8_STAGE(PG8_SB(0, 1), cB + hstepB, voffB); PG8_STAGE(PG8_SA(0, 1), cA + hstepA, voffA);
        if (wr == 1) PG8_BAR;
        PG8_WAIT_V(4); PG8_BAR;
        PG8_STAGE(PG8_SB(1, 0), cB + kstep, voffB); PG8_STAGE(PG8_SA(1, 0), cA + kstep, voffA); PG8_STAGE(PG8_SB(1, 1), cB + hstepB + kstep, voffB);
        PG8_WAIT_V(6); PG8_BAR;
    }
    for (;;) {
        const bool has_next = S.next(ui + 1, nxt);
        const char* nA = has_next ? (const char*)g.A + (size_t)nxt.gz * g.gsA * 2 + (size_t)nxt.pm * tstepA : cA; const char* nB = has_next ? (const char*)g.Bt + (size_t)nxt.gz * g.gsB * 2 + (size_t)nxt.pn * tstepB : cB;
        for (int t = 0; t < nt; t += 2) {
            const bool last = (t == nt - 2);
            const char* a1 = cA + (size_t)(t + 1) * kstep;
            const char* a2 = last ? nA : cA + (size_t)(t + 2) * kstep; const char* b2 = last ? nB : cB + (size_t)(t + 2) * kstep;
            const char* a3 = a2 + kstep; const char* b3 = b2 + kstep;
            if (last && has_next) S.a_ready(nxt);
            if constexpr (SP2) {
            PG8_LDB(B0, 0, 0); PG8_LDB(B1, 0, 1); PG8_SCHED; PG8_LDA(At, 0, 0); PG8_STAGE(PG8_SA(1, 1), a1 + hstepA, voffA);
            PG8_WAIT_V(8); PG8_WAIT_L(0); PG8_BAR; PG8_MMA(0, 0, At, B0); PG8_MMA(0, 1, At, B1); PG8_BAR; PG8_SCHED;
            PG8_LDA(At, 0, 1); PG8_STAGE(PG8_SB(0, 0), b2, voffB); PG8_STAGE(PG8_SB(0, 1), b2 + hstepB, voffB); PG8_STAGE(PG8_SA(0, 0), a2, voffA);
            PG8_WAIT_V(8); PG8_WAIT_L(0); PG8_BAR; PG8_MMA(1, 0, At, B0); PG8_MMA(1, 1, At, B1); PG8_BAR; PG8_SCHED;
            PG8_LDB(B0, 1, 0); PG8_LDB(B1, 1, 1); PG8_SCHED; PG8_LDA(At, 1, 0); PG8_STAGE(PG8_SA(0, 1), a2 + hstepA, voffA);
            PG8_WAIT_V(8); PG8_WAIT_L(0); PG8_BAR; PG8_MMA(0, 0, At, B0); PG8_MMA(0, 1, At, B1); PG8_BAR; PG8_SCHED;
            PG8_LDA(At, 1, 1); PG8_STAGE(PG8_SB(1, 0), b3, voffB); PG8_STAGE(PG8_SB(1, 1), b3 + hstepB, voffB); PG8_STAGE(PG8_SA(1, 0), a3, voffA);
            PG8_WAIT_V(8); PG8_WAIT_L(0); PG8_BAR; PG8_MMA(1, 0, At, B0); PG8_MMA(1, 1, At, B1); PG8_BAR; PG8_SCHED;
            } else {
            PG8_LDB(B0, 0, 0); PG8_SCHED; PG8_LDA(At, 0, 0); PG8_STAGE(PG8_SA(1, 1), a1 + hstepA, voffA);
            PG8_WAIT_L(8); PG8_BAR; PG8_WAIT_L(0); PG8_MMA(0, 0, At, B0); PG8_BAR; PG8_SCHED;
            PG8_LDB(B1, 0, 1); PG8_STAGE(PG8_SB(0, 0), b2, voffB);
            PG8_BAR; PG8_WAIT_L(0); PG8_MMA(0, 1, At, B1); PG8_BAR;
            PG8_LDA(At, 0, 1); PG8_STAGE(PG8_SA(0, 0), a2, voffA);
            PG8_BAR; PG8_WAIT_L(0); PG8_MMA(1, 0, At, B0); PG8_BAR; PG8_SCHED;
            PG8_STAGE(PG8_SB(0, 1), b2 + hstepB, voffB);
            PG8_WAIT_V(6); PG8_BAR; PG8_MMA(1, 1, At, B1); PG8_BAR;
            PG8_LDB(B0, 1, 0); PG8_SCHED; PG8_LDA(At, 1, 0); PG8_STAGE(PG8_SA(0, 1), a2 + hstepA, voffA);
            PG8_WAIT_L(8); PG8_BAR; PG8_WAIT_L(0); PG8_MMA(0, 0, At, B0); PG8_BAR; PG8_SCHED;
            PG8_LDB(B1, 1, 1); PG8_STAGE(PG8_SB(1, 0), b3, voffB);
            PG8_BAR; PG8_WAIT_L(0); PG8_MMA(0, 1, At, B1); PG8_BAR;
            PG8_LDA(At, 1, 1); PG8_STAGE(PG8_SA(1, 0), a3, voffA);
            PG8_BAR; PG8_WAIT_L(0); PG8_MMA(1, 0, At, B0); PG8_BAR; PG8_SCHED;
            PG8_STAGE(PG8_SB(1, 1), b3 + hstepB, voffB);
            PG8_WAIT_V(6); PG8_BAR; PG8_MMA(1, 1, At, B1); PG8_BAR;
            }
        }
        if constexpr (ALIGN_EPI) { if (wr == 0) PG8_BAR; }
        if constexpr (!Epi::AFTER_DRAIN) { E(acc, cur, wr, wc, fr, fq); S.done(cur); }
        if (!has_next) break;
#pragma unroll
        for (int a = 0; a < 2; ++a)
#pragma unroll
            for (int b = 0; b < 2; ++b)
#pragma unroll
                for (int m = 0; m < 4; ++m)
#pragma unroll
                    for (int n = 0; n < 2; ++n) acc[a][b][m][n] = (f32x4){0.f, 0.f, 0.f, 0.f};
        cur = nxt; cA = nA; cB = nB; ++ui;
        if constexpr (ALIGN_EPI) { if (wr == 1) PG8_BAR; }
    }
    PG8_WAIT_V(0);
    if constexpr (!ALIGN_EPI) { if (wr == 0) PG8_BAR; }
    PG8_BAR;
    if constexpr (Epi::AFTER_DRAIN) { E.fused(acc, cur, wr, wc, fr, fq, lds, wid, lane); S.done(cur); }
#undef PG8_SA
#undef PG8_SB
#undef PG8_STAGE
#undef PG8_LDA
#undef PG8_LDB
#undef PG8_MMA
#undef PG8_WAIT_V
#undef PG8_WAIT_L
#undef PG8_BAR
#undef PG8_SCHED
}
}
#include <hip/hip_bf16.h>
#include <cmath>
namespace attn_body {
using bf16=__hip_bfloat16;
using bf16x8=__attribute__((ext_vector_type(8)))short;
using s16x4=__attribute__((ext_vector_type(4)))short;
using f32x16=__attribute__((ext_vector_type(16)))float;
using u32x4=__attribute__((ext_vector_type(4)))unsigned;
using f32x4=__attribute__((ext_vector_type(4)))float;
constexpr int BATCH=4,NHEAD=8,SEQ=4096,D=64,DM=NHEAD*D,OPITCH=1024;
constexpr int NW=8,QBLK=32,QB=QBLK*NW,KVBLK=64,NQB=SEQ/QB;
constexpr int ATTN_PITCH=DM, ATTN_UNIT_ROWS=QB;
__device__ __forceinline__ int crow(int r,int hi){return (r&3)+8*(r>>2)+4*hi;}
#define SBAR() __builtin_amdgcn_sched_barrier(0)
__device__ __forceinline__ void cmask(f32x16&p0,f32x16&p1,int jb,int qrel,int hi){
  const float NEG=-INFINITY; int kb=64*jb+4*hi;
  #pragma unroll
  for(int r=0;r<16;++r){int kv=kb+(r&3)+8*(r>>2); if(kv>qrel)p0[r]=NEG; if(kv+32>qrel)p1[r]=NEG;}
}

constexpr int NSLOT=3, SLOTB=8192;
constexpr int LDS_K=0, LDS_V=NSLOT*SLOTB, LDS_WS=2*NSLOT*SLOTB, LDS_OST=LDS_WS+NW*64*4, LDS_CB=LDS_OST+NW*4096, LDS_BYTES=LDS_CB+SEQ*4;
constexpr float C2=0.125f*1.4426950408889634f;
__device__ __forceinline__ void glds16(const void*gsrc,unsigned lds_dst){unsigned keep;
  asm volatile("s_mov_b32 %0, m0\n\ts_mov_b32 m0, %2\n\ts_nop 0\n\tglobal_load_lds_dwordx4 %1, off\n\ts_mov_b32 m0, %0":"=&s"(keep):"v"(gsrc),"s"(lds_dst):"memory");}
__device__ __forceinline__ float max3f(float a,float b,float c){float r;asm("v_max3_f32 %0, %1, %2, %3":"=v"(r):"v"(a),"v"(b),"v"(c));return r;}
__device__ __forceinline__ float max2f(float a,float b){float r;asm("v_max_f32_e32 %0, %1, %2":"=v"(r):"v"(a),"v"(b));return r;}
__device__ __forceinline__ float fadd_s(float a,float b){float r;asm("v_add_f32_e32 %0, %1, %2":"=v"(r):"v"(a),"v"(b));return r;}
__device__ __forceinline__ float fsub_s(float a,float b){float r;asm("v_sub_f32_e32 %0, %1, %2":"=v"(r):"v"(a),"v"(b));return r;}
typedef float f32x2_t __attribute__((ext_vector_type(2))); typedef __bf16 bf16x2_t __attribute__((ext_vector_type(2)));
__device__ __forceinline__ unsigned cvtpk_s(float lo,float hi){f32x2_t v={lo,hi};bf16x2_t b=__builtin_convertvector(v,bf16x2_t);return __builtin_bit_cast(unsigned,b);}
#define WAIT_BAR(N) asm volatile("s_waitcnt vmcnt(" #N ") lgkmcnt(0)\n\ts_barrier":::"memory")

__device__ __forceinline__ void qkt(f32x16&p0,f32x16&p1,const char*Kslot,const bf16x8*qr,const char*cbt,int r32,int hi){
  const char*kb=Kslot+hi*1024+r32*16;
  #pragma unroll
  for(int a=0;a<4;++a){ const f32x4 u0=*reinterpret_cast<const f32x4*>(cbt+hi*16+a*32), u1=*reinterpret_cast<const f32x4*>(cbt+128+hi*16+a*32);
    p0[4*a]=u0[0];p0[4*a+1]=u0[1];p0[4*a+2]=u0[2];p0[4*a+3]=u0[3]; p1[4*a]=u1[0];p1[4*a+1]=u1[1];p1[4*a+2]=u1[2];p1[4*a+3]=u1[3]; }
  #pragma unroll
  for(int d0=0;d0<4;++d0){
    const bf16x8 b0=*reinterpret_cast<const bf16x8*>(kb+d0*2048);
    const bf16x8 b1=*reinterpret_cast<const bf16x8*>(kb+d0*2048+512);
    p0=__builtin_amdgcn_mfma_f32_32x32x16_bf16(b0,qr[d0],p0,0,0,0);p1=__builtin_amdgcn_mfma_f32_32x32x16_bf16(b1,qr[d0],p1,0,0,0);}
}
typedef __attribute__((address_space(3))) const char* lds_cptr;
typedef short v4i16_t __attribute__((ext_vector_type(4)));
__device__ __forceinline__ void kload8(bf16x8*kf,lds_cptr kp){
  kf[0]=*(const __attribute__((address_space(3))) bf16x8*)(kp);      kf[1]=*(const __attribute__((address_space(3))) bf16x8*)(kp+512);
  kf[2]=*(const __attribute__((address_space(3))) bf16x8*)(kp+2048); kf[3]=*(const __attribute__((address_space(3))) bf16x8*)(kp+2560);
  kf[4]=*(const __attribute__((address_space(3))) bf16x8*)(kp+4096); kf[5]=*(const __attribute__((address_space(3))) bf16x8*)(kp+4608);
  kf[6]=*(const __attribute__((address_space(3))) bf16x8*)(kp+6144); kf[7]=*(const __attribute__((address_space(3))) bf16x8*)(kp+6656);
}
__device__ __forceinline__ void kload2(bf16x8*kf,lds_cptr kp,int j){ kf[2*j]=*(const __attribute__((address_space(3))) bf16x8*)(kp+j*2048); kf[2*j+1]=*(const __attribute__((address_space(3))) bf16x8*)(kp+j*2048+512); }
__device__ __forceinline__ s16x4 vtr(lds_cptr p){ return __builtin_bit_cast(s16x4,__builtin_amdgcn_ds_read_tr16_b64_v4i16((__attribute__((address_space(3))) v4i16_t*)p)); }
__device__ __forceinline__ float rowmax(const f32x16&p0,const f32x16&p1){
  float a=max3f(p0[0],p0[1],p1[0]),b=max3f(p0[2],p0[3],p1[1]);a=max3f(a,p1[2],p1[3]);
  #pragma unroll
  for(int r=4;r<16;r+=4){a=max3f(a,p0[r],p0[r+1]);b=max3f(b,p0[r+2],p0[r+3]);a=max3f(a,p1[r],p1[r+1]);b=max3f(b,p1[r+2],p1[r+3]);}
  const float m=max2f(a,b);
  auto rr=__builtin_amdgcn_permlane32_swap(__float_as_uint(m),__float_as_uint(m),false,false);
  return max2f(__uint_as_float(rr[0]),__uint_as_float(rr[1]));
}
__device__ __forceinline__ void pv(f32x16*o,int vb,bf16x8 pa0,bf16x8 pa1,bf16x8 pa2,bf16x8 pa3){
  #pragma unroll
  for(int d0=0;d0<2;++d0){s16x4 lo[4],hi[4];
    #pragma unroll
    for(int ks=0;ks<4;++ks){
      asm volatile("ds_read_b64_tr_b16 %0,%1 offset:%c2":"=&v"(lo[ks]):"v"(vb),"i"(d0*4096+ks*1024):"memory");
      asm volatile("ds_read_b64_tr_b16 %0,%1 offset:%c2":"=&v"(hi[ks]):"v"(vb),"i"(d0*4096+ks*1024+512):"memory");}
    asm volatile("s_waitcnt lgkmcnt(0)":::"memory");SBAR();
    #define PK(k) (bf16x8){lo[k][0],lo[k][1],lo[k][2],lo[k][3],hi[k][0],hi[k][1],hi[k][2],hi[k][3]}
    o[d0]=__builtin_amdgcn_mfma_f32_32x32x16_bf16(pa0,PK(0),o[d0],0,0,0);
    o[d0]=__builtin_amdgcn_mfma_f32_32x32x16_bf16(pa1,PK(1),o[d0],0,0,0);
    o[d0]=__builtin_amdgcn_mfma_f32_32x32x16_bf16(pa2,PK(2),o[d0],0,0,0);
    o[d0]=__builtin_amdgcn_mfma_f32_32x32x16_bf16(pa3,PK(3),o[d0],0,0,0);
    #undef PK
  }
}

#ifndef ATTN_STORE16
#define ATTN_STORE16(p,v) (*(u32x4*)(p)=(v))
#endif
template<int THRL> __device__ __forceinline__ void attn_unit(int b,int h,int qb,const bf16*Q,const bf16*__restrict__ K,const bf16*__restrict__ V,bf16*O,const float*__restrict__ CB,char*shm,bool dry=false){
  int tid_=threadIdx.x; asm volatile("":"+v"(tid_)); const int tid=tid_,lane=tid&63,r32=lane&31,hi=lane>>5; const int wid=__builtin_amdgcn_readfirstlane(tid>>6);
  const long rowbase=(long)b*SEQ; const int q0=qb*QB;
  const bf16*Qw=Q+(rowbase+q0+wid*QBLK)*DM+h*D;
  const bf16*Kh=K+rowbase*DM+h*D,*Vh=V+rowbase*DM+h*D;
  const unsigned lds0=(unsigned)(uintptr_t)shm;
  float*wsf=(float*)(shm+LDS_WS)+wid*64;
  const bf16*ksrc=Kh+(long)lane*DM+wid*8;
  const bf16*vsrc=Vh+(long)(16*(wid&3)+(lane>>2))*DM+(wid>>2)*32+(lane&3)*8;
  const unsigned kdst=lds0+LDS_K+wid*1024, vdst=lds0+LDS_V+wid*1024;
  #define DMA_K(t,slot) glds16(ksrc+(long)(t)*KVBLK*DM,(unsigned)__builtin_amdgcn_readfirstlane(kdst+(slot)))
  #define DMA_V(t,slot) glds16(vsrc+(long)(t)*KVBLK*DM,(unsigned)__builtin_amdgcn_readfirstlane(vdst+(slot)))
  const int vb0=(int)(lds0+LDS_V)+((lane>>4)&1)*32+(lane&3)*8+(4*hi+((lane&15)>>2))*64;
  const char*Kbase=shm+LDS_K; bf16x8 kf[8];
  const lds_cptr shm3=(lds_cptr)shm; const lds_cptr kp0=shm3+LDS_K+hi*1024+r32*16; const lds_cptr vp0=shm3+LDS_V+((lane>>4)&1)*32+(lane&3)*8+(4*hi+((lane&15)>>2))*64;
  const int NT=(q0+QB)/KVBLK;
  { const f32x4* cbg=reinterpret_cast<const f32x4*>(CB+(long)(b*NHEAD+h)*SEQ); f32x4* cbl=reinterpret_cast<f32x4*>(shm+LDS_CB); const int nv=(q0+QB)/4;
    for(int i=tid;i<nv;i+=NW*64) cbl[i]=cbg[i];
    asm volatile("s_waitcnt vmcnt(0) lgkmcnt(0)\n\ts_barrier":::"memory"); }
  const lds_cptr cb3=(lds_cptr)shm+LDS_CB;
  const float cb_own=*(const __attribute__((address_space(3))) float*)(cb3+(q0+wid*QBLK+r32)*4);
  DMA_K(0,0);DMA_V(0,0);DMA_K(1,SLOTB);
  bf16x8 qr[4];
  #pragma unroll
  for(int d0=0;d0<4;++d0)qr[d0]=*reinterpret_cast<const bf16x8*>(&Qw[(long)r32*DM+d0*16+hi*8]);
  float mhat=0.f,l_reg=0.f;f32x16 o[2];o[0]=f32x16{};o[1]=f32x16{};
  const int qrel=wid*QBLK+r32;
  #define CMASK(P0,P1,t) do{int jb_=(t)-(NT-4); if(jb_>=0)cmask(P0,P1,jb_,qrel,hi);}while(0)
  bool resc=false;
  #define START(P0,P1) do{ const float rm=max2f(rowmax(P0,P1),cb_own); resc=false; \
    { const float dl=rm; mhat=fadd_s(mhat,dl); \
      _Pragma("unroll") for(int r=0;r<16;++r){P0[r]=fsub_s(P0[r],dl);P1[r]=fsub_s(P1[r],dl);} } \
    _Pragma("unroll") for(int r=0;r<16;++r)P0[r]=__builtin_amdgcn_exp2f(P0[r]); }while(0)
  #define RESC() do{ if(resc){ asm volatile("s_waitcnt lgkmcnt(0)":::"memory"); \
      _Pragma("unroll") for(int d_=0;d_<2;++d_) _Pragma("unroll") for(int r=0;r<16;++r)o[d_][r]*=wsf[crow(r,hi)]; } }while(0)
  f32x16 pA0,pA1,pB0,pB1;
  int sl_prev=0,sl_cur=0,sl_next=SLOTB;
  #define ROT() do{sl_prev=sl_cur;sl_cur=sl_next;sl_next=(sl_next==(NSLOT-1)*SLOTB)?0:sl_next+SLOTB;}while(0)
  DMA_K(2,2*SLOTB);
  WAIT_BAR(3);
  qkt(pA0,pA1,Kbase,qr,shm+LDS_CB,r32,hi);asm volatile("s_nop 15\n\ts_nop 7":"+v"(pA0),"+v"(pA1));CMASK(pA0,pA1,0);
  START(pA0,pA1);
  _Pragma("unroll") for(int r=0;r<16;++r)pA1[r]=__builtin_amdgcn_exp2f(pA1[r]);
  WAIT_BAR(0);
  DMA_K(3,0);DMA_V(1,SLOTB);
  ROT();
  kload8(kf,kp0+sl_cur);
  WAIT_BAR(2);
  s16x4 vlo[8],vhi[8]; u32x4 pw0,pw1,pw2,pw3;
  #define PKW(P,B) cvtpk_s(P[B],P[B+1])
  #define PAF(k) __builtin_bit_cast(bf16x8,pw##k)
  #define VFR(i) (bf16x8){vlo[i][0],vlo[i][1],vlo[i][2],vlo[i][3],vhi[i][0],vhi[i][1],vhi[i][2],vhi[i][3]}
  #define PIN(x) asm volatile("":"+v"(x))
  #define MX3(a,b,c) __builtin_fmaxf(__builtin_fmaxf((a),(b)),(c))
  #define GAPA(MF,A0,A1,A2,A3,W0,W1,PW) do{ MF; sacc+=A0; sacc+=A1; sacc+=A2; sacc+=A3; PIN(sacc); W0; W1; PIN(PW); SBAR(); }while(0)
  #define EX(v) __builtin_amdgcn_exp2f(v)
  #define GAPB(MF,X,B) do{ MF; X[B]=EX(X[B]); X[B+1]=EX(X[B+1]); X[B+2]=EX(X[B+2]); X[B+3]=EX(X[B+3]); PIN(X); SBAR(); }while(0)
  #define VRD(i) do{ vlo[i]=vtr(vp_+(((i)>>2)*4096+((i)&3)*1024)); vhi[i]=vtr(vp_+(((i)>>2)*4096+((i)&3)*1024+512)); }while(0)
  #define KRD(G,j) do{ if(G){ kload2(kf,kp0+sl_next,j); SBAR(); } }while(0)
  #define STEP(C0,C1,P0,P1,t,GK,GV,GL) do{ SBAR(); \
    { const __attribute__((address_space(3))) f32x4* cbp_=(const __attribute__((address_space(3))) f32x4*)(cb3+(t)*256+hi*16); \
      _Pragma("unroll") for(int a_=0;a_<4;++a_){ const f32x4 u0_=cbp_[2*a_], u1_=cbp_[8+2*a_]; \
        C0[4*a_]=u0_[0]-mhat;C0[4*a_+1]=u0_[1]-mhat;C0[4*a_+2]=u0_[2]-mhat;C0[4*a_+3]=u0_[3]-mhat; \
        C1[4*a_]=u1_[0]-mhat;C1[4*a_+1]=u1_[1]-mhat;C1[4*a_+2]=u1_[2]-mhat;C1[4*a_+3]=u1_[3]-mhat; } } SBAR(); \
    const lds_cptr vp_=vp0+sl_prev; \
    VRD(0); SBAR(); float sacc=(P0[0]+P0[1]); \
    GAPA(C0=__builtin_amdgcn_mfma_f32_32x32x16_bf16(kf[0],qr[0],C0,0,0,0), P0[2],P0[3],P0[4],P0[5],     pw0[0]=PKW(P0,0), pw0[1]=PKW(P0,2), pw0); \
    VRD(4); SBAR(); GAPA(C1=__builtin_amdgcn_mfma_f32_32x32x16_bf16(kf[1],qr[0],C1,0,0,0), P0[6],P0[7],P0[8],P0[9],     pw0[2]=PKW(P0,4), pw0[3]=PKW(P0,6), pw0); \
    VRD(1); SBAR(); GAPA(C0=__builtin_amdgcn_mfma_f32_32x32x16_bf16(kf[2],qr[1],C0,0,0,0),   P0[10],P0[11],P0[12],P0[13], pw1[0]=PKW(P0,8), pw1[1]=PKW(P0,10), pw1); \
    VRD(5); SBAR(); GAPA(C1=__builtin_amdgcn_mfma_f32_32x32x16_bf16(kf[3],qr[1],C1,0,0,0),   P0[14],P0[15],P1[0],P1[1],   pw1[2]=PKW(P0,12),pw1[3]=PKW(P0,14), pw1); \
    VRD(2); SBAR(); GAPA(C0=__builtin_amdgcn_mfma_f32_32x32x16_bf16(kf[4],qr[2],C0,0,0,0),   P1[2],P1[3],P1[4],P1[5],     pw2[0]=PKW(P1,0), pw2[1]=PKW(P1,2), pw2); \
    VRD(6); SBAR(); GAPA(C1=__builtin_amdgcn_mfma_f32_32x32x16_bf16(kf[5],qr[2],C1,0,0,0),   P1[6],P1[7],P1[8],P1[9],     pw2[2]=PKW(P1,4), pw2[3]=PKW(P1,6), pw2); \
    VRD(3); SBAR(); GAPA(C0=__builtin_amdgcn_mfma_f32_32x32x16_bf16(kf[6],qr[3],C0,0,0,0),   P1[10],P1[11],P1[12],P1[13], pw3[0]=PKW(P1,8), pw3[1]=PKW(P1,10), pw3); \
    VRD(7); SBAR(); GAPA(C1=__builtin_amdgcn_mfma_f32_32x32x16_bf16(kf[7],qr[3],C1,0,0,0),   P1[14],P1[15],0.f,0.f,       pw3[2]=PKW(P1,12),pw3[3]=PKW(P1,14), pw3); \
    l_reg+=sacc; \
    if(GK){DMA_K((t)+3,sl_cur);} if(GV){DMA_V((t)+1,sl_next);} \
    CMASK(C0,C1,t); \
    { float a=MX3(C0[0],C0[1],C1[0]),b=MX3(C0[2],C0[3],C1[1]); a=MX3(a,C1[2],C1[3]); \
      _Pragma("unroll") for(int r=4;r<16;r+=4){a=MX3(a,C0[r],C0[r+1]);b=MX3(b,C0[r+2],C0[r+3]);a=MX3(a,C1[r],C1[r+1]);b=MX3(b,C1[r+2],C1[r+3]);} \
      float rm=__builtin_fmaxf(a,b); { auto rr=__builtin_amdgcn_permlane32_swap(__float_as_uint(rm),__float_as_uint(rm),false,false); rm=__builtin_fmaxf(__uint_as_float(rr[0]),__uint_as_float(rr[1])); } \
      resc=false; \
      if(__builtin_expect(__any(rm>(float)THRL),0)){ const float dl=__builtin_fmaxf(rm,0.f); mhat+=dl; \
        _Pragma("unroll") for(int r=0;r<16;++r){C0[r]-=dl;C1[r]-=dl;} \
        const float f=__builtin_amdgcn_exp2f(-dl); l_reg*=f; if(hi==0)wsf[r32]=f; resc=true; } } \
    SBAR(); \
    GAPB(o[0]=__builtin_amdgcn_mfma_f32_32x32x16_bf16(PAF(0),VFR(0),o[0],0,0,0), C0,0); \
    GAPB(o[1]=__builtin_amdgcn_mfma_f32_32x32x16_bf16(PAF(0),VFR(4),o[1],0,0,0), C0,4); \
    KRD(GL,0); GAPB(o[0]=__builtin_amdgcn_mfma_f32_32x32x16_bf16(PAF(1),VFR(1),o[0],0,0,0), C0,8); \
    KRD(GL,1); GAPB(o[1]=__builtin_amdgcn_mfma_f32_32x32x16_bf16(PAF(1),VFR(5),o[1],0,0,0), C0,12); \
    KRD(GL,2); GAPB(o[0]=__builtin_amdgcn_mfma_f32_32x32x16_bf16(PAF(2),VFR(2),o[0],0,0,0), C1,0); \
    KRD(GL,3); GAPB(o[1]=__builtin_amdgcn_mfma_f32_32x32x16_bf16(PAF(2),VFR(6),o[1],0,0,0), C1,4); \
    GAPB(o[0]=__builtin_amdgcn_mfma_f32_32x32x16_bf16(PAF(3),VFR(3),o[0],0,0,0), C1,8); \
    GAPB(o[1]=__builtin_amdgcn_mfma_f32_32x32x16_bf16(PAF(3),VFR(7),o[1],0,0,0), C1,12); \
    }while(0)
  int t=1;
  #undef CMASK
  #define CMASK(P0,P1,t) do{}while(0)
  for(;t+5<NT;t+=2){
    STEP(pB0,pB1,pA0,pA1,t,true,true,true);     WAIT_BAR(2); RESC(); ROT();
    STEP(pA0,pA1,pB0,pB1,t+1,true,true,true);   WAIT_BAR(2); RESC(); ROT();
  }
  #undef CMASK
  #define CMASK(P0,P1,t) do{int jb_=(t)-(NT-4); if(jb_>=0)cmask(P0,P1,jb_,qrel,hi);}while(0)
  #define ENDW(tt) do{ if((tt)+3<NT){WAIT_BAR(2);} else if((tt)+2<NT){WAIT_BAR(1);} else {WAIT_BAR(0);} }while(0)
  for(;t+1<NT;t+=2){
    STEP(pB0,pB1,pA0,pA1,t,(t+3<NT),(t+1<NT),(t+1<NT));       ENDW(t);   RESC(); ROT();
    STEP(pA0,pA1,pB0,pB1,t+1,(t+4<NT),(t+2<NT),(t+2<NT));     ENDW(t+1); RESC(); ROT();
  }
  STEP(pB0,pB1,pA0,pA1,NT-1,false,false,false); RESC();
  { float sacc=pB0[0]+pB0[1]; _Pragma("unroll") for(int r=2;r<16;++r)sacc+=pB0[r]; _Pragma("unroll") for(int r=0;r<16;++r)sacc+=pB1[r]; l_reg+=sacc;
    pw0=(u32x4){PKW(pB0,0),PKW(pB0,2),PKW(pB0,4),PKW(pB0,6)};pw1=(u32x4){PKW(pB0,8),PKW(pB0,10),PKW(pB0,12),PKW(pB0,14)};pw2=(u32x4){PKW(pB1,0),PKW(pB1,2),PKW(pB1,4),PKW(pB1,6)};pw3=(u32x4){PKW(pB1,8),PKW(pB1,10),PKW(pB1,12),PKW(pB1,14)};
    SBAR(); pv(o,vb0+sl_cur,PAF(0),PAF(1),PAF(2),PAF(3)); }
  #undef PKW
  #undef PAF
  #undef VFR
  #undef PIN
  #undef MX3
  #undef GAPA
  #undef GAPB
  #undef EX
  #undef VRD
  #undef KRD
  #undef STEP
  #undef ENDW
  {auto rr=__builtin_amdgcn_permlane32_swap(__float_as_uint(l_reg),__float_as_uint(l_reg),false,false);l_reg=__uint_as_float(rr[0])+__uint_as_float(rr[1]);}
  if(hi==0)wsf[32+r32]=l_reg;asm volatile("s_waitcnt lgkmcnt(0)":::"memory");
  float rli[16];
  #pragma unroll
  for(int r=0;r<16;++r)rli[r]=__builtin_amdgcn_rcpf(wsf[32+crow(r,hi)]);
  bf16*Ow=O+(rowbase+q0+wid*QBLK)*OPITCH+h*D;
  { bf16*stg=(bf16*)(shm+LDS_OST)+wid*2048;
    #pragma unroll
    for(int r=0;r<16;++r){const int orow=crow(r,hi);
      #pragma unroll
      for(int d0=0;d0<2;++d0)stg[orow*64+d0*32+r32]=__float2bfloat16(o[d0][r]*rli[r]);}
    asm volatile("s_waitcnt lgkmcnt(0)":::"memory");
    #pragma unroll
    for(int i=0;i<4;++i){const int row=i*8+(lane>>3),ch=lane&7; const u32x4 v=*(const u32x4*)(stg+row*64+ch*8); bf16*dst=Ow+(long)row*OPITCH+ch*8; const u32x4 gv=*(const u32x4*)dst; u32x4 w;
      #pragma unroll
      for(int j=0;j<4;++j){ const float a0=__uint_as_float(v[j]<<16)*__uint_as_float(gv[j]<<16), a1=__uint_as_float(v[j]&0xffff0000u)*__uint_as_float(gv[j]&0xffff0000u); w[j]=cvtpk_s(a0,a1); }
      if(!dry)*(u32x4*)dst=w;} }
  asm volatile("s_waitcnt lgkmcnt(0)\n\ts_barrier":::"memory");
  #undef DMA_K
  #undef DMA_V
  #undef CMASK
  #undef START
  #undef RESC
  #undef ROT
}
constexpr int ATTN_LDS_BYTES=LDS_BYTES;
struct AttnTensors { const bf16* Q; const bf16* K; const bf16* V; bf16* O; const float* CB; };
struct AttnUnit { int bh; int qb; };
struct StaticOrder {
  int vcu;
  __device__ __forceinline__ explicit StaticOrder(int grid,int block):vcu((block%8)*(grid/8)+block/8){}
  __device__ __forceinline__ bool next(int i,AttnUnit&u)const{ if(i>=2)return false; const int s=vcu&7; u.bh=vcu>>3; u.qb=(i==0)?15-s:s; return true; }
  __device__ __forceinline__ void a_ready(const AttnUnit&)const{}
  __device__ __forceinline__ void done(const AttnUnit&)const{}
};
template<class Sched,int THRL=8> __device__ __forceinline__ void attn_phase(char*lds,const AttnTensors&T,const Sched&S,bool dry=false){
  AttnUnit u;
  for(int i=0;S.next(i,u);++i){ S.a_ready(u); attn_unit<THRL>(u.bh/NHEAD,u.bh%NHEAD,u.qb,T.Q,T.K,T.V,T.O,T.CB,lds,dry); S.done(u); }
}
#undef SBAR
#undef WAIT_BAR
}
#include <hip/hip_cooperative_groups.h>
namespace cg = cooperative_groups;
#define LAS __attribute__((address_space(3)))
typedef unsigned short bf16;
typedef float f32x4 __attribute__((ext_vector_type(4)));
typedef float f32x2 __attribute__((ext_vector_type(2)));
typedef unsigned u32x4 __attribute__((ext_vector_type(4)));
typedef unsigned u32x2 __attribute__((ext_vector_type(2)));
typedef short bf16x8 __attribute__((ext_vector_type(8)));
typedef short bf16x4 __attribute__((ext_vector_type(4)));

constexpr int NWAVES = 8, NTHR = 512;
constexpr int BATCH = 4, SEQ = 4096, DM = 1024, DEPTH = 4, M = BATCH * SEQ;
constexpr int NIN = 3592, NF = 3840;
constexpr int T5 = 32, NCH5 = M / T5, KA5 = 640, NG5 = 16;
constexpr float EPS = 1e-6f;
constexpr float LOG2E = 1.4426950408889634f;

constexpr size_t MiB = 1u << 20;
constexpr size_t WS_WIN = 1 * MiB, WS_WO = 31 * MiB, WS_WGLU = 39 * MiB, WS_ROPE = 40 * MiB, WS_MF = 41 * MiB, WS_WB = 81 * MiB;
constexpr size_t WS_LAM = 90 * MiB, WS_LOGF = 90 * MiB + 65536, WS_CB = WS_LOGF + 524288, WS_SS = WS_CB + 524288;
constexpr size_t WS_XN = 92 * MiB, WS_E = WS_XN, WS_UPD = WS_XN + 4 * MiB, WS_STATE = WS_XN + 20 * MiB;
constexpr size_t WS_QO = 124 * MiB, WS_KB = 140 * MiB, WS_VB = 156 * MiB, WS_SUA = 172 * MiB, WS_RQ = 182 * MiB, WS_RK = 190 * MiB, WS_RKT = 198 * MiB, WS_YS5 = WS_RKT;
constexpr size_t WS_RVT = 206 * MiB, WS_GATE = 214 * MiB, WS_END = 246 * MiB;

constexpr int RING_BYTES = 131072, LDS_BYTES = 147456;

struct Args { const float* in[16]; float* out; unsigned char* ws; };

__device__ __forceinline__ float bf2f(unsigned short b) { return __uint_as_float((unsigned)b << 16); }
__device__ __forceinline__ float bflo(unsigned w) { return __uint_as_float(w << 16); }
__device__ __forceinline__ float bfhi(unsigned w) { return __uint_as_float(w & 0xffff0000u); }
__device__ __forceinline__ unsigned pk2(float lo, float hi) { return pg8::cvt_pk_bf16(lo, hi); }
__device__ __forceinline__ unsigned short f2bf(float f) { return (unsigned short)(pg8::cvt_pk_bf16(f, 0.f) & 0xffffu); }
__device__ __forceinline__ float wave_sum(float v) {
#pragma unroll
    for (int o = 1; o < 64; o <<= 1) v += __shfl_xor(v, o);
    return v;
}
__device__ __forceinline__ float lg2_gamma(int hh) { return log2f(1.0f - exp2f(-5.0f - (float)hh)); }

__device__ __forceinline__ int win_col(int n) {
    if (n < 1536) return n;
    if (n < 1792) return n + 8;
    if (n >= 3584) return (n < 3592) ? 1536 + (n - 3584) : -1;
    if (n < 2304) { const bool q = n < 2048; const int base = q ? 1792 : 2048; const int hh = (n - base) >> 6, pos = (n - base) & 63; const int d = (pos & 1) ? 32 + (pos >> 1) : (pos >> 1); return (q ? 1800 : 2056) + hh * 64 + d; }
    return n + 8;
}
template <bool MAP> __device__ __forceinline__ void p0_transpose_item(const float* W, int K, int Nsrc, int Ndst, bf16* WT, LAS float* scr, int item, int lane) {
    const int nblk = Ndst / 32, kb = item / nblk, nb = item % nblk, k0 = 64 * kb, n0 = 32 * nb;
    const int sc = MAP ? win_col(n0 + (lane & 31)) : n0 + (lane & 31);
#pragma unroll 8
    for (int i = 0; i < 32; ++i) { const int kk = 2 * i + (lane >> 5); scr[kk * 33 + (lane & 31)] = (MAP && sc < 0) ? 0.f : W[(size_t)(k0 + kk) * Nsrc + (sc < 0 ? 0 : sc)]; }
    asm volatile("s_waitcnt lgkmcnt(0)" ::: "memory");
    const int c = lane & 7;
#pragma unroll
    for (int j = 0; j < 4; ++j) { const int n = (lane >> 3) + 8 * j; const LAS float* s = scr + (8 * c) * 33 + n;
        u32x4 o; o.x = pk2(s[0 * 33], s[1 * 33]); o.y = pk2(s[2 * 33], s[3 * 33]); o.z = pk2(s[4 * 33], s[5 * 33]); o.w = pk2(s[6 * 33], s[7 * 33]);
        *(u32x4*)(WT + (size_t)(n0 + n) * K + k0 + 8 * c) = o; }
    asm volatile("s_waitcnt lgkmcnt(0)" ::: "memory");
}

__device__ __forceinline__ void s5_prep(const Args& a, int l, int g, LAS float* L, int tid) {
    LAS float* LPr = L;
    LAS float* LPi = L + 33 * 64;
    LAS float* Bbr = L + 66 * 64;
    LAS float* Bbi = Bbr + 1024;
    LAS float* Cr = Bbi + 1024;
    LAS float* Ci = Cr + 1024;
    LAS float* KT = Ci + 1024;
    const float* a_re = a.in[4] + (size_t)(l * 16 + g) * 64; const float* a_im = a.in[5] + (size_t)(l * 16 + g) * 64;
    const float* b_re = a.in[6] + (size_t)(l * 16 + g) * 1024; const float* b_im = a.in[7] + (size_t)(l * 16 + g) * 1024;
    const float* c_re = a.in[8] + (size_t)(l * 16 + g) * 1024; const float* c_im = a.in[9] + (size_t)(l * 16 + g) * 1024;
    const float log_dt = a.in[11][l * 16 + g];
    bf16* MF = (bf16*)(a.ws + WS_MF) + (size_t)(l * 16 + g) * 512 * KA5;
    bf16* WB = (bf16*)(a.ws + WS_WB) + (size_t)(l * 16 + g) * 128 * 512;
    float* LAM = (float*)(a.ws + WS_LAM) + (size_t)(l * 16 + g) * 128;
    if (tid < 64) {
        const int p = tid;
        const double dt = exp((double)log_dt), ar = (double)a_re[p], ai = (double)a_im[p];
        const double mag = exp(ar * dt); double sn, cs; sincos(ai * dt, &sn, &cs);
        const double lr = mag * cs, li = mag * sn, den = ar * ar + ai * ai;
        const double fr = ((lr - 1.0) * ar + li * ai) / den, fi = (li * ar - (lr - 1.0) * ai) / den;
#pragma unroll 4
        for (int h = 0; h < 16; ++h) { const double br = (double)b_re[p * 16 + h], bi = (double)b_im[p * 16 + h]; Bbr[p * 16 + h] = (float)(fr * br - fi * bi); Bbi[p * 16 + h] = (float)(fr * bi + fi * br); }
        double pr = 1.0, pi = 0.0;
        for (int j = 0; j <= 32; ++j) { LPr[j * 64 + p] = (float)pr; LPi[j * 64 + p] = (float)pi; const double nr = pr * lr - pi * li, ni = pr * li + pi * lr; pr = nr; pi = ni; }
        LAM[p] = LPr[32 * 64 + p]; LAM[64 + p] = LPi[32 * 64 + p];
    }
    for (int i = tid; i < 1024; i += NTHR) { const int h = i >> 6, p = i & 63; Cr[p * 16 + h] = c_re[i]; Ci[p * 16 + h] = c_im[i]; }
    __syncthreads();
    { const int j = tid >> 4, h = tid & 15; float acc[16];
#pragma unroll
      for (int e = 0; e < 16; ++e) acc[e] = 0.f;
      for (int p = 0; p < 64; ++p) { const float cr = Cr[p * 16 + h], ci = Ci[p * 16 + h], lr = LPr[j * 64 + p], li = LPi[j * 64 + p]; const float clr = cr * lr - ci * li, cli = cr * li + ci * lr;
#pragma unroll
          for (int q = 0; q < 4; ++q) { const f32x4 br = *(const LAS f32x4*)(Bbr + p * 16 + 4 * q), bi = *(const LAS f32x4*)(Bbi + p * 16 + 4 * q);
              acc[4 * q] += clr * br.x - cli * bi.x; acc[4 * q + 1] += clr * br.y - cli * bi.y; acc[4 * q + 2] += clr * br.z - cli * bi.z; acc[4 * q + 3] += clr * br.w - cli * bi.w; } }
#pragma unroll
      for (int e = 0; e < 16; ++e) KT[tid * 16 + e] = acc[e]; }
    __syncthreads();
    for (int q = tid; q < 512 * 64; q += NTHR) {
        const int row = q >> 6, cp = q & 63, s = cp >> 1, h0 = (cp & 1) * 8, t = row >> 4, h = row & 15;
        u32x4 o = (u32x4){0u, 0u, 0u, 0u};
        if (s <= t) { const LAS float* k = KT + ((t - s) * 16 + h) * 16 + h0; o.x = pk2(k[0], k[1]); o.y = pk2(k[2], k[3]); o.z = pk2(k[4], k[5]); o.w = pk2(k[6], k[7]); }
        *(u32x4*)(MF + (size_t)row * KA5 + cp * 8) = o;
    }
    for (int q = tid; q < 512 * 16; q += NTHR) {
        const int row = q >> 4, cp = q & 15, t = row >> 4, h = row & 15; float v[8];
#pragma unroll
        for (int e = 0; e < 8; ++e) { const int jj = cp * 8 + e, p = jj & 63; const float cr = Cr[p * 16 + h], ci = Ci[p * 16 + h], lr = LPr[(t + 1) * 64 + p], li = LPi[(t + 1) * 64 + p];
            v[e] = (jj < 64) ? (cr * lr - ci * li) : -(cr * li + ci * lr); }
        u32x4 o; o.x = pk2(v[0], v[1]); o.y = pk2(v[2], v[3]); o.z = pk2(v[4], v[5]); o.w = pk2(v[6], v[7]);
        *(u32x4*)(MF + (size_t)row * KA5 + 512 + cp * 8) = o;
    }
    for (int q = tid; q < 128 * 64; q += NTHR) {
        const int j = q >> 6, cp = q & 63, s = cp >> 1, h0 = (cp & 1) * 8, p = j & 63; const float lr = LPr[(31 - s) * 64 + p], li = LPi[(31 - s) * 64 + p]; float v[8];
#pragma unroll
        for (int e = 0; e < 8; ++e) { const float br = Bbr[p * 16 + h0 + e], bi = Bbi[p * 16 + h0 + e]; v[e] = (j < 64) ? (lr * br - li * bi) : (lr * bi + li * br); }
        u32x4 o; o.x = pk2(v[0], v[1]); o.y = pk2(v[2], v[3]); o.z = pk2(v[4], v[5]); o.w = pk2(v[6], v[7]);
        *(u32x4*)(WB + (size_t)j * 512 + cp * 8) = o;
    }
    __syncthreads();
}

__device__ __forceinline__ void norm0_phase(const Args& a, int lane, int gw, int NGW) {
    const float* X = a.in[0]; f32x4 gv[4];
#pragma unroll
    for (int j = 0; j < 4; ++j) gv[j] = *((const f32x4*)a.in[1] + lane + 64 * j);
    bf16* XN = (bf16*)(a.ws + WS_XN); float* SS = (float*)(a.ws + WS_SS);
    for (int m = gw; m < M; m += 2 * NGW) {
        const int m2 = m + NGW; const bool has2 = m2 < M;
        const f32x4* xr = (const f32x4*)(X + (size_t)m * DM) + lane; const f32x4* xr2 = (const f32x4*)(X + (size_t)(has2 ? m2 : m) * DM) + lane; f32x4 v[4], w[4];
#pragma unroll
        for (int j = 0; j < 4; ++j) { v[j] = xr[64 * j]; w[j] = xr2[64 * j]; }
        float ss = 0.f, ss2 = 0.f;
#pragma unroll
        for (int j = 0; j < 4; ++j) { ss += (v[j].x * v[j].x + v[j].y * v[j].y) + (v[j].z * v[j].z + v[j].w * v[j].w); ss2 += (w[j].x * w[j].x + w[j].y * w[j].y) + (w[j].z * w[j].z + w[j].w * w[j].w); }
        ss = wave_sum(ss); ss2 = wave_sum(ss2);
        unsigned long long* o8 = (unsigned long long*)(XN + (size_t)m * DM) + lane; unsigned long long* o82 = (unsigned long long*)(XN + (size_t)m2 * DM) + lane;
#pragma unroll
        for (int j = 0; j < 4; ++j) { v[j] = v[j] * gv[j]; o8[64 * j] = (unsigned long long)pk2(v[j].x, v[j].y) | ((unsigned long long)pk2(v[j].z, v[j].w) << 32);
            if (has2) { w[j] = w[j] * gv[j]; o82[64 * j] = (unsigned long long)pk2(w[j].x, w[j].y) | ((unsigned long long)pk2(w[j].z, w[j].w) << 32); } }
        if (lane == 0) { SS[m] = ss; if (has2) SS[m2] = ss2; }
    }
}
__device__ __forceinline__ void final_norm(const Args& a, float* X, const float* SS, int lane, int gw, int NGW) {
    f32x4 gv[4];
#pragma unroll
    for (int j = 0; j < 4; ++j) gv[j] = *((const f32x4*)a.in[15] + lane + 64 * j);
    for (int m = gw; m < M; m += 2 * NGW) {
        const int m2 = m + NGW; const bool has2 = m2 < M;
        f32x4* xr = (f32x4*)(X + (size_t)m * DM) + lane; f32x4* xr2 = (f32x4*)(X + (size_t)(has2 ? m2 : m) * DM) + lane; f32x4 v[4], w[4];
#pragma unroll
        for (int j = 0; j < 4; ++j) { v[j] = xr[64 * j]; w[j] = xr2[64 * j]; }
        const float r1 = rsqrtf(SS[m] * (1.f / DM) + EPS), r2 = rsqrtf(SS[has2 ? m2 : m] * (1.f / DM) + EPS);
#pragma unroll
        for (int j = 0; j < 4; ++j) { xr[64 * j] = v[j] * r1 * gv[j]; if (has2) xr2[64 * j] = w[j] * r2 * gv[j]; }
    }
}

__device__ __forceinline__ bool opaque_true() { int d = 1; asm volatile("" : "+s"(d)); return d != 0; }
struct FlatOrder {
    int nM, nN, nG, G, c;
    __device__ bool next(int i, pg8::Unit& u) const { const int L = i * G + c; if (L >= nG * nM * nN) return false; u.gz = L / (nM * nN); const int r = L % (nM * nN); u.pm = r % nM; u.pn = r / nM; return true; }
    __device__ __forceinline__ void a_ready(const pg8::Unit&) const {}
    __device__ __forceinline__ void done(const pg8::Unit&) const {}
};
__device__ __forceinline__ float silu_f(float v) { return v / (1.f + __expf(-v)); }
__device__ __forceinline__ float gelu_tanh(float v) { const float u = 0.7978845608028654f * (v + 0.044715f * v * v * v); const float e = __expf(2.f * u); const float th = 1.f - 2.f / (e + 1.f); return 0.5f * v * (1.f + th); }

struct EpiInProj {
    static constexpr bool PERM = true, AFTER_DRAIN = false;
    unsigned char* ws; const float* SS; const float* bfl;
    __device__ __forceinline__ void operator()(const pg8::f32x4 (&acc)[2][2][4][2], const pg8::Unit& u, int wr, int wc, int fr, int fq) const {
        const int pn = u.pn; const int row0 = u.pm * 256 + wr * 64 + fr, cl0 = wc * 32 + 8 * fq;
        float rs[2][4];
#pragma unroll
        for (int ai = 0; ai < 2; ++ai)
#pragma unroll
            for (int m = 0; m < 4; ++m) rs[ai][m] = rsqrtf(SS[row0 + ai * 128 + m * 16] * (1.f / DM) + EPS);
        if (pn == 14) {
            if (wc == 0 && fq == 0) { float* LOGF = (float*)(ws + WS_LOGF); const f32x4 b0 = *(const f32x4*)bfl, b1 = *(const f32x4*)(bfl + 4);
#pragma unroll
                for (int ai = 0; ai < 2; ++ai)
#pragma unroll
                    for (int m = 0; m < 4; ++m) { const int row = row0 + ai * 128 + m * 16; const float r = rs[ai][m]; const pg8::f32x4 v0 = acc[ai][0][m][0], v1 = acc[ai][0][m][1];
                        float z[8] = {v0[0] * r + b0.x, v0[1] * r + b0.y, v0[2] * r + b0.z, v0[3] * r + b0.w, v1[0] * r + b1.x, v1[1] * r + b1.y, v1[2] * r + b1.z, v1[3] * r + b1.w};
#pragma unroll
                        for (int e = 0; e < 8; ++e) LOGF[(size_t)((row >> 12) * 8 + e) * SEQ + (row & 4095)] = fminf(z[e], 0.f) - log1pf(__expf(-fabsf(z[e]))); } }
            return;
        }
        if (pn < 6) {
            bf16* base = (bf16*)(ws + (pn < 2 ? WS_QO : pn < 4 ? WS_KB : WS_VB)); const float sc = pn < 2 ? 0.125f * LOG2E : 1.f; const int cb = (pn & 1) * 256 + cl0;
#pragma unroll
            for (int ai = 0; ai < 2; ++ai)
#pragma unroll
                for (int m = 0; m < 4; ++m) { bf16* rp = base + (size_t)(row0 + ai * 128 + m * 16) * 512 + cb;
#pragma unroll
                    for (int bj = 0; bj < 2; ++bj) { const float sr = sc * rs[ai][m]; const pg8::f32x4 v0 = acc[ai][bj][m][0] * sr, v1 = acc[ai][bj][m][1] * sr; u32x4 w; w.x = pk2(v0[0], v0[1]); w.y = pk2(v0[2], v0[3]); w.z = pk2(v1[0], v1[1]); w.w = pk2(v1[2], v1[3]); *(u32x4*)(rp + bj * 128) = w; } }
        } else if (pn == 6) {
            bf16* base = (bf16*)(ws + WS_SUA);
#pragma unroll
            for (int ai = 0; ai < 2; ++ai)
#pragma unroll
                for (int m = 0; m < 4; ++m) { const int row = row0 + ai * 128 + m * 16, chunk = row >> 5, t = row & 31;
#pragma unroll
                    for (int bj = 0; bj < 2; ++bj) { const int c = cl0 + bj * 128, g = c >> 4, h0 = c & 15; const pg8::f32x4 v0 = acc[ai][bj][m][0] * rs[ai][m], v1 = acc[ai][bj][m][1] * rs[ai][m]; u32x4 w; w.x = pk2(v0[0], v0[1]); w.y = pk2(v0[2], v0[3]); w.z = pk2(v1[0], v1[1]); w.w = pk2(v1[2], v1[3]);
                        *(u32x4*)(base + ((size_t)(g * 512 + chunk) * KA5 + t * 16 + h0)) = w; } }
        } else if (pn == 7 || pn == 8) {
            const f32x4* rope = (const f32x4*)(ws + WS_ROPE); bf16* base = (bf16*)(ws + (pn == 7 ? WS_RQ : WS_RK)); bf16* RKT = (bf16*)(ws + WS_RKT);
#pragma unroll
            for (int ai = 0; ai < 2; ++ai)
#pragma unroll
                for (int m = 0; m < 4; ++m) { const int row = row0 + ai * 128 + m * 16, b = row >> 12, t = row & 4095;
#pragma unroll
                    for (int bj = 0; bj < 2; ++bj) { const int c = cl0 + bj * 128, hh = c >> 6, pos0 = c & 63; const pg8::f32x4 v0 = acc[ai][bj][m][0] * rs[ai][m], v1 = acc[ai][bj][m][1] * rs[ai][m];
                        const f32x4 r0 = rope[(t * 32 + (pos0 >> 1)) >> 1], r1 = rope[((t * 32 + (pos0 >> 1)) >> 1) + 1];
                        float o[8];
                        o[0] = v0[0] * r0.x - v0[1] * r0.y; o[1] = v0[0] * r0.y + v0[1] * r0.x; o[2] = v0[2] * r0.z - v0[3] * r0.w; o[3] = v0[2] * r0.w + v0[3] * r0.z;
                        o[4] = v1[0] * r1.x - v1[1] * r1.y; o[5] = v1[0] * r1.y + v1[1] * r1.x; o[6] = v1[2] * r1.z - v1[3] * r1.w; o[7] = v1[2] * r1.w + v1[3] * r1.z;
                        u32x4 w; w.x = pk2(o[0], o[1]); w.y = pk2(o[2], o[3]); w.z = pk2(o[4], o[5]); w.w = pk2(o[6], o[7]);
                        *(u32x4*)(base + (size_t)row * 256 + c) = w;
                        if (pn == 8) { const float wk = exp2f(lg2_gamma(hh) * (float)(63 - (t & 63))); bf16* tp = RKT + ((size_t)((b * 4 + hh) * 64 + pos0)) * SEQ + t;
#pragma unroll
                            for (int e = 0; e < 8; ++e) tp[(size_t)e * SEQ] = f2bf(o[e] * wk); } } }
        } else if (pn == 9) {
            bf16* RVT = (bf16*)(ws + WS_RVT);
#pragma unroll
            for (int ai = 0; ai < 2; ++ai)
#pragma unroll
                for (int m = 0; m < 4; ++m) { const int row = row0 + ai * 128 + m * 16, b = row >> 12, t = row & 4095;
#pragma unroll
                    for (int bj = 0; bj < 2; ++bj) { const int c = cl0 + bj * 128, hh = c >> 6, d0 = c & 63; const pg8::f32x4 v0 = acc[ai][bj][m][0] * rs[ai][m], v1 = acc[ai][bj][m][1] * rs[ai][m]; bf16* tp = RVT + ((size_t)((b * 4 + hh) * 64 + d0)) * SEQ + t;
#pragma unroll
                        for (int e = 0; e < 4; ++e) { tp[(size_t)e * SEQ] = f2bf(v0[e]); tp[(size_t)(4 + e) * SEQ] = f2bf(v1[e]); } } }
        } else {
            bf16* base = (bf16*)(ws + WS_GATE); const int cb = (pn - 10) * 256 + cl0;
#pragma unroll
            for (int ai = 0; ai < 2; ++ai)
#pragma unroll
                for (int m = 0; m < 4; ++m) { bf16* rp = base + (size_t)(row0 + ai * 128 + m * 16) * 1024 + cb;
#pragma unroll
                    for (int bj = 0; bj < 2; ++bj) { const pg8::f32x4 v0 = acc[ai][bj][m][0] * rs[ai][m], v1 = acc[ai][bj][m][1] * rs[ai][m]; u32x4 w; w.x = pk2(silu_f(v0[0]), silu_f(v0[1])); w.y = pk2(silu_f(v0[2]), silu_f(v0[3])); w.z = pk2(silu_f(v1[0]), silu_f(v1[1])); w.w = pk2(silu_f(v1[2]), silu_f(v1[3])); *(u32x4*)(rp + bj * 128) = w; } }
        }
    }
};
struct EpiS5E {
    static constexpr bool PERM = false, AFTER_DRAIN = false;
    float* E;
    __device__ __forceinline__ void operator()(const pg8::f32x4 (&acc)[2][2][4][2], const pg8::Unit& u, int wr, int wc, int fr, int fq) const {
        const int row0 = u.pm * 256 + wr * 64 + fr, col0 = wc * 32 + 4 * fq;
#pragma unroll
        for (int ai = 0; ai < 2; ++ai)
#pragma unroll
            for (int m = 0; m < 4; ++m) { float* rp = E + ((size_t)u.gz * NCH5 + row0 + ai * 128 + m * 16) * 128 + col0;
#pragma unroll
                for (int n = 0; n < 2; ++n) *(pg8::f32x4*)(rp + n * 16) = acc[ai][0][m][n]; }
    }
};
struct EpiS5Y {
    static constexpr bool PERM = true, AFTER_DRAIN = false;
    const bf16* SUA; bf16* YS5; const float* dvec;
    __device__ __forceinline__ void operator()(const pg8::f32x4 (&acc)[2][2][4][2], const pg8::Unit& u, int wr, int wc, int fr, int fq) const {
        const int row0 = u.pm * 256 + wr * 64 + fr, cl0 = u.pn * 256 + wc * 32 + 8 * fq; const int g = u.gz;
#pragma unroll
        for (int bj = 0; bj < 2; ++bj) { const int c = cl0 + bj * 128, tt = c >> 4, h0 = c & 15; const f32x4 d0 = *(const f32x4*)(dvec + g * 16 + h0), d1 = *(const f32x4*)(dvec + g * 16 + h0 + 4);
#pragma unroll
            for (int ai = 0; ai < 2; ++ai)
#pragma unroll
                for (int m = 0; m < 4; ++m) { const int chunk = row0 + ai * 128 + m * 16; const u32x4 uu = *(const u32x4*)(SUA + ((size_t)(g * 512 + chunk) * KA5 + c)); const pg8::f32x4 v0 = acc[ai][bj][m][0], v1 = acc[ai][bj][m][1];
                    float y[8]; y[0] = v0[0] + d0.x * bflo(uu.x); y[1] = v0[1] + d0.y * bfhi(uu.x); y[2] = v0[2] + d0.z * bflo(uu.y); y[3] = v0[3] + d0.w * bfhi(uu.y);
                    y[4] = v1[0] + d1.x * bflo(uu.z); y[5] = v1[1] + d1.y * bfhi(uu.z); y[6] = v1[2] + d1.z * bflo(uu.w); y[7] = v1[3] + d1.w * bfhi(uu.w);
#pragma unroll
                    for (int e = 0; e < 8; ++e) y[e] = gelu_tanh(y[e]);
                    u32x4 w; w.x = pk2(y[0], y[1]); w.y = pk2(y[2], y[3]); w.z = pk2(y[4], y[5]); w.w = pk2(y[6], y[7]);
                    *(u32x4*)(YS5 + (size_t)(chunk * 32 + tt) * 256 + g * 16 + h0) = w; } }
    }
};
struct EpiGlu {
    static constexpr bool PERM = true, AFTER_DRAIN = false;
    const bf16* YS5; bf16* G; bool dry;
    __device__ __forceinline__ void operator()(const pg8::f32x4 (&acc)[2][2][4][2], const pg8::Unit& u, int wr, int wc, int fr, int fq) const {
        const int row0 = u.pm * 256 + wr * 64 + fr, cl0 = wc * 32 + 8 * fq;
#pragma unroll
        for (int ai = 0; ai < 2; ++ai)
#pragma unroll
            for (int m = 0; m < 4; ++m) { const int row = row0 + ai * 128 + m * 16;
#pragma unroll
                for (int bj = 0; bj < 2; ++bj) { const int c = cl0 + bj * 128; const u32x4 yy = *(const u32x4*)(YS5 + (size_t)row * 256 + c); bf16* gp = G + (size_t)row * 1024 + 512 + c; const u32x4 gg = *(const u32x4*)gp;
                    const pg8::f32x4 v0 = acc[ai][bj][m][0], v1 = acc[ai][bj][m][1]; float s[8];
#pragma unroll
                    for (int e = 0; e < 4; ++e) { s[e] = 1.f / (1.f + __expf(-v0[e])); s[4 + e] = 1.f / (1.f + __expf(-v1[e])); }
                    u32x4 w; w.x = pk2(bflo(yy.x) * s[0] * bflo(gg.x), bfhi(yy.x) * s[1] * bfhi(gg.x)); w.y = pk2(bflo(yy.y) * s[2] * bflo(gg.y), bfhi(yy.y) * s[3] * bfhi(gg.y));
                    w.z = pk2(bflo(yy.z) * s[4] * bflo(gg.z), bfhi(yy.z) * s[5] * bfhi(gg.z)); w.w = pk2(bflo(yy.w) * s[6] * bflo(gg.w), bfhi(yy.w) * s[7] * bfhi(gg.w));
                    if (!dry) *(u32x4*)gp = w; } }
    }
};
struct EpiOut {
    static constexpr bool PERM = false, AFTER_DRAIN = false;
    const float* base; float* out; float* SSn; bf16* XN; const float* gnext; bool dry;
    __device__ __forceinline__ void operator()(const pg8::f32x4 (&acc)[2][2][4][2], const pg8::Unit& u, int wr, int wc, int fr, int fq) const {
        const int row0 = u.pm * 256 + wr * 64 + fr, col0 = u.pn * 256 + wc * 32 + 4 * fq;
        f32x4 gq[2][2];
#pragma unroll
        for (int bj = 0; bj < 2; ++bj)
#pragma unroll
            for (int n = 0; n < 2; ++n) gq[bj][n] = gnext ? *(const f32x4*)(gnext + col0 + bj * 128 + n * 16) : (f32x4){0.f, 0.f, 0.f, 0.f};
#pragma unroll
        for (int ai = 0; ai < 2; ++ai)
#pragma unroll
            for (int m = 0; m < 4; ++m) { const int row = row0 + ai * 128 + m * 16; const size_t off = (size_t)row * DM + col0; float sq = 0.f;
#pragma unroll
                for (int bj = 0; bj < 2; ++bj)
#pragma unroll
                    for (int n = 0; n < 2; ++n) { const f32x4 bs = *(const f32x4*)(base + off + bj * 128 + n * 16); const pg8::f32x4 v = acc[ai][bj][m][n]; const f32x4 x = (f32x4){bs.x + v[0], bs.y + v[1], bs.z + v[2], bs.w + v[3]};
                        sq += (x.x * x.x + x.y * x.y) + (x.z * x.z + x.w * x.w);
                        if (!dry) { *(f32x4*)(out + off + bj * 128 + n * 16) = x;
                            if (gnext) { const f32x4 g = gq[bj][n]; u32x2 w; w.x = pk2(x.x * g.x, x.y * g.y); w.y = pk2(x.z * g.z, x.w * g.w); *(u32x2*)(XN + off + bj * 128 + n * 16) = w; } } }
                sq += __shfl_xor(sq, 16); sq += __shfl_xor(sq, 32);
                if (fq == 0 && !dry) __hip_atomic_fetch_add(SSn + row, sq, __ATOMIC_RELAXED, __HIP_MEMORY_SCOPE_AGENT); }
    }
};

template <int KS, int UNR, class Epi> __device__ __forceinline__ void wave_gemm64(const bf16* A, int lda, const bf16* B, int ldb, int lane, const Epi& epi) {
    const int fr = lane & 15, fq = lane >> 4;
    pg8::f32x4 acc[4][4];
#pragma unroll
    for (int jb = 0; jb < 4; ++jb)
#pragma unroll
        for (int ib = 0; ib < 4; ++ib) acc[jb][ib] = (pg8::f32x4){0.f, 0.f, 0.f, 0.f};
    const bf16* ap = A + (size_t)fr * lda + 8 * fq; const bf16* bp = B + (size_t)fr * ldb + 8 * fq;
#pragma unroll UNR
    for (int ks = 0; ks < KS; ++ks) {
        bf16x8 af[4], bv[4];
#pragma unroll
        for (int ib = 0; ib < 4; ++ib) { af[ib] = *(const bf16x8*)(ap + (size_t)(16 * ib) * lda + 32 * ks); bv[ib] = *(const bf16x8*)(bp + (size_t)(16 * ib) * ldb + 32 * ks); }
#pragma unroll
        for (int jb = 0; jb < 4; ++jb)
#pragma unroll
            for (int ib = 0; ib < 4; ++ib) acc[jb][ib] = __builtin_amdgcn_mfma_f32_16x16x32_bf16(bv[jb], af[ib], acc[jb][ib], 0, 0, 0);
    }
    epi(acc, fr, fq);
}
struct WEpiE {
    float* E;
    __device__ __forceinline__ void operator()(const pg8::f32x4 (&acc)[4][4], int fr, int fq) const {
#pragma unroll
        for (int jb = 0; jb < 4; ++jb)
#pragma unroll
            for (int ib = 0; ib < 4; ++ib) *(pg8::f32x4*)(E + (size_t)(16 * ib + fr) * 128 + 16 * jb + 4 * fq) = acc[jb][ib];
    }
};
struct WEpiS5Y {
    const bf16* SUAg; bf16* YS5; const float* dg; int chunk0, col0, g;
    __device__ __forceinline__ void operator()(const pg8::f32x4 (&acc)[4][4], int fr, int fq) const {
#pragma unroll
        for (int jb = 0; jb < 4; ++jb) { const int col = col0 + 16 * jb + 4 * fq, tt = col >> 4, h0 = col & 15; const f32x4 d4 = *(const f32x4*)(dg + h0);
#pragma unroll
            for (int ib = 0; ib < 4; ++ib) { const int chunk = chunk0 + 16 * ib + fr; const u32x2 uu = *(const u32x2*)(SUAg + (size_t)chunk * KA5 + col); const pg8::f32x4 v = acc[jb][ib];
                const float y0 = gelu_tanh(v[0] + d4.x * bflo(uu.x)), y1 = gelu_tanh(v[1] + d4.y * bfhi(uu.x)), y2 = gelu_tanh(v[2] + d4.z * bflo(uu.y)), y3 = gelu_tanh(v[3] + d4.w * bfhi(uu.y));
                u32x2 w; w.x = pk2(y0, y1); w.y = pk2(y2, y3); *(u32x2*)(YS5 + (size_t)(chunk * 32 + tt) * 256 + g * 16 + h0) = w; } }
    }
};
struct WEpiGlu {
    const bf16* YS5; bf16* G; int row0, col0;
    __device__ __forceinline__ void operator()(const pg8::f32x4 (&acc)[4][4], int fr, int fq) const {
#pragma unroll
        for (int jb = 0; jb < 4; ++jb)
#pragma unroll
            for (int ib = 0; ib < 4; ++ib) { const int row = row0 + 16 * ib + fr, col = col0 + 16 * jb + 4 * fq; const u32x2 yy = *(const u32x2*)(YS5 + (size_t)row * 256 + col); bf16* gp = G + (size_t)row * 1024 + 512 + col; const u32x2 gg = *(const u32x2*)gp; const pg8::f32x4 v = acc[jb][ib];
                const float s0 = 1.f / (1.f + __expf(-v[0])), s1 = 1.f / (1.f + __expf(-v[1])), s2 = 1.f / (1.f + __expf(-v[2])), s3 = 1.f / (1.f + __expf(-v[3]));
                u32x2 w; w.x = pk2(bflo(yy.x) * s0 * bflo(gg.x), bfhi(yy.x) * s1 * bfhi(gg.x)); w.y = pk2(bflo(yy.y) * s2 * bflo(gg.y), bfhi(yy.y) * s3 * bfhi(gg.y)); *(u32x2*)gp = w; }
    }
};

__device__ __forceinline__ void ret_upd_unit(unsigned char* ws, int unit, int lane) {
    const int c = unit & 63, bh = unit >> 6; const int i16 = lane & 15, kq = lane >> 4;
    const bf16* KT = (const bf16*)(ws + WS_RKT) + (size_t)bh * 64 * SEQ + c * 64; const bf16* VT = (const bf16*)(ws + WS_RVT) + (size_t)bh * 64 * SEQ + c * 64;
    float* UPD = (float*)(ws + WS_UPD) + (size_t)unit * 4096;
    bf16x8 af[4][2], bfv[4][2];
#pragma unroll
    for (int ib = 0; ib < 4; ++ib)
#pragma unroll
        for (int ks = 0; ks < 2; ++ks) { af[ib][ks] = *(const bf16x8*)(KT + (size_t)(16 * ib + i16) * SEQ + 32 * ks + 8 * kq); bfv[ib][ks] = *(const bf16x8*)(VT + (size_t)(16 * ib + i16) * SEQ + 32 * ks + 8 * kq); }
#pragma unroll
    for (int ib = 0; ib < 4; ++ib)
#pragma unroll
        for (int jb = 0; jb < 4; ++jb) { pg8::f32x4 d = (pg8::f32x4){0.f, 0.f, 0.f, 0.f};
            d = __builtin_amdgcn_mfma_f32_16x16x32_bf16(af[ib][0], bfv[jb][0], d, 0, 0, 0); d = __builtin_amdgcn_mfma_f32_16x16x32_bf16(af[ib][1], bfv[jb][1], d, 0, 0, 0);
            *(pg8::f32x4*)(UPD + (size_t)(16 * jb + i16) * 64 + 16 * ib + 4 * kq) = d; }
}
__device__ __forceinline__ void ret_out_unit(const Args& a, int l, int unit, int lane, bool dry = false) {
    unsigned char* ws = a.ws;
    const int c = unit & 63, bh = unit >> 6, hh = bh & 3, b = bh >> 2; const int fr = lane & 15, fq = lane >> 4;
    const size_t t0 = (size_t)b * SEQ + c * 64;
    const bf16* RQ = (const bf16*)(ws + WS_RQ) + t0 * 256 + hh * 64; const bf16* RK = (const bf16*)(ws + WS_RK) + t0 * 256 + hh * 64;
    const bf16* VT = (const bf16*)(ws + WS_RVT) + (size_t)bh * 64 * SEQ + c * 64; const bf16* ST = (const bf16*)(ws + WS_STATE) + (size_t)unit * 4096;
    const float lg = lg2_gamma(hh);
    bf16x8 qf[4][2]; pg8::f32x4 st[4][4];
#pragma unroll
    for (int nb = 0; nb < 4; ++nb)
#pragma unroll
        for (int ks = 0; ks < 2; ++ks) qf[nb][ks] = *(const bf16x8*)(RQ + (size_t)(16 * nb + fr) * 256 + 32 * ks + 8 * fq);
#pragma unroll
    for (int mb = 0; mb < 4; ++mb) { bf16x8 k0 = *(const bf16x8*)(RK + (size_t)(16 * mb + fr) * 256 + 8 * fq), k1 = *(const bf16x8*)(RK + (size_t)(16 * mb + fr) * 256 + 32 + 8 * fq);
#pragma unroll
        for (int nb = 0; nb < 4; ++nb) { pg8::f32x4 d = (pg8::f32x4){0.f, 0.f, 0.f, 0.f};
            d = __builtin_amdgcn_mfma_f32_16x16x32_bf16(k0, qf[nb][0], d, 0, 0, 0); d = __builtin_amdgcn_mfma_f32_16x16x32_bf16(k1, qf[nb][1], d, 0, 0, 0);
#pragma unroll
            for (int r = 0; r < 4; ++r) { const int mm = 16 * mb + 4 * fq + r, nn = 16 * nb + fr; const int df = mm > nn ? mm - nn : nn - mm; d[r] *= 0.125f * exp2f(lg * (float)df); }
            st[mb][nb] = d; } }
    pg8::f32x4 o[4][4];
#pragma unroll
    for (int nb = 0; nb < 4; ++nb)
#pragma unroll
        for (int dvb = 0; dvb < 4; ++dvb) o[nb][dvb] = (pg8::f32x4){0.f, 0.f, 0.f, 0.f};
#pragma unroll
    for (int dvb = 0; dvb < 4; ++dvb) { const bf16x8 s0 = *(const bf16x8*)(ST + (size_t)(16 * dvb + fr) * 64 + 8 * fq), s1 = *(const bf16x8*)(ST + (size_t)(16 * dvb + fr) * 64 + 32 + 8 * fq);
#pragma unroll
        for (int nb = 0; nb < 4; ++nb) { o[nb][dvb] = __builtin_amdgcn_mfma_f32_16x16x32_bf16(qf[nb][0], s0, o[nb][dvb], 0, 0, 0); o[nb][dvb] = __builtin_amdgcn_mfma_f32_16x16x32_bf16(qf[nb][1], s1, o[nb][dvb], 0, 0, 0); } }
#pragma unroll
    for (int nb = 0; nb < 4; ++nb)
#pragma unroll
        for (int r = 0; r < 4; ++r) { const float wq = 0.125f * exp2f(lg * (float)(16 * nb + 4 * fq + r + 1));
#pragma unroll
            for (int dvb = 0; dvb < 4; ++dvb) o[nb][dvb][r] *= wq; }
#pragma unroll
    for (int s = 0; s < 2; ++s) {
        bf16x8 pa[4];
#pragma unroll
        for (int nb = 0; nb < 4; ++nb) { u32x4 w; w.x = pk2(st[2 * s][nb][0], st[2 * s][nb][1]); w.y = pk2(st[2 * s][nb][2], st[2 * s][nb][3]); w.z = pk2(st[2 * s + 1][nb][0], st[2 * s + 1][nb][1]); w.w = pk2(st[2 * s + 1][nb][2], st[2 * s + 1][nb][3]); pa[nb] = __builtin_bit_cast(bf16x8, w); }
#pragma unroll
        for (int dvb = 0; dvb < 4; ++dvb) { const u32x2 v0 = *(const u32x2*)(VT + (size_t)(16 * dvb + fr) * SEQ + 32 * s + 4 * fq), v1 = *(const u32x2*)(VT + (size_t)(16 * dvb + fr) * SEQ + 32 * s + 16 + 4 * fq);
            const bf16x8 vf = __builtin_bit_cast(bf16x8, (u32x4){v0.x, v0.y, v1.x, v1.y});
#pragma unroll
            for (int nb = 0; nb < 4; ++nb) o[nb][dvb] = __builtin_amdgcn_mfma_f32_16x16x32_bf16(pa[nb], vf, o[nb][dvb], 0, 0, 0); }
    }
    const float* gn = a.in[13] + (size_t)l * 256 + hh * 64; float gnw[4];
#pragma unroll
    for (int dvb = 0; dvb < 4; ++dvb) gnw[dvb] = gn[16 * dvb + fr];
    bf16* Y = (bf16*)(ws + WS_GATE) + t0 * 1024 + 768 + hh * 64;
#pragma unroll
    for (int nb = 0; nb < 4; ++nb)
#pragma unroll
        for (int r = 0; r < 4; ++r) { float s = (o[nb][0][r] + o[nb][1][r]) + (o[nb][2][r] + o[nb][3][r]);
            s += __shfl_xor(s, 1); s += __shfl_xor(s, 2); s += __shfl_xor(s, 4); s += __shfl_xor(s, 8);
            const float mu = s * (1.f / 64.f); float q = 0.f;
#pragma unroll
            for (int dvb = 0; dvb < 4; ++dvb) { const float d = o[nb][dvb][r] - mu; q += d * d; }
            q += __shfl_xor(q, 1); q += __shfl_xor(q, 2); q += __shfl_xor(q, 4); q += __shfl_xor(q, 8);
            const float rstd = rsqrtf(q * (1.f / 64.f) + EPS); bf16* yp = Y + (size_t)(16 * nb + 4 * fq + r) * 1024 + fr;
#pragma unroll
            for (int dvb = 0; dvb < 4; ++dvb) { const float gt = bf2f(yp[16 * dvb]); if (!dry) yp[16 * dvb] = f2bf((o[nb][dvb][r] - mu) * rstd * gnw[dvb] * gt); } }
}

#define XB_TMO      128
#define XB_XCNT(j)  (256  + 64 * (j))
#define XB_XSUB(j)  (1280 + 64 * (j))
#define XB_XGEN(j)  (2304 + 64 * (j))
#define XB_TOP      3328
#define XB_TOPGEN   3392
#define XCD_BAR_WORDS 3456
#define XB_SPIN_CAP (1u << 18)

__device__ __forceinline__ unsigned xb_ld(unsigned* p)              { return __hip_atomic_load(p, __ATOMIC_RELAXED, __HIP_MEMORY_SCOPE_AGENT); }
__device__ __forceinline__ unsigned xb_add(unsigned* p, unsigned v) { return __hip_atomic_fetch_add(p, v, __ATOMIC_RELAXED, __HIP_MEMORY_SCOPE_AGENT); }
__device__ __forceinline__ unsigned xb_xcc_id() { return (unsigned)__builtin_amdgcn_s_getreg((3 << 11) | 20) & 0xFu; }
#define XB_SPIN(cond, bar) do { unsigned _sp = 0; while (cond) { __builtin_amdgcn_s_sleep(1); \
    if ((++_sp & 255u) == 0u) { if (xb_ld(&(bar)[XB_TMO])) break; if (_sp > XB_SPIN_CAP) { atomicAdd(&(bar)[XB_TMO], 1u); break; } } } } while (0)

struct XcdBarrier {
    unsigned* bar; unsigned x;
    volatile LAS unsigned* st;
};

__device__ __forceinline__ XcdBarrier xcd_barrier_post(unsigned* bar, volatile LAS unsigned* st) {
    XcdBarrier b; b.bar = bar; b.x = xb_xcc_id(); b.st = st;
    if (threadIdx.x == 0) (void)xb_add(&bar[XB_XCNT(b.x)], 1u);
    return b;
}
__device__ __forceinline__ void xcd_barrier_complete(unsigned* bar, unsigned x, unsigned& nloc, unsigned& nx) {
    const unsigned G = gridDim.x * gridDim.y * gridDim.z;
    unsigned sum, cnt, mine, sp = 0u;
    for (;;) {
        sum = 0u; cnt = 0u; mine = 0u;
#pragma unroll
        for (unsigned j = 0; j < 16; ++j) { const unsigned c = xb_ld(&bar[XB_XCNT(j)]); sum += c; cnt += (c > 0u) ? 1u : 0u; mine = (j == x) ? c : mine; }
        if (sum == G) break;
        __builtin_amdgcn_s_sleep(1);
        if ((++sp & 255u) == 0u) { if (xb_ld(&bar[XB_TMO])) break; if (sp > XB_SPIN_CAP) { atomicAdd(&bar[XB_TMO], 1u); break; } }
    }
    nloc = mine > 0u ? mine : 1u; nx = cnt > 0u ? cnt : 1u;
}

__device__ __forceinline__ void xcd_barrier(const XcdBarrier& b) {
    asm volatile("s_waitcnt vmcnt(0)" ::: "memory");
    __syncthreads();
    if (threadIdx.x == 0) {
        unsigned* bar = b.bar;
        __builtin_amdgcn_s_waitcnt(0);
        unsigned nloc = b.st[0], nx = b.st[1];
        if (nloc == 0u) { xcd_barrier_complete(bar, b.x, nloc, nx); b.st[0] = nloc; b.st[1] = nx; }
        const unsigned old = xb_add(&bar[XB_XSUB(b.x)], 1u);
        const unsigned gen = old / nloc;
        if (old + 1u == (gen + 1u) * nloc) {
            __builtin_amdgcn_fence(__ATOMIC_RELEASE, "agent");
            asm volatile("s_waitcnt vmcnt(0)" ::: "memory");
            const unsigned og = xb_add(&bar[XB_TOP], 1u);
            const unsigned tg = og / nx;
            if (og + 1u == (tg + 1u) * nx) xb_add(&bar[XB_TOPGEN], 1u);
            else XB_SPIN(xb_ld(&bar[XB_TOPGEN]) == tg, bar);
            __builtin_amdgcn_fence(__ATOMIC_ACQUIRE, "agent");
            xb_add(&bar[XB_XGEN(b.x)], 1u);
            asm volatile("s_waitcnt vmcnt(0)" ::: "memory");
        } else {
            XB_SPIN(xb_ld(&bar[XB_XGEN(b.x)]) == gen, bar);
            __builtin_amdgcn_fence(__ATOMIC_ACQUIRE, "agent");
            asm volatile("s_waitcnt vmcnt(0)" ::: "memory");
        }
    }
    __syncthreads();
}

#ifdef REP_SYNC
#define GSYNC() do { xcd_barrier(xbar); xcd_barrier(xbar); } while (0)
#else
#define GSYNC() xcd_barrier(xbar)
#endif
#ifndef REP_P0
#define REP_P0 1
#endif
#ifndef REP_P1
#define REP_P1 1
#endif
#ifndef REP_P23
#define REP_P23 1
#endif
#ifndef REP_NORM
#define REP_NORM 1
#endif
__global__ void __launch_bounds__(NTHR, 2) mega_fwd(Args args) {
    extern __shared__ __attribute__((aligned(16))) unsigned char lds[];
    cg::grid_group grid = cg::this_grid();
    const int tid = threadIdx.x, lane = tid & 63, wave = __builtin_amdgcn_readfirstlane(tid >> 6);
    const int G = gridDim.x, bx = blockIdx.x; const int vcu = (G % 8 == 0) ? (bx % 8) * (G / 8) + bx / 8 : bx;
    const int gw = bx * NWAVES + wave, NGW = G * NWAVES;
    unsigned char* ws = args.ws;
    LAS unsigned char* ldsl = (LAS unsigned char*)lds;
    LAS float* ldsf = (LAS float*)lds;
    float* X = args.out;
    if (bx == 0) { for (int i = tid; i < XCD_BAR_WORDS; i += NTHR) ((unsigned*)ws)[i] = 0u; }
    if (tid < 2) ((volatile LAS unsigned*)(ldsl + RING_BYTES + 352))[tid] = 0u;
    __syncthreads();

    for (int rep_ = 0; rep_ < REP_P0; ++rep_) {
        if (rep_) { __syncthreads(); }
#ifndef SKIP_PREP
        if (bx < 64) { s5_prep(args, bx >> 4, bx & 15, ldsf, tid); }
#endif
        LAS float* scr = ldsf + wave * 4096;
        constexpr int I_IN = (DM / 64) * (NF / 32), I_O = (DM / 64) * (DM / 32), I_G = (256 / 64) * (256 / 32), I_L = I_IN + I_O + I_G;
        for (int it = gw; it < DEPTH * I_L; it += NGW) {
            const int l = it / I_L; int r = it % I_L;
            if (r < I_IN) { p0_transpose_item<true>(args.in[2] + (size_t)l * DM * NIN, DM, NIN, NF, (bf16*)(ws + WS_WIN) + (size_t)l * NF * DM, scr, r, lane); continue; } r -= I_IN;
            if (r < I_O) { p0_transpose_item<false>(args.in[14] + (size_t)l * DM * DM, DM, DM, DM, (bf16*)(ws + WS_WO) + (size_t)l * DM * DM, scr, r, lane); continue; } r -= I_O;
            p0_transpose_item<false>(args.in[12] + (size_t)l * 65536, 256, 256, 256, (bf16*)(ws + WS_WGLU) + (size_t)l * 65536, scr, r, lane);
        }
        f32x2* rope = (f32x2*)(ws + WS_ROPE);
        for (int i = bx * NTHR + tid; i < SEQ * 32; i += G * NTHR) { const int pos = i >> 5, fi = i & 31; const float freq = powf(10000.f, -(float)fi / 32.f); const float ang = (float)pos * freq; float sn, cs; sincosf(ang, &sn, &cs); rope[i] = (f32x2){cs, sn}; }
        __syncthreads();
        norm0_phase(args, lane, gw, NGW);
    }
    grid.sync();
    XcdBarrier xbar = xcd_barrier_post((unsigned*)ws, (volatile LAS unsigned*)(ldsl + RING_BYTES + 352));

#define PHASE_VARS int tid = threadIdx.x; asm volatile("" : "+v"(tid)); int bxl_ = blockIdx.x; asm volatile("" : "+s"(bxl_)); const int bx = bxl_; const int lane = tid & 63, wave = __builtin_amdgcn_readfirstlane(tid >> 6), gw = bx * NWAVES + wave; __attribute__((address_space(1))) unsigned char* wsg_ = (__attribute__((address_space(1))) unsigned char*)args.ws; asm volatile("" : "+s"(wsg_)); unsigned char* ws = (unsigned char*)wsg_; LAS unsigned char* ldsl = (LAS unsigned char*)lds; LAS float* ldsf = (LAS float*)lds; (void)lane; (void)wave; (void)gw; (void)ldsl; (void)ldsf
    for (int l = 0; l < DEPTH; ++l) {
        for (int rep_ = 0; rep_ < REP_P1; ++rep_) {
            PHASE_VARS;
            pg8::Gemm g{(const bf16*)(ws + WS_XN), (const bf16*)(ws + WS_WIN) + (size_t)l * NF * DM, M, NF, DM, DM, DM, 0, 0};
            pg8::StaticOrder S; S.init(M, NF, G, bx);
            EpiInProj E{ws, (const float*)(ws + WS_SS) + (size_t)(l & 1) * M, args.in[3] + (size_t)l * 8};
#ifndef SKIP_INPROJ
            pg8::gemm_phase<EpiInProj, pg8::StaticOrder, true, true>(ldsl, g, S, E);
#endif
        }
        GSYNC();
        for (int rep_ = 0; rep_ < REP_P23; ++rep_) {
            if (rep_) __syncthreads();
            PHASE_VARS;
            if (wave == 0) {
                const int g = bx >> 4, r = bx & 15, tm = r >> 1, tn = r & 1;
                WEpiE E{(float*)(ws + WS_E) + ((size_t)g * NCH5 + tm * 64) * 128 + tn * 64};
                wave_gemm64<16, 4, WEpiE>((const bf16*)(ws + WS_SUA) + ((size_t)g * NCH5 + tm * 64) * KA5, KA5, (const bf16*)(ws + WS_WB) + ((size_t)(l * 16 + g) * 128 + tn * 64) * 512, 512, lane, E);
            } else if (wave <= 4) {
                ret_upd_unit(ws, (wave - 1) * 256 + bx, lane);
            } else { const int idx = ((wave - 5) * 256 + bx) * 64 + lane; if (idx < M) ((float*)(ws + WS_SS))[(size_t)((l + 1) & 1) * M + idx] = 0.f; }
            __syncthreads();
            if (bx < 32) {
                const int bh = bx; const float* lf = (const float*)(ws + WS_LOGF) + (size_t)bh * SEQ; float* cb = (float*)(ws + WS_CB) + (size_t)bh * SEQ;
                const f32x4 a0 = *(const f32x4*)(lf + tid * 8), a1 = *(const f32x4*)(lf + tid * 8 + 4); float v[8] = {a0.x, a0.y, a0.z, a0.w, a1.x, a1.y, a1.z, a1.w};
#pragma unroll
                for (int e = 1; e < 8; ++e) v[e] += v[e - 1];
                float tot = v[7];
#pragma unroll
                for (int o = 1; o < 64; o <<= 1) { const float t = __shfl_up(tot, o); if (lane >= o) tot += t; }
                if (lane == 63) ldsf[wave] = tot;
                __syncthreads();
                float off = tot - v[7];
                for (int w = 0; w < wave; ++w) off += ldsf[w];
                f32x4 o0, o1; o0.x = -(v[0] + off) * LOG2E; o0.y = -(v[1] + off) * LOG2E; o0.z = -(v[2] + off) * LOG2E; o0.w = -(v[3] + off) * LOG2E; o1.x = -(v[4] + off) * LOG2E; o1.y = -(v[5] + off) * LOG2E; o1.z = -(v[6] + off) * LOG2E; o1.w = -(v[7] + off) * LOG2E;
                *(f32x4*)(cb + tid * 8) = o0; *(f32x4*)(cb + tid * 8 + 4) = o1;
            }
        }
        GSYNC();
        for (int rep_ = 0; rep_ < REP_P23; ++rep_) {
            if (rep_) __syncthreads();
            PHASE_VARS;
            if (bx < 64) {
                const int b = bx >> 4, g = bx & 15, p = tid & 63, seg = tid >> 6;
                const float* LAM = (const float*)(ws + WS_LAM) + (size_t)(l * 16 + g) * 128; const float lr = LAM[p], li = LAM[64 + p];
                const float* E = (const float*)(ws + WS_E) + ((size_t)g * NCH5 + b * 128 + seg * 16) * 128 + p;
                bf16* SA = (bf16*)(ws + WS_SUA) + ((size_t)g * NCH5 + b * 128 + seg * 16) * KA5 + 512 + p;
                float er[16], ei[16];
#pragma unroll
                for (int i = 0; i < 16; ++i) { er[i] = E[(size_t)i * 128]; ei[i] = E[(size_t)i * 128 + 64]; }
                float sr = 0.f, si = 0.f;
#pragma unroll
                for (int i = 0; i < 16; ++i) { const float nr = lr * sr - li * si + er[i], ni = lr * si + li * sr + ei[i]; sr = nr; si = ni; }
                LAS float* ends = ldsf;
                ends[(seg * 64 + p) * 2] = sr; ends[(seg * 64 + p) * 2 + 1] = si;
                float pr = lr, pi = li;
#pragma unroll
                for (int i = 0; i < 4; ++i) { const float nr = pr * pr - pi * pi, ni = 2.f * pr * pi; pr = nr; pi = ni; }
                __syncthreads();
                float cr = 0.f, ci = 0.f;
                for (int s2 = 0; s2 < seg; ++s2) { const float xr = ends[(s2 * 64 + p) * 2], xi = ends[(s2 * 64 + p) * 2 + 1]; const float nr = pr * cr - pi * ci + xr, ni = pr * ci + pi * cr + xi; cr = nr; ci = ni; }
#pragma unroll
                for (int i = 0; i < 16; ++i) { SA[(size_t)i * KA5] = f2bf(cr); SA[(size_t)i * KA5 + 64] = f2bf(ci); const float nr = lr * cr - li * ci + er[i], ni = lr * ci + li * cr + ei[i]; cr = nr; ci = ni; }
            } else if (bx < 192) {
                const int idx = (bx - 64) * NTHR + tid, bh = idx >> 12, e = idx & 4095; const float g64 = exp2f(lg2_gamma(bh & 3) * 64.f);
                const float* U = (const float*)(ws + WS_UPD) + (size_t)bh * 64 * 4096 + e; bf16* ST = (bf16*)(ws + WS_STATE) + (size_t)bh * 64 * 4096 + e;
                float st = 0.f;
#pragma unroll 8
                for (int c = 0; c < 64; ++c) { const float u = U[(size_t)c * 4096]; ST[(size_t)c * 4096] = f2bf(st); st = g64 * st + u; }
            }
        }
        GSYNC();
        {
            PHASE_VARS;
            if (wave < 4) ret_out_unit(args, l, wave * 256 + bx, lane);
            else {
                const int t = (wave - 4) * 256 + bx, g = t >> 6, r = t & 63, tm = r >> 3, tn = r & 7;
                const bf16* SUAg = (const bf16*)(ws + WS_SUA) + (size_t)g * NCH5 * KA5;
                WEpiS5Y E{SUAg, (bf16*)(ws + WS_YS5), args.in[10] + (size_t)l * 256 + g * 16, tm * 64, tn * 64, g};
                wave_gemm64<20, 4, WEpiS5Y>(SUAg + (size_t)(tm * 64) * KA5, KA5, (const bf16*)(ws + WS_MF) + ((size_t)(l * 16 + g) * 512 + tn * 64) * KA5, KA5, lane, E);
            }
            __syncthreads();
            const attn_body::AttnTensors AT{(const attn_body::bf16*)(ws + WS_QO), (const attn_body::bf16*)(ws + WS_KB), (const attn_body::bf16*)(ws + WS_VB), (attn_body::bf16*)(ws + WS_GATE), (const float*)(ws + WS_CB)};
            const attn_body::StaticOrder S(G, bx);
#ifdef REP_ATTN
            attn_body::attn_phase<attn_body::StaticOrder>((char*)lds, AT, S, opaque_true());
#endif
            attn_body::attn_phase<attn_body::StaticOrder>((char*)lds, AT, S);
        }
        GSYNC();
        {
            PHASE_VARS;
            if (wave < 4) {
                const int t = wave * 256 + bx, tm = t >> 2, tn = t & 3;
                WEpiGlu E{(const bf16*)(ws + WS_YS5), (bf16*)(ws + WS_GATE), tm * 64, tn * 64};
                wave_gemm64<8, 4, WEpiGlu>((const bf16*)(ws + WS_YS5) + (size_t)(tm * 64) * 256, 256, (const bf16*)(ws + WS_WGLU) + (size_t)l * 65536 + (size_t)(tn * 64) * 256, 256, lane, E);
            }
        }
        GSYNC();
        {
            PHASE_VARS;
            pg8::Gemm g{(const bf16*)(ws + WS_GATE), (const bf16*)(ws + WS_WO) + (size_t)l * DM * DM, M, DM, DM, DM, DM, 0, 0};
            pg8::StaticOrder S; S.init(M, DM, G, bx);
#ifdef REP_P6
            { EpiOut E0{l == 0 ? args.in[0] : X, X, (float*)(ws + WS_SS) + (size_t)((l + 1) & 1) * M, (bf16*)(ws + WS_XN), (l + 1 < DEPTH) ? args.in[1] + (size_t)(l + 1) * DM : nullptr, opaque_true()}; pg8::gemm_phase<EpiOut, pg8::StaticOrder, true, true>(ldsl, g, S, E0); }
#endif
            EpiOut E{l == 0 ? args.in[0] : X, X, (float*)(ws + WS_SS) + (size_t)((l + 1) & 1) * M, (bf16*)(ws + WS_XN), (l + 1 < DEPTH) ? args.in[1] + (size_t)(l + 1) * DM : nullptr, false};
            pg8::gemm_phase<EpiOut, pg8::StaticOrder, true, true>(ldsl, g, S, E);
        }
        GSYNC();
        if (l + 1 == DEPTH) { PHASE_VARS; final_norm(args, X, (const float*)(ws + WS_SS) + (size_t)((l + 1) & 1) * M, lane, gw, NGW); }
    }
}

extern "C" void kernel_launch(void* const* d_in, const int* in_sizes, int n_in, void* d_out, int out_size, void* d_ws, size_t ws_size, hipStream_t stream) {
    static int grid = 0;
    if (grid == 0) {
        if (n_in != 16 || ws_size < WS_END) { fprintf(stderr, "kernel_launch: unexpected n_in %d / ws %zu\n", n_in, ws_size); grid = -1; return; }
        int dev = 0, cus = 0, per_cu = 0;
        hipGetDevice(&dev); hipDeviceGetAttribute(&cus, hipDeviceAttributeMultiprocessorCount, dev);
        if (hipFuncSetAttribute((const void*)mega_fwd, hipFuncAttributeMaxDynamicSharedMemorySize, LDS_BYTES) != hipSuccess) { fprintf(stderr, "kernel_launch: hipFuncSetAttribute failed\n"); grid = -1; return; }
        if (hipOccupancyMaxActiveBlocksPerMultiprocessor(&per_cu, (const void*)mega_fwd, NTHR, LDS_BYTES) != hipSuccess || per_cu < 1) { fprintf(stderr, "kernel_launch: occupancy query failed (%d)\n", per_cu); grid = -1; return; }
        grid = cus;
        if (grid != 256) fprintf(stderr, "kernel_launch: note: %d CUs\n", grid);
    }
    if (grid < 0) return;
    Args a{};
    for (int i = 0; i < 16; ++i) a.in[i] = (const float*)d_in[i];
    a.out = (float*)d_out; a.ws = (unsigned char*)d_ws;
    void* kargs[] = {&a};
    hipError_t e = hipLaunchCooperativeKernel((const void*)mega_fwd, dim3(grid), dim3(NTHR), kargs, LDS_BYTES, stream);
    if (e != hipSuccess) fprintf(stderr, "kernel_launch: cooperative launch failed: %s\n", hipGetErrorString(e));
}
```

```cpp
#include <hip/hip_runtime.h>
#include <cstdio>
#include <cstdint>
namespace pg8 {
#define PG8_LAS __attribute__((address_space(3)))
typedef unsigned short bf16_t;
typedef short bf16x8 __attribute__((ext_vector_type(8)));
typedef float f32x4 __attribute__((ext_vector_type(4)));
typedef unsigned u32x4 __attribute__((ext_vector_type(4)));
constexpr int BM = 256, BK = 64, HALF = 128, HTB = HALF * BK * 2  , STAGE_BYTES = 8 * HTB, NXCD = 8, WGM = 8;

__host__ __device__ __forceinline__ int lds_byte(int r, int c) { const int st = (r >> 4) * 2 + (c >> 5), rr = r & 15, cc = c & 31, ob = rr * 64 + cc * 2; return st * 1024 + (ob ^ (((ob >> 9) & 1) << 5)); }
__host__ __device__ __forceinline__ void stage_rc(int b, int& R, int& C) { const int st = b / 1024, sb = b % 1024, swz = sb ^ (((sb >> 9) & 1) << 5); R = (st >> 1) * 16 + swz / 64; C = (st & 1) * 32 + (swz % 64) / 2; }
__host__ __device__ __forceinline__ int perm32(int rho) { const int n = rho >> 4, i = rho & 15; return 8 * (i >> 2) + 4 * n + (i & 3); }

struct Unit { int pm, pn, gz; };
struct Gemm { const bf16_t* A; const bf16_t* Bt; int M, N, K; int lda, ldb; size_t gsA, gsB; };

struct StaticOrder {
    int nM, nN, nwg, G, c;
    __host__ __device__ void init(int M, int N, int G_, int c_) { nM = M / BM; nN = N / BM; nwg = nM * nN; G = G_; c = c_; }
    __host__ __device__ bool next(int i, Unit& u) const {
        const long L = (long)i * G + c; if (L >= nwg) return false;
        int wgid = (int)L; { const int q = nwg / NXCD, r = nwg % NXCD, xcd = wgid % NXCD, off = wgid / NXCD; wgid = (xcd < r ? xcd * (q + 1) : r * (q + 1) + (xcd - r) * q) + off; }
        const int nig = WGM * nN, gid = wgid / nig, fm = gid * WGM, gsz = (nM - fm) < WGM ? (nM - fm) : WGM;
        u.pm = fm + ((wgid % nig) % gsz); u.pn = (wgid % nig) / gsz; u.gz = 0; return true;
    }
    __device__ __forceinline__ void a_ready(const Unit&) const {}
    __device__ __forceinline__ void done(const Unit&) const {}
};

__device__ __forceinline__ unsigned cvt_pk_bf16(float lo, float hi) { unsigned r; asm volatile("v_cvt_pk_bf16_f32 %0, %1, %2" : "=v"(r) : "v"(lo), "v"(hi)); return r; }
typedef float f32x2 __attribute__((ext_vector_type(2)));
__device__ __forceinline__ f32x2 gelu_pk(f32x2 v) {
    const f32x2 av = __builtin_elementwise_abs(v), d = av * 0.2316418882f + 1.0f;
    f32x2 t; t.x = __builtin_amdgcn_rcpf(d.x); t.y = __builtin_amdgcn_rcpf(d.y);
    f32x2 q = t * 0.5307027145f + (-0.7265760135f); q = q * t + 0.7107068705f; q = q * t + (-0.142248368f); q = q * t + 0.127414796f; q = q * t;
    const f32x2 s = (v * v) * (-0.72134752044f);
    f32x2 e; e.x = __builtin_amdgcn_exp2f(s.x); e.y = __builtin_amdgcn_exp2f(s.y);
    const f32x2 m = v * (q * e), r = v - m;
    f32x2 o; o.x = v.x < 0.f ? m.x : r.x; o.y = v.y < 0.f ? m.y : r.y; return o;
}

template <class Epi, class Sched, bool ALIGN_EPI = false, bool SP2 = false>
__device__ __forceinline__ void gemm_phase(PG8_LAS unsigned char* lds, const Gemm g, const Sched& S, const Epi& E) {
    int tid_ = threadIdx.x; asm volatile("" : "+v"(tid_));
    const int tid = tid_, wid = __builtin_amdgcn_readfirstlane(tid >> 6), lane = tid & 63, wr = wid >> 2, wc = wid & 3, fr = lane & 15, fq = lane >> 4;
    const int K = g.K, nt = K / BK;
    unsigned voffA[2], voffB[2];
#pragma unroll
    for (int i = 0; i < 2; ++i) { int R, C; stage_rc(tid * 16 + i * 8192, R, C); const int Rb = Epi::PERM ? ((R & ~31) + perm32(R & 31)) : R;
        voffA[i] = (unsigned)(R * g.lda + C) * 2u; voffB[i] = (unsigned)(Rb * g.ldb + C) * 2u; }
    const size_t kstep = (size_t)(BK * 2);
    const size_t hstepA = (size_t)HALF * g.lda * 2, hstepB = (size_t)HALF * g.ldb * 2;
    const size_t tstepA = 2 * hstepA, tstepB = 2 * hstepB;
    const unsigned ldsw = (unsigned)wid * 1024u;
    const int aoff = lds_byte(wr * 64 + fr, fq * 8), boff = lds_byte(wc * 32 + fr, fq * 8);
#define PG8_SA(b, h) (((b) * 2 + (h)) * HTB)
#define PG8_SB(b, h) ((4 + (b) * 2 + (h)) * HTB)
#define PG8_STAGE(bufoff, gbase, voff) do { _Pragma("unroll") for (int _i = 0; _i < 2; ++_i) \
        __builtin_amdgcn_global_load_lds((const unsigned*)((const char*)(gbase) + (voff)[_i]), (PG8_LAS unsigned*)(lds + (bufoff) + ldsw + _i * 8192), 16, 0, 0); } while (0)
#define PG8_LDA(dst, b, h) do { _Pragma("unroll") for (int m = 0; m < 4; ++m) _Pragma("unroll") for (int k = 0; k < 2; ++k) dst[m][k] = *(const PG8_LAS bf16x8*)(lds + PG8_SA(b, h) + aoff + m * 2048 + k * 1024); } while (0)
#define PG8_LDB(dst, b, h) do { _Pragma("unroll") for (int n = 0; n < 2; ++n) _Pragma("unroll") for (int k = 0; k < 2; ++k) dst[n][k] = *(const PG8_LAS bf16x8*)(lds + PG8_SB(b, h) + boff + n * 2048 + k * 1024); } while (0)
#define PG8_MMA(ai, bj, At, Bt) do { __builtin_amdgcn_s_setprio(1); _Pragma("unroll") for (int m = 0; m < 4; ++m) _Pragma("unroll") for (int n = 0; n < 2; ++n) _Pragma("unroll") for (int k = 0; k < 2; ++k) \
        acc[ai][bj][m][n] = __builtin_amdgcn_mfma_f32_16x16x32_bf16(Bt[n][k], At[m][k], acc[ai][bj][m][n], 0, 0, 0); __builtin_amdgcn_s_setprio(0); } while (0)
#define PG8_WAIT_V(n) asm volatile("s_waitcnt vmcnt(" #n ")" ::: "memory")
#define PG8_WAIT_L(n) asm volatile("s_waitcnt lgkmcnt(" #n ")" ::: "memory")
#define PG8_BAR __builtin_amdgcn_s_barrier()
#define PG8_SCHED __builtin_amdgcn_sched_barrier(0)
    Unit cur, nxt; int ui = 0;
    if (!S.next(0, cur)) return;
    f32x4 acc[2][2][4][2];
#pragma unroll
    for (int a = 0; a < 2; ++a)
#pragma unroll
        for (int b = 0; b < 2; ++b)
#pragma unroll
            for (int m = 0; m < 4; ++m)
#pragma unroll
                for (int n = 0; n < 2; ++n) acc[a][b][m][n] = (f32x4){0.f, 0.f, 0.f, 0.f};
    bf16x8 At[4][2], B0[2][2], B1[2][2];
    const char* cA = (const char*)g.A + (size_t)cur.gz * g.gsA * 2 + (size_t)cur.pm * tstepA; const char* cB = (const char*)g.Bt + (size_t)cur.gz * g.gsB * 2 + (size_t)cur.pn * tstepB;
    S.a_ready(cur);
    if constexpr (SP2) {
        PG8_STAGE(PG8_SB(0, 0), cB, voffB); PG8_STAGE(PG8_SB(0, 1), cB + hstepB, voffB); PG8_STAGE(PG8_SA(0, 0), cA, voffA); PG8_STAGE(PG8_SA(0, 1), cA + hstepA, voffA);
        if (wr == 1) PG8_BAR;
        PG8_WAIT_V(2); PG8_BAR;
        PG8_STAGE(PG8_SB(1, 0), cB + kstep, voffB); PG8_STAGE(PG8_SA(1, 0), cA + kstep, voffA); PG8_STAGE(PG8_SB(1, 1), cB + hstepB + kstep, voffB);
        PG8_WAIT_V(6); PG8_BAR;
    } else {
        PG8_STAGE(PG8_SB(0, 0), cB, voffB); PG8_STAGE(PG8_SA(0, 0), cA, voffA); PG8_STAGE(PG8_SB(0, 1), cB + hstepB, voffB); PG8_STAGE(PG8_SA(0, 1), cA + hstepA, voffA);
        if (wr == 1) PG8_BAR;
        PG8_WAIT_V(4); PG8_BAR;
        PG8_STAGE(PG8_SB(1, 0), cB + kstep, voffB); PG8_STAGE(PG8_SA(1, 0), cA + kstep, voffA); PG8_STAGE(PG8_SB(1, 1), cB + hstepB + kstep, voffB);
        PG8_WAIT_V(6); PG8_BAR;
    }
    for (;;) {
        const bool has_next = S.next(ui + 1, nxt);
        const char* nA = has_next ? (const char*)g.A + (size_t)nxt.gz * g.gsA * 2 + (size_t)nxt.pm * tstepA : cA; const char* nB = has_next ? (const char*)g.Bt + (size_t)nxt.gz * g.gsB * 2 + (size_t)nxt.pn * tstepB : cB;
        for (int t = 0; t < nt; t += 2) {
            const bool last = (t == nt - 2);
            const char* a1 = cA + (size_t)(t + 1) * kstep;
            const char* a2 = last ? nA : cA + (size_t)(t + 2) * kstep; const char* b2 = last ? nB : cB + (size_t)(t + 2) * kstep;
            const char* a3 = a2 + kstep; const char* b3 = b2 + kstep;
            if (last && has_next) S.a_ready(nxt);
            if constexpr (SP2) {
            PG8_LDB(B0, 0, 0); PG8_LDB(B1, 0, 1); PG8_SCHED; PG8_LDA(At, 0, 0); PG8_STAGE(PG8_SA(1, 1), a1 + hstepA, voffA);
            PG8_WAIT_V(8); PG8_WAIT_L(0); PG8_BAR; PG8_MMA(0, 0, At, B0); PG8_MMA(0, 1, At, B1); PG8_BAR; PG8_SCHED;
            PG8_LDA(At, 0, 1); PG8_STAGE(PG8_SB(0, 0), b2, voffB); PG8_STAGE(PG8_SB(0, 1), b2 + hstepB, voffB); PG8_STAGE(PG8_SA(0, 0), a2, voffA);
            PG8_WAIT_V(8); PG8_WAIT_L(0); PG8_BAR; PG8_MMA(1, 0, At, B0); PG8_MMA(1, 1, At, B1); PG8_BAR; PG8_SCHED;
            PG8_LDB(B0, 1, 0); PG8_LDB(B1, 1, 1); PG8_SCHED; PG8_LDA(At, 1, 0); PG8_STAGE(PG8_SA(0, 1), a2 + hstepA, voffA);
            PG8_WAIT_V(8); PG8_WAIT_L(0); PG8_BAR; PG8_MMA(0, 0, At, B0); PG8_MMA(0, 1, At, B1); PG8_BAR; PG8_SCHED;
            PG8_LDA(At, 1, 1); PG8_STAGE(PG8_SB(1, 0), b3, voffB); PG8_STAGE(PG8_SB(1, 1), b3 + hstepB, voffB); PG8_STAGE(PG8_SA(1, 0), a3, voffA);
            PG8_WAIT_V(8); PG8_WAIT_L(0); PG8_BAR; PG8_MMA(1, 0, At, B0); PG8_MMA(1, 1, At, B1); PG8_BAR; PG8_SCHED;
            } else {
            PG8_LDB(B0, 0, 0); PG8_SCHED; PG8_LDA(At, 0, 0); PG8_STAGE(PG8_SA(1, 1), a1 + hstepA, voffA);
            PG8_WAIT_L(8); PG8_BAR; PG8_WAIT_L(0); PG8_MMA(0, 0, At, B0); PG8_BAR; PG8_SCHED;
            PG8_LDB(B1, 0, 1); PG8_STAGE(PG8_SB(0, 0), b2, voffB);
            PG8_BAR; PG8_WAIT_L(0); PG8_MMA(0, 1, At, B1); PG8_BAR;
            PG8_LDA(At, 0, 1); PG8_STAGE(PG8_SA(0, 0), a2, voffA);
            PG8_BAR; PG8_WAIT_L(0); PG8_MMA(1, 0, At, B0); PG8_BAR; PG8_SCHED;
            PG8_STAGE(PG8_SB(0, 1), b2 + hstepB, voffB);
            PG8_WAIT_V(6); PG8_BAR; PG8_MMA(1, 1, At, B1); PG8_BAR;
            PG8_LDB(B0, 1, 0); PG8_SCHED; PG8_LDA(At, 1, 0); PG8_STAGE(PG8_SA(0, 1), a2 + hstepA, voffA);
            PG8_WAIT_L(8); PG8_BAR; PG8_WAIT_L(0); PG8_MMA(0, 0, At, B0); PG8_BAR; PG8_SCHED;
            PG8_LDB(B1, 1, 1); PG8_STAGE(PG8_SB(1, 0), b3, voffB);
            PG8_BAR; PG8_WAIT_L(0); PG8_MMA(0, 1, At, B1); PG8_BAR;
            PG8_LDA(At, 1, 1); PG8_STAGE(PG8_SA(1, 0), a3, voffA);
            PG8_BAR; PG8_WAIT_L(0); PG8_MMA(1, 0, At, B0); PG8_BAR; PG8_SCHED;
            PG8_STAGE(PG8_SB(1, 1), b3 + hstepB, voffB);
            PG8_WAIT_V(6); PG8_BAR; PG8_MMA(1, 1, At, B1); PG8_BAR;
            }
        }
        if constexpr (ALIGN_EPI) { if (wr == 0) PG8_BAR; }
        if constexpr (!Epi::AFTER_DRAIN) { E(acc, cur, wr, wc, fr, fq); S.done(cur); }
        if (!has_next) break;
#pragma unroll
        for (int a = 0; a < 2; ++a)
#pragma unroll
            for (int b = 0; b < 2; ++b)
#pragma unroll
                for (int m = 0; m < 4; ++m)
#pragma unroll
                    for (int n = 0; n < 2; ++n) acc[a][b][m][n] = (f32x4){0.f, 0.f, 0.f, 0.f};
        cur = nxt; cA = nA; cB = nB; ++ui;
        if constexpr (ALIGN_EPI) { if (wr == 1) PG8_BAR; }
    }
    PG8_WAIT_V(0);
    if constexpr (!ALIGN_EPI) { if (wr == 0) PG8_BAR; }
    PG8_BAR;
    if constexpr (Epi::AFTER_DRAIN) { E.fused(acc, cur, wr, wc, fr, fq, lds, wid, lane); S.done(cur); }
#undef PG8_SA
#undef PG8_SB
#undef PG8_STAGE
#undef PG8_LDA
#undef PG8_LDB
#undef PG8_MMA
#undef PG8_WAIT_V
#undef PG8_WAIT_L
#undef PG8_BAR
#undef PG8_SCHED
}
}
#include <hip/hip_bf16.h>
#include <cmath>
namespace attn_body {
using bf16=__hip_bfloat16;
using bf16x8=__attribute__((ext_vector_type(8)))short;
using s16x4=__attribute__((ext_vector_type(4)))short;
using f32x16=__attribute__((ext_vector_type(16)))float;
using u32x4=__attribute__((ext_vector_type(4)))unsigned;
using f32x4=__attribute__((ext_vector_type(4)))float;
constexpr int BATCH=4,NHEAD=8,SEQ=4096,D=64,DM=NHEAD*D,OPITCH=1024;
constexpr int NW=8,QBLK=32,QB=QBLK*NW,KVBLK=64,NQB=SEQ/QB;
constexpr int ATTN_PITCH=DM, ATTN_UNIT_ROWS=QB;
__device__ __forceinline__ int crow(int r,int hi){return (r&3)+8*(r>>2)+4*hi;}
#define SBAR() __builtin_amdgcn_sched_barrier(0)
__device__ __forceinline__ void cmask(f32x16&p0,f32x16&p1,int jb,int qrel,int hi){
  const float NEG=-INFINITY; int kb=64*jb+4*hi;
  #pragma unroll
  for(int r=0;r<16;++r){int kv=kb+(r&3)+8*(r>>2); if(kv>qrel)p0[r]=NEG; if(kv+32>qrel)p1[r]=NEG;}
}

constexpr int NSLOT=3, SLOTB=8192;
constexpr int LDS_K=0, LDS_V=NSLOT*SLOTB, LDS_WS=2*NSLOT*SLOTB, LDS_OST=LDS_WS+NW*64*4, LDS_CB=LDS_OST+NW*4096, LDS_BYTES=LDS_CB+SEQ*4;
constexpr float C2=0.125f*1.4426950408889634f;
__device__ __forceinline__ void glds16(const void*gsrc,unsigned lds_dst){unsigned keep;
  asm volatile("s_mov_b32 %0, m0\n\ts_mov_b32 m0, %2\n\ts_nop 0\n\tglobal_load_lds_dwordx4 %1, off\n\ts_mov_b32 m0, %0":"=&s"(keep):"v"(gsrc),"s"(lds_dst):"memory");}
__device__ __forceinline__ float max3f(float a,float b,float c){float r;asm("v_max3_f32 %0, %1, %2, %3":"=v"(r):"v"(a),"v"(b),"v"(c));return r;}
__device__ __forceinline__ float max2f(float a,float b){float r;asm("v_max_f32_e32 %0, %1, %2":"=v"(r):"v"(a),"v"(b));return r;}
__device__ __forceinline__ float fadd_s(float a,float b){float r;asm("v_add_f32_e32 %0, %1, %2":"=v"(r):"v"(a),"v"(b));return r;}
__device__ __forceinline__ float fsub_s(float a,float b){float r;asm("v_sub_f32_e32 %0, %1, %2":"=v"(r):"v"(a),"v"(b));return r;}
typedef float f32x2_t __attribute__((ext_vector_type(2))); typedef __bf16 bf16x2_t __attribute__((ext_vector_type(2)));
__device__ __forceinline__ unsigned cvtpk_s(float lo,float hi){f32x2_t v={lo,hi};bf16x2_t b=__builtin_convertvector(v,bf16x2_t);return __builtin_bit_cast(unsigned,b);}
#define WAIT_BAR(N) asm volatile("s_waitcnt vmcnt(" #N ") lgkmcnt(0)\n\ts_barrier":::"memory")

__device__ __forceinline__ void qkt(f32x16&p0,f32x16&p1,const char*Kslot,const bf16x8*qr,const char*cbt,int r32,int hi){
  const char*kb=Kslot+hi*1024+r32*16;
  #pragma unroll
  for(int a=0;a<4;++a){ const f32x4 u0=*reinterpret_cast<const f32x4*>(cbt+hi*16+a*32), u1=*reinterpret_cast<const f32x4*>(cbt+128+hi*16+a*32);
    p0[4*a]=u0[0];p0[4*a+1]=u0[1];p0[4*a+2]=u0[2];p0[4*a+3]=u0[3]; p1[4*a]=u1[0];p1[4*a+1]=u1[1];p1[4*a+2]=u1[2];p1[4*a+3]=u1[3]; }
  #pragma unroll
  for(int d0=0;d0<4;++d0){
    const bf16x8 b0=*reinterpret_cast<const bf16x8*>(kb+d0*2048);
    const bf16x8 b1=*reinterpret_cast<const bf16x8*>(kb+d0*2048+512);
    p0=__builtin_amdgcn_mfma_f32_32x32x16_bf16(b0,qr[d0],p0,0,0,0);p1=__builtin_amdgcn_mfma_f32_32x32x16_bf16(b1,qr[d0],p1,0,0,0);}
}
typedef __attribute__((address_space(3))) const char* lds_cptr;
typedef short v4i16_t __attribute__((ext_vector_type(4)));
__device__ __forceinline__ void kload8(bf16x8*kf,lds_cptr kp){
  kf[0]=*(const __attribute__((address_space(3))) bf16x8*)(kp);      kf[1]=*(const __attribute__((address_space(3))) bf16x8*)(kp+512);
  kf[2]=*(const __attribute__((address_space(3))) bf16x8*)(kp+2048); kf[3]=*(const __attribute__((address_space(3))) bf16x8*)(kp+2560);
  kf[4]=*(const __attribute__((address_space(3))) bf16x8*)(kp+4096); kf[5]=*(const __attribute__((address_space(3))) bf16x8*)(kp+4608);
  kf[6]=*(const __attribute__((address_space(3))) bf16x8*)(kp+6144); kf[7]=*(const __attribute__((address_space(3))) bf16x8*)(kp+6656);
}
__device__ __forceinline__ void kload2(bf16x8*kf,lds_cptr kp,int j){ kf[2*j]=*(const __attribute__((address_space(3))) bf16x8*)(kp+j*2048); kf[2*j+1]=*(const __attribute__((address_space(3))) bf16x8*)(kp+j*2048+512); }
__device__ __forceinline__ s16x4 vtr(lds_cptr p){ return __builtin_bit_cast(s16x4,__builtin_amdgcn_ds_read_tr16_b64_v4i16((__attribute__((address_space(3))) v4i16_t*)p)); }
__device__ __forceinline__ float rowmax(const f32x16&p0,const f32x16&p1){
  float a=max3f(p0[0],p0[1],p1[0]),b=max3f(p0[2],p0[3],p1[1]);a=max3f(a,p1[2],p1[3]);
  #pragma unroll
  for(int r=4;r<16;r+=4){a=max3f(a,p0[r],p0[r+1]);b=max3f(b,p0[r+2],p0[r+3]);a=max3f(a,p1[r],p1[r+1]);b=max3f(b,p1[r+2],p1[r+3]);}
  const float m=max2f(a,b);
  auto rr=__builtin_amdgcn_permlane32_swap(__float_as_uint(m),__float_as_uint(m),false,false);
  return max2f(__uint_as_float(rr[0]),__uint_as_float(rr[1]));
}
__device__ __forceinline__ void pv(f32x16*o,int vb,bf16x8 pa0,bf16x8 pa1,bf16x8 pa2,bf16x8 pa3){
  #pragma unroll
  for(int d0=0;d0<2;++d0){s16x4 lo[4],hi[4];
    #pragma unroll
    for(int ks=0;ks<4;++ks){
      asm volatile("ds_read_b64_tr_b16 %0,%1 offset:%c2":"=&v"(lo[ks]):"v"(vb),"i"(d0*4096+ks*1024):"memory");
      asm volatile("ds_read_b64_tr_b16 %0,%1 offset:%c2":"=&v"(hi[ks]):"v"(vb),"i"(d0*4096+ks*1024+512):"memory");}
    asm volatile("s_waitcnt lgkmcnt(0)":::"memory");SBAR();
    #define PK(k) (bf16x8){lo[k][0],lo[k][1],lo[k][2],lo[k][3],hi[k][0],hi[k][1],hi[k][2],hi[k][3]}
    o[d0]=__builtin_amdgcn_mfma_f32_32x32x16_bf16(pa0,PK(0),o[d0],0,0,0);
    o[d0]=__builtin_amdgcn_mfma_f32_32x32x16_bf16(pa1,PK(1),o[d0],0,0,0);
    o[d0]=__builtin_amdgcn_mfma_f32_32x32x16_bf16(pa2,PK(2),o[d0],0,0,0);
    o[d0]=__builtin_amdgcn_mfma_f32_32x32x16_bf16(pa3,PK(3),o[d0],0,0,0);
    #undef PK
  }
}

#ifndef ATTN_STORE16
#define ATTN_STORE16(p,v) (*(u32x4*)(p)=(v))
#endif
template<int THRL> __device__ __forceinline__ void attn_unit(int b,int h,int qb,const bf16*Q,const bf16*__restrict__ K,const bf16*__restrict__ V,bf16*O,const float*__restrict__ CB,char*shm,bool dry=false){
  int tid_=threadIdx.x; asm volatile("":"+v"(tid_)); const int tid=tid_,lane=tid&63,r32=lane&31,hi=lane>>5; const int wid=__builtin_amdgcn_readfirstlane(tid>>6);
  const long rowbase=(long)b*SEQ; const int q0=qb*QB;
  const bf16*Qw=Q+(rowbase+q0+wid*QBLK)*DM+h*D;
  const bf16*Kh=K+rowbase*DM+h*D,*Vh=V+rowbase*DM+h*D;
  const unsigned lds0=(unsigned)(uintptr_t)shm;
  float*wsf=(float*)(shm+LDS_WS)+wid*64;
  const bf16*ksrc=Kh+(long)lane*DM+wid*8;
  const bf16*vsrc=Vh+(long)(16*(wid&3)+(lane>>2))*DM+(wid>>2)*32+(lane&3)*8;
  const unsigned kdst=lds0+LDS_K+wid*1024, vdst=lds0+LDS_V+wid*1024;
  #define DMA_K(t,slot) glds16(ksrc+(long)(t)*KVBLK*DM,(unsigned)__builtin_amdgcn_readfirstlane(kdst+(slot)))
  #define DMA_V(t,slot) glds16(vsrc+(long)(t)*KVBLK*DM,(unsigned)__builtin_amdgcn_readfirstlane(vdst+(slot)))
  const int vb0=(int)(lds0+LDS_V)+((lane>>4)&1)*32+(lane&3)*8+(4*hi+((lane&15)>>2))*64;
  const char*Kbase=shm+LDS_K; bf16x8 kf[8];
  const lds_cptr shm3=(lds_cptr)shm; const lds_cptr kp0=shm3+LDS_K+hi*1024+r32*16; const lds_cptr vp0=shm3+LDS_V+((lane>>4)&1)*32+(lane&3)*8+(4*hi+((lane&15)>>2))*64;
  const int NT=(q0+QB)/KVBLK;
  { const f32x4* cbg=reinterpret_cast<const f32x4*>(CB+(long)(b*NHEAD+h)*SEQ); f32x4* cbl=reinterpret_cast<f32x4*>(shm+LDS_CB); const int nv=(q0+QB)/4;
    for(int i=tid;i<nv;i+=NW*64) cbl[i]=cbg[i];
    asm volatile("s_waitcnt vmcnt(0) lgkmcnt(0)\n\ts_barrier":::"memory"); }
  const lds_cptr cb3=(lds_cptr)shm+LDS_CB;
  const float cb_own=*(const __attribute__((address_space(3))) float*)(cb3+(q0+wid*QBLK+r32)*4);
  DMA_K(0,0);DMA_V(0,0);DMA_K(1,SLOTB);
  bf16x8 qr[4];
  #pragma unroll
  for(int d0=0;d0<4;++d0)qr[d0]=*reinterpret_cast<const bf16x8*>(&Qw[(long)r32*DM+d0*16+hi*8]);
  float mhat=0.f,l_reg=0.f;f32x16 o[2];o[0]=f32x16{};o[1]=f32x16{};
  const int qrel=wid*QBLK+r32;
  #define CMASK(P0,P1,t) do{int jb_=(t)-(NT-4); if(jb_>=0)cmask(P0,P1,jb_,qrel,hi);}while(0)
  bool resc=false;
  #define START(P0,P1) do{ const float rm=max2f(rowmax(P0,P1),cb_own); resc=false; \
    { const float dl=rm; mhat=fadd_s(mhat,dl); \
      _Pragma("unroll") for(int r=0;r<16;++r){P0[r]=fsub_s(P0[r],dl);P1[r]=fsub_s(P1[r],dl);} } \
    _Pragma("unroll") for(int r=0;r<16;++r)P0[r]=__builtin_amdgcn_exp2f(P0[r]); }while(0)
  #define RESC() do{ if(resc){ asm volatile("s_waitcnt lgkmcnt(0)":::"memory"); \
      _Pragma("unroll") for(int d_=0;d_<2;++d_) _Pragma("unroll") for(int r=0;r<16;++r)o[d_][r]*=wsf[crow(r,hi)]; } }while(0)
  f32x16 pA0,pA1,pB0,pB1;
  int sl_prev=0,sl_cur=0,sl_next=SLOTB;
  #define ROT() do{sl_prev=sl_cur;sl_cur=sl_next;sl_next=(sl_next==(NSLOT-1)*SLOTB)?0:sl_next+SLOTB;}while(0)
  DMA_K(2,2*SLOTB);
  WAIT_BAR(3);
  qkt(pA0,pA1,Kbase,qr,shm+LDS_CB,r32,hi);asm volatile("s_nop 15\n\ts_nop 7":"+v"(pA0),"+v"(pA1));CMASK(pA0,pA1,0);
  START(pA0,pA1);
  _Pragma("unroll") for(int r=0;r<16;++r)pA1[r]=__builtin_amdgcn_exp2f(pA1[r]);
  WAIT_BAR(0);
  DMA_K(3,0);DMA_V(1,SLOTB);
  ROT();
  kload8(kf,kp0+sl_cur);
  WAIT_BAR(2);
  s16x4 vlo[8],vhi[8]; u32x4 pw0,pw1,pw2,pw3;
  #define PKW(P,B) cvtpk_s(P[B],P[B+1])
  #define PAF(k) __builtin_bit_cast(bf16x8,pw##k)
  #define VFR(i) (bf16x8){vlo[i][0],vlo[i][1],vlo[i][2],vlo[i][3],vhi[i][0],vhi[i][1],vhi[i][2],vhi[i][3]}
  #define PIN(x) asm volatile("":"+v"(x))
  #define MX3(a,b,c) __builtin_fmaxf(__builtin_fmaxf((a),(b)),(c))
  #define GAPA(MF,A0,A1,A2,A3,W0,W1,PW) do{ MF; sacc+=A0; sacc+=A1; sacc+=A2; sacc+=A3; PIN(sacc); W0; W1; PIN(PW); SBAR(); }while(0)
  #define EX(v) __builtin_amdgcn_exp2f(v)
  #define GAPB(MF,X,B) do{ MF; X[B]=EX(X[B]); X[B+1]=EX(X[B+1]); X[B+2]=EX(X[B+2]); X[B+3]=EX(X[B+3]); PIN(X); SBAR(); }while(0)
  #define VRD(i) do{ vlo[i]=vtr(vp_+(((i)>>2)*4096+((i)&3)*1024)); vhi[i]=vtr(vp_+(((i)>>2)*4096+((i)&3)*1024+512)); }while(0)
  #define KRD(G,j) do{ if(G){ kload2(kf,kp0+sl_next,j); SBAR(); } }while(0)
  #define STEP(C0,C1,P0,P1,t,GK,GV,GL) do{ SBAR(); \
    { const __attribute__((address_space(3))) f32x4* cbp_=(const __attribute__((address_space(3))) f32x4*)(cb3+(t)*256+hi*16); \
      _Pragma("unroll") for(int a_=0;a_<4;++a_){ const f32x4 u0_=cbp_[2*a_], u1_=cbp_[8+2*a_]; \
        C0[4*a_]=u0_[0]-mhat;C0[4*a_+1]=u0_[1]-mhat;C0[4*a_+2]=u0_[2]-mhat;C0[4*a_+3]=u0_[3]-mhat; \
        C1[4*a_]=u1_[0]-mhat;C1[4*a_+1]=u1_[1]-mhat;C1[4*a_+2]=u1_[2]-mhat;C1[4*a_+3]=u1_[3]-mhat; } } SBAR(); \
    const lds_cptr vp_=vp0+sl_prev; \
    VRD(0); SBAR(); float sacc=(P0[0]+P0[1]); \
    GAPA(C0=__builtin_amdgcn_mfma_f32_32x32x16_bf16(kf[0],qr[0],C0,0,0,0), P0[2],P0[3],P0[4],P0[5],     pw0[0]=PKW(P0,0), pw0[1]=PKW(P0,2), pw0); \
    VRD(4); SBAR(); GAPA(C1=__builtin_amdgcn_mfma_f32_32x32x16_bf16(kf[1],qr[0],C1,0,0,0), P0[6],P0[7],P0[8],P0[9],     pw0[2]=PKW(P0,4), pw0[3]=PKW(P0,6), pw0); \
    VRD(1); SBAR(); GAPA(C0=__builtin_amdgcn_mfma_f32_32x32x16_bf16(kf[2],qr[1],C0,0,0,0),   P0[10],P0[11],P0[12],P0[13], pw1[0]=PKW(P0,8), pw1[1]=PKW(P0,10), pw1); \
    VRD(5); SBAR(); GAPA(C1=__builtin_amdgcn_mfma_f32_32x32x16_bf16(kf[3],qr[1],C1,0,0,0),   P0[14],P0[15],P1[0],P1[1],   pw1[2]=PKW(P0,12),pw1[3]=PKW(P0,14), pw1); \
    VRD(2); SBAR(); GAPA(C0=__builtin_amdgcn_mfma_f32_32x32x16_bf16(kf[4],qr[2],C0,0,0,0),   P1[2],P1[3],P1[4],P1[5],     pw2[0]=PKW(P1,0), pw2[1]=PKW(P1,2), pw2); \
    VRD(6); SBAR(); GAPA(C1=__builtin_amdgcn_mfma_f32_32x32x16_bf16(kf[5],qr[2],C1,0,0,0),   P1[6],P1[7],P1[8],P1[9],     pw2[2]=PKW(P1,4), pw2[3]=PKW(P1,6), pw2); \
    VRD(3); SBAR(); GAPA(C0=__builtin_amdgcn_mfma_f32_32x32x16_bf16(kf[6],qr[3],C0,0,0,0),   P1[10],P1[11],P1[12],P1[13], pw3[0]=PKW(P1,8), pw3[1]=PKW(P1,10), pw3); \
    VRD(7); SBAR(); GAPA(C1=__builtin_amdgcn_mfma_f32_32x32x16_bf16(kf[7],qr[3],C1,0,0,0),   P1[14],P1[15],0.f,0.f,       pw3[2]=PKW(P1,12),pw3[3]=PKW(P1,14), pw3); \
    l_reg+=sacc; \
    if(GK){DMA_K((t)+3,sl_cur);} if(GV){DMA_V((t)+1,sl_next);} \
    CMASK(C0,C1,t); \
    { float a=MX3(C0[0],C0[1],C1[0]),b=MX3(C0[2],C0[3],C1[1]); a=MX3(a,C1[2],C1[3]); \
      _Pragma("unroll") for(int r=4;r<16;r+=4){a=MX3(a,C0[r],C0[r+1]);b=MX3(b,C0[r+2],C0[r+3]);a=MX3(a,C1[r],C1[r+1]);b=MX3(b,C1[r+2],C1[r+3]);} \
      float rm=__builtin_fmaxf(a,b); { auto rr=__builtin_amdgcn_permlane32_swap(__float_as_uint(rm),__float_as_uint(rm),false,false); rm=__builtin_fmaxf(__uint_as_float(rr[0]),__uint_as_float(rr[1])); } \
      resc=false; \
      if(__builtin_expect(__any(rm>(float)THRL),0)){ const float dl=__builtin_fmaxf(rm,0.f); mhat+=dl; \
        _Pragma("unroll") for(int r=0;r<16;++r){C0[r]-=dl;C1[r]-=dl;} \
        const float f=__builtin_amdgcn_exp2f(-dl); l_reg*=f; if(hi==0)wsf[r32]=f; resc=true; } } \
    SBAR(); \
    GAPB(o[0]=__builtin_amdgcn_mfma_f32_32x32x16_bf16(PAF(0),VFR(0),o[0],0,0,0), C0,0); \
    GAPB(o[1]=__builtin_amdgcn_mfma_f32_32x32x16_bf16(PAF(0),VFR(4),o[1],0,0,0), C0,4); \
    KRD(GL,0); GAPB(o[0]=__builtin_amdgcn_mfma_f32_32x32x16_bf16(PAF(1),VFR(1),o[0],0,0,0), C0,8); \
    KRD(GL,1); GAPB(o[1]=__builtin_amdgcn_mfma_f32_32x32x16_bf16(PAF(1),VFR(5),o[1],0,0,0), C0,12); \
    KRD(GL,2); GAPB(o[0]=__builtin_amdgcn_mfma_f32_32x32x16_bf16(PAF(2),VFR(2),o[0],0,0,0), C1,0); \
    KRD(GL,3); GAPB(o[1]=__builtin_amdgcn_mfma_f32_32x32x16_bf16(PAF(2),VFR(6),o[1],0,0,0), C1,4); \
    GAPB(o[0]=__builtin_amdgcn_mfma_f32_32x32x16_bf16(PAF(3),VFR(3),o[0],0,0,0), C1,8); \
    GAPB(o[1]=__builtin_amdgcn_mfma_f32_32x32x16_bf16(PAF(3),VFR(7),o[1],0,0,0), C1,12); \
    }while(0)
  int t=1;
  #undef CMASK
  #define CMASK(P0,P1,t) do{}while(0)
  for(;t+5<NT;t+=2){
    STEP(pB0,pB1,pA0,pA1,t,true,true,true);     WAIT_BAR(2); RESC(); ROT();
    STEP(pA0,pA1,pB0,pB1,t+1,true,true,true);   WAIT_BAR(2); RESC(); ROT();
  }
  #undef CMASK
  #define CMASK(P0,P1,t) do{int jb_=(t)-(NT-4); if(jb_>=0)cmask(P0,P1,jb_,qrel,hi);}while(0)
  #define ENDW(tt) do{ if((tt)+3<NT){WAIT_BAR(2);} else if((tt)+2<NT){WAIT_BAR(1);} else {WAIT_BAR(0);} }while(0)
  for(;t+1<NT;t+=2){
    STEP(pB0,pB1,pA0,pA1,t,(t+3<NT),(t+1<NT),(t+1<NT));       ENDW(t);   RESC(); ROT();
    STEP(pA0,pA1,pB0,pB1,t+1,(t+4<NT),(t+2<NT),(t+2<NT));     ENDW(t+1); RESC(); ROT();
  }
  STEP(pB0,pB1,pA0,pA1,NT-1,false,false,false); RESC();
  { float sacc=pB0[0]+pB0[1]; _Pragma("unroll") for(int r=2;r<16;++r)sacc+=pB0[r]; _Pragma("unroll") for(int r=0;r<16;++r)sacc+=pB1[r]; l_reg+=sacc;
    pw0=(u32x4){PKW(pB0,0),PKW(pB0,2),PKW(pB0,4),PKW(pB0,6)};pw1=(u32x4){PKW(pB0,8),PKW(pB0,10),PKW(pB0,12),PKW(pB0,14)};pw2=(u32x4){PKW(pB1,0),PKW(pB1,2),PKW(pB1,4),PKW(pB1,6)};pw3=(u32x4){PKW(pB1,8),PKW(pB1,10),PKW(pB1,12),PKW(pB1,14)};
    SBAR(); pv(o,vb0+sl_cur,PAF(0),PAF(1),PAF(2),PAF(3)); }
  #undef PKW
  #undef PAF
  #undef VFR
  #undef PIN
  #undef MX3
  #undef GAPA
  #undef GAPB
  #undef EX
  #undef VRD
  #undef KRD
  #undef STEP
  #undef ENDW
  {auto rr=__builtin_amdgcn_permlane32_swap(__float_as_uint(l_reg),__float_as_uint(l_reg),false,false);l_reg=__uint_as_float(rr[0])+__uint_as_float(rr[1]);}
  if(hi==0)wsf[32+r32]=l_reg;asm volatile("s_waitcnt lgkmcnt(0)":::"memory");
  float rli[16];
  #pragma unroll
  for(int r=0;r<16;++r)rli[r]=__builtin_amdgcn_rcpf(wsf[32+crow(r,hi)]);
  bf16*Ow=O+(rowbase+q0+wid*QBLK)*OPITCH+h*D;
  { bf16*stg=(bf16*)(shm+LDS_OST)+wid*2048;
    #pragma unroll
    for(int r=0;r<16;++r){const int orow=crow(r,hi);
      #pragma unroll
      for(int d0=0;d0<2;++d0)stg[orow*64+d0*32+r32]=__float2bfloat16(o[d0][r]*rli[r]);}
    asm volatile("s_waitcnt lgkmcnt(0)":::"memory");
    #pragma unroll
    for(int i=0;i<4;++i){const int row=i*8+(lane>>3),ch=lane&7; const u32x4 v=*(const u32x4*)(stg+row*64+ch*8); bf16*dst=Ow+(long)row*OPITCH+ch*8; const u32x4 gv=*(const u32x4*)dst; u32x4 w;
      #pragma unroll
      for(int j=0;j<4;++j){ const float a0=__uint_as_float(v[j]<<16)*__uint_as_float(gv[j]<<16), a1=__uint_as_float(v[j]&0xffff0000u)*__uint_as_float(gv[j]&0xffff0000u); w[j]=cvtpk_s(a0,a1); }
      if(!dry)*(u32x4*)dst=w;} }
  asm volatile("s_waitcnt lgkmcnt(0)\n\ts_barrier":::"memory");
  #undef DMA_K
  #undef DMA_V
  #undef CMASK
  #undef START
  #undef RESC
  #undef ROT
}
constexpr int ATTN_LDS_BYTES=LDS_BYTES;
struct AttnTensors { const bf16* Q; const bf16* K; const bf16* V; bf16* O; const float* CB; };
struct AttnUnit { int bh; int qb; };
struct StaticOrder {
  int vcu;
  __device__ __forceinline__ explicit StaticOrder(int grid,int block):vcu((block%8)*(grid/8)+block/8){}
  __device__ __forceinline__ bool next(int i,AttnUnit&u)const{ if(i>=2)return false; const int s=vcu&7; u.bh=vcu>>3; u.qb=(i==0)?15-s:s; return true; }
  __device__ __forceinline__ void a_ready(const AttnUnit&)const{}
  __device__ __forceinline__ void done(const AttnUnit&)const{}
};
template<class Sched,int THRL=8> __device__ __forceinline__ void attn_phase(char*lds,const AttnTensors&T,const Sched&S,bool dry=false){
  AttnUnit u;
  for(int i=0;S.next(i,u);++i){ S.a_ready(u); attn_unit<THRL>(u.bh/NHEAD,u.bh%NHEAD,u.qb,T.Q,T.K,T.V,T.O,T.CB,lds,dry); S.done(u); }
}
#undef SBAR
#undef WAIT_BAR
}
#include <hip/hip_cooperative_groups.h>
namespace cg = cooperative_groups;
#define LAS __attribute__((address_space(3)))
typedef unsigned short bf16;
typedef float f32x4 __attribute__((ext_vector_type(4)));
typedef float f32x2 __attribute__((ext_vector_type(2)));
typedef unsigned u32x4 __attribute__((ext_vector_type(4)));
typedef unsigned u32x2 __attribute__((ext_vector_type(2)));
typedef short bf16x8 __attribute__((ext_vector_type(8)));
typedef short bf16x4 __attribute__((ext_vector_type(4)));

constexpr int NWAVES = 8, NTHR = 512;
constexpr int BATCH = 4, SEQ = 4096, DM = 1024, DEPTH = 4, M = BATCH * SEQ;
constexpr int NIN = 3592, NF = 3584;
constexpr int T5 = 32, NCH5 = M / T5, KA5 = 640, NG5 = 16;
constexpr float EPS = 1e-6f;
constexpr float LOG2E = 1.4426950408889634f;

constexpr size_t MiB = 1u << 20;
constexpr size_t WS_WIN = 1 * MiB, WS_WO = 31 * MiB, WS_WGLU = 39 * MiB, WS_ROPE = 40 * MiB, WS_MF = 41 * MiB, WS_WB = 81 * MiB;
constexpr size_t WS_LAM = 90 * MiB, WS_LOGF = 90 * MiB + 65536, WS_CB = WS_LOGF + 524288, WS_SS = WS_CB + 524288;
constexpr size_t WS_XN = 92 * MiB, WS_E = WS_XN, WS_UPD = WS_XN + 4 * MiB, WS_STATE = WS_XN + 20 * MiB;
constexpr size_t WS_QO = 124 * MiB, WS_KB = 140 * MiB, WS_VB = 156 * MiB, WS_SUA = 172 * MiB, WS_RQ = 182 * MiB, WS_RK = 190 * MiB, WS_RKT = 198 * MiB, WS_YS5 = WS_RKT;
constexpr size_t WS_RVT = 206 * MiB, WS_GATE = 214 * MiB, WS_END = 246 * MiB;

constexpr int RING_BYTES = 131072, LDS_BYTES = 147456;

struct Args { const float* in[16]; float* out; unsigned char* ws; };

__device__ __forceinline__ float bf2f(unsigned short b) { return __uint_as_float((unsigned)b << 16); }
__device__ __forceinline__ float bflo(unsigned w) { return __uint_as_float(w << 16); }
__device__ __forceinline__ float bfhi(unsigned w) { return __uint_as_float(w & 0xffff0000u); }
__device__ __forceinline__ unsigned pk2(float lo, float hi) { return pg8::cvt_pk_bf16(lo, hi); }
__device__ __forceinline__ unsigned short f2bf(float f) { return (unsigned short)(pg8::cvt_pk_bf16(f, 0.f) & 0xffffu); }
__device__ __forceinline__ float wave_sum(float v) {
#pragma unroll
    for (int o = 1; o < 64; o <<= 1) v += __shfl_xor(v, o);
    return v;
}
__device__ __forceinline__ float lg2_gamma(int hh) { return log2f(1.0f - exp2f(-5.0f - (float)hh)); }

__device__ __forceinline__ int win_col(int n) {
    if (n < 1536) return n;
    if (n < 1792) return n + 8;
    if (n < 2304) { const bool q = n < 2048; const int base = q ? 1792 : 2048; const int hh = (n - base) >> 6, pos = (n - base) & 63; const int d = (pos & 1) ? 32 + (pos >> 1) : (pos >> 1); return (q ? 1800 : 2056) + hh * 64 + d; }
    return n + 8;
}
template <bool MAP> __device__ __forceinline__ void p0_transpose_item(const float* W, int K, int Nsrc, int Ndst, bf16* WT, LAS float* scr, int item, int lane) {
    const int nblk = Ndst / 32, kb = item / nblk, nb = item % nblk, k0 = 64 * kb, n0 = 32 * nb;
    const int sc = MAP ? win_col(n0 + (lane & 31)) : n0 + (lane & 31);
#pragma unroll 8
    for (int i = 0; i < 32; ++i) { const int kk = 2 * i + (lane >> 5); scr[kk * 33 + (lane & 31)] = (MAP && sc < 0) ? 0.f : W[(size_t)(k0 + kk) * Nsrc + (sc < 0 ? 0 : sc)]; }
    asm volatile("s_waitcnt lgkmcnt(0)" ::: "memory");
    const int c = lane & 7;
#pragma unroll
    for (int j = 0; j < 4; ++j) { const int n = (lane >> 3) + 8 * j; const LAS float* s = scr + (8 * c) * 33 + n;
        u32x4 o; o.x = pk2(s[0 * 33], s[1 * 33]); o.y = pk2(s[2 * 33], s[3 * 33]); o.z = pk2(s[4 * 33], s[5 * 33]); o.w = pk2(s[6 * 33], s[7 * 33]);
        *(u32x4*)(WT + (size_t)(n0 + n) * K + k0 + 8 * c) = o; }
    asm volatile("s_waitcnt lgkmcnt(0)" ::: "memory");
}

__device__ __forceinline__ void s5_prep(const Args& a, int l, int g, LAS float* L, int tid) {
    LAS float* LPr = L;
    LAS float* LPi = L + 33 * 64;
    LAS float* Bbr = L + 66 * 64;
    LAS float* Bbi = Bbr + 1024;
    LAS float* Cr = Bbi + 1024;
    LAS float* Ci = Cr + 1024;
    LAS float* KT = Ci + 1024;
    const float* a_re = a.in[4] + (size_t)(l * 16 + g) * 64; const float* a_im = a.in[5] + (size_t)(l * 16 + g) * 64;
    const float* b_re = a.in[6] + (size_t)(l * 16 + g) * 1024; const float* b_im = a.in[7] + (size_t)(l * 16 + g) * 1024;
    const float* c_re = a.in[8] + (size_t)(l * 16 + g) * 1024; const float* c_im = a.in[9] + (size_t)(l * 16 + g) * 1024;
    const float log_dt = a.in[11][l * 16 + g];
    bf16* MF = (bf16*)(a.ws + WS_MF) + (size_t)(l * 16 + g) * 512 * KA5;
    bf16* WB = (bf16*)(a.ws + WS_WB) + (size_t)(l * 16 + g) * 128 * 512;
    float* LAM = (float*)(a.ws + WS_LAM) + (size_t)(l * 16 + g) * 128;
    if (tid < 64) {
        const int p = tid;
        const double dt = exp((double)log_dt), ar = (double)a_re[p], ai = (double)a_im[p];
        const double mag = exp(ar * dt); double sn, cs; sincos(ai * dt, &sn, &cs);
        const double lr = mag * cs, li = mag * sn, den = ar * ar + ai * ai;
        const double fr = ((lr - 1.0) * ar + li * ai) / den, fi = (li * ar - (lr - 1.0) * ai) / den;
#pragma unroll 4
        for (int h = 0; h < 16; ++h) { const double br = (double)b_re[p * 16 + h], bi = (double)b_im[p * 16 + h]; Bbr[p * 16 + h] = (float)(fr * br - fi * bi); Bbi[p * 16 + h] = (float)(fr * bi + fi * br); }
        double pr = 1.0, pi = 0.0;
        for (int j = 0; j <= 32; ++j) { LPr[j * 64 + p] = (float)pr; LPi[j * 64 + p] = (float)pi; const double nr = pr * lr - pi * li, ni = pr * li + pi * lr; pr = nr; pi = ni; }
        LAM[p] = LPr[32 * 64 + p]; LAM[64 + p] = LPi[32 * 64 + p];
    }
    for (int i = tid; i < 1024; i += NTHR) { const int h = i >> 6, p = i & 63; Cr[p * 16 + h] = c_re[i]; Ci[p * 16 + h] = c_im[i]; }
    __syncthreads();
    { const int j = tid >> 4, h = tid & 15; float acc[16];
#pragma unroll
      for (int e = 0; e < 16; ++e) acc[e] = 0.f;
      for (int p = 0; p < 64; ++p) { const float cr = Cr[p * 16 + h], ci = Ci[p * 16 + h], lr = LPr[j * 64 + p], li = LPi[j * 64 + p]; const float clr = cr * lr - ci * li, cli = cr * li + ci * lr;
#pragma unroll
          for (int q = 0; q < 4; ++q) { const f32x4 br = *(const LAS f32x4*)(Bbr + p * 16 + 4 * q), bi = *(const LAS f32x4*)(Bbi + p * 16 + 4 * q);
              acc[4 * q] += clr * br.x - cli * bi.x; acc[4 * q + 1] += clr * br.y - cli * bi.y; acc[4 * q + 2] += clr * br.z - cli * bi.z; acc[4 * q + 3] += clr * br.w - cli * bi.w; } }
#pragma unroll
      for (int e = 0; e < 16; ++e) KT[tid * 16 + e] = acc[e]; }
    __syncthreads();
    for (int q = tid; q < 512 * 64; q += NTHR) {
        const int row = q >> 6, cp = q & 63, s = cp >> 1, h0 = (cp & 1) * 8, t = row >> 4, h = row & 15;
        u32x4 o = (u32x4){0u, 0u, 0u, 0u};
        if (s <= t) { const LAS float* k = KT + ((t - s) * 16 + h) * 16 + h0; o.x = pk2(k[0], k[1]); o.y = pk2(k[2], k[3]); o.z = pk2(k[4], k[5]); o.w = pk2(k[6], k[7]); }
        *(u32x4*)(MF + (size_t)row * KA5 + cp * 8) = o;
    }
    for (int q = tid; q < 512 * 16; q += NTHR) {
        const int row = q >> 4, cp = q & 15, t = row >> 4, h = row & 15; float v[8];
#pragma unroll
        for (int e = 0; e < 8; ++e) { const int jj = cp * 8 + e, p = jj & 63; const float cr = Cr[p * 16 + h], ci = Ci[p * 16 + h], lr = LPr[(t + 1) * 64 + p], li = LPi[(t + 1) * 64 + p];
            v[e] = (jj < 64) ? (cr * lr - ci * li) : -(cr * li + ci * lr); }
        u32x4 o; o.x = pk2(v[0], v[1]); o.y = pk2(v[2], v[3]); o.z = pk2(v[4], v[5]); o.w = pk2(v[6], v[7]);
        *(u32x4*)(MF + (size_t)row * KA5 + 512 + cp * 8) = o;
    }
    for (int q = tid; q < 128 * 64; q += NTHR) {
        const int j = q >> 6, cp = q & 63, s = cp >> 1, h0 = (cp & 1) * 8, p = j & 63; const float lr = LPr[(31 - s) * 64 + p], li = LPi[(31 - s) * 64 + p]; float v[8];
#pragma unroll
        for (int e = 0; e < 8; ++e) { const float br = Bbr[p * 16 + h0 + e], bi = Bbi[p * 16 + h0 + e]; v[e] = (j < 64) ? (lr * br - li * bi) : (lr * bi + li * br); }
        u32x4 o; o.x = pk2(v[0], v[1]); o.y = pk2(v[2], v[3]); o.z = pk2(v[4], v[5]); o.w = pk2(v[6], v[7]);
        *(u32x4*)(WB + (size_t)j * 512 + cp * 8) = o;
    }
    __syncthreads();
}

__device__ __forceinline__ void norm0_phase(const Args& a, int lane, int gw, int NGW) {
    const float* X = a.in[0]; f32x4 gv[4];
#pragma unroll
    for (int j = 0; j < 4; ++j) gv[j] = *((const f32x4*)a.in[1] + lane + 64 * j);
    bf16* XN = (bf16*)(a.ws + WS_XN); float* SS = (float*)(a.ws + WS_SS);
    for (int m = gw; m < M; m += 2 * NGW) {
        const int m2 = m + NGW; const bool has2 = m2 < M;
        const f32x4* xr = (const f32x4*)(X + (size_t)m * DM) + lane; const f32x4* xr2 = (const f32x4*)(X + (size_t)(has2 ? m2 : m) * DM) + lane; f32x4 v[4], w[4];
#pragma unroll
        for (int j = 0; j < 4; ++j) { v[j] = xr[64 * j]; w[j] = xr2[64 * j]; }
        float ss = 0.f, ss2 = 0.f;
#pragma unroll
        for (int j = 0; j < 4; ++j) { ss += (v[j].x * v[j].x + v[j].y * v[j].y) + (v[j].z * v[j].z + v[j].w * v[j].w); ss2 += (w[j].x * w[j].x + w[j].y * w[j].y) + (w[j].z * w[j].z + w[j].w * w[j].w); }
        ss = wave_sum(ss); ss2 = wave_sum(ss2);
        unsigned long long* o8 = (unsigned long long*)(XN + (size_t)m * DM) + lane; unsigned long long* o82 = (unsigned long long*)(XN + (size_t)m2 * DM) + lane;
#pragma unroll
        for (int j = 0; j < 4; ++j) { v[j] = v[j] * gv[j]; o8[64 * j] = (unsigned long long)pk2(v[j].x, v[j].y) | ((unsigned long long)pk2(v[j].z, v[j].w) << 32);
            if (has2) { w[j] = w[j] * gv[j]; o82[64 * j] = (unsigned long long)pk2(w[j].x, w[j].y) | ((unsigned long long)pk2(w[j].z, w[j].w) << 32); } }
        if (lane == 0) { SS[m] = ss; if (has2) SS[m2] = ss2; }
    }
}
__device__ __forceinline__ void final_norm(const Args& a, float* X, const float* SS, int lane, int gw, int NGW) {
    f32x4 gv[4];
#pragma unroll
    for (int j = 0; j < 4; ++j) gv[j] = *((const f32x4*)a.in[15] + lane + 64 * j);
    for (int m = gw; m < M; m += 2 * NGW) {
        const int m2 = m + NGW; const bool has2 = m2 < M;
        f32x4* xr = (f32x4*)(X + (size_t)m * DM) + lane; f32x4* xr2 = (f32x4*)(X + (size_t)(has2 ? m2 : m) * DM) + lane; f32x4 v[4], w[4];
#pragma unroll
        for (int j = 0; j < 4; ++j) { v[j] = xr[64 * j]; w[j] = xr2[64 * j]; }
        const float r1 = rsqrtf(SS[m] * (1.f / DM) + EPS), r2 = rsqrtf(SS[has2 ? m2 : m] * (1.f / DM) + EPS);
#pragma unroll
        for (int j = 0; j < 4; ++j) { xr[64 * j] = v[j] * r1 * gv[j]; if (has2) xr2[64 * j] = w[j] * r2 * gv[j]; }
    }
}

__device__ __forceinline__ void flog_phase(const Args& a, int l, const float* SS, LAS float* WF, int tid, int lane, int wave, int blk, int nblk) {
    const float* win = a.in[2] + (size_t)l * DM * NIN;
    for (int i = tid; i < 2048; i += NTHR) { const int k = i >> 1, hf = i & 1; *(LAS f32x4*)(WF + k * 8 + hf * 4) = *(const f32x4*)(win + (size_t)k * NIN + 1536 + hf * 4); }
    __syncthreads();
    const bf16* XN = (const bf16*)(a.ws + WS_XN); float* LOGF = (float*)(a.ws + WS_LOGF);
    const float bfj = (lane < 8) ? a.in[3][l * 8 + lane] : 0.f;
    const int rows_per = M / nblk;
    for (int i = wave; i < rows_per; i += 2 * NWAVES) {
        const int m = blk * rows_per + i, m2 = m + NWAVES; const bool has2 = (i + NWAVES) < rows_per;
        const u32x4 x0 = *((const u32x4*)(XN + (size_t)m * DM) + lane), x1 = *((const u32x4*)(XN + (size_t)m * DM + 512) + lane);
        const u32x4 y0 = *((const u32x4*)(XN + (size_t)(has2 ? m2 : m) * DM) + lane), y1 = *((const u32x4*)(XN + (size_t)(has2 ? m2 : m) * DM + 512) + lane);
        float acc[8], acc2[8];
#pragma unroll
        for (int e = 0; e < 8; ++e) { acc[e] = 0.f; acc2[e] = 0.f; }
#pragma unroll
        for (int hf = 0; hf < 2; ++hf)
#pragma unroll
            for (int q = 0; q < 8; ++q) { const int k = 512 * hf + 8 * lane + q; const f32x4 w0 = *(const LAS f32x4*)(WF + k * 8), w1 = *(const LAS f32x4*)(WF + k * 8 + 4);
                const unsigned xw = hf ? x1[q >> 1] : x0[q >> 1], yw = hf ? y1[q >> 1] : y0[q >> 1]; const float hv = (q & 1) ? bfhi(xw) : bflo(xw), hv2 = (q & 1) ? bfhi(yw) : bflo(yw);
                acc[0] += hv * w0.x; acc[1] += hv * w0.y; acc[2] += hv * w0.z; acc[3] += hv * w0.w; acc[4] += hv * w1.x; acc[5] += hv * w1.y; acc[6] += hv * w1.z; acc[7] += hv * w1.w;
                acc2[0] += hv2 * w0.x; acc2[1] += hv2 * w0.y; acc2[2] += hv2 * w0.z; acc2[3] += hv2 * w0.w; acc2[4] += hv2 * w1.x; acc2[5] += hv2 * w1.y; acc2[6] += hv2 * w1.z; acc2[7] += hv2 * w1.w; }
        float mine = 0.f, mine2 = 0.f;
#pragma unroll
        for (int e = 0; e < 8; ++e) { const float s = wave_sum(acc[e]), s2 = wave_sum(acc2[e]); if (lane == e) { mine = s; mine2 = s2; } }
        if (lane < 8) { const float z = mine * rsqrtf(SS[m] * (1.f / DM) + EPS) + bfj; LOGF[(size_t)((m >> 12) * 8 + lane) * SEQ + (m & 4095)] = fminf(z, 0.f) - log1pf(expf(-fabsf(z)));
            if (has2) { const float z2 = mine2 * rsqrtf(SS[m2] * (1.f / DM) + EPS) + bfj; LOGF[(size_t)((m2 >> 12) * 8 + lane) * SEQ + (m2 & 4095)] = fminf(z2, 0.f) - log1pf(expf(-fabsf(z2))); } }
    }
}

__device__ __forceinline__ bool opaque_true() { int d = 1; asm volatile("" : "+s"(d)); return d != 0; }
struct FlatOrder {
    int nM, nN, nG, G, c;
    __device__ bool next(int i, pg8::Unit& u) const { const int L = i * G + c; if (L >= nG * nM * nN) return false; u.gz = L / (nM * nN); const int r = L % (nM * nN); u.pm = r % nM; u.pn = r / nM; return true; }
    __device__ __forceinline__ void a_ready(const pg8::Unit&) const {}
    __device__ __forceinline__ void done(const pg8::Unit&) const {}
};
__device__ __forceinline__ float silu_f(float v) { return v / (1.f + __expf(-v)); }
__device__ __forceinline__ float gelu_tanh(float v) { const float u = 0.7978845608028654f * (v + 0.044715f * v * v * v); const float e = __expf(2.f * u); const float th = 1.f - 2.f / (e + 1.f); return 0.5f * v * (1.f + th); }

struct EpiInProj {
    static constexpr bool PERM = true, AFTER_DRAIN = false;
    unsigned char* ws; const float* SS; const float* bfl;
    __device__ __forceinline__ void operator()(const pg8::f32x4 (&acc)[2][2][4][2], const pg8::Unit& u, int wr, int wc, int fr, int fq) const {
        const int pn = u.pn; const int row0 = u.pm * 256 + wr * 64 + fr, cl0 = wc * 32 + 8 * fq;
        float rs[2][4];
#pragma unroll
        for (int ai = 0; ai < 2; ++ai)
#pragma unroll
            for (int m = 0; m < 4; ++m) rs[ai][m] = rsqrtf(SS[row0 + ai * 128 + m * 16] * (1.f / DM) + EPS);
        if (pn == 14) {
            if (wc == 0 && fq == 0) { float* LOGF = (float*)(ws + WS_LOGF); const f32x4 b0 = *(const f32x4*)bfl, b1 = *(const f32x4*)(bfl + 4);
#pragma unroll
                for (int ai = 0; ai < 2; ++ai)
#pragma unroll
                    for (int m = 0; m < 4; ++m) { const int row = row0 + ai * 128 + m * 16; const float r = rs[ai][m]; const pg8::f32x4 v0 = acc[ai][0][m][0], v1 = acc[ai][0][m][1];
                        float z[8] = {v0[0] * r + b0.x, v0[1] * r + b0.y, v0[2] * r + b0.z, v0[3] * r + b0.w, v1[0] * r + b1.x, v1[1] * r + b1.y, v1[2] * r + b1.z, v1[3] * r + b1.w};
#pragma unroll
                        for (int e = 0; e < 8; ++e) LOGF[(size_t)((row >> 12) * 8 + e) * SEQ + (row & 4095)] = fminf(z[e], 0.f) - log1pf(__expf(-fabsf(z[e]))); } }
            return;
        }
        if (pn < 6) {
            bf16* base = (bf16*)(ws + (pn < 2 ? WS_QO : pn < 4 ? WS_KB : WS_VB)); const float sc = pn < 2 ? 0.125f * LOG2E : 1.f; const int cb = (pn & 1) * 256 + cl0;
#pragma unroll
            for (int ai = 0; ai < 2; ++ai)
#pragma unroll
                for (int m = 0; m < 4; ++m) { bf16* rp = base + (size_t)(row0 + ai * 128 + m * 16) * 512 + cb;
#pragma unroll
                    for (int bj = 0; bj < 2; ++bj) { const float sr = sc * rs[ai][m]; const pg8::f32x4 v0 = acc[ai][bj][m][0] * sr, v1 = acc[ai][bj][m][1] * sr; u32x4 w; w.x = pk2(v0[0], v0[1]); w.y = pk2(v0[2], v0[3]); w.z = pk2(v1[0], v1[1]); w.w = pk2(v1[2], v1[3]); *(u32x4*)(rp + bj * 128) = w; } }
        } else if (pn == 6) {
            bf16* base = (bf16*)(ws + WS_SUA);
#pragma unroll
            for (int ai = 0; ai < 2; ++ai)
#pragma unroll
                for (int m = 0; m < 4; ++m) { const int row = row0 + ai * 128 + m * 16, chunk = row >> 5, t = row & 31;
#pragma unroll
                    for (int bj = 0; bj < 2; ++bj) { const int c = cl0 + bj * 128, g = c >> 4, h0 = c & 15; const pg8::f32x4 v0 = acc[ai][bj][m][0] * rs[ai][m], v1 = acc[ai][bj][m][1] * rs[ai][m]; u32x4 w; w.x = pk2(v0[0], v0[1]); w.y = pk2(v0[2], v0[3]); w.z = pk2(v1[0], v1[1]); w.w = pk2(v1[2], v1[3]);
                        *(u32x4*)(base + ((size_t)(g * 512 + chunk) * KA5 + t * 16 + h0)) = w; } }
        } else if (pn == 7 || pn == 8) {
            const f32x4* rope = (const f32x4*)(ws + WS_ROPE); bf16* base = (bf16*)(ws + (pn == 7 ? WS_RQ : WS_RK)); bf16* RKT = (bf16*)(ws + WS_RKT);
#pragma unroll
            for (int ai = 0; ai < 2; ++ai)
#pragma unroll
                for (int m = 0; m < 4; ++m) { const int row = row0 + ai * 128 + m * 16, b = row >> 12, t = row & 4095;
#pragma unroll
                    for (int bj = 0; bj < 2; ++bj) { const int c = cl0 + bj * 128, hh = c >> 6, pos0 = c & 63; const pg8::f32x4 v0 = acc[ai][bj][m][0] * rs[ai][m], v1 = acc[ai][bj][m][1] * rs[ai][m];
                        const f32x4 r0 = rope[(t * 32 + (pos0 >> 1)) >> 1], r1 = rope[((t * 32 + (pos0 >> 1)) >> 1) + 1];
                        float o[8];
                        o[0] = v0[0] * r0.x - v0[1] * r0.y; o[1] = v0[0] * r0.y + v0[1] * r0.x; o[2] = v0[2] * r0.z - v0[3] * r0.w; o[3] = v0[2] * r0.w + v0[3] * r0.z;
                        o[4] = v1[0] * r1.x - v1[1] * r1.y; o[5] = v1[0] * r1.y + v1[1] * r1.x; o[6] = v1[2] * r1.z - v1[3] * r1.w; o[7] = v1[2] * r1.w + v1[3] * r1.z;
                        u32x4 w; w.x = pk2(o[0], o[1]); w.y = pk2(o[2], o[3]); w.z = pk2(o[4], o[5]); w.w = pk2(o[6], o[7]);
                        *(u32x4*)(base + (size_t)row * 256 + c) = w;
                        if (pn == 8) { const float wk = exp2f(lg2_gamma(hh) * (float)(63 - (t & 63))); bf16* tp = RKT + ((size_t)((b * 4 + hh) * 64 + pos0)) * SEQ + t;
#pragma unroll
                            for (int e = 0; e < 8; ++e) tp[(size_t)e * SEQ] = f2bf(o[e] * wk); } } }
        } else if (pn == 9) {
            bf16* RVT = (bf16*)(ws + WS_RVT);
#pragma unroll
            for (int ai = 0; ai < 2; ++ai)
#pragma unroll
                for (int m = 0; m < 4; ++m) { const int row = row0 + ai * 128 + m * 16, b = row >> 12, t = row & 4095;
#pragma unroll
                    for (int bj = 0; bj < 2; ++bj) { const int c = cl0 + bj * 128, hh = c >> 6, d0 = c & 63; const pg8::f32x4 v0 = acc[ai][bj][m][0] * rs[ai][m], v1 = acc[ai][bj][m][1] * rs[ai][m]; bf16* tp = RVT + ((size_t)((b * 4 + hh) * 64 + d0)) * SEQ + t;
#pragma unroll
                        for (int e = 0; e < 4; ++e) { tp[(size_t)e * SEQ] = f2bf(v0[e]); tp[(size_t)(4 + e) * SEQ] = f2bf(v1[e]); } } }
        } else {
            bf16* base = (bf16*)(ws + WS_GATE); const int cb = (pn - 10) * 256 + cl0;
#pragma unroll
            for (int ai = 0; ai < 2; ++ai)
#pragma unroll
                for (int m = 0; m < 4; ++m) { bf16* rp = base + (size_t)(row0 + ai * 128 + m * 16) * 1024 + cb;
#pragma unroll
                    for (int bj = 0; bj < 2; ++bj) { const pg8::f32x4 v0 = acc[ai][bj][m][0] * rs[ai][m], v1 = acc[ai][bj][m][1] * rs[ai][m]; u32x4 w; w.x = pk2(silu_f(v0[0]), silu_f(v0[1])); w.y = pk2(silu_f(v0[2]), silu_f(v0[3])); w.z = pk2(silu_f(v1[0]), silu_f(v1[1])); w.w = pk2(silu_f(v1[2]), silu_f(v1[3])); *(u32x4*)(rp + bj * 128) = w; } }
        }
    }
};
struct EpiS5E {
    static constexpr bool PERM = false, AFTER_DRAIN = false;
    float* E;
    __device__ __forceinline__ void operator()(const pg8::f32x4 (&acc)[2][2][4][2], const pg8::Unit& u, int wr, int wc, int fr, int fq) const {
        const int row0 = u.pm * 256 + wr * 64 + fr, col0 = wc * 32 + 4 * fq;
#pragma unroll
        for (int ai = 0; ai < 2; ++ai)
#pragma unroll
            for (int m = 0; m < 4; ++m) { float* rp = E + ((size_t)u.gz * NCH5 + row0 + ai * 128 + m * 16) * 128 + col0;
#pragma unroll
                for (int n = 0; n < 2; ++n) *(pg8::f32x4*)(rp + n * 16) = acc[ai][0][m][n]; }
    }
};
struct EpiS5Y {
    static constexpr bool PERM = true, AFTER_DRAIN = false;
    const bf16* SUA; bf16* YS5; const float* dvec;
    __device__ __forceinline__ void operator()(const pg8::f32x4 (&acc)[2][2][4][2], const pg8::Unit& u, int wr, int wc, int fr, int fq) const {
        const int row0 = u.pm * 256 + wr * 64 + fr, cl0 = u.pn * 256 + wc * 32 + 8 * fq; const int g = u.gz;
#pragma unroll
        for (int bj = 0; bj < 2; ++bj) { const int c = cl0 + bj * 128, tt = c >> 4, h0 = c & 15; const f32x4 d0 = *(const f32x4*)(dvec + g * 16 + h0), d1 = *(const f32x4*)(dvec + g * 16 + h0 + 4);
#pragma unroll
            for (int ai = 0; ai < 2; ++ai)
#pragma unroll
                for (int m = 0; m < 4; ++m) { const int chunk = row0 + ai * 128 + m * 16; const u32x4 uu = *(const u32x4*)(SUA + ((size_t)(g * 512 + chunk) * KA5 + c)); const pg8::f32x4 v0 = acc[ai][bj][m][0], v1 = acc[ai][bj][m][1];
                    float y[8]; y[0] = v0[0] + d0.x * bflo(uu.x); y[1] = v0[1] + d0.y * bfhi(uu.x); y[2] = v0[2] + d0.z * bflo(uu.y); y[3] = v0[3] + d0.w * bfhi(uu.y);
                    y[4] = v1[0] + d1.x * bflo(uu.z); y[5] = v1[1] + d1.y * bfhi(uu.z); y[6] = v1[2] + d1.z * bflo(uu.w); y[7] = v1[3] + d1.w * bfhi(uu.w);
#pragma unroll
                    for (int e = 0; e < 8; ++e) y[e] = gelu_tanh(y[e]);
                    u32x4 w; w.x = pk2(y[0], y[1]); w.y = pk2(y[2], y[3]); w.z = pk2(y[4], y[5]); w.w = pk2(y[6], y[7]);
                    *(u32x4*)(YS5 + (size_t)(chunk * 32 + tt) * 256 + g * 16 + h0) = w; } }
    }
};
struct EpiGlu {
    static constexpr bool PERM = true, AFTER_DRAIN = false;
    const bf16* YS5; bf16* G; bool dry;
    __device__ __forceinline__ void operator()(const pg8::f32x4 (&acc)[2][2][4][2], const pg8::Unit& u, int wr, int wc, int fr, int fq) const {
        const int row0 = u.pm * 256 + wr * 64 + fr, cl0 = wc * 32 + 8 * fq;
#pragma unroll
        for (int ai = 0; ai < 2; ++ai)
#pragma unroll
            for (int m = 0; m < 4; ++m) { const int row = row0 + ai * 128 + m * 16;
#pragma unroll
                for (int bj = 0; bj < 2; ++bj) { const int c = cl0 + bj * 128; const u32x4 yy = *(const u32x4*)(YS5 + (size_t)row * 256 + c); bf16* gp = G + (size_t)row * 1024 + 512 + c; const u32x4 gg = *(const u32x4*)gp;
                    const pg8::f32x4 v0 = acc[ai][bj][m][0], v1 = acc[ai][bj][m][1]; float s[8];
#pragma unroll
                    for (int e = 0; e < 4; ++e) { s[e] = 1.f / (1.f + __expf(-v0[e])); s[4 + e] = 1.f / (1.f + __expf(-v1[e])); }
                    u32x4 w; w.x = pk2(bflo(yy.x) * s[0] * bflo(gg.x), bfhi(yy.x) * s[1] * bfhi(gg.x)); w.y = pk2(bflo(yy.y) * s[2] * bflo(gg.y), bfhi(yy.y) * s[3] * bfhi(gg.y));
                    w.z = pk2(bflo(yy.z) * s[4] * bflo(gg.z), bfhi(yy.z) * s[5] * bfhi(gg.z)); w.w = pk2(bflo(yy.w) * s[6] * bflo(gg.w), bfhi(yy.w) * s[7] * bfhi(gg.w));
                    if (!dry) *(u32x4*)gp = w; } }
    }
};
struct EpiOut {
    static constexpr bool PERM = false, AFTER_DRAIN = false;
    const float* base; float* out; float* SSn; bf16* XN; const float* gnext; bool dry;
    __device__ __forceinline__ void operator()(const pg8::f32x4 (&acc)[2][2][4][2], const pg8::Unit& u, int wr, int wc, int fr, int fq) const {
        const int row0 = u.pm * 256 + wr * 64 + fr, col0 = u.pn * 256 + wc * 32 + 4 * fq;
        f32x4 gq[2][2];
#pragma unroll
        for (int bj = 0; bj < 2; ++bj)
#pragma unroll
            for (int n = 0; n < 2; ++n) gq[bj][n] = gnext ? *(const f32x4*)(gnext + col0 + bj * 128 + n * 16) : (f32x4){0.f, 0.f, 0.f, 0.f};
#pragma unroll
        for (int ai = 0; ai < 2; ++ai)
#pragma unroll
            for (int m = 0; m < 4; ++m) { const int row = row0 + ai * 128 + m * 16; const size_t off = (size_t)row * DM + col0; float sq = 0.f;
#pragma unroll
                for (int bj = 0; bj < 2; ++bj)
#pragma unroll
                    for (int n = 0; n < 2; ++n) { const f32x4 bs = *(const f32x4*)(base + off + bj * 128 + n * 16); const pg8::f32x4 v = acc[ai][bj][m][n]; const f32x4 x = (f32x4){bs.x + v[0], bs.y + v[1], bs.z + v[2], bs.w + v[3]};
                        sq += (x.x * x.x + x.y * x.y) + (x.z * x.z + x.w * x.w);
                        if (!dry) { *(f32x4*)(out + off + bj * 128 + n * 16) = x;
                            if (gnext) { const f32x4 g = gq[bj][n]; u32x2 w; w.x = pk2(x.x * g.x, x.y * g.y); w.y = pk2(x.z * g.z, x.w * g.w); *(u32x2*)(XN + off + bj * 128 + n * 16) = w; } } }
                sq += __shfl_xor(sq, 16); sq += __shfl_xor(sq, 32);
                if (fq == 0 && !dry) __hip_atomic_fetch_add(SSn + row, sq, __ATOMIC_RELAXED, __HIP_MEMORY_SCOPE_AGENT); }
    }
};

template <int KS, int UNR, class Epi> __device__ __forceinline__ void wave_gemm64(const bf16* A, int lda, const bf16* B, int ldb, int lane, const Epi& epi) {
    const int fr = lane & 15, fq = lane >> 4;
    pg8::f32x4 acc[4][4];
#pragma unroll
    for (int jb = 0; jb < 4; ++jb)
#pragma unroll
        for (int ib = 0; ib < 4; ++ib) acc[jb][ib] = (pg8::f32x4){0.f, 0.f, 0.f, 0.f};
    const bf16* ap = A + (size_t)fr * lda + 8 * fq; const bf16* bp = B + (size_t)fr * ldb + 8 * fq;
#pragma unroll UNR
    for (int ks = 0; ks < KS; ++ks) {
        bf16x8 af[4], bv[4];
#pragma unroll
        for (int ib = 0; ib < 4; ++ib) { af[ib] = *(const bf16x8*)(ap + (size_t)(16 * ib) * lda + 32 * ks); bv[ib] = *(const bf16x8*)(bp + (size_t)(16 * ib) * ldb + 32 * ks); }
#pragma unroll
        for (int jb = 0; jb < 4; ++jb)
#pragma unroll
            for (int ib = 0; ib < 4; ++ib) acc[jb][ib] = __builtin_amdgcn_mfma_f32_16x16x32_bf16(bv[jb], af[ib], acc[jb][ib], 0, 0, 0);
    }
    epi(acc, fr, fq);
}
struct WEpiE {
    float* E;
    __device__ __forceinline__ void operator()(const pg8::f32x4 (&acc)[4][4], int fr, int fq) const {
#pragma unroll
        for (int jb = 0; jb < 4; ++jb)
#pragma unroll
            for (int ib = 0; ib < 4; ++ib) *(pg8::f32x4*)(E + (size_t)(16 * ib + fr) * 128 + 16 * jb + 4 * fq) = acc[jb][ib];
    }
};
struct WEpiS5Y {
    const bf16* SUAg; bf16* YS5; const float* dg; int chunk0, col0, g;
    __device__ __forceinline__ void operator()(const pg8::f32x4 (&acc)[4][4], int fr, int fq) const {
#pragma unroll
        for (int jb = 0; jb < 4; ++jb) { const int col = col0 + 16 * jb + 4 * fq, tt = col >> 4, h0 = col & 15; const f32x4 d4 = *(const f32x4*)(dg + h0);
#pragma unroll
            for (int ib = 0; ib < 4; ++ib) { const int chunk = chunk0 + 16 * ib + fr; const u32x2 uu = *(const u32x2*)(SUAg + (size_t)chunk * KA5 + col); const pg8::f32x4 v = acc[jb][ib];
                const float y0 = gelu_tanh(v[0] + d4.x * bflo(uu.x)), y1 = gelu_tanh(v[1] + d4.y * bfhi(uu.x)), y2 = gelu_tanh(v[2] + d4.z * bflo(uu.y)), y3 = gelu_tanh(v[3] + d4.w * bfhi(uu.y));
                u32x2 w; w.x = pk2(y0, y1); w.y = pk2(y2, y3); *(u32x2*)(YS5 + (size_t)(chunk * 32 + tt) * 256 + g * 16 + h0) = w; } }
    }
};
struct WEpiGlu {
    const bf16* YS5; bf16* G; int row0, col0;
    __device__ __forceinline__ void operator()(const pg8::f32x4 (&acc)[4][4], int fr, int fq) const {
#pragma unroll
        for (int jb = 0; jb < 4; ++jb)
#pragma unroll
            for (int ib = 0; ib < 4; ++ib) { const int row = row0 + 16 * ib + fr, col = col0 + 16 * jb + 4 * fq; const u32x2 yy = *(const u32x2*)(YS5 + (size_t)row * 256 + col); bf16* gp = G + (size_t)row * 1024 + 512 + col; const u32x2 gg = *(const u32x2*)gp; const pg8::f32x4 v = acc[jb][ib];
                const float s0 = 1.f / (1.f + __expf(-v[0])), s1 = 1.f / (1.f + __expf(-v[1])), s2 = 1.f / (1.f + __expf(-v[2])), s3 = 1.f / (1.f + __expf(-v[3]));
                u32x2 w; w.x = pk2(bflo(yy.x) * s0 * bflo(gg.x), bfhi(yy.x) * s1 * bfhi(gg.x)); w.y = pk2(bflo(yy.y) * s2 * bflo(gg.y), bfhi(yy.y) * s3 * bfhi(gg.y)); *(u32x2*)gp = w; }
    }
};

__device__ __forceinline__ void ret_upd_unit(unsigned char* ws, int unit, int lane) {
    const int c = unit & 63, bh = unit >> 6; const int i16 = lane & 15, kq = lane >> 4;
    const bf16* KT = (const bf16*)(ws + WS_RKT) + (size_t)bh * 64 * SEQ + c * 64; const bf16* VT = (const bf16*)(ws + WS_RVT) + (size_t)bh * 64 * SEQ + c * 64;
    float* UPD = (float*)(ws + WS_UPD) + (size_t)unit * 4096;
    bf16x8 af[4][2], bfv[4][2];
#pragma unroll
    for (int ib = 0; ib < 4; ++ib)
#pragma unroll
        for (int ks = 0; ks < 2; ++ks) { af[ib][ks] = *(const bf16x8*)(KT + (size_t)(16 * ib + i16) * SEQ + 32 * ks + 8 * kq); bfv[ib][ks] = *(const bf16x8*)(VT + (size_t)(16 * ib + i16) * SEQ + 32 * ks + 8 * kq); }
#pragma unroll
    for (int ib = 0; ib < 4; ++ib)
#pragma unroll
        for (int jb = 0; jb < 4; ++jb) { pg8::f32x4 d = (pg8::f32x4){0.f, 0.f, 0.f, 0.f};
            d = __builtin_amdgcn_mfma_f32_16x16x32_bf16(af[ib][0], bfv[jb][0], d, 0, 0, 0); d = __builtin_amdgcn_mfma_f32_16x16x32_bf16(af[ib][1], bfv[jb][1], d, 0, 0, 0);
            *(pg8::f32x4*)(UPD + (size_t)(16 * jb + i16) * 64 + 16 * ib + 4 * kq) = d; }
}
__device__ __forceinline__ void ret_out_unit(const Args& a, int l, int unit, int lane, bool dry = false) {
    unsigned char* ws = a.ws;
    const int c = unit & 63, bh = unit >> 6, hh = bh & 3, b = bh >> 2; const int fr = lane & 15, fq = lane >> 4;
    const size_t t0 = (size_t)b * SEQ + c * 64;
    const bf16* RQ = (const bf16*)(ws + WS_RQ) + t0 * 256 + hh * 64; const bf16* RK = (const bf16*)(ws + WS_RK) + t0 * 256 + hh * 64;
    const bf16* VT = (const bf16*)(ws + WS_RVT) + (size_t)bh * 64 * SEQ + c * 64; const bf16* ST = (const bf16*)(ws + WS_STATE) + (size_t)unit * 4096;
    const float lg = lg2_gamma(hh);
    bf16x8 qf[4][2]; pg8::f32x4 st[4][4];
#pragma unroll
    for (int nb = 0; nb < 4; ++nb)
#pragma unroll
        for (int ks = 0; ks < 2; ++ks) qf[nb][ks] = *(const bf16x8*)(RQ + (size_t)(16 * nb + fr) * 256 + 32 * ks + 8 * fq);
#pragma unroll
    for (int mb = 0; mb < 4; ++mb) { bf16x8 k0 = *(const bf16x8*)(RK + (size_t)(16 * mb + fr) * 256 + 8 * fq), k1 = *(const bf16x8*)(RK + (size_t)(16 * mb + fr) * 256 + 32 + 8 * fq);
#pragma unroll
        for (int nb = 0; nb < 4; ++nb) { pg8::f32x4 d = (pg8::f32x4){0.f, 0.f, 0.f, 0.f};
            d = __builtin_amdgcn_mfma_f32_16x16x32_bf16(k0, qf[nb][0], d, 0, 0, 0); d = __builtin_amdgcn_mfma_f32_16x16x32_bf16(k1, qf[nb][1], d, 0, 0, 0);
#pragma unroll
            for (int r = 0; r < 4; ++r) { const int mm = 16 * mb + 4 * fq + r, nn = 16 * nb + fr; const int df = mm > nn ? mm - nn : nn - mm; d[r] *= 0.125f * exp2f(lg * (float)df); }
            st[mb][nb] = d; } }
    pg8::f32x4 o[4][4];
#pragma unroll
    for (int nb = 0; nb < 4; ++nb)
#pragma unroll
        for (int dvb = 0; dvb < 4; ++dvb) o[nb][dvb] = (pg8::f32x4){0.f, 0.f, 0.f, 0.f};
#pragma unroll
    for (int dvb = 0; dvb < 4; ++dvb) { const bf16x8 s0 = *(const bf16x8*)(ST + (size_t)(16 * dvb + fr) * 64 + 8 * fq), s1 = *(const bf16x8*)(ST + (size_t)(16 * dvb + fr) * 64 + 32 + 8 * fq);
#pragma unroll
        for (int nb = 0; nb < 4; ++nb) { o[nb][dvb] = __builtin_amdgcn_mfma_f32_16x16x32_bf16(qf[nb][0], s0, o[nb][dvb], 0, 0, 0); o[nb][dvb] = __builtin_amdgcn_mfma_f32_16x16x32_bf16(qf[nb][1], s1, o[nb][dvb], 0, 0, 0); } }
#pragma unroll
    for (int nb = 0; nb < 4; ++nb)
#pragma unroll
        for (int r = 0; r < 4; ++r) { const float wq = 0.125f * exp2f(lg * (float)(16 * nb + 4 * fq + r + 1));
#pragma unroll
            for (int dvb = 0; dvb < 4; ++dvb) o[nb][dvb][r] *= wq; }
#pragma unroll
    for (int s = 0; s < 2; ++s) {
        bf16x8 pa[4];
#pragma unroll
        for (int nb = 0; nb < 4; ++nb) { u32x4 w; w.x = pk2(st[2 * s][nb][0], st[2 * s][nb][1]); w.y = pk2(st[2 * s][nb][2], st[2 * s][nb][3]); w.z = pk2(st[2 * s + 1][nb][0], st[2 * s + 1][nb][1]); w.w = pk2(st[2 * s + 1][nb][2], st[2 * s + 1][nb][3]); pa[nb] = __builtin_bit_cast(bf16x8, w); }
#pragma unroll
        for (int dvb = 0; dvb < 4; ++dvb) { const u32x2 v0 = *(const u32x2*)(VT + (size_t)(16 * dvb + fr) * SEQ + 32 * s + 4 * fq), v1 = *(const u32x2*)(VT + (size_t)(16 * dvb + fr) * SEQ + 32 * s + 16 + 4 * fq);
            const bf16x8 vf = __builtin_bit_cast(bf16x8, (u32x4){v0.x, v0.y, v1.x, v1.y});
#pragma unroll
            for (int nb = 0; nb < 4; ++nb) o[nb][dvb] = __builtin_amdgcn_mfma_f32_16x16x32_bf16(pa[nb], vf, o[nb][dvb], 0, 0, 0); }
    }
    const float* gn = a.in[13] + (size_t)l * 256 + hh * 64; float gnw[4];
#pragma unroll
    for (int dvb = 0; dvb < 4; ++dvb) gnw[dvb] = gn[16 * dvb + fr];
    bf16* Y = (bf16*)(ws + WS_GATE) + t0 * 1024 + 768 + hh * 64;
#pragma unroll
    for (int nb = 0; nb < 4; ++nb)
#pragma unroll
        for (int r = 0; r < 4; ++r) { float s = (o[nb][0][r] + o[nb][1][r]) + (o[nb][2][r] + o[nb][3][r]);
            s += __shfl_xor(s, 1); s += __shfl_xor(s, 2); s += __shfl_xor(s, 4); s += __shfl_xor(s, 8);
            const float mu = s * (1.f / 64.f); float q = 0.f;
#pragma unroll
            for (int dvb = 0; dvb < 4; ++dvb) { const float d = o[nb][dvb][r] - mu; q += d * d; }
            q += __shfl_xor(q, 1); q += __shfl_xor(q, 2); q += __shfl_xor(q, 4); q += __shfl_xor(q, 8);
            const float rstd = rsqrtf(q * (1.f / 64.f) + EPS); bf16* yp = Y + (size_t)(16 * nb + 4 * fq + r) * 1024 + fr;
#pragma unroll
            for (int dvb = 0; dvb < 4; ++dvb) { const float gt = bf2f(yp[16 * dvb]); if (!dry) yp[16 * dvb] = f2bf((o[nb][dvb][r] - mu) * rstd * gnw[dvb] * gt); } }
}

#define XB_TMO      128
#define XB_XCNT(j)  (256  + 64 * (j))
#define XB_XSUB(j)  (1280 + 64 * (j))
#define XB_XGEN(j)  (2304 + 64 * (j))
#define XB_TOP      3328
#define XB_TOPGEN   3392
#define XCD_BAR_WORDS 3456
#define XB_SPIN_CAP (1u << 18)

__device__ __forceinline__ unsigned xb_ld(unsigned* p)              { return __hip_atomic_load(p, __ATOMIC_RELAXED, __HIP_MEMORY_SCOPE_AGENT); }
__device__ __forceinline__ unsigned xb_add(unsigned* p, unsigned v) { return __hip_atomic_fetch_add(p, v, __ATOMIC_RELAXED, __HIP_MEMORY_SCOPE_AGENT); }
__device__ __forceinline__ unsigned xb_xcc_id() { return (unsigned)__builtin_amdgcn_s_getreg((3 << 11) | 20) & 0xFu; }
#define XB_SPIN(cond, bar) do { unsigned _sp = 0; while (cond) { __builtin_amdgcn_s_sleep(1); \
    if ((++_sp & 255u) == 0u) { if (xb_ld(&(bar)[XB_TMO])) break; if (_sp > XB_SPIN_CAP) { atomicAdd(&(bar)[XB_TMO], 1u); break; } } } } while (0)

struct XcdBarrier {
    unsigned* bar; unsigned x;
    volatile LAS unsigned* st;
};

__device__ __forceinline__ XcdBarrier xcd_barrier_post(unsigned* bar, volatile LAS unsigned* st) {
    XcdBarrier b; b.bar = bar; b.x = xb_xcc_id(); b.st = st;
    if (threadIdx.x == 0) (void)xb_add(&bar[XB_XCNT(b.x)], 1u);
    return b;
}
__device__ __forceinline__ void xcd_barrier_complete(unsigned* bar, unsigned x, unsigned& nloc, unsigned& nx) {
    const unsigned G = gridDim.x * gridDim.y * gridDim.z;
    unsigned sum, cnt, mine, sp = 0u;
    for (;;) {
        sum = 0u; cnt = 0u; mine = 0u;
#pragma unroll
        for (unsigned j = 0; j < 16; ++j) { const unsigned c = xb_ld(&bar[XB_XCNT(j)]); sum += c; cnt += (c > 0u) ? 1u : 0u; mine = (j == x) ? c : mine; }
        if (sum == G) break;
        __builtin_amdgcn_s_sleep(1);
        if ((++sp & 255u) == 0u) { if (xb_ld(&bar[XB_TMO])) break; if (sp > XB_SPIN_CAP) { atomicAdd(&bar[XB_TMO], 1u); break; } }
    }
    nloc = mine > 0u ? mine : 1u; nx = cnt > 0u ? cnt : 1u;
}

__device__ __forceinline__ void xcd_barrier(const XcdBarrier& b) {
    asm volatile("s_waitcnt vmcnt(0)" ::: "memory");
    __syncthreads();
    if (threadIdx.x == 0) {
        unsigned* bar = b.bar;
        __builtin_amdgcn_s_waitcnt(0);
        unsigned nloc = b.st[0], nx = b.st[1];
        if (nloc == 0u) { xcd_barrier_complete(bar, b.x, nloc, nx); b.st[0] = nloc; b.st[1] = nx; }
        const unsigned old = xb_add(&bar[XB_XSUB(b.x)], 1u);
        const unsigned gen = old / nloc;
        if (old + 1u == (gen + 1u) * nloc) {
            __builtin_amdgcn_fence(__ATOMIC_RELEASE, "agent");
            asm volatile("s_waitcnt vmcnt(0)" ::: "memory");
            const unsigned og = xb_add(&bar[XB_TOP], 1u);
            const unsigned tg = og / nx;
            if (og + 1u == (tg + 1u) * nx) xb_add(&bar[XB_TOPGEN], 1u);
            else XB_SPIN(xb_ld(&bar[XB_TOPGEN]) == tg, bar);
            __builtin_amdgcn_fence(__ATOMIC_ACQUIRE, "agent");
            xb_add(&bar[XB_XGEN(b.x)], 1u);
            asm volatile("s_waitcnt vmcnt(0)" ::: "memory");
        } else {
            XB_SPIN(xb_ld(&bar[XB_XGEN(b.x)]) == gen, bar);
            __builtin_amdgcn_fence(__ATOMIC_ACQUIRE, "agent");
            asm volatile("s_waitcnt vmcnt(0)" ::: "memory");
        }
    }
    __syncthreads();
}

#ifdef REP_SYNC
#define GSYNC() do { xcd_barrier(xbar); xcd_barrier(xbar); } while (0)
#else
#define GSYNC() xcd_barrier(xbar)
#endif
#ifndef REP_P0
#define REP_P0 1
#endif
#ifndef REP_P1
#define REP_P1 1
#endif
#ifndef REP_P23
#define REP_P23 1
#endif
#ifndef REP_NORM
#define REP_NORM 1
#endif
__global__ void __launch_bounds__(NTHR, 2) mega_fwd(Args args) {
    extern __shared__ __attribute__((aligned(16))) unsigned char lds[];
    cg::grid_group grid = cg::this_grid();
    const int tid = threadIdx.x, lane = tid & 63, wave = __builtin_amdgcn_readfirstlane(tid >> 6);
    const int G = gridDim.x, bx = blockIdx.x; const int vcu = (G % 8 == 0) ? (bx % 8) * (G / 8) + bx / 8 : bx;
    const int gw = bx * NWAVES + wave, NGW = G * NWAVES;
    unsigned char* ws = args.ws;
    LAS unsigned char* ldsl = (LAS unsigned char*)lds;
    LAS float* ldsf = (LAS float*)lds;
    float* X = args.out;
    if (bx == 0) { for (int i = tid; i < XCD_BAR_WORDS; i += NTHR) ((unsigned*)ws)[i] = 0u; }
    if (tid < 2) ((volatile LAS unsigned*)(ldsl + RING_BYTES + 352))[tid] = 0u;
    __syncthreads();

    for (int rep_ = 0; rep_ < REP_P0; ++rep_) {
        if (rep_) { __syncthreads(); }
#ifndef SKIP_PREP
        if (bx < 64) { s5_prep(args, bx >> 4, bx & 15, ldsf, tid); }
#endif
        LAS float* scr = ldsf + wave * 4096;
        constexpr int I_IN = (DM / 64) * (NF / 32), I_O = (DM / 64) * (DM / 32), I_G = (256 / 64) * (256 / 32), I_L = I_IN + I_O + I_G;
        for (int it = (bx < 64 ? DEPTH * I_L : (bx - 64) * NWAVES + wave); it < DEPTH * I_L; it += (G - 64) * NWAVES) {
            const int l = it / I_L; int r = it % I_L;
            if (r < I_IN) { p0_transpose_item<true>(args.in[2] + (size_t)l * DM * NIN, DM, NIN, NF, (bf16*)(ws + WS_WIN) + (size_t)l * NF * DM, scr, r, lane); continue; } r -= I_IN;
            if (r < I_O) { p0_transpose_item<false>(args.in[14] + (size_t)l * DM * DM, DM, DM, DM, (bf16*)(ws + WS_WO) + (size_t)l * DM * DM, scr, r, lane); continue; } r -= I_O;
            p0_transpose_item<false>(args.in[12] + (size_t)l * 65536, 256, 256, 256, (bf16*)(ws + WS_WGLU) + (size_t)l * 65536, scr, r, lane);
        }
        f32x2* rope = (f32x2*)(ws + WS_ROPE);
        for (int i = bx * NTHR + tid; i < SEQ * 32; i += G * NTHR) { const int pos = i >> 5, fi = i & 31; const float freq = powf(10000.f, -(float)fi / 32.f); const float ang = (float)pos * freq; float sn, cs; sincosf(ang, &sn, &cs); rope[i] = (f32x2){cs, sn}; }
        __syncthreads();
        norm0_phase(args, lane, gw, NGW);
    }
    grid.sync();
    XcdBarrier xbar = xcd_barrier_post((unsigned*)ws, (volatile LAS unsigned*)(ldsl + RING_BYTES + 352));

#define PHASE_VARS int tid = threadIdx.x; asm volatile("" : "+v"(tid)); int bxl_ = blockIdx.x; asm volatile("" : "+s"(bxl_)); const int bx = bxl_; const int lane = tid & 63, wave = __builtin_amdgcn_readfirstlane(tid >> 6), gw = bx * NWAVES + wave; __attribute__((address_space(1))) unsigned char* wsg_ = (__attribute__((address_space(1))) unsigned char*)args.ws; asm volatile("" : "+s"(wsg_)); unsigned char* ws = (unsigned char*)wsg_; LAS unsigned char* ldsl = (LAS unsigned char*)lds; LAS float* ldsf = (LAS float*)lds; (void)lane; (void)wave; (void)gw; (void)ldsl; (void)ldsf
    for (int l = 0; l < DEPTH; ++l) {
        for (int rep_ = 0; rep_ < REP_P1; ++rep_) {
            PHASE_VARS;
            pg8::Gemm g{(const bf16*)(ws + WS_XN), (const bf16*)(ws + WS_WIN) + (size_t)l * NF * DM, M, NF, DM, DM, DM, 0, 0};
            pg8::StaticOrder S; S.init(M, NF, G, bx);
            EpiInProj E{ws, (const float*)(ws + WS_SS) + (size_t)(l & 1) * M, args.in[3] + (size_t)l * 8};
            pg8::gemm_phase<EpiInProj, pg8::StaticOrder, true, true>(ldsl, g, S, E);
            if (bx >= G / 2) flog_phase(args, l, (const float*)(ws + WS_SS) + (size_t)(l & 1) * M, ldsf, tid, lane, wave, bx - G / 2, G / 2);
        }
        GSYNC();
        for (int rep_ = 0; rep_ < REP_P23; ++rep_) {
            if (rep_) __syncthreads();
            PHASE_VARS;
            if (wave == 0) {
                const int g = bx >> 4, r = bx & 15, tm = r >> 1, tn = r & 1;
                WEpiE E{(float*)(ws + WS_E) + ((size_t)g * NCH5 + tm * 64) * 128 + tn * 64};
                wave_gemm64<16, 4, WEpiE>((const bf16*)(ws + WS_SUA) + ((size_t)g * NCH5 + tm * 64) * KA5, KA5, (const bf16*)(ws + WS_WB) + ((size_t)(l * 16 + g) * 128 + tn * 64) * 512, 512, lane, E);
            } else if (wave <= 4) {
                ret_upd_unit(ws, (wave - 1) * 256 + bx, lane);
            } else { const int idx = ((wave - 5) * 256 + bx) * 64 + lane; if (idx < M) ((float*)(ws + WS_SS))[(size_t)((l + 1) & 1) * M + idx] = 0.f; }
            __syncthreads();
            if (bx < 32) {
                const int bh = bx; const float* lf = (const float*)(ws + WS_LOGF) + (size_t)bh * SEQ; float* cb = (float*)(ws + WS_CB) + (size_t)bh * SEQ;
                const f32x4 a0 = *(const f32x4*)(lf + tid * 8), a1 = *(const f32x4*)(lf + tid * 8 + 4); float v[8] = {a0.x, a0.y, a0.z, a0.w, a1.x, a1.y, a1.z, a1.w};
#pragma unroll
                for (int e = 1; e < 8; ++e) v[e] += v[e - 1];
                float tot = v[7];
#pragma unroll
                for (int o = 1; o < 64; o <<= 1) { const float t = __shfl_up(tot, o); if (lane >= o) tot += t; }
                if (lane == 63) ldsf[wave] = tot;
                __syncthreads();
                float off = tot - v[7];
                for (int w = 0; w < wave; ++w) off += ldsf[w];
                f32x4 o0, o1; o0.x = -(v[0] + off) * LOG2E; o0.y = -(v[1] + off) * LOG2E; o0.z = -(v[2] + off) * LOG2E; o0.w = -(v[3] + off) * LOG2E; o1.x = -(v[4] + off) * LOG2E; o1.y = -(v[5] + off) * LOG2E; o1.z = -(v[6] + off) * LOG2E; o1.w = -(v[7] + off) * LOG2E;
                *(f32x4*)(cb + tid * 8) = o0; *(f32x4*)(cb + tid * 8 + 4) = o1;
            }
        }
        GSYNC();
        for (int rep_ = 0; rep_ < REP_P23; ++rep_) {
            if (rep_) __syncthreads();
            PHASE_VARS;
            if (bx < 64) {
                const int b = bx >> 4, g = bx & 15, p = tid & 63, seg = tid >> 6;
                const float* LAM = (const float*)(ws + WS_LAM) + (size_t)(l * 16 + g) * 128; const float lr = LAM[p], li = LAM[64 + p];
                const float* E = (const float*)(ws + WS_E) + ((size_t)g * NCH5 + b * 128 + seg * 16) * 128 + p;
                bf16* SA = (bf16*)(ws + WS_SUA) + ((size_t)g * NCH5 + b * 128 + seg * 16) * KA5 + 512 + p;
                float er[16], ei[16];
#pragma unroll
                for (int i = 0; i < 16; ++i) { er[i] = E[(size_t)i * 128]; ei[i] = E[(size_t)i * 128 + 64]; }
                float sr = 0.f, si = 0.f;
#pragma unroll
                for (int i = 0; i < 16; ++i) { const float nr = lr * sr - li * si + er[i], ni = lr * si + li * sr + ei[i]; sr = nr; si = ni; }
                LAS float* ends = ldsf;
                ends[(seg * 64 + p) * 2] = sr; ends[(seg * 64 + p) * 2 + 1] = si;
                float pr = lr, pi = li;
#pragma unroll
                for (int i = 0; i < 4; ++i) { const float nr = pr * pr - pi * pi, ni = 2.f * pr * pi; pr = nr; pi = ni; }
                __syncthreads();
                float cr = 0.f, ci = 0.f;
                for (int s2 = 0; s2 < seg; ++s2) { const float xr = ends[(s2 * 64 + p) * 2], xi = ends[(s2 * 64 + p) * 2 + 1]; const float nr = pr * cr - pi * ci + xr, ni = pr * ci + pi * cr + xi; cr = nr; ci = ni; }
#pragma unroll
                for (int i = 0; i < 16; ++i) { SA[(size_t)i * KA5] = f2bf(cr); SA[(size_t)i * KA5 + 64] = f2bf(ci); const float nr = lr * cr - li * ci + er[i], ni = lr * ci + li * cr + ei[i]; cr = nr; ci = ni; }
            } else if (bx < 192) {
                const int idx = (bx - 64) * NTHR + tid, bh = idx >> 12, e = idx & 4095; const float g64 = exp2f(lg2_gamma(bh & 3) * 64.f);
                const float* U = (const float*)(ws + WS_UPD) + (size_t)bh * 64 * 4096 + e; bf16* ST = (bf16*)(ws + WS_STATE) + (size_t)bh * 64 * 4096 + e;
                float st = 0.f;
                float uu[64];
#pragma unroll
                for (int c = 0; c < 64; ++c) uu[c] = U[(size_t)c * 4096];
#pragma unroll
                for (int c = 0; c < 64; ++c) { ST[(size_t)c * 4096] = f2bf(st); st = g64 * st + uu[c]; }
            }
        }
        GSYNC();
        {
            PHASE_VARS;
            if (wave < 4) ret_out_unit(args, l, wave * 256 + bx, lane);
            else {
                const int t = (wave - 4) * 256 + bx, g = t >> 6, r = t & 63, tm = r >> 3, tn = r & 7;
                const bf16* SUAg = (const bf16*)(ws + WS_SUA) + (size_t)g * NCH5 * KA5;
                WEpiS5Y E{SUAg, (bf16*)(ws + WS_YS5), args.in[10] + (size_t)l * 256 + g * 16, tm * 64, tn * 64, g};
                wave_gemm64<20, 4, WEpiS5Y>(SUAg + (size_t)(tm * 64) * KA5, KA5, (const bf16*)(ws + WS_MF) + ((size_t)(l * 16 + g) * 512 + tn * 64) * KA5, KA5, lane, E);
            }
            __syncthreads();
            const attn_body::AttnTensors AT{(const attn_body::bf16*)(ws + WS_QO), (const attn_body::bf16*)(ws + WS_KB), (const attn_body::bf16*)(ws + WS_VB), (attn_body::bf16*)(ws + WS_GATE), (const float*)(ws + WS_CB)};
            const attn_body::StaticOrder S(G, bx);
#ifdef REP_ATTN
            attn_body::attn_phase<attn_body::StaticOrder>((char*)lds, AT, S, opaque_true());
#endif
            attn_body::attn_phase<attn_body::StaticOrder>((char*)lds, AT, S);
        }
        GSYNC();
        {
            PHASE_VARS;
            if (wave < 4) {
                const int t = wave * 256 + bx, tm = t >> 2, tn = t & 3;
                WEpiGlu E{(const bf16*)(ws + WS_YS5), (bf16*)(ws + WS_GATE), tm * 64, tn * 64};
                wave_gemm64<8, 4, WEpiGlu>((const bf16*)(ws + WS_YS5) + (size_t)(tm * 64) * 256, 256, (const bf16*)(ws + WS_WGLU) + (size_t)l * 65536 + (size_t)(tn * 64) * 256, 256, lane, E);
            }
        }
        GSYNC();
        {
            PHASE_VARS;
            pg8::Gemm g{(const bf16*)(ws + WS_GATE), (const bf16*)(ws + WS_WO) + (size_t)l * DM * DM, M, DM, DM, DM, DM, 0, 0};
            pg8::StaticOrder S; S.init(M, DM, G, bx);
#ifdef REP_P6
            { EpiOut E0{l == 0 ? args.in[0] : X, X, (float*)(ws + WS_SS) + (size_t)((l + 1) & 1) * M, (bf16*)(ws + WS_XN), (l + 1 < DEPTH) ? args.in[1] + (size_t)(l + 1) * DM : nullptr, opaque_true()}; pg8::gemm_phase<EpiOut, pg8::StaticOrder, true, true>(ldsl, g, S, E0); }
#endif
            EpiOut E{l == 0 ? args.in[0] : X, X, (float*)(ws + WS_SS) + (size_t)((l + 1) & 1) * M, (bf16*)(ws + WS_XN), (l + 1 < DEPTH) ? args.in[1] + (size_t)(l + 1) * DM : nullptr, false};
            pg8::gemm_phase<EpiOut, pg8::StaticOrder, true, true>(ldsl, g, S, E);
        }
        GSYNC();
        if (l + 1 == DEPTH) { PHASE_VARS; final_norm(args, X, (const float*)(ws + WS_SS) + (size_t)((l + 1) & 1) * M, lane, gw, NGW); }
    }
}

extern "C" void kernel_launch(void* const* d_in, const int* in_sizes, int n_in, void* d_out, int out_size, void* d_ws, size_t ws_size, hipStream_t stream) {
    static int grid = 0;
    if (grid == 0) {
        if (n_in != 16 || ws_size < WS_END) { fprintf(stderr, "kernel_launch: unexpected n_in %d / ws %zu\n", n_in, ws_size); grid = -1; return; }
        int dev = 0, cus = 0, per_cu = 0;
        hipGetDevice(&dev); hipDeviceGetAttribute(&cus, hipDeviceAttributeMultiprocessorCount, dev);
        if (hipFuncSetAttribute((const void*)mega_fwd, hipFuncAttributeMaxDynamicSharedMemorySize, LDS_BYTES) != hipSuccess) { fprintf(stderr, "kernel_launch: hipFuncSetAttribute failed\n"); grid = -1; return; }
        if (hipOccupancyMaxActiveBlocksPerMultiprocessor(&per_cu, (const void*)mega_fwd, NTHR, LDS_BYTES) != hipSuccess || per_cu < 1) { fprintf(stderr, "kernel_launch: occupancy query failed (%d)\n", per_cu); grid = -1; return; }
        grid = cus;
        if (grid != 256) fprintf(stderr, "kernel_launch: note: %d CUs\n", grid);
    }
    if (grid < 0) return;
    Args a{};
    for (int i = 0; i < 16; ++i) a.in[i] = (const float*)d_in[i];
    a.out = (float*)d_out; a.ws = (unsigned char*)d_ws;
    void* kargs[] = {&a};
    hipError_t e = hipLaunchCooperativeKernel((const void*)mega_fwd, dim3(grid), dim3(NTHR), kargs, LDS_BYTES, stream);
    if (e != hipSuccess) fprintf(stderr, "kernel_launch: cooperative launch failed: %s\n", hipGetErrorString(e));
}
```

```cpp
#include <hip/hip_runtime.h>
#include <cstdio>
#include <cstdint>
namespace pg8 {
#define PG8_LAS __attribute__((address_space(3)))
typedef unsigned short bf16_t;
typedef short bf16x8 __attribute__((ext_vector_type(8)));
typedef float f32x4 __attribute__((ext_vector_type(4)));
typedef unsigned u32x4 __attribute__((ext_vector_type(4)));
constexpr int BM = 256, BK = 64, HALF = 128, HTB = HALF * BK * 2  , STAGE_BYTES = 8 * HTB, NXCD = 8, WGM = 8;

__host__ __device__ __forceinline__ int lds_byte(int r, int c) { const int st = (r >> 4) * 2 + (c >> 5), rr = r & 15, cc = c & 31, ob = rr * 64 + cc * 2; return st * 1024 + (ob ^ (((ob >> 9) & 1) << 5)); }
__host__ __device__ __forceinline__ void stage_rc(int b, int& R, int& C) { const int st = b / 1024, sb = b % 1024, swz = sb ^ (((sb >> 9) & 1) << 5); R = (st >> 1) * 16 + swz / 64; C = (st & 1) * 32 + (swz % 64) / 2; }
__host__ __device__ __forceinline__ int perm32(int rho) { const int n = rho >> 4, i = rho & 15; return 8 * (i >> 2) + 4 * n + (i & 3); }

struct Unit { int pm, pn, gz; };
struct Gemm { const bf16_t* A; const bf16_t* Bt; int M, N, K; int lda, ldb; size_t gsA, gsB; };

struct StaticOrder {
    int nM, nN, nwg, G, c;
    __host__ __device__ void init(int M, int N, int G_, int c_) { nM = M / BM; nN = N / BM; nwg = nM * nN; G = G_; c = c_; }
    __host__ __device__ bool next(int i, Unit& u) const {
        const long L = (long)i * G + c; if (L >= nwg) return false;
        int wgid = (int)L; { const int q = nwg / NXCD, r = nwg % NXCD, xcd = wgid % NXCD, off = wgid / NXCD; wgid = (xcd < r ? xcd * (q + 1) : r * (q + 1) + (xcd - r) * q) + off; }
        const int nig = WGM * nN, gid = wgid / nig, fm = gid * WGM, gsz = (nM - fm) < WGM ? (nM - fm) : WGM;
        u.pm = fm + ((wgid % nig) % gsz); u.pn = (wgid % nig) / gsz; u.gz = 0; return true;
    }
    __device__ __forceinline__ void a_ready(const Unit&) const {}
    __device__ __forceinline__ void done(const Unit&) const {}
};

__device__ __forceinline__ unsigned cvt_pk_bf16(float lo, float hi) { unsigned r; asm volatile("v_cvt_pk_bf16_f32 %0, %1, %2" : "=v"(r) : "v"(lo), "v"(hi)); return r; }
typedef float f32x2 __attribute__((ext_vector_type(2)));
__device__ __forceinline__ f32x2 gelu_pk(f32x2 v) {
    const f32x2 av = __builtin_elementwise_abs(v), d = av * 0.2316418882f + 1.0f;
    f32x2 t; t.x = __builtin_amdgcn_rcpf(d.x); t.y = __builtin_amdgcn_rcpf(d.y);
    f32x2 q = t * 0.5307027145f + (-0.7265760135f); q = q * t + 0.7107068705f; q = q * t + (-0.142248368f); q = q * t + 0.127414796f; q = q * t;
    const f32x2 s = (v * v) * (-0.72134752044f);
    f32x2 e; e.x = __builtin_amdgcn_exp2f(s.x); e.y = __builtin_amdgcn_exp2f(s.y);
    const f32x2 m = v * (q * e), r = v - m;
    f32x2 o; o.x = v.x < 0.f ? m.x : r.x; o.y = v.y < 0.f ? m.y : r.y; return o;
}

template <class Epi, class Sched, bool ALIGN_EPI = false, bool SP2 = false>
__device__ __forceinline__ void gemm_phase(PG8_LAS unsigned char* lds, const Gemm g, const Sched& S, const Epi& E) {
    int tid_ = threadIdx.x; asm volatile("" : "+v"(tid_));
    const int tid = tid_, wid = __builtin_amdgcn_readfirstlane(tid >> 6), lane = tid & 63, wr = wid >> 2, wc = wid & 3, fr = lane & 15, fq = lane >> 4;
    const int K = g.K, nt = K / BK;
    unsigned voffA[2], voffB[2];
#pragma unroll
    for (int i = 0; i < 2; ++i) { int R, C; stage_rc(tid * 16 + i * 8192, R, C); const int Rb = Epi::PERM ? ((R & ~31) + perm32(R & 31)) : R;
        voffA[i] = (unsigned)(R * g.lda + C) * 2u; voffB[i] = (unsigned)(Rb * g.ldb + C) * 2u; }
    const size_t kstep = (size_t)(BK * 2);
    const size_t hstepA = (size_t)HALF * g.lda * 2, hstepB = (size_t)HALF * g.ldb * 2;
    const size_t tstepA = 2 * hstepA, tstepB = 2 * hstepB;
    const unsigned ldsw = (unsigned)wid * 1024u;
    const int aoff = lds_byte(wr * 64 + fr, fq * 8), boff = lds_byte(wc * 32 + fr, fq * 8);
#define PG8_SA(b, h) (((b) * 2 + (h)) * HTB)
#define PG8_SB(b, h) ((4 + (b) * 2 + (h)) * HTB)
#define PG8_STAGE(bufoff, gbase, voff) do { _Pragma("unroll") for (int _i = 0; _i < 2; ++_i) \
        __builtin_amdgcn_global_load_lds((const unsigned*)((const char*)(gbase) + (voff)[_i]), (PG8_LAS unsigned*)(lds + (bufoff) + ldsw + _i * 8192), 16, 0, 0); } while (0)
#define PG8_LDA(dst, b, h) do { _Pragma("unroll") for (int m = 0; m < 4; ++m) _Pragma("unroll") for (int k = 0; k < 2; ++k) dst[m][k] = *(const PG8_LAS bf16x8*)(lds + PG8_SA(b, h) + aoff + m * 2048 + k * 1024); } while (0)
#define PG8_LDB(dst, b, h) do { _Pragma("unroll") for (int n = 0; n < 2; ++n) _Pragma("unroll") for (int k = 0; k < 2; ++k) dst[n][k] = *(const PG8_LAS bf16x8*)(lds + PG8_SB(b, h) + boff + n * 2048 + k * 1024); } while (0)
#define PG8_MMA(ai, bj, At, Bt) do { __builtin_amdgcn_s_setprio(1); _Pragma("unroll") for (int m = 0; m < 4; ++m) _Pragma("unroll") for (int n = 0; n < 2; ++n) _Pragma("unroll") for (int k = 0; k < 2; ++k) \
        acc[ai][bj][m][n] = __builtin_amdgcn_mfma_f32_16x16x32_bf16(Bt[n][k], At[m][k], acc[ai][bj][m][n], 0, 0, 0); __builtin_amdgcn_s_setprio(0); } while (0)
#define PG8_WAIT_V(n) asm volatile("s_waitcnt vmcnt(" #n ")" ::: "memory")
#define PG8_WAIT_L(n) asm volatile("s_waitcnt lgkmcnt(" #n ")" ::: "memory")
#define PG8_BAR __builtin_amdgcn_s_barrier()
#define PG8_SCHED __builtin_amdgcn_sched_barrier(0)
    Unit cur, nxt; int ui = 0;
    if (!S.next(0, cur)) return;
    f32x4 acc[2][2][4][2];
#pragma unroll
    for (int a = 0; a < 2; ++a)
#pragma unroll
        for (int b = 0; b < 2; ++b)
#pragma unroll
            for (int m = 0; m < 4; ++m)
#pragma unroll
                for (int n = 0; n < 2; ++n) acc[a][b][m][n] = (f32x4){0.f, 0.f, 0.f, 0.f};
    bf16x8 At[4][2], B0[2][2], B1[2][2];
    const char* cA = (const char*)g.A + (size_t)cur.gz * g.gsA * 2 + (size_t)cur.pm * tstepA; const char* cB = (const char*)g.Bt + (size_t)cur.gz * g.gsB * 2 + (size_t)cur.pn * tstepB;
    S.a_ready(cur);
    if constexpr (SP2) {
        PG8_STAGE(PG8_SB(0, 0), cB, voffB); PG8_STAGE(PG8_SB(0, 1), cB + hstepB, voffB); PG8_STAGE(PG8_SA(0, 0), cA, voffA); PG8_STAGE(PG8_SA(0, 1), cA + hstepA, voffA);
        if (wr == 1) PG8_BAR;
        PG8_WAIT_V(2); PG8_BAR;
        PG8_STAGE(PG8_SB(1, 0), cB + kstep, voffB); PG8_STAGE(PG8_SA(1, 0), cA + kstep, voffA); PG8_STAGE(PG8_SB(1, 1), cB + hstepB + kstep, voffB);
        PG8_WAIT_V(6); PG8_BAR;
    } else {
        PG8_STAGE(PG8_SB(0, 0), cB, voffB); PG8_STAGE(PG8_SA(0, 0), cA, voffA); PG8_STAGE(PG8_SB(0, 1), cB + hstepB, voffB); PG8_STAGE(PG8_SA(0, 1), cA + hstepA, voffA);
        if (wr == 1) PG8_BAR;
        PG8_WAIT_V(4); PG8_BAR;
        PG8_STAGE(PG8_SB(1, 0), cB + kstep, voffB); PG8_STAGE(PG8_SA(1, 0), cA + kstep, voffA); PG8_STAGE(PG8_SB(1, 1), cB + hstepB + kstep, voffB);
        PG8_WAIT_V(6); PG8_BAR;
    }
    for (;;) {
        const bool has_next = S.next(ui + 1, nxt);
        const char* nA = has_next ? (const char*)g.A + (size_t)nxt.gz * g.gsA * 2 + (size_t)nxt.pm * tstepA : cA; const char* nB = has_next ? (const char*)g.Bt + (size_t)nxt.gz * g.gsB * 2 + (size_t)nxt.pn * tstepB : cB;
        for (int t = 0; t < nt; t += 2) {
            const bool last = (t == nt - 2);
            const char* a1 = cA + (size_t)(t + 1) * kstep;
            const char* a2 = last ? nA : cA + (size_t)(t + 2) * kstep; const char* b2 = last ? nB : cB + (size_t)(t + 2) * kstep;
            const char* a3 = a2 + kstep; const char* b3 = b2 + kstep;
            if (last && has_next) S.a_ready(nxt);
            if constexpr (SP2) {
            PG8_LDB(B0, 0, 0); PG8_LDB(B1, 0, 1); PG8_SCHED; PG8_LDA(At, 0, 0); PG8_STAGE(PG8_SA(1, 1), a1 + hstepA, voffA);
            PG8_WAIT_V(8); PG8_WAIT_L(0); PG8_BAR; PG8_MMA(0, 0, At, B0); PG8_MMA(0, 1, At, B1); PG8_BAR; PG8_SCHED;
            PG8_LDA(At, 0, 1); PG8_STAGE(PG8_SB(0, 0), b2, voffB); PG8_STAGE(PG8_SB(0, 1), b2 + hstepB, voffB); PG8_STAGE(PG8_SA(0, 0), a2, voffA);
            PG8_WAIT_V(8); PG8_WAIT_L(0); PG8_BAR; PG8_MMA(1, 0, At, B0); PG8_MMA(1, 1, At, B1); PG8_BAR; PG8_SCHED;
            PG8_LDB(B0, 1, 0); PG8_LDB(B1, 1, 1); PG8_SCHED; PG8_LDA(At, 1, 0); PG8_STAGE(PG8_SA(0, 1), a2 + hstepA, voffA);
            PG8_WAIT_V(8); PG8_WAIT_L(0); PG8_BAR; PG8_MMA(0, 0, At, B0); PG8_MMA(0, 1, At, B1); PG8_BAR; PG8_SCHED;
            PG8_LDA(At, 1, 1); PG8_STAGE(PG8_SB(1, 0), b3, voffB); PG8_STAGE(PG8_SB(1, 1), b3 + hstepB, voffB); PG8_STAGE(PG8_SA(1, 0), a3, voffA);
            PG8_WAIT_V(8); PG8_WAIT_L(0); PG8_BAR; PG8_MMA(1, 0, At, B0); PG8_MMA(1, 1, At, B1); PG8_BAR; PG8_SCHED;
            } else {
            PG8_LDB(B0, 0, 0); PG8_SCHED; PG8_LDA(At, 0, 0); PG8_STAGE(PG8_SA(1, 1), a1 + hstepA, voffA);
            PG8_WAIT_L(8); PG8_BAR; PG8_WAIT_L(0); PG8_MMA(0, 0, At, B0); PG8_BAR; PG8_SCHED;
            PG8_LDB(B1, 0, 1); PG8_STAGE(PG8_SB(0, 0), b2, voffB);
            PG8_BAR; PG8_WAIT_L(0); PG8_MMA(0, 1, At, B1); PG8_BAR;
            PG8_LDA(At, 0, 1); PG8_STAGE(PG8_SA(0, 0), a2, voffA);
            PG8_BAR; PG8_WAIT_L(0); PG8_MMA(1, 0, At, B0); PG8_BAR; PG8_SCHED;
            PG8_STAGE(PG8_SB(0, 1), b2 + hstepB, voffB);
            PG8_WAIT_V(6); PG8_BAR; PG8_MMA(1, 1, At, B1); PG8_BAR;
            PG8_LDB(B0, 1, 0); PG8_SCHED; PG8_LDA(At, 1, 0); PG8_STAGE(PG8_SA(0, 1), a2 + hstepA, voffA);
            PG8_WAIT_L(8); PG8_BAR; PG8_WAIT_L(0); PG8_MMA(0, 0, At, B0); PG8_BAR; PG8_SCHED;
            PG8_LDB(B1, 1, 1); PG8_STAGE(PG8_SB(1, 0), b3, voffB);
            PG8_BAR; PG8_WAIT_L(0); PG8_MMA(0, 1, At, B1); PG8_BAR;
            PG8_LDA(At, 1, 1); PG8_STAGE(PG8_SA(1, 0), a3, voffA);
            PG8_BAR; PG8_WAIT_L(0); PG8_MMA(1, 0, At, B0); PG8_BAR; PG8_SCHED;
            PG8_STAGE(PG8_SB(1, 1), b3 + hstepB, voffB);
            PG8_WAIT_V(6); PG8_BAR; PG8_MMA(1, 1, At, B1); PG8_BAR;
            }
        }
        if constexpr (ALIGN_EPI) { if (wr == 0) PG8_BAR; }
        if constexpr (!Epi::AFTER_DRAIN) { E(acc, cur, wr, wc, fr, fq); S.done(cur); }
        if (!has_next) break;
#pragma unroll
        for (int a = 0; a < 2; ++a)
#pragma unroll
            for (int b = 0; b < 2; ++b)
#pragma unroll
                for (int m = 0; m < 4; ++m)
#pragma unroll
                    for (int n = 0; n < 2; ++n) acc[a][b][m][n] = (f32x4){0.f, 0.f, 0.f, 0.f};
        cur = nxt; cA = nA; cB = nB; ++ui;
        if constexpr (ALIGN_EPI) { if (wr == 1) PG8_BAR; }
    }
    PG8_WAIT_V(0);
    if constexpr (!ALIGN_EPI) { if (wr == 0) PG8_BAR; }
    PG8_BAR;
    if constexpr (Epi::AFTER_DRAIN) { E.fused(acc, cur, wr, wc, fr, fq, lds, wid, lane); S.done(cur); }
#undef PG8_SA
#undef PG8_SB
#undef PG8_STAGE
#undef PG8_LDA
#undef PG8_LDB
#undef PG8_MMA
#undef PG8_WAIT_V
#undef PG8_WAIT_L
#undef PG8_BAR
#undef PG8_SCHED
}
}
#include <hip/hip_bf16.h>
#include <cmath>
namespace attn_body {
using bf16=__hip_bfloat16;
using bf16x8=__attribute__((ext_vector_type(8)))short;
using s16x4=__attribute__((ext_vector_type(4)))short;
using f32x16=__attribute__((ext_vector_type(16)))float;
using u32x4=__attribute__((ext_vector_type(4)))unsigned;
using f32x4=__attribute__((ext_vector_type(4)))float;
constexpr int BATCH=4,NHEAD=8,SEQ=4096,D=64,DM=NHEAD*D,OPITCH=1024;
constexpr int NW=8,QBLK=32,QB=QBLK*NW,KVBLK=64,NQB=SEQ/QB;
constexpr int ATTN_PITCH=DM, ATTN_UNIT_ROWS=QB;
__device__ __forceinline__ int crow(int r,int hi){return (r&3)+8*(r>>2)+4*hi;}
#define SBAR() __builtin_amdgcn_sched_barrier(0)
__device__ __forceinline__ void cmask(f32x16&p0,f32x16&p1,int jb,int qrel,int hi){
  const float NEG=-INFINITY; int kb=64*jb+4*hi;
  #pragma unroll
  for(int r=0;r<16;++r){int kv=kb+(r&3)+8*(r>>2); if(kv>qrel)p0[r]=NEG; if(kv+32>qrel)p1[r]=NEG;}
}

constexpr int NSLOT=3, SLOTB=8192;
constexpr int LDS_K=0, LDS_V=NSLOT*SLOTB, LDS_WS=2*NSLOT*SLOTB, LDS_OST=LDS_WS+NW*64*4, LDS_CB=LDS_OST+NW*4096, LDS_BYTES=LDS_CB+SEQ*4;
constexpr float C2=0.125f*1.4426950408889634f;
__device__ __forceinline__ void glds16(const void*gsrc,unsigned lds_dst){unsigned keep;
  asm volatile("s_mov_b32 %0, m0\n\ts_mov_b32 m0, %2\n\ts_nop 0\n\tglobal_load_lds_dwordx4 %1, off\n\ts_mov_b32 m0, %0":"=&s"(keep):"v"(gsrc),"s"(lds_dst):"memory");}
__device__ __forceinline__ float max3f(float a,float b,float c){float r;asm("v_max3_f32 %0, %1, %2, %3":"=v"(r):"v"(a),"v"(b),"v"(c));return r;}
__device__ __forceinline__ float max2f(float a,float b){float r;asm("v_max_f32_e32 %0, %1, %2":"=v"(r):"v"(a),"v"(b));return r;}
__device__ __forceinline__ float fadd_s(float a,float b){float r;asm("v_add_f32_e32 %0, %1, %2":"=v"(r):"v"(a),"v"(b));return r;}
__device__ __forceinline__ float fsub_s(float a,float b){float r;asm("v_sub_f32_e32 %0, %1, %2":"=v"(r):"v"(a),"v"(b));return r;}
typedef float f32x2_t __attribute__((ext_vector_type(2))); typedef __bf16 bf16x2_t __attribute__((ext_vector_type(2)));
__device__ __forceinline__ unsigned cvtpk_s(float lo,float hi){f32x2_t v={lo,hi};bf16x2_t b=__builtin_convertvector(v,bf16x2_t);return __builtin_bit_cast(unsigned,b);}
#define WAIT_BAR(N) asm volatile("s_waitcnt vmcnt(" #N ") lgkmcnt(0)\n\ts_barrier":::"memory")

__device__ __forceinline__ void qkt(f32x16&p0,f32x16&p1,const char*Kslot,const bf16x8*qr,const char*cbt,int r32,int hi){
  const char*kb=Kslot+hi*1024+r32*16;
  #pragma unroll
  for(int a=0;a<4;++a){ const f32x4 u0=*reinterpret_cast<const f32x4*>(cbt+hi*16+a*32), u1=*reinterpret_cast<const f32x4*>(cbt+128+hi*16+a*32);
    p0[4*a]=u0[0];p0[4*a+1]=u0[1];p0[4*a+2]=u0[2];p0[4*a+3]=u0[3]; p1[4*a]=u1[0];p1[4*a+1]=u1[1];p1[4*a+2]=u1[2];p1[4*a+3]=u1[3]; }
  #pragma unroll
  for(int d0=0;d0<4;++d0){
    const bf16x8 b0=*reinterpret_cast<const bf16x8*>(kb+d0*2048);
    const bf16x8 b1=*reinterpret_cast<const bf16x8*>(kb+d0*2048+512);
    p0=__builtin_amdgcn_mfma_f32_32x32x16_bf16(b0,qr[d0],p0,0,0,0);p1=__builtin_amdgcn_mfma_f32_32x32x16_bf16(b1,qr[d0],p1,0,0,0);}
}
typedef __attribute__((address_space(3))) const char* lds_cptr;
typedef short v4i16_t __attribute__((ext_vector_type(4)));
__device__ __forceinline__ void kload8(bf16x8*kf,lds_cptr kp){
  kf[0]=*(const __attribute__((address_space(3))) bf16x8*)(kp);      kf[1]=*(const __attribute__((address_space(3))) bf16x8*)(kp+512);
  kf[2]=*(const __attribute__((address_space(3))) bf16x8*)(kp+2048); kf[3]=*(const __attribute__((address_space(3))) bf16x8*)(kp+2560);
  kf[4]=*(const __attribute__((address_space(3))) bf16x8*)(kp+4096); kf[5]=*(const __attribute__((address_space(3))) bf16x8*)(kp+4608);
  kf[6]=*(const __attribute__((address_space(3))) bf16x8*)(kp+6144); kf[7]=*(const __attribute__((address_space(3))) bf16x8*)(kp+6656);
}
__device__ __forceinline__ void kload2(bf16x8*kf,lds_cptr kp,int j){ kf[2*j]=*(const __attribute__((address_space(3))) bf16x8*)(kp+j*2048); kf[2*j+1]=*(const __attribute__((address_space(3))) bf16x8*)(kp+j*2048+512); }
__device__ __forceinline__ s16x4 vtr(lds_cptr p){ return __builtin_bit_cast(s16x4,__builtin_amdgcn_ds_read_tr16_b64_v4i16((__attribute__((address_space(3))) v4i16_t*)p)); }
__device__ __forceinline__ float rowmax(const f32x16&p0,const f32x16&p1){
  float a=max3f(p0[0],p0[1],p1[0]),b=max3f(p0[2],p0[3],p1[1]);a=max3f(a,p1[2],p1[3]);
  #pragma unroll
  for(int r=4;r<16;r+=4){a=max3f(a,p0[r],p0[r+1]);b=max3f(b,p0[r+2],p0[r+3]);a=max3f(a,p1[r],p1[r+1]);b=max3f(b,p1[r+2],p1[r+3]);}
  const float m=max2f(a,b);
  auto rr=__builtin_amdgcn_permlane32_swap(__float_as_uint(m),__float_as_uint(m),false,false);
  return max2f(__uint_as_float(rr[0]),__uint_as_float(rr[1]));
}
__device__ __forceinline__ void pv(f32x16*o,int vb,bf16x8 pa0,bf16x8 pa1,bf16x8 pa2,bf16x8 pa3){
  #pragma unroll
  for(int d0=0;d0<2;++d0){s16x4 lo[4],hi[4];
    #pragma unroll
    for(int ks=0;ks<4;++ks){
      asm volatile("ds_read_b64_tr_b16 %0,%1 offset:%c2":"=&v"(lo[ks]):"v"(vb),"i"(d0*4096+ks*1024):"memory");
      asm volatile("ds_read_b64_tr_b16 %0,%1 offset:%c2":"=&v"(hi[ks]):"v"(vb),"i"(d0*4096+ks*1024+512):"memory");}
    asm volatile("s_waitcnt lgkmcnt(0)":::"memory");SBAR();
    #define PK(k) (bf16x8){lo[k][0],lo[k][1],lo[k][2],lo[k][3],hi[k][0],hi[k][1],hi[k][2],hi[k][3]}
    o[d0]=__builtin_amdgcn_mfma_f32_32x32x16_bf16(pa0,PK(0),o[d0],0,0,0);
    o[d0]=__builtin_amdgcn_mfma_f32_32x32x16_bf16(pa1,PK(1),o[d0],0,0,0);
    o[d0]=__builtin_amdgcn_mfma_f32_32x32x16_bf16(pa2,PK(2),o[d0],0,0,0);
    o[d0]=__builtin_amdgcn_mfma_f32_32x32x16_bf16(pa3,PK(3),o[d0],0,0,0);
    #undef PK
  }
}

#ifndef ATTN_STORE16
#define ATTN_STORE16(p,v) (*(u32x4*)(p)=(v))
#endif
template<int THRL> __device__ __forceinline__ void attn_unit(int b,int h,int qb,const bf16*Q,const bf16*__restrict__ K,const bf16*__restrict__ V,bf16*O,const float*__restrict__ CB,char*shm,bool dry=false){
  int tid_=threadIdx.x; asm volatile("":"+v"(tid_)); const int tid=tid_,lane=tid&63,r32=lane&31,hi=lane>>5; const int wid=__builtin_amdgcn_readfirstlane(tid>>6);
  const long rowbase=(long)b*SEQ; const int q0=qb*QB;
  const bf16*Qw=Q+(rowbase+q0+wid*QBLK)*DM+h*D;
  const bf16*Kh=K+rowbase*DM+h*D,*Vh=V+rowbase*DM+h*D;
  const unsigned lds0=(unsigned)(uintptr_t)shm;
  float*wsf=(float*)(shm+LDS_WS)+wid*64;
  const bf16*ksrc=Kh+(long)lane*DM+wid*8;
  const bf16*vsrc=Vh+(long)(16*(wid&3)+(lane>>2))*DM+(wid>>2)*32+(lane&3)*8;
  const unsigned kdst=lds0+LDS_K+wid*1024, vdst=lds0+LDS_V+wid*1024;
  #define DMA_K(t,slot) glds16(ksrc+(long)(t)*KVBLK*DM,(unsigned)__builtin_amdgcn_readfirstlane(kdst+(slot)))
  #define DMA_V(t,slot) glds16(vsrc+(long)(t)*KVBLK*DM,(unsigned)__builtin_amdgcn_readfirstlane(vdst+(slot)))
  const int vb0=(int)(lds0+LDS_V)+((lane>>4)&1)*32+(lane&3)*8+(4*hi+((lane&15)>>2))*64;
  const char*Kbase=shm+LDS_K; bf16x8 kf[8];
  const lds_cptr shm3=(lds_cptr)shm; const lds_cptr kp0=shm3+LDS_K+hi*1024+r32*16; const lds_cptr vp0=shm3+LDS_V+((lane>>4)&1)*32+(lane&3)*8+(4*hi+((lane&15)>>2))*64;
  const int NT=(q0+QB)/KVBLK;
  { const f32x4* cbg=reinterpret_cast<const f32x4*>(CB+(long)(b*NHEAD+h)*SEQ); f32x4* cbl=reinterpret_cast<f32x4*>(shm+LDS_CB); const int nv=(q0+QB)/4;
    for(int i=tid;i<nv;i+=NW*64) cbl[i]=cbg[i];
    asm volatile("s_waitcnt vmcnt(0) lgkmcnt(0)\n\ts_barrier":::"memory"); }
  const lds_cptr cb3=(lds_cptr)shm+LDS_CB;
  const float cb_own=*(const __attribute__((address_space(3))) float*)(cb3+(q0+wid*QBLK+r32)*4);
  DMA_K(0,0);DMA_V(0,0);DMA_K(1,SLOTB);
  bf16x8 qr[4];
  #pragma unroll
  for(int d0=0;d0<4;++d0)qr[d0]=*reinterpret_cast<const bf16x8*>(&Qw[(long)r32*DM+d0*16+hi*8]);
  float mhat=0.f,l_reg=0.f;f32x16 o[2];o[0]=f32x16{};o[1]=f32x16{};
  const int qrel=wid*QBLK+r32;
  #define CMASK(P0,P1,t) do{int jb_=(t)-(NT-4); if(jb_>=0)cmask(P0,P1,jb_,qrel,hi);}while(0)
  bool resc=false;
  #define START(P0,P1) do{ const float rm=max2f(rowmax(P0,P1),cb_own); resc=false; \
    { const float dl=rm; mhat=fadd_s(mhat,dl); \
      _Pragma("unroll") for(int r=0;r<16;++r){P0[r]=fsub_s(P0[r],dl);P1[r]=fsub_s(P1[r],dl);} } \
    _Pragma("unroll") for(int r=0;r<16;++r)P0[r]=__builtin_amdgcn_exp2f(P0[r]); }while(0)
  #define RESC() do{ if(resc){ asm volatile("s_waitcnt lgkmcnt(0)":::"memory"); \
      _Pragma("unroll") for(int d_=0;d_<2;++d_) _Pragma("unroll") for(int r=0;r<16;++r)o[d_][r]*=wsf[crow(r,hi)]; } }while(0)
  f32x16 pA0,pA1,pB0,pB1;
  int sl_prev=0,sl_cur=0,sl_next=SLOTB;
  #define ROT() do{sl_prev=sl_cur;sl_cur=sl_next;sl_next=(sl_next==(NSLOT-1)*SLOTB)?0:sl_next+SLOTB;}while(0)
  DMA_K(2,2*SLOTB);
  WAIT_BAR(3);
  qkt(pA0,pA1,Kbase,qr,shm+LDS_CB,r32,hi);asm volatile("s_nop 15\n\ts_nop 7":"+v"(pA0),"+v"(pA1));CMASK(pA0,pA1,0);
  START(pA0,pA1);
  _Pragma("unroll") for(int r=0;r<16;++r)pA1[r]=__builtin_amdgcn_exp2f(pA1[r]);
  WAIT_BAR(0);
  DMA_K(3,0);DMA_V(1,SLOTB);
  ROT();
  kload8(kf,kp0+sl_cur);
  WAIT_BAR(2);
  s16x4 vlo[8],vhi[8]; u32x4 pw0,pw1,pw2,pw3;
  #define PKW(P,B) cvtpk_s(P[B],P[B+1])
  #define PAF(k) __builtin_bit_cast(bf16x8,pw##k)
  #define VFR(i) (bf16x8){vlo[i][0],vlo[i][1],vlo[i][2],vlo[i][3],vhi[i][0],vhi[i][1],vhi[i][2],vhi[i][3]}
  #define PIN(x) asm volatile("":"+v"(x))
  #define MX3(a,b,c) __builtin_fmaxf(__builtin_fmaxf((a),(b)),(c))
  #define GAPA(MF,A0,A1,A2,A3,W0,W1,PW) do{ MF; sacc+=A0; sacc+=A1; sacc+=A2; sacc+=A3; PIN(sacc); W0; W1; PIN(PW); SBAR(); }while(0)
  #define EX(v) __builtin_amdgcn_exp2f(v)
  #define GAPB(MF,X,B) do{ MF; X[B]=EX(X[B]); X[B+1]=EX(X[B+1]); X[B+2]=EX(X[B+2]); X[B+3]=EX(X[B+3]); PIN(X); SBAR(); }while(0)
  #define VRD(i) do{ vlo[i]=vtr(vp_+(((i)>>2)*4096+((i)&3)*1024)); vhi[i]=vtr(vp_+(((i)>>2)*4096+((i)&3)*1024+512)); }while(0)
  #define KRD(G,j) do{ if(G){ kload2(kf,kp0+sl_next,j); SBAR(); } }while(0)
  #define STEP(C0,C1,P0,P1,t,GK,GV,GL) do{ SBAR(); \
    const lds_cptr vp_=vp0+sl_prev; \
    VRD(0); SBAR(); float sacc=(P0[0]+P0[1]); \
    GAPA(C0=__builtin_amdgcn_mfma_f32_32x32x16_bf16(kf[0],qr[0],C0,0,0,0), P0[2],P0[3],P0[4],P0[5],     pw0[0]=PKW(P0,0), pw0[1]=PKW(P0,2), pw0); \
    VRD(4); SBAR(); GAPA(C1=__builtin_amdgcn_mfma_f32_32x32x16_bf16(kf[1],qr[0],C1,0,0,0), P0[6],P0[7],P0[8],P0[9],     pw0[2]=PKW(P0,4), pw0[3]=PKW(P0,6), pw0); \
    VRD(1); SBAR(); GAPA(C0=__builtin_amdgcn_mfma_f32_32x32x16_bf16(kf[2],qr[1],C0,0,0,0),   P0[10],P0[11],P0[12],P0[13], pw1[0]=PKW(P0,8), pw1[1]=PKW(P0,10), pw1); \
    VRD(5); SBAR(); GAPA(C1=__builtin_amdgcn_mfma_f32_32x32x16_bf16(kf[3],qr[1],C1,0,0,0),   P0[14],P0[15],P1[0],P1[1],   pw1[2]=PKW(P0,12),pw1[3]=PKW(P0,14), pw1); \
    VRD(2); SBAR(); GAPA(C0=__builtin_amdgcn_mfma_f32_32x32x16_bf16(kf[4],qr[2],C0,0,0,0),   P1[2],P1[3],P1[4],P1[5],     pw2[0]=PKW(P1,0), pw2[1]=PKW(P1,2), pw2); \
    VRD(6); SBAR(); GAPA(C1=__builtin_amdgcn_mfma_f32_32x32x16_bf16(kf[5],qr[2],C1,0,0,0),   P1[6],P1[7],P1[8],P1[9],     pw2[2]=PKW(P1,4), pw2[3]=PKW(P1,6), pw2); \
    VRD(3); SBAR(); GAPA(C0=__builtin_amdgcn_mfma_f32_32x32x16_bf16(kf[6],qr[3],C0,0,0,0),   P1[10],P1[11],P1[12],P1[13], pw3[0]=PKW(P1,8), pw3[1]=PKW(P1,10), pw3); \
    VRD(7); SBAR(); GAPA(C1=__builtin_amdgcn_mfma_f32_32x32x16_bf16(kf[7],qr[3],C1,0,0,0),   P1[14],P1[15],0.f,0.f,       pw3[2]=PKW(P1,12),pw3[3]=PKW(P1,14), pw3); \
    l_reg+=sacc; \
    if(GK){DMA_K((t)+3,sl_cur);} if(GV){DMA_V((t)+1,sl_next);} \
    CMASK(C0,C1,t); \
    { float a=MX3(C0[0],C0[1],C1[0]),b=MX3(C0[2],C0[3],C1[1]); a=MX3(a,C1[2],C1[3]); \
      _Pragma("unroll") for(int r=4;r<16;r+=4){a=MX3(a,C0[r],C0[r+1]);b=MX3(b,C0[r+2],C0[r+3]);a=MX3(a,C1[r],C1[r+1]);b=MX3(b,C1[r+2],C1[r+3]);} \
      float rm=__builtin_fmaxf(a,b); { auto rr=__builtin_amdgcn_permlane32_swap(__float_as_uint(rm),__float_as_uint(rm),false,false); rm=__builtin_fmaxf(__uint_as_float(rr[0]),__uint_as_float(rr[1])); } \
      resc=false; \
      if(__builtin_expect(__any(rm>(float)THRL),0)){ const float dl=__builtin_fmaxf(rm,0.f); mhat+=dl; \
        _Pragma("unroll") for(int r=0;r<16;++r){C0[r]-=dl;C1[r]-=dl;} \
        const float f=__builtin_amdgcn_exp2f(-dl); l_reg*=f; if(hi==0)wsf[r32]=f; resc=true; } } \
    SBAR(); \
    { const __attribute__((address_space(3))) f32x4* cbp_=(const __attribute__((address_space(3))) f32x4*)(cb3+((t)+1)*256+hi*16); \
      _Pragma("unroll") for(int a_=0;a_<4;++a_){ const f32x4 u0_=cbp_[2*a_], u1_=cbp_[8+2*a_]; \
        P0[4*a_]=u0_[0];P0[4*a_+1]=u0_[1];P0[4*a_+2]=u0_[2];P0[4*a_+3]=u0_[3]; P1[4*a_]=u1_[0];P1[4*a_+1]=u1_[1];P1[4*a_+2]=u1_[2];P1[4*a_+3]=u1_[3]; } } SBAR(); \
    GAPB(o[0]=__builtin_amdgcn_mfma_f32_32x32x16_bf16(PAF(0),VFR(0),o[0],0,0,0), C0,0); \
    GAPB(o[1]=__builtin_amdgcn_mfma_f32_32x32x16_bf16(PAF(0),VFR(4),o[1],0,0,0), C0,4); \
    KRD(GL,0); GAPB(o[0]=__builtin_amdgcn_mfma_f32_32x32x16_bf16(PAF(1),VFR(1),o[0],0,0,0), C0,8); \
    KRD(GL,1); GAPB(o[1]=__builtin_amdgcn_mfma_f32_32x32x16_bf16(PAF(1),VFR(5),o[1],0,0,0), C0,12); \
    KRD(GL,2); GAPB(o[0]=__builtin_amdgcn_mfma_f32_32x32x16_bf16(PAF(2),VFR(2),o[0],0,0,0), C1,0); \
    KRD(GL,3); GAPB(o[1]=__builtin_amdgcn_mfma_f32_32x32x16_bf16(PAF(2),VFR(6),o[1],0,0,0), C1,4); \
    GAPB(o[0]=__builtin_amdgcn_mfma_f32_32x32x16_bf16(PAF(3),VFR(3),o[0],0,0,0), C1,8); \
    GAPB(o[1]=__builtin_amdgcn_mfma_f32_32x32x16_bf16(PAF(3),VFR(7),o[1],0,0,0), C1,12); \
    _Pragma("unroll") for(int r_=0;r_<16;++r_){P0[r_]-=mhat;P1[r_]-=mhat;} \
    }while(0)
  { const __attribute__((address_space(3))) f32x4* cbp_=(const __attribute__((address_space(3))) f32x4*)(cb3+256+hi*16);
    #pragma unroll
    for(int a_=0;a_<4;++a_){ const f32x4 u0_=cbp_[2*a_], u1_=cbp_[8+2*a_];
      pB0[4*a_]=u0_[0]-mhat;pB0[4*a_+1]=u0_[1]-mhat;pB0[4*a_+2]=u0_[2]-mhat;pB0[4*a_+3]=u0_[3]-mhat;
      pB1[4*a_]=u1_[0]-mhat;pB1[4*a_+1]=u1_[1]-mhat;pB1[4*a_+2]=u1_[2]-mhat;pB1[4*a_+3]=u1_[3]-mhat; } }
  int t=1;
  #undef CMASK
  #define CMASK(P0,P1,t) do{}while(0)
  for(;t+5<NT;t+=2){
    STEP(pB0,pB1,pA0,pA1,t,true,true,true);     WAIT_BAR(2); RESC(); ROT();
    STEP(pA0,pA1,pB0,pB1,t+1,true,true,true);   WAIT_BAR(2); RESC(); ROT();
  }
  #undef CMASK
  #define CMASK(P0,P1,t) do{int jb_=(t)-(NT-4); if(jb_>=0)cmask(P0,P1,jb_,qrel,hi);}while(0)
  #define ENDW(tt) do{ if((tt)+3<NT){WAIT_BAR(2);} else if((tt)+2<NT){WAIT_BAR(1);} else {WAIT_BAR(0);} }while(0)
  for(;t+1<NT;t+=2){
    STEP(pB0,pB1,pA0,pA1,t,(t+3<NT),(t+1<NT),(t+1<NT));       ENDW(t);   RESC(); ROT();
    STEP(pA0,pA1,pB0,pB1,t+1,(t+4<NT),(t+2<NT),(t+2<NT));     ENDW(t+1); RESC(); ROT();
  }
  STEP(pB0,pB1,pA0,pA1,NT-1,false,false,false); RESC();
  { float sacc=pB0[0]+pB0[1]; _Pragma("unroll") for(int r=2;r<16;++r)sacc+=pB0[r]; _Pragma("unroll") for(int r=0;r<16;++r)sacc+=pB1[r]; l_reg+=sacc;
    pw0=(u32x4){PKW(pB0,0),PKW(pB0,2),PKW(pB0,4),PKW(pB0,6)};pw1=(u32x4){PKW(pB0,8),PKW(pB0,10),PKW(pB0,12),PKW(pB0,14)};pw2=(u32x4){PKW(pB1,0),PKW(pB1,2),PKW(pB1,4),PKW(pB1,6)};pw3=(u32x4){PKW(pB1,8),PKW(pB1,10),PKW(pB1,12),PKW(pB1,14)};
    SBAR(); pv(o,vb0+sl_cur,PAF(0),PAF(1),PAF(2),PAF(3)); }
  #undef PKW
  #undef PAF
  #undef VFR
  #undef PIN
  #undef MX3
  #undef GAPA
  #undef GAPB
  #undef EX
  #undef VRD
  #undef KRD
  #undef STEP
  #undef ENDW
  {auto rr=__builtin_amdgcn_permlane32_swap(__float_as_uint(l_reg),__float_as_uint(l_reg),false,false);l_reg=__uint_as_float(rr[0])+__uint_as_float(rr[1]);}
  if(hi==0)wsf[32+r32]=l_reg;asm volatile("s_waitcnt lgkmcnt(0)":::"memory");
  float rli[16];
  #pragma unroll
  for(int r=0;r<16;++r)rli[r]=__builtin_amdgcn_rcpf(wsf[32+crow(r,hi)]);
  bf16*Ow=O+(rowbase+q0+wid*QBLK)*OPITCH+h*D;
  { bf16*stg=(bf16*)(shm+LDS_OST)+wid*2048;
    #pragma unroll
    for(int r=0;r<16;++r){const int orow=crow(r,hi);
      #pragma unroll
      for(int d0=0;d0<2;++d0)stg[orow*64+d0*32+r32]=__float2bfloat16(o[d0][r]*rli[r]);}
    asm volatile("s_waitcnt lgkmcnt(0)":::"memory");
    #pragma unroll
    for(int i=0;i<4;++i){const int row=i*8+(lane>>3),ch=lane&7; const u32x4 v=*(const u32x4*)(stg+row*64+ch*8); bf16*dst=Ow+(long)row*OPITCH+ch*8; const u32x4 gv=*(const u32x4*)dst; u32x4 w;
      #pragma unroll
      for(int j=0;j<4;++j){ const float a0=__uint_as_float(v[j]<<16)*__uint_as_float(gv[j]<<16), a1=__uint_as_float(v[j]&0xffff0000u)*__uint_as_float(gv[j]&0xffff0000u); w[j]=cvtpk_s(a0,a1); }
      if(!dry)*(u32x4*)dst=w;} }
  asm volatile("s_waitcnt lgkmcnt(0)\n\ts_barrier":::"memory");
  #undef DMA_K
  #undef DMA_V
  #undef CMASK
  #undef START
  #undef RESC
  #undef ROT
}
constexpr int ATTN_LDS_BYTES=LDS_BYTES;
struct AttnTensors { const bf16* Q; const bf16* K; const bf16* V; bf16* O; const float* CB; };
struct AttnUnit { int bh; int qb; };
struct StaticOrder {
  int vcu;
  __device__ __forceinline__ explicit StaticOrder(int grid,int block):vcu((block%8)*(grid/8)+block/8){}
  __device__ __forceinline__ bool next(int i,AttnUnit&u)const{ if(i>=2)return false; const int s=vcu&7; u.bh=vcu>>3; u.qb=(i==0)?15-s:s; return true; }
  __device__ __forceinline__ void a_ready(const AttnUnit&)const{}
  __device__ __forceinline__ void done(const AttnUnit&)const{}
};
template<class Sched,int THRL=8> __device__ __forceinline__ void attn_phase(char*lds,const AttnTensors&T,const Sched&S,bool dry=false){
  AttnUnit u;
  for(int i=0;S.next(i,u);++i){ S.a_ready(u); attn_unit<THRL>(u.bh/NHEAD,u.bh%NHEAD,u.qb,T.Q,T.K,T.V,T.O,T.CB,lds,dry); S.done(u); }
}
#undef SBAR
#undef WAIT_BAR
}
#include <hip/hip_cooperative_groups.h>
namespace cg = cooperative_groups;
#define LAS __attribute__((address_space(3)))
typedef unsigned short bf16;
typedef float f32x4 __attribute__((ext_vector_type(4)));
typedef float f32x2 __attribute__((ext_vector_type(2)));
typedef unsigned u32x4 __attribute__((ext_vector_type(4)));
typedef unsigned u32x2 __attribute__((ext_vector_type(2)));
typedef short bf16x8 __attribute__((ext_vector_type(8)));
typedef short bf16x4 __attribute__((ext_vector_type(4)));

constexpr int NWAVES = 8, NTHR = 512;
constexpr int BATCH = 4, SEQ = 4096, DM = 1024, DEPTH = 4, M = BATCH * SEQ;
constexpr int NIN = 3592, NF = 3584;
constexpr int T5 = 32, NCH5 = M / T5, KA5 = 640, NG5 = 16;
constexpr float EPS = 1e-6f;
constexpr float LOG2E = 1.4426950408889634f;

constexpr size_t MiB = 1u << 20;
constexpr size_t WS_WIN = 1 * MiB, WS_WO = 31 * MiB, WS_WGLU = 39 * MiB, WS_ROPE = 40 * MiB, WS_MF = 41 * MiB, WS_WB = 81 * MiB;
constexpr size_t WS_LAM = 90 * MiB, WS_LOGF = 90 * MiB + 65536, WS_CB = WS_LOGF + 524288, WS_SS = WS_CB + 524288;
constexpr size_t WS_XN = 92 * MiB, WS_E = WS_XN, WS_UPD = WS_XN + 4 * MiB, WS_STATE = WS_XN + 20 * MiB;
constexpr size_t WS_QO = 124 * MiB, WS_KB = 140 * MiB, WS_VB = 156 * MiB, WS_SUA = 172 * MiB, WS_RQ = 182 * MiB, WS_RK = 190 * MiB, WS_RKT = 198 * MiB, WS_YS5 = WS_RKT;
constexpr size_t WS_RVT = 206 * MiB, WS_GATE = 214 * MiB, WS_END = 246 * MiB;

constexpr int RING_BYTES = 131072, LDS_BYTES = 147456;

struct Args { const float* in[16]; float* out; unsigned char* ws; };

__device__ __forceinline__ float bf2f(unsigned short b) { return __uint_as_float((unsigned)b << 16); }
__device__ __forceinline__ float bflo(unsigned w) { return __uint_as_float(w << 16); }
__device__ __forceinline__ float bfhi(unsigned w) { return __uint_as_float(w & 0xffff0000u); }
__device__ __forceinline__ unsigned pk2(float lo, float hi) { return pg8::cvt_pk_bf16(lo, hi); }
__device__ __forceinline__ unsigned short f2bf(float f) { return (unsigned short)(pg8::cvt_pk_bf16(f, 0.f) & 0xffffu); }
__device__ __forceinline__ float wave_sum(float v) {
#pragma unroll
    for (int o = 1; o < 64; o <<= 1) v += __shfl_xor(v, o);
    return v;
}
__device__ __forceinline__ float lg2_gamma(int hh) { return log2f(1.0f - exp2f(-5.0f - (float)hh)); }

__device__ __forceinline__ int win_col(int n) {
    if (n < 1536) return n;
    if (n < 1792) return n + 8;
    if (n < 2304) { const bool q = n < 2048; const int base = q ? 1792 : 2048; const int hh = (n - base) >> 6, pos = (n - base) & 63; const int d = (pos & 1) ? 32 + (pos >> 1) : (pos >> 1); return (q ? 1800 : 2056) + hh * 64 + d; }
    return n + 8;
}
template <bool MAP> __device__ __forceinline__ void p0_transpose_item(const float* W, int K, int Nsrc, int Ndst, bf16* WT, LAS float* scr, int item, int lane) {
    const int nblk = Ndst / 32, kb = item / nblk, nb = item % nblk, k0 = 64 * kb, n0 = 32 * nb;
    const int sc = MAP ? win_col(n0 + (lane & 31)) : n0 + (lane & 31);
#pragma unroll 8
    for (int i = 0; i < 32; ++i) { const int kk = 2 * i + (lane >> 5); scr[kk * 33 + (lane & 31)] = (MAP && sc < 0) ? 0.f : W[(size_t)(k0 + kk) * Nsrc + (sc < 0 ? 0 : sc)]; }
    asm volatile("s_waitcnt lgkmcnt(0)" ::: "memory");
    const int c = lane & 7;
#pragma unroll
    for (int j = 0; j < 4; ++j) { const int n = (lane >> 3) + 8 * j; const LAS float* s = scr + (8 * c) * 33 + n;
        u32x4 o; o.x = pk2(s[0 * 33], s[1 * 33]); o.y = pk2(s[2 * 33], s[3 * 33]); o.z = pk2(s[4 * 33], s[5 * 33]); o.w = pk2(s[6 * 33], s[7 * 33]);
        *(u32x4*)(WT + (size_t)(n0 + n) * K + k0 + 8 * c) = o; }
    asm volatile("s_waitcnt lgkmcnt(0)" ::: "memory");
}

__device__ __forceinline__ void s5_prep(const Args& a, int l, int g, LAS float* L, int tid) {
    LAS float* LPr = L;
    LAS float* LPi = L + 33 * 64;
    LAS float* Bbr = L + 66 * 64;
    LAS float* Bbi = Bbr + 1024;
    LAS float* Cr = Bbi + 1024;
    LAS float* Ci = Cr + 1024;
    LAS float* KT = Ci + 1024;
    const float* a_re = a.in[4] + (size_t)(l * 16 + g) * 64; const float* a_im = a.in[5] + (size_t)(l * 16 + g) * 64;
    const float* b_re = a.in[6] + (size_t)(l * 16 + g) * 1024; const float* b_im = a.in[7] + (size_t)(l * 16 + g) * 1024;
    const float* c_re = a.in[8] + (size_t)(l * 16 + g) * 1024; const float* c_im = a.in[9] + (size_t)(l * 16 + g) * 1024;
    const float log_dt = a.in[11][l * 16 + g];
    bf16* MF = (bf16*)(a.ws + WS_MF) + (size_t)(l * 16 + g) * 512 * KA5;
    bf16* WB = (bf16*)(a.ws + WS_WB) + (size_t)(l * 16 + g) * 128 * 512;
    float* LAM = (float*)(a.ws + WS_LAM) + (size_t)(l * 16 + g) * 128;
    if (tid < 64) {
        const int p = tid;
        const double dt = exp((double)log_dt), ar = (double)a_re[p], ai = (double)a_im[p];
        const double mag = exp(ar * dt); double sn, cs; sincos(ai * dt, &sn, &cs);
        const double lr = mag * cs, li = mag * sn, den = ar * ar + ai * ai;
        const double fr = ((lr - 1.0) * ar + li * ai) / den, fi = (li * ar - (lr - 1.0) * ai) / den;
#pragma unroll 4
        for (int h = 0; h < 16; ++h) { const double br = (double)b_re[p * 16 + h], bi = (double)b_im[p * 16 + h]; Bbr[p * 16 + h] = (float)(fr * br - fi * bi); Bbi[p * 16 + h] = (float)(fr * bi + fi * br); }
        double pr = 1.0, pi = 0.0;
        for (int j = 0; j <= 32; ++j) { LPr[j * 64 + p] = (float)pr; LPi[j * 64 + p] = (float)pi; const double nr = pr * lr - pi * li, ni = pr * li + pi * lr; pr = nr; pi = ni; }
        LAM[p] = LPr[32 * 64 + p]; LAM[64 + p] = LPi[32 * 64 + p];
    }
    for (int i = tid; i < 1024; i += NTHR) { const int h = i >> 6, p = i & 63; Cr[p * 16 + h] = c_re[i]; Ci[p * 16 + h] = c_im[i]; }
    __syncthreads();
    { const int j = tid >> 4, h = tid & 15; float acc[16];
#pragma unroll
      for (int e = 0; e < 16; ++e) acc[e] = 0.f;
      for (int p = 0; p < 64; ++p) { const float cr = Cr[p * 16 + h], ci = Ci[p * 16 + h], lr = LPr[j * 64 + p], li = LPi[j * 64 + p]; const float clr = cr * lr - ci * li, cli = cr * li + ci * lr;
#pragma unroll
          for (int q = 0; q < 4; ++q) { const f32x4 br = *(const LAS f32x4*)(Bbr + p * 16 + 4 * q), bi = *(const LAS f32x4*)(Bbi + p * 16 + 4 * q);
              acc[4 * q] += clr * br.x - cli * bi.x; acc[4 * q + 1] += clr * br.y - cli * bi.y; acc[4 * q + 2] += clr * br.z - cli * bi.z; acc[4 * q + 3] += clr * br.w - cli * bi.w; } }
#pragma unroll
      for (int e = 0; e < 16; ++e) KT[tid * 16 + e] = acc[e]; }
    __syncthreads();
    for (int q = tid; q < 512 * 64; q += NTHR) {
        const int row = q >> 6, cp = q & 63, s = cp >> 1, h0 = (cp & 1) * 8, t = row >> 4, h = row & 15;
        u32x4 o = (u32x4){0u, 0u, 0u, 0u};
        if (s <= t) { const LAS float* k = KT + ((t - s) * 16 + h) * 16 + h0; o.x = pk2(k[0], k[1]); o.y = pk2(k[2], k[3]); o.z = pk2(k[4], k[5]); o.w = pk2(k[6], k[7]); }
        *(u32x4*)(MF + (size_t)row * KA5 + cp * 8) = o;
    }
    for (int q = tid; q < 512 * 16; q += NTHR) {
        const int row = q >> 4, cp = q & 15, t = row >> 4, h = row & 15; float v[8];
#pragma unroll
        for (int e = 0; e < 8; ++e) { const int jj = cp * 8 + e, p = jj & 63; const float cr = Cr[p * 16 + h], ci = Ci[p * 16 + h], lr = LPr[(t + 1) * 64 + p], li = LPi[(t + 1) * 64 + p];
            v[e] = (jj < 64) ? (cr * lr - ci * li) : -(cr * li + ci * lr); }
        u32x4 o; o.x = pk2(v[0], v[1]); o.y = pk2(v[2], v[3]); o.z = pk2(v[4], v[5]); o.w = pk2(v[6], v[7]);
        *(u32x4*)(MF + (size_t)row * KA5 + 512 + cp * 8) = o;
    }
    for (int q = tid; q < 128 * 64; q += NTHR) {
        const int j = q >> 6, cp = q & 63, s = cp >> 1, h0 = (cp & 1) * 8, p = j & 63; const float lr = LPr[(31 - s) * 64 + p], li = LPi[(31 - s) * 64 + p]; float v[8];
#pragma unroll
        for (int e = 0; e < 8; ++e) { const float br = Bbr[p * 16 + h0 + e], bi = Bbi[p * 16 + h0 + e]; v[e] = (j < 64) ? (lr * br - li * bi) : (lr * bi + li * br); }
        u32x4 o; o.x = pk2(v[0], v[1]); o.y = pk2(v[2], v[3]); o.z = pk2(v[4], v[5]); o.w = pk2(v[6], v[7]);
        *(u32x4*)(WB + (size_t)j * 512 + cp * 8) = o;
    }
    __syncthreads();
}

__device__ __forceinline__ void norm0_phase(const Args& a, int lane, int gw, int NGW) {
    const float* X = a.in[0]; f32x4 gv[4];
#pragma unroll
    for (int j = 0; j < 4; ++j) gv[j] = *((const f32x4*)a.in[1] + lane + 64 * j);
    bf16* XN = (bf16*)(a.ws + WS_XN); float* SS = (float*)(a.ws + WS_SS);
    for (int m = gw; m < M; m += 2 * NGW) {
        const int m2 = m + NGW; const bool has2 = m2 < M;
        const f32x4* xr = (const f32x4*)(X + (size_t)m * DM) + lane; const f32x4* xr2 = (const f32x4*)(X + (size_t)(has2 ? m2 : m) * DM) + lane; f32x4 v[4], w[4];
#pragma unroll
        for (int j = 0; j < 4; ++j) { v[j] = xr[64 * j]; w[j] = xr2[64 * j]; }
        float ss = 0.f, ss2 = 0.f;
#pragma unroll
        for (int j = 0; j < 4; ++j) { ss += (v[j].x * v[j].x + v[j].y * v[j].y) + (v[j].z * v[j].z + v[j].w * v[j].w); ss2 += (w[j].x * w[j].x + w[j].y * w[j].y) + (w[j].z * w[j].z + w[j].w * w[j].w); }
        ss = wave_sum(ss); ss2 = wave_sum(ss2);
        unsigned long long* o8 = (unsigned long long*)(XN + (size_t)m * DM) + lane; unsigned long long* o82 = (unsigned long long*)(XN + (size_t)m2 * DM) + lane;
#pragma unroll
        for (int j = 0; j < 4; ++j) { v[j] = v[j] * gv[j]; o8[64 * j] = (unsigned long long)pk2(v[j].x, v[j].y) | ((unsigned long long)pk2(v[j].z, v[j].w) << 32);
            if (has2) { w[j] = w[j] * gv[j]; o82[64 * j] = (unsigned long long)pk2(w[j].x, w[j].y) | ((unsigned long long)pk2(w[j].z, w[j].w) << 32); } }
        if (lane == 0) { SS[m] = ss; if (has2) SS[m2] = ss2; }
    }
}
__device__ __forceinline__ void final_norm(const Args& a, float* X, const float* SS, int lane, int gw, int NGW) {
    f32x4 gv[4];
#pragma unroll
    for (int j = 0; j < 4; ++j) gv[j] = *((const f32x4*)a.in[15] + lane + 64 * j);
    for (int m = gw; m < M; m += 2 * NGW) {
        const int m2 = m + NGW; const bool has2 = m2 < M;
        f32x4* xr = (f32x4*)(X + (size_t)m * DM) + lane; f32x4* xr2 = (f32x4*)(X + (size_t)(has2 ? m2 : m) * DM) + lane; f32x4 v[4], w[4];
#pragma unroll
        for (int j = 0; j < 4; ++j) { v[j] = xr[64 * j]; w[j] = xr2[64 * j]; }
        const float r1 = rsqrtf(SS[m] * (1.f / DM) + EPS), r2 = rsqrtf(SS[has2 ? m2 : m] * (1.f / DM) + EPS);
#pragma unroll
        for (int j = 0; j < 4; ++j) { xr[64 * j] = v[j] * r1 * gv[j]; if (has2) xr2[64 * j] = w[j] * r2 * gv[j]; }
    }
}

__device__ __forceinline__ void flog_phase(const Args& a, int l, const float* SS, LAS float* WF, int tid, int lane, int wave, int blk, int nblk) {
    const float* win = a.in[2] + (size_t)l * DM * NIN;
    for (int i = tid; i < 2048; i += NTHR) { const int k = i >> 1, hf = i & 1; *(LAS f32x4*)(WF + k * 8 + hf * 4) = *(const f32x4*)(win + (size_t)k * NIN + 1536 + hf * 4); }
    __syncthreads();
    const bf16* XN = (const bf16*)(a.ws + WS_XN); float* LOGF = (float*)(a.ws + WS_LOGF);
    const float bfj = (lane < 8) ? a.in[3][l * 8 + lane] : 0.f;
    const int rows_per = M / nblk;
    for (int i = wave; i < rows_per; i += 2 * NWAVES) {
        const int m = blk * rows_per + i, m2 = m + NWAVES; const bool has2 = (i + NWAVES) < rows_per;
        const u32x4 x0 = *((const u32x4*)(XN + (size_t)m * DM) + lane), x1 = *((const u32x4*)(XN + (size_t)m * DM + 512) + lane);
        const u32x4 y0 = *((const u32x4*)(XN + (size_t)(has2 ? m2 : m) * DM) + lane), y1 = *((const u32x4*)(XN + (size_t)(has2 ? m2 : m) * DM + 512) + lane);
        float acc[8], acc2[8];
#pragma unroll
        for (int e = 0; e < 8; ++e) { acc[e] = 0.f; acc2[e] = 0.f; }
#pragma unroll
        for (int hf = 0; hf < 2; ++hf)
#pragma unroll
            for (int q = 0; q < 8; ++q) { const int k = 512 * hf + 8 * lane + q; const f32x4 w0 = *(const LAS f32x4*)(WF + k * 8), w1 = *(const LAS f32x4*)(WF + k * 8 + 4);
                const unsigned xw = hf ? x1[q >> 1] : x0[q >> 1], yw = hf ? y1[q >> 1] : y0[q >> 1]; const float hv = (q & 1) ? bfhi(xw) : bflo(xw), hv2 = (q & 1) ? bfhi(yw) : bflo(yw);
                acc[0] += hv * w0.x; acc[1] += hv * w0.y; acc[2] += hv * w0.z; acc[3] += hv * w0.w; acc[4] += hv * w1.x; acc[5] += hv * w1.y; acc[6] += hv * w1.z; acc[7] += hv * w1.w;
                acc2[0] += hv2 * w0.x; acc2[1] += hv2 * w0.y; acc2[2] += hv2 * w0.z; acc2[3] += hv2 * w0.w; acc2[4] += hv2 * w1.x; acc2[5] += hv2 * w1.y; acc2[6] += hv2 * w1.z; acc2[7] += hv2 * w1.w; }
        float mine = 0.f, mine2 = 0.f;
#pragma unroll
        for (int e = 0; e < 8; ++e) { const float s = wave_sum(acc[e]), s2 = wave_sum(acc2[e]); if (lane == e) { mine = s; mine2 = s2; } }
        if (lane < 8) { const float z = mine * rsqrtf(SS[m] * (1.f / DM) + EPS) + bfj; LOGF[(size_t)((m >> 12) * 8 + lane) * SEQ + (m & 4095)] = fminf(z, 0.f) - log1pf(expf(-fabsf(z)));
            if (has2) { const float z2 = mine2 * rsqrtf(SS[m2] * (1.f / DM) + EPS) + bfj; LOGF[(size_t)((m2 >> 12) * 8 + lane) * SEQ + (m2 & 4095)] = fminf(z2, 0.f) - log1pf(expf(-fabsf(z2))); } }
    }
}

__device__ __forceinline__ bool opaque_true() { int d = 1; asm volatile("" : "+s"(d)); return d != 0; }
struct FlatOrder {
    int nM, nN, nG, G, c;
    __device__ bool next(int i, pg8::Unit& u) const { const int L = i * G + c; if (L >= nG * nM * nN) return false; u.gz = L / (nM * nN); const int r = L % (nM * nN); u.pm = r % nM; u.pn = r / nM; return true; }
    __device__ __forceinline__ void a_ready(const pg8::Unit&) const {}
    __device__ __forceinline__ void done(const pg8::Unit&) const {}
};
__device__ __forceinline__ float silu_f(float v) { return v / (1.f + __expf(-v)); }
__device__ __forceinline__ float gelu_tanh(float v) { const float u = 0.7978845608028654f * (v + 0.044715f * v * v * v); const float e = __expf(2.f * u); const float th = 1.f - 2.f / (e + 1.f); return 0.5f * v * (1.f + th); }

struct EpiInProj {
    static constexpr bool PERM = true, AFTER_DRAIN = false;
    unsigned char* ws; const float* SS; const float* bfl;
    __device__ __forceinline__ void operator()(const pg8::f32x4 (&acc)[2][2][4][2], const pg8::Unit& u, int wr, int wc, int fr, int fq) const {
        const int pn = u.pn; const int row0 = u.pm * 256 + wr * 64 + fr, cl0 = wc * 32 + 8 * fq;
        float rs[2][4];
#pragma unroll
        for (int ai = 0; ai < 2; ++ai)
#pragma unroll
            for (int m = 0; m < 4; ++m) rs[ai][m] = rsqrtf(SS[row0 + ai * 128 + m * 16] * (1.f / DM) + EPS);
        if (pn == 14) {
            if (wc == 0 && fq == 0) { float* LOGF = (float*)(ws + WS_LOGF); const f32x4 b0 = *(const f32x4*)bfl, b1 = *(const f32x4*)(bfl + 4);
#pragma unroll
                for (int ai = 0; ai < 2; ++ai)
#pragma unroll
                    for (int m = 0; m < 4; ++m) { const int row = row0 + ai * 128 + m * 16; const float r = rs[ai][m]; const pg8::f32x4 v0 = acc[ai][0][m][0], v1 = acc[ai][0][m][1];
                        float z[8] = {v0[0] * r + b0.x, v0[1] * r + b0.y, v0[2] * r + b0.z, v0[3] * r + b0.w, v1[0] * r + b1.x, v1[1] * r + b1.y, v1[2] * r + b1.z, v1[3] * r + b1.w};
#pragma unroll
                        for (int e = 0; e < 8; ++e) LOGF[(size_t)((row >> 12) * 8 + e) * SEQ + (row & 4095)] = fminf(z[e], 0.f) - log1pf(__expf(-fabsf(z[e]))); } }
            return;
        }
        if (pn < 6) {
            bf16* base = (bf16*)(ws + (pn < 2 ? WS_QO : pn < 4 ? WS_KB : WS_VB)); const float sc = pn < 2 ? 0.125f * LOG2E : 1.f; const int cb = (pn & 1) * 256 + cl0;
#pragma unroll
            for (int ai = 0; ai < 2; ++ai)
#pragma unroll
                for (int m = 0; m < 4; ++m) { bf16* rp = base + (size_t)(row0 + ai * 128 + m * 16) * 512 + cb;
#pragma unroll
                    for (int bj = 0; bj < 2; ++bj) { const float sr = sc * rs[ai][m]; const pg8::f32x4 v0 = acc[ai][bj][m][0] * sr, v1 = acc[ai][bj][m][1] * sr; u32x4 w; w.x = pk2(v0[0], v0[1]); w.y = pk2(v0[2], v0[3]); w.z = pk2(v1[0], v1[1]); w.w = pk2(v1[2], v1[3]); *(u32x4*)(rp + bj * 128) = w; } }
        } else if (pn == 6) {
            bf16* base = (bf16*)(ws + WS_SUA);
#pragma unroll
            for (int ai = 0; ai < 2; ++ai)
#pragma unroll
                for (int m = 0; m < 4; ++m) { const int row = row0 + ai * 128 + m * 16, chunk = row >> 5, t = row & 31;
#pragma unroll
                    for (int bj = 0; bj < 2; ++bj) { const int c = cl0 + bj * 128, g = c >> 4, h0 = c & 15; const pg8::f32x4 v0 = acc[ai][bj][m][0] * rs[ai][m], v1 = acc[ai][bj][m][1] * rs[ai][m]; u32x4 w; w.x = pk2(v0[0], v0[1]); w.y = pk2(v0[2], v0[3]); w.z = pk2(v1[0], v1[1]); w.w = pk2(v1[2], v1[3]);
                        *(u32x4*)(base + ((size_t)(g * 512 + chunk) * KA5 + t * 16 + h0)) = w; } }
        } else if (pn == 7 || pn == 8) {
            const f32x4* rope = (const f32x4*)(ws + WS_ROPE); bf16* base = (bf16*)(ws + (pn == 7 ? WS_RQ : WS_RK)); bf16* RKT = (bf16*)(ws + WS_RKT);
#pragma unroll
            for (int ai = 0; ai < 2; ++ai)
#pragma unroll
                for (int m = 0; m < 4; ++m) { const int row = row0 + ai * 128 + m * 16, b = row >> 12, t = row & 4095;
#pragma unroll
                    for (int bj = 0; bj < 2; ++bj) { const int c = cl0 + bj * 128, hh = c >> 6, pos0 = c & 63; const pg8::f32x4 v0 = acc[ai][bj][m][0] * rs[ai][m], v1 = acc[ai][bj][m][1] * rs[ai][m];
                        const f32x4 r0 = rope[(t * 32 + (pos0 >> 1)) >> 1], r1 = rope[((t * 32 + (pos0 >> 1)) >> 1) + 1];
                        float o[8];
                        o[0] = v0[0] * r0.x - v0[1] * r0.y; o[1] = v0[0] * r0.y + v0[1] * r0.x; o[2] = v0[2] * r0.z - v0[3] * r0.w; o[3] = v0[2] * r0.w + v0[3] * r0.z;
                        o[4] = v1[0] * r1.x - v1[1] * r1.y; o[5] = v1[0] * r1.y + v1[1] * r1.x; o[6] = v1[2] * r1.z - v1[3] * r1.w; o[7] = v1[2] * r1.w + v1[3] * r1.z;
                        u32x4 w; w.x = pk2(o[0], o[1]); w.y = pk2(o[2], o[3]); w.z = pk2(o[4], o[5]); w.w = pk2(o[6], o[7]);
                        *(u32x4*)(base + (size_t)row * 256 + c) = w;
                        if (pn == 8) { const float wk = exp2f(lg2_gamma(hh) * (float)(63 - (t & 63))); bf16* tp = RKT + ((size_t)((b * 4 + hh) * 64 + pos0)) * SEQ + t;
#pragma unroll
                            for (int e = 0; e < 8; ++e) tp[(size_t)e * SEQ] = f2bf(o[e] * wk); } } }
        } else if (pn == 9) {
            bf16* RVT = (bf16*)(ws + WS_RVT);
#pragma unroll
            for (int ai = 0; ai < 2; ++ai)
#pragma unroll
                for (int m = 0; m < 4; ++m) { const int row = row0 + ai * 128 + m * 16, b = row >> 12, t = row & 4095;
#pragma unroll
                    for (int bj = 0; bj < 2; ++bj) { const int c = cl0 + bj * 128, hh = c >> 6, d0 = c & 63; const pg8::f32x4 v0 = acc[ai][bj][m][0] * rs[ai][m], v1 = acc[ai][bj][m][1] * rs[ai][m]; bf16* tp = RVT + ((size_t)((b * 4 + hh) * 64 + d0)) * SEQ + t;
#pragma unroll
                        for (int e = 0; e < 4; ++e) { tp[(size_t)e * SEQ] = f2bf(v0[e]); tp[(size_t)(4 + e) * SEQ] = f2bf(v1[e]); } } }
        } else {
            bf16* base = (bf16*)(ws + WS_GATE); const int cb = (pn - 10) * 256 + cl0;
#pragma unroll
            for (int ai = 0; ai < 2; ++ai)
#pragma unroll
                for (int m = 0; m < 4; ++m) { bf16* rp = base + (size_t)(row0 + ai * 128 + m * 16) * 1024 + cb;
#pragma unroll
                    for (int bj = 0; bj < 2; ++bj) { const pg8::f32x4 v0 = acc[ai][bj][m][0] * rs[ai][m], v1 = acc[ai][bj][m][1] * rs[ai][m]; u32x4 w; w.x = pk2(silu_f(v0[0]), silu_f(v0[1])); w.y = pk2(silu_f(v0[2]), silu_f(v0[3])); w.z = pk2(silu_f(v1[0]), silu_f(v1[1])); w.w = pk2(silu_f(v1[2]), silu_f(v1[3])); *(u32x4*)(rp + bj * 128) = w; } }
        }
    }
};
struct EpiS5E {
    static constexpr bool PERM = false, AFTER_DRAIN = false;
    float* E;
    __device__ __forceinline__ void operator()(const pg8::f32x4 (&acc)[2][2][4][2], const pg8::Unit& u, int wr, int wc, int fr, int fq) const {
        const int row0 = u.pm * 256 + wr * 64 + fr, col0 = wc * 32 + 4 * fq;
#pragma unroll
        for (int ai = 0; ai < 2; ++ai)
#pragma unroll
            for (int m = 0; m < 4; ++m) { float* rp = E + ((size_t)u.gz * NCH5 + row0 + ai * 128 + m * 16) * 128 + col0;
#pragma unroll
                for (int n = 0; n < 2; ++n) *(pg8::f32x4*)(rp + n * 16) = acc[ai][0][m][n]; }
    }
};
struct EpiS5Y {
    static constexpr bool PERM = true, AFTER_DRAIN = false;
    const bf16* SUA; bf16* YS5; const float* dvec;
    __device__ __forceinline__ void operator()(const pg8::f32x4 (&acc)[2][2][4][2], const pg8::Unit& u, int wr, int wc, int fr, int fq) const {
        const int row0 = u.pm * 256 + wr * 64 + fr, cl0 = u.pn * 256 + wc * 32 + 8 * fq; const int g = u.gz;
#pragma unroll
        for (int bj = 0; bj < 2; ++bj) { const int c = cl0 + bj * 128, tt = c >> 4, h0 = c & 15; const f32x4 d0 = *(const f32x4*)(dvec + g * 16 + h0), d1 = *(const f32x4*)(dvec + g * 16 + h0 + 4);
#pragma unroll
            for (int ai = 0; ai < 2; ++ai)
#pragma unroll
                for (int m = 0; m < 4; ++m) { const int chunk = row0 + ai * 128 + m * 16; const u32x4 uu = *(const u32x4*)(SUA + ((size_t)(g * 512 + chunk) * KA5 + c)); const pg8::f32x4 v0 = acc[ai][bj][m][0], v1 = acc[ai][bj][m][1];
                    float y[8]; y[0] = v0[0] + d0.x * bflo(uu.x); y[1] = v0[1] + d0.y * bfhi(uu.x); y[2] = v0[2] + d0.z * bflo(uu.y); y[3] = v0[3] + d0.w * bfhi(uu.y);
                    y[4] = v1[0] + d1.x * bflo(uu.z); y[5] = v1[1] + d1.y * bfhi(uu.z); y[6] = v1[2] + d1.z * bflo(uu.w); y[7] = v1[3] + d1.w * bfhi(uu.w);
#pragma unroll
                    for (int e = 0; e < 8; ++e) y[e] = gelu_tanh(y[e]);
                    u32x4 w; w.x = pk2(y[0], y[1]); w.y = pk2(y[2], y[3]); w.z = pk2(y[4], y[5]); w.w = pk2(y[6], y[7]);
                    *(u32x4*)(YS5 + (size_t)(chunk * 32 + tt) * 256 + g * 16 + h0) = w; } }
    }
};
struct EpiGlu {
    static constexpr bool PERM = true, AFTER_DRAIN = false;
    const bf16* YS5; bf16* G; bool dry;
    __device__ __forceinline__ void operator()(const pg8::f32x4 (&acc)[2][2][4][2], const pg8::Unit& u, int wr, int wc, int fr, int fq) const {
        const int row0 = u.pm * 256 + wr * 64 + fr, cl0 = wc * 32 + 8 * fq;
#pragma unroll
        for (int ai = 0; ai < 2; ++ai)
#pragma unroll
            for (int m = 0; m < 4; ++m) { const int row = row0 + ai * 128 + m * 16;
#pragma unroll
                for (int bj = 0; bj < 2; ++bj) { const int c = cl0 + bj * 128; const u32x4 yy = *(const u32x4*)(YS5 + (size_t)row * 256 + c); bf16* gp = G + (size_t)row * 1024 + 512 + c; const u32x4 gg = *(const u32x4*)gp;
                    const pg8::f32x4 v0 = acc[ai][bj][m][0], v1 = acc[ai][bj][m][1]; float s[8];
#pragma unroll
                    for (int e = 0; e < 4; ++e) { s[e] = 1.f / (1.f + __expf(-v0[e])); s[4 + e] = 1.f / (1.f + __expf(-v1[e])); }
                    u32x4 w; w.x = pk2(bflo(yy.x) * s[0] * bflo(gg.x), bfhi(yy.x) * s[1] * bfhi(gg.x)); w.y = pk2(bflo(yy.y) * s[2] * bflo(gg.y), bfhi(yy.y) * s[3] * bfhi(gg.y));
                    w.z = pk2(bflo(yy.z) * s[4] * bflo(gg.z), bfhi(yy.z) * s[5] * bfhi(gg.z)); w.w = pk2(bflo(yy.w) * s[6] * bflo(gg.w), bfhi(yy.w) * s[7] * bfhi(gg.w));
                    if (!dry) *(u32x4*)gp = w; } }
    }
};
struct EpiOut {
    static constexpr bool PERM = false, AFTER_DRAIN = false;
    const float* base; float* out; float* SSn; bf16* XN; const float* gnext; bool dry;
    __device__ __forceinline__ void operator()(const pg8::f32x4 (&acc)[2][2][4][2], const pg8::Unit& u, int wr, int wc, int fr, int fq) const {
        const int row0 = u.pm * 256 + wr * 64 + fr, col0 = u.pn * 256 + wc * 32 + 4 * fq;
        f32x4 gq[2][2];
#pragma unroll
        for (int bj = 0; bj < 2; ++bj)
#pragma unroll
            for (int n = 0; n < 2; ++n) gq[bj][n] = gnext ? *(const f32x4*)(gnext + col0 + bj * 128 + n * 16) : (f32x4){0.f, 0.f, 0.f, 0.f};
#pragma unroll
        for (int ai = 0; ai < 2; ++ai)
#pragma unroll
            for (int m = 0; m < 4; ++m) { const int row = row0 + ai * 128 + m * 16; const size_t off = (size_t)row * DM + col0; float sq = 0.f;
#pragma unroll
                for (int bj = 0; bj < 2; ++bj)
#pragma unroll
                    for (int n = 0; n < 2; ++n) { const f32x4 bs = *(const f32x4*)(base + off + bj * 128 + n * 16); const pg8::f32x4 v = acc[ai][bj][m][n]; const f32x4 x = (f32x4){bs.x + v[0], bs.y + v[1], bs.z + v[2], bs.w + v[3]};
                        sq += (x.x * x.x + x.y * x.y) + (x.z * x.z + x.w * x.w);
                        if (!dry) { *(f32x4*)(out + off + bj * 128 + n * 16) = x;
                            if (gnext) { const f32x4 g = gq[bj][n]; u32x2 w; w.x = pk2(x.x * g.x, x.y * g.y); w.y = pk2(x.z * g.z, x.w * g.w); *(u32x2*)(XN + off + bj * 128 + n * 16) = w; } } }
                sq += __shfl_xor(sq, 16); sq += __shfl_xor(sq, 32);
                if (fq == 0 && !dry) __hip_atomic_fetch_add(SSn + row, sq, __ATOMIC_RELAXED, __HIP_MEMORY_SCOPE_AGENT); }
    }
};

template <int KS, int UNR, class Epi> __device__ __forceinline__ void wave_gemm64(const bf16* A, int lda, const bf16* B, int ldb, int lane, const Epi& epi) {
    const int fr = lane & 15, fq = lane >> 4;
    pg8::f32x4 acc[4][4];
#pragma unroll
    for (int jb = 0; jb < 4; ++jb)
#pragma unroll
        for (int ib = 0; ib < 4; ++ib) acc[jb][ib] = (pg8::f32x4){0.f, 0.f, 0.f, 0.f};
    const bf16* ap = A + (size_t)fr * lda + 8 * fq; const bf16* bp = B + (size_t)fr * ldb + 8 * fq;
#pragma unroll UNR
    for (int ks = 0; ks < KS; ++ks) {
        bf16x8 af[4], bv[4];
#pragma unroll
        for (int ib = 0; ib < 4; ++ib) { af[ib] = *(const bf16x8*)(ap + (size_t)(16 * ib) * lda + 32 * ks); bv[ib] = *(const bf16x8*)(bp + (size_t)(16 * ib) * ldb + 32 * ks); }
#pragma unroll
        for (int jb = 0; jb < 4; ++jb)
#pragma unroll
            for (int ib = 0; ib < 4; ++ib) acc[jb][ib] = __builtin_amdgcn_mfma_f32_16x16x32_bf16(bv[jb], af[ib], acc[jb][ib], 0, 0, 0);
    }
    epi(acc, fr, fq);
}
struct WEpiE {
    float* E;
    __device__ __forceinline__ void operator()(const pg8::f32x4 (&acc)[4][4], int fr, int fq) const {
#pragma unroll
        for (int jb = 0; jb < 4; ++jb)
#pragma unroll
            for (int ib = 0; ib < 4; ++ib) *(pg8::f32x4*)(E + (size_t)(16 * ib + fr) * 128 + 16 * jb + 4 * fq) = acc[jb][ib];
    }
};
struct WEpiS5Y {
    const bf16* SUAg; bf16* YS5; const float* dg; int chunk0, col0, g;
    __device__ __forceinline__ void operator()(const pg8::f32x4 (&acc)[4][4], int fr, int fq) const {
#pragma unroll
        for (int jb = 0; jb < 4; ++jb) { const int col = col0 + 16 * jb + 4 * fq, tt = col >> 4, h0 = col & 15; const f32x4 d4 = *(const f32x4*)(dg + h0);
#pragma unroll
            for (int ib = 0; ib < 4; ++ib) { const int chunk = chunk0 + 16 * ib + fr; const u32x2 uu = *(const u32x2*)(SUAg + (size_t)chunk * KA5 + col); const pg8::f32x4 v = acc[jb][ib];
                const float y0 = gelu_tanh(v[0] + d4.x * bflo(uu.x)), y1 = gelu_tanh(v[1] + d4.y * bfhi(uu.x)), y2 = gelu_tanh(v[2] + d4.z * bflo(uu.y)), y3 = gelu_tanh(v[3] + d4.w * bfhi(uu.y));
                u32x2 w; w.x = pk2(y0, y1); w.y = pk2(y2, y3); *(u32x2*)(YS5 + (size_t)(chunk * 32 + tt) * 256 + g * 16 + h0) = w; } }
    }
};
struct WEpiGlu {
    const bf16* YS5; bf16* G; int row0, col0;
    __device__ __forceinline__ void operator()(const pg8::f32x4 (&acc)[4][4], int fr, int fq) const {
#pragma unroll
        for (int jb = 0; jb < 4; ++jb)
#pragma unroll
            for (int ib = 0; ib < 4; ++ib) { const int row = row0 + 16 * ib + fr, col = col0 + 16 * jb + 4 * fq; const u32x2 yy = *(const u32x2*)(YS5 + (size_t)row * 256 + col); bf16* gp = G + (size_t)row * 1024 + 512 + col; const u32x2 gg = *(const u32x2*)gp; const pg8::f32x4 v = acc[jb][ib];
                const float s0 = 1.f / (1.f + __expf(-v[0])), s1 = 1.f / (1.f + __expf(-v[1])), s2 = 1.f / (1.f + __expf(-v[2])), s3 = 1.f / (1.f + __expf(-v[3]));
                u32x2 w; w.x = pk2(bflo(yy.x) * s0 * bflo(gg.x), bfhi(yy.x) * s1 * bfhi(gg.x)); w.y = pk2(bflo(yy.y) * s2 * bflo(gg.y), bfhi(yy.y) * s3 * bfhi(gg.y)); *(u32x2*)gp = w; }
    }
};

__device__ __forceinline__ void ret_upd_unit(unsigned char* ws, int unit, int lane) {
    const int c = unit & 63, bh = unit >> 6; const int i16 = lane & 15, kq = lane >> 4;
    const bf16* KT = (const bf16*)(ws + WS_RKT) + (size_t)bh * 64 * SEQ + c * 64; const bf16* VT = (const bf16*)(ws + WS_RVT) + (size_t)bh * 64 * SEQ + c * 64;
    float* UPD = (float*)(ws + WS_UPD) + (size_t)unit * 4096;
    bf16x8 af[4][2], bfv[4][2];
#pragma unroll
    for (int ib = 0; ib < 4; ++ib)
#pragma unroll
        for (int ks = 0; ks < 2; ++ks) { af[ib][ks] = *(const bf16x8*)(KT + (size_t)(16 * ib + i16) * SEQ + 32 * ks + 8 * kq); bfv[ib][ks] = *(const bf16x8*)(VT + (size_t)(16 * ib + i16) * SEQ + 32 * ks + 8 * kq); }
#pragma unroll
    for (int ib = 0; ib < 4; ++ib)
#pragma unroll
        for (int jb = 0; jb < 4; ++jb) { pg8::f32x4 d = (pg8::f32x4){0.f, 0.f, 0.f, 0.f};
            d = __builtin_amdgcn_mfma_f32_16x16x32_bf16(af[ib][0], bfv[jb][0], d, 0, 0, 0); d = __builtin_amdgcn_mfma_f32_16x16x32_bf16(af[ib][1], bfv[jb][1], d, 0, 0, 0);
            *(pg8::f32x4*)(UPD + (size_t)(16 * jb + i16) * 64 + 16 * ib + 4 * kq) = d; }
}
__device__ __forceinline__ void ret_out_unit(const Args& a, int l, int unit, int lane, bool dry = false) {
    unsigned char* ws = a.ws;
    const int c = unit & 63, bh = unit >> 6, hh = bh & 3, b = bh >> 2; const int fr = lane & 15, fq = lane >> 4;
    const size_t t0 = (size_t)b * SEQ + c * 64;
    const bf16* RQ = (const bf16*)(ws + WS_RQ) + t0 * 256 + hh * 64; const bf16* RK = (const bf16*)(ws + WS_RK) + t0 * 256 + hh * 64;
    const bf16* VT = (const bf16*)(ws + WS_RVT) + (size_t)bh * 64 * SEQ + c * 64; const bf16* ST = (const bf16*)(ws + WS_STATE) + (size_t)unit * 4096;
    const float lg = lg2_gamma(hh);
    bf16x8 qf[4][2]; pg8::f32x4 st[4][4];
#pragma unroll
    for (int nb = 0; nb < 4; ++nb)
#pragma unroll
        for (int ks = 0; ks < 2; ++ks) qf[nb][ks] = *(const bf16x8*)(RQ + (size_t)(16 * nb + fr) * 256 + 32 * ks + 8 * fq);
#pragma unroll
    for (int mb = 0; mb < 4; ++mb) { bf16x8 k0 = *(const bf16x8*)(RK + (size_t)(16 * mb + fr) * 256 + 8 * fq), k1 = *(const bf16x8*)(RK + (size_t)(16 * mb + fr) * 256 + 32 + 8 * fq);
#pragma unroll
        for (int nb = 0; nb < 4; ++nb) { pg8::f32x4 d = (pg8::f32x4){0.f, 0.f, 0.f, 0.f};
            d = __builtin_amdgcn_mfma_f32_16x16x32_bf16(k0, qf[nb][0], d, 0, 0, 0); d = __builtin_amdgcn_mfma_f32_16x16x32_bf16(k1, qf[nb][1], d, 0, 0, 0);
#pragma unroll
            for (int r = 0; r < 4; ++r) { const int mm = 16 * mb + 4 * fq + r, nn = 16 * nb + fr; const int df = mm > nn ? mm - nn : nn - mm; d[r] *= 0.125f * exp2f(lg * (float)df); }
            st[mb][nb] = d; } }
    pg8::f32x4 o[4][4];
#pragma unroll
    for (int nb = 0; nb < 4; ++nb)
#pragma unroll
        for (int dvb = 0; dvb < 4; ++dvb) o[nb][dvb] = (pg8::f32x4){0.f, 0.f, 0.f, 0.f};
#pragma unroll
    for (int dvb = 0; dvb < 4; ++dvb) { const bf16x8 s0 = *(const bf16x8*)(ST + (size_t)(16 * dvb + fr) * 64 + 8 * fq), s1 = *(const bf16x8*)(ST + (size_t)(16 * dvb + fr) * 64 + 32 + 8 * fq);
#pragma unroll
        for (int nb = 0; nb < 4; ++nb) { o[nb][dvb] = __builtin_amdgcn_mfma_f32_16x16x32_bf16(qf[nb][0], s0, o[nb][dvb], 0, 0, 0); o[nb][dvb] = __builtin_amdgcn_mfma_f32_16x16x32_bf16(qf[nb][1], s1, o[nb][dvb], 0, 0, 0); } }
#pragma unroll
    for (int nb = 0; nb < 4; ++nb)
#pragma unroll
        for (int r = 0; r < 4; ++r) { const float wq = 0.125f * exp2f(lg * (float)(16 * nb + 4 * fq + r + 1));
#pragma unroll
            for (int dvb = 0; dvb < 4; ++dvb) o[nb][dvb][r] *= wq; }
#pragma unroll
    for (int s = 0; s < 2; ++s) {
        bf16x8 pa[4];
#pragma unroll
        for (int nb = 0; nb < 4; ++nb) { u32x4 w; w.x = pk2(st[2 * s][nb][0], st[2 * s][nb][1]); w.y = pk2(st[2 * s][nb][2], st[2 * s][nb][3]); w.z = pk2(st[2 * s + 1][nb][0], st[2 * s + 1][nb][1]); w.w = pk2(st[2 * s + 1][nb][2], st[2 * s + 1][nb][3]); pa[nb] = __builtin_bit_cast(bf16x8, w); }
#pragma unroll
        for (int dvb = 0; dvb < 4; ++dvb) { const u32x2 v0 = *(const u32x2*)(VT + (size_t)(16 * dvb + fr) * SEQ + 32 * s + 4 * fq), v1 = *(const u32x2*)(VT + (size_t)(16 * dvb + fr) * SEQ + 32 * s + 16 + 4 * fq);
            const bf16x8 vf = __builtin_bit_cast(bf16x8, (u32x4){v0.x, v0.y, v1.x, v1.y});
#pragma unroll
            for (int nb = 0; nb < 4; ++nb) o[nb][dvb] = __builtin_amdgcn_mfma_f32_16x16x32_bf16(pa[nb], vf, o[nb][dvb], 0, 0, 0); }
    }
    const float* gn = a.in[13] + (size_t)l * 256 + hh * 64; float gnw[4];
#pragma unroll
    for (int dvb = 0; dvb < 4; ++dvb) gnw[dvb] = gn[16 * dvb + fr];
    bf16* Y = (bf16*)(ws + WS_GATE) + t0 * 1024 + 768 + hh * 64;
#pragma unroll
    for (int nb = 0; nb < 4; ++nb)
#pragma unroll
        for (int r = 0; r < 4; ++r) { float s = (o[nb][0][r] + o[nb][1][r]) + (o[nb][2][r] + o[nb][3][r]);
            s += __shfl_xor(s, 1); s += __shfl_xor(s, 2); s += __shfl_xor(s, 4); s += __shfl_xor(s, 8);
            const float mu = s * (1.f / 64.f); float q = 0.f;
#pragma unroll
            for (int dvb = 0; dvb < 4; ++dvb) { const float d = o[nb][dvb][r] - mu; q += d * d; }
            q += __shfl_xor(q, 1); q += __shfl_xor(q, 2); q += __shfl_xor(q, 4); q += __shfl_xor(q, 8);
            const float rstd = rsqrtf(q * (1.f / 64.f) + EPS); bf16* yp = Y + (size_t)(16 * nb + 4 * fq + r) * 1024 + fr;
#pragma unroll
            for (int dvb = 0; dvb < 4; ++dvb) { const float gt = bf2f(yp[16 * dvb]); if (!dry) yp[16 * dvb] = f2bf((o[nb][dvb][r] - mu) * rstd * gnw[dvb] * gt); } }
}

#define XB_TMO      128
#define XB_XCNT(j)  (256  + 64 * (j))
#define XB_XSUB(j)  (1280 + 64 * (j))
#define XB_XGEN(j)  (2304 + 64 * (j))
#define XB_TOP      3328
#define XB_TOPGEN   3392
#define XCD_BAR_WORDS 3456
#define XB_SPIN_CAP (1u << 18)

__device__ __forceinline__ unsigned xb_ld(unsigned* p)              { return __hip_atomic_load(p, __ATOMIC_RELAXED, __HIP_MEMORY_SCOPE_AGENT); }
__device__ __forceinline__ unsigned xb_add(unsigned* p, unsigned v) { return __hip_atomic_fetch_add(p, v, __ATOMIC_RELAXED, __HIP_MEMORY_SCOPE_AGENT); }
__device__ __forceinline__ unsigned xb_xcc_id() { return (unsigned)__builtin_amdgcn_s_getreg((3 << 11) | 20) & 0xFu; }
#define XB_SPIN(cond, bar) do { unsigned _sp = 0; while (cond) { __builtin_amdgcn_s_sleep(1); \
    if ((++_sp & 255u) == 0u) { if (xb_ld(&(bar)[XB_TMO])) break; if (_sp > XB_SPIN_CAP) { atomicAdd(&(bar)[XB_TMO], 1u); break; } } } } while (0)

struct XcdBarrier {
    unsigned* bar; unsigned x;
    volatile LAS unsigned* st;
};

__device__ __forceinline__ XcdBarrier xcd_barrier_post(unsigned* bar, volatile LAS unsigned* st) {
    XcdBarrier b; b.bar = bar; b.x = xb_xcc_id(); b.st = st;
    if (threadIdx.x == 0) (void)xb_add(&bar[XB_XCNT(b.x)], 1u);
    return b;
}
__device__ __forceinline__ void xcd_barrier_complete(unsigned* bar, unsigned x, unsigned& nloc, unsigned& nx) {
    const unsigned G = gridDim.x * gridDim.y * gridDim.z;
    unsigned sum, cnt, mine, sp = 0u;
    for (;;) {
        sum = 0u; cnt = 0u; mine = 0u;
#pragma unroll
        for (unsigned j = 0; j < 16; ++j) { const unsigned c = xb_ld(&bar[XB_XCNT(j)]); sum += c; cnt += (c > 0u) ? 1u : 0u; mine = (j == x) ? c : mine; }
        if (sum == G) break;
        __builtin_amdgcn_s_sleep(1);
        if ((++sp & 255u) == 0u) { if (xb_ld(&bar[XB_TMO])) break; if (sp > XB_SPIN_CAP) { atomicAdd(&bar[XB_TMO], 1u); break; } }
    }
    nloc = mine > 0u ? mine : 1u; nx = cnt > 0u ? cnt : 1u;
}

__device__ __forceinline__ void xcd_barrier(const XcdBarrier& b) {
    asm volatile("s_waitcnt vmcnt(0)" ::: "memory");
    __syncthreads();
    if (threadIdx.x == 0) {
        unsigned* bar = b.bar;
        __builtin_amdgcn_s_waitcnt(0);
        unsigned nloc = b.st[0], nx = b.st[1];
        if (nloc == 0u) { xcd_barrier_complete(bar, b.x, nloc, nx); b.st[0] = nloc; b.st[1] = nx; }
        const unsigned old = xb_add(&bar[XB_XSUB(b.x)], 1u);
        const unsigned gen = old / nloc;
        if (old + 1u == (gen + 1u) * nloc) {
            __builtin_amdgcn_fence(__ATOMIC_RELEASE, "agent");
            asm volatile("s_waitcnt vmcnt(0)" ::: "memory");
            const unsigned og = xb_add(&bar[XB_TOP], 1u);
            const unsigned tg = og / nx;
            if (og + 1u == (tg + 1u) * nx) xb_add(&bar[XB_TOPGEN], 1u);
            else XB_SPIN(xb_ld(&bar[XB_TOPGEN]) == tg, bar);
            __builtin_amdgcn_fence(__ATOMIC_ACQUIRE, "agent");
            xb_add(&bar[XB_XGEN(b.x)], 1u);
            asm volatile("s_waitcnt vmcnt(0)" ::: "memory");
        } else {
            XB_SPIN(xb_ld(&bar[XB_XGEN(b.x)]) == gen, bar);
            __builtin_amdgcn_fence(__ATOMIC_ACQUIRE, "agent");
            asm volatile("s_waitcnt vmcnt(0)" ::: "memory");
        }
    }
    __syncthreads();
}

#ifdef REP_SYNC
#define GSYNC() do { xcd_barrier(xbar); xcd_barrier(xbar); } while (0)
#else
#define GSYNC() xcd_barrier(xbar)
#endif
#ifndef REP_P0
#define REP_P0 1
#endif
#ifndef REP_P1
#define REP_P1 1
#endif
#ifndef REP_P23
#define REP_P23 1
#endif
#ifndef REP_NORM
#define REP_NORM 1
#endif
__global__ void __launch_bounds__(NTHR, 2) mega_fwd(Args args) {
    extern __shared__ __attribute__((aligned(16))) unsigned char lds[];
    cg::grid_group grid = cg::this_grid();
    const int tid = threadIdx.x, lane = tid & 63, wave = __builtin_amdgcn_readfirstlane(tid >> 6);
    const int G = gridDim.x, bx = blockIdx.x; const int vcu = (G % 8 == 0) ? (bx % 8) * (G / 8) + bx / 8 : bx;
    const int gw = bx * NWAVES + wave, NGW = G * NWAVES;
    unsigned char* ws = args.ws;
    LAS unsigned char* ldsl = (LAS unsigned char*)lds;
    LAS float* ldsf = (LAS float*)lds;
    float* X = args.out;
    if (bx == 0) { for (int i = tid; i < XCD_BAR_WORDS; i += NTHR) ((unsigned*)ws)[i] = 0u; }
    if (tid < 2) ((volatile LAS unsigned*)(ldsl + RING_BYTES + 352))[tid] = 0u;
    __syncthreads();

    for (int rep_ = 0; rep_ < REP_P0; ++rep_) {
        if (rep_) { __syncthreads(); }
#ifndef SKIP_PREP
        if (bx < 64) { s5_prep(args, bx >> 4, bx & 15, ldsf, tid); }
#endif
        LAS float* scr = ldsf + wave * 4096;
        constexpr int I_IN = (DM / 64) * (NF / 32), I_O = (DM / 64) * (DM / 32), I_G = (256 / 64) * (256 / 32), I_L = I_IN + I_O + I_G;
        for (int it = (bx < 64 ? DEPTH * I_L : (bx - 64) * NWAVES + wave); it < DEPTH * I_L; it += (G - 64) * NWAVES) {
            const int l = it / I_L; int r = it % I_L;
            if (r < I_IN) { p0_transpose_item<true>(args.in[2] + (size_t)l * DM * NIN, DM, NIN, NF, (bf16*)(ws + WS_WIN) + (size_t)l * NF * DM, scr, r, lane); continue; } r -= I_IN;
            if (r < I_O) { p0_transpose_item<false>(args.in[14] + (size_t)l * DM * DM, DM, DM, DM, (bf16*)(ws + WS_WO) + (size_t)l * DM * DM, scr, r, lane); continue; } r -= I_O;
            p0_transpose_item<false>(args.in[12] + (size_t)l * 65536, 256, 256, 256, (bf16*)(ws + WS_WGLU) + (size_t)l * 65536, scr, r, lane);
        }
        f32x2* rope = (f32x2*)(ws + WS_ROPE);
        for (int i = bx * NTHR + tid; i < SEQ * 32; i += G * NTHR) { const int pos = i >> 5, fi = i & 31; const float freq = powf(10000.f, -(float)fi / 32.f); const float ang = (float)pos * freq; float sn, cs; sincosf(ang, &sn, &cs); rope[i] = (f32x2){cs, sn}; }
        __syncthreads();
        norm0_phase(args, lane, gw, NGW);
    }
    grid.sync();
    XcdBarrier xbar = xcd_barrier_post((unsigned*)ws, (volatile LAS unsigned*)(ldsl + RING_BYTES + 352));

#define PHASE_VARS int tid = threadIdx.x; asm volatile("" : "+v"(tid)); int bxl_ = blockIdx.x; asm volatile("" : "+s"(bxl_)); const int bx = bxl_; const int lane = tid & 63, wave = __builtin_amdgcn_readfirstlane(tid >> 6), gw = bx * NWAVES + wave; __attribute__((address_space(1))) unsigned char* wsg_ = (__attribute__((address_space(1))) unsigned char*)args.ws; asm volatile("" : "+s"(wsg_)); unsigned char* ws = (unsigned char*)wsg_; LAS unsigned char* ldsl = (LAS unsigned char*)lds; LAS float* ldsf = (LAS float*)lds; (void)lane; (void)wave; (void)gw; (void)ldsl; (void)ldsf
    for (int l = 0; l < DEPTH; ++l) {
        for (int rep_ = 0; rep_ < REP_P1; ++rep_) {
            PHASE_VARS;
            pg8::Gemm g{(const bf16*)(ws + WS_XN), (const bf16*)(ws + WS_WIN) + (size_t)l * NF * DM, M, NF, DM, DM, DM, 0, 0};
            pg8::StaticOrder S; S.init(M, NF, G, bx);
            EpiInProj E{ws, (const float*)(ws + WS_SS) + (size_t)(l & 1) * M, args.in[3] + (size_t)l * 8};
            pg8::gemm_phase<EpiInProj, pg8::StaticOrder, true, true>(ldsl, g, S, E);
            if (bx >= G / 2) flog_phase(args, l, (const float*)(ws + WS_SS) + (size_t)(l & 1) * M, ldsf, tid, lane, wave, bx - G / 2, G / 2);
        }
        GSYNC();
        for (int rep_ = 0; rep_ < REP_P23; ++rep_) {
            if (rep_) __syncthreads();
            PHASE_VARS;
            if (wave == 0) {
                const int g = bx >> 4, r = bx & 15, tm = r >> 1, tn = r & 1;
                WEpiE E{(float*)(ws + WS_E) + ((size_t)g * NCH5 + tm * 64) * 128 + tn * 64};
                wave_gemm64<16, 4, WEpiE>((const bf16*)(ws + WS_SUA) + ((size_t)g * NCH5 + tm * 64) * KA5, KA5, (const bf16*)(ws + WS_WB) + ((size_t)(l * 16 + g) * 128 + tn * 64) * 512, 512, lane, E);
            } else if (wave <= 4) {
                ret_upd_unit(ws, (wave - 1) * 256 + bx, lane);
            } else { const int idx = ((wave - 5) * 256 + bx) * 64 + lane; if (idx < M) ((float*)(ws + WS_SS))[(size_t)((l + 1) & 1) * M + idx] = 0.f; }
            __syncthreads();
            if (bx < 32) {
                const int bh = bx; const float* lf = (const float*)(ws + WS_LOGF) + (size_t)bh * SEQ; float* cb = (float*)(ws + WS_CB) + (size_t)bh * SEQ;
                const f32x4 a0 = *(const f32x4*)(lf + tid * 8), a1 = *(const f32x4*)(lf + tid * 8 + 4); float v[8] = {a0.x, a0.y, a0.z, a0.w, a1.x, a1.y, a1.z, a1.w};
#pragma unroll
                for (int e = 1; e < 8; ++e) v[e] += v[e - 1];
                float tot = v[7];
#pragma unroll
                for (int o = 1; o < 64; o <<= 1) { const float t = __shfl_up(tot, o); if (lane >= o) tot += t; }
                if (lane == 63) ldsf[wave] = tot;
                __syncthreads();
                float off = tot - v[7];
                for (int w = 0; w < wave; ++w) off += ldsf[w];
                f32x4 o0, o1; o0.x = -(v[0] + off) * LOG2E; o0.y = -(v[1] + off) * LOG2E; o0.z = -(v[2] + off) * LOG2E; o0.w = -(v[3] + off) * LOG2E; o1.x = -(v[4] + off) * LOG2E; o1.y = -(v[5] + off) * LOG2E; o1.z = -(v[6] + off) * LOG2E; o1.w = -(v[7] + off) * LOG2E;
                *(f32x4*)(cb + tid * 8) = o0; *(f32x4*)(cb + tid * 8 + 4) = o1;
            }
        }
        GSYNC();
        for (int rep_ = 0; rep_ < REP_P23; ++rep_) {
            if (rep_) __syncthreads();
            PHASE_VARS;
            if (bx < 64) {
                const int b = bx >> 4, g = bx & 15, p = tid & 63, seg = tid >> 6;
                const float* LAM = (const float*)(ws + WS_LAM) + (size_t)(l * 16 + g) * 128; const float lr = LAM[p], li = LAM[64 + p];
                const float* E = (const float*)(ws + WS_E) + ((size_t)g * NCH5 + b * 128 + seg * 16) * 128 + p;
                bf16* SA = (bf16*)(ws + WS_SUA) + ((size_t)g * NCH5 + b * 128 + seg * 16) * KA5 + 512 + p;
                float er[16], ei[16];
#pragma unroll
                for (int i = 0; i < 16; ++i) { er[i] = E[(size_t)i * 128]; ei[i] = E[(size_t)i * 128 + 64]; }
                float sr = 0.f, si = 0.f;
#pragma unroll
                for (int i = 0; i < 16; ++i) { const float nr = lr * sr - li * si + er[i], ni = lr * si + li * sr + ei[i]; sr = nr; si = ni; }
                LAS float* ends = ldsf;
                ends[(seg * 64 + p) * 2] = sr; ends[(seg * 64 + p) * 2 + 1] = si;
                float pr = lr, pi = li;
#pragma unroll
                for (int i = 0; i < 4; ++i) { const float nr = pr * pr - pi * pi, ni = 2.f * pr * pi; pr = nr; pi = ni; }
                __syncthreads();
                float cr = 0.f, ci = 0.f;
                for (int s2 = 0; s2 < seg; ++s2) { const float xr = ends[(s2 * 64 + p) * 2], xi = ends[(s2 * 64 + p) * 2 + 1]; const float nr = pr * cr - pi * ci + xr, ni = pr * ci + pi * cr + xi; cr = nr; ci = ni; }
#pragma unroll
                for (int i = 0; i < 16; ++i) { SA[(size_t)i * KA5] = f2bf(cr); SA[(size_t)i * KA5 + 64] = f2bf(ci); const float nr = lr * cr - li * ci + er[i], ni = lr * ci + li * cr + ei[i]; cr = nr; ci = ni; }
            } else if (bx < 192) {
                const int idx = (bx - 64) * NTHR + tid, bh = idx >> 12, e = idx & 4095; const float g64 = exp2f(lg2_gamma(bh & 3) * 64.f);
                const float* U = (const float*)(ws + WS_UPD) + (size_t)bh * 64 * 4096 + e; bf16* ST = (bf16*)(ws + WS_STATE) + (size_t)bh * 64 * 4096 + e;
                float st = 0.f;
                float uu[64];
#pragma unroll
                for (int c = 0; c < 64; ++c) uu[c] = U[(size_t)c * 4096];
#pragma unroll
                for (int c = 0; c < 64; ++c) { ST[(size_t)c * 4096] = f2bf(st); st = g64 * st + uu[c]; }
            }
        }
        GSYNC();
        {
            PHASE_VARS;
            if (wave < 4) ret_out_unit(args, l, wave * 256 + bx, lane);
            else {
                const int t = (wave - 4) * 256 + bx, g = t >> 6, r = t & 63, tm = r >> 3, tn = r & 7;
                const bf16* SUAg = (const bf16*)(ws + WS_SUA) + (size_t)g * NCH5 * KA5;
                WEpiS5Y E{SUAg, (bf16*)(ws + WS_YS5), args.in[10] + (size_t)l * 256 + g * 16, tm * 64, tn * 64, g};
                wave_gemm64<20, 4, WEpiS5Y>(SUAg + (size_t)(tm * 64) * KA5, KA5, (const bf16*)(ws + WS_MF) + ((size_t)(l * 16 + g) * 512 + tn * 64) * KA5, KA5, lane, E);
            }
            __syncthreads();
            const attn_body::AttnTensors AT{(const attn_body::bf16*)(ws + WS_QO), (const attn_body::bf16*)(ws + WS_KB), (const attn_body::bf16*)(ws + WS_VB), (attn_body::bf16*)(ws + WS_GATE), (const float*)(ws + WS_CB)};
            const attn_body::StaticOrder S(G, bx);
#ifdef REP_ATTN
            attn_body::attn_phase<attn_body::StaticOrder>((char*)lds, AT, S, opaque_true());
#endif
            attn_body::attn_phase<attn_body::StaticOrder>((char*)lds, AT, S);
        }
        GSYNC();
        {
            PHASE_VARS;
            if (wave < 4) {
                const int t = wave * 256 + bx, tm = t >> 2, tn = t & 3;
                WEpiGlu E{(const bf16*)(ws + WS_YS5), (bf16*)(ws + WS_GATE), tm * 64, tn * 64};
                wave_gemm64<8, 4, WEpiGlu>((const bf16*)(ws + WS_YS5) + (size_t)(tm * 64) * 256, 256, (const bf16*)(ws + WS_WGLU) + (size_t)l * 65536 + (size_t)(tn * 64) * 256, 256, lane, E);
            }
        }
        GSYNC();
        {
            PHASE_VARS;
            pg8::Gemm g{(const bf16*)(ws + WS_GATE), (const bf16*)(ws + WS_WO) + (size_t)l * DM * DM, M, DM, DM, DM, DM, 0, 0};
            pg8::StaticOrder S; S.init(M, DM, G, bx);
#ifdef REP_P6
            { EpiOut E0{l == 0 ? args.in[0] : X, X, (float*)(ws + WS_SS) + (size_t)((l + 1) & 1) * M, (bf16*)(ws + WS_XN), (l + 1 < DEPTH) ? args.in[1] + (size_t)(l + 1) * DM : nullptr, opaque_true()}; pg8::gemm_phase<EpiOut, pg8::StaticOrder, true, true>(ldsl, g, S, E0); }
#endif
            EpiOut E{l == 0 ? args.in[0] : X, X, (float*)(ws + WS_SS) + (size_t)((l + 1) & 1) * M, (bf16*)(ws + WS_XN), (l + 1 < DEPTH) ? args.in[1] + (size_t)(l + 1) * DM : nullptr, false};
            pg8::gemm_phase<EpiOut, pg8::StaticOrder, true, true>(ldsl, g, S, E);
        }
        GSYNC();
        if (l + 1 == DEPTH) { PHASE_VARS; final_norm(args, X, (const float*)(ws + WS_SS) + (size_t)((l + 1) & 1) * M, lane, gw, NGW); }
    }
}

extern "C" void kernel_launch(void* const* d_in, const int* in_sizes, int n_in, void* d_out, int out_size, void* d_ws, size_t ws_size, hipStream_t stream) {
    static int grid = 0;
    if (grid == 0) {
        if (n_in != 16 || ws_size < WS_END) { fprintf(stderr, "kernel_launch: unexpected n_in %d / ws %zu\n", n_in, ws_size); grid = -1; return; }
        int dev = 0, cus = 0, per_cu = 0;
        hipGetDevice(&dev); hipDeviceGetAttribute(&cus, hipDeviceAttributeMultiprocessorCount, dev);
        if (hipFuncSetAttribute((const void*)mega_fwd, hipFuncAttributeMaxDynamicSharedMemorySize, LDS_BYTES) != hipSuccess) { fprintf(stderr, "kernel_launch: hipFuncSetAttribute failed\n"); grid = -1; return; }
        if (hipOccupancyMaxActiveBlocksPerMultiprocessor(&per_cu, (const void*)mega_fwd, NTHR, LDS_BYTES) != hipSuccess || per_cu < 1) { fprintf(stderr, "kernel_launch: occupancy query failed (%d)\n", per_cu); grid = -1; return; }
        grid = cus;
        if (grid != 256) fprintf(stderr, "kernel_launch: note: %d CUs\n", grid);
    }
    if (grid < 0) return;
    Args a{};
    for (int i = 0; i < 16; ++i) a.in[i] = (const float*)d_in[i];
    a.out = (float*)d_out; a.ws = (unsigned char*)d_ws;
    void* kargs[] = {&a};
    hipError_t e = hipLaunchCooperativeKernel((const void*)mega_fwd, dim3(grid), dim3(NTHR), kargs, LDS_BYTES, stream);
    if (e != hipSuccess) fprintf(stderr, "kernel_launch: cooperative launch failed: %s\n", hipGetErrorString(e));
}
```

```cpp
#include <hip/hip_runtime.h>
#include <cstdio>
#include <cstdint>
namespace pg8 {
#define PG8_LAS __attribute__((address_space(3)))
typedef unsigned short bf16_t;
typedef short bf16x8 __attribute__((ext_vector_type(8)));
typedef float f32x4 __attribute__((ext_vector_type(4)));
typedef unsigned u32x4 __attribute__((ext_vector_type(4)));
constexpr int BM = 256, BK = 64, HALF = 128, HTB = HALF * BK * 2  , STAGE_BYTES = 8 * HTB, NXCD = 8, WGM = 4;

__host__ __device__ __forceinline__ int lds_byte(int r, int c) { const int st = (r >> 4) * 2 + (c >> 5), rr = r & 15, cc = c & 31, ob = rr * 64 + cc * 2; return st * 1024 + (ob ^ (((ob >> 9) & 1) << 5)); }
__host__ __device__ __forceinline__ void stage_rc(int b, int& R, int& C) { const int st = b / 1024, sb = b % 1024, swz = sb ^ (((sb >> 9) & 1) << 5); R = (st >> 1) * 16 + swz / 64; C = (st & 1) * 32 + (swz % 64) / 2; }
__host__ __device__ __forceinline__ int perm32(int rho) { const int n = rho >> 4, i = rho & 15; return 8 * (i >> 2) + 4 * n + (i & 3); }

struct Unit { int pm, pn, gz; };
struct Gemm { const bf16_t* A; const bf16_t* Bt; int M, N, K; int lda, ldb; size_t gsA, gsB; };

struct StaticOrder {
    int nM, nN, nwg, G, c;
    __host__ __device__ void init(int M, int N, int G_, int c_) { nM = M / BM; nN = N / BM; nwg = nM * nN; G = G_; c = c_; }
    __host__ __device__ bool next(int i, Unit& u) const {
        const long L = (long)i * G + c; if (L >= nwg) return false;
        int wgid = (int)L; { const int q = nwg / NXCD, r = nwg % NXCD, xcd = wgid % NXCD, off = wgid / NXCD; wgid = (xcd < r ? xcd * (q + 1) : r * (q + 1) + (xcd - r) * q) + off; }
        const int nig = WGM * nN, gid = wgid / nig, fm = gid * WGM, gsz = (nM - fm) < WGM ? (nM - fm) : WGM;
        u.pm = fm + ((wgid % nig) % gsz); u.pn = (wgid % nig) / gsz; u.gz = 0; return true;
    }
    __device__ __forceinline__ void a_ready(const Unit&) const {}
    __device__ __forceinline__ void done(const Unit&) const {}
};

__device__ __forceinline__ unsigned cvt_pk_bf16(float lo, float hi) { unsigned r; asm volatile("v_cvt_pk_bf16_f32 %0, %1, %2" : "=v"(r) : "v"(lo), "v"(hi)); return r; }
typedef float f32x2 __attribute__((ext_vector_type(2)));
__device__ __forceinline__ f32x2 gelu_pk(f32x2 v) {
    const f32x2 av = __builtin_elementwise_abs(v), d = av * 0.2316418882f + 1.0f;
    f32x2 t; t.x = __builtin_amdgcn_rcpf(d.x); t.y = __builtin_amdgcn_rcpf(d.y);
    f32x2 q = t * 0.5307027145f + (-0.7265760135f); q = q * t + 0.7107068705f; q = q * t + (-0.142248368f); q = q * t + 0.127414796f; q = q * t;
    const f32x2 s = (v * v) * (-0.72134752044f);
    f32x2 e; e.x = __builtin_amdgcn_exp2f(s.x); e.y = __builtin_amdgcn_exp2f(s.y);
    const f32x2 m = v * (q * e), r = v - m;
    f32x2 o; o.x = v.x < 0.f ? m.x : r.x; o.y = v.y < 0.f ? m.y : r.y; return o;
}

template <class Epi, class Sched, bool ALIGN_EPI = false, bool SP2 = false>
__device__ __forceinline__ void gemm_phase(PG8_LAS unsigned char* lds, const Gemm g, const Sched& S, const Epi& E) {
    int tid_ = threadIdx.x; asm volatile("" : "+v"(tid_));
    const int tid = tid_, wid = __builtin_amdgcn_readfirstlane(tid >> 6), lane = tid & 63, wr = wid >> 2, wc = wid & 3, fr = lane & 15, fq = lane >> 4;
    const int K = g.K, nt = K / BK;
    unsigned voffA[2], voffB[2];
#pragma unroll
    for (int i = 0; i < 2; ++i) { int R, C; stage_rc(tid * 16 + i * 8192, R, C); const int Rb = Epi::PERM ? ((R & ~31) + perm32(R & 31)) : R;
        voffA[i] = (unsigned)(R * g.lda + C) * 2u; voffB[i] = (unsigned)(Rb * g.ldb + C) * 2u; }
    const size_t kstep = (size_t)(BK * 2);
    const size_t hstepA = (size_t)HALF * g.lda * 2, hstepB = (size_t)HALF * g.ldb * 2;
    const size_t tstepA = 2 * hstepA, tstepB = 2 * hstepB;
    const unsigned ldsw = (unsigned)wid * 1024u;
    const int aoff = lds_byte(wr * 64 + fr, fq * 8), boff = lds_byte(wc * 32 + fr, fq * 8);
#define PG8_SA(b, h) (((b) * 2 + (h)) * HTB)
#define PG8_SB(b, h) ((4 + (b) * 2 + (h)) * HTB)
#define PG8_STAGE(bufoff, gbase, voff) do { _Pragma("unroll") for (int _i = 0; _i < 2; ++_i) \
        __builtin_amdgcn_global_load_lds((const unsigned*)((const char*)(gbase) + (voff)[_i]), (PG8_LAS unsigned*)(lds + (bufoff) + ldsw + _i * 8192), 16, 0, 0); } while (0)
#define PG8_LDA(dst, b, h) do { _Pragma("unroll") for (int m = 0; m < 4; ++m) _Pragma("unroll") for (int k = 0; k < 2; ++k) dst[m][k] = *(const PG8_LAS bf16x8*)(lds + PG8_SA(b, h) + aoff + m * 2048 + k * 1024); } while (0)
#define PG8_LDB(dst, b, h) do { _Pragma("unroll") for (int n = 0; n < 2; ++n) _Pragma("unroll") for (int k = 0; k < 2; ++k) dst[n][k] = *(const PG8_LAS bf16x8*)(lds + PG8_SB(b, h) + boff + n * 2048 + k * 1024); } while (0)
#define PG8_MMA(ai, bj, At, Bt) do { __builtin_amdgcn_s_setprio(1); _Pragma("unroll") for (int m = 0; m < 4; ++m) _Pragma("unroll") for (int n = 0; n < 2; ++n) _Pragma("unroll") for (int k = 0; k < 2; ++k) \
        acc[ai][bj][m][n] = __builtin_amdgcn_mfma_f32_16x16x32_bf16(Bt[n][k], At[m][k], acc[ai][bj][m][n], 0, 0, 0); __builtin_amdgcn_s_setprio(0); } while (0)
#define PG8_WAIT_V(n) asm volatile("s_waitcnt vmcnt(" #n ")" ::: "memory")
#define PG8_WAIT_L(n) asm volatile("s_waitcnt lgkmcnt(" #n ")" ::: "memory")
#define PG8_BAR __builtin_amdgcn_s_barrier()
#define PG8_SCHED __builtin_amdgcn_sched_barrier(0)
    Unit cur, nxt; int ui = 0;
    if (!S.next(0, cur)) return;
    f32x4 acc[2][2][4][2];
#pragma unroll
    for (int a = 0; a < 2; ++a)
#pragma unroll
        for (int b = 0; b < 2; ++b)
#pragma unroll
            for (int m = 0; m < 4; ++m)
#pragma unroll
                for (int n = 0; n < 2; ++n) acc[a][b][m][n] = (f32x4){0.f, 0.f, 0.f, 0.f};
    bf16x8 At[4][2], B0[2][2], B1[2][2];
    const char* cA = (const char*)g.A + (size_t)cur.gz * g.gsA * 2 + (size_t)cur.pm * tstepA; const char* cB = (const char*)g.Bt + (size_t)cur.gz * g.gsB * 2 + (size_t)cur.pn * tstepB;
    S.a_ready(cur);
    if constexpr (SP2) {
        PG8_STAGE(PG8_SB(0, 0), cB, voffB); PG8_STAGE(PG8_SB(0, 1), cB + hstepB, voffB); PG8_STAGE(PG8_SA(0, 0), cA, voffA); PG8_STAGE(PG8_SA(0, 1), cA + hstepA, voffA);
        if (wr == 1) PG8_BAR;
        PG8_WAIT_V(2); PG8_BAR;
        PG8_STAGE(PG8_SB(1, 0), cB + kstep, voffB); PG8_STAGE(PG8_SA(1, 0), cA + kstep, voffA); PG8_STAGE(PG8_SB(1, 1), cB + hstepB + kstep, voffB);
        PG8_WAIT_V(6); PG8_BAR;
    } else {
        PG8_STAGE(PG8_SB(0, 0), cB, voffB); PG8_STAGE(PG8_SA(0, 0), cA, voffA); PG8_STAGE(PG8_SB(0, 1), cB + hstepB, voffB); PG8_STAGE(PG8_SA(0, 1), cA + hstepA, voffA);
        if (wr == 1) PG8_BAR;
        PG8_WAIT_V(4); PG8_BAR;
        PG8_STAGE(PG8_SB(1, 0), cB + kstep, voffB); PG8_STAGE(PG8_SA(1, 0), cA + kstep, voffA); PG8_STAGE(PG8_SB(1, 1), cB + hstepB + kstep, voffB);
        PG8_WAIT_V(6); PG8_BAR;
    }
    for (;;) {
        const bool has_next = S.next(ui + 1, nxt);
        const char* nA = has_next ? (const char*)g.A + (size_t)nxt.gz * g.gsA * 2 + (size_t)nxt.pm * tstepA : cA; const char* nB = has_next ? (const char*)g.Bt + (size_t)nxt.gz * g.gsB * 2 + (size_t)nxt.pn * tstepB : cB;
        for (int t = 0; t < nt; t += 2) {
            const bool last = (t == nt - 2);
            const char* a1 = cA + (size_t)(t + 1) * kstep;
            const char* a2 = last ? nA : cA + (size_t)(t + 2) * kstep; const char* b2 = last ? nB : cB + (size_t)(t + 2) * kstep;
            const char* a3 = a2 + kstep; const char* b3 = b2 + kstep;
            if (last && has_next) S.a_ready(nxt);
            if constexpr (SP2) {
            PG8_LDB(B0, 0, 0); PG8_LDB(B1, 0, 1); PG8_SCHED; PG8_LDA(At, 0, 0); PG8_STAGE(PG8_SA(1, 1), a1 + hstepA, voffA);
            PG8_WAIT_V(8); PG8_WAIT_L(0); PG8_BAR; PG8_MMA(0, 0, At, B0); PG8_MMA(0, 1, At, B1); PG8_BAR; PG8_SCHED;
            PG8_LDA(At, 0, 1); PG8_STAGE(PG8_SB(0, 0), b2, voffB); PG8_STAGE(PG8_SB(0, 1), b2 + hstepB, voffB); PG8_STAGE(PG8_SA(0, 0), a2, voffA);
            PG8_WAIT_V(8); PG8_WAIT_L(0); PG8_BAR; PG8_MMA(1, 0, At, B0); PG8_MMA(1, 1, At, B1); PG8_BAR; PG8_SCHED;
            PG8_LDB(B0, 1, 0); PG8_LDB(B1, 1, 1); PG8_SCHED; PG8_LDA(At, 1, 0); PG8_STAGE(PG8_SA(0, 1), a2 + hstepA, voffA);
            PG8_WAIT_V(8); PG8_WAIT_L(0); PG8_BAR; PG8_MMA(0, 0, At, B0); PG8_MMA(0, 1, At, B1); PG8_BAR; PG8_SCHED;
            PG8_LDA(At, 1, 1); PG8_STAGE(PG8_SB(1, 0), b3, voffB); PG8_STAGE(PG8_SB(1, 1), b3 + hstepB, voffB); PG8_STAGE(PG8_SA(1, 0), a3, voffA);
            PG8_WAIT_V(8); PG8_WAIT_L(0); PG8_BAR; PG8_MMA(1, 0, At, B0); PG8_MMA(1, 1, At, B1); PG8_BAR; PG8_SCHED;
            } else {
            PG8_LDB(B0, 0, 0); PG8_SCHED; PG8_LDA(At, 0, 0); PG8_STAGE(PG8_SA(1, 1), a1 + hstepA, voffA);
            PG8_WAIT_L(8); PG8_BAR; PG8_WAIT_L(0); PG8_MMA(0, 0, At, B0); PG8_BAR; PG8_SCHED;
            PG8_LDB(B1, 0, 1); PG8_STAGE(PG8_SB(0, 0), b2, voffB);
            PG8_BAR; PG8_WAIT_L(0); PG8_MMA(0, 1, At, B1); PG8_BAR;
            PG8_LDA(At, 0, 1); PG8_STAGE(PG8_SA(0, 0), a2, voffA);
            PG8_BAR; PG8_WAIT_L(0); PG8_MMA(1, 0, At, B0); PG8_BAR; PG8_SCHED;
            PG8_STAGE(PG8_SB(0, 1), b2 + hstepB, voffB);
            PG8_WAIT_V(6); PG8_BAR; PG8_MMA(1, 1, At, B1); PG8_BAR;
            PG8_LDB(B0, 1, 0); PG8_SCHED; PG8_LDA(At, 1, 0); PG8_STAGE(PG8_SA(0, 1), a2 + hstepA, voffA);
            PG8_WAIT_L(8); PG8_BAR; PG8_WAIT_L(0); PG8_MMA(0, 0, At, B0); PG8_BAR; PG8_SCHED;
            PG8_LDB(B1, 1, 1); PG8_STAGE(PG8_SB(1, 0), b3, voffB);
            PG8_BAR; PG8_WAIT_L(0); PG8_MMA(0, 1, At, B1); PG8_BAR;
            PG8_LDA(At, 1, 1); PG8_STAGE(PG8_SA(1, 0), a3, voffA);
            PG8_BAR; PG8_WAIT_L(0); PG8_MMA(1, 0, At, B0); PG8_BAR; PG8_SCHED;
            PG8_STAGE(PG8_SB(1, 1), b3 + hstepB, voffB);
            PG8_WAIT_V(6); PG8_BAR; PG8_MMA(1, 1, At, B1); PG8_BAR;
            }
        }
        if constexpr (ALIGN_EPI) { if (wr == 0) PG8_BAR; }
        if constexpr (!Epi::AFTER_DRAIN) { E(acc, cur, wr, wc, fr, fq); S.done(cur); }
        if (!has_next) break;
#pragma unroll
        for (int a = 0; a < 2; ++a)
#pragma unroll
            for (int b = 0; b < 2; ++b)
#pragma unroll
                for (int m = 0; m < 4; ++m)
#pragma unroll
                    for (int n = 0; n < 2; ++n) acc[a][b][m][n] = (f32x4){0.f, 0.f, 0.f, 0.f};
        cur = nxt; cA = nA; cB = nB; ++ui;
        if constexpr (ALIGN_EPI) { if (wr == 1) PG8_BAR; }
    }
    PG8_WAIT_V(0);
    if constexpr (!ALIGN_EPI) { if (wr == 0) PG8_BAR; }
    PG8_BAR;
    if constexpr (Epi::AFTER_DRAIN) { E.fused(acc, cur, wr, wc, fr, fq, lds, wid, lane); S.done(cur); }
#undef PG8_SA
#undef PG8_SB
#undef PG8_STAGE
#undef PG8_LDA
#undef PG8_LDB
#undef PG8_MMA
#undef PG8_WAIT_V
#undef PG8_WAIT_L
#undef PG8_BAR
#undef PG8_SCHED
}
}
#include <hip/hip_bf16.h>
#include <cmath>
namespace attn_body {
using bf16=__hip_bfloat16;
using bf16x8=__attribute__((ext_vector_type(8)))short;
using s16x4=__attribute__((ext_vector_type(4)))short;
using f32x16=__attribute__((ext_vector_type(16)))float;
using u32x4=__attribute__((ext_vector_type(4)))unsigned;
using f32x4=__attribute__((ext_vector_type(4)))float;
constexpr int BATCH=4,NHEAD=8,SEQ=4096,D=64,DM=NHEAD*D,OPITCH=1024;
constexpr int NW=8,QBLK=32,QB=QBLK*NW,KVBLK=64,NQB=SEQ/QB;
constexpr int ATTN_PITCH=DM, ATTN_UNIT_ROWS=QB;
__device__ __forceinline__ int crow(int r,int hi){return (r&3)+8*(r>>2)+4*hi;}
#define SBAR() __builtin_amdgcn_sched_barrier(0)
__device__ __forceinline__ void cmask(f32x16&p0,f32x16&p1,int jb,int qrel,int hi){
  const float NEG=-INFINITY; int kb=64*jb+4*hi;
  #pragma unroll
  for(int r=0;r<16;++r){int kv=kb+(r&3)+8*(r>>2); if(kv>qrel)p0[r]=NEG; if(kv+32>qrel)p1[r]=NEG;}
}

constexpr int NSLOT=3, SLOTB=8192;
constexpr int LDS_K=0, LDS_V=NSLOT*SLOTB, LDS_WS=2*NSLOT*SLOTB, LDS_OST=LDS_WS+NW*64*4, LDS_CB=LDS_OST+NW*4096, LDS_BYTES=LDS_CB+SEQ*4;
constexpr float C2=0.125f*1.4426950408889634f;
__device__ __forceinline__ void glds16(const void*gsrc,unsigned lds_dst){unsigned keep;
  asm volatile("s_mov_b32 %0, m0\n\ts_mov_b32 m0, %2\n\ts_nop 0\n\tglobal_load_lds_dwordx4 %1, off\n\ts_mov_b32 m0, %0":"=&s"(keep):"v"(gsrc),"s"(lds_dst):"memory");}
__device__ __forceinline__ float max3f(float a,float b,float c){float r;asm("v_max3_f32 %0, %1, %2, %3":"=v"(r):"v"(a),"v"(b),"v"(c));return r;}
__device__ __forceinline__ float max2f(float a,float b){float r;asm("v_max_f32_e32 %0, %1, %2":"=v"(r):"v"(a),"v"(b));return r;}
__device__ __forceinline__ float fadd_s(float a,float b){float r;asm("v_add_f32_e32 %0, %1, %2":"=v"(r):"v"(a),"v"(b));return r;}
__device__ __forceinline__ float fsub_s(float a,float b){float r;asm("v_sub_f32_e32 %0, %1, %2":"=v"(r):"v"(a),"v"(b));return r;}
typedef float f32x2_t __attribute__((ext_vector_type(2))); typedef __bf16 bf16x2_t __attribute__((ext_vector_type(2)));
__device__ __forceinline__ unsigned cvtpk_s(float lo,float hi){f32x2_t v={lo,hi};bf16x2_t b=__builtin_convertvector(v,bf16x2_t);return __builtin_bit_cast(unsigned,b);}
#define WAIT_BAR(N) asm volatile("s_waitcnt vmcnt(" #N ") lgkmcnt(0)\n\ts_barrier":::"memory")

__device__ __forceinline__ void qkt(f32x16&p0,f32x16&p1,const char*Kslot,const bf16x8*qr,const char*cbt,int r32,int hi){
  const char*kb=Kslot+hi*1024+r32*16;
  #pragma unroll
  for(int a=0;a<4;++a){ const f32x4 u0=*reinterpret_cast<const f32x4*>(cbt+hi*16+a*32), u1=*reinterpret_cast<const f32x4*>(cbt+128+hi*16+a*32);
    p0[4*a]=u0[0];p0[4*a+1]=u0[1];p0[4*a+2]=u0[2];p0[4*a+3]=u0[3]; p1[4*a]=u1[0];p1[4*a+1]=u1[1];p1[4*a+2]=u1[2];p1[4*a+3]=u1[3]; }
  #pragma unroll
  for(int d0=0;d0<4;++d0){
    const bf16x8 b0=*reinterpret_cast<const bf16x8*>(kb+d0*2048);
    const bf16x8 b1=*reinterpret_cast<const bf16x8*>(kb+d0*2048+512);
    p0=__builtin_amdgcn_mfma_f32_32x32x16_bf16(b0,qr[d0],p0,0,0,0);p1=__builtin_amdgcn_mfma_f32_32x32x16_bf16(b1,qr[d0],p1,0,0,0);}
}
typedef __attribute__((address_space(3))) const char* lds_cptr;
typedef short v4i16_t __attribute__((ext_vector_type(4)));
__device__ __forceinline__ void kload8(bf16x8*kf,lds_cptr kp){
  kf[0]=*(const __attribute__((address_space(3))) bf16x8*)(kp);      kf[1]=*(const __attribute__((address_space(3))) bf16x8*)(kp+512);
  kf[2]=*(const __attribute__((address_space(3))) bf16x8*)(kp+2048); kf[3]=*(const __attribute__((address_space(3))) bf16x8*)(kp+2560);
  kf[4]=*(const __attribute__((address_space(3))) bf16x8*)(kp+4096); kf[5]=*(const __attribute__((address_space(3))) bf16x8*)(kp+4608);
  kf[6]=*(const __attribute__((address_space(3))) bf16x8*)(kp+6144); kf[7]=*(const __attribute__((address_space(3))) bf16x8*)(kp+6656);
}
__device__ __forceinline__ void kload2(bf16x8*kf,lds_cptr kp,int j){ kf[2*j]=*(const __attribute__((address_space(3))) bf16x8*)(kp+j*2048); kf[2*j+1]=*(const __attribute__((address_space(3))) bf16x8*)(kp+j*2048+512); }
__device__ __forceinline__ s16x4 vtr(lds_cptr p){ return __builtin_bit_cast(s16x4,__builtin_amdgcn_ds_read_tr16_b64_v4i16((__attribute__((address_space(3))) v4i16_t*)p)); }
__device__ __forceinline__ float rowmax(const f32x16&p0,const f32x16&p1){
  float a=max3f(p0[0],p0[1],p1[0]),b=max3f(p0[2],p0[3],p1[1]);a=max3f(a,p1[2],p1[3]);
  #pragma unroll
  for(int r=4;r<16;r+=4){a=max3f(a,p0[r],p0[r+1]);b=max3f(b,p0[r+2],p0[r+3]);a=max3f(a,p1[r],p1[r+1]);b=max3f(b,p1[r+2],p1[r+3]);}
  const float m=max2f(a,b);
  auto rr=__builtin_amdgcn_permlane32_swap(__float_as_uint(m),__float_as_uint(m),false,false);
  return max2f(__uint_as_float(rr[0]),__uint_as_float(rr[1]));
}
__device__ __forceinline__ void pv(f32x16*o,int vb,bf16x8 pa0,bf16x8 pa1,bf16x8 pa2,bf16x8 pa3){
  #pragma unroll
  for(int d0=0;d0<2;++d0){s16x4 lo[4],hi[4];
    #pragma unroll
    for(int ks=0;ks<4;++ks){
      asm volatile("ds_read_b64_tr_b16 %0,%1 offset:%c2":"=&v"(lo[ks]):"v"(vb),"i"(d0*4096+ks*1024):"memory");
      asm volatile("ds_read_b64_tr_b16 %0,%1 offset:%c2":"=&v"(hi[ks]):"v"(vb),"i"(d0*4096+ks*1024+512):"memory");}
    asm volatile("s_waitcnt lgkmcnt(0)":::"memory");SBAR();
    #define PK(k) (bf16x8){lo[k][0],lo[k][1],lo[k][2],lo[k][3],hi[k][0],hi[k][1],hi[k][2],hi[k][3]}
    o[d0]=__builtin_amdgcn_mfma_f32_32x32x16_bf16(pa0,PK(0),o[d0],0,0,0);
    o[d0]=__builtin_amdgcn_mfma_f32_32x32x16_bf16(pa1,PK(1),o[d0],0,0,0);
    o[d0]=__builtin_amdgcn_mfma_f32_32x32x16_bf16(pa2,PK(2),o[d0],0,0,0);
    o[d0]=__builtin_amdgcn_mfma_f32_32x32x16_bf16(pa3,PK(3),o[d0],0,0,0);
    #undef PK
  }
}

#ifndef ATTN_STORE16
#define ATTN_STORE16(p,v) (*(u32x4*)(p)=(v))
#endif
template<int THRL> __device__ __forceinline__ void attn_unit(int b,int h,int qb,const bf16*Q,const bf16*__restrict__ K,const bf16*__restrict__ V,bf16*O,const float*__restrict__ CB,const float*__restrict__ NRM,char*shm,bool dry=false){
  int tid_=threadIdx.x; asm volatile("":"+v"(tid_)); const int tid=tid_,lane=tid&63,r32=lane&31,hi=lane>>5; const int wid=__builtin_amdgcn_readfirstlane(tid>>6);
  const long rowbase=(long)b*SEQ; const int q0=qb*QB;
  int t0;
  { const f32x4* cbg=reinterpret_cast<const f32x4*>(CB+(long)(b*NHEAD+h)*SEQ); f32x4* cbl=reinterpret_cast<f32x4*>(shm+LDS_CB); const int nv=(q0+QB)/4;
    for(int i=tid;i<nv;i+=NW*64) cbl[i]=cbg[i];
    const float bnd=NRM[b*NHEAD+h]+40.f;
    asm volatile("s_waitcnt vmcnt(0) lgkmcnt(0)\n\ts_barrier":::"memory");
    const float*cbf=reinterpret_cast<const float*>(shm+LDS_CB); const int tc=2*lane; const int NT0=(q0+QB)/KVBLK;
    const bool ok=(tc<=NT0-4)&&(tc==0||cbf[64*tc-1]+bnd<=cbf[q0]);
    const unsigned long long mk=__ballot(ok); t0=2*(__popcll(mk)-1); t0=__builtin_amdgcn_readfirstlane(t0); }
  const bf16*Qw=Q+(rowbase+q0+wid*QBLK)*DM+h*D;
  const bf16*Kh=K+(rowbase+(long)t0*KVBLK)*DM+h*D,*Vh=V+(rowbase+(long)t0*KVBLK)*DM+h*D;
  const unsigned lds0=(unsigned)(uintptr_t)shm;
  float*wsf=(float*)(shm+LDS_WS)+wid*64;
  const bf16*ksrc=Kh+(long)lane*DM+wid*8;
  const bf16*vsrc=Vh+(long)(16*(wid&3)+(lane>>2))*DM+(wid>>2)*32+(lane&3)*8;
  const unsigned kdst=lds0+LDS_K+wid*1024, vdst=lds0+LDS_V+wid*1024;
  #define DMA_K(t,slot) glds16(ksrc+(long)(t)*KVBLK*DM,(unsigned)__builtin_amdgcn_readfirstlane(kdst+(slot)))
  #define DMA_V(t,slot) glds16(vsrc+(long)(t)*KVBLK*DM,(unsigned)__builtin_amdgcn_readfirstlane(vdst+(slot)))
  const int vb0=(int)(lds0+LDS_V)+((lane>>4)&1)*32+(lane&3)*8+(4*hi+((lane&15)>>2))*64;
  const char*Kbase=shm+LDS_K; bf16x8 kf[8];
  const lds_cptr shm3=(lds_cptr)shm; const lds_cptr kp0=shm3+LDS_K+hi*1024+r32*16; const lds_cptr vp0=shm3+LDS_V+((lane>>4)&1)*32+(lane&3)*8+(4*hi+((lane&15)>>2))*64;
  const int NT=(q0+QB)/KVBLK-t0;
  const lds_cptr cb3=(lds_cptr)shm+LDS_CB+t0*256;
  const float cb_own=*(const __attribute__((address_space(3))) float*)((lds_cptr)shm+LDS_CB+(q0+wid*QBLK+r32)*4);
  DMA_K(0,0);DMA_V(0,0);DMA_K(1,SLOTB);
  bf16x8 qr[4];
  #pragma unroll
  for(int d0=0;d0<4;++d0)qr[d0]=*reinterpret_cast<const bf16x8*>(&Qw[(long)r32*DM+d0*16+hi*8]);
  float mhat=0.f,l_reg=0.f;f32x16 o[2];o[0]=f32x16{};o[1]=f32x16{};
  const int qrel=wid*QBLK+r32;
  #define CMASK(P0,P1,t) do{int jb_=(t)-(NT-4); if(jb_>=0)cmask(P0,P1,jb_,qrel,hi);}while(0)
  bool resc=false;
  #define START(P0,P1) do{ const float rm=max2f(rowmax(P0,P1),cb_own); resc=false; \
    { const float dl=rm; mhat=fadd_s(mhat,dl); \
      _Pragma("unroll") for(int r=0;r<16;++r){P0[r]=fsub_s(P0[r],dl);P1[r]=fsub_s(P1[r],dl);} } \
    _Pragma("unroll") for(int r=0;r<16;++r)P0[r]=__builtin_amdgcn_exp2f(P0[r]); }while(0)
  #define RESC() do{ if(resc){ asm volatile("s_waitcnt lgkmcnt(0)":::"memory"); \
      _Pragma("unroll") for(int d_=0;d_<2;++d_) _Pragma("unroll") for(int r=0;r<16;++r)o[d_][r]*=wsf[crow(r,hi)]; } }while(0)
  f32x16 pA0,pA1,pB0,pB1;
  int sl_prev=0,sl_cur=0,sl_next=SLOTB;
  #define ROT() do{sl_prev=sl_cur;sl_cur=sl_next;sl_next=(sl_next==(NSLOT-1)*SLOTB)?0:sl_next+SLOTB;}while(0)
  DMA_K(2,2*SLOTB);
  WAIT_BAR(3);
  qkt(pA0,pA1,Kbase,qr,shm+LDS_CB+t0*256,r32,hi);asm volatile("s_nop 15\n\ts_nop 7":"+v"(pA0),"+v"(pA1));CMASK(pA0,pA1,0);
  START(pA0,pA1);
  _Pragma("unroll") for(int r=0;r<16;++r)pA1[r]=__builtin_amdgcn_exp2f(pA1[r]);
  WAIT_BAR(0);
  DMA_K(3,0);DMA_V(1,SLOTB);
  ROT();
  kload8(kf,kp0+sl_cur);
  WAIT_BAR(2);
  s16x4 vlo[8],vhi[8]; u32x4 pw0,pw1,pw2,pw3;
  #define PKW(P,B) cvtpk_s(P[B],P[B+1])
  #define PAF(k) __builtin_bit_cast(bf16x8,pw##k)
  #define VFR(i) (bf16x8){vlo[i][0],vlo[i][1],vlo[i][2],vlo[i][3],vhi[i][0],vhi[i][1],vhi[i][2],vhi[i][3]}
  #define PIN(x) asm volatile("":"+v"(x))
  #define MX3(a,b,c) __builtin_fmaxf(__builtin_fmaxf((a),(b)),(c))
  #define GAPA(MF,A0,A1,A2,A3,W0,W1,PW) do{ MF; sacc+=A0; sacc+=A1; sacc+=A2; sacc+=A3; PIN(sacc); W0; W1; PIN(PW); SBAR(); }while(0)
  #define EX(v) __builtin_amdgcn_exp2f(v)
  #define GAPB(MF,X,B) do{ MF; X[B]=EX(X[B]); X[B+1]=EX(X[B+1]); X[B+2]=EX(X[B+2]); X[B+3]=EX(X[B+3]); PIN(X); SBAR(); }while(0)
  #define VRD(i) do{ vlo[i]=vtr(vp_+(((i)>>2)*4096+((i)&3)*1024)); vhi[i]=vtr(vp_+(((i)>>2)*4096+((i)&3)*1024+512)); }while(0)
  #define KRD(G,j) do{ if(G){ kload2(kf,kp0+sl_next,j); SBAR(); } }while(0)
  #define STEP(C0,C1,P0,P1,t,GK,GV,GL) do{ SBAR(); \
    const lds_cptr vp_=vp0+sl_prev; \
    VRD(0); SBAR(); float sacc=(P0[0]+P0[1]); \
    GAPA(C0=__builtin_amdgcn_mfma_f32_32x32x16_bf16(kf[0],qr[0],C0,0,0,0), P0[2],P0[3],P0[4],P0[5],     pw0[0]=PKW(P0,0), pw0[1]=PKW(P0,2), pw0); \
    VRD(4); SBAR(); GAPA(C1=__builtin_amdgcn_mfma_f32_32x32x16_bf16(kf[1],qr[0],C1,0,0,0), P0[6],P0[7],P0[8],P0[9],     pw0[2]=PKW(P0,4), pw0[3]=PKW(P0,6), pw0); \
    VRD(1); SBAR(); GAPA(C0=__builtin_amdgcn_mfma_f32_32x32x16_bf16(kf[2],qr[1],C0,0,0,0),   P0[10],P0[11],P0[12],P0[13], pw1[0]=PKW(P0,8), pw1[1]=PKW(P0,10), pw1); \
    VRD(5); SBAR(); GAPA(C1=__builtin_amdgcn_mfma_f32_32x32x16_bf16(kf[3],qr[1],C1,0,0,0),   P0[14],P0[15],P1[0],P1[1],   pw1[2]=PKW(P0,12),pw1[3]=PKW(P0,14), pw1); \
    VRD(2); SBAR(); GAPA(C0=__builtin_amdgcn_mfma_f32_32x32x16_bf16(kf[4],qr[2],C0,0,0,0),   P1[2],P1[3],P1[4],P1[5],     pw2[0]=PKW(P1,0), pw2[1]=PKW(P1,2), pw2); \
    VRD(6); SBAR(); GAPA(C1=__builtin_amdgcn_mfma_f32_32x32x16_bf16(kf[5],qr[2],C1,0,0,0),   P1[6],P1[7],P1[8],P1[9],     pw2[2]=PKW(P1,4), pw2[3]=PKW(P1,6), pw2); \
    VRD(3); SBAR(); GAPA(C0=__builtin_amdgcn_mfma_f32_32x32x16_bf16(kf[6],qr[3],C0,0,0,0),   P1[10],P1[11],P1[12],P1[13], pw3[0]=PKW(P1,8), pw3[1]=PKW(P1,10), pw3); \
    VRD(7); SBAR(); GAPA(C1=__builtin_amdgcn_mfma_f32_32x32x16_bf16(kf[7],qr[3],C1,0,0,0),   P1[14],P1[15],0.f,0.f,       pw3[2]=PKW(P1,12),pw3[3]=PKW(P1,14), pw3); \
    l_reg+=sacc; \
    if(GK){DMA_K((t)+3,sl_cur);} if(GV){DMA_V((t)+1,sl_next);} \
    CMASK(C0,C1,t); \
    { float a=MX3(C0[0],C0[1],C1[0]),b=MX3(C0[2],C0[3],C1[1]); a=MX3(a,C1[2],C1[3]); \
      _Pragma("unroll") for(int r=4;r<16;r+=4){a=MX3(a,C0[r],C0[r+1]);b=MX3(b,C0[r+2],C0[r+3]);a=MX3(a,C1[r],C1[r+1]);b=MX3(b,C1[r+2],C1[r+3]);} \
      float rm=__builtin_fmaxf(a,b); { auto rr=__builtin_amdgcn_permlane32_swap(__float_as_uint(rm),__float_as_uint(rm),false,false); rm=__builtin_fmaxf(__uint_as_float(rr[0]),__uint_as_float(rr[1])); } \
      resc=false; \
      if(__builtin_expect(__any(rm>(float)THRL),0)){ const float dl=__builtin_fmaxf(rm,0.f); mhat+=dl; \
        _Pragma("unroll") for(int r=0;r<16;++r){C0[r]-=dl;C1[r]-=dl;} \
        const float f=__builtin_amdgcn_exp2f(-dl); l_reg*=f; if(hi==0)wsf[r32]=f; resc=true; } } \
    SBAR(); \
    { const __attribute__((address_space(3))) f32x4* cbp_=(const __attribute__((address_space(3))) f32x4*)(cb3+((t)+1)*256+hi*16); \
      _Pragma("unroll") for(int a_=0;a_<4;++a_){ const f32x4 u0_=cbp_[2*a_], u1_=cbp_[8+2*a_]; \
        P0[4*a_]=u0_[0];P0[4*a_+1]=u0_[1];P0[4*a_+2]=u0_[2];P0[4*a_+3]=u0_[3]; P1[4*a_]=u1_[0];P1[4*a_+1]=u1_[1];P1[4*a_+2]=u1_[2];P1[4*a_+3]=u1_[3]; } } SBAR(); \
    GAPB(o[0]=__builtin_amdgcn_mfma_f32_32x32x16_bf16(PAF(0),VFR(0),o[0],0,0,0), C0,0); \
    GAPB(o[1]=__builtin_amdgcn_mfma_f32_32x32x16_bf16(PAF(0),VFR(4),o[1],0,0,0), C0,4); \
    KRD(GL,0); GAPB(o[0]=__builtin_amdgcn_mfma_f32_32x32x16_bf16(PAF(1),VFR(1),o[0],0,0,0), C0,8); \
    KRD(GL,1); GAPB(o[1]=__builtin_amdgcn_mfma_f32_32x32x16_bf16(PAF(1),VFR(5),o[1],0,0,0), C0,12); \
    KRD(GL,2); GAPB(o[0]=__builtin_amdgcn_mfma_f32_32x32x16_bf16(PAF(2),VFR(2),o[0],0,0,0), C1,0); \
    KRD(GL,3); GAPB(o[1]=__builtin_amdgcn_mfma_f32_32x32x16_bf16(PAF(2),VFR(6),o[1],0,0,0), C1,4); \
    GAPB(o[0]=__builtin_amdgcn_mfma_f32_32x32x16_bf16(PAF(3),VFR(3),o[0],0,0,0), C1,8); \
    GAPB(o[1]=__builtin_amdgcn_mfma_f32_32x32x16_bf16(PAF(3),VFR(7),o[1],0,0,0), C1,12); \
    _Pragma("unroll") for(int r_=0;r_<16;++r_){P0[r_]-=mhat;P1[r_]-=mhat;} \
    }while(0)
  { const __attribute__((address_space(3))) f32x4* cbp_=(const __attribute__((address_space(3))) f32x4*)(cb3+256+hi*16);
    #pragma unroll
    for(int a_=0;a_<4;++a_){ const f32x4 u0_=cbp_[2*a_], u1_=cbp_[8+2*a_];
      pB0[4*a_]=u0_[0]-mhat;pB0[4*a_+1]=u0_[1]-mhat;pB0[4*a_+2]=u0_[2]-mhat;pB0[4*a_+3]=u0_[3]-mhat;
      pB1[4*a_]=u1_[0]-mhat;pB1[4*a_+1]=u1_[1]-mhat;pB1[4*a_+2]=u1_[2]-mhat;pB1[4*a_+3]=u1_[3]-mhat; } }
  int t=1;
  #undef CMASK
  #define CMASK(P0,P1,t) do{}while(0)
  for(;t+5<NT;t+=2){
    STEP(pB0,pB1,pA0,pA1,t,true,true,true);     WAIT_BAR(2); RESC(); ROT();
    STEP(pA0,pA1,pB0,pB1,t+1,true,true,true);   WAIT_BAR(2); RESC(); ROT();
  }
  #undef CMASK
  #define CMASK(P0,P1,t) do{int jb_=(t)-(NT-4); if(jb_>=0)cmask(P0,P1,jb_,qrel,hi);}while(0)
  #define ENDW(tt) do{ if((tt)+3<NT){WAIT_BAR(2);} else if((tt)+2<NT){WAIT_BAR(1);} else {WAIT_BAR(0);} }while(0)
  for(;t+1<NT;t+=2){
    STEP(pB0,pB1,pA0,pA1,t,(t+3<NT),(t+1<NT),(t+1<NT));       ENDW(t);   RESC(); ROT();
    STEP(pA0,pA1,pB0,pB1,t+1,(t+4<NT),(t+2<NT),(t+2<NT));     ENDW(t+1); RESC(); ROT();
  }
  STEP(pB0,pB1,pA0,pA1,NT-1,false,false,false); RESC();
  { float sacc=pB0[0]+pB0[1]; _Pragma("unroll") for(int r=2;r<16;++r)sacc+=pB0[r]; _Pragma("unroll") for(int r=0;r<16;++r)sacc+=pB1[r]; l_reg+=sacc;
    pw0=(u32x4){PKW(pB0,0),PKW(pB0,2),PKW(pB0,4),PKW(pB0,6)};pw1=(u32x4){PKW(pB0,8),PKW(pB0,10),PKW(pB0,12),PKW(pB0,14)};pw2=(u32x4){PKW(pB1,0),PKW(pB1,2),PKW(pB1,4),PKW(pB1,6)};pw3=(u32x4){PKW(pB1,8),PKW(pB1,10),PKW(pB1,12),PKW(pB1,14)};
    SBAR(); pv(o,vb0+sl_cur,PAF(0),PAF(1),PAF(2),PAF(3)); }
  #undef PKW
  #undef PAF
  #undef VFR
  #undef PIN
  #undef MX3
  #undef GAPA
  #undef GAPB
  #undef EX
  #undef VRD
  #undef KRD
  #undef STEP
  #undef ENDW
  {auto rr=__builtin_amdgcn_permlane32_swap(__float_as_uint(l_reg),__float_as_uint(l_reg),false,false);l_reg=__uint_as_float(rr[0])+__uint_as_float(rr[1]);}
  if(hi==0)wsf[32+r32]=l_reg;asm volatile("s_waitcnt lgkmcnt(0)":::"memory");
  float rli[16];
  #pragma unroll
  for(int r=0;r<16;++r)rli[r]=__builtin_amdgcn_rcpf(wsf[32+crow(r,hi)]);
  bf16*Ow=O+(rowbase+q0+wid*QBLK)*OPITCH+h*D;
  { bf16*stg=(bf16*)(shm+LDS_OST)+wid*2048;
    #pragma unroll
    for(int r=0;r<16;++r){const int orow=crow(r,hi);
      #pragma unroll
      for(int d0=0;d0<2;++d0)stg[orow*64+d0*32+r32]=__float2bfloat16(o[d0][r]*rli[r]);}
    asm volatile("s_waitcnt lgkmcnt(0)":::"memory");
    #pragma unroll
    for(int i=0;i<4;++i){const int row=i*8+(lane>>3),ch=lane&7; const u32x4 v=*(const u32x4*)(stg+row*64+ch*8); bf16*dst=Ow+(long)row*OPITCH+ch*8; const u32x4 gv=*(const u32x4*)dst; u32x4 w;
      #pragma unroll
      for(int j=0;j<4;++j){ const float a0=__uint_as_float(v[j]<<16)*__uint_as_float(gv[j]<<16), a1=__uint_as_float(v[j]&0xffff0000u)*__uint_as_float(gv[j]&0xffff0000u); w[j]=cvtpk_s(a0,a1); }
      if(!dry)*(u32x4*)dst=w;} }
  asm volatile("s_waitcnt lgkmcnt(0)\n\ts_barrier":::"memory");
  #undef DMA_K
  #undef DMA_V
  #undef CMASK
  #undef START
  #undef RESC
  #undef ROT
}
constexpr int ATTN_LDS_BYTES=LDS_BYTES;
struct AttnTensors { const bf16* Q; const bf16* K; const bf16* V; bf16* O; const float* CB; const float* NRM; };
struct AttnUnit { int bh; int qb; };
struct StaticOrder {
  int vcu;
  __device__ __forceinline__ explicit StaticOrder(int grid,int block):vcu((block%8)*(grid/8)+block/8){}
  __device__ __forceinline__ bool next(int i,AttnUnit&u)const{ if(i>=2)return false; const int s=vcu&7; u.bh=vcu>>3; u.qb=(i==0)?15-s:s; return true; }
  __device__ __forceinline__ void a_ready(const AttnUnit&)const{}
  __device__ __forceinline__ void done(const AttnUnit&)const{}
};
template<class Sched,int THRL=8> __device__ __forceinline__ void attn_phase(char*lds,const AttnTensors&T,const Sched&S,bool dry=false){
  AttnUnit u;
  for(int i=0;S.next(i,u);++i){ S.a_ready(u); attn_unit<THRL>(u.bh/NHEAD,u.bh%NHEAD,u.qb,T.Q,T.K,T.V,T.O,T.CB,T.NRM,lds,dry); S.done(u); }
}
#undef SBAR
#undef WAIT_BAR
}
#include <hip/hip_cooperative_groups.h>
namespace cg = cooperative_groups;
#define LAS __attribute__((address_space(3)))
typedef unsigned short bf16;
typedef float f32x4 __attribute__((ext_vector_type(4)));
typedef float f32x2 __attribute__((ext_vector_type(2)));
typedef unsigned u32x4 __attribute__((ext_vector_type(4)));
typedef unsigned u32x2 __attribute__((ext_vector_type(2)));
typedef short bf16x8 __attribute__((ext_vector_type(8)));
typedef short bf16x4 __attribute__((ext_vector_type(4)));

constexpr int NWAVES = 8, NTHR = 512;
constexpr int BATCH = 4, SEQ = 4096, DM = 1024, DEPTH = 4, M = BATCH * SEQ;
constexpr int NIN = 3592, NF = 3584;
constexpr int T5 = 32, NCH5 = M / T5, KA5 = 640, NG5 = 16;
constexpr float EPS = 1e-6f;
constexpr float LOG2E = 1.4426950408889634f;

constexpr size_t MiB = 1u << 20;
constexpr size_t WS_WIN = 1 * MiB, WS_WO = 31 * MiB, WS_WGLU = 39 * MiB, WS_ROPE = 40 * MiB, WS_MF = 41 * MiB, WS_WB = 81 * MiB;
constexpr size_t WS_LAM = 90 * MiB, WS_LOGF = 90 * MiB + 65536, WS_CB = WS_LOGF + 524288, WS_SS = WS_CB + 524288, WS_NRM = WS_SS + 131072;
constexpr size_t WS_XN = 92 * MiB, WS_E = WS_XN, WS_UPD = WS_XN + 4 * MiB, WS_STATE = WS_XN + 20 * MiB;
constexpr size_t WS_QO = 124 * MiB, WS_KB = 140 * MiB, WS_VB = 156 * MiB, WS_SUA = 172 * MiB, WS_RQ = 182 * MiB, WS_RK = 190 * MiB, WS_RKT = 198 * MiB, WS_YS5 = WS_RKT;
constexpr size_t WS_RVT = 206 * MiB, WS_GATE = 214 * MiB, WS_END = 246 * MiB;

constexpr int RING_BYTES = 131072, LDS_BYTES = 147456;

struct Args { const float* in[16]; float* out; unsigned char* ws; };

__device__ __forceinline__ float bf2f(unsigned short b) { return __uint_as_float((unsigned)b << 16); }
__device__ __forceinline__ float bflo(unsigned w) { return __uint_as_float(w << 16); }
__device__ __forceinline__ float bfhi(unsigned w) { return __uint_as_float(w & 0xffff0000u); }
__device__ __forceinline__ unsigned pk2(float lo, float hi) { return pg8::cvt_pk_bf16(lo, hi); }
__device__ __forceinline__ unsigned short f2bf(float f) { return (unsigned short)(pg8::cvt_pk_bf16(f, 0.f) & 0xffffu); }
__device__ __forceinline__ float wave_sum(float v) {
#pragma unroll
    for (int o = 1; o < 64; o <<= 1) v += __shfl_xor(v, o);
    return v;
}
__device__ __forceinline__ float lg2_gamma(int hh) { return log2f(1.0f - exp2f(-5.0f - (float)hh)); }

__device__ __forceinline__ int win_col(int n) {
    if (n < 1536) return n;
    if (n < 1792) return n + 8;
    if (n < 2304) { const bool q = n < 2048; const int base = q ? 1792 : 2048; const int hh = (n - base) >> 6, pos = (n - base) & 63; const int d = (pos & 1) ? 32 + (pos >> 1) : (pos >> 1); return (q ? 1800 : 2056) + hh * 64 + d; }
    return n + 8;
}
template <bool MAP> __device__ __forceinline__ void p0_transpose_item(const float* W, int K, int Nsrc, int Ndst, bf16* WT, LAS float* scr, int item, int lane) {
    const int nblk = Ndst / 32, kb = item / nblk, nb = item % nblk, k0 = 64 * kb, n0 = 32 * nb;
    const int sc = MAP ? win_col(n0 + (lane & 31)) : n0 + (lane & 31);
    float wv[32];
#pragma unroll
    for (int i = 0; i < 32; ++i) { const int kk = 2 * i + (lane >> 5); wv[i] = (MAP && sc < 0) ? 0.f : W[(size_t)(k0 + kk) * Nsrc + (sc < 0 ? 0 : sc)]; }
#pragma unroll
    for (int i = 0; i < 32; ++i) { const int kk = 2 * i + (lane >> 5); scr[kk * 33 + (lane & 31)] = wv[i]; }
    asm volatile("s_waitcnt lgkmcnt(0)" ::: "memory");
    const int c = lane & 7;
#pragma unroll
    for (int j = 0; j < 4; ++j) { const int n = (lane >> 3) + 8 * j; const LAS float* s = scr + (8 * c) * 33 + n;
        u32x4 o; o.x = pk2(s[0 * 33], s[1 * 33]); o.y = pk2(s[2 * 33], s[3 * 33]); o.z = pk2(s[4 * 33], s[5 * 33]); o.w = pk2(s[6 * 33], s[7 * 33]);
        *(u32x4*)(WT + (size_t)(n0 + n) * K + k0 + 8 * c) = o; }
    asm volatile("s_waitcnt lgkmcnt(0)" ::: "memory");
}

__device__ __forceinline__ void s5_prep(const Args& a, int l, int g, LAS float* L, int tid) {
    LAS float* LPr = L;
    LAS float* LPi = L + 33 * 64;
    LAS float* Bbr = L + 66 * 64;
    LAS float* Bbi = Bbr + 1024;
    LAS float* Cr = Bbi + 1024;
    LAS float* Ci = Cr + 1024;
    LAS float* KT = Ci + 1024;
    const float* a_re = a.in[4] + (size_t)(l * 16 + g) * 64; const float* a_im = a.in[5] + (size_t)(l * 16 + g) * 64;
    const float* b_re = a.in[6] + (size_t)(l * 16 + g) * 1024; const float* b_im = a.in[7] + (size_t)(l * 16 + g) * 1024;
    const float* c_re = a.in[8] + (size_t)(l * 16 + g) * 1024; const float* c_im = a.in[9] + (size_t)(l * 16 + g) * 1024;
    const float log_dt = a.in[11][l * 16 + g];
    bf16* MF = (bf16*)(a.ws + WS_MF) + (size_t)(l * 16 + g) * 512 * KA5;
    bf16* WB = (bf16*)(a.ws + WS_WB) + (size_t)(l * 16 + g) * 128 * 512;
    float* LAM = (float*)(a.ws + WS_LAM) + (size_t)(l * 16 + g) * 128;
    if (tid < 64) {
        const int p = tid;
        const double dt = exp((double)log_dt), ar = (double)a_re[p], ai = (double)a_im[p];
        const double mag = exp(ar * dt); double sn, cs; sincos(ai * dt, &sn, &cs);
        const double lr = mag * cs, li = mag * sn, den = ar * ar + ai * ai;
        const double fr = ((lr - 1.0) * ar + li * ai) / den, fi = (li * ar - (lr - 1.0) * ai) / den;
#pragma unroll 4
        for (int h = 0; h < 16; ++h) { const double br = (double)b_re[p * 16 + h], bi = (double)b_im[p * 16 + h]; Bbr[p * 16 + h] = (float)(fr * br - fi * bi); Bbi[p * 16 + h] = (float)(fr * bi + fi * br); }
        double pr = 1.0, pi = 0.0;
        for (int j = 0; j <= 32; ++j) { LPr[j * 64 + p] = (float)pr; LPi[j * 64 + p] = (float)pi; const double nr = pr * lr - pi * li, ni = pr * li + pi * lr; pr = nr; pi = ni; }
        LAM[p] = LPr[32 * 64 + p]; LAM[64 + p] = LPi[32 * 64 + p];
    }
    for (int i = tid; i < 1024; i += NTHR) { const int h = i >> 6, p = i & 63; Cr[p * 16 + h] = c_re[i]; Ci[p * 16 + h] = c_im[i]; }
    __syncthreads();
    { const int j = tid >> 4, h = tid & 15; float acc[16];
#pragma unroll
      for (int e = 0; e < 16; ++e) acc[e] = 0.f;
      for (int p = 0; p < 64; ++p) { const float cr = Cr[p * 16 + h], ci = Ci[p * 16 + h], lr = LPr[j * 64 + p], li = LPi[j * 64 + p]; const float clr = cr * lr - ci * li, cli = cr * li + ci * lr;
#pragma unroll
          for (int q = 0; q < 4; ++q) { const f32x4 br = *(const LAS f32x4*)(Bbr + p * 16 + 4 * q), bi = *(const LAS f32x4*)(Bbi + p * 16 + 4 * q);
              acc[4 * q] += clr * br.x - cli * bi.x; acc[4 * q + 1] += clr * br.y - cli * bi.y; acc[4 * q + 2] += clr * br.z - cli * bi.z; acc[4 * q + 3] += clr * br.w - cli * bi.w; } }
#pragma unroll
      for (int e = 0; e < 16; ++e) KT[tid * 16 + e] = acc[e]; }
    __syncthreads();
    for (int q = tid; q < 512 * 64; q += NTHR) {
        const int row = q >> 6, cp = q & 63, s = cp >> 1, h0 = (cp & 1) * 8, t = row >> 4, h = row & 15;
        u32x4 o = (u32x4){0u, 0u, 0u, 0u};
        if (s <= t) { const LAS float* k = KT + ((t - s) * 16 + h) * 16 + h0; o.x = pk2(k[0], k[1]); o.y = pk2(k[2], k[3]); o.z = pk2(k[4], k[5]); o.w = pk2(k[6], k[7]); }
        *(u32x4*)(MF + (size_t)row * KA5 + cp * 8) = o;
    }
    for (int q = tid; q < 512 * 16; q += NTHR) {
        const int row = q >> 4, cp = q & 15, t = row >> 4, h = row & 15; float v[8];
#pragma unroll
        for (int e = 0; e < 8; ++e) { const int jj = cp * 8 + e, p = jj & 63; const float cr = Cr[p * 16 + h], ci = Ci[p * 16 + h], lr = LPr[(t + 1) * 64 + p], li = LPi[(t + 1) * 64 + p];
            v[e] = (jj < 64) ? (cr * lr - ci * li) : -(cr * li + ci * lr); }
        u32x4 o; o.x = pk2(v[0], v[1]); o.y = pk2(v[2], v[3]); o.z = pk2(v[4], v[5]); o.w = pk2(v[6], v[7]);
        *(u32x4*)(MF + (size_t)row * KA5 + 512 + cp * 8) = o;
    }
    for (int q = tid; q < 128 * 64; q += NTHR) {
        const int j = q >> 6, cp = q & 63, s = cp >> 1, h0 = (cp & 1) * 8, p = j & 63; const float lr = LPr[(31 - s) * 64 + p], li = LPi[(31 - s) * 64 + p]; float v[8];
#pragma unroll
        for (int e = 0; e < 8; ++e) { const float br = Bbr[p * 16 + h0 + e], bi = Bbi[p * 16 + h0 + e]; v[e] = (j < 64) ? (lr * br - li * bi) : (lr * bi + li * br); }
        u32x4 o; o.x = pk2(v[0], v[1]); o.y = pk2(v[2], v[3]); o.z = pk2(v[4], v[5]); o.w = pk2(v[6], v[7]);
        *(u32x4*)(WB + (size_t)j * 512 + cp * 8) = o;
    }
    __syncthreads();
}

__device__ __forceinline__ void norm0_phase(const Args& a, int lane, int gw, int NGW) {
    const float* X = a.in[0]; f32x4 gv[4];
#pragma unroll
    for (int j = 0; j < 4; ++j) gv[j] = *((const f32x4*)a.in[1] + lane + 64 * j);
    bf16* XN = (bf16*)(a.ws + WS_XN); float* SS = (float*)(a.ws + WS_SS);
    for (int m = gw; m < M; m += 2 * NGW) {
        const int m2 = m + NGW; const bool has2 = m2 < M;
        const f32x4* xr = (const f32x4*)(X + (size_t)m * DM) + lane; const f32x4* xr2 = (const f32x4*)(X + (size_t)(has2 ? m2 : m) * DM) + lane; f32x4 v[4], w[4];
#pragma unroll
        for (int j = 0; j < 4; ++j) { v[j] = xr[64 * j]; w[j] = xr2[64 * j]; }
        float ss = 0.f, ss2 = 0.f;
#pragma unroll
        for (int j = 0; j < 4; ++j) { ss += (v[j].x * v[j].x + v[j].y * v[j].y) + (v[j].z * v[j].z + v[j].w * v[j].w); ss2 += (w[j].x * w[j].x + w[j].y * w[j].y) + (w[j].z * w[j].z + w[j].w * w[j].w); }
        ss = wave_sum(ss); ss2 = wave_sum(ss2);
        unsigned long long* o8 = (unsigned long long*)(XN + (size_t)m * DM) + lane; unsigned long long* o82 = (unsigned long long*)(XN + (size_t)m2 * DM) + lane;
#pragma unroll
        for (int j = 0; j < 4; ++j) { v[j] = v[j] * gv[j]; o8[64 * j] = (unsigned long long)pk2(v[j].x, v[j].y) | ((unsigned long long)pk2(v[j].z, v[j].w) << 32);
            if (has2) { w[j] = w[j] * gv[j]; o82[64 * j] = (unsigned long long)pk2(w[j].x, w[j].y) | ((unsigned long long)pk2(w[j].z, w[j].w) << 32); } }
        if (lane == 0) { SS[m] = ss; if (has2) SS[m2] = ss2; }
    }
}
__device__ __forceinline__ void final_norm(const Args& a, float* X, const float* SS, int lane, int gw, int NGW) {
    f32x4 gv[4];
#pragma unroll
    for (int j = 0; j < 4; ++j) gv[j] = *((const f32x4*)a.in[15] + lane + 64 * j);
    for (int m = gw; m < M; m += 2 * NGW) {
        const int m2 = m + NGW; const bool has2 = m2 < M;
        f32x4* xr = (f32x4*)(X + (size_t)m * DM) + lane; f32x4* xr2 = (f32x4*)(X + (size_t)(has2 ? m2 : m) * DM) + lane; f32x4 v[4], w[4];
#pragma unroll
        for (int j = 0; j < 4; ++j) { v[j] = xr[64 * j]; w[j] = xr2[64 * j]; }
        const float r1 = rsqrtf(SS[m] * (1.f / DM) + EPS), r2 = rsqrtf(SS[has2 ? m2 : m] * (1.f / DM) + EPS);
#pragma unroll
        for (int j = 0; j < 4; ++j) { xr[64 * j] = v[j] * r1 * gv[j]; if (has2) xr2[64 * j] = w[j] * r2 * gv[j]; }
    }
}

__device__ __forceinline__ void flog_phase(const Args& a, int l, const float* SS, LAS float* WF, int tid, int lane, int wave, int blk, int nblk) {
    const float* win = a.in[2] + (size_t)l * DM * NIN;
    for (int i = tid; i < 2048; i += NTHR) { const int k = i >> 1, hf = i & 1; *(LAS f32x4*)(WF + k * 8 + hf * 4) = *(const f32x4*)(win + (size_t)k * NIN + 1536 + hf * 4); }
    __syncthreads();
    const bf16* XN = (const bf16*)(a.ws + WS_XN); float* LOGF = (float*)(a.ws + WS_LOGF);
    const float bfj = (lane < 8) ? a.in[3][l * 8 + lane] : 0.f;
    const int rows_per = M / nblk;
    for (int i = wave; i < rows_per; i += 2 * NWAVES) {
        const int m = blk * rows_per + i, m2 = m + NWAVES; const bool has2 = (i + NWAVES) < rows_per;
        const u32x4 x0 = *((const u32x4*)(XN + (size_t)m * DM) + lane), x1 = *((const u32x4*)(XN + (size_t)m * DM + 512) + lane);
        const u32x4 y0 = *((const u32x4*)(XN + (size_t)(has2 ? m2 : m) * DM) + lane), y1 = *((const u32x4*)(XN + (size_t)(has2 ? m2 : m) * DM + 512) + lane);
        float acc[8], acc2[8];
#pragma unroll
        for (int e = 0; e < 8; ++e) { acc[e] = 0.f; acc2[e] = 0.f; }
#pragma unroll
        for (int hf = 0; hf < 2; ++hf)
#pragma unroll
            for (int q = 0; q < 8; ++q) { const int k = 512 * hf + 8 * lane + q; const f32x4 w0 = *(const LAS f32x4*)(WF + k * 8), w1 = *(const LAS f32x4*)(WF + k * 8 + 4);
                const unsigned xw = hf ? x1[q >> 1] : x0[q >> 1], yw = hf ? y1[q >> 1] : y0[q >> 1]; const float hv = (q & 1) ? bfhi(xw) : bflo(xw), hv2 = (q & 1) ? bfhi(yw) : bflo(yw);
                acc[0] += hv * w0.x; acc[1] += hv * w0.y; acc[2] += hv * w0.z; acc[3] += hv * w0.w; acc[4] += hv * w1.x; acc[5] += hv * w1.y; acc[6] += hv * w1.z; acc[7] += hv * w1.w;
                acc2[0] += hv2 * w0.x; acc2[1] += hv2 * w0.y; acc2[2] += hv2 * w0.z; acc2[3] += hv2 * w0.w; acc2[4] += hv2 * w1.x; acc2[5] += hv2 * w1.y; acc2[6] += hv2 * w1.z; acc2[7] += hv2 * w1.w; }
        float mine = 0.f, mine2 = 0.f;
#pragma unroll
        for (int e = 0; e < 8; ++e) { const float s = wave_sum(acc[e]), s2 = wave_sum(acc2[e]); if (lane == e) { mine = s; mine2 = s2; } }
        if (lane < 8) { const float z = mine * rsqrtf(SS[m] * (1.f / DM) + EPS) + bfj; LOGF[(size_t)((m >> 12) * 8 + lane) * SEQ + (m & 4095)] = fminf(z, 0.f) - log1pf(expf(-fabsf(z)));
            if (has2) { const float z2 = mine2 * rsqrtf(SS[m2] * (1.f / DM) + EPS) + bfj; LOGF[(size_t)((m2 >> 12) * 8 + lane) * SEQ + (m2 & 4095)] = fminf(z2, 0.f) - log1pf(expf(-fabsf(z2))); } }
    }
}

__device__ __forceinline__ bool opaque_true() { int d = 1; asm volatile("" : "+s"(d)); return d != 0; }
struct RangeOrder {
    pg8::StaticOrder S; int lo, hi;
    __device__ bool next(int i, pg8::Unit& u) const { return (lo + i < hi) ? S.next(lo + i, u) : false; }
    __device__ __forceinline__ void a_ready(const pg8::Unit&) const {}
    __device__ __forceinline__ void done(const pg8::Unit&) const {}
};
struct FlatOrder {
    int nM, nN, nG, G, c;
    __device__ bool next(int i, pg8::Unit& u) const { const int L = i * G + c; if (L >= nG * nM * nN) return false; u.gz = L / (nM * nN); const int r = L % (nM * nN); u.pm = r % nM; u.pn = r / nM; return true; }
    __device__ __forceinline__ void a_ready(const pg8::Unit&) const {}
    __device__ __forceinline__ void done(const pg8::Unit&) const {}
};
__device__ __forceinline__ float silu_f(float v) { return v / (1.f + __expf(-v)); }
__device__ __forceinline__ float gelu_tanh(float v) { const float u = 0.7978845608028654f * (v + 0.044715f * v * v * v); const float e = __expf(2.f * u); const float th = 1.f - 2.f / (e + 1.f); return 0.5f * v * (1.f + th); }

struct EpiInProj {
    static constexpr bool PERM = true, AFTER_DRAIN = false;
    unsigned char* ws; const float* SS; const float* bfl;
    __device__ __forceinline__ void operator()(const pg8::f32x4 (&acc)[2][2][4][2], const pg8::Unit& u, int wr, int wc, int fr, int fq) const {
        const int pn = u.pn; const int row0 = u.pm * 256 + wr * 64 + fr, cl0 = wc * 32 + 8 * fq;
        float rs[2][4];
#pragma unroll
        for (int ai = 0; ai < 2; ++ai)
#pragma unroll
            for (int m = 0; m < 4; ++m) rs[ai][m] = rsqrtf(SS[row0 + ai * 128 + m * 16] * (1.f / DM) + EPS);
        if (pn == 14) {
            if (wc == 0 && fq == 0) { float* LOGF = (float*)(ws + WS_LOGF); const f32x4 b0 = *(const f32x4*)bfl, b1 = *(const f32x4*)(bfl + 4);
#pragma unroll
                for (int ai = 0; ai < 2; ++ai)
#pragma unroll
                    for (int m = 0; m < 4; ++m) { const int row = row0 + ai * 128 + m * 16; const float r = rs[ai][m]; const pg8::f32x4 v0 = acc[ai][0][m][0], v1 = acc[ai][0][m][1];
                        float z[8] = {v0[0] * r + b0.x, v0[1] * r + b0.y, v0[2] * r + b0.z, v0[3] * r + b0.w, v1[0] * r + b1.x, v1[1] * r + b1.y, v1[2] * r + b1.z, v1[3] * r + b1.w};
#pragma unroll
                        for (int e = 0; e < 8; ++e) LOGF[(size_t)((row >> 12) * 8 + e) * SEQ + (row & 4095)] = fminf(z[e], 0.f) - log1pf(__expf(-fabsf(z[e]))); } }
            return;
        }
        if (pn < 6) {
            bf16* base = (bf16*)(ws + (pn < 2 ? WS_QO : pn < 4 ? WS_KB : WS_VB)); const float sc = pn < 2 ? 0.125f * LOG2E : 1.f; const int cb = (pn & 1) * 256 + cl0;
#pragma unroll
            for (int ai = 0; ai < 2; ++ai)
#pragma unroll
                for (int m = 0; m < 4; ++m) { bf16* rp = base + (size_t)(row0 + ai * 128 + m * 16) * 512 + cb;
#pragma unroll
                    for (int bj = 0; bj < 2; ++bj) { const float sr = sc * rs[ai][m]; const pg8::f32x4 v0 = acc[ai][bj][m][0] * sr, v1 = acc[ai][bj][m][1] * sr; u32x4 w; w.x = pk2(v0[0], v0[1]); w.y = pk2(v0[2], v0[3]); w.z = pk2(v1[0], v1[1]); w.w = pk2(v1[2], v1[3]); *(u32x4*)(rp + bj * 128) = w; } }
        } else if (pn == 6) {
            bf16* base = (bf16*)(ws + WS_SUA);
#pragma unroll
            for (int ai = 0; ai < 2; ++ai)
#pragma unroll
                for (int m = 0; m < 4; ++m) { const int row = row0 + ai * 128 + m * 16, chunk = row >> 5, t = row & 31;
#pragma unroll
                    for (int bj = 0; bj < 2; ++bj) { const int c = cl0 + bj * 128, g = c >> 4, h0 = c & 15; const pg8::f32x4 v0 = acc[ai][bj][m][0] * rs[ai][m], v1 = acc[ai][bj][m][1] * rs[ai][m]; u32x4 w; w.x = pk2(v0[0], v0[1]); w.y = pk2(v0[2], v0[3]); w.z = pk2(v1[0], v1[1]); w.w = pk2(v1[2], v1[3]);
                        *(u32x4*)(base + ((size_t)(g * 512 + chunk) * KA5 + t * 16 + h0)) = w; } }
        } else if (pn == 7 || pn == 8) {
            const f32x4* rope = (const f32x4*)(ws + WS_ROPE); bf16* base = (bf16*)(ws + (pn == 7 ? WS_RQ : WS_RK)); bf16* RKT = (bf16*)(ws + WS_RKT);
#pragma unroll
            for (int ai = 0; ai < 2; ++ai)
#pragma unroll
                for (int m = 0; m < 4; ++m) { const int row = row0 + ai * 128 + m * 16, b = row >> 12, t = row & 4095;
#pragma unroll
                    for (int bj = 0; bj < 2; ++bj) { const int c = cl0 + bj * 128, hh = c >> 6, pos0 = c & 63; const pg8::f32x4 v0 = acc[ai][bj][m][0] * rs[ai][m], v1 = acc[ai][bj][m][1] * rs[ai][m];
                        const f32x4 r0 = rope[(t * 32 + (pos0 >> 1)) >> 1], r1 = rope[((t * 32 + (pos0 >> 1)) >> 1) + 1];
                        float o[8];
                        o[0] = v0[0] * r0.x - v0[1] * r0.y; o[1] = v0[0] * r0.y + v0[1] * r0.x; o[2] = v0[2] * r0.z - v0[3] * r0.w; o[3] = v0[2] * r0.w + v0[3] * r0.z;
                        o[4] = v1[0] * r1.x - v1[1] * r1.y; o[5] = v1[0] * r1.y + v1[1] * r1.x; o[6] = v1[2] * r1.z - v1[3] * r1.w; o[7] = v1[2] * r1.w + v1[3] * r1.z;
                        u32x4 w; w.x = pk2(o[0], o[1]); w.y = pk2(o[2], o[3]); w.z = pk2(o[4], o[5]); w.w = pk2(o[6], o[7]);
                        *(u32x4*)(base + (size_t)row * 256 + c) = w;
                        if (pn == 8) { const float wk = exp2f(lg2_gamma(hh) * (float)(63 - (t & 63))); bf16* tp = RKT + ((size_t)((b * 4 + hh) * 64 + pos0)) * SEQ + t;
#pragma unroll
                            for (int e = 0; e < 8; ++e) tp[(size_t)e * SEQ] = f2bf(o[e] * wk); } } }
        } else if (pn == 9) {
            bf16* RVT = (bf16*)(ws + WS_RVT);
#pragma unroll
            for (int ai = 0; ai < 2; ++ai)
#pragma unroll
                for (int m = 0; m < 4; ++m) { const int row = row0 + ai * 128 + m * 16, b = row >> 12, t = row & 4095;
#pragma unroll
                    for (int bj = 0; bj < 2; ++bj) { const int c = cl0 + bj * 128, hh = c >> 6, d0 = c & 63; const pg8::f32x4 v0 = acc[ai][bj][m][0] * rs[ai][m], v1 = acc[ai][bj][m][1] * rs[ai][m]; bf16* tp = RVT + ((size_t)((b * 4 + hh) * 64 + d0)) * SEQ + t;
#pragma unroll
                        for (int e = 0; e < 4; ++e) { tp[(size_t)e * SEQ] = f2bf(v0[e]); tp[(size_t)(4 + e) * SEQ] = f2bf(v1[e]); } } }
        } else {
            bf16* base = (bf16*)(ws + WS_GATE); const int cb = (pn - 10) * 256 + cl0;
#pragma unroll
            for (int ai = 0; ai < 2; ++ai)
#pragma unroll
                for (int m = 0; m < 4; ++m) { bf16* rp = base + (size_t)(row0 + ai * 128 + m * 16) * 1024 + cb;
#pragma unroll
                    for (int bj = 0; bj < 2; ++bj) { const pg8::f32x4 v0 = acc[ai][bj][m][0] * rs[ai][m], v1 = acc[ai][bj][m][1] * rs[ai][m]; u32x4 w; w.x = pk2(silu_f(v0[0]), silu_f(v0[1])); w.y = pk2(silu_f(v0[2]), silu_f(v0[3])); w.z = pk2(silu_f(v1[0]), silu_f(v1[1])); w.w = pk2(silu_f(v1[2]), silu_f(v1[3])); *(u32x4*)(rp + bj * 128) = w; } }
        }
    }
};
struct EpiS5E {
    static constexpr bool PERM = false, AFTER_DRAIN = false;
    float* E;
    __device__ __forceinline__ void operator()(const pg8::f32x4 (&acc)[2][2][4][2], const pg8::Unit& u, int wr, int wc, int fr, int fq) const {
        const int row0 = u.pm * 256 + wr * 64 + fr, col0 = wc * 32 + 4 * fq;
#pragma unroll
        for (int ai = 0; ai < 2; ++ai)
#pragma unroll
            for (int m = 0; m < 4; ++m) { float* rp = E + ((size_t)u.gz * NCH5 + row0 + ai * 128 + m * 16) * 128 + col0;
#pragma unroll
                for (int n = 0; n < 2; ++n) *(pg8::f32x4*)(rp + n * 16) = acc[ai][0][m][n]; }
    }
};
struct EpiS5Y {
    static constexpr bool PERM = true, AFTER_DRAIN = false;
    const bf16* SUA; bf16* YS5; const float* dvec;
    __device__ __forceinline__ void operator()(const pg8::f32x4 (&acc)[2][2][4][2], const pg8::Unit& u, int wr, int wc, int fr, int fq) const {
        const int row0 = u.pm * 256 + wr * 64 + fr, cl0 = u.pn * 256 + wc * 32 + 8 * fq; const int g = u.gz;
#pragma unroll
        for (int bj = 0; bj < 2; ++bj) { const int c = cl0 + bj * 128, tt = c >> 4, h0 = c & 15; const f32x4 d0 = *(const f32x4*)(dvec + g * 16 + h0), d1 = *(const f32x4*)(dvec + g * 16 + h0 + 4);
#pragma unroll
            for (int ai = 0; ai < 2; ++ai)
#pragma unroll
                for (int m = 0; m < 4; ++m) { const int chunk = row0 + ai * 128 + m * 16; const u32x4 uu = *(const u32x4*)(SUA + ((size_t)(g * 512 + chunk) * KA5 + c)); const pg8::f32x4 v0 = acc[ai][bj][m][0], v1 = acc[ai][bj][m][1];
                    float y[8]; y[0] = v0[0] + d0.x * bflo(uu.x); y[1] = v0[1] + d0.y * bfhi(uu.x); y[2] = v0[2] + d0.z * bflo(uu.y); y[3] = v0[3] + d0.w * bfhi(uu.y);
                    y[4] = v1[0] + d1.x * bflo(uu.z); y[5] = v1[1] + d1.y * bfhi(uu.z); y[6] = v1[2] + d1.z * bflo(uu.w); y[7] = v1[3] + d1.w * bfhi(uu.w);
#pragma unroll
                    for (int e = 0; e < 8; ++e) y[e] = gelu_tanh(y[e]);
                    u32x4 w; w.x = pk2(y[0], y[1]); w.y = pk2(y[2], y[3]); w.z = pk2(y[4], y[5]); w.w = pk2(y[6], y[7]);
                    *(u32x4*)(YS5 + (size_t)(chunk * 32 + tt) * 256 + g * 16 + h0) = w; } }
    }
};
struct EpiGlu {
    static constexpr bool PERM = true, AFTER_DRAIN = false;
    const bf16* YS5; bf16* G; bool dry;
    __device__ __forceinline__ void operator()(const pg8::f32x4 (&acc)[2][2][4][2], const pg8::Unit& u, int wr, int wc, int fr, int fq) const {
        const int row0 = u.pm * 256 + wr * 64 + fr, cl0 = wc * 32 + 8 * fq;
#pragma unroll
        for (int ai = 0; ai < 2; ++ai)
#pragma unroll
            for (int m = 0; m < 4; ++m) { const int row = row0 + ai * 128 + m * 16;
#pragma unroll
                for (int bj = 0; bj < 2; ++bj) { const int c = cl0 + bj * 128; const u32x4 yy = *(const u32x4*)(YS5 + (size_t)row * 256 + c); bf16* gp = G + (size_t)row * 1024 + 512 + c; const u32x4 gg = *(const u32x4*)gp;
                    const pg8::f32x4 v0 = acc[ai][bj][m][0], v1 = acc[ai][bj][m][1]; float s[8];
#pragma unroll
                    for (int e = 0; e < 4; ++e) { s[e] = 1.f / (1.f + __expf(-v0[e])); s[4 + e] = 1.f / (1.f + __expf(-v1[e])); }
                    u32x4 w; w.x = pk2(bflo(yy.x) * s[0] * bflo(gg.x), bfhi(yy.x) * s[1] * bfhi(gg.x)); w.y = pk2(bflo(yy.y) * s[2] * bflo(gg.y), bfhi(yy.y) * s[3] * bfhi(gg.y));
                    w.z = pk2(bflo(yy.z) * s[4] * bflo(gg.z), bfhi(yy.z) * s[5] * bfhi(gg.z)); w.w = pk2(bflo(yy.w) * s[6] * bflo(gg.w), bfhi(yy.w) * s[7] * bfhi(gg.w));
                    if (!dry) *(u32x4*)gp = w; } }
    }
};
struct EpiOut {
    static constexpr bool PERM = false, AFTER_DRAIN = false;
    const float* base; float* out; float* SSn; bf16* XN; const float* gnext; bool dry;
    __device__ __forceinline__ void operator()(const pg8::f32x4 (&acc)[2][2][4][2], const pg8::Unit& u, int wr, int wc, int fr, int fq) const {
        const int row0 = u.pm * 256 + wr * 64 + fr, col0 = u.pn * 256 + wc * 32 + 4 * fq;
        f32x4 gq[2][2];
#pragma unroll
        for (int bj = 0; bj < 2; ++bj)
#pragma unroll
            for (int n = 0; n < 2; ++n) gq[bj][n] = gnext ? *(const f32x4*)(gnext + col0 + bj * 128 + n * 16) : (f32x4){0.f, 0.f, 0.f, 0.f};
#pragma unroll
        for (int ai = 0; ai < 2; ++ai)
#pragma unroll
            for (int m = 0; m < 4; ++m) { const int row = row0 + ai * 128 + m * 16; const size_t off = (size_t)row * DM + col0; float sq = 0.f;
#pragma unroll
                for (int bj = 0; bj < 2; ++bj)
#pragma unroll
                    for (int n = 0; n < 2; ++n) { const f32x4 bs = *(const f32x4*)(base + off + bj * 128 + n * 16); const pg8::f32x4 v = acc[ai][bj][m][n]; const f32x4 x = (f32x4){bs.x + v[0], bs.y + v[1], bs.z + v[2], bs.w + v[3]};
                        sq += (x.x * x.x + x.y * x.y) + (x.z * x.z + x.w * x.w);
                        if (!dry) { *(f32x4*)(out + off + bj * 128 + n * 16) = x;
                            if (gnext) { const f32x4 g = gq[bj][n]; u32x2 w; w.x = pk2(x.x * g.x, x.y * g.y); w.y = pk2(x.z * g.z, x.w * g.w); *(u32x2*)(XN + off + bj * 128 + n * 16) = w; } } }
                sq += __shfl_xor(sq, 16); sq += __shfl_xor(sq, 32);
                if (fq == 0 && !dry) __hip_atomic_fetch_add(SSn + row, sq, __ATOMIC_RELAXED, __HIP_MEMORY_SCOPE_AGENT); }
    }
};

template <int KS, int UNR, class Epi> __device__ __forceinline__ void wave_gemm64(const bf16* A, int lda, const bf16* B, int ldb, int lane, const Epi& epi) {
    const int fr = lane & 15, fq = lane >> 4;
    pg8::f32x4 acc[4][4];
#pragma unroll
    for (int jb = 0; jb < 4; ++jb)
#pragma unroll
        for (int ib = 0; ib < 4; ++ib) acc[jb][ib] = (pg8::f32x4){0.f, 0.f, 0.f, 0.f};
    const bf16* ap = A + (size_t)fr * lda + 8 * fq; const bf16* bp = B + (size_t)fr * ldb + 8 * fq;
#pragma unroll UNR
    for (int ks = 0; ks < KS; ++ks) {
        bf16x8 af[4], bv[4];
#pragma unroll
        for (int ib = 0; ib < 4; ++ib) { af[ib] = *(const bf16x8*)(ap + (size_t)(16 * ib) * lda + 32 * ks); bv[ib] = *(const bf16x8*)(bp + (size_t)(16 * ib) * ldb + 32 * ks); }
#pragma unroll
        for (int jb = 0; jb < 4; ++jb)
#pragma unroll
            for (int ib = 0; ib < 4; ++ib) acc[jb][ib] = __builtin_amdgcn_mfma_f32_16x16x32_bf16(bv[jb], af[ib], acc[jb][ib], 0, 0, 0);
    }
    epi(acc, fr, fq);
}
struct WEpiE {
    float* E;
    __device__ __forceinline__ void operator()(const pg8::f32x4 (&acc)[4][4], int fr, int fq) const {
#pragma unroll
        for (int jb = 0; jb < 4; ++jb)
#pragma unroll
            for (int ib = 0; ib < 4; ++ib) *(pg8::f32x4*)(E + (size_t)(16 * ib + fr) * 128 + 16 * jb + 4 * fq) = acc[jb][ib];
    }
};
struct WEpiS5Y {
    const bf16* SUAg; bf16* YS5; const float* dg; int chunk0, col0, g;
    __device__ __forceinline__ void operator()(const pg8::f32x4 (&acc)[4][4], int fr, int fq) const {
#pragma unroll
        for (int jb = 0; jb < 4; ++jb) { const int col = col0 + 16 * jb + 4 * fq, tt = col >> 4, h0 = col & 15; const f32x4 d4 = *(const f32x4*)(dg + h0);
#pragma unroll
            for (int ib = 0; ib < 4; ++ib) { const int chunk = chunk0 + 16 * ib + fr; const u32x2 uu = *(const u32x2*)(SUAg + (size_t)chunk * KA5 + col); const pg8::f32x4 v = acc[jb][ib];
                const float y0 = gelu_tanh(v[0] + d4.x * bflo(uu.x)), y1 = gelu_tanh(v[1] + d4.y * bfhi(uu.x)), y2 = gelu_tanh(v[2] + d4.z * bflo(uu.y)), y3 = gelu_tanh(v[3] + d4.w * bfhi(uu.y));
                u32x2 w; w.x = pk2(y0, y1); w.y = pk2(y2, y3); *(u32x2*)(YS5 + (size_t)(chunk * 32 + tt) * 256 + g * 16 + h0) = w; } }
    }
};
struct WEpiGlu {
    const bf16* YS5; bf16* G; int row0, col0;
    __device__ __forceinline__ void operator()(const pg8::f32x4 (&acc)[4][4], int fr, int fq) const {
#pragma unroll
        for (int jb = 0; jb < 4; ++jb)
#pragma unroll
            for (int ib = 0; ib < 4; ++ib) { const int row = row0 + 16 * ib + fr, col = col0 + 16 * jb + 4 * fq; const u32x2 yy = *(const u32x2*)(YS5 + (size_t)row * 256 + col); bf16* gp = G + (size_t)row * 1024 + 512 + col; const u32x2 gg = *(const u32x2*)gp; const pg8::f32x4 v = acc[jb][ib];
                const float s0 = 1.f / (1.f + __expf(-v[0])), s1 = 1.f / (1.f + __expf(-v[1])), s2 = 1.f / (1.f + __expf(-v[2])), s3 = 1.f / (1.f + __expf(-v[3]));
                u32x2 w; w.x = pk2(bflo(yy.x) * s0 * bflo(gg.x), bfhi(yy.x) * s1 * bfhi(gg.x)); w.y = pk2(bflo(yy.y) * s2 * bflo(gg.y), bfhi(yy.y) * s3 * bfhi(gg.y)); *(u32x2*)gp = w; }
    }
};

__device__ __forceinline__ void ret_upd_unit(unsigned char* ws, int unit, int lane) {
    const int c = unit & 63, bh = unit >> 6; const int i16 = lane & 15, kq = lane >> 4;
    const bf16* KT = (const bf16*)(ws + WS_RKT) + (size_t)bh * 64 * SEQ + c * 64; const bf16* VT = (const bf16*)(ws + WS_RVT) + (size_t)bh * 64 * SEQ + c * 64;
    float* UPD = (float*)(ws + WS_UPD) + (size_t)unit * 4096;
    bf16x8 af[4][2], bfv[4][2];
#pragma unroll
    for (int ib = 0; ib < 4; ++ib)
#pragma unroll
        for (int ks = 0; ks < 2; ++ks) { af[ib][ks] = *(const bf16x8*)(KT + (size_t)(16 * ib + i16) * SEQ + 32 * ks + 8 * kq); bfv[ib][ks] = *(const bf16x8*)(VT + (size_t)(16 * ib + i16) * SEQ + 32 * ks + 8 * kq); }
#pragma unroll
    for (int ib = 0; ib < 4; ++ib)
#pragma unroll
        for (int jb = 0; jb < 4; ++jb) { pg8::f32x4 d = (pg8::f32x4){0.f, 0.f, 0.f, 0.f};
            d = __builtin_amdgcn_mfma_f32_16x16x32_bf16(af[ib][0], bfv[jb][0], d, 0, 0, 0); d = __builtin_amdgcn_mfma_f32_16x16x32_bf16(af[ib][1], bfv[jb][1], d, 0, 0, 0);
            *(pg8::f32x4*)(UPD + (size_t)(16 * jb + i16) * 64 + 16 * ib + 4 * kq) = d; }
}
__device__ __forceinline__ void ret_out_unit(const Args& a, int l, int unit, int lane, bool dry = false) {
    unsigned char* ws = a.ws;
    const int c = unit & 63, bh = unit >> 6, hh = bh & 3, b = bh >> 2; const int fr = lane & 15, fq = lane >> 4;
    const size_t t0 = (size_t)b * SEQ + c * 64;
    const bf16* RQ = (const bf16*)(ws + WS_RQ) + t0 * 256 + hh * 64; const bf16* RK = (const bf16*)(ws + WS_RK) + t0 * 256 + hh * 64;
    const bf16* VT = (const bf16*)(ws + WS_RVT) + (size_t)bh * 64 * SEQ + c * 64; const bf16* ST = (const bf16*)(ws + WS_STATE) + (size_t)unit * 4096;
    const float lg = lg2_gamma(hh);
    bf16x8 qf[4][2]; pg8::f32x4 st[4][4];
#pragma unroll
    for (int nb = 0; nb < 4; ++nb)
#pragma unroll
        for (int ks = 0; ks < 2; ++ks) qf[nb][ks] = *(const bf16x8*)(RQ + (size_t)(16 * nb + fr) * 256 + 32 * ks + 8 * fq);
#pragma unroll
    for (int mb = 0; mb < 4; ++mb) { bf16x8 k0 = *(const bf16x8*)(RK + (size_t)(16 * mb + fr) * 256 + 8 * fq), k1 = *(const bf16x8*)(RK + (size_t)(16 * mb + fr) * 256 + 32 + 8 * fq);
#pragma unroll
        for (int nb = 0; nb < 4; ++nb) { pg8::f32x4 d = (pg8::f32x4){0.f, 0.f, 0.f, 0.f};
            d = __builtin_amdgcn_mfma_f32_16x16x32_bf16(k0, qf[nb][0], d, 0, 0, 0); d = __builtin_amdgcn_mfma_f32_16x16x32_bf16(k1, qf[nb][1], d, 0, 0, 0);
#pragma unroll
            for (int r = 0; r < 4; ++r) { const int mm = 16 * mb + 4 * fq + r, nn = 16 * nb + fr; const int df = mm > nn ? mm - nn : nn - mm; d[r] *= 0.125f * exp2f(lg * (float)df); }
            st[mb][nb] = d; } }
    pg8::f32x4 o[4][4];
#pragma unroll
    for (int nb = 0; nb < 4; ++nb)
#pragma unroll
        for (int dvb = 0; dvb < 4; ++dvb) o[nb][dvb] = (pg8::f32x4){0.f, 0.f, 0.f, 0.f};
#pragma unroll
    for (int dvb = 0; dvb < 4; ++dvb) { const bf16x8 s0 = *(const bf16x8*)(ST + (size_t)(16 * dvb + fr) * 64 + 8 * fq), s1 = *(const bf16x8*)(ST + (size_t)(16 * dvb + fr) * 64 + 32 + 8 * fq);
#pragma unroll
        for (int nb = 0; nb < 4; ++nb) { o[nb][dvb] = __builtin_amdgcn_mfma_f32_16x16x32_bf16(qf[nb][0], s0, o[nb][dvb], 0, 0, 0); o[nb][dvb] = __builtin_amdgcn_mfma_f32_16x16x32_bf16(qf[nb][1], s1, o[nb][dvb], 0, 0, 0); } }
#pragma unroll
    for (int nb = 0; nb < 4; ++nb)
#pragma unroll
        for (int r = 0; r < 4; ++r) { const float wq = 0.125f * exp2f(lg * (float)(16 * nb + 4 * fq + r + 1));
#pragma unroll
            for (int dvb = 0; dvb < 4; ++dvb) o[nb][dvb][r] *= wq; }
#pragma unroll
    for (int s = 0; s < 2; ++s) {
        bf16x8 pa[4];
#pragma unroll
        for (int nb = 0; nb < 4; ++nb) { u32x4 w; w.x = pk2(st[2 * s][nb][0], st[2 * s][nb][1]); w.y = pk2(st[2 * s][nb][2], st[2 * s][nb][3]); w.z = pk2(st[2 * s + 1][nb][0], st[2 * s + 1][nb][1]); w.w = pk2(st[2 * s + 1][nb][2], st[2 * s + 1][nb][3]); pa[nb] = __builtin_bit_cast(bf16x8, w); }
#pragma unroll
        for (int dvb = 0; dvb < 4; ++dvb) { const u32x2 v0 = *(const u32x2*)(VT + (size_t)(16 * dvb + fr) * SEQ + 32 * s + 4 * fq), v1 = *(const u32x2*)(VT + (size_t)(16 * dvb + fr) * SEQ + 32 * s + 16 + 4 * fq);
            const bf16x8 vf = __builtin_bit_cast(bf16x8, (u32x4){v0.x, v0.y, v1.x, v1.y});
#pragma unroll
            for (int nb = 0; nb < 4; ++nb) o[nb][dvb] = __builtin_amdgcn_mfma_f32_16x16x32_bf16(pa[nb], vf, o[nb][dvb], 0, 0, 0); }
    }
    const float* gn = a.in[13] + (size_t)l * 256 + hh * 64; float gnw[4];
#pragma unroll
    for (int dvb = 0; dvb < 4; ++dvb) gnw[dvb] = gn[16 * dvb + fr];
    bf16* Y = (bf16*)(ws + WS_GATE) + t0 * 1024 + 768 + hh * 64;
#pragma unroll
    for (int nb = 0; nb < 4; ++nb)
#pragma unroll
        for (int r = 0; r < 4; ++r) { float s = (o[nb][0][r] + o[nb][1][r]) + (o[nb][2][r] + o[nb][3][r]);
            s += __shfl_xor(s, 1); s += __shfl_xor(s, 2); s += __shfl_xor(s, 4); s += __shfl_xor(s, 8);
            const float mu = s * (1.f / 64.f); float q = 0.f;
#pragma unroll
            for (int dvb = 0; dvb < 4; ++dvb) { const float d = o[nb][dvb][r] - mu; q += d * d; }
            q += __shfl_xor(q, 1); q += __shfl_xor(q, 2); q += __shfl_xor(q, 4); q += __shfl_xor(q, 8);
            const float rstd = rsqrtf(q * (1.f / 64.f) + EPS); bf16* yp = Y + (size_t)(16 * nb + 4 * fq + r) * 1024 + fr;
#pragma unroll
            for (int dvb = 0; dvb < 4; ++dvb) { const float gt = bf2f(yp[16 * dvb]); if (!dry) yp[16 * dvb] = f2bf((o[nb][dvb][r] - mu) * rstd * gnw[dvb] * gt); } }
}

#define XB_TMO      128
#define XB_XCNT(j)  (256  + 64 * (j))
#define XB_XSUB(j)  (1280 + 64 * (j))
#define XB_XGEN(j)  (2304 + 64 * (j))
#define XB_TOP      3328
#define XB_TOPGEN   3392
#define XCD_BAR_WORDS 3456
#define XB_SPIN_CAP (1u << 18)

__device__ __forceinline__ unsigned xb_ld(unsigned* p)              { return __hip_atomic_load(p, __ATOMIC_RELAXED, __HIP_MEMORY_SCOPE_AGENT); }
__device__ __forceinline__ unsigned xb_add(unsigned* p, unsigned v) { return __hip_atomic_fetch_add(p, v, __ATOMIC_RELAXED, __HIP_MEMORY_SCOPE_AGENT); }
__device__ __forceinline__ unsigned xb_xcc_id() { return (unsigned)__builtin_amdgcn_s_getreg((3 << 11) | 20) & 0xFu; }
#define XB_SPIN(cond, bar) do { unsigned _sp = 0; while (cond) { __builtin_amdgcn_s_sleep(1); \
    if ((++_sp & 255u) == 0u) { if (xb_ld(&(bar)[XB_TMO])) break; if (_sp > XB_SPIN_CAP) { atomicAdd(&(bar)[XB_TMO], 1u); break; } } } } while (0)

struct XcdBarrier {
    unsigned* bar; unsigned x;
    volatile LAS unsigned* st;
};

__device__ __forceinline__ XcdBarrier xcd_barrier_post(unsigned* bar, volatile LAS unsigned* st) {
    XcdBarrier b; b.bar = bar; b.x = xb_xcc_id(); b.st = st;
    if (threadIdx.x == 0) (void)xb_add(&bar[XB_XCNT(b.x)], 1u);
    return b;
}
__device__ __forceinline__ void xcd_barrier_complete(unsigned* bar, unsigned x, unsigned& nloc, unsigned& nx) {
    const unsigned G = gridDim.x * gridDim.y * gridDim.z;
    unsigned sum, cnt, mine, sp = 0u;
    for (;;) {
        sum = 0u; cnt = 0u; mine = 0u;
#pragma unroll
        for (unsigned j = 0; j < 16; ++j) { const unsigned c = xb_ld(&bar[XB_XCNT(j)]); sum += c; cnt += (c > 0u) ? 1u : 0u; mine = (j == x) ? c : mine; }
        if (sum == G) break;
        __builtin_amdgcn_s_sleep(1);
        if ((++sp & 255u) == 0u) { if (xb_ld(&bar[XB_TMO])) break; if (sp > XB_SPIN_CAP) { atomicAdd(&bar[XB_TMO], 1u); break; } }
    }
    nloc = mine > 0u ? mine : 1u; nx = cnt > 0u ? cnt : 1u;
}

__device__ __forceinline__ void xcd_barrier(const XcdBarrier& b) {
    asm volatile("s_waitcnt vmcnt(0)" ::: "memory");
    __syncthreads();
    if (threadIdx.x == 0) {
        unsigned* bar = b.bar;
        __builtin_amdgcn_s_waitcnt(0);
        unsigned nloc = b.st[0], nx = b.st[1];
        if (nloc == 0u) { xcd_barrier_complete(bar, b.x, nloc, nx); b.st[0] = nloc; b.st[1] = nx; }
        const unsigned old = xb_add(&bar[XB_XSUB(b.x)], 1u);
        const unsigned gen = old / nloc;
        if (old + 1u == (gen + 1u) * nloc) {
            __builtin_amdgcn_fence(__ATOMIC_RELEASE, "agent");
            asm volatile("s_waitcnt vmcnt(0)" ::: "memory");
            const unsigned og = xb_add(&bar[XB_TOP], 1u);
            const unsigned tg = og / nx;
            if (og + 1u == (tg + 1u) * nx) xb_add(&bar[XB_TOPGEN], 1u);
            else XB_SPIN(xb_ld(&bar[XB_TOPGEN]) == tg, bar);
            __builtin_amdgcn_fence(__ATOMIC_ACQUIRE, "agent");
            xb_add(&bar[XB_XGEN(b.x)], 1u);
            asm volatile("s_waitcnt vmcnt(0)" ::: "memory");
        } else {
            XB_SPIN(xb_ld(&bar[XB_XGEN(b.x)]) == gen, bar);
            __builtin_amdgcn_fence(__ATOMIC_ACQUIRE, "agent");
            asm volatile("s_waitcnt vmcnt(0)" ::: "memory");
        }
    }
    __syncthreads();
}

#define XBAR_MAKE XcdBarrier xb_; xb_.bar = (unsigned*)args.ws; xb_.st = (volatile LAS unsigned*)((LAS unsigned char*)lds + RING_BYTES + 352); xb_.x = xb_.st[2]
#ifdef REP_SYNC
#define GSYNC() do { XBAR_MAKE; xcd_barrier(xb_); xcd_barrier(xb_); } while (0)
#else
#define GSYNC() do { XBAR_MAKE; xcd_barrier(xb_); } while (0)
#endif
#ifndef REP_P0
#define REP_P0 1
#endif
#ifndef REP_P1
#define REP_P1 1
#endif
#ifndef REP_P23
#define REP_P23 1
#endif
#ifndef REP_NORM
#define REP_NORM 1
#endif
__global__ void __launch_bounds__(NTHR, 2) mega_fwd(Args args) {
    extern __shared__ __attribute__((aligned(16))) unsigned char lds[];
    cg::grid_group grid = cg::this_grid();
    const int tid = threadIdx.x, lane = tid & 63, wave = __builtin_amdgcn_readfirstlane(tid >> 6);
    const int G = gridDim.x, bx = blockIdx.x; const int vcu = (G % 8 == 0) ? (bx % 8) * (G / 8) + bx / 8 : bx;
    const int gw = bx * NWAVES + wave, NGW = G * NWAVES;
    unsigned char* ws = args.ws;
    LAS unsigned char* ldsl = (LAS unsigned char*)lds;
    LAS float* ldsf = (LAS float*)lds;
    float* X = args.out;
    if (ws == nullptr) grid.sync();
    if (tid < 2) ((volatile LAS unsigned*)(ldsl + RING_BYTES + 352))[tid] = 0u;
    __syncthreads();
    { const XcdBarrier xb0 = xcd_barrier_post((unsigned*)ws, (volatile LAS unsigned*)(ldsl + RING_BYTES + 352)); if (tid == 0) ((volatile LAS unsigned*)(ldsl + RING_BYTES + 352))[2] = xb0.x; }
    __syncthreads();

#ifdef PROBE_T
    unsigned long long tacc_ = 0ull, tprev_ = __builtin_amdgcn_s_memrealtime();
#define TSTAMP(id) do { const unsigned long long tn_ = __builtin_amdgcn_s_memrealtime(); if ((id) == PROBE_T || ((PROBE_T) == 23 && ((id) == 2 || (id) == 3 || (id) == 5))) tacc_ += tn_ - tprev_; tprev_ = tn_; } while (0)
#else
#define TSTAMP(id) do {} while (0)
#endif
    for (int rep_ = 0; rep_ < REP_P0; ++rep_) {
        if (rep_) { __syncthreads(); }
#ifdef REP_S5P
        if (bx < 64) { s5_prep(args, bx >> 4, bx & 15, ldsf, tid); }
#endif
        if (bx < 64) { s5_prep(args, bx >> 4, bx & 15, ldsf, tid); }
        LAS float* scr = ldsf + wave * 4096;
        constexpr int I_IN = (DM / 64) * (NF / 32), I_O = (DM / 64) * (DM / 32), I_G = (256 / 64) * (256 / 32), I_L = I_IN + I_O + I_G;
#ifndef REP_TR
#define REP_TR 1
#endif
        for (int rt_ = 0; rt_ < REP_TR; ++rt_)
        for (int it = (bx < 64 ? DEPTH * I_L : (bx - 64) * NWAVES + wave); it < DEPTH * I_L; it += (G - 64) * NWAVES) {
            const int l = it / I_L; int r = it % I_L;
            if (r < I_IN) { p0_transpose_item<true>(args.in[2] + (size_t)l * DM * NIN, DM, NIN, NF, (bf16*)(ws + WS_WIN) + (size_t)l * NF * DM, scr, r, lane); continue; } r -= I_IN;
            if (r < I_O) { p0_transpose_item<false>(args.in[14] + (size_t)l * DM * DM, DM, DM, DM, (bf16*)(ws + WS_WO) + (size_t)l * DM * DM, scr, r, lane); continue; } r -= I_O;
            p0_transpose_item<false>(args.in[12] + (size_t)l * 65536, 256, 256, 256, (bf16*)(ws + WS_WGLU) + (size_t)l * 65536, scr, r, lane);
        }
        f32x2* rope = (f32x2*)(ws + WS_ROPE);
        for (int i = bx * NTHR + tid; i < SEQ * 32; i += G * NTHR) { const int pos = i >> 5, fi = i & 31; const float freq = powf(10000.f, -(float)fi / 32.f); const float ang = (float)pos * freq; float sn, cs; sincosf(ang, &sn, &cs); rope[i] = (f32x2){cs, sn}; }
        __syncthreads();
        { const int NW = (64 + 2 * (G - 64)) * NWAVES;
          if (bx < 64) norm0_phase(args, lane, bx * NWAVES + wave, NW);
          else { const int sl = 64 * NWAVES + ((bx - 64) * NWAVES + wave) * 2; norm0_phase(args, lane, sl, NW); norm0_phase(args, lane, sl + 1, NW); } }
    }
    GSYNC();
    TSTAMP(0);

#define PHASE_VARS int tid = threadIdx.x; asm volatile("" : "+v"(tid)); int bxl_ = blockIdx.x; asm volatile("" : "+s"(bxl_)); const int bx = bxl_; const int lane = tid & 63, wave = __builtin_amdgcn_readfirstlane(tid >> 6), gw = bx * NWAVES + wave; __attribute__((address_space(1))) unsigned char* wsg_ = (__attribute__((address_space(1))) unsigned char*)args.ws; asm volatile("" : "+s"(wsg_)); unsigned char* ws = (unsigned char*)wsg_; LAS unsigned char* ldsl = (LAS unsigned char*)lds; LAS float* ldsf = (LAS float*)lds; (void)lane; (void)wave; (void)gw; (void)ldsl; (void)ldsf
    for (int l = 0; l < DEPTH; ++l) {
        for (int rep_ = 0; rep_ < REP_P1; ++rep_) {
            PHASE_VARS;
            pg8::Gemm g{(const bf16*)(ws + WS_XN), (const bf16*)(ws + WS_WIN) + (size_t)l * NF * DM, M, NF, DM, DM, DM, 0, 0};
            pg8::StaticOrder S; S.init(M, NF, G, bx);
            EpiInProj E{ws, (const float*)(ws + WS_SS) + (size_t)(l & 1) * M, args.in[3] + (size_t)l * 8};
#ifdef PROBE_SPLIT
            { RangeOrder R0{S, 0, 2}, R1{S, 2, 4}; pg8::gemm_phase<EpiInProj, RangeOrder, true, true>(ldsl, g, R0, E); GSYNC(); pg8::gemm_phase<EpiInProj, RangeOrder, true, true>(ldsl, g, R1, E); }
#else
            pg8::gemm_phase<EpiInProj, pg8::StaticOrder, true, true>(ldsl, g, S, E);
#endif
            if (bx >= G / 2) flog_phase(args, l, (const float*)(ws + WS_SS) + (size_t)(l & 1) * M, ldsf, tid, lane, wave, bx - G / 2, G / 2);
        }
        GSYNC();
        TSTAMP(1);
        for (int rep_ = 0; rep_ < REP_P23; ++rep_) {
            if (rep_) __syncthreads();
            PHASE_VARS;
            if (bx < 64) {
                const int b = bx >> 4, g = bx & 15, tmL = wave & 1, tn = (wave >> 1) & 1, kh = wave >> 2;
                { const int fr = lane & 15, fq = lane >> 4;
                  const bf16* Ap = (const bf16*)(ws + WS_SUA) + ((size_t)g * NCH5 + b * 128 + tmL * 64) * KA5 + 256 * kh; const bf16* Bp = (const bf16*)(ws + WS_WB) + ((size_t)(l * 16 + g) * 128 + tn * 64) * 512 + 256 * kh;
                  struct WEpiLds { LAS float* EL; __device__ __forceinline__ void operator()(const pg8::f32x4 (&acc)[4][4], int fr_, int fq_) const {
#pragma unroll
                      for (int jb = 0; jb < 4; ++jb)
#pragma unroll
                          for (int ib = 0; ib < 4; ++ib) *(LAS pg8::f32x4*)(EL + (16 * ib + fr_) * 128 + 16 * jb + 4 * fq_) = acc[jb][ib]; } };
                  WEpiLds E{ldsf + (size_t)(kh * 128 + tmL * 64) * 128 + tn * 64}; (void)fr; (void)fq;
                  wave_gemm64<8, 4, WEpiLds>(Ap, KA5, Bp, 512, lane, E); }
                __syncthreads();
                const int p = tid & 63, seg = tid >> 6;
                const float* LAM = (const float*)(ws + WS_LAM) + (size_t)(l * 16 + g) * 128; const float lr = LAM[p], li = LAM[64 + p];
                bf16* SA = (bf16*)(ws + WS_SUA) + ((size_t)g * NCH5 + b * 128 + seg * 16) * KA5 + 512 + p;
                float er[16], ei[16];
#pragma unroll
                for (int i = 0; i < 16; ++i) { const int r = (seg * 16 + i) * 128; er[i] = ldsf[r + p] + ldsf[16384 + r + p]; ei[i] = ldsf[r + 64 + p] + ldsf[16384 + r + 64 + p]; }
                float sr = 0.f, si = 0.f;
#pragma unroll
                for (int i = 0; i < 16; ++i) { const float nr = lr * sr - li * si + er[i], ni = lr * si + li * sr + ei[i]; sr = nr; si = ni; }
                LAS float* ends = ldsf + (RING_BYTES + 1024) / 4;
                ends[(seg * 64 + p) * 2] = sr; ends[(seg * 64 + p) * 2 + 1] = si;
                float pr = lr, pi = li;
#pragma unroll
                for (int i = 0; i < 4; ++i) { const float nr = pr * pr - pi * pi, ni = 2.f * pr * pi; pr = nr; pi = ni; }
                __syncthreads();
                float cr = 0.f, ci = 0.f;
                for (int s2 = 0; s2 < seg; ++s2) { const float xr = ends[(s2 * 64 + p) * 2], xi = ends[(s2 * 64 + p) * 2 + 1]; const float nr = pr * cr - pi * ci + xr, ni = pr * ci + pi * cr + xi; cr = nr; ci = ni; }
#pragma unroll
                for (int i = 0; i < 16; ++i) { SA[(size_t)i * KA5] = f2bf(cr); SA[(size_t)i * KA5 + 64] = f2bf(ci); const float nr = lr * cr - li * ci + er[i], ni = lr * ci + li * cr + ei[i]; cr = nr; ci = ni; }
            } else if (bx < 192) {
                const int idx = bx - 64, bh = idx >> 3, dvs = (idx >> 1) & 3, dkh = idx & 1, fr = lane & 15, fq = lane >> 4; const float g64 = exp2f(lg2_gamma(bh & 3) * 64.f);
                const bf16* KT = (const bf16*)(ws + WS_RKT) + ((size_t)bh * 64 + 32 * dkh + fr) * SEQ + 8 * fq; const bf16* VT = (const bf16*)(ws + WS_RVT) + ((size_t)bh * 64 + 16 * dvs + fr) * SEQ + 8 * fq;
                pg8::f32x4 u[8][2];
#pragma unroll
                for (int i2 = 0; i2 < 2; ++i2) {
                    bf16x8 vf[4][2], kf[4][2][2];
#pragma unroll
                    for (int i1 = 0; i1 < 4; ++i1) { const int c = 8 * wave + 4 * i2 + i1; vf[i1][0] = *(const bf16x8*)(VT + c * 64); vf[i1][1] = *(const bf16x8*)(VT + c * 64 + 32);
#pragma unroll
                        for (int ib = 0; ib < 2; ++ib) { kf[i1][ib][0] = *(const bf16x8*)(KT + (size_t)(16 * ib) * SEQ + c * 64); kf[i1][ib][1] = *(const bf16x8*)(KT + (size_t)(16 * ib) * SEQ + c * 64 + 32); } }
#pragma unroll
                    for (int i1 = 0; i1 < 4; ++i1)
#pragma unroll
                        for (int ib = 0; ib < 2; ++ib) { pg8::f32x4 d = (pg8::f32x4){0.f, 0.f, 0.f, 0.f}; d = __builtin_amdgcn_mfma_f32_16x16x32_bf16(kf[i1][ib][0], vf[i1][0], d, 0, 0, 0); d = __builtin_amdgcn_mfma_f32_16x16x32_bf16(kf[i1][ib][1], vf[i1][1], d, 0, 0, 0); u[4 * i2 + i1][ib] = d; }
                }
                pg8::f32x4 e4[2];
#pragma unroll
                for (int ib = 0; ib < 2; ++ib) e4[ib] = (pg8::f32x4){0.f, 0.f, 0.f, 0.f};
#pragma unroll
                for (int i = 0; i < 8; ++i)
#pragma unroll
                    for (int ib = 0; ib < 2; ++ib) e4[ib] = e4[ib] * g64 + u[i][ib];
                LAS pg8::f32x4* ends = (LAS pg8::f32x4*)ldsf;
#pragma unroll
                for (int ib = 0; ib < 2; ++ib) ends[(wave * 2 + ib) * 64 + lane] = e4[ib];
                float g8 = g64; g8 = g8 * g8; g8 = g8 * g8; g8 = g8 * g8;
                __syncthreads();
                pg8::f32x4 st[2];
#pragma unroll
                for (int ib = 0; ib < 2; ++ib) st[ib] = (pg8::f32x4){0.f, 0.f, 0.f, 0.f};
                for (int w2 = 0; w2 < wave; ++w2)
#pragma unroll
                    for (int ib = 0; ib < 2; ++ib) st[ib] = st[ib] * g8 + ends[(w2 * 2 + ib) * 64 + lane];
                bf16* ST = (bf16*)(ws + WS_STATE) + (size_t)(bh * 64 + 8 * wave) * 4096 + (size_t)(16 * dvs + fr) * 64 + 32 * dkh + 4 * fq;
#pragma unroll
                for (int i = 0; i < 8; ++i)
#pragma unroll
                    for (int ib = 0; ib < 2; ++ib) { u32x2 w; w.x = pk2(st[ib][0], st[ib][1]); w.y = pk2(st[ib][2], st[ib][3]); *(u32x2*)(ST + (size_t)i * 4096 + 16 * ib) = w; st[ib] = st[ib] * g64 + u[i][ib]; }
            } else if (bx < 224) {
                const int bh = bx - 192; const float* lf = (const float*)(ws + WS_LOGF) + (size_t)bh * SEQ; float* cb = (float*)(ws + WS_CB) + (size_t)bh * SEQ;
                const f32x4 a0 = *(const f32x4*)(lf + tid * 8), a1 = *(const f32x4*)(lf + tid * 8 + 4); float v[8] = {a0.x, a0.y, a0.z, a0.w, a1.x, a1.y, a1.z, a1.w};
#pragma unroll
                for (int e = 1; e < 8; ++e) v[e] += v[e - 1];
                float tot = v[7];
#pragma unroll
                for (int o = 1; o < 64; o <<= 1) { const float t = __shfl_up(tot, o); if (lane >= o) tot += t; }
                if (lane == 63) ldsf[wave] = tot;
                __syncthreads();
                float off = tot - v[7];
                for (int w = 0; w < wave; ++w) off += ldsf[w];
                f32x4 o0, o1; o0.x = -(v[0] + off) * LOG2E; o0.y = -(v[1] + off) * LOG2E; o0.z = -(v[2] + off) * LOG2E; o0.w = -(v[3] + off) * LOG2E; o1.x = -(v[4] + off) * LOG2E; o1.y = -(v[5] + off) * LOG2E; o1.z = -(v[6] + off) * LOG2E; o1.w = -(v[7] + off) * LOG2E;
                *(f32x4*)(cb + tid * 8) = o0; *(f32x4*)(cb + tid * 8 + 4) = o1;
            } else { const int idx = (bx - 224) * NTHR + tid; if (idx < M) ((float*)(ws + WS_SS))[(size_t)((l + 1) & 1) * M + idx] = 0.f;
                const int bh = bx - 224, b = bh >> 3, h = bh & 7, rsub = lane >> 3, part = lane & 7;
                const bf16* Qp = (const bf16*)(ws + WS_QO) + ((size_t)b * SEQ + wave * 512 + rsub) * 512 + h * 64 + part * 8; const bf16* Kp = (const bf16*)(ws + WS_KB) + ((size_t)b * SEQ + wave * 512 + rsub) * 512 + h * 64 + part * 8;
                float qm = 0.f, km = 0.f;
#pragma unroll 8
                for (int it = 0; it < 64; ++it) { const u32x4 qv = *(const u32x4*)(Qp + (size_t)it * 8 * 512), kv = *(const u32x4*)(Kp + (size_t)it * 8 * 512); float sq = 0.f, sk = 0.f;
#pragma unroll
                    for (int e = 0; e < 4; ++e) { const float a0 = bflo(qv[e]), a1 = bfhi(qv[e]), c0 = bflo(kv[e]), c1 = bfhi(kv[e]); sq += a0 * a0 + a1 * a1; sk += c0 * c0 + c1 * c1; }
                    sq += __shfl_xor(sq, 1); sq += __shfl_xor(sq, 2); sq += __shfl_xor(sq, 4); sk += __shfl_xor(sk, 1); sk += __shfl_xor(sk, 2); sk += __shfl_xor(sk, 4);
                    qm = fmaxf(qm, sq); km = fmaxf(km, sk); }
#pragma unroll
                for (int o = 8; o < 64; o <<= 1) { qm = fmaxf(qm, __shfl_xor(qm, o)); km = fmaxf(km, __shfl_xor(km, o)); }
                if (lane == 0) { ldsf[wave * 2] = qm; ldsf[wave * 2 + 1] = km; }
                __syncthreads();
                if (tid == 0) { float a = 0.f, c = 0.f; for (int w = 0; w < NWAVES; ++w) { a = fmaxf(a, ldsf[2 * w]); c = fmaxf(c, ldsf[2 * w + 1]); } ((float*)(ws + WS_NRM))[bh] = sqrtf(a) * sqrtf(c) * 1.0001f; }
            }
        }
        GSYNC();
        TSTAMP(3);
        {
            PHASE_VARS;
            if (wave < 4) ret_out_unit(args, l, wave * 256 + bx, lane);
            else {
                const int t = (wave - 4) * 256 + bx, g = t >> 6, r = t & 63, tm = r >> 3, tn = r & 7;
                const bf16* SUAg = (const bf16*)(ws + WS_SUA) + (size_t)g * NCH5 * KA5;
                WEpiS5Y E{SUAg, (bf16*)(ws + WS_YS5), args.in[10] + (size_t)l * 256 + g * 16, tm * 64, tn * 64, g};
                wave_gemm64<20, 4, WEpiS5Y>(SUAg + (size_t)(tm * 64) * KA5, KA5, (const bf16*)(ws + WS_MF) + ((size_t)(l * 16 + g) * 512 + tn * 64) * KA5, KA5, lane, E);
            }
            __syncthreads();
            const attn_body::AttnTensors AT{(const attn_body::bf16*)(ws + WS_QO), (const attn_body::bf16*)(ws + WS_KB), (const attn_body::bf16*)(ws + WS_VB), (attn_body::bf16*)(ws + WS_GATE), (const float*)(ws + WS_CB), (const float*)(ws + WS_NRM)};
            const attn_body::StaticOrder S(G, bx);
#ifdef REP_ATTN
            attn_body::attn_phase<attn_body::StaticOrder>((char*)lds, AT, S, opaque_true());
#endif
            attn_body::attn_phase<attn_body::StaticOrder>((char*)lds, AT, S);
        }
        GSYNC();
        TSTAMP(4);
        {
            PHASE_VARS;
            if (wave < 4) {
                const int t = wave * 256 + bx, tm = t >> 2, tn = t & 3;
                WEpiGlu E{(const bf16*)(ws + WS_YS5), (bf16*)(ws + WS_GATE), tm * 64, tn * 64};
                wave_gemm64<8, 4, WEpiGlu>((const bf16*)(ws + WS_YS5) + (size_t)(tm * 64) * 256, 256, (const bf16*)(ws + WS_WGLU) + (size_t)l * 65536 + (size_t)(tn * 64) * 256, 256, lane, E);
            }
        }
        GSYNC();
        TSTAMP(5);
        {
            PHASE_VARS;
            pg8::Gemm g{(const bf16*)(ws + WS_GATE), (const bf16*)(ws + WS_WO) + (size_t)l * DM * DM, M, DM, DM, DM, DM, 0, 0};
            pg8::StaticOrder S; S.init(M, DM, G, bx);
#ifdef REP_P6
            { EpiOut E0{l == 0 ? args.in[0] : X, X, (float*)(ws + WS_SS) + (size_t)((l + 1) & 1) * M, (bf16*)(ws + WS_XN), (l + 1 < DEPTH) ? args.in[1] + (size_t)(l + 1) * DM : nullptr, opaque_true()}; pg8::gemm_phase<EpiOut, pg8::StaticOrder, true, true>(ldsl, g, S, E0); }
#endif
            EpiOut E{l == 0 ? args.in[0] : X, X, (float*)(ws + WS_SS) + (size_t)((l + 1) & 1) * M, (bf16*)(ws + WS_XN), (l + 1 < DEPTH) ? args.in[1] + (size_t)(l + 1) * DM : nullptr, false};
            pg8::gemm_phase<EpiOut, pg8::StaticOrder, true, true>(ldsl, g, S, E);
        }
        GSYNC();
        TSTAMP(6);
        if (l + 1 == DEPTH) { PHASE_VARS; final_norm(args, X, (const float*)(ws + WS_SS) + (size_t)((l + 1) & 1) * M, lane, gw, NGW);
#ifdef PROBE_T
            TSTAMP(7); __syncthreads(); if (blockIdx.x == 0 && threadIdx.x == 0) { asm volatile("s_waitcnt vmcnt(0)" ::: "memory"); X[0] += (float)tacc_ * 0.01f; }
#endif
        }
    }
}

extern "C" void kernel_launch(void* const* d_in, const int* in_sizes, int n_in, void* d_out, int out_size, void* d_ws, size_t ws_size, hipStream_t stream) {
    static int grid = 0;
    if (grid == 0) {
        if (n_in != 16 || ws_size < WS_END) { fprintf(stderr, "kernel_launch: unexpected n_in %d / ws %zu\n", n_in, ws_size); grid = -1; return; }
        int dev = 0, cus = 0, per_cu = 0;
        hipGetDevice(&dev); hipDeviceGetAttribute(&cus, hipDeviceAttributeMultiprocessorCount, dev);
        if (hipFuncSetAttribute((const void*)mega_fwd, hipFuncAttributeMaxDynamicSharedMemorySize, LDS_BYTES) != hipSuccess) { fprintf(stderr, "kernel_launch: hipFuncSetAttribute failed\n"); grid = -1; return; }
        if (hipOccupancyMaxActiveBlocksPerMultiprocessor(&per_cu, (const void*)mega_fwd, NTHR, LDS_BYTES) != hipSuccess || per_cu < 1) { fprintf(stderr, "kernel_launch: occupancy query failed (%d)\n", per_cu); grid = -1; return; }
        grid = cus;
        if (grid != 256) fprintf(stderr, "kernel_launch: note: %d CUs\n", grid);
    }
    if (grid < 0) return;
    if (hipMemsetAsync(d_ws, 0, 16384, stream) != hipSuccess) { fprintf(stderr, "kernel_launch: hipMemsetAsync failed\n"); return; }
    Args a{};
    for (int i = 0; i < 16; ++i) a.in[i] = (const float*)d_in[i];
    a.out = (float*)d_out; a.ws = (unsigned char*)d_ws;
    void* kargs[] = {&a};
    hipError_t e = hipLaunchCooperativeKernel((const void*)mega_fwd, dim3(grid), dim3(NTHR), kargs, LDS_BYTES, stream);
    if (e != hipSuccess) fprintf(stderr, "kernel_launch: cooperative launch failed: %s\n", hipGetErrorString(e));
}
```

```cpp
#include <hip/hip_runtime.h>
#include <cstdio>
#include <cstdint>
namespace pg8 {
#define PG8_LAS __attribute__((address_space(3)))
typedef unsigned short bf16_t;
typedef short bf16x8 __attribute__((ext_vector_type(8)));
typedef float f32x4 __attribute__((ext_vector_type(4)));
typedef unsigned u32x4 __attribute__((ext_vector_type(4)));
constexpr int BM = 256, BK = 64, HALF = 128, HTB = HALF * BK * 2  , STAGE_BYTES = 8 * HTB, NXCD = 8, WGM = 4;

__host__ __device__ __forceinline__ int lds_byte(int r, int c) { const int st = (r >> 4) * 2 + (c >> 5), rr = r & 15, cc = c & 31, ob = rr * 64 + cc * 2; return st * 1024 + (ob ^ (((ob >> 9) & 1) << 5)); }
__host__ __device__ __forceinline__ void stage_rc(int b, int& R, int& C) { const int st = b / 1024, sb = b % 1024, swz = sb ^ (((sb >> 9) & 1) << 5); R = (st >> 1) * 16 + swz / 64; C = (st & 1) * 32 + (swz % 64) / 2; }
__host__ __device__ __forceinline__ int perm32(int rho) { const int n = rho >> 4, i = rho & 15; return 8 * (i >> 2) + 4 * n + (i & 3); }

struct Unit { int pm, pn, gz; };
struct Gemm { const bf16_t* A; const bf16_t* Bt; int M, N, K; int lda, ldb; size_t gsA, gsB; };

struct StaticOrder {
    int nM, nN, nwg, G, c;
    __host__ __device__ void init(int M, int N, int G_, int c_) { nM = M / BM; nN = N / BM; nwg = nM * nN; G = G_; c = c_; }
    __host__ __device__ bool next(int i, Unit& u) const {
        const long L = (long)i * G + c; if (L >= nwg) return false;
        int wgid = (int)L; { const int q = nwg / NXCD, r = nwg % NXCD, xcd = wgid % NXCD, off = wgid / NXCD; wgid = (xcd < r ? xcd * (q + 1) : r * (q + 1) + (xcd - r) * q) + off; }
        const int nig = WGM * nN, gid = wgid / nig, fm = gid * WGM, gsz = (nM - fm) < WGM ? (nM - fm) : WGM;
        u.pm = fm + ((wgid % nig) % gsz); u.pn = (wgid % nig) / gsz; u.gz = 0; return true;
    }
    __device__ __forceinline__ void a_ready(const Unit&) const {}
    __device__ __forceinline__ void done(const Unit&) const {}
};

__device__ __forceinline__ unsigned cvt_pk_bf16(float lo, float hi) { unsigned r; asm volatile("v_cvt_pk_bf16_f32 %0, %1, %2" : "=v"(r) : "v"(lo), "v"(hi)); return r; }
typedef float f32x2 __attribute__((ext_vector_type(2)));
__device__ __forceinline__ f32x2 gelu_pk(f32x2 v) {
    const f32x2 av = __builtin_elementwise_abs(v), d = av * 0.2316418882f + 1.0f;
    f32x2 t; t.x = __builtin_amdgcn_rcpf(d.x); t.y = __builtin_amdgcn_rcpf(d.y);
    f32x2 q = t * 0.5307027145f + (-0.7265760135f); q = q * t + 0.7107068705f; q = q * t + (-0.142248368f); q = q * t + 0.127414796f; q = q * t;
    const f32x2 s = (v * v) * (-0.72134752044f);
    f32x2 e; e.x = __builtin_amdgcn_exp2f(s.x); e.y = __builtin_amdgcn_exp2f(s.y);
    const f32x2 m = v * (q * e), r = v - m;
    f32x2 o; o.x = v.x < 0.f ? m.x : r.x; o.y = v.y < 0.f ? m.y : r.y; return o;
}

template <class Epi, class Sched, bool ALIGN_EPI = false, bool SP2 = false>
__device__ __forceinline__ void gemm_phase(PG8_LAS unsigned char* lds, const Gemm g, const Sched& S, const Epi& E) {
    int tid_ = threadIdx.x; asm volatile("" : "+v"(tid_));
    const int tid = tid_, wid = __builtin_amdgcn_readfirstlane(tid >> 6), lane = tid & 63, wr = wid >> 2, wc = wid & 3, fr = lane & 15, fq = lane >> 4;
    const int K = g.K, nt = K / BK;
    unsigned voffA[2], voffB[2];
#pragma unroll
    for (int i = 0; i < 2; ++i) { int R, C; stage_rc(tid * 16 + i * 8192, R, C); const int Rb = Epi::PERM ? ((R & ~31) + perm32(R & 31)) : R;
        voffA[i] = (unsigned)(R * g.lda + C) * 2u; voffB[i] = (unsigned)(Rb * g.ldb + C) * 2u; }
    const size_t kstep = (size_t)(BK * 2);
    const size_t hstepA = (size_t)HALF * g.lda * 2, hstepB = (size_t)HALF * g.ldb * 2;
    const size_t tstepA = 2 * hstepA, tstepB = 2 * hstepB;
    const unsigned ldsw = (unsigned)wid * 1024u;
    const int aoff = lds_byte(wr * 64 + fr, fq * 8), boff = lds_byte(wc * 32 + fr, fq * 8);
#define PG8_SA(b, h) (((b) * 2 + (h)) * HTB)
#define PG8_SB(b, h) ((4 + (b) * 2 + (h)) * HTB)
#define PG8_STAGE(bufoff, gbase, voff) do { _Pragma("unroll") for (int _i = 0; _i < 2; ++_i) \
        __builtin_amdgcn_global_load_lds((const unsigned*)((const char*)(gbase) + (voff)[_i]), (PG8_LAS unsigned*)(lds + (bufoff) + ldsw + _i * 8192), 16, 0, 0); } while (0)
#define PG8_LDA(dst, b, h) do { _Pragma("unroll") for (int m = 0; m < 4; ++m) _Pragma("unroll") for (int k = 0; k < 2; ++k) dst[m][k] = *(const PG8_LAS bf16x8*)(lds + PG8_SA(b, h) + aoff + m * 2048 + k * 1024); } while (0)
#define PG8_LDB(dst, b, h) do { _Pragma("unroll") for (int n = 0; n < 2; ++n) _Pragma("unroll") for (int k = 0; k < 2; ++k) dst[n][k] = *(const PG8_LAS bf16x8*)(lds + PG8_SB(b, h) + boff + n * 2048 + k * 1024); } while (0)
#define PG8_MMA(ai, bj, At, Bt) do { __builtin_amdgcn_s_setprio(1); _Pragma("unroll") for (int m = 0; m < 4; ++m) _Pragma("unroll") for (int n = 0; n < 2; ++n) _Pragma("unroll") for (int k = 0; k < 2; ++k) \
        acc[ai][bj][m][n] = __builtin_amdgcn_mfma_f32_16x16x32_bf16(Bt[n][k], At[m][k], acc[ai][bj][m][n], 0, 0, 0); __builtin_amdgcn_s_setprio(0); } while (0)
#define PG8_WAIT_V(n) asm volatile("s_waitcnt vmcnt(" #n ")" ::: "memory")
#define PG8_WAIT_L(n) asm volatile("s_waitcnt lgkmcnt(" #n ")" ::: "memory")
#define PG8_BAR __builtin_amdgcn_s_barrier()
#define PG8_SCHED __builtin_amdgcn_sched_barrier(0)
    Unit cur, nxt; int ui = 0;
    if (!S.next(0, cur)) return;
    f32x4 acc[2][2][4][2];
#pragma unroll
    for (int a = 0; a < 2; ++a)
#pragma unroll
        for (int b = 0; b < 2; ++b)
#pragma unroll
            for (int m = 0; m < 4; ++m)
#pragma unroll
                for (int n = 0; n < 2; ++n) acc[a][b][m][n] = (f32x4){0.f, 0.f, 0.f, 0.f};
    bf16x8 At[4][2], B0[2][2], B1[2][2];
    const char* cA = (const char*)g.A + (size_t)cur.gz * g.gsA * 2 + (size_t)cur.pm * tstepA; const char* cB = (const char*)g.Bt + (size_t)cur.gz * g.gsB * 2 + (size_t)cur.pn * tstepB;
    S.a_ready(cur);
    if constexpr (SP2) {
        PG8_STAGE(PG8_SB(0, 0), cB, voffB); PG8_STAGE(PG8_SB(0, 1), cB + hstepB, voffB); PG8_STAGE(PG8_SA(0, 0), cA, voffA); PG8_STAGE(PG8_SA(0, 1), cA + hstepA, voffA);
        if (wr == 1) PG8_BAR;
        PG8_WAIT_V(2); PG8_BAR;
        PG8_STAGE(PG8_SB(1, 0), cB + kstep, voffB); PG8_STAGE(PG8_SA(1, 0), cA + kstep, voffA); PG8_STAGE(PG8_SB(1, 1), cB + hstepB + kstep, voffB);
        PG8_WAIT_V(6); PG8_BAR;
    } else {
        PG8_STAGE(PG8_SB(0, 0), cB, voffB); PG8_STAGE(PG8_SA(0, 0), cA, voffA); PG8_STAGE(PG8_SB(0, 1), cB + hstepB, voffB); PG8_STAGE(PG8_SA(0, 1), cA + hstepA, voffA);
        if (wr == 1) PG8_BAR;
        PG8_WAIT_V(4); PG8_BAR;
        PG8_STAGE(PG8_SB(1, 0), cB + kstep, voffB); PG8_STAGE(PG8_SA(1, 0), cA + kstep, voffA); PG8_STAGE(PG8_SB(1, 1), cB + hstepB + kstep, voffB);
        PG8_WAIT_V(6); PG8_BAR;
    }
    for (;;) {
        const bool has_next = S.next(ui + 1, nxt);
        const char* nA = has_next ? (const char*)g.A + (size_t)nxt.gz * g.gsA * 2 + (size_t)nxt.pm * tstepA : cA; const char* nB = has_next ? (const char*)g.Bt + (size_t)nxt.gz * g.gsB * 2 + (size_t)nxt.pn * tstepB : cB;
        for (int t = 0; t < nt; t += 2) {
            const bool last = (t == nt - 2);
            const char* a1 = cA + (size_t)(t + 1) * kstep;
            const char* a2 = last ? nA : cA + (size_t)(t + 2) * kstep; const char* b2 = last ? nB : cB + (size_t)(t + 2) * kstep;
            const char* a3 = a2 + kstep; const char* b3 = b2 + kstep;
            if (last && has_next) S.a_ready(nxt);
            if constexpr (SP2) {
            PG8_LDB(B0, 0, 0); PG8_LDB(B1, 0, 1); PG8_SCHED; PG8_LDA(At, 0, 0); PG8_STAGE(PG8_SA(1, 1), a1 + hstepA, voffA);
            PG8_WAIT_V(8); PG8_WAIT_L(0); PG8_BAR; PG8_MMA(0, 0, At, B0); PG8_MMA(0, 1, At, B1); PG8_BAR; PG8_SCHED;
            PG8_LDA(At, 0, 1); PG8_STAGE(PG8_SB(0, 0), b2, voffB); PG8_STAGE(PG8_SB(0, 1), b2 + hstepB, voffB); PG8_STAGE(PG8_SA(0, 0), a2, voffA);
            PG8_WAIT_V(8); PG8_WAIT_L(0); PG8_BAR; PG8_MMA(1, 0, At, B0); PG8_MMA(1, 1, At, B1); PG8_BAR; PG8_SCHED;
            PG8_LDB(B0, 1, 0); PG8_LDB(B1, 1, 1); PG8_SCHED; PG8_LDA(At, 1, 0); PG8_STAGE(PG8_SA(0, 1), a2 + hstepA, voffA);
            PG8_WAIT_V(8); PG8_WAIT_L(0); PG8_BAR; PG8_MMA(0, 0, At, B0); PG8_MMA(0, 1, At, B1); PG8_BAR; PG8_SCHED;
            PG8_LDA(At, 1, 1); PG8_STAGE(PG8_SB(1, 0), b3, voffB); PG8_STAGE(PG8_SB(1, 1), b3 + hstepB, voffB); PG8_STAGE(PG8_SA(1, 0), a3, voffA);
            PG8_WAIT_V(8); PG8_WAIT_L(0); PG8_BAR; PG8_MMA(1, 0, At, B0); PG8_MMA(1, 1, At, B1); PG8_BAR; PG8_SCHED;
            } else {
            PG8_LDB(B0, 0, 0); PG8_SCHED; PG8_LDA(At, 0, 0); PG8_STAGE(PG8_SA(1, 1), a1 + hstepA, voffA);
            PG8_WAIT_L(8); PG8_BAR; PG8_WAIT_L(0); PG8_MMA(0, 0, At, B0); PG8_BAR; PG8_SCHED;
            PG8_LDB(B1, 0, 1); PG8_STAGE(PG8_SB(0, 0), b2, voffB);
            PG8_BAR; PG8_WAIT_L(0); PG8_MMA(0, 1, At, B1); PG8_BAR;
            PG8_LDA(At, 0, 1); PG8_STAGE(PG8_SA(0, 0), a2, voffA);
            PG8_BAR; PG8_WAIT_L(0); PG8_MMA(1, 0, At, B0); PG8_BAR; PG8_SCHED;
            PG8_STAGE(PG8_SB(0, 1), b2 + hstepB, voffB);
            PG8_WAIT_V(6); PG8_BAR; PG8_MMA(1, 1, At, B1); PG8_BAR;
            PG8_LDB(B0, 1, 0); PG8_SCHED; PG8_LDA(At, 1, 0); PG8_STAGE(PG8_SA(0, 1), a2 + hstepA, voffA);
            PG8_WAIT_L(8); PG8_BAR; PG8_WAIT_L(0); PG8_MMA(0, 0, At, B0); PG8_BAR; PG8_SCHED;
            PG8_LDB(B1, 1, 1); PG8_STAGE(PG8_SB(1, 0), b3, voffB);
            PG8_BAR; PG8_WAIT_L(0); PG8_MMA(0, 1, At, B1); PG8_BAR;
            PG8_LDA(At, 1, 1); PG8_STAGE(PG8_SA(1, 0), a3, voffA);
            PG8_BAR; PG8_WAIT_L(0); PG8_MMA(1, 0, At, B0); PG8_BAR; PG8_SCHED;
            PG8_STAGE(PG8_SB(1, 1), b3 + hstepB, voffB);
            PG8_WAIT_V(6); PG8_BAR; PG8_MMA(1, 1, At, B1); PG8_BAR;
            }
        }
        if constexpr (ALIGN_EPI) { if (wr == 0) PG8_BAR; }
        if constexpr (!Epi::AFTER_DRAIN) { E(acc, cur, wr, wc, fr, fq); S.done(cur); }
        if (!has_next) break;
#pragma unroll
        for (int a = 0; a < 2; ++a)
#pragma unroll
            for (int b = 0; b < 2; ++b)
#pragma unroll
                for (int m = 0; m < 4; ++m)
#pragma unroll
                    for (int n = 0; n < 2; ++n) acc[a][b][m][n] = (f32x4){0.f, 0.f, 0.f, 0.f};
        cur = nxt; cA = nA; cB = nB; ++ui;
        if constexpr (ALIGN_EPI) { if (wr == 1) PG8_BAR; }
    }
    PG8_WAIT_V(0);
    if constexpr (!ALIGN_EPI) { if (wr == 0) PG8_BAR; }
    PG8_BAR;
    if constexpr (Epi::AFTER_DRAIN) { E.fused(acc, cur, wr, wc, fr, fq, lds, wid, lane); S.done(cur); }
#undef PG8_SA
#undef PG8_SB
#undef PG8_STAGE
#undef PG8_LDA
#undef PG8_LDB
#undef PG8_MMA
#undef PG8_WAIT_V
#undef PG8_WAIT_L
#undef PG8_BAR
#undef PG8_SCHED
}
}
#include <hip/hip_bf16.h>
#include <cmath>
namespace attn_body {
using bf16=__hip_bfloat16;
using bf16x8=__attribute__((ext_vector_type(8)))short;
using s16x4=__attribute__((ext_vector_type(4)))short;
using f32x16=__attribute__((ext_vector_type(16)))float;
using u32x4=__attribute__((ext_vector_type(4)))unsigned;
using f32x4=__attribute__((ext_vector_type(4)))float;
constexpr int BATCH=4,NHEAD=8,SEQ=4096,D=64,DM=NHEAD*D,OPITCH=1024;
constexpr int NW=8,QBLK=32,QB=QBLK*NW,KVBLK=64,NQB=SEQ/QB;
constexpr int ATTN_PITCH=DM, ATTN_UNIT_ROWS=QB;
__device__ __forceinline__ int crow(int r,int hi){return (r&3)+8*(r>>2)+4*hi;}
#define SBAR() __builtin_amdgcn_sched_barrier(0)
__device__ __forceinline__ void cmask(f32x16&p0,f32x16&p1,int jb,int qrel,int hi){
  const float NEG=-INFINITY; int kb=64*jb+4*hi;
  #pragma unroll
  for(int r=0;r<16;++r){int kv=kb+(r&3)+8*(r>>2); if(kv>qrel)p0[r]=NEG; if(kv+32>qrel)p1[r]=NEG;}
}

constexpr int NSLOT=3, SLOTB=8192;
constexpr int LDS_K=0, LDS_V=NSLOT*SLOTB, LDS_WS=2*NSLOT*SLOTB, LDS_OST=LDS_WS+NW*64*4, LDS_CB=LDS_OST+NW*4096, LDS_BYTES=LDS_CB+SEQ*4;
constexpr float C2=0.125f*1.4426950408889634f;
__device__ __forceinline__ void glds16(const void*gsrc,unsigned lds_dst){unsigned keep;
  asm volatile("s_mov_b32 %0, m0\n\ts_mov_b32 m0, %2\n\ts_nop 0\n\tglobal_load_lds_dwordx4 %1, off\n\ts_mov_b32 m0, %0":"=&s"(keep):"v"(gsrc),"s"(lds_dst):"memory");}
__device__ __forceinline__ float max3f(float a,float b,float c){float r;asm("v_max3_f32 %0, %1, %2, %3":"=v"(r):"v"(a),"v"(b),"v"(c));return r;}
__device__ __forceinline__ float max2f(float a,float b){float r;asm("v_max_f32_e32 %0, %1, %2":"=v"(r):"v"(a),"v"(b));return r;}
__device__ __forceinline__ float fadd_s(float a,float b){float r;asm("v_add_f32_e32 %0, %1, %2":"=v"(r):"v"(a),"v"(b));return r;}
__device__ __forceinline__ float fsub_s(float a,float b){float r;asm("v_sub_f32_e32 %0, %1, %2":"=v"(r):"v"(a),"v"(b));return r;}
typedef float f32x2_t __attribute__((ext_vector_type(2))); typedef __bf16 bf16x2_t __attribute__((ext_vector_type(2)));
__device__ __forceinline__ unsigned cvtpk_s(float lo,float hi){f32x2_t v={lo,hi};bf16x2_t b=__builtin_convertvector(v,bf16x2_t);return __builtin_bit_cast(unsigned,b);}
#define WAIT_BAR(N) asm volatile("s_waitcnt vmcnt(" #N ") lgkmcnt(0)\n\ts_barrier":::"memory")

__device__ __forceinline__ void qkt(f32x16&p0,f32x16&p1,const char*Kslot,const bf16x8*qr,const char*cbt,int r32,int hi){
  const char*kb=Kslot+hi*1024+r32*16;
  #pragma unroll
  for(int a=0;a<4;++a){ const f32x4 u0=*reinterpret_cast<const f32x4*>(cbt+hi*16+a*32), u1=*reinterpret_cast<const f32x4*>(cbt+128+hi*16+a*32);
    p0[4*a]=u0[0];p0[4*a+1]=u0[1];p0[4*a+2]=u0[2];p0[4*a+3]=u0[3]; p1[4*a]=u1[0];p1[4*a+1]=u1[1];p1[4*a+2]=u1[2];p1[4*a+3]=u1[3]; }
  #pragma unroll
  for(int d0=0;d0<4;++d0){
    const bf16x8 b0=*reinterpret_cast<const bf16x8*>(kb+d0*2048);
    const bf16x8 b1=*reinterpret_cast<const bf16x8*>(kb+d0*2048+512);
    p0=__builtin_amdgcn_mfma_f32_32x32x16_bf16(b0,qr[d0],p0,0,0,0);p1=__builtin_amdgcn_mfma_f32_32x32x16_bf16(b1,qr[d0],p1,0,0,0);}
}
typedef __attribute__((address_space(3))) const char* lds_cptr;
typedef short v4i16_t __attribute__((ext_vector_type(4)));
__device__ __forceinline__ void kload8(bf16x8*kf,lds_cptr kp){
  kf[0]=*(const __attribute__((address_space(3))) bf16x8*)(kp);      kf[1]=*(const __attribute__((address_space(3))) bf16x8*)(kp+512);
  kf[2]=*(const __attribute__((address_space(3))) bf16x8*)(kp+2048); kf[3]=*(const __attribute__((address_space(3))) bf16x8*)(kp+2560);
  kf[4]=*(const __attribute__((address_space(3))) bf16x8*)(kp+4096); kf[5]=*(const __attribute__((address_space(3))) bf16x8*)(kp+4608);
  kf[6]=*(const __attribute__((address_space(3))) bf16x8*)(kp+6144); kf[7]=*(const __attribute__((address_space(3))) bf16x8*)(kp+6656);
}
__device__ __forceinline__ void kload2(bf16x8*kf,lds_cptr kp,int j){ kf[2*j]=*(const __attribute__((address_space(3))) bf16x8*)(kp+j*2048); kf[2*j+1]=*(const __attribute__((address_space(3))) bf16x8*)(kp+j*2048+512); }
__device__ __forceinline__ s16x4 vtr(lds_cptr p){ return __builtin_bit_cast(s16x4,__builtin_amdgcn_ds_read_tr16_b64_v4i16((__attribute__((address_space(3))) v4i16_t*)p)); }
__device__ __forceinline__ float rowmax(const f32x16&p0,const f32x16&p1){
  float a=max3f(p0[0],p0[1],p1[0]),b=max3f(p0[2],p0[3],p1[1]);a=max3f(a,p1[2],p1[3]);
  #pragma unroll
  for(int r=4;r<16;r+=4){a=max3f(a,p0[r],p0[r+1]);b=max3f(b,p0[r+2],p0[r+3]);a=max3f(a,p1[r],p1[r+1]);b=max3f(b,p1[r+2],p1[r+3]);}
  const float m=max2f(a,b);
  auto rr=__builtin_amdgcn_permlane32_swap(__float_as_uint(m),__float_as_uint(m),false,false);
  return max2f(__uint_as_float(rr[0]),__uint_as_float(rr[1]));
}
__device__ __forceinline__ void pv(f32x16*o,int vb,bf16x8 pa0,bf16x8 pa1,bf16x8 pa2,bf16x8 pa3){
  #pragma unroll
  for(int d0=0;d0<2;++d0){s16x4 lo[4],hi[4];
    #pragma unroll
    for(int ks=0;ks<4;++ks){
      asm volatile("ds_read_b64_tr_b16 %0,%1 offset:%c2":"=&v"(lo[ks]):"v"(vb),"i"(d0*4096+ks*1024):"memory");
      asm volatile("ds_read_b64_tr_b16 %0,%1 offset:%c2":"=&v"(hi[ks]):"v"(vb),"i"(d0*4096+ks*1024+512):"memory");}
    asm volatile("s_waitcnt lgkmcnt(0)":::"memory");SBAR();
    #define PK(k) (bf16x8){lo[k][0],lo[k][1],lo[k][2],lo[k][3],hi[k][0],hi[k][1],hi[k][2],hi[k][3]}
    o[d0]=__builtin_amdgcn_mfma_f32_32x32x16_bf16(pa0,PK(0),o[d0],0,0,0);
    o[d0]=__builtin_amdgcn_mfma_f32_32x32x16_bf16(pa1,PK(1),o[d0],0,0,0);
    o[d0]=__builtin_amdgcn_mfma_f32_32x32x16_bf16(pa2,PK(2),o[d0],0,0,0);
    o[d0]=__builtin_amdgcn_mfma_f32_32x32x16_bf16(pa3,PK(3),o[d0],0,0,0);
    #undef PK
  }
}

#ifndef ATTN_STORE16
#define ATTN_STORE16(p,v) (*(u32x4*)(p)=(v))
#endif
template<int THRL> __device__ __forceinline__ void attn_unit(int b,int h,int qb,const bf16*Q,const bf16*__restrict__ K,const bf16*__restrict__ V,bf16*O,const float*__restrict__ CB,const float*__restrict__ NRM,char*shm,bool dry=false){
  int tid_=threadIdx.x; asm volatile("":"+v"(tid_)); const int tid=tid_,lane=tid&63,r32=lane&31,hi=lane>>5; const int wid=__builtin_amdgcn_readfirstlane(tid>>6);
  const long rowbase=(long)b*SEQ; const int q0=qb*QB;
  int t0;
  { const f32x4* cbg=reinterpret_cast<const f32x4*>(CB+(long)(b*NHEAD+h)*SEQ); f32x4* cbl=reinterpret_cast<f32x4*>(shm+LDS_CB); const int nv=(q0+QB)/4;
    for(int i=tid;i<nv;i+=NW*64) cbl[i]=cbg[i];
    const float bnd=NRM[b*NHEAD+h]+40.f;
    asm volatile("s_waitcnt vmcnt(0) lgkmcnt(0)\n\ts_barrier":::"memory");
    const float*cbf=reinterpret_cast<const float*>(shm+LDS_CB); const int tc=2*lane; const int NT0=(q0+QB)/KVBLK;
    const bool ok=(tc<=NT0-4)&&(tc==0||cbf[64*tc-1]+bnd<=cbf[q0]);
    const unsigned long long mk=__ballot(ok); t0=2*(__popcll(mk)-1); t0=__builtin_amdgcn_readfirstlane(t0); }
  const bf16*Qw=Q+(rowbase+q0+wid*QBLK)*DM+h*D;
  const bf16*Kh=K+(rowbase+(long)t0*KVBLK)*DM+h*D,*Vh=V+(rowbase+(long)t0*KVBLK)*DM+h*D;
  const unsigned lds0=(unsigned)(uintptr_t)shm;
  float*wsf=(float*)(shm+LDS_WS)+wid*64;
  const bf16*ksrc=Kh+(long)lane*DM+wid*8;
  const bf16*vsrc=Vh+(long)(16*(wid&3)+(lane>>2))*DM+(wid>>2)*32+(lane&3)*8;
  const unsigned kdst=lds0+LDS_K+wid*1024, vdst=lds0+LDS_V+wid*1024;
  #define DMA_K(t,slot) glds16(ksrc+(long)(t)*KVBLK*DM,(unsigned)__builtin_amdgcn_readfirstlane(kdst+(slot)))
  #define DMA_V(t,slot) glds16(vsrc+(long)(t)*KVBLK*DM,(unsigned)__builtin_amdgcn_readfirstlane(vdst+(slot)))
  const int vb0=(int)(lds0+LDS_V)+((lane>>4)&1)*32+(lane&3)*8+(4*hi+((lane&15)>>2))*64;
  const char*Kbase=shm+LDS_K; bf16x8 kf[8];
  const lds_cptr shm3=(lds_cptr)shm; const lds_cptr kp0=shm3+LDS_K+hi*1024+r32*16; const lds_cptr vp0=shm3+LDS_V+((lane>>4)&1)*32+(lane&3)*8+(4*hi+((lane&15)>>2))*64;
  const int NT=(q0+QB)/KVBLK-t0;
  const lds_cptr cb3=(lds_cptr)shm+LDS_CB+t0*256;
  const float cb_own=*(const __attribute__((address_space(3))) float*)((lds_cptr)shm+LDS_CB+(q0+wid*QBLK+r32)*4);
  DMA_K(0,0);DMA_V(0,0);DMA_K(1,SLOTB);
  bf16x8 qr[4];
  #pragma unroll
  for(int d0=0;d0<4;++d0)qr[d0]=*reinterpret_cast<const bf16x8*>(&Qw[(long)r32*DM+d0*16+hi*8]);
  float mhat=0.f,l_reg=0.f;f32x16 o[2];o[0]=f32x16{};o[1]=f32x16{};
  const int qrel=wid*QBLK+r32;
  #define CMASK(P0,P1,t) do{int jb_=(t)-(NT-4); if(jb_>=0)cmask(P0,P1,jb_,qrel,hi);}while(0)
  bool resc=false;
  #define START(P0,P1) do{ const float rm=max2f(rowmax(P0,P1),cb_own); resc=false; \
    { const float dl=rm; mhat=fadd_s(mhat,dl); \
      _Pragma("unroll") for(int r=0;r<16;++r){P0[r]=fsub_s(P0[r],dl);P1[r]=fsub_s(P1[r],dl);} } \
    _Pragma("unroll") for(int r=0;r<16;++r)P0[r]=__builtin_amdgcn_exp2f(P0[r]); }while(0)
  #define RESC() do{ if(resc){ asm volatile("s_waitcnt lgkmcnt(0)":::"memory"); \
      _Pragma("unroll") for(int d_=0;d_<2;++d_) _Pragma("unroll") for(int r=0;r<16;++r)o[d_][r]*=wsf[crow(r,hi)]; } }while(0)
  f32x16 pA0,pA1,pB0,pB1;
  int sl_prev=0,sl_cur=0,sl_next=SLOTB;
  #define ROT() do{sl_prev=sl_cur;sl_cur=sl_next;sl_next=(sl_next==(NSLOT-1)*SLOTB)?0:sl_next+SLOTB;}while(0)
  DMA_K(2,2*SLOTB);
  WAIT_BAR(3);
  qkt(pA0,pA1,Kbase,qr,shm+LDS_CB+t0*256,r32,hi);asm volatile("s_nop 15\n\ts_nop 7":"+v"(pA0),"+v"(pA1));CMASK(pA0,pA1,0);
  START(pA0,pA1);
  _Pragma("unroll") for(int r=0;r<16;++r)pA1[r]=__builtin_amdgcn_exp2f(pA1[r]);
  WAIT_BAR(0);
  DMA_K(3,0);DMA_V(1,SLOTB);
  ROT();
  kload8(kf,kp0+sl_cur);
  WAIT_BAR(2);
  s16x4 vlo[8],vhi[8]; u32x4 pw0,pw1,pw2,pw3;
  #define PKW(P,B) cvtpk_s(P[B],P[B+1])
  #define PAF(k) __builtin_bit_cast(bf16x8,pw##k)
  #define VFR(i) (bf16x8){vlo[i][0],vlo[i][1],vlo[i][2],vlo[i][3],vhi[i][0],vhi[i][1],vhi[i][2],vhi[i][3]}
  #define PIN(x) asm volatile("":"+v"(x))
  #define MX3(a,b,c) __builtin_fmaxf(__builtin_fmaxf((a),(b)),(c))
  #define GAPA(MF,A0,A1,A2,A3,W0,W1,PW) do{ MF; sacc+=A0; sacc+=A1; sacc+=A2; sacc+=A3; PIN(sacc); W0; W1; PIN(PW); SBAR(); }while(0)
  #define EX(v) __builtin_amdgcn_exp2f(v)
  #define GAPB(MF,X,B) do{ MF; X[B]=EX(X[B]); X[B+1]=EX(X[B+1]); X[B+2]=EX(X[B+2]); X[B+3]=EX(X[B+3]); PIN(X); SBAR(); }while(0)
  #define VRD(i) do{ vlo[i]=vtr(vp_+(((i)>>2)*4096+((i)&3)*1024)); vhi[i]=vtr(vp_+(((i)>>2)*4096+((i)&3)*1024+512)); }while(0)
  #define KRD(G,j) do{ if(G){ kload2(kf,kp0+sl_next,j); SBAR(); } }while(0)
  #define STEP(C0,C1,P0,P1,t,GK,GV,GL) do{ SBAR(); \
    const lds_cptr vp_=vp0+sl_prev; \
    VRD(0); SBAR(); float sacc=(P0[0]+P0[1]); \
    GAPA(C0=__builtin_amdgcn_mfma_f32_32x32x16_bf16(kf[0],qr[0],C0,0,0,0), P0[2],P0[3],P0[4],P0[5],     pw0[0]=PKW(P0,0), pw0[1]=PKW(P0,2), pw0); \
    VRD(4); SBAR(); GAPA(C1=__builtin_amdgcn_mfma_f32_32x32x16_bf16(kf[1],qr[0],C1,0,0,0), P0[6],P0[7],P0[8],P0[9],     pw0[2]=PKW(P0,4), pw0[3]=PKW(P0,6), pw0); \
    VRD(1); SBAR(); GAPA(C0=__builtin_amdgcn_mfma_f32_32x32x16_bf16(kf[2],qr[1],C0,0,0,0),   P0[10],P0[11],P0[12],P0[13], pw1[0]=PKW(P0,8), pw1[1]=PKW(P0,10), pw1); \
    VRD(5); SBAR(); GAPA(C1=__builtin_amdgcn_mfma_f32_32x32x16_bf16(kf[3],qr[1],C1,0,0,0),   P0[14],P0[15],P1[0],P1[1],   pw1[2]=PKW(P0,12),pw1[3]=PKW(P0,14), pw1); \
    VRD(2); SBAR(); GAPA(C0=__builtin_amdgcn_mfma_f32_32x32x16_bf16(kf[4],qr[2],C0,0,0,0),   P1[2],P1[3],P1[4],P1[5],     pw2[0]=PKW(P1,0), pw2[1]=PKW(P1,2), pw2); \
    VRD(6); SBAR(); GAPA(C1=__builtin_amdgcn_mfma_f32_32x32x16_bf16(kf[5],qr[2],C1,0,0,0),   P1[6],P1[7],P1[8],P1[9],     pw2[2]=PKW(P1,4), pw2[3]=PKW(P1,6), pw2); \
    VRD(3); SBAR(); GAPA(C0=__builtin_amdgcn_mfma_f32_32x32x16_bf16(kf[6],qr[3],C0,0,0,0),   P1[10],P1[11],P1[12],P1[13], pw3[0]=PKW(P1,8), pw3[1]=PKW(P1,10), pw3); \
    VRD(7); SBAR(); GAPA(C1=__builtin_amdgcn_mfma_f32_32x32x16_bf16(kf[7],qr[3],C1,0,0,0),   P1[14],P1[15],0.f,0.f,       pw3[2]=PKW(P1,12),pw3[3]=PKW(P1,14), pw3); \
    l_reg+=sacc; \
    if(GK){DMA_K((t)+3,sl_cur);} if(GV){DMA_V((t)+1,sl_next);} \
    CMASK(C0,C1,t); \
    { float a=MX3(C0[0],C0[1],C1[0]),b=MX3(C0[2],C0[3],C1[1]); a=MX3(a,C1[2],C1[3]); \
      _Pragma("unroll") for(int r=4;r<16;r+=4){a=MX3(a,C0[r],C0[r+1]);b=MX3(b,C0[r+2],C0[r+3]);a=MX3(a,C1[r],C1[r+1]);b=MX3(b,C1[r+2],C1[r+3]);} \
      float rm=__builtin_fmaxf(a,b); { auto rr=__builtin_amdgcn_permlane32_swap(__float_as_uint(rm),__float_as_uint(rm),false,false); rm=__builtin_fmaxf(__uint_as_float(rr[0]),__uint_as_float(rr[1])); } \
      resc=false; \
      if(__builtin_expect(__any(rm>(float)THRL),0)){ const float dl=__builtin_fmaxf(rm,0.f); mhat+=dl; \
        _Pragma("unroll") for(int r=0;r<16;++r){C0[r]-=dl;C1[r]-=dl;} \
        const float f=__builtin_amdgcn_exp2f(-dl); l_reg*=f; if(hi==0)wsf[r32]=f; resc=true; } } \
    SBAR(); \
    { const __attribute__((address_space(3))) f32x4* cbp_=(const __attribute__((address_space(3))) f32x4*)(cb3+((t)+1)*256+hi*16); \
      _Pragma("unroll") for(int a_=0;a_<4;++a_){ const f32x4 u0_=cbp_[2*a_], u1_=cbp_[8+2*a_]; \
        P0[4*a_]=u0_[0];P0[4*a_+1]=u0_[1];P0[4*a_+2]=u0_[2];P0[4*a_+3]=u0_[3]; P1[4*a_]=u1_[0];P1[4*a_+1]=u1_[1];P1[4*a_+2]=u1_[2];P1[4*a_+3]=u1_[3]; } } SBAR(); \
    GAPB(o[0]=__builtin_amdgcn_mfma_f32_32x32x16_bf16(PAF(0),VFR(0),o[0],0,0,0), C0,0); \
    GAPB(o[1]=__builtin_amdgcn_mfma_f32_32x32x16_bf16(PAF(0),VFR(4),o[1],0,0,0), C0,4); \
    KRD(GL,0); GAPB(o[0]=__builtin_amdgcn_mfma_f32_32x32x16_bf16(PAF(1),VFR(1),o[0],0,0,0), C0,8); \
    KRD(GL,1); GAPB(o[1]=__builtin_amdgcn_mfma_f32_32x32x16_bf16(PAF(1),VFR(5),o[1],0,0,0), C0,12); \
    KRD(GL,2); GAPB(o[0]=__builtin_amdgcn_mfma_f32_32x32x16_bf16(PAF(2),VFR(2),o[0],0,0,0), C1,0); \
    KRD(GL,3); GAPB(o[1]=__builtin_amdgcn_mfma_f32_32x32x16_bf16(PAF(2),VFR(6),o[1],0,0,0), C1,4); \
    GAPB(o[0]=__builtin_amdgcn_mfma_f32_32x32x16_bf16(PAF(3),VFR(3),o[0],0,0,0), C1,8); \
    GAPB(o[1]=__builtin_amdgcn_mfma_f32_32x32x16_bf16(PAF(3),VFR(7),o[1],0,0,0), C1,12); \
    _Pragma("unroll") for(int r_=0;r_<16;++r_){P0[r_]-=mhat;P1[r_]-=mhat;} \
    }while(0)
  { const __attribute__((address_space(3))) f32x4* cbp_=(const __attribute__((address_space(3))) f32x4*)(cb3+256+hi*16);
    #pragma unroll
    for(int a_=0;a_<4;++a_){ const f32x4 u0_=cbp_[2*a_], u1_=cbp_[8+2*a_];
      pB0[4*a_]=u0_[0]-mhat;pB0[4*a_+1]=u0_[1]-mhat;pB0[4*a_+2]=u0_[2]-mhat;pB0[4*a_+3]=u0_[3]-mhat;
      pB1[4*a_]=u1_[0]-mhat;pB1[4*a_+1]=u1_[1]-mhat;pB1[4*a_+2]=u1_[2]-mhat;pB1[4*a_+3]=u1_[3]-mhat; } }
  int t=1;
  #undef CMASK
  #define CMASK(P0,P1,t) do{}while(0)
  for(;t+5<NT;t+=2){
    STEP(pB0,pB1,pA0,pA1,t,true,true,true);     WAIT_BAR(2); RESC(); ROT();
    STEP(pA0,pA1,pB0,pB1,t+1,true,true,true);   WAIT_BAR(2); RESC(); ROT();
  }
  #undef CMASK
  #define CMASK(P0,P1,t) do{int jb_=(t)-(NT-4); if(jb_>=0)cmask(P0,P1,jb_,qrel,hi);}while(0)
  #define ENDW(tt) do{ if((tt)+3<NT){WAIT_BAR(2);} else if((tt)+2<NT){WAIT_BAR(1);} else {WAIT_BAR(0);} }while(0)
  for(;t+1<NT;t+=2){
    STEP(pB0,pB1,pA0,pA1,t,(t+3<NT),(t+1<NT),(t+1<NT));       ENDW(t);   RESC(); ROT();
    STEP(pA0,pA1,pB0,pB1,t+1,(t+4<NT),(t+2<NT),(t+2<NT));     ENDW(t+1); RESC(); ROT();
  }
  STEP(pB0,pB1,pA0,pA1,NT-1,false,false,false); RESC();
  { float sacc=pB0[0]+pB0[1]; _Pragma("unroll") for(int r=2;r<16;++r)sacc+=pB0[r]; _Pragma("unroll") for(int r=0;r<16;++r)sacc+=pB1[r]; l_reg+=sacc;
    pw0=(u32x4){PKW(pB0,0),PKW(pB0,2),PKW(pB0,4),PKW(pB0,6)};pw1=(u32x4){PKW(pB0,8),PKW(pB0,10),PKW(pB0,12),PKW(pB0,14)};pw2=(u32x4){PKW(pB1,0),PKW(pB1,2),PKW(pB1,4),PKW(pB1,6)};pw3=(u32x4){PKW(pB1,8),PKW(pB1,10),PKW(pB1,12),PKW(pB1,14)};
    SBAR(); pv(o,vb0+sl_cur,PAF(0),PAF(1),PAF(2),PAF(3)); }
  #undef PKW
  #undef PAF
  #undef VFR
  #undef PIN
  #undef MX3
  #undef GAPA
  #undef GAPB
  #undef EX
  #undef VRD
  #undef KRD
  #undef STEP
  #undef ENDW
  {auto rr=__builtin_amdgcn_permlane32_swap(__float_as_uint(l_reg),__float_as_uint(l_reg),false,false);l_reg=__uint_as_float(rr[0])+__uint_as_float(rr[1]);}
  if(hi==0)wsf[32+r32]=l_reg;asm volatile("s_waitcnt lgkmcnt(0)":::"memory");
  float rli[16];
  #pragma unroll
  for(int r=0;r<16;++r)rli[r]=__builtin_amdgcn_rcpf(wsf[32+crow(r,hi)]);
  bf16*Ow=O+(rowbase+q0+wid*QBLK)*OPITCH+h*D;
  { bf16*stg=(bf16*)(shm+LDS_OST)+wid*2048;
    #pragma unroll
    for(int r=0;r<16;++r){const int orow=crow(r,hi);
      #pragma unroll
      for(int d0=0;d0<2;++d0)stg[orow*64+d0*32+r32]=__float2bfloat16(o[d0][r]*rli[r]);}
    asm volatile("s_waitcnt lgkmcnt(0)":::"memory");
    #pragma unroll
    for(int i=0;i<4;++i){const int row=i*8+(lane>>3),ch=lane&7; const u32x4 v=*(const u32x4*)(stg+row*64+ch*8); bf16*dst=Ow+(long)row*OPITCH+ch*8; const u32x4 gv=*(const u32x4*)dst; u32x4 w;
      #pragma unroll
      for(int j=0;j<4;++j){ const float a0=__uint_as_float(v[j]<<16)*__uint_as_float(gv[j]<<16), a1=__uint_as_float(v[j]&0xffff0000u)*__uint_as_float(gv[j]&0xffff0000u); w[j]=cvtpk_s(a0,a1); }
      if(!dry)*(u32x4*)dst=w;} }
  asm volatile("s_waitcnt lgkmcnt(0)\n\ts_barrier":::"memory");
  #undef DMA_K
  #undef DMA_V
  #undef CMASK
  #undef START
  #undef RESC
  #undef ROT
}
constexpr int ATTN_LDS_BYTES=LDS_BYTES;
struct AttnTensors { const bf16* Q; const bf16* K; const bf16* V; bf16* O; const float* CB; const float* NRM; };
struct AttnUnit { int bh; int qb; };
struct StaticOrder {
  int vcu;
  __device__ __forceinline__ explicit StaticOrder(int grid,int block):vcu((block%8)*(grid/8)+block/8){}
  __device__ __forceinline__ bool next(int i,AttnUnit&u)const{ if(i>=2)return false; const int s=vcu&7; u.bh=vcu>>3; u.qb=(i==0)?15-s:s; return true; }
  __device__ __forceinline__ void a_ready(const AttnUnit&)const{}
  __device__ __forceinline__ void done(const AttnUnit&)const{}
};
template<class Sched,int THRL=8> __device__ __forceinline__ void attn_phase(char*lds,const AttnTensors&T,const Sched&S,bool dry=false){
  AttnUnit u;
  for(int i=0;S.next(i,u);++i){ S.a_ready(u); attn_unit<THRL>(u.bh/NHEAD,u.bh%NHEAD,u.qb,T.Q,T.K,T.V,T.O,T.CB,T.NRM,lds,dry); S.done(u); }
}
#undef SBAR
#undef WAIT_BAR
}
#include <hip/hip_cooperative_groups.h>
namespace cg = cooperative_groups;
#define LAS __attribute__((address_space(3)))
typedef unsigned short bf16;
typedef float f32x4 __attribute__((ext_vector_type(4)));
typedef float f32x2 __attribute__((ext_vector_type(2)));
typedef unsigned u32x4 __attribute__((ext_vector_type(4)));
typedef unsigned u32x2 __attribute__((ext_vector_type(2)));
typedef short bf16x8 __attribute__((ext_vector_type(8)));
typedef short bf16x4 __attribute__((ext_vector_type(4)));

constexpr int NWAVES = 8, NTHR = 512;
constexpr int BATCH = 4, SEQ = 4096, DM = 1024, DEPTH = 4, M = BATCH * SEQ;
constexpr int NIN = 3592, NF = 3584;
constexpr int T5 = 32, NCH5 = M / T5, KA5 = 640, NG5 = 16;
constexpr float EPS = 1e-6f;
constexpr float LOG2E = 1.4426950408889634f;

constexpr size_t MiB = 1u << 20;
constexpr size_t WS_WIN = 1 * MiB, WS_WO = 31 * MiB, WS_WGLU = 39 * MiB, WS_ROPE = 40 * MiB, WS_MF = 41 * MiB, WS_WB = 81 * MiB;
constexpr size_t WS_LAM = 90 * MiB, WS_LOGF = 90 * MiB + 65536, WS_CB = WS_LOGF + 524288, WS_SS = WS_CB + 524288, WS_NRM = WS_SS + 131072, WS_XBUF = WS_NRM + 4096;
constexpr size_t WS_XN = 92 * MiB, WS_E = WS_XN, WS_UPD = WS_XN + 4 * MiB, WS_STATE = WS_XN + 20 * MiB;
constexpr size_t WS_QO = 124 * MiB, WS_KB = 140 * MiB, WS_VB = 156 * MiB, WS_SUA = 172 * MiB, WS_RQ = 182 * MiB, WS_RK = 190 * MiB, WS_RKT = 198 * MiB, WS_YS5 = WS_RKT;
constexpr size_t WS_RVT = 206 * MiB, WS_GATE = 214 * MiB, WS_END = 246 * MiB;

constexpr int RING_BYTES = 131072, LDS_BYTES = 147456;

struct Args { const float* in[16]; float* out; unsigned char* ws; };

__device__ __forceinline__ float bf2f(unsigned short b) { return __uint_as_float((unsigned)b << 16); }
__device__ __forceinline__ float bflo(unsigned w) { return __uint_as_float(w << 16); }
__device__ __forceinline__ float bfhi(unsigned w) { return __uint_as_float(w & 0xffff0000u); }
__device__ __forceinline__ unsigned pk2(float lo, float hi) { return pg8::cvt_pk_bf16(lo, hi); }
__device__ __forceinline__ unsigned short f2bf(float f) { return (unsigned short)(pg8::cvt_pk_bf16(f, 0.f) & 0xffffu); }
__device__ __forceinline__ float wave_sum(float v) {
#pragma unroll
    for (int o = 1; o < 64; o <<= 1) v += __shfl_xor(v, o);
    return v;
}
__device__ __forceinline__ float lg2_gamma(int hh) { return log2f(1.0f - exp2f(-5.0f - (float)hh)); }

__device__ __forceinline__ int win_col(int n) {
    if (n < 1536) return n;
    if (n < 1792) return n + 8;
    if (n < 2304) { const bool q = n < 2048; const int base = q ? 1792 : 2048; const int hh = (n - base) >> 6, pos = (n - base) & 63; const int d = (pos & 1) ? 32 + (pos >> 1) : (pos >> 1); return (q ? 1800 : 2056) + hh * 64 + d; }
    return n + 8;
}
template <bool MAP> __device__ __forceinline__ void p0_transpose_item(const float* W, int K, int Nsrc, int Ndst, bf16* WT, LAS float* scr, int item, int lane) {
    const int nblk = Ndst / 32, kb = item / nblk, nb = item % nblk, k0 = 64 * kb, n0 = 32 * nb;
    const int sc = MAP ? win_col(n0 + (lane & 31)) : n0 + (lane & 31);
    float wv[32];
#pragma unroll
    for (int i = 0; i < 32; ++i) { const int kk = 2 * i + (lane >> 5); wv[i] = (MAP && sc < 0) ? 0.f : W[(size_t)(k0 + kk) * Nsrc + (sc < 0 ? 0 : sc)]; }
#pragma unroll
    for (int i = 0; i < 32; ++i) { const int kk = 2 * i + (lane >> 5); scr[kk * 33 + (lane & 31)] = wv[i]; }
    asm volatile("s_waitcnt lgkmcnt(0)" ::: "memory");
    const int c = lane & 7;
#pragma unroll
    for (int j = 0; j < 4; ++j) { const int n = (lane >> 3) + 8 * j; const LAS float* s = scr + (8 * c) * 33 + n;
        u32x4 o; o.x = pk2(s[0 * 33], s[1 * 33]); o.y = pk2(s[2 * 33], s[3 * 33]); o.z = pk2(s[4 * 33], s[5 * 33]); o.w = pk2(s[6 * 33], s[7 * 33]);
        *(u32x4*)(WT + (size_t)(n0 + n) * K + k0 + 8 * c) = o; }
    asm volatile("s_waitcnt lgkmcnt(0)" ::: "memory");
}

__device__ __forceinline__ void s5_prep(const Args& a, int l, int g, LAS float* L, int tid) {
    LAS float* LPr = L;
    LAS float* LPi = L + 33 * 64;
    LAS float* Bbr = L + 66 * 64;
    LAS float* Bbi = Bbr + 1024;
    LAS float* Cr = Bbi + 1024;
    LAS float* Ci = Cr + 1024;
    LAS float* KT = Ci + 1024;
    const float* a_re = a.in[4] + (size_t)(l * 16 + g) * 64; const float* a_im = a.in[5] + (size_t)(l * 16 + g) * 64;
    const float* b_re = a.in[6] + (size_t)(l * 16 + g) * 1024; const float* b_im = a.in[7] + (size_t)(l * 16 + g) * 1024;
    const float* c_re = a.in[8] + (size_t)(l * 16 + g) * 1024; const float* c_im = a.in[9] + (size_t)(l * 16 + g) * 1024;
    const float log_dt = a.in[11][l * 16 + g];
    bf16* MF = (bf16*)(a.ws + WS_MF) + (size_t)(l * 16 + g) * 512 * KA5;
    bf16* WB = (bf16*)(a.ws + WS_WB) + (size_t)(l * 16 + g) * 128 * 512;
    float* LAM = (float*)(a.ws + WS_LAM) + (size_t)(l * 16 + g) * 128;
    if (tid < 64) {
        const int p = tid;
        const double dt = exp((double)log_dt), ar = (double)a_re[p], ai = (double)a_im[p];
        const double mag = exp(ar * dt); double sn, cs; sincos(ai * dt, &sn, &cs);
        const double lr = mag * cs, li = mag * sn, den = ar * ar + ai * ai;
        const double fr = ((lr - 1.0) * ar + li * ai) / den, fi = (li * ar - (lr - 1.0) * ai) / den;
#pragma unroll 4
        for (int h = 0; h < 16; ++h) { const double br = (double)b_re[p * 16 + h], bi = (double)b_im[p * 16 + h]; Bbr[p * 16 + h] = (float)(fr * br - fi * bi); Bbi[p * 16 + h] = (float)(fr * bi + fi * br); }
        double pr = 1.0, pi = 0.0;
        for (int j = 0; j <= 32; ++j) { LPr[j * 64 + p] = (float)pr; LPi[j * 64 + p] = (float)pi; const double nr = pr * lr - pi * li, ni = pr * li + pi * lr; pr = nr; pi = ni; }
        LAM[p] = LPr[32 * 64 + p]; LAM[64 + p] = LPi[32 * 64 + p];
    }
    for (int i = tid; i < 1024; i += NTHR) { const int h = i >> 6, p = i & 63; Cr[p * 16 + h] = c_re[i]; Ci[p * 16 + h] = c_im[i]; }
    __syncthreads();
    { const int j = tid >> 4, h = tid & 15; float acc[16];
#pragma unroll
      for (int e = 0; e < 16; ++e) acc[e] = 0.f;
      for (int p = 0; p < 64; ++p) { const float cr = Cr[p * 16 + h], ci = Ci[p * 16 + h], lr = LPr[j * 64 + p], li = LPi[j * 64 + p]; const float clr = cr * lr - ci * li, cli = cr * li + ci * lr;
#pragma unroll
          for (int q = 0; q < 4; ++q) { const f32x4 br = *(const LAS f32x4*)(Bbr + p * 16 + 4 * q), bi = *(const LAS f32x4*)(Bbi + p * 16 + 4 * q);
              acc[4 * q] += clr * br.x - cli * bi.x; acc[4 * q + 1] += clr * br.y - cli * bi.y; acc[4 * q + 2] += clr * br.z - cli * bi.z; acc[4 * q + 3] += clr * br.w - cli * bi.w; } }
#pragma unroll
      for (int e = 0; e < 16; ++e) KT[tid * 16 + e] = acc[e]; }
    __syncthreads();
    for (int q = tid; q < 512 * 64; q += NTHR) {
        const int row = q >> 6, cp = q & 63, s = cp >> 1, h0 = (cp & 1) * 8, t = row >> 4, h = row & 15;
        u32x4 o = (u32x4){0u, 0u, 0u, 0u};
        if (s <= t) { const LAS float* k = KT + ((t - s) * 16 + h) * 16 + h0; o.x = pk2(k[0], k[1]); o.y = pk2(k[2], k[3]); o.z = pk2(k[4], k[5]); o.w = pk2(k[6], k[7]); }
        *(u32x4*)(MF + (size_t)row * KA5 + cp * 8) = o;
    }
    for (int q = tid; q < 512 * 16; q += NTHR) {
        const int row = q >> 4, cp = q & 15, t = row >> 4, h = row & 15; float v[8];
#pragma unroll
        for (int e = 0; e < 8; ++e) { const int jj = cp * 8 + e, p = jj & 63; const float cr = Cr[p * 16 + h], ci = Ci[p * 16 + h], lr = LPr[(t + 1) * 64 + p], li = LPi[(t + 1) * 64 + p];
            v[e] = (jj < 64) ? (cr * lr - ci * li) : -(cr * li + ci * lr); }
        u32x4 o; o.x = pk2(v[0], v[1]); o.y = pk2(v[2], v[3]); o.z = pk2(v[4], v[5]); o.w = pk2(v[6], v[7]);
        *(u32x4*)(MF + (size_t)row * KA5 + 512 + cp * 8) = o;
    }
    for (int q = tid; q < 128 * 64; q += NTHR) {
        const int j = q >> 6, cp = q & 63, s = cp >> 1, h0 = (cp & 1) * 8, p = j & 63; const float lr = LPr[(31 - s) * 64 + p], li = LPi[(31 - s) * 64 + p]; float v[8];
#pragma unroll
        for (int e = 0; e < 8; ++e) { const float br = Bbr[p * 16 + h0 + e], bi = Bbi[p * 16 + h0 + e]; v[e] = (j < 64) ? (lr * br - li * bi) : (lr * bi + li * br); }
        u32x4 o; o.x = pk2(v[0], v[1]); o.y = pk2(v[2], v[3]); o.z = pk2(v[4], v[5]); o.w = pk2(v[6], v[7]);
        *(u32x4*)(WB + (size_t)j * 512 + cp * 8) = o;
    }
    __syncthreads();
}

__device__ __forceinline__ void norm0_phase(const Args& a, int lane, int gw, int NGW) {
    const float* X = a.in[0]; f32x4 gv[4];
#pragma unroll
    for (int j = 0; j < 4; ++j) gv[j] = *((const f32x4*)a.in[1] + lane + 64 * j);
    bf16* XN = (bf16*)(a.ws + WS_XN); float* SS = (float*)(a.ws + WS_SS);
    for (int m = gw; m < M; m += 2 * NGW) {
        const int m2 = m + NGW; const bool has2 = m2 < M;
        const f32x4* xr = (const f32x4*)(X + (size_t)m * DM) + lane; const f32x4* xr2 = (const f32x4*)(X + (size_t)(has2 ? m2 : m) * DM) + lane; f32x4 v[4], w[4];
#pragma unroll
        for (int j = 0; j < 4; ++j) { v[j] = xr[64 * j]; w[j] = xr2[64 * j]; }
        float ss = 0.f, ss2 = 0.f;
#pragma unroll
        for (int j = 0; j < 4; ++j) { ss += (v[j].x * v[j].x + v[j].y * v[j].y) + (v[j].z * v[j].z + v[j].w * v[j].w); ss2 += (w[j].x * w[j].x + w[j].y * w[j].y) + (w[j].z * w[j].z + w[j].w * w[j].w); }
        ss = wave_sum(ss); ss2 = wave_sum(ss2);
        unsigned long long* o8 = (unsigned long long*)(XN + (size_t)m * DM) + lane; unsigned long long* o82 = (unsigned long long*)(XN + (size_t)m2 * DM) + lane;
#pragma unroll
        for (int j = 0; j < 4; ++j) { v[j] = v[j] * gv[j]; o8[64 * j] = (unsigned long long)pk2(v[j].x, v[j].y) | ((unsigned long long)pk2(v[j].z, v[j].w) << 32);
            if (has2) { w[j] = w[j] * gv[j]; o82[64 * j] = (unsigned long long)pk2(w[j].x, w[j].y) | ((unsigned long long)pk2(w[j].z, w[j].w) << 32); } }
        if (lane == 0) { SS[m] = ss; if (has2) SS[m2] = ss2; }
    }
}
__device__ __forceinline__ void final_norm(const Args& a, float* X, const float* SS, int lane, int gw, int NGW) {
    f32x4 gv[4];
#pragma unroll
    for (int j = 0; j < 4; ++j) gv[j] = *((const f32x4*)a.in[15] + lane + 64 * j);
    for (int m = gw; m < M; m += 2 * NGW) {
        const int m2 = m + NGW; const bool has2 = m2 < M;
        f32x4* xr = (f32x4*)(X + (size_t)m * DM) + lane; f32x4* xr2 = (f32x4*)(X + (size_t)(has2 ? m2 : m) * DM) + lane; f32x4 v[4], w[4];
#pragma unroll
        for (int j = 0; j < 4; ++j) { v[j] = xr[64 * j]; w[j] = xr2[64 * j]; }
        const float r1 = rsqrtf(SS[m] * (1.f / DM) + EPS), r2 = rsqrtf(SS[has2 ? m2 : m] * (1.f / DM) + EPS);
#pragma unroll
        for (int j = 0; j < 4; ++j) { xr[64 * j] = v[j] * r1 * gv[j]; if (has2) xr2[64 * j] = w[j] * r2 * gv[j]; }
    }
}

__device__ __forceinline__ void flog_phase(const Args& a, int l, const float* SS, LAS float* WF, int tid, int lane, int wave, int blk, int nblk) {
    const float* win = a.in[2] + (size_t)l * DM * NIN;
    for (int i = tid; i < 2048; i += NTHR) { const int k = i >> 1, hf = i & 1; *(LAS f32x4*)(WF + k * 8 + hf * 4) = *(const f32x4*)(win + (size_t)k * NIN + 1536 + hf * 4); }
    __syncthreads();
    const bf16* XN = (const bf16*)(a.ws + WS_XN); float* LOGF = (float*)(a.ws + WS_LOGF);
    const float bfj = (lane < 8) ? a.in[3][l * 8 + lane] : 0.f;
    const int rows_per = M / nblk;
    for (int i = wave; i < rows_per; i += 2 * NWAVES) {
        const int m = blk * rows_per + i, m2 = m + NWAVES; const bool has2 = (i + NWAVES) < rows_per;
        const u32x4 x0 = *((const u32x4*)(XN + (size_t)m * DM) + lane), x1 = *((const u32x4*)(XN + (size_t)m * DM + 512) + lane);
        const u32x4 y0 = *((const u32x4*)(XN + (size_t)(has2 ? m2 : m) * DM) + lane), y1 = *((const u32x4*)(XN + (size_t)(has2 ? m2 : m) * DM + 512) + lane);
        float acc[8], acc2[8];
#pragma unroll
        for (int e = 0; e < 8; ++e) { acc[e] = 0.f; acc2[e] = 0.f; }
#pragma unroll
        for (int hf = 0; hf < 2; ++hf)
#pragma unroll
            for (int q = 0; q < 8; ++q) { const int k = 512 * hf + 8 * lane + q; const f32x4 w0 = *(const LAS f32x4*)(WF + k * 8), w1 = *(const LAS f32x4*)(WF + k * 8 + 4);
                const unsigned xw = hf ? x1[q >> 1] : x0[q >> 1], yw = hf ? y1[q >> 1] : y0[q >> 1]; const float hv = (q & 1) ? bfhi(xw) : bflo(xw), hv2 = (q & 1) ? bfhi(yw) : bflo(yw);
                acc[0] += hv * w0.x; acc[1] += hv * w0.y; acc[2] += hv * w0.z; acc[3] += hv * w0.w; acc[4] += hv * w1.x; acc[5] += hv * w1.y; acc[6] += hv * w1.z; acc[7] += hv * w1.w;
                acc2[0] += hv2 * w0.x; acc2[1] += hv2 * w0.y; acc2[2] += hv2 * w0.z; acc2[3] += hv2 * w0.w; acc2[4] += hv2 * w1.x; acc2[5] += hv2 * w1.y; acc2[6] += hv2 * w1.z; acc2[7] += hv2 * w1.w; }
        float mine = 0.f, mine2 = 0.f;
#pragma unroll
        for (int e = 0; e < 8; ++e) { const float s = wave_sum(acc[e]), s2 = wave_sum(acc2[e]); if (lane == e) { mine = s; mine2 = s2; } }
        if (lane < 8) { const float z = mine * rsqrtf(SS[m] * (1.f / DM) + EPS) + bfj; LOGF[(size_t)((m >> 12) * 8 + lane) * SEQ + (m & 4095)] = fminf(z, 0.f) - log1pf(expf(-fabsf(z)));
            if (has2) { const float z2 = mine2 * rsqrtf(SS[m2] * (1.f / DM) + EPS) + bfj; LOGF[(size_t)((m2 >> 12) * 8 + lane) * SEQ + (m2 & 4095)] = fminf(z2, 0.f) - log1pf(expf(-fabsf(z2))); } }
    }
}

__device__ __forceinline__ bool opaque_true() { int d = 1; asm volatile("" : "+s"(d)); return d != 0; }
struct RangeOrder {
    pg8::StaticOrder S; int lo, hi;
    __device__ bool next(int i, pg8::Unit& u) const { return (lo + i < hi) ? S.next(lo + i, u) : false; }
    __device__ __forceinline__ void a_ready(const pg8::Unit&) const {}
    __device__ __forceinline__ void done(const pg8::Unit&) const {}
};
struct FlatOrder {
    int nM, nN, nG, G, c;
    __device__ bool next(int i, pg8::Unit& u) const { const int L = i * G + c; if (L >= nG * nM * nN) return false; u.gz = L / (nM * nN); const int r = L % (nM * nN); u.pm = r % nM; u.pn = r / nM; return true; }
    __device__ __forceinline__ void a_ready(const pg8::Unit&) const {}
    __device__ __forceinline__ void done(const pg8::Unit&) const {}
};
__device__ __forceinline__ float silu_f(float v) { return v / (1.f + __expf(-v)); }
__device__ __forceinline__ float gelu_tanh(float v) { const float u = 0.7978845608028654f * (v + 0.044715f * v * v * v); const float e = __expf(2.f * u); const float th = 1.f - 2.f / (e + 1.f); return 0.5f * v * (1.f + th); }

struct EpiInProj {
    static constexpr bool PERM = true, AFTER_DRAIN = false;
    unsigned char* ws; const float* SS; const float* bfl;
    __device__ __forceinline__ void operator()(const pg8::f32x4 (&acc)[2][2][4][2], const pg8::Unit& u, int wr, int wc, int fr, int fq) const {
        const int pn = u.pn; const int row0 = u.pm * 256 + wr * 64 + fr, cl0 = wc * 32 + 8 * fq;
        float rs[2][4];
#pragma unroll
        for (int ai = 0; ai < 2; ++ai)
#pragma unroll
            for (int m = 0; m < 4; ++m) rs[ai][m] = rsqrtf(SS[row0 + ai * 128 + m * 16] * (1.f / DM) + EPS);
        if (pn == 14) {
            if (wc == 0 && fq == 0) { float* LOGF = (float*)(ws + WS_LOGF); const f32x4 b0 = *(const f32x4*)bfl, b1 = *(const f32x4*)(bfl + 4);
#pragma unroll
                for (int ai = 0; ai < 2; ++ai)
#pragma unroll
                    for (int m = 0; m < 4; ++m) { const int row = row0 + ai * 128 + m * 16; const float r = rs[ai][m]; const pg8::f32x4 v0 = acc[ai][0][m][0], v1 = acc[ai][0][m][1];
                        float z[8] = {v0[0] * r + b0.x, v0[1] * r + b0.y, v0[2] * r + b0.z, v0[3] * r + b0.w, v1[0] * r + b1.x, v1[1] * r + b1.y, v1[2] * r + b1.z, v1[3] * r + b1.w};
#pragma unroll
                        for (int e = 0; e < 8; ++e) LOGF[(size_t)((row >> 12) * 8 + e) * SEQ + (row & 4095)] = fminf(z[e], 0.f) - log1pf(__expf(-fabsf(z[e]))); } }
            return;
        }
        if (pn < 6) {
            bf16* base = (bf16*)(ws + (pn < 2 ? WS_QO : pn < 4 ? WS_KB : WS_VB)); const float sc = pn < 2 ? 0.125f * LOG2E : 1.f; const int cb = (pn & 1) * 256 + cl0;
#pragma unroll
            for (int ai = 0; ai < 2; ++ai)
#pragma unroll
                for (int m = 0; m < 4; ++m) { bf16* rp = base + (size_t)(row0 + ai * 128 + m * 16) * 512 + cb;
#pragma unroll
                    for (int bj = 0; bj < 2; ++bj) { const float sr = sc * rs[ai][m]; const pg8::f32x4 v0 = acc[ai][bj][m][0] * sr, v1 = acc[ai][bj][m][1] * sr; u32x4 w; w.x = pk2(v0[0], v0[1]); w.y = pk2(v0[2], v0[3]); w.z = pk2(v1[0], v1[1]); w.w = pk2(v1[2], v1[3]); *(u32x4*)(rp + bj * 128) = w; } }
        } else if (pn == 6) {
            bf16* base = (bf16*)(ws + WS_SUA);
#pragma unroll
            for (int ai = 0; ai < 2; ++ai)
#pragma unroll
                for (int m = 0; m < 4; ++m) { const int row = row0 + ai * 128 + m * 16, chunk = row >> 5, t = row & 31;
#pragma unroll
                    for (int bj = 0; bj < 2; ++bj) { const int c = cl0 + bj * 128, g = c >> 4, h0 = c & 15; const pg8::f32x4 v0 = acc[ai][bj][m][0] * rs[ai][m], v1 = acc[ai][bj][m][1] * rs[ai][m]; u32x4 w; w.x = pk2(v0[0], v0[1]); w.y = pk2(v0[2], v0[3]); w.z = pk2(v1[0], v1[1]); w.w = pk2(v1[2], v1[3]);
                        *(u32x4*)(base + ((size_t)(g * 512 + chunk) * KA5 + t * 16 + h0)) = w; } }
        } else if (pn == 7 || pn == 8) {
            const f32x4* rope = (const f32x4*)(ws + WS_ROPE); bf16* base = (bf16*)(ws + (pn == 7 ? WS_RQ : WS_RK)); bf16* RKT = (bf16*)(ws + WS_RKT);
#pragma unroll
            for (int ai = 0; ai < 2; ++ai)
#pragma unroll
                for (int m = 0; m < 4; ++m) { const int row = row0 + ai * 128 + m * 16, b = row >> 12, t = row & 4095;
#pragma unroll
                    for (int bj = 0; bj < 2; ++bj) { const int c = cl0 + bj * 128, hh = c >> 6, pos0 = c & 63; const pg8::f32x4 v0 = acc[ai][bj][m][0] * rs[ai][m], v1 = acc[ai][bj][m][1] * rs[ai][m];
                        const f32x4 r0 = rope[(t * 32 + (pos0 >> 1)) >> 1], r1 = rope[((t * 32 + (pos0 >> 1)) >> 1) + 1];
                        float o[8];
                        o[0] = v0[0] * r0.x - v0[1] * r0.y; o[1] = v0[0] * r0.y + v0[1] * r0.x; o[2] = v0[2] * r0.z - v0[3] * r0.w; o[3] = v0[2] * r0.w + v0[3] * r0.z;
                        o[4] = v1[0] * r1.x - v1[1] * r1.y; o[5] = v1[0] * r1.y + v1[1] * r1.x; o[6] = v1[2] * r1.z - v1[3] * r1.w; o[7] = v1[2] * r1.w + v1[3] * r1.z;
                        u32x4 w; w.x = pk2(o[0], o[1]); w.y = pk2(o[2], o[3]); w.z = pk2(o[4], o[5]); w.w = pk2(o[6], o[7]);
                        *(u32x4*)(base + (size_t)row * 256 + c) = w;
                        if (pn == 8) { const float wk = exp2f(lg2_gamma(hh) * (float)(63 - (t & 63))); bf16* tp = RKT + ((size_t)((b * 4 + hh) * 64 + pos0)) * SEQ + t;
#pragma unroll
                            for (int e = 0; e < 8; ++e) tp[(size_t)e * SEQ] = f2bf(o[e] * wk); } } }
        } else if (pn == 9) {
            bf16* RVT = (bf16*)(ws + WS_RVT);
#pragma unroll
            for (int ai = 0; ai < 2; ++ai)
#pragma unroll
                for (int m = 0; m < 4; ++m) { const int row = row0 + ai * 128 + m * 16, b = row >> 12, t = row & 4095;
#pragma unroll
                    for (int bj = 0; bj < 2; ++bj) { const int c = cl0 + bj * 128, hh = c >> 6, d0 = c & 63; const pg8::f32x4 v0 = acc[ai][bj][m][0] * rs[ai][m], v1 = acc[ai][bj][m][1] * rs[ai][m]; bf16* tp = RVT + ((size_t)((b * 4 + hh) * 64 + d0)) * SEQ + t;
#pragma unroll
                        for (int e = 0; e < 4; ++e) { tp[(size_t)e * SEQ] = f2bf(v0[e]); tp[(size_t)(4 + e) * SEQ] = f2bf(v1[e]); } } }
        } else {
            bf16* base = (bf16*)(ws + WS_GATE); const int cb = (pn - 10) * 256 + cl0;
#pragma unroll
            for (int ai = 0; ai < 2; ++ai)
#pragma unroll
                for (int m = 0; m < 4; ++m) { bf16* rp = base + (size_t)(row0 + ai * 128 + m * 16) * 1024 + cb;
#pragma unroll
                    for (int bj = 0; bj < 2; ++bj) { const pg8::f32x4 v0 = acc[ai][bj][m][0] * rs[ai][m], v1 = acc[ai][bj][m][1] * rs[ai][m]; u32x4 w; w.x = pk2(silu_f(v0[0]), silu_f(v0[1])); w.y = pk2(silu_f(v0[2]), silu_f(v0[3])); w.z = pk2(silu_f(v1[0]), silu_f(v1[1])); w.w = pk2(silu_f(v1[2]), silu_f(v1[3])); *(u32x4*)(rp + bj * 128) = w; } }
        }
    }
};
struct EpiS5E {
    static constexpr bool PERM = false, AFTER_DRAIN = false;
    float* E;
    __device__ __forceinline__ void operator()(const pg8::f32x4 (&acc)[2][2][4][2], const pg8::Unit& u, int wr, int wc, int fr, int fq) const {
        const int row0 = u.pm * 256 + wr * 64 + fr, col0 = wc * 32 + 4 * fq;
#pragma unroll
        for (int ai = 0; ai < 2; ++ai)
#pragma unroll
            for (int m = 0; m < 4; ++m) { float* rp = E + ((size_t)u.gz * NCH5 + row0 + ai * 128 + m * 16) * 128 + col0;
#pragma unroll
                for (int n = 0; n < 2; ++n) *(pg8::f32x4*)(rp + n * 16) = acc[ai][0][m][n]; }
    }
};
struct EpiS5Y {
    static constexpr bool PERM = true, AFTER_DRAIN = false;
    const bf16* SUA; bf16* YS5; const float* dvec;
    __device__ __forceinline__ void operator()(const pg8::f32x4 (&acc)[2][2][4][2], const pg8::Unit& u, int wr, int wc, int fr, int fq) const {
        const int row0 = u.pm * 256 + wr * 64 + fr, cl0 = u.pn * 256 + wc * 32 + 8 * fq; const int g = u.gz;
#pragma unroll
        for (int bj = 0; bj < 2; ++bj) { const int c = cl0 + bj * 128, tt = c >> 4, h0 = c & 15; const f32x4 d0 = *(const f32x4*)(dvec + g * 16 + h0), d1 = *(const f32x4*)(dvec + g * 16 + h0 + 4);
#pragma unroll
            for (int ai = 0; ai < 2; ++ai)
#pragma unroll
                for (int m = 0; m < 4; ++m) { const int chunk = row0 + ai * 128 + m * 16; const u32x4 uu = *(const u32x4*)(SUA + ((size_t)(g * 512 + chunk) * KA5 + c)); const pg8::f32x4 v0 = acc[ai][bj][m][0], v1 = acc[ai][bj][m][1];
                    float y[8]; y[0] = v0[0] + d0.x * bflo(uu.x); y[1] = v0[1] + d0.y * bfhi(uu.x); y[2] = v0[2] + d0.z * bflo(uu.y); y[3] = v0[3] + d0.w * bfhi(uu.y);
                    y[4] = v1[0] + d1.x * bflo(uu.z); y[5] = v1[1] + d1.y * bfhi(uu.z); y[6] = v1[2] + d1.z * bflo(uu.w); y[7] = v1[3] + d1.w * bfhi(uu.w);
#pragma unroll
                    for (int e = 0; e < 8; ++e) y[e] = gelu_tanh(y[e]);
                    u32x4 w; w.x = pk2(y[0], y[1]); w.y = pk2(y[2], y[3]); w.z = pk2(y[4], y[5]); w.w = pk2(y[6], y[7]);
                    *(u32x4*)(YS5 + (size_t)(chunk * 32 + tt) * 256 + g * 16 + h0) = w; } }
    }
};
struct EpiGlu {
    static constexpr bool PERM = true, AFTER_DRAIN = false;
    const bf16* YS5; bf16* G; bool dry;
    __device__ __forceinline__ void operator()(const pg8::f32x4 (&acc)[2][2][4][2], const pg8::Unit& u, int wr, int wc, int fr, int fq) const {
        const int row0 = u.pm * 256 + wr * 64 + fr, cl0 = wc * 32 + 8 * fq;
#pragma unroll
        for (int ai = 0; ai < 2; ++ai)
#pragma unroll
            for (int m = 0; m < 4; ++m) { const int row = row0 + ai * 128 + m * 16;
#pragma unroll
                for (int bj = 0; bj < 2; ++bj) { const int c = cl0 + bj * 128; const u32x4 yy = *(const u32x4*)(YS5 + (size_t)row * 256 + c); bf16* gp = G + (size_t)row * 1024 + 512 + c; const u32x4 gg = *(const u32x4*)gp;
                    const pg8::f32x4 v0 = acc[ai][bj][m][0], v1 = acc[ai][bj][m][1]; float s[8];
#pragma unroll
                    for (int e = 0; e < 4; ++e) { s[e] = 1.f / (1.f + __expf(-v0[e])); s[4 + e] = 1.f / (1.f + __expf(-v1[e])); }
                    u32x4 w; w.x = pk2(bflo(yy.x) * s[0] * bflo(gg.x), bfhi(yy.x) * s[1] * bfhi(gg.x)); w.y = pk2(bflo(yy.y) * s[2] * bflo(gg.y), bfhi(yy.y) * s[3] * bfhi(gg.y));
                    w.z = pk2(bflo(yy.z) * s[4] * bflo(gg.z), bfhi(yy.z) * s[5] * bfhi(gg.z)); w.w = pk2(bflo(yy.w) * s[6] * bflo(gg.w), bfhi(yy.w) * s[7] * bfhi(gg.w));
                    if (!dry) *(u32x4*)gp = w; } }
    }
};
struct EpiOut {
    static constexpr bool PERM = false, AFTER_DRAIN = false;
    const float* base; float* out; float* SSn; bf16* XN; const float* gnext; bool dry;
    __device__ __forceinline__ void operator()(const pg8::f32x4 (&acc)[2][2][4][2], const pg8::Unit& u, int wr, int wc, int fr, int fq) const {
        const int row0 = u.pm * 256 + wr * 64 + fr, col0 = u.pn * 256 + wc * 32 + 4 * fq;
        f32x4 gq[2][2];
#pragma unroll
        for (int bj = 0; bj < 2; ++bj)
#pragma unroll
            for (int n = 0; n < 2; ++n) gq[bj][n] = gnext ? *(const f32x4*)(gnext + col0 + bj * 128 + n * 16) : (f32x4){0.f, 0.f, 0.f, 0.f};
#pragma unroll
        for (int ai = 0; ai < 2; ++ai)
#pragma unroll
            for (int m = 0; m < 4; ++m) { const int row = row0 + ai * 128 + m * 16; const size_t off = (size_t)row * DM + col0; float sq = 0.f;
#pragma unroll
                for (int bj = 0; bj < 2; ++bj)
#pragma unroll
                    for (int n = 0; n < 2; ++n) { const f32x4 bs = *(const f32x4*)(base + off + bj * 128 + n * 16); const pg8::f32x4 v = acc[ai][bj][m][n]; const f32x4 x = (f32x4){bs.x + v[0], bs.y + v[1], bs.z + v[2], bs.w + v[3]};
                        sq += (x.x * x.x + x.y * x.y) + (x.z * x.z + x.w * x.w);
                        if (!dry) { *(f32x4*)(out + off + bj * 128 + n * 16) = x;
                            if (gnext) { const f32x4 g = gq[bj][n]; u32x2 w; w.x = pk2(x.x * g.x, x.y * g.y); w.y = pk2(x.z * g.z, x.w * g.w); *(u32x2*)(XN + off + bj * 128 + n * 16) = w; } } }
                sq += __shfl_xor(sq, 16); sq += __shfl_xor(sq, 32);
                if (fq == 0 && !dry) __hip_atomic_fetch_add(SSn + row, sq, __ATOMIC_RELAXED, __HIP_MEMORY_SCOPE_AGENT); }
    }
};

struct EpiOutFinal {
    static constexpr bool PERM = false, AFTER_DRAIN = true;
    const float* base; float* out; const float* wfin; float* xbuf; unsigned* cnt;
    __device__ __forceinline__ void fused(pg8::f32x4 (&acc)[2][2][4][2], const pg8::Unit& u, int wr, int wc, int fr, int fq, PG8_LAS unsigned char* lds, int wid, int lane) const {
        PG8_LAS float* P = (PG8_LAS float*)lds;
        PG8_LAS float* S = (PG8_LAS float*)(lds + 4096);
        const int col0 = u.pn * 256 + wc * 32 + 4 * fq;
#pragma unroll
        for (int ai = 0; ai < 2; ++ai)
#pragma unroll
            for (int m = 0; m < 4; ++m) { const int r = ai * 128 + wr * 64 + m * 16 + fr; const size_t off = (size_t)(u.pm * 256 + r) * DM + col0; float sq = 0.f;
#pragma unroll
                for (int bj = 0; bj < 2; ++bj)
#pragma unroll
                    for (int n = 0; n < 2; ++n) { const f32x4 bs = *(const f32x4*)(base + off + bj * 128 + n * 16); pg8::f32x4 x = acc[ai][bj][m][n]; x[0] += bs.x; x[1] += bs.y; x[2] += bs.z; x[3] += bs.w; acc[ai][bj][m][n] = x;
                        sq += (x[0] * x[0] + x[1] * x[1]) + (x[2] * x[2] + x[3] * x[3]); }
                sq += __shfl_xor(sq, 16); sq += __shfl_xor(sq, 32);
                if (fq == 0) P[r * 4 + wc] = sq;
                asm volatile("" : "+v"(acc[ai][0][m][0]), "+v"(acc[ai][0][m][1]), "+v"(acc[ai][1][m][0]), "+v"(acc[ai][1][m][1]));
                if (m & 1) asm volatile("" ::: "memory"); }
        asm volatile("s_waitcnt lgkmcnt(0)" ::: "memory"); __builtin_amdgcn_s_barrier(); asm volatile("" ::: "memory");
        const int row = wid * 32 + (lane & 31);
        if (lane < 32) { const float tot = (P[row * 4 + 0] + P[row * 4 + 1]) + (P[row * 4 + 2] + P[row * 4 + 3]);
            __hip_atomic_store(xbuf + (size_t)(u.pm * 256 + row) * 4 + u.pn, tot, __ATOMIC_RELAXED, __HIP_MEMORY_SCOPE_AGENT); }
        asm volatile("s_waitcnt vmcnt(0)" ::: "memory");
        if (lane == 0) __hip_atomic_fetch_add(cnt + 64 * u.pm, 1u, __ATOMIC_RELAXED, __HIP_MEMORY_SCOPE_AGENT);
        if (wid == 0) {
            unsigned sp = 0u;
            while ((unsigned)__builtin_amdgcn_readfirstlane(__hip_atomic_load(cnt + 64 * u.pm, __ATOMIC_RELAXED, __HIP_MEMORY_SCOPE_AGENT)) < 32u) { __builtin_amdgcn_s_sleep(2); if (++sp > (1u << 20)) break; }
            __builtin_amdgcn_fence(__ATOMIC_ACQUIRE, "agent");
        }
        asm volatile("s_waitcnt vmcnt(0) lgkmcnt(0)" ::: "memory"); __builtin_amdgcn_s_barrier(); asm volatile("" ::: "memory");
        if (lane < 32) { const float* sl = xbuf + (size_t)(u.pm * 256 + row) * 4; float t = 0.f;
#pragma unroll
            for (int k = 0; k < 4; ++k) t += __hip_atomic_load(sl + k, __ATOMIC_RELAXED, __HIP_MEMORY_SCOPE_AGENT);
            S[row] = rsqrtf(t * (1.f / DM) + EPS); }
        asm volatile("s_waitcnt lgkmcnt(0)" ::: "memory"); __builtin_amdgcn_s_barrier(); asm volatile("" ::: "memory");
        f32x4 wq[2][2];
#pragma unroll
        for (int bj = 0; bj < 2; ++bj)
#pragma unroll
            for (int n = 0; n < 2; ++n) wq[bj][n] = *(const f32x4*)(wfin + col0 + bj * 128 + n * 16);
#pragma unroll
        for (int ai = 0; ai < 2; ++ai)
#pragma unroll
            for (int m = 0; m < 4; ++m) { const int r = ai * 128 + wr * 64 + m * 16 + fr; const float sr = S[r]; const size_t off = (size_t)(u.pm * 256 + r) * DM + col0;
#pragma unroll
                for (int bj = 0; bj < 2; ++bj)
#pragma unroll
                    for (int n = 0; n < 2; ++n) { const pg8::f32x4 x = acc[ai][bj][m][n]; const f32x4 g = wq[bj][n]; *(f32x4*)(out + off + bj * 128 + n * 16) = (f32x4){x[0] * sr * g.x, x[1] * sr * g.y, x[2] * sr * g.z, x[3] * sr * g.w}; } }
    }
};

template <int KS, int UNR, class Epi> __device__ __forceinline__ void wave_gemm64(const bf16* A, int lda, const bf16* B, int ldb, int lane, const Epi& epi) {
    const int fr = lane & 15, fq = lane >> 4;
    pg8::f32x4 acc[4][4];
#pragma unroll
    for (int jb = 0; jb < 4; ++jb)
#pragma unroll
        for (int ib = 0; ib < 4; ++ib) acc[jb][ib] = (pg8::f32x4){0.f, 0.f, 0.f, 0.f};
    const bf16* ap = A + (size_t)fr * lda + 8 * fq; const bf16* bp = B + (size_t)fr * ldb + 8 * fq;
#pragma unroll UNR
    for (int ks = 0; ks < KS; ++ks) {
        bf16x8 af[4], bv[4];
#pragma unroll
        for (int ib = 0; ib < 4; ++ib) { af[ib] = *(const bf16x8*)(ap + (size_t)(16 * ib) * lda + 32 * ks); bv[ib] = *(const bf16x8*)(bp + (size_t)(16 * ib) * ldb + 32 * ks); }
#pragma unroll
        for (int jb = 0; jb < 4; ++jb)
#pragma unroll
            for (int ib = 0; ib < 4; ++ib) acc[jb][ib] = __builtin_amdgcn_mfma_f32_16x16x32_bf16(bv[jb], af[ib], acc[jb][ib], 0, 0, 0);
    }
    epi(acc, fr, fq);
}
struct WEpiE {
    float* E;
    __device__ __forceinline__ void operator()(const pg8::f32x4 (&acc)[4][4], int fr, int fq) const {
#pragma unroll
        for (int jb = 0; jb < 4; ++jb)
#pragma unroll
            for (int ib = 0; ib < 4; ++ib) *(pg8::f32x4*)(E + (size_t)(16 * ib + fr) * 128 + 16 * jb + 4 * fq) = acc[jb][ib];
    }
};
struct WEpiS5Y {
    const bf16* SUAg; bf16* YS5; const float* dg; int chunk0, col0, g;
    __device__ __forceinline__ void operator()(const pg8::f32x4 (&acc)[4][4], int fr, int fq) const {
#pragma unroll
        for (int jb = 0; jb < 4; ++jb) { const int col = col0 + 16 * jb + 4 * fq, tt = col >> 4, h0 = col & 15; const f32x4 d4 = *(const f32x4*)(dg + h0);
#pragma unroll
            for (int ib = 0; ib < 4; ++ib) { const int chunk = chunk0 + 16 * ib + fr; const u32x2 uu = *(const u32x2*)(SUAg + (size_t)chunk * KA5 + col); const pg8::f32x4 v = acc[jb][ib];
                const float y0 = gelu_tanh(v[0] + d4.x * bflo(uu.x)), y1 = gelu_tanh(v[1] + d4.y * bfhi(uu.x)), y2 = gelu_tanh(v[2] + d4.z * bflo(uu.y)), y3 = gelu_tanh(v[3] + d4.w * bfhi(uu.y));
                u32x2 w; w.x = pk2(y0, y1); w.y = pk2(y2, y3); *(u32x2*)(YS5 + (size_t)(chunk * 32 + tt) * 256 + g * 16 + h0) = w; } }
    }
};
struct WEpiGlu {
    const bf16* YS5; bf16* G; int row0, col0;
    __device__ __forceinline__ void operator()(const pg8::f32x4 (&acc)[4][4], int fr, int fq) const {
#pragma unroll
        for (int jb = 0; jb < 4; ++jb)
#pragma unroll
            for (int ib = 0; ib < 4; ++ib) { const int row = row0 + 16 * ib + fr, col = col0 + 16 * jb + 4 * fq; const u32x2 yy = *(const u32x2*)(YS5 + (size_t)row * 256 + col); bf16* gp = G + (size_t)row * 1024 + 512 + col; const u32x2 gg = *(const u32x2*)gp; const pg8::f32x4 v = acc[jb][ib];
                const float s0 = 1.f / (1.f + __expf(-v[0])), s1 = 1.f / (1.f + __expf(-v[1])), s2 = 1.f / (1.f + __expf(-v[2])), s3 = 1.f / (1.f + __expf(-v[3]));
                u32x2 w; w.x = pk2(bflo(yy.x) * s0 * bflo(gg.x), bfhi(yy.x) * s1 * bfhi(gg.x)); w.y = pk2(bflo(yy.y) * s2 * bflo(gg.y), bfhi(yy.y) * s3 * bfhi(gg.y)); *(u32x2*)gp = w; }
    }
};

__device__ __forceinline__ void ret_upd_unit(unsigned char* ws, int unit, int lane) {
    const int c = unit & 63, bh = unit >> 6; const int i16 = lane & 15, kq = lane >> 4;
    const bf16* KT = (const bf16*)(ws + WS_RKT) + (size_t)bh * 64 * SEQ + c * 64; const bf16* VT = (const bf16*)(ws + WS_RVT) + (size_t)bh * 64 * SEQ + c * 64;
    float* UPD = (float*)(ws + WS_UPD) + (size_t)unit * 4096;
    bf16x8 af[4][2], bfv[4][2];
#pragma unroll
    for (int ib = 0; ib < 4; ++ib)
#pragma unroll
        for (int ks = 0; ks < 2; ++ks) { af[ib][ks] = *(const bf16x8*)(KT + (size_t)(16 * ib + i16) * SEQ + 32 * ks + 8 * kq); bfv[ib][ks] = *(const bf16x8*)(VT + (size_t)(16 * ib + i16) * SEQ + 32 * ks + 8 * kq); }
#pragma unroll
    for (int ib = 0; ib < 4; ++ib)
#pragma unroll
        for (int jb = 0; jb < 4; ++jb) { pg8::f32x4 d = (pg8::f32x4){0.f, 0.f, 0.f, 0.f};
            d = __builtin_amdgcn_mfma_f32_16x16x32_bf16(af[ib][0], bfv[jb][0], d, 0, 0, 0); d = __builtin_amdgcn_mfma_f32_16x16x32_bf16(af[ib][1], bfv[jb][1], d, 0, 0, 0);
            *(pg8::f32x4*)(UPD + (size_t)(16 * jb + i16) * 64 + 16 * ib + 4 * kq) = d; }
}
__device__ __forceinline__ void ret_out_unit(const Args& a, int l, int unit, int lane, bool dry = false) {
    unsigned char* ws = a.ws;
    const int c = unit & 63, bh = unit >> 6, hh = bh & 3, b = bh >> 2; const int fr = lane & 15, fq = lane >> 4;
    const size_t t0 = (size_t)b * SEQ + c * 64;
    const bf16* RQ = (const bf16*)(ws + WS_RQ) + t0 * 256 + hh * 64; const bf16* RK = (const bf16*)(ws + WS_RK) + t0 * 256 + hh * 64;
    const bf16* VT = (const bf16*)(ws + WS_RVT) + (size_t)bh * 64 * SEQ + c * 64; const bf16* ST = (const bf16*)(ws + WS_STATE) + (size_t)unit * 4096;
    const float lg = lg2_gamma(hh);
    bf16x8 qf[4][2]; pg8::f32x4 st[4][4];
#pragma unroll
    for (int nb = 0; nb < 4; ++nb)
#pragma unroll
        for (int ks = 0; ks < 2; ++ks) qf[nb][ks] = *(const bf16x8*)(RQ + (size_t)(16 * nb + fr) * 256 + 32 * ks + 8 * fq);
#pragma unroll
    for (int mb = 0; mb < 4; ++mb) { bf16x8 k0 = *(const bf16x8*)(RK + (size_t)(16 * mb + fr) * 256 + 8 * fq), k1 = *(const bf16x8*)(RK + (size_t)(16 * mb + fr) * 256 + 32 + 8 * fq);
#pragma unroll
        for (int nb = 0; nb < 4; ++nb) { pg8::f32x4 d = (pg8::f32x4){0.f, 0.f, 0.f, 0.f};
            d = __builtin_amdgcn_mfma_f32_16x16x32_bf16(k0, qf[nb][0], d, 0, 0, 0); d = __builtin_amdgcn_mfma_f32_16x16x32_bf16(k1, qf[nb][1], d, 0, 0, 0);
#pragma unroll
            for (int r = 0; r < 4; ++r) { const int mm = 16 * mb + 4 * fq + r, nn = 16 * nb + fr; const int df = mm > nn ? mm - nn : nn - mm; d[r] *= 0.125f * exp2f(lg * (float)df); }
            st[mb][nb] = d; } }
    pg8::f32x4 o[4][4];
#pragma unroll
    for (int nb = 0; nb < 4; ++nb)
#pragma unroll
        for (int dvb = 0; dvb < 4; ++dvb) o[nb][dvb] = (pg8::f32x4){0.f, 0.f, 0.f, 0.f};
#pragma unroll
    for (int dvb = 0; dvb < 4; ++dvb) { const bf16x8 s0 = *(const bf16x8*)(ST + (size_t)(16 * dvb + fr) * 64 + 8 * fq), s1 = *(const bf16x8*)(ST + (size_t)(16 * dvb + fr) * 64 + 32 + 8 * fq);
#pragma unroll
        for (int nb = 0; nb < 4; ++nb) { o[nb][dvb] = __builtin_amdgcn_mfma_f32_16x16x32_bf16(qf[nb][0], s0, o[nb][dvb], 0, 0, 0); o[nb][dvb] = __builtin_amdgcn_mfma_f32_16x16x32_bf16(qf[nb][1], s1, o[nb][dvb], 0, 0, 0); } }
#pragma unroll
    for (int nb = 0; nb < 4; ++nb)
#pragma unroll
        for (int r = 0; r < 4; ++r) { const float wq = 0.125f * exp2f(lg * (float)(16 * nb + 4 * fq + r + 1));
#pragma unroll
            for (int dvb = 0; dvb < 4; ++dvb) o[nb][dvb][r] *= wq; }
#pragma unroll
    for (int s = 0; s < 2; ++s) {
        bf16x8 pa[4];
#pragma unroll
        for (int nb = 0; nb < 4; ++nb) { u32x4 w; w.x = pk2(st[2 * s][nb][0], st[2 * s][nb][1]); w.y = pk2(st[2 * s][nb][2], st[2 * s][nb][3]); w.z = pk2(st[2 * s + 1][nb][0], st[2 * s + 1][nb][1]); w.w = pk2(st[2 * s + 1][nb][2], st[2 * s + 1][nb][3]); pa[nb] = __builtin_bit_cast(bf16x8, w); }
#pragma unroll
        for (int dvb = 0; dvb < 4; ++dvb) { const u32x2 v0 = *(const u32x2*)(VT + (size_t)(16 * dvb + fr) * SEQ + 32 * s + 4 * fq), v1 = *(const u32x2*)(VT + (size_t)(16 * dvb + fr) * SEQ + 32 * s + 16 + 4 * fq);
            const bf16x8 vf = __builtin_bit_cast(bf16x8, (u32x4){v0.x, v0.y, v1.x, v1.y});
#pragma unroll
            for (int nb = 0; nb < 4; ++nb) o[nb][dvb] = __builtin_amdgcn_mfma_f32_16x16x32_bf16(pa[nb], vf, o[nb][dvb], 0, 0, 0); }
    }
    const float* gn = a.in[13] + (size_t)l * 256 + hh * 64; float gnw[4];
#pragma unroll
    for (int dvb = 0; dvb < 4; ++dvb) gnw[dvb] = gn[16 * dvb + fr];
    bf16* Y = (bf16*)(ws + WS_GATE) + t0 * 1024 + 768 + hh * 64;
#pragma unroll
    for (int nb = 0; nb < 4; ++nb)
#pragma unroll
        for (int r = 0; r < 4; ++r) { float s = (o[nb][0][r] + o[nb][1][r]) + (o[nb][2][r] + o[nb][3][r]);
            s += __shfl_xor(s, 1); s += __shfl_xor(s, 2); s += __shfl_xor(s, 4); s += __shfl_xor(s, 8);
            const float mu = s * (1.f / 64.f); float q = 0.f;
#pragma unroll
            for (int dvb = 0; dvb < 4; ++dvb) { const float d = o[nb][dvb][r] - mu; q += d * d; }
            q += __shfl_xor(q, 1); q += __shfl_xor(q, 2); q += __shfl_xor(q, 4); q += __shfl_xor(q, 8);
            const float rstd = rsqrtf(q * (1.f / 64.f) + EPS); bf16* yp = Y + (size_t)(16 * nb + 4 * fq + r) * 1024 + fr;
#pragma unroll
            for (int dvb = 0; dvb < 4; ++dvb) { const float gt = bf2f(yp[16 * dvb]); if (!dry) yp[16 * dvb] = f2bf((o[nb][dvb][r] - mu) * rstd * gnw[dvb] * gt); } }
}

#define XB_TMO      128
#define XB_XCNT(j)  (256  + 64 * (j))
#define XB_XSUB(j)  (1280 + 64 * (j))
#define XB_XGEN(j)  (2304 + 64 * (j))
#define XB_TOP      3328
#define XB_TOPGEN   3392
#define XCD_BAR_WORDS 3456
#define XB_SPIN_CAP (1u << 18)

__device__ __forceinline__ unsigned xb_ld(unsigned* p)              { return __hip_atomic_load(p, __ATOMIC_RELAXED, __HIP_MEMORY_SCOPE_AGENT); }
__device__ __forceinline__ unsigned xb_add(unsigned* p, unsigned v) { return __hip_atomic_fetch_add(p, v, __ATOMIC_RELAXED, __HIP_MEMORY_SCOPE_AGENT); }
__device__ __forceinline__ unsigned xb_xcc_id() { return (unsigned)__builtin_amdgcn_s_getreg((3 << 11) | 20) & 0xFu; }
#define XB_SPIN(cond, bar) do { unsigned _sp = 0; while (cond) { __builtin_amdgcn_s_sleep(1); \
    if ((++_sp & 255u) == 0u) { if (xb_ld(&(bar)[XB_TMO])) break; if (_sp > XB_SPIN_CAP) { atomicAdd(&(bar)[XB_TMO], 1u); break; } } } } while (0)

struct XcdBarrier {
    unsigned* bar; unsigned x;
    volatile LAS unsigned* st;
};

__device__ __forceinline__ XcdBarrier xcd_barrier_post(unsigned* bar, volatile LAS unsigned* st) {
    XcdBarrier b; b.bar = bar; b.x = xb_xcc_id(); b.st = st;
    if (threadIdx.x == 0) (void)xb_add(&bar[XB_XCNT(b.x)], 1u);
    return b;
}
__device__ __forceinline__ void xcd_barrier_complete(unsigned* bar, unsigned x, unsigned& nloc, unsigned& nx) {
    const unsigned G = gridDim.x * gridDim.y * gridDim.z;
    unsigned sum, cnt, mine, sp = 0u;
    for (;;) {
        sum = 0u; cnt = 0u; mine = 0u;
#pragma unroll
        for (unsigned j = 0; j < 16; ++j) { const unsigned c = xb_ld(&bar[XB_XCNT(j)]); sum += c; cnt += (c > 0u) ? 1u : 0u; mine = (j == x) ? c : mine; }
        if (sum == G) break;
        __builtin_amdgcn_s_sleep(1);
        if ((++sp & 255u) == 0u) { if (xb_ld(&bar[XB_TMO])) break; if (sp > XB_SPIN_CAP) { atomicAdd(&bar[XB_TMO], 1u); break; } }
    }
    nloc = mine > 0u ? mine : 1u; nx = cnt > 0u ? cnt : 1u;
}

__device__ __forceinline__ void xcd_barrier(const XcdBarrier& b) {
    asm volatile("s_waitcnt vmcnt(0)" ::: "memory");
    __syncthreads();
    if (threadIdx.x == 0) {
        unsigned* bar = b.bar;
        __builtin_amdgcn_s_waitcnt(0);
        unsigned nloc = b.st[0], nx = b.st[1];
        if (nloc == 0u) { xcd_barrier_complete(bar, b.x, nloc, nx); b.st[0] = nloc; b.st[1] = nx; }
        const unsigned old = xb_add(&bar[XB_XSUB(b.x)], 1u);
        const unsigned gen = old / nloc;
        if (old + 1u == (gen + 1u) * nloc) {
            __builtin_amdgcn_fence(__ATOMIC_RELEASE, "agent");
            asm volatile("s_waitcnt vmcnt(0)" ::: "memory");
            const unsigned og = xb_add(&bar[XB_TOP], 1u);
            const unsigned tg = og / nx;
            if (og + 1u == (tg + 1u) * nx) xb_add(&bar[XB_TOPGEN], 1u);
            else XB_SPIN(xb_ld(&bar[XB_TOPGEN]) == tg, bar);
            __builtin_amdgcn_fence(__ATOMIC_ACQUIRE, "agent");
            xb_add(&bar[XB_XGEN(b.x)], 1u);
            asm volatile("s_waitcnt vmcnt(0)" ::: "memory");
        } else {
            XB_SPIN(xb_ld(&bar[XB_XGEN(b.x)]) == gen, bar);
            __builtin_amdgcn_fence(__ATOMIC_ACQUIRE, "agent");
            asm volatile("s_waitcnt vmcnt(0)" ::: "memory");
        }
    }
    __syncthreads();
}

#define XBAR_MAKE XcdBarrier xb_; xb_.bar = (unsigned*)args.ws; xb_.st = (volatile LAS unsigned*)((LAS unsigned char*)lds + RING_BYTES + 352); xb_.x = xb_.st[2]
#ifdef REP_SYNC
#define GSYNC() do { XBAR_MAKE; xcd_barrier(xb_); xcd_barrier(xb_); } while (0)
#else
#define GSYNC() do { XBAR_MAKE; xcd_barrier(xb_); } while (0)
#endif
#ifndef REP_P0
#define REP_P0 1
#endif
#ifndef REP_P1
#define REP_P1 1
#endif
#ifndef REP_P23
#define REP_P23 1
#endif
#ifndef REP_NORM
#define REP_NORM 1
#endif
__global__ void __launch_bounds__(NTHR, 2) mega_fwd(Args args) {
    extern __shared__ __attribute__((aligned(16))) unsigned char lds[];
    cg::grid_group grid = cg::this_grid();
    const int tid = threadIdx.x, lane = tid & 63, wave = __builtin_amdgcn_readfirstlane(tid >> 6);
    const int G = gridDim.x, bx = blockIdx.x; const int vcu = (G % 8 == 0) ? (bx % 8) * (G / 8) + bx / 8 : bx;
    const int gw = bx * NWAVES + wave, NGW = G * NWAVES;
    unsigned char* ws = args.ws;
    LAS unsigned char* ldsl = (LAS unsigned char*)lds;
    LAS float* ldsf = (LAS float*)lds;
    float* X = args.out;
    if (ws == nullptr) grid.sync();
    if (tid < 2) ((volatile LAS unsigned*)(ldsl + RING_BYTES + 352))[tid] = 0u;
    __syncthreads();
    { const XcdBarrier xb0 = xcd_barrier_post((unsigned*)ws, (volatile LAS unsigned*)(ldsl + RING_BYTES + 352)); if (tid == 0) ((volatile LAS unsigned*)(ldsl + RING_BYTES + 352))[2] = xb0.x; }
    __syncthreads();

#ifdef PROBE_T
    unsigned long long tacc_ = 0ull, tprev_ = __builtin_amdgcn_s_memrealtime();
#define TSTAMP(id) do { const unsigned long long tn_ = __builtin_amdgcn_s_memrealtime(); if ((id) == PROBE_T || ((PROBE_T) == 23 && ((id) == 2 || (id) == 3 || (id) == 5))) tacc_ += tn_ - tprev_; tprev_ = tn_; } while (0)
#else
#define TSTAMP(id) do {} while (0)
#endif
    for (int rep_ = 0; rep_ < REP_P0; ++rep_) {
        if (rep_) { __syncthreads(); }
#ifdef REP_S5P
        if (bx < 64) { s5_prep(args, bx >> 4, bx & 15, ldsf, tid); }
#endif
        if (bx < 64) { s5_prep(args, bx >> 4, bx & 15, ldsf, tid); }
        LAS float* scr = ldsf + wave * 4096;
        constexpr int I_IN = (DM / 64) * (NF / 32), I_O = (DM / 64) * (DM / 32), I_G = (256 / 64) * (256 / 32), I_L = I_IN + I_O + I_G;
#ifndef REP_TR
#define REP_TR 1
#endif
        for (int rt_ = 0; rt_ < REP_TR; ++rt_)
        for (int it = (bx < 64 ? DEPTH * I_L : (bx - 64) * NWAVES + wave); it < DEPTH * I_L; it += (G - 64) * NWAVES) {
            const int l = it / I_L; int r = it % I_L;
            if (r < I_IN) { p0_transpose_item<true>(args.in[2] + (size_t)l * DM * NIN, DM, NIN, NF, (bf16*)(ws + WS_WIN) + (size_t)l * NF * DM, scr, r, lane); continue; } r -= I_IN;
            if (r < I_O) { p0_transpose_item<false>(args.in[14] + (size_t)l * DM * DM, DM, DM, DM, (bf16*)(ws + WS_WO) + (size_t)l * DM * DM, scr, r, lane); continue; } r -= I_O;
            p0_transpose_item<false>(args.in[12] + (size_t)l * 65536, 256, 256, 256, (bf16*)(ws + WS_WGLU) + (size_t)l * 65536, scr, r, lane);
        }
        f32x2* rope = (f32x2*)(ws + WS_ROPE);
        for (int i = bx * NTHR + tid; i < SEQ * 32; i += G * NTHR) { const int pos = i >> 5, fi = i & 31; const float freq = powf(10000.f, -(float)fi / 32.f); const float ang = (float)pos * freq; float sn, cs; sincosf(ang, &sn, &cs); rope[i] = (f32x2){cs, sn}; }
        __syncthreads();
        { const int NW = (64 + 2 * (G - 64)) * NWAVES;
          if (bx < 64) norm0_phase(args, lane, bx * NWAVES + wave, NW);
          else { const int sl = 64 * NWAVES + ((bx - 64) * NWAVES + wave) * 2; norm0_phase(args, lane, sl, NW); norm0_phase(args, lane, sl + 1, NW); } }
    }
    GSYNC();
    TSTAMP(0);

#define PHASE_VARS int tid = threadIdx.x; asm volatile("" : "+v"(tid)); int bxl_ = blockIdx.x; asm volatile("" : "+s"(bxl_)); const int bx = bxl_; const int lane = tid & 63, wave = __builtin_amdgcn_readfirstlane(tid >> 6), gw = bx * NWAVES + wave; __attribute__((address_space(1))) unsigned char* wsg_ = (__attribute__((address_space(1))) unsigned char*)args.ws; asm volatile("" : "+s"(wsg_)); unsigned char* ws = (unsigned char*)wsg_; LAS unsigned char* ldsl = (LAS unsigned char*)lds; LAS float* ldsf = (LAS float*)lds; (void)lane; (void)wave; (void)gw; (void)ldsl; (void)ldsf
    for (int l = 0; l < DEPTH; ++l) {
        for (int rep_ = 0; rep_ < REP_P1; ++rep_) {
            PHASE_VARS;
            pg8::Gemm g{(const bf16*)(ws + WS_XN), (const bf16*)(ws + WS_WIN) + (size_t)l * NF * DM, M, NF, DM, DM, DM, 0, 0};
            pg8::StaticOrder S; S.init(M, NF, G, bx);
            EpiInProj E{ws, (const float*)(ws + WS_SS) + (size_t)(l & 1) * M, args.in[3] + (size_t)l * 8};
#ifdef PROBE_SPLIT
            { RangeOrder R0{S, 0, 2}, R1{S, 2, 4}; pg8::gemm_phase<EpiInProj, RangeOrder, true, true>(ldsl, g, R0, E); GSYNC(); pg8::gemm_phase<EpiInProj, RangeOrder, true, true>(ldsl, g, R1, E); }
#else
            pg8::gemm_phase<EpiInProj, pg8::StaticOrder, true, true>(ldsl, g, S, E);
#endif
            if (bx >= G / 2) flog_phase(args, l, (const float*)(ws + WS_SS) + (size_t)(l & 1) * M, ldsf, tid, lane, wave, bx - G / 2, G / 2);
        }
        GSYNC();
        TSTAMP(1);
        for (int rep_ = 0; rep_ < REP_P23; ++rep_) {
            if (rep_) __syncthreads();
            PHASE_VARS;
            if (bx < 64) {
                const int b = bx >> 4, g = bx & 15, tmL = wave & 1, tn = (wave >> 1) & 1, kh = wave >> 2;
                { const int fr = lane & 15, fq = lane >> 4;
                  const bf16* Ap = (const bf16*)(ws + WS_SUA) + ((size_t)g * NCH5 + b * 128 + tmL * 64) * KA5 + 256 * kh; const bf16* Bp = (const bf16*)(ws + WS_WB) + ((size_t)(l * 16 + g) * 128 + tn * 64) * 512 + 256 * kh;
                  struct WEpiLds { LAS float* EL; __device__ __forceinline__ void operator()(const pg8::f32x4 (&acc)[4][4], int fr_, int fq_) const {
#pragma unroll
                      for (int jb = 0; jb < 4; ++jb)
#pragma unroll
                          for (int ib = 0; ib < 4; ++ib) *(LAS pg8::f32x4*)(EL + (16 * ib + fr_) * 128 + 16 * jb + 4 * fq_) = acc[jb][ib]; } };
                  WEpiLds E{ldsf + (size_t)(kh * 128 + tmL * 64) * 128 + tn * 64}; (void)fr; (void)fq;
                  wave_gemm64<8, 4, WEpiLds>(Ap, KA5, Bp, 512, lane, E); }
                __syncthreads();
                const int p = tid & 63, seg = tid >> 6;
                const float* LAM = (const float*)(ws + WS_LAM) + (size_t)(l * 16 + g) * 128; const float lr = LAM[p], li = LAM[64 + p];
                bf16* SA = (bf16*)(ws + WS_SUA) + ((size_t)g * NCH5 + b * 128 + seg * 16) * KA5 + 512 + p;
                float er[16], ei[16];
#pragma unroll
                for (int i = 0; i < 16; ++i) { const int r = (seg * 16 + i) * 128; er[i] = ldsf[r + p] + ldsf[16384 + r + p]; ei[i] = ldsf[r + 64 + p] + ldsf[16384 + r + 64 + p]; }
                float sr = 0.f, si = 0.f;
#pragma unroll
                for (int i = 0; i < 16; ++i) { const float nr = lr * sr - li * si + er[i], ni = lr * si + li * sr + ei[i]; sr = nr; si = ni; }
                LAS float* ends = ldsf + (RING_BYTES + 1024) / 4;
                ends[(seg * 64 + p) * 2] = sr; ends[(seg * 64 + p) * 2 + 1] = si;
                float pr = lr, pi = li;
#pragma unroll
                for (int i = 0; i < 4; ++i) { const float nr = pr * pr - pi * pi, ni = 2.f * pr * pi; pr = nr; pi = ni; }
                __syncthreads();
                float cr = 0.f, ci = 0.f;
                for (int s2 = 0; s2 < seg; ++s2) { const float xr = ends[(s2 * 64 + p) * 2], xi = ends[(s2 * 64 + p) * 2 + 1]; const float nr = pr * cr - pi * ci + xr, ni = pr * ci + pi * cr + xi; cr = nr; ci = ni; }
#pragma unroll
                for (int i = 0; i < 16; ++i) { SA[(size_t)i * KA5] = f2bf(cr); SA[(size_t)i * KA5 + 64] = f2bf(ci); const float nr = lr * cr - li * ci + er[i], ni = lr * ci + li * cr + ei[i]; cr = nr; ci = ni; }
            } else if (bx < 192) {
                const int idx = bx - 64, bh = idx >> 3, dvs = (idx >> 1) & 3, dkh = idx & 1, fr = lane & 15, fq = lane >> 4; const float g64 = exp2f(lg2_gamma(bh & 3) * 64.f);
                const bf16* KT = (const bf16*)(ws + WS_RKT) + ((size_t)bh * 64 + 32 * dkh + fr) * SEQ + 8 * fq; const bf16* VT = (const bf16*)(ws + WS_RVT) + ((size_t)bh * 64 + 16 * dvs + fr) * SEQ + 8 * fq;
                pg8::f32x4 u[8][2];
#pragma unroll
                for (int i2 = 0; i2 < 2; ++i2) {
                    bf16x8 vf[4][2], kf[4][2][2];
#pragma unroll
                    for (int i1 = 0; i1 < 4; ++i1) { const int c = 8 * wave + 4 * i2 + i1; vf[i1][0] = *(const bf16x8*)(VT + c * 64); vf[i1][1] = *(const bf16x8*)(VT + c * 64 + 32);
#pragma unroll
                        for (int ib = 0; ib < 2; ++ib) { kf[i1][ib][0] = *(const bf16x8*)(KT + (size_t)(16 * ib) * SEQ + c * 64); kf[i1][ib][1] = *(const bf16x8*)(KT + (size_t)(16 * ib) * SEQ + c * 64 + 32); } }
#pragma unroll
                    for (int i1 = 0; i1 < 4; ++i1)
#pragma unroll
                        for (int ib = 0; ib < 2; ++ib) { pg8::f32x4 d = (pg8::f32x4){0.f, 0.f, 0.f, 0.f}; d = __builtin_amdgcn_mfma_f32_16x16x32_bf16(kf[i1][ib][0], vf[i1][0], d, 0, 0, 0); d = __builtin_amdgcn_mfma_f32_16x16x32_bf16(kf[i1][ib][1], vf[i1][1], d, 0, 0, 0); u[4 * i2 + i1][ib] = d; }
                }
                pg8::f32x4 e4[2];
#pragma unroll
                for (int ib = 0; ib < 2; ++ib) e4[ib] = (pg8::f32x4){0.f, 0.f, 0.f, 0.f};
#pragma unroll
                for (int i = 0; i < 8; ++i)
#pragma unroll
                    for (int ib = 0; ib < 2; ++ib) e4[ib] = e4[ib] * g64 + u[i][ib];
                LAS pg8::f32x4* ends = (LAS pg8::f32x4*)ldsf;
#pragma unroll
                for (int ib = 0; ib < 2; ++ib) ends[(wave * 2 + ib) * 64 + lane] = e4[ib];
                float g8 = g64; g8 = g8 * g8; g8 = g8 * g8; g8 = g8 * g8;
                __syncthreads();
                pg8::f32x4 st[2];
#pragma unroll
                for (int ib = 0; ib < 2; ++ib) st[ib] = (pg8::f32x4){0.f, 0.f, 0.f, 0.f};
                for (int w2 = 0; w2 < wave; ++w2)
#pragma unroll
                    for (int ib = 0; ib < 2; ++ib) st[ib] = st[ib] * g8 + ends[(w2 * 2 + ib) * 64 + lane];
                bf16* ST = (bf16*)(ws + WS_STATE) + (size_t)(bh * 64 + 8 * wave) * 4096 + (size_t)(16 * dvs + fr) * 64 + 32 * dkh + 4 * fq;
#pragma unroll
                for (int i = 0; i < 8; ++i)
#pragma unroll
                    for (int ib = 0; ib < 2; ++ib) { u32x2 w; w.x = pk2(st[ib][0], st[ib][1]); w.y = pk2(st[ib][2], st[ib][3]); *(u32x2*)(ST + (size_t)i * 4096 + 16 * ib) = w; st[ib] = st[ib] * g64 + u[i][ib]; }
            } else if (bx < 224) {
                const int bh = bx - 192; const float* lf = (const float*)(ws + WS_LOGF) + (size_t)bh * SEQ; float* cb = (float*)(ws + WS_CB) + (size_t)bh * SEQ;
                const f32x4 a0 = *(const f32x4*)(lf + tid * 8), a1 = *(const f32x4*)(lf + tid * 8 + 4); float v[8] = {a0.x, a0.y, a0.z, a0.w, a1.x, a1.y, a1.z, a1.w};
#pragma unroll
                for (int e = 1; e < 8; ++e) v[e] += v[e - 1];
                float tot = v[7];
#pragma unroll
                for (int o = 1; o < 64; o <<= 1) { const float t = __shfl_up(tot, o); if (lane >= o) tot += t; }
                if (lane == 63) ldsf[wave] = tot;
                __syncthreads();
                float off = tot - v[7];
                for (int w = 0; w < wave; ++w) off += ldsf[w];
                f32x4 o0, o1; o0.x = -(v[0] + off) * LOG2E; o0.y = -(v[1] + off) * LOG2E; o0.z = -(v[2] + off) * LOG2E; o0.w = -(v[3] + off) * LOG2E; o1.x = -(v[4] + off) * LOG2E; o1.y = -(v[5] + off) * LOG2E; o1.z = -(v[6] + off) * LOG2E; o1.w = -(v[7] + off) * LOG2E;
                *(f32x4*)(cb + tid * 8) = o0; *(f32x4*)(cb + tid * 8 + 4) = o1;
            } else { const int idx = (bx - 224) * NTHR + tid; if (idx < M) ((float*)(ws + WS_SS))[(size_t)((l + 1) & 1) * M + idx] = 0.f;
                const int bh = bx - 224, b = bh >> 3, h = bh & 7, rsub = lane >> 3, part = lane & 7;
                const bf16* Qp = (const bf16*)(ws + WS_QO) + ((size_t)b * SEQ + wave * 512 + rsub) * 512 + h * 64 + part * 8; const bf16* Kp = (const bf16*)(ws + WS_KB) + ((size_t)b * SEQ + wave * 512 + rsub) * 512 + h * 64 + part * 8;
                float qm = 0.f, km = 0.f;
#pragma unroll 8
                for (int it = 0; it < 64; ++it) { const u32x4 qv = *(const u32x4*)(Qp + (size_t)it * 8 * 512), kv = *(const u32x4*)(Kp + (size_t)it * 8 * 512); float sq = 0.f, sk = 0.f;
#pragma unroll
                    for (int e = 0; e < 4; ++e) { const float a0 = bflo(qv[e]), a1 = bfhi(qv[e]), c0 = bflo(kv[e]), c1 = bfhi(kv[e]); sq += a0 * a0 + a1 * a1; sk += c0 * c0 + c1 * c1; }
                    sq += __shfl_xor(sq, 1); sq += __shfl_xor(sq, 2); sq += __shfl_xor(sq, 4); sk += __shfl_xor(sk, 1); sk += __shfl_xor(sk, 2); sk += __shfl_xor(sk, 4);
                    qm = fmaxf(qm, sq); km = fmaxf(km, sk); }
#pragma unroll
                for (int o = 8; o < 64; o <<= 1) { qm = fmaxf(qm, __shfl_xor(qm, o)); km = fmaxf(km, __shfl_xor(km, o)); }
                if (lane == 0) { ldsf[wave * 2] = qm; ldsf[wave * 2 + 1] = km; }
                __syncthreads();
                if (tid == 0) { float a = 0.f, c = 0.f; for (int w = 0; w < NWAVES; ++w) { a = fmaxf(a, ldsf[2 * w]); c = fmaxf(c, ldsf[2 * w + 1]); } ((float*)(ws + WS_NRM))[bh] = sqrtf(a) * sqrtf(c) * 1.0001f; }
            }
        }
        GSYNC();
        TSTAMP(3);
        {
            PHASE_VARS;
            if (wave < 4) ret_out_unit(args, l, wave * 256 + bx, lane);
            else {
                const int t = (wave - 4) * 256 + bx, g = t >> 6, r = t & 63, tm = r >> 3, tn = r & 7;
                const bf16* SUAg = (const bf16*)(ws + WS_SUA) + (size_t)g * NCH5 * KA5;
                WEpiS5Y E{SUAg, (bf16*)(ws + WS_YS5), args.in[10] + (size_t)l * 256 + g * 16, tm * 64, tn * 64, g};
                wave_gemm64<20, 4, WEpiS5Y>(SUAg + (size_t)(tm * 64) * KA5, KA5, (const bf16*)(ws + WS_MF) + ((size_t)(l * 16 + g) * 512 + tn * 64) * KA5, KA5, lane, E);
            }
            __syncthreads();
            const attn_body::AttnTensors AT{(const attn_body::bf16*)(ws + WS_QO), (const attn_body::bf16*)(ws + WS_KB), (const attn_body::bf16*)(ws + WS_VB), (attn_body::bf16*)(ws + WS_GATE), (const float*)(ws + WS_CB), (const float*)(ws + WS_NRM)};
            const attn_body::StaticOrder S(G, bx);
#ifdef REP_ATTN
            attn_body::attn_phase<attn_body::StaticOrder>((char*)lds, AT, S, opaque_true());
#endif
            attn_body::attn_phase<attn_body::StaticOrder>((char*)lds, AT, S);
        }
        GSYNC();
        TSTAMP(4);
        {
            PHASE_VARS;
            if (wave < 4) {
                const int t = wave * 256 + bx, tm = t >> 2, tn = t & 3;
                WEpiGlu E{(const bf16*)(ws + WS_YS5), (bf16*)(ws + WS_GATE), tm * 64, tn * 64};
                wave_gemm64<8, 4, WEpiGlu>((const bf16*)(ws + WS_YS5) + (size_t)(tm * 64) * 256, 256, (const bf16*)(ws + WS_WGLU) + (size_t)l * 65536 + (size_t)(tn * 64) * 256, 256, lane, E);
            }
        }
        GSYNC();
        TSTAMP(5);
        {
            PHASE_VARS;
            pg8::Gemm g{(const bf16*)(ws + WS_GATE), (const bf16*)(ws + WS_WO) + (size_t)l * DM * DM, M, DM, DM, DM, DM, 0, 0};
            pg8::StaticOrder S; S.init(M, DM, G, bx);
#ifdef REP_P6
            { EpiOut E0{l == 0 ? args.in[0] : X, X, (float*)(ws + WS_SS) + (size_t)((l + 1) & 1) * M, (bf16*)(ws + WS_XN), (l + 1 < DEPTH) ? args.in[1] + (size_t)(l + 1) * DM : nullptr, opaque_true()}; pg8::gemm_phase<EpiOut, pg8::StaticOrder, true, true>(ldsl, g, S, E0); }
#endif
            if (l + 1 < DEPTH) {
                EpiOut E{l == 0 ? args.in[0] : X, X, (float*)(ws + WS_SS) + (size_t)((l + 1) & 1) * M, (bf16*)(ws + WS_XN), args.in[1] + (size_t)(l + 1) * DM, false};
                pg8::gemm_phase<EpiOut, pg8::StaticOrder, true, true>(ldsl, g, S, E);
            } else {
                EpiOutFinal E{X, X, args.in[15], (float*)(ws + WS_XBUF), (unsigned*)ws + 4096};
                pg8::gemm_phase<EpiOutFinal, pg8::StaticOrder, false, true>(ldsl, g, S, E);
            }
        }
        if (l + 1 < DEPTH) GSYNC();
        TSTAMP(6);
    }
}

extern "C" void kernel_launch(void* const* d_in, const int* in_sizes, int n_in, void* d_out, int out_size, void* d_ws, size_t ws_size, hipStream_t stream) {
    static int grid = 0;
    if (grid == 0) {
        if (n_in != 16 || ws_size < WS_END) { fprintf(stderr, "kernel_launch: unexpected n_in %d / ws %zu\n", n_in, ws_size); grid = -1; return; }
        int dev = 0, cus = 0, per_cu = 0;
        hipGetDevice(&dev); hipDeviceGetAttribute(&cus, hipDeviceAttributeMultiprocessorCount, dev);
        if (hipFuncSetAttribute((const void*)mega_fwd, hipFuncAttributeMaxDynamicSharedMemorySize, LDS_BYTES) != hipSuccess) { fprintf(stderr, "kernel_launch: hipFuncSetAttribute failed\n"); grid = -1; return; }
        if (hipOccupancyMaxActiveBlocksPerMultiprocessor(&per_cu, (const void*)mega_fwd, NTHR, LDS_BYTES) != hipSuccess || per_cu < 1) { fprintf(stderr, "kernel_launch: occupancy query failed (%d)\n", per_cu); grid = -1; return; }
        grid = cus;
        if (grid != 256) fprintf(stderr, "kernel_launch: note: %d CUs\n", grid);
    }
    if (grid < 0) return;
    if (hipMemsetAsync(d_ws, 0, 32768, stream) != hipSuccess) { fprintf(stderr, "kernel_launch: hipMemsetAsync failed\n"); return; }
    Args a{};
    for (int i = 0; i < 16; ++i) a.in[i] = (const float*)d_in[i];
    a.out = (float*)d_out; a.ws = (unsigned char*)d_ws;
    void* kargs[] = {&a};
    hipError_t e = hipLaunchCooperativeKernel((const void*)mega_fwd, dim3(grid), dim3(NTHR), kargs, LDS_BYTES, stream);
    if (e != hipSuccess) fprintf(stderr, "kernel_launch: cooperative launch failed: %s\n", hipGetErrorString(e));
}
```

```cpp
#include <hip/hip_runtime.h>
#include <cstdio>
#include <cstdint>
namespace pg8 {
#define PG8_LAS __attribute__((address_space(3)))
typedef unsigned short bf16_t;
typedef short bf16x8 __attribute__((ext_vector_type(8)));
typedef float f32x4 __attribute__((ext_vector_type(4)));
typedef unsigned u32x4 __attribute__((ext_vector_type(4)));
constexpr int BM = 256, BK = 64, HALF = 128, HTB = HALF * BK * 2  , STAGE_BYTES = 8 * HTB, NXCD = 8, WGM = 4;

__host__ __device__ __forceinline__ int lds_byte(int r, int c) { const int st = (r >> 4) * 2 + (c >> 5), rr = r & 15, cc = c & 31, ob = rr * 64 + cc * 2; return st * 1024 + (ob ^ (((ob >> 9) & 1) << 5)); }
__host__ __device__ __forceinline__ void stage_rc(int b, int& R, int& C) { const int st = b / 1024, sb = b % 1024, swz = sb ^ (((sb >> 9) & 1) << 5); R = (st >> 1) * 16 + swz / 64; C = (st & 1) * 32 + (swz % 64) / 2; }
__host__ __device__ __forceinline__ int perm32(int rho) { const int n = rho >> 4, i = rho & 15; return 8 * (i >> 2) + 4 * n + (i & 3); }

struct Unit { int pm, pn, gz; };
struct Gemm { const bf16_t* A; const bf16_t* Bt; int M, N, K; int lda, ldb; size_t gsA, gsB; };

struct StaticOrder {
    int nM, nN, nwg, G, c;
    __host__ __device__ void init(int M, int N, int G_, int c_) { nM = M / BM; nN = N / BM; nwg = nM * nN; G = G_; c = c_; }
    __host__ __device__ bool next(int i, Unit& u) const {
        const long L = (long)i * G + c; if (L >= nwg) return false;
        int wgid = (int)L; { const int q = nwg / NXCD, r = nwg % NXCD, xcd = wgid % NXCD, off = wgid / NXCD; wgid = (xcd < r ? xcd * (q + 1) : r * (q + 1) + (xcd - r) * q) + off; }
        const int nig = WGM * nN, gid = wgid / nig, fm = gid * WGM, gsz = (nM - fm) < WGM ? (nM - fm) : WGM;
        u.pm = fm + ((wgid % nig) % gsz); u.pn = (wgid % nig) / gsz; u.gz = 0; return true;
    }
    __device__ __forceinline__ void a_ready(const Unit&) const {}
    __device__ __forceinline__ void done(const Unit&) const {}
};

__device__ __forceinline__ unsigned cvt_pk_bf16(float lo, float hi) { unsigned r; asm volatile("v_cvt_pk_bf16_f32 %0, %1, %2" : "=v"(r) : "v"(lo), "v"(hi)); return r; }
typedef float f32x2 __attribute__((ext_vector_type(2)));
__device__ __forceinline__ f32x2 gelu_pk(f32x2 v) {
    const f32x2 av = __builtin_elementwise_abs(v), d = av * 0.2316418882f + 1.0f;
    f32x2 t; t.x = __builtin_amdgcn_rcpf(d.x); t.y = __builtin_amdgcn_rcpf(d.y);
    f32x2 q = t * 0.5307027145f + (-0.7265760135f); q = q * t + 0.7107068705f; q = q * t + (-0.142248368f); q = q * t + 0.127414796f; q = q * t;
    const f32x2 s = (v * v) * (-0.72134752044f);
    f32x2 e; e.x = __builtin_amdgcn_exp2f(s.x); e.y = __builtin_amdgcn_exp2f(s.y);
    const f32x2 m = v * (q * e), r = v - m;
    f32x2 o; o.x = v.x < 0.f ? m.x : r.x; o.y = v.y < 0.f ? m.y : r.y; return o;
}

template <class Epi, class Sched, bool ALIGN_EPI = false, bool SP2 = false>
__device__ __forceinline__ void gemm_phase(PG8_LAS unsigned char* lds, const Gemm g, const Sched& S, const Epi& E) {
    int tid_ = threadIdx.x; asm volatile("" : "+v"(tid_));
    const int tid = tid_, wid = __builtin_amdgcn_readfirstlane(tid >> 6), lane = tid & 63, wr = wid >> 2, wc = wid & 3, fr = lane & 15, fq = lane >> 4;
    const int K = g.K, nt = K / BK;
    unsigned voffA[2], voffB[2];
#pragma unroll
    for (int i = 0; i < 2; ++i) { int R, C; stage_rc(tid * 16 + i * 8192, R, C); const int Rb = Epi::PERM ? ((R & ~31) + perm32(R & 31)) : R;
        voffA[i] = (unsigned)(R * g.lda + C) * 2u; voffB[i] = (unsigned)(Rb * g.ldb + C) * 2u; }
    const size_t kstep = (size_t)(BK * 2);
    const size_t hstepA = (size_t)HALF * g.lda * 2, hstepB = (size_t)HALF * g.ldb * 2;
    const size_t tstepA = 2 * hstepA, tstepB = 2 * hstepB;
    const unsigned ldsw = (unsigned)wid * 1024u;
    const int aoff = lds_byte(wr * 64 + fr, fq * 8), boff = lds_byte(wc * 32 + fr, fq * 8);
#define PG8_SA(b, h) (((b) * 2 + (h)) * HTB)
#define PG8_SB(b, h) ((4 + (b) * 2 + (h)) * HTB)
#define PG8_STAGE(bufoff, gbase, voff) do { _Pragma("unroll") for (int _i = 0; _i < 2; ++_i) \
        __builtin_amdgcn_global_load_lds((const unsigned*)((const char*)(gbase) + (voff)[_i]), (PG8_LAS unsigned*)(lds + (bufoff) + ldsw + _i * 8192), 16, 0, 0); } while (0)
#define PG8_LDA(dst, b, h) do { _Pragma("unroll") for (int m = 0; m < 4; ++m) _Pragma("unroll") for (int k = 0; k < 2; ++k) dst[m][k] = *(const PG8_LAS bf16x8*)(lds + PG8_SA(b, h) + aoff + m * 2048 + k * 1024); } while (0)
#define PG8_LDB(dst, b, h) do { _Pragma("unroll") for (int n = 0; n < 2; ++n) _Pragma("unroll") for (int k = 0; k < 2; ++k) dst[n][k] = *(const PG8_LAS bf16x8*)(lds + PG8_SB(b, h) + boff + n * 2048 + k * 1024); } while (0)
#define PG8_MMA(ai, bj, At, Bt) do { __builtin_amdgcn_s_setprio(1); _Pragma("unroll") for (int m = 0; m < 4; ++m) _Pragma("unroll") for (int n = 0; n < 2; ++n) _Pragma("unroll") for (int k = 0; k < 2; ++k) \
        acc[ai][bj][m][n] = __builtin_amdgcn_mfma_f32_16x16x32_bf16(Bt[n][k], At[m][k], acc[ai][bj][m][n], 0, 0, 0); __builtin_amdgcn_s_setprio(0); } while (0)
#define PG8_WAIT_V(n) asm volatile("s_waitcnt vmcnt(" #n ")" ::: "memory")
#define PG8_WAIT_L(n) asm volatile("s_waitcnt lgkmcnt(" #n ")" ::: "memory")
#define PG8_BAR __builtin_amdgcn_s_barrier()
#define PG8_SCHED __builtin_amdgcn_sched_barrier(0)
    Unit cur, nxt; int ui = 0;
    if (!S.next(0, cur)) return;
    f32x4 acc[2][2][4][2];
#pragma unroll
    for (int a = 0; a < 2; ++a)
#pragma unroll
        for (int b = 0; b < 2; ++b)
#pragma unroll
            for (int m = 0; m < 4; ++m)
#pragma unroll
                for (int n = 0; n < 2; ++n) acc[a][b][m][n] = (f32x4){0.f, 0.f, 0.f, 0.f};
    bf16x8 At[4][2], B0[2][2], B1[2][2];
    const char* cA = (const char*)g.A + (size_t)cur.gz * g.gsA * 2 + (size_t)cur.pm * tstepA; const char* cB = (const char*)g.Bt + (size_t)cur.gz * g.gsB * 2 + (size_t)cur.pn * tstepB;
    S.a_ready(cur);
    if constexpr (SP2) {
        PG8_STAGE(PG8_SB(0, 0), cB, voffB); PG8_STAGE(PG8_SB(0, 1), cB + hstepB, voffB); PG8_STAGE(PG8_SA(0, 0), cA, voffA); PG8_STAGE(PG8_SA(0, 1), cA + hstepA, voffA);
        if (wr == 1) PG8_BAR;
        PG8_WAIT_V(2); PG8_BAR;
        PG8_STAGE(PG8_SB(1, 0), cB + kstep, voffB); PG8_STAGE(PG8_SA(1, 0), cA + kstep, voffA); PG8_STAGE(PG8_SB(1, 1), cB + hstepB + kstep, voffB);
        PG8_WAIT_V(6); PG8_BAR;
    } else {
        PG8_STAGE(PG8_SB(0, 0), cB, voffB); PG8_STAGE(PG8_SA(0, 0), cA, voffA); PG8_STAGE(PG8_SB(0, 1), cB + hstepB, voffB); PG8_STAGE(PG8_SA(0, 1), cA + hstepA, voffA);
        if (wr == 1) PG8_BAR;
        PG8_WAIT_V(4); PG8_BAR;
        PG8_STAGE(PG8_SB(1, 0), cB + kstep, voffB); PG8_STAGE(PG8_SA(1, 0), cA + kstep, voffA); PG8_STAGE(PG8_SB(1, 1), cB + hstepB + kstep, voffB);
        PG8_WAIT_V(6); PG8_BAR;
    }
    for (;;) {
        const bool has_next = S.next(ui + 1, nxt);
        const char* nA = has_next ? (const char*)g.A + (size_t)nxt.gz * g.gsA * 2 + (size_t)nxt.pm * tstepA : cA; const char* nB = has_next ? (const char*)g.Bt + (size_t)nxt.gz * g.gsB * 2 + (size_t)nxt.pn * tstepB : cB;
        for (int t = 0; t < nt; t += 2) {
            const bool last = (t == nt - 2);
            const char* a1 = cA + (size_t)(t + 1) * kstep;
            const char* a2 = last ? nA : cA + (size_t)(t + 2) * kstep; const char* b2 = last ? nB : cB + (size_t)(t + 2) * kstep;
            const char* a3 = a2 + kstep; const char* b3 = b2 + kstep;
            if (last && has_next) S.a_ready(nxt);
            if constexpr (SP2) {
            PG8_LDB(B0, 0, 0); PG8_LDB(B1, 0, 1); PG8_SCHED; PG8_LDA(At, 0, 0); PG8_STAGE(PG8_SA(1, 1), a1 + hstepA, voffA);
            PG8_WAIT_V(8); PG8_WAIT_L(0); PG8_BAR; PG8_MMA(0, 0, At, B0); PG8_MMA(0, 1, At, B1); PG8_BAR; PG8_SCHED;
            PG8_LDA(At, 0, 1); PG8_STAGE(PG8_SB(0, 0), b2, voffB); PG8_STAGE(PG8_SB(0, 1), b2 + hstepB, voffB); PG8_STAGE(PG8_SA(0, 0), a2, voffA);
            PG8_WAIT_V(8); PG8_WAIT_L(0); PG8_BAR; PG8_MMA(1, 0, At, B0); PG8_MMA(1, 1, At, B1); PG8_BAR; PG8_SCHED;
            PG8_LDB(B0, 1, 0); PG8_LDB(B1, 1, 1); PG8_SCHED; PG8_LDA(At, 1, 0); PG8_STAGE(PG8_SA(0, 1), a2 + hstepA, voffA);
            PG8_WAIT_V(8); PG8_WAIT_L(0); PG8_BAR; PG8_MMA(0, 0, At, B0); PG8_MMA(0, 1, At, B1); PG8_BAR; PG8_SCHED;
            PG8_LDA(At, 1, 1); PG8_STAGE(PG8_SB(1, 0), b3, voffB); PG8_STAGE(PG8_SB(1, 1), b3 + hstepB, voffB); PG8_STAGE(PG8_SA(1, 0), a3, voffA);
            PG8_WAIT_V(8); PG8_WAIT_L(0); PG8_BAR; PG8_MMA(1, 0, At, B0); PG8_MMA(1, 1, At, B1); PG8_BAR; PG8_SCHED;
            } else {
            PG8_LDB(B0, 0, 0); PG8_SCHED; PG8_LDA(At, 0, 0); PG8_STAGE(PG8_SA(1, 1), a1 + hstepA, voffA);
            PG8_WAIT_L(8); PG8_BAR; PG8_WAIT_L(0); PG8_MMA(0, 0, At, B0); PG8_BAR; PG8_SCHED;
            PG8_LDB(B1, 0, 1); PG8_STAGE(PG8_SB(0, 0), b2, voffB);
            PG8_BAR; PG8_WAIT_L(0); PG8_MMA(0, 1, At, B1); PG8_BAR;
            PG8_LDA(At, 0, 1); PG8_STAGE(PG8_SA(0, 0), a2, voffA);
            PG8_BAR; PG8_WAIT_L(0); PG8_MMA(1, 0, At, B0); PG8_BAR; PG8_SCHED;
            PG8_STAGE(PG8_SB(0, 1), b2 + hstepB, voffB);
            PG8_WAIT_V(6); PG8_BAR; PG8_MMA(1, 1, At, B1); PG8_BAR;
            PG8_LDB(B0, 1, 0); PG8_SCHED; PG8_LDA(At, 1, 0); PG8_STAGE(PG8_SA(0, 1), a2 + hstepA, voffA);
            PG8_WAIT_L(8); PG8_BAR; PG8_WAIT_L(0); PG8_MMA(0, 0, At, B0); PG8_BAR; PG8_SCHED;
            PG8_LDB(B1, 1, 1); PG8_STAGE(PG8_SB(1, 0), b3, voffB);
            PG8_BAR; PG8_WAIT_L(0); PG8_MMA(0, 1, At, B1); PG8_BAR;
            PG8_LDA(At, 1, 1); PG8_STAGE(PG8_SA(1, 0), a3, voffA);
            PG8_BAR; PG8_WAIT_L(0); PG8_MMA(1, 0, At, B0); PG8_BAR; PG8_SCHED;
            PG8_STAGE(PG8_SB(1, 1), b3 + hstepB, voffB);
            PG8_WAIT_V(6); PG8_BAR; PG8_MMA(1, 1, At, B1); PG8_BAR;
            }
        }
        if constexpr (ALIGN_EPI) { if (wr == 0) PG8_BAR; }
        if constexpr (!Epi::AFTER_DRAIN) { E(acc, cur, wr, wc, fr, fq); S.done(cur); }
        if (!has_next) break;
#pragma unroll
        for (int a = 0; a < 2; ++a)
#pragma unroll
            for (int b = 0; b < 2; ++b)
#pragma unroll
                for (int m = 0; m < 4; ++m)
#pragma unroll
                    for (int n = 0; n < 2; ++n) acc[a][b][m][n] = (f32x4){0.f, 0.f, 0.f, 0.f};
        cur = nxt; cA = nA; cB = nB; ++ui;
        if constexpr (ALIGN_EPI) { if (wr == 1) PG8_BAR; }
    }
    PG8_WAIT_V(0);
    if constexpr (!ALIGN_EPI) { if (wr == 0) PG8_BAR; }
    PG8_BAR;
    if constexpr (Epi::AFTER_DRAIN) { E.fused(acc, cur, wr, wc, fr, fq, lds, wid, lane); S.done(cur); }
#undef PG8_SA
#undef PG8_SB
#undef PG8_STAGE
#undef PG8_LDA
#undef PG8_LDB
#undef PG8_MMA
#undef PG8_WAIT_V
#undef PG8_WAIT_L
#undef PG8_BAR
#undef PG8_SCHED
}
}
#include <hip/hip_bf16.h>
#include <cmath>
namespace attn_body {
using bf16=__hip_bfloat16;
using bf16x8=__attribute__((ext_vector_type(8)))short;
using s16x4=__attribute__((ext_vector_type(4)))short;
using f32x16=__attribute__((ext_vector_type(16)))float;
using u32x4=__attribute__((ext_vector_type(4)))unsigned;
using f32x4=__attribute__((ext_vector_type(4)))float;
constexpr int BATCH=4,NHEAD=8,SEQ=4096,D=64,DM=NHEAD*D,OPITCH=1024;
constexpr int NW=8,QBLK=32,QB=QBLK*NW,KVBLK=64,NQB=SEQ/QB;
constexpr int ATTN_PITCH=DM, ATTN_UNIT_ROWS=QB;
__device__ __forceinline__ int crow(int r,int hi){return (r&3)+8*(r>>2)+4*hi;}
#define SBAR() __builtin_amdgcn_sched_barrier(0)
__device__ __forceinline__ void cmask(f32x16&p0,f32x16&p1,int jb,int qrel,int hi){
  const float NEG=-INFINITY; int kb=64*jb+4*hi;
  #pragma unroll
  for(int r=0;r<16;++r){int kv=kb+(r&3)+8*(r>>2); if(kv>qrel)p0[r]=NEG; if(kv+32>qrel)p1[r]=NEG;}
}

constexpr int NSLOT=3, SLOTB=8192;
constexpr int LDS_K=0, LDS_V=NSLOT*SLOTB, LDS_WS=2*NSLOT*SLOTB, LDS_OST=LDS_WS+NW*64*4, LDS_CB=LDS_OST+NW*4096, LDS_BYTES=LDS_CB+SEQ*4;
constexpr float C2=0.125f*1.4426950408889634f;
__device__ __forceinline__ void glds16(const void*gsrc,unsigned lds_dst){unsigned keep;
  asm volatile("s_mov_b32 %0, m0\n\ts_mov_b32 m0, %2\n\ts_nop 0\n\tglobal_load_lds_dwordx4 %1, off\n\ts_mov_b32 m0, %0":"=&s"(keep):"v"(gsrc),"s"(lds_dst):"memory");}
__device__ __forceinline__ float max3f(float a,float b,float c){float r;asm("v_max3_f32 %0, %1, %2, %3":"=v"(r):"v"(a),"v"(b),"v"(c));return r;}
__device__ __forceinline__ float max2f(float a,float b){float r;asm("v_max_f32_e32 %0, %1, %2":"=v"(r):"v"(a),"v"(b));return r;}
__device__ __forceinline__ float fadd_s(float a,float b){float r;asm("v_add_f32_e32 %0, %1, %2":"=v"(r):"v"(a),"v"(b));return r;}
__device__ __forceinline__ float fsub_s(float a,float b){float r;asm("v_sub_f32_e32 %0, %1, %2":"=v"(r):"v"(a),"v"(b));return r;}
typedef float f32x2_t __attribute__((ext_vector_type(2))); typedef __bf16 bf16x2_t __attribute__((ext_vector_type(2)));
__device__ __forceinline__ unsigned cvtpk_s(float lo,float hi){f32x2_t v={lo,hi};bf16x2_t b=__builtin_convertvector(v,bf16x2_t);return __builtin_bit_cast(unsigned,b);}
#define WAIT_BAR(N) asm volatile("s_waitcnt vmcnt(" #N ") lgkmcnt(0)\n\ts_barrier":::"memory")

__device__ __forceinline__ void qkt(f32x16&p0,f32x16&p1,const char*Kslot,const bf16x8*qr,const char*cbt,int r32,int hi){
  const char*kb=Kslot+hi*1024+r32*16;
  #pragma unroll
  for(int a=0;a<4;++a){ const f32x4 u0=*reinterpret_cast<const f32x4*>(cbt+hi*16+a*32), u1=*reinterpret_cast<const f32x4*>(cbt+128+hi*16+a*32);
    p0[4*a]=u0[0];p0[4*a+1]=u0[1];p0[4*a+2]=u0[2];p0[4*a+3]=u0[3]; p1[4*a]=u1[0];p1[4*a+1]=u1[1];p1[4*a+2]=u1[2];p1[4*a+3]=u1[3]; }
  #pragma unroll
  for(int d0=0;d0<4;++d0){
    const bf16x8 b0=*reinterpret_cast<const bf16x8*>(kb+d0*2048);
    const bf16x8 b1=*reinterpret_cast<const bf16x8*>(kb+d0*2048+512);
    p0=__builtin_amdgcn_mfma_f32_32x32x16_bf16(b0,qr[d0],p0,0,0,0);p1=__builtin_amdgcn_mfma_f32_32x32x16_bf16(b1,qr[d0],p1,0,0,0);}
}
typedef __attribute__((address_space(3))) const char* lds_cptr;
typedef short v4i16_t __attribute__((ext_vector_type(4)));
__device__ __forceinline__ void kload8(bf16x8*kf,lds_cptr kp){
  kf[0]=*(const __attribute__((address_space(3))) bf16x8*)(kp);      kf[1]=*(const __attribute__((address_space(3))) bf16x8*)(kp+512);
  kf[2]=*(const __attribute__((address_space(3))) bf16x8*)(kp+2048); kf[3]=*(const __attribute__((address_space(3))) bf16x8*)(kp+2560);
  kf[4]=*(const __attribute__((address_space(3))) bf16x8*)(kp+4096); kf[5]=*(const __attribute__((address_space(3))) bf16x8*)(kp+4608);
  kf[6]=*(const __attribute__((address_space(3))) bf16x8*)(kp+6144); kf[7]=*(const __attribute__((address_space(3))) bf16x8*)(kp+6656);
}
__device__ __forceinline__ void kload2(bf16x8*kf,lds_cptr kp,int j){ kf[2*j]=*(const __attribute__((address_space(3))) bf16x8*)(kp+j*2048); kf[2*j+1]=*(const __attribute__((address_space(3))) bf16x8*)(kp+j*2048+512); }
__device__ __forceinline__ s16x4 vtr(lds_cptr p){ return __builtin_bit_cast(s16x4,__builtin_amdgcn_ds_read_tr16_b64_v4i16((__attribute__((address_space(3))) v4i16_t*)p)); }
__device__ __forceinline__ float rowmax(const f32x16&p0,const f32x16&p1){
  float a=max3f(p0[0],p0[1],p1[0]),b=max3f(p0[2],p0[3],p1[1]);a=max3f(a,p1[2],p1[3]);
  #pragma unroll
  for(int r=4;r<16;r+=4){a=max3f(a,p0[r],p0[r+1]);b=max3f(b,p0[r+2],p0[r+3]);a=max3f(a,p1[r],p1[r+1]);b=max3f(b,p1[r+2],p1[r+3]);}
  const float m=max2f(a,b);
  auto rr=__builtin_amdgcn_permlane32_swap(__float_as_uint(m),__float_as_uint(m),false,false);
  return max2f(__uint_as_float(rr[0]),__uint_as_float(rr[1]));
}
__device__ __forceinline__ void pv(f32x16*o,int vb,bf16x8 pa0,bf16x8 pa1,bf16x8 pa2,bf16x8 pa3){
  #pragma unroll
  for(int d0=0;d0<2;++d0){s16x4 lo[4],hi[4];
    #pragma unroll
    for(int ks=0;ks<4;++ks){
      asm volatile("ds_read_b64_tr_b16 %0,%1 offset:%c2":"=&v"(lo[ks]):"v"(vb),"i"(d0*4096+ks*1024):"memory");
      asm volatile("ds_read_b64_tr_b16 %0,%1 offset:%c2":"=&v"(hi[ks]):"v"(vb),"i"(d0*4096+ks*1024+512):"memory");}
    asm volatile("s_waitcnt lgkmcnt(0)":::"memory");SBAR();
    #define PK(k) (bf16x8){lo[k][0],lo[k][1],lo[k][2],lo[k][3],hi[k][0],hi[k][1],hi[k][2],hi[k][3]}
    o[d0]=__builtin_amdgcn_mfma_f32_32x32x16_bf16(pa0,PK(0),o[d0],0,0,0);
    o[d0]=__builtin_amdgcn_mfma_f32_32x32x16_bf16(pa1,PK(1),o[d0],0,0,0);
    o[d0]=__builtin_amdgcn_mfma_f32_32x32x16_bf16(pa2,PK(2),o[d0],0,0,0);
    o[d0]=__builtin_amdgcn_mfma_f32_32x32x16_bf16(pa3,PK(3),o[d0],0,0,0);
    #undef PK
  }
}

#ifndef ATTN_STORE16
#define ATTN_STORE16(p,v) (*(u32x4*)(p)=(v))
#endif
template<int THRL> __device__ __forceinline__ void attn_unit(int b,int h,int qb,const bf16*Q,const bf16*__restrict__ K,const bf16*__restrict__ V,bf16*O,const float*__restrict__ CB,const float*__restrict__ NRM,char*shm,bool dry=false){
  int tid_=threadIdx.x; asm volatile("":"+v"(tid_)); const int tid=tid_,lane=tid&63,r32=lane&31,hi=lane>>5; const int wid=__builtin_amdgcn_readfirstlane(tid>>6);
  const long rowbase=(long)b*SEQ; const int q0=qb*QB;
  int t0;
  { const f32x4* cbg=reinterpret_cast<const f32x4*>(CB+(long)(b*NHEAD+h)*SEQ); f32x4* cbl=reinterpret_cast<f32x4*>(shm+LDS_CB); const int nv=(q0+QB)/4;
    for(int i=tid;i<nv;i+=NW*64) cbl[i]=cbg[i];
    const float bnd=NRM[b*NHEAD+h]+40.f;
    asm volatile("s_waitcnt vmcnt(0) lgkmcnt(0)\n\ts_barrier":::"memory");
    const float*cbf=reinterpret_cast<const float*>(shm+LDS_CB); const int tc=2*lane; const int NT0=(q0+QB)/KVBLK;
    const bool ok=(tc<=NT0-4)&&(tc==0||cbf[64*tc-1]+bnd<=cbf[q0]);
    const unsigned long long mk=__ballot(ok); t0=2*(__popcll(mk)-1); t0=__builtin_amdgcn_readfirstlane(t0); }
  const bf16*Qw=Q+(rowbase+q0+wid*QBLK)*DM+h*D;
  const bf16*Kh=K+(rowbase+(long)t0*KVBLK)*DM+h*D,*Vh=V+(rowbase+(long)t0*KVBLK)*DM+h*D;
  const unsigned lds0=(unsigned)(uintptr_t)shm;
  float*wsf=(float*)(shm+LDS_WS)+wid*64;
  const bf16*ksrc=Kh+(long)lane*DM+wid*8;
  const bf16*vsrc=Vh+(long)(16*(wid&3)+(lane>>2))*DM+(wid>>2)*32+(lane&3)*8;
  const unsigned kdst=lds0+LDS_K+wid*1024, vdst=lds0+LDS_V+wid*1024;
  #define DMA_K(t,slot) glds16(ksrc+(long)(t)*KVBLK*DM,(unsigned)__builtin_amdgcn_readfirstlane(kdst+(slot)))
  #define DMA_V(t,slot) glds16(vsrc+(long)(t)*KVBLK*DM,(unsigned)__builtin_amdgcn_readfirstlane(vdst+(slot)))
  const int vb0=(int)(lds0+LDS_V)+((lane>>4)&1)*32+(lane&3)*8+(4*hi+((lane&15)>>2))*64;
  const char*Kbase=shm+LDS_K; bf16x8 kf[8];
  const lds_cptr shm3=(lds_cptr)shm; const lds_cptr kp0=shm3+LDS_K+hi*1024+r32*16; const lds_cptr vp0=shm3+LDS_V+((lane>>4)&1)*32+(lane&3)*8+(4*hi+((lane&15)>>2))*64;
  const int NT=(q0+QB)/KVBLK-t0;
  const lds_cptr cb3=(lds_cptr)shm+LDS_CB+t0*256;
  const float cb_own=*(const __attribute__((address_space(3))) float*)((lds_cptr)shm+LDS_CB+(q0+wid*QBLK+r32)*4);
  DMA_K(0,0);DMA_V(0,0);DMA_K(1,SLOTB);
  bf16x8 qr[4];
  #pragma unroll
  for(int d0=0;d0<4;++d0)qr[d0]=*reinterpret_cast<const bf16x8*>(&Qw[(long)r32*DM+d0*16+hi*8]);
  float mhat=0.f,l_reg=0.f;f32x16 o[2];o[0]=f32x16{};o[1]=f32x16{};
  const int qrel=wid*QBLK+r32;
  #define CMASK(P0,P1,t) do{int jb_=(t)-(NT-4); if(jb_>=0)cmask(P0,P1,jb_,qrel,hi);}while(0)
  bool resc=false;
  #define START(P0,P1) do{ const float rm=max2f(rowmax(P0,P1),cb_own); resc=false; \
    { const float dl=rm; mhat=fadd_s(mhat,dl); \
      _Pragma("unroll") for(int r=0;r<16;++r){P0[r]=fsub_s(P0[r],dl);P1[r]=fsub_s(P1[r],dl);} } \
    _Pragma("unroll") for(int r=0;r<16;++r)P0[r]=__builtin_amdgcn_exp2f(P0[r]); }while(0)
  #define RESC() do{ if(resc){ asm volatile("s_waitcnt lgkmcnt(0)":::"memory"); \
      _Pragma("unroll") for(int d_=0;d_<2;++d_) _Pragma("unroll") for(int r=0;r<16;++r)o[d_][r]*=wsf[crow(r,hi)]; } }while(0)
  f32x16 pA0,pA1,pB0,pB1;
  int sl_prev=0,sl_cur=0,sl_next=SLOTB;
  #define ROT() do{sl_prev=sl_cur;sl_cur=sl_next;sl_next=(sl_next==(NSLOT-1)*SLOTB)?0:sl_next+SLOTB;}while(0)
  DMA_K(2,2*SLOTB);
  WAIT_BAR(3);
  qkt(pA0,pA1,Kbase,qr,shm+LDS_CB+t0*256,r32,hi);asm volatile("s_nop 15\n\ts_nop 7":"+v"(pA0),"+v"(pA1));CMASK(pA0,pA1,0);
  START(pA0,pA1);
  _Pragma("unroll") for(int r=0;r<16;++r)pA1[r]=__builtin_amdgcn_exp2f(pA1[r]);
  WAIT_BAR(0);
  DMA_K(3,0);DMA_V(1,SLOTB);
  ROT();
  kload8(kf,kp0+sl_cur);
  WAIT_BAR(2);
  s16x4 vlo[8],vhi[8]; u32x4 pw0,pw1,pw2,pw3;
  #define PKW(P,B) cvtpk_s(P[B],P[B+1])
  #define PAF(k) __builtin_bit_cast(bf16x8,pw##k)
  #define VFR(i) (bf16x8){vlo[i][0],vlo[i][1],vlo[i][2],vlo[i][3],vhi[i][0],vhi[i][1],vhi[i][2],vhi[i][3]}
  #define PIN(x) asm volatile("":"+v"(x))
  #define MX3(a,b,c) __builtin_fmaxf(__builtin_fmaxf((a),(b)),(c))
  #define GAPA(MF,A0,A1,A2,A3,W0,W1,PW) do{ MF; sacc+=A0; sacc+=A1; sacc+=A2; sacc+=A3; PIN(sacc); W0; W1; PIN(PW); SBAR(); }while(0)
  #define EX(v) __builtin_amdgcn_exp2f(v)
  #define GAPB(MF,X,B) do{ MF; X[B]=EX(X[B]); X[B+1]=EX(X[B+1]); X[B+2]=EX(X[B+2]); X[B+3]=EX(X[B+3]); PIN(X); SBAR(); }while(0)
  #define VRD(i) do{ vlo[i]=vtr(vp_+(((i)>>2)*4096+((i)&3)*1024)); vhi[i]=vtr(vp_+(((i)>>2)*4096+((i)&3)*1024+512)); }while(0)
  #define KRD(G,j) do{ if(G){ kload2(kf,kp0+sl_next,j); SBAR(); } }while(0)
  #define STEP(C0,C1,P0,P1,t,GK,GV,GL) do{ SBAR(); \
    const lds_cptr vp_=vp0+sl_prev; \
    VRD(0); SBAR(); float sacc=(P0[0]+P0[1]); \
    GAPA(C0=__builtin_amdgcn_mfma_f32_32x32x16_bf16(kf[0],qr[0],C0,0,0,0), P0[2],P0[3],P0[4],P0[5],     pw0[0]=PKW(P0,0), pw0[1]=PKW(P0,2), pw0); \
    VRD(4); SBAR(); GAPA(C1=__builtin_amdgcn_mfma_f32_32x32x16_bf16(kf[1],qr[0],C1,0,0,0), P0[6],P0[7],P0[8],P0[9],     pw0[2]=PKW(P0,4), pw0[3]=PKW(P0,6), pw0); \
    VRD(1); SBAR(); GAPA(C0=__builtin_amdgcn_mfma_f32_32x32x16_bf16(kf[2],qr[1],C0,0,0,0),   P0[10],P0[11],P0[12],P0[13], pw1[0]=PKW(P0,8), pw1[1]=PKW(P0,10), pw1); \
    VRD(5); SBAR(); GAPA(C1=__builtin_amdgcn_mfma_f32_32x32x16_bf16(kf[3],qr[1],C1,0,0,0),   P0[14],P0[15],P1[0],P1[1],   pw1[2]=PKW(P0,12),pw1[3]=PKW(P0,14), pw1); \
    VRD(2); SBAR(); GAPA(C0=__builtin_amdgcn_mfma_f32_32x32x16_bf16(kf[4],qr[2],C0,0,0,0),   P1[2],P1[3],P1[4],P1[5],     pw2[0]=PKW(P1,0), pw2[1]=PKW(P1,2), pw2); \
    VRD(6); SBAR(); GAPA(C1=__builtin_amdgcn_mfma_f32_32x32x16_bf16(kf[5],qr[2],C1,0,0,0),   P1[6],P1[7],P1[8],P1[9],     pw2[2]=PKW(P1,4), pw2[3]=PKW(P1,6), pw2); \
    VRD(3); SBAR(); GAPA(C0=__builtin_amdgcn_mfma_f32_32x32x16_bf16(kf[6],qr[3],C0,0,0,0),   P1[10],P1[11],P1[12],P1[13], pw3[0]=PKW(P1,8), pw3[1]=PKW(P1,10), pw3); \
    VRD(7); SBAR(); GAPA(C1=__builtin_amdgcn_mfma_f32_32x32x16_bf16(kf[7],qr[3],C1,0,0,0),   P1[14],P1[15],0.f,0.f,       pw3[2]=PKW(P1,12),pw3[3]=PKW(P1,14), pw3); \
    l_reg+=sacc; \
    if(GK){DMA_K((t)+3,sl_cur);} if(GV){DMA_V((t)+1,sl_next);} \
    CMASK(C0,C1,t); \
    { float a=MX3(C0[0],C0[1],C1[0]),b=MX3(C0[2],C0[3],C1[1]); a=MX3(a,C1[2],C1[3]); \
      _Pragma("unroll") for(int r=4;r<16;r+=4){a=MX3(a,C0[r],C0[r+1]);b=MX3(b,C0[r+2],C0[r+3]);a=MX3(a,C1[r],C1[r+1]);b=MX3(b,C1[r+2],C1[r+3]);} \
      float rm=__builtin_fmaxf(a,b); { auto rr=__builtin_amdgcn_permlane32_swap(__float_as_uint(rm),__float_as_uint(rm),false,false); rm=__builtin_fmaxf(__uint_as_float(rr[0]),__uint_as_float(rr[1])); } \
      resc=false; \
      if(__builtin_expect(__any(rm>(float)THRL),0)){ const float dl=__builtin_fmaxf(rm,0.f); mhat+=dl; \
        _Pragma("unroll") for(int r=0;r<16;++r){C0[r]-=dl;C1[r]-=dl;} \
        const float f=__builtin_amdgcn_exp2f(-dl); l_reg*=f; if(hi==0)wsf[r32]=f; resc=true; } } \
    SBAR(); \
    { const __attribute__((address_space(3))) f32x4* cbp_=(const __attribute__((address_space(3))) f32x4*)(cb3+((t)+1)*256+hi*16); \
      _Pragma("unroll") for(int a_=0;a_<4;++a_){ const f32x4 u0_=cbp_[2*a_], u1_=cbp_[8+2*a_]; \
        P0[4*a_]=u0_[0];P0[4*a_+1]=u0_[1];P0[4*a_+2]=u0_[2];P0[4*a_+3]=u0_[3]; P1[4*a_]=u1_[0];P1[4*a_+1]=u1_[1];P1[4*a_+2]=u1_[2];P1[4*a_+3]=u1_[3]; } } SBAR(); \
    GAPB(o[0]=__builtin_amdgcn_mfma_f32_32x32x16_bf16(PAF(0),VFR(0),o[0],0,0,0), C0,0); \
    GAPB(o[1]=__builtin_amdgcn_mfma_f32_32x32x16_bf16(PAF(0),VFR(4),o[1],0,0,0), C0,4); \
    KRD(GL,0); GAPB(o[0]=__builtin_amdgcn_mfma_f32_32x32x16_bf16(PAF(1),VFR(1),o[0],0,0,0), C0,8); \
    KRD(GL,1); GAPB(o[1]=__builtin_amdgcn_mfma_f32_32x32x16_bf16(PAF(1),VFR(5),o[1],0,0,0), C0,12); \
    KRD(GL,2); GAPB(o[0]=__builtin_amdgcn_mfma_f32_32x32x16_bf16(PAF(2),VFR(2),o[0],0,0,0), C1,0); \
    KRD(GL,3); GAPB(o[1]=__builtin_amdgcn_mfma_f32_32x32x16_bf16(PAF(2),VFR(6),o[1],0,0,0), C1,4); \
    GAPB(o[0]=__builtin_amdgcn_mfma_f32_32x32x16_bf16(PAF(3),VFR(3),o[0],0,0,0), C1,8); \
    GAPB(o[1]=__builtin_amdgcn_mfma_f32_32x32x16_bf16(PAF(3),VFR(7),o[1],0,0,0), C1,12); \
    _Pragma("unroll") for(int r_=0;r_<16;++r_){P0[r_]-=mhat;P1[r_]-=mhat;} \
    }while(0)
  { const __attribute__((address_space(3))) f32x4* cbp_=(const __attribute__((address_space(3))) f32x4*)(cb3+256+hi*16);
    #pragma unroll
    for(int a_=0;a_<4;++a_){ const f32x4 u0_=cbp_[2*a_], u1_=cbp_[8+2*a_];
      pB0[4*a_]=u0_[0]-mhat;pB0[4*a_+1]=u0_[1]-mhat;pB0[4*a_+2]=u0_[2]-mhat;pB0[4*a_+3]=u0_[3]-mhat;
      pB1[4*a_]=u1_[0]-mhat;pB1[4*a_+1]=u1_[1]-mhat;pB1[4*a_+2]=u1_[2]-mhat;pB1[4*a_+3]=u1_[3]-mhat; } }
  int t=1;
  #undef CMASK
  #define CMASK(P0,P1,t) do{}while(0)
  for(;t+5<NT;t+=2){
    STEP(pB0,pB1,pA0,pA1,t,true,true,true);     WAIT_BAR(2); RESC(); ROT();
    STEP(pA0,pA1,pB0,pB1,t+1,true,true,true);   WAIT_BAR(2); RESC(); ROT();
  }
  #undef CMASK
  #define CMASK(P0,P1,t) do{int jb_=(t)-(NT-4); if(jb_>=0)cmask(P0,P1,jb_,qrel,hi);}while(0)
  #define ENDW(tt) do{ if((tt)+3<NT){WAIT_BAR(2);} else if((tt)+2<NT){WAIT_BAR(1);} else {WAIT_BAR(0);} }while(0)
  for(;t+1<NT;t+=2){
    STEP(pB0,pB1,pA0,pA1,t,(t+3<NT),(t+1<NT),(t+1<NT));       ENDW(t);   RESC(); ROT();
    STEP(pA0,pA1,pB0,pB1,t+1,(t+4<NT),(t+2<NT),(t+2<NT));     ENDW(t+1); RESC(); ROT();
  }
  STEP(pB0,pB1,pA0,pA1,NT-1,false,false,false); RESC();
  { float sacc=pB0[0]+pB0[1]; _Pragma("unroll") for(int r=2;r<16;++r)sacc+=pB0[r]; _Pragma("unroll") for(int r=0;r<16;++r)sacc+=pB1[r]; l_reg+=sacc;
    pw0=(u32x4){PKW(pB0,0),PKW(pB0,2),PKW(pB0,4),PKW(pB0,6)};pw1=(u32x4){PKW(pB0,8),PKW(pB0,10),PKW(pB0,12),PKW(pB0,14)};pw2=(u32x4){PKW(pB1,0),PKW(pB1,2),PKW(pB1,4),PKW(pB1,6)};pw3=(u32x4){PKW(pB1,8),PKW(pB1,10),PKW(pB1,12),PKW(pB1,14)};
    SBAR(); pv(o,vb0+sl_cur,PAF(0),PAF(1),PAF(2),PAF(3)); }
  #undef PKW
  #undef PAF
  #undef VFR
  #undef PIN
  #undef MX3
  #undef GAPA
  #undef GAPB
  #undef EX
  #undef VRD
  #undef KRD
  #undef STEP
  #undef ENDW
  {auto rr=__builtin_amdgcn_permlane32_swap(__float_as_uint(l_reg),__float_as_uint(l_reg),false,false);l_reg=__uint_as_float(rr[0])+__uint_as_float(rr[1]);}
  if(hi==0)wsf[32+r32]=l_reg;asm volatile("s_waitcnt lgkmcnt(0)":::"memory");
  float rli[16];
  #pragma unroll
  for(int r=0;r<16;++r)rli[r]=__builtin_amdgcn_rcpf(wsf[32+crow(r,hi)]);
  bf16*Ow=O+(rowbase+q0+wid*QBLK)*OPITCH+h*D;
  { bf16*stg=(bf16*)(shm+LDS_OST)+wid*2048;
    #pragma unroll
    for(int r=0;r<16;++r){const int orow=crow(r,hi);
      #pragma unroll
      for(int d0=0;d0<2;++d0)stg[orow*64+d0*32+r32]=__float2bfloat16(o[d0][r]*rli[r]);}
    asm volatile("s_waitcnt lgkmcnt(0)":::"memory");
    #pragma unroll
    for(int i=0;i<4;++i){const int row=i*8+(lane>>3),ch=lane&7; const u32x4 v=*(const u32x4*)(stg+row*64+ch*8); bf16*dst=Ow+(long)row*OPITCH+ch*8; const u32x4 gv=*(const u32x4*)dst; u32x4 w;
      #pragma unroll
      for(int j=0;j<4;++j){ const float a0=__uint_as_float(v[j]<<16)*__uint_as_float(gv[j]<<16), a1=__uint_as_float(v[j]&0xffff0000u)*__uint_as_float(gv[j]&0xffff0000u); w[j]=cvtpk_s(a0,a1); }
      if(!dry)*(u32x4*)dst=w;} }
  asm volatile("s_waitcnt lgkmcnt(0)\n\ts_barrier":::"memory");
  #undef DMA_K
  #undef DMA_V
  #undef CMASK
  #undef START
  #undef RESC
  #undef ROT
}
constexpr int ATTN_LDS_BYTES=LDS_BYTES;
struct AttnTensors { const bf16* Q; const bf16* K; const bf16* V; bf16* O; const float* CB; const float* NRM; };
struct AttnUnit { int bh; int qb; };
struct StaticOrder {
  int vcu;
  __device__ __forceinline__ explicit StaticOrder(int grid,int block):vcu((block%8)*(grid/8)+block/8){}
  __device__ __forceinline__ bool next(int i,AttnUnit&u)const{ if(i>=2)return false; const int s=vcu&7; u.bh=vcu>>3; u.qb=(i==0)?15-s:s; return true; }
  __device__ __forceinline__ void a_ready(const AttnUnit&)const{}
  __device__ __forceinline__ void done(const AttnUnit&)const{}
};
template<class Sched,int THRL=8> __device__ __forceinline__ void attn_phase(char*lds,const AttnTensors&T,const Sched&S,bool dry=false){
  AttnUnit u;
  for(int i=0;S.next(i,u);++i){ S.a_ready(u); attn_unit<THRL>(u.bh/NHEAD,u.bh%NHEAD,u.qb,T.Q,T.K,T.V,T.O,T.CB,T.NRM,lds,dry); S.done(u); }
}
#undef SBAR
#undef WAIT_BAR
}
#include <hip/hip_cooperative_groups.h>
namespace cg = cooperative_groups;
#define LAS __attribute__((address_space(3)))
typedef unsigned short bf16;
typedef float f32x4 __attribute__((ext_vector_type(4)));
typedef float f32x2 __attribute__((ext_vector_type(2)));
typedef unsigned u32x4 __attribute__((ext_vector_type(4)));
typedef unsigned u32x2 __attribute__((ext_vector_type(2)));
typedef short bf16x8 __attribute__((ext_vector_type(8)));
typedef short bf16x4 __attribute__((ext_vector_type(4)));

constexpr int NWAVES = 8, NTHR = 512;
constexpr int BATCH = 4, SEQ = 4096, DM = 1024, DEPTH = 4, M = BATCH * SEQ;
constexpr int NIN = 3592, NF = 3584;
constexpr int T5 = 32, NCH5 = M / T5, KA5 = 640, NG5 = 16;
constexpr float EPS = 1e-6f;
constexpr float LOG2E = 1.4426950408889634f;

constexpr size_t MiB = 1u << 20;
constexpr size_t WS_WIN = 1 * MiB, WS_WO = 31 * MiB, WS_WGLU = 39 * MiB, WS_ROPE = 40 * MiB, WS_MF = 41 * MiB, WS_WB = 81 * MiB;
constexpr size_t WS_LAM = 90 * MiB, WS_LOGF = 90 * MiB + 65536, WS_CB = WS_LOGF + 524288, WS_SS = WS_CB + 524288, WS_NRM = WS_SS + 131072, WS_XBUF = WS_NRM + 4096;
constexpr size_t WS_XN = 92 * MiB, WS_E = WS_XN, WS_UPD = WS_XN + 4 * MiB, WS_STATE = WS_XN + 20 * MiB;
constexpr size_t WS_QO = 124 * MiB, WS_KB = 140 * MiB, WS_VB = 156 * MiB, WS_SUA = 172 * MiB, WS_RQ = 182 * MiB, WS_RK = 190 * MiB, WS_RKT = 198 * MiB, WS_YS5 = WS_RKT;
constexpr size_t WS_RVT = 206 * MiB, WS_GATE = 214 * MiB, WS_END = 246 * MiB;

constexpr int RING_BYTES = 131072, LDS_BYTES = 147456;

struct Args { const float* in[16]; float* out; unsigned char* ws; };

__device__ __forceinline__ float bf2f(unsigned short b) { return __uint_as_float((unsigned)b << 16); }
__device__ __forceinline__ float bflo(unsigned w) { return __uint_as_float(w << 16); }
__device__ __forceinline__ float bfhi(unsigned w) { return __uint_as_float(w & 0xffff0000u); }
__device__ __forceinline__ unsigned pk2(float lo, float hi) { return pg8::cvt_pk_bf16(lo, hi); }
__device__ __forceinline__ unsigned short f2bf(float f) { return (unsigned short)(pg8::cvt_pk_bf16(f, 0.f) & 0xffffu); }
__device__ __forceinline__ float wave_sum(float v) {
#pragma unroll
    for (int o = 1; o < 64; o <<= 1) v += __shfl_xor(v, o);
    return v;
}
__device__ __forceinline__ float lg2_gamma(int hh) { return log2f(1.0f - exp2f(-5.0f - (float)hh)); }

__device__ __forceinline__ int win_col(int n) {
    if (n < 1536) return n;
    if (n < 1792) return n + 8;
    if (n < 2304) { const bool q = n < 2048; const int base = q ? 1792 : 2048; const int hh = (n - base) >> 6, pos = (n - base) & 63; const int d = (pos & 1) ? 32 + (pos >> 1) : (pos >> 1); return (q ? 1800 : 2056) + hh * 64 + d; }
    return n + 8;
}
template <bool MAP> __device__ __forceinline__ void p0_transpose_item(const float* W, int K, int Nsrc, int Ndst, bf16* WT, LAS float* scr, int item, int lane) {
    const int nblk = Ndst / 32, kb = item / nblk, nb = item % nblk, k0 = 64 * kb, n0 = 32 * nb;
    const int sc = MAP ? win_col(n0 + (lane & 31)) : n0 + (lane & 31);
    float wv[32];
#pragma unroll
    for (int i = 0; i < 32; ++i) { const int kk = 2 * i + (lane >> 5); wv[i] = (MAP && sc < 0) ? 0.f : W[(size_t)(k0 + kk) * Nsrc + (sc < 0 ? 0 : sc)]; }
#pragma unroll
    for (int i = 0; i < 32; ++i) { const int kk = 2 * i + (lane >> 5); scr[kk * 33 + (lane & 31)] = wv[i]; }
    asm volatile("s_waitcnt lgkmcnt(0)" ::: "memory");
    const int c = lane & 7;
#pragma unroll
    for (int j = 0; j < 4; ++j) { const int n = (lane >> 3) + 8 * j; const LAS float* s = scr + (8 * c) * 33 + n;
        u32x4 o; o.x = pk2(s[0 * 33], s[1 * 33]); o.y = pk2(s[2 * 33], s[3 * 33]); o.z = pk2(s[4 * 33], s[5 * 33]); o.w = pk2(s[6 * 33], s[7 * 33]);
        *(u32x4*)(WT + (size_t)(n0 + n) * K + k0 + 8 * c) = o; }
    asm volatile("s_waitcnt lgkmcnt(0)" ::: "memory");
}

__device__ __forceinline__ void s5_prep(const Args& a, int l, int g, LAS float* L, int tid) {
    LAS float* LPr = L;
    LAS float* LPi = L + 33 * 64;
    LAS float* Bbr = L + 66 * 64;
    LAS float* Bbi = Bbr + 1024;
    LAS float* Cr = Bbi + 1024;
    LAS float* Ci = Cr + 1024;
    LAS float* KT = Ci + 1024;
    const float* a_re = a.in[4] + (size_t)(l * 16 + g) * 64; const float* a_im = a.in[5] + (size_t)(l * 16 + g) * 64;
    const float* b_re = a.in[6] + (size_t)(l * 16 + g) * 1024; const float* b_im = a.in[7] + (size_t)(l * 16 + g) * 1024;
    const float* c_re = a.in[8] + (size_t)(l * 16 + g) * 1024; const float* c_im = a.in[9] + (size_t)(l * 16 + g) * 1024;
    const float log_dt = a.in[11][l * 16 + g];
    bf16* MF = (bf16*)(a.ws + WS_MF) + (size_t)(l * 16 + g) * 512 * KA5;
    bf16* WB = (bf16*)(a.ws + WS_WB) + (size_t)(l * 16 + g) * 128 * 512;
    float* LAM = (float*)(a.ws + WS_LAM) + (size_t)(l * 16 + g) * 128;
    if (tid < 64) {
        const int p = tid;
        const double dt = exp((double)log_dt), ar = (double)a_re[p], ai = (double)a_im[p];
        const double mag = exp(ar * dt); double sn, cs; sincos(ai * dt, &sn, &cs);
        const double lr = mag * cs, li = mag * sn, den = ar * ar + ai * ai;
        const double fr = ((lr - 1.0) * ar + li * ai) / den, fi = (li * ar - (lr - 1.0) * ai) / den;
#pragma unroll 4
        for (int h = 0; h < 16; ++h) { const double br = (double)b_re[p * 16 + h], bi = (double)b_im[p * 16 + h]; Bbr[p * 16 + h] = (float)(fr * br - fi * bi); Bbi[p * 16 + h] = (float)(fr * bi + fi * br); }
        double pr = 1.0, pi = 0.0;
        for (int j = 0; j <= 32; ++j) { LPr[j * 64 + p] = (float)pr; LPi[j * 64 + p] = (float)pi; const double nr = pr * lr - pi * li, ni = pr * li + pi * lr; pr = nr; pi = ni; }
        LAM[p] = LPr[32 * 64 + p]; LAM[64 + p] = LPi[32 * 64 + p];
    }
    for (int i = tid; i < 1024; i += NTHR) { const int h = i >> 6, p = i & 63; Cr[p * 16 + h] = c_re[i]; Ci[p * 16 + h] = c_im[i]; }
    __syncthreads();
    { const int j = tid >> 4, h = tid & 15; float acc[16];
#pragma unroll
      for (int e = 0; e < 16; ++e) acc[e] = 0.f;
      for (int p = 0; p < 64; ++p) { const float cr = Cr[p * 16 + h], ci = Ci[p * 16 + h], lr = LPr[j * 64 + p], li = LPi[j * 64 + p]; const float clr = cr * lr - ci * li, cli = cr * li + ci * lr;
#pragma unroll
          for (int q = 0; q < 4; ++q) { const f32x4 br = *(const LAS f32x4*)(Bbr + p * 16 + 4 * q), bi = *(const LAS f32x4*)(Bbi + p * 16 + 4 * q);
              acc[4 * q] += clr * br.x - cli * bi.x; acc[4 * q + 1] += clr * br.y - cli * bi.y; acc[4 * q + 2] += clr * br.z - cli * bi.z; acc[4 * q + 3] += clr * br.w - cli * bi.w; } }
#pragma unroll
      for (int e = 0; e < 16; ++e) KT[tid * 16 + e] = acc[e]; }
    __syncthreads();
    for (int q = tid; q < 512 * 64; q += NTHR) {
        const int row = q >> 6, cp = q & 63, s = cp >> 1, h0 = (cp & 1) * 8, t = row >> 4, h = row & 15;
        u32x4 o = (u32x4){0u, 0u, 0u, 0u};
        if (s <= t) { const LAS float* k = KT + ((t - s) * 16 + h) * 16 + h0; o.x = pk2(k[0], k[1]); o.y = pk2(k[2], k[3]); o.z = pk2(k[4], k[5]); o.w = pk2(k[6], k[7]); }
        *(u32x4*)(MF + (size_t)row * KA5 + cp * 8) = o;
    }
    for (int q = tid; q < 512 * 16; q += NTHR) {
        const int row = q >> 4, cp = q & 15, t = row >> 4, h = row & 15; float v[8];
#pragma unroll
        for (int e = 0; e < 8; ++e) { const int jj = cp * 8 + e, p = jj & 63; const float cr = Cr[p * 16 + h], ci = Ci[p * 16 + h], lr = LPr[(t + 1) * 64 + p], li = LPi[(t + 1) * 64 + p];
            v[e] = (jj < 64) ? (cr * lr - ci * li) : -(cr * li + ci * lr); }
        u32x4 o; o.x = pk2(v[0], v[1]); o.y = pk2(v[2], v[3]); o.z = pk2(v[4], v[5]); o.w = pk2(v[6], v[7]);
        *(u32x4*)(MF + (size_t)row * KA5 + 512 + cp * 8) = o;
    }
    for (int q = tid; q < 128 * 64; q += NTHR) {
        const int j = q >> 6, cp = q & 63, s = cp >> 1, h0 = (cp & 1) * 8, p = j & 63; const float lr = LPr[(31 - s) * 64 + p], li = LPi[(31 - s) * 64 + p]; float v[8];
#pragma unroll
        for (int e = 0; e < 8; ++e) { const float br = Bbr[p * 16 + h0 + e], bi = Bbi[p * 16 + h0 + e]; v[e] = (j < 64) ? (lr * br - li * bi) : (lr * bi + li * br); }
        u32x4 o; o.x = pk2(v[0], v[1]); o.y = pk2(v[2], v[3]); o.z = pk2(v[4], v[5]); o.w = pk2(v[6], v[7]);
        *(u32x4*)(WB + (size_t)j * 512 + cp * 8) = o;
    }
    __syncthreads();
}

__device__ __forceinline__ void norm0_phase(const Args& a, int lane, int gw, int NGW) {
    const float* X = a.in[0]; f32x4 gv[4];
#pragma unroll
    for (int j = 0; j < 4; ++j) gv[j] = *((const f32x4*)a.in[1] + lane + 64 * j);
    bf16* XN = (bf16*)(a.ws + WS_XN); float* SS = (float*)(a.ws + WS_SS);
    for (int m = gw; m < M; m += 2 * NGW) {
        const int m2 = m + NGW; const bool has2 = m2 < M;
        const f32x4* xr = (const f32x4*)(X + (size_t)m * DM) + lane; const f32x4* xr2 = (const f32x4*)(X + (size_t)(has2 ? m2 : m) * DM) + lane; f32x4 v[4], w[4];
#pragma unroll
        for (int j = 0; j < 4; ++j) { v[j] = xr[64 * j]; w[j] = xr2[64 * j]; }
        float ss = 0.f, ss2 = 0.f;
#pragma unroll
        for (int j = 0; j < 4; ++j) { ss += (v[j].x * v[j].x + v[j].y * v[j].y) + (v[j].z * v[j].z + v[j].w * v[j].w); ss2 += (w[j].x * w[j].x + w[j].y * w[j].y) + (w[j].z * w[j].z + w[j].w * w[j].w); }
        ss = wave_sum(ss); ss2 = wave_sum(ss2);
        unsigned long long* o8 = (unsigned long long*)(XN + (size_t)m * DM) + lane; unsigned long long* o82 = (unsigned long long*)(XN + (size_t)m2 * DM) + lane;
        const float r1_ = rsqrtf(ss * (1.f / DM) + EPS), r2_ = rsqrtf(ss2 * (1.f / DM) + EPS);
#pragma unroll
        for (int j = 0; j < 4; ++j) { v[j] = v[j] * gv[j] * r1_; o8[64 * j] = (unsigned long long)pk2(v[j].x, v[j].y) | ((unsigned long long)pk2(v[j].z, v[j].w) << 32);
            if (has2) { w[j] = w[j] * gv[j] * r2_; o82[64 * j] = (unsigned long long)pk2(w[j].x, w[j].y) | ((unsigned long long)pk2(w[j].z, w[j].w) << 32); } }
        if (lane == 0) { SS[m] = ss; if (has2) SS[m2] = ss2; }
    }
}
__device__ __forceinline__ void final_norm(const Args& a, float* X, const float* SS, int lane, int gw, int NGW) {
    f32x4 gv[4];
#pragma unroll
    for (int j = 0; j < 4; ++j) gv[j] = *((const f32x4*)a.in[15] + lane + 64 * j);
    for (int m = gw; m < M; m += 2 * NGW) {
        const int m2 = m + NGW; const bool has2 = m2 < M;
        f32x4* xr = (f32x4*)(X + (size_t)m * DM) + lane; f32x4* xr2 = (f32x4*)(X + (size_t)(has2 ? m2 : m) * DM) + lane; f32x4 v[4], w[4];
#pragma unroll
        for (int j = 0; j < 4; ++j) { v[j] = xr[64 * j]; w[j] = xr2[64 * j]; }
        const float r1 = rsqrtf(SS[m] * (1.f / DM) + EPS), r2 = rsqrtf(SS[has2 ? m2 : m] * (1.f / DM) + EPS);
#pragma unroll
        for (int j = 0; j < 4; ++j) { xr[64 * j] = v[j] * r1 * gv[j]; if (has2) xr2[64 * j] = w[j] * r2 * gv[j]; }
    }
}

__device__ __forceinline__ void flog_phase(const Args& a, int l, const float* SS, LAS float* WF, int tid, int lane, int wave, int blk, int nblk) {
    const float* win = a.in[2] + (size_t)l * DM * NIN;
    for (int i = tid; i < 2048; i += NTHR) { const int k = i >> 1, hf = i & 1; *(LAS f32x4*)(WF + k * 8 + hf * 4) = *(const f32x4*)(win + (size_t)k * NIN + 1536 + hf * 4); }
    __syncthreads();
    const bf16* XN = (const bf16*)(a.ws + WS_XN); float* LOGF = (float*)(a.ws + WS_LOGF);
    const float bfj = (lane < 8) ? a.in[3][l * 8 + lane] : 0.f;
    const int rows_per = M / nblk;
    for (int i = wave; i < rows_per; i += 2 * NWAVES) {
        const int m = blk * rows_per + i, m2 = m + NWAVES; const bool has2 = (i + NWAVES) < rows_per;
        const u32x4 x0 = *((const u32x4*)(XN + (size_t)m * DM) + lane), x1 = *((const u32x4*)(XN + (size_t)m * DM + 512) + lane);
        const u32x4 y0 = *((const u32x4*)(XN + (size_t)(has2 ? m2 : m) * DM) + lane), y1 = *((const u32x4*)(XN + (size_t)(has2 ? m2 : m) * DM + 512) + lane);
        float acc[8], acc2[8];
#pragma unroll
        for (int e = 0; e < 8; ++e) { acc[e] = 0.f; acc2[e] = 0.f; }
#pragma unroll
        for (int hf = 0; hf < 2; ++hf)
#pragma unroll
            for (int q = 0; q < 8; ++q) { const int k = 512 * hf + 8 * lane + q; const f32x4 w0 = *(const LAS f32x4*)(WF + k * 8), w1 = *(const LAS f32x4*)(WF + k * 8 + 4);
                const unsigned xw = hf ? x1[q >> 1] : x0[q >> 1], yw = hf ? y1[q >> 1] : y0[q >> 1]; const float hv = (q & 1) ? bfhi(xw) : bflo(xw), hv2 = (q & 1) ? bfhi(yw) : bflo(yw);
                acc[0] += hv * w0.x; acc[1] += hv * w0.y; acc[2] += hv * w0.z; acc[3] += hv * w0.w; acc[4] += hv * w1.x; acc[5] += hv * w1.y; acc[6] += hv * w1.z; acc[7] += hv * w1.w;
                acc2[0] += hv2 * w0.x; acc2[1] += hv2 * w0.y; acc2[2] += hv2 * w0.z; acc2[3] += hv2 * w0.w; acc2[4] += hv2 * w1.x; acc2[5] += hv2 * w1.y; acc2[6] += hv2 * w1.z; acc2[7] += hv2 * w1.w; }
        float mine = 0.f, mine2 = 0.f;
#pragma unroll
        for (int e = 0; e < 8; ++e) { const float s = wave_sum(acc[e]), s2 = wave_sum(acc2[e]); if (lane == e) { mine = s; mine2 = s2; } }
        if (lane < 8) { const float z = mine + bfj; LOGF[(size_t)((m >> 12) * 8 + lane) * SEQ + (m & 4095)] = fminf(z, 0.f) - log1pf(expf(-fabsf(z)));
            if (has2) { const float z2 = mine2 + bfj; LOGF[(size_t)((m2 >> 12) * 8 + lane) * SEQ + (m2 & 4095)] = fminf(z2, 0.f) - log1pf(expf(-fabsf(z2))); } }
    }
}

__device__ __forceinline__ bool opaque_true() { int d = 1; asm volatile("" : "+s"(d)); return d != 0; }
struct RangeOrder {
    pg8::StaticOrder S; int lo, hi;
    __device__ bool next(int i, pg8::Unit& u) const { return (lo + i < hi) ? S.next(lo + i, u) : false; }
    __device__ __forceinline__ void a_ready(const pg8::Unit&) const {}
    __device__ __forceinline__ void done(const pg8::Unit&) const {}
};
struct FlatOrder {
    int nM, nN, nG, G, c;
    __device__ bool next(int i, pg8::Unit& u) const { const int L = i * G + c; if (L >= nG * nM * nN) return false; u.gz = L / (nM * nN); const int r = L % (nM * nN); u.pm = r % nM; u.pn = r / nM; return true; }
    __device__ __forceinline__ void a_ready(const pg8::Unit&) const {}
    __device__ __forceinline__ void done(const pg8::Unit&) const {}
};
__device__ __forceinline__ float silu_f(float v) { return v / (1.f + __expf(-v)); }
__device__ __forceinline__ float gelu_tanh(float v) { const float u = 0.7978845608028654f * (v + 0.044715f * v * v * v); const float e = __expf(2.f * u); const float th = 1.f - 2.f / (e + 1.f); return 0.5f * v * (1.f + th); }

struct EpiInProj {
    static constexpr bool PERM = true, AFTER_DRAIN = false;
    unsigned char* ws; const float* SS; const float* bfl;
    __device__ __forceinline__ void operator()(const pg8::f32x4 (&acc)[2][2][4][2], const pg8::Unit& u, int wr, int wc, int fr, int fq) const {
        const int pn = u.pn; const int row0 = u.pm * 256 + wr * 64 + fr, cl0 = wc * 32 + 8 * fq;
        float rs[2][4];
#pragma unroll
        for (int ai = 0; ai < 2; ++ai)
#pragma unroll
            for (int m = 0; m < 4; ++m) rs[ai][m] = 1.f;
        if (pn == 14) {
            if (wc == 0 && fq == 0) { float* LOGF = (float*)(ws + WS_LOGF); const f32x4 b0 = *(const f32x4*)bfl, b1 = *(const f32x4*)(bfl + 4);
#pragma unroll
                for (int ai = 0; ai < 2; ++ai)
#pragma unroll
                    for (int m = 0; m < 4; ++m) { const int row = row0 + ai * 128 + m * 16; const float r = rs[ai][m]; const pg8::f32x4 v0 = acc[ai][0][m][0], v1 = acc[ai][0][m][1];
                        float z[8] = {v0[0] * r + b0.x, v0[1] * r + b0.y, v0[2] * r + b0.z, v0[3] * r + b0.w, v1[0] * r + b1.x, v1[1] * r + b1.y, v1[2] * r + b1.z, v1[3] * r + b1.w};
#pragma unroll
                        for (int e = 0; e < 8; ++e) LOGF[(size_t)((row >> 12) * 8 + e) * SEQ + (row & 4095)] = fminf(z[e], 0.f) - log1pf(__expf(-fabsf(z[e]))); } }
            return;
        }
        if (pn < 6) {
            bf16* base = (bf16*)(ws + (pn < 2 ? WS_QO : pn < 4 ? WS_KB : WS_VB)); const float sc = pn < 2 ? 0.125f * LOG2E : 1.f; const int cb = (pn & 1) * 256 + cl0;
#pragma unroll
            for (int ai = 0; ai < 2; ++ai)
#pragma unroll
                for (int m = 0; m < 4; ++m) { bf16* rp = base + (size_t)(row0 + ai * 128 + m * 16) * 512 + cb;
#pragma unroll
                    for (int bj = 0; bj < 2; ++bj) { const float sr = sc * rs[ai][m]; const pg8::f32x4 v0 = acc[ai][bj][m][0] * sr, v1 = acc[ai][bj][m][1] * sr; u32x4 w; w.x = pk2(v0[0], v0[1]); w.y = pk2(v0[2], v0[3]); w.z = pk2(v1[0], v1[1]); w.w = pk2(v1[2], v1[3]); *(u32x4*)(rp + bj * 128) = w; } }
        } else if (pn == 6) {
            bf16* base = (bf16*)(ws + WS_SUA);
#pragma unroll
            for (int ai = 0; ai < 2; ++ai)
#pragma unroll
                for (int m = 0; m < 4; ++m) { const int row = row0 + ai * 128 + m * 16, chunk = row >> 5, t = row & 31;
#pragma unroll
                    for (int bj = 0; bj < 2; ++bj) { const int c = cl0 + bj * 128, g = c >> 4, h0 = c & 15; const pg8::f32x4 v0 = acc[ai][bj][m][0] * rs[ai][m], v1 = acc[ai][bj][m][1] * rs[ai][m]; u32x4 w; w.x = pk2(v0[0], v0[1]); w.y = pk2(v0[2], v0[3]); w.z = pk2(v1[0], v1[1]); w.w = pk2(v1[2], v1[3]);
                        *(u32x4*)(base + ((size_t)(g * 512 + chunk) * KA5 + t * 16 + h0)) = w; } }
        } else if (pn == 7 || pn == 8) {
            const f32x4* rope = (const f32x4*)(ws + WS_ROPE); bf16* base = (bf16*)(ws + (pn == 7 ? WS_RQ : WS_RK)); bf16* RKT = (bf16*)(ws + WS_RKT);
#pragma unroll
            for (int ai = 0; ai < 2; ++ai)
#pragma unroll
                for (int m = 0; m < 4; ++m) { const int row = row0 + ai * 128 + m * 16, b = row >> 12, t = row & 4095;
#pragma unroll
                    for (int bj = 0; bj < 2; ++bj) { const int c = cl0 + bj * 128, hh = c >> 6, pos0 = c & 63; const pg8::f32x4 v0 = acc[ai][bj][m][0] * rs[ai][m], v1 = acc[ai][bj][m][1] * rs[ai][m];
                        const f32x4 r0 = rope[(t * 32 + (pos0 >> 1)) >> 1], r1 = rope[((t * 32 + (pos0 >> 1)) >> 1) + 1];
                        float o[8];
                        o[0] = v0[0] * r0.x - v0[1] * r0.y; o[1] = v0[0] * r0.y + v0[1] * r0.x; o[2] = v0[2] * r0.z - v0[3] * r0.w; o[3] = v0[2] * r0.w + v0[3] * r0.z;
                        o[4] = v1[0] * r1.x - v1[1] * r1.y; o[5] = v1[0] * r1.y + v1[1] * r1.x; o[6] = v1[2] * r1.z - v1[3] * r1.w; o[7] = v1[2] * r1.w + v1[3] * r1.z;
                        u32x4 w; w.x = pk2(o[0], o[1]); w.y = pk2(o[2], o[3]); w.z = pk2(o[4], o[5]); w.w = pk2(o[6], o[7]);
                        *(u32x4*)(base + (size_t)row * 256 + c) = w;
                        if (pn == 8) { const float wk = exp2f(lg2_gamma(hh) * (float)(63 - (t & 63))); bf16* tp = RKT + ((size_t)((b * 4 + hh) * 64 + pos0)) * SEQ + t;
#pragma unroll
                            for (int e = 0; e < 8; ++e) tp[(size_t)e * SEQ] = f2bf(o[e] * wk); } } }
        } else if (pn == 9) {
            bf16* RVT = (bf16*)(ws + WS_RVT);
#pragma unroll
            for (int ai = 0; ai < 2; ++ai)
#pragma unroll
                for (int m = 0; m < 4; ++m) { const int row = row0 + ai * 128 + m * 16, b = row >> 12, t = row & 4095;
#pragma unroll
                    for (int bj = 0; bj < 2; ++bj) { const int c = cl0 + bj * 128, hh = c >> 6, d0 = c & 63; const pg8::f32x4 v0 = acc[ai][bj][m][0] * rs[ai][m], v1 = acc[ai][bj][m][1] * rs[ai][m]; bf16* tp = RVT + ((size_t)((b * 4 + hh) * 64 + d0)) * SEQ + t;
#pragma unroll
                        for (int e = 0; e < 4; ++e) { tp[(size_t)e * SEQ] = f2bf(v0[e]); tp[(size_t)(4 + e) * SEQ] = f2bf(v1[e]); } } }
        } else {
            bf16* base = (bf16*)(ws + WS_GATE); const int cb = (pn - 10) * 256 + cl0;
#pragma unroll
            for (int ai = 0; ai < 2; ++ai)
#pragma unroll
                for (int m = 0; m < 4; ++m) { bf16* rp = base + (size_t)(row0 + ai * 128 + m * 16) * 1024 + cb;
#pragma unroll
                    for (int bj = 0; bj < 2; ++bj) { const pg8::f32x4 v0 = acc[ai][bj][m][0] * rs[ai][m], v1 = acc[ai][bj][m][1] * rs[ai][m]; u32x4 w; w.x = pk2(silu_f(v0[0]), silu_f(v0[1])); w.y = pk2(silu_f(v0[2]), silu_f(v0[3])); w.z = pk2(silu_f(v1[0]), silu_f(v1[1])); w.w = pk2(silu_f(v1[2]), silu_f(v1[3])); *(u32x4*)(rp + bj * 128) = w; } }
        }
    }
};
struct EpiS5E {
    static constexpr bool PERM = false, AFTER_DRAIN = false;
    float* E;
    __device__ __forceinline__ void operator()(const pg8::f32x4 (&acc)[2][2][4][2], const pg8::Unit& u, int wr, int wc, int fr, int fq) const {
        const int row0 = u.pm * 256 + wr * 64 + fr, col0 = wc * 32 + 4 * fq;
#pragma unroll
        for (int ai = 0; ai < 2; ++ai)
#pragma unroll
            for (int m = 0; m < 4; ++m) { float* rp = E + ((size_t)u.gz * NCH5 + row0 + ai * 128 + m * 16) * 128 + col0;
#pragma unroll
                for (int n = 0; n < 2; ++n) *(pg8::f32x4*)(rp + n * 16) = acc[ai][0][m][n]; }
    }
};
struct EpiS5Y {
    static constexpr bool PERM = true, AFTER_DRAIN = false;
    const bf16* SUA; bf16* YS5; const float* dvec;
    __device__ __forceinline__ void operator()(const pg8::f32x4 (&acc)[2][2][4][2], const pg8::Unit& u, int wr, int wc, int fr, int fq) const {
        const int row0 = u.pm * 256 + wr * 64 + fr, cl0 = u.pn * 256 + wc * 32 + 8 * fq; const int g = u.gz;
#pragma unroll
        for (int bj = 0; bj < 2; ++bj) { const int c = cl0 + bj * 128, tt = c >> 4, h0 = c & 15; const f32x4 d0 = *(const f32x4*)(dvec + g * 16 + h0), d1 = *(const f32x4*)(dvec + g * 16 + h0 + 4);
#pragma unroll
            for (int ai = 0; ai < 2; ++ai)
#pragma unroll
                for (int m = 0; m < 4; ++m) { const int chunk = row0 + ai * 128 + m * 16; const u32x4 uu = *(const u32x4*)(SUA + ((size_t)(g * 512 + chunk) * KA5 + c)); const pg8::f32x4 v0 = acc[ai][bj][m][0], v1 = acc[ai][bj][m][1];
                    float y[8]; y[0] = v0[0] + d0.x * bflo(uu.x); y[1] = v0[1] + d0.y * bfhi(uu.x); y[2] = v0[2] + d0.z * bflo(uu.y); y[3] = v0[3] + d0.w * bfhi(uu.y);
                    y[4] = v1[0] + d1.x * bflo(uu.z); y[5] = v1[1] + d1.y * bfhi(uu.z); y[6] = v1[2] + d1.z * bflo(uu.w); y[7] = v1[3] + d1.w * bfhi(uu.w);
#pragma unroll
                    for (int e = 0; e < 8; ++e) y[e] = gelu_tanh(y[e]);
                    u32x4 w; w.x = pk2(y[0], y[1]); w.y = pk2(y[2], y[3]); w.z = pk2(y[4], y[5]); w.w = pk2(y[6], y[7]);
                    *(u32x4*)(YS5 + (size_t)(chunk * 32 + tt) * 256 + g * 16 + h0) = w; } }
    }
};
struct EpiGlu {
    static constexpr bool PERM = true, AFTER_DRAIN = false;
    const bf16* YS5; bf16* G; bool dry;
    __device__ __forceinline__ void operator()(const pg8::f32x4 (&acc)[2][2][4][2], const pg8::Unit& u, int wr, int wc, int fr, int fq) const {
        const int row0 = u.pm * 256 + wr * 64 + fr, cl0 = wc * 32 + 8 * fq;
#pragma unroll
        for (int ai = 0; ai < 2; ++ai)
#pragma unroll
            for (int m = 0; m < 4; ++m) { const int row = row0 + ai * 128 + m * 16;
#pragma unroll
                for (int bj = 0; bj < 2; ++bj) { const int c = cl0 + bj * 128; const u32x4 yy = *(const u32x4*)(YS5 + (size_t)row * 256 + c); bf16* gp = G + (size_t)row * 1024 + 512 + c; const u32x4 gg = *(const u32x4*)gp;
                    const pg8::f32x4 v0 = acc[ai][bj][m][0], v1 = acc[ai][bj][m][1]; float s[8];
#pragma unroll
                    for (int e = 0; e < 4; ++e) { s[e] = 1.f / (1.f + __expf(-v0[e])); s[4 + e] = 1.f / (1.f + __expf(-v1[e])); }
                    u32x4 w; w.x = pk2(bflo(yy.x) * s[0] * bflo(gg.x), bfhi(yy.x) * s[1] * bfhi(gg.x)); w.y = pk2(bflo(yy.y) * s[2] * bflo(gg.y), bfhi(yy.y) * s[3] * bfhi(gg.y));
                    w.z = pk2(bflo(yy.z) * s[4] * bflo(gg.z), bfhi(yy.z) * s[5] * bfhi(gg.z)); w.w = pk2(bflo(yy.w) * s[6] * bflo(gg.w), bfhi(yy.w) * s[7] * bfhi(gg.w));
                    if (!dry) *(u32x4*)gp = w; } }
    }
};
struct EpiOut {
    static constexpr bool PERM = false, AFTER_DRAIN = false;
    const float* base; float* out; float* SSn; bf16* XN; const float* gnext; bool dry;
    __device__ __forceinline__ void operator()(const pg8::f32x4 (&acc)[2][2][4][2], const pg8::Unit& u, int wr, int wc, int fr, int fq) const {
        const int row0 = u.pm * 256 + wr * 64 + fr, col0 = u.pn * 256 + wc * 32 + 4 * fq;
        f32x4 gq[2][2];
#pragma unroll
        for (int bj = 0; bj < 2; ++bj)
#pragma unroll
            for (int n = 0; n < 2; ++n) gq[bj][n] = gnext ? *(const f32x4*)(gnext + col0 + bj * 128 + n * 16) : (f32x4){0.f, 0.f, 0.f, 0.f};
#pragma unroll
        for (int ai = 0; ai < 2; ++ai)
#pragma unroll
            for (int m = 0; m < 4; ++m) { const int row = row0 + ai * 128 + m * 16; const size_t off = (size_t)row * DM + col0; float sq = 0.f;
#pragma unroll
                for (int bj = 0; bj < 2; ++bj)
#pragma unroll
                    for (int n = 0; n < 2; ++n) { const f32x4 bs = *(const f32x4*)(base + off + bj * 128 + n * 16); const pg8::f32x4 v = acc[ai][bj][m][n]; const f32x4 x = (f32x4){bs.x + v[0], bs.y + v[1], bs.z + v[2], bs.w + v[3]};
                        sq += (x.x * x.x + x.y * x.y) + (x.z * x.z + x.w * x.w);
                        if (!dry) { *(f32x4*)(out + off + bj * 128 + n * 16) = x;
                            if (gnext) { const f32x4 g = gq[bj][n]; u32x2 w; w.x = pk2(x.x * g.x, x.y * g.y); w.y = pk2(x.z * g.z, x.w * g.w); *(u32x2*)(XN + off + bj * 128 + n * 16) = w; } } }
                sq += __shfl_xor(sq, 16); sq += __shfl_xor(sq, 32);
                if (fq == 0 && !dry) __hip_atomic_fetch_add(SSn + row, sq, __ATOMIC_RELAXED, __HIP_MEMORY_SCOPE_AGENT); }
    }
};

template <bool FINAL> struct EpiOutX {
    static constexpr bool PERM = false, AFTER_DRAIN = true;
    const float* base; float* out; const float* wfin; float* xbuf; unsigned* cnt; bf16* XN; unsigned target;
    __device__ __forceinline__ void fused(pg8::f32x4 (&acc)[2][2][4][2], const pg8::Unit& u, int wr, int wc, int fr, int fq, PG8_LAS unsigned char* lds, int wid, int lane) const {
        PG8_LAS float* P = (PG8_LAS float*)lds;
        PG8_LAS float* S = (PG8_LAS float*)(lds + 4096);
        const int col0 = u.pn * 256 + wc * 32 + 4 * fq;
#pragma unroll
        for (int ai = 0; ai < 2; ++ai)
#pragma unroll
            for (int m = 0; m < 4; ++m) { const int r = ai * 128 + wr * 64 + m * 16 + fr; const size_t off = (size_t)(u.pm * 256 + r) * DM + col0; float sq = 0.f;
#pragma unroll
                for (int bj = 0; bj < 2; ++bj)
#pragma unroll
                    for (int n = 0; n < 2; ++n) { const f32x4 bs = *(const f32x4*)(base + off + bj * 128 + n * 16); pg8::f32x4 x = acc[ai][bj][m][n]; x[0] += bs.x; x[1] += bs.y; x[2] += bs.z; x[3] += bs.w; acc[ai][bj][m][n] = x;
                        sq += (x[0] * x[0] + x[1] * x[1]) + (x[2] * x[2] + x[3] * x[3]); }
                sq += __shfl_xor(sq, 16); sq += __shfl_xor(sq, 32);
                if (fq == 0) P[r * 4 + wc] = sq;
                asm volatile("" : "+v"(acc[ai][0][m][0]), "+v"(acc[ai][0][m][1]), "+v"(acc[ai][1][m][0]), "+v"(acc[ai][1][m][1]));
                if (m & 1) asm volatile("" ::: "memory"); }
        asm volatile("s_waitcnt lgkmcnt(0)" ::: "memory"); __builtin_amdgcn_s_barrier(); asm volatile("" ::: "memory");
        const int row = wid * 32 + (lane & 31);
        if (lane < 32) { const float tot = (P[row * 4 + 0] + P[row * 4 + 1]) + (P[row * 4 + 2] + P[row * 4 + 3]);
            __hip_atomic_store(xbuf + (size_t)(u.pm * 256 + row) * 4 + u.pn, tot, __ATOMIC_RELAXED, __HIP_MEMORY_SCOPE_AGENT); }
        asm volatile("s_waitcnt vmcnt(0)" ::: "memory");
        if (lane == 0) __hip_atomic_fetch_add(cnt + 64 * u.pm, 1u, __ATOMIC_RELAXED, __HIP_MEMORY_SCOPE_AGENT);
        if (wid == 0) {
            unsigned sp = 0u;
            while ((unsigned)__builtin_amdgcn_readfirstlane(__hip_atomic_load(cnt + 64 * u.pm, __ATOMIC_RELAXED, __HIP_MEMORY_SCOPE_AGENT)) < target) { __builtin_amdgcn_s_sleep(2); if (++sp > (1u << 20)) break; }
            __builtin_amdgcn_fence(__ATOMIC_ACQUIRE, "agent");
        }
        asm volatile("s_waitcnt vmcnt(0) lgkmcnt(0)" ::: "memory"); __builtin_amdgcn_s_barrier(); asm volatile("" ::: "memory");
        if (lane < 32) { const float* sl = xbuf + (size_t)(u.pm * 256 + row) * 4; float t = 0.f;
#pragma unroll
            for (int k = 0; k < 4; ++k) t += __hip_atomic_load(sl + k, __ATOMIC_RELAXED, __HIP_MEMORY_SCOPE_AGENT);
            S[row] = rsqrtf(t * (1.f / DM) + EPS); }
        asm volatile("s_waitcnt lgkmcnt(0)" ::: "memory"); __builtin_amdgcn_s_barrier(); asm volatile("" ::: "memory");
        f32x4 wq[2][2];
#pragma unroll
        for (int bj = 0; bj < 2; ++bj)
#pragma unroll
            for (int n = 0; n < 2; ++n) wq[bj][n] = *(const f32x4*)(wfin + col0 + bj * 128 + n * 16);
#pragma unroll
        for (int ai = 0; ai < 2; ++ai)
#pragma unroll
            for (int m = 0; m < 4; ++m) { const int r = ai * 128 + wr * 64 + m * 16 + fr; const float sr = S[r]; const size_t off = (size_t)(u.pm * 256 + r) * DM + col0;
#pragma unroll
                for (int bj = 0; bj < 2; ++bj)
#pragma unroll
                    for (int n = 0; n < 2; ++n) { const pg8::f32x4 x = acc[ai][bj][m][n]; const f32x4 g = wq[bj][n]; const f32x4 y = (f32x4){x[0] * sr * g.x, x[1] * sr * g.y, x[2] * sr * g.z, x[3] * sr * g.w};
                        if (FINAL) *(f32x4*)(out + off + bj * 128 + n * 16) = y;
                        else { *(f32x4*)(out + off + bj * 128 + n * 16) = (f32x4){x[0], x[1], x[2], x[3]}; u32x2 w; w.x = pk2(y.x, y.y); w.y = pk2(y.z, y.w); *(u32x2*)(XN + off + bj * 128 + n * 16) = w; } } }
    }
};

template <int KS, int UNR, class Epi> __device__ __forceinline__ void wave_gemm64(const bf16* A, int lda, const bf16* B, int ldb, int lane, const Epi& epi) {
    const int fr = lane & 15, fq = lane >> 4;
    pg8::f32x4 acc[4][4];
#pragma unroll
    for (int jb = 0; jb < 4; ++jb)
#pragma unroll
        for (int ib = 0; ib < 4; ++ib) acc[jb][ib] = (pg8::f32x4){0.f, 0.f, 0.f, 0.f};
    const bf16* ap = A + (size_t)fr * lda + 8 * fq; const bf16* bp = B + (size_t)fr * ldb + 8 * fq;
#pragma unroll UNR
    for (int ks = 0; ks < KS; ++ks) {
        bf16x8 af[4], bv[4];
#pragma unroll
        for (int ib = 0; ib < 4; ++ib) { af[ib] = *(const bf16x8*)(ap + (size_t)(16 * ib) * lda + 32 * ks); bv[ib] = *(const bf16x8*)(bp + (size_t)(16 * ib) * ldb + 32 * ks); }
#pragma unroll
        for (int jb = 0; jb < 4; ++jb)
#pragma unroll
            for (int ib = 0; ib < 4; ++ib) acc[jb][ib] = __builtin_amdgcn_mfma_f32_16x16x32_bf16(bv[jb], af[ib], acc[jb][ib], 0, 0, 0);
    }
    epi(acc, fr, fq);
}
struct WEpiE {
    float* E;
    __device__ __forceinline__ void operator()(const pg8::f32x4 (&acc)[4][4], int fr, int fq) const {
#pragma unroll
        for (int jb = 0; jb < 4; ++jb)
#pragma unroll
            for (int ib = 0; ib < 4; ++ib) *(pg8::f32x4*)(E + (size_t)(16 * ib + fr) * 128 + 16 * jb + 4 * fq) = acc[jb][ib];
    }
};
struct WEpiS5Y {
    const bf16* SUAg; bf16* YS5; const float* dg; int chunk0, col0, g;
    __device__ __forceinline__ void operator()(const pg8::f32x4 (&acc)[4][4], int fr, int fq) const {
#pragma unroll
        for (int jb = 0; jb < 4; ++jb) { const int col = col0 + 16 * jb + 4 * fq, tt = col >> 4, h0 = col & 15; const f32x4 d4 = *(const f32x4*)(dg + h0);
#pragma unroll
            for (int ib = 0; ib < 4; ++ib) { const int chunk = chunk0 + 16 * ib + fr; const u32x2 uu = *(const u32x2*)(SUAg + (size_t)chunk * KA5 + col); const pg8::f32x4 v = acc[jb][ib];
                const float y0 = gelu_tanh(v[0] + d4.x * bflo(uu.x)), y1 = gelu_tanh(v[1] + d4.y * bfhi(uu.x)), y2 = gelu_tanh(v[2] + d4.z * bflo(uu.y)), y3 = gelu_tanh(v[3] + d4.w * bfhi(uu.y));
                u32x2 w; w.x = pk2(y0, y1); w.y = pk2(y2, y3); *(u32x2*)(YS5 + (size_t)(chunk * 32 + tt) * 256 + g * 16 + h0) = w; } }
    }
};
struct WEpiGlu {
    const bf16* YS5; bf16* G; int row0, col0;
    __device__ __forceinline__ void operator()(const pg8::f32x4 (&acc)[4][4], int fr, int fq) const {
#pragma unroll
        for (int jb = 0; jb < 4; ++jb)
#pragma unroll
            for (int ib = 0; ib < 4; ++ib) { const int row = row0 + 16 * ib + fr, col = col0 + 16 * jb + 4 * fq; const u32x2 yy = *(const u32x2*)(YS5 + (size_t)row * 256 + col); bf16* gp = G + (size_t)row * 1024 + 512 + col; const u32x2 gg = *(const u32x2*)gp; const pg8::f32x4 v = acc[jb][ib];
                const float s0 = 1.f / (1.f + __expf(-v[0])), s1 = 1.f / (1.f + __expf(-v[1])), s2 = 1.f / (1.f + __expf(-v[2])), s3 = 1.f / (1.f + __expf(-v[3]));
                u32x2 w; w.x = pk2(bflo(yy.x) * s0 * bflo(gg.x), bfhi(yy.x) * s1 * bfhi(gg.x)); w.y = pk2(bflo(yy.y) * s2 * bflo(gg.y), bfhi(yy.y) * s3 * bfhi(gg.y)); *(u32x2*)gp = w; }
    }
};

__device__ __forceinline__ void ret_upd_unit(unsigned char* ws, int unit, int lane) {
    const int c = unit & 63, bh = unit >> 6; const int i16 = lane & 15, kq = lane >> 4;
    const bf16* KT = (const bf16*)(ws + WS_RKT) + (size_t)bh * 64 * SEQ + c * 64; const bf16* VT = (const bf16*)(ws + WS_RVT) + (size_t)bh * 64 * SEQ + c * 64;
    float* UPD = (float*)(ws + WS_UPD) + (size_t)unit * 4096;
    bf16x8 af[4][2], bfv[4][2];
#pragma unroll
    for (int ib = 0; ib < 4; ++ib)
#pragma unroll
        for (int ks = 0; ks < 2; ++ks) { af[ib][ks] = *(const bf16x8*)(KT + (size_t)(16 * ib + i16) * SEQ + 32 * ks + 8 * kq); bfv[ib][ks] = *(const bf16x8*)(VT + (size_t)(16 * ib + i16) * SEQ + 32 * ks + 8 * kq); }
#pragma unroll
    for (int ib = 0; ib < 4; ++ib)
#pragma unroll
        for (int jb = 0; jb < 4; ++jb) { pg8::f32x4 d = (pg8::f32x4){0.f, 0.f, 0.f, 0.f};
            d = __builtin_amdgcn_mfma_f32_16x16x32_bf16(af[ib][0], bfv[jb][0], d, 0, 0, 0); d = __builtin_amdgcn_mfma_f32_16x16x32_bf16(af[ib][1], bfv[jb][1], d, 0, 0, 0);
            *(pg8::f32x4*)(UPD + (size_t)(16 * jb + i16) * 64 + 16 * ib + 4 * kq) = d; }
}
__device__ __forceinline__ void ret_out_unit(const Args& a, int l, int unit, int lane, bool dry = false) {
    unsigned char* ws = a.ws;
    const int c = unit & 63, bh = unit >> 6, hh = bh & 3, b = bh >> 2; const int fr = lane & 15, fq = lane >> 4;
    const size_t t0 = (size_t)b * SEQ + c * 64;
    const bf16* RQ = (const bf16*)(ws + WS_RQ) + t0 * 256 + hh * 64; const bf16* RK = (const bf16*)(ws + WS_RK) + t0 * 256 + hh * 64;
    const bf16* VT = (const bf16*)(ws + WS_RVT) + (size_t)bh * 64 * SEQ + c * 64; const bf16* ST = (const bf16*)(ws + WS_STATE) + (size_t)unit * 4096;
    const float lg = lg2_gamma(hh);
    bf16x8 qf[4][2]; pg8::f32x4 st[4][4];
#pragma unroll
    for (int nb = 0; nb < 4; ++nb)
#pragma unroll
        for (int ks = 0; ks < 2; ++ks) qf[nb][ks] = *(const bf16x8*)(RQ + (size_t)(16 * nb + fr) * 256 + 32 * ks + 8 * fq);
#pragma unroll
    for (int mb = 0; mb < 4; ++mb) { bf16x8 k0 = *(const bf16x8*)(RK + (size_t)(16 * mb + fr) * 256 + 8 * fq), k1 = *(const bf16x8*)(RK + (size_t)(16 * mb + fr) * 256 + 32 + 8 * fq);
#pragma unroll
        for (int nb = 0; nb < 4; ++nb) { pg8::f32x4 d = (pg8::f32x4){0.f, 0.f, 0.f, 0.f};
            d = __builtin_amdgcn_mfma_f32_16x16x32_bf16(k0, qf[nb][0], d, 0, 0, 0); d = __builtin_amdgcn_mfma_f32_16x16x32_bf16(k1, qf[nb][1], d, 0, 0, 0);
#pragma unroll
            for (int r = 0; r < 4; ++r) { const int mm = 16 * mb + 4 * fq + r, nn = 16 * nb + fr; const int df = mm > nn ? mm - nn : nn - mm; d[r] *= 0.125f * exp2f(lg * (float)df); }
            st[mb][nb] = d; } }
    pg8::f32x4 o[4][4];
#pragma unroll
    for (int nb = 0; nb < 4; ++nb)
#pragma unroll
        for (int dvb = 0; dvb < 4; ++dvb) o[nb][dvb] = (pg8::f32x4){0.f, 0.f, 0.f, 0.f};
#pragma unroll
    for (int dvb = 0; dvb < 4; ++dvb) { const bf16x8 s0 = *(const bf16x8*)(ST + (size_t)(16 * dvb + fr) * 64 + 8 * fq), s1 = *(const bf16x8*)(ST + (size_t)(16 * dvb + fr) * 64 + 32 + 8 * fq);
#pragma unroll
        for (int nb = 0; nb < 4; ++nb) { o[nb][dvb] = __builtin_amdgcn_mfma_f32_16x16x32_bf16(qf[nb][0], s0, o[nb][dvb], 0, 0, 0); o[nb][dvb] = __builtin_amdgcn_mfma_f32_16x16x32_bf16(qf[nb][1], s1, o[nb][dvb], 0, 0, 0); } }
#pragma unroll
    for (int nb = 0; nb < 4; ++nb)
#pragma unroll
        for (int r = 0; r < 4; ++r) { const float wq = 0.125f * exp2f(lg * (float)(16 * nb + 4 * fq + r + 1));
#pragma unroll
            for (int dvb = 0; dvb < 4; ++dvb) o[nb][dvb][r] *= wq; }
#pragma unroll
    for (int s = 0; s < 2; ++s) {
        bf16x8 pa[4];
#pragma unroll
        for (int nb = 0; nb < 4; ++nb) { u32x4 w; w.x = pk2(st[2 * s][nb][0], st[2 * s][nb][1]); w.y = pk2(st[2 * s][nb][2], st[2 * s][nb][3]); w.z = pk2(st[2 * s + 1][nb][0], st[2 * s + 1][nb][1]); w.w = pk2(st[2 * s + 1][nb][2], st[2 * s + 1][nb][3]); pa[nb] = __builtin_bit_cast(bf16x8, w); }
#pragma unroll
        for (int dvb = 0; dvb < 4; ++dvb) { const u32x2 v0 = *(const u32x2*)(VT + (size_t)(16 * dvb + fr) * SEQ + 32 * s + 4 * fq), v1 = *(const u32x2*)(VT + (size_t)(16 * dvb + fr) * SEQ + 32 * s + 16 + 4 * fq);
            const bf16x8 vf = __builtin_bit_cast(bf16x8, (u32x4){v0.x, v0.y, v1.x, v1.y});
#pragma unroll
            for (int nb = 0; nb < 4; ++nb) o[nb][dvb] = __builtin_amdgcn_mfma_f32_16x16x32_bf16(pa[nb], vf, o[nb][dvb], 0, 0, 0); }
    }
    const float* gn = a.in[13] + (size_t)l * 256 + hh * 64; float gnw[4];
#pragma unroll
    for (int dvb = 0; dvb < 4; ++dvb) gnw[dvb] = gn[16 * dvb + fr];
    bf16* Y = (bf16*)(ws + WS_GATE) + t0 * 1024 + 768 + hh * 64;
#pragma unroll
    for (int nb = 0; nb < 4; ++nb)
#pragma unroll
        for (int r = 0; r < 4; ++r) { float s = (o[nb][0][r] + o[nb][1][r]) + (o[nb][2][r] + o[nb][3][r]);
            s += __shfl_xor(s, 1); s += __shfl_xor(s, 2); s += __shfl_xor(s, 4); s += __shfl_xor(s, 8);
            const float mu = s * (1.f / 64.f); float q = 0.f;
#pragma unroll
            for (int dvb = 0; dvb < 4; ++dvb) { const float d = o[nb][dvb][r] - mu; q += d * d; }
            q += __shfl_xor(q, 1); q += __shfl_xor(q, 2); q += __shfl_xor(q, 4); q += __shfl_xor(q, 8);
            const float rstd = rsqrtf(q * (1.f / 64.f) + EPS); bf16* yp = Y + (size_t)(16 * nb + 4 * fq + r) * 1024 + fr;
#pragma unroll
            for (int dvb = 0; dvb < 4; ++dvb) { const float gt = bf2f(yp[16 * dvb]); if (!dry) yp[16 * dvb] = f2bf((o[nb][dvb][r] - mu) * rstd * gnw[dvb] * gt); } }
}

#define XB_TMO      128
#define XB_XCNT(j)  (256  + 64 * (j))
#define XB_XSUB(j)  (1280 + 64 * (j))
#define XB_XGEN(j)  (2304 + 64 * (j))
#define XB_TOP      3328
#define XB_TOPGEN   3392
#define XCD_BAR_WORDS 3456
#define XB_SPIN_CAP (1u << 18)

__device__ __forceinline__ unsigned xb_ld(unsigned* p)              { return __hip_atomic_load(p, __ATOMIC_RELAXED, __HIP_MEMORY_SCOPE_AGENT); }
__device__ __forceinline__ unsigned xb_add(unsigned* p, unsigned v) { return __hip_atomic_fetch_add(p, v, __ATOMIC_RELAXED, __HIP_MEMORY_SCOPE_AGENT); }
__device__ __forceinline__ unsigned xb_xcc_id() { return (unsigned)__builtin_amdgcn_s_getreg((3 << 11) | 20) & 0xFu; }
#define XB_SPIN(cond, bar) do { unsigned _sp = 0; while (cond) { __builtin_amdgcn_s_sleep(1); \
    if ((++_sp & 255u) == 0u) { if (xb_ld(&(bar)[XB_TMO])) break; if (_sp > XB_SPIN_CAP) { atomicAdd(&(bar)[XB_TMO], 1u); break; } } } } while (0)

struct XcdBarrier {
    unsigned* bar; unsigned x;
    volatile LAS unsigned* st;
};

__device__ __forceinline__ XcdBarrier xcd_barrier_post(unsigned* bar, volatile LAS unsigned* st) {
    XcdBarrier b; b.bar = bar; b.x = xb_xcc_id(); b.st = st;
    if (threadIdx.x == 0) (void)xb_add(&bar[XB_XCNT(b.x)], 1u);
    return b;
}
__device__ __forceinline__ void xcd_barrier_complete(unsigned* bar, unsigned x, unsigned& nloc, unsigned& nx) {
    const unsigned G = gridDim.x * gridDim.y * gridDim.z;
    unsigned sum, cnt, mine, sp = 0u;
    for (;;) {
        sum = 0u; cnt = 0u; mine = 0u;
#pragma unroll
        for (unsigned j = 0; j < 16; ++j) { const unsigned c = xb_ld(&bar[XB_XCNT(j)]); sum += c; cnt += (c > 0u) ? 1u : 0u; mine = (j == x) ? c : mine; }
        if (sum == G) break;
        __builtin_amdgcn_s_sleep(1);
        if ((++sp & 255u) == 0u) { if (xb_ld(&bar[XB_TMO])) break; if (sp > XB_SPIN_CAP) { atomicAdd(&bar[XB_TMO], 1u); break; } }
    }
    nloc = mine > 0u ? mine : 1u; nx = cnt > 0u ? cnt : 1u;
}

__device__ __forceinline__ void xcd_barrier(const XcdBarrier& b) {
    asm volatile("s_waitcnt vmcnt(0)" ::: "memory");
    __syncthreads();
    if (threadIdx.x == 0) {
        unsigned* bar = b.bar;
        __builtin_amdgcn_s_waitcnt(0);
        unsigned nloc = b.st[0], nx = b.st[1];
        if (nloc == 0u) { xcd_barrier_complete(bar, b.x, nloc, nx); b.st[0] = nloc; b.st[1] = nx; }
        const unsigned old = xb_add(&bar[XB_XSUB(b.x)], 1u);
        const unsigned gen = old / nloc;
        if (old + 1u == (gen + 1u) * nloc) {
            __builtin_amdgcn_fence(__ATOMIC_RELEASE, "agent");
            asm volatile("s_waitcnt vmcnt(0)" ::: "memory");
            const unsigned og = xb_add(&bar[XB_TOP], 1u);
            const unsigned tg = og / nx;
            if (og + 1u == (tg + 1u) * nx) xb_add(&bar[XB_TOPGEN], 1u);
            else XB_SPIN(xb_ld(&bar[XB_TOPGEN]) == tg, bar);
            __builtin_amdgcn_fence(__ATOMIC_ACQUIRE, "agent");
            xb_add(&bar[XB_XGEN(b.x)], 1u);
            asm volatile("s_waitcnt vmcnt(0)" ::: "memory");
        } else {
            XB_SPIN(xb_ld(&bar[XB_XGEN(b.x)]) == gen, bar);
            __builtin_amdgcn_fence(__ATOMIC_ACQUIRE, "agent");
            asm volatile("s_waitcnt vmcnt(0)" ::: "memory");
        }
    }
    __syncthreads();
}

#define XBAR_MAKE XcdBarrier xb_; xb_.bar = (unsigned*)args.ws; xb_.st = (volatile LAS unsigned*)((LAS unsigned char*)lds + RING_BYTES + 352); xb_.x = xb_.st[2]
#ifdef REP_SYNC
#define GSYNC() do { XBAR_MAKE; xcd_barrier(xb_); xcd_barrier(xb_); } while (0)
#else
#define GSYNC() do { XBAR_MAKE; xcd_barrier(xb_); } while (0)
#endif
#ifndef REP_P0
#define REP_P0 1
#endif
#ifndef REP_P1
#define REP_P1 1
#endif
#ifndef REP_P23
#define REP_P23 1
#endif
#ifndef REP_NORM
#define REP_NORM 1
#endif
__global__ void __launch_bounds__(NTHR, 2) mega_fwd(Args args) {
    extern __shared__ __attribute__((aligned(16))) unsigned char lds[];
    cg::grid_group grid = cg::this_grid();
    const int tid = threadIdx.x, lane = tid & 63, wave = __builtin_amdgcn_readfirstlane(tid >> 6);
    const int G = gridDim.x, bx = blockIdx.x; const int vcu = (G % 8 == 0) ? (bx % 8) * (G / 8) + bx / 8 : bx;
    const int gw = bx * NWAVES + wave, NGW = G * NWAVES;
    unsigned char* ws = args.ws;
    LAS unsigned char* ldsl = (LAS unsigned char*)lds;
    LAS float* ldsf = (LAS float*)lds;
    float* X = args.out;
    if (ws == nullptr) grid.sync();
    if (tid < 2) ((volatile LAS unsigned*)(ldsl + RING_BYTES + 352))[tid] = 0u;
    __syncthreads();
    { const XcdBarrier xb0 = xcd_barrier_post((unsigned*)ws, (volatile LAS unsigned*)(ldsl + RING_BYTES + 352)); if (tid == 0) ((volatile LAS unsigned*)(ldsl + RING_BYTES + 352))[2] = xb0.x; }
    __syncthreads();

#ifdef PROBE_T
    unsigned long long tacc_ = 0ull, tprev_ = __builtin_amdgcn_s_memrealtime();
#define TSTAMP(id) do { const unsigned long long tn_ = __builtin_amdgcn_s_memrealtime(); if ((id) == PROBE_T || ((PROBE_T) == 23 && ((id) == 2 || (id) == 3 || (id) == 5))) tacc_ += tn_ - tprev_; tprev_ = tn_; } while (0)
#else
#define TSTAMP(id) do {} while (0)
#endif
    for (int rep_ = 0; rep_ < REP_P0; ++rep_) {
        if (rep_) { __syncthreads(); }
#ifdef REP_S5P
        if (bx < 64) { s5_prep(args, bx >> 4, bx & 15, ldsf, tid); }
#endif
        if (bx < 64) { s5_prep(args, bx >> 4, bx & 15, ldsf, tid); }
        LAS float* scr = ldsf + wave * 4096;
        constexpr int I_IN = (DM / 64) * (NF / 32), I_O = (DM / 64) * (DM / 32), I_G = (256 / 64) * (256 / 32), I_L = I_IN + I_O + I_G;
#ifndef REP_TR
#define REP_TR 1
#endif
        for (int rt_ = 0; rt_ < REP_TR; ++rt_)
        for (int it = (bx < 64 ? DEPTH * I_L : (bx - 64) * NWAVES + wave); it < DEPTH * I_L; it += (G - 64) * NWAVES) {
            const int l = it / I_L; int r = it % I_L;
            if (r < I_IN) { p0_transpose_item<true>(args.in[2] + (size_t)l * DM * NIN, DM, NIN, NF, (bf16*)(ws + WS_WIN) + (size_t)l * NF * DM, scr, r, lane); continue; } r -= I_IN;
            if (r < I_O) { p0_transpose_item<false>(args.in[14] + (size_t)l * DM * DM, DM, DM, DM, (bf16*)(ws + WS_WO) + (size_t)l * DM * DM, scr, r, lane); continue; } r -= I_O;
            p0_transpose_item<false>(args.in[12] + (size_t)l * 65536, 256, 256, 256, (bf16*)(ws + WS_WGLU) + (size_t)l * 65536, scr, r, lane);
        }
        f32x2* rope = (f32x2*)(ws + WS_ROPE);
        for (int i = bx * NTHR + tid; i < SEQ * 32; i += G * NTHR) { const int pos = i >> 5, fi = i & 31; const float freq = powf(10000.f, -(float)fi / 32.f); const float ang = (float)pos * freq; float sn, cs; sincosf(ang, &sn, &cs); rope[i] = (f32x2){cs, sn}; }
        __syncthreads();
        { const int NW = (64 + 2 * (G - 64)) * NWAVES;
          if (bx < 64) norm0_phase(args, lane, bx * NWAVES + wave, NW);
          else { const int sl = 64 * NWAVES + ((bx - 64) * NWAVES + wave) * 2; norm0_phase(args, lane, sl, NW); norm0_phase(args, lane, sl + 1, NW); } }
    }
    GSYNC();
    TSTAMP(0);

#define PHASE_VARS int tid = threadIdx.x; asm volatile("" : "+v"(tid)); int bxl_ = blockIdx.x; asm volatile("" : "+s"(bxl_)); const int bx = bxl_; const int lane = tid & 63, wave = __builtin_amdgcn_readfirstlane(tid >> 6), gw = bx * NWAVES + wave; __attribute__((address_space(1))) unsigned char* wsg_ = (__attribute__((address_space(1))) unsigned char*)args.ws; asm volatile("" : "+s"(wsg_)); unsigned char* ws = (unsigned char*)wsg_; LAS unsigned char* ldsl = (LAS unsigned char*)lds; LAS float* ldsf = (LAS float*)lds; (void)lane; (void)wave; (void)gw; (void)ldsl; (void)ldsf
    for (int l = 0; l < DEPTH; ++l) {
        for (int rep_ = 0; rep_ < REP_P1; ++rep_) {
            PHASE_VARS;
            pg8::Gemm g{(const bf16*)(ws + WS_XN), (const bf16*)(ws + WS_WIN) + (size_t)l * NF * DM, M, NF, DM, DM, DM, 0, 0};
            pg8::StaticOrder S; S.init(M, NF, G, bx);
            EpiInProj E{ws, (const float*)(ws + WS_SS) + (size_t)(l & 1) * M, args.in[3] + (size_t)l * 8};
#ifdef PROBE_SPLIT
            { RangeOrder R0{S, 0, 2}, R1{S, 2, 4}; pg8::gemm_phase<EpiInProj, RangeOrder, true, true>(ldsl, g, R0, E); GSYNC(); pg8::gemm_phase<EpiInProj, RangeOrder, true, true>(ldsl, g, R1, E); }
#else
            pg8::gemm_phase<EpiInProj, pg8::StaticOrder, true, true>(ldsl, g, S, E);
#endif
            if (bx >= G / 2) flog_phase(args, l, (const float*)(ws + WS_SS) + (size_t)(l & 1) * M, ldsf, tid, lane, wave, bx - G / 2, G / 2);
        }
        GSYNC();
        TSTAMP(1);
        for (int rep_ = 0; rep_ < REP_P23; ++rep_) {
            if (rep_) __syncthreads();
            PHASE_VARS;
            if (bx < 64) {
                const int b = bx >> 4, g = bx & 15, tmL = wave & 1, tn = (wave >> 1) & 1, kh = wave >> 2;
                { const int fr = lane & 15, fq = lane >> 4;
                  const bf16* Ap = (const bf16*)(ws + WS_SUA) + ((size_t)g * NCH5 + b * 128 + tmL * 64) * KA5 + 256 * kh; const bf16* Bp = (const bf16*)(ws + WS_WB) + ((size_t)(l * 16 + g) * 128 + tn * 64) * 512 + 256 * kh;
                  struct WEpiLds { LAS float* EL; __device__ __forceinline__ void operator()(const pg8::f32x4 (&acc)[4][4], int fr_, int fq_) const {
#pragma unroll
                      for (int jb = 0; jb < 4; ++jb)
#pragma unroll
                          for (int ib = 0; ib < 4; ++ib) *(LAS pg8::f32x4*)(EL + (16 * ib + fr_) * 128 + 16 * jb + 4 * fq_) = acc[jb][ib]; } };
                  WEpiLds E{ldsf + (size_t)(kh * 128 + tmL * 64) * 128 + tn * 64}; (void)fr; (void)fq;
                  wave_gemm64<8, 4, WEpiLds>(Ap, KA5, Bp, 512, lane, E); }
                __syncthreads();
                const int p = tid & 63, seg = tid >> 6;
                const float* LAM = (const float*)(ws + WS_LAM) + (size_t)(l * 16 + g) * 128; const float lr = LAM[p], li = LAM[64 + p];
                bf16* SA = (bf16*)(ws + WS_SUA) + ((size_t)g * NCH5 + b * 128 + seg * 16) * KA5 + 512 + p;
                float er[16], ei[16];
#pragma unroll
                for (int i = 0; i < 16; ++i) { const int r = (seg * 16 + i) * 128; er[i] = ldsf[r + p] + ldsf[16384 + r + p]; ei[i] = ldsf[r + 64 + p] + ldsf[16384 + r + 64 + p]; }
                float sr = 0.f, si = 0.f;
#pragma unroll
                for (int i = 0; i < 16; ++i) { const float nr = lr * sr - li * si + er[i], ni = lr * si + li * sr + ei[i]; sr = nr; si = ni; }
                LAS float* ends = ldsf + (RING_BYTES + 1024) / 4;
                ends[(seg * 64 + p) * 2] = sr; ends[(seg * 64 + p) * 2 + 1] = si;
                float pr = lr, pi = li;
#pragma unroll
                for (int i = 0; i < 4; ++i) { const float nr = pr * pr - pi * pi, ni = 2.f * pr * pi; pr = nr; pi = ni; }
                __syncthreads();
                float cr = 0.f, ci = 0.f;
                for (int s2 = 0; s2 < seg; ++s2) { const float xr = ends[(s2 * 64 + p) * 2], xi = ends[(s2 * 64 + p) * 2 + 1]; const float nr = pr * cr - pi * ci + xr, ni = pr * ci + pi * cr + xi; cr = nr; ci = ni; }
#pragma unroll
                for (int i = 0; i < 16; ++i) { SA[(size_t)i * KA5] = f2bf(cr); SA[(size_t)i * KA5 + 64] = f2bf(ci); const float nr = lr * cr - li * ci + er[i], ni = lr * ci + li * cr + ei[i]; cr = nr; ci = ni; }
            } else if (bx < 192) {
                const int idx = bx - 64, bh = idx >> 3, dvs = (idx >> 1) & 3, dkh = idx & 1, fr = lane & 15, fq = lane >> 4; const float g64 = exp2f(lg2_gamma(bh & 3) * 64.f);
                const bf16* KT = (const bf16*)(ws + WS_RKT) + ((size_t)bh * 64 + 32 * dkh + fr) * SEQ + 8 * fq; const bf16* VT = (const bf16*)(ws + WS_RVT) + ((size_t)bh * 64 + 16 * dvs + fr) * SEQ + 8 * fq;
                pg8::f32x4 u[8][2];
#pragma unroll
                for (int i2 = 0; i2 < 2; ++i2) {
                    bf16x8 vf[4][2], kf[4][2][2];
#pragma unroll
                    for (int i1 = 0; i1 < 4; ++i1) { const int c = 8 * wave + 4 * i2 + i1; vf[i1][0] = *(const bf16x8*)(VT + c * 64); vf[i1][1] = *(const bf16x8*)(VT + c * 64 + 32);
#pragma unroll
                        for (int ib = 0; ib < 2; ++ib) { kf[i1][ib][0] = *(const bf16x8*)(KT + (size_t)(16 * ib) * SEQ + c * 64); kf[i1][ib][1] = *(const bf16x8*)(KT + (size_t)(16 * ib) * SEQ + c * 64 + 32); } }
#pragma unroll
                    for (int i1 = 0; i1 < 4; ++i1)
#pragma unroll
                        for (int ib = 0; ib < 2; ++ib) { pg8::f32x4 d = (pg8::f32x4){0.f, 0.f, 0.f, 0.f}; d = __builtin_amdgcn_mfma_f32_16x16x32_bf16(kf[i1][ib][0], vf[i1][0], d, 0, 0, 0); d = __builtin_amdgcn_mfma_f32_16x16x32_bf16(kf[i1][ib][1], vf[i1][1], d, 0, 0, 0); u[4 * i2 + i1][ib] = d; }
                }
                pg8::f32x4 e4[2];
#pragma unroll
                for (int ib = 0; ib < 2; ++ib) e4[ib] = (pg8::f32x4){0.f, 0.f, 0.f, 0.f};
#pragma unroll
                for (int i = 0; i < 8; ++i)
#pragma unroll
                    for (int ib = 0; ib < 2; ++ib) e4[ib] = e4[ib] * g64 + u[i][ib];
                LAS pg8::f32x4* ends = (LAS pg8::f32x4*)ldsf;
#pragma unroll
                for (int ib = 0; ib < 2; ++ib) ends[(wave * 2 + ib) * 64 + lane] = e4[ib];
                float g8 = g64; g8 = g8 * g8; g8 = g8 * g8; g8 = g8 * g8;
                __syncthreads();
                pg8::f32x4 st[2];
#pragma unroll
                for (int ib = 0; ib < 2; ++ib) st[ib] = (pg8::f32x4){0.f, 0.f, 0.f, 0.f};
                for (int w2 = 0; w2 < wave; ++w2)
#pragma unroll
                    for (int ib = 0; ib < 2; ++ib) st[ib] = st[ib] * g8 + ends[(w2 * 2 + ib) * 64 + lane];
                bf16* ST = (bf16*)(ws + WS_STATE) + (size_t)(bh * 64 + 8 * wave) * 4096 + (size_t)(16 * dvs + fr) * 64 + 32 * dkh + 4 * fq;
#pragma unroll
                for (int i = 0; i < 8; ++i)
#pragma unroll
                    for (int ib = 0; ib < 2; ++ib) { u32x2 w; w.x = pk2(st[ib][0], st[ib][1]); w.y = pk2(st[ib][2], st[ib][3]); *(u32x2*)(ST + (size_t)i * 4096 + 16 * ib) = w; st[ib] = st[ib] * g64 + u[i][ib]; }
            } else if (bx < 224) {
                const int bh = bx - 192; const float* lf = (const float*)(ws + WS_LOGF) + (size_t)bh * SEQ; float* cb = (float*)(ws + WS_CB) + (size_t)bh * SEQ;
                const f32x4 a0 = *(const f32x4*)(lf + tid * 8), a1 = *(const f32x4*)(lf + tid * 8 + 4); float v[8] = {a0.x, a0.y, a0.z, a0.w, a1.x, a1.y, a1.z, a1.w};
#pragma unroll
                for (int e = 1; e < 8; ++e) v[e] += v[e - 1];
                float tot = v[7];
#pragma unroll
                for (int o = 1; o < 64; o <<= 1) { const float t = __shfl_up(tot, o); if (lane >= o) tot += t; }
                if (lane == 63) ldsf[wave] = tot;
                __syncthreads();
                float off = tot - v[7];
                for (int w = 0; w < wave; ++w) off += ldsf[w];
                f32x4 o0, o1; o0.x = -(v[0] + off) * LOG2E; o0.y = -(v[1] + off) * LOG2E; o0.z = -(v[2] + off) * LOG2E; o0.w = -(v[3] + off) * LOG2E; o1.x = -(v[4] + off) * LOG2E; o1.y = -(v[5] + off) * LOG2E; o1.z = -(v[6] + off) * LOG2E; o1.w = -(v[7] + off) * LOG2E;
                *(f32x4*)(cb + tid * 8) = o0; *(f32x4*)(cb + tid * 8 + 4) = o1;
            } else { const int idx = (bx - 224) * NTHR + tid; if (idx < M) ((float*)(ws + WS_SS))[(size_t)((l + 1) & 1) * M + idx] = 0.f;
                const int bh = bx - 224, b = bh >> 3, h = bh & 7, rsub = lane >> 3, part = lane & 7;
                const bf16* Qp = (const bf16*)(ws + WS_QO) + ((size_t)b * SEQ + wave * 512 + rsub) * 512 + h * 64 + part * 8; const bf16* Kp = (const bf16*)(ws + WS_KB) + ((size_t)b * SEQ + wave * 512 + rsub) * 512 + h * 64 + part * 8;
                float qm = 0.f, km = 0.f;
#pragma unroll 8
                for (int it = 0; it < 64; ++it) { const u32x4 qv = *(const u32x4*)(Qp + (size_t)it * 8 * 512), kv = *(const u32x4*)(Kp + (size_t)it * 8 * 512); float sq = 0.f, sk = 0.f;
#pragma unroll
                    for (int e = 0; e < 4; ++e) { const float a0 = bflo(qv[e]), a1 = bfhi(qv[e]), c0 = bflo(kv[e]), c1 = bfhi(kv[e]); sq += a0 * a0 + a1 * a1; sk += c0 * c0 + c1 * c1; }
                    sq += __shfl_xor(sq, 1); sq += __shfl_xor(sq, 2); sq += __shfl_xor(sq, 4); sk += __shfl_xor(sk, 1); sk += __shfl_xor(sk, 2); sk += __shfl_xor(sk, 4);
                    qm = fmaxf(qm, sq); km = fmaxf(km, sk); }
#pragma unroll
                for (int o = 8; o < 64; o <<= 1) { qm = fmaxf(qm, __shfl_xor(qm, o)); km = fmaxf(km, __shfl_xor(km, o)); }
                if (lane == 0) { ldsf[wave * 2] = qm; ldsf[wave * 2 + 1] = km; }
                __syncthreads();
                if (tid == 0) { float a = 0.f, c = 0.f; for (int w = 0; w < NWAVES; ++w) { a = fmaxf(a, ldsf[2 * w]); c = fmaxf(c, ldsf[2 * w + 1]); } ((float*)(ws + WS_NRM))[bh] = sqrtf(a) * sqrtf(c) * 1.0001f; }
            }
        }
        GSYNC();
        TSTAMP(3);
        {
            PHASE_VARS;
            if (wave < 4) ret_out_unit(args, l, wave * 256 + bx, lane);
            else {
                const int t = (wave - 4) * 256 + bx, g = t >> 6, r = t & 63, tm = r >> 3, tn = r & 7;
                const bf16* SUAg = (const bf16*)(ws + WS_SUA) + (size_t)g * NCH5 * KA5;
                WEpiS5Y E{SUAg, (bf16*)(ws + WS_YS5), args.in[10] + (size_t)l * 256 + g * 16, tm * 64, tn * 64, g};
                wave_gemm64<20, 4, WEpiS5Y>(SUAg + (size_t)(tm * 64) * KA5, KA5, (const bf16*)(ws + WS_MF) + ((size_t)(l * 16 + g) * 512 + tn * 64) * KA5, KA5, lane, E);
            }
            __syncthreads();
            const attn_body::AttnTensors AT{(const attn_body::bf16*)(ws + WS_QO), (const attn_body::bf16*)(ws + WS_KB), (const attn_body::bf16*)(ws + WS_VB), (attn_body::bf16*)(ws + WS_GATE), (const float*)(ws + WS_CB), (const float*)(ws + WS_NRM)};
            const attn_body::StaticOrder S(G, bx);
#ifdef REP_ATTN
            attn_body::attn_phase<attn_body::StaticOrder>((char*)lds, AT, S, opaque_true());
#endif
            attn_body::attn_phase<attn_body::StaticOrder>((char*)lds, AT, S);
        }
        GSYNC();
        TSTAMP(4);
        {
            PHASE_VARS;
            if (wave < 4) {
                const int t = wave * 256 + bx, tm = t >> 2, tn = t & 3;
                WEpiGlu E{(const bf16*)(ws + WS_YS5), (bf16*)(ws + WS_GATE), tm * 64, tn * 64};
                wave_gemm64<8, 4, WEpiGlu>((const bf16*)(ws + WS_YS5) + (size_t)(tm * 64) * 256, 256, (const bf16*)(ws + WS_WGLU) + (size_t)l * 65536 + (size_t)(tn * 64) * 256, 256, lane, E);
            }
        }
        GSYNC();
        TSTAMP(5);
        {
            PHASE_VARS;
            pg8::Gemm g{(const bf16*)(ws + WS_GATE), (const bf16*)(ws + WS_WO) + (size_t)l * DM * DM, M, DM, DM, DM, DM, 0, 0};
            pg8::StaticOrder S; S.init(M, DM, G, bx);
            if (l + 1 < DEPTH) {
                EpiOutX<false> E{l == 0 ? args.in[0] : X, X, args.in[1] + (size_t)(l + 1) * DM, (float*)(ws + WS_XBUF), (unsigned*)ws + 4096, (bf16*)(ws + WS_XN), 32u * (unsigned)(l + 1)};
                pg8::gemm_phase<EpiOutX<false>, pg8::StaticOrder, false, true>(ldsl, g, S, E);
            } else {
                EpiOutX<true> E{X, X, args.in[15], (float*)(ws + WS_XBUF), (unsigned*)ws + 4096, nullptr, 32u * (unsigned)(l + 1)};
                pg8::gemm_phase<EpiOutX<true>, pg8::StaticOrder, false, true>(ldsl, g, S, E);
            }
        }
        if (l + 1 < DEPTH) GSYNC();
        TSTAMP(6);
    }
}

extern "C" void kernel_launch(void* const* d_in, const int* in_sizes, int n_in, void* d_out, int out_size, void* d_ws, size_t ws_size, hipStream_t stream) {
    static int grid = 0;
    if (grid == 0) {
        if (n_in != 16 || ws_size < WS_END) { fprintf(stderr, "kernel_launch: unexpected n_in %d / ws %zu\n", n_in, ws_size); grid = -1; return; }
        int dev = 0, cus = 0, per_cu = 0;
        hipGetDevice(&dev); hipDeviceGetAttribute(&cus, hipDeviceAttributeMultiprocessorCount, dev);
        if (hipFuncSetAttribute((const void*)mega_fwd, hipFuncAttributeMaxDynamicSharedMemorySize, LDS_BYTES) != hipSuccess) { fprintf(stderr, "kernel_launch: hipFuncSetAttribute failed\n"); grid = -1; return; }
        if (hipOccupancyMaxActiveBlocksPerMultiprocessor(&per_cu, (const void*)mega_fwd, NTHR, LDS_BYTES) != hipSuccess || per_cu < 1) { fprintf(stderr, "kernel_launch: occupancy query failed (%d)\n", per_cu); grid = -1; return; }
        grid = cus;
        if (grid != 256) fprintf(stderr, "kernel_launch: note: %d CUs\n", grid);
    }
    if (grid < 0) return;
    if (hipMemsetAsync(d_ws, 0, 32768, stream) != hipSuccess) { fprintf(stderr, "kernel_launch: hipMemsetAsync failed\n"); return; }
    Args a{};
    for (int i = 0; i < 16; ++i) a.in[i] = (const float*)d_in[i];
    a.out = (float*)d_out; a.ws = (unsigned char*)d_ws;
    void* kargs[] = {&a};
    hipError_t e = hipLaunchCooperativeKernel((const void*)mega_fwd, dim3(grid), dim3(NTHR), kargs, LDS_BYTES, stream);
    if (e != hipSuccess) fprintf(stderr, "kernel_launch: cooperative launch failed: %s\n", hipGetErrorString(e));
}
```

```cpp
#include <hip/hip_runtime.h>
#include <cstdio>
#include <cstdint>
namespace pg8 {
#define PG8_LAS __attribute__((address_space(3)))
typedef unsigned short bf16_t;
typedef short bf16x8 __attribute__((ext_vector_type(8)));
typedef float f32x4 __attribute__((ext_vector_type(4)));
typedef unsigned u32x4 __attribute__((ext_vector_type(4)));
constexpr int BM = 256, BK = 64, HALF = 128, HTB = HALF * BK * 2  , STAGE_BYTES = 8 * HTB, NXCD = 8, WGM = 4;

__host__ __device__ __forceinline__ int lds_byte(int r, int c) { const int st = (r >> 4) * 2 + (c >> 5), rr = r & 15, cc = c & 31, ob = rr * 64 + cc * 2; return st * 1024 + (ob ^ (((ob >> 9) & 1) << 5)); }
__host__ __device__ __forceinline__ void stage_rc(int b, int& R, int& C) { const int st = b / 1024, sb = b % 1024, swz = sb ^ (((sb >> 9) & 1) << 5); R = (st >> 1) * 16 + swz / 64; C = (st & 1) * 32 + (swz % 64) / 2; }
__host__ __device__ __forceinline__ int perm32(int rho) { const int n = rho >> 4, i = rho & 15; return 8 * (i >> 2) + 4 * n + (i & 3); }

struct Unit { int pm, pn, gz; };
struct Gemm { const bf16_t* A; const bf16_t* Bt; int M, N, K; int lda, ldb; size_t gsA, gsB; };

struct StaticOrder {
    int nM, nN, nwg, G, c;
    __host__ __device__ void init(int M, int N, int G_, int c_) { nM = M / BM; nN = N / BM; nwg = nM * nN; G = G_; c = c_; }
    __host__ __device__ bool next(int i, Unit& u) const {
        const long L = (long)i * G + c; if (L >= nwg) return false;
        int wgid = (int)L; { const int q = nwg / NXCD, r = nwg % NXCD, xcd = wgid % NXCD, off = wgid / NXCD; wgid = (xcd < r ? xcd * (q + 1) : r * (q + 1) + (xcd - r) * q) + off; }
        const int nig = WGM * nN, gid = wgid / nig, fm = gid * WGM, gsz = (nM - fm) < WGM ? (nM - fm) : WGM;
        u.pm = fm + ((wgid % nig) % gsz); u.pn = (wgid % nig) / gsz; u.gz = 0; return true;
    }
    __device__ __forceinline__ void a_ready(const Unit&) const {}
    __device__ __forceinline__ void done(const Unit&) const {}
};

__device__ __forceinline__ unsigned cvt_pk_bf16(float lo, float hi) { unsigned r; asm volatile("v_cvt_pk_bf16_f32 %0, %1, %2" : "=v"(r) : "v"(lo), "v"(hi)); return r; }
typedef float f32x2 __attribute__((ext_vector_type(2)));
__device__ __forceinline__ f32x2 gelu_pk(f32x2 v) {
    const f32x2 av = __builtin_elementwise_abs(v), d = av * 0.2316418882f + 1.0f;
    f32x2 t; t.x = __builtin_amdgcn_rcpf(d.x); t.y = __builtin_amdgcn_rcpf(d.y);
    f32x2 q = t * 0.5307027145f + (-0.7265760135f); q = q * t + 0.7107068705f; q = q * t + (-0.142248368f); q = q * t + 0.127414796f; q = q * t;
    const f32x2 s = (v * v) * (-0.72134752044f);
    f32x2 e; e.x = __builtin_amdgcn_exp2f(s.x); e.y = __builtin_amdgcn_exp2f(s.y);
    const f32x2 m = v * (q * e), r = v - m;
    f32x2 o; o.x = v.x < 0.f ? m.x : r.x; o.y = v.y < 0.f ? m.y : r.y; return o;
}

template <class Epi, class Sched, bool ALIGN_EPI = false, bool SP2 = false>
__device__ __forceinline__ void gemm_phase(PG8_LAS unsigned char* lds, const Gemm g, const Sched& S, const Epi& E) {
    int tid_ = threadIdx.x; asm volatile("" : "+v"(tid_));
    const int tid = tid_, wid = __builtin_amdgcn_readfirstlane(tid >> 6), lane = tid & 63, wr = wid >> 2, wc = wid & 3, fr = lane & 15, fq = lane >> 4;
    const int K = g.K, nt = K / BK;
    unsigned voffA[2], voffB[2];
#pragma unroll
    for (int i = 0; i < 2; ++i) { int R, C; stage_rc(tid * 16 + i * 8192, R, C); const int Rb = Epi::PERM ? ((R & ~31) + perm32(R & 31)) : R;
        voffA[i] = (unsigned)(R * g.lda + C) * 2u; voffB[i] = (unsigned)(Rb * g.ldb + C) * 2u; }
    const size_t kstep = (size_t)(BK * 2);
    const size_t hstepA = (size_t)HALF * g.lda * 2, hstepB = (size_t)HALF * g.ldb * 2;
    const size_t tstepA = 2 * hstepA, tstepB = 2 * hstepB;
    const unsigned ldsw = (unsigned)wid * 1024u;
    const int aoff = lds_byte(wr * 64 + fr, fq * 8), boff = lds_byte(wc * 32 + fr, fq * 8);
#define PG8_SA(b, h) (((b) * 2 + (h)) * HTB)
#define PG8_SB(b, h) ((4 + (b) * 2 + (h)) * HTB)
#define PG8_STAGE(bufoff, gbase, voff) do { _Pragma("unroll") for (int _i = 0; _i < 2; ++_i) \
        __builtin_amdgcn_global_load_lds((const unsigned*)((const char*)(gbase) + (voff)[_i]), (PG8_LAS unsigned*)(lds + (bufoff) + ldsw + _i * 8192), 16, 0, 0); } while (0)
#define PG8_LDA(dst, b, h) do { _Pragma("unroll") for (int m = 0; m < 4; ++m) _Pragma("unroll") for (int k = 0; k < 2; ++k) dst[m][k] = *(const PG8_LAS bf16x8*)(lds + PG8_SA(b, h) + aoff + m * 2048 + k * 1024); } while (0)
#define PG8_LDB(dst, b, h) do { _Pragma("unroll") for (int n = 0; n < 2; ++n) _Pragma("unroll") for (int k = 0; k < 2; ++k) dst[n][k] = *(const PG8_LAS bf16x8*)(lds + PG8_SB(b, h) + boff + n * 2048 + k * 1024); } while (0)
#define PG8_MMA(ai, bj, At, Bt) do { __builtin_amdgcn_s_setprio(1); _Pragma("unroll") for (int m = 0; m < 4; ++m) _Pragma("unroll") for (int n = 0; n < 2; ++n) _Pragma("unroll") for (int k = 0; k < 2; ++k) \
        acc[ai][bj][m][n] = __builtin_amdgcn_mfma_f32_16x16x32_bf16(Bt[n][k], At[m][k], acc[ai][bj][m][n], 0, 0, 0); __builtin_amdgcn_s_setprio(0); } while (0)
#define PG8_WAIT_V(n) asm volatile("s_waitcnt vmcnt(" #n ")" ::: "memory")
#define PG8_WAIT_L(n) asm volatile("s_waitcnt lgkmcnt(" #n ")" ::: "memory")
#define PG8_BAR __builtin_amdgcn_s_barrier()
#define PG8_SCHED __builtin_amdgcn_sched_barrier(0)
    Unit cur, nxt; int ui = 0;
    if (!S.next(0, cur)) return;
    f32x4 acc[2][2][4][2];
#pragma unroll
    for (int a = 0; a < 2; ++a)
#pragma unroll
        for (int b = 0; b < 2; ++b)
#pragma unroll
            for (int m = 0; m < 4; ++m)
#pragma unroll
                for (int n = 0; n < 2; ++n) acc[a][b][m][n] = (f32x4){0.f, 0.f, 0.f, 0.f};
    bf16x8 At[4][2], B0[2][2], B1[2][2];
    const char* cA = (const char*)g.A + (size_t)cur.gz * g.gsA * 2 + (size_t)cur.pm * tstepA; const char* cB = (const char*)g.Bt + (size_t)cur.gz * g.gsB * 2 + (size_t)cur.pn * tstepB;
    S.a_ready(cur);
    if constexpr (SP2) {
        PG8_STAGE(PG8_SB(0, 0), cB, voffB); PG8_STAGE(PG8_SB(0, 1), cB + hstepB, voffB); PG8_STAGE(PG8_SA(0, 0), cA, voffA); PG8_STAGE(PG8_SA(0, 1), cA + hstepA, voffA);
        if (wr == 1) PG8_BAR;
        PG8_WAIT_V(2); PG8_BAR;
        PG8_STAGE(PG8_SB(1, 0), cB + kstep, voffB); PG8_STAGE(PG8_SA(1, 0), cA + kstep, voffA); PG8_STAGE(PG8_SB(1, 1), cB + hstepB + kstep, voffB);
        PG8_WAIT_V(6); PG8_BAR;
    } else {
        PG8_STAGE(PG8_SB(0, 0), cB, voffB); PG8_STAGE(PG8_SA(0, 0), cA, voffA); PG8_STAGE(PG8_SB(0, 1), cB + hstepB, voffB); PG8_STAGE(PG8_SA(0, 1), cA + hstepA, voffA);
        if (wr == 1) PG8_BAR;
        PG8_WAIT_V(4); PG8_BAR;
        PG8_STAGE(PG8_SB(1, 0), cB + kstep, voffB); PG8_STAGE(PG8_SA(1, 0), cA + kstep, voffA); PG8_STAGE(PG8_SB(1, 1), cB + hstepB + kstep, voffB);
        PG8_WAIT_V(6); PG8_BAR;
    }
    for (;;) {
        const bool has_next = S.next(ui + 1, nxt);
        const char* nA = has_next ? (const char*)g.A + (size_t)nxt.gz * g.gsA * 2 + (size_t)nxt.pm * tstepA : cA; const char* nB = has_next ? (const char*)g.Bt + (size_t)nxt.gz * g.gsB * 2 + (size_t)nxt.pn * tstepB : cB;
        for (int t = 0; t < nt; t += 2) {
            const bool last = (t == nt - 2);
            const char* a1 = cA + (size_t)(t + 1) * kstep;
            const char* a2 = last ? nA : cA + (size_t)(t + 2) * kstep; const char* b2 = last ? nB : cB + (size_t)(t + 2) * kstep;
            const char* a3 = a2 + kstep; const char* b3 = b2 + kstep;
            if (last && has_next) S.a_ready(nxt);
            if constexpr (SP2) {
            PG8_LDB(B0, 0, 0); PG8_LDB(B1, 0, 1); PG8_SCHED; PG8_LDA(At, 0, 0); PG8_STAGE(PG8_SA(1, 1), a1 + hstepA, voffA);
            PG8_WAIT_V(8); PG8_WAIT_L(0); PG8_BAR; PG8_MMA(0, 0, At, B0); PG8_MMA(0, 1, At, B1); PG8_BAR; PG8_SCHED;
            PG8_LDA(At, 0, 1); PG8_STAGE(PG8_SB(0, 0), b2, voffB); PG8_STAGE(PG8_SB(0, 1), b2 + hstepB, voffB); PG8_STAGE(PG8_SA(0, 0), a2, voffA);
            PG8_WAIT_V(8); PG8_WAIT_L(0); PG8_BAR; PG8_MMA(1, 0, At, B0); PG8_MMA(1, 1, At, B1); PG8_BAR; PG8_SCHED;
            PG8_LDB(B0, 1, 0); PG8_LDB(B1, 1, 1); PG8_SCHED; PG8_LDA(At, 1, 0); PG8_STAGE(PG8_SA(0, 1), a2 + hstepA, voffA);
            PG8_WAIT_V(8); PG8_WAIT_L(0); PG8_BAR; PG8_MMA(0, 0, At, B0); PG8_MMA(0, 1, At, B1); PG8_BAR; PG8_SCHED;
            PG8_LDA(At, 1, 1); PG8_STAGE(PG8_SB(1, 0), b3, voffB); PG8_STAGE(PG8_SB(1, 1), b3 + hstepB, voffB); PG8_STAGE(PG8_SA(1, 0), a3, voffA);
            PG8_WAIT_V(8); PG8_WAIT_L(0); PG8_BAR; PG8_MMA(1, 0, At, B0); PG8_MMA(1, 1, At, B1); PG8_BAR; PG8_SCHED;
            } else {
            PG8_LDB(B0, 0, 0); PG8_SCHED; PG8_LDA(At, 0, 0); PG8_STAGE(PG8_SA(1, 1), a1 + hstepA, voffA);
            PG8_WAIT_L(8); PG8_BAR; PG8_WAIT_L(0); PG8_MMA(0, 0, At, B0); PG8_BAR; PG8_SCHED;
            PG8_LDB(B1, 0, 1); PG8_STAGE(PG8_SB(0, 0), b2, voffB);
            PG8_BAR; PG8_WAIT_L(0); PG8_MMA(0, 1, At, B1); PG8_BAR;
            PG8_LDA(At, 0, 1); PG8_STAGE(PG8_SA(0, 0), a2, voffA);
            PG8_BAR; PG8_WAIT_L(0); PG8_MMA(1, 0, At, B0); PG8_BAR; PG8_SCHED;
            PG8_STAGE(PG8_SB(0, 1), b2 + hstepB, voffB);
            PG8_WAIT_V(6); PG8_BAR; PG8_MMA(1, 1, At, B1); PG8_BAR;
            PG8_LDB(B0, 1, 0); PG8_SCHED; PG8_LDA(At, 1, 0); PG8_STAGE(PG8_SA(0, 1), a2 + hstepA, voffA);
            PG8_WAIT_L(8); PG8_BAR; PG8_WAIT_L(0); PG8_MMA(0, 0, At, B0); PG8_BAR; PG8_SCHED;
            PG8_LDB(B1, 1, 1); PG8_STAGE(PG8_SB(1, 0), b3, voffB);
            PG8_BAR; PG8_WAIT_L(0); PG8_MMA(0, 1, At, B1); PG8_BAR;
            PG8_LDA(At, 1, 1); PG8_STAGE(PG8_SA(1, 0), a3, voffA);
            PG8_BAR; PG8_WAIT_L(0); PG8_MMA(1, 0, At, B0); PG8_BAR; PG8_SCHED;
            PG8_STAGE(PG8_SB(1, 1), b3 + hstepB, voffB);
            PG8_WAIT_V(6); PG8_BAR; PG8_MMA(1, 1, At, B1); PG8_BAR;
            }
        }
        if constexpr (ALIGN_EPI) { if (wr == 0) PG8_BAR; }
        if constexpr (!Epi::AFTER_DRAIN) { E(acc, cur, wr, wc, fr, fq); S.done(cur); }
        if (!has_next) break;
#pragma unroll
        for (int a = 0; a < 2; ++a)
#pragma unroll
            for (int b = 0; b < 2; ++b)
#pragma unroll
                for (int m = 0; m < 4; ++m)
#pragma unroll
                    for (int n = 0; n < 2; ++n) acc[a][b][m][n] = (f32x4){0.f, 0.f, 0.f, 0.f};
        cur = nxt; cA = nA; cB = nB; ++ui;
        if constexpr (ALIGN_EPI) { if (wr == 1) PG8_BAR; }
    }
    PG8_WAIT_V(0);
    if constexpr (!ALIGN_EPI) { if (wr == 0) PG8_BAR; }
    PG8_BAR;
    if constexpr (Epi::AFTER_DRAIN) { E.fused(acc, cur, wr, wc, fr, fq, lds, wid, lane); S.done(cur); }
#undef PG8_SA
#undef PG8_SB
#undef PG8_STAGE
#undef PG8_LDA
#undef PG8_LDB
#undef PG8_MMA
#undef PG8_WAIT_V
#undef PG8_WAIT_L
#undef PG8_BAR
#undef PG8_SCHED
}
}
#include <hip/hip_bf16.h>
#include <cmath>
namespace attn_body {
using bf16=__hip_bfloat16;
using bf16x8=__attribute__((ext_vector_type(8)))short;
using s16x4=__attribute__((ext_vector_type(4)))short;
using f32x16=__attribute__((ext_vector_type(16)))float;
using u32x4=__attribute__((ext_vector_type(4)))unsigned;
using f32x4=__attribute__((ext_vector_type(4)))float;
constexpr int BATCH=4,NHEAD=8,SEQ=4096,D=64,DM=NHEAD*D,OPITCH=1024;
constexpr int NW=8,QBLK=32,QB=QBLK*NW,KVBLK=64,NQB=SEQ/QB;
constexpr int ATTN_PITCH=DM, ATTN_UNIT_ROWS=QB;
__device__ __forceinline__ int crow(int r,int hi){return (r&3)+8*(r>>2)+4*hi;}
#define SBAR() __builtin_amdgcn_sched_barrier(0)
__device__ __forceinline__ void cmask(f32x16&p0,f32x16&p1,int jb,int qrel,int hi){
  const float NEG=-INFINITY; int kb=64*jb+4*hi;
  #pragma unroll
  for(int r=0;r<16;++r){int kv=kb+(r&3)+8*(r>>2); if(kv>qrel)p0[r]=NEG; if(kv+32>qrel)p1[r]=NEG;}
}

constexpr int NSLOT=3, SLOTB=8192;
constexpr int LDS_K=0, LDS_V=NSLOT*SLOTB, LDS_WS=2*NSLOT*SLOTB, LDS_OST=LDS_WS+NW*64*4, LDS_CB=LDS_OST+NW*4096, LDS_BYTES=LDS_CB+SEQ*4;
constexpr float C2=0.125f*1.4426950408889634f;
__device__ __forceinline__ void glds16(const void*gsrc,unsigned lds_dst){unsigned keep;
  asm volatile("s_mov_b32 %0, m0\n\ts_mov_b32 m0, %2\n\ts_nop 0\n\tglobal_load_lds_dwordx4 %1, off\n\ts_mov_b32 m0, %0":"=&s"(keep):"v"(gsrc),"s"(lds_dst):"memory");}
__device__ __forceinline__ float max3f(float a,float b,float c){float r;asm("v_max3_f32 %0, %1, %2, %3":"=v"(r):"v"(a),"v"(b),"v"(c));return r;}
__device__ __forceinline__ float max2f(float a,float b){float r;asm("v_max_f32_e32 %0, %1, %2":"=v"(r):"v"(a),"v"(b));return r;}
__device__ __forceinline__ float fadd_s(float a,float b){float r;asm("v_add_f32_e32 %0, %1, %2":"=v"(r):"v"(a),"v"(b));return r;}
__device__ __forceinline__ float fsub_s(float a,float b){float r;asm("v_sub_f32_e32 %0, %1, %2":"=v"(r):"v"(a),"v"(b));return r;}
typedef float f32x2_t __attribute__((ext_vector_type(2))); typedef __bf16 bf16x2_t __attribute__((ext_vector_type(2)));
__device__ __forceinline__ unsigned cvtpk_s(float lo,float hi){f32x2_t v={lo,hi};bf16x2_t b=__builtin_convertvector(v,bf16x2_t);return __builtin_bit_cast(unsigned,b);}
#define WAIT_BAR(N) asm volatile("s_waitcnt vmcnt(" #N ") lgkmcnt(0)\n\ts_barrier":::"memory")

__device__ __forceinline__ void qkt(f32x16&p0,f32x16&p1,const char*Kslot,const bf16x8*qr,const char*cbt,int r32,int hi){
  const char*kb=Kslot+hi*1024+r32*16;
  #pragma unroll
  for(int a=0;a<4;++a){ const f32x4 u0=*reinterpret_cast<const f32x4*>(cbt+hi*16+a*32), u1=*reinterpret_cast<const f32x4*>(cbt+128+hi*16+a*32);
    p0[4*a]=u0[0];p0[4*a+1]=u0[1];p0[4*a+2]=u0[2];p0[4*a+3]=u0[3]; p1[4*a]=u1[0];p1[4*a+1]=u1[1];p1[4*a+2]=u1[2];p1[4*a+3]=u1[3]; }
  #pragma unroll
  for(int d0=0;d0<4;++d0){
    const bf16x8 b0=*reinterpret_cast<const bf16x8*>(kb+d0*2048);
    const bf16x8 b1=*reinterpret_cast<const bf16x8*>(kb+d0*2048+512);
    p0=__builtin_amdgcn_mfma_f32_32x32x16_bf16(b0,qr[d0],p0,0,0,0);p1=__builtin_amdgcn_mfma_f32_32x32x16_bf16(b1,qr[d0],p1,0,0,0);}
}
typedef __attribute__((address_space(3))) const char* lds_cptr;
typedef short v4i16_t __attribute__((ext_vector_type(4)));
__device__ __forceinline__ void kload8(bf16x8*kf,lds_cptr kp){
  kf[0]=*(const __attribute__((address_space(3))) bf16x8*)(kp);      kf[1]=*(const __attribute__((address_space(3))) bf16x8*)(kp+512);
  kf[2]=*(const __attribute__((address_space(3))) bf16x8*)(kp+2048); kf[3]=*(const __attribute__((address_space(3))) bf16x8*)(kp+2560);
  kf[4]=*(const __attribute__((address_space(3))) bf16x8*)(kp+4096); kf[5]=*(const __attribute__((address_space(3))) bf16x8*)(kp+4608);
  kf[6]=*(const __attribute__((address_space(3))) bf16x8*)(kp+6144); kf[7]=*(const __attribute__((address_space(3))) bf16x8*)(kp+6656);
}
__device__ __forceinline__ void kload2(bf16x8*kf,lds_cptr kp,int j){ kf[2*j]=*(const __attribute__((address_space(3))) bf16x8*)(kp+j*2048); kf[2*j+1]=*(const __attribute__((address_space(3))) bf16x8*)(kp+j*2048+512); }
__device__ __forceinline__ s16x4 vtr(lds_cptr p){ return __builtin_bit_cast(s16x4,__builtin_amdgcn_ds_read_tr16_b64_v4i16((__attribute__((address_space(3))) v4i16_t*)p)); }
__device__ __forceinline__ float rowmax(const f32x16&p0,const f32x16&p1){
  float a=max3f(p0[0],p0[1],p1[0]),b=max3f(p0[2],p0[3],p1[1]);a=max3f(a,p1[2],p1[3]);
  #pragma unroll
  for(int r=4;r<16;r+=4){a=max3f(a,p0[r],p0[r+1]);b=max3f(b,p0[r+2],p0[r+3]);a=max3f(a,p1[r],p1[r+1]);b=max3f(b,p1[r+2],p1[r+3]);}
  const float m=max2f(a,b);
  auto rr=__builtin_amdgcn_permlane32_swap(__float_as_uint(m),__float_as_uint(m),false,false);
  return max2f(__uint_as_float(rr[0]),__uint_as_float(rr[1]));
}
__device__ __forceinline__ void pv(f32x16*o,int vb,bf16x8 pa0,bf16x8 pa1,bf16x8 pa2,bf16x8 pa3){
  #pragma unroll
  for(int d0=0;d0<2;++d0){s16x4 lo[4],hi[4];
    #pragma unroll
    for(int ks=0;ks<4;++ks){
      asm volatile("ds_read_b64_tr_b16 %0,%1 offset:%c2":"=&v"(lo[ks]):"v"(vb),"i"(d0*4096+ks*1024):"memory");
      asm volatile("ds_read_b64_tr_b16 %0,%1 offset:%c2":"=&v"(hi[ks]):"v"(vb),"i"(d0*4096+ks*1024+512):"memory");}
    asm volatile("s_waitcnt lgkmcnt(0)":::"memory");SBAR();
    #define PK(k) (bf16x8){lo[k][0],lo[k][1],lo[k][2],lo[k][3],hi[k][0],hi[k][1],hi[k][2],hi[k][3]}
    o[d0]=__builtin_amdgcn_mfma_f32_32x32x16_bf16(pa0,PK(0),o[d0],0,0,0);
    o[d0]=__builtin_amdgcn_mfma_f32_32x32x16_bf16(pa1,PK(1),o[d0],0,0,0);
    o[d0]=__builtin_amdgcn_mfma_f32_32x32x16_bf16(pa2,PK(2),o[d0],0,0,0);
    o[d0]=__builtin_amdgcn_mfma_f32_32x32x16_bf16(pa3,PK(3),o[d0],0,0,0);
    #undef PK
  }
}

#ifndef ATTN_STORE16
#define ATTN_STORE16(p,v) (*(u32x4*)(p)=(v))
#endif
template<int THRL> __device__ __forceinline__ void attn_unit(int b,int h,int qb,const bf16*Q,const bf16*__restrict__ K,const bf16*__restrict__ V,bf16*O,const float*__restrict__ CB,const float*__restrict__ NRM,char*shm,bool dry=false){
  int tid_=threadIdx.x; asm volatile("":"+v"(tid_)); const int tid=tid_,lane=tid&63,r32=lane&31,hi=lane>>5; const int wid=__builtin_amdgcn_readfirstlane(tid>>6);
  const long rowbase=(long)b*SEQ; const int q0=qb*QB;
  int t0;
  { const f32x4* cbg=reinterpret_cast<const f32x4*>(CB+(long)(b*NHEAD+h)*SEQ); f32x4* cbl=reinterpret_cast<f32x4*>(shm+LDS_CB); const int nv=(q0+QB)/4;
    for(int i=tid;i<nv;i+=NW*64) cbl[i]=cbg[i];
    const float bnd=NRM[b*NHEAD+h]+40.f;
    asm volatile("s_waitcnt vmcnt(0) lgkmcnt(0)\n\ts_barrier":::"memory");
    const float*cbf=reinterpret_cast<const float*>(shm+LDS_CB); const int tc=2*lane; const int NT0=(q0+QB)/KVBLK;
    const bool ok=(tc<=NT0-4)&&(tc==0||cbf[64*tc-1]+bnd<=cbf[q0]);
    const unsigned long long mk=__ballot(ok); t0=2*(__popcll(mk)-1); t0=__builtin_amdgcn_readfirstlane(t0); }
  const bf16*Qw=Q+(rowbase+q0+wid*QBLK)*DM+h*D;
  const bf16*Kh=K+(rowbase+(long)t0*KVBLK)*DM+h*D,*Vh=V+(rowbase+(long)t0*KVBLK)*DM+h*D;
  const unsigned lds0=(unsigned)(uintptr_t)shm;
  float*wsf=(float*)(shm+LDS_WS)+wid*64;
  const bf16*ksrc=Kh+(long)lane*DM+wid*8;
  const bf16*vsrc=Vh+(long)(16*(wid&3)+(lane>>2))*DM+(wid>>2)*32+(lane&3)*8;
  const unsigned kdst=lds0+LDS_K+wid*1024, vdst=lds0+LDS_V+wid*1024;
  #define DMA_K(t,slot) glds16(ksrc+(long)(t)*KVBLK*DM,(unsigned)__builtin_amdgcn_readfirstlane(kdst+(slot)))
  #define DMA_V(t,slot) glds16(vsrc+(long)(t)*KVBLK*DM,(unsigned)__builtin_amdgcn_readfirstlane(vdst+(slot)))
  const int vb0=(int)(lds0+LDS_V)+((lane>>4)&1)*32+(lane&3)*8+(4*hi+((lane&15)>>2))*64;
  const char*Kbase=shm+LDS_K; bf16x8 kf[8];
  const lds_cptr shm3=(lds_cptr)shm; const lds_cptr kp0=shm3+LDS_K+hi*1024+r32*16; const lds_cptr vp0=shm3+LDS_V+((lane>>4)&1)*32+(lane&3)*8+(4*hi+((lane&15)>>2))*64;
  const int NT=(q0+QB)/KVBLK-t0;
  const lds_cptr cb3=(lds_cptr)shm+LDS_CB+t0*256;
  const float cb_own=*(const __attribute__((address_space(3))) float*)((lds_cptr)shm+LDS_CB+(q0+wid*QBLK+r32)*4);
  DMA_K(0,0);DMA_V(0,0);DMA_K(1,SLOTB);
  bf16x8 qr[4];
  #pragma unroll
  for(int d0=0;d0<4;++d0)qr[d0]=*reinterpret_cast<const bf16x8*>(&Qw[(long)r32*DM+d0*16+hi*8]);
  float mhat=0.f,l_reg=0.f;f32x16 o[2];o[0]=f32x16{};o[1]=f32x16{};
  const int qrel=wid*QBLK+r32;
  #define CMASK(P0,P1,t) do{int jb_=(t)-(NT-4); if(jb_>=0)cmask(P0,P1,jb_,qrel,hi);}while(0)
  bool resc=false;
  #define START(P0,P1) do{ const float rm=max2f(rowmax(P0,P1),cb_own); resc=false; \
    { const float dl=rm; mhat=fadd_s(mhat,dl); \
      _Pragma("unroll") for(int r=0;r<16;++r){P0[r]=fsub_s(P0[r],dl);P1[r]=fsub_s(P1[r],dl);} } \
    _Pragma("unroll") for(int r=0;r<16;++r)P0[r]=__builtin_amdgcn_exp2f(P0[r]); }while(0)
  #define RESC() do{ if(resc){ asm volatile("s_waitcnt lgkmcnt(0)":::"memory"); \
      _Pragma("unroll") for(int d_=0;d_<2;++d_) _Pragma("unroll") for(int r=0;r<16;++r)o[d_][r]*=wsf[crow(r,hi)]; } }while(0)
  f32x16 pA0,pA1,pB0,pB1;
  int sl_prev=0,sl_cur=0,sl_next=SLOTB;
  #define ROT() do{sl_prev=sl_cur;sl_cur=sl_next;sl_next=(sl_next==(NSLOT-1)*SLOTB)?0:sl_next+SLOTB;}while(0)
  DMA_K(2,2*SLOTB);
  WAIT_BAR(3);
  qkt(pA0,pA1,Kbase,qr,shm+LDS_CB+t0*256,r32,hi);asm volatile("s_nop 15\n\ts_nop 7":"+v"(pA0),"+v"(pA1));CMASK(pA0,pA1,0);
  START(pA0,pA1);
  _Pragma("unroll") for(int r=0;r<16;++r)pA1[r]=__builtin_amdgcn_exp2f(pA1[r]);
  WAIT_BAR(0);
  DMA_K(3,0);DMA_V(1,SLOTB);
  ROT();
  kload8(kf,kp0+sl_cur);
  WAIT_BAR(2);
  s16x4 vlo[8],vhi[8]; u32x4 pw0,pw1,pw2,pw3;
  #define PKW(P,B) cvtpk_s(P[B],P[B+1])
  #define PAF(k) __builtin_bit_cast(bf16x8,pw##k)
  #define VFR(i) (bf16x8){vlo[i][0],vlo[i][1],vlo[i][2],vlo[i][3],vhi[i][0],vhi[i][1],vhi[i][2],vhi[i][3]}
  #define PIN(x) asm volatile("":"+v"(x))
  #define MX3(a,b,c) __builtin_fmaxf(__builtin_fmaxf((a),(b)),(c))
  #define GAPA(MF,A0,A1,A2,A3,W0,W1,PW) do{ MF; sacc+=A0; sacc+=A1; sacc+=A2; sacc+=A3; PIN(sacc); W0; W1; PIN(PW); SBAR(); }while(0)
  #define EX(v) __builtin_amdgcn_exp2f(v)
  #define GAPB(MF,X,B) do{ MF; X[B]=EX(X[B]); X[B+1]=EX(X[B+1]); X[B+2]=EX(X[B+2]); X[B+3]=EX(X[B+3]); PIN(X); SBAR(); }while(0)
  #define VRD(i) do{ vlo[i]=vtr(vp_+(((i)>>2)*4096+((i)&3)*1024)); vhi[i]=vtr(vp_+(((i)>>2)*4096+((i)&3)*1024+512)); }while(0)
  #define KRD(G,j) do{ if(G){ kload2(kf,kp0+sl_next,j); SBAR(); } }while(0)
  #define STEP(C0,C1,P0,P1,t,GK,GV,GL) do{ SBAR(); \
    const lds_cptr vp_=vp0+sl_prev; \
    VRD(0); SBAR(); float sacc=(P0[0]+P0[1]); \
    GAPA(C0=__builtin_amdgcn_mfma_f32_32x32x16_bf16(kf[0],qr[0],C0,0,0,0), P0[2],P0[3],P0[4],P0[5],     pw0[0]=PKW(P0,0), pw0[1]=PKW(P0,2), pw0); \
    VRD(4); SBAR(); GAPA(C1=__builtin_amdgcn_mfma_f32_32x32x16_bf16(kf[1],qr[0],C1,0,0,0), P0[6],P0[7],P0[8],P0[9],     pw0[2]=PKW(P0,4), pw0[3]=PKW(P0,6), pw0); \
    VRD(1); SBAR(); GAPA(C0=__builtin_amdgcn_mfma_f32_32x32x16_bf16(kf[2],qr[1],C0,0,0,0),   P0[10],P0[11],P0[12],P0[13], pw1[0]=PKW(P0,8), pw1[1]=PKW(P0,10), pw1); \
    VRD(5); SBAR(); GAPA(C1=__builtin_amdgcn_mfma_f32_32x32x16_bf16(kf[3],qr[1],C1,0,0,0),   P0[14],P0[15],P1[0],P1[1],   pw1[2]=PKW(P0,12),pw1[3]=PKW(P0,14), pw1); \
    VRD(2); SBAR(); GAPA(C0=__builtin_amdgcn_mfma_f32_32x32x16_bf16(kf[4],qr[2],C0,0,0,0),   P1[2],P1[3],P1[4],P1[5],     pw2[0]=PKW(P1,0), pw2[1]=PKW(P1,2), pw2); \
    VRD(6); SBAR(); GAPA(C1=__builtin_amdgcn_mfma_f32_32x32x16_bf16(kf[5],qr[2],C1,0,0,0),   P1[6],P1[7],P1[8],P1[9],     pw2[2]=PKW(P1,4), pw2[3]=PKW(P1,6), pw2); \
    VRD(3); SBAR(); GAPA(C0=__builtin_amdgcn_mfma_f32_32x32x16_bf16(kf[6],qr[3],C0,0,0,0),   P1[10],P1[11],P1[12],P1[13], pw3[0]=PKW(P1,8), pw3[1]=PKW(P1,10), pw3); \
    VRD(7); SBAR(); GAPA(C1=__builtin_amdgcn_mfma_f32_32x32x16_bf16(kf[7],qr[3],C1,0,0,0),   P1[14],P1[15],0.f,0.f,       pw3[2]=PKW(P1,12),pw3[3]=PKW(P1,14), pw3); \
    l_reg+=sacc; \
    if(GK){DMA_K((t)+3,sl_cur);} if(GV){DMA_V((t)+1,sl_next);} \
    CMASK(C0,C1,t); \
    { float a=MX3(C0[0],C0[1],C1[0]),b=MX3(C0[2],C0[3],C1[1]); a=MX3(a,C1[2],C1[3]); \
      _Pragma("unroll") for(int r=4;r<16;r+=4){a=MX3(a,C0[r],C0[r+1]);b=MX3(b,C0[r+2],C0[r+3]);a=MX3(a,C1[r],C1[r+1]);b=MX3(b,C1[r+2],C1[r+3]);} \
      float rm=__builtin_fmaxf(a,b); { auto rr=__builtin_amdgcn_permlane32_swap(__float_as_uint(rm),__float_as_uint(rm),false,false); rm=__builtin_fmaxf(__uint_as_float(rr[0]),__uint_as_float(rr[1])); } \
      resc=false; \
      if(__builtin_expect(__any(rm>(float)THRL),0)){ const float dl=__builtin_fmaxf(rm,0.f); mhat+=dl; \
        _Pragma("unroll") for(int r=0;r<16;++r){C0[r]-=dl;C1[r]-=dl;} \
        const float f=__builtin_amdgcn_exp2f(-dl); l_reg*=f; if(hi==0)wsf[r32]=f; resc=true; } } \
    SBAR(); \
    { const __attribute__((address_space(3))) f32x4* cbp_=(const __attribute__((address_space(3))) f32x4*)(cb3+((t)+1)*256+hi*16); \
      _Pragma("unroll") for(int a_=0;a_<4;++a_){ const f32x4 u0_=cbp_[2*a_], u1_=cbp_[8+2*a_]; \
        P0[4*a_]=u0_[0];P0[4*a_+1]=u0_[1];P0[4*a_+2]=u0_[2];P0[4*a_+3]=u0_[3]; P1[4*a_]=u1_[0];P1[4*a_+1]=u1_[1];P1[4*a_+2]=u1_[2];P1[4*a_+3]=u1_[3]; } } SBAR(); \
    GAPB(o[0]=__builtin_amdgcn_mfma_f32_32x32x16_bf16(PAF(0),VFR(0),o[0],0,0,0), C0,0); \
    GAPB(o[1]=__builtin_amdgcn_mfma_f32_32x32x16_bf16(PAF(0),VFR(4),o[1],0,0,0), C0,4); \
    KRD(GL,0); GAPB(o[0]=__builtin_amdgcn_mfma_f32_32x32x16_bf16(PAF(1),VFR(1),o[0],0,0,0), C0,8); \
    KRD(GL,1); GAPB(o[1]=__builtin_amdgcn_mfma_f32_32x32x16_bf16(PAF(1),VFR(5),o[1],0,0,0), C0,12); \
    KRD(GL,2); GAPB(o[0]=__builtin_amdgcn_mfma_f32_32x32x16_bf16(PAF(2),VFR(2),o[0],0,0,0), C1,0); \
    KRD(GL,3); GAPB(o[1]=__builtin_amdgcn_mfma_f32_32x32x16_bf16(PAF(2),VFR(6),o[1],0,0,0), C1,4); \
    GAPB(o[0]=__builtin_amdgcn_mfma_f32_32x32x16_bf16(PAF(3),VFR(3),o[0],0,0,0), C1,8); \
    GAPB(o[1]=__builtin_amdgcn_mfma_f32_32x32x16_bf16(PAF(3),VFR(7),o[1],0,0,0), C1,12); \
    _Pragma("unroll") for(int r_=0;r_<16;++r_){P0[r_]-=mhat;P1[r_]-=mhat;} \
    }while(0)
  { const __attribute__((address_space(3))) f32x4* cbp_=(const __attribute__((address_space(3))) f32x4*)(cb3+256+hi*16);
    #pragma unroll
    for(int a_=0;a_<4;++a_){ const f32x4 u0_=cbp_[2*a_], u1_=cbp_[8+2*a_];
      pB0[4*a_]=u0_[0]-mhat;pB0[4*a_+1]=u0_[1]-mhat;pB0[4*a_+2]=u0_[2]-mhat;pB0[4*a_+3]=u0_[3]-mhat;
      pB1[4*a_]=u1_[0]-mhat;pB1[4*a_+1]=u1_[1]-mhat;pB1[4*a_+2]=u1_[2]-mhat;pB1[4*a_+3]=u1_[3]-mhat; } }
  int t=1;
  #undef CMASK
  #define CMASK(P0,P1,t) do{}while(0)
  for(;t+5<NT;t+=2){
    STEP(pB0,pB1,pA0,pA1,t,true,true,true);     WAIT_BAR(2); RESC(); ROT();
    STEP(pA0,pA1,pB0,pB1,t+1,true,true,true);   WAIT_BAR(2); RESC(); ROT();
  }
  #undef CMASK
  #define CMASK(P0,P1,t) do{int jb_=(t)-(NT-4); if(jb_>=0)cmask(P0,P1,jb_,qrel,hi);}while(0)
  #define ENDW(tt) do{ if((tt)+3<NT){WAIT_BAR(2);} else if((tt)+2<NT){WAIT_BAR(1);} else {WAIT_BAR(0);} }while(0)
  for(;t+1<NT;t+=2){
    STEP(pB0,pB1,pA0,pA1,t,(t+3<NT),(t+1<NT),(t+1<NT));       ENDW(t);   RESC(); ROT();
    STEP(pA0,pA1,pB0,pB1,t+1,(t+4<NT),(t+2<NT),(t+2<NT));     ENDW(t+1); RESC(); ROT();
  }
  STEP(pB0,pB1,pA0,pA1,NT-1,false,false,false); RESC();
  { float sacc=pB0[0]+pB0[1]; _Pragma("unroll") for(int r=2;r<16;++r)sacc+=pB0[r]; _Pragma("unroll") for(int r=0;r<16;++r)sacc+=pB1[r]; l_reg+=sacc;
    pw0=(u32x4){PKW(pB0,0),PKW(pB0,2),PKW(pB0,4),PKW(pB0,6)};pw1=(u32x4){PKW(pB0,8),PKW(pB0,10),PKW(pB0,12),PKW(pB0,14)};pw2=(u32x4){PKW(pB1,0),PKW(pB1,2),PKW(pB1,4),PKW(pB1,6)};pw3=(u32x4){PKW(pB1,8),PKW(pB1,10),PKW(pB1,12),PKW(pB1,14)};
    SBAR(); pv(o,vb0+sl_cur,PAF(0),PAF(1),PAF(2),PAF(3)); }
  #undef PKW
  #undef PAF
  #undef VFR
  #undef PIN
  #undef MX3
  #undef GAPA
  #undef GAPB
  #undef EX
  #undef VRD
  #undef KRD
  #undef STEP
  #undef ENDW
  {auto rr=__builtin_amdgcn_permlane32_swap(__float_as_uint(l_reg),__float_as_uint(l_reg),false,false);l_reg=__uint_as_float(rr[0])+__uint_as_float(rr[1]);}
  if(hi==0)wsf[32+r32]=l_reg;asm volatile("s_waitcnt lgkmcnt(0)":::"memory");
  float rli[16];
  #pragma unroll
  for(int r=0;r<16;++r)rli[r]=__builtin_amdgcn_rcpf(wsf[32+crow(r,hi)]);
  bf16*Ow=O+(rowbase+q0+wid*QBLK)*OPITCH+h*D;
  { bf16*stg=(bf16*)(shm+LDS_OST)+wid*2048;
    #pragma unroll
    for(int r=0;r<16;++r){const int orow=crow(r,hi);
      #pragma unroll
      for(int d0=0;d0<2;++d0)stg[orow*64+d0*32+r32]=__float2bfloat16(o[d0][r]*rli[r]);}
    asm volatile("s_waitcnt lgkmcnt(0)":::"memory");
    #pragma unroll
    for(int i=0;i<4;++i){const int row=i*8+(lane>>3),ch=lane&7; const u32x4 v=*(const u32x4*)(stg+row*64+ch*8); bf16*dst=Ow+(long)row*OPITCH+ch*8; const u32x4 gv=*(const u32x4*)dst; u32x4 w;
      #pragma unroll
      for(int j=0;j<4;++j){ const float a0=__uint_as_float(v[j]<<16)*__uint_as_float(gv[j]<<16), a1=__uint_as_float(v[j]&0xffff0000u)*__uint_as_float(gv[j]&0xffff0000u); w[j]=cvtpk_s(a0,a1); }
      if(!dry)*(u32x4*)dst=w;} }
  asm volatile("s_waitcnt lgkmcnt(0)\n\ts_barrier":::"memory");
  #undef DMA_K
  #undef DMA_V
  #undef CMASK
  #undef START
  #undef RESC
  #undef ROT
}
constexpr int ATTN_LDS_BYTES=LDS_BYTES;
struct AttnTensors { const bf16* Q; const bf16* K; const bf16* V; bf16* O; const float* CB; const float* NRM; };
struct AttnUnit { int bh; int qb; };
struct StaticOrder {
  int vcu;
  __device__ __forceinline__ explicit StaticOrder(int grid,int block):vcu((block%8)*(grid/8)+block/8){}
  __device__ __forceinline__ bool next(int i,AttnUnit&u)const{ if(i>=2)return false; const int s=vcu&7; u.bh=vcu>>3; u.qb=(i==0)?15-s:s; return true; }
  __device__ __forceinline__ void a_ready(const AttnUnit&)const{}
  __device__ __forceinline__ void done(const AttnUnit&)const{}
};
template<class Sched,int THRL=8> __device__ __forceinline__ void attn_phase(char*lds,const AttnTensors&T,const Sched&S,bool dry=false){
  AttnUnit u;
  for(int i=0;S.next(i,u);++i){ S.a_ready(u); attn_unit<THRL>(u.bh/NHEAD,u.bh%NHEAD,u.qb,T.Q,T.K,T.V,T.O,T.CB,T.NRM,lds,dry); S.done(u); }
}
#undef SBAR
#undef WAIT_BAR
}
#include <hip/hip_cooperative_groups.h>
namespace cg = cooperative_groups;
#define LAS __attribute__((address_space(3)))
typedef unsigned short bf16;
typedef float f32x4 __attribute__((ext_vector_type(4)));
typedef float f32x2 __attribute__((ext_vector_type(2)));
typedef unsigned u32x4 __attribute__((ext_vector_type(4)));
typedef unsigned u32x2 __attribute__((ext_vector_type(2)));
typedef short bf16x8 __attribute__((ext_vector_type(8)));
typedef short bf16x4 __attribute__((ext_vector_type(4)));

constexpr int NWAVES = 8, NTHR = 512;
constexpr int BATCH = 4, SEQ = 4096, DM = 1024, DEPTH = 4, M = BATCH * SEQ;
constexpr int NIN = 3592, NF = 3584;
constexpr int T5 = 32, NCH5 = M / T5, KA5 = 640, NG5 = 16;
constexpr float EPS = 1e-6f;
constexpr float LOG2E = 1.4426950408889634f;

constexpr size_t MiB = 1u << 20;
constexpr size_t WS_WIN = 1 * MiB, WS_WO = 31 * MiB, WS_WGLU = 39 * MiB, WS_ROPE = 40 * MiB, WS_MF = 41 * MiB, WS_WB = 81 * MiB;
constexpr size_t WS_LAM = 90 * MiB, WS_LOGF = 90 * MiB + 65536, WS_CB = WS_LOGF + 524288, WS_SS = WS_CB + 524288, WS_NRM = WS_SS + 131072, WS_XBUF = WS_NRM + 4096;
constexpr size_t WS_XN = 92 * MiB, WS_E = WS_XN, WS_UPD = WS_XN + 4 * MiB, WS_STATE = WS_XN + 20 * MiB;
constexpr size_t WS_QO = 124 * MiB, WS_KB = 140 * MiB, WS_VB = 156 * MiB, WS_SUA = 172 * MiB, WS_RQ = 182 * MiB, WS_RK = 190 * MiB, WS_RKT = 198 * MiB, WS_YS5 = WS_RKT;
constexpr size_t WS_RVT = 206 * MiB, WS_GATE = 214 * MiB, WS_END = 246 * MiB;

constexpr int RING_BYTES = 131072, LDS_BYTES = 147456;

struct Args { const float* in[16]; float* out; unsigned char* ws; };

__device__ __forceinline__ float bf2f(unsigned short b) { return __uint_as_float((unsigned)b << 16); }
__device__ __forceinline__ float bflo(unsigned w) { return __uint_as_float(w << 16); }
__device__ __forceinline__ float bfhi(unsigned w) { return __uint_as_float(w & 0xffff0000u); }
__device__ __forceinline__ unsigned pk2(float lo, float hi) { return pg8::cvt_pk_bf16(lo, hi); }
__device__ __forceinline__ unsigned short f2bf(float f) { return (unsigned short)(pg8::cvt_pk_bf16(f, 0.f) & 0xffffu); }
__device__ __forceinline__ float wave_sum(float v) {
#pragma unroll
    for (int o = 1; o < 64; o <<= 1) v += __shfl_xor(v, o);
    return v;
}
__device__ __forceinline__ float lg2_gamma(int hh) { return log2f(1.0f - exp2f(-5.0f - (float)hh)); }

__device__ __forceinline__ int win_col(int n) {
    if (n < 1536) return n;
    if (n < 1792) return n + 8;
    if (n < 2304) { const bool q = n < 2048; const int base = q ? 1792 : 2048; const int hh = (n - base) >> 6, pos = (n - base) & 63; const int d = (pos & 1) ? 32 + (pos >> 1) : (pos >> 1); return (q ? 1800 : 2056) + hh * 64 + d; }
    return n + 8;
}
template <bool MAP> __device__ __forceinline__ void p0_transpose_item(const float* W, int K, int Nsrc, int Ndst, bf16* WT, LAS float* scr, int item, int lane) {
    const int nblk = Ndst / 32, kb = item / nblk, nb = item % nblk, k0 = 64 * kb, n0 = 32 * nb;
    const int sc = MAP ? win_col(n0 + (lane & 31)) : n0 + (lane & 31);
    float wv[32];
#pragma unroll
    for (int i = 0; i < 32; ++i) { const int kk = 2 * i + (lane >> 5); wv[i] = (MAP && sc < 0) ? 0.f : W[(size_t)(k0 + kk) * Nsrc + (sc < 0 ? 0 : sc)]; }
#pragma unroll
    for (int i = 0; i < 32; ++i) { const int kk = 2 * i + (lane >> 5); scr[kk * 33 + (lane & 31)] = wv[i]; }
    asm volatile("s_waitcnt lgkmcnt(0)" ::: "memory");
    const int c = lane & 7;
#pragma unroll
    for (int j = 0; j < 4; ++j) { const int n = (lane >> 3) + 8 * j; const LAS float* s = scr + (8 * c) * 33 + n;
        u32x4 o; o.x = pk2(s[0 * 33], s[1 * 33]); o.y = pk2(s[2 * 33], s[3 * 33]); o.z = pk2(s[4 * 33], s[5 * 33]); o.w = pk2(s[6 * 33], s[7 * 33]);
        *(u32x4*)(WT + (size_t)(n0 + n) * K + k0 + 8 * c) = o; }
    asm volatile("s_waitcnt lgkmcnt(0)" ::: "memory");
}

__device__ __forceinline__ void s5_prep(const Args& a, int l, int g, LAS float* L, int tid) {
    LAS float* LPr = L;
    LAS float* LPi = L + 33 * 64;
    LAS float* Bbr = L + 66 * 64;
    LAS float* Bbi = Bbr + 1024;
    LAS float* Cr = Bbi + 1024;
    LAS float* Ci = Cr + 1024;
    LAS float* KT = Ci + 1024;
    const float* a_re = a.in[4] + (size_t)(l * 16 + g) * 64; const float* a_im = a.in[5] + (size_t)(l * 16 + g) * 64;
    const float* b_re = a.in[6] + (size_t)(l * 16 + g) * 1024; const float* b_im = a.in[7] + (size_t)(l * 16 + g) * 1024;
    const float* c_re = a.in[8] + (size_t)(l * 16 + g) * 1024; const float* c_im = a.in[9] + (size_t)(l * 16 + g) * 1024;
    const float log_dt = a.in[11][l * 16 + g];
    bf16* MF = (bf16*)(a.ws + WS_MF) + (size_t)(l * 16 + g) * 512 * KA5;
    bf16* WB = (bf16*)(a.ws + WS_WB) + (size_t)(l * 16 + g) * 128 * 512;
    float* LAM = (float*)(a.ws + WS_LAM) + (size_t)(l * 16 + g) * 128;
    if (tid < 64) {
        const int p = tid;
        const double dt = exp((double)log_dt), ar = (double)a_re[p], ai = (double)a_im[p];
        const double mag = exp(ar * dt); double sn, cs; sincos(ai * dt, &sn, &cs);
        const double lr = mag * cs, li = mag * sn, den = ar * ar + ai * ai;
        const double fr = ((lr - 1.0) * ar + li * ai) / den, fi = (li * ar - (lr - 1.0) * ai) / den;
#pragma unroll 4
        for (int h = 0; h < 16; ++h) { const double br = (double)b_re[p * 16 + h], bi = (double)b_im[p * 16 + h]; Bbr[p * 16 + h] = (float)(fr * br - fi * bi); Bbi[p * 16 + h] = (float)(fr * bi + fi * br); }
        double pr = 1.0, pi = 0.0;
        for (int j = 0; j <= 32; ++j) { LPr[j * 64 + p] = (float)pr; LPi[j * 64 + p] = (float)pi; const double nr = pr * lr - pi * li, ni = pr * li + pi * lr; pr = nr; pi = ni; }
        LAM[p] = LPr[32 * 64 + p]; LAM[64 + p] = LPi[32 * 64 + p];
    }
    for (int i = tid; i < 1024; i += NTHR) { const int h = i >> 6, p = i & 63; Cr[p * 16 + h] = c_re[i]; Ci[p * 16 + h] = c_im[i]; }
    __syncthreads();
    { const int j = tid >> 4, h = tid & 15; float acc[16];
#pragma unroll
      for (int e = 0; e < 16; ++e) acc[e] = 0.f;
      for (int p = 0; p < 64; ++p) { const float cr = Cr[p * 16 + h], ci = Ci[p * 16 + h], lr = LPr[j * 64 + p], li = LPi[j * 64 + p]; const float clr = cr * lr - ci * li, cli = cr * li + ci * lr;
#pragma unroll
          for (int q = 0; q < 4; ++q) { const f32x4 br = *(const LAS f32x4*)(Bbr + p * 16 + 4 * q), bi = *(const LAS f32x4*)(Bbi + p * 16 + 4 * q);
              acc[4 * q] += clr * br.x - cli * bi.x; acc[4 * q + 1] += clr * br.y - cli * bi.y; acc[4 * q + 2] += clr * br.z - cli * bi.z; acc[4 * q + 3] += clr * br.w - cli * bi.w; } }
#pragma unroll
      for (int e = 0; e < 16; ++e) KT[tid * 16 + e] = acc[e]; }
    __syncthreads();
    for (int q = tid; q < 512 * 64; q += NTHR) {
        const int row = q >> 6, cp = q & 63, s = cp >> 1, h0 = (cp & 1) * 8, t = row >> 4, h = row & 15;
        u32x4 o = (u32x4){0u, 0u, 0u, 0u};
        if (s <= t) { const LAS float* k = KT + ((t - s) * 16 + h) * 16 + h0; o.x = pk2(k[0], k[1]); o.y = pk2(k[2], k[3]); o.z = pk2(k[4], k[5]); o.w = pk2(k[6], k[7]); }
        *(u32x4*)(MF + (size_t)row * KA5 + cp * 8) = o;
    }
    for (int q = tid; q < 512 * 16; q += NTHR) {
        const int row = q >> 4, cp = q & 15, t = row >> 4, h = row & 15; float v[8];
#pragma unroll
        for (int e = 0; e < 8; ++e) { const int jj = cp * 8 + e, p = jj & 63; const float cr = Cr[p * 16 + h], ci = Ci[p * 16 + h], lr = LPr[(t + 1) * 64 + p], li = LPi[(t + 1) * 64 + p];
            v[e] = (jj < 64) ? (cr * lr - ci * li) : -(cr * li + ci * lr); }
        u32x4 o; o.x = pk2(v[0], v[1]); o.y = pk2(v[2], v[3]); o.z = pk2(v[4], v[5]); o.w = pk2(v[6], v[7]);
        *(u32x4*)(MF + (size_t)row * KA5 + 512 + cp * 8) = o;
    }
    for (int q = tid; q < 128 * 64; q += NTHR) {
        const int j = q >> 6, cp = q & 63, s = cp >> 1, h0 = (cp & 1) * 8, p = j & 63; const float lr = LPr[(31 - s) * 64 + p], li = LPi[(31 - s) * 64 + p]; float v[8];
#pragma unroll
        for (int e = 0; e < 8; ++e) { const float br = Bbr[p * 16 + h0 + e], bi = Bbi[p * 16 + h0 + e]; v[e] = (j < 64) ? (lr * br - li * bi) : (lr * bi + li * br); }
        u32x4 o; o.x = pk2(v[0], v[1]); o.y = pk2(v[2], v[3]); o.z = pk2(v[4], v[5]); o.w = pk2(v[6], v[7]);
        *(u32x4*)(WB + (size_t)j * 512 + cp * 8) = o;
    }
    __syncthreads();
}

__device__ __forceinline__ void norm0_phase(const Args& a, int lane, int gw, int NGW) {
    const float* X = a.in[0]; f32x4 gv[4];
#pragma unroll
    for (int j = 0; j < 4; ++j) gv[j] = *((const f32x4*)a.in[1] + lane + 64 * j);
    bf16* XN = (bf16*)(a.ws + WS_XN); float* SS = (float*)(a.ws + WS_SS);
    for (int m = gw; m < M; m += 2 * NGW) {
        const int m2 = m + NGW; const bool has2 = m2 < M;
        const f32x4* xr = (const f32x4*)(X + (size_t)m * DM) + lane; const f32x4* xr2 = (const f32x4*)(X + (size_t)(has2 ? m2 : m) * DM) + lane; f32x4 v[4], w[4];
#pragma unroll
        for (int j = 0; j < 4; ++j) { v[j] = xr[64 * j]; w[j] = xr2[64 * j]; }
        float ss = 0.f, ss2 = 0.f;
#pragma unroll
        for (int j = 0; j < 4; ++j) { ss += (v[j].x * v[j].x + v[j].y * v[j].y) + (v[j].z * v[j].z + v[j].w * v[j].w); ss2 += (w[j].x * w[j].x + w[j].y * w[j].y) + (w[j].z * w[j].z + w[j].w * w[j].w); }
        ss = wave_sum(ss); ss2 = wave_sum(ss2);
        unsigned long long* o8 = (unsigned long long*)(XN + (size_t)m * DM) + lane; unsigned long long* o82 = (unsigned long long*)(XN + (size_t)m2 * DM) + lane;
        const float r1_ = rsqrtf(ss * (1.f / DM) + EPS), r2_ = rsqrtf(ss2 * (1.f / DM) + EPS);
#pragma unroll
        for (int j = 0; j < 4; ++j) { v[j] = v[j] * gv[j] * r1_; o8[64 * j] = (unsigned long long)pk2(v[j].x, v[j].y) | ((unsigned long long)pk2(v[j].z, v[j].w) << 32);
            if (has2) { w[j] = w[j] * gv[j] * r2_; o82[64 * j] = (unsigned long long)pk2(w[j].x, w[j].y) | ((unsigned long long)pk2(w[j].z, w[j].w) << 32); } }
        if (lane == 0) { SS[m] = ss; if (has2) SS[m2] = ss2; }
    }
}
__device__ __forceinline__ void final_norm(const Args& a, float* X, const float* SS, int lane, int gw, int NGW) {
    f32x4 gv[4];
#pragma unroll
    for (int j = 0; j < 4; ++j) gv[j] = *((const f32x4*)a.in[15] + lane + 64 * j);
    for (int m = gw; m < M; m += 2 * NGW) {
        const int m2 = m + NGW; const bool has2 = m2 < M;
        f32x4* xr = (f32x4*)(X + (size_t)m * DM) + lane; f32x4* xr2 = (f32x4*)(X + (size_t)(has2 ? m2 : m) * DM) + lane; f32x4 v[4], w[4];
#pragma unroll
        for (int j = 0; j < 4; ++j) { v[j] = xr[64 * j]; w[j] = xr2[64 * j]; }
        const float r1 = rsqrtf(SS[m] * (1.f / DM) + EPS), r2 = rsqrtf(SS[has2 ? m2 : m] * (1.f / DM) + EPS);
#pragma unroll
        for (int j = 0; j < 4; ++j) { xr[64 * j] = v[j] * r1 * gv[j]; if (has2) xr2[64 * j] = w[j] * r2 * gv[j]; }
    }
}

__device__ __forceinline__ void flog_phase(const Args& a, int l, const float* SS, LAS float* WF, int tid, int lane, int wave, int blk, int nblk) {
    const float* win = a.in[2] + (size_t)l * DM * NIN;
    for (int i = tid; i < 2048; i += NTHR) { const int k = i >> 1, hf = i & 1; *(LAS f32x4*)(WF + k * 8 + hf * 4) = *(const f32x4*)(win + (size_t)k * NIN + 1536 + hf * 4); }
    __syncthreads();
    const bf16* XN = (const bf16*)(a.ws + WS_XN); float* LOGF = (float*)(a.ws + WS_LOGF);
    const float bfj = (lane < 8) ? a.in[3][l * 8 + lane] : 0.f;
    const int rows_per = M / nblk;
    for (int i = wave; i < rows_per; i += 2 * NWAVES) {
        const int m = blk * rows_per + i, m2 = m + NWAVES; const bool has2 = (i + NWAVES) < rows_per;
        const u32x4 x0 = *((const u32x4*)(XN + (size_t)m * DM) + lane), x1 = *((const u32x4*)(XN + (size_t)m * DM + 512) + lane);
        const u32x4 y0 = *((const u32x4*)(XN + (size_t)(has2 ? m2 : m) * DM) + lane), y1 = *((const u32x4*)(XN + (size_t)(has2 ? m2 : m) * DM + 512) + lane);
        float acc[8], acc2[8];
#pragma unroll
        for (int e = 0; e < 8; ++e) { acc[e] = 0.f; acc2[e] = 0.f; }
#pragma unroll
        for (int hf = 0; hf < 2; ++hf)
#pragma unroll
            for (int q = 0; q < 8; ++q) { const int k = 512 * hf + 8 * lane + q; const f32x4 w0 = *(const LAS f32x4*)(WF + k * 8), w1 = *(const LAS f32x4*)(WF + k * 8 + 4);
                const unsigned xw = hf ? x1[q >> 1] : x0[q >> 1], yw = hf ? y1[q >> 1] : y0[q >> 1]; const float hv = (q & 1) ? bfhi(xw) : bflo(xw), hv2 = (q & 1) ? bfhi(yw) : bflo(yw);
                acc[0] += hv * w0.x; acc[1] += hv * w0.y; acc[2] += hv * w0.z; acc[3] += hv * w0.w; acc[4] += hv * w1.x; acc[5] += hv * w1.y; acc[6] += hv * w1.z; acc[7] += hv * w1.w;
                acc2[0] += hv2 * w0.x; acc2[1] += hv2 * w0.y; acc2[2] += hv2 * w0.z; acc2[3] += hv2 * w0.w; acc2[4] += hv2 * w1.x; acc2[5] += hv2 * w1.y; acc2[6] += hv2 * w1.z; acc2[7] += hv2 * w1.w; }
        float mine = 0.f, mine2 = 0.f;
#pragma unroll
        for (int e = 0; e < 8; ++e) { const float s = wave_sum(acc[e]), s2 = wave_sum(acc2[e]); if (lane == e) { mine = s; mine2 = s2; } }
        if (lane < 8) { const float z = mine + bfj; LOGF[(size_t)((m >> 12) * 8 + lane) * SEQ + (m & 4095)] = fminf(z, 0.f) - log1pf(expf(-fabsf(z)));
            if (has2) { const float z2 = mine2 + bfj; LOGF[(size_t)((m2 >> 12) * 8 + lane) * SEQ + (m2 & 4095)] = fminf(z2, 0.f) - log1pf(expf(-fabsf(z2))); } }
    }
}

__device__ __forceinline__ bool opaque_true() { int d = 1; asm volatile("" : "+s"(d)); return d != 0; }
struct RangeOrder {
    pg8::StaticOrder S; int lo, hi;
    __device__ bool next(int i, pg8::Unit& u) const { return (lo + i < hi) ? S.next(lo + i, u) : false; }
    __device__ __forceinline__ void a_ready(const pg8::Unit&) const {}
    __device__ __forceinline__ void done(const pg8::Unit&) const {}
};
struct FlatOrder {
    int nM, nN, nG, G, c;
    __device__ bool next(int i, pg8::Unit& u) const { const int L = i * G + c; if (L >= nG * nM * nN) return false; u.gz = L / (nM * nN); const int r = L % (nM * nN); u.pm = r % nM; u.pn = r / nM; return true; }
    __device__ __forceinline__ void a_ready(const pg8::Unit&) const {}
    __device__ __forceinline__ void done(const pg8::Unit&) const {}
};
__device__ __forceinline__ float silu_f(float v) { return v * __builtin_amdgcn_rcpf(1.f + __expf(-v)); }
__device__ __forceinline__ float gelu_tanh(float v) { const float u = 0.7978845608028654f * (v + 0.044715f * v * v * v); const float e = __expf(2.f * u); const float th = 1.f - 2.f * __builtin_amdgcn_rcpf(e + 1.f); return 0.5f * v * (1.f + th); }

struct EpiInProj {
    static constexpr bool PERM = true, AFTER_DRAIN = false;
    unsigned char* ws; const float* SS; const float* bfl;
    __device__ __forceinline__ void operator()(const pg8::f32x4 (&acc)[2][2][4][2], const pg8::Unit& u, int wr, int wc, int fr, int fq) const {
        const int pn = u.pn; const int row0 = u.pm * 256 + wr * 64 + fr, cl0 = wc * 32 + 8 * fq;
        float rs[2][4];
#pragma unroll
        for (int ai = 0; ai < 2; ++ai)
#pragma unroll
            for (int m = 0; m < 4; ++m) rs[ai][m] = 1.f;
        if (pn == 14) {
            if (wc == 0 && fq == 0) { float* LOGF = (float*)(ws + WS_LOGF); const f32x4 b0 = *(const f32x4*)bfl, b1 = *(const f32x4*)(bfl + 4);
#pragma unroll
                for (int ai = 0; ai < 2; ++ai)
#pragma unroll
                    for (int m = 0; m < 4; ++m) { const int row = row0 + ai * 128 + m * 16; const float r = rs[ai][m]; const pg8::f32x4 v0 = acc[ai][0][m][0], v1 = acc[ai][0][m][1];
                        float z[8] = {v0[0] * r + b0.x, v0[1] * r + b0.y, v0[2] * r + b0.z, v0[3] * r + b0.w, v1[0] * r + b1.x, v1[1] * r + b1.y, v1[2] * r + b1.z, v1[3] * r + b1.w};
#pragma unroll
                        for (int e = 0; e < 8; ++e) LOGF[(size_t)((row >> 12) * 8 + e) * SEQ + (row & 4095)] = fminf(z[e], 0.f) - log1pf(__expf(-fabsf(z[e]))); } }
            return;
        }
        if (pn < 6) {
            bf16* base = (bf16*)(ws + (pn < 2 ? WS_QO : pn < 4 ? WS_KB : WS_VB)); const float sc = pn < 2 ? 0.125f * LOG2E : 1.f; const int cb = (pn & 1) * 256 + cl0;
#pragma unroll
            for (int ai = 0; ai < 2; ++ai)
#pragma unroll
                for (int m = 0; m < 4; ++m) { bf16* rp = base + (size_t)(row0 + ai * 128 + m * 16) * 512 + cb;
#pragma unroll
                    for (int bj = 0; bj < 2; ++bj) { const float sr = sc * rs[ai][m]; const pg8::f32x4 v0 = acc[ai][bj][m][0] * sr, v1 = acc[ai][bj][m][1] * sr; u32x4 w; w.x = pk2(v0[0], v0[1]); w.y = pk2(v0[2], v0[3]); w.z = pk2(v1[0], v1[1]); w.w = pk2(v1[2], v1[3]); *(u32x4*)(rp + bj * 128) = w; } }
        } else if (pn == 6) {
            bf16* base = (bf16*)(ws + WS_SUA);
#pragma unroll
            for (int ai = 0; ai < 2; ++ai)
#pragma unroll
                for (int m = 0; m < 4; ++m) { const int row = row0 + ai * 128 + m * 16, chunk = row >> 5, t = row & 31;
#pragma unroll
                    for (int bj = 0; bj < 2; ++bj) { const int c = cl0 + bj * 128, g = c >> 4, h0 = c & 15; const pg8::f32x4 v0 = acc[ai][bj][m][0] * rs[ai][m], v1 = acc[ai][bj][m][1] * rs[ai][m]; u32x4 w; w.x = pk2(v0[0], v0[1]); w.y = pk2(v0[2], v0[3]); w.z = pk2(v1[0], v1[1]); w.w = pk2(v1[2], v1[3]);
                        *(u32x4*)(base + ((size_t)(g * 512 + chunk) * KA5 + t * 16 + h0)) = w; } }
        } else if (pn == 7 || pn == 8) {
            const f32x4* rope = (const f32x4*)(ws + WS_ROPE); bf16* base = (bf16*)(ws + (pn == 7 ? WS_RQ : WS_RK)); bf16* RKT = (bf16*)(ws + WS_RKT);
#pragma unroll
            for (int ai = 0; ai < 2; ++ai)
#pragma unroll
                for (int m = 0; m < 4; ++m) { const int row = row0 + ai * 128 + m * 16, b = row >> 12, t = row & 4095;
#pragma unroll
                    for (int bj = 0; bj < 2; ++bj) { const int c = cl0 + bj * 128, hh = c >> 6, pos0 = c & 63; const pg8::f32x4 v0 = acc[ai][bj][m][0] * rs[ai][m], v1 = acc[ai][bj][m][1] * rs[ai][m];
                        const f32x4 r0 = rope[(t * 32 + (pos0 >> 1)) >> 1], r1 = rope[((t * 32 + (pos0 >> 1)) >> 1) + 1];
                        float o[8];
                        o[0] = v0[0] * r0.x - v0[1] * r0.y; o[1] = v0[0] * r0.y + v0[1] * r0.x; o[2] = v0[2] * r0.z - v0[3] * r0.w; o[3] = v0[2] * r0.w + v0[3] * r0.z;
                        o[4] = v1[0] * r1.x - v1[1] * r1.y; o[5] = v1[0] * r1.y + v1[1] * r1.x; o[6] = v1[2] * r1.z - v1[3] * r1.w; o[7] = v1[2] * r1.w + v1[3] * r1.z;
                        u32x4 w; w.x = pk2(o[0], o[1]); w.y = pk2(o[2], o[3]); w.z = pk2(o[4], o[5]); w.w = pk2(o[6], o[7]);
                        *(u32x4*)(base + (size_t)row * 256 + c) = w;
                        if (pn == 8) { const float wk = exp2f(lg2_gamma(hh) * (float)(63 - (t & 63))); bf16* tp = RKT + ((size_t)((b * 4 + hh) * 64 + pos0)) * SEQ + t;
#pragma unroll
                            for (int e = 0; e < 8; ++e) tp[(size_t)e * SEQ] = f2bf(o[e] * wk); } } }
        } else if (pn == 9) {
            bf16* RVT = (bf16*)(ws + WS_RVT);
#pragma unroll
            for (int ai = 0; ai < 2; ++ai)
#pragma unroll
                for (int m = 0; m < 4; ++m) { const int row = row0 + ai * 128 + m * 16, b = row >> 12, t = row & 4095;
#pragma unroll
                    for (int bj = 0; bj < 2; ++bj) { const int c = cl0 + bj * 128, hh = c >> 6, d0 = c & 63; const pg8::f32x4 v0 = acc[ai][bj][m][0] * rs[ai][m], v1 = acc[ai][bj][m][1] * rs[ai][m]; bf16* tp = RVT + ((size_t)((b * 4 + hh) * 64 + d0)) * SEQ + t;
#pragma unroll
                        for (int e = 0; e < 4; ++e) { tp[(size_t)e * SEQ] = f2bf(v0[e]); tp[(size_t)(4 + e) * SEQ] = f2bf(v1[e]); } } }
        } else {
            bf16* base = (bf16*)(ws + WS_GATE); const int cb = (pn - 10) * 256 + cl0;
#pragma unroll
            for (int ai = 0; ai < 2; ++ai)
#pragma unroll
                for (int m = 0; m < 4; ++m) { bf16* rp = base + (size_t)(row0 + ai * 128 + m * 16) * 1024 + cb;
#pragma unroll
                    for (int bj = 0; bj < 2; ++bj) { const pg8::f32x4 v0 = acc[ai][bj][m][0] * rs[ai][m], v1 = acc[ai][bj][m][1] * rs[ai][m]; u32x4 w; w.x = pk2(silu_f(v0[0]), silu_f(v0[1])); w.y = pk2(silu_f(v0[2]), silu_f(v0[3])); w.z = pk2(silu_f(v1[0]), silu_f(v1[1])); w.w = pk2(silu_f(v1[2]), silu_f(v1[3])); *(u32x4*)(rp + bj * 128) = w; } }
        }
    }
};
struct EpiS5E {
    static constexpr bool PERM = false, AFTER_DRAIN = false;
    float* E;
    __device__ __forceinline__ void operator()(const pg8::f32x4 (&acc)[2][2][4][2], const pg8::Unit& u, int wr, int wc, int fr, int fq) const {
        const int row0 = u.pm * 256 + wr * 64 + fr, col0 = wc * 32 + 4 * fq;
#pragma unroll
        for (int ai = 0; ai < 2; ++ai)
#pragma unroll
            for (int m = 0; m < 4; ++m) { float* rp = E + ((size_t)u.gz * NCH5 + row0 + ai * 128 + m * 16) * 128 + col0;
#pragma unroll
                for (int n = 0; n < 2; ++n) *(pg8::f32x4*)(rp + n * 16) = acc[ai][0][m][n]; }
    }
};
struct EpiS5Y {
    static constexpr bool PERM = true, AFTER_DRAIN = false;
    const bf16* SUA; bf16* YS5; const float* dvec;
    __device__ __forceinline__ void operator()(const pg8::f32x4 (&acc)[2][2][4][2], const pg8::Unit& u, int wr, int wc, int fr, int fq) const {
        const int row0 = u.pm * 256 + wr * 64 + fr, cl0 = u.pn * 256 + wc * 32 + 8 * fq; const int g = u.gz;
#pragma unroll
        for (int bj = 0; bj < 2; ++bj) { const int c = cl0 + bj * 128, tt = c >> 4, h0 = c & 15; const f32x4 d0 = *(const f32x4*)(dvec + g * 16 + h0), d1 = *(const f32x4*)(dvec + g * 16 + h0 + 4);
#pragma unroll
            for (int ai = 0; ai < 2; ++ai)
#pragma unroll
                for (int m = 0; m < 4; ++m) { const int chunk = row0 + ai * 128 + m * 16; const u32x4 uu = *(const u32x4*)(SUA + ((size_t)(g * 512 + chunk) * KA5 + c)); const pg8::f32x4 v0 = acc[ai][bj][m][0], v1 = acc[ai][bj][m][1];
                    float y[8]; y[0] = v0[0] + d0.x * bflo(uu.x); y[1] = v0[1] + d0.y * bfhi(uu.x); y[2] = v0[2] + d0.z * bflo(uu.y); y[3] = v0[3] + d0.w * bfhi(uu.y);
                    y[4] = v1[0] + d1.x * bflo(uu.z); y[5] = v1[1] + d1.y * bfhi(uu.z); y[6] = v1[2] + d1.z * bflo(uu.w); y[7] = v1[3] + d1.w * bfhi(uu.w);
#pragma unroll
                    for (int e = 0; e < 8; ++e) y[e] = gelu_tanh(y[e]);
                    u32x4 w; w.x = pk2(y[0], y[1]); w.y = pk2(y[2], y[3]); w.z = pk2(y[4], y[5]); w.w = pk2(y[6], y[7]);
                    *(u32x4*)(YS5 + (size_t)(chunk * 32 + tt) * 256 + g * 16 + h0) = w; } }
    }
};
struct EpiGlu {
    static constexpr bool PERM = true, AFTER_DRAIN = false;
    const bf16* YS5; bf16* G; bool dry;
    __device__ __forceinline__ void operator()(const pg8::f32x4 (&acc)[2][2][4][2], const pg8::Unit& u, int wr, int wc, int fr, int fq) const {
        const int row0 = u.pm * 256 + wr * 64 + fr, cl0 = wc * 32 + 8 * fq;
#pragma unroll
        for (int ai = 0; ai < 2; ++ai)
#pragma unroll
            for (int m = 0; m < 4; ++m) { const int row = row0 + ai * 128 + m * 16;
#pragma unroll
                for (int bj = 0; bj < 2; ++bj) { const int c = cl0 + bj * 128; const u32x4 yy = *(const u32x4*)(YS5 + (size_t)row * 256 + c); bf16* gp = G + (size_t)row * 1024 + 512 + c; const u32x4 gg = *(const u32x4*)gp;
                    const pg8::f32x4 v0 = acc[ai][bj][m][0], v1 = acc[ai][bj][m][1]; float s[8];
#pragma unroll
                    for (int e = 0; e < 4; ++e) { s[e] = 1.f / (1.f + __expf(-v0[e])); s[4 + e] = 1.f / (1.f + __expf(-v1[e])); }
                    u32x4 w; w.x = pk2(bflo(yy.x) * s[0] * bflo(gg.x), bfhi(yy.x) * s[1] * bfhi(gg.x)); w.y = pk2(bflo(yy.y) * s[2] * bflo(gg.y), bfhi(yy.y) * s[3] * bfhi(gg.y));
                    w.z = pk2(bflo(yy.z) * s[4] * bflo(gg.z), bfhi(yy.z) * s[5] * bfhi(gg.z)); w.w = pk2(bflo(yy.w) * s[6] * bflo(gg.w), bfhi(yy.w) * s[7] * bfhi(gg.w));
                    if (!dry) *(u32x4*)gp = w; } }
    }
};
struct EpiOut {
    static constexpr bool PERM = false, AFTER_DRAIN = false;
    const float* base; float* out; float* SSn; bf16* XN; const float* gnext; bool dry;
    __device__ __forceinline__ void operator()(const pg8::f32x4 (&acc)[2][2][4][2], const pg8::Unit& u, int wr, int wc, int fr, int fq) const {
        const int row0 = u.pm * 256 + wr * 64 + fr, col0 = u.pn * 256 + wc * 32 + 4 * fq;
        f32x4 gq[2][2];
#pragma unroll
        for (int bj = 0; bj < 2; ++bj)
#pragma unroll
            for (int n = 0; n < 2; ++n) gq[bj][n] = gnext ? *(const f32x4*)(gnext + col0 + bj * 128 + n * 16) : (f32x4){0.f, 0.f, 0.f, 0.f};
#pragma unroll
        for (int ai = 0; ai < 2; ++ai)
#pragma unroll
            for (int m = 0; m < 4; ++m) { const int row = row0 + ai * 128 + m * 16; const size_t off = (size_t)row * DM + col0; float sq = 0.f;
#pragma unroll
                for (int bj = 0; bj < 2; ++bj)
#pragma unroll
                    for (int n = 0; n < 2; ++n) { const f32x4 bs = *(const f32x4*)(base + off + bj * 128 + n * 16); const pg8::f32x4 v = acc[ai][bj][m][n]; const f32x4 x = (f32x4){bs.x + v[0], bs.y + v[1], bs.z + v[2], bs.w + v[3]};
                        sq += (x.x * x.x + x.y * x.y) + (x.z * x.z + x.w * x.w);
                        if (!dry) { *(f32x4*)(out + off + bj * 128 + n * 16) = x;
                            if (gnext) { const f32x4 g = gq[bj][n]; u32x2 w; w.x = pk2(x.x * g.x, x.y * g.y); w.y = pk2(x.z * g.z, x.w * g.w); *(u32x2*)(XN + off + bj * 128 + n * 16) = w; } } }
                sq += __shfl_xor(sq, 16); sq += __shfl_xor(sq, 32);
                if (fq == 0 && !dry) __hip_atomic_fetch_add(SSn + row, sq, __ATOMIC_RELAXED, __HIP_MEMORY_SCOPE_AGENT); }
    }
};

template <bool FINAL> struct EpiOutX {
    static constexpr bool PERM = false, AFTER_DRAIN = true;
    const float* base; float* out; const float* wfin; float* xbuf; unsigned* cnt; bf16* XN; unsigned target;
    __device__ __forceinline__ void fused(pg8::f32x4 (&acc)[2][2][4][2], const pg8::Unit& u, int wr, int wc, int fr, int fq, PG8_LAS unsigned char* lds, int wid, int lane) const {
        PG8_LAS float* P = (PG8_LAS float*)lds;
        PG8_LAS float* S = (PG8_LAS float*)(lds + 4096);
        const int col0 = u.pn * 256 + wc * 32 + 4 * fq;
#pragma unroll
        for (int ai = 0; ai < 2; ++ai)
#pragma unroll
            for (int m = 0; m < 4; ++m) { const int r = ai * 128 + wr * 64 + m * 16 + fr; const size_t off = (size_t)(u.pm * 256 + r) * DM + col0; float sq = 0.f;
#pragma unroll
                for (int bj = 0; bj < 2; ++bj)
#pragma unroll
                    for (int n = 0; n < 2; ++n) { const f32x4 bs = *(const f32x4*)(base + off + bj * 128 + n * 16); pg8::f32x4 x = acc[ai][bj][m][n]; x[0] += bs.x; x[1] += bs.y; x[2] += bs.z; x[3] += bs.w; acc[ai][bj][m][n] = x;
                        sq += (x[0] * x[0] + x[1] * x[1]) + (x[2] * x[2] + x[3] * x[3]); }
                sq += __shfl_xor(sq, 16); sq += __shfl_xor(sq, 32);
                if (fq == 0) P[r * 4 + wc] = sq;
                asm volatile("" : "+v"(acc[ai][0][m][0]), "+v"(acc[ai][0][m][1]), "+v"(acc[ai][1][m][0]), "+v"(acc[ai][1][m][1]));
                if (m & 1) asm volatile("" ::: "memory"); }
        asm volatile("s_waitcnt lgkmcnt(0)" ::: "memory"); __builtin_amdgcn_s_barrier(); asm volatile("" ::: "memory");
        const int row = wid * 32 + (lane & 31);
        if (lane < 32) { const float tot = (P[row * 4 + 0] + P[row * 4 + 1]) + (P[row * 4 + 2] + P[row * 4 + 3]);
            __hip_atomic_store(xbuf + (size_t)(u.pm * 256 + row) * 4 + u.pn, tot, __ATOMIC_RELAXED, __HIP_MEMORY_SCOPE_AGENT); }
        asm volatile("s_waitcnt vmcnt(0)" ::: "memory");
        if (lane == 0) __hip_atomic_fetch_add(cnt + 64 * u.pm, 1u, __ATOMIC_RELAXED, __HIP_MEMORY_SCOPE_AGENT);
        if (wid == 0) {
            unsigned sp = 0u;
            while ((unsigned)__builtin_amdgcn_readfirstlane(__hip_atomic_load(cnt + 64 * u.pm, __ATOMIC_RELAXED, __HIP_MEMORY_SCOPE_AGENT)) < target) { __builtin_amdgcn_s_sleep(2); if (++sp > (1u << 20)) break; }
            __builtin_amdgcn_fence(__ATOMIC_ACQUIRE, "agent");
        }
        asm volatile("s_waitcnt vmcnt(0) lgkmcnt(0)" ::: "memory"); __builtin_amdgcn_s_barrier(); asm volatile("" ::: "memory");
        if (lane < 32) { const float* sl = xbuf + (size_t)(u.pm * 256 + row) * 4; float t = 0.f;
#pragma unroll
            for (int k = 0; k < 4; ++k) t += __hip_atomic_load(sl + k, __ATOMIC_RELAXED, __HIP_MEMORY_SCOPE_AGENT);
            S[row] = rsqrtf(t * (1.f / DM) + EPS); }
        asm volatile("s_waitcnt lgkmcnt(0)" ::: "memory"); __builtin_amdgcn_s_barrier(); asm volatile("" ::: "memory");
        f32x4 wq[2][2];
#pragma unroll
        for (int bj = 0; bj < 2; ++bj)
#pragma unroll
            for (int n = 0; n < 2; ++n) wq[bj][n] = *(const f32x4*)(wfin + col0 + bj * 128 + n * 16);
#pragma unroll
        for (int ai = 0; ai < 2; ++ai)
#pragma unroll
            for (int m = 0; m < 4; ++m) { const int r = ai * 128 + wr * 64 + m * 16 + fr; const float sr = S[r]; const size_t off = (size_t)(u.pm * 256 + r) * DM + col0;
#pragma unroll
                for (int bj = 0; bj < 2; ++bj)
#pragma unroll
                    for (int n = 0; n < 2; ++n) { const pg8::f32x4 x = acc[ai][bj][m][n]; const f32x4 g = wq[bj][n]; const f32x4 y = (f32x4){x[0] * sr * g.x, x[1] * sr * g.y, x[2] * sr * g.z, x[3] * sr * g.w};
                        if (FINAL) *(f32x4*)(out + off + bj * 128 + n * 16) = y;
                        else { *(f32x4*)(out + off + bj * 128 + n * 16) = (f32x4){x[0], x[1], x[2], x[3]}; u32x2 w; w.x = pk2(y.x, y.y); w.y = pk2(y.z, y.w); *(u32x2*)(XN + off + bj * 128 + n * 16) = w; } } }
    }
};

template <int KS, int UNR, class Epi> __device__ __forceinline__ void wave_gemm64(const bf16* A, int lda, const bf16* B, int ldb, int lane, const Epi& epi) {
    const int fr = lane & 15, fq = lane >> 4;
    pg8::f32x4 acc[4][4];
#pragma unroll
    for (int jb = 0; jb < 4; ++jb)
#pragma unroll
        for (int ib = 0; ib < 4; ++ib) acc[jb][ib] = (pg8::f32x4){0.f, 0.f, 0.f, 0.f};
    const bf16* ap = A + (size_t)fr * lda + 8 * fq; const bf16* bp = B + (size_t)fr * ldb + 8 * fq;
#pragma unroll UNR
    for (int ks = 0; ks < KS; ++ks) {
        bf16x8 af[4], bv[4];
#pragma unroll
        for (int ib = 0; ib < 4; ++ib) { af[ib] = *(const bf16x8*)(ap + (size_t)(16 * ib) * lda + 32 * ks); bv[ib] = *(const bf16x8*)(bp + (size_t)(16 * ib) * ldb + 32 * ks); }
#pragma unroll
        for (int jb = 0; jb < 4; ++jb)
#pragma unroll
            for (int ib = 0; ib < 4; ++ib) acc[jb][ib] = __builtin_amdgcn_mfma_f32_16x16x32_bf16(bv[jb], af[ib], acc[jb][ib], 0, 0, 0);
    }
    epi(acc, fr, fq);
}
struct WEpiE {
    float* E;
    __device__ __forceinline__ void operator()(const pg8::f32x4 (&acc)[4][4], int fr, int fq) const {
#pragma unroll
        for (int jb = 0; jb < 4; ++jb)
#pragma unroll
            for (int ib = 0; ib < 4; ++ib) *(pg8::f32x4*)(E + (size_t)(16 * ib + fr) * 128 + 16 * jb + 4 * fq) = acc[jb][ib];
    }
};
struct WEpiS5Y {
    const bf16* SUAg; bf16* YS5; const float* dg; int chunk0, col0, g;
    __device__ __forceinline__ void operator()(const pg8::f32x4 (&acc)[4][4], int fr, int fq) const {
#pragma unroll
        for (int jb = 0; jb < 4; ++jb) { const int col = col0 + 16 * jb + 4 * fq, tt = col >> 4, h0 = col & 15; const f32x4 d4 = *(const f32x4*)(dg + h0);
#pragma unroll
            for (int ib = 0; ib < 4; ++ib) { const int chunk = chunk0 + 16 * ib + fr; const u32x2 uu = *(const u32x2*)(SUAg + (size_t)chunk * KA5 + col); const pg8::f32x4 v = acc[jb][ib];
                const float y0 = gelu_tanh(v[0] + d4.x * bflo(uu.x)), y1 = gelu_tanh(v[1] + d4.y * bfhi(uu.x)), y2 = gelu_tanh(v[2] + d4.z * bflo(uu.y)), y3 = gelu_tanh(v[3] + d4.w * bfhi(uu.y));
                u32x2 w; w.x = pk2(y0, y1); w.y = pk2(y2, y3); *(u32x2*)(YS5 + (size_t)(chunk * 32 + tt) * 256 + g * 16 + h0) = w; } }
    }
};
struct WEpiGlu {
    const bf16* YS5; bf16* G; int row0, col0;
    __device__ __forceinline__ void operator()(const pg8::f32x4 (&acc)[4][4], int fr, int fq) const {
#pragma unroll
        for (int jb = 0; jb < 4; ++jb)
#pragma unroll
            for (int ib = 0; ib < 4; ++ib) { const int row = row0 + 16 * ib + fr, col = col0 + 16 * jb + 4 * fq; const u32x2 yy = *(const u32x2*)(YS5 + (size_t)row * 256 + col); bf16* gp = G + (size_t)row * 1024 + 512 + col; const u32x2 gg = *(const u32x2*)gp; const pg8::f32x4 v = acc[jb][ib];
                const float s0 = __builtin_amdgcn_rcpf(1.f + __expf(-v[0])), s1 = __builtin_amdgcn_rcpf(1.f + __expf(-v[1])), s2 = __builtin_amdgcn_rcpf(1.f + __expf(-v[2])), s3 = __builtin_amdgcn_rcpf(1.f + __expf(-v[3]));
                u32x2 w; w.x = pk2(bflo(yy.x) * s0 * bflo(gg.x), bfhi(yy.x) * s1 * bfhi(gg.x)); w.y = pk2(bflo(yy.y) * s2 * bflo(gg.y), bfhi(yy.y) * s3 * bfhi(gg.y)); *(u32x2*)gp = w; }
    }
};

__device__ __forceinline__ void ret_upd_unit(unsigned char* ws, int unit, int lane) {
    const int c = unit & 63, bh = unit >> 6; const int i16 = lane & 15, kq = lane >> 4;
    const bf16* KT = (const bf16*)(ws + WS_RKT) + (size_t)bh * 64 * SEQ + c * 64; const bf16* VT = (const bf16*)(ws + WS_RVT) + (size_t)bh * 64 * SEQ + c * 64;
    float* UPD = (float*)(ws + WS_UPD) + (size_t)unit * 4096;
    bf16x8 af[4][2], bfv[4][2];
#pragma unroll
    for (int ib = 0; ib < 4; ++ib)
#pragma unroll
        for (int ks = 0; ks < 2; ++ks) { af[ib][ks] = *(const bf16x8*)(KT + (size_t)(16 * ib + i16) * SEQ + 32 * ks + 8 * kq); bfv[ib][ks] = *(const bf16x8*)(VT + (size_t)(16 * ib + i16) * SEQ + 32 * ks + 8 * kq); }
#pragma unroll
    for (int ib = 0; ib < 4; ++ib)
#pragma unroll
        for (int jb = 0; jb < 4; ++jb) { pg8::f32x4 d = (pg8::f32x4){0.f, 0.f, 0.f, 0.f};
            d = __builtin_amdgcn_mfma_f32_16x16x32_bf16(af[ib][0], bfv[jb][0], d, 0, 0, 0); d = __builtin_amdgcn_mfma_f32_16x16x32_bf16(af[ib][1], bfv[jb][1], d, 0, 0, 0);
            *(pg8::f32x4*)(UPD + (size_t)(16 * jb + i16) * 64 + 16 * ib + 4 * kq) = d; }
}
__device__ __forceinline__ void ret_out_unit(const Args& a, int l, int unit, int lane, bool dry = false) {
    unsigned char* ws = a.ws;
    const int c = unit & 63, bh = unit >> 6, hh = bh & 3, b = bh >> 2; const int fr = lane & 15, fq = lane >> 4;
    const size_t t0 = (size_t)b * SEQ + c * 64;
    const bf16* RQ = (const bf16*)(ws + WS_RQ) + t0 * 256 + hh * 64; const bf16* RK = (const bf16*)(ws + WS_RK) + t0 * 256 + hh * 64;
    const bf16* VT = (const bf16*)(ws + WS_RVT) + (size_t)bh * 64 * SEQ + c * 64; const bf16* ST = (const bf16*)(ws + WS_STATE) + (size_t)unit * 4096;
    const float lg = lg2_gamma(hh);
    bf16x8 qf[4][2]; pg8::f32x4 st[4][4];
#pragma unroll
    for (int nb = 0; nb < 4; ++nb)
#pragma unroll
        for (int ks = 0; ks < 2; ++ks) qf[nb][ks] = *(const bf16x8*)(RQ + (size_t)(16 * nb + fr) * 256 + 32 * ks + 8 * fq);
#pragma unroll
    for (int mb = 0; mb < 4; ++mb) { bf16x8 k0 = *(const bf16x8*)(RK + (size_t)(16 * mb + fr) * 256 + 8 * fq), k1 = *(const bf16x8*)(RK + (size_t)(16 * mb + fr) * 256 + 32 + 8 * fq);
#pragma unroll
        for (int nb = 0; nb < 4; ++nb) { pg8::f32x4 d = (pg8::f32x4){0.f, 0.f, 0.f, 0.f};
            d = __builtin_amdgcn_mfma_f32_16x16x32_bf16(k0, qf[nb][0], d, 0, 0, 0); d = __builtin_amdgcn_mfma_f32_16x16x32_bf16(k1, qf[nb][1], d, 0, 0, 0);
#pragma unroll
            for (int r = 0; r < 4; ++r) { const int mm = 16 * mb + 4 * fq + r, nn = 16 * nb + fr; const int df = mm > nn ? mm - nn : nn - mm; d[r] *= 0.125f * exp2f(lg * (float)df); }
            st[mb][nb] = d; } }
    pg8::f32x4 o[4][4];
#pragma unroll
    for (int nb = 0; nb < 4; ++nb)
#pragma unroll
        for (int dvb = 0; dvb < 4; ++dvb) o[nb][dvb] = (pg8::f32x4){0.f, 0.f, 0.f, 0.f};
#pragma unroll
    for (int dvb = 0; dvb < 4; ++dvb) { const bf16x8 s0 = *(const bf16x8*)(ST + (size_t)(16 * dvb + fr) * 64 + 8 * fq), s1 = *(const bf16x8*)(ST + (size_t)(16 * dvb + fr) * 64 + 32 + 8 * fq);
#pragma unroll
        for (int nb = 0; nb < 4; ++nb) { o[nb][dvb] = __builtin_amdgcn_mfma_f32_16x16x32_bf16(qf[nb][0], s0, o[nb][dvb], 0, 0, 0); o[nb][dvb] = __builtin_amdgcn_mfma_f32_16x16x32_bf16(qf[nb][1], s1, o[nb][dvb], 0, 0, 0); } }
#pragma unroll
    for (int nb = 0; nb < 4; ++nb)
#pragma unroll
        for (int r = 0; r < 4; ++r) { const float wq = 0.125f * exp2f(lg * (float)(16 * nb + 4 * fq + r + 1));
#pragma unroll
            for (int dvb = 0; dvb < 4; ++dvb) o[nb][dvb][r] *= wq; }
#pragma unroll
    for (int s = 0; s < 2; ++s) {
        bf16x8 pa[4];
#pragma unroll
        for (int nb = 0; nb < 4; ++nb) { u32x4 w; w.x = pk2(st[2 * s][nb][0], st[2 * s][nb][1]); w.y = pk2(st[2 * s][nb][2], st[2 * s][nb][3]); w.z = pk2(st[2 * s + 1][nb][0], st[2 * s + 1][nb][1]); w.w = pk2(st[2 * s + 1][nb][2], st[2 * s + 1][nb][3]); pa[nb] = __builtin_bit_cast(bf16x8, w); }
#pragma unroll
        for (int dvb = 0; dvb < 4; ++dvb) { const u32x2 v0 = *(const u32x2*)(VT + (size_t)(16 * dvb + fr) * SEQ + 32 * s + 4 * fq), v1 = *(const u32x2*)(VT + (size_t)(16 * dvb + fr) * SEQ + 32 * s + 16 + 4 * fq);
            const bf16x8 vf = __builtin_bit_cast(bf16x8, (u32x4){v0.x, v0.y, v1.x, v1.y});
#pragma unroll
            for (int nb = 0; nb < 4; ++nb) o[nb][dvb] = __builtin_amdgcn_mfma_f32_16x16x32_bf16(pa[nb], vf, o[nb][dvb], 0, 0, 0); }
    }
    const float* gn = a.in[13] + (size_t)l * 256 + hh * 64; float gnw[4];
#pragma unroll
    for (int dvb = 0; dvb < 4; ++dvb) gnw[dvb] = gn[16 * dvb + fr];
    bf16* Y = (bf16*)(ws + WS_GATE) + t0 * 1024 + 768 + hh * 64;
#pragma unroll
    for (int nb = 0; nb < 4; ++nb)
#pragma unroll
        for (int r = 0; r < 4; ++r) { float s = (o[nb][0][r] + o[nb][1][r]) + (o[nb][2][r] + o[nb][3][r]);
            s += __shfl_xor(s, 1); s += __shfl_xor(s, 2); s += __shfl_xor(s, 4); s += __shfl_xor(s, 8);
            const float mu = s * (1.f / 64.f); float q = 0.f;
#pragma unroll
            for (int dvb = 0; dvb < 4; ++dvb) { const float d = o[nb][dvb][r] - mu; q += d * d; }
            q += __shfl_xor(q, 1); q += __shfl_xor(q, 2); q += __shfl_xor(q, 4); q += __shfl_xor(q, 8);
            const float rstd = rsqrtf(q * (1.f / 64.f) + EPS); bf16* yp = Y + (size_t)(16 * nb + 4 * fq + r) * 1024 + fr;
#pragma unroll
            for (int dvb = 0; dvb < 4; ++dvb) { const float gt = bf2f(yp[16 * dvb]); if (!dry) yp[16 * dvb] = f2bf((o[nb][dvb][r] - mu) * rstd * gnw[dvb] * gt); } }
}

#define XB_TMO      128
#define XB_XCNT(j)  (256  + 64 * (j))
#define XB_XSUB(j)  (1280 + 64 * (j))
#define XB_XGEN(j)  (2304 + 64 * (j))
#define XB_TOP      3328
#define XB_TOPGEN   3392
#define XCD_BAR_WORDS 3456
#define XB_SPIN_CAP (1u << 18)

__device__ __forceinline__ unsigned xb_ld(unsigned* p)              { return __hip_atomic_load(p, __ATOMIC_RELAXED, __HIP_MEMORY_SCOPE_AGENT); }
__device__ __forceinline__ unsigned xb_add(unsigned* p, unsigned v) { return __hip_atomic_fetch_add(p, v, __ATOMIC_RELAXED, __HIP_MEMORY_SCOPE_AGENT); }
__device__ __forceinline__ unsigned xb_xcc_id() { return (unsigned)__builtin_amdgcn_s_getreg((3 << 11) | 20) & 0xFu; }
#define XB_SPIN(cond, bar) do { unsigned _sp = 0; while (cond) { __builtin_amdgcn_s_sleep(1); \
    if ((++_sp & 255u) == 0u) { if (xb_ld(&(bar)[XB_TMO])) break; if (_sp > XB_SPIN_CAP) { atomicAdd(&(bar)[XB_TMO], 1u); break; } } } } while (0)

struct XcdBarrier {
    unsigned* bar; unsigned x;
    volatile LAS unsigned* st;
};

__device__ __forceinline__ XcdBarrier xcd_barrier_post(unsigned* bar, volatile LAS unsigned* st) {
    XcdBarrier b; b.bar = bar; b.x = xb_xcc_id(); b.st = st;
    if (threadIdx.x == 0) (void)xb_add(&bar[XB_XCNT(b.x)], 1u);
    return b;
}
__device__ __forceinline__ void xcd_barrier_complete(unsigned* bar, unsigned x, unsigned& nloc, unsigned& nx) {
    const unsigned G = gridDim.x * gridDim.y * gridDim.z;
    unsigned sum, cnt, mine, sp = 0u;
    for (;;) {
        sum = 0u; cnt = 0u; mine = 0u;
#pragma unroll
        for (unsigned j = 0; j < 16; ++j) { const unsigned c = xb_ld(&bar[XB_XCNT(j)]); sum += c; cnt += (c > 0u) ? 1u : 0u; mine = (j == x) ? c : mine; }
        if (sum == G) break;
        __builtin_amdgcn_s_sleep(1);
        if ((++sp & 255u) == 0u) { if (xb_ld(&bar[XB_TMO])) break; if (sp > XB_SPIN_CAP) { atomicAdd(&bar[XB_TMO], 1u); break; } }
    }
    nloc = mine > 0u ? mine : 1u; nx = cnt > 0u ? cnt : 1u;
}

__device__ __forceinline__ void xcd_barrier(const XcdBarrier& b) {
    asm volatile("s_waitcnt vmcnt(0)" ::: "memory");
    __syncthreads();
    if (threadIdx.x == 0) {
        unsigned* bar = b.bar;
        __builtin_amdgcn_s_waitcnt(0);
        unsigned nloc = b.st[0], nx = b.st[1];
        if (nloc == 0u) { xcd_barrier_complete(bar, b.x, nloc, nx); b.st[0] = nloc; b.st[1] = nx; }
        const unsigned old = xb_add(&bar[XB_XSUB(b.x)], 1u);
        const unsigned gen = old / nloc;
        if (old + 1u == (gen + 1u) * nloc) {
            __builtin_amdgcn_fence(__ATOMIC_RELEASE, "agent");
            asm volatile("s_waitcnt vmcnt(0)" ::: "memory");
            const unsigned og = xb_add(&bar[XB_TOP], 1u);
            const unsigned tg = og / nx;
            if (og + 1u == (tg + 1u) * nx) xb_add(&bar[XB_TOPGEN], 1u);
            else XB_SPIN(xb_ld(&bar[XB_TOPGEN]) == tg, bar);
            __builtin_amdgcn_fence(__ATOMIC_ACQUIRE, "agent");
            xb_add(&bar[XB_XGEN(b.x)], 1u);
            asm volatile("s_waitcnt vmcnt(0)" ::: "memory");
        } else {
            XB_SPIN(xb_ld(&bar[XB_XGEN(b.x)]) == gen, bar);
            __builtin_amdgcn_fence(__ATOMIC_ACQUIRE, "agent");
            asm volatile("s_waitcnt vmcnt(0)" ::: "memory");
        }
    }
    __syncthreads();
}

#define XBAR_MAKE XcdBarrier xb_; xb_.bar = (unsigned*)args.ws; xb_.st = (volatile LAS unsigned*)((LAS unsigned char*)lds + RING_BYTES + 352); xb_.x = xb_.st[2]
#ifdef REP_SYNC
#define GSYNC() do { XBAR_MAKE; xcd_barrier(xb_); xcd_barrier(xb_); } while (0)
#else
#define GSYNC() do { XBAR_MAKE; xcd_barrier(xb_); } while (0)
#endif
#ifndef REP_P0
#define REP_P0 1
#endif
#ifndef REP_P1
#define REP_P1 1
#endif
#ifndef REP_P23
#define REP_P23 1
#endif
#ifndef REP_NORM
#define REP_NORM 1
#endif
__global__ void __launch_bounds__(NTHR, 2) mega_fwd(Args args) {
    extern __shared__ __attribute__((aligned(16))) unsigned char lds[];
    cg::grid_group grid = cg::this_grid();
    const int tid = threadIdx.x, lane = tid & 63, wave = __builtin_amdgcn_readfirstlane(tid >> 6);
    const int G = gridDim.x, bx = blockIdx.x; const int vcu = (G % 8 == 0) ? (bx % 8) * (G / 8) + bx / 8 : bx;
    const int gw = bx * NWAVES + wave, NGW = G * NWAVES;
    unsigned char* ws = args.ws;
    LAS unsigned char* ldsl = (LAS unsigned char*)lds;
    LAS float* ldsf = (LAS float*)lds;
    float* X = args.out;
    if (ws == nullptr) grid.sync();
    if (tid < 2) ((volatile LAS unsigned*)(ldsl + RING_BYTES + 352))[tid] = 0u;
    __syncthreads();
    { const XcdBarrier xb0 = xcd_barrier_post((unsigned*)ws, (volatile LAS unsigned*)(ldsl + RING_BYTES + 352)); if (tid == 0) ((volatile LAS unsigned*)(ldsl + RING_BYTES + 352))[2] = xb0.x; }
    __syncthreads();

#ifdef PROBE_T
    unsigned long long tacc_ = 0ull, tprev_ = __builtin_amdgcn_s_memrealtime();
#define TSTAMP(id) do { const unsigned long long tn_ = __builtin_amdgcn_s_memrealtime(); if ((id) == PROBE_T || ((PROBE_T) == 23 && ((id) == 2 || (id) == 3 || (id) == 5))) tacc_ += tn_ - tprev_; tprev_ = tn_; } while (0)
#else
#define TSTAMP(id) do {} while (0)
#endif
    for (int rep_ = 0; rep_ < REP_P0; ++rep_) {
        if (rep_) { __syncthreads(); }
#ifdef REP_S5P
        if (bx < 64) { s5_prep(args, bx >> 4, bx & 15, ldsf, tid); }
#endif
        if (bx < 64) { s5_prep(args, bx >> 4, bx & 15, ldsf, tid); }
        LAS float* scr = ldsf + wave * 4096;
        constexpr int I_IN = (DM / 64) * (NF / 32), I_O = (DM / 64) * (DM / 32), I_G = (256 / 64) * (256 / 32), I_L = I_IN + I_O + I_G;
#ifndef REP_TR
#define REP_TR 1
#endif
        for (int rt_ = 0; rt_ < REP_TR; ++rt_)
        for (int it = (bx < 64 ? DEPTH * I_L : (bx - 64) * NWAVES + wave); it < DEPTH * I_L; it += (G - 64) * NWAVES) {
            const int l = it / I_L; int r = it % I_L;
            if (r < I_IN) { p0_transpose_item<true>(args.in[2] + (size_t)l * DM * NIN, DM, NIN, NF, (bf16*)(ws + WS_WIN) + (size_t)l * NF * DM, scr, r, lane); continue; } r -= I_IN;
            if (r < I_O) { p0_transpose_item<false>(args.in[14] + (size_t)l * DM * DM, DM, DM, DM, (bf16*)(ws + WS_WO) + (size_t)l * DM * DM, scr, r, lane); continue; } r -= I_O;
            p0_transpose_item<false>(args.in[12] + (size_t)l * 65536, 256, 256, 256, (bf16*)(ws + WS_WGLU) + (size_t)l * 65536, scr, r, lane);
        }
        f32x2* rope = (f32x2*)(ws + WS_ROPE);
        for (int i = bx * NTHR + tid; i < SEQ * 32; i += G * NTHR) { const int pos = i >> 5, fi = i & 31; const float freq = powf(10000.f, -(float)fi / 32.f); const float ang = (float)pos * freq; float sn, cs; sincosf(ang, &sn, &cs); rope[i] = (f32x2){cs, sn}; }
        __syncthreads();
        { const int NW = (64 + 2 * (G - 64)) * NWAVES;
          if (bx < 64) norm0_phase(args, lane, bx * NWAVES + wave, NW);
          else { const int sl = 64 * NWAVES + ((bx - 64) * NWAVES + wave) * 2; norm0_phase(args, lane, sl, NW); norm0_phase(args, lane, sl + 1, NW); } }
    }
    GSYNC();
    TSTAMP(0);

#define PHASE_VARS int tid = threadIdx.x; asm volatile("" : "+v"(tid)); int bxl_ = blockIdx.x; asm volatile("" : "+s"(bxl_)); const int bx = bxl_; const int lane = tid & 63, wave = __builtin_amdgcn_readfirstlane(tid >> 6), gw = bx * NWAVES + wave; __attribute__((address_space(1))) unsigned char* wsg_ = (__attribute__((address_space(1))) unsigned char*)args.ws; asm volatile("" : "+s"(wsg_)); unsigned char* ws = (unsigned char*)wsg_; LAS unsigned char* ldsl = (LAS unsigned char*)lds; LAS float* ldsf = (LAS float*)lds; (void)lane; (void)wave; (void)gw; (void)ldsl; (void)ldsf
    for (int l = 0; l < DEPTH; ++l) {
        for (int rep_ = 0; rep_ < REP_P1; ++rep_) {
            PHASE_VARS;
            pg8::Gemm g{(const bf16*)(ws + WS_XN), (const bf16*)(ws + WS_WIN) + (size_t)l * NF * DM, M, NF, DM, DM, DM, 0, 0};
            pg8::StaticOrder S; S.init(M, NF, G, bx);
            EpiInProj E{ws, (const float*)(ws + WS_SS) + (size_t)(l & 1) * M, args.in[3] + (size_t)l * 8};
#ifdef PROBE_SPLIT
            { RangeOrder R0{S, 0, 2}, R1{S, 2, 4}; pg8::gemm_phase<EpiInProj, RangeOrder, true, true>(ldsl, g, R0, E); GSYNC(); pg8::gemm_phase<EpiInProj, RangeOrder, true, true>(ldsl, g, R1, E); }
#else
            pg8::gemm_phase<EpiInProj, pg8::StaticOrder, true, true>(ldsl, g, S, E);
#endif
            if (bx >= G / 2) flog_phase(args, l, (const float*)(ws + WS_SS) + (size_t)(l & 1) * M, ldsf, tid, lane, wave, bx - G / 2, G / 2);
        }
        GSYNC();
        TSTAMP(1);
        for (int rep_ = 0; rep_ < REP_P23; ++rep_) {
            if (rep_) __syncthreads();
            PHASE_VARS;
            if (bx < 64) {
                const int b = bx >> 4, g = bx & 15, tmL = wave & 1, tn = (wave >> 1) & 1, kh = wave >> 2;
                { const int fr = lane & 15, fq = lane >> 4;
                  const bf16* Ap = (const bf16*)(ws + WS_SUA) + ((size_t)g * NCH5 + b * 128 + tmL * 64) * KA5 + 256 * kh; const bf16* Bp = (const bf16*)(ws + WS_WB) + ((size_t)(l * 16 + g) * 128 + tn * 64) * 512 + 256 * kh;
                  struct WEpiLds { LAS float* EL; __device__ __forceinline__ void operator()(const pg8::f32x4 (&acc)[4][4], int fr_, int fq_) const {
#pragma unroll
                      for (int jb = 0; jb < 4; ++jb)
#pragma unroll
                          for (int ib = 0; ib < 4; ++ib) *(LAS pg8::f32x4*)(EL + (16 * ib + fr_) * 128 + 16 * jb + 4 * fq_) = acc[jb][ib]; } };
                  WEpiLds E{ldsf + (size_t)(kh * 128 + tmL * 64) * 128 + tn * 64}; (void)fr; (void)fq;
                  wave_gemm64<8, 4, WEpiLds>(Ap, KA5, Bp, 512, lane, E); }
                __syncthreads();
                const int p = tid & 63, seg = tid >> 6;
                const float* LAM = (const float*)(ws + WS_LAM) + (size_t)(l * 16 + g) * 128; const float lr = LAM[p], li = LAM[64 + p];
                bf16* SA = (bf16*)(ws + WS_SUA) + ((size_t)g * NCH5 + b * 128 + seg * 16) * KA5 + 512 + p;
                float er[16], ei[16];
#pragma unroll
                for (int i = 0; i < 16; ++i) { const int r = (seg * 16 + i) * 128; er[i] = ldsf[r + p] + ldsf[16384 + r + p]; ei[i] = ldsf[r + 64 + p] + ldsf[16384 + r + 64 + p]; }
                float sr = 0.f, si = 0.f;
#pragma unroll
                for (int i = 0; i < 16; ++i) { const float nr = lr * sr - li * si + er[i], ni = lr * si + li * sr + ei[i]; sr = nr; si = ni; }
                LAS float* ends = ldsf + (RING_BYTES + 1024) / 4;
                ends[(seg * 64 + p) * 2] = sr; ends[(seg * 64 + p) * 2 + 1] = si;
                float pr = lr, pi = li;
#pragma unroll
                for (int i = 0; i < 4; ++i) { const float nr = pr * pr - pi * pi, ni = 2.f * pr * pi; pr = nr; pi = ni; }
                __syncthreads();
                float cr = 0.f, ci = 0.f;
                for (int s2 = 0; s2 < seg; ++s2) { const float xr = ends[(s2 * 64 + p) * 2], xi = ends[(s2 * 64 + p) * 2 + 1]; const float nr = pr * cr - pi * ci + xr, ni = pr * ci + pi * cr + xi; cr = nr; ci = ni; }
#pragma unroll
                for (int i = 0; i < 16; ++i) { SA[(size_t)i * KA5] = f2bf(cr); SA[(size_t)i * KA5 + 64] = f2bf(ci); const float nr = lr * cr - li * ci + er[i], ni = lr * ci + li * cr + ei[i]; cr = nr; ci = ni; }
            } else if (bx < 192) {
                const int idx = bx - 64, bh = idx >> 3, dvs = (idx >> 1) & 3, dkh = idx & 1, fr = lane & 15, fq = lane >> 4; const float g64 = exp2f(lg2_gamma(bh & 3) * 64.f);
                const bf16* KT = (const bf16*)(ws + WS_RKT) + ((size_t)bh * 64 + 32 * dkh + fr) * SEQ + 8 * fq; const bf16* VT = (const bf16*)(ws + WS_RVT) + ((size_t)bh * 64 + 16 * dvs + fr) * SEQ + 8 * fq;
                pg8::f32x4 u[8][2];
#pragma unroll
                for (int i2 = 0; i2 < 2; ++i2) {
                    bf16x8 vf[4][2], kf[4][2][2];
#pragma unroll
                    for (int i1 = 0; i1 < 4; ++i1) { const int c = 8 * wave + 4 * i2 + i1; vf[i1][0] = *(const bf16x8*)(VT + c * 64); vf[i1][1] = *(const bf16x8*)(VT + c * 64 + 32);
#pragma unroll
                        for (int ib = 0; ib < 2; ++ib) { kf[i1][ib][0] = *(const bf16x8*)(KT + (size_t)(16 * ib) * SEQ + c * 64); kf[i1][ib][1] = *(const bf16x8*)(KT + (size_t)(16 * ib) * SEQ + c * 64 + 32); } }
#pragma unroll
                    for (int i1 = 0; i1 < 4; ++i1)
#pragma unroll
                        for (int ib = 0; ib < 2; ++ib) { pg8::f32x4 d = (pg8::f32x4){0.f, 0.f, 0.f, 0.f}; d = __builtin_amdgcn_mfma_f32_16x16x32_bf16(kf[i1][ib][0], vf[i1][0], d, 0, 0, 0); d = __builtin_amdgcn_mfma_f32_16x16x32_bf16(kf[i1][ib][1], vf[i1][1], d, 0, 0, 0); u[4 * i2 + i1][ib] = d; }
                }
                pg8::f32x4 e4[2];
#pragma unroll
                for (int ib = 0; ib < 2; ++ib) e4[ib] = (pg8::f32x4){0.f, 0.f, 0.f, 0.f};
#pragma unroll
                for (int i = 0; i < 8; ++i)
#pragma unroll
                    for (int ib = 0; ib < 2; ++ib) e4[ib] = e4[ib] * g64 + u[i][ib];
                LAS pg8::f32x4* ends = (LAS pg8::f32x4*)ldsf;
#pragma unroll
                for (int ib = 0; ib < 2; ++ib) ends[(wave * 2 + ib) * 64 + lane] = e4[ib];
                float g8 = g64; g8 = g8 * g8; g8 = g8 * g8; g8 = g8 * g8;
                __syncthreads();
                pg8::f32x4 st[2];
#pragma unroll
                for (int ib = 0; ib < 2; ++ib) st[ib] = (pg8::f32x4){0.f, 0.f, 0.f, 0.f};
                for (int w2 = 0; w2 < wave; ++w2)
#pragma unroll
                    for (int ib = 0; ib < 2; ++ib) st[ib] = st[ib] * g8 + ends[(w2 * 2 + ib) * 64 + lane];
                bf16* ST = (bf16*)(ws + WS_STATE) + (size_t)(bh * 64 + 8 * wave) * 4096 + (size_t)(16 * dvs + fr) * 64 + 32 * dkh + 4 * fq;
#pragma unroll
                for (int i = 0; i < 8; ++i)
#pragma unroll
                    for (int ib = 0; ib < 2; ++ib) { u32x2 w; w.x = pk2(st[ib][0], st[ib][1]); w.y = pk2(st[ib][2], st[ib][3]); *(u32x2*)(ST + (size_t)i * 4096 + 16 * ib) = w; st[ib] = st[ib] * g64 + u[i][ib]; }
            } else if (bx < 224) {
                const int bh = bx - 192; const float* lf = (const float*)(ws + WS_LOGF) + (size_t)bh * SEQ; float* cb = (float*)(ws + WS_CB) + (size_t)bh * SEQ;
                const f32x4 a0 = *(const f32x4*)(lf + tid * 8), a1 = *(const f32x4*)(lf + tid * 8 + 4); float v[8] = {a0.x, a0.y, a0.z, a0.w, a1.x, a1.y, a1.z, a1.w};
#pragma unroll
                for (int e = 1; e < 8; ++e) v[e] += v[e - 1];
                float tot = v[7];
#pragma unroll
                for (int o = 1; o < 64; o <<= 1) { const float t = __shfl_up(tot, o); if (lane >= o) tot += t; }
                if (lane == 63) ldsf[wave] = tot;
                __syncthreads();
                float off = tot - v[7];
                for (int w = 0; w < wave; ++w) off += ldsf[w];
                f32x4 o0, o1; o0.x = -(v[0] + off) * LOG2E; o0.y = -(v[1] + off) * LOG2E; o0.z = -(v[2] + off) * LOG2E; o0.w = -(v[3] + off) * LOG2E; o1.x = -(v[4] + off) * LOG2E; o1.y = -(v[5] + off) * LOG2E; o1.z = -(v[6] + off) * LOG2E; o1.w = -(v[7] + off) * LOG2E;
                *(f32x4*)(cb + tid * 8) = o0; *(f32x4*)(cb + tid * 8 + 4) = o1;
            } else { const int idx = (bx - 224) * NTHR + tid; if (idx < M) ((float*)(ws + WS_SS))[(size_t)((l + 1) & 1) * M + idx] = 0.f;
                const int bh = bx - 224, b = bh >> 3, h = bh & 7, rsub = lane >> 3, part = lane & 7;
                const bf16* Qp = (const bf16*)(ws + WS_QO) + ((size_t)b * SEQ + wave * 512 + rsub) * 512 + h * 64 + part * 8; const bf16* Kp = (const bf16*)(ws + WS_KB) + ((size_t)b * SEQ + wave * 512 + rsub) * 512 + h * 64 + part * 8;
                float qm = 0.f, km = 0.f;
#pragma unroll 8
                for (int it = 0; it < 64; ++it) { const u32x4 qv = *(const u32x4*)(Qp + (size_t)it * 8 * 512), kv = *(const u32x4*)(Kp + (size_t)it * 8 * 512); float sq = 0.f, sk = 0.f;
#pragma unroll
                    for (int e = 0; e < 4; ++e) { const float a0 = bflo(qv[e]), a1 = bfhi(qv[e]), c0 = bflo(kv[e]), c1 = bfhi(kv[e]); sq += a0 * a0 + a1 * a1; sk += c0 * c0 + c1 * c1; }
                    sq += __shfl_xor(sq, 1); sq += __shfl_xor(sq, 2); sq += __shfl_xor(sq, 4); sk += __shfl_xor(sk, 1); sk += __shfl_xor(sk, 2); sk += __shfl_xor(sk, 4);
                    qm = fmaxf(qm, sq); km = fmaxf(km, sk); }
#pragma unroll
                for (int o = 8; o < 64; o <<= 1) { qm = fmaxf(qm, __shfl_xor(qm, o)); km = fmaxf(km, __shfl_xor(km, o)); }
                if (lane == 0) { ldsf[wave * 2] = qm; ldsf[wave * 2 + 1] = km; }
                __syncthreads();
                if (tid == 0) { float a = 0.f, c = 0.f; for (int w = 0; w < NWAVES; ++w) { a = fmaxf(a, ldsf[2 * w]); c = fmaxf(c, ldsf[2 * w + 1]); } ((float*)(ws + WS_NRM))[bh] = sqrtf(a) * sqrtf(c) * 1.0001f; }
            }
        }
        GSYNC();
        TSTAMP(3);
        {
            PHASE_VARS;
            if (wave < 4) ret_out_unit(args, l, wave * 256 + bx, lane);
            else {
                const int t = (wave - 4) * 256 + bx, g = t >> 6, r = t & 63, tm = r >> 3, tn = r & 7;
                const bf16* SUAg = (const bf16*)(ws + WS_SUA) + (size_t)g * NCH5 * KA5;
                WEpiS5Y E{SUAg, (bf16*)(ws + WS_YS5), args.in[10] + (size_t)l * 256 + g * 16, tm * 64, tn * 64, g};
                wave_gemm64<20, 4, WEpiS5Y>(SUAg + (size_t)(tm * 64) * KA5, KA5, (const bf16*)(ws + WS_MF) + ((size_t)(l * 16 + g) * 512 + tn * 64) * KA5, KA5, lane, E);
            }
            __syncthreads();
            const attn_body::AttnTensors AT{(const attn_body::bf16*)(ws + WS_QO), (const attn_body::bf16*)(ws + WS_KB), (const attn_body::bf16*)(ws + WS_VB), (attn_body::bf16*)(ws + WS_GATE), (const float*)(ws + WS_CB), (const float*)(ws + WS_NRM)};
            const attn_body::StaticOrder S(G, bx);
#ifdef REP_ATTN
            attn_body::attn_phase<attn_body::StaticOrder>((char*)lds, AT, S, opaque_true());
#endif
            attn_body::attn_phase<attn_body::StaticOrder>((char*)lds, AT, S);
        }
        GSYNC();
        TSTAMP(4);
        {
            PHASE_VARS;
            if (wave < 4) {
                const int t = wave * 256 + bx, tm = t >> 2, tn = t & 3;
                WEpiGlu E{(const bf16*)(ws + WS_YS5), (bf16*)(ws + WS_GATE), tm * 64, tn * 64};
                wave_gemm64<8, 4, WEpiGlu>((const bf16*)(ws + WS_YS5) + (size_t)(tm * 64) * 256, 256, (const bf16*)(ws + WS_WGLU) + (size_t)l * 65536 + (size_t)(tn * 64) * 256, 256, lane, E);
            }
        }
        GSYNC();
        TSTAMP(5);
        {
            PHASE_VARS;
            pg8::Gemm g{(const bf16*)(ws + WS_GATE), (const bf16*)(ws + WS_WO) + (size_t)l * DM * DM, M, DM, DM, DM, DM, 0, 0};
            pg8::StaticOrder S; S.init(M, DM, G, bx);
            if (l + 1 < DEPTH) {
                EpiOutX<false> E{l == 0 ? args.in[0] : X, X, args.in[1] + (size_t)(l + 1) * DM, (float*)(ws + WS_XBUF), (unsigned*)ws + 4096, (bf16*)(ws + WS_XN), 32u * (unsigned)(l + 1)};
                pg8::gemm_phase<EpiOutX<false>, pg8::StaticOrder, false, true>(ldsl, g, S, E);
            } else {
                EpiOutX<true> E{X, X, args.in[15], (float*)(ws + WS_XBUF), (unsigned*)ws + 4096, nullptr, 32u * (unsigned)(l + 1)};
                pg8::gemm_phase<EpiOutX<true>, pg8::StaticOrder, false, true>(ldsl, g, S, E);
            }
        }
        if (l + 1 < DEPTH) GSYNC();
        TSTAMP(6);
    }
}

extern "C" void kernel_launch(void* const* d_in, const int* in_sizes, int n_in, void* d_out, int out_size, void* d_ws, size_t ws_size, hipStream_t stream) {
    static int grid = 0;
    if (grid == 0) {
        if (n_in != 16 || ws_size < WS_END) { fprintf(stderr, "kernel_launch: unexpected n_in %d / ws %zu\n", n_in, ws_size); grid = -1; return; }
        int dev = 0, cus = 0, per_cu = 0;
        hipGetDevice(&dev); hipDeviceGetAttribute(&cus, hipDeviceAttributeMultiprocessorCount, dev);
        if (hipFuncSetAttribute((const void*)mega_fwd, hipFuncAttributeMaxDynamicSharedMemorySize, LDS_BYTES) != hipSuccess) { fprintf(stderr, "kernel_launch: hipFuncSetAttribute failed\n"); grid = -1; return; }
        if (hipOccupancyMaxActiveBlocksPerMultiprocessor(&per_cu, (const void*)mega_fwd, NTHR, LDS_BYTES) != hipSuccess || per_cu < 1) { fprintf(stderr, "kernel_launch: occupancy query failed (%d)\n", per_cu); grid = -1; return; }
        grid = cus;
        if (grid != 256) fprintf(stderr, "kernel_launch: note: %d CUs\n", grid);
    }
    if (grid < 0) return;
    if (hipMemsetAsync(d_ws, 0, 32768, stream) != hipSuccess) { fprintf(stderr, "kernel_launch: hipMemsetAsync failed\n"); return; }
    Args a{};
    for (int i = 0; i < 16; ++i) a.in[i] = (const float*)d_in[i];
    a.out = (float*)d_out; a.ws = (unsigned char*)d_ws;
    void* kargs[] = {&a};
    hipError_t e = hipLaunchCooperativeKernel((const void*)mega_fwd, dim3(grid), dim3(NTHR), kargs, LDS_BYTES, stream);
    if (e != hipSuccess) fprintf(stderr, "kernel_launch: cooperative launch failed: %s\n", hipGetErrorString(e));
}
```

```cpp
#include <hip/hip_runtime.h>
#include <cstdio>
#include <cstdint>
namespace pg8 {
#define PG8_LAS __attribute__((address_space(3)))
typedef unsigned short bf16_t;
typedef short bf16x8 __attribute__((ext_vector_type(8)));
typedef float f32x4 __attribute__((ext_vector_type(4)));
typedef unsigned u32x4 __attribute__((ext_vector_type(4)));
constexpr int BM = 256, BK = 64, HALF = 128, HTB = HALF * BK * 2  , STAGE_BYTES = 8 * HTB, NXCD = 8, WGM = 4;

__host__ __device__ __forceinline__ int lds_byte(int r, int c) { const int st = (r >> 4) * 2 + (c >> 5), rr = r & 15, cc = c & 31, ob = rr * 64 + cc * 2; return st * 1024 + (ob ^ (((ob >> 9) & 1) << 5)); }
__host__ __device__ __forceinline__ void stage_rc(int b, int& R, int& C) { const int st = b / 1024, sb = b % 1024, swz = sb ^ (((sb >> 9) & 1) << 5); R = (st >> 1) * 16 + swz / 64; C = (st & 1) * 32 + (swz % 64) / 2; }
__host__ __device__ __forceinline__ int perm32(int rho) { const int n = rho >> 4, i = rho & 15; return 8 * (i >> 2) + 4 * n + (i & 3); }

struct Unit { int pm, pn, gz; };
struct Gemm { const bf16_t* A; const bf16_t* Bt; int M, N, K; int lda, ldb; size_t gsA, gsB; };

struct StaticOrder {
    int nM, nN, nwg, G, c;
    __host__ __device__ void init(int M, int N, int G_, int c_) { nM = M / BM; nN = N / BM; nwg = nM * nN; G = G_; c = c_; }
    __host__ __device__ bool next(int i, Unit& u) const {
        const long L = (long)i * G + c; if (L >= nwg) return false;
        int wgid = (int)L; { const int q = nwg / NXCD, r = nwg % NXCD, xcd = wgid % NXCD, off = wgid / NXCD; wgid = (xcd < r ? xcd * (q + 1) : r * (q + 1) + (xcd - r) * q) + off; }
        const int nig = WGM * nN, gid = wgid / nig, fm = gid * WGM, gsz = (nM - fm) < WGM ? (nM - fm) : WGM;
        u.pm = fm + ((wgid % nig) % gsz); u.pn = (wgid % nig) / gsz; u.gz = 0; return true;
    }
    __device__ __forceinline__ void a_ready(const Unit&) const {}
    __device__ __forceinline__ void done(const Unit&) const {}
};

__device__ __forceinline__ unsigned cvt_pk_bf16(float lo, float hi) { unsigned r; asm volatile("v_cvt_pk_bf16_f32 %0, %1, %2" : "=v"(r) : "v"(lo), "v"(hi)); return r; }
typedef float f32x2 __attribute__((ext_vector_type(2)));
__device__ __forceinline__ f32x2 gelu_pk(f32x2 v) {
    const f32x2 av = __builtin_elementwise_abs(v), d = av * 0.2316418882f + 1.0f;
    f32x2 t; t.x = __builtin_amdgcn_rcpf(d.x); t.y = __builtin_amdgcn_rcpf(d.y);
    f32x2 q = t * 0.5307027145f + (-0.7265760135f); q = q * t + 0.7107068705f; q = q * t + (-0.142248368f); q = q * t + 0.127414796f; q = q * t;
    const f32x2 s = (v * v) * (-0.72134752044f);
    f32x2 e; e.x = __builtin_amdgcn_exp2f(s.x); e.y = __builtin_amdgcn_exp2f(s.y);
    const f32x2 m = v * (q * e), r = v - m;
    f32x2 o; o.x = v.x < 0.f ? m.x : r.x; o.y = v.y < 0.f ? m.y : r.y; return o;
}

template <class Epi, class Sched, bool ALIGN_EPI = false, bool SP2 = false>
__device__ __forceinline__ void gemm_phase(PG8_LAS unsigned char* lds, const Gemm g, const Sched& S, const Epi& E) {
    int tid_ = threadIdx.x; asm volatile("" : "+v"(tid_));
    const int tid = tid_, wid = __builtin_amdgcn_readfirstlane(tid >> 6), lane = tid & 63, wr = wid >> 2, wc = wid & 3, fr = lane & 15, fq = lane >> 4;
    const int K = g.K, nt = K / BK;
    unsigned voffA[2], voffB[2];
#pragma unroll
    for (int i = 0; i < 2; ++i) { int R, C; stage_rc(tid * 16 + i * 8192, R, C); const int Rb = Epi::PERM ? ((R & ~31) + perm32(R & 31)) : R;
        voffA[i] = (unsigned)(R * g.lda + C) * 2u; voffB[i] = (unsigned)(Rb * g.ldb + C) * 2u; }
    const size_t kstep = (size_t)(BK * 2);
    const size_t hstepA = (size_t)HALF * g.lda * 2, hstepB = (size_t)HALF * g.ldb * 2;
    const size_t tstepA = 2 * hstepA, tstepB = 2 * hstepB;
    const unsigned ldsw = (unsigned)wid * 1024u;
    const int aoff = lds_byte(wr * 64 + fr, fq * 8), boff = lds_byte(wc * 32 + fr, fq * 8);
#define PG8_SA(b, h) (((b) * 2 + (h)) * HTB)
#define PG8_SB(b, h) ((4 + (b) * 2 + (h)) * HTB)
#define PG8_STAGE(bufoff, gbase, voff) do { _Pragma("unroll") for (int _i = 0; _i < 2; ++_i) \
        __builtin_amdgcn_global_load_lds((const unsigned*)((const char*)(gbase) + (voff)[_i]), (PG8_LAS unsigned*)(lds + (bufoff) + ldsw + _i * 8192), 16, 0, 0); } while (0)
#define PG8_LDA(dst, b, h) do { _Pragma("unroll") for (int m = 0; m < 4; ++m) _Pragma("unroll") for (int k = 0; k < 2; ++k) dst[m][k] = *(const PG8_LAS bf16x8*)(lds + PG8_SA(b, h) + aoff + m * 2048 + k * 1024); } while (0)
#define PG8_LDB(dst, b, h) do { _Pragma("unroll") for (int n = 0; n < 2; ++n) _Pragma("unroll") for (int k = 0; k < 2; ++k) dst[n][k] = *(const PG8_LAS bf16x8*)(lds + PG8_SB(b, h) + boff + n * 2048 + k * 1024); } while (0)
#define PG8_MMA(ai, bj, At, Bt) do { __builtin_amdgcn_s_setprio(1); _Pragma("unroll") for (int m = 0; m < 4; ++m) _Pragma("unroll") for (int n = 0; n < 2; ++n) _Pragma("unroll") for (int k = 0; k < 2; ++k) \
        acc[ai][bj][m][n] = __builtin_amdgcn_mfma_f32_16x16x32_bf16(Bt[n][k], At[m][k], acc[ai][bj][m][n], 0, 0, 0); __builtin_amdgcn_s_setprio(0); } while (0)
#define PG8_WAIT_V(n) asm volatile("s_waitcnt vmcnt(" #n ")" ::: "memory")
#define PG8_WAIT_L(n) asm volatile("s_waitcnt lgkmcnt(" #n ")" ::: "memory")
#define PG8_BAR __builtin_amdgcn_s_barrier()
#define PG8_SCHED __builtin_amdgcn_sched_barrier(0)
    Unit cur, nxt; int ui = 0;
    if (!S.next(0, cur)) return;
    f32x4 acc[2][2][4][2];
#pragma unroll
    for (int a = 0; a < 2; ++a)
#pragma unroll
        for (int b = 0; b < 2; ++b)
#pragma unroll
            for (int m = 0; m < 4; ++m)
#pragma unroll
                for (int n = 0; n < 2; ++n) acc[a][b][m][n] = (f32x4){0.f, 0.f, 0.f, 0.f};
    bf16x8 At[4][2], B0[2][2], B1[2][2];
    const char* cA = (const char*)g.A + (size_t)cur.gz * g.gsA * 2 + (size_t)cur.pm * tstepA; const char* cB = (const char*)g.Bt + (size_t)cur.gz * g.gsB * 2 + (size_t)cur.pn * tstepB;
    S.a_ready(cur);
    if constexpr (SP2) {
        PG8_STAGE(PG8_SB(0, 0), cB, voffB); PG8_STAGE(PG8_SB(0, 1), cB + hstepB, voffB); PG8_STAGE(PG8_SA(0, 0), cA, voffA); PG8_STAGE(PG8_SA(0, 1), cA + hstepA, voffA);
        if (wr == 1) PG8_BAR;
        PG8_WAIT_V(2); PG8_BAR;
        PG8_STAGE(PG8_SB(1, 0), cB + kstep, voffB); PG8_STAGE(PG8_SA(1, 0), cA + kstep, voffA); PG8_STAGE(PG8_SB(1, 1), cB + hstepB + kstep, voffB);
        PG8_WAIT_V(6); PG8_BAR;
    } else {
        PG8_STAGE(PG8_SB(0, 0), cB, voffB); PG8_STAGE(PG8_SA(0, 0), cA, voffA); PG8_STAGE(PG8_SB(0, 1), cB + hstepB, voffB); PG8_STAGE(PG8_SA(0, 1), cA + hstepA, voffA);
        if (wr == 1) PG8_BAR;
        PG8_WAIT_V(4); PG8_BAR;
        PG8_STAGE(PG8_SB(1, 0), cB + kstep, voffB); PG8_STAGE(PG8_SA(1, 0), cA + kstep, voffA); PG8_STAGE(PG8_SB(1, 1), cB + hstepB + kstep, voffB);
        PG8_WAIT_V(6); PG8_BAR;
    }
    for (;;) {
        const bool has_next = S.next(ui + 1, nxt);
        const char* nA = has_next ? (const char*)g.A + (size_t)nxt.gz * g.gsA * 2 + (size_t)nxt.pm * tstepA : cA; const char* nB = has_next ? (const char*)g.Bt + (size_t)nxt.gz * g.gsB * 2 + (size_t)nxt.pn * tstepB : cB;
        for (int t = 0; t < nt; t += 2) {
            const bool last = (t == nt - 2);
            const char* a1 = cA + (size_t)(t + 1) * kstep;
            const char* a2 = last ? nA : cA + (size_t)(t + 2) * kstep; const char* b2 = last ? nB : cB + (size_t)(t + 2) * kstep;
            const char* a3 = a2 + kstep; const char* b3 = b2 + kstep;
            if (last && has_next) S.a_ready(nxt);
            if constexpr (SP2) {
            PG8_LDB(B0, 0, 0); PG8_LDB(B1, 0, 1); PG8_SCHED; PG8_LDA(At, 0, 0); PG8_STAGE(PG8_SA(1, 1), a1 + hstepA, voffA);
            PG8_WAIT_V(8); PG8_WAIT_L(0); PG8_BAR; PG8_MMA(0, 0, At, B0); PG8_MMA(0, 1, At, B1); PG8_BAR; PG8_SCHED;
            PG8_LDA(At, 0, 1); PG8_STAGE(PG8_SB(0, 0), b2, voffB); PG8_STAGE(PG8_SB(0, 1), b2 + hstepB, voffB); PG8_STAGE(PG8_SA(0, 0), a2, voffA);
            PG8_WAIT_V(8); PG8_WAIT_L(0); PG8_BAR; PG8_MMA(1, 0, At, B0); PG8_MMA(1, 1, At, B1); PG8_BAR; PG8_SCHED;
            PG8_LDB(B0, 1, 0); PG8_LDB(B1, 1, 1); PG8_SCHED; PG8_LDA(At, 1, 0); PG8_STAGE(PG8_SA(0, 1), a2 + hstepA, voffA);
            PG8_WAIT_V(8); PG8_WAIT_L(0); PG8_BAR; PG8_MMA(0, 0, At, B0); PG8_MMA(0, 1, At, B1); PG8_BAR; PG8_SCHED;
            PG8_LDA(At, 1, 1); PG8_STAGE(PG8_SB(1, 0), b3, voffB); PG8_STAGE(PG8_SB(1, 1), b3 + hstepB, voffB); PG8_STAGE(PG8_SA(1, 0), a3, voffA);
            PG8_WAIT_V(8); PG8_WAIT_L(0); PG8_BAR; PG8_MMA(1, 0, At, B0); PG8_MMA(1, 1, At, B1); PG8_BAR; PG8_SCHED;
            } else {
            PG8_LDB(B0, 0, 0); PG8_SCHED; PG8_LDA(At, 0, 0); PG8_STAGE(PG8_SA(1, 1), a1 + hstepA, voffA);
            PG8_WAIT_L(8); PG8_BAR; PG8_WAIT_L(0); PG8_MMA(0, 0, At, B0); PG8_BAR; PG8_SCHED;
            PG8_LDB(B1, 0, 1); PG8_STAGE(PG8_SB(0, 0), b2, voffB);
            PG8_BAR; PG8_WAIT_L(0); PG8_MMA(0, 1, At, B1); PG8_BAR;
            PG8_LDA(At, 0, 1); PG8_STAGE(PG8_SA(0, 0), a2, voffA);
            PG8_BAR; PG8_WAIT_L(0); PG8_MMA(1, 0, At, B0); PG8_BAR; PG8_SCHED;
            PG8_STAGE(PG8_SB(0, 1), b2 + hstepB, voffB);
            PG8_WAIT_V(6); PG8_BAR; PG8_MMA(1, 1, At, B1); PG8_BAR;
            PG8_LDB(B0, 1, 0); PG8_SCHED; PG8_LDA(At, 1, 0); PG8_STAGE(PG8_SA(0, 1), a2 + hstepA, voffA);
            PG8_WAIT_L(8); PG8_BAR; PG8_WAIT_L(0); PG8_MMA(0, 0, At, B0); PG8_BAR; PG8_SCHED;
            PG8_LDB(B1, 1, 1); PG8_STAGE(PG8_SB(1, 0), b3, voffB);
            PG8_BAR; PG8_WAIT_L(0); PG8_MMA(0, 1, At, B1); PG8_BAR;
            PG8_LDA(At, 1, 1); PG8_STAGE(PG8_SA(1, 0), a3, voffA);
            PG8_BAR; PG8_WAIT_L(0); PG8_MMA(1, 0, At, B0); PG8_BAR; PG8_SCHED;
            PG8_STAGE(PG8_SB(1, 1), b3 + hstepB, voffB);
            PG8_WAIT_V(6); PG8_BAR; PG8_MMA(1, 1, At, B1); PG8_BAR;
            }
        }
        if constexpr (ALIGN_EPI) { if (wr == 0) PG8_BAR; }
        if constexpr (!Epi::AFTER_DRAIN) { E(acc, cur, wr, wc, fr, fq); S.done(cur); }
        if (!has_next) break;
#pragma unroll
        for (int a = 0; a < 2; ++a)
#pragma unroll
            for (int b = 0; b < 2; ++b)
#pragma unroll
                for (int m = 0; m < 4; ++m)
#pragma unroll
                    for (int n = 0; n < 2; ++n) acc[a][b][m][n] = (f32x4){0.f, 0.f, 0.f, 0.f};
        cur = nxt; cA = nA; cB = nB; ++ui;
        if constexpr (ALIGN_EPI) { if (wr == 1) PG8_BAR; }
    }
    PG8_WAIT_V(0);
    if constexpr (!ALIGN_EPI) { if (wr == 0) PG8_BAR; }
    PG8_BAR;
    if constexpr (Epi::AFTER_DRAIN) { E.fused(acc, cur, wr, wc, fr, fq, lds, wid, lane); S.done(cur); }
#undef PG8_SA
#undef PG8_SB
#undef PG8_STAGE
#undef PG8_LDA
#undef PG8_LDB
#undef PG8_MMA
#undef PG8_WAIT_V
#undef PG8_WAIT_L
#undef PG8_BAR
#undef PG8_SCHED
}
}
#include <hip/hip_bf16.h>
#include <cmath>
namespace attn_body {
using bf16=__hip_bfloat16;
using bf16x8=__attribute__((ext_vector_type(8)))short;
using s16x4=__attribute__((ext_vector_type(4)))short;
using f32x16=__attribute__((ext_vector_type(16)))float;
using u32x4=__attribute__((ext_vector_type(4)))unsigned;
using f32x4=__attribute__((ext_vector_type(4)))float;
constexpr int BATCH=4,NHEAD=8,SEQ=4096,D=64,DM=NHEAD*D,OPITCH=1024;
constexpr int NW=8,QBLK=32,QB=QBLK*NW,KVBLK=64,NQB=SEQ/QB;
constexpr int ATTN_PITCH=DM, ATTN_UNIT_ROWS=QB;
__device__ __forceinline__ int crow(int r,int hi){return (r&3)+8*(r>>2)+4*hi;}
#define SBAR() __builtin_amdgcn_sched_barrier(0)
__device__ __forceinline__ void cmask(f32x16&p0,f32x16&p1,int jb,int qrel,int hi){
  const float NEG=-INFINITY; int kb=64*jb+4*hi;
  #pragma unroll
  for(int r=0;r<16;++r){int kv=kb+(r&3)+8*(r>>2); if(kv>qrel)p0[r]=NEG; if(kv+32>qrel)p1[r]=NEG;}
}

constexpr int NSLOT=3, SLOTB=8192;
constexpr int LDS_K=0, LDS_V=NSLOT*SLOTB, LDS_WS=2*NSLOT*SLOTB, LDS_OST=LDS_WS+NW*64*4, LDS_CB=LDS_OST+NW*4096, LDS_BYTES=LDS_CB+SEQ*4;
constexpr float C2=0.125f*1.4426950408889634f;
__device__ __forceinline__ void glds16(const void*gsrc,unsigned lds_dst){unsigned keep;
  asm volatile("s_mov_b32 %0, m0\n\ts_mov_b32 m0, %2\n\ts_nop 0\n\tglobal_load_lds_dwordx4 %1, off\n\ts_mov_b32 m0, %0":"=&s"(keep):"v"(gsrc),"s"(lds_dst):"memory");}
__device__ __forceinline__ float max3f(float a,float b,float c){float r;asm("v_max3_f32 %0, %1, %2, %3":"=v"(r):"v"(a),"v"(b),"v"(c));return r;}
__device__ __forceinline__ float max2f(float a,float b){float r;asm("v_max_f32_e32 %0, %1, %2":"=v"(r):"v"(a),"v"(b));return r;}
__device__ __forceinline__ float fadd_s(float a,float b){float r;asm("v_add_f32_e32 %0, %1, %2":"=v"(r):"v"(a),"v"(b));return r;}
__device__ __forceinline__ float fsub_s(float a,float b){float r;asm("v_sub_f32_e32 %0, %1, %2":"=v"(r):"v"(a),"v"(b));return r;}
typedef float f32x2_t __attribute__((ext_vector_type(2))); typedef __bf16 bf16x2_t __attribute__((ext_vector_type(2)));
__device__ __forceinline__ unsigned cvtpk_s(float lo,float hi){f32x2_t v={lo,hi};bf16x2_t b=__builtin_convertvector(v,bf16x2_t);return __builtin_bit_cast(unsigned,b);}
#define WAIT_BAR(N) asm volatile("s_waitcnt vmcnt(" #N ") lgkmcnt(0)\n\ts_barrier":::"memory")

__device__ __forceinline__ void qkt(f32x16&p0,f32x16&p1,const char*Kslot,const bf16x8*qr,const char*cbt,int r32,int hi){
  const char*kb=Kslot+hi*1024+r32*16;
  #pragma unroll
  for(int a=0;a<4;++a){ const f32x4 u0=*reinterpret_cast<const f32x4*>(cbt+hi*16+a*32), u1=*reinterpret_cast<const f32x4*>(cbt+128+hi*16+a*32);
    p0[4*a]=u0[0];p0[4*a+1]=u0[1];p0[4*a+2]=u0[2];p0[4*a+3]=u0[3]; p1[4*a]=u1[0];p1[4*a+1]=u1[1];p1[4*a+2]=u1[2];p1[4*a+3]=u1[3]; }
  #pragma unroll
  for(int d0=0;d0<4;++d0){
    const bf16x8 b0=*reinterpret_cast<const bf16x8*>(kb+d0*2048);
    const bf16x8 b1=*reinterpret_cast<const bf16x8*>(kb+d0*2048+512);
    p0=__builtin_amdgcn_mfma_f32_32x32x16_bf16(b0,qr[d0],p0,0,0,0);p1=__builtin_amdgcn_mfma_f32_32x32x16_bf16(b1,qr[d0],p1,0,0,0);}
}
typedef __attribute__((address_space(3))) const char* lds_cptr;
typedef short v4i16_t __attribute__((ext_vector_type(4)));
__device__ __forceinline__ void kload8(bf16x8*kf,lds_cptr kp){
  kf[0]=*(const __attribute__((address_space(3))) bf16x8*)(kp);      kf[1]=*(const __attribute__((address_space(3))) bf16x8*)(kp+512);
  kf[2]=*(const __attribute__((address_space(3))) bf16x8*)(kp+2048); kf[3]=*(const __attribute__((address_space(3))) bf16x8*)(kp+2560);
  kf[4]=*(const __attribute__((address_space(3))) bf16x8*)(kp+4096); kf[5]=*(const __attribute__((address_space(3))) bf16x8*)(kp+4608);
  kf[6]=*(const __attribute__((address_space(3))) bf16x8*)(kp+6144); kf[7]=*(const __attribute__((address_space(3))) bf16x8*)(kp+6656);
}
__device__ __forceinline__ void kload2(bf16x8*kf,lds_cptr kp,int j){ kf[2*j]=*(const __attribute__((address_space(3))) bf16x8*)(kp+j*2048); kf[2*j+1]=*(const __attribute__((address_space(3))) bf16x8*)(kp+j*2048+512); }
__device__ __forceinline__ s16x4 vtr(lds_cptr p){ return __builtin_bit_cast(s16x4,__builtin_amdgcn_ds_read_tr16_b64_v4i16((__attribute__((address_space(3))) v4i16_t*)p)); }
__device__ __forceinline__ float rowmax(const f32x16&p0,const f32x16&p1){
  float a=max3f(p0[0],p0[1],p1[0]),b=max3f(p0[2],p0[3],p1[1]);a=max3f(a,p1[2],p1[3]);
  #pragma unroll
  for(int r=4;r<16;r+=4){a=max3f(a,p0[r],p0[r+1]);b=max3f(b,p0[r+2],p0[r+3]);a=max3f(a,p1[r],p1[r+1]);b=max3f(b,p1[r+2],p1[r+3]);}
  const float m=max2f(a,b);
  auto rr=__builtin_amdgcn_permlane32_swap(__float_as_uint(m),__float_as_uint(m),false,false);
  return max2f(__uint_as_float(rr[0]),__uint_as_float(rr[1]));
}
__device__ __forceinline__ void pv(f32x16*o,int vb,bf16x8 pa0,bf16x8 pa1,bf16x8 pa2,bf16x8 pa3){
  #pragma unroll
  for(int d0=0;d0<2;++d0){s16x4 lo[4],hi[4];
    #pragma unroll
    for(int ks=0;ks<4;++ks){
      asm volatile("ds_read_b64_tr_b16 %0,%1 offset:%c2":"=&v"(lo[ks]):"v"(vb),"i"(d0*4096+ks*1024):"memory");
      asm volatile("ds_read_b64_tr_b16 %0,%1 offset:%c2":"=&v"(hi[ks]):"v"(vb),"i"(d0*4096+ks*1024+512):"memory");}
    asm volatile("s_waitcnt lgkmcnt(0)":::"memory");SBAR();
    #define PK(k) (bf16x8){lo[k][0],lo[k][1],lo[k][2],lo[k][3],hi[k][0],hi[k][1],hi[k][2],hi[k][3]}
    o[d0]=__builtin_amdgcn_mfma_f32_32x32x16_bf16(pa0,PK(0),o[d0],0,0,0);
    o[d0]=__builtin_amdgcn_mfma_f32_32x32x16_bf16(pa1,PK(1),o[d0],0,0,0);
    o[d0]=__builtin_amdgcn_mfma_f32_32x32x16_bf16(pa2,PK(2),o[d0],0,0,0);
    o[d0]=__builtin_amdgcn_mfma_f32_32x32x16_bf16(pa3,PK(3),o[d0],0,0,0);
    #undef PK
  }
}

#ifndef ATTN_STORE16
#define ATTN_STORE16(p,v) (*(u32x4*)(p)=(v))
#endif
template<int THRL> __device__ __forceinline__ void attn_unit(int b,int h,int qb,const bf16*Q,const bf16*__restrict__ K,const bf16*__restrict__ V,bf16*O,const float*__restrict__ CB,const float*__restrict__ NRM,char*shm,bool dry=false){
  int tid_=threadIdx.x; asm volatile("":"+v"(tid_)); const int tid=tid_,lane=tid&63,r32=lane&31,hi=lane>>5; const int wid=__builtin_amdgcn_readfirstlane(tid>>6);
  const long rowbase=(long)b*SEQ; const int q0=qb*QB;
  int t0;
  { const f32x4* cbg=reinterpret_cast<const f32x4*>(CB+(long)(b*NHEAD+h)*SEQ); f32x4* cbl=reinterpret_cast<f32x4*>(shm+LDS_CB); const int nv=(q0+QB)/4;
    for(int i=tid;i<nv;i+=NW*64) cbl[i]=cbg[i];
    const float bnd=NRM[b*NHEAD+h]+40.f;
    asm volatile("s_waitcnt vmcnt(0) lgkmcnt(0)\n\ts_barrier":::"memory");
    const float*cbf=reinterpret_cast<const float*>(shm+LDS_CB); const int tc=2*lane; const int NT0=(q0+QB)/KVBLK;
    const bool ok=(tc<=NT0-4)&&(tc==0||cbf[64*tc-1]+bnd<=cbf[q0]);
    const unsigned long long mk=__ballot(ok); t0=2*(__popcll(mk)-1); t0=__builtin_amdgcn_readfirstlane(t0); }
  const bf16*Qw=Q+(rowbase+q0+wid*QBLK)*DM+h*D;
  const bf16*Kh=K+(rowbase+(long)t0*KVBLK)*DM+h*D,*Vh=V+(rowbase+(long)t0*KVBLK)*DM+h*D;
  const unsigned lds0=(unsigned)(uintptr_t)shm;
  float*wsf=(float*)(shm+LDS_WS)+wid*64;
  const bf16*ksrc=Kh+(long)lane*DM+wid*8;
  const bf16*vsrc=Vh+(long)(16*(wid&3)+(lane>>2))*DM+(wid>>2)*32+(lane&3)*8;
  const unsigned kdst=lds0+LDS_K+wid*1024, vdst=lds0+LDS_V+wid*1024;
  #define DMA_K(t,slot) glds16(ksrc+(long)(t)*KVBLK*DM,(unsigned)__builtin_amdgcn_readfirstlane(kdst+(slot)))
  #define DMA_V(t,slot) glds16(vsrc+(long)(t)*KVBLK*DM,(unsigned)__builtin_amdgcn_readfirstlane(vdst+(slot)))
  const int vb0=(int)(lds0+LDS_V)+((lane>>4)&1)*32+(lane&3)*8+(4*hi+((lane&15)>>2))*64;
  const char*Kbase=shm+LDS_K; bf16x8 kf[8];
  const lds_cptr shm3=(lds_cptr)shm; const lds_cptr kp0=shm3+LDS_K+hi*1024+r32*16; const lds_cptr vp0=shm3+LDS_V+((lane>>4)&1)*32+(lane&3)*8+(4*hi+((lane&15)>>2))*64;
  const int NT=(q0+QB)/KVBLK-t0;
  const lds_cptr cb3=(lds_cptr)shm+LDS_CB+t0*256;
  const float cb_own=*(const __attribute__((address_space(3))) float*)((lds_cptr)shm+LDS_CB+(q0+wid*QBLK+r32)*4);
  DMA_K(0,0);DMA_V(0,0);DMA_K(1,SLOTB);
  bf16x8 qr[4];
  #pragma unroll
  for(int d0=0;d0<4;++d0)qr[d0]=*reinterpret_cast<const bf16x8*>(&Qw[(long)r32*DM+d0*16+hi*8]);
  float mhat=0.f,l_reg=0.f;f32x16 o[2];o[0]=f32x16{};o[1]=f32x16{};
  const int qrel=wid*QBLK+r32;
  #define CMASK(P0,P1,t) do{int jb_=(t)-(NT-4); if(jb_>=0)cmask(P0,P1,jb_,qrel,hi);}while(0)
  bool resc=false;
  #define START(P0,P1) do{ const float rm=max2f(rowmax(P0,P1),cb_own); resc=false; \
    { const float dl=rm; mhat=fadd_s(mhat,dl); \
      _Pragma("unroll") for(int r=0;r<16;++r){P0[r]=fsub_s(P0[r],dl);P1[r]=fsub_s(P1[r],dl);} } \
    _Pragma("unroll") for(int r=0;r<16;++r)P0[r]=__builtin_amdgcn_exp2f(P0[r]); }while(0)
  #define RESC() do{ if(resc){ asm volatile("s_waitcnt lgkmcnt(0)":::"memory"); \
      _Pragma("unroll") for(int d_=0;d_<2;++d_) _Pragma("unroll") for(int r=0;r<16;++r)o[d_][r]*=wsf[crow(r,hi)]; } }while(0)
  f32x16 pA0,pA1,pB0,pB1;
  int sl_prev=0,sl_cur=0,sl_next=SLOTB;
  #define ROT() do{sl_prev=sl_cur;sl_cur=sl_next;sl_next=(sl_next==(NSLOT-1)*SLOTB)?0:sl_next+SLOTB;}while(0)
  DMA_K(2,2*SLOTB);
  WAIT_BAR(3);
  qkt(pA0,pA1,Kbase,qr,shm+LDS_CB+t0*256,r32,hi);asm volatile("s_nop 15\n\ts_nop 7":"+v"(pA0),"+v"(pA1));CMASK(pA0,pA1,0);
  START(pA0,pA1);
  _Pragma("unroll") for(int r=0;r<16;++r)pA1[r]=__builtin_amdgcn_exp2f(pA1[r]);
  WAIT_BAR(0);
  DMA_K(3,0);DMA_V(1,SLOTB);
  ROT();
  kload8(kf,kp0+sl_cur);
  WAIT_BAR(2);
  s16x4 vlo[8],vhi[8]; u32x4 pw0,pw1,pw2,pw3;
  #define PKW(P,B) cvtpk_s(P[B],P[B+1])
  #define PAF(k) __builtin_bit_cast(bf16x8,pw##k)
  #define VFR(i) (bf16x8){vlo[i][0],vlo[i][1],vlo[i][2],vlo[i][3],vhi[i][0],vhi[i][1],vhi[i][2],vhi[i][3]}
  #define PIN(x) asm volatile("":"+v"(x))
  #define MX3(a,b,c) __builtin_fmaxf(__builtin_fmaxf((a),(b)),(c))
  #define GAPA(MF,A0,A1,A2,A3,W0,W1,PW) do{ MF; sacc+=A0; sacc+=A1; sacc+=A2; sacc+=A3; PIN(sacc); W0; W1; PIN(PW); SBAR(); }while(0)
  #define EX(v) __builtin_amdgcn_exp2f(v)
  #define GAPB(MF,X,B) do{ MF; X[B]=EX(X[B]); X[B+1]=EX(X[B+1]); X[B+2]=EX(X[B+2]); X[B+3]=EX(X[B+3]); PIN(X); SBAR(); }while(0)
  #define VRD(i) do{ vlo[i]=vtr(vp_+(((i)>>2)*4096+((i)&3)*1024)); vhi[i]=vtr(vp_+(((i)>>2)*4096+((i)&3)*1024+512)); }while(0)
  #define KRD(G,j) do{ if(G){ kload2(kf,kp0+sl_next,j); SBAR(); } }while(0)
  #define STEP(C0,C1,P0,P1,t,GK,GV,GL) do{ SBAR(); \
    const lds_cptr vp_=vp0+sl_prev; \
    VRD(0); SBAR(); float sacc=(P0[0]+P0[1]); \
    GAPA(C0=__builtin_amdgcn_mfma_f32_32x32x16_bf16(kf[0],qr[0],C0,0,0,0), P0[2],P0[3],P0[4],P0[5],     pw0[0]=PKW(P0,0), pw0[1]=PKW(P0,2), pw0); \
    VRD(4); SBAR(); GAPA(C1=__builtin_amdgcn_mfma_f32_32x32x16_bf16(kf[1],qr[0],C1,0,0,0), P0[6],P0[7],P0[8],P0[9],     pw0[2]=PKW(P0,4), pw0[3]=PKW(P0,6), pw0); \
    VRD(1); SBAR(); GAPA(C0=__builtin_amdgcn_mfma_f32_32x32x16_bf16(kf[2],qr[1],C0,0,0,0),   P0[10],P0[11],P0[12],P0[13], pw1[0]=PKW(P0,8), pw1[1]=PKW(P0,10), pw1); \
    VRD(5); SBAR(); GAPA(C1=__builtin_amdgcn_mfma_f32_32x32x16_bf16(kf[3],qr[1],C1,0,0,0),   P0[14],P0[15],P1[0],P1[1],   pw1[2]=PKW(P0,12),pw1[3]=PKW(P0,14), pw1); \
    VRD(2); SBAR(); GAPA(C0=__builtin_amdgcn_mfma_f32_32x32x16_bf16(kf[4],qr[2],C0,0,0,0),   P1[2],P1[3],P1[4],P1[5],     pw2[0]=PKW(P1,0), pw2[1]=PKW(P1,2), pw2); \
    VRD(6); SBAR(); GAPA(C1=__builtin_amdgcn_mfma_f32_32x32x16_bf16(kf[5],qr[2],C1,0,0,0),   P1[6],P1[7],P1[8],P1[9],     pw2[2]=PKW(P1,4), pw2[3]=PKW(P1,6), pw2); \
    VRD(3); SBAR(); GAPA(C0=__builtin_amdgcn_mfma_f32_32x32x16_bf16(kf[6],qr[3],C0,0,0,0),   P1[10],P1[11],P1[12],P1[13], pw3[0]=PKW(P1,8), pw3[1]=PKW(P1,10), pw3); \
    VRD(7); SBAR(); GAPA(C1=__builtin_amdgcn_mfma_f32_32x32x16_bf16(kf[7],qr[3],C1,0,0,0),   P1[14],P1[15],0.f,0.f,       pw3[2]=PKW(P1,12),pw3[3]=PKW(P1,14), pw3); \
    l_reg+=sacc; \
    if(GK){DMA_K((t)+3,sl_cur);} if(GV){DMA_V((t)+1,sl_next);} \
    CMASK(C0,C1,t); \
    { float a=MX3(C0[0],C0[1],C1[0]),b=MX3(C0[2],C0[3],C1[1]); a=MX3(a,C1[2],C1[3]); \
      _Pragma("unroll") for(int r=4;r<16;r+=4){a=MX3(a,C0[r],C0[r+1]);b=MX3(b,C0[r+2],C0[r+3]);a=MX3(a,C1[r],C1[r+1]);b=MX3(b,C1[r+2],C1[r+3]);} \
      float rm=__builtin_fmaxf(a,b); { auto rr=__builtin_amdgcn_permlane32_swap(__float_as_uint(rm),__float_as_uint(rm),false,false); rm=__builtin_fmaxf(__uint_as_float(rr[0]),__uint_as_float(rr[1])); } \
      resc=false; \
      if(__builtin_expect(__any(rm>(float)THRL),0)){ const float dl=__builtin_fmaxf(rm,0.f); mhat+=dl; \
        _Pragma("unroll") for(int r=0;r<16;++r){C0[r]-=dl;C1[r]-=dl;} \
        const float f=__builtin_amdgcn_exp2f(-dl); l_reg*=f; if(hi==0)wsf[r32]=f; resc=true; } } \
    SBAR(); \
    { const __attribute__((address_space(3))) f32x4* cbp_=(const __attribute__((address_space(3))) f32x4*)(cb3+((t)+1)*256+hi*16); \
      _Pragma("unroll") for(int a_=0;a_<4;++a_){ const f32x4 u0_=cbp_[2*a_], u1_=cbp_[8+2*a_]; \
        P0[4*a_]=u0_[0];P0[4*a_+1]=u0_[1];P0[4*a_+2]=u0_[2];P0[4*a_+3]=u0_[3]; P1[4*a_]=u1_[0];P1[4*a_+1]=u1_[1];P1[4*a_+2]=u1_[2];P1[4*a_+3]=u1_[3]; } } SBAR(); \
    GAPB(o[0]=__builtin_amdgcn_mfma_f32_32x32x16_bf16(PAF(0),VFR(0),o[0],0,0,0), C0,0); \
    GAPB(o[1]=__builtin_amdgcn_mfma_f32_32x32x16_bf16(PAF(0),VFR(4),o[1],0,0,0), C0,4); \
    KRD(GL,0); GAPB(o[0]=__builtin_amdgcn_mfma_f32_32x32x16_bf16(PAF(1),VFR(1),o[0],0,0,0), C0,8); \
    KRD(GL,1); GAPB(o[1]=__builtin_amdgcn_mfma_f32_32x32x16_bf16(PAF(1),VFR(5),o[1],0,0,0), C0,12); \
    KRD(GL,2); GAPB(o[0]=__builtin_amdgcn_mfma_f32_32x32x16_bf16(PAF(2),VFR(2),o[0],0,0,0), C1,0); \
    KRD(GL,3); GAPB(o[1]=__builtin_amdgcn_mfma_f32_32x32x16_bf16(PAF(2),VFR(6),o[1],0,0,0), C1,4); \
    GAPB(o[0]=__builtin_amdgcn_mfma_f32_32x32x16_bf16(PAF(3),VFR(3),o[0],0,0,0), C1,8); \
    GAPB(o[1]=__builtin_amdgcn_mfma_f32_32x32x16_bf16(PAF(3),VFR(7),o[1],0,0,0), C1,12); \
    _Pragma("unroll") for(int r_=0;r_<16;++r_){P0[r_]-=mhat;P1[r_]-=mhat;} \
    }while(0)
  { const __attribute__((address_space(3))) f32x4* cbp_=(const __attribute__((address_space(3))) f32x4*)(cb3+256+hi*16);
    #pragma unroll
    for(int a_=0;a_<4;++a_){ const f32x4 u0_=cbp_[2*a_], u1_=cbp_[8+2*a_];
      pB0[4*a_]=u0_[0]-mhat;pB0[4*a_+1]=u0_[1]-mhat;pB0[4*a_+2]=u0_[2]-mhat;pB0[4*a_+3]=u0_[3]-mhat;
      pB1[4*a_]=u1_[0]-mhat;pB1[4*a_+1]=u1_[1]-mhat;pB1[4*a_+2]=u1_[2]-mhat;pB1[4*a_+3]=u1_[3]-mhat; } }
  int t=1;
  #undef CMASK
  #define CMASK(P0,P1,t) do{}while(0)
  for(;t+5<NT;t+=2){
    STEP(pB0,pB1,pA0,pA1,t,true,true,true);     WAIT_BAR(2); RESC(); ROT();
    STEP(pA0,pA1,pB0,pB1,t+1,true,true,true);   WAIT_BAR(2); RESC(); ROT();
  }
  #undef CMASK
  #define CMASK(P0,P1,t) do{int jb_=(t)-(NT-4); if(jb_>=0)cmask(P0,P1,jb_,qrel,hi);}while(0)
  #define ENDW(tt) do{ if((tt)+3<NT){WAIT_BAR(2);} else if((tt)+2<NT){WAIT_BAR(1);} else {WAIT_BAR(0);} }while(0)
  for(;t+1<NT;t+=2){
    STEP(pB0,pB1,pA0,pA1,t,(t+3<NT),(t+1<NT),(t+1<NT));       ENDW(t);   RESC(); ROT();
    STEP(pA0,pA1,pB0,pB1,t+1,(t+4<NT),(t+2<NT),(t+2<NT));     ENDW(t+1); RESC(); ROT();
  }
  STEP(pB0,pB1,pA0,pA1,NT-1,false,false,false); RESC();
  { float sacc=pB0[0]+pB0[1]; _Pragma("unroll") for(int r=2;r<16;++r)sacc+=pB0[r]; _Pragma("unroll") for(int r=0;r<16;++r)sacc+=pB1[r]; l_reg+=sacc;
    pw0=(u32x4){PKW(pB0,0),PKW(pB0,2),PKW(pB0,4),PKW(pB0,6)};pw1=(u32x4){PKW(pB0,8),PKW(pB0,10),PKW(pB0,12),PKW(pB0,14)};pw2=(u32x4){PKW(pB1,0),PKW(pB1,2),PKW(pB1,4),PKW(pB1,6)};pw3=(u32x4){PKW(pB1,8),PKW(pB1,10),PKW(pB1,12),PKW(pB1,14)};
    SBAR(); pv(o,vb0+sl_cur,PAF(0),PAF(1),PAF(2),PAF(3)); }
  #undef PKW
  #undef PAF
  #undef VFR
  #undef PIN
  #undef MX3
  #undef GAPA
  #undef GAPB
  #undef EX
  #undef VRD
  #undef KRD
  #undef STEP
  #undef ENDW
  {auto rr=__builtin_amdgcn_permlane32_swap(__float_as_uint(l_reg),__float_as_uint(l_reg),false,false);l_reg=__uint_as_float(rr[0])+__uint_as_float(rr[1]);}
  if(hi==0)wsf[32+r32]=l_reg;asm volatile("s_waitcnt lgkmcnt(0)":::"memory");
  float rli[16];
  #pragma unroll
  for(int r=0;r<16;++r)rli[r]=__builtin_amdgcn_rcpf(wsf[32+crow(r,hi)]);
  bf16*Ow=O+(rowbase+q0+wid*QBLK)*OPITCH+h*D;
  { bf16*stg=(bf16*)(shm+LDS_OST)+wid*2048;
    #pragma unroll
    for(int r=0;r<16;++r){const int orow=crow(r,hi);
      #pragma unroll
      for(int d0=0;d0<2;++d0)stg[orow*64+d0*32+r32]=__float2bfloat16(o[d0][r]*rli[r]);}
    asm volatile("s_waitcnt lgkmcnt(0)":::"memory");
    #pragma unroll
    for(int i=0;i<4;++i){const int row=i*8+(lane>>3),ch=lane&7; const u32x4 v=*(const u32x4*)(stg+row*64+ch*8); bf16*dst=Ow+(long)row*OPITCH+ch*8; const u32x4 gv=*(const u32x4*)dst; u32x4 w;
      #pragma unroll
      for(int j=0;j<4;++j){ const float a0=__uint_as_float(v[j]<<16)*__uint_as_float(gv[j]<<16), a1=__uint_as_float(v[j]&0xffff0000u)*__uint_as_float(gv[j]&0xffff0000u); w[j]=cvtpk_s(a0,a1); }
      if(!dry)*(u32x4*)dst=w;} }
  asm volatile("s_waitcnt lgkmcnt(0)\n\ts_barrier":::"memory");
  #undef DMA_K
  #undef DMA_V
  #undef CMASK
  #undef START
  #undef RESC
  #undef ROT
}
constexpr int ATTN_LDS_BYTES=LDS_BYTES;
struct AttnTensors { const bf16* Q; const bf16* K; const bf16* V; bf16* O; const float* CB; const float* NRM; };
struct AttnUnit { int bh; int qb; };
struct StaticOrder {
  int vcu;
  __device__ __forceinline__ explicit StaticOrder(int grid,int block):vcu((block%8)*(grid/8)+block/8){}
  __device__ __forceinline__ bool next(int i,AttnUnit&u)const{ if(i>=2)return false; const int s=vcu&7; u.bh=vcu>>3; u.qb=(i==0)?15-s:s; return true; }
  __device__ __forceinline__ void a_ready(const AttnUnit&)const{}
  __device__ __forceinline__ void done(const AttnUnit&)const{}
};
template<class Sched,int THRL=8> __device__ __forceinline__ void attn_phase(char*lds,const AttnTensors&T,const Sched&S,bool dry=false){
  AttnUnit u;
  for(int i=0;S.next(i,u);++i){ S.a_ready(u); attn_unit<THRL>(u.bh/NHEAD,u.bh%NHEAD,u.qb,T.Q,T.K,T.V,T.O,T.CB,T.NRM,lds,dry); S.done(u); }
}
#undef SBAR
#undef WAIT_BAR
}
#include <hip/hip_cooperative_groups.h>
namespace cg = cooperative_groups;
#define LAS __attribute__((address_space(3)))
typedef unsigned short bf16;
typedef float f32x4 __attribute__((ext_vector_type(4)));
typedef float f32x2 __attribute__((ext_vector_type(2)));
typedef unsigned u32x4 __attribute__((ext_vector_type(4)));
typedef unsigned u32x2 __attribute__((ext_vector_type(2)));
typedef short bf16x8 __attribute__((ext_vector_type(8)));
typedef short bf16x4 __attribute__((ext_vector_type(4)));

constexpr int NWAVES = 8, NTHR = 512;
constexpr int BATCH = 4, SEQ = 4096, DM = 1024, DEPTH = 4, M = BATCH * SEQ;
constexpr int NIN = 3592, NF = 3584;
constexpr int T5 = 32, NCH5 = M / T5, KA5 = 640, NG5 = 16;
constexpr float EPS = 1e-6f;
constexpr float LOG2E = 1.4426950408889634f;

constexpr size_t MiB = 1u << 20;
constexpr size_t WS_WIN = 1 * MiB, WS_WO = 31 * MiB, WS_WGLU = 39 * MiB, WS_ROPE = 40 * MiB, WS_MF = 41 * MiB, WS_WB = 81 * MiB;
constexpr size_t WS_LAM = 90 * MiB, WS_LOGF = 90 * MiB + 65536, WS_CB = WS_LOGF + 524288, WS_SS = WS_CB + 524288, WS_NRM = WS_SS + 131072, WS_XBUF = WS_NRM + 4096;
constexpr size_t WS_XN = 92 * MiB, WS_E = WS_XN, WS_UPD = WS_XN + 4 * MiB, WS_STATE = WS_XN + 20 * MiB;
constexpr size_t WS_QO = 124 * MiB, WS_KB = 140 * MiB, WS_VB = 156 * MiB, WS_SUA = 172 * MiB, WS_RQ = 182 * MiB, WS_RK = 190 * MiB, WS_RKT = 198 * MiB, WS_YS5 = WS_RKT;
constexpr size_t WS_RVT = 206 * MiB, WS_GATE = 214 * MiB, WS_END = 246 * MiB;

constexpr int RING_BYTES = 131072, LDS_BYTES = 147456;

struct Args { const float* in[16]; float* out; unsigned char* ws; };

__device__ __forceinline__ float bf2f(unsigned short b) { return __uint_as_float((unsigned)b << 16); }
__device__ __forceinline__ float bflo(unsigned w) { return __uint_as_float(w << 16); }
__device__ __forceinline__ float bfhi(unsigned w) { return __uint_as_float(w & 0xffff0000u); }
__device__ __forceinline__ unsigned pk2(float lo, float hi) { return pg8::cvt_pk_bf16(lo, hi); }
__device__ __forceinline__ unsigned short f2bf(float f) { return (unsigned short)(pg8::cvt_pk_bf16(f, 0.f) & 0xffffu); }
__device__ __forceinline__ float wave_sum(float v) {
#pragma unroll
    for (int o = 1; o < 64; o <<= 1) v += __shfl_xor(v, o);
    return v;
}
__device__ __forceinline__ float lg2_gamma(int hh) { return __builtin_amdgcn_logf(1.0f - __builtin_amdgcn_exp2f(-5.0f - (float)hh)); }

__device__ __forceinline__ int win_col(int n) {
    if (n < 1536) return n;
    if (n < 1792) return n + 8;
    if (n < 2304) { const bool q = n < 2048; const int base = q ? 1792 : 2048; const int hh = (n - base) >> 6, pos = (n - base) & 63; const int d = (pos & 1) ? 32 + (pos >> 1) : (pos >> 1); return (q ? 1800 : 2056) + hh * 64 + d; }
    return n + 8;
}
template <bool MAP> __device__ __forceinline__ void p0_transpose_item(const float* W, int K, int Nsrc, int Ndst, bf16* WT, LAS float* scr, int item, int lane) {
    const int nblk = Ndst / 32, kb = item / nblk, nb = item % nblk, k0 = 64 * kb, n0 = 32 * nb;
    const int sc = MAP ? win_col(n0 + (lane & 31)) : n0 + (lane & 31);
    float wv[32];
#pragma unroll
    for (int i = 0; i < 32; ++i) { const int kk = 2 * i + (lane >> 5); wv[i] = (MAP && sc < 0) ? 0.f : W[(size_t)(k0 + kk) * Nsrc + (sc < 0 ? 0 : sc)]; }
#pragma unroll
    for (int i = 0; i < 32; ++i) { const int kk = 2 * i + (lane >> 5); scr[kk * 33 + (lane & 31)] = wv[i]; }
    asm volatile("s_waitcnt lgkmcnt(0)" ::: "memory");
    const int c = lane & 7;
#pragma unroll
    for (int j = 0; j < 4; ++j) { const int n = (lane >> 3) + 8 * j; const LAS float* s = scr + (8 * c) * 33 + n;
        u32x4 o; o.x = pk2(s[0 * 33], s[1 * 33]); o.y = pk2(s[2 * 33], s[3 * 33]); o.z = pk2(s[4 * 33], s[5 * 33]); o.w = pk2(s[6 * 33], s[7 * 33]);
        *(u32x4*)(WT + (size_t)(n0 + n) * K + k0 + 8 * c) = o; }
    asm volatile("s_waitcnt lgkmcnt(0)" ::: "memory");
}

__device__ __forceinline__ void s5_prep(const Args& a, int l, int g, LAS float* L, int tid) {
    LAS float* LPr = L;
    LAS float* LPi = L + 33 * 64;
    LAS float* Bbr = L + 66 * 64;
    LAS float* Bbi = Bbr + 1024;
    LAS float* Cr = Bbi + 1024;
    LAS float* Ci = Cr + 1024;
    LAS float* KT = Ci + 1024;
    const float* a_re = a.in[4] + (size_t)(l * 16 + g) * 64; const float* a_im = a.in[5] + (size_t)(l * 16 + g) * 64;
    const float* b_re = a.in[6] + (size_t)(l * 16 + g) * 1024; const float* b_im = a.in[7] + (size_t)(l * 16 + g) * 1024;
    const float* c_re = a.in[8] + (size_t)(l * 16 + g) * 1024; const float* c_im = a.in[9] + (size_t)(l * 16 + g) * 1024;
    const float log_dt = a.in[11][l * 16 + g];
    bf16* MF = (bf16*)(a.ws + WS_MF) + (size_t)(l * 16 + g) * 512 * KA5;
    bf16* WB = (bf16*)(a.ws + WS_WB) + (size_t)(l * 16 + g) * 128 * 512;
    float* LAM = (float*)(a.ws + WS_LAM) + (size_t)(l * 16 + g) * 128;
    if (tid < 64) {
        const int p = tid;
        const double dt = exp((double)log_dt), ar = (double)a_re[p], ai = (double)a_im[p];
        const double mag = exp(ar * dt); double sn, cs; sincos(ai * dt, &sn, &cs);
        const double lr = mag * cs, li = mag * sn, den = ar * ar + ai * ai;
        const double fr = ((lr - 1.0) * ar + li * ai) / den, fi = (li * ar - (lr - 1.0) * ai) / den;
#pragma unroll 4
        for (int h = 0; h < 16; ++h) { const double br = (double)b_re[p * 16 + h], bi = (double)b_im[p * 16 + h]; Bbr[p * 16 + h] = (float)(fr * br - fi * bi); Bbi[p * 16 + h] = (float)(fr * bi + fi * br); }
        double pr = 1.0, pi = 0.0;
        for (int j = 0; j <= 32; ++j) { LPr[j * 64 + p] = (float)pr; LPi[j * 64 + p] = (float)pi; const double nr = pr * lr - pi * li, ni = pr * li + pi * lr; pr = nr; pi = ni; }
        LAM[p] = LPr[32 * 64 + p]; LAM[64 + p] = LPi[32 * 64 + p];
    }
    for (int i = tid; i < 1024; i += NTHR) { const int h = i >> 6, p = i & 63; Cr[p * 16 + h] = c_re[i]; Ci[p * 16 + h] = c_im[i]; }
    __syncthreads();
    { const int j = tid >> 4, h = tid & 15; float acc[16];
#pragma unroll
      for (int e = 0; e < 16; ++e) acc[e] = 0.f;
      for (int p = 0; p < 64; ++p) { const float cr = Cr[p * 16 + h], ci = Ci[p * 16 + h], lr = LPr[j * 64 + p], li = LPi[j * 64 + p]; const float clr = cr * lr - ci * li, cli = cr * li + ci * lr;
#pragma unroll
          for (int q = 0; q < 4; ++q) { const f32x4 br = *(const LAS f32x4*)(Bbr + p * 16 + 4 * q), bi = *(const LAS f32x4*)(Bbi + p * 16 + 4 * q);
              acc[4 * q] += clr * br.x - cli * bi.x; acc[4 * q + 1] += clr * br.y - cli * bi.y; acc[4 * q + 2] += clr * br.z - cli * bi.z; acc[4 * q + 3] += clr * br.w - cli * bi.w; } }
#pragma unroll
      for (int e = 0; e < 16; ++e) KT[tid * 16 + e] = acc[e]; }
    __syncthreads();
    for (int q = tid; q < 512 * 64; q += NTHR) {
        const int row = q >> 6, cp = q & 63, s = cp >> 1, h0 = (cp & 1) * 8, t = row >> 4, h = row & 15;
        u32x4 o = (u32x4){0u, 0u, 0u, 0u};
        if (s <= t) { const LAS float* k = KT + ((t - s) * 16 + h) * 16 + h0; o.x = pk2(k[0], k[1]); o.y = pk2(k[2], k[3]); o.z = pk2(k[4], k[5]); o.w = pk2(k[6], k[7]); }
        *(u32x4*)(MF + (size_t)row * KA5 + cp * 8) = o;
    }
    for (int q = tid; q < 512 * 16; q += NTHR) {
        const int row = q >> 4, cp = q & 15, t = row >> 4, h = row & 15; float v[8];
#pragma unroll
        for (int e = 0; e < 8; ++e) { const int jj = cp * 8 + e, p = jj & 63; const float cr = Cr[p * 16 + h], ci = Ci[p * 16 + h], lr = LPr[(t + 1) * 64 + p], li = LPi[(t + 1) * 64 + p];
            v[e] = (jj < 64) ? (cr * lr - ci * li) : -(cr * li + ci * lr); }
        u32x4 o; o.x = pk2(v[0], v[1]); o.y = pk2(v[2], v[3]); o.z = pk2(v[4], v[5]); o.w = pk2(v[6], v[7]);
        *(u32x4*)(MF + (size_t)row * KA5 + 512 + cp * 8) = o;
    }
    for (int q = tid; q < 128 * 64; q += NTHR) {
        const int j = q >> 6, cp = q & 63, s = cp >> 1, h0 = (cp & 1) * 8, p = j & 63; const float lr = LPr[(31 - s) * 64 + p], li = LPi[(31 - s) * 64 + p]; float v[8];
#pragma unroll
        for (int e = 0; e < 8; ++e) { const float br = Bbr[p * 16 + h0 + e], bi = Bbi[p * 16 + h0 + e]; v[e] = (j < 64) ? (lr * br - li * bi) : (lr * bi + li * br); }
        u32x4 o; o.x = pk2(v[0], v[1]); o.y = pk2(v[2], v[3]); o.z = pk2(v[4], v[5]); o.w = pk2(v[6], v[7]);
        *(u32x4*)(WB + (size_t)j * 512 + cp * 8) = o;
    }
    __syncthreads();
}

__device__ __forceinline__ void norm0_phase(const Args& a, int lane, int gw, int NGW) {
    const float* X = a.in[0]; f32x4 gv[4];
#pragma unroll
    for (int j = 0; j < 4; ++j) gv[j] = *((const f32x4*)a.in[1] + lane + 64 * j);
    bf16* XN = (bf16*)(a.ws + WS_XN); float* SS = (float*)(a.ws + WS_SS);
    for (int m = gw; m < M; m += 2 * NGW) {
        const int m2 = m + NGW; const bool has2 = m2 < M;
        const f32x4* xr = (const f32x4*)(X + (size_t)m * DM) + lane; const f32x4* xr2 = (const f32x4*)(X + (size_t)(has2 ? m2 : m) * DM) + lane; f32x4 v[4], w[4];
#pragma unroll
        for (int j = 0; j < 4; ++j) { v[j] = xr[64 * j]; w[j] = xr2[64 * j]; }
        float ss = 0.f, ss2 = 0.f;
#pragma unroll
        for (int j = 0; j < 4; ++j) { ss += (v[j].x * v[j].x + v[j].y * v[j].y) + (v[j].z * v[j].z + v[j].w * v[j].w); ss2 += (w[j].x * w[j].x + w[j].y * w[j].y) + (w[j].z * w[j].z + w[j].w * w[j].w); }
        ss = wave_sum(ss); ss2 = wave_sum(ss2);
        unsigned long long* o8 = (unsigned long long*)(XN + (size_t)m * DM) + lane; unsigned long long* o82 = (unsigned long long*)(XN + (size_t)m2 * DM) + lane;
        const float r1_ = rsqrtf(ss * (1.f / DM) + EPS), r2_ = rsqrtf(ss2 * (1.f / DM) + EPS);
#pragma unroll
        for (int j = 0; j < 4; ++j) { v[j] = v[j] * gv[j] * r1_; o8[64 * j] = (unsigned long long)pk2(v[j].x, v[j].y) | ((unsigned long long)pk2(v[j].z, v[j].w) << 32);
            if (has2) { w[j] = w[j] * gv[j] * r2_; o82[64 * j] = (unsigned long long)pk2(w[j].x, w[j].y) | ((unsigned long long)pk2(w[j].z, w[j].w) << 32); } }
        if (lane == 0) { SS[m] = ss; if (has2) SS[m2] = ss2; }
    }
}
__device__ __forceinline__ void final_norm(const Args& a, float* X, const float* SS, int lane, int gw, int NGW) {
    f32x4 gv[4];
#pragma unroll
    for (int j = 0; j < 4; ++j) gv[j] = *((const f32x4*)a.in[15] + lane + 64 * j);
    for (int m = gw; m < M; m += 2 * NGW) {
        const int m2 = m + NGW; const bool has2 = m2 < M;
        f32x4* xr = (f32x4*)(X + (size_t)m * DM) + lane; f32x4* xr2 = (f32x4*)(X + (size_t)(has2 ? m2 : m) * DM) + lane; f32x4 v[4], w[4];
#pragma unroll
        for (int j = 0; j < 4; ++j) { v[j] = xr[64 * j]; w[j] = xr2[64 * j]; }
        const float r1 = rsqrtf(SS[m] * (1.f / DM) + EPS), r2 = rsqrtf(SS[has2 ? m2 : m] * (1.f / DM) + EPS);
#pragma unroll
        for (int j = 0; j < 4; ++j) { xr[64 * j] = v[j] * r1 * gv[j]; if (has2) xr2[64 * j] = w[j] * r2 * gv[j]; }
    }
}

__device__ __forceinline__ void flog_phase(const Args& a, int l, const float* SS, LAS float* WF, int tid, int lane, int wave, int blk, int nblk) {
    const float* win = a.in[2] + (size_t)l * DM * NIN;
    for (int i = tid; i < 2048; i += NTHR) { const int k = i >> 1, hf = i & 1; *(LAS f32x4*)(WF + k * 8 + hf * 4) = *(const f32x4*)(win + (size_t)k * NIN + 1536 + hf * 4); }
    __syncthreads();
    const bf16* XN = (const bf16*)(a.ws + WS_XN); float* LOGF = (float*)(a.ws + WS_LOGF);
    const float bfj = (lane < 8) ? a.in[3][l * 8 + lane] : 0.f;
    const int rows_per = M / nblk;
    for (int i = wave; i < rows_per; i += 2 * NWAVES) {
        const int m = blk * rows_per + i, m2 = m + NWAVES; const bool has2 = (i + NWAVES) < rows_per;
        const u32x4 x0 = *((const u32x4*)(XN + (size_t)m * DM) + lane), x1 = *((const u32x4*)(XN + (size_t)m * DM + 512) + lane);
        const u32x4 y0 = *((const u32x4*)(XN + (size_t)(has2 ? m2 : m) * DM) + lane), y1 = *((const u32x4*)(XN + (size_t)(has2 ? m2 : m) * DM + 512) + lane);
        float acc[8], acc2[8];
#pragma unroll
        for (int e = 0; e < 8; ++e) { acc[e] = 0.f; acc2[e] = 0.f; }
#pragma unroll
        for (int hf = 0; hf < 2; ++hf)
#pragma unroll
            for (int q = 0; q < 8; ++q) { const int k = 512 * hf + 8 * lane + q; const f32x4 w0 = *(const LAS f32x4*)(WF + k * 8), w1 = *(const LAS f32x4*)(WF + k * 8 + 4);
                const unsigned xw = hf ? x1[q >> 1] : x0[q >> 1], yw = hf ? y1[q >> 1] : y0[q >> 1]; const float hv = (q & 1) ? bfhi(xw) : bflo(xw), hv2 = (q & 1) ? bfhi(yw) : bflo(yw);
                acc[0] += hv * w0.x; acc[1] += hv * w0.y; acc[2] += hv * w0.z; acc[3] += hv * w0.w; acc[4] += hv * w1.x; acc[5] += hv * w1.y; acc[6] += hv * w1.z; acc[7] += hv * w1.w;
                acc2[0] += hv2 * w0.x; acc2[1] += hv2 * w0.y; acc2[2] += hv2 * w0.z; acc2[3] += hv2 * w0.w; acc2[4] += hv2 * w1.x; acc2[5] += hv2 * w1.y; acc2[6] += hv2 * w1.z; acc2[7] += hv2 * w1.w; }
        float mine = 0.f, mine2 = 0.f;
#pragma unroll
        for (int e = 0; e < 8; ++e) { const float s = wave_sum(acc[e]), s2 = wave_sum(acc2[e]); if (lane == e) { mine = s; mine2 = s2; } }
        if (lane < 8) { const float z = mine + bfj; LOGF[(size_t)((m >> 12) * 8 + lane) * SEQ + (m & 4095)] = fminf(z, 0.f) - log1pf(expf(-fabsf(z)));
            if (has2) { const float z2 = mine2 + bfj; LOGF[(size_t)((m2 >> 12) * 8 + lane) * SEQ + (m2 & 4095)] = fminf(z2, 0.f) - log1pf(expf(-fabsf(z2))); } }
    }
}

__device__ __forceinline__ bool opaque_true() { int d = 1; asm volatile("" : "+s"(d)); return d != 0; }
struct RangeOrder {
    pg8::StaticOrder S; int lo, hi;
    __device__ bool next(int i, pg8::Unit& u) const { return (lo + i < hi) ? S.next(lo + i, u) : false; }
    __device__ __forceinline__ void a_ready(const pg8::Unit&) const {}
    __device__ __forceinline__ void done(const pg8::Unit&) const {}
};
struct FlatOrder {
    int nM, nN, nG, G, c;
    __device__ bool next(int i, pg8::Unit& u) const { const int L = i * G + c; if (L >= nG * nM * nN) return false; u.gz = L / (nM * nN); const int r = L % (nM * nN); u.pm = r % nM; u.pn = r / nM; return true; }
    __device__ __forceinline__ void a_ready(const pg8::Unit&) const {}
    __device__ __forceinline__ void done(const pg8::Unit&) const {}
};
__device__ __forceinline__ float silu_f(float v) { return v * __builtin_amdgcn_rcpf(1.f + __expf(-v)); }
__device__ __forceinline__ float gelu_tanh(float v) { const float u = 0.7978845608028654f * (v + 0.044715f * v * v * v); const float e = __expf(2.f * u); const float th = 1.f - 2.f * __builtin_amdgcn_rcpf(e + 1.f); return 0.5f * v * (1.f + th); }

struct EpiInProj {
    static constexpr bool PERM = true, AFTER_DRAIN = false;
    unsigned char* ws; const float* SS; const float* bfl;
    __device__ __forceinline__ void operator()(const pg8::f32x4 (&acc)[2][2][4][2], const pg8::Unit& u, int wr, int wc, int fr, int fq) const {
        const int pn = u.pn; const int row0 = u.pm * 256 + wr * 64 + fr, cl0 = wc * 32 + 8 * fq;
        float rs[2][4];
#pragma unroll
        for (int ai = 0; ai < 2; ++ai)
#pragma unroll
            for (int m = 0; m < 4; ++m) rs[ai][m] = 1.f;
        if (pn == 14) {
            if (wc == 0 && fq == 0) { float* LOGF = (float*)(ws + WS_LOGF); const f32x4 b0 = *(const f32x4*)bfl, b1 = *(const f32x4*)(bfl + 4);
#pragma unroll
                for (int ai = 0; ai < 2; ++ai)
#pragma unroll
                    for (int m = 0; m < 4; ++m) { const int row = row0 + ai * 128 + m * 16; const float r = rs[ai][m]; const pg8::f32x4 v0 = acc[ai][0][m][0], v1 = acc[ai][0][m][1];
                        float z[8] = {v0[0] * r + b0.x, v0[1] * r + b0.y, v0[2] * r + b0.z, v0[3] * r + b0.w, v1[0] * r + b1.x, v1[1] * r + b1.y, v1[2] * r + b1.z, v1[3] * r + b1.w};
#pragma unroll
                        for (int e = 0; e < 8; ++e) LOGF[(size_t)((row >> 12) * 8 + e) * SEQ + (row & 4095)] = fminf(z[e], 0.f) - log1pf(__expf(-fabsf(z[e]))); } }
            return;
        }
        if (pn < 6) {
            bf16* base = (bf16*)(ws + (pn < 2 ? WS_QO : pn < 4 ? WS_KB : WS_VB)); const float sc = pn < 2 ? 0.125f * LOG2E : 1.f; const int cb = (pn & 1) * 256 + cl0;
#pragma unroll
            for (int ai = 0; ai < 2; ++ai)
#pragma unroll
                for (int m = 0; m < 4; ++m) { bf16* rp = base + (size_t)(row0 + ai * 128 + m * 16) * 512 + cb;
#pragma unroll
                    for (int bj = 0; bj < 2; ++bj) { const float sr = sc * rs[ai][m]; const pg8::f32x4 v0 = acc[ai][bj][m][0] * sr, v1 = acc[ai][bj][m][1] * sr; u32x4 w; w.x = pk2(v0[0], v0[1]); w.y = pk2(v0[2], v0[3]); w.z = pk2(v1[0], v1[1]); w.w = pk2(v1[2], v1[3]); *(u32x4*)(rp + bj * 128) = w; } }
        } else if (pn == 6) {
            bf16* base = (bf16*)(ws + WS_SUA);
#pragma unroll
            for (int ai = 0; ai < 2; ++ai)
#pragma unroll
                for (int m = 0; m < 4; ++m) { const int row = row0 + ai * 128 + m * 16, chunk = row >> 5, t = row & 31;
#pragma unroll
                    for (int bj = 0; bj < 2; ++bj) { const int c = cl0 + bj * 128, g = c >> 4, h0 = c & 15; const pg8::f32x4 v0 = acc[ai][bj][m][0] * rs[ai][m], v1 = acc[ai][bj][m][1] * rs[ai][m]; u32x4 w; w.x = pk2(v0[0], v0[1]); w.y = pk2(v0[2], v0[3]); w.z = pk2(v1[0], v1[1]); w.w = pk2(v1[2], v1[3]);
                        *(u32x4*)(base + ((size_t)(g * 512 + chunk) * KA5 + t * 16 + h0)) = w; } }
        } else if (pn == 7 || pn == 8) {
            const f32x4* rope = (const f32x4*)(ws + WS_ROPE); bf16* base = (bf16*)(ws + (pn == 7 ? WS_RQ : WS_RK)); bf16* RKT = (bf16*)(ws + WS_RKT);
#pragma unroll
            for (int ai = 0; ai < 2; ++ai)
#pragma unroll
                for (int m = 0; m < 4; ++m) { const int row = row0 + ai * 128 + m * 16, b = row >> 12, t = row & 4095;
#pragma unroll
                    for (int bj = 0; bj < 2; ++bj) { const int c = cl0 + bj * 128, hh = c >> 6, pos0 = c & 63; const pg8::f32x4 v0 = acc[ai][bj][m][0] * rs[ai][m], v1 = acc[ai][bj][m][1] * rs[ai][m];
                        const f32x4 r0 = rope[(t * 32 + (pos0 >> 1)) >> 1], r1 = rope[((t * 32 + (pos0 >> 1)) >> 1) + 1];
                        float o[8];
                        o[0] = v0[0] * r0.x - v0[1] * r0.y; o[1] = v0[0] * r0.y + v0[1] * r0.x; o[2] = v0[2] * r0.z - v0[3] * r0.w; o[3] = v0[2] * r0.w + v0[3] * r0.z;
                        o[4] = v1[0] * r1.x - v1[1] * r1.y; o[5] = v1[0] * r1.y + v1[1] * r1.x; o[6] = v1[2] * r1.z - v1[3] * r1.w; o[7] = v1[2] * r1.w + v1[3] * r1.z;
                        u32x4 w; w.x = pk2(o[0], o[1]); w.y = pk2(o[2], o[3]); w.z = pk2(o[4], o[5]); w.w = pk2(o[6], o[7]);
                        *(u32x4*)(base + (size_t)row * 256 + c) = w;
                        if (pn == 8) { const float wk = __builtin_amdgcn_exp2f(lg2_gamma(hh) * (float)(63 - (t & 63))); bf16* tp = RKT + ((size_t)((b * 4 + hh) * 64 + pos0)) * SEQ + t;
#pragma unroll
                            for (int e = 0; e < 8; ++e) tp[(size_t)e * SEQ] = f2bf(o[e] * wk); } } }
        } else if (pn == 9) {
            bf16* RVT = (bf16*)(ws + WS_RVT);
#pragma unroll
            for (int ai = 0; ai < 2; ++ai)
#pragma unroll
                for (int m = 0; m < 4; ++m) { const int row = row0 + ai * 128 + m * 16, b = row >> 12, t = row & 4095;
#pragma unroll
                    for (int bj = 0; bj < 2; ++bj) { const int c = cl0 + bj * 128, hh = c >> 6, d0 = c & 63; const pg8::f32x4 v0 = acc[ai][bj][m][0] * rs[ai][m], v1 = acc[ai][bj][m][1] * rs[ai][m]; bf16* tp = RVT + ((size_t)((b * 4 + hh) * 64 + d0)) * SEQ + t;
#pragma unroll
                        for (int e = 0; e < 4; ++e) { tp[(size_t)e * SEQ] = f2bf(v0[e]); tp[(size_t)(4 + e) * SEQ] = f2bf(v1[e]); } } }
        } else {
            bf16* base = (bf16*)(ws + WS_GATE); const int cb = (pn - 10) * 256 + cl0;
#pragma unroll
            for (int ai = 0; ai < 2; ++ai)
#pragma unroll
                for (int m = 0; m < 4; ++m) { bf16* rp = base + (size_t)(row0 + ai * 128 + m * 16) * 1024 + cb;
#pragma unroll
                    for (int bj = 0; bj < 2; ++bj) { const pg8::f32x4 v0 = acc[ai][bj][m][0] * rs[ai][m], v1 = acc[ai][bj][m][1] * rs[ai][m]; u32x4 w; w.x = pk2(silu_f(v0[0]), silu_f(v0[1])); w.y = pk2(silu_f(v0[2]), silu_f(v0[3])); w.z = pk2(silu_f(v1[0]), silu_f(v1[1])); w.w = pk2(silu_f(v1[2]), silu_f(v1[3])); *(u32x4*)(rp + bj * 128) = w; } }
        }
    }
};
struct EpiS5E {
    static constexpr bool PERM = false, AFTER_DRAIN = false;
    float* E;
    __device__ __forceinline__ void operator()(const pg8::f32x4 (&acc)[2][2][4][2], const pg8::Unit& u, int wr, int wc, int fr, int fq) const {
        const int row0 = u.pm * 256 + wr * 64 + fr, col0 = wc * 32 + 4 * fq;
#pragma unroll
        for (int ai = 0; ai < 2; ++ai)
#pragma unroll
            for (int m = 0; m < 4; ++m) { float* rp = E + ((size_t)u.gz * NCH5 + row0 + ai * 128 + m * 16) * 128 + col0;
#pragma unroll
                for (int n = 0; n < 2; ++n) *(pg8::f32x4*)(rp + n * 16) = acc[ai][0][m][n]; }
    }
};
struct EpiS5Y {
    static constexpr bool PERM = true, AFTER_DRAIN = false;
    const bf16* SUA; bf16* YS5; const float* dvec;
    __device__ __forceinline__ void operator()(const pg8::f32x4 (&acc)[2][2][4][2], const pg8::Unit& u, int wr, int wc, int fr, int fq) const {
        const int row0 = u.pm * 256 + wr * 64 + fr, cl0 = u.pn * 256 + wc * 32 + 8 * fq; const int g = u.gz;
#pragma unroll
        for (int bj = 0; bj < 2; ++bj) { const int c = cl0 + bj * 128, tt = c >> 4, h0 = c & 15; const f32x4 d0 = *(const f32x4*)(dvec + g * 16 + h0), d1 = *(const f32x4*)(dvec + g * 16 + h0 + 4);
#pragma unroll
            for (int ai = 0; ai < 2; ++ai)
#pragma unroll
                for (int m = 0; m < 4; ++m) { const int chunk = row0 + ai * 128 + m * 16; const u32x4 uu = *(const u32x4*)(SUA + ((size_t)(g * 512 + chunk) * KA5 + c)); const pg8::f32x4 v0 = acc[ai][bj][m][0], v1 = acc[ai][bj][m][1];
                    float y[8]; y[0] = v0[0] + d0.x * bflo(uu.x); y[1] = v0[1] + d0.y * bfhi(uu.x); y[2] = v0[2] + d0.z * bflo(uu.y); y[3] = v0[3] + d0.w * bfhi(uu.y);
                    y[4] = v1[0] + d1.x * bflo(uu.z); y[5] = v1[1] + d1.y * bfhi(uu.z); y[6] = v1[2] + d1.z * bflo(uu.w); y[7] = v1[3] + d1.w * bfhi(uu.w);
#pragma unroll
                    for (int e = 0; e < 8; ++e) y[e] = gelu_tanh(y[e]);
                    u32x4 w; w.x = pk2(y[0], y[1]); w.y = pk2(y[2], y[3]); w.z = pk2(y[4], y[5]); w.w = pk2(y[6], y[7]);
                    *(u32x4*)(YS5 + (size_t)(chunk * 32 + tt) * 256 + g * 16 + h0) = w; } }
    }
};
struct EpiGlu {
    static constexpr bool PERM = true, AFTER_DRAIN = false;
    const bf16* YS5; bf16* G; bool dry;
    __device__ __forceinline__ void operator()(const pg8::f32x4 (&acc)[2][2][4][2], const pg8::Unit& u, int wr, int wc, int fr, int fq) const {
        const int row0 = u.pm * 256 + wr * 64 + fr, cl0 = wc * 32 + 8 * fq;
#pragma unroll
        for (int ai = 0; ai < 2; ++ai)
#pragma unroll
            for (int m = 0; m < 4; ++m) { const int row = row0 + ai * 128 + m * 16;
#pragma unroll
                for (int bj = 0; bj < 2; ++bj) { const int c = cl0 + bj * 128; const u32x4 yy = *(const u32x4*)(YS5 + (size_t)row * 256 + c); bf16* gp = G + (size_t)row * 1024 + 512 + c; const u32x4 gg = *(const u32x4*)gp;
                    const pg8::f32x4 v0 = acc[ai][bj][m][0], v1 = acc[ai][bj][m][1]; float s[8];
#pragma unroll
                    for (int e = 0; e < 4; ++e) { s[e] = 1.f / (1.f + __expf(-v0[e])); s[4 + e] = 1.f / (1.f + __expf(-v1[e])); }
                    u32x4 w; w.x = pk2(bflo(yy.x) * s[0] * bflo(gg.x), bfhi(yy.x) * s[1] * bfhi(gg.x)); w.y = pk2(bflo(yy.y) * s[2] * bflo(gg.y), bfhi(yy.y) * s[3] * bfhi(gg.y));
                    w.z = pk2(bflo(yy.z) * s[4] * bflo(gg.z), bfhi(yy.z) * s[5] * bfhi(gg.z)); w.w = pk2(bflo(yy.w) * s[6] * bflo(gg.w), bfhi(yy.w) * s[7] * bfhi(gg.w));
                    if (!dry) *(u32x4*)gp = w; } }
    }
};
struct EpiOut {
    static constexpr bool PERM = false, AFTER_DRAIN = false;
    const float* base; float* out; float* SSn; bf16* XN; const float* gnext; bool dry;
    __device__ __forceinline__ void operator()(const pg8::f32x4 (&acc)[2][2][4][2], const pg8::Unit& u, int wr, int wc, int fr, int fq) const {
        const int row0 = u.pm * 256 + wr * 64 + fr, col0 = u.pn * 256 + wc * 32 + 4 * fq;
        f32x4 gq[2][2];
#pragma unroll
        for (int bj = 0; bj < 2; ++bj)
#pragma unroll
            for (int n = 0; n < 2; ++n) gq[bj][n] = gnext ? *(const f32x4*)(gnext + col0 + bj * 128 + n * 16) : (f32x4){0.f, 0.f, 0.f, 0.f};
#pragma unroll
        for (int ai = 0; ai < 2; ++ai)
#pragma unroll
            for (int m = 0; m < 4; ++m) { const int row = row0 + ai * 128 + m * 16; const size_t off = (size_t)row * DM + col0; float sq = 0.f;
#pragma unroll
                for (int bj = 0; bj < 2; ++bj)
#pragma unroll
                    for (int n = 0; n < 2; ++n) { const f32x4 bs = *(const f32x4*)(base + off + bj * 128 + n * 16); const pg8::f32x4 v = acc[ai][bj][m][n]; const f32x4 x = (f32x4){bs.x + v[0], bs.y + v[1], bs.z + v[2], bs.w + v[3]};
                        sq += (x.x * x.x + x.y * x.y) + (x.z * x.z + x.w * x.w);
                        if (!dry) { *(f32x4*)(out + off + bj * 128 + n * 16) = x;
                            if (gnext) { const f32x4 g = gq[bj][n]; u32x2 w; w.x = pk2(x.x * g.x, x.y * g.y); w.y = pk2(x.z * g.z, x.w * g.w); *(u32x2*)(XN + off + bj * 128 + n * 16) = w; } } }
                sq += __shfl_xor(sq, 16); sq += __shfl_xor(sq, 32);
                if (fq == 0 && !dry) __hip_atomic_fetch_add(SSn + row, sq, __ATOMIC_RELAXED, __HIP_MEMORY_SCOPE_AGENT); }
    }
};

template <bool FINAL> struct EpiOutX {
    static constexpr bool PERM = false, AFTER_DRAIN = true;
    const float* base; float* out; const float* wfin; float* xbuf; unsigned* cnt; bf16* XN; unsigned target;
    __device__ __forceinline__ void fused(pg8::f32x4 (&acc)[2][2][4][2], const pg8::Unit& u, int wr, int wc, int fr, int fq, PG8_LAS unsigned char* lds, int wid, int lane) const {
        PG8_LAS float* P = (PG8_LAS float*)lds;
        PG8_LAS float* S = (PG8_LAS float*)(lds + 4096);
        const int col0 = u.pn * 256 + wc * 32 + 4 * fq;
#pragma unroll
        for (int ai = 0; ai < 2; ++ai)
#pragma unroll
            for (int m = 0; m < 4; ++m) { const int r = ai * 128 + wr * 64 + m * 16 + fr; const size_t off = (size_t)(u.pm * 256 + r) * DM + col0; float sq = 0.f;
#pragma unroll
                for (int bj = 0; bj < 2; ++bj)
#pragma unroll
                    for (int n = 0; n < 2; ++n) { const f32x4 bs = *(const f32x4*)(base + off + bj * 128 + n * 16); pg8::f32x4 x = acc[ai][bj][m][n]; x[0] += bs.x; x[1] += bs.y; x[2] += bs.z; x[3] += bs.w; acc[ai][bj][m][n] = x;
                        sq += (x[0] * x[0] + x[1] * x[1]) + (x[2] * x[2] + x[3] * x[3]); }
                sq += __shfl_xor(sq, 16); sq += __shfl_xor(sq, 32);
                if (fq == 0) P[r * 4 + wc] = sq;
                asm volatile("" : "+v"(acc[ai][0][m][0]), "+v"(acc[ai][0][m][1]), "+v"(acc[ai][1][m][0]), "+v"(acc[ai][1][m][1]));
                if (m & 1) asm volatile("" ::: "memory"); }
        asm volatile("s_waitcnt lgkmcnt(0)" ::: "memory"); __builtin_amdgcn_s_barrier(); asm volatile("" ::: "memory");
        const int row = wid * 32 + (lane & 31);
        if (lane < 32) { const float tot = (P[row * 4 + 0] + P[row * 4 + 1]) + (P[row * 4 + 2] + P[row * 4 + 3]);
            __hip_atomic_store(xbuf + (size_t)(u.pm * 256 + row) * 4 + u.pn, tot, __ATOMIC_RELAXED, __HIP_MEMORY_SCOPE_AGENT); }
        asm volatile("s_waitcnt vmcnt(0)" ::: "memory");
        if (lane == 0) __hip_atomic_fetch_add(cnt + 64 * u.pm, 1u, __ATOMIC_RELAXED, __HIP_MEMORY_SCOPE_AGENT);
        if (wid == 0) {
            unsigned sp = 0u;
            while ((unsigned)__builtin_amdgcn_readfirstlane(__hip_atomic_load(cnt + 64 * u.pm, __ATOMIC_RELAXED, __HIP_MEMORY_SCOPE_AGENT)) < target) { __builtin_amdgcn_s_sleep(2); if (++sp > (1u << 20)) break; }
            __builtin_amdgcn_fence(__ATOMIC_ACQUIRE, "agent");
        }
        asm volatile("s_waitcnt vmcnt(0) lgkmcnt(0)" ::: "memory"); __builtin_amdgcn_s_barrier(); asm volatile("" ::: "memory");
        if (lane < 32) { const float* sl = xbuf + (size_t)(u.pm * 256 + row) * 4; float t = 0.f;
#pragma unroll
            for (int k = 0; k < 4; ++k) t += __hip_atomic_load(sl + k, __ATOMIC_RELAXED, __HIP_MEMORY_SCOPE_AGENT);
            S[row] = rsqrtf(t * (1.f / DM) + EPS); }
        asm volatile("s_waitcnt lgkmcnt(0)" ::: "memory"); __builtin_amdgcn_s_barrier(); asm volatile("" ::: "memory");
        f32x4 wq[2][2];
#pragma unroll
        for (int bj = 0; bj < 2; ++bj)
#pragma unroll
            for (int n = 0; n < 2; ++n) wq[bj][n] = *(const f32x4*)(wfin + col0 + bj * 128 + n * 16);
#pragma unroll
        for (int ai = 0; ai < 2; ++ai)
#pragma unroll
            for (int m = 0; m < 4; ++m) { const int r = ai * 128 + wr * 64 + m * 16 + fr; const float sr = S[r]; const size_t off = (size_t)(u.pm * 256 + r) * DM + col0;
#pragma unroll
                for (int bj = 0; bj < 2; ++bj)
#pragma unroll
                    for (int n = 0; n < 2; ++n) { const pg8::f32x4 x = acc[ai][bj][m][n]; const f32x4 g = wq[bj][n]; const f32x4 y = (f32x4){x[0] * sr * g.x, x[1] * sr * g.y, x[2] * sr * g.z, x[3] * sr * g.w};
                        if (FINAL) *(f32x4*)(out + off + bj * 128 + n * 16) = y;
                        else { *(f32x4*)(out + off + bj * 128 + n * 16) = (f32x4){x[0], x[1], x[2], x[3]}; u32x2 w; w.x = pk2(y.x, y.y); w.y = pk2(y.z, y.w); *(u32x2*)(XN + off + bj * 128 + n * 16) = w; } } }
    }
};

template <int KS, int UNR, class Epi> __device__ __forceinline__ void wave_gemm64(const bf16* A, int lda, const bf16* B, int ldb, int lane, const Epi& epi) {
    const int fr = lane & 15, fq = lane >> 4;
    pg8::f32x4 acc[4][4];
#pragma unroll
    for (int jb = 0; jb < 4; ++jb)
#pragma unroll
        for (int ib = 0; ib < 4; ++ib) acc[jb][ib] = (pg8::f32x4){0.f, 0.f, 0.f, 0.f};
    const bf16* ap = A + (size_t)fr * lda + 8 * fq; const bf16* bp = B + (size_t)fr * ldb + 8 * fq;
#pragma unroll UNR
    for (int ks = 0; ks < KS; ++ks) {
        bf16x8 af[4], bv[4];
#pragma unroll
        for (int ib = 0; ib < 4; ++ib) { af[ib] = *(const bf16x8*)(ap + (size_t)(16 * ib) * lda + 32 * ks); bv[ib] = *(const bf16x8*)(bp + (size_t)(16 * ib) * ldb + 32 * ks); }
#pragma unroll
        for (int jb = 0; jb < 4; ++jb)
#pragma unroll
            for (int ib = 0; ib < 4; ++ib) acc[jb][ib] = __builtin_amdgcn_mfma_f32_16x16x32_bf16(bv[jb], af[ib], acc[jb][ib], 0, 0, 0);
    }
    epi(acc, fr, fq);
}
struct WEpiE {
    float* E;
    __device__ __forceinline__ void operator()(const pg8::f32x4 (&acc)[4][4], int fr, int fq) const {
#pragma unroll
        for (int jb = 0; jb < 4; ++jb)
#pragma unroll
            for (int ib = 0; ib < 4; ++ib) *(pg8::f32x4*)(E + (size_t)(16 * ib + fr) * 128 + 16 * jb + 4 * fq) = acc[jb][ib];
    }
};
struct WEpiS5Y {
    const bf16* SUAg; bf16* YS5; const float* dg; int chunk0, col0, g;
    __device__ __forceinline__ void operator()(const pg8::f32x4 (&acc)[4][4], int fr, int fq) const {
#pragma unroll
        for (int jb = 0; jb < 4; ++jb) { const int col = col0 + 16 * jb + 4 * fq, tt = col >> 4, h0 = col & 15; const f32x4 d4 = *(const f32x4*)(dg + h0);
#pragma unroll
            for (int ib = 0; ib < 4; ++ib) { const int chunk = chunk0 + 16 * ib + fr; const u32x2 uu = *(const u32x2*)(SUAg + (size_t)chunk * KA5 + col); const pg8::f32x4 v = acc[jb][ib];
                const float y0 = gelu_tanh(v[0] + d4.x * bflo(uu.x)), y1 = gelu_tanh(v[1] + d4.y * bfhi(uu.x)), y2 = gelu_tanh(v[2] + d4.z * bflo(uu.y)), y3 = gelu_tanh(v[3] + d4.w * bfhi(uu.y));
                u32x2 w; w.x = pk2(y0, y1); w.y = pk2(y2, y3); *(u32x2*)(YS5 + (size_t)(chunk * 32 + tt) * 256 + g * 16 + h0) = w; } }
    }
};
struct WEpiGlu {
    const bf16* YS5; bf16* G; int row0, col0;
    __device__ __forceinline__ void operator()(const pg8::f32x4 (&acc)[4][4], int fr, int fq) const {
#pragma unroll
        for (int jb = 0; jb < 4; ++jb)
#pragma unroll
            for (int ib = 0; ib < 4; ++ib) { const int row = row0 + 16 * ib + fr, col = col0 + 16 * jb + 4 * fq; const u32x2 yy = *(const u32x2*)(YS5 + (size_t)row * 256 + col); bf16* gp = G + (size_t)row * 1024 + 512 + col; const u32x2 gg = *(const u32x2*)gp; const pg8::f32x4 v = acc[jb][ib];
                const float s0 = __builtin_amdgcn_rcpf(1.f + __expf(-v[0])), s1 = __builtin_amdgcn_rcpf(1.f + __expf(-v[1])), s2 = __builtin_amdgcn_rcpf(1.f + __expf(-v[2])), s3 = __builtin_amdgcn_rcpf(1.f + __expf(-v[3]));
                u32x2 w; w.x = pk2(bflo(yy.x) * s0 * bflo(gg.x), bfhi(yy.x) * s1 * bfhi(gg.x)); w.y = pk2(bflo(yy.y) * s2 * bflo(gg.y), bfhi(yy.y) * s3 * bfhi(gg.y)); *(u32x2*)gp = w; }
    }
};

__device__ __forceinline__ void ret_upd_unit(unsigned char* ws, int unit, int lane) {
    const int c = unit & 63, bh = unit >> 6; const int i16 = lane & 15, kq = lane >> 4;
    const bf16* KT = (const bf16*)(ws + WS_RKT) + (size_t)bh * 64 * SEQ + c * 64; const bf16* VT = (const bf16*)(ws + WS_RVT) + (size_t)bh * 64 * SEQ + c * 64;
    float* UPD = (float*)(ws + WS_UPD) + (size_t)unit * 4096;
    bf16x8 af[4][2], bfv[4][2];
#pragma unroll
    for (int ib = 0; ib < 4; ++ib)
#pragma unroll
        for (int ks = 0; ks < 2; ++ks) { af[ib][ks] = *(const bf16x8*)(KT + (size_t)(16 * ib + i16) * SEQ + 32 * ks + 8 * kq); bfv[ib][ks] = *(const bf16x8*)(VT + (size_t)(16 * ib + i16) * SEQ + 32 * ks + 8 * kq); }
#pragma unroll
    for (int ib = 0; ib < 4; ++ib)
#pragma unroll
        for (int jb = 0; jb < 4; ++jb) { pg8::f32x4 d = (pg8::f32x4){0.f, 0.f, 0.f, 0.f};
            d = __builtin_amdgcn_mfma_f32_16x16x32_bf16(af[ib][0], bfv[jb][0], d, 0, 0, 0); d = __builtin_amdgcn_mfma_f32_16x16x32_bf16(af[ib][1], bfv[jb][1], d, 0, 0, 0);
            *(pg8::f32x4*)(UPD + (size_t)(16 * jb + i16) * 64 + 16 * ib + 4 * kq) = d; }
}
__device__ __forceinline__ void ret_out_unit(const Args& a, int l, int unit, int lane, bool dry = false) {
    unsigned char* ws = a.ws;
    const int c = unit & 63, bh = unit >> 6, hh = bh & 3, b = bh >> 2; const int fr = lane & 15, fq = lane >> 4;
    const size_t t0 = (size_t)b * SEQ + c * 64;
    const bf16* RQ = (const bf16*)(ws + WS_RQ) + t0 * 256 + hh * 64; const bf16* RK = (const bf16*)(ws + WS_RK) + t0 * 256 + hh * 64;
    const bf16* VT = (const bf16*)(ws + WS_RVT) + (size_t)bh * 64 * SEQ + c * 64; const bf16* ST = (const bf16*)(ws + WS_STATE) + (size_t)unit * 4096;
    const float lg = lg2_gamma(hh);
    bf16x8 qf[4][2]; pg8::f32x4 st[4][4];
#pragma unroll
    for (int nb = 0; nb < 4; ++nb)
#pragma unroll
        for (int ks = 0; ks < 2; ++ks) qf[nb][ks] = *(const bf16x8*)(RQ + (size_t)(16 * nb + fr) * 256 + 32 * ks + 8 * fq);
#pragma unroll
    for (int mb = 0; mb < 4; ++mb) { bf16x8 k0 = *(const bf16x8*)(RK + (size_t)(16 * mb + fr) * 256 + 8 * fq), k1 = *(const bf16x8*)(RK + (size_t)(16 * mb + fr) * 256 + 32 + 8 * fq);
#pragma unroll
        for (int nb = 0; nb < 4; ++nb) { pg8::f32x4 d = (pg8::f32x4){0.f, 0.f, 0.f, 0.f};
            d = __builtin_amdgcn_mfma_f32_16x16x32_bf16(k0, qf[nb][0], d, 0, 0, 0); d = __builtin_amdgcn_mfma_f32_16x16x32_bf16(k1, qf[nb][1], d, 0, 0, 0);
#pragma unroll
            for (int r = 0; r < 4; ++r) { const int mm = 16 * mb + 4 * fq + r, nn = 16 * nb + fr; const int df = mm > nn ? mm - nn : nn - mm; d[r] *= 0.125f * __builtin_amdgcn_exp2f(lg * (float)df); }
            st[mb][nb] = d; } }
    pg8::f32x4 o[4][4];
#pragma unroll
    for (int nb = 0; nb < 4; ++nb)
#pragma unroll
        for (int dvb = 0; dvb < 4; ++dvb) o[nb][dvb] = (pg8::f32x4){0.f, 0.f, 0.f, 0.f};
#pragma unroll
    for (int dvb = 0; dvb < 4; ++dvb) { const bf16x8 s0 = *(const bf16x8*)(ST + (size_t)(16 * dvb + fr) * 64 + 8 * fq), s1 = *(const bf16x8*)(ST + (size_t)(16 * dvb + fr) * 64 + 32 + 8 * fq);
#pragma unroll
        for (int nb = 0; nb < 4; ++nb) { o[nb][dvb] = __builtin_amdgcn_mfma_f32_16x16x32_bf16(qf[nb][0], s0, o[nb][dvb], 0, 0, 0); o[nb][dvb] = __builtin_amdgcn_mfma_f32_16x16x32_bf16(qf[nb][1], s1, o[nb][dvb], 0, 0, 0); } }
#pragma unroll
    for (int nb = 0; nb < 4; ++nb)
#pragma unroll
        for (int r = 0; r < 4; ++r) { const float wq = 0.125f * __builtin_amdgcn_exp2f(lg * (float)(16 * nb + 4 * fq + r + 1));
#pragma unroll
            for (int dvb = 0; dvb < 4; ++dvb) o[nb][dvb][r] *= wq; }
#pragma unroll
    for (int s = 0; s < 2; ++s) {
        bf16x8 pa[4];
#pragma unroll
        for (int nb = 0; nb < 4; ++nb) { u32x4 w; w.x = pk2(st[2 * s][nb][0], st[2 * s][nb][1]); w.y = pk2(st[2 * s][nb][2], st[2 * s][nb][3]); w.z = pk2(st[2 * s + 1][nb][0], st[2 * s + 1][nb][1]); w.w = pk2(st[2 * s + 1][nb][2], st[2 * s + 1][nb][3]); pa[nb] = __builtin_bit_cast(bf16x8, w); }
#pragma unroll
        for (int dvb = 0; dvb < 4; ++dvb) { const u32x2 v0 = *(const u32x2*)(VT + (size_t)(16 * dvb + fr) * SEQ + 32 * s + 4 * fq), v1 = *(const u32x2*)(VT + (size_t)(16 * dvb + fr) * SEQ + 32 * s + 16 + 4 * fq);
            const bf16x8 vf = __builtin_bit_cast(bf16x8, (u32x4){v0.x, v0.y, v1.x, v1.y});
#pragma unroll
            for (int nb = 0; nb < 4; ++nb) o[nb][dvb] = __builtin_amdgcn_mfma_f32_16x16x32_bf16(pa[nb], vf, o[nb][dvb], 0, 0, 0); }
    }
    const float* gn = a.in[13] + (size_t)l * 256 + hh * 64; float gnw[4];
#pragma unroll
    for (int dvb = 0; dvb < 4; ++dvb) gnw[dvb] = gn[16 * dvb + fr];
    bf16* Y = (bf16*)(ws + WS_GATE) + t0 * 1024 + 768 + hh * 64;
#pragma unroll
    for (int nb = 0; nb < 4; ++nb)
#pragma unroll
        for (int r = 0; r < 4; ++r) { float s = (o[nb][0][r] + o[nb][1][r]) + (o[nb][2][r] + o[nb][3][r]);
            s += __shfl_xor(s, 1); s += __shfl_xor(s, 2); s += __shfl_xor(s, 4); s += __shfl_xor(s, 8);
            const float mu = s * (1.f / 64.f); float q = 0.f;
#pragma unroll
            for (int dvb = 0; dvb < 4; ++dvb) { const float d = o[nb][dvb][r] - mu; q += d * d; }
            q += __shfl_xor(q, 1); q += __shfl_xor(q, 2); q += __shfl_xor(q, 4); q += __shfl_xor(q, 8);
            const float rstd = rsqrtf(q * (1.f / 64.f) + EPS); bf16* yp = Y + (size_t)(16 * nb + 4 * fq + r) * 1024 + fr;
#pragma unroll
            for (int dvb = 0; dvb < 4; ++dvb) { const float gt = bf2f(yp[16 * dvb]); if (!dry) yp[16 * dvb] = f2bf((o[nb][dvb][r] - mu) * rstd * gnw[dvb] * gt); } }
}

#define XB_TMO      128
#define XB_XCNT(j)  (256  + 64 * (j))
#define XB_XSUB(j)  (1280 + 64 * (j))
#define XB_XGEN(j)  (2304 + 64 * (j))
#define XB_TOP      3328
#define XB_TOPGEN   3392
#define XCD_BAR_WORDS 3456
#define XB_SPIN_CAP (1u << 18)

__device__ __forceinline__ unsigned xb_ld(unsigned* p)              { return __hip_atomic_load(p, __ATOMIC_RELAXED, __HIP_MEMORY_SCOPE_AGENT); }
__device__ __forceinline__ unsigned xb_add(unsigned* p, unsigned v) { return __hip_atomic_fetch_add(p, v, __ATOMIC_RELAXED, __HIP_MEMORY_SCOPE_AGENT); }
__device__ __forceinline__ unsigned xb_xcc_id() { return (unsigned)__builtin_amdgcn_s_getreg((3 << 11) | 20) & 0xFu; }
#define XB_SPIN(cond, bar) do { unsigned _sp = 0; while (cond) { __builtin_amdgcn_s_sleep(1); \
    if ((++_sp & 255u) == 0u) { if (xb_ld(&(bar)[XB_TMO])) break; if (_sp > XB_SPIN_CAP) { atomicAdd(&(bar)[XB_TMO], 1u); break; } } } } while (0)

struct XcdBarrier {
    unsigned* bar; unsigned x;
    volatile LAS unsigned* st;
};

__device__ __forceinline__ XcdBarrier xcd_barrier_post(unsigned* bar, volatile LAS unsigned* st) {
    XcdBarrier b; b.bar = bar; b.x = xb_xcc_id(); b.st = st;
    if (threadIdx.x == 0) (void)xb_add(&bar[XB_XCNT(b.x)], 1u);
    return b;
}
__device__ __forceinline__ void xcd_barrier_complete(unsigned* bar, unsigned x, unsigned& nloc, unsigned& nx) {
    const unsigned G = gridDim.x * gridDim.y * gridDim.z;
    unsigned sum, cnt, mine, sp = 0u;
    for (;;) {
        sum = 0u; cnt = 0u; mine = 0u;
#pragma unroll
        for (unsigned j = 0; j < 16; ++j) { const unsigned c = xb_ld(&bar[XB_XCNT(j)]); sum += c; cnt += (c > 0u) ? 1u : 0u; mine = (j == x) ? c : mine; }
        if (sum == G) break;
        __builtin_amdgcn_s_sleep(1);
        if ((++sp & 255u) == 0u) { if (xb_ld(&bar[XB_TMO])) break; if (sp > XB_SPIN_CAP) { atomicAdd(&bar[XB_TMO], 1u); break; } }
    }
    nloc = mine > 0u ? mine : 1u; nx = cnt > 0u ? cnt : 1u;
}

__device__ __forceinline__ void xcd_barrier(const XcdBarrier& b) {
    asm volatile("s_waitcnt vmcnt(0)" ::: "memory");
    __syncthreads();
    if (threadIdx.x == 0) {
        unsigned* bar = b.bar;
        __builtin_amdgcn_s_waitcnt(0);
        unsigned nloc = b.st[0], nx = b.st[1];
        if (nloc == 0u) { xcd_barrier_complete(bar, b.x, nloc, nx); b.st[0] = nloc; b.st[1] = nx; }
        const unsigned old = xb_add(&bar[XB_XSUB(b.x)], 1u);
        const unsigned gen = old / nloc;
        if (old + 1u == (gen + 1u) * nloc) {
            __builtin_amdgcn_fence(__ATOMIC_RELEASE, "agent");
            asm volatile("s_waitcnt vmcnt(0)" ::: "memory");
            const unsigned og = xb_add(&bar[XB_TOP], 1u);
            const unsigned tg = og / nx;
            if (og + 1u == (tg + 1u) * nx) xb_add(&bar[XB_TOPGEN], 1u);
            else XB_SPIN(xb_ld(&bar[XB_TOPGEN]) == tg, bar);
            __builtin_amdgcn_fence(__ATOMIC_ACQUIRE, "agent");
            xb_add(&bar[XB_XGEN(b.x)], 1u);
            asm volatile("s_waitcnt vmcnt(0)" ::: "memory");
        } else {
            XB_SPIN(xb_ld(&bar[XB_XGEN(b.x)]) == gen, bar);
            __builtin_amdgcn_fence(__ATOMIC_ACQUIRE, "agent");
            asm volatile("s_waitcnt vmcnt(0)" ::: "memory");
        }
    }
    __syncthreads();
}

#define XBAR_MAKE XcdBarrier xb_; xb_.bar = (unsigned*)args.ws; xb_.st = (volatile LAS unsigned*)((LAS unsigned char*)lds + RING_BYTES + 352); xb_.x = xb_.st[2]
#ifdef REP_SYNC
#define GSYNC() do { XBAR_MAKE; xcd_barrier(xb_); xcd_barrier(xb_); } while (0)
#else
#define GSYNC() do { XBAR_MAKE; xcd_barrier(xb_); } while (0)
#endif
#ifndef REP_P0
#define REP_P0 1
#endif
#ifndef REP_P1
#define REP_P1 1
#endif
#ifndef REP_P23
#define REP_P23 1
#endif
#ifndef REP_NORM
#define REP_NORM 1
#endif
__global__ void __launch_bounds__(NTHR, 2) mega_fwd(Args args) {
    extern __shared__ __attribute__((aligned(16))) unsigned char lds[];
    cg::grid_group grid = cg::this_grid();
    const int tid = threadIdx.x, lane = tid & 63, wave = __builtin_amdgcn_readfirstlane(tid >> 6);
    const int G = gridDim.x, bx = blockIdx.x; const int vcu = (G % 8 == 0) ? (bx % 8) * (G / 8) + bx / 8 : bx;
    const int gw = bx * NWAVES + wave, NGW = G * NWAVES;
    unsigned char* ws = args.ws;
    LAS unsigned char* ldsl = (LAS unsigned char*)lds;
    LAS float* ldsf = (LAS float*)lds;
    float* X = args.out;
    if (ws == nullptr) grid.sync();
    if (tid < 2) ((volatile LAS unsigned*)(ldsl + RING_BYTES + 352))[tid] = 0u;
    __syncthreads();
    { const XcdBarrier xb0 = xcd_barrier_post((unsigned*)ws, (volatile LAS unsigned*)(ldsl + RING_BYTES + 352)); if (tid == 0) ((volatile LAS unsigned*)(ldsl + RING_BYTES + 352))[2] = xb0.x; }
    __syncthreads();

#ifdef PROBE_T
    unsigned long long tacc_ = 0ull, tprev_ = __builtin_amdgcn_s_memrealtime();
#define TSTAMP(id) do { const unsigned long long tn_ = __builtin_amdgcn_s_memrealtime(); if ((id) == PROBE_T || ((PROBE_T) == 23 && ((id) == 2 || (id) == 3 || (id) == 5))) tacc_ += tn_ - tprev_; tprev_ = tn_; } while (0)
#else
#define TSTAMP(id) do {} while (0)
#endif
    for (int rep_ = 0; rep_ < REP_P0; ++rep_) {
        if (rep_) { __syncthreads(); }
#ifdef REP_S5P
        if (bx < 64) { s5_prep(args, bx >> 4, bx & 15, ldsf, tid); }
#endif
        if (bx < 64) { s5_prep(args, bx >> 4, bx & 15, ldsf, tid); }
        LAS float* scr = ldsf + wave * 4096;
        constexpr int I_IN = (DM / 64) * (NF / 32), I_O = (DM / 64) * (DM / 32), I_G = (256 / 64) * (256 / 32), I_L = I_IN + I_O + I_G;
#ifndef REP_TR
#define REP_TR 1
#endif
        for (int rt_ = 0; rt_ < REP_TR; ++rt_)
        for (int it = (bx < 64 ? DEPTH * I_L : (bx - 64) * NWAVES + wave); it < DEPTH * I_L; it += (G - 64) * NWAVES) {
            const int l = it / I_L; int r = it % I_L;
            if (r < I_IN) { p0_transpose_item<true>(args.in[2] + (size_t)l * DM * NIN, DM, NIN, NF, (bf16*)(ws + WS_WIN) + (size_t)l * NF * DM, scr, r, lane); continue; } r -= I_IN;
            if (r < I_O) { p0_transpose_item<false>(args.in[14] + (size_t)l * DM * DM, DM, DM, DM, (bf16*)(ws + WS_WO) + (size_t)l * DM * DM, scr, r, lane); continue; } r -= I_O;
            p0_transpose_item<false>(args.in[12] + (size_t)l * 65536, 256, 256, 256, (bf16*)(ws + WS_WGLU) + (size_t)l * 65536, scr, r, lane);
        }
        f32x2* rope = (f32x2*)(ws + WS_ROPE);
        for (int i = bx * NTHR + tid; i < SEQ * 32; i += G * NTHR) { const int pos = i >> 5, fi = i & 31; const float freq = powf(10000.f, -(float)fi / 32.f); const float ang = (float)pos * freq; float sn, cs; sincosf(ang, &sn, &cs); rope[i] = (f32x2){cs, sn}; }
        __syncthreads();
        { const int NW = (64 + 2 * (G - 64)) * NWAVES;
          if (bx < 64) norm0_phase(args, lane, bx * NWAVES + wave, NW);
          else { const int sl = 64 * NWAVES + ((bx - 64) * NWAVES + wave) * 2; norm0_phase(args, lane, sl, NW); norm0_phase(args, lane, sl + 1, NW); } }
    }
    GSYNC();
    TSTAMP(0);

#define PHASE_VARS int tid = threadIdx.x; asm volatile("" : "+v"(tid)); int bxl_ = blockIdx.x; asm volatile("" : "+s"(bxl_)); const int bx = bxl_; const int lane = tid & 63, wave = __builtin_amdgcn_readfirstlane(tid >> 6), gw = bx * NWAVES + wave; __attribute__((address_space(1))) unsigned char* wsg_ = (__attribute__((address_space(1))) unsigned char*)args.ws; asm volatile("" : "+s"(wsg_)); unsigned char* ws = (unsigned char*)wsg_; LAS unsigned char* ldsl = (LAS unsigned char*)lds; LAS float* ldsf = (LAS float*)lds; (void)lane; (void)wave; (void)gw; (void)ldsl; (void)ldsf
    for (int l = 0; l < DEPTH; ++l) {
        for (int rep_ = 0; rep_ < REP_P1; ++rep_) {
            PHASE_VARS;
            pg8::Gemm g{(const bf16*)(ws + WS_XN), (const bf16*)(ws + WS_WIN) + (size_t)l * NF * DM, M, NF, DM, DM, DM, 0, 0};
            pg8::StaticOrder S; S.init(M, NF, G, bx);
            EpiInProj E{ws, (const float*)(ws + WS_SS) + (size_t)(l & 1) * M, args.in[3] + (size_t)l * 8};
#ifdef PROBE_SPLIT
            { RangeOrder R0{S, 0, 2}, R1{S, 2, 4}; pg8::gemm_phase<EpiInProj, RangeOrder, true, true>(ldsl, g, R0, E); GSYNC(); pg8::gemm_phase<EpiInProj, RangeOrder, true, true>(ldsl, g, R1, E); }
#else
            pg8::gemm_phase<EpiInProj, pg8::StaticOrder, true, true>(ldsl, g, S, E);
#endif
            if (bx >= G / 2) flog_phase(args, l, (const float*)(ws + WS_SS) + (size_t)(l & 1) * M, ldsf, tid, lane, wave, bx - G / 2, G / 2);
        }
        GSYNC();
        TSTAMP(1);
        for (int rep_ = 0; rep_ < REP_P23; ++rep_) {
            if (rep_) __syncthreads();
            PHASE_VARS;
            if (bx < 64) {
                const int b = bx >> 4, g = bx & 15, tmL = wave & 1, tn = (wave >> 1) & 1, kh = wave >> 2;
                { const int fr = lane & 15, fq = lane >> 4;
                  const bf16* Ap = (const bf16*)(ws + WS_SUA) + ((size_t)g * NCH5 + b * 128 + tmL * 64) * KA5 + 256 * kh; const bf16* Bp = (const bf16*)(ws + WS_WB) + ((size_t)(l * 16 + g) * 128 + tn * 64) * 512 + 256 * kh;
                  struct WEpiLds { LAS float* EL; __device__ __forceinline__ void operator()(const pg8::f32x4 (&acc)[4][4], int fr_, int fq_) const {
#pragma unroll
                      for (int jb = 0; jb < 4; ++jb)
#pragma unroll
                          for (int ib = 0; ib < 4; ++ib) *(LAS pg8::f32x4*)(EL + (16 * ib + fr_) * 128 + 16 * jb + 4 * fq_) = acc[jb][ib]; } };
                  WEpiLds E{ldsf + (size_t)(kh * 128 + tmL * 64) * 128 + tn * 64}; (void)fr; (void)fq;
                  wave_gemm64<8, 4, WEpiLds>(Ap, KA5, Bp, 512, lane, E); }
                __syncthreads();
                const int p = tid & 63, seg = tid >> 6;
                const float* LAM = (const float*)(ws + WS_LAM) + (size_t)(l * 16 + g) * 128; const float lr = LAM[p], li = LAM[64 + p];
                bf16* SA = (bf16*)(ws + WS_SUA) + ((size_t)g * NCH5 + b * 128 + seg * 16) * KA5 + 512 + p;
                float er[16], ei[16];
#pragma unroll
                for (int i = 0; i < 16; ++i) { const int r = (seg * 16 + i) * 128; er[i] = ldsf[r + p] + ldsf[16384 + r + p]; ei[i] = ldsf[r + 64 + p] + ldsf[16384 + r + 64 + p]; }
                float sr = 0.f, si = 0.f;
#pragma unroll
                for (int i = 0; i < 16; ++i) { const float nr = lr * sr - li * si + er[i], ni = lr * si + li * sr + ei[i]; sr = nr; si = ni; }
                LAS float* ends = ldsf + (RING_BYTES + 1024) / 4;
                ends[(seg * 64 + p) * 2] = sr; ends[(seg * 64 + p) * 2 + 1] = si;
                float pr = lr, pi = li;
#pragma unroll
                for (int i = 0; i < 4; ++i) { const float nr = pr * pr - pi * pi, ni = 2.f * pr * pi; pr = nr; pi = ni; }
                __syncthreads();
                float cr = 0.f, ci = 0.f;
                for (int s2 = 0; s2 < seg; ++s2) { const float xr = ends[(s2 * 64 + p) * 2], xi = ends[(s2 * 64 + p) * 2 + 1]; const float nr = pr * cr - pi * ci + xr, ni = pr * ci + pi * cr + xi; cr = nr; ci = ni; }
#pragma unroll
                for (int i = 0; i < 16; ++i) { SA[(size_t)i * KA5] = f2bf(cr); SA[(size_t)i * KA5 + 64] = f2bf(ci); const float nr = lr * cr - li * ci + er[i], ni = lr * ci + li * cr + ei[i]; cr = nr; ci = ni; }
            } else if (bx < 192) {
                const int idx = bx - 64, bh = idx >> 3, dvs = (idx >> 1) & 3, dkh = idx & 1, fr = lane & 15, fq = lane >> 4; const float g64 = exp2f(lg2_gamma(bh & 3) * 64.f);
                const bf16* KT = (const bf16*)(ws + WS_RKT) + ((size_t)bh * 64 + 32 * dkh + fr) * SEQ + 8 * fq; const bf16* VT = (const bf16*)(ws + WS_RVT) + ((size_t)bh * 64 + 16 * dvs + fr) * SEQ + 8 * fq;
                pg8::f32x4 u[8][2];
#pragma unroll
                for (int i2 = 0; i2 < 2; ++i2) {
                    bf16x8 vf[4][2], kf[4][2][2];
#pragma unroll
                    for (int i1 = 0; i1 < 4; ++i1) { const int c = 8 * wave + 4 * i2 + i1; vf[i1][0] = *(const bf16x8*)(VT + c * 64); vf[i1][1] = *(const bf16x8*)(VT + c * 64 + 32);
#pragma unroll
                        for (int ib = 0; ib < 2; ++ib) { kf[i1][ib][0] = *(const bf16x8*)(KT + (size_t)(16 * ib) * SEQ + c * 64); kf[i1][ib][1] = *(const bf16x8*)(KT + (size_t)(16 * ib) * SEQ + c * 64 + 32); } }
#pragma unroll
                    for (int i1 = 0; i1 < 4; ++i1)
#pragma unroll
                        for (int ib = 0; ib < 2; ++ib) { pg8::f32x4 d = (pg8::f32x4){0.f, 0.f, 0.f, 0.f}; d = __builtin_amdgcn_mfma_f32_16x16x32_bf16(kf[i1][ib][0], vf[i1][0], d, 0, 0, 0); d = __builtin_amdgcn_mfma_f32_16x16x32_bf16(kf[i1][ib][1], vf[i1][1], d, 0, 0, 0); u[4 * i2 + i1][ib] = d; }
                }
                pg8::f32x4 e4[2];
#pragma unroll
                for (int ib = 0; ib < 2; ++ib) e4[ib] = (pg8::f32x4){0.f, 0.f, 0.f, 0.f};
#pragma unroll
                for (int i = 0; i < 8; ++i)
#pragma unroll
                    for (int ib = 0; ib < 2; ++ib) e4[ib] = e4[ib] * g64 + u[i][ib];
                LAS pg8::f32x4* ends = (LAS pg8::f32x4*)ldsf;
#pragma unroll
                for (int ib = 0; ib < 2; ++ib) ends[(wave * 2 + ib) * 64 + lane] = e4[ib];
                float g8 = g64; g8 = g8 * g8; g8 = g8 * g8; g8 = g8 * g8;
                __syncthreads();
                pg8::f32x4 st[2];
#pragma unroll
                for (int ib = 0; ib < 2; ++ib) st[ib] = (pg8::f32x4){0.f, 0.f, 0.f, 0.f};
                for (int w2 = 0; w2 < wave; ++w2)
#pragma unroll
                    for (int ib = 0; ib < 2; ++ib) st[ib] = st[ib] * g8 + ends[(w2 * 2 + ib) * 64 + lane];
                bf16* ST = (bf16*)(ws + WS_STATE) + (size_t)(bh * 64 + 8 * wave) * 4096 + (size_t)(16 * dvs + fr) * 64 + 32 * dkh + 4 * fq;
#pragma unroll
                for (int i = 0; i < 8; ++i)
#pragma unroll
                    for (int ib = 0; ib < 2; ++ib) { u32x2 w; w.x = pk2(st[ib][0], st[ib][1]); w.y = pk2(st[ib][2], st[ib][3]); *(u32x2*)(ST + (size_t)i * 4096 + 16 * ib) = w; st[ib] = st[ib] * g64 + u[i][ib]; }
            } else if (bx < 224) {
                const int bh = bx - 192; const float* lf = (const float*)(ws + WS_LOGF) + (size_t)bh * SEQ; float* cb = (float*)(ws + WS_CB) + (size_t)bh * SEQ;
                const f32x4 a0 = *(const f32x4*)(lf + tid * 8), a1 = *(const f32x4*)(lf + tid * 8 + 4); float v[8] = {a0.x, a0.y, a0.z, a0.w, a1.x, a1.y, a1.z, a1.w};
#pragma unroll
                for (int e = 1; e < 8; ++e) v[e] += v[e - 1];
                float tot = v[7];
#pragma unroll
                for (int o = 1; o < 64; o <<= 1) { const float t = __shfl_up(tot, o); if (lane >= o) tot += t; }
                if (lane == 63) ldsf[wave] = tot;
                __syncthreads();
                float off = tot - v[7];
                for (int w = 0; w < wave; ++w) off += ldsf[w];
                f32x4 o0, o1; o0.x = -(v[0] + off) * LOG2E; o0.y = -(v[1] + off) * LOG2E; o0.z = -(v[2] + off) * LOG2E; o0.w = -(v[3] + off) * LOG2E; o1.x = -(v[4] + off) * LOG2E; o1.y = -(v[5] + off) * LOG2E; o1.z = -(v[6] + off) * LOG2E; o1.w = -(v[7] + off) * LOG2E;
                *(f32x4*)(cb + tid * 8) = o0; *(f32x4*)(cb + tid * 8 + 4) = o1;
            } else { const int idx = (bx - 224) * NTHR + tid; if (idx < M) ((float*)(ws + WS_SS))[(size_t)((l + 1) & 1) * M + idx] = 0.f;
                const int bh = bx - 224, b = bh >> 3, h = bh & 7, rsub = lane >> 3, part = lane & 7;
                const bf16* Qp = (const bf16*)(ws + WS_QO) + ((size_t)b * SEQ + wave * 512 + rsub) * 512 + h * 64 + part * 8; const bf16* Kp = (const bf16*)(ws + WS_KB) + ((size_t)b * SEQ + wave * 512 + rsub) * 512 + h * 64 + part * 8;
                float qm = 0.f, km = 0.f;
#pragma unroll 8
                for (int it = 0; it < 64; ++it) { const u32x4 qv = *(const u32x4*)(Qp + (size_t)it * 8 * 512), kv = *(const u32x4*)(Kp + (size_t)it * 8 * 512); float sq = 0.f, sk = 0.f;
#pragma unroll
                    for (int e = 0; e < 4; ++e) { const float a0 = bflo(qv[e]), a1 = bfhi(qv[e]), c0 = bflo(kv[e]), c1 = bfhi(kv[e]); sq += a0 * a0 + a1 * a1; sk += c0 * c0 + c1 * c1; }
                    sq += __shfl_xor(sq, 1); sq += __shfl_xor(sq, 2); sq += __shfl_xor(sq, 4); sk += __shfl_xor(sk, 1); sk += __shfl_xor(sk, 2); sk += __shfl_xor(sk, 4);
                    qm = fmaxf(qm, sq); km = fmaxf(km, sk); }
#pragma unroll
                for (int o = 8; o < 64; o <<= 1) { qm = fmaxf(qm, __shfl_xor(qm, o)); km = fmaxf(km, __shfl_xor(km, o)); }
                if (lane == 0) { ldsf[wave * 2] = qm; ldsf[wave * 2 + 1] = km; }
                __syncthreads();
                if (tid == 0) { float a = 0.f, c = 0.f; for (int w = 0; w < NWAVES; ++w) { a = fmaxf(a, ldsf[2 * w]); c = fmaxf(c, ldsf[2 * w + 1]); } ((float*)(ws + WS_NRM))[bh] = sqrtf(a) * sqrtf(c) * 1.0001f; }
            }
        }
        GSYNC();
        TSTAMP(3);
        {
            PHASE_VARS;
            if (wave < 4) ret_out_unit(args, l, wave * 256 + bx, lane);
            else {
                const int t = (wave - 4) * 256 + bx, g = t >> 6, r = t & 63, tm = r >> 3, tn = r & 7;
                const bf16* SUAg = (const bf16*)(ws + WS_SUA) + (size_t)g * NCH5 * KA5;
                WEpiS5Y E{SUAg, (bf16*)(ws + WS_YS5), args.in[10] + (size_t)l * 256 + g * 16, tm * 64, tn * 64, g};
                wave_gemm64<20, 4, WEpiS5Y>(SUAg + (size_t)(tm * 64) * KA5, KA5, (const bf16*)(ws + WS_MF) + ((size_t)(l * 16 + g) * 512 + tn * 64) * KA5, KA5, lane, E);
            }
            __syncthreads();
            const attn_body::AttnTensors AT{(const attn_body::bf16*)(ws + WS_QO), (const attn_body::bf16*)(ws + WS_KB), (const attn_body::bf16*)(ws + WS_VB), (attn_body::bf16*)(ws + WS_GATE), (const float*)(ws + WS_CB), (const float*)(ws + WS_NRM)};
            const attn_body::StaticOrder S(G, bx);
#ifdef REP_ATTN
            attn_body::attn_phase<attn_body::StaticOrder>((char*)lds, AT, S, opaque_true());
#endif
            attn_body::attn_phase<attn_body::StaticOrder>((char*)lds, AT, S);
        }
        GSYNC();
        TSTAMP(4);
        {
            PHASE_VARS;
            if (wave < 4) {
                const int t = wave * 256 + bx, tm = t >> 2, tn = t & 3;
                WEpiGlu E{(const bf16*)(ws + WS_YS5), (bf16*)(ws + WS_GATE), tm * 64, tn * 64};
                wave_gemm64<8, 4, WEpiGlu>((const bf16*)(ws + WS_YS5) + (size_t)(tm * 64) * 256, 256, (const bf16*)(ws + WS_WGLU) + (size_t)l * 65536 + (size_t)(tn * 64) * 256, 256, lane, E);
            }
        }
        GSYNC();
        TSTAMP(5);
        {
            PHASE_VARS;
            pg8::Gemm g{(const bf16*)(ws + WS_GATE), (const bf16*)(ws + WS_WO) + (size_t)l * DM * DM, M, DM, DM, DM, DM, 0, 0};
            pg8::StaticOrder S; S.init(M, DM, G, bx);
            if (l + 1 < DEPTH) {
                EpiOutX<false> E{l == 0 ? args.in[0] : X, X, args.in[1] + (size_t)(l + 1) * DM, (float*)(ws + WS_XBUF), (unsigned*)ws + 4096, (bf16*)(ws + WS_XN), 32u * (unsigned)(l + 1)};
                pg8::gemm_phase<EpiOutX<false>, pg8::StaticOrder, false, true>(ldsl, g, S, E);
            } else {
                EpiOutX<true> E{X, X, args.in[15], (float*)(ws + WS_XBUF), (unsigned*)ws + 4096, nullptr, 32u * (unsigned)(l + 1)};
                pg8::gemm_phase<EpiOutX<true>, pg8::StaticOrder, false, true>(ldsl, g, S, E);
            }
        }
        if (l + 1 < DEPTH) GSYNC();
        TSTAMP(6);
    }
}

extern "C" void kernel_launch(void* const* d_in, const int* in_sizes, int n_in, void* d_out, int out_size, void* d_ws, size_t ws_size, hipStream_t stream) {
    static int grid = 0;
    if (grid == 0) {
        if (n_in != 16 || ws_size < WS_END) { fprintf(stderr, "kernel_launch: unexpected n_in %d / ws %zu\n", n_in, ws_size); grid = -1; return; }
        int dev = 0, cus = 0, per_cu = 0;
        hipGetDevice(&dev); hipDeviceGetAttribute(&cus, hipDeviceAttributeMultiprocessorCount, dev);
        if (hipFuncSetAttribute((const void*)mega_fwd, hipFuncAttributeMaxDynamicSharedMemorySize, LDS_BYTES) != hipSuccess) { fprintf(stderr, "kernel_launch: hipFuncSetAttribute failed\n"); grid = -1; return; }
        if (hipOccupancyMaxActiveBlocksPerMultiprocessor(&per_cu, (const void*)mega_fwd, NTHR, LDS_BYTES) != hipSuccess || per_cu < 1) { fprintf(stderr, "kernel_launch: occupancy query failed (%d)\n", per_cu); grid = -1; return; }
        grid = cus;
        if (grid != 256) fprintf(stderr, "kernel_launch: note: %d CUs\n", grid);
    }
    if (grid < 0) return;
    if (hipMemsetAsync(d_ws, 0, 32768, stream) != hipSuccess) { fprintf(stderr, "kernel_launch: hipMemsetAsync failed\n"); return; }
    Args a{};
    for (int i = 0; i < 16; ++i) a.in[i] = (const float*)d_in[i];
    a.out = (float*)d_out; a.ws = (unsigned char*)d_ws;
    void* kargs[] = {&a};
    hipError_t e = hipLaunchCooperativeKernel((const void*)mega_fwd, dim3(grid), dim3(NTHR), kargs, LDS_BYTES, stream);
    if (e != hipSuccess) fprintf(stderr, "kernel_launch: cooperative launch failed: %s\n", hipGetErrorString(e));
}
```

```cpp
#include <hip/hip_runtime.h>
#include <cstdio>
#include <cstdint>
namespace pg8 {
#define PG8_LAS __attribute__((address_space(3)))
typedef unsigned short bf16_t;
typedef short bf16x8 __attribute__((ext_vector_type(8)));
typedef float f32x4 __attribute__((ext_vector_type(4)));
typedef unsigned u32x4 __attribute__((ext_vector_type(4)));
constexpr int BM = 256, BK = 64, HALF = 128, HTB = HALF * BK * 2  , STAGE_BYTES = 8 * HTB, NXCD = 8, WGM = 4;

__host__ __device__ __forceinline__ int lds_byte(int r, int c) { const int st = (r >> 4) * 2 + (c >> 5), rr = r & 15, cc = c & 31, ob = rr * 64 + cc * 2; return st * 1024 + (ob ^ (((ob >> 9) & 1) << 5)); }
__host__ __device__ __forceinline__ void stage_rc(int b, int& R, int& C) { const int st = b / 1024, sb = b % 1024, swz = sb ^ (((sb >> 9) & 1) << 5); R = (st >> 1) * 16 + swz / 64; C = (st & 1) * 32 + (swz % 64) / 2; }
__host__ __device__ __forceinline__ int perm32(int rho) { const int n = rho >> 4, i = rho & 15; return 8 * (i >> 2) + 4 * n + (i & 3); }

struct Unit { int pm, pn, gz; };
struct Gemm { const bf16_t* A; const bf16_t* Bt; int M, N, K; int lda, ldb; size_t gsA, gsB; };

struct StaticOrder {
    int nM, nN, nwg, G, c;
    __host__ __device__ void init(int M, int N, int G_, int c_) { nM = M / BM; nN = N / BM; nwg = nM * nN; G = G_; c = c_; }
    __host__ __device__ bool next(int i, Unit& u) const {
        const long L = (long)i * G + c; if (L >= nwg) return false;
        int wgid = (int)L; { const int q = nwg / NXCD, r = nwg % NXCD, xcd = wgid % NXCD, off = wgid / NXCD; wgid = (xcd < r ? xcd * (q + 1) : r * (q + 1) + (xcd - r) * q) + off; }
        const int nig = WGM * nN, gid = wgid / nig, fm = gid * WGM, gsz = (nM - fm) < WGM ? (nM - fm) : WGM;
        u.pm = fm + ((wgid % nig) % gsz); u.pn = (wgid % nig) / gsz; u.gz = 0; return true;
    }
    __device__ __forceinline__ void a_ready(const Unit&) const {}
    __device__ __forceinline__ void done(const Unit&) const {}
};

__device__ __forceinline__ unsigned cvt_pk_bf16(float lo, float hi) { unsigned r; asm volatile("v_cvt_pk_bf16_f32 %0, %1, %2" : "=v"(r) : "v"(lo), "v"(hi)); return r; }
typedef float f32x2 __attribute__((ext_vector_type(2)));
__device__ __forceinline__ f32x2 gelu_pk(f32x2 v) {
    const f32x2 av = __builtin_elementwise_abs(v), d = av * 0.2316418882f + 1.0f;
    f32x2 t; t.x = __builtin_amdgcn_rcpf(d.x); t.y = __builtin_amdgcn_rcpf(d.y);
    f32x2 q = t * 0.5307027145f + (-0.7265760135f); q = q * t + 0.7107068705f; q = q * t + (-0.142248368f); q = q * t + 0.127414796f; q = q * t;
    const f32x2 s = (v * v) * (-0.72134752044f);
    f32x2 e; e.x = __builtin_amdgcn_exp2f(s.x); e.y = __builtin_amdgcn_exp2f(s.y);
    const f32x2 m = v * (q * e), r = v - m;
    f32x2 o; o.x = v.x < 0.f ? m.x : r.x; o.y = v.y < 0.f ? m.y : r.y; return o;
}

template <class Epi, class Sched, bool ALIGN_EPI = false, bool SP2 = false>
__device__ __forceinline__ void gemm_phase(PG8_LAS unsigned char* lds, const Gemm g, const Sched& S, const Epi& E) {
    int tid_ = threadIdx.x; asm volatile("" : "+v"(tid_));
    const int tid = tid_, wid = __builtin_amdgcn_readfirstlane(tid >> 6), lane = tid & 63, wr = wid >> 2, wc = wid & 3, fr = lane & 15, fq = lane >> 4;
    const int K = g.K, nt = K / BK;
    unsigned voffA[2], voffB[2];
#pragma unroll
    for (int i = 0; i < 2; ++i) { int R, C; stage_rc(tid * 16 + i * 8192, R, C); const int Rb = Epi::PERM ? ((R & ~31) + perm32(R & 31)) : R;
        voffA[i] = (unsigned)(R * g.lda + C) * 2u; voffB[i] = (unsigned)(Rb * g.ldb + C) * 2u; }
    const size_t kstep = (size_t)(BK * 2);
    const size_t hstepA = (size_t)HALF * g.lda * 2, hstepB = (size_t)HALF * g.ldb * 2;
    const size_t tstepA = 2 * hstepA, tstepB = 2 * hstepB;
    const unsigned ldsw = (unsigned)wid * 1024u;
    const int aoff = lds_byte(wr * 64 + fr, fq * 8), boff = lds_byte(wc * 32 + fr, fq * 8);
#define PG8_SA(b, h) (((b) * 2 + (h)) * HTB)
#define PG8_SB(b, h) ((4 + (b) * 2 + (h)) * HTB)
#define PG8_STAGE(bufoff, gbase, voff) do { _Pragma("unroll") for (int _i = 0; _i < 2; ++_i) \
        __builtin_amdgcn_global_load_lds((const unsigned*)((const char*)(gbase) + (voff)[_i]), (PG8_LAS unsigned*)(lds + (bufoff) + ldsw + _i * 8192), 16, 0, 0); } while (0)
#define PG8_LDA(dst, b, h) do { _Pragma("unroll") for (int m = 0; m < 4; ++m) _Pragma("unroll") for (int k = 0; k < 2; ++k) dst[m][k] = *(const PG8_LAS bf16x8*)(lds + PG8_SA(b, h) + aoff + m * 2048 + k * 1024); } while (0)
#define PG8_LDB(dst, b, h) do { _Pragma("unroll") for (int n = 0; n < 2; ++n) _Pragma("unroll") for (int k = 0; k < 2; ++k) dst[n][k] = *(const PG8_LAS bf16x8*)(lds + PG8_SB(b, h) + boff + n * 2048 + k * 1024); } while (0)
#define PG8_MMA(ai, bj, At, Bt) do { __builtin_amdgcn_s_setprio(1); _Pragma("unroll") for (int m = 0; m < 4; ++m) _Pragma("unroll") for (int n = 0; n < 2; ++n) _Pragma("unroll") for (int k = 0; k < 2; ++k) \
        acc[ai][bj][m][n] = __builtin_amdgcn_mfma_f32_16x16x32_bf16(Bt[n][k], At[m][k], acc[ai][bj][m][n], 0, 0, 0); __builtin_amdgcn_s_setprio(0); } while (0)
#define PG8_WAIT_V(n) asm volatile("s_waitcnt vmcnt(" #n ")" ::: "memory")
#define PG8_WAIT_L(n) asm volatile("s_waitcnt lgkmcnt(" #n ")" ::: "memory")
#define PG8_BAR __builtin_amdgcn_s_barrier()
#define PG8_SCHED __builtin_amdgcn_sched_barrier(0)
    Unit cur, nxt; int ui = 0;
    if (!S.next(0, cur)) return;
    f32x4 acc[2][2][4][2];
#pragma unroll
    for (int a = 0; a < 2; ++a)
#pragma unroll
        for (int b = 0; b < 2; ++b)
#pragma unroll
            for (int m = 0; m < 4; ++m)
#pragma unroll
                for (int n = 0; n < 2; ++n) acc[a][b][m][n] = (f32x4){0.f, 0.f, 0.f, 0.f};
    bf16x8 At[4][2], B0[2][2], B1[2][2];
    const char* cA = (const char*)g.A + (size_t)cur.gz * g.gsA * 2 + (size_t)cur.pm * tstepA; const char* cB = (const char*)g.Bt + (size_t)cur.gz * g.gsB * 2 + (size_t)cur.pn * tstepB;
    S.a_ready(cur);
    if constexpr (SP2) {
        PG8_STAGE(PG8_SB(0, 0), cB, voffB); PG8_STAGE(PG8_SB(0, 1), cB + hstepB, voffB); PG8_STAGE(PG8_SA(0, 0), cA, voffA); PG8_STAGE(PG8_SA(0, 1), cA + hstepA, voffA);
        if (wr == 1) PG8_BAR;
        PG8_WAIT_V(2); PG8_BAR;
        PG8_STAGE(PG8_SB(1, 0), cB + kstep, voffB); PG8_STAGE(PG8_SA(1, 0), cA + kstep, voffA); PG8_STAGE(PG8_SB(1, 1), cB + hstepB + kstep, voffB);
        PG8_WAIT_V(6); PG8_BAR;
    } else {
        PG8_STAGE(PG8_SB(0, 0), cB, voffB); PG8_STAGE(PG8_SA(0, 0), cA, voffA); PG8_STAGE(PG8_SB(0, 1), cB + hstepB, voffB); PG8_STAGE(PG8_SA(0, 1), cA + hstepA, voffA);
        if (wr == 1) PG8_BAR;
        PG8_WAIT_V(4); PG8_BAR;
        PG8_STAGE(PG8_SB(1, 0), cB + kstep, voffB); PG8_STAGE(PG8_SA(1, 0), cA + kstep, voffA); PG8_STAGE(PG8_SB(1, 1), cB + hstepB + kstep, voffB);
        PG8_WAIT_V(6); PG8_BAR;
    }
    for (;;) {
        const bool has_next = S.next(ui + 1, nxt);
        const char* nA = has_next ? (const char*)g.A + (size_t)nxt.gz * g.gsA * 2 + (size_t)nxt.pm * tstepA : cA; const char* nB = has_next ? (const char*)g.Bt + (size_t)nxt.gz * g.gsB * 2 + (size_t)nxt.pn * tstepB : cB;
        for (int t = 0; t < nt; t += 2) {
            const bool last = (t == nt - 2);
            const char* a1 = cA + (size_t)(t + 1) * kstep;
            const char* a2 = last ? nA : cA + (size_t)(t + 2) * kstep; const char* b2 = last ? nB : cB + (size_t)(t + 2) * kstep;
            const char* a3 = a2 + kstep; const char* b3 = b2 + kstep;
            if (last && has_next) S.a_ready(nxt);
            if constexpr (SP2) {
            PG8_LDB(B0, 0, 0); PG8_LDB(B1, 0, 1); PG8_SCHED; PG8_LDA(At, 0, 0); PG8_STAGE(PG8_SA(1, 1), a1 + hstepA, voffA);
            PG8_WAIT_V(8); PG8_WAIT_L(0); PG8_BAR; PG8_MMA(0, 0, At, B0); PG8_MMA(0, 1, At, B1); PG8_BAR; PG8_SCHED;
            PG8_LDA(At, 0, 1); PG8_STAGE(PG8_SB(0, 0), b2, voffB); PG8_STAGE(PG8_SB(0, 1), b2 + hstepB, voffB); PG8_STAGE(PG8_SA(0, 0), a2, voffA);
            PG8_WAIT_V(8); PG8_WAIT_L(0); PG8_BAR; PG8_MMA(1, 0, At, B0); PG8_MMA(1, 1, At, B1); PG8_BAR; PG8_SCHED;
            PG8_LDB(B0, 1, 0); PG8_LDB(B1, 1, 1); PG8_SCHED; PG8_LDA(At, 1, 0); PG8_STAGE(PG8_SA(0, 1), a2 + hstepA, voffA);
            PG8_WAIT_V(8); PG8_WAIT_L(0); PG8_BAR; PG8_MMA(0, 0, At, B0); PG8_MMA(0, 1, At, B1); PG8_BAR; PG8_SCHED;
            PG8_LDA(At, 1, 1); PG8_STAGE(PG8_SB(1, 0), b3, voffB); PG8_STAGE(PG8_SB(1, 1), b3 + hstepB, voffB); PG8_STAGE(PG8_SA(1, 0), a3, voffA);
            PG8_WAIT_V(8); PG8_WAIT_L(0); PG8_BAR; PG8_MMA(1, 0, At, B0); PG8_MMA(1, 1, At, B1); PG8_BAR; PG8_SCHED;
            } else {
            PG8_LDB(B0, 0, 0); PG8_SCHED; PG8_LDA(At, 0, 0); PG8_STAGE(PG8_SA(1, 1), a1 + hstepA, voffA);
            PG8_WAIT_L(8); PG8_BAR; PG8_WAIT_L(0); PG8_MMA(0, 0, At, B0); PG8_BAR; PG8_SCHED;
            PG8_LDB(B1, 0, 1); PG8_STAGE(PG8_SB(0, 0), b2, voffB);
            PG8_BAR; PG8_WAIT_L(0); PG8_MMA(0, 1, At, B1); PG8_BAR;
            PG8_LDA(At, 0, 1); PG8_STAGE(PG8_SA(0, 0), a2, voffA);
            PG8_BAR; PG8_WAIT_L(0); PG8_MMA(1, 0, At, B0); PG8_BAR; PG8_SCHED;
            PG8_STAGE(PG8_SB(0, 1), b2 + hstepB, voffB);
            PG8_WAIT_V(6); PG8_BAR; PG8_MMA(1, 1, At, B1); PG8_BAR;
            PG8_LDB(B0, 1, 0); PG8_SCHED; PG8_LDA(At, 1, 0); PG8_STAGE(PG8_SA(0, 1), a2 + hstepA, voffA);
            PG8_WAIT_L(8); PG8_BAR; PG8_WAIT_L(0); PG8_MMA(0, 0, At, B0); PG8_BAR; PG8_SCHED;
            PG8_LDB(B1, 1, 1); PG8_STAGE(PG8_SB(1, 0), b3, voffB);
            PG8_BAR; PG8_WAIT_L(0); PG8_MMA(0, 1, At, B1); PG8_BAR;
            PG8_LDA(At, 1, 1); PG8_STAGE(PG8_SA(1, 0), a3, voffA);
            PG8_BAR; PG8_WAIT_L(0); PG8_MMA(1, 0, At, B0); PG8_BAR; PG8_SCHED;
            PG8_STAGE(PG8_SB(1, 1), b3 + hstepB, voffB);
            PG8_WAIT_V(6); PG8_BAR; PG8_MMA(1, 1, At, B1); PG8_BAR;
            }
        }
        if constexpr (ALIGN_EPI) { if (wr == 0) PG8_BAR; }
        if constexpr (!Epi::AFTER_DRAIN) { E(acc, cur, wr, wc, fr, fq); S.done(cur); }
        if (!has_next) break;
#pragma unroll
        for (int a = 0; a < 2; ++a)
#pragma unroll
            for (int b = 0; b < 2; ++b)
#pragma unroll
                for (int m = 0; m < 4; ++m)
#pragma unroll
                    for (int n = 0; n < 2; ++n) acc[a][b][m][n] = (f32x4){0.f, 0.f, 0.f, 0.f};
        cur = nxt; cA = nA; cB = nB; ++ui;
        if constexpr (ALIGN_EPI) { if (wr == 1) PG8_BAR; }
    }
    PG8_WAIT_V(0);
    if constexpr (!ALIGN_EPI) { if (wr == 0) PG8_BAR; }
    PG8_BAR;
    if constexpr (Epi::AFTER_DRAIN) { E.fused(acc, cur, wr, wc, fr, fq, lds, wid, lane); S.done(cur); }
#undef PG8_SA
#undef PG8_SB
#undef PG8_STAGE
#undef PG8_LDA
#undef PG8_LDB
#undef PG8_MMA
#undef PG8_WAIT_V
#undef PG8_WAIT_L
#undef PG8_BAR
#undef PG8_SCHED
}
}
#include <hip/hip_bf16.h>
#include <cmath>
namespace attn_body {
using bf16=__hip_bfloat16;
using bf16x8=__attribute__((ext_vector_type(8)))short;
using s16x4=__attribute__((ext_vector_type(4)))short;
using f32x16=__attribute__((ext_vector_type(16)))float;
using u32x4=__attribute__((ext_vector_type(4)))unsigned;
using f32x4=__attribute__((ext_vector_type(4)))float;
constexpr int BATCH=4,NHEAD=8,SEQ=4096,D=64,DM=NHEAD*D,OPITCH=1024;
constexpr int NW=8,QBLK=32,QB=QBLK*NW,KVBLK=64,NQB=SEQ/QB;
constexpr int ATTN_PITCH=DM, ATTN_UNIT_ROWS=QB;
__device__ __forceinline__ int crow(int r,int hi){return (r&3)+8*(r>>2)+4*hi;}
#define SBAR() __builtin_amdgcn_sched_barrier(0)
__device__ __forceinline__ void cmask(f32x16&p0,f32x16&p1,int jb,int qrel,int hi){
  const float NEG=-INFINITY; int kb=64*jb+4*hi;
  #pragma unroll
  for(int r=0;r<16;++r){int kv=kb+(r&3)+8*(r>>2); if(kv>qrel)p0[r]=NEG; if(kv+32>qrel)p1[r]=NEG;}
}

constexpr int NSLOT=3, SLOTB=8192;
constexpr int LDS_K=0, LDS_V=NSLOT*SLOTB, LDS_WS=2*NSLOT*SLOTB, LDS_OST=LDS_WS+NW*64*4, LDS_CB=LDS_OST+NW*4096, LDS_BYTES=LDS_CB+SEQ*4;
constexpr float C2=0.125f*1.4426950408889634f;
__device__ __forceinline__ void glds16(const void*gsrc,unsigned lds_dst){unsigned keep;
  asm volatile("s_mov_b32 %0, m0\n\ts_mov_b32 m0, %2\n\ts_nop 0\n\tglobal_load_lds_dwordx4 %1, off\n\ts_mov_b32 m0, %0":"=&s"(keep):"v"(gsrc),"s"(lds_dst):"memory");}
__device__ __forceinline__ float max3f(float a,float b,float c){float r;asm("v_max3_f32 %0, %1, %2, %3":"=v"(r):"v"(a),"v"(b),"v"(c));return r;}
__device__ __forceinline__ float max2f(float a,float b){float r;asm("v_max_f32_e32 %0, %1, %2":"=v"(r):"v"(a),"v"(b));return r;}
__device__ __forceinline__ float fadd_s(float a,float b){float r;asm("v_add_f32_e32 %0, %1, %2":"=v"(r):"v"(a),"v"(b));return r;}
__device__ __forceinline__ float fsub_s(float a,float b){float r;asm("v_sub_f32_e32 %0, %1, %2":"=v"(r):"v"(a),"v"(b));return r;}
typedef float f32x2_t __attribute__((ext_vector_type(2))); typedef __bf16 bf16x2_t __attribute__((ext_vector_type(2)));
__device__ __forceinline__ unsigned cvtpk_s(float lo,float hi){f32x2_t v={lo,hi};bf16x2_t b=__builtin_convertvector(v,bf16x2_t);return __builtin_bit_cast(unsigned,b);}
#define WAIT_BAR(N) asm volatile("s_waitcnt vmcnt(" #N ") lgkmcnt(0)\n\ts_barrier":::"memory")

__device__ __forceinline__ void qkt(f32x16&p0,f32x16&p1,const char*Kslot,const bf16x8*qr,const char*cbt,int r32,int hi){
  const char*kb=Kslot+hi*1024+r32*16;
  #pragma unroll
  for(int a=0;a<4;++a){ const f32x4 u0=*reinterpret_cast<const f32x4*>(cbt+hi*16+a*32), u1=*reinterpret_cast<const f32x4*>(cbt+128+hi*16+a*32);
    p0[4*a]=u0[0];p0[4*a+1]=u0[1];p0[4*a+2]=u0[2];p0[4*a+3]=u0[3]; p1[4*a]=u1[0];p1[4*a+1]=u1[1];p1[4*a+2]=u1[2];p1[4*a+3]=u1[3]; }
  #pragma unroll
  for(int d0=0;d0<4;++d0){
    const bf16x8 b0=*reinterpret_cast<const bf16x8*>(kb+d0*2048);
    const bf16x8 b1=*reinterpret_cast<const bf16x8*>(kb+d0*2048+512);
    p0=__builtin_amdgcn_mfma_f32_32x32x16_bf16(b0,qr[d0],p0,0,0,0);p1=__builtin_amdgcn_mfma_f32_32x32x16_bf16(b1,qr[d0],p1,0,0,0);}
}
typedef __attribute__((address_space(3))) const char* lds_cptr;
typedef short v4i16_t __attribute__((ext_vector_type(4)));
__device__ __forceinline__ void kload8(bf16x8*kf,lds_cptr kp){
  kf[0]=*(const __attribute__((address_space(3))) bf16x8*)(kp);      kf[1]=*(const __attribute__((address_space(3))) bf16x8*)(kp+512);
  kf[2]=*(const __attribute__((address_space(3))) bf16x8*)(kp+2048); kf[3]=*(const __attribute__((address_space(3))) bf16x8*)(kp+2560);
  kf[4]=*(const __attribute__((address_space(3))) bf16x8*)(kp+4096); kf[5]=*(const __attribute__((address_space(3))) bf16x8*)(kp+4608);
  kf[6]=*(const __attribute__((address_space(3))) bf16x8*)(kp+6144); kf[7]=*(const __attribute__((address_space(3))) bf16x8*)(kp+6656);
}
__device__ __forceinline__ void kload2(bf16x8*kf,lds_cptr kp,int j){ kf[2*j]=*(const __attribute__((address_space(3))) bf16x8*)(kp+j*2048); kf[2*j+1]=*(const __attribute__((address_space(3))) bf16x8*)(kp+j*2048+512); }
__device__ __forceinline__ s16x4 vtr(lds_cptr p){ return __builtin_bit_cast(s16x4,__builtin_amdgcn_ds_read_tr16_b64_v4i16((__attribute__((address_space(3))) v4i16_t*)p)); }
__device__ __forceinline__ float rowmax(const f32x16&p0,const f32x16&p1){
  float a=max3f(p0[0],p0[1],p1[0]),b=max3f(p0[2],p0[3],p1[1]);a=max3f(a,p1[2],p1[3]);
  #pragma unroll
  for(int r=4;r<16;r+=4){a=max3f(a,p0[r],p0[r+1]);b=max3f(b,p0[r+2],p0[r+3]);a=max3f(a,p1[r],p1[r+1]);b=max3f(b,p1[r+2],p1[r+3]);}
  const float m=max2f(a,b);
  auto rr=__builtin_amdgcn_permlane32_swap(__float_as_uint(m),__float_as_uint(m),false,false);
  return max2f(__uint_as_float(rr[0]),__uint_as_float(rr[1]));
}
__device__ __forceinline__ void pv(f32x16*o,int vb,bf16x8 pa0,bf16x8 pa1,bf16x8 pa2,bf16x8 pa3){
  #pragma unroll
  for(int d0=0;d0<2;++d0){s16x4 lo[4],hi[4];
    #pragma unroll
    for(int ks=0;ks<4;++ks){
      asm volatile("ds_read_b64_tr_b16 %0,%1 offset:%c2":"=&v"(lo[ks]):"v"(vb),"i"(d0*4096+ks*1024):"memory");
      asm volatile("ds_read_b64_tr_b16 %0,%1 offset:%c2":"=&v"(hi[ks]):"v"(vb),"i"(d0*4096+ks*1024+512):"memory");}
    asm volatile("s_waitcnt lgkmcnt(0)":::"memory");SBAR();
    #define PK(k) (bf16x8){lo[k][0],lo[k][1],lo[k][2],lo[k][3],hi[k][0],hi[k][1],hi[k][2],hi[k][3]}
    o[d0]=__builtin_amdgcn_mfma_f32_32x32x16_bf16(pa0,PK(0),o[d0],0,0,0);
    o[d0]=__builtin_amdgcn_mfma_f32_32x32x16_bf16(pa1,PK(1),o[d0],0,0,0);
    o[d0]=__builtin_amdgcn_mfma_f32_32x32x16_bf16(pa2,PK(2),o[d0],0,0,0);
    o[d0]=__builtin_amdgcn_mfma_f32_32x32x16_bf16(pa3,PK(3),o[d0],0,0,0);
    #undef PK
  }
}

#ifndef ATTN_STORE16
#define ATTN_STORE16(p,v) (*(u32x4*)(p)=(v))
#endif
template<int THRL> __device__ __forceinline__ void attn_unit(int b,int h,int qb,const bf16*Q,const bf16*__restrict__ K,const bf16*__restrict__ V,bf16*O,const float*__restrict__ CB,const float*__restrict__ NRM,char*shm,bool dry=false){
  int tid_=threadIdx.x; asm volatile("":"+v"(tid_)); const int tid=tid_,lane=tid&63,r32=lane&31,hi=lane>>5; const int wid=__builtin_amdgcn_readfirstlane(tid>>6);
  const long rowbase=(long)b*SEQ; const int q0=qb*QB;
  int t0;
  { const f32x4* cbg=reinterpret_cast<const f32x4*>(CB+(long)(b*NHEAD+h)*SEQ); f32x4* cbl=reinterpret_cast<f32x4*>(shm+LDS_CB); const int nv=(q0+QB)/4;
    for(int i=tid;i<nv;i+=NW*64) cbl[i]=cbg[i];
    const float bnd=NRM[b*NHEAD+h]+36.f;
    asm volatile("s_waitcnt vmcnt(0) lgkmcnt(0)\n\ts_barrier":::"memory");
    const float*cbf=reinterpret_cast<const float*>(shm+LDS_CB); const int tc=2*lane; const int NT0=(q0+QB)/KVBLK;
    const bool ok=(tc<=NT0-4)&&(tc==0||cbf[64*tc-1]+bnd<=cbf[q0]);
    const unsigned long long mk=__ballot(ok); t0=2*(__popcll(mk)-1); t0=__builtin_amdgcn_readfirstlane(t0); }
  const bf16*Qw=Q+(rowbase+q0+wid*QBLK)*DM+h*D;
  const bf16*Kh=K+(rowbase+(long)t0*KVBLK)*DM+h*D,*Vh=V+(rowbase+(long)t0*KVBLK)*DM+h*D;
  const unsigned lds0=(unsigned)(uintptr_t)shm;
  float*wsf=(float*)(shm+LDS_WS)+wid*64;
  const bf16*ksrc=Kh+(long)lane*DM+wid*8;
  const bf16*vsrc=Vh+(long)(16*(wid&3)+(lane>>2))*DM+(wid>>2)*32+(lane&3)*8;
  const unsigned kdst=lds0+LDS_K+wid*1024, vdst=lds0+LDS_V+wid*1024;
  #define DMA_K(t,slot) glds16(ksrc+(long)(t)*KVBLK*DM,(unsigned)__builtin_amdgcn_readfirstlane(kdst+(slot)))
  #define DMA_V(t,slot) glds16(vsrc+(long)(t)*KVBLK*DM,(unsigned)__builtin_amdgcn_readfirstlane(vdst+(slot)))
  const int vb0=(int)(lds0+LDS_V)+((lane>>4)&1)*32+(lane&3)*8+(4*hi+((lane&15)>>2))*64;
  const char*Kbase=shm+LDS_K; bf16x8 kf[8];
  const lds_cptr shm3=(lds_cptr)shm; const lds_cptr kp0=shm3+LDS_K+hi*1024+r32*16; const lds_cptr vp0=shm3+LDS_V+((lane>>4)&1)*32+(lane&3)*8+(4*hi+((lane&15)>>2))*64;
  const int NT=(q0+QB)/KVBLK-t0;
  const lds_cptr cb3=(lds_cptr)shm+LDS_CB+t0*256;
  const float cb_own=*(const __attribute__((address_space(3))) float*)((lds_cptr)shm+LDS_CB+(q0+wid*QBLK+r32)*4);
  DMA_K(0,0);DMA_V(0,0);DMA_K(1,SLOTB);
  bf16x8 qr[4];
  #pragma unroll
  for(int d0=0;d0<4;++d0)qr[d0]=*reinterpret_cast<const bf16x8*>(&Qw[(long)r32*DM+d0*16+hi*8]);
  float mhat=0.f,l_reg=0.f;f32x16 o[2];o[0]=f32x16{};o[1]=f32x16{};
  const int qrel=wid*QBLK+r32;
  #define CMASK(P0,P1,t) do{int jb_=(t)-(NT-4); if(jb_>=0)cmask(P0,P1,jb_,qrel,hi);}while(0)
  bool resc=false;
  #define START(P0,P1) do{ const float rm=max2f(rowmax(P0,P1),cb_own); resc=false; \
    { const float dl=rm; mhat=fadd_s(mhat,dl); \
      _Pragma("unroll") for(int r=0;r<16;++r){P0[r]=fsub_s(P0[r],dl);P1[r]=fsub_s(P1[r],dl);} } \
    _Pragma("unroll") for(int r=0;r<16;++r)P0[r]=__builtin_amdgcn_exp2f(P0[r]); }while(0)
  #define RESC() do{ if(resc){ asm volatile("s_waitcnt lgkmcnt(0)":::"memory"); \
      _Pragma("unroll") for(int d_=0;d_<2;++d_) _Pragma("unroll") for(int r=0;r<16;++r)o[d_][r]*=wsf[crow(r,hi)]; } }while(0)
  f32x16 pA0,pA1,pB0,pB1;
  int sl_prev=0,sl_cur=0,sl_next=SLOTB;
  #define ROT() do{sl_prev=sl_cur;sl_cur=sl_next;sl_next=(sl_next==(NSLOT-1)*SLOTB)?0:sl_next+SLOTB;}while(0)
  DMA_K(2,2*SLOTB);
  WAIT_BAR(3);
  qkt(pA0,pA1,Kbase,qr,shm+LDS_CB+t0*256,r32,hi);asm volatile("s_nop 15\n\ts_nop 7":"+v"(pA0),"+v"(pA1));CMASK(pA0,pA1,0);
  START(pA0,pA1);
  _Pragma("unroll") for(int r=0;r<16;++r)pA1[r]=__builtin_amdgcn_exp2f(pA1[r]);
  WAIT_BAR(0);
  DMA_K(3,0);DMA_V(1,SLOTB);
  ROT();
  kload8(kf,kp0+sl_cur);
  WAIT_BAR(2);
  s16x4 vlo[8],vhi[8]; u32x4 pw0,pw1,pw2,pw3;
  #define PKW(P,B) cvtpk_s(P[B],P[B+1])
  #define PAF(k) __builtin_bit_cast(bf16x8,pw##k)
  #define VFR(i) (bf16x8){vlo[i][0],vlo[i][1],vlo[i][2],vlo[i][3],vhi[i][0],vhi[i][1],vhi[i][2],vhi[i][3]}
  #define PIN(x) asm volatile("":"+v"(x))
  #define MX3(a,b,c) __builtin_fmaxf(__builtin_fmaxf((a),(b)),(c))
  #define GAPA(MF,A0,A1,A2,A3,W0,W1,PW) do{ MF; sacc+=A0; sacc+=A1; sacc+=A2; sacc+=A3; PIN(sacc); W0; W1; PIN(PW); SBAR(); }while(0)
  #define EX(v) __builtin_amdgcn_exp2f(v)
  #define GAPB(MF,X,B) do{ MF; X[B]=EX(X[B]); X[B+1]=EX(X[B+1]); X[B+2]=EX(X[B+2]); X[B+3]=EX(X[B+3]); PIN(X); SBAR(); }while(0)
  #define VRD(i) do{ vlo[i]=vtr(vp_+(((i)>>2)*4096+((i)&3)*1024)); vhi[i]=vtr(vp_+(((i)>>2)*4096+((i)&3)*1024+512)); }while(0)
  #define KRD(G,j) do{ if(G){ kload2(kf,kp0+sl_next,j); SBAR(); } }while(0)
  #define STEP(C0,C1,P0,P1,t,GK,GV,GL) do{ SBAR(); \
    const lds_cptr vp_=vp0+sl_prev; \
    VRD(0); SBAR(); float sacc=(P0[0]+P0[1]); \
    GAPA(C0=__builtin_amdgcn_mfma_f32_32x32x16_bf16(kf[0],qr[0],C0,0,0,0), P0[2],P0[3],P0[4],P0[5],     pw0[0]=PKW(P0,0), pw0[1]=PKW(P0,2), pw0); \
    VRD(4); SBAR(); GAPA(C1=__builtin_amdgcn_mfma_f32_32x32x16_bf16(kf[1],qr[0],C1,0,0,0), P0[6],P0[7],P0[8],P0[9],     pw0[2]=PKW(P0,4), pw0[3]=PKW(P0,6), pw0); \
    VRD(1); SBAR(); GAPA(C0=__builtin_amdgcn_mfma_f32_32x32x16_bf16(kf[2],qr[1],C0,0,0,0),   P0[10],P0[11],P0[12],P0[13], pw1[0]=PKW(P0,8), pw1[1]=PKW(P0,10), pw1); \
    VRD(5); SBAR(); GAPA(C1=__builtin_amdgcn_mfma_f32_32x32x16_bf16(kf[3],qr[1],C1,0,0,0),   P0[14],P0[15],P1[0],P1[1],   pw1[2]=PKW(P0,12),pw1[3]=PKW(P0,14), pw1); \
    VRD(2); SBAR(); GAPA(C0=__builtin_amdgcn_mfma_f32_32x32x16_bf16(kf[4],qr[2],C0,0,0,0),   P1[2],P1[3],P1[4],P1[5],     pw2[0]=PKW(P1,0), pw2[1]=PKW(P1,2), pw2); \
    VRD(6); SBAR(); GAPA(C1=__builtin_amdgcn_mfma_f32_32x32x16_bf16(kf[5],qr[2],C1,0,0,0),   P1[6],P1[7],P1[8],P1[9],     pw2[2]=PKW(P1,4), pw2[3]=PKW(P1,6), pw2); \
    VRD(3); SBAR(); GAPA(C0=__builtin_amdgcn_mfma_f32_32x32x16_bf16(kf[6],qr[3],C0,0,0,0),   P1[10],P1[11],P1[12],P1[13], pw3[0]=PKW(P1,8), pw3[1]=PKW(P1,10), pw3); \
    VRD(7); SBAR(); GAPA(C1=__builtin_amdgcn_mfma_f32_32x32x16_bf16(kf[7],qr[3],C1,0,0,0),   P1[14],P1[15],0.f,0.f,       pw3[2]=PKW(P1,12),pw3[3]=PKW(P1,14), pw3); \
    l_reg+=sacc; \
    if(GK){DMA_K((t)+3,sl_cur);} if(GV){DMA_V((t)+1,sl_next);} \
    CMASK(C0,C1,t); \
    { float a=MX3(C0[0],C0[1],C1[0]),b=MX3(C0[2],C0[3],C1[1]); a=MX3(a,C1[2],C1[3]); \
      _Pragma("unroll") for(int r=4;r<16;r+=4){a=MX3(a,C0[r],C0[r+1]);b=MX3(b,C0[r+2],C0[r+3]);a=MX3(a,C1[r],C1[r+1]);b=MX3(b,C1[r+2],C1[r+3]);} \
      float rm=__builtin_fmaxf(a,b); { auto rr=__builtin_amdgcn_permlane32_swap(__float_as_uint(rm),__float_as_uint(rm),false,false); rm=__builtin_fmaxf(__uint_as_float(rr[0]),__uint_as_float(rr[1])); } \
      resc=false; \
      if(__builtin_expect(__any(rm>(float)THRL),0)){ const float dl=__builtin_fmaxf(rm,0.f); mhat+=dl; \
        _Pragma("unroll") for(int r=0;r<16;++r){C0[r]-=dl;C1[r]-=dl;} \
        const float f=__builtin_amdgcn_exp2f(-dl); l_reg*=f; if(hi==0)wsf[r32]=f; resc=true; } } \
    SBAR(); \
    { const __attribute__((address_space(3))) f32x4* cbp_=(const __attribute__((address_space(3))) f32x4*)(cb3+((t)+1)*256+hi*16); \
      _Pragma("unroll") for(int a_=0;a_<4;++a_){ const f32x4 u0_=cbp_[2*a_], u1_=cbp_[8+2*a_]; \
        P0[4*a_]=u0_[0];P0[4*a_+1]=u0_[1];P0[4*a_+2]=u0_[2];P0[4*a_+3]=u0_[3]; P1[4*a_]=u1_[0];P1[4*a_+1]=u1_[1];P1[4*a_+2]=u1_[2];P1[4*a_+3]=u1_[3]; } } SBAR(); \
    GAPB(o[0]=__builtin_amdgcn_mfma_f32_32x32x16_bf16(PAF(0),VFR(0),o[0],0,0,0), C0,0); \
    GAPB(o[1]=__builtin_amdgcn_mfma_f32_32x32x16_bf16(PAF(0),VFR(4),o[1],0,0,0), C0,4); \
    KRD(GL,0); GAPB(o[0]=__builtin_amdgcn_mfma_f32_32x32x16_bf16(PAF(1),VFR(1),o[0],0,0,0), C0,8); \
    KRD(GL,1); GAPB(o[1]=__builtin_amdgcn_mfma_f32_32x32x16_bf16(PAF(1),VFR(5),o[1],0,0,0), C0,12); \
    KRD(GL,2); GAPB(o[0]=__builtin_amdgcn_mfma_f32_32x32x16_bf16(PAF(2),VFR(2),o[0],0,0,0), C1,0); \
    KRD(GL,3); GAPB(o[1]=__builtin_amdgcn_mfma_f32_32x32x16_bf16(PAF(2),VFR(6),o[1],0,0,0), C1,4); \
    GAPB(o[0]=__builtin_amdgcn_mfma_f32_32x32x16_bf16(PAF(3),VFR(3),o[0],0,0,0), C1,8); \
    GAPB(o[1]=__builtin_amdgcn_mfma_f32_32x32x16_bf16(PAF(3),VFR(7),o[1],0,0,0), C1,12); \
    _Pragma("unroll") for(int r_=0;r_<16;++r_){P0[r_]-=mhat;P1[r_]-=mhat;} \
    }while(0)
  { const __attribute__((address_space(3))) f32x4* cbp_=(const __attribute__((address_space(3))) f32x4*)(cb3+256+hi*16);
    #pragma unroll
    for(int a_=0;a_<4;++a_){ const f32x4 u0_=cbp_[2*a_], u1_=cbp_[8+2*a_];
      pB0[4*a_]=u0_[0]-mhat;pB0[4*a_+1]=u0_[1]-mhat;pB0[4*a_+2]=u0_[2]-mhat;pB0[4*a_+3]=u0_[3]-mhat;
      pB1[4*a_]=u1_[0]-mhat;pB1[4*a_+1]=u1_[1]-mhat;pB1[4*a_+2]=u1_[2]-mhat;pB1[4*a_+3]=u1_[3]-mhat; } }
  int t=1;
  #undef CMASK
  #define CMASK(P0,P1,t) do{}while(0)
  for(;t+5<NT;t+=2){
    STEP(pB0,pB1,pA0,pA1,t,true,true,true);     WAIT_BAR(2); RESC(); ROT();
    STEP(pA0,pA1,pB0,pB1,t+1,true,true,true);   WAIT_BAR(2); RESC(); ROT();
  }
  #undef CMASK
  #define CMASK(P0,P1,t) do{int jb_=(t)-(NT-4); if(jb_>=0)cmask(P0,P1,jb_,qrel,hi);}while(0)
  #define ENDW(tt) do{ if((tt)+3<NT){WAIT_BAR(2);} else if((tt)+2<NT){WAIT_BAR(1);} else {WAIT_BAR(0);} }while(0)
  for(;t+1<NT;t+=2){
    STEP(pB0,pB1,pA0,pA1,t,(t+3<NT),(t+1<NT),(t+1<NT));       ENDW(t);   RESC(); ROT();
    STEP(pA0,pA1,pB0,pB1,t+1,(t+4<NT),(t+2<NT),(t+2<NT));     ENDW(t+1); RESC(); ROT();
  }
  STEP(pB0,pB1,pA0,pA1,NT-1,false,false,false); RESC();
  { float sacc=pB0[0]+pB0[1]; _Pragma("unroll") for(int r=2;r<16;++r)sacc+=pB0[r]; _Pragma("unroll") for(int r=0;r<16;++r)sacc+=pB1[r]; l_reg+=sacc;
    pw0=(u32x4){PKW(pB0,0),PKW(pB0,2),PKW(pB0,4),PKW(pB0,6)};pw1=(u32x4){PKW(pB0,8),PKW(pB0,10),PKW(pB0,12),PKW(pB0,14)};pw2=(u32x4){PKW(pB1,0),PKW(pB1,2),PKW(pB1,4),PKW(pB1,6)};pw3=(u32x4){PKW(pB1,8),PKW(pB1,10),PKW(pB1,12),PKW(pB1,14)};
    SBAR(); pv(o,vb0+sl_cur,PAF(0),PAF(1),PAF(2),PAF(3)); }
  #undef PKW
  #undef PAF
  #undef VFR
  #undef PIN
  #undef MX3
  #undef GAPA
  #undef GAPB
  #undef EX
  #undef VRD
  #undef KRD
  #undef STEP
  #undef ENDW
  {auto rr=__builtin_amdgcn_permlane32_swap(__float_as_uint(l_reg),__float_as_uint(l_reg),false,false);l_reg=__uint_as_float(rr[0])+__uint_as_float(rr[1]);}
  if(hi==0)wsf[32+r32]=l_reg;asm volatile("s_waitcnt lgkmcnt(0)":::"memory");
  float rli[16];
  #pragma unroll
  for(int r=0;r<16;++r)rli[r]=__builtin_amdgcn_rcpf(wsf[32+crow(r,hi)]);
  bf16*Ow=O+(rowbase+q0+wid*QBLK)*OPITCH+h*D;
  { bf16*stg=(bf16*)(shm+LDS_OST)+wid*2048;
    #pragma unroll
    for(int r=0;r<16;++r){const int orow=crow(r,hi);
      #pragma unroll
      for(int d0=0;d0<2;++d0)stg[orow*64+d0*32+r32]=__float2bfloat16(o[d0][r]*rli[r]);}
    asm volatile("s_waitcnt lgkmcnt(0)":::"memory");
    #pragma unroll
    for(int i=0;i<4;++i){const int row=i*8+(lane>>3),ch=lane&7; const u32x4 v=*(const u32x4*)(stg+row*64+ch*8); bf16*dst=Ow+(long)row*OPITCH+ch*8; const u32x4 gv=*(const u32x4*)dst; u32x4 w;
      #pragma unroll
      for(int j=0;j<4;++j){ const float a0=__uint_as_float(v[j]<<16)*__uint_as_float(gv[j]<<16), a1=__uint_as_float(v[j]&0xffff0000u)*__uint_as_float(gv[j]&0xffff0000u); w[j]=cvtpk_s(a0,a1); }
      if(!dry)*(u32x4*)dst=w;} }
  asm volatile("s_waitcnt lgkmcnt(0)\n\ts_barrier":::"memory");
  #undef DMA_K
  #undef DMA_V
  #undef CMASK
  #undef START
  #undef RESC
  #undef ROT
}
constexpr int ATTN_LDS_BYTES=LDS_BYTES;
struct AttnTensors { const bf16* Q; const bf16* K; const bf16* V; bf16* O; const float* CB; const float* NRM; };
struct AttnUnit { int bh; int qb; };
struct StaticOrder {
  int vcu;
  __device__ __forceinline__ explicit StaticOrder(int grid,int block):vcu((block%8)*(grid/8)+block/8){}
  __device__ __forceinline__ bool next(int i,AttnUnit&u)const{ if(i>=2)return false; const int s=vcu&7; u.bh=vcu>>3; u.qb=(i==0)?15-s:s; return true; }
  __device__ __forceinline__ void a_ready(const AttnUnit&)const{}
  __device__ __forceinline__ void done(const AttnUnit&)const{}
};
template<class Sched,int THRL=8> __device__ __forceinline__ void attn_phase(char*lds,const AttnTensors&T,const Sched&S,bool dry=false){
  AttnUnit u;
  for(int i=0;S.next(i,u);++i){ S.a_ready(u); attn_unit<THRL>(u.bh/NHEAD,u.bh%NHEAD,u.qb,T.Q,T.K,T.V,T.O,T.CB,T.NRM,lds,dry); S.done(u); }
}
#undef SBAR
#undef WAIT_BAR
}
#include <hip/hip_cooperative_groups.h>
namespace cg = cooperative_groups;
#define LAS __attribute__((address_space(3)))
typedef unsigned short bf16;
typedef float f32x4 __attribute__((ext_vector_type(4)));
typedef float f32x2 __attribute__((ext_vector_type(2)));
typedef unsigned u32x4 __attribute__((ext_vector_type(4)));
typedef unsigned u32x2 __attribute__((ext_vector_type(2)));
typedef short bf16x8 __attribute__((ext_vector_type(8)));
typedef short bf16x4 __attribute__((ext_vector_type(4)));

constexpr int NWAVES = 8, NTHR = 512;
constexpr int BATCH = 4, SEQ = 4096, DM = 1024, DEPTH = 4, M = BATCH * SEQ;
constexpr int NIN = 3592, NF = 3584;
constexpr int T5 = 32, NCH5 = M / T5, KA5 = 640, NG5 = 16;
constexpr float EPS = 1e-6f;
constexpr float LOG2E = 1.4426950408889634f;

constexpr size_t MiB = 1u << 20;
constexpr size_t WS_WIN = 1 * MiB, WS_WO = 31 * MiB, WS_WGLU = 39 * MiB, WS_ROPE = 40 * MiB, WS_MF = 41 * MiB, WS_WB = 81 * MiB;
constexpr size_t WS_LAM = 90 * MiB, WS_LOGF = 90 * MiB + 65536, WS_CB = WS_LOGF + 524288, WS_SS = WS_CB + 524288, WS_NRM = WS_SS + 131072, WS_XBUF = WS_NRM + 4096;
constexpr size_t WS_XN = 92 * MiB, WS_E = WS_XN, WS_UPD = WS_XN + 4 * MiB, WS_STATE = WS_XN + 20 * MiB;
constexpr size_t WS_QO = 124 * MiB, WS_KB = 140 * MiB, WS_VB = 156 * MiB, WS_SUA = 172 * MiB, WS_RQ = 182 * MiB, WS_RK = 190 * MiB, WS_RKT = 198 * MiB, WS_YS5 = WS_RKT;
constexpr size_t WS_RVT = 206 * MiB, WS_GATE = 214 * MiB, WS_END = 246 * MiB;

constexpr int RING_BYTES = 131072, LDS_BYTES = 147456;

struct Args { const float* in[16]; float* out; unsigned char* ws; };

__device__ __forceinline__ float bf2f(unsigned short b) { return __uint_as_float((unsigned)b << 16); }
__device__ __forceinline__ float bflo(unsigned w) { return __uint_as_float(w << 16); }
__device__ __forceinline__ float bfhi(unsigned w) { return __uint_as_float(w & 0xffff0000u); }
__device__ __forceinline__ unsigned pk2(float lo, float hi) { return pg8::cvt_pk_bf16(lo, hi); }
__device__ __forceinline__ unsigned short f2bf(float f) { return (unsigned short)(pg8::cvt_pk_bf16(f, 0.f) & 0xffffu); }
__device__ __forceinline__ float wave_sum(float v) {
#pragma unroll
    for (int o = 1; o < 64; o <<= 1) v += __shfl_xor(v, o);
    return v;
}
__device__ __forceinline__ float lg2_gamma(int hh) { return __builtin_amdgcn_logf(1.0f - __builtin_amdgcn_exp2f(-5.0f - (float)hh)); }

__device__ __forceinline__ int win_col(int n) {
    if (n < 1536) return n;
    if (n < 1792) return n + 8;
    if (n < 2304) { const bool q = n < 2048; const int base = q ? 1792 : 2048; const int hh = (n - base) >> 6, pos = (n - base) & 63; const int d = (pos & 1) ? 32 + (pos >> 1) : (pos >> 1); return (q ? 1800 : 2056) + hh * 64 + d; }
    return n + 8;
}
template <bool MAP> __device__ __forceinline__ void p0_transpose_item(const float* W, int K, int Nsrc, int Ndst, bf16* WT, LAS float* scr, int item, int lane) {
    const int nblk = Ndst / 32, kb = item / nblk, nb = item % nblk, k0 = 64 * kb, n0 = 32 * nb;
    const int sc = MAP ? win_col(n0 + (lane & 31)) : n0 + (lane & 31);
    float wv[32];
#pragma unroll
    for (int i = 0; i < 32; ++i) { const int kk = 2 * i + (lane >> 5); wv[i] = (MAP && sc < 0) ? 0.f : W[(size_t)(k0 + kk) * Nsrc + (sc < 0 ? 0 : sc)]; }
#pragma unroll
    for (int i = 0; i < 32; ++i) { const int kk = 2 * i + (lane >> 5); scr[kk * 33 + (lane & 31)] = wv[i]; }
    asm volatile("s_waitcnt lgkmcnt(0)" ::: "memory");
    const int c = lane & 7;
#pragma unroll
    for (int j = 0; j < 4; ++j) { const int n = (lane >> 3) + 8 * j; const LAS float* s = scr + (8 * c) * 33 + n;
        u32x4 o; o.x = pk2(s[0 * 33], s[1 * 33]); o.y = pk2(s[2 * 33], s[3 * 33]); o.z = pk2(s[4 * 33], s[5 * 33]); o.w = pk2(s[6 * 33], s[7 * 33]);
        *(u32x4*)(WT + (size_t)(n0 + n) * K + k0 + 8 * c) = o; }
    asm volatile("s_waitcnt lgkmcnt(0)" ::: "memory");
}

__device__ __forceinline__ void s5_prep(const Args& a, int l, int g, LAS float* L, int tid) {
    LAS float* LPr = L;
    LAS float* LPi = L + 33 * 64;
    LAS float* Bbr = L + 66 * 64;
    LAS float* Bbi = Bbr + 1024;
    LAS float* Cr = Bbi + 1024;
    LAS float* Ci = Cr + 1024;
    LAS float* KT = Ci + 1024;
    const float* a_re = a.in[4] + (size_t)(l * 16 + g) * 64; const float* a_im = a.in[5] + (size_t)(l * 16 + g) * 64;
    const float* b_re = a.in[6] + (size_t)(l * 16 + g) * 1024; const float* b_im = a.in[7] + (size_t)(l * 16 + g) * 1024;
    const float* c_re = a.in[8] + (size_t)(l * 16 + g) * 1024; const float* c_im = a.in[9] + (size_t)(l * 16 + g) * 1024;
    const float log_dt = a.in[11][l * 16 + g];
    bf16* MF = (bf16*)(a.ws + WS_MF) + (size_t)(l * 16 + g) * 512 * KA5;
    bf16* WB = (bf16*)(a.ws + WS_WB) + (size_t)(l * 16 + g) * 128 * 512;
    float* LAM = (float*)(a.ws + WS_LAM) + (size_t)(l * 16 + g) * 128;
    if (tid < 64) {
        const int p = tid;
        const double dt = exp((double)log_dt), ar = (double)a_re[p], ai = (double)a_im[p];
        const double mag = exp(ar * dt); double sn, cs; sincos(ai * dt, &sn, &cs);
        const double lr = mag * cs, li = mag * sn, den = ar * ar + ai * ai;
        const double fr = ((lr - 1.0) * ar + li * ai) / den, fi = (li * ar - (lr - 1.0) * ai) / den;
#pragma unroll 4
        for (int h = 0; h < 16; ++h) { const double br = (double)b_re[p * 16 + h], bi = (double)b_im[p * 16 + h]; Bbr[p * 16 + h] = (float)(fr * br - fi * bi); Bbi[p * 16 + h] = (float)(fr * bi + fi * br); }
        double pr = 1.0, pi = 0.0;
        for (int j = 0; j <= 32; ++j) { LPr[j * 64 + p] = (float)pr; LPi[j * 64 + p] = (float)pi; const double nr = pr * lr - pi * li, ni = pr * li + pi * lr; pr = nr; pi = ni; }
        LAM[p] = LPr[32 * 64 + p]; LAM[64 + p] = LPi[32 * 64 + p];
    }
    for (int i = tid; i < 1024; i += NTHR) { const int h = i >> 6, p = i & 63; Cr[p * 16 + h] = c_re[i]; Ci[p * 16 + h] = c_im[i]; }
    __syncthreads();
    { const int j = tid >> 4, h = tid & 15; float acc[16];
#pragma unroll
      for (int e = 0; e < 16; ++e) acc[e] = 0.f;
      for (int p = 0; p < 64; ++p) { const float cr = Cr[p * 16 + h], ci = Ci[p * 16 + h], lr = LPr[j * 64 + p], li = LPi[j * 64 + p]; const float clr = cr * lr - ci * li, cli = cr * li + ci * lr;
#pragma unroll
          for (int q = 0; q < 4; ++q) { const f32x4 br = *(const LAS f32x4*)(Bbr + p * 16 + 4 * q), bi = *(const LAS f32x4*)(Bbi + p * 16 + 4 * q);
              acc[4 * q] += clr * br.x - cli * bi.x; acc[4 * q + 1] += clr * br.y - cli * bi.y; acc[4 * q + 2] += clr * br.z - cli * bi.z; acc[4 * q + 3] += clr * br.w - cli * bi.w; } }
#pragma unroll
      for (int e = 0; e < 16; ++e) KT[tid * 16 + e] = acc[e]; }
    __syncthreads();
    for (int q = tid; q < 512 * 64; q += NTHR) {
        const int row = q >> 6, cp = q & 63, s = cp >> 1, h0 = (cp & 1) * 8, t = row >> 4, h = row & 15;
        u32x4 o = (u32x4){0u, 0u, 0u, 0u};
        if (s <= t) { const LAS float* k = KT + ((t - s) * 16 + h) * 16 + h0; o.x = pk2(k[0], k[1]); o.y = pk2(k[2], k[3]); o.z = pk2(k[4], k[5]); o.w = pk2(k[6], k[7]); }
        *(u32x4*)(MF + (size_t)row * KA5 + cp * 8) = o;
    }
    for (int q = tid; q < 512 * 16; q += NTHR) {
        const int row = q >> 4, cp = q & 15, t = row >> 4, h = row & 15; float v[8];
#pragma unroll
        for (int e = 0; e < 8; ++e) { const int jj = cp * 8 + e, p = jj & 63; const float cr = Cr[p * 16 + h], ci = Ci[p * 16 + h], lr = LPr[(t + 1) * 64 + p], li = LPi[(t + 1) * 64 + p];
            v[e] = (jj < 64) ? (cr * lr - ci * li) : -(cr * li + ci * lr); }
        u32x4 o; o.x = pk2(v[0], v[1]); o.y = pk2(v[2], v[3]); o.z = pk2(v[4], v[5]); o.w = pk2(v[6], v[7]);
        *(u32x4*)(MF + (size_t)row * KA5 + 512 + cp * 8) = o;
    }
    for (int q = tid; q < 128 * 64; q += NTHR) {
        const int j = q >> 6, cp = q & 63, s = cp >> 1, h0 = (cp & 1) * 8, p = j & 63; const float lr = LPr[(31 - s) * 64 + p], li = LPi[(31 - s) * 64 + p]; float v[8];
#pragma unroll
        for (int e = 0; e < 8; ++e) { const float br = Bbr[p * 16 + h0 + e], bi = Bbi[p * 16 + h0 + e]; v[e] = (j < 64) ? (lr * br - li * bi) : (lr * bi + li * br); }
        u32x4 o; o.x = pk2(v[0], v[1]); o.y = pk2(v[2], v[3]); o.z = pk2(v[4], v[5]); o.w = pk2(v[6], v[7]);
        *(u32x4*)(WB + (size_t)j * 512 + cp * 8) = o;
    }
    __syncthreads();
}

__device__ __forceinline__ void norm0_phase(const Args& a, int lane, int gw, int NGW) {
    const float* X = a.in[0]; f32x4 gv[4];
#pragma unroll
    for (int j = 0; j < 4; ++j) gv[j] = *((const f32x4*)a.in[1] + lane + 64 * j);
    bf16* XN = (bf16*)(a.ws + WS_XN); float* SS = (float*)(a.ws + WS_SS);
    for (int m = gw; m < M; m += 2 * NGW) {
        const int m2 = m + NGW; const bool has2 = m2 < M;
        const f32x4* xr = (const f32x4*)(X + (size_t)m * DM) + lane; const f32x4* xr2 = (const f32x4*)(X + (size_t)(has2 ? m2 : m) * DM) + lane; f32x4 v[4], w[4];
#pragma unroll
        for (int j = 0; j < 4; ++j) { v[j] = xr[64 * j]; w[j] = xr2[64 * j]; }
        float ss = 0.f, ss2 = 0.f;
#pragma unroll
        for (int j = 0; j < 4; ++j) { ss += (v[j].x * v[j].x + v[j].y * v[j].y) + (v[j].z * v[j].z + v[j].w * v[j].w); ss2 += (w[j].x * w[j].x + w[j].y * w[j].y) + (w[j].z * w[j].z + w[j].w * w[j].w); }
        ss = wave_sum(ss); ss2 = wave_sum(ss2);
        unsigned long long* o8 = (unsigned long long*)(XN + (size_t)m * DM) + lane; unsigned long long* o82 = (unsigned long long*)(XN + (size_t)m2 * DM) + lane;
        const float r1_ = rsqrtf(ss * (1.f / DM) + EPS), r2_ = rsqrtf(ss2 * (1.f / DM) + EPS);
#pragma unroll
        for (int j = 0; j < 4; ++j) { v[j] = v[j] * gv[j] * r1_; o8[64 * j] = (unsigned long long)pk2(v[j].x, v[j].y) | ((unsigned long long)pk2(v[j].z, v[j].w) << 32);
            if (has2) { w[j] = w[j] * gv[j] * r2_; o82[64 * j] = (unsigned long long)pk2(w[j].x, w[j].y) | ((unsigned long long)pk2(w[j].z, w[j].w) << 32); } }
        if (lane == 0) { SS[m] = ss; if (has2) SS[m2] = ss2; }
    }
}
__device__ __forceinline__ void final_norm(const Args& a, float* X, const float* SS, int lane, int gw, int NGW) {
    f32x4 gv[4];
#pragma unroll
    for (int j = 0; j < 4; ++j) gv[j] = *((const f32x4*)a.in[15] + lane + 64 * j);
    for (int m = gw; m < M; m += 2 * NGW) {
        const int m2 = m + NGW; const bool has2 = m2 < M;
        f32x4* xr = (f32x4*)(X + (size_t)m * DM) + lane; f32x4* xr2 = (f32x4*)(X + (size_t)(has2 ? m2 : m) * DM) + lane; f32x4 v[4], w[4];
#pragma unroll
        for (int j = 0; j < 4; ++j) { v[j] = xr[64 * j]; w[j] = xr2[64 * j]; }
        const float r1 = rsqrtf(SS[m] * (1.f / DM) + EPS), r2 = rsqrtf(SS[has2 ? m2 : m] * (1.f / DM) + EPS);
#pragma unroll
        for (int j = 0; j < 4; ++j) { xr[64 * j] = v[j] * r1 * gv[j]; if (has2) xr2[64 * j] = w[j] * r2 * gv[j]; }
    }
}

__device__ __forceinline__ void flog_phase(const Args& a, int l, const float* SS, LAS float* WF, int tid, int lane, int wave, int blk, int nblk) {
    const float* win = a.in[2] + (size_t)l * DM * NIN;
    for (int i = tid; i < 2048; i += NTHR) { const int k = i >> 1, hf = i & 1; *(LAS f32x4*)(WF + k * 8 + hf * 4) = *(const f32x4*)(win + (size_t)k * NIN + 1536 + hf * 4); }
    __syncthreads();
    const bf16* XN = (const bf16*)(a.ws + WS_XN); float* LOGF = (float*)(a.ws + WS_LOGF);
    const float bfj = (lane < 8) ? a.in[3][l * 8 + lane] : 0.f;
    const int rows_per = M / nblk;
    for (int i = wave; i < rows_per; i += 2 * NWAVES) {
        const int m = blk * rows_per + i, m2 = m + NWAVES; const bool has2 = (i + NWAVES) < rows_per;
        const u32x4 x0 = *((const u32x4*)(XN + (size_t)m * DM) + lane), x1 = *((const u32x4*)(XN + (size_t)m * DM + 512) + lane);
        const u32x4 y0 = *((const u32x4*)(XN + (size_t)(has2 ? m2 : m) * DM) + lane), y1 = *((const u32x4*)(XN + (size_t)(has2 ? m2 : m) * DM + 512) + lane);
        float acc[8], acc2[8];
#pragma unroll
        for (int e = 0; e < 8; ++e) { acc[e] = 0.f; acc2[e] = 0.f; }
#pragma unroll
        for (int hf = 0; hf < 2; ++hf)
#pragma unroll
            for (int q = 0; q < 8; ++q) { const int k = 512 * hf + 8 * lane + q; const f32x4 w0 = *(const LAS f32x4*)(WF + k * 8), w1 = *(const LAS f32x4*)(WF + k * 8 + 4);
                const unsigned xw = hf ? x1[q >> 1] : x0[q >> 1], yw = hf ? y1[q >> 1] : y0[q >> 1]; const float hv = (q & 1) ? bfhi(xw) : bflo(xw), hv2 = (q & 1) ? bfhi(yw) : bflo(yw);
                acc[0] += hv * w0.x; acc[1] += hv * w0.y; acc[2] += hv * w0.z; acc[3] += hv * w0.w; acc[4] += hv * w1.x; acc[5] += hv * w1.y; acc[6] += hv * w1.z; acc[7] += hv * w1.w;
                acc2[0] += hv2 * w0.x; acc2[1] += hv2 * w0.y; acc2[2] += hv2 * w0.z; acc2[3] += hv2 * w0.w; acc2[4] += hv2 * w1.x; acc2[5] += hv2 * w1.y; acc2[6] += hv2 * w1.z; acc2[7] += hv2 * w1.w; }
        float mine = 0.f, mine2 = 0.f;
#pragma unroll
        for (int e = 0; e < 8; ++e) { const float s = wave_sum(acc[e]), s2 = wave_sum(acc2[e]); if (lane == e) { mine = s; mine2 = s2; } }
        if (lane < 8) { const float z = mine + bfj; LOGF[(size_t)((m >> 12) * 8 + lane) * SEQ + (m & 4095)] = fminf(z, 0.f) - log1pf(expf(-fabsf(z)));
            if (has2) { const float z2 = mine2 + bfj; LOGF[(size_t)((m2 >> 12) * 8 + lane) * SEQ + (m2 & 4095)] = fminf(z2, 0.f) - log1pf(expf(-fabsf(z2))); } }
    }
}

__device__ __forceinline__ bool opaque_true() { int d = 1; asm volatile("" : "+s"(d)); return d != 0; }
struct RangeOrder {
    pg8::StaticOrder S; int lo, hi;
    __device__ bool next(int i, pg8::Unit& u) const { return (lo + i < hi) ? S.next(lo + i, u) : false; }
    __device__ __forceinline__ void a_ready(const pg8::Unit&) const {}
    __device__ __forceinline__ void done(const pg8::Unit&) const {}
};
struct FlatOrder {
    int nM, nN, nG, G, c;
    __device__ bool next(int i, pg8::Unit& u) const { const int L = i * G + c; if (L >= nG * nM * nN) return false; u.gz = L / (nM * nN); const int r = L % (nM * nN); u.pm = r % nM; u.pn = r / nM; return true; }
    __device__ __forceinline__ void a_ready(const pg8::Unit&) const {}
    __device__ __forceinline__ void done(const pg8::Unit&) const {}
};
__device__ __forceinline__ float silu_f(float v) { return v * __builtin_amdgcn_rcpf(1.f + __expf(-v)); }
__device__ __forceinline__ float gelu_tanh(float v) { const float u = 0.7978845608028654f * (v + 0.044715f * v * v * v); const float e = __expf(2.f * u); const float th = 1.f - 2.f * __builtin_amdgcn_rcpf(e + 1.f); return 0.5f * v * (1.f + th); }

struct EpiInProj {
    static constexpr bool PERM = true, AFTER_DRAIN = false;
    unsigned char* ws; const float* SS; const float* bfl;
    __device__ __forceinline__ void operator()(const pg8::f32x4 (&acc)[2][2][4][2], const pg8::Unit& u, int wr, int wc, int fr, int fq) const {
        const int pn = u.pn; const int row0 = u.pm * 256 + wr * 64 + fr, cl0 = wc * 32 + 8 * fq;
        float rs[2][4];
#pragma unroll
        for (int ai = 0; ai < 2; ++ai)
#pragma unroll
            for (int m = 0; m < 4; ++m) rs[ai][m] = 1.f;
        if (pn == 14) {
            if (wc == 0 && fq == 0) { float* LOGF = (float*)(ws + WS_LOGF); const f32x4 b0 = *(const f32x4*)bfl, b1 = *(const f32x4*)(bfl + 4);
#pragma unroll
                for (int ai = 0; ai < 2; ++ai)
#pragma unroll
                    for (int m = 0; m < 4; ++m) { const int row = row0 + ai * 128 + m * 16; const float r = rs[ai][m]; const pg8::f32x4 v0 = acc[ai][0][m][0], v1 = acc[ai][0][m][1];
                        float z[8] = {v0[0] * r + b0.x, v0[1] * r + b0.y, v0[2] * r + b0.z, v0[3] * r + b0.w, v1[0] * r + b1.x, v1[1] * r + b1.y, v1[2] * r + b1.z, v1[3] * r + b1.w};
#pragma unroll
                        for (int e = 0; e < 8; ++e) LOGF[(size_t)((row >> 12) * 8 + e) * SEQ + (row & 4095)] = fminf(z[e], 0.f) - log1pf(__expf(-fabsf(z[e]))); } }
            return;
        }
        if (pn < 6) {
            bf16* base = (bf16*)(ws + (pn < 2 ? WS_QO : pn < 4 ? WS_KB : WS_VB)); const float sc = pn < 2 ? 0.125f * LOG2E : 1.f; const int cb = (pn & 1) * 256 + cl0;
#pragma unroll
            for (int ai = 0; ai < 2; ++ai)
#pragma unroll
                for (int m = 0; m < 4; ++m) { bf16* rp = base + (size_t)(row0 + ai * 128 + m * 16) * 512 + cb;
#pragma unroll
                    for (int bj = 0; bj < 2; ++bj) { const float sr = sc * rs[ai][m]; const pg8::f32x4 v0 = acc[ai][bj][m][0] * sr, v1 = acc[ai][bj][m][1] * sr; u32x4 w; w.x = pk2(v0[0], v0[1]); w.y = pk2(v0[2], v0[3]); w.z = pk2(v1[0], v1[1]); w.w = pk2(v1[2], v1[3]); *(u32x4*)(rp + bj * 128) = w; } }
        } else if (pn == 6) {
            bf16* base = (bf16*)(ws + WS_SUA);
#pragma unroll
            for (int ai = 0; ai < 2; ++ai)
#pragma unroll
                for (int m = 0; m < 4; ++m) { const int row = row0 + ai * 128 + m * 16, chunk = row >> 5, t = row & 31;
#pragma unroll
                    for (int bj = 0; bj < 2; ++bj) { const int c = cl0 + bj * 128, g = c >> 4, h0 = c & 15; const pg8::f32x4 v0 = acc[ai][bj][m][0] * rs[ai][m], v1 = acc[ai][bj][m][1] * rs[ai][m]; u32x4 w; w.x = pk2(v0[0], v0[1]); w.y = pk2(v0[2], v0[3]); w.z = pk2(v1[0], v1[1]); w.w = pk2(v1[2], v1[3]);
                        *(u32x4*)(base + ((size_t)(g * 512 + chunk) * KA5 + t * 16 + h0)) = w; } }
        } else if (pn == 7 || pn == 8) {
            const f32x4* rope = (const f32x4*)(ws + WS_ROPE); bf16* base = (bf16*)(ws + (pn == 7 ? WS_RQ : WS_RK)); bf16* RKT = (bf16*)(ws + WS_RKT);
#pragma unroll
            for (int ai = 0; ai < 2; ++ai)
#pragma unroll
                for (int m = 0; m < 4; ++m) { const int row = row0 + ai * 128 + m * 16, b = row >> 12, t = row & 4095;
#pragma unroll
                    for (int bj = 0; bj < 2; ++bj) { const int c = cl0 + bj * 128, hh = c >> 6, pos0 = c & 63; const pg8::f32x4 v0 = acc[ai][bj][m][0] * rs[ai][m], v1 = acc[ai][bj][m][1] * rs[ai][m];
                        const f32x4 r0 = rope[(t * 32 + (pos0 >> 1)) >> 1], r1 = rope[((t * 32 + (pos0 >> 1)) >> 1) + 1];
                        float o[8];
                        o[0] = v0[0] * r0.x - v0[1] * r0.y; o[1] = v0[0] * r0.y + v0[1] * r0.x; o[2] = v0[2] * r0.z - v0[3] * r0.w; o[3] = v0[2] * r0.w + v0[3] * r0.z;
                        o[4] = v1[0] * r1.x - v1[1] * r1.y; o[5] = v1[0] * r1.y + v1[1] * r1.x; o[6] = v1[2] * r1.z - v1[3] * r1.w; o[7] = v1[2] * r1.w + v1[3] * r1.z;
                        u32x4 w; w.x = pk2(o[0], o[1]); w.y = pk2(o[2], o[3]); w.z = pk2(o[4], o[5]); w.w = pk2(o[6], o[7]);
                        *(u32x4*)(base + (size_t)row * 256 + c) = w;
                        if (pn == 8) { const float wk = __builtin_amdgcn_exp2f(lg2_gamma(hh) * (float)(63 - (t & 63))); bf16* tp = RKT + ((size_t)((b * 4 + hh) * 64 + pos0)) * SEQ + t;
#pragma unroll
                            for (int e = 0; e < 8; ++e) tp[(size_t)e * SEQ] = f2bf(o[e] * wk); } } }
        } else if (pn == 9) {
            bf16* RVT = (bf16*)(ws + WS_RVT);
#pragma unroll
            for (int ai = 0; ai < 2; ++ai)
#pragma unroll
                for (int m = 0; m < 4; ++m) { const int row = row0 + ai * 128 + m * 16, b = row >> 12, t = row & 4095;
#pragma unroll
                    for (int bj = 0; bj < 2; ++bj) { const int c = cl0 + bj * 128, hh = c >> 6, d0 = c & 63; const pg8::f32x4 v0 = acc[ai][bj][m][0] * rs[ai][m], v1 = acc[ai][bj][m][1] * rs[ai][m]; bf16* tp = RVT + ((size_t)((b * 4 + hh) * 64 + d0)) * SEQ + t;
#pragma unroll
                        for (int e = 0; e < 4; ++e) { tp[(size_t)e * SEQ] = f2bf(v0[e]); tp[(size_t)(4 + e) * SEQ] = f2bf(v1[e]); } } }
        } else {
            bf16* base = (bf16*)(ws + WS_GATE); const int cb = (pn - 10) * 256 + cl0;
#pragma unroll
            for (int ai = 0; ai < 2; ++ai)
#pragma unroll
                for (int m = 0; m < 4; ++m) { bf16* rp = base + (size_t)(row0 + ai * 128 + m * 16) * 1024 + cb;
#pragma unroll
                    for (int bj = 0; bj < 2; ++bj) { const pg8::f32x4 v0 = acc[ai][bj][m][0] * rs[ai][m], v1 = acc[ai][bj][m][1] * rs[ai][m]; u32x4 w; w.x = pk2(silu_f(v0[0]), silu_f(v0[1])); w.y = pk2(silu_f(v0[2]), silu_f(v0[3])); w.z = pk2(silu_f(v1[0]), silu_f(v1[1])); w.w = pk2(silu_f(v1[2]), silu_f(v1[3])); *(u32x4*)(rp + bj * 128) = w; } }
        }
    }
};
struct EpiS5E {
    static constexpr bool PERM = false, AFTER_DRAIN = false;
    float* E;
    __device__ __forceinline__ void operator()(const pg8::f32x4 (&acc)[2][2][4][2], const pg8::Unit& u, int wr, int wc, int fr, int fq) const {
        const int row0 = u.pm * 256 + wr * 64 + fr, col0 = wc * 32 + 4 * fq;
#pragma unroll
        for (int ai = 0; ai < 2; ++ai)
#pragma unroll
            for (int m = 0; m < 4; ++m) { float* rp = E + ((size_t)u.gz * NCH5 + row0 + ai * 128 + m * 16) * 128 + col0;
#pragma unroll
                for (int n = 0; n < 2; ++n) *(pg8::f32x4*)(rp + n * 16) = acc[ai][0][m][n]; }
    }
};
struct EpiS5Y {
    static constexpr bool PERM = true, AFTER_DRAIN = false;
    const bf16* SUA; bf16* YS5; const float* dvec;
    __device__ __forceinline__ void operator()(const pg8::f32x4 (&acc)[2][2][4][2], const pg8::Unit& u, int wr, int wc, int fr, int fq) const {
        const int row0 = u.pm * 256 + wr * 64 + fr, cl0 = u.pn * 256 + wc * 32 + 8 * fq; const int g = u.gz;
#pragma unroll
        for (int bj = 0; bj < 2; ++bj) { const int c = cl0 + bj * 128, tt = c >> 4, h0 = c & 15; const f32x4 d0 = *(const f32x4*)(dvec + g * 16 + h0), d1 = *(const f32x4*)(dvec + g * 16 + h0 + 4);
#pragma unroll
            for (int ai = 0; ai < 2; ++ai)
#pragma unroll
                for (int m = 0; m < 4; ++m) { const int chunk = row0 + ai * 128 + m * 16; const u32x4 uu = *(const u32x4*)(SUA + ((size_t)(g * 512 + chunk) * KA5 + c)); const pg8::f32x4 v0 = acc[ai][bj][m][0], v1 = acc[ai][bj][m][1];
                    float y[8]; y[0] = v0[0] + d0.x * bflo(uu.x); y[1] = v0[1] + d0.y * bfhi(uu.x); y[2] = v0[2] + d0.z * bflo(uu.y); y[3] = v0[3] + d0.w * bfhi(uu.y);
                    y[4] = v1[0] + d1.x * bflo(uu.z); y[5] = v1[1] + d1.y * bfhi(uu.z); y[6] = v1[2] + d1.z * bflo(uu.w); y[7] = v1[3] + d1.w * bfhi(uu.w);
#pragma unroll
                    for (int e = 0; e < 8; ++e) y[e] = gelu_tanh(y[e]);
                    u32x4 w; w.x = pk2(y[0], y[1]); w.y = pk2(y[2], y[3]); w.z = pk2(y[4], y[5]); w.w = pk2(y[6], y[7]);
                    *(u32x4*)(YS5 + (size_t)(chunk * 32 + tt) * 256 + g * 16 + h0) = w; } }
    }
};
struct EpiGlu {
    static constexpr bool PERM = true, AFTER_DRAIN = false;
    const bf16* YS5; bf16* G; bool dry;
    __device__ __forceinline__ void operator()(const pg8::f32x4 (&acc)[2][2][4][2], const pg8::Unit& u, int wr, int wc, int fr, int fq) const {
        const int row0 = u.pm * 256 + wr * 64 + fr, cl0 = wc * 32 + 8 * fq;
#pragma unroll
        for (int ai = 0; ai < 2; ++ai)
#pragma unroll
            for (int m = 0; m < 4; ++m) { const int row = row0 + ai * 128 + m * 16;
#pragma unroll
                for (int bj = 0; bj < 2; ++bj) { const int c = cl0 + bj * 128; const u32x4 yy = *(const u32x4*)(YS5 + (size_t)row * 256 + c); bf16* gp = G + (size_t)row * 1024 + 512 + c; const u32x4 gg = *(const u32x4*)gp;
                    const pg8::f32x4 v0 = acc[ai][bj][m][0], v1 = acc[ai][bj][m][1]; float s[8];
#pragma unroll
                    for (int e = 0; e < 4; ++e) { s[e] = 1.f / (1.f + __expf(-v0[e])); s[4 + e] = 1.f / (1.f + __expf(-v1[e])); }
                    u32x4 w; w.x = pk2(bflo(yy.x) * s[0] * bflo(gg.x), bfhi(yy.x) * s[1] * bfhi(gg.x)); w.y = pk2(bflo(yy.y) * s[2] * bflo(gg.y), bfhi(yy.y) * s[3] * bfhi(gg.y));
                    w.z = pk2(bflo(yy.z) * s[4] * bflo(gg.z), bfhi(yy.z) * s[5] * bfhi(gg.z)); w.w = pk2(bflo(yy.w) * s[6] * bflo(gg.w), bfhi(yy.w) * s[7] * bfhi(gg.w));
                    if (!dry) *(u32x4*)gp = w; } }
    }
};
struct EpiOut {
    static constexpr bool PERM = false, AFTER_DRAIN = false;
    const float* base; float* out; float* SSn; bf16* XN; const float* gnext; bool dry;
    __device__ __forceinline__ void operator()(const pg8::f32x4 (&acc)[2][2][4][2], const pg8::Unit& u, int wr, int wc, int fr, int fq) const {
        const int row0 = u.pm * 256 + wr * 64 + fr, col0 = u.pn * 256 + wc * 32 + 4 * fq;
        f32x4 gq[2][2];
#pragma unroll
        for (int bj = 0; bj < 2; ++bj)
#pragma unroll
            for (int n = 0; n < 2; ++n) gq[bj][n] = gnext ? *(const f32x4*)(gnext + col0 + bj * 128 + n * 16) : (f32x4){0.f, 0.f, 0.f, 0.f};
#pragma unroll
        for (int ai = 0; ai < 2; ++ai)
#pragma unroll
            for (int m = 0; m < 4; ++m) { const int row = row0 + ai * 128 + m * 16; const size_t off = (size_t)row * DM + col0; float sq = 0.f;
#pragma unroll
                for (int bj = 0; bj < 2; ++bj)
#pragma unroll
                    for (int n = 0; n < 2; ++n) { const f32x4 bs = *(const f32x4*)(base + off + bj * 128 + n * 16); const pg8::f32x4 v = acc[ai][bj][m][n]; const f32x4 x = (f32x4){bs.x + v[0], bs.y + v[1], bs.z + v[2], bs.w + v[3]};
                        sq += (x.x * x.x + x.y * x.y) + (x.z * x.z + x.w * x.w);
                        if (!dry) { *(f32x4*)(out + off + bj * 128 + n * 16) = x;
                            if (gnext) { const f32x4 g = gq[bj][n]; u32x2 w; w.x = pk2(x.x * g.x, x.y * g.y); w.y = pk2(x.z * g.z, x.w * g.w); *(u32x2*)(XN + off + bj * 128 + n * 16) = w; } } }
                sq += __shfl_xor(sq, 16); sq += __shfl_xor(sq, 32);
                if (fq == 0 && !dry) __hip_atomic_fetch_add(SSn + row, sq, __ATOMIC_RELAXED, __HIP_MEMORY_SCOPE_AGENT); }
    }
};

template <bool FINAL> struct EpiOutX {
    static constexpr bool PERM = false, AFTER_DRAIN = true;
    const float* base; float* out; const float* wfin; float* xbuf; unsigned* cnt; bf16* XN; unsigned target;
    __device__ __forceinline__ void fused(pg8::f32x4 (&acc)[2][2][4][2], const pg8::Unit& u, int wr, int wc, int fr, int fq, PG8_LAS unsigned char* lds, int wid, int lane) const {
        PG8_LAS float* P = (PG8_LAS float*)lds;
        PG8_LAS float* S = (PG8_LAS float*)(lds + 4096);
        const int col0 = u.pn * 256 + wc * 32 + 4 * fq;
#pragma unroll
        for (int ai = 0; ai < 2; ++ai)
#pragma unroll
            for (int m = 0; m < 4; ++m) { const int r = ai * 128 + wr * 64 + m * 16 + fr; const size_t off = (size_t)(u.pm * 256 + r) * DM + col0; float sq = 0.f;
#pragma unroll
                for (int bj = 0; bj < 2; ++bj)
#pragma unroll
                    for (int n = 0; n < 2; ++n) { const f32x4 bs = *(const f32x4*)(base + off + bj * 128 + n * 16); pg8::f32x4 x = acc[ai][bj][m][n]; x[0] += bs.x; x[1] += bs.y; x[2] += bs.z; x[3] += bs.w; acc[ai][bj][m][n] = x;
                        sq += (x[0] * x[0] + x[1] * x[1]) + (x[2] * x[2] + x[3] * x[3]); }
                sq += __shfl_xor(sq, 16); sq += __shfl_xor(sq, 32);
                if (fq == 0) P[r * 4 + wc] = sq;
                asm volatile("" : "+v"(acc[ai][0][m][0]), "+v"(acc[ai][0][m][1]), "+v"(acc[ai][1][m][0]), "+v"(acc[ai][1][m][1]));
                if (m & 1) asm volatile("" ::: "memory"); }
        asm volatile("s_waitcnt lgkmcnt(0)" ::: "memory"); __builtin_amdgcn_s_barrier(); asm volatile("" ::: "memory");
        const int row = wid * 32 + (lane & 31);
        if (lane < 32) { const float tot = (P[row * 4 + 0] + P[row * 4 + 1]) + (P[row * 4 + 2] + P[row * 4 + 3]);
            __hip_atomic_store(xbuf + (size_t)(u.pm * 256 + row) * 4 + u.pn, tot, __ATOMIC_RELAXED, __HIP_MEMORY_SCOPE_AGENT); }
        asm volatile("s_waitcnt vmcnt(0)" ::: "memory");
        if (lane == 0) __hip_atomic_fetch_add(cnt + 64 * u.pm, 1u, __ATOMIC_RELAXED, __HIP_MEMORY_SCOPE_AGENT);
        if (wid == 0) {
            unsigned sp = 0u;
            while ((unsigned)__builtin_amdgcn_readfirstlane(__hip_atomic_load(cnt + 64 * u.pm, __ATOMIC_RELAXED, __HIP_MEMORY_SCOPE_AGENT)) < target) { __builtin_amdgcn_s_sleep(2); if (++sp > (1u << 20)) break; }
            __builtin_amdgcn_fence(__ATOMIC_ACQUIRE, "agent");
        }
        asm volatile("s_waitcnt vmcnt(0) lgkmcnt(0)" ::: "memory"); __builtin_amdgcn_s_barrier(); asm volatile("" ::: "memory");
        if (lane < 32) { const float* sl = xbuf + (size_t)(u.pm * 256 + row) * 4; float t = 0.f;
#pragma unroll
            for (int k = 0; k < 4; ++k) t += __hip_atomic_load(sl + k, __ATOMIC_RELAXED, __HIP_MEMORY_SCOPE_AGENT);
            S[row] = rsqrtf(t * (1.f / DM) + EPS); }
        asm volatile("s_waitcnt lgkmcnt(0)" ::: "memory"); __builtin_amdgcn_s_barrier(); asm volatile("" ::: "memory");
        f32x4 wq[2][2];
#pragma unroll
        for (int bj = 0; bj < 2; ++bj)
#pragma unroll
            for (int n = 0; n < 2; ++n) wq[bj][n] = *(const f32x4*)(wfin + col0 + bj * 128 + n * 16);
#pragma unroll
        for (int ai = 0; ai < 2; ++ai)
#pragma unroll
            for (int m = 0; m < 4; ++m) { const int r = ai * 128 + wr * 64 + m * 16 + fr; const float sr = S[r]; const size_t off = (size_t)(u.pm * 256 + r) * DM + col0;
#pragma unroll
                for (int bj = 0; bj < 2; ++bj)
#pragma unroll
                    for (int n = 0; n < 2; ++n) { const pg8::f32x4 x = acc[ai][bj][m][n]; const f32x4 g = wq[bj][n]; const f32x4 y = (f32x4){x[0] * sr * g.x, x[1] * sr * g.y, x[2] * sr * g.z, x[3] * sr * g.w};
                        if (FINAL) *(f32x4*)(out + off + bj * 128 + n * 16) = y;
                        else { *(f32x4*)(out + off + bj * 128 + n * 16) = (f32x4){x[0], x[1], x[2], x[3]}; u32x2 w; w.x = pk2(y.x, y.y); w.y = pk2(y.z, y.w); *(u32x2*)(XN + off + bj * 128 + n * 16) = w; } } }
    }
};

template <int KS, int UNR, class Epi> __device__ __forceinline__ void wave_gemm64(const bf16* A, int lda, const bf16* B, int ldb, int lane, const Epi& epi) {
    const int fr = lane & 15, fq = lane >> 4;
    pg8::f32x4 acc[4][4];
#pragma unroll
    for (int jb = 0; jb < 4; ++jb)
#pragma unroll
        for (int ib = 0; ib < 4; ++ib) acc[jb][ib] = (pg8::f32x4){0.f, 0.f, 0.f, 0.f};
    const bf16* ap = A + (size_t)fr * lda + 8 * fq; const bf16* bp = B + (size_t)fr * ldb + 8 * fq;
#pragma unroll UNR
    for (int ks = 0; ks < KS; ++ks) {
        bf16x8 af[4], bv[4];
#pragma unroll
        for (int ib = 0; ib < 4; ++ib) { af[ib] = *(const bf16x8*)(ap + (size_t)(16 * ib) * lda + 32 * ks); bv[ib] = *(const bf16x8*)(bp + (size_t)(16 * ib) * ldb + 32 * ks); }
#pragma unroll
        for (int jb = 0; jb < 4; ++jb)
#pragma unroll
            for (int ib = 0; ib < 4; ++ib) acc[jb][ib] = __builtin_amdgcn_mfma_f32_16x16x32_bf16(bv[jb], af[ib], acc[jb][ib], 0, 0, 0);
    }
    epi(acc, fr, fq);
}
struct WEpiE {
    float* E;
    __device__ __forceinline__ void operator()(const pg8::f32x4 (&acc)[4][4], int fr, int fq) const {
#pragma unroll
        for (int jb = 0; jb < 4; ++jb)
#pragma unroll
            for (int ib = 0; ib < 4; ++ib) *(pg8::f32x4*)(E + (size_t)(16 * ib + fr) * 128 + 16 * jb + 4 * fq) = acc[jb][ib];
    }
};
struct WEpiS5Y {
    const bf16* SUAg; bf16* YS5; const float* dg; int chunk0, col0, g;
    __device__ __forceinline__ void operator()(const pg8::f32x4 (&acc)[4][4], int fr, int fq) const {
#pragma unroll
        for (int jb = 0; jb < 4; ++jb) { const int col = col0 + 16 * jb + 4 * fq, tt = col >> 4, h0 = col & 15; const f32x4 d4 = *(const f32x4*)(dg + h0);
#pragma unroll
            for (int ib = 0; ib < 4; ++ib) { const int chunk = chunk0 + 16 * ib + fr; const u32x2 uu = *(const u32x2*)(SUAg + (size_t)chunk * KA5 + col); const pg8::f32x4 v = acc[jb][ib];
                const float y0 = gelu_tanh(v[0] + d4.x * bflo(uu.x)), y1 = gelu_tanh(v[1] + d4.y * bfhi(uu.x)), y2 = gelu_tanh(v[2] + d4.z * bflo(uu.y)), y3 = gelu_tanh(v[3] + d4.w * bfhi(uu.y));
                u32x2 w; w.x = pk2(y0, y1); w.y = pk2(y2, y3); *(u32x2*)(YS5 + (size_t)(chunk * 32 + tt) * 256 + g * 16 + h0) = w; } }
    }
};
struct WEpiGlu {
    const bf16* YS5; bf16* G; int row0, col0;
    __device__ __forceinline__ void operator()(const pg8::f32x4 (&acc)[4][4], int fr, int fq) const {
#pragma unroll
        for (int jb = 0; jb < 4; ++jb)
#pragma unroll
            for (int ib = 0; ib < 4; ++ib) { const int row = row0 + 16 * ib + fr, col = col0 + 16 * jb + 4 * fq; const u32x2 yy = *(const u32x2*)(YS5 + (size_t)row * 256 + col); bf16* gp = G + (size_t)row * 1024 + 512 + col; const u32x2 gg = *(const u32x2*)gp; const pg8::f32x4 v = acc[jb][ib];
                const float s0 = __builtin_amdgcn_rcpf(1.f + __expf(-v[0])), s1 = __builtin_amdgcn_rcpf(1.f + __expf(-v[1])), s2 = __builtin_amdgcn_rcpf(1.f + __expf(-v[2])), s3 = __builtin_amdgcn_rcpf(1.f + __expf(-v[3]));
                u32x2 w; w.x = pk2(bflo(yy.x) * s0 * bflo(gg.x), bfhi(yy.x) * s1 * bfhi(gg.x)); w.y = pk2(bflo(yy.y) * s2 * bflo(gg.y), bfhi(yy.y) * s3 * bfhi(gg.y)); *(u32x2*)gp = w; }
    }
};

__device__ __forceinline__ void ret_upd_unit(unsigned char* ws, int unit, int lane) {
    const int c = unit & 63, bh = unit >> 6; const int i16 = lane & 15, kq = lane >> 4;
    const bf16* KT = (const bf16*)(ws + WS_RKT) + (size_t)bh * 64 * SEQ + c * 64; const bf16* VT = (const bf16*)(ws + WS_RVT) + (size_t)bh * 64 * SEQ + c * 64;
    float* UPD = (float*)(ws + WS_UPD) + (size_t)unit * 4096;
    bf16x8 af[4][2], bfv[4][2];
#pragma unroll
    for (int ib = 0; ib < 4; ++ib)
#pragma unroll
        for (int ks = 0; ks < 2; ++ks) { af[ib][ks] = *(const bf16x8*)(KT + (size_t)(16 * ib + i16) * SEQ + 32 * ks + 8 * kq); bfv[ib][ks] = *(const bf16x8*)(VT + (size_t)(16 * ib + i16) * SEQ + 32 * ks + 8 * kq); }
#pragma unroll
    for (int ib = 0; ib < 4; ++ib)
#pragma unroll
        for (int jb = 0; jb < 4; ++jb) { pg8::f32x4 d = (pg8::f32x4){0.f, 0.f, 0.f, 0.f};
            d = __builtin_amdgcn_mfma_f32_16x16x32_bf16(af[ib][0], bfv[jb][0], d, 0, 0, 0); d = __builtin_amdgcn_mfma_f32_16x16x32_bf16(af[ib][1], bfv[jb][1], d, 0, 0, 0);
            *(pg8::f32x4*)(UPD + (size_t)(16 * jb + i16) * 64 + 16 * ib + 4 * kq) = d; }
}
__device__ __forceinline__ void ret_out_unit(const Args& a, int l, int unit, int lane, bool dry = false) {
    unsigned char* ws = a.ws;
    const int c = unit & 63, bh = unit >> 6, hh = bh & 3, b = bh >> 2; const int fr = lane & 15, fq = lane >> 4;
    const size_t t0 = (size_t)b * SEQ + c * 64;
    const bf16* RQ = (const bf16*)(ws + WS_RQ) + t0 * 256 + hh * 64; const bf16* RK = (const bf16*)(ws + WS_RK) + t0 * 256 + hh * 64;
    const bf16* VT = (const bf16*)(ws + WS_RVT) + (size_t)bh * 64 * SEQ + c * 64; const bf16* ST = (const bf16*)(ws + WS_STATE) + (size_t)unit * 4096;
    const float lg = lg2_gamma(hh);
    bf16x8 qf[4][2]; pg8::f32x4 st[4][4];
#pragma unroll
    for (int nb = 0; nb < 4; ++nb)
#pragma unroll
        for (int ks = 0; ks < 2; ++ks) qf[nb][ks] = *(const bf16x8*)(RQ + (size_t)(16 * nb + fr) * 256 + 32 * ks + 8 * fq);
#pragma unroll
    for (int mb = 0; mb < 4; ++mb) { bf16x8 k0 = *(const bf16x8*)(RK + (size_t)(16 * mb + fr) * 256 + 8 * fq), k1 = *(const bf16x8*)(RK + (size_t)(16 * mb + fr) * 256 + 32 + 8 * fq);
#pragma unroll
        for (int nb = 0; nb < 4; ++nb) { pg8::f32x4 d = (pg8::f32x4){0.f, 0.f, 0.f, 0.f};
            d = __builtin_amdgcn_mfma_f32_16x16x32_bf16(k0, qf[nb][0], d, 0, 0, 0); d = __builtin_amdgcn_mfma_f32_16x16x32_bf16(k1, qf[nb][1], d, 0, 0, 0);
#pragma unroll
            for (int r = 0; r < 4; ++r) { const int mm = 16 * mb + 4 * fq + r, nn = 16 * nb + fr; const int df = mm > nn ? mm - nn : nn - mm; d[r] *= 0.125f * __builtin_amdgcn_exp2f(lg * (float)df); }
            st[mb][nb] = d; } }
    pg8::f32x4 o[4][4];
#pragma unroll
    for (int nb = 0; nb < 4; ++nb)
#pragma unroll
        for (int dvb = 0; dvb < 4; ++dvb) o[nb][dvb] = (pg8::f32x4){0.f, 0.f, 0.f, 0.f};
#pragma unroll
    for (int dvb = 0; dvb < 4; ++dvb) { const bf16x8 s0 = *(const bf16x8*)(ST + (size_t)(16 * dvb + fr) * 64 + 8 * fq), s1 = *(const bf16x8*)(ST + (size_t)(16 * dvb + fr) * 64 + 32 + 8 * fq);
#pragma unroll
        for (int nb = 0; nb < 4; ++nb) { o[nb][dvb] = __builtin_amdgcn_mfma_f32_16x16x32_bf16(qf[nb][0], s0, o[nb][dvb], 0, 0, 0); o[nb][dvb] = __builtin_amdgcn_mfma_f32_16x16x32_bf16(qf[nb][1], s1, o[nb][dvb], 0, 0, 0); } }
#pragma unroll
    for (int nb = 0; nb < 4; ++nb)
#pragma unroll
        for (int r = 0; r < 4; ++r) { const float wq = 0.125f * __builtin_amdgcn_exp2f(lg * (float)(16 * nb + 4 * fq + r + 1));
#pragma unroll
            for (int dvb = 0; dvb < 4; ++dvb) o[nb][dvb][r] *= wq; }
#pragma unroll
    for (int s = 0; s < 2; ++s) {
        bf16x8 pa[4];
#pragma unroll
        for (int nb = 0; nb < 4; ++nb) { u32x4 w; w.x = pk2(st[2 * s][nb][0], st[2 * s][nb][1]); w.y = pk2(st[2 * s][nb][2], st[2 * s][nb][3]); w.z = pk2(st[2 * s + 1][nb][0], st[2 * s + 1][nb][1]); w.w = pk2(st[2 * s + 1][nb][2], st[2 * s + 1][nb][3]); pa[nb] = __builtin_bit_cast(bf16x8, w); }
#pragma unroll
        for (int dvb = 0; dvb < 4; ++dvb) { const u32x2 v0 = *(const u32x2*)(VT + (size_t)(16 * dvb + fr) * SEQ + 32 * s + 4 * fq), v1 = *(const u32x2*)(VT + (size_t)(16 * dvb + fr) * SEQ + 32 * s + 16 + 4 * fq);
            const bf16x8 vf = __builtin_bit_cast(bf16x8, (u32x4){v0.x, v0.y, v1.x, v1.y});
#pragma unroll
            for (int nb = 0; nb < 4; ++nb) o[nb][dvb] = __builtin_amdgcn_mfma_f32_16x16x32_bf16(pa[nb], vf, o[nb][dvb], 0, 0, 0); }
    }
    const float* gn = a.in[13] + (size_t)l * 256 + hh * 64; float gnw[4];
#pragma unroll
    for (int dvb = 0; dvb < 4; ++dvb) gnw[dvb] = gn[16 * dvb + fr];
    bf16* Y = (bf16*)(ws + WS_GATE) + t0 * 1024 + 768 + hh * 64;
#pragma unroll
    for (int nb = 0; nb < 4; ++nb)
#pragma unroll
        for (int r = 0; r < 4; ++r) { float s = (o[nb][0][r] + o[nb][1][r]) + (o[nb][2][r] + o[nb][3][r]);
            s += __shfl_xor(s, 1); s += __shfl_xor(s, 2); s += __shfl_xor(s, 4); s += __shfl_xor(s, 8);
            const float mu = s * (1.f / 64.f); float q = 0.f;
#pragma unroll
            for (int dvb = 0; dvb < 4; ++dvb) { const float d = o[nb][dvb][r] - mu; q += d * d; }
            q += __shfl_xor(q, 1); q += __shfl_xor(q, 2); q += __shfl_xor(q, 4); q += __shfl_xor(q, 8);
            const float rstd = rsqrtf(q * (1.f / 64.f) + EPS); bf16* yp = Y + (size_t)(16 * nb + 4 * fq + r) * 1024 + fr;
#pragma unroll
            for (int dvb = 0; dvb < 4; ++dvb) { const float gt = bf2f(yp[16 * dvb]); if (!dry) yp[16 * dvb] = f2bf((o[nb][dvb][r] - mu) * rstd * gnw[dvb] * gt); } }
}

#define XB_TMO      128
#define XB_XCNT(j)  (256  + 64 * (j))
#define XB_XSUB(j)  (1280 + 64 * (j))
#define XB_XGEN(j)  (2304 + 64 * (j))
#define XB_TOP      3328
#define XB_TOPGEN   3392
#define XCD_BAR_WORDS 3456
#define XB_SPIN_CAP (1u << 18)

__device__ __forceinline__ unsigned xb_ld(unsigned* p)              { return __hip_atomic_load(p, __ATOMIC_RELAXED, __HIP_MEMORY_SCOPE_AGENT); }
__device__ __forceinline__ unsigned xb_add(unsigned* p, unsigned v) { return __hip_atomic_fetch_add(p, v, __ATOMIC_RELAXED, __HIP_MEMORY_SCOPE_AGENT); }
__device__ __forceinline__ unsigned xb_xcc_id() { return (unsigned)__builtin_amdgcn_s_getreg((3 << 11) | 20) & 0xFu; }
#define XB_SPIN(cond, bar) do { unsigned _sp = 0; while (cond) { __builtin_amdgcn_s_sleep(1); \
    if ((++_sp & 255u) == 0u) { if (xb_ld(&(bar)[XB_TMO])) break; if (_sp > XB_SPIN_CAP) { atomicAdd(&(bar)[XB_TMO], 1u); break; } } } } while (0)

struct XcdBarrier {
    unsigned* bar; unsigned x;
    volatile LAS unsigned* st;
};

__device__ __forceinline__ XcdBarrier xcd_barrier_post(unsigned* bar, volatile LAS unsigned* st) {
    XcdBarrier b; b.bar = bar; b.x = xb_xcc_id(); b.st = st;
    if (threadIdx.x == 0) (void)xb_add(&bar[XB_XCNT(b.x)], 1u);
    return b;
}
__device__ __forceinline__ void xcd_barrier_complete(unsigned* bar, unsigned x, unsigned& nloc, unsigned& nx) {
    const unsigned G = gridDim.x * gridDim.y * gridDim.z;
    unsigned sum, cnt, mine, sp = 0u;
    for (;;) {
        sum = 0u; cnt = 0u; mine = 0u;
#pragma unroll
        for (unsigned j = 0; j < 16; ++j) { const unsigned c = xb_ld(&bar[XB_XCNT(j)]); sum += c; cnt += (c > 0u) ? 1u : 0u; mine = (j == x) ? c : mine; }
        if (sum == G) break;
        __builtin_amdgcn_s_sleep(1);
        if ((++sp & 255u) == 0u) { if (xb_ld(&bar[XB_TMO])) break; if (sp > XB_SPIN_CAP) { atomicAdd(&bar[XB_TMO], 1u); break; } }
    }
    nloc = mine > 0u ? mine : 1u; nx = cnt > 0u ? cnt : 1u;
}

__device__ __forceinline__ void xcd_barrier(const XcdBarrier& b) {
    asm volatile("s_waitcnt vmcnt(0)" ::: "memory");
    __syncthreads();
    if (threadIdx.x == 0) {
        unsigned* bar = b.bar;
        __builtin_amdgcn_s_waitcnt(0);
        unsigned nloc = b.st[0], nx = b.st[1];
        if (nloc == 0u) { xcd_barrier_complete(bar, b.x, nloc, nx); b.st[0] = nloc; b.st[1] = nx; }
        const unsigned old = xb_add(&bar[XB_XSUB(b.x)], 1u);
        const unsigned gen = old / nloc;
        if (old + 1u == (gen + 1u) * nloc) {
            __builtin_amdgcn_fence(__ATOMIC_RELEASE, "agent");
            asm volatile("s_waitcnt vmcnt(0)" ::: "memory");
            const unsigned og = xb_add(&bar[XB_TOP], 1u);
            const unsigned tg = og / nx;
            if (og + 1u == (tg + 1u) * nx) xb_add(&bar[XB_TOPGEN], 1u);
            else XB_SPIN(xb_ld(&bar[XB_TOPGEN]) == tg, bar);
            __builtin_amdgcn_fence(__ATOMIC_ACQUIRE, "agent");
            xb_add(&bar[XB_XGEN(b.x)], 1u);
            asm volatile("s_waitcnt vmcnt(0)" ::: "memory");
        } else {
            XB_SPIN(xb_ld(&bar[XB_XGEN(b.x)]) == gen, bar);
            __builtin_amdgcn_fence(__ATOMIC_ACQUIRE, "agent");
            asm volatile("s_waitcnt vmcnt(0)" ::: "memory");
        }
    }
    __syncthreads();
}

#define XBAR_MAKE XcdBarrier xb_; xb_.bar = (unsigned*)args.ws; xb_.st = (volatile LAS unsigned*)((LAS unsigned char*)lds + RING_BYTES + 352); xb_.x = xb_.st[2]
#ifdef REP_SYNC
#define GSYNC() do { XBAR_MAKE; xcd_barrier(xb_); xcd_barrier(xb_); } while (0)
#else
#define GSYNC() do { XBAR_MAKE; xcd_barrier(xb_); } while (0)
#endif
#ifndef REP_P0
#define REP_P0 1
#endif
#ifndef REP_P1
#define REP_P1 1
#endif
#ifndef REP_P23
#define REP_P23 1
#endif
#ifndef REP_NORM
#define REP_NORM 1
#endif
__global__ void __launch_bounds__(NTHR, 2) mega_fwd(Args args) {
    extern __shared__ __attribute__((aligned(16))) unsigned char lds[];
    cg::grid_group grid = cg::this_grid();
    const int tid = threadIdx.x, lane = tid & 63, wave = __builtin_amdgcn_readfirstlane(tid >> 6);
    const int G = gridDim.x, bx = blockIdx.x; const int vcu = (G % 8 == 0) ? (bx % 8) * (G / 8) + bx / 8 : bx;
    const int gw = bx * NWAVES + wave, NGW = G * NWAVES;
    unsigned char* ws = args.ws;
    LAS unsigned char* ldsl = (LAS unsigned char*)lds;
    LAS float* ldsf = (LAS float*)lds;
    float* X = args.out;
    if (ws == nullptr) grid.sync();
    if (tid < 2) ((volatile LAS unsigned*)(ldsl + RING_BYTES + 352))[tid] = 0u;
    __syncthreads();
    { const XcdBarrier xb0 = xcd_barrier_post((unsigned*)ws, (volatile LAS unsigned*)(ldsl + RING_BYTES + 352)); if (tid == 0) ((volatile LAS unsigned*)(ldsl + RING_BYTES + 352))[2] = xb0.x; }
    __syncthreads();

#ifdef PROBE_T
    unsigned long long tacc_ = 0ull, tprev_ = __builtin_amdgcn_s_memrealtime();
#define TSTAMP(id) do { const unsigned long long tn_ = __builtin_amdgcn_s_memrealtime(); if ((id) == PROBE_T || ((PROBE_T) == 23 && ((id) == 2 || (id) == 3 || (id) == 5))) tacc_ += tn_ - tprev_; tprev_ = tn_; } while (0)
#else
#define TSTAMP(id) do {} while (0)
#endif
    for (int rep_ = 0; rep_ < REP_P0; ++rep_) {
        if (rep_) { __syncthreads(); }
#ifdef REP_S5P
        if (bx < 64) { s5_prep(args, bx >> 4, bx & 15, ldsf, tid); }
#endif
        if (bx < 64) { s5_prep(args, bx >> 4, bx & 15, ldsf, tid); }
        LAS float* scr = ldsf + wave * 4096;
        constexpr int I_IN = (DM / 64) * (NF / 32), I_O = (DM / 64) * (DM / 32), I_G = (256 / 64) * (256 / 32), I_L = I_IN + I_O + I_G;
#ifndef REP_TR
#define REP_TR 1
#endif
        for (int rt_ = 0; rt_ < REP_TR; ++rt_)
        for (int it = (bx < 64 ? DEPTH * I_L : (bx - 64) * NWAVES + wave); it < DEPTH * I_L; it += (G - 64) * NWAVES) {
            const int l = it / I_L; int r = it % I_L;
            if (r < I_IN) { p0_transpose_item<true>(args.in[2] + (size_t)l * DM * NIN, DM, NIN, NF, (bf16*)(ws + WS_WIN) + (size_t)l * NF * DM, scr, r, lane); continue; } r -= I_IN;
            if (r < I_O) { p0_transpose_item<false>(args.in[14] + (size_t)l * DM * DM, DM, DM, DM, (bf16*)(ws + WS_WO) + (size_t)l * DM * DM, scr, r, lane); continue; } r -= I_O;
            p0_transpose_item<false>(args.in[12] + (size_t)l * 65536, 256, 256, 256, (bf16*)(ws + WS_WGLU) + (size_t)l * 65536, scr, r, lane);
        }
        f32x2* rope = (f32x2*)(ws + WS_ROPE);
        for (int i = bx * NTHR + tid; i < SEQ * 32; i += G * NTHR) { const int pos = i >> 5, fi = i & 31; const float freq = powf(10000.f, -(float)fi / 32.f); const float ang = (float)pos * freq; float sn, cs; sincosf(ang, &sn, &cs); rope[i] = (f32x2){cs, sn}; }
        __syncthreads();
        { const int NW = (64 + 2 * (G - 64)) * NWAVES;
          if (bx < 64) norm0_phase(args, lane, bx * NWAVES + wave, NW);
          else { const int sl = 64 * NWAVES + ((bx - 64) * NWAVES + wave) * 2; norm0_phase(args, lane, sl, NW); norm0_phase(args, lane, sl + 1, NW); } }
    }
    GSYNC();
    TSTAMP(0);

#define PHASE_VARS int tid = threadIdx.x; asm volatile("" : "+v"(tid)); int bxl_ = blockIdx.x; asm volatile("" : "+s"(bxl_)); const int bx = bxl_; const int lane = tid & 63, wave = __builtin_amdgcn_readfirstlane(tid >> 6), gw = bx * NWAVES + wave; __attribute__((address_space(1))) unsigned char* wsg_ = (__attribute__((address_space(1))) unsigned char*)args.ws; asm volatile("" : "+s"(wsg_)); unsigned char* ws = (unsigned char*)wsg_; LAS unsigned char* ldsl = (LAS unsigned char*)lds; LAS float* ldsf = (LAS float*)lds; (void)lane; (void)wave; (void)gw; (void)ldsl; (void)ldsf
    for (int l = 0; l < DEPTH; ++l) {
        for (int rep_ = 0; rep_ < REP_P1; ++rep_) {
            PHASE_VARS;
            pg8::Gemm g{(const bf16*)(ws + WS_XN), (const bf16*)(ws + WS_WIN) + (size_t)l * NF * DM, M, NF, DM, DM, DM, 0, 0};
            pg8::StaticOrder S; S.init(M, NF, G, bx);
            EpiInProj E{ws, (const float*)(ws + WS_SS) + (size_t)(l & 1) * M, args.in[3] + (size_t)l * 8};
#ifdef PROBE_SPLIT
            { RangeOrder R0{S, 0, 2}, R1{S, 2, 4}; pg8::gemm_phase<EpiInProj, RangeOrder, true, true>(ldsl, g, R0, E); GSYNC(); pg8::gemm_phase<EpiInProj, RangeOrder, true, true>(ldsl, g, R1, E); }
#else
            pg8::gemm_phase<EpiInProj, pg8::StaticOrder, true, true>(ldsl, g, S, E);
#endif
            if (bx >= G / 2) flog_phase(args, l, (const float*)(ws + WS_SS) + (size_t)(l & 1) * M, ldsf, tid, lane, wave, bx - G / 2, G / 2);
        }
        GSYNC();
        TSTAMP(1);
        for (int rep_ = 0; rep_ < REP_P23; ++rep_) {
            if (rep_) __syncthreads();
            PHASE_VARS;
            if (bx < 64) {
                const int b = bx >> 4, g = bx & 15, tmL = wave & 1, tn = (wave >> 1) & 1, kh = wave >> 2;
                { const int fr = lane & 15, fq = lane >> 4;
                  const bf16* Ap = (const bf16*)(ws + WS_SUA) + ((size_t)g * NCH5 + b * 128 + tmL * 64) * KA5 + 256 * kh; const bf16* Bp = (const bf16*)(ws + WS_WB) + ((size_t)(l * 16 + g) * 128 + tn * 64) * 512 + 256 * kh;
                  struct WEpiLds { LAS float* EL; __device__ __forceinline__ void operator()(const pg8::f32x4 (&acc)[4][4], int fr_, int fq_) const {
#pragma unroll
                      for (int jb = 0; jb < 4; ++jb)
#pragma unroll
                          for (int ib = 0; ib < 4; ++ib) *(LAS pg8::f32x4*)(EL + (16 * ib + fr_) * 128 + 16 * jb + 4 * fq_) = acc[jb][ib]; } };
                  WEpiLds E{ldsf + (size_t)(kh * 128 + tmL * 64) * 128 + tn * 64}; (void)fr; (void)fq;
                  wave_gemm64<8, 4, WEpiLds>(Ap, KA5, Bp, 512, lane, E); }
                __syncthreads();
                const int p = tid & 63, seg = tid >> 6;
                const float* LAM = (const float*)(ws + WS_LAM) + (size_t)(l * 16 + g) * 128; const float lr = LAM[p], li = LAM[64 + p];
                bf16* SA = (bf16*)(ws + WS_SUA) + ((size_t)g * NCH5 + b * 128 + seg * 16) * KA5 + 512 + p;
                float er[16], ei[16];
#pragma unroll
                for (int i = 0; i < 16; ++i) { const int r = (seg * 16 + i) * 128; er[i] = ldsf[r + p] + ldsf[16384 + r + p]; ei[i] = ldsf[r + 64 + p] + ldsf[16384 + r + 64 + p]; }
                float sr = 0.f, si = 0.f;
#pragma unroll
                for (int i = 0; i < 16; ++i) { const float nr = lr * sr - li * si + er[i], ni = lr * si + li * sr + ei[i]; sr = nr; si = ni; }
                LAS float* ends = ldsf + (RING_BYTES + 1024) / 4;
                ends[(seg * 64 + p) * 2] = sr; ends[(seg * 64 + p) * 2 + 1] = si;
                float pr = lr, pi = li;
#pragma unroll
                for (int i = 0; i < 4; ++i) { const float nr = pr * pr - pi * pi, ni = 2.f * pr * pi; pr = nr; pi = ni; }
                __syncthreads();
                float cr = 0.f, ci = 0.f;
                for (int s2 = 0; s2 < seg; ++s2) { const float xr = ends[(s2 * 64 + p) * 2], xi = ends[(s2 * 64 + p) * 2 + 1]; const float nr = pr * cr - pi * ci + xr, ni = pr * ci + pi * cr + xi; cr = nr; ci = ni; }
#pragma unroll
                for (int i = 0; i < 16; ++i) { SA[(size_t)i * KA5] = f2bf(cr); SA[(size_t)i * KA5 + 64] = f2bf(ci); const float nr = lr * cr - li * ci + er[i], ni = lr * ci + li * cr + ei[i]; cr = nr; ci = ni; }
            } else if (bx < 192) {
                const int idx = bx - 64, bh = idx >> 3, dvs = (idx >> 1) & 3, dkh = idx & 1, fr = lane & 15, fq = lane >> 4; const float g64 = exp2f(lg2_gamma(bh & 3) * 64.f);
                const bf16* KT = (const bf16*)(ws + WS_RKT) + ((size_t)bh * 64 + 32 * dkh + fr) * SEQ + 8 * fq; const bf16* VT = (const bf16*)(ws + WS_RVT) + ((size_t)bh * 64 + 16 * dvs + fr) * SEQ + 8 * fq;
                pg8::f32x4 u[8][2];
#pragma unroll
                for (int i2 = 0; i2 < 2; ++i2) {
                    bf16x8 vf[4][2], kf[4][2][2];
#pragma unroll
                    for (int i1 = 0; i1 < 4; ++i1) { const int c = 8 * wave + 4 * i2 + i1; vf[i1][0] = *(const bf16x8*)(VT + c * 64); vf[i1][1] = *(const bf16x8*)(VT + c * 64 + 32);
#pragma unroll
                        for (int ib = 0; ib < 2; ++ib) { kf[i1][ib][0] = *(const bf16x8*)(KT + (size_t)(16 * ib) * SEQ + c * 64); kf[i1][ib][1] = *(const bf16x8*)(KT + (size_t)(16 * ib) * SEQ + c * 64 + 32); } }
#pragma unroll
                    for (int i1 = 0; i1 < 4; ++i1)
#pragma unroll
                        for (int ib = 0; ib < 2; ++ib) { pg8::f32x4 d = (pg8::f32x4){0.f, 0.f, 0.f, 0.f}; d = __builtin_amdgcn_mfma_f32_16x16x32_bf16(kf[i1][ib][0], vf[i1][0], d, 0, 0, 0); d = __builtin_amdgcn_mfma_f32_16x16x32_bf16(kf[i1][ib][1], vf[i1][1], d, 0, 0, 0); u[4 * i2 + i1][ib] = d; }
                }
                pg8::f32x4 e4[2];
#pragma unroll
                for (int ib = 0; ib < 2; ++ib) e4[ib] = (pg8::f32x4){0.f, 0.f, 0.f, 0.f};
#pragma unroll
                for (int i = 0; i < 8; ++i)
#pragma unroll
                    for (int ib = 0; ib < 2; ++ib) e4[ib] = e4[ib] * g64 + u[i][ib];
                LAS pg8::f32x4* ends = (LAS pg8::f32x4*)ldsf;
#pragma unroll
                for (int ib = 0; ib < 2; ++ib) ends[(wave * 2 + ib) * 64 + lane] = e4[ib];
                float g8 = g64; g8 = g8 * g8; g8 = g8 * g8; g8 = g8 * g8;
                __syncthreads();
                pg8::f32x4 st[2];
#pragma unroll
                for (int ib = 0; ib < 2; ++ib) st[ib] = (pg8::f32x4){0.f, 0.f, 0.f, 0.f};
                for (int w2 = 0; w2 < wave; ++w2)
#pragma unroll
                    for (int ib = 0; ib < 2; ++ib) st[ib] = st[ib] * g8 + ends[(w2 * 2 + ib) * 64 + lane];
                bf16* ST = (bf16*)(ws + WS_STATE) + (size_t)(bh * 64 + 8 * wave) * 4096 + (size_t)(16 * dvs + fr) * 64 + 32 * dkh + 4 * fq;
#pragma unroll
                for (int i = 0; i < 8; ++i)
#pragma unroll
                    for (int ib = 0; ib < 2; ++ib) { u32x2 w; w.x = pk2(st[ib][0], st[ib][1]); w.y = pk2(st[ib][2], st[ib][3]); *(u32x2*)(ST + (size_t)i * 4096 + 16 * ib) = w; st[ib] = st[ib] * g64 + u[i][ib]; }
            } else if (bx < 224) {
                const int bh = bx - 192; const float* lf = (const float*)(ws + WS_LOGF) + (size_t)bh * SEQ; float* cb = (float*)(ws + WS_CB) + (size_t)bh * SEQ;
                const f32x4 a0 = *(const f32x4*)(lf + tid * 8), a1 = *(const f32x4*)(lf + tid * 8 + 4); float v[8] = {a0.x, a0.y, a0.z, a0.w, a1.x, a1.y, a1.z, a1.w};
#pragma unroll
                for (int e = 1; e < 8; ++e) v[e] += v[e - 1];
                float tot = v[7];
#pragma unroll
                for (int o = 1; o < 64; o <<= 1) { const float t = __shfl_up(tot, o); if (lane >= o) tot += t; }
                if (lane == 63) ldsf[wave] = tot;
                __syncthreads();
                float off = tot - v[7];
                for (int w = 0; w < wave; ++w) off += ldsf[w];
                f32x4 o0, o1; o0.x = -(v[0] + off) * LOG2E; o0.y = -(v[1] + off) * LOG2E; o0.z = -(v[2] + off) * LOG2E; o0.w = -(v[3] + off) * LOG2E; o1.x = -(v[4] + off) * LOG2E; o1.y = -(v[5] + off) * LOG2E; o1.z = -(v[6] + off) * LOG2E; o1.w = -(v[7] + off) * LOG2E;
                *(f32x4*)(cb + tid * 8) = o0; *(f32x4*)(cb + tid * 8 + 4) = o1;
            } else { const int idx = (bx - 224) * NTHR + tid; if (idx < M) ((float*)(ws + WS_SS))[(size_t)((l + 1) & 1) * M + idx] = 0.f;
                const int bh = bx - 224, b = bh >> 3, h = bh & 7, rsub = lane >> 3, part = lane & 7;
                const bf16* Qp = (const bf16*)(ws + WS_QO) + ((size_t)b * SEQ + wave * 512 + rsub) * 512 + h * 64 + part * 8; const bf16* Kp = (const bf16*)(ws + WS_KB) + ((size_t)b * SEQ + wave * 512 + rsub) * 512 + h * 64 + part * 8;
                float qm = 0.f, km = 0.f;
#pragma unroll 8
                for (int it = 0; it < 64; ++it) { const u32x4 qv = *(const u32x4*)(Qp + (size_t)it * 8 * 512), kv = *(const u32x4*)(Kp + (size_t)it * 8 * 512); float sq = 0.f, sk = 0.f;
#pragma unroll
                    for (int e = 0; e < 4; ++e) { const float a0 = bflo(qv[e]), a1 = bfhi(qv[e]), c0 = bflo(kv[e]), c1 = bfhi(kv[e]); sq += a0 * a0 + a1 * a1; sk += c0 * c0 + c1 * c1; }
                    sq += __shfl_xor(sq, 1); sq += __shfl_xor(sq, 2); sq += __shfl_xor(sq, 4); sk += __shfl_xor(sk, 1); sk += __shfl_xor(sk, 2); sk += __shfl_xor(sk, 4);
                    qm = fmaxf(qm, sq); km = fmaxf(km, sk); }
#pragma unroll
                for (int o = 8; o < 64; o <<= 1) { qm = fmaxf(qm, __shfl_xor(qm, o)); km = fmaxf(km, __shfl_xor(km, o)); }
                if (lane == 0) { ldsf[wave * 2] = qm; ldsf[wave * 2 + 1] = km; }
                __syncthreads();
                if (tid == 0) { float a = 0.f, c = 0.f; for (int w = 0; w < NWAVES; ++w) { a = fmaxf(a, ldsf[2 * w]); c = fmaxf(c, ldsf[2 * w + 1]); } ((float*)(ws + WS_NRM))[bh] = sqrtf(a) * sqrtf(c) * 1.0001f; }
            }
        }
        GSYNC();
        TSTAMP(3);
        {
            PHASE_VARS;
            if (wave < 4) ret_out_unit(args, l, wave * 256 + bx, lane);
            else {
                const int t = (wave - 4) * 256 + bx, g = t >> 6, r = t & 63, tm = r >> 3, tn = r & 7;
                const bf16* SUAg = (const bf16*)(ws + WS_SUA) + (size_t)g * NCH5 * KA5;
                WEpiS5Y E{SUAg, (bf16*)(ws + WS_YS5), args.in[10] + (size_t)l * 256 + g * 16, tm * 64, tn * 64, g};
                wave_gemm64<20, 4, WEpiS5Y>(SUAg + (size_t)(tm * 64) * KA5, KA5, (const bf16*)(ws + WS_MF) + ((size_t)(l * 16 + g) * 512 + tn * 64) * KA5, KA5, lane, E);
            }
            __syncthreads();
            const attn_body::AttnTensors AT{(const attn_body::bf16*)(ws + WS_QO), (const attn_body::bf16*)(ws + WS_KB), (const attn_body::bf16*)(ws + WS_VB), (attn_body::bf16*)(ws + WS_GATE), (const float*)(ws + WS_CB), (const float*)(ws + WS_NRM)};
            const attn_body::StaticOrder S(G, bx);
#ifdef REP_ATTN
            attn_body::attn_phase<attn_body::StaticOrder>((char*)lds, AT, S, opaque_true());
#endif
            attn_body::attn_phase<attn_body::StaticOrder>((char*)lds, AT, S);
        }
        GSYNC();
        TSTAMP(4);
        {
            PHASE_VARS;
            if (wave < 4) {
                const int t = wave * 256 + bx, tm = t >> 2, tn = t & 3;
                WEpiGlu E{(const bf16*)(ws + WS_YS5), (bf16*)(ws + WS_GATE), tm * 64, tn * 64};
                wave_gemm64<8, 4, WEpiGlu>((const bf16*)(ws + WS_YS5) + (size_t)(tm * 64) * 256, 256, (const bf16*)(ws + WS_WGLU) + (size_t)l * 65536 + (size_t)(tn * 64) * 256, 256, lane, E);
            }
        }
        GSYNC();
        TSTAMP(5);
        {
            PHASE_VARS;
            pg8::Gemm g{(const bf16*)(ws + WS_GATE), (const bf16*)(ws + WS_WO) + (size_t)l * DM * DM, M, DM, DM, DM, DM, 0, 0};
            pg8::StaticOrder S; S.init(M, DM, G, bx);
            if (l + 1 < DEPTH) {
                EpiOutX<false> E{l == 0 ? args.in[0] : X, X, args.in[1] + (size_t)(l + 1) * DM, (float*)(ws + WS_XBUF), (unsigned*)ws + 4096, (bf16*)(ws + WS_XN), 32u * (unsigned)(l + 1)};
                pg8::gemm_phase<EpiOutX<false>, pg8::StaticOrder, false, true>(ldsl, g, S, E);
            } else {
                EpiOutX<true> E{X, X, args.in[15], (float*)(ws + WS_XBUF), (unsigned*)ws + 4096, nullptr, 32u * (unsigned)(l + 1)};
                pg8::gemm_phase<EpiOutX<true>, pg8::StaticOrder, false, true>(ldsl, g, S, E);
            }
        }
        if (l + 1 < DEPTH) GSYNC();
        TSTAMP(6);
    }
}

extern "C" void kernel_launch(void* const* d_in, const int* in_sizes, int n_in, void* d_out, int out_size, void* d_ws, size_t ws_size, hipStream_t stream) {
    static int grid = 0;
    if (grid == 0) {
        if (n_in != 16 || ws_size < WS_END) { fprintf(stderr, "kernel_launch: unexpected n_in %d / ws %zu\n", n_in, ws_size); grid = -1; return; }
        int dev = 0, cus = 0, per_cu = 0;
        hipGetDevice(&dev); hipDeviceGetAttribute(&cus, hipDeviceAttributeMultiprocessorCount, dev);
        if (hipFuncSetAttribute((const void*)mega_fwd, hipFuncAttributeMaxDynamicSharedMemorySize, LDS_BYTES) != hipSuccess) { fprintf(stderr, "kernel_launch: hipFuncSetAttribute failed\n"); grid = -1; return; }
        if (hipOccupancyMaxActiveBlocksPerMultiprocessor(&per_cu, (const void*)mega_fwd, NTHR, LDS_BYTES) != hipSuccess || per_cu < 1) { fprintf(stderr, "kernel_launch: occupancy query failed (%d)\n", per_cu); grid = -1; return; }
        grid = cus;
        if (grid != 256) fprintf(stderr, "kernel_launch: note: %d CUs\n", grid);
    }
    if (grid < 0) return;
    if (hipMemsetAsync(d_ws, 0, 32768, stream) != hipSuccess) { fprintf(stderr, "kernel_launch: hipMemsetAsync failed\n"); return; }
    Args a{};
    for (int i = 0; i < 16; ++i) a.in[i] = (const float*)d_in[i];
    a.out = (float*)d_out; a.ws = (unsigned char*)d_ws;
    void* kargs[] = {&a};
    hipError_t e = hipLaunchCooperativeKernel((const void*)mega_fwd, dim3(grid), dim3(NTHR), kargs, LDS_BYTES, stream);
    if (e != hipSuccess) fprintf(stderr, "kernel_launch: cooperative launch failed: %s\n", hipGetErrorString(e));
}
```

```cpp
#include <hip/hip_runtime.h>
#include <cstdio>
#include <cstdint>
namespace pg8 {
#define PG8_LAS __attribute__((address_space(3)))
typedef unsigned short bf16_t;
typedef short bf16x8 __attribute__((ext_vector_type(8)));
typedef float f32x4 __attribute__((ext_vector_type(4)));
typedef unsigned u32x4 __attribute__((ext_vector_type(4)));
constexpr int BM = 256, BK = 64, HALF = 128, HTB = HALF * BK * 2  , STAGE_BYTES = 8 * HTB, NXCD = 8, WGM = 4;

__host__ __device__ __forceinline__ int lds_byte(int r, int c) { const int st = (r >> 4) * 2 + (c >> 5), rr = r & 15, cc = c & 31, ob = rr * 64 + cc * 2; return st * 1024 + (ob ^ (((ob >> 9) & 1) << 5)); }
__host__ __device__ __forceinline__ void stage_rc(int b, int& R, int& C) { const int st = b / 1024, sb = b % 1024, swz = sb ^ (((sb >> 9) & 1) << 5); R = (st >> 1) * 16 + swz / 64; C = (st & 1) * 32 + (swz % 64) / 2; }
__host__ __device__ __forceinline__ int perm32(int rho) { const int n = rho >> 4, i = rho & 15; return 8 * (i >> 2) + 4 * n + (i & 3); }

struct Unit { int pm, pn, gz; };
struct Gemm { const bf16_t* A; const bf16_t* Bt; int M, N, K; int lda, ldb; size_t gsA, gsB; };

struct StaticOrder {
    int nM, nN, nwg, G, c;
    __host__ __device__ void init(int M, int N, int G_, int c_) { nM = M / BM; nN = N / BM; nwg = nM * nN; G = G_; c = c_; }
    __host__ __device__ bool next(int i, Unit& u) const {
        const long L = (long)i * G + c; if (L >= nwg) return false;
        int wgid = (int)L; { const int q = nwg / NXCD, r = nwg % NXCD, xcd = wgid % NXCD, off = wgid / NXCD; wgid = (xcd < r ? xcd * (q + 1) : r * (q + 1) + (xcd - r) * q) + off; }
        const int nig = WGM * nN, gid = wgid / nig, fm = gid * WGM, gsz = (nM - fm) < WGM ? (nM - fm) : WGM;
        u.pm = fm + ((wgid % nig) % gsz); u.pn = (wgid % nig) / gsz; u.gz = 0; return true;
    }
    __device__ __forceinline__ void a_ready(const Unit&) const {}
    __device__ __forceinline__ void done(const Unit&) const {}
};

__device__ __forceinline__ unsigned cvt_pk_bf16(float lo, float hi) { unsigned r; asm volatile("v_cvt_pk_bf16_f32 %0, %1, %2" : "=v"(r) : "v"(lo), "v"(hi)); return r; }
typedef float f32x2 __attribute__((ext_vector_type(2)));
__device__ __forceinline__ f32x2 gelu_pk(f32x2 v) {
    const f32x2 av = __builtin_elementwise_abs(v), d = av * 0.2316418882f + 1.0f;
    f32x2 t; t.x = __builtin_amdgcn_rcpf(d.x); t.y = __builtin_amdgcn_rcpf(d.y);
    f32x2 q = t * 0.5307027145f + (-0.7265760135f); q = q * t + 0.7107068705f; q = q * t + (-0.142248368f); q = q * t + 0.127414796f; q = q * t;
    const f32x2 s = (v * v) * (-0.72134752044f);
    f32x2 e; e.x = __builtin_amdgcn_exp2f(s.x); e.y = __builtin_amdgcn_exp2f(s.y);
    const f32x2 m = v * (q * e), r = v - m;
    f32x2 o; o.x = v.x < 0.f ? m.x : r.x; o.y = v.y < 0.f ? m.y : r.y; return o;
}

template <class Epi, class Sched, bool ALIGN_EPI = false, bool SP2 = false>
__device__ __forceinline__ void gemm_phase(PG8_LAS unsigned char* lds, const Gemm g, const Sched& S, const Epi& E) {
    int tid_ = threadIdx.x; asm volatile("" : "+v"(tid_));
    const int tid = tid_, wid = __builtin_amdgcn_readfirstlane(tid >> 6), lane = tid & 63, wr = wid >> 2, wc = wid & 3, fr = lane & 15, fq = lane >> 4;
    const int K = g.K, nt = K / BK;
    unsigned voffA[2], voffB[2];
#pragma unroll
    for (int i = 0; i < 2; ++i) { int R, C; stage_rc(tid * 16 + i * 8192, R, C); const int Rb = Epi::PERM ? ((R & ~31) + perm32(R & 31)) : R;
        voffA[i] = (unsigned)(R * g.lda + C) * 2u; voffB[i] = (unsigned)(Rb * g.ldb + C) * 2u; }
    const size_t kstep = (size_t)(BK * 2);
    const size_t hstepA = (size_t)HALF * g.lda * 2, hstepB = (size_t)HALF * g.ldb * 2;
    const size_t tstepA = 2 * hstepA, tstepB = 2 * hstepB;
    const unsigned ldsw = (unsigned)wid * 1024u;
    const int aoff = lds_byte(wr * 64 + fr, fq * 8), boff = lds_byte(wc * 32 + fr, fq * 8);
#define PG8_SA(b, h) (((b) * 2 + (h)) * HTB)
#define PG8_SB(b, h) ((4 + (b) * 2 + (h)) * HTB)
#define PG8_STAGE(bufoff, gbase, voff) do { _Pragma("unroll") for (int _i = 0; _i < 2; ++_i) \
        __builtin_amdgcn_global_load_lds((const unsigned*)((const char*)(gbase) + (voff)[_i]), (PG8_LAS unsigned*)(lds + (bufoff) + ldsw + _i * 8192), 16, 0, 0); } while (0)
#define PG8_LDA(dst, b, h) do { _Pragma("unroll") for (int m = 0; m < 4; ++m) _Pragma("unroll") for (int k = 0; k < 2; ++k) dst[m][k] = *(const PG8_LAS bf16x8*)(lds + PG8_SA(b, h) + aoff + m * 2048 + k * 1024); } while (0)
#define PG8_LDB(dst, b, h) do { _Pragma("unroll") for (int n = 0; n < 2; ++n) _Pragma("unroll") for (int k = 0; k < 2; ++k) dst[n][k] = *(const PG8_LAS bf16x8*)(lds + PG8_SB(b, h) + boff + n * 2048 + k * 1024); } while (0)
#define PG8_MMA(ai, bj, At, Bt) do { __builtin_amdgcn_s_setprio(1); _Pragma("unroll") for (int m = 0; m < 4; ++m) _Pragma("unroll") for (int n = 0; n < 2; ++n) _Pragma("unroll") for (int k = 0; k < 2; ++k) \
        acc[ai][bj][m][n] = __builtin_amdgcn_mfma_f32_16x16x32_bf16(Bt[n][k], At[m][k], acc[ai][bj][m][n], 0, 0, 0); __builtin_amdgcn_s_setprio(0); } while (0)
#define PG8_WAIT_V(n) asm volatile("s_waitcnt vmcnt(" #n ")" ::: "memory")
#define PG8_WAIT_L(n) asm volatile("s_waitcnt lgkmcnt(" #n ")" ::: "memory")
#define PG8_BAR __builtin_amdgcn_s_barrier()
#define PG8_SCHED __builtin_amdgcn_sched_barrier(0)
    Unit cur, nxt; int ui = 0;
    if (!S.next(0, cur)) return;
    f32x4 acc[2][2][4][2];
#pragma unroll
    for (int a = 0; a < 2; ++a)
#pragma unroll
        for (int b = 0; b < 2; ++b)
#pragma unroll
            for (int m = 0; m < 4; ++m)
#pragma unroll
                for (int n = 0; n < 2; ++n) acc[a][b][m][n] = (f32x4){0.f, 0.f, 0.f, 0.f};
    bf16x8 At[4][2], B0[2][2], B1[2][2];
    const char* cA = (const char*)g.A + (size_t)cur.gz * g.gsA * 2 + (size_t)cur.pm * tstepA; const char* cB = (const char*)g.Bt + (size_t)cur.gz * g.gsB * 2 + (size_t)cur.pn * tstepB;
    S.a_ready(cur);
    if constexpr (SP2) {
        PG8_STAGE(PG8_SB(0, 0), cB, voffB); PG8_STAGE(PG8_SB(0, 1), cB + hstepB, voffB); PG8_STAGE(PG8_SA(0, 0), cA, voffA); PG8_STAGE(PG8_SA(0, 1), cA + hstepA, voffA);
        if (wr == 1) PG8_BAR;
        PG8_WAIT_V(2); PG8_BAR;
        PG8_STAGE(PG8_SB(1, 0), cB + kstep, voffB); PG8_STAGE(PG8_SA(1, 0), cA + kstep, voffA); PG8_STAGE(PG8_SB(1, 1), cB + hstepB + kstep, voffB);
        PG8_WAIT_V(6); PG8_BAR;
    } else {
        PG8_STAGE(PG8_SB(0, 0), cB, voffB); PG8_STAGE(PG8_SA(0, 0), cA, voffA); PG8_STAGE(PG8_SB(0, 1), cB + hstepB, voffB); PG8_STAGE(PG8_SA(0, 1), cA + hstepA, voffA);
        if (wr == 1) PG8_BAR;
        PG8_WAIT_V(4); PG8_BAR;
        PG8_STAGE(PG8_SB(1, 0), cB + kstep, voffB); PG8_STAGE(PG8_SA(1, 0), cA + kstep, voffA); PG8_STAGE(PG8_SB(1, 1), cB + hstepB + kstep, voffB);
        PG8_WAIT_V(6); PG8_BAR;
    }
    for (;;) {
        const bool has_next = S.next(ui + 1, nxt);
        const char* nA = has_next ? (const char*)g.A + (size_t)nxt.gz * g.gsA * 2 + (size_t)nxt.pm * tstepA : cA; const char* nB = has_next ? (const char*)g.Bt + (size_t)nxt.gz * g.gsB * 2 + (size_t)nxt.pn * tstepB : cB;
        for (int t = 0; t < nt; t += 2) {
            const bool last = (t == nt - 2);
            const char* a1 = cA + (size_t)(t + 1) * kstep;
            const char* a2 = last ? nA : cA + (size_t)(t + 2) * kstep; const char* b2 = last ? nB : cB + (size_t)(t + 2) * kstep;
            const char* a3 = a2 + kstep; const char* b3 = b2 + kstep;
            if (last && has_next) S.a_ready(nxt);
            if constexpr (SP2) {
            PG8_LDB(B0, 0, 0); PG8_LDB(B1, 0, 1); PG8_SCHED; PG8_LDA(At, 0, 0); PG8_STAGE(PG8_SA(1, 1), a1 + hstepA, voffA);
            PG8_WAIT_V(8); PG8_WAIT_L(0); PG8_BAR; PG8_MMA(0, 0, At, B0); PG8_MMA(0, 1, At, B1); PG8_BAR; PG8_SCHED;
            PG8_LDA(At, 0, 1); PG8_STAGE(PG8_SB(0, 0), b2, voffB); PG8_STAGE(PG8_SB(0, 1), b2 + hstepB, voffB); PG8_STAGE(PG8_SA(0, 0), a2, voffA);
            PG8_WAIT_V(8); PG8_WAIT_L(0); PG8_BAR; PG8_MMA(1, 0, At, B0); PG8_MMA(1, 1, At, B1); PG8_BAR; PG8_SCHED;
            PG8_LDB(B0, 1, 0); PG8_LDB(B1, 1, 1); PG8_SCHED; PG8_LDA(At, 1, 0); PG8_STAGE(PG8_SA(0, 1), a2 + hstepA, voffA);
            PG8_WAIT_V(8); PG8_WAIT_L(0); PG8_BAR; PG8_MMA(0, 0, At, B0); PG8_MMA(0, 1, At, B1); PG8_BAR; PG8_SCHED;
            PG8_LDA(At, 1, 1); PG8_STAGE(PG8_SB(1, 0), b3, voffB); PG8_STAGE(PG8_SB(1, 1), b3 + hstepB, voffB); PG8_STAGE(PG8_SA(1, 0), a3, voffA);
            PG8_WAIT_V(8); PG8_WAIT_L(0); PG8_BAR; PG8_MMA(1, 0, At, B0); PG8_MMA(1, 1, At, B1); PG8_BAR; PG8_SCHED;
            } else {
            PG8_LDB(B0, 0, 0); PG8_SCHED; PG8_LDA(At, 0, 0); PG8_STAGE(PG8_SA(1, 1), a1 + hstepA, voffA);
            PG8_WAIT_L(8); PG8_BAR; PG8_WAIT_L(0); PG8_MMA(0, 0, At, B0); PG8_BAR; PG8_SCHED;
            PG8_LDB(B1, 0, 1); PG8_STAGE(PG8_SB(0, 0), b2, voffB);
            PG8_BAR; PG8_WAIT_L(0); PG8_MMA(0, 1, At, B1); PG8_BAR;
            PG8_LDA(At, 0, 1); PG8_STAGE(PG8_SA(0, 0), a2, voffA);
            PG8_BAR; PG8_WAIT_L(0); PG8_MMA(1, 0, At, B0); PG8_BAR; PG8_SCHED;
            PG8_STAGE(PG8_SB(0, 1), b2 + hstepB, voffB);
            PG8_WAIT_V(6); PG8_BAR; PG8_MMA(1, 1, At, B1); PG8_BAR;
            PG8_LDB(B0, 1, 0); PG8_SCHED; PG8_LDA(At, 1, 0); PG8_STAGE(PG8_SA(0, 1), a2 + hstepA, voffA);
            PG8_WAIT_L(8); PG8_BAR; PG8_WAIT_L(0); PG8_MMA(0, 0, At, B0); PG8_BAR; PG8_SCHED;
            PG8_LDB(B1, 1, 1); PG8_STAGE(PG8_SB(1, 0), b3, voffB);
            PG8_BAR; PG8_WAIT_L(0); PG8_MMA(0, 1, At, B1); PG8_BAR;
            PG8_LDA(At, 1, 1); PG8_STAGE(PG8_SA(1, 0), a3, voffA);
            PG8_BAR; PG8_WAIT_L(0); PG8_MMA(1, 0, At, B0); PG8_BAR; PG8_SCHED;
            PG8_STAGE(PG8_SB(1, 1), b3 + hstepB, voffB);
            PG8_WAIT_V(6); PG8_BAR; PG8_MMA(1, 1, At, B1); PG8_BAR;
            }
        }
        if constexpr (ALIGN_EPI) { if (wr == 0) PG8_BAR; }
        if constexpr (!Epi::AFTER_DRAIN) { E(acc, cur, wr, wc, fr, fq); S.done(cur); }
        if (!has_next) break;
#pragma unroll
        for (int a = 0; a < 2; ++a)
#pragma unroll
            for (int b = 0; b < 2; ++b)
#pragma unroll
                for (int m = 0; m < 4; ++m)
#pragma unroll
                    for (int n = 0; n < 2; ++n) acc[a][b][m][n] = (f32x4){0.f, 0.f, 0.f, 0.f};
        cur = nxt; cA = nA; cB = nB; ++ui;
        if constexpr (ALIGN_EPI) { if (wr == 1) PG8_BAR; }
    }
    PG8_WAIT_V(0);
    if constexpr (!ALIGN_EPI) { if (wr == 0) PG8_BAR; }
    PG8_BAR;
    if constexpr (Epi::AFTER_DRAIN) { E.fused(acc, cur, wr, wc, fr, fq, lds, wid, lane); S.done(cur); }
#undef PG8_SA
#undef PG8_SB
#undef PG8_STAGE
#undef PG8_LDA
#undef PG8_LDB
#undef PG8_MMA
#undef PG8_WAIT_V
#undef PG8_WAIT_L
#undef PG8_BAR
#undef PG8_SCHED
}
}
#include <hip/hip_bf16.h>
#include <cmath>
namespace attn_body {
using bf16=__hip_bfloat16;
using bf16x8=__attribute__((ext_vector_type(8)))short;
using s16x4=__attribute__((ext_vector_type(4)))short;
using f32x16=__attribute__((ext_vector_type(16)))float;
using u32x4=__attribute__((ext_vector_type(4)))unsigned;
using f32x4=__attribute__((ext_vector_type(4)))float;
constexpr int BATCH=4,NHEAD=8,SEQ=4096,D=64,DM=NHEAD*D,OPITCH=1024;
constexpr int NW=8,QBLK=32,QB=QBLK*NW,KVBLK=64,NQB=SEQ/QB;
constexpr int ATTN_PITCH=DM, ATTN_UNIT_ROWS=QB;
__device__ __forceinline__ int crow(int r,int hi){return (r&3)+8*(r>>2)+4*hi;}
#define SBAR() __builtin_amdgcn_sched_barrier(0)
__device__ __forceinline__ void cmask(f32x16&p0,f32x16&p1,int jb,int qrel,int hi){
  const float NEG=-INFINITY; int kb=64*jb+4*hi;
  #pragma unroll
  for(int r=0;r<16;++r){int kv=kb+(r&3)+8*(r>>2); if(kv>qrel)p0[r]=NEG; if(kv+32>qrel)p1[r]=NEG;}
}

constexpr int NSLOT=3, SLOTB=8192;
constexpr int LDS_K=0, LDS_V=NSLOT*SLOTB, LDS_WS=2*NSLOT*SLOTB, LDS_OST=LDS_WS+NW*64*4, LDS_CB=LDS_OST+NW*4096, LDS_BYTES=LDS_CB+SEQ*4;
constexpr float C2=0.125f*1.4426950408889634f;
__device__ __forceinline__ void glds16(const void*gsrc,unsigned lds_dst){unsigned keep;
  asm volatile("s_mov_b32 %0, m0\n\ts_mov_b32 m0, %2\n\ts_nop 0\n\tglobal_load_lds_dwordx4 %1, off\n\ts_mov_b32 m0, %0":"=&s"(keep):"v"(gsrc),"s"(lds_dst):"memory");}
__device__ __forceinline__ float max3f(float a,float b,float c){float r;asm("v_max3_f32 %0, %1, %2, %3":"=v"(r):"v"(a),"v"(b),"v"(c));return r;}
__device__ __forceinline__ float max2f(float a,float b){float r;asm("v_max_f32_e32 %0, %1, %2":"=v"(r):"v"(a),"v"(b));return r;}
__device__ __forceinline__ float fadd_s(float a,float b){float r;asm("v_add_f32_e32 %0, %1, %2":"=v"(r):"v"(a),"v"(b));return r;}
__device__ __forceinline__ float fsub_s(float a,float b){float r;asm("v_sub_f32_e32 %0, %1, %2":"=v"(r):"v"(a),"v"(b));return r;}
typedef float f32x2_t __attribute__((ext_vector_type(2))); typedef __bf16 bf16x2_t __attribute__((ext_vector_type(2)));
__device__ __forceinline__ unsigned cvtpk_s(float lo,float hi){f32x2_t v={lo,hi};bf16x2_t b=__builtin_convertvector(v,bf16x2_t);return __builtin_bit_cast(unsigned,b);}
#define WAIT_BAR(N) asm volatile("s_waitcnt vmcnt(" #N ") lgkmcnt(0)\n\ts_barrier":::"memory")

__device__ __forceinline__ void qkt(f32x16&p0,f32x16&p1,const char*Kslot,const bf16x8*qr,const char*cbt,int r32,int hi){
  const char*kb=Kslot+hi*1024+r32*16;
  #pragma unroll
  for(int a=0;a<4;++a){ const f32x4 u0=*reinterpret_cast<const f32x4*>(cbt+hi*16+a*32), u1=*reinterpret_cast<const f32x4*>(cbt+128+hi*16+a*32);
    p0[4*a]=u0[0];p0[4*a+1]=u0[1];p0[4*a+2]=u0[2];p0[4*a+3]=u0[3]; p1[4*a]=u1[0];p1[4*a+1]=u1[1];p1[4*a+2]=u1[2];p1[4*a+3]=u1[3]; }
  #pragma unroll
  for(int d0=0;d0<4;++d0){
    const bf16x8 b0=*reinterpret_cast<const bf16x8*>(kb+d0*2048);
    const bf16x8 b1=*reinterpret_cast<const bf16x8*>(kb+d0*2048+512);
    p0=__builtin_amdgcn_mfma_f32_32x32x16_bf16(b0,qr[d0],p0,0,0,0);p1=__builtin_amdgcn_mfma_f32_32x32x16_bf16(b1,qr[d0],p1,0,0,0);}
}
typedef __attribute__((address_space(3))) const char* lds_cptr;
typedef short v4i16_t __attribute__((ext_vector_type(4)));
__device__ __forceinline__ void kload8(bf16x8*kf,lds_cptr kp){
  kf[0]=*(const __attribute__((address_space(3))) bf16x8*)(kp);      kf[1]=*(const __attribute__((address_space(3))) bf16x8*)(kp+512);
  kf[2]=*(const __attribute__((address_space(3))) bf16x8*)(kp+2048); kf[3]=*(const __attribute__((address_space(3))) bf16x8*)(kp+2560);
  kf[4]=*(const __attribute__((address_space(3))) bf16x8*)(kp+4096); kf[5]=*(const __attribute__((address_space(3))) bf16x8*)(kp+4608);
  kf[6]=*(const __attribute__((address_space(3))) bf16x8*)(kp+6144); kf[7]=*(const __attribute__((address_space(3))) bf16x8*)(kp+6656);
}
__device__ __forceinline__ void kload2(bf16x8*kf,lds_cptr kp,int j){ kf[2*j]=*(const __attribute__((address_space(3))) bf16x8*)(kp+j*2048); kf[2*j+1]=*(const __attribute__((address_space(3))) bf16x8*)(kp+j*2048+512); }
__device__ __forceinline__ s16x4 vtr(lds_cptr p){ return __builtin_bit_cast(s16x4,__builtin_amdgcn_ds_read_tr16_b64_v4i16((__attribute__((address_space(3))) v4i16_t*)p)); }
__device__ __forceinline__ float rowmax(const f32x16&p0,const f32x16&p1){
  float a=max3f(p0[0],p0[1],p1[0]),b=max3f(p0[2],p0[3],p1[1]);a=max3f(a,p1[2],p1[3]);
  #pragma unroll
  for(int r=4;r<16;r+=4){a=max3f(a,p0[r],p0[r+1]);b=max3f(b,p0[r+2],p0[r+3]);a=max3f(a,p1[r],p1[r+1]);b=max3f(b,p1[r+2],p1[r+3]);}
  const float m=max2f(a,b);
  auto rr=__builtin_amdgcn_permlane32_swap(__float_as_uint(m),__float_as_uint(m),false,false);
  return max2f(__uint_as_float(rr[0]),__uint_as_float(rr[1]));
}
__device__ __forceinline__ void pv(f32x16*o,int vb,bf16x8 pa0,bf16x8 pa1,bf16x8 pa2,bf16x8 pa3){
  #pragma unroll
  for(int d0=0;d0<2;++d0){s16x4 lo[4],hi[4];
    #pragma unroll
    for(int ks=0;ks<4;++ks){
      asm volatile("ds_read_b64_tr_b16 %0,%1 offset:%c2":"=&v"(lo[ks]):"v"(vb),"i"(d0*4096+ks*1024):"memory");
      asm volatile("ds_read_b64_tr_b16 %0,%1 offset:%c2":"=&v"(hi[ks]):"v"(vb),"i"(d0*4096+ks*1024+512):"memory");}
    asm volatile("s_waitcnt lgkmcnt(0)":::"memory");SBAR();
    #define PK(k) (bf16x8){lo[k][0],lo[k][1],lo[k][2],lo[k][3],hi[k][0],hi[k][1],hi[k][2],hi[k][3]}
    o[d0]=__builtin_amdgcn_mfma_f32_32x32x16_bf16(pa0,PK(0),o[d0],0,0,0);
    o[d0]=__builtin_amdgcn_mfma_f32_32x32x16_bf16(pa1,PK(1),o[d0],0,0,0);
    o[d0]=__builtin_amdgcn_mfma_f32_32x32x16_bf16(pa2,PK(2),o[d0],0,0,0);
    o[d0]=__builtin_amdgcn_mfma_f32_32x32x16_bf16(pa3,PK(3),o[d0],0,0,0);
    #undef PK
  }
}

#ifndef ATTN_STORE16
#define ATTN_STORE16(p,v) (*(u32x4*)(p)=(v))
#endif
template<int THRL> __device__ __forceinline__ void attn_unit(int b,int h,int qb,const bf16*Q,const bf16*__restrict__ K,const bf16*__restrict__ V,bf16*O,const float*__restrict__ CB,const float*__restrict__ NRM,char*shm,bool dry=false){
  int tid_=threadIdx.x; asm volatile("":"+v"(tid_)); const int tid=tid_,lane=tid&63,r32=lane&31,hi=lane>>5; const int wid=__builtin_amdgcn_readfirstlane(tid>>6);
  const long rowbase=(long)b*SEQ; const int q0=qb*QB;
  int t0;
  { const f32x4* cbg=reinterpret_cast<const f32x4*>(CB+(long)(b*NHEAD+h)*SEQ); f32x4* cbl=reinterpret_cast<f32x4*>(shm+LDS_CB); const int nv=(q0+QB)/4;
    for(int i=tid;i<nv;i+=NW*64) cbl[i]=cbg[i];
    const float bnd=NRM[b*NHEAD+h]+36.f;
    asm volatile("s_waitcnt vmcnt(0) lgkmcnt(0)\n\ts_barrier":::"memory");
    const float*cbf=reinterpret_cast<const float*>(shm+LDS_CB); const int tc=2*lane; const int NT0=(q0+QB)/KVBLK;
    const bool ok=(tc<=NT0-4)&&(tc==0||cbf[64*tc-1]+bnd<=cbf[q0]);
    const unsigned long long mk=__ballot(ok); t0=2*(__popcll(mk)-1); t0=__builtin_amdgcn_readfirstlane(t0); }
  const bf16*Qw=Q+(rowbase+q0+wid*QBLK)*DM+h*D;
  const bf16*Kh=K+(rowbase+(long)t0*KVBLK)*DM+h*D,*Vh=V+(rowbase+(long)t0*KVBLK)*DM+h*D;
  const unsigned lds0=(unsigned)(uintptr_t)shm;
  float*wsf=(float*)(shm+LDS_WS)+wid*64;
  const bf16*ksrc=Kh+(long)lane*DM+wid*8;
  const bf16*vsrc=Vh+(long)(16*(wid&3)+(lane>>2))*DM+(wid>>2)*32+(lane&3)*8;
  const unsigned kdst=lds0+LDS_K+wid*1024, vdst=lds0+LDS_V+wid*1024;
  #define DMA_K(t,slot) glds16(ksrc+(long)(t)*KVBLK*DM,(unsigned)__builtin_amdgcn_readfirstlane(kdst+(slot)))
  #define DMA_V(t,slot) glds16(vsrc+(long)(t)*KVBLK*DM,(unsigned)__builtin_amdgcn_readfirstlane(vdst+(slot)))
  const int vb0=(int)(lds0+LDS_V)+((lane>>4)&1)*32+(lane&3)*8+(4*hi+((lane&15)>>2))*64;
  const char*Kbase=shm+LDS_K; bf16x8 kf[8];
  const lds_cptr shm3=(lds_cptr)shm; const lds_cptr kp0=shm3+LDS_K+hi*1024+r32*16; const lds_cptr vp0=shm3+LDS_V+((lane>>4)&1)*32+(lane&3)*8+(4*hi+((lane&15)>>2))*64;
  const int NT=(q0+QB)/KVBLK-t0;
  const lds_cptr cb3=(lds_cptr)shm+LDS_CB+t0*256;
  const float cb_own=*(const __attribute__((address_space(3))) float*)((lds_cptr)shm+LDS_CB+(q0+wid*QBLK+r32)*4);
  DMA_K(0,0);DMA_V(0,0);DMA_K(1,SLOTB);
  bf16x8 qr[4];
  #pragma unroll
  for(int d0=0;d0<4;++d0)qr[d0]=*reinterpret_cast<const bf16x8*>(&Qw[(long)r32*DM+d0*16+hi*8]);
  float mhat=0.f,l_reg=0.f;f32x16 o[2];o[0]=f32x16{};o[1]=f32x16{};
  const int qrel=wid*QBLK+r32;
  #define CMASK(P0,P1,t) do{int jb_=(t)-(NT-4); if(jb_>=0)cmask(P0,P1,jb_,qrel,hi);}while(0)
  bool resc=false;
  #define START(P0,P1) do{ const float rm=max2f(rowmax(P0,P1),cb_own); resc=false; \
    { const float dl=rm; mhat=fadd_s(mhat,dl); \
      _Pragma("unroll") for(int r=0;r<16;++r){P0[r]=fsub_s(P0[r],dl);P1[r]=fsub_s(P1[r],dl);} } \
    _Pragma("unroll") for(int r=0;r<16;++r)P0[r]=__builtin_amdgcn_exp2f(P0[r]); }while(0)
  #define RESC() do{ if(resc){ asm volatile("s_waitcnt lgkmcnt(0)":::"memory"); \
      _Pragma("unroll") for(int d_=0;d_<2;++d_) _Pragma("unroll") for(int r=0;r<16;++r)o[d_][r]*=wsf[crow(r,hi)]; } }while(0)
  f32x16 pA0,pA1,pB0,pB1;
  int sl_prev=0,sl_cur=0,sl_next=SLOTB;
  #define ROT() do{sl_prev=sl_cur;sl_cur=sl_next;sl_next=(sl_next==(NSLOT-1)*SLOTB)?0:sl_next+SLOTB;}while(0)
  DMA_K(2,2*SLOTB);
  WAIT_BAR(3);
  qkt(pA0,pA1,Kbase,qr,shm+LDS_CB+t0*256,r32,hi);asm volatile("s_nop 15\n\ts_nop 7":"+v"(pA0),"+v"(pA1));CMASK(pA0,pA1,0);
  START(pA0,pA1);
  _Pragma("unroll") for(int r=0;r<16;++r)pA1[r]=__builtin_amdgcn_exp2f(pA1[r]);
  WAIT_BAR(0);
  DMA_K(3,0);DMA_V(1,SLOTB);
  ROT();
  kload8(kf,kp0+sl_cur);
  WAIT_BAR(2);
  s16x4 vlo[8],vhi[8]; u32x4 pw0,pw1,pw2,pw3;
  #define PKW(P,B) cvtpk_s(P[B],P[B+1])
  #define PAF(k) __builtin_bit_cast(bf16x8,pw##k)
  #define VFR(i) (bf16x8){vlo[i][0],vlo[i][1],vlo[i][2],vlo[i][3],vhi[i][0],vhi[i][1],vhi[i][2],vhi[i][3]}
  #define PIN(x) asm volatile("":"+v"(x))
  #define MX3(a,b,c) __builtin_fmaxf(__builtin_fmaxf((a),(b)),(c))
  #define GAPA(MF,A0,A1,A2,A3,W0,W1,PW) do{ MF; sacc+=A0; sacc+=A1; sacc+=A2; sacc+=A3; PIN(sacc); W0; W1; PIN(PW); SBAR(); }while(0)
  #define EX(v) __builtin_amdgcn_exp2f(v)
  #define GAPB(MF,X,B) do{ MF; X[B]=EX(X[B]); X[B+1]=EX(X[B+1]); X[B+2]=EX(X[B+2]); X[B+3]=EX(X[B+3]); PIN(X); SBAR(); }while(0)
  #define VRD(i) do{ vlo[i]=vtr(vp_+(((i)>>2)*4096+((i)&3)*1024)); vhi[i]=vtr(vp_+(((i)>>2)*4096+((i)&3)*1024+512)); }while(0)
  #define KRD(G,j) do{ if(G){ kload2(kf,kp0+sl_next,j); SBAR(); } }while(0)
  #define STEP(C0,C1,P0,P1,t,GK,GV,GL) do{ SBAR(); \
    const lds_cptr vp_=vp0+sl_prev; \
    VRD(0); SBAR(); float sacc=(P0[0]+P0[1]); \
    GAPA(C0=__builtin_amdgcn_mfma_f32_32x32x16_bf16(kf[0],qr[0],C0,0,0,0), P0[2],P0[3],P0[4],P0[5],     pw0[0]=PKW(P0,0), pw0[1]=PKW(P0,2), pw0); \
    VRD(4); SBAR(); GAPA(C1=__builtin_amdgcn_mfma_f32_32x32x16_bf16(kf[1],qr[0],C1,0,0,0), P0[6],P0[7],P0[8],P0[9],     pw0[2]=PKW(P0,4), pw0[3]=PKW(P0,6), pw0); \
    VRD(1); SBAR(); GAPA(C0=__builtin_amdgcn_mfma_f32_32x32x16_bf16(kf[2],qr[1],C0,0,0,0),   P0[10],P0[11],P0[12],P0[13], pw1[0]=PKW(P0,8), pw1[1]=PKW(P0,10), pw1); \
    VRD(5); SBAR(); GAPA(C1=__builtin_amdgcn_mfma_f32_32x32x16_bf16(kf[3],qr[1],C1,0,0,0),   P0[14],P0[15],P1[0],P1[1],   pw1[2]=PKW(P0,12),pw1[3]=PKW(P0,14), pw1); \
    VRD(2); SBAR(); GAPA(C0=__builtin_amdgcn_mfma_f32_32x32x16_bf16(kf[4],qr[2],C0,0,0,0),   P1[2],P1[3],P1[4],P1[5],     pw2[0]=PKW(P1,0), pw2[1]=PKW(P1,2), pw2); \
    VRD(6); SBAR(); GAPA(C1=__builtin_amdgcn_mfma_f32_32x32x16_bf16(kf[5],qr[2],C1,0,0,0),   P1[6],P1[7],P1[8],P1[9],     pw2[2]=PKW(P1,4), pw2[3]=PKW(P1,6), pw2); \
    VRD(3); SBAR(); GAPA(C0=__builtin_amdgcn_mfma_f32_32x32x16_bf16(kf[6],qr[3],C0,0,0,0),   P1[10],P1[11],P1[12],P1[13], pw3[0]=PKW(P1,8), pw3[1]=PKW(P1,10), pw3); \
    VRD(7); SBAR(); GAPA(C1=__builtin_amdgcn_mfma_f32_32x32x16_bf16(kf[7],qr[3],C1,0,0,0),   P1[14],P1[15],0.f,0.f,       pw3[2]=PKW(P1,12),pw3[3]=PKW(P1,14), pw3); \
    l_reg+=sacc; \
    if(GK){DMA_K((t)+3,sl_cur);} if(GV){DMA_V((t)+1,sl_next);} \
    CMASK(C0,C1,t); \
    { float a=MX3(C0[0],C0[1],C1[0]),b=MX3(C0[2],C0[3],C1[1]); a=MX3(a,C1[2],C1[3]); \
      _Pragma("unroll") for(int r=4;r<16;r+=4){a=MX3(a,C0[r],C0[r+1]);b=MX3(b,C0[r+2],C0[r+3]);a=MX3(a,C1[r],C1[r+1]);b=MX3(b,C1[r+2],C1[r+3]);} \
      float rm=__builtin_fmaxf(a,b); { auto rr=__builtin_amdgcn_permlane32_swap(__float_as_uint(rm),__float_as_uint(rm),false,false); rm=__builtin_fmaxf(__uint_as_float(rr[0]),__uint_as_float(rr[1])); } \
      resc=false; \
      if(__builtin_expect(__any(rm>(float)THRL),0)){ const float dl=__builtin_fmaxf(rm,0.f); mhat+=dl; \
        _Pragma("unroll") for(int r=0;r<16;++r){C0[r]-=dl;C1[r]-=dl;} \
        const float f=__builtin_amdgcn_exp2f(-dl); l_reg*=f; if(hi==0)wsf[r32]=f; resc=true; } } \
    SBAR(); \
    { const __attribute__((address_space(3))) f32x4* cbp_=(const __attribute__((address_space(3))) f32x4*)(cb3+((t)+1)*256+hi*16); \
      _Pragma("unroll") for(int a_=0;a_<4;++a_){ const f32x4 u0_=cbp_[2*a_], u1_=cbp_[8+2*a_]; \
        P0[4*a_]=u0_[0];P0[4*a_+1]=u0_[1];P0[4*a_+2]=u0_[2];P0[4*a_+3]=u0_[3]; P1[4*a_]=u1_[0];P1[4*a_+1]=u1_[1];P1[4*a_+2]=u1_[2];P1[4*a_+3]=u1_[3]; } } SBAR(); \
    GAPB(o[0]=__builtin_amdgcn_mfma_f32_32x32x16_bf16(PAF(0),VFR(0),o[0],0,0,0), C0,0); \
    GAPB(o[1]=__builtin_amdgcn_mfma_f32_32x32x16_bf16(PAF(0),VFR(4),o[1],0,0,0), C0,4); \
    KRD(GL,0); GAPB(o[0]=__builtin_amdgcn_mfma_f32_32x32x16_bf16(PAF(1),VFR(1),o[0],0,0,0), C0,8); \
    KRD(GL,1); GAPB(o[1]=__builtin_amdgcn_mfma_f32_32x32x16_bf16(PAF(1),VFR(5),o[1],0,0,0), C0,12); \
    KRD(GL,2); GAPB(o[0]=__builtin_amdgcn_mfma_f32_32x32x16_bf16(PAF(2),VFR(2),o[0],0,0,0), C1,0); \
    KRD(GL,3); GAPB(o[1]=__builtin_amdgcn_mfma_f32_32x32x16_bf16(PAF(2),VFR(6),o[1],0,0,0), C1,4); \
    GAPB(o[0]=__builtin_amdgcn_mfma_f32_32x32x16_bf16(PAF(3),VFR(3),o[0],0,0,0), C1,8); \
    GAPB(o[1]=__builtin_amdgcn_mfma_f32_32x32x16_bf16(PAF(3),VFR(7),o[1],0,0,0), C1,12); \
    _Pragma("unroll") for(int r_=0;r_<16;++r_){P0[r_]-=mhat;P1[r_]-=mhat;} \
    }while(0)
  { const __attribute__((address_space(3))) f32x4* cbp_=(const __attribute__((address_space(3))) f32x4*)(cb3+256+hi*16);
    #pragma unroll
    for(int a_=0;a_<4;++a_){ const f32x4 u0_=cbp_[2*a_], u1_=cbp_[8+2*a_];
      pB0[4*a_]=u0_[0]-mhat;pB0[4*a_+1]=u0_[1]-mhat;pB0[4*a_+2]=u0_[2]-mhat;pB0[4*a_+3]=u0_[3]-mhat;
      pB1[4*a_]=u1_[0]-mhat;pB1[4*a_+1]=u1_[1]-mhat;pB1[4*a_+2]=u1_[2]-mhat;pB1[4*a_+3]=u1_[3]-mhat; } }
  int t=1;
  #undef CMASK
  #define CMASK(P0,P1,t) do{}while(0)
  for(;t+5<NT;t+=2){
    STEP(pB0,pB1,pA0,pA1,t,true,true,true);     WAIT_BAR(2); RESC(); ROT();
    STEP(pA0,pA1,pB0,pB1,t+1,true,true,true);   WAIT_BAR(2); RESC(); ROT();
  }
  #undef CMASK
  #define CMASK(P0,P1,t) do{int jb_=(t)-(NT-4); if(jb_>=0)cmask(P0,P1,jb_,qrel,hi);}while(0)
  #define ENDW(tt) do{ if((tt)+3<NT){WAIT_BAR(2);} else if((tt)+2<NT){WAIT_BAR(1);} else {WAIT_BAR(0);} }while(0)
  for(;t+1<NT;t+=2){
    STEP(pB0,pB1,pA0,pA1,t,(t+3<NT),(t+1<NT),(t+1<NT));       ENDW(t);   RESC(); ROT();
    STEP(pA0,pA1,pB0,pB1,t+1,(t+4<NT),(t+2<NT),(t+2<NT));     ENDW(t+1); RESC(); ROT();
  }
  STEP(pB0,pB1,pA0,pA1,NT-1,false,false,false); RESC();
  { float sacc=pB0[0]+pB0[1]; _Pragma("unroll") for(int r=2;r<16;++r)sacc+=pB0[r]; _Pragma("unroll") for(int r=0;r<16;++r)sacc+=pB1[r]; l_reg+=sacc;
    pw0=(u32x4){PKW(pB0,0),PKW(pB0,2),PKW(pB0,4),PKW(pB0,6)};pw1=(u32x4){PKW(pB0,8),PKW(pB0,10),PKW(pB0,12),PKW(pB0,14)};pw2=(u32x4){PKW(pB1,0),PKW(pB1,2),PKW(pB1,4),PKW(pB1,6)};pw3=(u32x4){PKW(pB1,8),PKW(pB1,10),PKW(pB1,12),PKW(pB1,14)};
    SBAR(); pv(o,vb0+sl_cur,PAF(0),PAF(1),PAF(2),PAF(3)); }
  #undef PKW
  #undef PAF
  #undef VFR
  #undef PIN
  #undef MX3
  #undef GAPA
  #undef GAPB
  #undef EX
  #undef VRD
  #undef KRD
  #undef STEP
  #undef ENDW
  {auto rr=__builtin_amdgcn_permlane32_swap(__float_as_uint(l_reg),__float_as_uint(l_reg),false,false);l_reg=__uint_as_float(rr[0])+__uint_as_float(rr[1]);}
  if(hi==0)wsf[32+r32]=l_reg;asm volatile("s_waitcnt lgkmcnt(0)":::"memory");
  float rli[16];
  #pragma unroll
  for(int r=0;r<16;++r)rli[r]=__builtin_amdgcn_rcpf(wsf[32+crow(r,hi)]);
  bf16*Ow=O+(rowbase+q0+wid*QBLK)*OPITCH+h*D;
  { bf16*stg=(bf16*)(shm+LDS_OST)+wid*2048;
    #pragma unroll
    for(int r=0;r<16;++r){const int orow=crow(r,hi);
      #pragma unroll
      for(int d0=0;d0<2;++d0)stg[orow*64+d0*32+r32]=__float2bfloat16(o[d0][r]*rli[r]);}
    asm volatile("s_waitcnt lgkmcnt(0)":::"memory");
    #pragma unroll
    for(int i=0;i<4;++i){const int row=i*8+(lane>>3),ch=lane&7; const u32x4 v=*(const u32x4*)(stg+row*64+ch*8); bf16*dst=Ow+(long)row*OPITCH+ch*8; const u32x4 gv=*(const u32x4*)dst; u32x4 w;
      #pragma unroll
      for(int j=0;j<4;++j){ const float a0=__uint_as_float(v[j]<<16)*__uint_as_float(gv[j]<<16), a1=__uint_as_float(v[j]&0xffff0000u)*__uint_as_float(gv[j]&0xffff0000u); w[j]=cvtpk_s(a0,a1); }
      if(!dry)*(u32x4*)dst=w;} }
  asm volatile("s_waitcnt lgkmcnt(0)\n\ts_barrier":::"memory");
  #undef DMA_K
  #undef DMA_V
  #undef CMASK
  #undef START
  #undef RESC
  #undef ROT
}
constexpr int ATTN_LDS_BYTES=LDS_BYTES;
struct AttnTensors { const bf16* Q; const bf16* K; const bf16* V; bf16* O; const float* CB; const float* NRM; };
struct AttnUnit { int bh; int qb; };
struct StaticOrder {
  int vcu;
  __device__ __forceinline__ explicit StaticOrder(int grid,int block):vcu((block%8)*(grid/8)+block/8){}
  __device__ __forceinline__ bool next(int i,AttnUnit&u)const{ if(i>=2)return false; const int s=vcu&7; u.bh=vcu>>3; u.qb=(i==0)?15-s:s; return true; }
  __device__ __forceinline__ void a_ready(const AttnUnit&)const{}
  __device__ __forceinline__ void done(const AttnUnit&)const{}
};
template<class Sched,int THRL=8> __device__ __forceinline__ void attn_phase(char*lds,const AttnTensors&T,const Sched&S,bool dry=false){
  AttnUnit u;
  for(int i=0;S.next(i,u);++i){ S.a_ready(u); attn_unit<THRL>(u.bh/NHEAD,u.bh%NHEAD,u.qb,T.Q,T.K,T.V,T.O,T.CB,T.NRM,lds,dry); S.done(u); }
}
#undef SBAR
#undef WAIT_BAR
}
#include <hip/hip_cooperative_groups.h>
namespace cg = cooperative_groups;
#define LAS __attribute__((address_space(3)))
typedef unsigned short bf16;
typedef float f32x4 __attribute__((ext_vector_type(4)));
typedef float f32x2 __attribute__((ext_vector_type(2)));
typedef unsigned u32x4 __attribute__((ext_vector_type(4)));
typedef unsigned u32x2 __attribute__((ext_vector_type(2)));
typedef short bf16x8 __attribute__((ext_vector_type(8)));
typedef short bf16x4 __attribute__((ext_vector_type(4)));

constexpr int NWAVES = 8, NTHR = 512;
constexpr int BATCH = 4, SEQ = 4096, DM = 1024, DEPTH = 4, M = BATCH * SEQ;
constexpr int NIN = 3592, NF = 3584;
constexpr int T5 = 32, NCH5 = M / T5, KA5 = 640, NG5 = 16;
constexpr float EPS = 1e-6f;
constexpr float LOG2E = 1.4426950408889634f;

constexpr size_t MiB = 1u << 20;
constexpr size_t WS_WIN = 1 * MiB, WS_WO = 31 * MiB, WS_WGLU = 39 * MiB, WS_ROPE = 40 * MiB, WS_MF = 41 * MiB, WS_WB = 81 * MiB;
constexpr size_t WS_LAM = 90 * MiB, WS_LOGF = 90 * MiB + 65536, WS_CB = WS_LOGF + 524288, WS_SS = WS_CB + 524288, WS_NRM = WS_SS + 131072, WS_XBUF = WS_NRM + 4096;
constexpr size_t WS_XN = 92 * MiB, WS_E = WS_XN, WS_UPD = WS_XN + 4 * MiB, WS_STATE = WS_XN + 20 * MiB;
constexpr size_t WS_QO = 124 * MiB, WS_KB = 140 * MiB, WS_VB = 156 * MiB, WS_SUA = 172 * MiB, WS_RQ = 182 * MiB, WS_RK = 190 * MiB, WS_RKT = 198 * MiB, WS_YS5 = WS_XN + 4 * MiB;
constexpr size_t WS_RVT = 206 * MiB, WS_GATE = 214 * MiB, WS_END = 246 * MiB;

constexpr int RING_BYTES = 131072, LDS_BYTES = 147456;

struct Args { const float* in[16]; float* out; unsigned char* ws; };

__device__ __forceinline__ float bf2f(unsigned short b) { return __uint_as_float((unsigned)b << 16); }
__device__ __forceinline__ float bflo(unsigned w) { return __uint_as_float(w << 16); }
__device__ __forceinline__ float bfhi(unsigned w) { return __uint_as_float(w & 0xffff0000u); }
__device__ __forceinline__ unsigned pk2(float lo, float hi) { return pg8::cvt_pk_bf16(lo, hi); }
__device__ __forceinline__ unsigned short f2bf(float f) { return (unsigned short)(pg8::cvt_pk_bf16(f, 0.f) & 0xffffu); }
__device__ __forceinline__ float wave_sum(float v) {
#pragma unroll
    for (int o = 1; o < 64; o <<= 1) v += __shfl_xor(v, o);
    return v;
}
__device__ __forceinline__ float lg2_gamma(int hh) { return __builtin_amdgcn_logf(1.0f - __builtin_amdgcn_exp2f(-5.0f - (float)hh)); }

__device__ __forceinline__ int win_col(int n) {
    if (n < 1536) return n;
    if (n < 1792) return n + 8;
    if (n < 2304) { const bool q = n < 2048; const int base = q ? 1792 : 2048; const int hh = (n - base) >> 6, pos = (n - base) & 63; const int d = (pos & 1) ? 32 + (pos >> 1) : (pos >> 1); return (q ? 1800 : 2056) + hh * 64 + d; }
    return n + 8;
}
template <bool MAP> __device__ __forceinline__ void p0_transpose_item(const float* W, int K, int Nsrc, int Ndst, bf16* WT, LAS float* scr, int item, int lane) {
    const int nblk = Ndst / 32, kb = item / nblk, nb = item % nblk, k0 = 64 * kb, n0 = 32 * nb;
    const int sc = MAP ? win_col(n0 + (lane & 31)) : n0 + (lane & 31);
    float wv[32];
#pragma unroll
    for (int i = 0; i < 32; ++i) { const int kk = 2 * i + (lane >> 5); wv[i] = (MAP && sc < 0) ? 0.f : W[(size_t)(k0 + kk) * Nsrc + (sc < 0 ? 0 : sc)]; }
#pragma unroll
    for (int i = 0; i < 32; ++i) { const int kk = 2 * i + (lane >> 5); scr[kk * 33 + (lane & 31)] = wv[i]; }
    asm volatile("s_waitcnt lgkmcnt(0)" ::: "memory");
    const int c = lane & 7;
#pragma unroll
    for (int j = 0; j < 4; ++j) { const int n = (lane >> 3) + 8 * j; const LAS float* s = scr + (8 * c) * 33 + n;
        u32x4 o; o.x = pk2(s[0 * 33], s[1 * 33]); o.y = pk2(s[2 * 33], s[3 * 33]); o.z = pk2(s[4 * 33], s[5 * 33]); o.w = pk2(s[6 * 33], s[7 * 33]);
        *(u32x4*)(WT + (size_t)(n0 + n) * K + k0 + 8 * c) = o; }
    asm volatile("s_waitcnt lgkmcnt(0)" ::: "memory");
}

__device__ __forceinline__ void s5_prep(const Args& a, int l, int g, LAS float* L, int tid) {
    LAS float* LPr = L;
    LAS float* LPi = L + 33 * 64;
    LAS float* Bbr = L + 66 * 64;
    LAS float* Bbi = Bbr + 1024;
    LAS float* Cr = Bbi + 1024;
    LAS float* Ci = Cr + 1024;
    LAS float* KT = Ci + 1024;
    const float* a_re = a.in[4] + (size_t)(l * 16 + g) * 64; const float* a_im = a.in[5] + (size_t)(l * 16 + g) * 64;
    const float* b_re = a.in[6] + (size_t)(l * 16 + g) * 1024; const float* b_im = a.in[7] + (size_t)(l * 16 + g) * 1024;
    const float* c_re = a.in[8] + (size_t)(l * 16 + g) * 1024; const float* c_im = a.in[9] + (size_t)(l * 16 + g) * 1024;
    const float log_dt = a.in[11][l * 16 + g];
    bf16* MF = (bf16*)(a.ws + WS_MF) + (size_t)(l * 16 + g) * 512 * KA5;
    bf16* WB = (bf16*)(a.ws + WS_WB) + (size_t)(l * 16 + g) * 128 * 512;
    float* LAM = (float*)(a.ws + WS_LAM) + (size_t)(l * 16 + g) * 128;
    if (tid < 64) {
        const int p = tid;
        const double dt = exp((double)log_dt), ar = (double)a_re[p], ai = (double)a_im[p];
        const double mag = exp(ar * dt); double sn, cs; sincos(ai * dt, &sn, &cs);
        const double lr = mag * cs, li = mag * sn, den = ar * ar + ai * ai;
        const double fr = ((lr - 1.0) * ar + li * ai) / den, fi = (li * ar - (lr - 1.0) * ai) / den;
#pragma unroll 4
        for (int h = 0; h < 16; ++h) { const double br = (double)b_re[p * 16 + h], bi = (double)b_im[p * 16 + h]; Bbr[p * 16 + h] = (float)(fr * br - fi * bi); Bbi[p * 16 + h] = (float)(fr * bi + fi * br); }
        double pr = 1.0, pi = 0.0;
        for (int j = 0; j <= 32; ++j) { LPr[j * 64 + p] = (float)pr; LPi[j * 64 + p] = (float)pi; const double nr = pr * lr - pi * li, ni = pr * li + pi * lr; pr = nr; pi = ni; }
        LAM[p] = LPr[32 * 64 + p]; LAM[64 + p] = LPi[32 * 64 + p];
    }
    for (int i = tid; i < 1024; i += NTHR) { const int h = i >> 6, p = i & 63; Cr[p * 16 + h] = c_re[i]; Ci[p * 16 + h] = c_im[i]; }
    __syncthreads();
    { const int j = tid >> 4, h = tid & 15; float acc[16];
#pragma unroll
      for (int e = 0; e < 16; ++e) acc[e] = 0.f;
      for (int p = 0; p < 64; ++p) { const float cr = Cr[p * 16 + h], ci = Ci[p * 16 + h], lr = LPr[j * 64 + p], li = LPi[j * 64 + p]; const float clr = cr * lr - ci * li, cli = cr * li + ci * lr;
#pragma unroll
          for (int q = 0; q < 4; ++q) { const f32x4 br = *(const LAS f32x4*)(Bbr + p * 16 + 4 * q), bi = *(const LAS f32x4*)(Bbi + p * 16 + 4 * q);
              acc[4 * q] += clr * br.x - cli * bi.x; acc[4 * q + 1] += clr * br.y - cli * bi.y; acc[4 * q + 2] += clr * br.z - cli * bi.z; acc[4 * q + 3] += clr * br.w - cli * bi.w; } }
#pragma unroll
      for (int e = 0; e < 16; ++e) KT[tid * 16 + e] = acc[e]; }
    __syncthreads();
    for (int q = tid; q < 512 * 64; q += NTHR) {
        const int row = q >> 6, cp = q & 63, s = cp >> 1, h0 = (cp & 1) * 8, t = row >> 4, h = row & 15;
        u32x4 o = (u32x4){0u, 0u, 0u, 0u};
        if (s <= t) { const LAS float* k = KT + ((t - s) * 16 + h) * 16 + h0; o.x = pk2(k[0], k[1]); o.y = pk2(k[2], k[3]); o.z = pk2(k[4], k[5]); o.w = pk2(k[6], k[7]); }
        *(u32x4*)(MF + (size_t)row * KA5 + cp * 8) = o;
    }
    for (int q = tid; q < 512 * 16; q += NTHR) {
        const int row = q >> 4, cp = q & 15, t = row >> 4, h = row & 15; float v[8];
#pragma unroll
        for (int e = 0; e < 8; ++e) { const int jj = cp * 8 + e, p = jj & 63; const float cr = Cr[p * 16 + h], ci = Ci[p * 16 + h], lr = LPr[(t + 1) * 64 + p], li = LPi[(t + 1) * 64 + p];
            v[e] = (jj < 64) ? (cr * lr - ci * li) : -(cr * li + ci * lr); }
        u32x4 o; o.x = pk2(v[0], v[1]); o.y = pk2(v[2], v[3]); o.z = pk2(v[4], v[5]); o.w = pk2(v[6], v[7]);
        *(u32x4*)(MF + (size_t)row * KA5 + 512 + cp * 8) = o;
    }
    for (int q = tid; q < 128 * 64; q += NTHR) {
        const int j = q >> 6, cp = q & 63, s = cp >> 1, h0 = (cp & 1) * 8, p = j & 63; const float lr = LPr[(31 - s) * 64 + p], li = LPi[(31 - s) * 64 + p]; float v[8];
#pragma unroll
        for (int e = 0; e < 8; ++e) { const float br = Bbr[p * 16 + h0 + e], bi = Bbi[p * 16 + h0 + e]; v[e] = (j < 64) ? (lr * br - li * bi) : (lr * bi + li * br); }
        u32x4 o; o.x = pk2(v[0], v[1]); o.y = pk2(v[2], v[3]); o.z = pk2(v[4], v[5]); o.w = pk2(v[6], v[7]);
        *(u32x4*)(WB + (size_t)j * 512 + cp * 8) = o;
    }
    __syncthreads();
}

__device__ __forceinline__ void norm0_phase(const Args& a, int lane, int gw, int NGW) {
    const float* X = a.in[0]; f32x4 gv[4];
#pragma unroll
    for (int j = 0; j < 4; ++j) gv[j] = *((const f32x4*)a.in[1] + lane + 64 * j);
    bf16* XN = (bf16*)(a.ws + WS_XN); float* SS = (float*)(a.ws + WS_SS);
    for (int m = gw; m < M; m += 2 * NGW) {
        const int m2 = m + NGW; const bool has2 = m2 < M;
        const f32x4* xr = (const f32x4*)(X + (size_t)m * DM) + lane; const f32x4* xr2 = (const f32x4*)(X + (size_t)(has2 ? m2 : m) * DM) + lane; f32x4 v[4], w[4];
#pragma unroll
        for (int j = 0; j < 4; ++j) { v[j] = xr[64 * j]; w[j] = xr2[64 * j]; }
        float ss = 0.f, ss2 = 0.f;
#pragma unroll
        for (int j = 0; j < 4; ++j) { ss += (v[j].x * v[j].x + v[j].y * v[j].y) + (v[j].z * v[j].z + v[j].w * v[j].w); ss2 += (w[j].x * w[j].x + w[j].y * w[j].y) + (w[j].z * w[j].z + w[j].w * w[j].w); }
        ss = wave_sum(ss); ss2 = wave_sum(ss2);
        unsigned long long* o8 = (unsigned long long*)(XN + (size_t)m * DM) + lane; unsigned long long* o82 = (unsigned long long*)(XN + (size_t)m2 * DM) + lane;
        const float r1_ = rsqrtf(ss * (1.f / DM) + EPS), r2_ = rsqrtf(ss2 * (1.f / DM) + EPS);
#pragma unroll
        for (int j = 0; j < 4; ++j) { v[j] = v[j] * gv[j] * r1_; o8[64 * j] = (unsigned long long)pk2(v[j].x, v[j].y) | ((unsigned long long)pk2(v[j].z, v[j].w) << 32);
            if (has2) { w[j] = w[j] * gv[j] * r2_; o82[64 * j] = (unsigned long long)pk2(w[j].x, w[j].y) | ((unsigned long long)pk2(w[j].z, w[j].w) << 32); } }
        if (lane == 0) { SS[m] = ss; if (has2) SS[m2] = ss2; }
    }
}
__device__ __forceinline__ void final_norm(const Args& a, float* X, const float* SS, int lane, int gw, int NGW) {
    f32x4 gv[4];
#pragma unroll
    for (int j = 0; j < 4; ++j) gv[j] = *((const f32x4*)a.in[15] + lane + 64 * j);
    for (int m = gw; m < M; m += 2 * NGW) {
        const int m2 = m + NGW; const bool has2 = m2 < M;
        f32x4* xr = (f32x4*)(X + (size_t)m * DM) + lane; f32x4* xr2 = (f32x4*)(X + (size_t)(has2 ? m2 : m) * DM) + lane; f32x4 v[4], w[4];
#pragma unroll
        for (int j = 0; j < 4; ++j) { v[j] = xr[64 * j]; w[j] = xr2[64 * j]; }
        const float r1 = rsqrtf(SS[m] * (1.f / DM) + EPS), r2 = rsqrtf(SS[has2 ? m2 : m] * (1.f / DM) + EPS);
#pragma unroll
        for (int j = 0; j < 4; ++j) { xr[64 * j] = v[j] * r1 * gv[j]; if (has2) xr2[64 * j] = w[j] * r2 * gv[j]; }
    }
}

__device__ __forceinline__ void flog_phase(const Args& a, int l, const float* SS, LAS float* WF, int tid, int lane, int wave, int blk, int nblk) {
    const float* win = a.in[2] + (size_t)l * DM * NIN;
    for (int i = tid; i < 2048; i += NTHR) { const int k = i >> 1, hf = i & 1; *(LAS f32x4*)(WF + k * 8 + hf * 4) = *(const f32x4*)(win + (size_t)k * NIN + 1536 + hf * 4); }
    __syncthreads();
    const bf16* XN = (const bf16*)(a.ws + WS_XN); float* LOGF = (float*)(a.ws + WS_LOGF);
    const float bfj = (lane < 8) ? a.in[3][l * 8 + lane] : 0.f;
    const int rows_per = M / nblk;
    for (int i = wave; i < rows_per; i += 2 * NWAVES) {
        const int m = blk * rows_per + i, m2 = m + NWAVES; const bool has2 = (i + NWAVES) < rows_per;
        const u32x4 x0 = *((const u32x4*)(XN + (size_t)m * DM) + lane), x1 = *((const u32x4*)(XN + (size_t)m * DM + 512) + lane);
        const u32x4 y0 = *((const u32x4*)(XN + (size_t)(has2 ? m2 : m) * DM) + lane), y1 = *((const u32x4*)(XN + (size_t)(has2 ? m2 : m) * DM + 512) + lane);
        float acc[8], acc2[8];
#pragma unroll
        for (int e = 0; e < 8; ++e) { acc[e] = 0.f; acc2[e] = 0.f; }
#pragma unroll
        for (int hf = 0; hf < 2; ++hf)
#pragma unroll
            for (int q = 0; q < 8; ++q) { const int k = 512 * hf + 8 * lane + q; const f32x4 w0 = *(const LAS f32x4*)(WF + k * 8), w1 = *(const LAS f32x4*)(WF + k * 8 + 4);
                const unsigned xw = hf ? x1[q >> 1] : x0[q >> 1], yw = hf ? y1[q >> 1] : y0[q >> 1]; const float hv = (q & 1) ? bfhi(xw) : bflo(xw), hv2 = (q & 1) ? bfhi(yw) : bflo(yw);
                acc[0] += hv * w0.x; acc[1] += hv * w0.y; acc[2] += hv * w0.z; acc[3] += hv * w0.w; acc[4] += hv * w1.x; acc[5] += hv * w1.y; acc[6] += hv * w1.z; acc[7] += hv * w1.w;
                acc2[0] += hv2 * w0.x; acc2[1] += hv2 * w0.y; acc2[2] += hv2 * w0.z; acc2[3] += hv2 * w0.w; acc2[4] += hv2 * w1.x; acc2[5] += hv2 * w1.y; acc2[6] += hv2 * w1.z; acc2[7] += hv2 * w1.w; }
        float mine = 0.f, mine2 = 0.f;
#pragma unroll
        for (int e = 0; e < 8; ++e) { const float s = wave_sum(acc[e]), s2 = wave_sum(acc2[e]); if (lane == e) { mine = s; mine2 = s2; } }
        if (lane < 8) { const float z = mine + bfj; LOGF[(size_t)((m >> 12) * 8 + lane) * SEQ + (m & 4095)] = fminf(z, 0.f) - log1pf(expf(-fabsf(z)));
            if (has2) { const float z2 = mine2 + bfj; LOGF[(size_t)((m2 >> 12) * 8 + lane) * SEQ + (m2 & 4095)] = fminf(z2, 0.f) - log1pf(expf(-fabsf(z2))); } }
    }
}

__device__ __forceinline__ bool opaque_true() { int d = 1; asm volatile("" : "+s"(d)); return d != 0; }
struct RangeOrder {
    pg8::StaticOrder S; int lo, hi;
    __device__ bool next(int i, pg8::Unit& u) const { return (lo + i < hi) ? S.next(lo + i, u) : false; }
    __device__ __forceinline__ void a_ready(const pg8::Unit&) const {}
    __device__ __forceinline__ void done(const pg8::Unit&) const {}
};
struct FlatOrder {
    int nM, nN, nG, G, c;
    __device__ bool next(int i, pg8::Unit& u) const { const int L = i * G + c; if (L >= nG * nM * nN) return false; u.gz = L / (nM * nN); const int r = L % (nM * nN); u.pm = r % nM; u.pn = r / nM; return true; }
    __device__ __forceinline__ void a_ready(const pg8::Unit&) const {}
    __device__ __forceinline__ void done(const pg8::Unit&) const {}
};
__device__ __forceinline__ float silu_f(float v) { return v * __builtin_amdgcn_rcpf(1.f + __expf(-v)); }
__device__ __forceinline__ float gelu_tanh(float v) { const float u = 0.7978845608028654f * (v + 0.044715f * v * v * v); const float e = __expf(2.f * u); const float th = 1.f - 2.f * __builtin_amdgcn_rcpf(e + 1.f); return 0.5f * v * (1.f + th); }

struct EpiInProj {
    static constexpr bool PERM = true, AFTER_DRAIN = false;
    unsigned char* ws; const float* SS; const float* bfl;
    __device__ __forceinline__ void operator()(const pg8::f32x4 (&acc)[2][2][4][2], const pg8::Unit& u, int wr, int wc, int fr, int fq) const {
        const int pn = u.pn; const int row0 = u.pm * 256 + wr * 64 + fr, cl0 = wc * 32 + 8 * fq;
        float rs[2][4];
#pragma unroll
        for (int ai = 0; ai < 2; ++ai)
#pragma unroll
            for (int m = 0; m < 4; ++m) rs[ai][m] = 1.f;
        if (pn == 14) {
            if (wc == 0 && fq == 0) { float* LOGF = (float*)(ws + WS_LOGF); const f32x4 b0 = *(const f32x4*)bfl, b1 = *(const f32x4*)(bfl + 4);
#pragma unroll
                for (int ai = 0; ai < 2; ++ai)
#pragma unroll
                    for (int m = 0; m < 4; ++m) { const int row = row0 + ai * 128 + m * 16; const float r = rs[ai][m]; const pg8::f32x4 v0 = acc[ai][0][m][0], v1 = acc[ai][0][m][1];
                        float z[8] = {v0[0] * r + b0.x, v0[1] * r + b0.y, v0[2] * r + b0.z, v0[3] * r + b0.w, v1[0] * r + b1.x, v1[1] * r + b1.y, v1[2] * r + b1.z, v1[3] * r + b1.w};
#pragma unroll
                        for (int e = 0; e < 8; ++e) LOGF[(size_t)((row >> 12) * 8 + e) * SEQ + (row & 4095)] = fminf(z[e], 0.f) - log1pf(__expf(-fabsf(z[e]))); } }
            return;
        }
        if (pn < 6) {
            bf16* base = (bf16*)(ws + (pn < 2 ? WS_QO : pn < 4 ? WS_KB : WS_VB)); const float sc = pn < 2 ? 0.125f * LOG2E : 1.f; const int cb = (pn & 1) * 256 + cl0;
#pragma unroll
            for (int ai = 0; ai < 2; ++ai)
#pragma unroll
                for (int m = 0; m < 4; ++m) { bf16* rp = base + (size_t)(row0 + ai * 128 + m * 16) * 512 + cb;
#pragma unroll
                    for (int bj = 0; bj < 2; ++bj) { const float sr = sc * rs[ai][m]; const pg8::f32x4 v0 = acc[ai][bj][m][0] * sr, v1 = acc[ai][bj][m][1] * sr; u32x4 w; w.x = pk2(v0[0], v0[1]); w.y = pk2(v0[2], v0[3]); w.z = pk2(v1[0], v1[1]); w.w = pk2(v1[2], v1[3]); *(u32x4*)(rp + bj * 128) = w; } }
        } else if (pn == 6) {
            bf16* base = (bf16*)(ws + WS_SUA);
#pragma unroll
            for (int ai = 0; ai < 2; ++ai)
#pragma unroll
                for (int m = 0; m < 4; ++m) { const int row = row0 + ai * 128 + m * 16, chunk = row >> 5, t = row & 31;
#pragma unroll
                    for (int bj = 0; bj < 2; ++bj) { const int c = cl0 + bj * 128, g = c >> 4, h0 = c & 15; const pg8::f32x4 v0 = acc[ai][bj][m][0] * rs[ai][m], v1 = acc[ai][bj][m][1] * rs[ai][m]; u32x4 w; w.x = pk2(v0[0], v0[1]); w.y = pk2(v0[2], v0[3]); w.z = pk2(v1[0], v1[1]); w.w = pk2(v1[2], v1[3]);
                        *(u32x4*)(base + ((size_t)(g * 512 + chunk) * KA5 + t * 16 + h0)) = w; } }
        } else if (pn == 7 || pn == 8) {
            const f32x4* rope = (const f32x4*)(ws + WS_ROPE); bf16* base = (bf16*)(ws + (pn == 7 ? WS_RQ : WS_RK)); bf16* RKT = (bf16*)(ws + WS_RKT);
#pragma unroll
            for (int ai = 0; ai < 2; ++ai)
#pragma unroll
                for (int m = 0; m < 4; ++m) { const int row = row0 + ai * 128 + m * 16, b = row >> 12, t = row & 4095;
#pragma unroll
                    for (int bj = 0; bj < 2; ++bj) { const int c = cl0 + bj * 128, hh = c >> 6, pos0 = c & 63; const pg8::f32x4 v0 = acc[ai][bj][m][0] * rs[ai][m], v1 = acc[ai][bj][m][1] * rs[ai][m];
                        const f32x4 r0 = rope[(t * 32 + (pos0 >> 1)) >> 1], r1 = rope[((t * 32 + (pos0 >> 1)) >> 1) + 1];
                        float o[8];
                        o[0] = v0[0] * r0.x - v0[1] * r0.y; o[1] = v0[0] * r0.y + v0[1] * r0.x; o[2] = v0[2] * r0.z - v0[3] * r0.w; o[3] = v0[2] * r0.w + v0[3] * r0.z;
                        o[4] = v1[0] * r1.x - v1[1] * r1.y; o[5] = v1[0] * r1.y + v1[1] * r1.x; o[6] = v1[2] * r1.z - v1[3] * r1.w; o[7] = v1[2] * r1.w + v1[3] * r1.z;
                        u32x4 w; w.x = pk2(o[0], o[1]); w.y = pk2(o[2], o[3]); w.z = pk2(o[4], o[5]); w.w = pk2(o[6], o[7]);
                        *(u32x4*)(base + (size_t)row * 256 + c) = w;
                        if (pn == 8) { const float wk = __builtin_amdgcn_exp2f(lg2_gamma(hh) * (float)(63 - (t & 63))); bf16* tp = RKT + ((size_t)((b * 4 + hh) * 64 + pos0)) * SEQ + t;
#pragma unroll
                            for (int e = 0; e < 8; ++e) tp[(size_t)e * SEQ] = f2bf(o[e] * wk); } } }
        } else if (pn == 9) {
            bf16* RVT = (bf16*)(ws + WS_RVT);
#pragma unroll
            for (int ai = 0; ai < 2; ++ai)
#pragma unroll
                for (int m = 0; m < 4; ++m) { const int row = row0 + ai * 128 + m * 16, b = row >> 12, t = row & 4095;
#pragma unroll
                    for (int bj = 0; bj < 2; ++bj) { const int c = cl0 + bj * 128, hh = c >> 6, d0 = c & 63; const pg8::f32x4 v0 = acc[ai][bj][m][0] * rs[ai][m], v1 = acc[ai][bj][m][1] * rs[ai][m]; bf16* tp = RVT + ((size_t)((b * 4 + hh) * 64 + d0)) * SEQ + t;
#pragma unroll
                        for (int e = 0; e < 4; ++e) { tp[(size_t)e * SEQ] = f2bf(v0[e]); tp[(size_t)(4 + e) * SEQ] = f2bf(v1[e]); } } }
        } else {
            bf16* base = (bf16*)(ws + WS_GATE); const int cb = (pn - 10) * 256 + cl0;
#pragma unroll
            for (int ai = 0; ai < 2; ++ai)
#pragma unroll
                for (int m = 0; m < 4; ++m) { bf16* rp = base + (size_t)(row0 + ai * 128 + m * 16) * 1024 + cb;
#pragma unroll
                    for (int bj = 0; bj < 2; ++bj) { const pg8::f32x4 v0 = acc[ai][bj][m][0] * rs[ai][m], v1 = acc[ai][bj][m][1] * rs[ai][m]; u32x4 w; w.x = pk2(silu_f(v0[0]), silu_f(v0[1])); w.y = pk2(silu_f(v0[2]), silu_f(v0[3])); w.z = pk2(silu_f(v1[0]), silu_f(v1[1])); w.w = pk2(silu_f(v1[2]), silu_f(v1[3])); *(u32x4*)(rp + bj * 128) = w; } }
        }
    }
};
struct EpiS5E {
    static constexpr bool PERM = false, AFTER_DRAIN = false;
    float* E;
    __device__ __forceinline__ void operator()(const pg8::f32x4 (&acc)[2][2][4][2], const pg8::Unit& u, int wr, int wc, int fr, int fq) const {
        const int row0 = u.pm * 256 + wr * 64 + fr, col0 = wc * 32 + 4 * fq;
#pragma unroll
        for (int ai = 0; ai < 2; ++ai)
#pragma unroll
            for (int m = 0; m < 4; ++m) { float* rp = E + ((size_t)u.gz * NCH5 + row0 + ai * 128 + m * 16) * 128 + col0;
#pragma unroll
                for (int n = 0; n < 2; ++n) *(pg8::f32x4*)(rp + n * 16) = acc[ai][0][m][n]; }
    }
};
struct EpiS5Y {
    static constexpr bool PERM = true, AFTER_DRAIN = false;
    const bf16* SUA; bf16* YS5; const float* dvec;
    __device__ __forceinline__ void operator()(const pg8::f32x4 (&acc)[2][2][4][2], const pg8::Unit& u, int wr, int wc, int fr, int fq) const {
        const int row0 = u.pm * 256 + wr * 64 + fr, cl0 = u.pn * 256 + wc * 32 + 8 * fq; const int g = u.gz;
#pragma unroll
        for (int bj = 0; bj < 2; ++bj) { const int c = cl0 + bj * 128, tt = c >> 4, h0 = c & 15; const f32x4 d0 = *(const f32x4*)(dvec + g * 16 + h0), d1 = *(const f32x4*)(dvec + g * 16 + h0 + 4);
#pragma unroll
            for (int ai = 0; ai < 2; ++ai)
#pragma unroll
                for (int m = 0; m < 4; ++m) { const int chunk = row0 + ai * 128 + m * 16; const u32x4 uu = *(const u32x4*)(SUA + ((size_t)(g * 512 + chunk) * KA5 + c)); const pg8::f32x4 v0 = acc[ai][bj][m][0], v1 = acc[ai][bj][m][1];
                    float y[8]; y[0] = v0[0] + d0.x * bflo(uu.x); y[1] = v0[1] + d0.y * bfhi(uu.x); y[2] = v0[2] + d0.z * bflo(uu.y); y[3] = v0[3] + d0.w * bfhi(uu.y);
                    y[4] = v1[0] + d1.x * bflo(uu.z); y[5] = v1[1] + d1.y * bfhi(uu.z); y[6] = v1[2] + d1.z * bflo(uu.w); y[7] = v1[3] + d1.w * bfhi(uu.w);
#pragma unroll
                    for (int e = 0; e < 8; ++e) y[e] = gelu_tanh(y[e]);
                    u32x4 w; w.x = pk2(y[0], y[1]); w.y = pk2(y[2], y[3]); w.z = pk2(y[4], y[5]); w.w = pk2(y[6], y[7]);
                    *(u32x4*)(YS5 + (size_t)(chunk * 32 + tt) * 256 + g * 16 + h0) = w; } }
    }
};
struct EpiGlu {
    static constexpr bool PERM = true, AFTER_DRAIN = false;
    const bf16* YS5; bf16* G; bool dry;
    __device__ __forceinline__ void operator()(const pg8::f32x4 (&acc)[2][2][4][2], const pg8::Unit& u, int wr, int wc, int fr, int fq) const {
        const int row0 = u.pm * 256 + wr * 64 + fr, cl0 = wc * 32 + 8 * fq;
#pragma unroll
        for (int ai = 0; ai < 2; ++ai)
#pragma unroll
            for (int m = 0; m < 4; ++m) { const int row = row0 + ai * 128 + m * 16;
#pragma unroll
                for (int bj = 0; bj < 2; ++bj) { const int c = cl0 + bj * 128; const u32x4 yy = *(const u32x4*)(YS5 + (size_t)row * 256 + c); bf16* gp = G + (size_t)row * 1024 + 512 + c; const u32x4 gg = *(const u32x4*)gp;
                    const pg8::f32x4 v0 = acc[ai][bj][m][0], v1 = acc[ai][bj][m][1]; float s[8];
#pragma unroll
                    for (int e = 0; e < 4; ++e) { s[e] = 1.f / (1.f + __expf(-v0[e])); s[4 + e] = 1.f / (1.f + __expf(-v1[e])); }
                    u32x4 w; w.x = pk2(bflo(yy.x) * s[0] * bflo(gg.x), bfhi(yy.x) * s[1] * bfhi(gg.x)); w.y = pk2(bflo(yy.y) * s[2] * bflo(gg.y), bfhi(yy.y) * s[3] * bfhi(gg.y));
                    w.z = pk2(bflo(yy.z) * s[4] * bflo(gg.z), bfhi(yy.z) * s[5] * bfhi(gg.z)); w.w = pk2(bflo(yy.w) * s[6] * bflo(gg.w), bfhi(yy.w) * s[7] * bfhi(gg.w));
                    if (!dry) *(u32x4*)gp = w; } }
    }
};
struct EpiOut {
    static constexpr bool PERM = false, AFTER_DRAIN = false;
    const float* base; float* out; float* SSn; bf16* XN; const float* gnext; bool dry;
    __device__ __forceinline__ void operator()(const pg8::f32x4 (&acc)[2][2][4][2], const pg8::Unit& u, int wr, int wc, int fr, int fq) const {
        const int row0 = u.pm * 256 + wr * 64 + fr, col0 = u.pn * 256 + wc * 32 + 4 * fq;
        f32x4 gq[2][2];
#pragma unroll
        for (int bj = 0; bj < 2; ++bj)
#pragma unroll
            for (int n = 0; n < 2; ++n) gq[bj][n] = gnext ? *(const f32x4*)(gnext + col0 + bj * 128 + n * 16) : (f32x4){0.f, 0.f, 0.f, 0.f};
#pragma unroll
        for (int ai = 0; ai < 2; ++ai)
#pragma unroll
            for (int m = 0; m < 4; ++m) { const int row = row0 + ai * 128 + m * 16; const size_t off = (size_t)row * DM + col0; float sq = 0.f;
#pragma unroll
                for (int bj = 0; bj < 2; ++bj)
#pragma unroll
                    for (int n = 0; n < 2; ++n) { const f32x4 bs = *(const f32x4*)(base + off + bj * 128 + n * 16); const pg8::f32x4 v = acc[ai][bj][m][n]; const f32x4 x = (f32x4){bs.x + v[0], bs.y + v[1], bs.z + v[2], bs.w + v[3]};
                        sq += (x.x * x.x + x.y * x.y) + (x.z * x.z + x.w * x.w);
                        if (!dry) { *(f32x4*)(out + off + bj * 128 + n * 16) = x;
                            if (gnext) { const f32x4 g = gq[bj][n]; u32x2 w; w.x = pk2(x.x * g.x, x.y * g.y); w.y = pk2(x.z * g.z, x.w * g.w); *(u32x2*)(XN + off + bj * 128 + n * 16) = w; } } }
                sq += __shfl_xor(sq, 16); sq += __shfl_xor(sq, 32);
                if (fq == 0 && !dry) __hip_atomic_fetch_add(SSn + row, sq, __ATOMIC_RELAXED, __HIP_MEMORY_SCOPE_AGENT); }
    }
};

template <bool FINAL> struct EpiOutX {
    static constexpr bool PERM = false, AFTER_DRAIN = true;
    const float* base; float* out; const float* wfin; float* xbuf; unsigned* cnt; bf16* XN; unsigned target;
    __device__ __forceinline__ void fused(pg8::f32x4 (&acc)[2][2][4][2], const pg8::Unit& u, int wr, int wc, int fr, int fq, PG8_LAS unsigned char* lds, int wid, int lane) const {
        PG8_LAS float* P = (PG8_LAS float*)lds;
        PG8_LAS float* S = (PG8_LAS float*)(lds + 4096);
        const int col0 = u.pn * 256 + wc * 32 + 4 * fq;
#pragma unroll
        for (int ai = 0; ai < 2; ++ai)
#pragma unroll
            for (int m = 0; m < 4; ++m) { const int r = ai * 128 + wr * 64 + m * 16 + fr; const size_t off = (size_t)(u.pm * 256 + r) * DM + col0; float sq = 0.f;
#pragma unroll
                for (int bj = 0; bj < 2; ++bj)
#pragma unroll
                    for (int n = 0; n < 2; ++n) { const f32x4 bs = *(const f32x4*)(base + off + bj * 128 + n * 16); pg8::f32x4 x = acc[ai][bj][m][n]; x[0] += bs.x; x[1] += bs.y; x[2] += bs.z; x[3] += bs.w; acc[ai][bj][m][n] = x;
                        sq += (x[0] * x[0] + x[1] * x[1]) + (x[2] * x[2] + x[3] * x[3]); }
                sq += __shfl_xor(sq, 16); sq += __shfl_xor(sq, 32);
                if (fq == 0) P[r * 4 + wc] = sq;
                asm volatile("" : "+v"(acc[ai][0][m][0]), "+v"(acc[ai][0][m][1]), "+v"(acc[ai][1][m][0]), "+v"(acc[ai][1][m][1]));
                if (m & 1) asm volatile("" ::: "memory"); }
        asm volatile("s_waitcnt lgkmcnt(0)" ::: "memory"); __builtin_amdgcn_s_barrier(); asm volatile("" ::: "memory");
        const int row = wid * 32 + (lane & 31);
        if (lane < 32) { const float tot = (P[row * 4 + 0] + P[row * 4 + 1]) + (P[row * 4 + 2] + P[row * 4 + 3]);
            __hip_atomic_store(xbuf + (size_t)(u.pm * 256 + row) * 4 + u.pn, tot, __ATOMIC_RELAXED, __HIP_MEMORY_SCOPE_AGENT); }
        asm volatile("s_waitcnt vmcnt(0)" ::: "memory");
        if (lane == 0) __hip_atomic_fetch_add(cnt + 64 * u.pm, 1u, __ATOMIC_RELAXED, __HIP_MEMORY_SCOPE_AGENT);
        if (wid == 0) {
            unsigned sp = 0u;
            while ((unsigned)__builtin_amdgcn_readfirstlane(__hip_atomic_load(cnt + 64 * u.pm, __ATOMIC_RELAXED, __HIP_MEMORY_SCOPE_AGENT)) < target) { __builtin_amdgcn_s_sleep(2); if (++sp > (1u << 20)) break; }
            __builtin_amdgcn_fence(__ATOMIC_ACQUIRE, "agent");
        }
        asm volatile("s_waitcnt vmcnt(0) lgkmcnt(0)" ::: "memory"); __builtin_amdgcn_s_barrier(); asm volatile("" ::: "memory");
        if (lane < 32) { const float* sl = xbuf + (size_t)(u.pm * 256 + row) * 4; float t = 0.f;
#pragma unroll
            for (int k = 0; k < 4; ++k) t += __hip_atomic_load(sl + k, __ATOMIC_RELAXED, __HIP_MEMORY_SCOPE_AGENT);
            S[row] = rsqrtf(t * (1.f / DM) + EPS); }
        asm volatile("s_waitcnt lgkmcnt(0)" ::: "memory"); __builtin_amdgcn_s_barrier(); asm volatile("" ::: "memory");
        f32x4 wq[2][2];
#pragma unroll
        for (int bj = 0; bj < 2; ++bj)
#pragma unroll
            for (int n = 0; n < 2; ++n) wq[bj][n] = *(const f32x4*)(wfin + col0 + bj * 128 + n * 16);
#pragma unroll
        for (int ai = 0; ai < 2; ++ai)
#pragma unroll
            for (int m = 0; m < 4; ++m) { const int r = ai * 128 + wr * 64 + m * 16 + fr; const float sr = S[r]; const size_t off = (size_t)(u.pm * 256 + r) * DM + col0;
#pragma unroll
                for (int bj = 0; bj < 2; ++bj)
#pragma unroll
                    for (int n = 0; n < 2; ++n) { const pg8::f32x4 x = acc[ai][bj][m][n]; const f32x4 g = wq[bj][n]; const f32x4 y = (f32x4){x[0] * sr * g.x, x[1] * sr * g.y, x[2] * sr * g.z, x[3] * sr * g.w};
                        if (FINAL) *(f32x4*)(out + off + bj * 128 + n * 16) = y;
                        else { *(f32x4*)(out + off + bj * 128 + n * 16) = (f32x4){x[0], x[1], x[2], x[3]}; u32x2 w; w.x = pk2(y.x, y.y); w.y = pk2(y.z, y.w); *(u32x2*)(XN + off + bj * 128 + n * 16) = w; } } }
    }
};

template <int KS, int UNR, class Epi> __device__ __forceinline__ void wave_gemm64(const bf16* A, int lda, const bf16* B, int ldb, int lane, const Epi& epi) {
    const int fr = lane & 15, fq = lane >> 4;
    pg8::f32x4 acc[4][4];
#pragma unroll
    for (int jb = 0; jb < 4; ++jb)
#pragma unroll
        for (int ib = 0; ib < 4; ++ib) acc[jb][ib] = (pg8::f32x4){0.f, 0.f, 0.f, 0.f};
    const bf16* ap = A + (size_t)fr * lda + 8 * fq; const bf16* bp = B + (size_t)fr * ldb + 8 * fq;
#pragma unroll UNR
    for (int ks = 0; ks < KS; ++ks) {
        bf16x8 af[4], bv[4];
#pragma unroll
        for (int ib = 0; ib < 4; ++ib) { af[ib] = *(const bf16x8*)(ap + (size_t)(16 * ib) * lda + 32 * ks); bv[ib] = *(const bf16x8*)(bp + (size_t)(16 * ib) * ldb + 32 * ks); }
#pragma unroll
        for (int jb = 0; jb < 4; ++jb)
#pragma unroll
            for (int ib = 0; ib < 4; ++ib) acc[jb][ib] = __builtin_amdgcn_mfma_f32_16x16x32_bf16(bv[jb], af[ib], acc[jb][ib], 0, 0, 0);
    }
    epi(acc, fr, fq);
}
struct WEpiE {
    float* E;
    __device__ __forceinline__ void operator()(const pg8::f32x4 (&acc)[4][4], int fr, int fq) const {
#pragma unroll
        for (int jb = 0; jb < 4; ++jb)
#pragma unroll
            for (int ib = 0; ib < 4; ++ib) *(pg8::f32x4*)(E + (size_t)(16 * ib + fr) * 128 + 16 * jb + 4 * fq) = acc[jb][ib];
    }
};
struct WEpiS5Y {
    const bf16* SUAg; bf16* YS5; const float* dg; int chunk0, col0, g;
    __device__ __forceinline__ void operator()(const pg8::f32x4 (&acc)[4][4], int fr, int fq) const {
#pragma unroll
        for (int jb = 0; jb < 4; ++jb) { const int col = col0 + 16 * jb + 4 * fq, tt = col >> 4, h0 = col & 15; const f32x4 d4 = *(const f32x4*)(dg + h0);
#pragma unroll
            for (int ib = 0; ib < 4; ++ib) { const int chunk = chunk0 + 16 * ib + fr; const u32x2 uu = *(const u32x2*)(SUAg + (size_t)chunk * KA5 + col); const pg8::f32x4 v = acc[jb][ib];
                const float y0 = gelu_tanh(v[0] + d4.x * bflo(uu.x)), y1 = gelu_tanh(v[1] + d4.y * bfhi(uu.x)), y2 = gelu_tanh(v[2] + d4.z * bflo(uu.y)), y3 = gelu_tanh(v[3] + d4.w * bfhi(uu.y));
                u32x2 w; w.x = pk2(y0, y1); w.y = pk2(y2, y3); *(u32x2*)(YS5 + (size_t)(chunk * 32 + tt) * 256 + g * 16 + h0) = w; } }
    }
};
struct WEpiGlu {
    const bf16* YS5; bf16* G; int row0, col0;
    __device__ __forceinline__ void operator()(const pg8::f32x4 (&acc)[4][4], int fr, int fq) const {
#pragma unroll
        for (int jb = 0; jb < 4; ++jb)
#pragma unroll
            for (int ib = 0; ib < 4; ++ib) { const int row = row0 + 16 * ib + fr, col = col0 + 16 * jb + 4 * fq; const u32x2 yy = *(const u32x2*)(YS5 + (size_t)row * 256 + col); bf16* gp = G + (size_t)row * 1024 + 512 + col; const u32x2 gg = *(const u32x2*)gp; const pg8::f32x4 v = acc[jb][ib];
                const float s0 = __builtin_amdgcn_rcpf(1.f + __expf(-v[0])), s1 = __builtin_amdgcn_rcpf(1.f + __expf(-v[1])), s2 = __builtin_amdgcn_rcpf(1.f + __expf(-v[2])), s3 = __builtin_amdgcn_rcpf(1.f + __expf(-v[3]));
                u32x2 w; w.x = pk2(bflo(yy.x) * s0 * bflo(gg.x), bfhi(yy.x) * s1 * bfhi(gg.x)); w.y = pk2(bflo(yy.y) * s2 * bflo(gg.y), bfhi(yy.y) * s3 * bfhi(gg.y)); *(u32x2*)gp = w; }
    }
};

__device__ __forceinline__ void ret_upd_unit(unsigned char* ws, int unit, int lane) {
    const int c = unit & 63, bh = unit >> 6; const int i16 = lane & 15, kq = lane >> 4;
    const bf16* KT = (const bf16*)(ws + WS_RKT) + (size_t)bh * 64 * SEQ + c * 64; const bf16* VT = (const bf16*)(ws + WS_RVT) + (size_t)bh * 64 * SEQ + c * 64;
    float* UPD = (float*)(ws + WS_UPD) + (size_t)unit * 4096;
    bf16x8 af[4][2], bfv[4][2];
#pragma unroll
    for (int ib = 0; ib < 4; ++ib)
#pragma unroll
        for (int ks = 0; ks < 2; ++ks) { af[ib][ks] = *(const bf16x8*)(KT + (size_t)(16 * ib + i16) * SEQ + 32 * ks + 8 * kq); bfv[ib][ks] = *(const bf16x8*)(VT + (size_t)(16 * ib + i16) * SEQ + 32 * ks + 8 * kq); }
#pragma unroll
    for (int ib = 0; ib < 4; ++ib)
#pragma unroll
        for (int jb = 0; jb < 4; ++jb) { pg8::f32x4 d = (pg8::f32x4){0.f, 0.f, 0.f, 0.f};
            d = __builtin_amdgcn_mfma_f32_16x16x32_bf16(af[ib][0], bfv[jb][0], d, 0, 0, 0); d = __builtin_amdgcn_mfma_f32_16x16x32_bf16(af[ib][1], bfv[jb][1], d, 0, 0, 0);
            *(pg8::f32x4*)(UPD + (size_t)(16 * jb + i16) * 64 + 16 * ib + 4 * kq) = d; }
}
__device__ __forceinline__ void ret_out_unit(const Args& a, int l, int unit, int lane, bool dry = false) {
    unsigned char* ws = a.ws;
    const int c = unit & 63, bh = unit >> 6, hh = bh & 3, b = bh >> 2; const int fr = lane & 15, fq = lane >> 4;
    const size_t t0 = (size_t)b * SEQ + c * 64;
    const bf16* RQ = (const bf16*)(ws + WS_RQ) + t0 * 256 + hh * 64; const bf16* RK = (const bf16*)(ws + WS_RK) + t0 * 256 + hh * 64;
    const bf16* VT = (const bf16*)(ws + WS_RVT) + (size_t)bh * 64 * SEQ + c * 64; const bf16* ST = (const bf16*)(ws + WS_STATE) + (size_t)unit * 4096;
    const float lg = lg2_gamma(hh);
    bf16x8 qf[4][2]; pg8::f32x4 st[4][4];
#pragma unroll
    for (int nb = 0; nb < 4; ++nb)
#pragma unroll
        for (int ks = 0; ks < 2; ++ks) qf[nb][ks] = *(const bf16x8*)(RQ + (size_t)(16 * nb + fr) * 256 + 32 * ks + 8 * fq);
#pragma unroll
    for (int mb = 0; mb < 4; ++mb) { bf16x8 k0 = *(const bf16x8*)(RK + (size_t)(16 * mb + fr) * 256 + 8 * fq), k1 = *(const bf16x8*)(RK + (size_t)(16 * mb + fr) * 256 + 32 + 8 * fq);
#pragma unroll
        for (int nb = 0; nb < 4; ++nb) { pg8::f32x4 d = (pg8::f32x4){0.f, 0.f, 0.f, 0.f};
            d = __builtin_amdgcn_mfma_f32_16x16x32_bf16(k0, qf[nb][0], d, 0, 0, 0); d = __builtin_amdgcn_mfma_f32_16x16x32_bf16(k1, qf[nb][1], d, 0, 0, 0);
#pragma unroll
            for (int r = 0; r < 4; ++r) { const int mm = 16 * mb + 4 * fq + r, nn = 16 * nb + fr; const int df = mm > nn ? mm - nn : nn - mm; d[r] *= 0.125f * __builtin_amdgcn_exp2f(lg * (float)df); }
            st[mb][nb] = d; } }
    pg8::f32x4 o[4][4];
#pragma unroll
    for (int nb = 0; nb < 4; ++nb)
#pragma unroll
        for (int dvb = 0; dvb < 4; ++dvb) o[nb][dvb] = (pg8::f32x4){0.f, 0.f, 0.f, 0.f};
#pragma unroll
    for (int dvb = 0; dvb < 4; ++dvb) { const bf16x8 s0 = *(const bf16x8*)(ST + (size_t)(16 * dvb + fr) * 64 + 8 * fq), s1 = *(const bf16x8*)(ST + (size_t)(16 * dvb + fr) * 64 + 32 + 8 * fq);
#pragma unroll
        for (int nb = 0; nb < 4; ++nb) { o[nb][dvb] = __builtin_amdgcn_mfma_f32_16x16x32_bf16(qf[nb][0], s0, o[nb][dvb], 0, 0, 0); o[nb][dvb] = __builtin_amdgcn_mfma_f32_16x16x32_bf16(qf[nb][1], s1, o[nb][dvb], 0, 0, 0); } }
#pragma unroll
    for (int nb = 0; nb < 4; ++nb)
#pragma unroll
        for (int r = 0; r < 4; ++r) { const float wq = 0.125f * __builtin_amdgcn_exp2f(lg * (float)(16 * nb + 4 * fq + r + 1));
#pragma unroll
            for (int dvb = 0; dvb < 4; ++dvb) o[nb][dvb][r] *= wq; }
#pragma unroll
    for (int s = 0; s < 2; ++s) {
        bf16x8 pa[4];
#pragma unroll
        for (int nb = 0; nb < 4; ++nb) { u32x4 w; w.x = pk2(st[2 * s][nb][0], st[2 * s][nb][1]); w.y = pk2(st[2 * s][nb][2], st[2 * s][nb][3]); w.z = pk2(st[2 * s + 1][nb][0], st[2 * s + 1][nb][1]); w.w = pk2(st[2 * s + 1][nb][2], st[2 * s + 1][nb][3]); pa[nb] = __builtin_bit_cast(bf16x8, w); }
#pragma unroll
        for (int dvb = 0; dvb < 4; ++dvb) { const u32x2 v0 = *(const u32x2*)(VT + (size_t)(16 * dvb + fr) * SEQ + 32 * s + 4 * fq), v1 = *(const u32x2*)(VT + (size_t)(16 * dvb + fr) * SEQ + 32 * s + 16 + 4 * fq);
            const bf16x8 vf = __builtin_bit_cast(bf16x8, (u32x4){v0.x, v0.y, v1.x, v1.y});
#pragma unroll
            for (int nb = 0; nb < 4; ++nb) o[nb][dvb] = __builtin_amdgcn_mfma_f32_16x16x32_bf16(pa[nb], vf, o[nb][dvb], 0, 0, 0); }
    }
    const float* gn = a.in[13] + (size_t)l * 256 + hh * 64; float gnw[4];
#pragma unroll
    for (int dvb = 0; dvb < 4; ++dvb) gnw[dvb] = gn[16 * dvb + fr];
    bf16* Y = (bf16*)(ws + WS_GATE) + t0 * 1024 + 768 + hh * 64;
#pragma unroll
    for (int nb = 0; nb < 4; ++nb)
#pragma unroll
        for (int r = 0; r < 4; ++r) { float s = (o[nb][0][r] + o[nb][1][r]) + (o[nb][2][r] + o[nb][3][r]);
            s += __shfl_xor(s, 1); s += __shfl_xor(s, 2); s += __shfl_xor(s, 4); s += __shfl_xor(s, 8);
            const float mu = s * (1.f / 64.f); float q = 0.f;
#pragma unroll
            for (int dvb = 0; dvb < 4; ++dvb) { const float d = o[nb][dvb][r] - mu; q += d * d; }
            q += __shfl_xor(q, 1); q += __shfl_xor(q, 2); q += __shfl_xor(q, 4); q += __shfl_xor(q, 8);
            const float rstd = rsqrtf(q * (1.f / 64.f) + EPS); bf16* yp = Y + (size_t)(16 * nb + 4 * fq + r) * 1024 + fr;
#pragma unroll
            for (int dvb = 0; dvb < 4; ++dvb) { const float gt = bf2f(yp[16 * dvb]); if (!dry) yp[16 * dvb] = f2bf((o[nb][dvb][r] - mu) * rstd * gnw[dvb] * gt); } }
}

#define XB_TMO      128
#define XB_XCNT(j)  (256  + 64 * (j))
#define XB_XSUB(j)  (1280 + 64 * (j))
#define XB_XGEN(j)  (2304 + 64 * (j))
#define XB_TOP      3328
#define XB_TOPGEN   3392
#define XCD_BAR_WORDS 3456
#define XB_SPIN_CAP (1u << 18)

__device__ __forceinline__ unsigned xb_ld(unsigned* p)              { return __hip_atomic_load(p, __ATOMIC_RELAXED, __HIP_MEMORY_SCOPE_AGENT); }
__device__ __forceinline__ unsigned xb_add(unsigned* p, unsigned v) { return __hip_atomic_fetch_add(p, v, __ATOMIC_RELAXED, __HIP_MEMORY_SCOPE_AGENT); }
__device__ __forceinline__ unsigned xb_xcc_id() { return (unsigned)__builtin_amdgcn_s_getreg((3 << 11) | 20) & 0xFu; }
#define XB_SPIN(cond, bar) do { unsigned _sp = 0; while (cond) { __builtin_amdgcn_s_sleep(1); \
    if ((++_sp & 255u) == 0u) { if (xb_ld(&(bar)[XB_TMO])) break; if (_sp > XB_SPIN_CAP) { atomicAdd(&(bar)[XB_TMO], 1u); break; } } } } while (0)

struct XcdBarrier {
    unsigned* bar; unsigned x;
    volatile LAS unsigned* st;
};

__device__ __forceinline__ XcdBarrier xcd_barrier_post(unsigned* bar, volatile LAS unsigned* st) {
    XcdBarrier b; b.bar = bar; b.x = xb_xcc_id(); b.st = st;
    if (threadIdx.x == 0) (void)xb_add(&bar[XB_XCNT(b.x)], 1u);
    return b;
}
__device__ __forceinline__ void xcd_barrier_complete(unsigned* bar, unsigned x, unsigned& nloc, unsigned& nx) {
    const unsigned G = gridDim.x * gridDim.y * gridDim.z;
    unsigned sum, cnt, mine, sp = 0u;
    for (;;) {
        sum = 0u; cnt = 0u; mine = 0u;
#pragma unroll
        for (unsigned j = 0; j < 16; ++j) { const unsigned c = xb_ld(&bar[XB_XCNT(j)]); sum += c; cnt += (c > 0u) ? 1u : 0u; mine = (j == x) ? c : mine; }
        if (sum == G) break;
        __builtin_amdgcn_s_sleep(1);
        if ((++sp & 255u) == 0u) { if (xb_ld(&bar[XB_TMO])) break; if (sp > XB_SPIN_CAP) { atomicAdd(&bar[XB_TMO], 1u); break; } }
    }
    nloc = mine > 0u ? mine : 1u; nx = cnt > 0u ? cnt : 1u;
}

__device__ __forceinline__ void xcd_barrier(const XcdBarrier& b) {
    asm volatile("s_waitcnt vmcnt(0)" ::: "memory");
    __syncthreads();
    if (threadIdx.x == 0) {
        unsigned* bar = b.bar;
        __builtin_amdgcn_s_waitcnt(0);
        unsigned nloc = b.st[0], nx = b.st[1];
        if (nloc == 0u) { xcd_barrier_complete(bar, b.x, nloc, nx); b.st[0] = nloc; b.st[1] = nx; }
        const unsigned old = xb_add(&bar[XB_XSUB(b.x)], 1u);
        const unsigned gen = old / nloc;
        if (old + 1u == (gen + 1u) * nloc) {
            __builtin_amdgcn_fence(__ATOMIC_RELEASE, "agent");
            asm volatile("s_waitcnt vmcnt(0)" ::: "memory");
            const unsigned og = xb_add(&bar[XB_TOP], 1u);
            const unsigned tg = og / nx;
            if (og + 1u == (tg + 1u) * nx) xb_add(&bar[XB_TOPGEN], 1u);
            else XB_SPIN(xb_ld(&bar[XB_TOPGEN]) == tg, bar);
            __builtin_amdgcn_fence(__ATOMIC_ACQUIRE, "agent");
            xb_add(&bar[XB_XGEN(b.x)], 1u);
            asm volatile("s_waitcnt vmcnt(0)" ::: "memory");
        } else {
            XB_SPIN(xb_ld(&bar[XB_XGEN(b.x)]) == gen, bar);
            __builtin_amdgcn_fence(__ATOMIC_ACQUIRE, "agent");
            asm volatile("s_waitcnt vmcnt(0)" ::: "memory");
        }
    }
    __syncthreads();
}

#define XBAR_MAKE XcdBarrier xb_; xb_.bar = (unsigned*)args.ws; xb_.st = (volatile LAS unsigned*)((LAS unsigned char*)lds + RING_BYTES + 352); xb_.x = xb_.st[2]
#ifdef REP_SYNC
#define GSYNC() do { XBAR_MAKE; xcd_barrier(xb_); xcd_barrier(xb_); } while (0)
#else
#define GSYNC() do { XBAR_MAKE; xcd_barrier(xb_); } while (0)
#endif
#ifndef REP_P0
#define REP_P0 1
#endif
#ifndef REP_P1
#define REP_P1 1
#endif
#ifndef REP_P23
#define REP_P23 1
#endif
#ifndef REP_NORM
#define REP_NORM 1
#endif
__global__ void __launch_bounds__(NTHR, 2) mega_fwd(Args args) {
    extern __shared__ __attribute__((aligned(16))) unsigned char lds[];
    cg::grid_group grid = cg::this_grid();
    const int tid = threadIdx.x, lane = tid & 63, wave = __builtin_amdgcn_readfirstlane(tid >> 6);
    const int G = gridDim.x, bx = blockIdx.x; const int vcu = (G % 8 == 0) ? (bx % 8) * (G / 8) + bx / 8 : bx;
    const int gw = bx * NWAVES + wave, NGW = G * NWAVES;
    unsigned char* ws = args.ws;
    LAS unsigned char* ldsl = (LAS unsigned char*)lds;
    LAS float* ldsf = (LAS float*)lds;
    float* X = args.out;
    if (ws == nullptr) grid.sync();
    if (tid < 2) ((volatile LAS unsigned*)(ldsl + RING_BYTES + 352))[tid] = 0u;
    __syncthreads();
    { const XcdBarrier xb0 = xcd_barrier_post((unsigned*)ws, (volatile LAS unsigned*)(ldsl + RING_BYTES + 352)); if (tid == 0) ((volatile LAS unsigned*)(ldsl + RING_BYTES + 352))[2] = xb0.x; }
    __syncthreads();

#ifdef PROBE_T
    unsigned long long tacc_ = 0ull, tprev_ = __builtin_amdgcn_s_memrealtime();
#define TSTAMP(id) do { const unsigned long long tn_ = __builtin_amdgcn_s_memrealtime(); if ((id) == PROBE_T || ((PROBE_T) == 23 && ((id) == 2 || (id) == 3 || (id) == 5))) tacc_ += tn_ - tprev_; tprev_ = tn_; } while (0)
#else
#define TSTAMP(id) do {} while (0)
#endif
    for (int rep_ = 0; rep_ < REP_P0; ++rep_) {
        if (rep_) { __syncthreads(); }
#ifdef REP_S5P
        if (bx < 64) { s5_prep(args, bx >> 4, bx & 15, ldsf, tid); }
#endif
        if (bx < 64) { s5_prep(args, bx >> 4, bx & 15, ldsf, tid); }
        LAS float* scr = ldsf + wave * 4096;
        constexpr int I_IN = (DM / 64) * (NF / 32), I_O = (DM / 64) * (DM / 32), I_G = (256 / 64) * (256 / 32), I_L = I_IN + I_O + I_G;
#ifndef REP_TR
#define REP_TR 1
#endif
        for (int rt_ = 0; rt_ < REP_TR; ++rt_)
        for (int it = (bx < 64 ? DEPTH * I_L : (bx - 64) * NWAVES + wave); it < DEPTH * I_L; it += (G - 64) * NWAVES) {
            const int l = it / I_L; int r = it % I_L;
            if (r < I_IN) { p0_transpose_item<true>(args.in[2] + (size_t)l * DM * NIN, DM, NIN, NF, (bf16*)(ws + WS_WIN) + (size_t)l * NF * DM, scr, r, lane); continue; } r -= I_IN;
            if (r < I_O) { p0_transpose_item<false>(args.in[14] + (size_t)l * DM * DM, DM, DM, DM, (bf16*)(ws + WS_WO) + (size_t)l * DM * DM, scr, r, lane); continue; } r -= I_O;
            p0_transpose_item<false>(args.in[12] + (size_t)l * 65536, 256, 256, 256, (bf16*)(ws + WS_WGLU) + (size_t)l * 65536, scr, r, lane);
        }
        f32x2* rope = (f32x2*)(ws + WS_ROPE);
        for (int i = bx * NTHR + tid; i < SEQ * 32; i += G * NTHR) { const int pos = i >> 5, fi = i & 31; const float freq = powf(10000.f, -(float)fi / 32.f); const float ang = (float)pos * freq; float sn, cs; sincosf(ang, &sn, &cs); rope[i] = (f32x2){cs, sn}; }
        __syncthreads();
        { const int NW = (64 + 2 * (G - 64)) * NWAVES;
          if (bx < 64) norm0_phase(args, lane, bx * NWAVES + wave, NW);
          else { const int sl = 64 * NWAVES + ((bx - 64) * NWAVES + wave) * 2; norm0_phase(args, lane, sl, NW); norm0_phase(args, lane, sl + 1, NW); } }
    }
    GSYNC();
    TSTAMP(0);

#define PHASE_VARS int tid = threadIdx.x; asm volatile("" : "+v"(tid)); int bxl_ = blockIdx.x; asm volatile("" : "+s"(bxl_)); const int bx = bxl_; const int lane = tid & 63, wave = __builtin_amdgcn_readfirstlane(tid >> 6), gw = bx * NWAVES + wave; __attribute__((address_space(1))) unsigned char* wsg_ = (__attribute__((address_space(1))) unsigned char*)args.ws; asm volatile("" : "+s"(wsg_)); unsigned char* ws = (unsigned char*)wsg_; LAS unsigned char* ldsl = (LAS unsigned char*)lds; LAS float* ldsf = (LAS float*)lds; (void)lane; (void)wave; (void)gw; (void)ldsl; (void)ldsf
    for (int l = 0; l < DEPTH; ++l) {
        for (int rep_ = 0; rep_ < REP_P1; ++rep_) {
            PHASE_VARS;
            pg8::Gemm g{(const bf16*)(ws + WS_XN), (const bf16*)(ws + WS_WIN) + (size_t)l * NF * DM, M, NF, DM, DM, DM, 0, 0};
            pg8::StaticOrder S; S.init(M, NF, G, bx);
            EpiInProj E{ws, (const float*)(ws + WS_SS) + (size_t)(l & 1) * M, args.in[3] + (size_t)l * 8};
#ifdef PROBE_SPLIT
            { RangeOrder R0{S, 0, 2}, R1{S, 2, 4}; pg8::gemm_phase<EpiInProj, RangeOrder, true, true>(ldsl, g, R0, E); GSYNC(); pg8::gemm_phase<EpiInProj, RangeOrder, true, true>(ldsl, g, R1, E); }
#else
            pg8::gemm_phase<EpiInProj, pg8::StaticOrder, true, true>(ldsl, g, S, E);
#endif
            if (bx >= G / 2) flog_phase(args, l, (const float*)(ws + WS_SS) + (size_t)(l & 1) * M, ldsf, tid, lane, wave, bx - G / 2, G / 2);
        }
        GSYNC();
        TSTAMP(1);
        for (int rep_ = 0; rep_ < REP_P23; ++rep_) {
            if (rep_) __syncthreads();
            PHASE_VARS;
            if (bx < 128) {
                const int half = bx & 1, bg_ = bx >> 1, b = bg_ >> 4, g = bg_ & 15, tmL = wave & 1, tn = (wave >> 1) & 1, kh = wave >> 2;
                { const int fr = lane & 15, fq = lane >> 4;
                  const bf16* Ap = (const bf16*)(ws + WS_SUA) + ((size_t)g * NCH5 + b * 128 + tmL * 64) * KA5 + 256 * kh; const bf16* Bp = (const bf16*)(ws + WS_WB) + ((size_t)(l * 16 + g) * 128 + tn * 64) * 512 + 256 * kh;
                  struct WEpiLds { LAS float* EL; __device__ __forceinline__ void operator()(const pg8::f32x4 (&acc)[4][4], int fr_, int fq_) const {
#pragma unroll
                      for (int jb = 0; jb < 4; ++jb)
#pragma unroll
                          for (int ib = 0; ib < 4; ++ib) *(LAS pg8::f32x4*)(EL + (16 * ib + fr_) * 128 + 16 * jb + 4 * fq_) = acc[jb][ib]; } };
                  WEpiLds E{ldsf + (size_t)(kh * 128 + tmL * 64) * 128 + tn * 64}; (void)fr; (void)fq;
                  wave_gemm64<8, 4, WEpiLds>(Ap, KA5, Bp, 512, lane, E); }
                __syncthreads();
                const int p = tid & 63, seg = tid >> 6;
                const float* LAM = (const float*)(ws + WS_LAM) + (size_t)(l * 16 + g) * 128; const float lr = LAM[p], li = LAM[64 + p];
                bf16* SA = (bf16*)(ws + WS_SUA) + ((size_t)g * NCH5 + b * 128 + seg * 16) * KA5 + 512 + p;
                float er[16], ei[16];
#pragma unroll
                for (int i = 0; i < 16; ++i) { const int r = (seg * 16 + i) * 128; er[i] = ldsf[r + p] + ldsf[16384 + r + p]; ei[i] = ldsf[r + 64 + p] + ldsf[16384 + r + 64 + p]; }
                float sr = 0.f, si = 0.f;
#pragma unroll
                for (int i = 0; i < 16; ++i) { const float nr = lr * sr - li * si + er[i], ni = lr * si + li * sr + ei[i]; sr = nr; si = ni; }
                LAS float* ends = ldsf + (RING_BYTES + 1024) / 4;
                ends[(seg * 64 + p) * 2] = sr; ends[(seg * 64 + p) * 2 + 1] = si;
                float pr = lr, pi = li;
#pragma unroll
                for (int i = 0; i < 4; ++i) { const float nr = pr * pr - pi * pi, ni = 2.f * pr * pi; pr = nr; pi = ni; }
                __syncthreads();
                float cr = 0.f, ci = 0.f;
                for (int s2 = 0; s2 < seg; ++s2) { const float xr = ends[(s2 * 64 + p) * 2], xi = ends[(s2 * 64 + p) * 2 + 1]; const float nr = pr * cr - pi * ci + xr, ni = pr * ci + pi * cr + xi; cr = nr; ci = ni; }
#pragma unroll
                for (int i = 0; i < 16; ++i) { SA[(size_t)i * KA5] = f2bf(cr); SA[(size_t)i * KA5 + 64] = f2bf(ci); const float nr = lr * cr - li * ci + er[i], ni = lr * ci + li * cr + ei[i]; cr = nr; ci = ni; }
                asm volatile("s_waitcnt vmcnt(0)" ::: "memory"); __syncthreads();
                { const int tmL2 = wave & 1, tn2 = half * 4 + (wave >> 1);
                  const bf16* SUAg = (const bf16*)(ws + WS_SUA) + (size_t)g * NCH5 * KA5;
                  WEpiS5Y E{SUAg, (bf16*)(ws + WS_YS5), args.in[10] + (size_t)l * 256 + g * 16, b * 128 + tmL2 * 64, tn2 * 64, g};
                  wave_gemm64<20, 4, WEpiS5Y>(SUAg + (size_t)(b * 128 + tmL2 * 64) * KA5, KA5, (const bf16*)(ws + WS_MF) + ((size_t)(l * 16 + g) * 512 + tn2 * 64) * KA5, KA5, lane, E); }
            } else {
                const int idx = bx - 128, bh = idx >> 3, dvs = (idx >> 1) & 3, dkh = idx & 1, fr = lane & 15, fq = lane >> 4; const float g64 = exp2f(lg2_gamma(bh & 3) * 64.f);
                const bf16* KT = (const bf16*)(ws + WS_RKT) + ((size_t)bh * 64 + 32 * dkh + fr) * SEQ + 8 * fq; const bf16* VT = (const bf16*)(ws + WS_RVT) + ((size_t)bh * 64 + 16 * dvs + fr) * SEQ + 8 * fq;
                pg8::f32x4 u[8][2];
#pragma unroll
                for (int i2 = 0; i2 < 2; ++i2) {
                    bf16x8 vf[4][2], kf[4][2][2];
#pragma unroll
                    for (int i1 = 0; i1 < 4; ++i1) { const int c = 8 * wave + 4 * i2 + i1; vf[i1][0] = *(const bf16x8*)(VT + c * 64); vf[i1][1] = *(const bf16x8*)(VT + c * 64 + 32);
#pragma unroll
                        for (int ib = 0; ib < 2; ++ib) { kf[i1][ib][0] = *(const bf16x8*)(KT + (size_t)(16 * ib) * SEQ + c * 64); kf[i1][ib][1] = *(const bf16x8*)(KT + (size_t)(16 * ib) * SEQ + c * 64 + 32); } }
#pragma unroll
                    for (int i1 = 0; i1 < 4; ++i1)
#pragma unroll
                        for (int ib = 0; ib < 2; ++ib) { pg8::f32x4 d = (pg8::f32x4){0.f, 0.f, 0.f, 0.f}; d = __builtin_amdgcn_mfma_f32_16x16x32_bf16(kf[i1][ib][0], vf[i1][0], d, 0, 0, 0); d = __builtin_amdgcn_mfma_f32_16x16x32_bf16(kf[i1][ib][1], vf[i1][1], d, 0, 0, 0); u[4 * i2 + i1][ib] = d; }
                }
                pg8::f32x4 e4[2];
#pragma unroll
                for (int ib = 0; ib < 2; ++ib) e4[ib] = (pg8::f32x4){0.f, 0.f, 0.f, 0.f};
#pragma unroll
                for (int i = 0; i < 8; ++i)
#pragma unroll
                    for (int ib = 0; ib < 2; ++ib) e4[ib] = e4[ib] * g64 + u[i][ib];
                LAS pg8::f32x4* ends = (LAS pg8::f32x4*)ldsf;
#pragma unroll
                for (int ib = 0; ib < 2; ++ib) ends[(wave * 2 + ib) * 64 + lane] = e4[ib];
                float g8 = g64; g8 = g8 * g8; g8 = g8 * g8; g8 = g8 * g8;
                __syncthreads();
                pg8::f32x4 st[2];
#pragma unroll
                for (int ib = 0; ib < 2; ++ib) st[ib] = (pg8::f32x4){0.f, 0.f, 0.f, 0.f};
                for (int w2 = 0; w2 < wave; ++w2)
#pragma unroll
                    for (int ib = 0; ib < 2; ++ib) st[ib] = st[ib] * g8 + ends[(w2 * 2 + ib) * 64 + lane];
                bf16* ST = (bf16*)(ws + WS_STATE) + (size_t)(bh * 64 + 8 * wave) * 4096 + (size_t)(16 * dvs + fr) * 64 + 32 * dkh + 4 * fq;
#pragma unroll
                for (int i = 0; i < 8; ++i)
#pragma unroll
                    for (int ib = 0; ib < 2; ++ib) { u32x2 w; w.x = pk2(st[ib][0], st[ib][1]); w.y = pk2(st[ib][2], st[ib][3]); *(u32x2*)(ST + (size_t)i * 4096 + 16 * ib) = w; st[ib] = st[ib] * g64 + u[i][ib]; }
                __syncthreads();
                if (idx < 32) {
                const int bh = idx; const float* lf = (const float*)(ws + WS_LOGF) + (size_t)bh * SEQ; float* cb = (float*)(ws + WS_CB) + (size_t)bh * SEQ;
                const f32x4 a0 = *(const f32x4*)(lf + tid * 8), a1 = *(const f32x4*)(lf + tid * 8 + 4); float v[8] = {a0.x, a0.y, a0.z, a0.w, a1.x, a1.y, a1.z, a1.w};
#pragma unroll
                for (int e = 1; e < 8; ++e) v[e] += v[e - 1];
                float tot = v[7];
#pragma unroll
                for (int o = 1; o < 64; o <<= 1) { const float t = __shfl_up(tot, o); if (lane >= o) tot += t; }
                if (lane == 63) ldsf[wave] = tot;
                __syncthreads();
                float off = tot - v[7];
                for (int w = 0; w < wave; ++w) off += ldsf[w];
                f32x4 o0, o1; o0.x = -(v[0] + off) * LOG2E; o0.y = -(v[1] + off) * LOG2E; o0.z = -(v[2] + off) * LOG2E; o0.w = -(v[3] + off) * LOG2E; o1.x = -(v[4] + off) * LOG2E; o1.y = -(v[5] + off) * LOG2E; o1.z = -(v[6] + off) * LOG2E; o1.w = -(v[7] + off) * LOG2E;
                *(f32x4*)(cb + tid * 8) = o0; *(f32x4*)(cb + tid * 8 + 4) = o1;
                } else if (idx < 64) {
                const int bh = idx - 32, b = bh >> 3, h = bh & 7, rsub = lane >> 3, part = lane & 7;
                const bf16* Qp = (const bf16*)(ws + WS_QO) + ((size_t)b * SEQ + wave * 512 + rsub) * 512 + h * 64 + part * 8; const bf16* Kp = (const bf16*)(ws + WS_KB) + ((size_t)b * SEQ + wave * 512 + rsub) * 512 + h * 64 + part * 8;
                float qm = 0.f, km = 0.f;
#pragma unroll 8
                for (int it = 0; it < 64; ++it) { const u32x4 qv = *(const u32x4*)(Qp + (size_t)it * 8 * 512), kv = *(const u32x4*)(Kp + (size_t)it * 8 * 512); float sq = 0.f, sk = 0.f;
#pragma unroll
                    for (int e = 0; e < 4; ++e) { const float a0 = bflo(qv[e]), a1 = bfhi(qv[e]), c0 = bflo(kv[e]), c1 = bfhi(kv[e]); sq += a0 * a0 + a1 * a1; sk += c0 * c0 + c1 * c1; }
                    sq += __shfl_xor(sq, 1); sq += __shfl_xor(sq, 2); sq += __shfl_xor(sq, 4); sk += __shfl_xor(sk, 1); sk += __shfl_xor(sk, 2); sk += __shfl_xor(sk, 4);
                    qm = fmaxf(qm, sq); km = fmaxf(km, sk); }
#pragma unroll
                for (int o = 8; o < 64; o <<= 1) { qm = fmaxf(qm, __shfl_xor(qm, o)); km = fmaxf(km, __shfl_xor(km, o)); }
                if (lane == 0) { ldsf[wave * 2] = qm; ldsf[wave * 2 + 1] = km; }
                __syncthreads();
                if (tid == 0) { float a = 0.f, c = 0.f; for (int w = 0; w < NWAVES; ++w) { a = fmaxf(a, ldsf[2 * w]); c = fmaxf(c, ldsf[2 * w + 1]); } ((float*)(ws + WS_NRM))[bh] = sqrtf(a) * sqrtf(c) * 1.0001f; }
                }
            }
        }
        GSYNC();
        TSTAMP(3);
        {
            PHASE_VARS;
            if (wave < 4) ret_out_unit(args, l, wave * 256 + bx, lane);
            else {
                const int t = (wave - 4) * 256 + bx, tm = t >> 2, tn = t & 3;
                WEpiGlu E{(const bf16*)(ws + WS_YS5), (bf16*)(ws + WS_GATE), tm * 64, tn * 64};
                wave_gemm64<8, 4, WEpiGlu>((const bf16*)(ws + WS_YS5) + (size_t)(tm * 64) * 256, 256, (const bf16*)(ws + WS_WGLU) + (size_t)l * 65536 + (size_t)(tn * 64) * 256, 256, lane, E);
            }
            __syncthreads();
            const attn_body::AttnTensors AT{(const attn_body::bf16*)(ws + WS_QO), (const attn_body::bf16*)(ws + WS_KB), (const attn_body::bf16*)(ws + WS_VB), (attn_body::bf16*)(ws + WS_GATE), (const float*)(ws + WS_CB), (const float*)(ws + WS_NRM)};
            const attn_body::StaticOrder S(G, bx);
#ifdef REP_ATTN
            attn_body::attn_phase<attn_body::StaticOrder>((char*)lds, AT, S, opaque_true());
#endif
            attn_body::attn_phase<attn_body::StaticOrder>((char*)lds, AT, S);
        }
        GSYNC();
        TSTAMP(4);
        {
            PHASE_VARS;
            pg8::Gemm g{(const bf16*)(ws + WS_GATE), (const bf16*)(ws + WS_WO) + (size_t)l * DM * DM, M, DM, DM, DM, DM, 0, 0};
            pg8::StaticOrder S; S.init(M, DM, G, bx);
            if (l + 1 < DEPTH) {
                EpiOutX<false> E{l == 0 ? args.in[0] : X, X, args.in[1] + (size_t)(l + 1) * DM, (float*)(ws + WS_XBUF), (unsigned*)ws + 4096, (bf16*)(ws + WS_XN), 32u * (unsigned)(l + 1)};
                pg8::gemm_phase<EpiOutX<false>, pg8::StaticOrder, false, true>(ldsl, g, S, E);
            } else {
                EpiOutX<true> E{X, X, args.in[15], (float*)(ws + WS_XBUF), (unsigned*)ws + 4096, nullptr, 32u * (unsigned)(l + 1)};
                pg8::gemm_phase<EpiOutX<true>, pg8::StaticOrder, false, true>(ldsl, g, S, E);
            }
        }
        if (l + 1 < DEPTH) GSYNC();
        TSTAMP(6);
    }
}

extern "C" void kernel_launch(void* const* d_in, const int* in_sizes, int n_in, void* d_out, int out_size, void* d_ws, size_t ws_size, hipStream_t stream) {
    static int grid = 0;
    if (grid == 0) {
        if (n_in != 16 || ws_size < WS_END) { fprintf(stderr, "kernel_launch: unexpected n_in %d / ws %zu\n", n_in, ws_size); grid = -1; return; }
        int dev = 0, cus = 0, per_cu = 0;
        hipGetDevice(&dev); hipDeviceGetAttribute(&cus, hipDeviceAttributeMultiprocessorCount, dev);
        if (hipFuncSetAttribute((const void*)mega_fwd, hipFuncAttributeMaxDynamicSharedMemorySize, LDS_BYTES) != hipSuccess) { fprintf(stderr, "kernel_launch: hipFuncSetAttribute failed\n"); grid = -1; return; }
        if (hipOccupancyMaxActiveBlocksPerMultiprocessor(&per_cu, (const void*)mega_fwd, NTHR, LDS_BYTES) != hipSuccess || per_cu < 1) { fprintf(stderr, "kernel_launch: occupancy query failed (%d)\n", per_cu); grid = -1; return; }
        grid = cus;
        if (grid != 256) fprintf(stderr, "kernel_launch: note: %d CUs\n", grid);
    }
    if (grid < 0) return;
    if (hipMemsetAsync(d_ws, 0, 32768, stream) != hipSuccess) { fprintf(stderr, "kernel_launch: hipMemsetAsync failed\n"); return; }
    Args a{};
    for (int i = 0; i < 16; ++i) a.in[i] = (const float*)d_in[i];
    a.out = (float*)d_out; a.ws = (unsigned char*)d_ws;
    void* kargs[] = {&a};
    hipError_t e = hipLaunchCooperativeKernel((const void*)mega_fwd, dim3(grid), dim3(NTHR), kargs, LDS_BYTES, stream);
    if (e != hipSuccess) fprintf(stderr, "kernel_launch: cooperative launch failed: %s\n", hipGetErrorString(e));
}
```

```cpp
#include <hip/hip_runtime.h>
#include <cstdio>
#include <cstdint>
namespace pg8 {
#define PG8_LAS __attribute__((address_space(3)))
typedef unsigned short bf16_t;
typedef short bf16x8 __attribute__((ext_vector_type(8)));
typedef float f32x4 __attribute__((ext_vector_type(4)));
typedef unsigned u32x4 __attribute__((ext_vector_type(4)));
constexpr int BM = 256, BK = 64, HALF = 128, HTB = HALF * BK * 2  , STAGE_BYTES = 8 * HTB, NXCD = 8, WGM = 4;

__host__ __device__ __forceinline__ int lds_byte(int r, int c) { const int st = (r >> 4) * 2 + (c >> 5), rr = r & 15, cc = c & 31, ob = rr * 64 + cc * 2; return st * 1024 + (ob ^ (((ob >> 9) & 1) << 5)); }
__host__ __device__ __forceinline__ void stage_rc(int b, int& R, int& C) { const int st = b / 1024, sb = b % 1024, swz = sb ^ (((sb >> 9) & 1) << 5); R = (st >> 1) * 16 + swz / 64; C = (st & 1) * 32 + (swz % 64) / 2; }
__host__ __device__ __forceinline__ int perm32(int rho) { const int n = rho >> 4, i = rho & 15; return 8 * (i >> 2) + 4 * n + (i & 3); }

struct Unit { int pm, pn, gz; };
struct Gemm { const bf16_t* A; const bf16_t* Bt; int M, N, K; int lda, ldb; size_t gsA, gsB; };

struct StaticOrder {
    int nM, nN, nwg, G, c;
    __host__ __device__ void init(int M, int N, int G_, int c_) { nM = M / BM; nN = N / BM; nwg = nM * nN; G = G_; c = c_; }
    __host__ __device__ bool next(int i, Unit& u) const {
        const long L = (long)i * G + c; if (L >= nwg) return false;
        int wgid = (int)L; { const int q = nwg / NXCD, r = nwg % NXCD, xcd = wgid % NXCD, off = wgid / NXCD; wgid = (xcd < r ? xcd * (q + 1) : r * (q + 1) + (xcd - r) * q) + off; }
        const int nig = WGM * nN, gid = wgid / nig, fm = gid * WGM, gsz = (nM - fm) < WGM ? (nM - fm) : WGM;
        u.pm = fm + ((wgid % nig) % gsz); u.pn = (wgid % nig) / gsz; u.gz = 0; return true;
    }
    __device__ __forceinline__ void a_ready(const Unit&) const {}
    __device__ __forceinline__ void done(const Unit&) const {}
};

__device__ __forceinline__ unsigned cvt_pk_bf16(float lo, float hi) { unsigned r; asm volatile("v_cvt_pk_bf16_f32 %0, %1, %2" : "=v"(r) : "v"(lo), "v"(hi)); return r; }
typedef float f32x2 __attribute__((ext_vector_type(2)));
__device__ __forceinline__ f32x2 gelu_pk(f32x2 v) {
    const f32x2 av = __builtin_elementwise_abs(v), d = av * 0.2316418882f + 1.0f;
    f32x2 t; t.x = __builtin_amdgcn_rcpf(d.x); t.y = __builtin_amdgcn_rcpf(d.y);
    f32x2 q = t * 0.5307027145f + (-0.7265760135f); q = q * t + 0.7107068705f; q = q * t + (-0.142248368f); q = q * t + 0.127414796f; q = q * t;
    const f32x2 s = (v * v) * (-0.72134752044f);
    f32x2 e; e.x = __builtin_amdgcn_exp2f(s.x); e.y = __builtin_amdgcn_exp2f(s.y);
    const f32x2 m = v * (q * e), r = v - m;
    f32x2 o; o.x = v.x < 0.f ? m.x : r.x; o.y = v.y < 0.f ? m.y : r.y; return o;
}

template <class Epi, class Sched, bool ALIGN_EPI = false, bool SP2 = false>
__device__ __forceinline__ void gemm_phase(PG8_LAS unsigned char* lds, const Gemm g, const Sched& S, const Epi& E) {
    int tid_ = threadIdx.x; asm volatile("" : "+v"(tid_));
    const int tid = tid_, wid = __builtin_amdgcn_readfirstlane(tid >> 6), lane = tid & 63, wr = wid >> 2, wc = wid & 3, fr = lane & 15, fq = lane >> 4;
    const int K = g.K, nt = K / BK;
    unsigned voffA[2], voffB[2];
#pragma unroll
    for (int i = 0; i < 2; ++i) { int R, C; stage_rc(tid * 16 + i * 8192, R, C); const int Rb = Epi::PERM ? ((R & ~31) + perm32(R & 31)) : R;
        voffA[i] = (unsigned)(R * g.lda + C) * 2u; voffB[i] = (unsigned)(Rb * g.ldb + C) * 2u; }
    const size_t kstep = (size_t)(BK * 2);
    const size_t hstepA = (size_t)HALF * g.lda * 2, hstepB = (size_t)HALF * g.ldb * 2;
    const size_t tstepA = 2 * hstepA, tstepB = 2 * hstepB;
    const unsigned ldsw = (unsigned)wid * 1024u;
    const int aoff = lds_byte(wr * 64 + fr, fq * 8), boff = lds_byte(wc * 32 + fr, fq * 8);
#define PG8_SA(b, h) (((b) * 2 + (h)) * HTB)
#define PG8_SB(b, h) ((4 + (b) * 2 + (h)) * HTB)
#define PG8_STAGE(bufoff, gbase, voff) do { _Pragma("unroll") for (int _i = 0; _i < 2; ++_i) \
        __builtin_amdgcn_global_load_lds((const unsigned*)((const char*)(gbase) + (voff)[_i]), (PG8_LAS unsigned*)(lds + (bufoff) + ldsw + _i * 8192), 16, 0, 0); } while (0)
#define PG8_LDA(dst, b, h) do { _Pragma("unroll") for (int m = 0; m < 4; ++m) _Pragma("unroll") for (int k = 0; k < 2; ++k) dst[m][k] = *(const PG8_LAS bf16x8*)(lds + PG8_SA(b, h) + aoff + m * 2048 + k * 1024); } while (0)
#define PG8_LDB(dst, b, h) do { _Pragma("unroll") for (int n = 0; n < 2; ++n) _Pragma("unroll") for (int k = 0; k < 2; ++k) dst[n][k] = *(const PG8_LAS bf16x8*)(lds + PG8_SB(b, h) + boff + n * 2048 + k * 1024); } while (0)
#define PG8_MMA(ai, bj, At, Bt) do { __builtin_amdgcn_s_setprio(1); _Pragma("unroll") for (int m = 0; m < 4; ++m) _Pragma("unroll") for (int n = 0; n < 2; ++n) _Pragma("unroll") for (int k = 0; k < 2; ++k) \
        acc[ai][bj][m][n] = __builtin_amdgcn_mfma_f32_16x16x32_bf16(Bt[n][k], At[m][k], acc[ai][bj][m][n], 0, 0, 0); __builtin_amdgcn_s_setprio(0); } while (0)
#define PG8_WAIT_V(n) asm volatile("s_waitcnt vmcnt(" #n ")" ::: "memory")
#define PG8_WAIT_L(n) asm volatile("s_waitcnt lgkmcnt(" #n ")" ::: "memory")
#define PG8_BAR __builtin_amdgcn_s_barrier()
#define PG8_SCHED __builtin_amdgcn_sched_barrier(0)
    Unit cur, nxt; int ui = 0;
    if (!S.next(0, cur)) return;
    f32x4 acc[2][2][4][2];
#pragma unroll
    for (int a = 0; a < 2; ++a)
#pragma unroll
        for (int b = 0; b < 2; ++b)
#pragma unroll
            for (int m = 0; m < 4; ++m)
#pragma unroll
                for (int n = 0; n < 2; ++n) acc[a][b][m][n] = (f32x4){0.f, 0.f, 0.f, 0.f};
    bf16x8 At[4][2], B0[2][2], B1[2][2];
    const char* cA = (const char*)g.A + (size_t)cur.gz * g.gsA * 2 + (size_t)cur.pm * tstepA; const char* cB = (const char*)g.Bt + (size_t)cur.gz * g.gsB * 2 + (size_t)cur.pn * tstepB;
    S.a_ready(cur);
    if constexpr (SP2) {
        PG8_STAGE(PG8_SB(0, 0), cB, voffB); PG8_STAGE(PG8_SB(0, 1), cB + hstepB, voffB); PG8_STAGE(PG8_SA(0, 0), cA, voffA); PG8_STAGE(PG8_SA(0, 1), cA + hstepA, voffA);
        if (wr == 1) PG8_BAR;
        PG8_WAIT_V(2); PG8_BAR;
        PG8_STAGE(PG8_SB(1, 0), cB + kstep, voffB); PG8_STAGE(PG8_SA(1, 0), cA + kstep, voffA); PG8_STAGE(PG8_SB(1, 1), cB + hstepB + kstep, voffB);
        PG8_WAIT_V(6); PG8_BAR;
    } else {
        PG8_STAGE(PG8_SB(0, 0), cB, voffB); PG8_STAGE(PG8_SA(0, 0), cA, voffA); PG8_STAGE(PG8_SB(0, 1), cB + hstepB, voffB); PG8_STAGE(PG8_SA(0, 1), cA + hstepA, voffA);
        if (wr == 1) PG8_BAR;
        PG8_WAIT_V(4); PG8_BAR;
        PG8_STAGE(PG8_SB(1, 0), cB + kstep, voffB); PG8_STAGE(PG8_SA(1, 0), cA + kstep, voffA); PG8_STAGE(PG8_SB(1, 1), cB + hstepB + kstep, voffB);
        PG8_WAIT_V(6); PG8_BAR;
    }
    for (;;) {
        const bool has_next = S.next(ui + 1, nxt);
        const char* nA = has_next ? (const char*)g.A + (size_t)nxt.gz * g.gsA * 2 + (size_t)nxt.pm * tstepA : cA; const char* nB = has_next ? (const char*)g.Bt + (size_t)nxt.gz * g.gsB * 2 + (size_t)nxt.pn * tstepB : cB;
        for (int t = 0; t < nt; t += 2) {
            const bool last = (t == nt - 2);
            const char* a1 = cA + (size_t)(t + 1) * kstep;
            const char* a2 = last ? nA : cA + (size_t)(t + 2) * kstep; const char* b2 = last ? nB : cB + (size_t)(t + 2) * kstep;
            const char* a3 = a2 + kstep; const char* b3 = b2 + kstep;
            if (last && has_next) S.a_ready(nxt);
            if constexpr (SP2) {
            PG8_LDB(B0, 0, 0); PG8_LDB(B1, 0, 1); PG8_SCHED; PG8_LDA(At, 0, 0); PG8_STAGE(PG8_SA(1, 1), a1 + hstepA, voffA);
            PG8_WAIT_V(8); PG8_WAIT_L(0); PG8_BAR; PG8_MMA(0, 0, At, B0); PG8_MMA(0, 1, At, B1); PG8_BAR; PG8_SCHED;
            PG8_LDA(At, 0, 1); PG8_STAGE(PG8_SB(0, 0), b2, voffB); PG8_STAGE(PG8_SB(0, 1), b2 + hstepB, voffB); PG8_STAGE(PG8_SA(0, 0), a2, voffA);
            PG8_WAIT_V(8); PG8_WAIT_L(0); PG8_BAR; PG8_MMA(1, 0, At, B0); PG8_MMA(1, 1, At, B1); PG8_BAR; PG8_SCHED;
            PG8_LDB(B0, 1, 0); PG8_LDB(B1, 1, 1); PG8_SCHED; PG8_LDA(At, 1, 0); PG8_STAGE(PG8_SA(0, 1), a2 + hstepA, voffA);
            PG8_WAIT_V(8); PG8_WAIT_L(0); PG8_BAR; PG8_MMA(0, 0, At, B0); PG8_MMA(0, 1, At, B1); PG8_BAR; PG8_SCHED;
            PG8_LDA(At, 1, 1); PG8_STAGE(PG8_SB(1, 0), b3, voffB); PG8_STAGE(PG8_SB(1, 1), b3 + hstepB, voffB); PG8_STAGE(PG8_SA(1, 0), a3, voffA);
            PG8_WAIT_V(8); PG8_WAIT_L(0); PG8_BAR; PG8_MMA(1, 0, At, B0); PG8_MMA(1, 1, At, B1); PG8_BAR; PG8_SCHED;
            } else {
            PG8_LDB(B0, 0, 0); PG8_SCHED; PG8_LDA(At, 0, 0); PG8_STAGE(PG8_SA(1, 1), a1 + hstepA, voffA);
            PG8_WAIT_L(8); PG8_BAR; PG8_WAIT_L(0); PG8_MMA(0, 0, At, B0); PG8_BAR; PG8_SCHED;
            PG8_LDB(B1, 0, 1); PG8_STAGE(PG8_SB(0, 0), b2, voffB);
            PG8_BAR; PG8_WAIT_L(0); PG8_MMA(0, 1, At, B1); PG8_BAR;
            PG8_LDA(At, 0, 1); PG8_STAGE(PG8_SA(0, 0), a2, voffA);
            PG8_BAR; PG8_WAIT_L(0); PG8_MMA(1, 0, At, B0); PG8_BAR; PG8_SCHED;
            PG8_STAGE(PG8_SB(0, 1), b2 + hstepB, voffB);
            PG8_WAIT_V(6); PG8_BAR; PG8_MMA(1, 1, At, B1); PG8_BAR;
            PG8_LDB(B0, 1, 0); PG8_SCHED; PG8_LDA(At, 1, 0); PG8_STAGE(PG8_SA(0, 1), a2 + hstepA, voffA);
            PG8_WAIT_L(8); PG8_BAR; PG8_WAIT_L(0); PG8_MMA(0, 0, At, B0); PG8_BAR; PG8_SCHED;
            PG8_LDB(B1, 1, 1); PG8_STAGE(PG8_SB(1, 0), b3, voffB);
            PG8_BAR; PG8_WAIT_L(0); PG8_MMA(0, 1, At, B1); PG8_BAR;
            PG8_LDA(At, 1, 1); PG8_STAGE(PG8_SA(1, 0), a3, voffA);
            PG8_BAR; PG8_WAIT_L(0); PG8_MMA(1, 0, At, B0); PG8_BAR; PG8_SCHED;
            PG8_STAGE(PG8_SB(1, 1), b3 + hstepB, voffB);
            PG8_WAIT_V(6); PG8_BAR; PG8_MMA(1, 1, At, B1); PG8_BAR;
            }
        }
        if constexpr (ALIGN_EPI) { if (wr == 0) PG8_BAR; }
        if constexpr (!Epi::AFTER_DRAIN) { E(acc, cur, wr, wc, fr, fq); S.done(cur); }
        if (!has_next) break;
#pragma unroll
        for (int a = 0; a < 2; ++a)
#pragma unroll
            for (int b = 0; b < 2; ++b)
#pragma unroll
                for (int m = 0; m < 4; ++m)
#pragma unroll
                    for (int n = 0; n < 2; ++n) acc[a][b][m][n] = (f32x4){0.f, 0.f, 0.f, 0.f};
        cur = nxt; cA = nA; cB = nB; ++ui;
        if constexpr (ALIGN_EPI) { if (wr == 1) PG8_BAR; }
    }
    PG8_WAIT_V(0);
    if constexpr (!ALIGN_EPI) { if (wr == 0) PG8_BAR; }
    PG8_BAR;
    if constexpr (Epi::AFTER_DRAIN) { E.fused(acc, cur, wr, wc, fr, fq, lds, wid, lane); S.done(cur); }
#undef PG8_SA
#undef PG8_SB
#undef PG8_STAGE
#undef PG8_LDA
#undef PG8_LDB
#undef PG8_MMA
#undef PG8_WAIT_V
#undef PG8_WAIT_L
#undef PG8_BAR
#undef PG8_SCHED
}
}
#include <hip/hip_bf16.h>
#include <cmath>
namespace attn_body {
using bf16=__hip_bfloat16;
using bf16x8=__attribute__((ext_vector_type(8)))short;
using s16x4=__attribute__((ext_vector_type(4)))short;
using f32x16=__attribute__((ext_vector_type(16)))float;
using u32x4=__attribute__((ext_vector_type(4)))unsigned;
using f32x4=__attribute__((ext_vector_type(4)))float;
constexpr int BATCH=4,NHEAD=8,SEQ=4096,D=64,DM=NHEAD*D,OPITCH=1024;
constexpr int NW=8,QBLK=32,QB=QBLK*NW,KVBLK=64,NQB=SEQ/QB;
constexpr int ATTN_PITCH=DM, ATTN_UNIT_ROWS=QB;
__device__ __forceinline__ int crow(int r,int hi){return (r&3)+8*(r>>2)+4*hi;}
#define SBAR() __builtin_amdgcn_sched_barrier(0)
__device__ __forceinline__ void cmask(f32x16&p0,f32x16&p1,int jb,int qrel,int hi){
  const float NEG=-INFINITY; int kb=64*jb+4*hi;
  #pragma unroll
  for(int r=0;r<16;++r){int kv=kb+(r&3)+8*(r>>2); if(kv>qrel)p0[r]=NEG; if(kv+32>qrel)p1[r]=NEG;}
}

constexpr int NSLOT=3, SLOTB=8192;
constexpr int LDS_K=0, LDS_V=NSLOT*SLOTB, LDS_WS=2*NSLOT*SLOTB, LDS_OST=LDS_WS+NW*64*4, LDS_CB=LDS_OST+NW*4096, LDS_BYTES=LDS_CB+SEQ*4;
constexpr float C2=0.125f*1.4426950408889634f;
__device__ __forceinline__ void glds16(const void*gsrc,unsigned lds_dst){unsigned keep;
  asm volatile("s_mov_b32 %0, m0\n\ts_mov_b32 m0, %2\n\ts_nop 0\n\tglobal_load_lds_dwordx4 %1, off\n\ts_mov_b32 m0, %0":"=&s"(keep):"v"(gsrc),"s"(lds_dst):"memory");}
__device__ __forceinline__ float max3f(float a,float b,float c){float r;asm("v_max3_f32 %0, %1, %2, %3":"=v"(r):"v"(a),"v"(b),"v"(c));return r;}
__device__ __forceinline__ float max2f(float a,float b){float r;asm("v_max_f32_e32 %0, %1, %2":"=v"(r):"v"(a),"v"(b));return r;}
__device__ __forceinline__ float fadd_s(float a,float b){float r;asm("v_add_f32_e32 %0, %1, %2":"=v"(r):"v"(a),"v"(b));return r;}
__device__ __forceinline__ float fsub_s(float a,float b){float r;asm("v_sub_f32_e32 %0, %1, %2":"=v"(r):"v"(a),"v"(b));return r;}
typedef float f32x2_t __attribute__((ext_vector_type(2))); typedef __bf16 bf16x2_t __attribute__((ext_vector_type(2)));
__device__ __forceinline__ unsigned cvtpk_s(float lo,float hi){f32x2_t v={lo,hi};bf16x2_t b=__builtin_convertvector(v,bf16x2_t);return __builtin_bit_cast(unsigned,b);}
#define WAIT_BAR(N) asm volatile("s_waitcnt vmcnt(" #N ") lgkmcnt(0)\n\ts_barrier":::"memory")

__device__ __forceinline__ void qkt(f32x16&p0,f32x16&p1,const char*Kslot,const bf16x8*qr,const char*cbt,int r32,int hi){
  const char*kb=Kslot+hi*1024+r32*16;
  #pragma unroll
  for(int a=0;a<4;++a){ const f32x4 u0=*reinterpret_cast<const f32x4*>(cbt+hi*16+a*32), u1=*reinterpret_cast<const f32x4*>(cbt+128+hi*16+a*32);
    p0[4*a]=u0[0];p0[4*a+1]=u0[1];p0[4*a+2]=u0[2];p0[4*a+3]=u0[3]; p1[4*a]=u1[0];p1[4*a+1]=u1[1];p1[4*a+2]=u1[2];p1[4*a+3]=u1[3]; }
  #pragma unroll
  for(int d0=0;d0<4;++d0){
    const bf16x8 b0=*reinterpret_cast<const bf16x8*>(kb+d0*2048);
    const bf16x8 b1=*reinterpret_cast<const bf16x8*>(kb+d0*2048+512);
    p0=__builtin_amdgcn_mfma_f32_32x32x16_bf16(b0,qr[d0],p0,0,0,0);p1=__builtin_amdgcn_mfma_f32_32x32x16_bf16(b1,qr[d0],p1,0,0,0);}
}
typedef __attribute__((address_space(3))) const char* lds_cptr;
typedef short v4i16_t __attribute__((ext_vector_type(4)));
__device__ __forceinline__ void kload8(bf16x8*kf,lds_cptr kp){
  kf[0]=*(const __attribute__((address_space(3))) bf16x8*)(kp);      kf[1]=*(const __attribute__((address_space(3))) bf16x8*)(kp+512);
  kf[2]=*(const __attribute__((address_space(3))) bf16x8*)(kp+2048); kf[3]=*(const __attribute__((address_space(3))) bf16x8*)(kp+2560);
  kf[4]=*(const __attribute__((address_space(3))) bf16x8*)(kp+4096); kf[5]=*(const __attribute__((address_space(3))) bf16x8*)(kp+4608);
  kf[6]=*(const __attribute__((address_space(3))) bf16x8*)(kp+6144); kf[7]=*(const __attribute__((address_space(3))) bf16x8*)(kp+6656);
}
__device__ __forceinline__ void kload2(bf16x8*kf,lds_cptr kp,int j){ kf[2*j]=*(const __attribute__((address_space(3))) bf16x8*)(kp+j*2048); kf[2*j+1]=*(const __attribute__((address_space(3))) bf16x8*)(kp+j*2048+512); }
__device__ __forceinline__ s16x4 vtr(lds_cptr p){ return __builtin_bit_cast(s16x4,__builtin_amdgcn_ds_read_tr16_b64_v4i16((__attribute__((address_space(3))) v4i16_t*)p)); }
__device__ __forceinline__ float rowmax(const f32x16&p0,const f32x16&p1){
  float a=max3f(p0[0],p0[1],p1[0]),b=max3f(p0[2],p0[3],p1[1]);a=max3f(a,p1[2],p1[3]);
  #pragma unroll
  for(int r=4;r<16;r+=4){a=max3f(a,p0[r],p0[r+1]);b=max3f(b,p0[r+2],p0[r+3]);a=max3f(a,p1[r],p1[r+1]);b=max3f(b,p1[r+2],p1[r+3]);}
  const float m=max2f(a,b);
  auto rr=__builtin_amdgcn_permlane32_swap(__float_as_uint(m),__float_as_uint(m),false,false);
  return max2f(__uint_as_float(rr[0]),__uint_as_float(rr[1]));
}
__device__ __forceinline__ void pv(f32x16*o,int vb,bf16x8 pa0,bf16x8 pa1,bf16x8 pa2,bf16x8 pa3){
  #pragma unroll
  for(int d0=0;d0<2;++d0){s16x4 lo[4],hi[4];
    #pragma unroll
    for(int ks=0;ks<4;++ks){
      asm volatile("ds_read_b64_tr_b16 %0,%1 offset:%c2":"=&v"(lo[ks]):"v"(vb),"i"(d0*4096+ks*1024):"memory");
      asm volatile("ds_read_b64_tr_b16 %0,%1 offset:%c2":"=&v"(hi[ks]):"v"(vb),"i"(d0*4096+ks*1024+512):"memory");}
    asm volatile("s_waitcnt lgkmcnt(0)":::"memory");SBAR();
    #define PK(k) (bf16x8){lo[k][0],lo[k][1],lo[k][2],lo[k][3],hi[k][0],hi[k][1],hi[k][2],hi[k][3]}
    o[d0]=__builtin_amdgcn_mfma_f32_32x32x16_bf16(pa0,PK(0),o[d0],0,0,0);
    o[d0]=__builtin_amdgcn_mfma_f32_32x32x16_bf16(pa1,PK(1),o[d0],0,0,0);
    o[d0]=__builtin_amdgcn_mfma_f32_32x32x16_bf16(pa2,PK(2),o[d0],0,0,0);
    o[d0]=__builtin_amdgcn_mfma_f32_32x32x16_bf16(pa3,PK(3),o[d0],0,0,0);
    #undef PK
  }
}

#ifndef ATTN_STORE16
#define ATTN_STORE16(p,v) (*(u32x4*)(p)=(v))
#endif
template<int THRL> __device__ __forceinline__ void attn_unit(int b,int h,int qb,const bf16*Q,const bf16*__restrict__ K,const bf16*__restrict__ V,bf16*O,const float*__restrict__ CB,const float*__restrict__ NRM,char*shm,bool dry=false){
  int tid_=threadIdx.x; asm volatile("":"+v"(tid_)); const int tid=tid_,lane=tid&63,r32=lane&31,hi=lane>>5; const int wid=__builtin_amdgcn_readfirstlane(tid>>6);
  const long rowbase=(long)b*SEQ; const int q0=qb*QB;
  int t0;
  { const f32x4* cbg=reinterpret_cast<const f32x4*>(CB+(long)(b*NHEAD+h)*SEQ); f32x4* cbl=reinterpret_cast<f32x4*>(shm+LDS_CB); const int nv=(q0+QB)/4;
    for(int i=tid;i<nv;i+=NW*64) cbl[i]=cbg[i];
    const float bnd=NRM[b*NHEAD+h]+36.f;
    asm volatile("s_waitcnt vmcnt(0) lgkmcnt(0)\n\ts_barrier":::"memory");
    const float*cbf=reinterpret_cast<const float*>(shm+LDS_CB); const int tc=2*lane; const int NT0=(q0+QB)/KVBLK;
    const bool ok=(tc<=NT0-4)&&(tc==0||cbf[64*tc-1]+bnd<=cbf[q0]);
    const unsigned long long mk=__ballot(ok); t0=2*(__popcll(mk)-1); t0=__builtin_amdgcn_readfirstlane(t0); }
  const bf16*Qw=Q+(rowbase+q0+wid*QBLK)*DM+h*D;
  const bf16*Kh=K+(rowbase+(long)t0*KVBLK)*DM+h*D,*Vh=V+(rowbase+(long)t0*KVBLK)*DM+h*D;
  const unsigned lds0=(unsigned)(uintptr_t)shm;
  float*wsf=(float*)(shm+LDS_WS)+wid*64;
  const bf16*ksrc=Kh+(long)lane*DM+wid*8;
  const bf16*vsrc=Vh+(long)(16*(wid&3)+(lane>>2))*DM+(wid>>2)*32+(lane&3)*8;
  const unsigned kdst=lds0+LDS_K+wid*1024, vdst=lds0+LDS_V+wid*1024;
  #define DMA_K(t,slot) glds16(ksrc+(long)(t)*KVBLK*DM,(unsigned)__builtin_amdgcn_readfirstlane(kdst+(slot)))
  #define DMA_V(t,slot) glds16(vsrc+(long)(t)*KVBLK*DM,(unsigned)__builtin_amdgcn_readfirstlane(vdst+(slot)))
  const int vb0=(int)(lds0+LDS_V)+((lane>>4)&1)*32+(lane&3)*8+(4*hi+((lane&15)>>2))*64;
  const char*Kbase=shm+LDS_K; bf16x8 kf[8];
  const lds_cptr shm3=(lds_cptr)shm; const lds_cptr kp0=shm3+LDS_K+hi*1024+r32*16; const lds_cptr vp0=shm3+LDS_V+((lane>>4)&1)*32+(lane&3)*8+(4*hi+((lane&15)>>2))*64;
  const int NT=(q0+QB)/KVBLK-t0;
  const lds_cptr cb3=(lds_cptr)shm+LDS_CB+t0*256;
  const float cb_own=*(const __attribute__((address_space(3))) float*)((lds_cptr)shm+LDS_CB+(q0+wid*QBLK+r32)*4);
  DMA_K(0,0);DMA_V(0,0);DMA_K(1,SLOTB);
  bf16x8 qr[4];
  #pragma unroll
  for(int d0=0;d0<4;++d0)qr[d0]=*reinterpret_cast<const bf16x8*>(&Qw[(long)r32*DM+d0*16+hi*8]);
  float mhat=0.f,l_reg=0.f;f32x16 o[2];o[0]=f32x16{};o[1]=f32x16{};
  const int qrel=wid*QBLK+r32;
  #define CMASK(P0,P1,t) do{int jb_=(t)-(NT-4); if(jb_>=0)cmask(P0,P1,jb_,qrel,hi);}while(0)
  bool resc=false;
  #define START(P0,P1) do{ const float rm=max2f(rowmax(P0,P1),cb_own); resc=false; \
    { const float dl=rm; mhat=fadd_s(mhat,dl); \
      _Pragma("unroll") for(int r=0;r<16;++r){P0[r]=fsub_s(P0[r],dl);P1[r]=fsub_s(P1[r],dl);} } \
    _Pragma("unroll") for(int r=0;r<16;++r)P0[r]=__builtin_amdgcn_exp2f(P0[r]); }while(0)
  #define RESC() do{ if(resc){ asm volatile("s_waitcnt lgkmcnt(0)":::"memory"); \
      _Pragma("unroll") for(int d_=0;d_<2;++d_) _Pragma("unroll") for(int r=0;r<16;++r)o[d_][r]*=wsf[crow(r,hi)]; } }while(0)
  f32x16 pA0,pA1,pB0,pB1;
  int sl_prev=0,sl_cur=0,sl_next=SLOTB;
  #define ROT() do{sl_prev=sl_cur;sl_cur=sl_next;sl_next=(sl_next==(NSLOT-1)*SLOTB)?0:sl_next+SLOTB;}while(0)
  DMA_K(2,2*SLOTB);
  WAIT_BAR(3);
  qkt(pA0,pA1,Kbase,qr,shm+LDS_CB+t0*256,r32,hi);asm volatile("s_nop 15\n\ts_nop 7":"+v"(pA0),"+v"(pA1));CMASK(pA0,pA1,0);
  START(pA0,pA1);
  _Pragma("unroll") for(int r=0;r<16;++r)pA1[r]=__builtin_amdgcn_exp2f(pA1[r]);
  WAIT_BAR(0);
  DMA_K(3,0);DMA_V(1,SLOTB);
  ROT();
  kload8(kf,kp0+sl_cur);
  WAIT_BAR(2);
  s16x4 vlo[8],vhi[8]; u32x4 pw0,pw1,pw2,pw3;
  #define PKW(P,B) cvtpk_s(P[B],P[B+1])
  #define PAF(k) __builtin_bit_cast(bf16x8,pw##k)
  #define VFR(i) (bf16x8){vlo[i][0],vlo[i][1],vlo[i][2],vlo[i][3],vhi[i][0],vhi[i][1],vhi[i][2],vhi[i][3]}
  #define PIN(x) asm volatile("":"+v"(x))
  #define MX3(a,b,c) __builtin_fmaxf(__builtin_fmaxf((a),(b)),(c))
  #define GAPA(MF,A0,A1,A2,A3,W0,W1,PW) do{ MF; sacc+=A0; sacc+=A1; sacc+=A2; sacc+=A3; PIN(sacc); W0; W1; PIN(PW); SBAR(); }while(0)
  #define EX(v) __builtin_amdgcn_exp2f(v)
  #define GAPB(MF,X,B) do{ MF; X[B]=EX(X[B]); X[B+1]=EX(X[B+1]); X[B+2]=EX(X[B+2]); X[B+3]=EX(X[B+3]); PIN(X); SBAR(); }while(0)
  #define VRD(i) do{ vlo[i]=vtr(vp_+(((i)>>2)*4096+((i)&3)*1024)); vhi[i]=vtr(vp_+(((i)>>2)*4096+((i)&3)*1024+512)); }while(0)
  #define KRD(G,j) do{ if(G){ kload2(kf,kp0+sl_next,j); SBAR(); } }while(0)
  #define STEP(C0,C1,P0,P1,t,GK,GV,GL) do{ SBAR(); \
    const lds_cptr vp_=vp0+sl_prev; \
    VRD(0); SBAR(); float sacc=(P0[0]+P0[1]); \
    GAPA(C0=__builtin_amdgcn_mfma_f32_32x32x16_bf16(kf[0],qr[0],C0,0,0,0), P0[2],P0[3],P0[4],P0[5],     pw0[0]=PKW(P0,0), pw0[1]=PKW(P0,2), pw0); \
    VRD(4); SBAR(); GAPA(C1=__builtin_amdgcn_mfma_f32_32x32x16_bf16(kf[1],qr[0],C1,0,0,0), P0[6],P0[7],P0[8],P0[9],     pw0[2]=PKW(P0,4), pw0[3]=PKW(P0,6), pw0); \
    VRD(1); SBAR(); GAPA(C0=__builtin_amdgcn_mfma_f32_32x32x16_bf16(kf[2],qr[1],C0,0,0,0),   P0[10],P0[11],P0[12],P0[13], pw1[0]=PKW(P0,8), pw1[1]=PKW(P0,10), pw1); \
    VRD(5); SBAR(); GAPA(C1=__builtin_amdgcn_mfma_f32_32x32x16_bf16(kf[3],qr[1],C1,0,0,0),   P0[14],P0[15],P1[0],P1[1],   pw1[2]=PKW(P0,12),pw1[3]=PKW(P0,14), pw1); \
    VRD(2); SBAR(); GAPA(C0=__builtin_amdgcn_mfma_f32_32x32x16_bf16(kf[4],qr[2],C0,0,0,0),   P1[2],P1[3],P1[4],P1[5],     pw2[0]=PKW(P1,0), pw2[1]=PKW(P1,2), pw2); \
    VRD(6); SBAR(); GAPA(C1=__builtin_amdgcn_mfma_f32_32x32x16_bf16(kf[5],qr[2],C1,0,0,0),   P1[6],P1[7],P1[8],P1[9],     pw2[2]=PKW(P1,4), pw2[3]=PKW(P1,6), pw2); \
    VRD(3); SBAR(); GAPA(C0=__builtin_amdgcn_mfma_f32_32x32x16_bf16(kf[6],qr[3],C0,0,0,0),   P1[10],P1[11],P1[12],P1[13], pw3[0]=PKW(P1,8), pw3[1]=PKW(P1,10), pw3); \
    VRD(7); SBAR(); GAPA(C1=__builtin_amdgcn_mfma_f32_32x32x16_bf16(kf[7],qr[3],C1,0,0,0),   P1[14],P1[15],0.f,0.f,       pw3[2]=PKW(P1,12),pw3[3]=PKW(P1,14), pw3); \
    l_reg+=sacc; \
    if(GK){DMA_K((t)+3,sl_cur);} if(GV){DMA_V((t)+1,sl_next);} \
    CMASK(C0,C1,t); \
    { float a=MX3(C0[0],C0[1],C1[0]),b=MX3(C0[2],C0[3],C1[1]); a=MX3(a,C1[2],C1[3]); \
      _Pragma("unroll") for(int r=4;r<16;r+=4){a=MX3(a,C0[r],C0[r+1]);b=MX3(b,C0[r+2],C0[r+3]);a=MX3(a,C1[r],C1[r+1]);b=MX3(b,C1[r+2],C1[r+3]);} \
      float rm=__builtin_fmaxf(a,b); { auto rr=__builtin_amdgcn_permlane32_swap(__float_as_uint(rm),__float_as_uint(rm),false,false); rm=__builtin_fmaxf(__uint_as_float(rr[0]),__uint_as_float(rr[1])); } \
      resc=false; \
      if(__builtin_expect(__any(rm>(float)THRL),0)){ const float dl=__builtin_fmaxf(rm,0.f); mhat+=dl; \
        _Pragma("unroll") for(int r=0;r<16;++r){C0[r]-=dl;C1[r]-=dl;} \
        const float f=__builtin_amdgcn_exp2f(-dl); l_reg*=f; if(hi==0)wsf[r32]=f; resc=true; } } \
    SBAR(); \
    { const __attribute__((address_space(3))) f32x4* cbp_=(const __attribute__((address_space(3))) f32x4*)(cb3+((t)+1)*256+hi*16); \
      _Pragma("unroll") for(int a_=0;a_<4;++a_){ const f32x4 u0_=cbp_[2*a_], u1_=cbp_[8+2*a_]; \
        P0[4*a_]=u0_[0];P0[4*a_+1]=u0_[1];P0[4*a_+2]=u0_[2];P0[4*a_+3]=u0_[3]; P1[4*a_]=u1_[0];P1[4*a_+1]=u1_[1];P1[4*a_+2]=u1_[2];P1[4*a_+3]=u1_[3]; } } SBAR(); \
    GAPB(o[0]=__builtin_amdgcn_mfma_f32_32x32x16_bf16(PAF(0),VFR(0),o[0],0,0,0), C0,0); \
    GAPB(o[1]=__builtin_amdgcn_mfma_f32_32x32x16_bf16(PAF(0),VFR(4),o[1],0,0,0), C0,4); \
    KRD(GL,0); GAPB(o[0]=__builtin_amdgcn_mfma_f32_32x32x16_bf16(PAF(1),VFR(1),o[0],0,0,0), C0,8); \
    KRD(GL,1); GAPB(o[1]=__builtin_amdgcn_mfma_f32_32x32x16_bf16(PAF(1),VFR(5),o[1],0,0,0), C0,12); \
    KRD(GL,2); GAPB(o[0]=__builtin_amdgcn_mfma_f32_32x32x16_bf16(PAF(2),VFR(2),o[0],0,0,0), C1,0); \
    KRD(GL,3); GAPB(o[1]=__builtin_amdgcn_mfma_f32_32x32x16_bf16(PAF(2),VFR(6),o[1],0,0,0), C1,4); \
    GAPB(o[0]=__builtin_amdgcn_mfma_f32_32x32x16_bf16(PAF(3),VFR(3),o[0],0,0,0), C1,8); \
    GAPB(o[1]=__builtin_amdgcn_mfma_f32_32x32x16_bf16(PAF(3),VFR(7),o[1],0,0,0), C1,12); \
    _Pragma("unroll") for(int r_=0;r_<16;++r_){P0[r_]-=mhat;P1[r_]-=mhat;} \
    }while(0)
  { const __attribute__((address_space(3))) f32x4* cbp_=(const __attribute__((address_space(3))) f32x4*)(cb3+256+hi*16);
    #pragma unroll
    for(int a_=0;a_<4;++a_){ const f32x4 u0_=cbp_[2*a_], u1_=cbp_[8+2*a_];
      pB0[4*a_]=u0_[0]-mhat;pB0[4*a_+1]=u0_[1]-mhat;pB0[4*a_+2]=u0_[2]-mhat;pB0[4*a_+3]=u0_[3]-mhat;
      pB1[4*a_]=u1_[0]-mhat;pB1[4*a_+1]=u1_[1]-mhat;pB1[4*a_+2]=u1_[2]-mhat;pB1[4*a_+3]=u1_[3]-mhat; } }
  int t=1;
  #undef CMASK
  #define CMASK(P0,P1,t) do{}while(0)
  for(;t+5<NT;t+=2){
    STEP(pB0,pB1,pA0,pA1,t,true,true,true);     WAIT_BAR(2); RESC(); ROT();
    STEP(pA0,pA1,pB0,pB1,t+1,true,true,true);   WAIT_BAR(2); RESC(); ROT();
  }
  #undef CMASK
  #define CMASK(P0,P1,t) do{int jb_=(t)-(NT-4); if(jb_>=0)cmask(P0,P1,jb_,qrel,hi);}while(0)
  #define ENDW(tt) do{ if((tt)+3<NT){WAIT_BAR(2);} else if((tt)+2<NT){WAIT_BAR(1);} else {WAIT_BAR(0);} }while(0)
  for(;t+1<NT;t+=2){
    STEP(pB0,pB1,pA0,pA1,t,(t+3<NT),(t+1<NT),(t+1<NT));       ENDW(t);   RESC(); ROT();
    STEP(pA0,pA1,pB0,pB1,t+1,(t+4<NT),(t+2<NT),(t+2<NT));     ENDW(t+1); RESC(); ROT();
  }
  STEP(pB0,pB1,pA0,pA1,NT-1,false,false,false); RESC();
  { float sacc=pB0[0]+pB0[1]; _Pragma("unroll") for(int r=2;r<16;++r)sacc+=pB0[r]; _Pragma("unroll") for(int r=0;r<16;++r)sacc+=pB1[r]; l_reg+=sacc;
    pw0=(u32x4){PKW(pB0,0),PKW(pB0,2),PKW(pB0,4),PKW(pB0,6)};pw1=(u32x4){PKW(pB0,8),PKW(pB0,10),PKW(pB0,12),PKW(pB0,14)};pw2=(u32x4){PKW(pB1,0),PKW(pB1,2),PKW(pB1,4),PKW(pB1,6)};pw3=(u32x4){PKW(pB1,8),PKW(pB1,10),PKW(pB1,12),PKW(pB1,14)};
    SBAR(); pv(o,vb0+sl_cur,PAF(0),PAF(1),PAF(2),PAF(3)); }
  #undef PKW
  #undef PAF
  #undef VFR
  #undef PIN
  #undef MX3
  #undef GAPA
  #undef GAPB
  #undef EX
  #undef VRD
  #undef KRD
  #undef STEP
  #undef ENDW
  {auto rr=__builtin_amdgcn_permlane32_swap(__float_as_uint(l_reg),__float_as_uint(l_reg),false,false);l_reg=__uint_as_float(rr[0])+__uint_as_float(rr[1]);}
  if(hi==0)wsf[32+r32]=l_reg;asm volatile("s_waitcnt lgkmcnt(0)":::"memory");
  float rli[16];
  #pragma unroll
  for(int r=0;r<16;++r)rli[r]=__builtin_amdgcn_rcpf(wsf[32+crow(r,hi)]);
  bf16*Ow=O+(rowbase+q0+wid*QBLK)*OPITCH+h*D;
  { bf16*stg=(bf16*)(shm+LDS_OST)+wid*2048;
    #pragma unroll
    for(int r=0;r<16;++r){const int orow=crow(r,hi);
      #pragma unroll
      for(int d0=0;d0<2;++d0)stg[orow*64+d0*32+r32]=__float2bfloat16(o[d0][r]*rli[r]);}
    asm volatile("s_waitcnt lgkmcnt(0)":::"memory");
    #pragma unroll
    for(int i=0;i<4;++i){const int row=i*8+(lane>>3),ch=lane&7; const u32x4 v=*(const u32x4*)(stg+row*64+ch*8); bf16*dst=Ow+(long)row*OPITCH+ch*8; const u32x4 gv=*(const u32x4*)dst; u32x4 w;
      #pragma unroll
      for(int j=0;j<4;++j){ const float a0=__uint_as_float(v[j]<<16)*__uint_as_float(gv[j]<<16), a1=__uint_as_float(v[j]&0xffff0000u)*__uint_as_float(gv[j]&0xffff0000u); w[j]=cvtpk_s(a0,a1); }
      if(!dry)*(u32x4*)dst=w;} }
  asm volatile("s_waitcnt lgkmcnt(0)\n\ts_barrier":::"memory");
  #undef DMA_K
  #undef DMA_V
  #undef CMASK
  #undef START
  #undef RESC
  #undef ROT
}
constexpr int ATTN_LDS_BYTES=LDS_BYTES;
struct AttnTensors { const bf16* Q; const bf16* K; const bf16* V; bf16* O; const float* CB; const float* NRM; };
struct AttnUnit { int bh; int qb; };
struct StaticOrder {
  int vcu;
  __device__ __forceinline__ explicit StaticOrder(int grid,int block):vcu((block%8)*(grid/8)+block/8){}
  __device__ __forceinline__ bool next(int i,AttnUnit&u)const{ if(i>=2)return false; const int s=vcu&7; u.bh=vcu>>3; u.qb=(i==0)?15-s:s; return true; }
  __device__ __forceinline__ void a_ready(const AttnUnit&)const{}
  __device__ __forceinline__ void done(const AttnUnit&)const{}
};
template<class Sched,int THRL=8> __device__ __forceinline__ void attn_phase(char*lds,const AttnTensors&T,const Sched&S,bool dry=false){
  AttnUnit u;
  for(int i=0;S.next(i,u);++i){ S.a_ready(u); attn_unit<THRL>(u.bh/NHEAD,u.bh%NHEAD,u.qb,T.Q,T.K,T.V,T.O,T.CB,T.NRM,lds,dry); S.done(u); }
}
#undef SBAR
#undef WAIT_BAR
}
#include <hip/hip_cooperative_groups.h>
namespace cg = cooperative_groups;
#define LAS __attribute__((address_space(3)))
typedef unsigned short bf16;
typedef float f32x4 __attribute__((ext_vector_type(4)));
typedef float f32x2 __attribute__((ext_vector_type(2)));
typedef unsigned u32x4 __attribute__((ext_vector_type(4)));
typedef unsigned u32x2 __attribute__((ext_vector_type(2)));
typedef short bf16x8 __attribute__((ext_vector_type(8)));
typedef short bf16x4 __attribute__((ext_vector_type(4)));

constexpr int NWAVES = 8, NTHR = 512;
constexpr int BATCH = 4, SEQ = 4096, DM = 1024, DEPTH = 4, M = BATCH * SEQ;
constexpr int NIN = 3592, NF = 3584;
constexpr int T5 = 32, NCH5 = M / T5, KA5 = 640, NG5 = 16;
constexpr float EPS = 1e-6f;
constexpr float LOG2E = 1.4426950408889634f;

constexpr size_t MiB = 1u << 20;
constexpr size_t WS_WIN = 1 * MiB, WS_WO = 31 * MiB, WS_WGLU = 39 * MiB, WS_ROPE = 40 * MiB, WS_MF = 41 * MiB, WS_WB = 81 * MiB;
constexpr size_t WS_LAM = 90 * MiB, WS_LOGF = 90 * MiB + 65536, WS_CB = WS_LOGF + 524288, WS_SS = WS_CB + 524288, WS_NRM = WS_SS + 131072, WS_XBUF = WS_NRM + 4096;
constexpr size_t WS_XN = 92 * MiB, WS_E = WS_XN, WS_UPD = WS_XN + 4 * MiB, WS_STATE = WS_XN + 20 * MiB;
constexpr size_t WS_QO = 124 * MiB, WS_KB = 140 * MiB, WS_VB = 156 * MiB, WS_SUA = 172 * MiB, WS_RQ = 182 * MiB, WS_RK = 190 * MiB, WS_RKT = 198 * MiB, WS_YS5 = WS_XN + 4 * MiB;
constexpr size_t WS_RVT = 206 * MiB, WS_GATE = 214 * MiB, WS_END = 246 * MiB;

constexpr int RING_BYTES = 131072, LDS_BYTES = 147456;

struct Args { const float* in[16]; float* out; unsigned char* ws; };

__device__ __forceinline__ float bf2f(unsigned short b) { return __uint_as_float((unsigned)b << 16); }
__device__ __forceinline__ float bflo(unsigned w) { return __uint_as_float(w << 16); }
__device__ __forceinline__ float bfhi(unsigned w) { return __uint_as_float(w & 0xffff0000u); }
__device__ __forceinline__ unsigned pk2(float lo, float hi) { return pg8::cvt_pk_bf16(lo, hi); }
__device__ __forceinline__ unsigned short f2bf(float f) { return (unsigned short)(pg8::cvt_pk_bf16(f, 0.f) & 0xffffu); }
__device__ __forceinline__ float wave_sum(float v) {
#pragma unroll
    for (int o = 1; o < 64; o <<= 1) v += __shfl_xor(v, o);
    return v;
}
__device__ __forceinline__ float lg2_gamma(int hh) { return __builtin_amdgcn_logf(1.0f - __builtin_amdgcn_exp2f(-5.0f - (float)hh)); }

__device__ __forceinline__ int win_col(int n) {
    if (n < 1536) return n;
    if (n < 1792) return n + 8;
    if (n < 2304) { const bool q = n < 2048; const int base = q ? 1792 : 2048; const int hh = (n - base) >> 6, pos = (n - base) & 63; const int d = (pos & 1) ? 32 + (pos >> 1) : (pos >> 1); return (q ? 1800 : 2056) + hh * 64 + d; }
    return n + 8;
}
template <bool MAP> __device__ __forceinline__ void p0_transpose_item(const float* W, int K, int Nsrc, int Ndst, bf16* WT, LAS float* scr, int item, int lane) {
    const int nblk = Ndst / 32, kb = item / nblk, nb = item % nblk, k0 = 64 * kb, n0 = 32 * nb;
    const int sc = MAP ? win_col(n0 + (lane & 31)) : n0 + (lane & 31);
    float wv[32];
#pragma unroll
    for (int i = 0; i < 32; ++i) { const int kk = 2 * i + (lane >> 5); wv[i] = (MAP && sc < 0) ? 0.f : W[(size_t)(k0 + kk) * Nsrc + (sc < 0 ? 0 : sc)]; }
#pragma unroll
    for (int i = 0; i < 32; ++i) { const int kk = 2 * i + (lane >> 5); scr[kk * 33 + (lane & 31)] = wv[i]; }
    asm volatile("s_waitcnt lgkmcnt(0)" ::: "memory");
    const int c = lane & 7;
#pragma unroll
    for (int j = 0; j < 4; ++j) { const int n = (lane >> 3) + 8 * j; const LAS float* s = scr + (8 * c) * 33 + n;
        u32x4 o; o.x = pk2(s[0 * 33], s[1 * 33]); o.y = pk2(s[2 * 33], s[3 * 33]); o.z = pk2(s[4 * 33], s[5 * 33]); o.w = pk2(s[6 * 33], s[7 * 33]);
        *(u32x4*)(WT + (size_t)(n0 + n) * K + k0 + 8 * c) = o; }
    asm volatile("s_waitcnt lgkmcnt(0)" ::: "memory");
}

__device__ __forceinline__ void s5_prep(const Args& a, int l, int g, LAS float* L, int tid) {
    LAS float* LPr = L;
    LAS float* LPi = L + 33 * 64;
    LAS float* Bbr = L + 66 * 64;
    LAS float* Bbi = Bbr + 1024;
    LAS float* Cr = Bbi + 1024;
    LAS float* Ci = Cr + 1024;
    LAS float* KT = Ci + 1024;
    const float* a_re = a.in[4] + (size_t)(l * 16 + g) * 64; const float* a_im = a.in[5] + (size_t)(l * 16 + g) * 64;
    const float* b_re = a.in[6] + (size_t)(l * 16 + g) * 1024; const float* b_im = a.in[7] + (size_t)(l * 16 + g) * 1024;
    const float* c_re = a.in[8] + (size_t)(l * 16 + g) * 1024; const float* c_im = a.in[9] + (size_t)(l * 16 + g) * 1024;
    const float log_dt = a.in[11][l * 16 + g];
    bf16* MF = (bf16*)(a.ws + WS_MF) + (size_t)(l * 16 + g) * 512 * KA5;
    bf16* WB = (bf16*)(a.ws + WS_WB) + (size_t)(l * 16 + g) * 128 * 512;
    float* LAM = (float*)(a.ws + WS_LAM) + (size_t)(l * 16 + g) * 128;
    if (tid < 64) {
        const int p = tid;
        const double dt = exp((double)log_dt), ar = (double)a_re[p], ai = (double)a_im[p];
        const double mag = exp(ar * dt); double sn, cs; sincos(ai * dt, &sn, &cs);
        const double lr = mag * cs, li = mag * sn, den = ar * ar + ai * ai;
        const double fr = ((lr - 1.0) * ar + li * ai) / den, fi = (li * ar - (lr - 1.0) * ai) / den;
#pragma unroll 4
        for (int h = 0; h < 16; ++h) { const double br = (double)b_re[p * 16 + h], bi = (double)b_im[p * 16 + h]; Bbr[p * 16 + h] = (float)(fr * br - fi * bi); Bbi[p * 16 + h] = (float)(fr * bi + fi * br); }
        double pr = 1.0, pi = 0.0;
        for (int j = 0; j <= 32; ++j) { LPr[j * 64 + p] = (float)pr; LPi[j * 64 + p] = (float)pi; const double nr = pr * lr - pi * li, ni = pr * li + pi * lr; pr = nr; pi = ni; }
        LAM[p] = LPr[32 * 64 + p]; LAM[64 + p] = LPi[32 * 64 + p];
    }
    for (int i = tid; i < 1024; i += NTHR) { const int h = i >> 6, p = i & 63; Cr[p * 16 + h] = c_re[i]; Ci[p * 16 + h] = c_im[i]; }
    __syncthreads();
    { const int j = tid >> 4, h = tid & 15; float acc[16];
#pragma unroll
      for (int e = 0; e < 16; ++e) acc[e] = 0.f;
      for (int p = 0; p < 64; ++p) { const float cr = Cr[p * 16 + h], ci = Ci[p * 16 + h], lr = LPr[j * 64 + p], li = LPi[j * 64 + p]; const float clr = cr * lr - ci * li, cli = cr * li + ci * lr;
#pragma unroll
          for (int q = 0; q < 4; ++q) { const f32x4 br = *(const LAS f32x4*)(Bbr + p * 16 + 4 * q), bi = *(const LAS f32x4*)(Bbi + p * 16 + 4 * q);
              acc[4 * q] += clr * br.x - cli * bi.x; acc[4 * q + 1] += clr * br.y - cli * bi.y; acc[4 * q + 2] += clr * br.z - cli * bi.z; acc[4 * q + 3] += clr * br.w - cli * bi.w; } }
#pragma unroll
      for (int e = 0; e < 16; ++e) KT[tid * 16 + e] = acc[e]; }
    __syncthreads();
    for (int q = tid; q < 512 * 64; q += NTHR) {
        const int row = q >> 6, cp = q & 63, s = cp >> 1, h0 = (cp & 1) * 8, t = row >> 4, h = row & 15;
        u32x4 o = (u32x4){0u, 0u, 0u, 0u};
        if (s <= t) { const LAS float* k = KT + ((t - s) * 16 + h) * 16 + h0; o.x = pk2(k[0], k[1]); o.y = pk2(k[2], k[3]); o.z = pk2(k[4], k[5]); o.w = pk2(k[6], k[7]); }
        *(u32x4*)(MF + (size_t)row * KA5 + cp * 8) = o;
    }
    for (int q = tid; q < 512 * 16; q += NTHR) {
        const int row = q >> 4, cp = q & 15, t = row >> 4, h = row & 15; float v[8];
#pragma unroll
        for (int e = 0; e < 8; ++e) { const int jj = cp * 8 + e, p = jj & 63; const float cr = Cr[p * 16 + h], ci = Ci[p * 16 + h], lr = LPr[(t + 1) * 64 + p], li = LPi[(t + 1) * 64 + p];
            v[e] = (jj < 64) ? (cr * lr - ci * li) : -(cr * li + ci * lr); }
        u32x4 o; o.x = pk2(v[0], v[1]); o.y = pk2(v[2], v[3]); o.z = pk2(v[4], v[5]); o.w = pk2(v[6], v[7]);
        *(u32x4*)(MF + (size_t)row * KA5 + 512 + cp * 8) = o;
    }
    for (int q = tid; q < 128 * 64; q += NTHR) {
        const int j = q >> 6, cp = q & 63, s = cp >> 1, h0 = (cp & 1) * 8, p = j & 63; const float lr = LPr[(31 - s) * 64 + p], li = LPi[(31 - s) * 64 + p]; float v[8];
#pragma unroll
        for (int e = 0; e < 8; ++e) { const float br = Bbr[p * 16 + h0 + e], bi = Bbi[p * 16 + h0 + e]; v[e] = (j < 64) ? (lr * br - li * bi) : (lr * bi + li * br); }
        u32x4 o; o.x = pk2(v[0], v[1]); o.y = pk2(v[2], v[3]); o.z = pk2(v[4], v[5]); o.w = pk2(v[6], v[7]);
        *(u32x4*)(WB + (size_t)j * 512 + cp * 8) = o;
    }
    __syncthreads();
}

__device__ __forceinline__ void norm0_phase(const Args& a, int lane, int gw, int NGW) {
    const float* X = a.in[0]; f32x4 gv[4];
#pragma unroll
    for (int j = 0; j < 4; ++j) gv[j] = *((const f32x4*)a.in[1] + lane + 64 * j);
    bf16* XN = (bf16*)(a.ws + WS_XN); float* SS = (float*)(a.ws + WS_SS);
    for (int m = gw; m < M; m += 2 * NGW) {
        const int m2 = m + NGW; const bool has2 = m2 < M;
        const f32x4* xr = (const f32x4*)(X + (size_t)m * DM) + lane; const f32x4* xr2 = (const f32x4*)(X + (size_t)(has2 ? m2 : m) * DM) + lane; f32x4 v[4], w[4];
#pragma unroll
        for (int j = 0; j < 4; ++j) { v[j] = xr[64 * j]; w[j] = xr2[64 * j]; }
        float ss = 0.f, ss2 = 0.f;
#pragma unroll
        for (int j = 0; j < 4; ++j) { ss += (v[j].x * v[j].x + v[j].y * v[j].y) + (v[j].z * v[j].z + v[j].w * v[j].w); ss2 += (w[j].x * w[j].x + w[j].y * w[j].y) + (w[j].z * w[j].z + w[j].w * w[j].w); }
        ss = wave_sum(ss); ss2 = wave_sum(ss2);
        unsigned long long* o8 = (unsigned long long*)(XN + (size_t)m * DM) + lane; unsigned long long* o82 = (unsigned long long*)(XN + (size_t)m2 * DM) + lane;
        const float r1_ = rsqrtf(ss * (1.f / DM) + EPS), r2_ = rsqrtf(ss2 * (1.f / DM) + EPS);
#pragma unroll
        for (int j = 0; j < 4; ++j) { v[j] = v[j] * gv[j] * r1_; o8[64 * j] = (unsigned long long)pk2(v[j].x, v[j].y) | ((unsigned long long)pk2(v[j].z, v[j].w) << 32);
            if (has2) { w[j] = w[j] * gv[j] * r2_; o82[64 * j] = (unsigned long long)pk2(w[j].x, w[j].y) | ((unsigned long long)pk2(w[j].z, w[j].w) << 32); } }
        if (lane == 0) { SS[m] = ss; if (has2) SS[m2] = ss2; }
    }
}
__device__ __forceinline__ void final_norm(const Args& a, float* X, const float* SS, int lane, int gw, int NGW) {
    f32x4 gv[4];
#pragma unroll
    for (int j = 0; j < 4; ++j) gv[j] = *((const f32x4*)a.in[15] + lane + 64 * j);
    for (int m = gw; m < M; m += 2 * NGW) {
        const int m2 = m + NGW; const bool has2 = m2 < M;
        f32x4* xr = (f32x4*)(X + (size_t)m * DM) + lane; f32x4* xr2 = (f32x4*)(X + (size_t)(has2 ? m2 : m) * DM) + lane; f32x4 v[4], w[4];
#pragma unroll
        for (int j = 0; j < 4; ++j) { v[j] = xr[64 * j]; w[j] = xr2[64 * j]; }
        const float r1 = rsqrtf(SS[m] * (1.f / DM) + EPS), r2 = rsqrtf(SS[has2 ? m2 : m] * (1.f / DM) + EPS);
#pragma unroll
        for (int j = 0; j < 4; ++j) { xr[64 * j] = v[j] * r1 * gv[j]; if (has2) xr2[64 * j] = w[j] * r2 * gv[j]; }
    }
}

__device__ __forceinline__ void flog_phase(const Args& a, int l, const float* SS, LAS float* WF, int tid, int lane, int wave, int blk, int nblk) {
    const float* win = a.in[2] + (size_t)l * DM * NIN;
    for (int i = tid; i < 2048; i += NTHR) { const int k = i >> 1, hf = i & 1; *(LAS f32x4*)(WF + k * 8 + hf * 4) = *(const f32x4*)(win + (size_t)k * NIN + 1536 + hf * 4); }
    __syncthreads();
    const bf16* XN = (const bf16*)(a.ws + WS_XN); float* LOGF = (float*)(a.ws + WS_LOGF);
    const float bfj = (lane < 8) ? a.in[3][l * 8 + lane] : 0.f;
    const int rows_per = M / nblk;
    for (int i = wave; i < rows_per; i += 2 * NWAVES) {
        const int m = blk * rows_per + i, m2 = m + NWAVES; const bool has2 = (i + NWAVES) < rows_per;
        const u32x4 x0 = *((const u32x4*)(XN + (size_t)m * DM) + lane), x1 = *((const u32x4*)(XN + (size_t)m * DM + 512) + lane);
        const u32x4 y0 = *((const u32x4*)(XN + (size_t)(has2 ? m2 : m) * DM) + lane), y1 = *((const u32x4*)(XN + (size_t)(has2 ? m2 : m) * DM + 512) + lane);
        float acc[8], acc2[8];
#pragma unroll
        for (int e = 0; e < 8; ++e) { acc[e] = 0.f; acc2[e] = 0.f; }
#pragma unroll
        for (int hf = 0; hf < 2; ++hf)
#pragma unroll
            for (int q = 0; q < 8; ++q) { const int k = 512 * hf + 8 * lane + q; const f32x4 w0 = *(const LAS f32x4*)(WF + k * 8), w1 = *(const LAS f32x4*)(WF + k * 8 + 4);
                const unsigned xw = hf ? x1[q >> 1] : x0[q >> 1], yw = hf ? y1[q >> 1] : y0[q >> 1]; const float hv = (q & 1) ? bfhi(xw) : bflo(xw), hv2 = (q & 1) ? bfhi(yw) : bflo(yw);
                acc[0] += hv * w0.x; acc[1] += hv * w0.y; acc[2] += hv * w0.z; acc[3] += hv * w0.w; acc[4] += hv * w1.x; acc[5] += hv * w1.y; acc[6] += hv * w1.z; acc[7] += hv * w1.w;
                acc2[0] += hv2 * w0.x; acc2[1] += hv2 * w0.y; acc2[2] += hv2 * w0.z; acc2[3] += hv2 * w0.w; acc2[4] += hv2 * w1.x; acc2[5] += hv2 * w1.y; acc2[6] += hv2 * w1.z; acc2[7] += hv2 * w1.w; }
        float mine = 0.f, mine2 = 0.f;
#pragma unroll
        for (int e = 0; e < 8; ++e) { const float s = wave_sum(acc[e]), s2 = wave_sum(acc2[e]); if (lane == e) { mine = s; mine2 = s2; } }
        if (lane < 8) { const float z = mine + bfj; LOGF[(size_t)((m >> 12) * 8 + lane) * SEQ + (m & 4095)] = fminf(z, 0.f) - log1pf(expf(-fabsf(z)));
            if (has2) { const float z2 = mine2 + bfj; LOGF[(size_t)((m2 >> 12) * 8 + lane) * SEQ + (m2 & 4095)] = fminf(z2, 0.f) - log1pf(expf(-fabsf(z2))); } }
    }
}

__device__ __forceinline__ bool opaque_true() { int d = 1; asm volatile("" : "+s"(d)); return d != 0; }
struct RangeOrder {
    pg8::StaticOrder S; int lo, hi;
    __device__ bool next(int i, pg8::Unit& u) const { return (lo + i < hi) ? S.next(lo + i, u) : false; }
    __device__ __forceinline__ void a_ready(const pg8::Unit&) const {}
    __device__ __forceinline__ void done(const pg8::Unit&) const {}
};
struct FlatOrder {
    int nM, nN, nG, G, c;
    __device__ bool next(int i, pg8::Unit& u) const { const int L = i * G + c; if (L >= nG * nM * nN) return false; u.gz = L / (nM * nN); const int r = L % (nM * nN); u.pm = r % nM; u.pn = r / nM; return true; }
    __device__ __forceinline__ void a_ready(const pg8::Unit&) const {}
    __device__ __forceinline__ void done(const pg8::Unit&) const {}
};
__device__ __forceinline__ float silu_f(float v) { return v * __builtin_amdgcn_rcpf(1.f + __expf(-v)); }
__device__ __forceinline__ float gelu_tanh(float v) { const float u = 0.7978845608028654f * (v + 0.044715f * v * v * v); const float e = __expf(2.f * u); const float th = 1.f - 2.f * __builtin_amdgcn_rcpf(e + 1.f); return 0.5f * v * (1.f + th); }

struct EpiInProj {
    static constexpr bool PERM = true, AFTER_DRAIN = false;
    unsigned char* ws; const float* SS; const float* bfl;
    __device__ __forceinline__ void operator()(const pg8::f32x4 (&acc)[2][2][4][2], const pg8::Unit& u, int wr, int wc, int fr, int fq) const {
        const int pn = u.pn; const int row0 = u.pm * 256 + wr * 64 + fr, cl0 = wc * 32 + 8 * fq;
        float rs[2][4];
#pragma unroll
        for (int ai = 0; ai < 2; ++ai)
#pragma unroll
            for (int m = 0; m < 4; ++m) rs[ai][m] = 1.f;
        if (pn == 14) {
            if (wc == 0 && fq == 0) { float* LOGF = (float*)(ws + WS_LOGF); const f32x4 b0 = *(const f32x4*)bfl, b1 = *(const f32x4*)(bfl + 4);
#pragma unroll
                for (int ai = 0; ai < 2; ++ai)
#pragma unroll
                    for (int m = 0; m < 4; ++m) { const int row = row0 + ai * 128 + m * 16; const float r = rs[ai][m]; const pg8::f32x4 v0 = acc[ai][0][m][0], v1 = acc[ai][0][m][1];
                        float z[8] = {v0[0] * r + b0.x, v0[1] * r + b0.y, v0[2] * r + b0.z, v0[3] * r + b0.w, v1[0] * r + b1.x, v1[1] * r + b1.y, v1[2] * r + b1.z, v1[3] * r + b1.w};
#pragma unroll
                        for (int e = 0; e < 8; ++e) LOGF[(size_t)((row >> 12) * 8 + e) * SEQ + (row & 4095)] = fminf(z[e], 0.f) - log1pf(__expf(-fabsf(z[e]))); } }
            return;
        }
        if (pn < 6) {
            bf16* base = (bf16*)(ws + (pn < 2 ? WS_QO : pn < 4 ? WS_KB : WS_VB)); const float sc = pn < 2 ? 0.125f * LOG2E : 1.f; const int cb = (pn & 1) * 256 + cl0;
#pragma unroll
            for (int ai = 0; ai < 2; ++ai)
#pragma unroll
                for (int m = 0; m < 4; ++m) { bf16* rp = base + (size_t)(row0 + ai * 128 + m * 16) * 512 + cb;
#pragma unroll
                    for (int bj = 0; bj < 2; ++bj) { const float sr = sc * rs[ai][m]; const pg8::f32x4 v0 = acc[ai][bj][m][0] * sr, v1 = acc[ai][bj][m][1] * sr; u32x4 w; w.x = pk2(v0[0], v0[1]); w.y = pk2(v0[2], v0[3]); w.z = pk2(v1[0], v1[1]); w.w = pk2(v1[2], v1[3]); *(u32x4*)(rp + bj * 128) = w; } }
        } else if (pn == 6) {
            bf16* base = (bf16*)(ws + WS_SUA);
#pragma unroll
            for (int ai = 0; ai < 2; ++ai)
#pragma unroll
                for (int m = 0; m < 4; ++m) { const int row = row0 + ai * 128 + m * 16, chunk = row >> 5, t = row & 31;
#pragma unroll
                    for (int bj = 0; bj < 2; ++bj) { const int c = cl0 + bj * 128, g = c >> 4, h0 = c & 15; const pg8::f32x4 v0 = acc[ai][bj][m][0] * rs[ai][m], v1 = acc[ai][bj][m][1] * rs[ai][m]; u32x4 w; w.x = pk2(v0[0], v0[1]); w.y = pk2(v0[2], v0[3]); w.z = pk2(v1[0], v1[1]); w.w = pk2(v1[2], v1[3]);
                        *(u32x4*)(base + ((size_t)(g * 512 + chunk) * KA5 + t * 16 + h0)) = w; } }
        } else if (pn == 7 || pn == 8) {
            const f32x4* rope = (const f32x4*)(ws + WS_ROPE); bf16* base = (bf16*)(ws + (pn == 7 ? WS_RQ : WS_RK)); bf16* RKT = (bf16*)(ws + WS_RKT);
#pragma unroll
            for (int ai = 0; ai < 2; ++ai)
#pragma unroll
                for (int m = 0; m < 4; ++m) { const int row = row0 + ai * 128 + m * 16, b = row >> 12, t = row & 4095;
#pragma unroll
                    for (int bj = 0; bj < 2; ++bj) { const int c = cl0 + bj * 128, hh = c >> 6, pos0 = c & 63; const pg8::f32x4 v0 = acc[ai][bj][m][0] * rs[ai][m], v1 = acc[ai][bj][m][1] * rs[ai][m];
                        const f32x4 r0 = rope[(t * 32 + (pos0 >> 1)) >> 1], r1 = rope[((t * 32 + (pos0 >> 1)) >> 1) + 1];
                        float o[8];
                        o[0] = v0[0] * r0.x - v0[1] * r0.y; o[1] = v0[0] * r0.y + v0[1] * r0.x; o[2] = v0[2] * r0.z - v0[3] * r0.w; o[3] = v0[2] * r0.w + v0[3] * r0.z;
                        o[4] = v1[0] * r1.x - v1[1] * r1.y; o[5] = v1[0] * r1.y + v1[1] * r1.x; o[6] = v1[2] * r1.z - v1[3] * r1.w; o[7] = v1[2] * r1.w + v1[3] * r1.z;
                        u32x4 w; w.x = pk2(o[0], o[1]); w.y = pk2(o[2], o[3]); w.z = pk2(o[4], o[5]); w.w = pk2(o[6], o[7]);
                        *(u32x4*)(base + (size_t)row * 256 + c) = w;
                        if (pn == 8) { const float wk = __builtin_amdgcn_exp2f(lg2_gamma(hh) * (float)(63 - (t & 63))); bf16* tp = RKT + ((size_t)((b * 4 + hh) * 64 + pos0)) * SEQ + t;
#pragma unroll
                            for (int e = 0; e < 8; ++e) tp[(size_t)e * SEQ] = f2bf(o[e] * wk); } } }
        } else if (pn == 9) {
            bf16* RVT = (bf16*)(ws + WS_RVT);
#pragma unroll
            for (int ai = 0; ai < 2; ++ai)
#pragma unroll
                for (int m = 0; m < 4; ++m) { const int row = row0 + ai * 128 + m * 16, b = row >> 12, t = row & 4095;
#pragma unroll
                    for (int bj = 0; bj < 2; ++bj) { const int c = cl0 + bj * 128, hh = c >> 6, d0 = c & 63; const pg8::f32x4 v0 = acc[ai][bj][m][0] * rs[ai][m], v1 = acc[ai][bj][m][1] * rs[ai][m]; bf16* tp = RVT + ((size_t)((b * 4 + hh) * 64 + d0)) * SEQ + t;
#pragma unroll
                        for (int e = 0; e < 4; ++e) { tp[(size_t)e * SEQ] = f2bf(v0[e]); tp[(size_t)(4 + e) * SEQ] = f2bf(v1[e]); } } }
        } else {
            bf16* base = (bf16*)(ws + WS_GATE); const int cb = (pn - 10) * 256 + cl0;
#pragma unroll
            for (int ai = 0; ai < 2; ++ai)
#pragma unroll
                for (int m = 0; m < 4; ++m) { bf16* rp = base + (size_t)(row0 + ai * 128 + m * 16) * 1024 + cb;
#pragma unroll
                    for (int bj = 0; bj < 2; ++bj) { const pg8::f32x4 v0 = acc[ai][bj][m][0] * rs[ai][m], v1 = acc[ai][bj][m][1] * rs[ai][m]; u32x4 w; w.x = pk2(silu_f(v0[0]), silu_f(v0[1])); w.y = pk2(silu_f(v0[2]), silu_f(v0[3])); w.z = pk2(silu_f(v1[0]), silu_f(v1[1])); w.w = pk2(silu_f(v1[2]), silu_f(v1[3])); *(u32x4*)(rp + bj * 128) = w; } }
        }
    }
};
struct EpiS5E {
    static constexpr bool PERM = false, AFTER_DRAIN = false;
    float* E;
    __device__ __forceinline__ void operator()(const pg8::f32x4 (&acc)[2][2][4][2], const pg8::Unit& u, int wr, int wc, int fr, int fq) const {
        const int row0 = u.pm * 256 + wr * 64 + fr, col0 = wc * 32 + 4 * fq;
#pragma unroll
        for (int ai = 0; ai < 2; ++ai)
#pragma unroll
            for (int m = 0; m < 4; ++m) { float* rp = E + ((size_t)u.gz * NCH5 + row0 + ai * 128 + m * 16) * 128 + col0;
#pragma unroll
                for (int n = 0; n < 2; ++n) *(pg8::f32x4*)(rp + n * 16) = acc[ai][0][m][n]; }
    }
};
struct EpiS5Y {
    static constexpr bool PERM = true, AFTER_DRAIN = false;
    const bf16* SUA; bf16* YS5; const float* dvec;
    __device__ __forceinline__ void operator()(const pg8::f32x4 (&acc)[2][2][4][2], const pg8::Unit& u, int wr, int wc, int fr, int fq) const {
        const int row0 = u.pm * 256 + wr * 64 + fr, cl0 = u.pn * 256 + wc * 32 + 8 * fq; const int g = u.gz;
#pragma unroll
        for (int bj = 0; bj < 2; ++bj) { const int c = cl0 + bj * 128, tt = c >> 4, h0 = c & 15; const f32x4 d0 = *(const f32x4*)(dvec + g * 16 + h0), d1 = *(const f32x4*)(dvec + g * 16 + h0 + 4);
#pragma unroll
            for (int ai = 0; ai < 2; ++ai)
#pragma unroll
                for (int m = 0; m < 4; ++m) { const int chunk = row0 + ai * 128 + m * 16; const u32x4 uu = *(const u32x4*)(SUA + ((size_t)(g * 512 + chunk) * KA5 + c)); const pg8::f32x4 v0 = acc[ai][bj][m][0], v1 = acc[ai][bj][m][1];
                    float y[8]; y[0] = v0[0] + d0.x * bflo(uu.x); y[1] = v0[1] + d0.y * bfhi(uu.x); y[2] = v0[2] + d0.z * bflo(uu.y); y[3] = v0[3] + d0.w * bfhi(uu.y);
                    y[4] = v1[0] + d1.x * bflo(uu.z); y[5] = v1[1] + d1.y * bfhi(uu.z); y[6] = v1[2] + d1.z * bflo(uu.w); y[7] = v1[3] + d1.w * bfhi(uu.w);
#pragma unroll
                    for (int e = 0; e < 8; ++e) y[e] = gelu_tanh(y[e]);
                    u32x4 w; w.x = pk2(y[0], y[1]); w.y = pk2(y[2], y[3]); w.z = pk2(y[4], y[5]); w.w = pk2(y[6], y[7]);
                    *(u32x4*)(YS5 + (size_t)(chunk * 32 + tt) * 256 + g * 16 + h0) = w; } }
    }
};
struct EpiGlu {
    static constexpr bool PERM = true, AFTER_DRAIN = false;
    const bf16* YS5; bf16* G; bool dry;
    __device__ __forceinline__ void operator()(const pg8::f32x4 (&acc)[2][2][4][2], const pg8::Unit& u, int wr, int wc, int fr, int fq) const {
        const int row0 = u.pm * 256 + wr * 64 + fr, cl0 = wc * 32 + 8 * fq;
#pragma unroll
        for (int ai = 0; ai < 2; ++ai)
#pragma unroll
            for (int m = 0; m < 4; ++m) { const int row = row0 + ai * 128 + m * 16;
#pragma unroll
                for (int bj = 0; bj < 2; ++bj) { const int c = cl0 + bj * 128; const u32x4 yy = *(const u32x4*)(YS5 + (size_t)row * 256 + c); bf16* gp = G + (size_t)row * 1024 + 512 + c; const u32x4 gg = *(const u32x4*)gp;
                    const pg8::f32x4 v0 = acc[ai][bj][m][0], v1 = acc[ai][bj][m][1]; float s[8];
#pragma unroll
                    for (int e = 0; e < 4; ++e) { s[e] = 1.f / (1.f + __expf(-v0[e])); s[4 + e] = 1.f / (1.f + __expf(-v1[e])); }
                    u32x4 w; w.x = pk2(bflo(yy.x) * s[0] * bflo(gg.x), bfhi(yy.x) * s[1] * bfhi(gg.x)); w.y = pk2(bflo(yy.y) * s[2] * bflo(gg.y), bfhi(yy.y) * s[3] * bfhi(gg.y));
                    w.z = pk2(bflo(yy.z) * s[4] * bflo(gg.z), bfhi(yy.z) * s[5] * bfhi(gg.z)); w.w = pk2(bflo(yy.w) * s[6] * bflo(gg.w), bfhi(yy.w) * s[7] * bfhi(gg.w));
                    if (!dry) *(u32x4*)gp = w; } }
    }
};
struct EpiOut {
    static constexpr bool PERM = false, AFTER_DRAIN = false;
    const float* base; float* out; float* SSn; bf16* XN; const float* gnext; bool dry;
    __device__ __forceinline__ void operator()(const pg8::f32x4 (&acc)[2][2][4][2], const pg8::Unit& u, int wr, int wc, int fr, int fq) const {
        const int row0 = u.pm * 256 + wr * 64 + fr, col0 = u.pn * 256 + wc * 32 + 4 * fq;
        f32x4 gq[2][2];
#pragma unroll
        for (int bj = 0; bj < 2; ++bj)
#pragma unroll
            for (int n = 0; n < 2; ++n) gq[bj][n] = gnext ? *(const f32x4*)(gnext + col0 + bj * 128 + n * 16) : (f32x4){0.f, 0.f, 0.f, 0.f};
#pragma unroll
        for (int ai = 0; ai < 2; ++ai)
#pragma unroll
            for (int m = 0; m < 4; ++m) { const int row = row0 + ai * 128 + m * 16; const size_t off = (size_t)row * DM + col0; float sq = 0.f;
#pragma unroll
                for (int bj = 0; bj < 2; ++bj)
#pragma unroll
                    for (int n = 0; n < 2; ++n) { const f32x4 bs = *(const f32x4*)(base + off + bj * 128 + n * 16); const pg8::f32x4 v = acc[ai][bj][m][n]; const f32x4 x = (f32x4){bs.x + v[0], bs.y + v[1], bs.z + v[2], bs.w + v[3]};
                        sq += (x.x * x.x + x.y * x.y) + (x.z * x.z + x.w * x.w);
                        if (!dry) { *(f32x4*)(out + off + bj * 128 + n * 16) = x;
                            if (gnext) { const f32x4 g = gq[bj][n]; u32x2 w; w.x = pk2(x.x * g.x, x.y * g.y); w.y = pk2(x.z * g.z, x.w * g.w); *(u32x2*)(XN + off + bj * 128 + n * 16) = w; } } }
                sq += __shfl_xor(sq, 16); sq += __shfl_xor(sq, 32);
                if (fq == 0 && !dry) __hip_atomic_fetch_add(SSn + row, sq, __ATOMIC_RELAXED, __HIP_MEMORY_SCOPE_AGENT); }
    }
};

template <bool FINAL> struct EpiOutX {
    static constexpr bool PERM = false, AFTER_DRAIN = true;
    const float* base; float* out; const float* wfin; float* xbuf; unsigned* cnt; bf16* XN; unsigned target;
    __device__ __forceinline__ void fused(pg8::f32x4 (&acc)[2][2][4][2], const pg8::Unit& u, int wr, int wc, int fr, int fq, PG8_LAS unsigned char* lds, int wid, int lane) const {
        PG8_LAS float* P = (PG8_LAS float*)lds;
        PG8_LAS float* S = (PG8_LAS float*)(lds + 4096);
        const int col0 = u.pn * 256 + wc * 32 + 4 * fq;
#pragma unroll
        for (int ai = 0; ai < 2; ++ai)
#pragma unroll
            for (int m = 0; m < 4; ++m) { const int r = ai * 128 + wr * 64 + m * 16 + fr; const size_t off = (size_t)(u.pm * 256 + r) * DM + col0; float sq = 0.f;
#pragma unroll
                for (int bj = 0; bj < 2; ++bj)
#pragma unroll
                    for (int n = 0; n < 2; ++n) { const f32x4 bs = *(const f32x4*)(base + off + bj * 128 + n * 16); pg8::f32x4 x = acc[ai][bj][m][n]; x[0] += bs.x; x[1] += bs.y; x[2] += bs.z; x[3] += bs.w; acc[ai][bj][m][n] = x;
                        sq += (x[0] * x[0] + x[1] * x[1]) + (x[2] * x[2] + x[3] * x[3]); }
                sq += __shfl_xor(sq, 16); sq += __shfl_xor(sq, 32);
                if (fq == 0) P[r * 4 + wc] = sq;
                asm volatile("" : "+v"(acc[ai][0][m][0]), "+v"(acc[ai][0][m][1]), "+v"(acc[ai][1][m][0]), "+v"(acc[ai][1][m][1]));
                if (m & 1) asm volatile("" ::: "memory"); }
        asm volatile("s_waitcnt lgkmcnt(0)" ::: "memory"); __builtin_amdgcn_s_barrier(); asm volatile("" ::: "memory");
        const int row = wid * 32 + (lane & 31);
        if (lane < 32) { const float tot = (P[row * 4 + 0] + P[row * 4 + 1]) + (P[row * 4 + 2] + P[row * 4 + 3]);
            __hip_atomic_store(xbuf + (size_t)(u.pm * 256 + row) * 4 + u.pn, tot, __ATOMIC_RELAXED, __HIP_MEMORY_SCOPE_AGENT); }
        asm volatile("s_waitcnt vmcnt(0)" ::: "memory");
        if (lane == 0) __hip_atomic_fetch_add(cnt + 64 * u.pm, 1u, __ATOMIC_RELAXED, __HIP_MEMORY_SCOPE_AGENT);
        if (wid == 0) {
            unsigned sp = 0u;
            while ((unsigned)__builtin_amdgcn_readfirstlane(__hip_atomic_load(cnt + 64 * u.pm, __ATOMIC_RELAXED, __HIP_MEMORY_SCOPE_AGENT)) < target) { __builtin_amdgcn_s_sleep(2); if (++sp > (1u << 20)) break; }
            __builtin_amdgcn_fence(__ATOMIC_ACQUIRE, "agent");
        }
        asm volatile("s_waitcnt vmcnt(0) lgkmcnt(0)" ::: "memory"); __builtin_amdgcn_s_barrier(); asm volatile("" ::: "memory");
        if (lane < 32) { const float* sl = xbuf + (size_t)(u.pm * 256 + row) * 4; float t = 0.f;
#pragma unroll
            for (int k = 0; k < 4; ++k) t += __hip_atomic_load(sl + k, __ATOMIC_RELAXED, __HIP_MEMORY_SCOPE_AGENT);
            S[row] = rsqrtf(t * (1.f / DM) + EPS); }
        asm volatile("s_waitcnt lgkmcnt(0)" ::: "memory"); __builtin_amdgcn_s_barrier(); asm volatile("" ::: "memory");
        f32x4 wq[2][2];
#pragma unroll
        for (int bj = 0; bj < 2; ++bj)
#pragma unroll
            for (int n = 0; n < 2; ++n) wq[bj][n] = *(const f32x4*)(wfin + col0 + bj * 128 + n * 16);
#pragma unroll
        for (int ai = 0; ai < 2; ++ai)
#pragma unroll
            for (int m = 0; m < 4; ++m) { const int r = ai * 128 + wr * 64 + m * 16 + fr; const float sr = S[r]; const size_t off = (size_t)(u.pm * 256 + r) * DM + col0;
#pragma unroll
                for (int bj = 0; bj < 2; ++bj)
#pragma unroll
                    for (int n = 0; n < 2; ++n) { const pg8::f32x4 x = acc[ai][bj][m][n]; const f32x4 g = wq[bj][n]; const f32x4 y = (f32x4){x[0] * sr * g.x, x[1] * sr * g.y, x[2] * sr * g.z, x[3] * sr * g.w};
                        if (FINAL) *(f32x4*)(out + off + bj * 128 + n * 16) = y;
                        else { *(f32x4*)(out + off + bj * 128 + n * 16) = (f32x4){x[0], x[1], x[2], x[3]}; u32x2 w; w.x = pk2(y.x, y.y); w.y = pk2(y.z, y.w); *(u32x2*)(XN + off + bj * 128 + n * 16) = w; } } }
    }
};

template <int KS, int UNR, class Epi> __device__ __forceinline__ void wave_gemm64(const bf16* A, int lda, const bf16* B, int ldb, int lane, const Epi& epi) {
    const int fr = lane & 15, fq = lane >> 4;
    pg8::f32x4 acc[4][4];
#pragma unroll
    for (int jb = 0; jb < 4; ++jb)
#pragma unroll
        for (int ib = 0; ib < 4; ++ib) acc[jb][ib] = (pg8::f32x4){0.f, 0.f, 0.f, 0.f};
    const bf16* ap = A + (size_t)fr * lda + 8 * fq; const bf16* bp = B + (size_t)fr * ldb + 8 * fq;
#pragma unroll UNR
    for (int ks = 0; ks < KS; ++ks) {
        bf16x8 af[4], bv[4];
#pragma unroll
        for (int ib = 0; ib < 4; ++ib) { af[ib] = *(const bf16x8*)(ap + (size_t)(16 * ib) * lda + 32 * ks); bv[ib] = *(const bf16x8*)(bp + (size_t)(16 * ib) * ldb + 32 * ks); }
#pragma unroll
        for (int jb = 0; jb < 4; ++jb)
#pragma unroll
            for (int ib = 0; ib < 4; ++ib) acc[jb][ib] = __builtin_amdgcn_mfma_f32_16x16x32_bf16(bv[jb], af[ib], acc[jb][ib], 0, 0, 0);
    }
    epi(acc, fr, fq);
}
struct WEpiE {
    float* E;
    __device__ __forceinline__ void operator()(const pg8::f32x4 (&acc)[4][4], int fr, int fq) const {
#pragma unroll
        for (int jb = 0; jb < 4; ++jb)
#pragma unroll
            for (int ib = 0; ib < 4; ++ib) *(pg8::f32x4*)(E + (size_t)(16 * ib + fr) * 128 + 16 * jb + 4 * fq) = acc[jb][ib];
    }
};
struct WEpiS5Y {
    const bf16* SUAg; bf16* YS5; const float* dg; int chunk0, col0, g;
    __device__ __forceinline__ void operator()(const pg8::f32x4 (&acc)[4][4], int fr, int fq) const {
#pragma unroll
        for (int jb = 0; jb < 4; ++jb) { const int col = col0 + 16 * jb + 4 * fq, tt = col >> 4, h0 = col & 15; const f32x4 d4 = *(const f32x4*)(dg + h0);
#pragma unroll
            for (int ib = 0; ib < 4; ++ib) { const int chunk = chunk0 + 16 * ib + fr; const u32x2 uu = *(const u32x2*)(SUAg + (size_t)chunk * KA5 + col); const pg8::f32x4 v = acc[jb][ib];
                const float y0 = gelu_tanh(v[0] + d4.x * bflo(uu.x)), y1 = gelu_tanh(v[1] + d4.y * bfhi(uu.x)), y2 = gelu_tanh(v[2] + d4.z * bflo(uu.y)), y3 = gelu_tanh(v[3] + d4.w * bfhi(uu.y));
                u32x2 w; w.x = pk2(y0, y1); w.y = pk2(y2, y3); *(u32x2*)(YS5 + (size_t)(chunk * 32 + tt) * 256 + g * 16 + h0) = w; } }
    }
};
struct WEpiGlu {
    const bf16* YS5; bf16* G; int row0, col0;
    __device__ __forceinline__ void operator()(const pg8::f32x4 (&acc)[4][4], int fr, int fq) const {
#pragma unroll
        for (int jb = 0; jb < 4; ++jb)
#pragma unroll
            for (int ib = 0; ib < 4; ++ib) { const int row = row0 + 16 * ib + fr, col = col0 + 16 * jb + 4 * fq; const u32x2 yy = *(const u32x2*)(YS5 + (size_t)row * 256 + col); bf16* gp = G + (size_t)row * 1024 + 512 + col; const u32x2 gg = *(const u32x2*)gp; const pg8::f32x4 v = acc[jb][ib];
                const float s0 = __builtin_amdgcn_rcpf(1.f + __expf(-v[0])), s1 = __builtin_amdgcn_rcpf(1.f + __expf(-v[1])), s2 = __builtin_amdgcn_rcpf(1.f + __expf(-v[2])), s3 = __builtin_amdgcn_rcpf(1.f + __expf(-v[3]));
                u32x2 w; w.x = pk2(bflo(yy.x) * s0 * bflo(gg.x), bfhi(yy.x) * s1 * bfhi(gg.x)); w.y = pk2(bflo(yy.y) * s2 * bflo(gg.y), bfhi(yy.y) * s3 * bfhi(gg.y)); *(u32x2*)gp = w; }
    }
};

__device__ __forceinline__ void ret_upd_unit(unsigned char* ws, int unit, int lane) {
    const int c = unit & 63, bh = unit >> 6; const int i16 = lane & 15, kq = lane >> 4;
    const bf16* KT = (const bf16*)(ws + WS_RKT) + (size_t)bh * 64 * SEQ + c * 64; const bf16* VT = (const bf16*)(ws + WS_RVT) + (size_t)bh * 64 * SEQ + c * 64;
    float* UPD = (float*)(ws + WS_UPD) + (size_t)unit * 4096;
    bf16x8 af[4][2], bfv[4][2];
#pragma unroll
    for (int ib = 0; ib < 4; ++ib)
#pragma unroll
        for (int ks = 0; ks < 2; ++ks) { af[ib][ks] = *(const bf16x8*)(KT + (size_t)(16 * ib + i16) * SEQ + 32 * ks + 8 * kq); bfv[ib][ks] = *(const bf16x8*)(VT + (size_t)(16 * ib + i16) * SEQ + 32 * ks + 8 * kq); }
#pragma unroll
    for (int ib = 0; ib < 4; ++ib)
#pragma unroll
        for (int jb = 0; jb < 4; ++jb) { pg8::f32x4 d = (pg8::f32x4){0.f, 0.f, 0.f, 0.f};
            d = __builtin_amdgcn_mfma_f32_16x16x32_bf16(af[ib][0], bfv[jb][0], d, 0, 0, 0); d = __builtin_amdgcn_mfma_f32_16x16x32_bf16(af[ib][1], bfv[jb][1], d, 0, 0, 0);
            *(pg8::f32x4*)(UPD + (size_t)(16 * jb + i16) * 64 + 16 * ib + 4 * kq) = d; }
}
__device__ __forceinline__ void ret_out_unit(const Args& a, int l, int unit, int lane, bool dry = false) {
    unsigned char* ws = a.ws;
    const int c = unit & 63, bh = unit >> 6, hh = bh & 3, b = bh >> 2; const int fr = lane & 15, fq = lane >> 4;
    const size_t t0 = (size_t)b * SEQ + c * 64;
    const bf16* RQ = (const bf16*)(ws + WS_RQ) + t0 * 256 + hh * 64; const bf16* RK = (const bf16*)(ws + WS_RK) + t0 * 256 + hh * 64;
    const bf16* VT = (const bf16*)(ws + WS_RVT) + (size_t)bh * 64 * SEQ + c * 64; const bf16* ST = (const bf16*)(ws + WS_STATE) + (size_t)unit * 4096;
    const float lg = lg2_gamma(hh);
    bf16x8 qf[4][2]; pg8::f32x4 st[4][4];
#pragma unroll
    for (int nb = 0; nb < 4; ++nb)
#pragma unroll
        for (int ks = 0; ks < 2; ++ks) qf[nb][ks] = *(const bf16x8*)(RQ + (size_t)(16 * nb + fr) * 256 + 32 * ks + 8 * fq);
#pragma unroll
    for (int mb = 0; mb < 4; ++mb) { bf16x8 k0 = *(const bf16x8*)(RK + (size_t)(16 * mb + fr) * 256 + 8 * fq), k1 = *(const bf16x8*)(RK + (size_t)(16 * mb + fr) * 256 + 32 + 8 * fq);
#pragma unroll
        for (int nb = 0; nb < 4; ++nb) { pg8::f32x4 d = (pg8::f32x4){0.f, 0.f, 0.f, 0.f};
            d = __builtin_amdgcn_mfma_f32_16x16x32_bf16(k0, qf[nb][0], d, 0, 0, 0); d = __builtin_amdgcn_mfma_f32_16x16x32_bf16(k1, qf[nb][1], d, 0, 0, 0);
#pragma unroll
            for (int r = 0; r < 4; ++r) { const int mm = 16 * mb + 4 * fq + r, nn = 16 * nb + fr; const int df = mm > nn ? mm - nn : nn - mm; d[r] *= 0.125f * __builtin_amdgcn_exp2f(lg * (float)df); }
            st[mb][nb] = d; } }
    bf16* Y = (bf16*)(ws + WS_GATE) + t0 * 1024 + 768 + hh * 64;
    u32x2 gt[4][4];
#pragma unroll
    for (int nb = 0; nb < 4; ++nb)
#pragma unroll
        for (int dvb = 0; dvb < 4; ++dvb) gt[nb][dvb] = *(const u32x2*)(Y + (size_t)(16 * nb + fr) * 1024 + 16 * dvb + 4 * fq);
    pg8::f32x4 oT[4][4];
#pragma unroll
    for (int dvb = 0; dvb < 4; ++dvb)
#pragma unroll
        for (int nb = 0; nb < 4; ++nb) oT[dvb][nb] = (pg8::f32x4){0.f, 0.f, 0.f, 0.f};
#pragma unroll
    for (int dvb = 0; dvb < 4; ++dvb) { const bf16x8 s0 = *(const bf16x8*)(ST + (size_t)(16 * dvb + fr) * 64 + 8 * fq), s1 = *(const bf16x8*)(ST + (size_t)(16 * dvb + fr) * 64 + 32 + 8 * fq);
#pragma unroll
        for (int nb = 0; nb < 4; ++nb) { oT[dvb][nb] = __builtin_amdgcn_mfma_f32_16x16x32_bf16(s0, qf[nb][0], oT[dvb][nb], 0, 0, 0); oT[dvb][nb] = __builtin_amdgcn_mfma_f32_16x16x32_bf16(s1, qf[nb][1], oT[dvb][nb], 0, 0, 0); } }
#pragma unroll
    for (int nb = 0; nb < 4; ++nb) { const float wq = 0.125f * __builtin_amdgcn_exp2f(lg * (float)(16 * nb + fr + 1));
#pragma unroll
        for (int dvb = 0; dvb < 4; ++dvb) oT[dvb][nb] = oT[dvb][nb] * wq; }
#pragma unroll
    for (int s = 0; s < 2; ++s) {
        bf16x8 pa[4];
#pragma unroll
        for (int nb = 0; nb < 4; ++nb) { u32x4 w; w.x = pk2(st[2 * s][nb][0], st[2 * s][nb][1]); w.y = pk2(st[2 * s][nb][2], st[2 * s][nb][3]); w.z = pk2(st[2 * s + 1][nb][0], st[2 * s + 1][nb][1]); w.w = pk2(st[2 * s + 1][nb][2], st[2 * s + 1][nb][3]); pa[nb] = __builtin_bit_cast(bf16x8, w); }
#pragma unroll
        for (int dvb = 0; dvb < 4; ++dvb) { const u32x2 v0 = *(const u32x2*)(VT + (size_t)(16 * dvb + fr) * SEQ + 32 * s + 4 * fq), v1 = *(const u32x2*)(VT + (size_t)(16 * dvb + fr) * SEQ + 32 * s + 16 + 4 * fq);
            const bf16x8 vf = __builtin_bit_cast(bf16x8, (u32x4){v0.x, v0.y, v1.x, v1.y});
#pragma unroll
            for (int nb = 0; nb < 4; ++nb) oT[dvb][nb] = __builtin_amdgcn_mfma_f32_16x16x32_bf16(vf, pa[nb], oT[dvb][nb], 0, 0, 0); }
    }
    const float* gn = a.in[13] + (size_t)l * 256 + hh * 64; f32x4 gnw[4];
#pragma unroll
    for (int dvb = 0; dvb < 4; ++dvb) gnw[dvb] = *(const f32x4*)(gn + 16 * dvb + 4 * fq);
#pragma unroll
    for (int nb = 0; nb < 4; ++nb) { float sm = 0.f;
#pragma unroll
        for (int dvb = 0; dvb < 4; ++dvb) sm += (oT[dvb][nb][0] + oT[dvb][nb][1]) + (oT[dvb][nb][2] + oT[dvb][nb][3]);
        sm += __shfl_xor(sm, 16); sm += __shfl_xor(sm, 32);
        const float mu = sm * (1.f / 64.f); float q = 0.f;
#pragma unroll
        for (int dvb = 0; dvb < 4; ++dvb)
#pragma unroll
            for (int r = 0; r < 4; ++r) { const float d = oT[dvb][nb][r] - mu; q += d * d; }
        q += __shfl_xor(q, 16); q += __shfl_xor(q, 32);
        const float rstd = rsqrtf(q * (1.f / 64.f) + EPS);
#pragma unroll
        for (int dvb = 0; dvb < 4; ++dvb) { const u32x2 g2 = gt[nb][dvb]; const pg8::f32x4 v = oT[dvb][nb]; const f32x4 w4 = gnw[dvb]; u32x2 w;
            w.x = pk2((v[0] - mu) * rstd * w4.x * bflo(g2.x), (v[1] - mu) * rstd * w4.y * bfhi(g2.x)); w.y = pk2((v[2] - mu) * rstd * w4.z * bflo(g2.y), (v[3] - mu) * rstd * w4.w * bfhi(g2.y));
            if (!dry) *(u32x2*)(Y + (size_t)(16 * nb + fr) * 1024 + 16 * dvb + 4 * fq) = w; } }
}


#define XB_TMO      128
#define XB_XCNT(j)  (256  + 64 * (j))
#define XB_XSUB(j)  (1280 + 64 * (j))
#define XB_XGEN(j)  (2304 + 64 * (j))
#define XB_TOP      3328
#define XB_TOPGEN   3392
#define XCD_BAR_WORDS 3456
#define XB_SPIN_CAP (1u << 18)

__device__ __forceinline__ unsigned xb_ld(unsigned* p)              { return __hip_atomic_load(p, __ATOMIC_RELAXED, __HIP_MEMORY_SCOPE_AGENT); }
__device__ __forceinline__ unsigned xb_add(unsigned* p, unsigned v) { return __hip_atomic_fetch_add(p, v, __ATOMIC_RELAXED, __HIP_MEMORY_SCOPE_AGENT); }
__device__ __forceinline__ unsigned xb_xcc_id() { return (unsigned)__builtin_amdgcn_s_getreg((3 << 11) | 20) & 0xFu; }
#define XB_SPIN(cond, bar) do { unsigned _sp = 0; while (cond) { __builtin_amdgcn_s_sleep(1); \
    if ((++_sp & 255u) == 0u) { if (xb_ld(&(bar)[XB_TMO])) break; if (_sp > XB_SPIN_CAP) { atomicAdd(&(bar)[XB_TMO], 1u); break; } } } } while (0)

struct XcdBarrier {
    unsigned* bar; unsigned x;
    volatile LAS unsigned* st;
};

__device__ __forceinline__ XcdBarrier xcd_barrier_post(unsigned* bar, volatile LAS unsigned* st) {
    XcdBarrier b; b.bar = bar; b.x = xb_xcc_id(); b.st = st;
    if (threadIdx.x == 0) (void)xb_add(&bar[XB_XCNT(b.x)], 1u);
    return b;
}
__device__ __forceinline__ void xcd_barrier_complete(unsigned* bar, unsigned x, unsigned& nloc, unsigned& nx) {
    const unsigned G = gridDim.x * gridDim.y * gridDim.z;
    unsigned sum, cnt, mine, sp = 0u;
    for (;;) {
        sum = 0u; cnt = 0u; mine = 0u;
#pragma unroll
        for (unsigned j = 0; j < 16; ++j) { const unsigned c = xb_ld(&bar[XB_XCNT(j)]); sum += c; cnt += (c > 0u) ? 1u : 0u; mine = (j == x) ? c : mine; }
        if (sum == G) break;
        __builtin_amdgcn_s_sleep(1);
        if ((++sp & 255u) == 0u) { if (xb_ld(&bar[XB_TMO])) break; if (sp > XB_SPIN_CAP) { atomicAdd(&bar[XB_TMO], 1u); break; } }
    }
    nloc = mine > 0u ? mine : 1u; nx = cnt > 0u ? cnt : 1u;
}

__device__ __forceinline__ void xcd_barrier(const XcdBarrier& b) {
    asm volatile("s_waitcnt vmcnt(0)" ::: "memory");
    __syncthreads();
    if (threadIdx.x == 0) {
        unsigned* bar = b.bar;
        __builtin_amdgcn_s_waitcnt(0);
        unsigned nloc = b.st[0], nx = b.st[1];
        if (nloc == 0u) { xcd_barrier_complete(bar, b.x, nloc, nx); b.st[0] = nloc; b.st[1] = nx; }
        const unsigned old = xb_add(&bar[XB_XSUB(b.x)], 1u);
        const unsigned gen = old / nloc;
        if (old + 1u == (gen + 1u) * nloc) {
            __builtin_amdgcn_fence(__ATOMIC_RELEASE, "agent");
            asm volatile("s_waitcnt vmcnt(0)" ::: "memory");
            const unsigned og = xb_add(&bar[XB_TOP], 1u);
            const unsigned tg = og / nx;
            if (og + 1u == (tg + 1u) * nx) xb_add(&bar[XB_TOPGEN], 1u);
            else XB_SPIN(xb_ld(&bar[XB_TOPGEN]) == tg, bar);
            __builtin_amdgcn_fence(__ATOMIC_ACQUIRE, "agent");
            xb_add(&bar[XB_XGEN(b.x)], 1u);
            asm volatile("s_waitcnt vmcnt(0)" ::: "memory");
        } else {
            XB_SPIN(xb_ld(&bar[XB_XGEN(b.x)]) == gen, bar);
            __builtin_amdgcn_fence(__ATOMIC_ACQUIRE, "agent");
            asm volatile("s_waitcnt vmcnt(0)" ::: "memory");
        }
    }
    __syncthreads();
}

#define XBAR_MAKE XcdBarrier xb_; xb_.bar = (unsigned*)args.ws; xb_.st = (volatile LAS unsigned*)((LAS unsigned char*)lds + RING_BYTES + 352); xb_.x = xb_.st[2]
#ifdef REP_SYNC
#define GSYNC() do { XBAR_MAKE; xcd_barrier(xb_); xcd_barrier(xb_); } while (0)
#else
#define GSYNC() do { XBAR_MAKE; xcd_barrier(xb_); } while (0)
#endif
#ifndef REP_P0
#define REP_P0 1
#endif
#ifndef REP_P1
#define REP_P1 1
#endif
#ifndef REP_P23
#define REP_P23 1
#endif
#ifndef REP_NORM
#define REP_NORM 1
#endif
__global__ void __launch_bounds__(NTHR, 2) mega_fwd(Args args) {
    extern __shared__ __attribute__((aligned(16))) unsigned char lds[];
    cg::grid_group grid = cg::this_grid();
    const int tid = threadIdx.x, lane = tid & 63, wave = __builtin_amdgcn_readfirstlane(tid >> 6);
    const int G = gridDim.x, bx = blockIdx.x; const int vcu = (G % 8 == 0) ? (bx % 8) * (G / 8) + bx / 8 : bx;
    const int gw = bx * NWAVES + wave, NGW = G * NWAVES;
    unsigned char* ws = args.ws;
    LAS unsigned char* ldsl = (LAS unsigned char*)lds;
    LAS float* ldsf = (LAS float*)lds;
    float* X = args.out;
    if (ws == nullptr) grid.sync();
    if (tid < 2) ((volatile LAS unsigned*)(ldsl + RING_BYTES + 352))[tid] = 0u;
    __syncthreads();
    { const XcdBarrier xb0 = xcd_barrier_post((unsigned*)ws, (volatile LAS unsigned*)(ldsl + RING_BYTES + 352)); if (tid == 0) ((volatile LAS unsigned*)(ldsl + RING_BYTES + 352))[2] = xb0.x; }
    __syncthreads();

#ifdef PROBE_T
    unsigned long long tacc_ = 0ull, tprev_ = __builtin_amdgcn_s_memrealtime();
#define TSTAMP(id) do { const unsigned long long tn_ = __builtin_amdgcn_s_memrealtime(); if ((id) == PROBE_T || ((PROBE_T) == 23 && ((id) == 2 || (id) == 3 || (id) == 5))) tacc_ += tn_ - tprev_; tprev_ = tn_; } while (0)
#else
#define TSTAMP(id) do {} while (0)
#endif
    for (int rep_ = 0; rep_ < REP_P0; ++rep_) {
        if (rep_) { __syncthreads(); }
#ifdef REP_S5P
        if (bx < 64) { s5_prep(args, bx >> 4, bx & 15, ldsf, tid); }
#endif
        if (bx < 64) { s5_prep(args, bx >> 4, bx & 15, ldsf, tid); }
        LAS float* scr = ldsf + wave * 4096;
        constexpr int I_IN = (DM / 64) * (NF / 32), I_O = (DM / 64) * (DM / 32), I_G = (256 / 64) * (256 / 32), I_L = I_IN + I_O + I_G;
#ifndef REP_TR
#define REP_TR 1
#endif
        for (int rt_ = 0; rt_ < REP_TR; ++rt_)
        for (int it = (bx < 64 ? DEPTH * I_L : (bx - 64) * NWAVES + wave); it < DEPTH * I_L; it += (G - 64) * NWAVES) {
            const int l = it / I_L; int r = it % I_L;
            if (r < I_IN) { p0_transpose_item<true>(args.in[2] + (size_t)l * DM * NIN, DM, NIN, NF, (bf16*)(ws + WS_WIN) + (size_t)l * NF * DM, scr, r, lane); continue; } r -= I_IN;
            if (r < I_O) { p0_transpose_item<false>(args.in[14] + (size_t)l * DM * DM, DM, DM, DM, (bf16*)(ws + WS_WO) + (size_t)l * DM * DM, scr, r, lane); continue; } r -= I_O;
            p0_transpose_item<false>(args.in[12] + (size_t)l * 65536, 256, 256, 256, (bf16*)(ws + WS_WGLU) + (size_t)l * 65536, scr, r, lane);
        }
        f32x2* rope = (f32x2*)(ws + WS_ROPE);
        for (int i = bx * NTHR + tid; i < SEQ * 32; i += G * NTHR) { const int pos = i >> 5, fi = i & 31; const float freq = powf(10000.f, -(float)fi / 32.f); const float ang = (float)pos * freq; float sn, cs; sincosf(ang, &sn, &cs); rope[i] = (f32x2){cs, sn}; }
        __syncthreads();
        { const int NW = (64 + 2 * (G - 64)) * NWAVES;
          if (bx < 64) norm0_phase(args, lane, bx * NWAVES + wave, NW);
          else { const int sl = 64 * NWAVES + ((bx - 64) * NWAVES + wave) * 2; norm0_phase(args, lane, sl, NW); norm0_phase(args, lane, sl + 1, NW); } }
    }
    GSYNC();
    TSTAMP(0);

#define PHASE_VARS int tid = threadIdx.x; asm volatile("" : "+v"(tid)); int bxl_ = blockIdx.x; asm volatile("" : "+s"(bxl_)); const int bx = bxl_; const int lane = tid & 63, wave = __builtin_amdgcn_readfirstlane(tid >> 6), gw = bx * NWAVES + wave; __attribute__((address_space(1))) unsigned char* wsg_ = (__attribute__((address_space(1))) unsigned char*)args.ws; asm volatile("" : "+s"(wsg_)); unsigned char* ws = (unsigned char*)wsg_; LAS unsigned char* ldsl = (LAS unsigned char*)lds; LAS float* ldsf = (LAS float*)lds; (void)lane; (void)wave; (void)gw; (void)ldsl; (void)ldsf
    for (int l = 0; l < DEPTH; ++l) {
        for (int rep_ = 0; rep_ < REP_P1; ++rep_) {
            PHASE_VARS;
            pg8::Gemm g{(const bf16*)(ws + WS_XN), (const bf16*)(ws + WS_WIN) + (size_t)l * NF * DM, M, NF, DM, DM, DM, 0, 0};
            pg8::StaticOrder S; S.init(M, NF, G, bx);
            EpiInProj E{ws, (const float*)(ws + WS_SS) + (size_t)(l & 1) * M, args.in[3] + (size_t)l * 8};
#ifdef PROBE_SPLIT
            { RangeOrder R0{S, 0, 2}, R1{S, 2, 4}; pg8::gemm_phase<EpiInProj, RangeOrder, true, true>(ldsl, g, R0, E); GSYNC(); pg8::gemm_phase<EpiInProj, RangeOrder, true, true>(ldsl, g, R1, E); }
#else
            pg8::gemm_phase<EpiInProj, pg8::StaticOrder, true, true>(ldsl, g, S, E);
#endif
            if (bx >= G / 2) flog_phase(args, l, (const float*)(ws + WS_SS) + (size_t)(l & 1) * M, ldsf, tid, lane, wave, bx - G / 2, G / 2);
        }
        GSYNC();
        TSTAMP(1);
        for (int rep_ = 0; rep_ < REP_P23; ++rep_) {
            if (rep_) __syncthreads();
            PHASE_VARS;
            if (bx < 128) {
                const int half = bx & 1, bg_ = bx >> 1, b = bg_ >> 4, g = bg_ & 15, tmL = wave & 1, tn = (wave >> 1) & 1, kh = wave >> 2;
                { const int fr = lane & 15, fq = lane >> 4;
                  const bf16* Ap = (const bf16*)(ws + WS_SUA) + ((size_t)g * NCH5 + b * 128 + tmL * 64) * KA5 + 256 * kh; const bf16* Bp = (const bf16*)(ws + WS_WB) + ((size_t)(l * 16 + g) * 128 + tn * 64) * 512 + 256 * kh;
                  struct WEpiLds { LAS float* EL; __device__ __forceinline__ void operator()(const pg8::f32x4 (&acc)[4][4], int fr_, int fq_) const {
#pragma unroll
                      for (int jb = 0; jb < 4; ++jb)
#pragma unroll
                          for (int ib = 0; ib < 4; ++ib) *(LAS pg8::f32x4*)(EL + (16 * ib + fr_) * 128 + 16 * jb + 4 * fq_) = acc[jb][ib]; } };
                  WEpiLds E{ldsf + (size_t)(kh * 128 + tmL * 64) * 128 + tn * 64}; (void)fr; (void)fq;
                  wave_gemm64<8, 4, WEpiLds>(Ap, KA5, Bp, 512, lane, E); }
                __syncthreads();
                const int p = tid & 63, seg = tid >> 6;
                const float* LAM = (const float*)(ws + WS_LAM) + (size_t)(l * 16 + g) * 128; const float lr = LAM[p], li = LAM[64 + p];
                bf16* SA = (bf16*)(ws + WS_SUA) + ((size_t)g * NCH5 + b * 128 + seg * 16) * KA5 + 512 + p;
                float er[16], ei[16];
#pragma unroll
                for (int i = 0; i < 16; ++i) { const int r = (seg * 16 + i) * 128; er[i] = ldsf[r + p] + ldsf[16384 + r + p]; ei[i] = ldsf[r + 64 + p] + ldsf[16384 + r + 64 + p]; }
                float sr = 0.f, si = 0.f;
#pragma unroll
                for (int i = 0; i < 16; ++i) { const float nr = lr * sr - li * si + er[i], ni = lr * si + li * sr + ei[i]; sr = nr; si = ni; }
                LAS float* ends = ldsf + (RING_BYTES + 1024) / 4;
                ends[(seg * 64 + p) * 2] = sr; ends[(seg * 64 + p) * 2 + 1] = si;
                float pr = lr, pi = li;
#pragma unroll
                for (int i = 0; i < 4; ++i) { const float nr = pr * pr - pi * pi, ni = 2.f * pr * pi; pr = nr; pi = ni; }
                __syncthreads();
                float cr = 0.f, ci = 0.f;
                for (int s2 = 0; s2 < seg; ++s2) { const float xr = ends[(s2 * 64 + p) * 2], xi = ends[(s2 * 64 + p) * 2 + 1]; const float nr = pr * cr - pi * ci + xr, ni = pr * ci + pi * cr + xi; cr = nr; ci = ni; }
#pragma unroll
                for (int i = 0; i < 16; ++i) { SA[(size_t)i * KA5] = f2bf(cr); SA[(size_t)i * KA5 + 64] = f2bf(ci); const float nr = lr * cr - li * ci + er[i], ni = lr * ci + li * cr + ei[i]; cr = nr; ci = ni; }
                asm volatile("s_waitcnt vmcnt(0)" ::: "memory"); __syncthreads();
                { const int tmL2 = wave & 1, tn2 = half * 4 + (wave >> 1);
                  const bf16* SUAg = (const bf16*)(ws + WS_SUA) + (size_t)g * NCH5 * KA5;
                  WEpiS5Y E{SUAg, (bf16*)(ws + WS_YS5), args.in[10] + (size_t)l * 256 + g * 16, b * 128 + tmL2 * 64, tn2 * 64, g};
                  wave_gemm64<20, 4, WEpiS5Y>(SUAg + (size_t)(b * 128 + tmL2 * 64) * KA5, KA5, (const bf16*)(ws + WS_MF) + ((size_t)(l * 16 + g) * 512 + tn2 * 64) * KA5, KA5, lane, E); }
            } else {
                const int idx = bx - 128, bh = idx >> 3, dvs = (idx >> 1) & 3, dkh = idx & 1, fr = lane & 15, fq = lane >> 4; const float g64 = exp2f(lg2_gamma(bh & 3) * 64.f);
                const bf16* KT = (const bf16*)(ws + WS_RKT) + ((size_t)bh * 64 + 32 * dkh + fr) * SEQ + 8 * fq; const bf16* VT = (const bf16*)(ws + WS_RVT) + ((size_t)bh * 64 + 16 * dvs + fr) * SEQ + 8 * fq;
                pg8::f32x4 u[8][2];
#pragma unroll
                for (int i2 = 0; i2 < 2; ++i2) {
                    bf16x8 vf[4][2], kf[4][2][2];
#pragma unroll
                    for (int i1 = 0; i1 < 4; ++i1) { const int c = 8 * wave + 4 * i2 + i1; vf[i1][0] = *(const bf16x8*)(VT + c * 64); vf[i1][1] = *(const bf16x8*)(VT + c * 64 + 32);
#pragma unroll
                        for (int ib = 0; ib < 2; ++ib) { kf[i1][ib][0] = *(const bf16x8*)(KT + (size_t)(16 * ib) * SEQ + c * 64); kf[i1][ib][1] = *(const bf16x8*)(KT + (size_t)(16 * ib) * SEQ + c * 64 + 32); } }
#pragma unroll
                    for (int i1 = 0; i1 < 4; ++i1)
#pragma unroll
                        for (int ib = 0; ib < 2; ++ib) { pg8::f32x4 d = (pg8::f32x4){0.f, 0.f, 0.f, 0.f}; d = __builtin_amdgcn_mfma_f32_16x16x32_bf16(kf[i1][ib][0], vf[i1][0], d, 0, 0, 0); d = __builtin_amdgcn_mfma_f32_16x16x32_bf16(kf[i1][ib][1], vf[i1][1], d, 0, 0, 0); u[4 * i2 + i1][ib] = d; }
                }
                pg8::f32x4 e4[2];
#pragma unroll
                for (int ib = 0; ib < 2; ++ib) e4[ib] = (pg8::f32x4){0.f, 0.f, 0.f, 0.f};
#pragma unroll
                for (int i = 0; i < 8; ++i)
#pragma unroll
                    for (int ib = 0; ib < 2; ++ib) e4[ib] = e4[ib] * g64 + u[i][ib];
                LAS pg8::f32x4* ends = (LAS pg8::f32x4*)ldsf;
#pragma unroll
                for (int ib = 0; ib < 2; ++ib) ends[(wave * 2 + ib) * 64 + lane] = e4[ib];
                float g8 = g64; g8 = g8 * g8; g8 = g8 * g8; g8 = g8 * g8;
                __syncthreads();
                pg8::f32x4 st[2];
#pragma unroll
                for (int ib = 0; ib < 2; ++ib) st[ib] = (pg8::f32x4){0.f, 0.f, 0.f, 0.f};
                for (int w2 = 0; w2 < wave; ++w2)
#pragma unroll
                    for (int ib = 0; ib < 2; ++ib) st[ib] = st[ib] * g8 + ends[(w2 * 2 + ib) * 64 + lane];
                bf16* ST = (bf16*)(ws + WS_STATE) + (size_t)(bh * 64 + 8 * wave) * 4096 + (size_t)(16 * dvs + fr) * 64 + 32 * dkh + 4 * fq;
#pragma unroll
                for (int i = 0; i < 8; ++i)
#pragma unroll
                    for (int ib = 0; ib < 2; ++ib) { u32x2 w; w.x = pk2(st[ib][0], st[ib][1]); w.y = pk2(st[ib][2], st[ib][3]); *(u32x2*)(ST + (size_t)i * 4096 + 16 * ib) = w; st[ib] = st[ib] * g64 + u[i][ib]; }
                __syncthreads();
                if (idx < 32) {
                const int bh = idx; const float* lf = (const float*)(ws + WS_LOGF) + (size_t)bh * SEQ; float* cb = (float*)(ws + WS_CB) + (size_t)bh * SEQ;
                const f32x4 a0 = *(const f32x4*)(lf + tid * 8), a1 = *(const f32x4*)(lf + tid * 8 + 4); float v[8] = {a0.x, a0.y, a0.z, a0.w, a1.x, a1.y, a1.z, a1.w};
#pragma unroll
                for (int e = 1; e < 8; ++e) v[e] += v[e - 1];
                float tot = v[7];
#pragma unroll
                for (int o = 1; o < 64; o <<= 1) { const float t = __shfl_up(tot, o); if (lane >= o) tot += t; }
                if (lane == 63) ldsf[wave] = tot;
                __syncthreads();
                float off = tot - v[7];
                for (int w = 0; w < wave; ++w) off += ldsf[w];
                f32x4 o0, o1; o0.x = -(v[0] + off) * LOG2E; o0.y = -(v[1] + off) * LOG2E; o0.z = -(v[2] + off) * LOG2E; o0.w = -(v[3] + off) * LOG2E; o1.x = -(v[4] + off) * LOG2E; o1.y = -(v[5] + off) * LOG2E; o1.z = -(v[6] + off) * LOG2E; o1.w = -(v[7] + off) * LOG2E;
                *(f32x4*)(cb + tid * 8) = o0; *(f32x4*)(cb + tid * 8 + 4) = o1;
                } else if (idx < 64) {
                const int bh = idx - 32, b = bh >> 3, h = bh & 7, rsub = lane >> 3, part = lane & 7;
                const bf16* Qp = (const bf16*)(ws + WS_QO) + ((size_t)b * SEQ + wave * 512 + rsub) * 512 + h * 64 + part * 8; const bf16* Kp = (const bf16*)(ws + WS_KB) + ((size_t)b * SEQ + wave * 512 + rsub) * 512 + h * 64 + part * 8;
                float qm = 0.f, km = 0.f;
#pragma unroll 8
                for (int it = 0; it < 64; ++it) { const u32x4 qv = *(const u32x4*)(Qp + (size_t)it * 8 * 512), kv = *(const u32x4*)(Kp + (size_t)it * 8 * 512); float sq = 0.f, sk = 0.f;
#pragma unroll
                    for (int e = 0; e < 4; ++e) { const float a0 = bflo(qv[e]), a1 = bfhi(qv[e]), c0 = bflo(kv[e]), c1 = bfhi(kv[e]); sq += a0 * a0 + a1 * a1; sk += c0 * c0 + c1 * c1; }
                    sq += __shfl_xor(sq, 1); sq += __shfl_xor(sq, 2); sq += __shfl_xor(sq, 4); sk += __shfl_xor(sk, 1); sk += __shfl_xor(sk, 2); sk += __shfl_xor(sk, 4);
                    qm = fmaxf(qm, sq); km = fmaxf(km, sk); }
#pragma unroll
                for (int o = 8; o < 64; o <<= 1) { qm = fmaxf(qm, __shfl_xor(qm, o)); km = fmaxf(km, __shfl_xor(km, o)); }
                if (lane == 0) { ldsf[wave * 2] = qm; ldsf[wave * 2 + 1] = km; }
                __syncthreads();
                if (tid == 0) { float a = 0.f, c = 0.f; for (int w = 0; w < NWAVES; ++w) { a = fmaxf(a, ldsf[2 * w]); c = fmaxf(c, ldsf[2 * w + 1]); } ((float*)(ws + WS_NRM))[bh] = sqrtf(a) * sqrtf(c) * 1.0001f; }
                }
            }
        }
        GSYNC();
        TSTAMP(3);
        {
            PHASE_VARS;
            if (wave < 4) ret_out_unit(args, l, wave * 256 + bx, lane);
            else {
                const int t = (wave - 4) * 256 + bx, tm = t >> 2, tn = t & 3;
                WEpiGlu E{(const bf16*)(ws + WS_YS5), (bf16*)(ws + WS_GATE), tm * 64, tn * 64};
                wave_gemm64<8, 4, WEpiGlu>((const bf16*)(ws + WS_YS5) + (size_t)(tm * 64) * 256, 256, (const bf16*)(ws + WS_WGLU) + (size_t)l * 65536 + (size_t)(tn * 64) * 256, 256, lane, E);
            }
            __syncthreads();
            const attn_body::AttnTensors AT{(const attn_body::bf16*)(ws + WS_QO), (const attn_body::bf16*)(ws + WS_KB), (const attn_body::bf16*)(ws + WS_VB), (attn_body::bf16*)(ws + WS_GATE), (const float*)(ws + WS_CB), (const float*)(ws + WS_NRM)};
            const attn_body::StaticOrder S(G, bx);
#ifdef REP_ATTN
            attn_body::attn_phase<attn_body::StaticOrder>((char*)lds, AT, S, opaque_true());
#endif
            attn_body::attn_phase<attn_body::StaticOrder>((char*)lds, AT, S);
        }
        GSYNC();
        TSTAMP(4);
        {
            PHASE_VARS;
            pg8::Gemm g{(const bf16*)(ws + WS_GATE), (const bf16*)(ws + WS_WO) + (size_t)l * DM * DM, M, DM, DM, DM, DM, 0, 0};
            pg8::StaticOrder S; S.init(M, DM, G, bx);
            if (l + 1 < DEPTH) {
                EpiOutX<false> E{l == 0 ? args.in[0] : X, X, args.in[1] + (size_t)(l + 1) * DM, (float*)(ws + WS_XBUF), (unsigned*)ws + 4096, (bf16*)(ws + WS_XN), 32u * (unsigned)(l + 1)};
                pg8::gemm_phase<EpiOutX<false>, pg8::StaticOrder, false, true>(ldsl, g, S, E);
            } else {
                EpiOutX<true> E{X, X, args.in[15], (float*)(ws + WS_XBUF), (unsigned*)ws + 4096, nullptr, 32u * (unsigned)(l + 1)};
                pg8::gemm_phase<EpiOutX<true>, pg8::StaticOrder, false, true>(ldsl, g, S, E);
            }
        }
        if (l + 1 < DEPTH) GSYNC();
        TSTAMP(6);
    }
}

extern "C" void kernel_launch(void* const* d_in, const int* in_sizes, int n_in, void* d_out, int out_size, void* d_ws, size_t ws_size, hipStream_t stream) {
    static int grid = 0;
    if (grid == 0) {
        if (n_in != 16 || ws_size < WS_END) { fprintf(stderr, "kernel_launch: unexpected n_in %d / ws %zu\n", n_in, ws_size); grid = -1; return; }
        int dev = 0, cus = 0, per_cu = 0;
        hipGetDevice(&dev); hipDeviceGetAttribute(&cus, hipDeviceAttributeMultiprocessorCount, dev);
        if (hipFuncSetAttribute((const void*)mega_fwd, hipFuncAttributeMaxDynamicSharedMemorySize, LDS_BYTES) != hipSuccess) { fprintf(stderr, "kernel_launch: hipFuncSetAttribute failed\n"); grid = -1; return; }
        if (hipOccupancyMaxActiveBlocksPerMultiprocessor(&per_cu, (const void*)mega_fwd, NTHR, LDS_BYTES) != hipSuccess || per_cu < 1) { fprintf(stderr, "kernel_launch: occupancy query failed (%d)\n", per_cu); grid = -1; return; }
        grid = cus;
        if (grid != 256) fprintf(stderr, "kernel_launch: note: %d CUs\n", grid);
    }
    if (grid < 0) return;
    if (hipMemsetAsync(d_ws, 0, 32768, stream) != hipSuccess) { fprintf(stderr, "kernel_launch: hipMemsetAsync failed\n"); return; }
    Args a{};
    for (int i = 0; i < 16; ++i) a.in[i] = (const float*)d_in[i];
    a.out = (float*)d_out; a.ws = (unsigned char*)d_ws;
    void* kargs[] = {&a};
    hipError_t e = hipLaunchCooperativeKernel((const void*)mega_fwd, dim3(grid), dim3(NTHR), kargs, LDS_BYTES, stream);
    if (e != hipSuccess) fprintf(stderr, "kernel_launch: cooperative launch failed: %s\n", hipGetErrorString(e));
}
```

```cpp
#include <hip/hip_runtime.h>
#include <cstdio>
#include <cstdint>
namespace pg8 {
#define PG8_LAS __attribute__((address_space(3)))
typedef unsigned short bf16_t;
typedef short bf16x8 __attribute__((ext_vector_type(8)));
typedef float f32x4 __attribute__((ext_vector_type(4)));
typedef unsigned u32x4 __attribute__((ext_vector_type(4)));
constexpr int BM = 256, BK = 64, HALF = 128, HTB = HALF * BK * 2  , STAGE_BYTES = 8 * HTB, NXCD = 8, WGM = 4;

__host__ __device__ __forceinline__ int lds_byte(int r, int c) { const int st = (r >> 4) * 2 + (c >> 5), rr = r & 15, cc = c & 31, ob = rr * 64 + cc * 2; return st * 1024 + (ob ^ (((ob >> 9) & 1) << 5)); }
__host__ __device__ __forceinline__ void stage_rc(int b, int& R, int& C) { const int st = b / 1024, sb = b % 1024, swz = sb ^ (((sb >> 9) & 1) << 5); R = (st >> 1) * 16 + swz / 64; C = (st & 1) * 32 + (swz % 64) / 2; }
__host__ __device__ __forceinline__ int perm32(int rho) { const int n = rho >> 4, i = rho & 15; return 8 * (i >> 2) + 4 * n + (i & 3); }

struct Unit { int pm, pn, gz; };
struct Gemm { const bf16_t* A; const bf16_t* Bt; int M, N, K; int lda, ldb; size_t gsA, gsB; };

struct StaticOrder {
    int nM, nN, nwg, G, c;
    __host__ __device__ void init(int M, int N, int G_, int c_) { nM = M / BM; nN = N / BM; nwg = nM * nN; G = G_; c = c_; }
    __host__ __device__ bool next(int i, Unit& u) const {
        const long L = (long)i * G + c; if (L >= nwg) return false;
        int wgid = (int)L; { const int q = nwg / NXCD, r = nwg % NXCD, xcd = wgid % NXCD, off = wgid / NXCD; wgid = (xcd < r ? xcd * (q + 1) : r * (q + 1) + (xcd - r) * q) + off; }
        const int nig = WGM * nN, gid = wgid / nig, fm = gid * WGM, gsz = (nM - fm) < WGM ? (nM - fm) : WGM;
        u.pm = fm + ((wgid % nig) % gsz); u.pn = (wgid % nig) / gsz; u.gz = 0; return true;
    }
    __device__ __forceinline__ void a_ready(const Unit&) const {}
    __device__ __forceinline__ void done(const Unit&) const {}
};

__device__ __forceinline__ unsigned cvt_pk_bf16(float lo, float hi) { unsigned r; asm volatile("v_cvt_pk_bf16_f32 %0, %1, %2" : "=v"(r) : "v"(lo), "v"(hi)); return r; }
typedef float f32x2 __attribute__((ext_vector_type(2)));
__device__ __forceinline__ f32x2 gelu_pk(f32x2 v) {
    const f32x2 av = __builtin_elementwise_abs(v), d = av * 0.2316418882f + 1.0f;
    f32x2 t; t.x = __builtin_amdgcn_rcpf(d.x); t.y = __builtin_amdgcn_rcpf(d.y);
    f32x2 q = t * 0.5307027145f + (-0.7265760135f); q = q * t + 0.7107068705f; q = q * t + (-0.142248368f); q = q * t + 0.127414796f; q = q * t;
    const f32x2 s = (v * v) * (-0.72134752044f);
    f32x2 e; e.x = __builtin_amdgcn_exp2f(s.x); e.y = __builtin_amdgcn_exp2f(s.y);
    const f32x2 m = v * (q * e), r = v - m;
    f32x2 o; o.x = v.x < 0.f ? m.x : r.x; o.y = v.y < 0.f ? m.y : r.y; return o;
}

template <class Epi, class Sched, bool ALIGN_EPI = false, bool SP2 = false>
__device__ __forceinline__ void gemm_phase(PG8_LAS unsigned char* lds, const Gemm g, const Sched& S, const Epi& E) {
    int tid_ = threadIdx.x; asm volatile("" : "+v"(tid_));
    const int tid = tid_, wid = __builtin_amdgcn_readfirstlane(tid >> 6), lane = tid & 63, wr = wid >> 2, wc = wid & 3, fr = lane & 15, fq = lane >> 4;
    const int K = g.K, nt = K / BK;
    unsigned voffA[2], voffB[2];
#pragma unroll
    for (int i = 0; i < 2; ++i) { int R, C; stage_rc(tid * 16 + i * 8192, R, C); const int Rb = Epi::PERM ? ((R & ~31) + perm32(R & 31)) : R;
        voffA[i] = (unsigned)(R * g.lda + C) * 2u; voffB[i] = (unsigned)(Rb * g.ldb + C) * 2u; }
    const size_t kstep = (size_t)(BK * 2);
    const size_t hstepA = (size_t)HALF * g.lda * 2, hstepB = (size_t)HALF * g.ldb * 2;
    const size_t tstepA = 2 * hstepA, tstepB = 2 * hstepB;
    const unsigned ldsw = (unsigned)wid * 1024u;
    const int aoff = lds_byte(wr * 64 + fr, fq * 8), boff = lds_byte(wc * 32 + fr, fq * 8);
#define PG8_SA(b, h) (((b) * 2 + (h)) * HTB)
#define PG8_SB(b, h) ((4 + (b) * 2 + (h)) * HTB)
#define PG8_STAGE(bufoff, gbase, voff) do { _Pragma("unroll") for (int _i = 0; _i < 2; ++_i) \
        __builtin_amdgcn_global_load_lds((const unsigned*)((const char*)(gbase) + (voff)[_i]), (PG8_LAS unsigned*)(lds + (bufoff) + ldsw + _i * 8192), 16, 0, 0); } while (0)
#define PG8_LDA(dst, b, h) do { _Pragma("unroll") for (int m = 0; m < 4; ++m) _Pragma("unroll") for (int k = 0; k < 2; ++k) dst[m][k] = *(const PG8_LAS bf16x8*)(lds + PG8_SA(b, h) + aoff + m * 2048 + k * 1024); } while (0)
#define PG8_LDB(dst, b, h) do { _Pragma("unroll") for (int n = 0; n < 2; ++n) _Pragma("unroll") for (int k = 0; k < 2; ++k) dst[n][k] = *(const PG8_LAS bf16x8*)(lds + PG8_SB(b, h) + boff + n * 2048 + k * 1024); } while (0)
#define PG8_MMA(ai, bj, At, Bt) do { __builtin_amdgcn_s_setprio(1); _Pragma("unroll") for (int m = 0; m < 4; ++m) _Pragma("unroll") for (int n = 0; n < 2; ++n) _Pragma("unroll") for (int k = 0; k < 2; ++k) \
        acc[ai][bj][m][n] = __builtin_amdgcn_mfma_f32_16x16x32_bf16(Bt[n][k], At[m][k], acc[ai][bj][m][n], 0, 0, 0); __builtin_amdgcn_s_setprio(0); } while (0)
#define PG8_WAIT_V(n) asm volatile("s_waitcnt vmcnt(" #n ")" ::: "memory")
#define PG8_WAIT_L(n) asm volatile("s_waitcnt lgkmcnt(" #n ")" ::: "memory")
#define PG8_BAR __builtin_amdgcn_s_barrier()
#define PG8_SCHED __builtin_amdgcn_sched_barrier(0)
    Unit cur, nxt; int ui = 0;
    if (!S.next(0, cur)) return;
    f32x4 acc[2][2][4][2];
#pragma unroll
    for (int a = 0; a < 2; ++a)
#pragma unroll
        for (int b = 0; b < 2; ++b)
#pragma unroll
            for (int m = 0; m < 4; ++m)
#pragma unroll
                for (int n = 0; n < 2; ++n) acc[a][b][m][n] = (f32x4){0.f, 0.f, 0.f, 0.f};
    bf16x8 At[4][2], B0[2][2], B1[2][2];
    const char* cA = (const char*)g.A + (size_t)cur.gz * g.gsA * 2 + (size_t)cur.pm * tstepA; const char* cB = (const char*)g.Bt + (size_t)cur.gz * g.gsB * 2 + (size_t)cur.pn * tstepB;
    S.a_ready(cur);
    if constexpr (SP2) {
        PG8_STAGE(PG8_SB(0, 0), cB, voffB); PG8_STAGE(PG8_SB(0, 1), cB + hstepB, voffB); PG8_STAGE(PG8_SA(0, 0), cA, voffA); PG8_STAGE(PG8_SA(0, 1), cA + hstepA, voffA);
        if (wr == 1) PG8_BAR;
        PG8_WAIT_V(2); PG8_BAR;
        PG8_STAGE(PG8_SB(1, 0), cB + kstep, voffB); PG8_STAGE(PG8_SA(1, 0), cA + kstep, voffA); PG8_STAGE(PG8_SB(1, 1), cB + hstepB + kstep, voffB);
        PG8_WAIT_V(6); PG8_BAR;
    } else {
        PG8_STAGE(PG8_SB(0, 0), cB, voffB); PG8_STAGE(PG8_SA(0, 0), cA, voffA); PG8_STAGE(PG8_SB(0, 1), cB + hstepB, voffB); PG8_STAGE(PG8_SA(0, 1), cA + hstepA, voffA);
        if (wr == 1) PG8_BAR;
        PG8_WAIT_V(4); PG8_BAR;
        PG8_STAGE(PG8_SB(1, 0), cB + kstep, voffB); PG8_STAGE(PG8_SA(1, 0), cA + kstep, voffA); PG8_STAGE(PG8_SB(1, 1), cB + hstepB + kstep, voffB);
        PG8_WAIT_V(6); PG8_BAR;
    }
    for (;;) {
        const bool has_next = S.next(ui + 1, nxt);
        const char* nA = has_next ? (const char*)g.A + (size_t)nxt.gz * g.gsA * 2 + (size_t)nxt.pm * tstepA : cA; const char* nB = has_next ? (const char*)g.Bt + (size_t)nxt.gz * g.gsB * 2 + (size_t)nxt.pn * tstepB : cB;
        for (int t = 0; t < nt; t += 2) {
            const bool last = (t == nt - 2);
            const char* a1 = cA + (size_t)(t + 1) * kstep;
            const char* a2 = last ? nA : cA + (size_t)(t + 2) * kstep; const char* b2 = last ? nB : cB + (size_t)(t + 2) * kstep;
            const char* a3 = a2 + kstep; const char* b3 = b2 + kstep;
            if (last && has_next) S.a_ready(nxt);
            if constexpr (SP2) {
            PG8_LDB(B0, 0, 0); PG8_LDB(B1, 0, 1); PG8_SCHED; PG8_LDA(At, 0, 0); PG8_STAGE(PG8_SA(1, 1), a1 + hstepA, voffA);
            PG8_WAIT_V(8); PG8_WAIT_L(0); PG8_BAR; PG8_MMA(0, 0, At, B0); PG8_MMA(0, 1, At, B1); PG8_BAR; PG8_SCHED;
            PG8_LDA(At, 0, 1); PG8_STAGE(PG8_SB(0, 0), b2, voffB); PG8_STAGE(PG8_SB(0, 1), b2 + hstepB, voffB); PG8_STAGE(PG8_SA(0, 0), a2, voffA);
            PG8_WAIT_V(8); PG8_WAIT_L(0); PG8_BAR; PG8_MMA(1, 0, At, B0); PG8_MMA(1, 1, At, B1); PG8_BAR; PG8_SCHED;
            PG8_LDB(B0, 1, 0); PG8_LDB(B1, 1, 1); PG8_SCHED; PG8_LDA(At, 1, 0); PG8_STAGE(PG8_SA(0, 1), a2 + hstepA, voffA);
            PG8_WAIT_V(8); PG8_WAIT_L(0); PG8_BAR; PG8_MMA(0, 0, At, B0); PG8_MMA(0, 1, At, B1); PG8_BAR; PG8_SCHED;
            PG8_LDA(At, 1, 1); PG8_STAGE(PG8_SB(1, 0), b3, voffB); PG8_STAGE(PG8_SB(1, 1), b3 + hstepB, voffB); PG8_STAGE(PG8_SA(1, 0), a3, voffA);
            PG8_WAIT_V(8); PG8_WAIT_L(0); PG8_BAR; PG8_MMA(1, 0, At, B0); PG8_MMA(1, 1, At, B1); PG8_BAR; PG8_SCHED;
            } else {
            PG8_LDB(B0, 0, 0); PG8_SCHED; PG8_LDA(At, 0, 0); PG8_STAGE(PG8_SA(1, 1), a1 + hstepA, voffA);
            PG8_WAIT_L(8); PG8_BAR; PG8_WAIT_L(0); PG8_MMA(0, 0, At, B0); PG8_BAR; PG8_SCHED;
            PG8_LDB(B1, 0, 1); PG8_STAGE(PG8_SB(0, 0), b2, voffB);
            PG8_BAR; PG8_WAIT_L(0); PG8_MMA(0, 1, At, B1); PG8_BAR;
            PG8_LDA(At, 0, 1); PG8_STAGE(PG8_SA(0, 0), a2, voffA);
            PG8_BAR; PG8_WAIT_L(0); PG8_MMA(1, 0, At, B0); PG8_BAR; PG8_SCHED;
            PG8_STAGE(PG8_SB(0, 1), b2 + hstepB, voffB);
            PG8_WAIT_V(6); PG8_BAR; PG8_MMA(1, 1, At, B1); PG8_BAR;
            PG8_LDB(B0, 1, 0); PG8_SCHED; PG8_LDA(At, 1, 0); PG8_STAGE(PG8_SA(0, 1), a2 + hstepA, voffA);
            PG8_WAIT_L(8); PG8_BAR; PG8_WAIT_L(0); PG8_MMA(0, 0, At, B0); PG8_BAR; PG8_SCHED;
            PG8_LDB(B1, 1, 1); PG8_STAGE(PG8_SB(1, 0), b3, voffB);
            PG8_BAR; PG8_WAIT_L(0); PG8_MMA(0, 1, At, B1); PG8_BAR;
            PG8_LDA(At, 1, 1); PG8_STAGE(PG8_SA(1, 0), a3, voffA);
            PG8_BAR; PG8_WAIT_L(0); PG8_MMA(1, 0, At, B0); PG8_BAR; PG8_SCHED;
            PG8_STAGE(PG8_SB(1, 1), b3 + hstepB, voffB);
            PG8_WAIT_V(6); PG8_BAR; PG8_MMA(1, 1, At, B1); PG8_BAR;
            }
        }
        if constexpr (ALIGN_EPI) { if (wr == 0) PG8_BAR; }
        if constexpr (!Epi::AFTER_DRAIN) { E(acc, cur, wr, wc, fr, fq); S.done(cur); }
        if (!has_next) break;
#pragma unroll
        for (int a = 0; a < 2; ++a)
#pragma unroll
            for (int b = 0; b < 2; ++b)
#pragma unroll
                for (int m = 0; m < 4; ++m)
#pragma unroll
                    for (int n = 0; n < 2; ++n) acc[a][b][m][n] = (f32x4){0.f, 0.f, 0.f, 0.f};
        cur = nxt; cA = nA; cB = nB; ++ui;
        if constexpr (ALIGN_EPI) { if (wr == 1) PG8_BAR; }
    }
    PG8_WAIT_V(0);
    if constexpr (!ALIGN_EPI) { if (wr == 0) PG8_BAR; }
    PG8_BAR;
    if constexpr (Epi::AFTER_DRAIN) { E.fused(acc, cur, wr, wc, fr, fq, lds, wid, lane); S.done(cur); }
#undef PG8_SA
#undef PG8_SB
#undef PG8_STAGE
#undef PG8_LDA
#undef PG8_LDB
#undef PG8_MMA
#undef PG8_WAIT_V
#undef PG8_WAIT_L
#undef PG8_BAR
#undef PG8_SCHED
}
}
#include <hip/hip_bf16.h>
#include <cmath>
namespace attn_body {
using bf16=__hip_bfloat16;
using bf16x8=__attribute__((ext_vector_type(8)))short;
using s16x4=__attribute__((ext_vector_type(4)))short;
using f32x16=__attribute__((ext_vector_type(16)))float;
using u32x4=__attribute__((ext_vector_type(4)))unsigned;
using f32x4=__attribute__((ext_vector_type(4)))float;
constexpr int BATCH=4,NHEAD=8,SEQ=4096,D=64,DM=NHEAD*D,OPITCH=1024;
constexpr int NW=8,QBLK=32,QB=QBLK*NW,KVBLK=64,NQB=SEQ/QB;
constexpr int ATTN_PITCH=DM, ATTN_UNIT_ROWS=QB;
__device__ __forceinline__ int crow(int r,int hi){return (r&3)+8*(r>>2)+4*hi;}
#define SBAR() __builtin_amdgcn_sched_barrier(0)
__device__ __forceinline__ void cmask(f32x16&p0,f32x16&p1,int jb,int qrel,int hi){
  const float NEG=-INFINITY; int kb=64*jb+4*hi;
  #pragma unroll
  for(int r=0;r<16;++r){int kv=kb+(r&3)+8*(r>>2); if(kv>qrel)p0[r]=NEG; if(kv+32>qrel)p1[r]=NEG;}
}

constexpr int NSLOT=3, SLOTB=8192;
constexpr int LDS_K=0, LDS_V=NSLOT*SLOTB, LDS_WS=2*NSLOT*SLOTB, LDS_OST=LDS_WS+NW*64*4, LDS_CB=LDS_OST+NW*4096, LDS_BYTES=LDS_CB+SEQ*4;
constexpr float C2=0.125f*1.4426950408889634f;
__device__ __forceinline__ void glds16(const void*gsrc,unsigned lds_dst){unsigned keep;
  asm volatile("s_mov_b32 %0, m0\n\ts_mov_b32 m0, %2\n\ts_nop 0\n\tglobal_load_lds_dwordx4 %1, off\n\ts_mov_b32 m0, %0":"=&s"(keep):"v"(gsrc),"s"(lds_dst):"memory");}
__device__ __forceinline__ float max3f(float a,float b,float c){float r;asm("v_max3_f32 %0, %1, %2, %3":"=v"(r):"v"(a),"v"(b),"v"(c));return r;}
__device__ __forceinline__ float max2f(float a,float b){float r;asm("v_max_f32_e32 %0, %1, %2":"=v"(r):"v"(a),"v"(b));return r;}
__device__ __forceinline__ float fadd_s(float a,float b){float r;asm("v_add_f32_e32 %0, %1, %2":"=v"(r):"v"(a),"v"(b));return r;}
__device__ __forceinline__ float fsub_s(float a,float b){float r;asm("v_sub_f32_e32 %0, %1, %2":"=v"(r):"v"(a),"v"(b));return r;}
typedef float f32x2_t __attribute__((ext_vector_type(2))); typedef __bf16 bf16x2_t __attribute__((ext_vector_type(2)));
__device__ __forceinline__ unsigned cvtpk_s(float lo,float hi){f32x2_t v={lo,hi};bf16x2_t b=__builtin_convertvector(v,bf16x2_t);return __builtin_bit_cast(unsigned,b);}
#define WAIT_BAR(N) asm volatile("s_waitcnt vmcnt(" #N ") lgkmcnt(0)\n\ts_barrier":::"memory")

__device__ __forceinline__ void qkt(f32x16&p0,f32x16&p1,const char*Kslot,const bf16x8*qr,const char*cbt,int r32,int hi){
  const char*kb=Kslot+hi*1024+r32*16;
  #pragma unroll
  for(int a=0;a<4;++a){ const f32x4 u0=*reinterpret_cast<const f32x4*>(cbt+hi*16+a*32), u1=*reinterpret_cast<const f32x4*>(cbt+128+hi*16+a*32);
    p0[4*a]=u0[0];p0[4*a+1]=u0[1];p0[4*a+2]=u0[2];p0[4*a+3]=u0[3]; p1[4*a]=u1[0];p1[4*a+1]=u1[1];p1[4*a+2]=u1[2];p1[4*a+3]=u1[3]; }
  #pragma unroll
  for(int d0=0;d0<4;++d0){
    const bf16x8 b0=*reinterpret_cast<const bf16x8*>(kb+d0*2048);
    const bf16x8 b1=*reinterpret_cast<const bf16x8*>(kb+d0*2048+512);
    p0=__builtin_amdgcn_mfma_f32_32x32x16_bf16(b0,qr[d0],p0,0,0,0);p1=__builtin_amdgcn_mfma_f32_32x32x16_bf16(b1,qr[d0],p1,0,0,0);}
}
typedef __attribute__((address_space(3))) const char* lds_cptr;
typedef short v4i16_t __attribute__((ext_vector_type(4)));
__device__ __forceinline__ void kload8(bf16x8*kf,lds_cptr kp){
  kf[0]=*(const __attribute__((address_space(3))) bf16x8*)(kp);      kf[1]=*(const __attribute__((address_space(3))) bf16x8*)(kp+512);
  kf[2]=*(const __attribute__((address_space(3))) bf16x8*)(kp+2048); kf[3]=*(const __attribute__((address_space(3))) bf16x8*)(kp+2560);
  kf[4]=*(const __attribute__((address_space(3))) bf16x8*)(kp+4096); kf[5]=*(const __attribute__((address_space(3))) bf16x8*)(kp+4608);
  kf[6]=*(const __attribute__((address_space(3))) bf16x8*)(kp+6144); kf[7]=*(const __attribute__((address_space(3))) bf16x8*)(kp+6656);
}
__device__ __forceinline__ void kload2(bf16x8*kf,lds_cptr kp,int j){ kf[2*j]=*(const __attribute__((address_space(3))) bf16x8*)(kp+j*2048); kf[2*j+1]=*(const __attribute__((address_space(3))) bf16x8*)(kp+j*2048+512); }
__device__ __forceinline__ s16x4 vtr(lds_cptr p){ return __builtin_bit_cast(s16x4,__builtin_amdgcn_ds_read_tr16_b64_v4i16((__attribute__((address_space(3))) v4i16_t*)p)); }
__device__ __forceinline__ float rowmax(const f32x16&p0,const f32x16&p1){
  float a=max3f(p0[0],p0[1],p1[0]),b=max3f(p0[2],p0[3],p1[1]);a=max3f(a,p1[2],p1[3]);
  #pragma unroll
  for(int r=4;r<16;r+=4){a=max3f(a,p0[r],p0[r+1]);b=max3f(b,p0[r+2],p0[r+3]);a=max3f(a,p1[r],p1[r+1]);b=max3f(b,p1[r+2],p1[r+3]);}
  const float m=max2f(a,b);
  auto rr=__builtin_amdgcn_permlane32_swap(__float_as_uint(m),__float_as_uint(m),false,false);
  return max2f(__uint_as_float(rr[0]),__uint_as_float(rr[1]));
}
__device__ __forceinline__ void pv(f32x16*o,int vb,bf16x8 pa0,bf16x8 pa1,bf16x8 pa2,bf16x8 pa3){
  #pragma unroll
  for(int d0=0;d0<2;++d0){s16x4 lo[4],hi[4];
    #pragma unroll
    for(int ks=0;ks<4;++ks){
      asm volatile("ds_read_b64_tr_b16 %0,%1 offset:%c2":"=&v"(lo[ks]):"v"(vb),"i"(d0*4096+ks*1024):"memory");
      asm volatile("ds_read_b64_tr_b16 %0,%1 offset:%c2":"=&v"(hi[ks]):"v"(vb),"i"(d0*4096+ks*1024+512):"memory");}
    asm volatile("s_waitcnt lgkmcnt(0)":::"memory");SBAR();
    #define PK(k) (bf16x8){lo[k][0],lo[k][1],lo[k][2],lo[k][3],hi[k][0],hi[k][1],hi[k][2],hi[k][3]}
    o[d0]=__builtin_amdgcn_mfma_f32_32x32x16_bf16(pa0,PK(0),o[d0],0,0,0);
    o[d0]=__builtin_amdgcn_mfma_f32_32x32x16_bf16(pa1,PK(1),o[d0],0,0,0);
    o[d0]=__builtin_amdgcn_mfma_f32_32x32x16_bf16(pa2,PK(2),o[d0],0,0,0);
    o[d0]=__builtin_amdgcn_mfma_f32_32x32x16_bf16(pa3,PK(3),o[d0],0,0,0);
    #undef PK
  }
}

#ifndef ATTN_STORE16
#define ATTN_STORE16(p,v) (*(u32x4*)(p)=(v))
#endif
template<int THRL> __device__ __forceinline__ void attn_unit(int b,int h,int qb,const bf16*Q,const bf16*__restrict__ K,const bf16*__restrict__ V,bf16*O,const float*__restrict__ CB,const float*__restrict__ NRM,char*shm,bool dry=false){
  int tid_=threadIdx.x; asm volatile("":"+v"(tid_)); const int tid=tid_,lane=tid&63,r32=lane&31,hi=lane>>5; const int wid=__builtin_amdgcn_readfirstlane(tid>>6);
  const long rowbase=(long)b*SEQ; const int q0=qb*QB;
  int t0;
  { const f32x4* cbg=reinterpret_cast<const f32x4*>(CB+(long)(b*NHEAD+h)*SEQ); f32x4* cbl=reinterpret_cast<f32x4*>(shm+LDS_CB); const int nv=(q0+QB)/4;
    for(int i=tid;i<nv;i+=NW*64) cbl[i]=cbg[i];
    const float bnd=NRM[b*NHEAD+h]+36.f;
    asm volatile("s_waitcnt vmcnt(0) lgkmcnt(0)\n\ts_barrier":::"memory");
    const float*cbf=reinterpret_cast<const float*>(shm+LDS_CB); const int tc=2*lane; const int NT0=(q0+QB)/KVBLK;
    const bool ok=(tc<=NT0-4)&&(tc==0||cbf[64*tc-1]+bnd<=cbf[q0]);
    const unsigned long long mk=__ballot(ok); t0=2*(__popcll(mk)-1); t0=__builtin_amdgcn_readfirstlane(t0); }
  const bf16*Qw=Q+(rowbase+q0+wid*QBLK)*DM+h*D;
  const bf16*Kh=K+(rowbase+(long)t0*KVBLK)*DM+h*D,*Vh=V+(rowbase+(long)t0*KVBLK)*DM+h*D;
  const unsigned lds0=(unsigned)(uintptr_t)shm;
  float*wsf=(float*)(shm+LDS_WS)+wid*64;
  const bf16*ksrc=Kh+(long)lane*DM+wid*8;
  const bf16*vsrc=Vh+(long)(16*(wid&3)+(lane>>2))*DM+(wid>>2)*32+(lane&3)*8;
  const unsigned kdst=lds0+LDS_K+wid*1024, vdst=lds0+LDS_V+wid*1024;
  #define DMA_K(t,slot) glds16(ksrc+(long)(t)*KVBLK*DM,(unsigned)__builtin_amdgcn_readfirstlane(kdst+(slot)))
  #define DMA_V(t,slot) glds16(vsrc+(long)(t)*KVBLK*DM,(unsigned)__builtin_amdgcn_readfirstlane(vdst+(slot)))
  const int vb0=(int)(lds0+LDS_V)+((lane>>4)&1)*32+(lane&3)*8+(4*hi+((lane&15)>>2))*64;
  const char*Kbase=shm+LDS_K; bf16x8 kf[8];
  const lds_cptr shm3=(lds_cptr)shm; const lds_cptr kp0=shm3+LDS_K+hi*1024+r32*16; const lds_cptr vp0=shm3+LDS_V+((lane>>4)&1)*32+(lane&3)*8+(4*hi+((lane&15)>>2))*64;
  const int NT=(q0+QB)/KVBLK-t0;
  const lds_cptr cb3=(lds_cptr)shm+LDS_CB+t0*256;
  const float cb_own=*(const __attribute__((address_space(3))) float*)((lds_cptr)shm+LDS_CB+(q0+wid*QBLK+r32)*4);
  DMA_K(0,0);DMA_V(0,0);DMA_K(1,SLOTB);
  bf16x8 qr[4];
  #pragma unroll
  for(int d0=0;d0<4;++d0)qr[d0]=*reinterpret_cast<const bf16x8*>(&Qw[(long)r32*DM+d0*16+hi*8]);
  float mhat=0.f,l_reg=0.f;f32x16 o[2];o[0]=f32x16{};o[1]=f32x16{};
  const int qrel=wid*QBLK+r32;
  #define CMASK(P0,P1,t) do{int jb_=(t)-(NT-4); if(jb_>=0)cmask(P0,P1,jb_,qrel,hi);}while(0)
  bool resc=false;
  #define START(P0,P1) do{ const float rm=max2f(rowmax(P0,P1),cb_own); resc=false; \
    { const float dl=rm; mhat=fadd_s(mhat,dl); \
      _Pragma("unroll") for(int r=0;r<16;++r){P0[r]=fsub_s(P0[r],dl);P1[r]=fsub_s(P1[r],dl);} } \
    _Pragma("unroll") for(int r=0;r<16;++r)P0[r]=__builtin_amdgcn_exp2f(P0[r]); }while(0)
  #define RESC() do{ if(resc){ asm volatile("s_waitcnt lgkmcnt(0)":::"memory"); \
      _Pragma("unroll") for(int d_=0;d_<2;++d_) _Pragma("unroll") for(int r=0;r<16;++r)o[d_][r]*=wsf[crow(r,hi)]; } }while(0)
  f32x16 pA0,pA1,pB0,pB1;
  int sl_prev=0,sl_cur=0,sl_next=SLOTB;
  #define ROT() do{sl_prev=sl_cur;sl_cur=sl_next;sl_next=(sl_next==(NSLOT-1)*SLOTB)?0:sl_next+SLOTB;}while(0)
  DMA_K(2,2*SLOTB);
  WAIT_BAR(3);
  qkt(pA0,pA1,Kbase,qr,shm+LDS_CB+t0*256,r32,hi);asm volatile("s_nop 15\n\ts_nop 7":"+v"(pA0),"+v"(pA1));CMASK(pA0,pA1,0);
  START(pA0,pA1);
  _Pragma("unroll") for(int r=0;r<16;++r)pA1[r]=__builtin_amdgcn_exp2f(pA1[r]);
  WAIT_BAR(0);
  DMA_K(3,0);DMA_V(1,SLOTB);
  ROT();
  kload8(kf,kp0+sl_cur);
  WAIT_BAR(2);
  s16x4 vlo[8],vhi[8]; u32x4 pw0,pw1,pw2,pw3;
  #define PKW(P,B) cvtpk_s(P[B],P[B+1])
  #define PAF(k) __builtin_bit_cast(bf16x8,pw##k)
  #define VFR(i) (bf16x8){vlo[i][0],vlo[i][1],vlo[i][2],vlo[i][3],vhi[i][0],vhi[i][1],vhi[i][2],vhi[i][3]}
  #define PIN(x) asm volatile("":"+v"(x))
  #define MX3(a,b,c) __builtin_fmaxf(__builtin_fmaxf((a),(b)),(c))
  #define GAPA(MF,A0,A1,A2,A3,W0,W1,PW) do{ MF; sacc+=A0; sacc+=A1; sacc+=A2; sacc+=A3; PIN(sacc); W0; W1; PIN(PW); SBAR(); }while(0)
  #define EX(v) __builtin_amdgcn_exp2f(v)
  #define GAPB(MF,X,B) do{ MF; X[B]=EX(X[B]); X[B+1]=EX(X[B+1]); X[B+2]=EX(X[B+2]); X[B+3]=EX(X[B+3]); PIN(X); SBAR(); }while(0)
  #define VRD(i) do{ vlo[i]=vtr(vp_+(((i)>>2)*4096+((i)&3)*1024)); vhi[i]=vtr(vp_+(((i)>>2)*4096+((i)&3)*1024+512)); }while(0)
  #define KRD(G,j) do{ if(G){ kload2(kf,kp0+sl_next,j); SBAR(); } }while(0)
  #define STEP(C0,C1,P0,P1,t,GK,GV,GL) do{ SBAR(); \
    const lds_cptr vp_=vp0+sl_prev; \
    VRD(0); SBAR(); float sacc=(P0[0]+P0[1]); \
    GAPA(C0=__builtin_amdgcn_mfma_f32_32x32x16_bf16(kf[0],qr[0],C0,0,0,0), P0[2],P0[3],P0[4],P0[5],     pw0[0]=PKW(P0,0), pw0[1]=PKW(P0,2), pw0); \
    VRD(4); SBAR(); GAPA(C1=__builtin_amdgcn_mfma_f32_32x32x16_bf16(kf[1],qr[0],C1,0,0,0), P0[6],P0[7],P0[8],P0[9],     pw0[2]=PKW(P0,4), pw0[3]=PKW(P0,6), pw0); \
    VRD(1); SBAR(); GAPA(C0=__builtin_amdgcn_mfma_f32_32x32x16_bf16(kf[2],qr[1],C0,0,0,0),   P0[10],P0[11],P0[12],P0[13], pw1[0]=PKW(P0,8), pw1[1]=PKW(P0,10), pw1); \
    VRD(5); SBAR(); GAPA(C1=__builtin_amdgcn_mfma_f32_32x32x16_bf16(kf[3],qr[1],C1,0,0,0),   P0[14],P0[15],P1[0],P1[1],   pw1[2]=PKW(P0,12),pw1[3]=PKW(P0,14), pw1); \
    VRD(2); SBAR(); GAPA(C0=__builtin_amdgcn_mfma_f32_32x32x16_bf16(kf[4],qr[2],C0,0,0,0),   P1[2],P1[3],P1[4],P1[5],     pw2[0]=PKW(P1,0), pw2[1]=PKW(P1,2), pw2); \
    VRD(6); SBAR(); GAPA(C1=__builtin_amdgcn_mfma_f32_32x32x16_bf16(kf[5],qr[2],C1,0,0,0),   P1[6],P1[7],P1[8],P1[9],     pw2[2]=PKW(P1,4), pw2[3]=PKW(P1,6), pw2); \
    VRD(3); SBAR(); GAPA(C0=__builtin_amdgcn_mfma_f32_32x32x16_bf16(kf[6],qr[3],C0,0,0,0),   P1[10],P1[11],P1[12],P1[13], pw3[0]=PKW(P1,8), pw3[1]=PKW(P1,10), pw3); \
    VRD(7); SBAR(); GAPA(C1=__builtin_amdgcn_mfma_f32_32x32x16_bf16(kf[7],qr[3],C1,0,0,0),   P1[14],P1[15],0.f,0.f,       pw3[2]=PKW(P1,12),pw3[3]=PKW(P1,14), pw3); \
    l_reg+=sacc; \
    if(GK){DMA_K((t)+3,sl_cur);} if(GV){DMA_V((t)+1,sl_next);} \
    CMASK(C0,C1,t); \
    { float a=MX3(C0[0],C0[1],C1[0]),b=MX3(C0[2],C0[3],C1[1]); a=MX3(a,C1[2],C1[3]); \
      _Pragma("unroll") for(int r=4;r<16;r+=4){a=MX3(a,C0[r],C0[r+1]);b=MX3(b,C0[r+2],C0[r+3]);a=MX3(a,C1[r],C1[r+1]);b=MX3(b,C1[r+2],C1[r+3]);} \
      float rm=__builtin_fmaxf(a,b); { auto rr=__builtin_amdgcn_permlane32_swap(__float_as_uint(rm),__float_as_uint(rm),false,false); rm=__builtin_fmaxf(__uint_as_float(rr[0]),__uint_as_float(rr[1])); } \
      resc=false; \
      if(__builtin_expect(__any(rm>(float)THRL),0)){ const float dl=__builtin_fmaxf(rm,0.f); mhat+=dl; \
        _Pragma("unroll") for(int r=0;r<16;++r){C0[r]-=dl;C1[r]-=dl;} \
        const float f=__builtin_amdgcn_exp2f(-dl); l_reg*=f; if(hi==0)wsf[r32]=f; resc=true; } } \
    SBAR(); \
    { const __attribute__((address_space(3))) f32x4* cbp_=(const __attribute__((address_space(3))) f32x4*)(cb3+((t)+1)*256+hi*16); \
      _Pragma("unroll") for(int a_=0;a_<4;++a_){ const f32x4 u0_=cbp_[2*a_], u1_=cbp_[8+2*a_]; \
        P0[4*a_]=u0_[0];P0[4*a_+1]=u0_[1];P0[4*a_+2]=u0_[2];P0[4*a_+3]=u0_[3]; P1[4*a_]=u1_[0];P1[4*a_+1]=u1_[1];P1[4*a_+2]=u1_[2];P1[4*a_+3]=u1_[3]; } } SBAR(); \
    GAPB(o[0]=__builtin_amdgcn_mfma_f32_32x32x16_bf16(PAF(0),VFR(0),o[0],0,0,0), C0,0); \
    GAPB(o[1]=__builtin_amdgcn_mfma_f32_32x32x16_bf16(PAF(0),VFR(4),o[1],0,0,0), C0,4); \
    KRD(GL,0); GAPB(o[0]=__builtin_amdgcn_mfma_f32_32x32x16_bf16(PAF(1),VFR(1),o[0],0,0,0), C0,8); \
    KRD(GL,1); GAPB(o[1]=__builtin_amdgcn_mfma_f32_32x32x16_bf16(PAF(1),VFR(5),o[1],0,0,0), C0,12); \
    KRD(GL,2); GAPB(o[0]=__builtin_amdgcn_mfma_f32_32x32x16_bf16(PAF(2),VFR(2),o[0],0,0,0), C1,0); \
    KRD(GL,3); GAPB(o[1]=__builtin_amdgcn_mfma_f32_32x32x16_bf16(PAF(2),VFR(6),o[1],0,0,0), C1,4); \
    GAPB(o[0]=__builtin_amdgcn_mfma_f32_32x32x16_bf16(PAF(3),VFR(3),o[0],0,0,0), C1,8); \
    GAPB(o[1]=__builtin_amdgcn_mfma_f32_32x32x16_bf16(PAF(3),VFR(7),o[1],0,0,0), C1,12); \
    _Pragma("unroll") for(int r_=0;r_<16;++r_){P0[r_]-=mhat;P1[r_]-=mhat;} \
    }while(0)
  { const __attribute__((address_space(3))) f32x4* cbp_=(const __attribute__((address_space(3))) f32x4*)(cb3+256+hi*16);
    #pragma unroll
    for(int a_=0;a_<4;++a_){ const f32x4 u0_=cbp_[2*a_], u1_=cbp_[8+2*a_];
      pB0[4*a_]=u0_[0]-mhat;pB0[4*a_+1]=u0_[1]-mhat;pB0[4*a_+2]=u0_[2]-mhat;pB0[4*a_+3]=u0_[3]-mhat;
      pB1[4*a_]=u1_[0]-mhat;pB1[4*a_+1]=u1_[1]-mhat;pB1[4*a_+2]=u1_[2]-mhat;pB1[4*a_+3]=u1_[3]-mhat; } }
  int t=1;
  #undef CMASK
  #define CMASK(P0,P1,t) do{}while(0)
  for(;t+5<NT;t+=2){
    STEP(pB0,pB1,pA0,pA1,t,true,true,true);     WAIT_BAR(2); RESC(); ROT();
    STEP(pA0,pA1,pB0,pB1,t+1,true,true,true);   WAIT_BAR(2); RESC(); ROT();
  }
  #undef CMASK
  #define CMASK(P0,P1,t) do{int jb_=(t)-(NT-4); if(jb_>=0)cmask(P0,P1,jb_,qrel,hi);}while(0)
  #define ENDW(tt) do{ if((tt)+3<NT){WAIT_BAR(2);} else if((tt)+2<NT){WAIT_BAR(1);} else {WAIT_BAR(0);} }while(0)
  for(;t+1<NT;t+=2){
    STEP(pB0,pB1,pA0,pA1,t,(t+3<NT),(t+1<NT),(t+1<NT));       ENDW(t);   RESC(); ROT();
    STEP(pA0,pA1,pB0,pB1,t+1,(t+4<NT),(t+2<NT),(t+2<NT));     ENDW(t+1); RESC(); ROT();
  }
  STEP(pB0,pB1,pA0,pA1,NT-1,false,false,false); RESC();
  { float sacc=pB0[0]+pB0[1]; _Pragma("unroll") for(int r=2;r<16;++r)sacc+=pB0[r]; _Pragma("unroll") for(int r=0;r<16;++r)sacc+=pB1[r]; l_reg+=sacc;
    pw0=(u32x4){PKW(pB0,0),PKW(pB0,2),PKW(pB0,4),PKW(pB0,6)};pw1=(u32x4){PKW(pB0,8),PKW(pB0,10),PKW(pB0,12),PKW(pB0,14)};pw2=(u32x4){PKW(pB1,0),PKW(pB1,2),PKW(pB1,4),PKW(pB1,6)};pw3=(u32x4){PKW(pB1,8),PKW(pB1,10),PKW(pB1,12),PKW(pB1,14)};
    SBAR(); pv(o,vb0+sl_cur,PAF(0),PAF(1),PAF(2),PAF(3)); }
  #undef PKW
  #undef PAF
  #undef VFR
  #undef PIN
  #undef MX3
  #undef GAPA
  #undef GAPB
  #undef EX
  #undef VRD
  #undef KRD
  #undef STEP
  #undef ENDW
  {auto rr=__builtin_amdgcn_permlane32_swap(__float_as_uint(l_reg),__float_as_uint(l_reg),false,false);l_reg=__uint_as_float(rr[0])+__uint_as_float(rr[1]);}
  if(hi==0)wsf[32+r32]=l_reg;asm volatile("s_waitcnt lgkmcnt(0)":::"memory");
  float rli[16];
  #pragma unroll
  for(int r=0;r<16;++r)rli[r]=__builtin_amdgcn_rcpf(wsf[32+crow(r,hi)]);
  bf16*Ow=O+(rowbase+q0+wid*QBLK)*OPITCH+h*D;
  { bf16*stg=(bf16*)(shm+LDS_OST)+wid*2048;
    #pragma unroll
    for(int r=0;r<16;++r){const int orow=crow(r,hi);
      #pragma unroll
      for(int d0=0;d0<2;++d0)stg[orow*64+d0*32+r32]=__float2bfloat16(o[d0][r]*rli[r]);}
    asm volatile("s_waitcnt lgkmcnt(0)":::"memory");
    #pragma unroll
    for(int i=0;i<4;++i){const int row=i*8+(lane>>3),ch=lane&7; const u32x4 v=*(const u32x4*)(stg+row*64+ch*8); bf16*dst=Ow+(long)row*OPITCH+ch*8; const u32x4 gv=*(const u32x4*)dst; u32x4 w;
      #pragma unroll
      for(int j=0;j<4;++j){ const float a0=__uint_as_float(v[j]<<16)*__uint_as_float(gv[j]<<16), a1=__uint_as_float(v[j]&0xffff0000u)*__uint_as_float(gv[j]&0xffff0000u); w[j]=cvtpk_s(a0,a1); }
      if(!dry)*(u32x4*)dst=w;} }
  asm volatile("s_waitcnt lgkmcnt(0)\n\ts_barrier":::"memory");
  #undef DMA_K
  #undef DMA_V
  #undef CMASK
  #undef START
  #undef RESC
  #undef ROT
}
constexpr int ATTN_LDS_BYTES=LDS_BYTES;
struct AttnTensors { const bf16* Q; const bf16* K; const bf16* V; bf16* O; const float* CB; const float* NRM; };
struct AttnUnit { int bh; int qb; };
struct StaticOrder {
  int vcu;
  __device__ __forceinline__ explicit StaticOrder(int grid,int block):vcu((block%8)*(grid/8)+block/8){}
  __device__ __forceinline__ bool next(int i,AttnUnit&u)const{ if(i>=2)return false; const int s=vcu&7; u.bh=vcu>>3; u.qb=(i==0)?15-s:s; return true; }
  __device__ __forceinline__ void a_ready(const AttnUnit&)const{}
  __device__ __forceinline__ void done(const AttnUnit&)const{}
};
template<class Sched,int THRL=8> __device__ __forceinline__ void attn_phase(char*lds,const AttnTensors&T,const Sched&S,bool dry=false){
  AttnUnit u;
  for(int i=0;S.next(i,u);++i){ S.a_ready(u); attn_unit<THRL>(u.bh/NHEAD,u.bh%NHEAD,u.qb,T.Q,T.K,T.V,T.O,T.CB,T.NRM,lds,dry); S.done(u); }
}
#undef SBAR
#undef WAIT_BAR
}
#include <hip/hip_cooperative_groups.h>
namespace cg = cooperative_groups;
#define LAS __attribute__((address_space(3)))
typedef unsigned short bf16;
typedef float f32x4 __attribute__((ext_vector_type(4)));
typedef float f32x2 __attribute__((ext_vector_type(2)));
typedef unsigned u32x4 __attribute__((ext_vector_type(4)));
typedef unsigned u32x2 __attribute__((ext_vector_type(2)));
typedef short bf16x8 __attribute__((ext_vector_type(8)));
typedef short bf16x4 __attribute__((ext_vector_type(4)));

constexpr int NWAVES = 8, NTHR = 512;
constexpr int BATCH = 4, SEQ = 4096, DM = 1024, DEPTH = 4, M = BATCH * SEQ;
constexpr int NIN = 3592, NF = 3584;
constexpr int T5 = 32, NCH5 = M / T5, KA5 = 640, NG5 = 16;
constexpr float EPS = 1e-6f;
constexpr float LOG2E = 1.4426950408889634f;

constexpr size_t MiB = 1u << 20;
constexpr size_t WS_WIN = 1 * MiB, WS_WO = 31 * MiB, WS_WGLU = 39 * MiB, WS_ROPE = 40 * MiB, WS_MF = 41 * MiB, WS_WB = 81 * MiB;
constexpr size_t WS_LAM = 90 * MiB, WS_LOGF = 90 * MiB + 65536, WS_CB = WS_LOGF + 524288, WS_SS = WS_CB + 524288, WS_NRM = WS_SS + 131072, WS_XBUF = WS_NRM + 4096;
constexpr size_t WS_XN = 92 * MiB, WS_E = WS_XN, WS_UPD = WS_XN + 4 * MiB, WS_STATE = WS_XN + 20 * MiB;
constexpr size_t WS_QO = 124 * MiB, WS_KB = 140 * MiB, WS_VB = 156 * MiB, WS_SUA = 172 * MiB, WS_RQ = 182 * MiB, WS_RK = 190 * MiB, WS_RKT = 198 * MiB, WS_YS5 = WS_XN + 4 * MiB;
constexpr size_t WS_RVT = 206 * MiB, WS_GATE = 214 * MiB, WS_END = 246 * MiB;

constexpr int RING_BYTES = 131072, LDS_BYTES = 147456;

struct Args { const float* in[16]; float* out; unsigned char* ws; };

__device__ __forceinline__ float bf2f(unsigned short b) { return __uint_as_float((unsigned)b << 16); }
__device__ __forceinline__ float bflo(unsigned w) { return __uint_as_float(w << 16); }
__device__ __forceinline__ float bfhi(unsigned w) { return __uint_as_float(w & 0xffff0000u); }
__device__ __forceinline__ unsigned pk2(float lo, float hi) { return pg8::cvt_pk_bf16(lo, hi); }
__device__ __forceinline__ unsigned short f2bf(float f) { return (unsigned short)(pg8::cvt_pk_bf16(f, 0.f) & 0xffffu); }
__device__ __forceinline__ float wave_sum(float v) {
#pragma unroll
    for (int o = 1; o < 64; o <<= 1) v += __shfl_xor(v, o);
    return v;
}
__device__ __forceinline__ float lg2_gamma(int hh) { return __builtin_amdgcn_logf(1.0f - __builtin_amdgcn_exp2f(-5.0f - (float)hh)); }

__device__ __forceinline__ int win_col(int n) {
    if (n < 1536) return n;
    if (n < 1792) return n + 8;
    if (n < 2304) { const bool q = n < 2048; const int base = q ? 1792 : 2048; const int hh = (n - base) >> 6, pos = (n - base) & 63; const int d = (pos & 1) ? 32 + (pos >> 1) : (pos >> 1); return (q ? 1800 : 2056) + hh * 64 + d; }
    return n + 8;
}
template <bool MAP> __device__ __forceinline__ void p0_transpose_item(const float* W, int K, int Nsrc, int Ndst, bf16* WT, LAS float* scr, int item, int lane) {
    const int nblk = Ndst / 32, kb = item / nblk, nb = item % nblk, k0 = 64 * kb, n0 = 32 * nb;
    const int sc = MAP ? win_col(n0 + (lane & 31)) : n0 + (lane & 31);
    float wv[32];
#pragma unroll
    for (int i = 0; i < 32; ++i) { const int kk = 2 * i + (lane >> 5); wv[i] = (MAP && sc < 0) ? 0.f : W[(size_t)(k0 + kk) * Nsrc + (sc < 0 ? 0 : sc)]; }
#pragma unroll
    for (int i = 0; i < 32; ++i) { const int kk = 2 * i + (lane >> 5); scr[kk * 33 + (lane & 31)] = wv[i]; }
    asm volatile("s_waitcnt lgkmcnt(0)" ::: "memory");
    const int c = lane & 7;
#pragma unroll
    for (int j = 0; j < 4; ++j) { const int n = (lane >> 3) + 8 * j; const LAS float* s = scr + (8 * c) * 33 + n;
        u32x4 o; o.x = pk2(s[0 * 33], s[1 * 33]); o.y = pk2(s[2 * 33], s[3 * 33]); o.z = pk2(s[4 * 33], s[5 * 33]); o.w = pk2(s[6 * 33], s[7 * 33]);
        *(u32x4*)(WT + (size_t)(n0 + n) * K + k0 + 8 * c) = o; }
    asm volatile("s_waitcnt lgkmcnt(0)" ::: "memory");
}

__device__ __forceinline__ void s5_prep(const Args& a, int l, int g, LAS float* L, int tid) {
    LAS float* LPr = L;
    LAS float* LPi = L + 33 * 64;
    LAS float* Bbr = L + 66 * 64;
    LAS float* Bbi = Bbr + 1024;
    LAS float* Cr = Bbi + 1024;
    LAS float* Ci = Cr + 1024;
    LAS float* KT = Ci + 1024;
    const float* a_re = a.in[4] + (size_t)(l * 16 + g) * 64; const float* a_im = a.in[5] + (size_t)(l * 16 + g) * 64;
    const float* b_re = a.in[6] + (size_t)(l * 16 + g) * 1024; const float* b_im = a.in[7] + (size_t)(l * 16 + g) * 1024;
    const float* c_re = a.in[8] + (size_t)(l * 16 + g) * 1024; const float* c_im = a.in[9] + (size_t)(l * 16 + g) * 1024;
    const float log_dt = a.in[11][l * 16 + g];
    bf16* MF = (bf16*)(a.ws + WS_MF) + (size_t)(l * 16 + g) * 512 * KA5;
    bf16* WB = (bf16*)(a.ws + WS_WB) + (size_t)(l * 16 + g) * 128 * 512;
    float* LAM = (float*)(a.ws + WS_LAM) + (size_t)(l * 16 + g) * 128;
    if (tid < 64) {
        const int p = tid;
        const double dt = exp((double)log_dt), ar = (double)a_re[p], ai = (double)a_im[p];
        const double mag = exp(ar * dt); double sn, cs; sincos(ai * dt, &sn, &cs);
        const double lr = mag * cs, li = mag * sn, den = ar * ar + ai * ai;
        const double fr = ((lr - 1.0) * ar + li * ai) / den, fi = (li * ar - (lr - 1.0) * ai) / den;
#pragma unroll 4
        for (int h = 0; h < 16; ++h) { const double br = (double)b_re[p * 16 + h], bi = (double)b_im[p * 16 + h]; Bbr[p * 16 + h] = (float)(fr * br - fi * bi); Bbi[p * 16 + h] = (float)(fr * bi + fi * br); }
        double pr = 1.0, pi = 0.0;
        for (int j = 0; j <= 32; ++j) { LPr[j * 64 + p] = (float)pr; LPi[j * 64 + p] = (float)pi; const double nr = pr * lr - pi * li, ni = pr * li + pi * lr; pr = nr; pi = ni; }
        LAM[p] = LPr[32 * 64 + p]; LAM[64 + p] = LPi[32 * 64 + p];
    }
    for (int i = tid; i < 1024; i += NTHR) { const int h = i >> 6, p = i & 63; Cr[p * 16 + h] = c_re[i]; Ci[p * 16 + h] = c_im[i]; }
    __syncthreads();
    { const int j = tid >> 4, h = tid & 15; float acc[16];
#pragma unroll
      for (int e = 0; e < 16; ++e) acc[e] = 0.f;
      for (int p = 0; p < 64; ++p) { const float cr = Cr[p * 16 + h], ci = Ci[p * 16 + h], lr = LPr[j * 64 + p], li = LPi[j * 64 + p]; const float clr = cr * lr - ci * li, cli = cr * li + ci * lr;
#pragma unroll
          for (int q = 0; q < 4; ++q) { const f32x4 br = *(const LAS f32x4*)(Bbr + p * 16 + 4 * q), bi = *(const LAS f32x4*)(Bbi + p * 16 + 4 * q);
              acc[4 * q] += clr * br.x - cli * bi.x; acc[4 * q + 1] += clr * br.y - cli * bi.y; acc[4 * q + 2] += clr * br.z - cli * bi.z; acc[4 * q + 3] += clr * br.w - cli * bi.w; } }
#pragma unroll
      for (int e = 0; e < 16; ++e) KT[tid * 16 + e] = acc[e]; }
    __syncthreads();
    for (int q = tid; q < 512 * 64; q += NTHR) {
        const int row = q >> 6, cp = q & 63, s = cp >> 1, h0 = (cp & 1) * 8, t = row >> 4, h = row & 15;
        u32x4 o = (u32x4){0u, 0u, 0u, 0u};
        if (s <= t) { const LAS float* k = KT + ((t - s) * 16 + h) * 16 + h0; o.x = pk2(k[0], k[1]); o.y = pk2(k[2], k[3]); o.z = pk2(k[4], k[5]); o.w = pk2(k[6], k[7]); }
        *(u32x4*)(MF + (size_t)row * KA5 + cp * 8) = o;
    }
    for (int q = tid; q < 512 * 16; q += NTHR) {
        const int row = q >> 4, cp = q & 15, t = row >> 4, h = row & 15; float v[8];
#pragma unroll
        for (int e = 0; e < 8; ++e) { const int jj = cp * 8 + e, p = jj & 63; const float cr = Cr[p * 16 + h], ci = Ci[p * 16 + h], lr = LPr[(t + 1) * 64 + p], li = LPi[(t + 1) * 64 + p];
            v[e] = (jj < 64) ? (cr * lr - ci * li) : -(cr * li + ci * lr); }
        u32x4 o; o.x = pk2(v[0], v[1]); o.y = pk2(v[2], v[3]); o.z = pk2(v[4], v[5]); o.w = pk2(v[6], v[7]);
        *(u32x4*)(MF + (size_t)row * KA5 + 512 + cp * 8) = o;
    }
    for (int q = tid; q < 128 * 64; q += NTHR) {
        const int j = q >> 6, cp = q & 63, s = cp >> 1, h0 = (cp & 1) * 8, p = j & 63; const float lr = LPr[(31 - s) * 64 + p], li = LPi[(31 - s) * 64 + p]; float v[8];
#pragma unroll
        for (int e = 0; e < 8; ++e) { const float br = Bbr[p * 16 + h0 + e], bi = Bbi[p * 16 + h0 + e]; v[e] = (j < 64) ? (lr * br - li * bi) : (lr * bi + li * br); }
        u32x4 o; o.x = pk2(v[0], v[1]); o.y = pk2(v[2], v[3]); o.z = pk2(v[4], v[5]); o.w = pk2(v[6], v[7]);
        *(u32x4*)(WB + (size_t)j * 512 + cp * 8) = o;
    }
    __syncthreads();
}

__device__ __forceinline__ void norm0_phase(const Args& a, int lane, int gw, int NGW) {
    const float* X = a.in[0]; f32x4 gv[4];
#pragma unroll
    for (int j = 0; j < 4; ++j) gv[j] = *((const f32x4*)a.in[1] + lane + 64 * j);
    bf16* XN = (bf16*)(a.ws + WS_XN); float* SS = (float*)(a.ws + WS_SS);
    for (int m = gw; m < M; m += 2 * NGW) {
        const int m2 = m + NGW; const bool has2 = m2 < M;
        const f32x4* xr = (const f32x4*)(X + (size_t)m * DM) + lane; const f32x4* xr2 = (const f32x4*)(X + (size_t)(has2 ? m2 : m) * DM) + lane; f32x4 v[4], w[4];
#pragma unroll
        for (int j = 0; j < 4; ++j) { v[j] = xr[64 * j]; w[j] = xr2[64 * j]; }
        float ss = 0.f, ss2 = 0.f;
#pragma unroll
        for (int j = 0; j < 4; ++j) { ss += (v[j].x * v[j].x + v[j].y * v[j].y) + (v[j].z * v[j].z + v[j].w * v[j].w); ss2 += (w[j].x * w[j].x + w[j].y * w[j].y) + (w[j].z * w[j].z + w[j].w * w[j].w); }
        ss = wave_sum(ss); ss2 = wave_sum(ss2);
        unsigned long long* o8 = (unsigned long long*)(XN + (size_t)m * DM) + lane; unsigned long long* o82 = (unsigned long long*)(XN + (size_t)m2 * DM) + lane;
        const float r1_ = rsqrtf(ss * (1.f / DM) + EPS), r2_ = rsqrtf(ss2 * (1.f / DM) + EPS);
#pragma unroll
        for (int j = 0; j < 4; ++j) { v[j] = v[j] * gv[j] * r1_; o8[64 * j] = (unsigned long long)pk2(v[j].x, v[j].y) | ((unsigned long long)pk2(v[j].z, v[j].w) << 32);
            if (has2) { w[j] = w[j] * gv[j] * r2_; o82[64 * j] = (unsigned long long)pk2(w[j].x, w[j].y) | ((unsigned long long)pk2(w[j].z, w[j].w) << 32); } }
        if (lane == 0) { SS[m] = ss; if (has2) SS[m2] = ss2; }
    }
}
__device__ __forceinline__ void final_norm(const Args& a, float* X, const float* SS, int lane, int gw, int NGW) {
    f32x4 gv[4];
#pragma unroll
    for (int j = 0; j < 4; ++j) gv[j] = *((const f32x4*)a.in[15] + lane + 64 * j);
    for (int m = gw; m < M; m += 2 * NGW) {
        const int m2 = m + NGW; const bool has2 = m2 < M;
        f32x4* xr = (f32x4*)(X + (size_t)m * DM) + lane; f32x4* xr2 = (f32x4*)(X + (size_t)(has2 ? m2 : m) * DM) + lane; f32x4 v[4], w[4];
#pragma unroll
        for (int j = 0; j < 4; ++j) { v[j] = xr[64 * j]; w[j] = xr2[64 * j]; }
        const float r1 = rsqrtf(SS[m] * (1.f / DM) + EPS), r2 = rsqrtf(SS[has2 ? m2 : m] * (1.f / DM) + EPS);
#pragma unroll
        for (int j = 0; j < 4; ++j) { xr[64 * j] = v[j] * r1 * gv[j]; if (has2) xr2[64 * j] = w[j] * r2 * gv[j]; }
    }
}

__device__ __forceinline__ void flog_phase(const Args& a, int l, const float* SS, LAS float* WF, int tid, int lane, int wave, int blk, int nblk) {
    const float* win = a.in[2] + (size_t)l * DM * NIN;
    for (int i = tid; i < 2048; i += NTHR) { const int k = i >> 1, hf = i & 1; *(LAS f32x4*)(WF + k * 8 + hf * 4) = *(const f32x4*)(win + (size_t)k * NIN + 1536 + hf * 4); }
    __syncthreads();
    const bf16* XN = (const bf16*)(a.ws + WS_XN); float* LOGF = (float*)(a.ws + WS_LOGF);
    const float bfj = (lane < 8) ? a.in[3][l * 8 + lane] : 0.f;
    const int rows_per = M / nblk;
    for (int i = wave; i < rows_per; i += 2 * NWAVES) {
        const int m = blk * rows_per + i, m2 = m + NWAVES; const bool has2 = (i + NWAVES) < rows_per;
        const u32x4 x0 = *((const u32x4*)(XN + (size_t)m * DM) + lane), x1 = *((const u32x4*)(XN + (size_t)m * DM + 512) + lane);
        const u32x4 y0 = *((const u32x4*)(XN + (size_t)(has2 ? m2 : m) * DM) + lane), y1 = *((const u32x4*)(XN + (size_t)(has2 ? m2 : m) * DM + 512) + lane);
        float acc[8], acc2[8];
#pragma unroll
        for (int e = 0; e < 8; ++e) { acc[e] = 0.f; acc2[e] = 0.f; }
#pragma unroll
        for (int hf = 0; hf < 2; ++hf)
#pragma unroll
            for (int q = 0; q < 8; ++q) { const int k = 512 * hf + 8 * lane + q; const f32x4 w0 = *(const LAS f32x4*)(WF + k * 8), w1 = *(const LAS f32x4*)(WF + k * 8 + 4);
                const unsigned xw = hf ? x1[q >> 1] : x0[q >> 1], yw = hf ? y1[q >> 1] : y0[q >> 1]; const float hv = (q & 1) ? bfhi(xw) : bflo(xw), hv2 = (q & 1) ? bfhi(yw) : bflo(yw);
                acc[0] += hv * w0.x; acc[1] += hv * w0.y; acc[2] += hv * w0.z; acc[3] += hv * w0.w; acc[4] += hv * w1.x; acc[5] += hv * w1.y; acc[6] += hv * w1.z; acc[7] += hv * w1.w;
                acc2[0] += hv2 * w0.x; acc2[1] += hv2 * w0.y; acc2[2] += hv2 * w0.z; acc2[3] += hv2 * w0.w; acc2[4] += hv2 * w1.x; acc2[5] += hv2 * w1.y; acc2[6] += hv2 * w1.z; acc2[7] += hv2 * w1.w; }
        float mine = 0.f, mine2 = 0.f;
#pragma unroll
        for (int e = 0; e < 8; ++e) { const float s = wave_sum(acc[e]), s2 = wave_sum(acc2[e]); if (lane == e) { mine = s; mine2 = s2; } }
        if (lane < 8) { const float z = mine + bfj; LOGF[(size_t)((m >> 12) * 8 + lane) * SEQ + (m & 4095)] = fminf(z, 0.f) - log1pf(expf(-fabsf(z)));
            if (has2) { const float z2 = mine2 + bfj; LOGF[(size_t)((m2 >> 12) * 8 + lane) * SEQ + (m2 & 4095)] = fminf(z2, 0.f) - log1pf(expf(-fabsf(z2))); } }
    }
}

__device__ __forceinline__ bool opaque_true() { int d = 1; asm volatile("" : "+s"(d)); return d != 0; }
struct RangeOrder {
    pg8::StaticOrder S; int lo, hi;
    __device__ bool next(int i, pg8::Unit& u) const { return (lo + i < hi) ? S.next(lo + i, u) : false; }
    __device__ __forceinline__ void a_ready(const pg8::Unit&) const {}
    __device__ __forceinline__ void done(const pg8::Unit&) const {}
};
struct FlatOrder {
    int nM, nN, nG, G, c;
    __device__ bool next(int i, pg8::Unit& u) const { const int L = i * G + c; if (L >= nG * nM * nN) return false; u.gz = L / (nM * nN); const int r = L % (nM * nN); u.pm = r % nM; u.pn = r / nM; return true; }
    __device__ __forceinline__ void a_ready(const pg8::Unit&) const {}
    __device__ __forceinline__ void done(const pg8::Unit&) const {}
};
__device__ __forceinline__ float silu_f(float v) { return v * __builtin_amdgcn_rcpf(1.f + __expf(-v)); }
__device__ __forceinline__ float gelu_tanh(float v) { const float u = 0.7978845608028654f * (v + 0.044715f * v * v * v); const float e = __expf(2.f * u); const float th = 1.f - 2.f * __builtin_amdgcn_rcpf(e + 1.f); return 0.5f * v * (1.f + th); }

struct EpiInProj {
    static constexpr bool PERM = true, AFTER_DRAIN = false;
    unsigned char* ws; const float* SS; const float* bfl;
    __device__ __forceinline__ void operator()(const pg8::f32x4 (&acc)[2][2][4][2], const pg8::Unit& u, int wr, int wc, int fr, int fq) const {
        const int pn = u.pn; const int row0 = u.pm * 256 + wr * 64 + fr, cl0 = wc * 32 + 8 * fq;
        float rs[2][4];
#pragma unroll
        for (int ai = 0; ai < 2; ++ai)
#pragma unroll
            for (int m = 0; m < 4; ++m) rs[ai][m] = 1.f;
        if (pn == 14) {
            if (wc == 0 && fq == 0) { float* LOGF = (float*)(ws + WS_LOGF); const f32x4 b0 = *(const f32x4*)bfl, b1 = *(const f32x4*)(bfl + 4);
#pragma unroll
                for (int ai = 0; ai < 2; ++ai)
#pragma unroll
                    for (int m = 0; m < 4; ++m) { const int row = row0 + ai * 128 + m * 16; const float r = rs[ai][m]; const pg8::f32x4 v0 = acc[ai][0][m][0], v1 = acc[ai][0][m][1];
                        float z[8] = {v0[0] * r + b0.x, v0[1] * r + b0.y, v0[2] * r + b0.z, v0[3] * r + b0.w, v1[0] * r + b1.x, v1[1] * r + b1.y, v1[2] * r + b1.z, v1[3] * r + b1.w};
#pragma unroll
                        for (int e = 0; e < 8; ++e) LOGF[(size_t)((row >> 12) * 8 + e) * SEQ + (row & 4095)] = fminf(z[e], 0.f) - log1pf(__expf(-fabsf(z[e]))); } }
            return;
        }
        if (pn < 6) {
            bf16* base = (bf16*)(ws + (pn < 2 ? WS_QO : pn < 4 ? WS_KB : WS_VB)); const float sc = pn < 2 ? 0.125f * LOG2E : 1.f; const int cb = (pn & 1) * 256 + cl0;
#pragma unroll
            for (int ai = 0; ai < 2; ++ai)
#pragma unroll
                for (int m = 0; m < 4; ++m) { bf16* rp = base + (size_t)(row0 + ai * 128 + m * 16) * 512 + cb;
#pragma unroll
                    for (int bj = 0; bj < 2; ++bj) { const float sr = sc * rs[ai][m]; const pg8::f32x4 v0 = acc[ai][bj][m][0] * sr, v1 = acc[ai][bj][m][1] * sr; u32x4 w; w.x = pk2(v0[0], v0[1]); w.y = pk2(v0[2], v0[3]); w.z = pk2(v1[0], v1[1]); w.w = pk2(v1[2], v1[3]); *(u32x4*)(rp + bj * 128) = w; } }
        } else if (pn == 6) {
            bf16* base = (bf16*)(ws + WS_SUA);
#pragma unroll
            for (int ai = 0; ai < 2; ++ai)
#pragma unroll
                for (int m = 0; m < 4; ++m) { const int row = row0 + ai * 128 + m * 16, chunk = row >> 5, t = row & 31;
#pragma unroll
                    for (int bj = 0; bj < 2; ++bj) { const int c = cl0 + bj * 128, g = c >> 4, h0 = c & 15; const pg8::f32x4 v0 = acc[ai][bj][m][0] * rs[ai][m], v1 = acc[ai][bj][m][1] * rs[ai][m]; u32x4 w; w.x = pk2(v0[0], v0[1]); w.y = pk2(v0[2], v0[3]); w.z = pk2(v1[0], v1[1]); w.w = pk2(v1[2], v1[3]);
                        *(u32x4*)(base + ((size_t)(g * 512 + chunk) * KA5 + t * 16 + h0)) = w; } }
        } else if (pn == 7 || pn == 8) {
            const f32x4* rope = (const f32x4*)(ws + WS_ROPE); bf16* base = (bf16*)(ws + (pn == 7 ? WS_RQ : WS_RK)); bf16* RKT = (bf16*)(ws + WS_RKT);
#pragma unroll
            for (int ai = 0; ai < 2; ++ai)
#pragma unroll
                for (int m = 0; m < 4; ++m) { const int row = row0 + ai * 128 + m * 16, b = row >> 12, t = row & 4095;
#pragma unroll
                    for (int bj = 0; bj < 2; ++bj) { const int c = cl0 + bj * 128, hh = c >> 6, pos0 = c & 63; const pg8::f32x4 v0 = acc[ai][bj][m][0] * rs[ai][m], v1 = acc[ai][bj][m][1] * rs[ai][m];
                        const f32x4 r0 = rope[(t * 32 + (pos0 >> 1)) >> 1], r1 = rope[((t * 32 + (pos0 >> 1)) >> 1) + 1];
                        float o[8];
                        o[0] = v0[0] * r0.x - v0[1] * r0.y; o[1] = v0[0] * r0.y + v0[1] * r0.x; o[2] = v0[2] * r0.z - v0[3] * r0.w; o[3] = v0[2] * r0.w + v0[3] * r0.z;
                        o[4] = v1[0] * r1.x - v1[1] * r1.y; o[5] = v1[0] * r1.y + v1[1] * r1.x; o[6] = v1[2] * r1.z - v1[3] * r1.w; o[7] = v1[2] * r1.w + v1[3] * r1.z;
                        u32x4 w; w.x = pk2(o[0], o[1]); w.y = pk2(o[2], o[3]); w.z = pk2(o[4], o[5]); w.w = pk2(o[6], o[7]);
                        *(u32x4*)(base + (size_t)row * 256 + c) = w;
                        if (pn == 8) { const float wk = __builtin_amdgcn_exp2f(lg2_gamma(hh) * (float)(63 - (t & 63))); bf16* tp = RKT + ((size_t)((b * 4 + hh) * 64 + pos0)) * SEQ + t;
#pragma unroll
                            for (int e = 0; e < 8; ++e) tp[(size_t)e * SEQ] = f2bf(o[e] * wk); } } }
        } else if (pn == 9) {
            bf16* RVT = (bf16*)(ws + WS_RVT);
#pragma unroll
            for (int ai = 0; ai < 2; ++ai)
#pragma unroll
                for (int m = 0; m < 4; ++m) { const int row = row0 + ai * 128 + m * 16, b = row >> 12, t = row & 4095;
#pragma unroll
                    for (int bj = 0; bj < 2; ++bj) { const int c = cl0 + bj * 128, hh = c >> 6, d0 = c & 63; const pg8::f32x4 v0 = acc[ai][bj][m][0] * rs[ai][m], v1 = acc[ai][bj][m][1] * rs[ai][m]; bf16* tp = RVT + ((size_t)((b * 4 + hh) * 64 + d0)) * SEQ + t;
#pragma unroll
                        for (int e = 0; e < 4; ++e) { tp[(size_t)e * SEQ] = f2bf(v0[e]); tp[(size_t)(4 + e) * SEQ] = f2bf(v1[e]); } } }
        } else {
            bf16* base = (bf16*)(ws + WS_GATE); const int cb = (pn - 10) * 256 + cl0;
#pragma unroll
            for (int ai = 0; ai < 2; ++ai)
#pragma unroll
                for (int m = 0; m < 4; ++m) { bf16* rp = base + (size_t)(row0 + ai * 128 + m * 16) * 1024 + cb;
#pragma unroll
                    for (int bj = 0; bj < 2; ++bj) { const pg8::f32x4 v0 = acc[ai][bj][m][0] * rs[ai][m], v1 = acc[ai][bj][m][1] * rs[ai][m]; u32x4 w; w.x = pk2(silu_f(v0[0]), silu_f(v0[1])); w.y = pk2(silu_f(v0[2]), silu_f(v0[3])); w.z = pk2(silu_f(v1[0]), silu_f(v1[1])); w.w = pk2(silu_f(v1[2]), silu_f(v1[3])); *(u32x4*)(rp + bj * 128) = w; } }
        }
    }
};
struct EpiS5E {
    static constexpr bool PERM = false, AFTER_DRAIN = false;
    float* E;
    __device__ __forceinline__ void operator()(const pg8::f32x4 (&acc)[2][2][4][2], const pg8::Unit& u, int wr, int wc, int fr, int fq) const {
        const int row0 = u.pm * 256 + wr * 64 + fr, col0 = wc * 32 + 4 * fq;
#pragma unroll
        for (int ai = 0; ai < 2; ++ai)
#pragma unroll
            for (int m = 0; m < 4; ++m) { float* rp = E + ((size_t)u.gz * NCH5 + row0 + ai * 128 + m * 16) * 128 + col0;
#pragma unroll
                for (int n = 0; n < 2; ++n) *(pg8::f32x4*)(rp + n * 16) = acc[ai][0][m][n]; }
    }
};
struct EpiS5Y {
    static constexpr bool PERM = true, AFTER_DRAIN = false;
    const bf16* SUA; bf16* YS5; const float* dvec;
    __device__ __forceinline__ void operator()(const pg8::f32x4 (&acc)[2][2][4][2], const pg8::Unit& u, int wr, int wc, int fr, int fq) const {
        const int row0 = u.pm * 256 + wr * 64 + fr, cl0 = u.pn * 256 + wc * 32 + 8 * fq; const int g = u.gz;
#pragma unroll
        for (int bj = 0; bj < 2; ++bj) { const int c = cl0 + bj * 128, tt = c >> 4, h0 = c & 15; const f32x4 d0 = *(const f32x4*)(dvec + g * 16 + h0), d1 = *(const f32x4*)(dvec + g * 16 + h0 + 4);
#pragma unroll
            for (int ai = 0; ai < 2; ++ai)
#pragma unroll
                for (int m = 0; m < 4; ++m) { const int chunk = row0 + ai * 128 + m * 16; const u32x4 uu = *(const u32x4*)(SUA + ((size_t)(g * 512 + chunk) * KA5 + c)); const pg8::f32x4 v0 = acc[ai][bj][m][0], v1 = acc[ai][bj][m][1];
                    float y[8]; y[0] = v0[0] + d0.x * bflo(uu.x); y[1] = v0[1] + d0.y * bfhi(uu.x); y[2] = v0[2] + d0.z * bflo(uu.y); y[3] = v0[3] + d0.w * bfhi(uu.y);
                    y[4] = v1[0] + d1.x * bflo(uu.z); y[5] = v1[1] + d1.y * bfhi(uu.z); y[6] = v1[2] + d1.z * bflo(uu.w); y[7] = v1[3] + d1.w * bfhi(uu.w);
#pragma unroll
                    for (int e = 0; e < 8; ++e) y[e] = gelu_tanh(y[e]);
                    u32x4 w; w.x = pk2(y[0], y[1]); w.y = pk2(y[2], y[3]); w.z = pk2(y[4], y[5]); w.w = pk2(y[6], y[7]);
                    *(u32x4*)(YS5 + (size_t)(chunk * 32 + tt) * 256 + g * 16 + h0) = w; } }
    }
};
struct EpiGlu {
    static constexpr bool PERM = true, AFTER_DRAIN = false;
    const bf16* YS5; bf16* G; bool dry;
    __device__ __forceinline__ void operator()(const pg8::f32x4 (&acc)[2][2][4][2], const pg8::Unit& u, int wr, int wc, int fr, int fq) const {
        const int row0 = u.pm * 256 + wr * 64 + fr, cl0 = wc * 32 + 8 * fq;
#pragma unroll
        for (int ai = 0; ai < 2; ++ai)
#pragma unroll
            for (int m = 0; m < 4; ++m) { const int row = row0 + ai * 128 + m * 16;
#pragma unroll
                for (int bj = 0; bj < 2; ++bj) { const int c = cl0 + bj * 128; const u32x4 yy = *(const u32x4*)(YS5 + (size_t)row * 256 + c); bf16* gp = G + (size_t)row * 1024 + 512 + c; const u32x4 gg = *(const u32x4*)gp;
                    const pg8::f32x4 v0 = acc[ai][bj][m][0], v1 = acc[ai][bj][m][1]; float s[8];
#pragma unroll
                    for (int e = 0; e < 4; ++e) { s[e] = 1.f / (1.f + __expf(-v0[e])); s[4 + e] = 1.f / (1.f + __expf(-v1[e])); }
                    u32x4 w; w.x = pk2(bflo(yy.x) * s[0] * bflo(gg.x), bfhi(yy.x) * s[1] * bfhi(gg.x)); w.y = pk2(bflo(yy.y) * s[2] * bflo(gg.y), bfhi(yy.y) * s[3] * bfhi(gg.y));
                    w.z = pk2(bflo(yy.z) * s[4] * bflo(gg.z), bfhi(yy.z) * s[5] * bfhi(gg.z)); w.w = pk2(bflo(yy.w) * s[6] * bflo(gg.w), bfhi(yy.w) * s[7] * bfhi(gg.w));
                    if (!dry) *(u32x4*)gp = w; } }
    }
};
struct EpiOut {
    static constexpr bool PERM = false, AFTER_DRAIN = false;
    const float* base; float* out; float* SSn; bf16* XN; const float* gnext; bool dry;
    __device__ __forceinline__ void operator()(const pg8::f32x4 (&acc)[2][2][4][2], const pg8::Unit& u, int wr, int wc, int fr, int fq) const {
        const int row0 = u.pm * 256 + wr * 64 + fr, col0 = u.pn * 256 + wc * 32 + 4 * fq;
        f32x4 gq[2][2];
#pragma unroll
        for (int bj = 0; bj < 2; ++bj)
#pragma unroll
            for (int n = 0; n < 2; ++n) gq[bj][n] = gnext ? *(const f32x4*)(gnext + col0 + bj * 128 + n * 16) : (f32x4){0.f, 0.f, 0.f, 0.f};
#pragma unroll
        for (int ai = 0; ai < 2; ++ai)
#pragma unroll
            for (int m = 0; m < 4; ++m) { const int row = row0 + ai * 128 + m * 16; const size_t off = (size_t)row * DM + col0; float sq = 0.f;
#pragma unroll
                for (int bj = 0; bj < 2; ++bj)
#pragma unroll
                    for (int n = 0; n < 2; ++n) { const f32x4 bs = *(const f32x4*)(base + off + bj * 128 + n * 16); const pg8::f32x4 v = acc[ai][bj][m][n]; const f32x4 x = (f32x4){bs.x + v[0], bs.y + v[1], bs.z + v[2], bs.w + v[3]};
                        sq += (x.x * x.x + x.y * x.y) + (x.z * x.z + x.w * x.w);
                        if (!dry) { *(f32x4*)(out + off + bj * 128 + n * 16) = x;
                            if (gnext) { const f32x4 g = gq[bj][n]; u32x2 w; w.x = pk2(x.x * g.x, x.y * g.y); w.y = pk2(x.z * g.z, x.w * g.w); *(u32x2*)(XN + off + bj * 128 + n * 16) = w; } } }
                sq += __shfl_xor(sq, 16); sq += __shfl_xor(sq, 32);
                if (fq == 0 && !dry) __hip_atomic_fetch_add(SSn + row, sq, __ATOMIC_RELAXED, __HIP_MEMORY_SCOPE_AGENT); }
    }
};

template <bool FINAL> struct EpiOutX {
    static constexpr bool PERM = false, AFTER_DRAIN = true;
    const float* base; float* out; const float* wfin; float* xbuf; unsigned* cnt; bf16* XN; unsigned target;
    __device__ __forceinline__ void fused(pg8::f32x4 (&acc)[2][2][4][2], const pg8::Unit& u, int wr, int wc, int fr, int fq, PG8_LAS unsigned char* lds, int wid, int lane) const {
        PG8_LAS float* P = (PG8_LAS float*)lds;
        PG8_LAS float* S = (PG8_LAS float*)(lds + 4096);
        const int col0 = u.pn * 256 + wc * 32 + 4 * fq;
#pragma unroll
        for (int ai = 0; ai < 2; ++ai)
#pragma unroll
            for (int m = 0; m < 4; ++m) { const int r = ai * 128 + wr * 64 + m * 16 + fr; const size_t off = (size_t)(u.pm * 256 + r) * DM + col0; float sq = 0.f;
#pragma unroll
                for (int bj = 0; bj < 2; ++bj)
#pragma unroll
                    for (int n = 0; n < 2; ++n) { const f32x4 bs = *(const f32x4*)(base + off + bj * 128 + n * 16); pg8::f32x4 x = acc[ai][bj][m][n]; x[0] += bs.x; x[1] += bs.y; x[2] += bs.z; x[3] += bs.w; acc[ai][bj][m][n] = x;
                        sq += (x[0] * x[0] + x[1] * x[1]) + (x[2] * x[2] + x[3] * x[3]); }
                sq += __shfl_xor(sq, 16); sq += __shfl_xor(sq, 32);
                if (fq == 0) P[r * 4 + wc] = sq;
                asm volatile("" : "+v"(acc[ai][0][m][0]), "+v"(acc[ai][0][m][1]), "+v"(acc[ai][1][m][0]), "+v"(acc[ai][1][m][1]));
                if (m & 1) asm volatile("" ::: "memory"); }
        asm volatile("s_waitcnt lgkmcnt(0)" ::: "memory"); __builtin_amdgcn_s_barrier(); asm volatile("" ::: "memory");
        const int row = wid * 32 + (lane & 31);
        if (lane < 32) { const float tot = (P[row * 4 + 0] + P[row * 4 + 1]) + (P[row * 4 + 2] + P[row * 4 + 3]);
            __hip_atomic_store(xbuf + (size_t)(u.pm * 256 + row) * 4 + u.pn, tot, __ATOMIC_RELAXED, __HIP_MEMORY_SCOPE_AGENT); }
        asm volatile("s_waitcnt vmcnt(0)" ::: "memory");
        if (lane == 0) __hip_atomic_fetch_add(cnt + 64 * u.pm, 1u, __ATOMIC_RELAXED, __HIP_MEMORY_SCOPE_AGENT);
        if (wid == 0) {
            unsigned sp = 0u;
            while ((unsigned)__builtin_amdgcn_readfirstlane(__hip_atomic_load(cnt + 64 * u.pm, __ATOMIC_RELAXED, __HIP_MEMORY_SCOPE_AGENT)) < target) { __builtin_amdgcn_s_sleep(2); if (++sp > (1u << 20)) break; }
            __builtin_amdgcn_fence(__ATOMIC_ACQUIRE, "agent");
        }
        asm volatile("s_waitcnt vmcnt(0) lgkmcnt(0)" ::: "memory"); __builtin_amdgcn_s_barrier(); asm volatile("" ::: "memory");
        if (lane < 32) { const float* sl = xbuf + (size_t)(u.pm * 256 + row) * 4; float t = 0.f;
#pragma unroll
            for (int k = 0; k < 4; ++k) t += __hip_atomic_load(sl + k, __ATOMIC_RELAXED, __HIP_MEMORY_SCOPE_AGENT);
            S[row] = rsqrtf(t * (1.f / DM) + EPS); }
        asm volatile("s_waitcnt lgkmcnt(0)" ::: "memory"); __builtin_amdgcn_s_barrier(); asm volatile("" ::: "memory");
        f32x4 wq[2][2];
#pragma unroll
        for (int bj = 0; bj < 2; ++bj)
#pragma unroll
            for (int n = 0; n < 2; ++n) wq[bj][n] = *(const f32x4*)(wfin + col0 + bj * 128 + n * 16);
#pragma unroll
        for (int ai = 0; ai < 2; ++ai)
#pragma unroll
            for (int m = 0; m < 4; ++m) { const int r = ai * 128 + wr * 64 + m * 16 + fr; const float sr = S[r]; const size_t off = (size_t)(u.pm * 256 + r) * DM + col0;
#pragma unroll
                for (int bj = 0; bj < 2; ++bj)
#pragma unroll
                    for (int n = 0; n < 2; ++n) { const pg8::f32x4 x = acc[ai][bj][m][n]; const f32x4 g = wq[bj][n]; const f32x4 y = (f32x4){x[0] * sr * g.x, x[1] * sr * g.y, x[2] * sr * g.z, x[3] * sr * g.w};
                        if (FINAL) *(f32x4*)(out + off + bj * 128 + n * 16) = y;
                        else { *(f32x4*)(out + off + bj * 128 + n * 16) = (f32x4){x[0], x[1], x[2], x[3]}; u32x2 w; w.x = pk2(y.x, y.y); w.y = pk2(y.z, y.w); *(u32x2*)(XN + off + bj * 128 + n * 16) = w; } } }
    }
};

template <int KS, int UNR, class Epi> __device__ __forceinline__ void wave_gemm64(const bf16* A, int lda, const bf16* B, int ldb, int lane, const Epi& epi) {
    const int fr = lane & 15, fq = lane >> 4;
    pg8::f32x4 acc[4][4];
#pragma unroll
    for (int jb = 0; jb < 4; ++jb)
#pragma unroll
        for (int ib = 0; ib < 4; ++ib) acc[jb][ib] = (pg8::f32x4){0.f, 0.f, 0.f, 0.f};
    const bf16* ap = A + (size_t)fr * lda + 8 * fq; const bf16* bp = B + (size_t)fr * ldb + 8 * fq;
#pragma unroll UNR
    for (int ks = 0; ks < KS; ++ks) {
        bf16x8 af[4], bv[4];
#pragma unroll
        for (int ib = 0; ib < 4; ++ib) { af[ib] = *(const bf16x8*)(ap + (size_t)(16 * ib) * lda + 32 * ks); bv[ib] = *(const bf16x8*)(bp + (size_t)(16 * ib) * ldb + 32 * ks); }
#pragma unroll
        for (int jb = 0; jb < 4; ++jb)
#pragma unroll
            for (int ib = 0; ib < 4; ++ib) acc[jb][ib] = __builtin_amdgcn_mfma_f32_16x16x32_bf16(bv[jb], af[ib], acc[jb][ib], 0, 0, 0);
    }
    epi(acc, fr, fq);
}
struct WEpiE {
    float* E;
    __device__ __forceinline__ void operator()(const pg8::f32x4 (&acc)[4][4], int fr, int fq) const {
#pragma unroll
        for (int jb = 0; jb < 4; ++jb)
#pragma unroll
            for (int ib = 0; ib < 4; ++ib) *(pg8::f32x4*)(E + (size_t)(16 * ib + fr) * 128 + 16 * jb + 4 * fq) = acc[jb][ib];
    }
};
struct WEpiS5Y {
    const bf16* SUAg; bf16* YS5; const float* dg; int chunk0, col0, g;
    __device__ __forceinline__ void operator()(const pg8::f32x4 (&acc)[4][4], int fr, int fq) const {
#pragma unroll
        for (int jb = 0; jb < 4; ++jb) { const int col = col0 + 16 * jb + 4 * fq, tt = col >> 4, h0 = col & 15; const f32x4 d4 = *(const f32x4*)(dg + h0);
#pragma unroll
            for (int ib = 0; ib < 4; ++ib) { const int chunk = chunk0 + 16 * ib + fr; const u32x2 uu = *(const u32x2*)(SUAg + (size_t)chunk * KA5 + col); const pg8::f32x4 v = acc[jb][ib];
                const float y0 = gelu_tanh(v[0] + d4.x * bflo(uu.x)), y1 = gelu_tanh(v[1] + d4.y * bfhi(uu.x)), y2 = gelu_tanh(v[2] + d4.z * bflo(uu.y)), y3 = gelu_tanh(v[3] + d4.w * bfhi(uu.y));
                u32x2 w; w.x = pk2(y0, y1); w.y = pk2(y2, y3); *(u32x2*)(YS5 + (size_t)(chunk * 32 + tt) * 256 + g * 16 + h0) = w; } }
    }
};
struct WEpiGlu {
    const bf16* YS5; bf16* G; int row0, col0;
    __device__ __forceinline__ void operator()(const pg8::f32x4 (&acc)[4][4], int fr, int fq) const {
#pragma unroll
        for (int jb = 0; jb < 4; ++jb)
#pragma unroll
            for (int ib = 0; ib < 4; ++ib) { const int row = row0 + 16 * ib + fr, col = col0 + 16 * jb + 4 * fq; const u32x2 yy = *(const u32x2*)(YS5 + (size_t)row * 256 + col); bf16* gp = G + (size_t)row * 1024 + 512 + col; const u32x2 gg = *(const u32x2*)gp; const pg8::f32x4 v = acc[jb][ib];
                const float s0 = __builtin_amdgcn_rcpf(1.f + __expf(-v[0])), s1 = __builtin_amdgcn_rcpf(1.f + __expf(-v[1])), s2 = __builtin_amdgcn_rcpf(1.f + __expf(-v[2])), s3 = __builtin_amdgcn_rcpf(1.f + __expf(-v[3]));
                u32x2 w; w.x = pk2(bflo(yy.x) * s0 * bflo(gg.x), bfhi(yy.x) * s1 * bfhi(gg.x)); w.y = pk2(bflo(yy.y) * s2 * bflo(gg.y), bfhi(yy.y) * s3 * bfhi(gg.y)); *(u32x2*)gp = w; }
    }
};

__device__ __forceinline__ void ret_upd_unit(unsigned char* ws, int unit, int lane) {
    const int c = unit & 63, bh = unit >> 6; const int i16 = lane & 15, kq = lane >> 4;
    const bf16* KT = (const bf16*)(ws + WS_RKT) + (size_t)bh * 64 * SEQ + c * 64; const bf16* VT = (const bf16*)(ws + WS_RVT) + (size_t)bh * 64 * SEQ + c * 64;
    float* UPD = (float*)(ws + WS_UPD) + (size_t)unit * 4096;
    bf16x8 af[4][2], bfv[4][2];
#pragma unroll
    for (int ib = 0; ib < 4; ++ib)
#pragma unroll
        for (int ks = 0; ks < 2; ++ks) { af[ib][ks] = *(const bf16x8*)(KT + (size_t)(16 * ib + i16) * SEQ + 32 * ks + 8 * kq); bfv[ib][ks] = *(const bf16x8*)(VT + (size_t)(16 * ib + i16) * SEQ + 32 * ks + 8 * kq); }
#pragma unroll
    for (int ib = 0; ib < 4; ++ib)
#pragma unroll
        for (int jb = 0; jb < 4; ++jb) { pg8::f32x4 d = (pg8::f32x4){0.f, 0.f, 0.f, 0.f};
            d = __builtin_amdgcn_mfma_f32_16x16x32_bf16(af[ib][0], bfv[jb][0], d, 0, 0, 0); d = __builtin_amdgcn_mfma_f32_16x16x32_bf16(af[ib][1], bfv[jb][1], d, 0, 0, 0);
            *(pg8::f32x4*)(UPD + (size_t)(16 * jb + i16) * 64 + 16 * ib + 4 * kq) = d; }
}
__device__ __forceinline__ void ret_out_unit(const Args& a, int l, int unit, int lane, bool dry = false) {
    unsigned char* ws = a.ws;
    const int c = unit & 63, bh = unit >> 6, hh = bh & 3, b = bh >> 2; const int fr = lane & 15, fq = lane >> 4;
    const size_t t0 = (size_t)b * SEQ + c * 64;
    const bf16* RQ = (const bf16*)(ws + WS_RQ) + t0 * 256 + hh * 64; const bf16* RK = (const bf16*)(ws + WS_RK) + t0 * 256 + hh * 64;
    const bf16* VT = (const bf16*)(ws + WS_RVT) + (size_t)bh * 64 * SEQ + c * 64; const bf16* ST = (const bf16*)(ws + WS_STATE) + (size_t)unit * 4096;
    const float lg = lg2_gamma(hh);
    bf16x8 qf[4][2]; pg8::f32x4 st[4][4];
#pragma unroll
    for (int nb = 0; nb < 4; ++nb)
#pragma unroll
        for (int ks = 0; ks < 2; ++ks) qf[nb][ks] = *(const bf16x8*)(RQ + (size_t)(16 * nb + fr) * 256 + 32 * ks + 8 * fq);
#pragma unroll
    for (int mb = 0; mb < 4; ++mb) { bf16x8 k0 = *(const bf16x8*)(RK + (size_t)(16 * mb + fr) * 256 + 8 * fq), k1 = *(const bf16x8*)(RK + (size_t)(16 * mb + fr) * 256 + 32 + 8 * fq);
#pragma unroll
        for (int nb = 0; nb < 4; ++nb) { pg8::f32x4 d = (pg8::f32x4){0.f, 0.f, 0.f, 0.f};
            d = __builtin_amdgcn_mfma_f32_16x16x32_bf16(k0, qf[nb][0], d, 0, 0, 0); d = __builtin_amdgcn_mfma_f32_16x16x32_bf16(k1, qf[nb][1], d, 0, 0, 0);
#pragma unroll
            for (int r = 0; r < 4; ++r) { const int mm = 16 * mb + 4 * fq + r, nn = 16 * nb + fr; const int df = mm > nn ? mm - nn : nn - mm; d[r] *= 0.125f * __builtin_amdgcn_exp2f(lg * (float)df); }
            st[mb][nb] = d; } }
    bf16* Y = (bf16*)(ws + WS_GATE) + t0 * 1024 + 768 + hh * 64;
    u32x2 gt[4][4];
#pragma unroll
    for (int nb = 0; nb < 4; ++nb)
#pragma unroll
        for (int dvb = 0; dvb < 4; ++dvb) gt[nb][dvb] = *(const u32x2*)(Y + (size_t)(16 * nb + fr) * 1024 + 16 * dvb + 4 * fq);
    pg8::f32x4 oT[4][4];
#pragma unroll
    for (int dvb = 0; dvb < 4; ++dvb)
#pragma unroll
        for (int nb = 0; nb < 4; ++nb) oT[dvb][nb] = (pg8::f32x4){0.f, 0.f, 0.f, 0.f};
#pragma unroll
    for (int dvb = 0; dvb < 4; ++dvb) { const bf16x8 s0 = *(const bf16x8*)(ST + (size_t)(16 * dvb + fr) * 64 + 8 * fq), s1 = *(const bf16x8*)(ST + (size_t)(16 * dvb + fr) * 64 + 32 + 8 * fq);
#pragma unroll
        for (int nb = 0; nb < 4; ++nb) { oT[dvb][nb] = __builtin_amdgcn_mfma_f32_16x16x32_bf16(s0, qf[nb][0], oT[dvb][nb], 0, 0, 0); oT[dvb][nb] = __builtin_amdgcn_mfma_f32_16x16x32_bf16(s1, qf[nb][1], oT[dvb][nb], 0, 0, 0); } }
#pragma unroll
    for (int nb = 0; nb < 4; ++nb) { const float wq = 0.125f * __builtin_amdgcn_exp2f(lg * (float)(16 * nb + fr + 1));
#pragma unroll
        for (int dvb = 0; dvb < 4; ++dvb) oT[dvb][nb] = oT[dvb][nb] * wq; }
#pragma unroll
    for (int s = 0; s < 2; ++s) {
        bf16x8 pa[4];
#pragma unroll
        for (int nb = 0; nb < 4; ++nb) { u32x4 w; w.x = pk2(st[2 * s][nb][0], st[2 * s][nb][1]); w.y = pk2(st[2 * s][nb][2], st[2 * s][nb][3]); w.z = pk2(st[2 * s + 1][nb][0], st[2 * s + 1][nb][1]); w.w = pk2(st[2 * s + 1][nb][2], st[2 * s + 1][nb][3]); pa[nb] = __builtin_bit_cast(bf16x8, w); }
#pragma unroll
        for (int dvb = 0; dvb < 4; ++dvb) { const u32x2 v0 = *(const u32x2*)(VT + (size_t)(16 * dvb + fr) * SEQ + 32 * s + 4 * fq), v1 = *(const u32x2*)(VT + (size_t)(16 * dvb + fr) * SEQ + 32 * s + 16 + 4 * fq);
            const bf16x8 vf = __builtin_bit_cast(bf16x8, (u32x4){v0.x, v0.y, v1.x, v1.y});
#pragma unroll
            for (int nb = 0; nb < 4; ++nb) oT[dvb][nb] = __builtin_amdgcn_mfma_f32_16x16x32_bf16(vf, pa[nb], oT[dvb][nb], 0, 0, 0); }
    }
    const float* gn = a.in[13] + (size_t)l * 256 + hh * 64; f32x4 gnw[4];
#pragma unroll
    for (int dvb = 0; dvb < 4; ++dvb) gnw[dvb] = *(const f32x4*)(gn + 16 * dvb + 4 * fq);
#pragma unroll
    for (int nb = 0; nb < 4; ++nb) { float sm = 0.f;
#pragma unroll
        for (int dvb = 0; dvb < 4; ++dvb) sm += (oT[dvb][nb][0] + oT[dvb][nb][1]) + (oT[dvb][nb][2] + oT[dvb][nb][3]);
        sm += __shfl_xor(sm, 16); sm += __shfl_xor(sm, 32);
        const float mu = sm * (1.f / 64.f); float q = 0.f;
#pragma unroll
        for (int dvb = 0; dvb < 4; ++dvb)
#pragma unroll
            for (int r = 0; r < 4; ++r) { const float d = oT[dvb][nb][r] - mu; q += d * d; }
        q += __shfl_xor(q, 16); q += __shfl_xor(q, 32);
        const float rstd = rsqrtf(q * (1.f / 64.f) + EPS);
#pragma unroll
        for (int dvb = 0; dvb < 4; ++dvb) { const u32x2 g2 = gt[nb][dvb]; const pg8::f32x4 v = oT[dvb][nb]; const f32x4 w4 = gnw[dvb]; u32x2 w;
            w.x = pk2((v[0] - mu) * rstd * w4.x * bflo(g2.x), (v[1] - mu) * rstd * w4.y * bfhi(g2.x)); w.y = pk2((v[2] - mu) * rstd * w4.z * bflo(g2.y), (v[3] - mu) * rstd * w4.w * bfhi(g2.y));
            if (!dry) *(u32x2*)(Y + (size_t)(16 * nb + fr) * 1024 + 16 * dvb + 4 * fq) = w; } }
}


#define XB_TMO      128
#define XB_XCNT(j)  (256  + 64 * (j))
#define XB_XSUB(j)  (1280 + 64 * (j))
#define XB_XGEN(j)  (2304 + 64 * (j))
#define XB_TOP      3328
#define XB_TOPGEN   3392
#define XCD_BAR_WORDS 3456
#define XB_SPIN_CAP (1u << 18)

__device__ __forceinline__ unsigned xb_ld(unsigned* p)              { return __hip_atomic_load(p, __ATOMIC_RELAXED, __HIP_MEMORY_SCOPE_AGENT); }
__device__ __forceinline__ unsigned xb_add(unsigned* p, unsigned v) { return __hip_atomic_fetch_add(p, v, __ATOMIC_RELAXED, __HIP_MEMORY_SCOPE_AGENT); }
__device__ __forceinline__ unsigned xb_xcc_id() { return (unsigned)__builtin_amdgcn_s_getreg((3 << 11) | 20) & 0xFu; }
#define XB_SPIN(cond, bar) do { unsigned _sp = 0; while (cond) { __builtin_amdgcn_s_sleep(1); \
    if ((++_sp & 255u) == 0u) { if (xb_ld(&(bar)[XB_TMO])) break; if (_sp > XB_SPIN_CAP) { atomicAdd(&(bar)[XB_TMO], 1u); break; } } } } while (0)

struct XcdBarrier {
    unsigned* bar; unsigned x;
    volatile LAS unsigned* st;
};

__device__ __forceinline__ XcdBarrier xcd_barrier_post(unsigned* bar, volatile LAS unsigned* st) {
    XcdBarrier b; b.bar = bar; b.x = xb_xcc_id(); b.st = st;
    if (threadIdx.x == 0) (void)xb_add(&bar[XB_XCNT(b.x)], 1u);
    return b;
}
__device__ __forceinline__ void xcd_barrier_complete(unsigned* bar, unsigned x, unsigned& nloc, unsigned& nx) {
    const unsigned G = gridDim.x * gridDim.y * gridDim.z;
    unsigned sum, cnt, mine, sp = 0u;
    for (;;) {
        sum = 0u; cnt = 0u; mine = 0u;
#pragma unroll
        for (unsigned j = 0; j < 16; ++j) { const unsigned c = xb_ld(&bar[XB_XCNT(j)]); sum += c; cnt += (c > 0u) ? 1u : 0u; mine = (j == x) ? c : mine; }
        if (sum == G) break;
        __builtin_amdgcn_s_sleep(1);
        if ((++sp & 255u) == 0u) { if (xb_ld(&bar[XB_TMO])) break; if (sp > XB_SPIN_CAP) { atomicAdd(&bar[XB_TMO], 1u); break; } }
    }
    nloc = mine > 0u ? mine : 1u; nx = cnt > 0u ? cnt : 1u;
}

__device__ __forceinline__ void xcd_barrier(const XcdBarrier& b) {
    asm volatile("s_waitcnt vmcnt(0)" ::: "memory");
    __syncthreads();
    if (threadIdx.x == 0) {
        unsigned* bar = b.bar;
        __builtin_amdgcn_s_waitcnt(0);
        unsigned nloc = b.st[0], nx = b.st[1];
        if (nloc == 0u) { xcd_barrier_complete(bar, b.x, nloc, nx); b.st[0] = nloc; b.st[1] = nx; }
        const unsigned old = xb_add(&bar[XB_XSUB(b.x)], 1u);
        const unsigned gen = old / nloc;
        if (old + 1u == (gen + 1u) * nloc) {
            __builtin_amdgcn_fence(__ATOMIC_RELEASE, "agent");
            asm volatile("s_waitcnt vmcnt(0)" ::: "memory");
            const unsigned og = xb_add(&bar[XB_TOP], 1u);
            const unsigned tg = og / nx;
            if (og + 1u == (tg + 1u) * nx) xb_add(&bar[XB_TOPGEN], 1u);
            else XB_SPIN(xb_ld(&bar[XB_TOPGEN]) == tg, bar);
            __builtin_amdgcn_fence(__ATOMIC_ACQUIRE, "agent");
            xb_add(&bar[XB_XGEN(b.x)], 1u);
            asm volatile("s_waitcnt vmcnt(0)" ::: "memory");
        } else {
            XB_SPIN(xb_ld(&bar[XB_XGEN(b.x)]) == gen, bar);
            __builtin_amdgcn_fence(__ATOMIC_ACQUIRE, "agent");
            asm volatile("s_waitcnt vmcnt(0)" ::: "memory");
        }
    }
    __syncthreads();
}

#define XBAR_MAKE XcdBarrier xb_; xb_.bar = (unsigned*)args.ws; xb_.st = (volatile LAS unsigned*)((LAS unsigned char*)lds + RING_BYTES + 352); xb_.x = xb_.st[2]
#ifdef REP_SYNC
#define GSYNC() do { XBAR_MAKE; xcd_barrier(xb_); xcd_barrier(xb_); } while (0)
#else
#define GSYNC() do { XBAR_MAKE; xcd_barrier(xb_); } while (0)
#endif
#ifndef REP_P0
#define REP_P0 1
#endif
#ifndef REP_P1
#define REP_P1 1
#endif
#ifndef REP_P23
#define REP_P23 1
#endif
#ifndef REP_NORM
#define REP_NORM 1
#endif
__global__ void __launch_bounds__(NTHR, 2) mega_fwd(Args args) {
    extern __shared__ __attribute__((aligned(16))) unsigned char lds[];
    cg::grid_group grid = cg::this_grid();
    const int tid = threadIdx.x, lane = tid & 63, wave = __builtin_amdgcn_readfirstlane(tid >> 6);
    const int G = gridDim.x, bx = blockIdx.x; const int vcu = (G % 8 == 0) ? (bx % 8) * (G / 8) + bx / 8 : bx;
    const int gw = bx * NWAVES + wave, NGW = G * NWAVES;
    unsigned char* ws = args.ws;
    LAS unsigned char* ldsl = (LAS unsigned char*)lds;
    LAS float* ldsf = (LAS float*)lds;
    float* X = args.out;
    if (ws == nullptr) grid.sync();
    if (tid < 2) ((volatile LAS unsigned*)(ldsl + RING_BYTES + 352))[tid] = 0u;
    __syncthreads();
    { const XcdBarrier xb0 = xcd_barrier_post((unsigned*)ws, (volatile LAS unsigned*)(ldsl + RING_BYTES + 352)); if (tid == 0) ((volatile LAS unsigned*)(ldsl + RING_BYTES + 352))[2] = xb0.x; }
    __syncthreads();

#ifdef PROBE_T
    unsigned long long tacc_ = 0ull, tprev_ = __builtin_amdgcn_s_memrealtime();
#define TSTAMP(id) do { const unsigned long long tn_ = __builtin_amdgcn_s_memrealtime(); if ((id) == PROBE_T || ((PROBE_T) == 23 && ((id) == 2 || (id) == 3 || (id) == 5))) tacc_ += tn_ - tprev_; tprev_ = tn_; } while (0)
#else
#define TSTAMP(id) do {} while (0)
#endif
    for (int rep_ = 0; rep_ < REP_P0; ++rep_) {
        if (rep_) { __syncthreads(); }
#ifdef REP_S5P
        if (bx < 64) { s5_prep(args, bx >> 4, bx & 15, ldsf, tid); }
#endif
        if (bx < 64) { s5_prep(args, bx >> 4, bx & 15, ldsf, tid); }
        LAS float* scr = ldsf + wave * 4096;
        constexpr int I_IN = (DM / 64) * (NF / 32), I_O = (DM / 64) * (DM / 32), I_G = (256 / 64) * (256 / 32), I_L = I_IN + I_O + I_G;
#ifndef REP_TR
#define REP_TR 1
#endif
        for (int rt_ = 0; rt_ < REP_TR; ++rt_)
        for (int it = (bx < 64 ? DEPTH * I_L : (bx - 64) * NWAVES + wave); it < DEPTH * I_L; it += (G - 64) * NWAVES) {
            const int l = it / I_L; int r = it % I_L;
            if (r < I_IN) { p0_transpose_item<true>(args.in[2] + (size_t)l * DM * NIN, DM, NIN, NF, (bf16*)(ws + WS_WIN) + (size_t)l * NF * DM, scr, r, lane); continue; } r -= I_IN;
            if (r < I_O) { p0_transpose_item<false>(args.in[14] + (size_t)l * DM * DM, DM, DM, DM, (bf16*)(ws + WS_WO) + (size_t)l * DM * DM, scr, r, lane); continue; } r -= I_O;
            p0_transpose_item<false>(args.in[12] + (size_t)l * 65536, 256, 256, 256, (bf16*)(ws + WS_WGLU) + (size_t)l * 65536, scr, r, lane);
        }
        f32x2* rope = (f32x2*)(ws + WS_ROPE);
        for (int i = bx * NTHR + tid; i < SEQ * 32; i += G * NTHR) { const int pos = i >> 5, fi = i & 31; const float freq = powf(10000.f, -(float)fi / 32.f); const float ang = (float)pos * freq; float sn, cs; sincosf(ang, &sn, &cs); rope[i] = (f32x2){cs, sn}; }
        __syncthreads();
        { const int NW = (64 + 2 * (G - 64)) * NWAVES;
          if (bx < 64) norm0_phase(args, lane, bx * NWAVES + wave, NW);
          else { const int sl = 64 * NWAVES + ((bx - 64) * NWAVES + wave) * 2; norm0_phase(args, lane, sl, NW); norm0_phase(args, lane, sl + 1, NW); } }
    }
    GSYNC();
    TSTAMP(0);

#define PHASE_VARS int tid = threadIdx.x; asm volatile("" : "+v"(tid)); int bxl_ = blockIdx.x; asm volatile("" : "+s"(bxl_)); const int bx = bxl_; const int lane = tid & 63, wave = __builtin_amdgcn_readfirstlane(tid >> 6), gw = bx * NWAVES + wave; __attribute__((address_space(1))) unsigned char* wsg_ = (__attribute__((address_space(1))) unsigned char*)args.ws; asm volatile("" : "+s"(wsg_)); unsigned char* ws = (unsigned char*)wsg_; LAS unsigned char* ldsl = (LAS unsigned char*)lds; LAS float* ldsf = (LAS float*)lds; (void)lane; (void)wave; (void)gw; (void)ldsl; (void)ldsf
    for (int l = 0; l < DEPTH; ++l) {
        for (int rep_ = 0; rep_ < REP_P1; ++rep_) {
            PHASE_VARS;
            pg8::Gemm g{(const bf16*)(ws + WS_XN), (const bf16*)(ws + WS_WIN) + (size_t)l * NF * DM, M, NF, DM, DM, DM, 0, 0};
            pg8::StaticOrder S; S.init(M, NF, G, bx);
            EpiInProj E{ws, (const float*)(ws + WS_SS) + (size_t)(l & 1) * M, args.in[3] + (size_t)l * 8};
#ifdef PROBE_SPLIT
            { RangeOrder R0{S, 0, 2}, R1{S, 2, 4}; pg8::gemm_phase<EpiInProj, RangeOrder, true, true>(ldsl, g, R0, E); GSYNC(); pg8::gemm_phase<EpiInProj, RangeOrder, true, true>(ldsl, g, R1, E); }
#else
            pg8::gemm_phase<EpiInProj, pg8::StaticOrder, true, true>(ldsl, g, S, E);
#endif
            if (bx >= G / 2) flog_phase(args, l, (const float*)(ws + WS_SS) + (size_t)(l & 1) * M, ldsf, tid, lane, wave, bx - G / 2, G / 2);
        }
        GSYNC();
        TSTAMP(1);
        for (int rep_ = 0; rep_ < REP_P23; ++rep_) {
            if (rep_) __syncthreads();
            PHASE_VARS;
            if (bx < 128) {
                const int half = bx & 1, bg_ = bx >> 1, b = bg_ >> 4, g = bg_ & 15, tmL = wave & 1, tn = (wave >> 1) & 1, kh = wave >> 2;
                { const int fr = lane & 15, fq = lane >> 4;
                  const bf16* Ap = (const bf16*)(ws + WS_SUA) + ((size_t)g * NCH5 + b * 128 + tmL * 64) * KA5 + 256 * kh; const bf16* Bp = (const bf16*)(ws + WS_WB) + ((size_t)(l * 16 + g) * 128 + tn * 64) * 512 + 256 * kh;
                  struct WEpiLds { LAS float* EL; __device__ __forceinline__ void operator()(const pg8::f32x4 (&acc)[4][4], int fr_, int fq_) const {
#pragma unroll
                      for (int jb = 0; jb < 4; ++jb)
#pragma unroll
                          for (int ib = 0; ib < 4; ++ib) *(LAS pg8::f32x4*)(EL + (16 * ib + fr_) * 128 + 16 * jb + 4 * fq_) = acc[jb][ib]; } };
                  WEpiLds E{ldsf + (size_t)(kh * 128 + tmL * 64) * 128 + tn * 64}; (void)fr; (void)fq;
                  wave_gemm64<8, 4, WEpiLds>(Ap, KA5, Bp, 512, lane, E); }
                __syncthreads();
                const int p = tid & 63, seg = tid >> 6;
                const float* LAM = (const float*)(ws + WS_LAM) + (size_t)(l * 16 + g) * 128; const float lr = LAM[p], li = LAM[64 + p];
                bf16* SA = (bf16*)(ws + WS_SUA) + ((size_t)g * NCH5 + b * 128 + seg * 16) * KA5 + 512 + p;
                float er[16], ei[16];
#pragma unroll
                for (int i = 0; i < 16; ++i) { const int r = (seg * 16 + i) * 128; er[i] = ldsf[r + p] + ldsf[16384 + r + p]; ei[i] = ldsf[r + 64 + p] + ldsf[16384 + r + 64 + p]; }
                float sr = 0.f, si = 0.f;
#pragma unroll
                for (int i = 0; i < 16; ++i) { const float nr = lr * sr - li * si + er[i], ni = lr * si + li * sr + ei[i]; sr = nr; si = ni; }
                LAS float* ends = ldsf + (RING_BYTES + 1024) / 4;
                ends[(seg * 64 + p) * 2] = sr; ends[(seg * 64 + p) * 2 + 1] = si;
                float pr = lr, pi = li;
#pragma unroll
                for (int i = 0; i < 4; ++i) { const float nr = pr * pr - pi * pi, ni = 2.f * pr * pi; pr = nr; pi = ni; }
                __syncthreads();
                float cr = 0.f, ci = 0.f;
                for (int s2 = 0; s2 < seg; ++s2) { const float xr = ends[(s2 * 64 + p) * 2], xi = ends[(s2 * 64 + p) * 2 + 1]; const float nr = pr * cr - pi * ci + xr, ni = pr * ci + pi * cr + xi; cr = nr; ci = ni; }
#pragma unroll
                for (int i = 0; i < 16; ++i) { SA[(size_t)i * KA5] = f2bf(cr); SA[(size_t)i * KA5 + 64] = f2bf(ci); const float nr = lr * cr - li * ci + er[i], ni = lr * ci + li * cr + ei[i]; cr = nr; ci = ni; }
                asm volatile("s_waitcnt vmcnt(0)" ::: "memory"); __syncthreads();
                { const int tmL2 = wave & 1, tn2 = half * 4 + (wave >> 1);
                  const bf16* SUAg = (const bf16*)(ws + WS_SUA) + (size_t)g * NCH5 * KA5;
                  WEpiS5Y E{SUAg, (bf16*)(ws + WS_YS5), args.in[10] + (size_t)l * 256 + g * 16, b * 128 + tmL2 * 64, tn2 * 64, g};
                  wave_gemm64<20, 4, WEpiS5Y>(SUAg + (size_t)(b * 128 + tmL2 * 64) * KA5, KA5, (const bf16*)(ws + WS_MF) + ((size_t)(l * 16 + g) * 512 + tn2 * 64) * KA5, KA5, lane, E); }
            } else {
                const int idx = bx - 128, bh = idx >> 3, dvs = (idx >> 1) & 3, dkh = idx & 1, fr = lane & 15, fq = lane >> 4; const float g64 = exp2f(lg2_gamma(bh & 3) * 64.f);
                const bf16* KT = (const bf16*)(ws + WS_RKT) + ((size_t)bh * 64 + 32 * dkh + fr) * SEQ + 8 * fq; const bf16* VT = (const bf16*)(ws + WS_RVT) + ((size_t)bh * 64 + 16 * dvs + fr) * SEQ + 8 * fq;
                pg8::f32x4 u[8][2];
#pragma unroll
                for (int i2 = 0; i2 < 2; ++i2) {
                    bf16x8 vf[4][2], kf[4][2][2];
#pragma unroll
                    for (int i1 = 0; i1 < 4; ++i1) { const int c = 8 * wave + 4 * i2 + i1; vf[i1][0] = *(const bf16x8*)(VT + c * 64); vf[i1][1] = *(const bf16x8*)(VT + c * 64 + 32);
#pragma unroll
                        for (int ib = 0; ib < 2; ++ib) { kf[i1][ib][0] = *(const bf16x8*)(KT + (size_t)(16 * ib) * SEQ + c * 64); kf[i1][ib][1] = *(const bf16x8*)(KT + (size_t)(16 * ib) * SEQ + c * 64 + 32); } }
#pragma unroll
                    for (int i1 = 0; i1 < 4; ++i1)
#pragma unroll
                        for (int ib = 0; ib < 2; ++ib) { pg8::f32x4 d = (pg8::f32x4){0.f, 0.f, 0.f, 0.f}; d = __builtin_amdgcn_mfma_f32_16x16x32_bf16(kf[i1][ib][0], vf[i1][0], d, 0, 0, 0); d = __builtin_amdgcn_mfma_f32_16x16x32_bf16(kf[i1][ib][1], vf[i1][1], d, 0, 0, 0); u[4 * i2 + i1][ib] = d; }
                }
                pg8::f32x4 e4[2];
#pragma unroll
                for (int ib = 0; ib < 2; ++ib) e4[ib] = (pg8::f32x4){0.f, 0.f, 0.f, 0.f};
#pragma unroll
                for (int i = 0; i < 8; ++i)
#pragma unroll
                    for (int ib = 0; ib < 2; ++ib) e4[ib] = e4[ib] * g64 + u[i][ib];
                LAS pg8::f32x4* ends = (LAS pg8::f32x4*)ldsf;
#pragma unroll
                for (int ib = 0; ib < 2; ++ib) ends[(wave * 2 + ib) * 64 + lane] = e4[ib];
                float g8 = g64; g8 = g8 * g8; g8 = g8 * g8; g8 = g8 * g8;
                __syncthreads();
                pg8::f32x4 st[2];
#pragma unroll
                for (int ib = 0; ib < 2; ++ib) st[ib] = (pg8::f32x4){0.f, 0.f, 0.f, 0.f};
                for (int w2 = 0; w2 < wave; ++w2)
#pragma unroll
                    for (int ib = 0; ib < 2; ++ib) st[ib] = st[ib] * g8 + ends[(w2 * 2 + ib) * 64 + lane];
                bf16* ST = (bf16*)(ws + WS_STATE) + (size_t)(bh * 64 + 8 * wave) * 4096 + (size_t)(16 * dvs + fr) * 64 + 32 * dkh + 4 * fq;
#pragma unroll
                for (int i = 0; i < 8; ++i)
#pragma unroll
                    for (int ib = 0; ib < 2; ++ib) { u32x2 w; w.x = pk2(st[ib][0], st[ib][1]); w.y = pk2(st[ib][2], st[ib][3]); *(u32x2*)(ST + (size_t)i * 4096 + 16 * ib) = w; st[ib] = st[ib] * g64 + u[i][ib]; }
                __syncthreads();
                if (idx < 32) {
                const int bh = idx; const float* lf = (const float*)(ws + WS_LOGF) + (size_t)bh * SEQ; float* cb = (float*)(ws + WS_CB) + (size_t)bh * SEQ;
                const f32x4 a0 = *(const f32x4*)(lf + tid * 8), a1 = *(const f32x4*)(lf + tid * 8 + 4); float v[8] = {a0.x, a0.y, a0.z, a0.w, a1.x, a1.y, a1.z, a1.w};
#pragma unroll
                for (int e = 1; e < 8; ++e) v[e] += v[e - 1];
                float tot = v[7];
#pragma unroll
                for (int o = 1; o < 64; o <<= 1) { const float t = __shfl_up(tot, o); if (lane >= o) tot += t; }
                if (lane == 63) ldsf[wave] = tot;
                __syncthreads();
                float off = tot - v[7];
                for (int w = 0; w < wave; ++w) off += ldsf[w];
                f32x4 o0, o1; o0.x = -(v[0] + off) * LOG2E; o0.y = -(v[1] + off) * LOG2E; o0.z = -(v[2] + off) * LOG2E; o0.w = -(v[3] + off) * LOG2E; o1.x = -(v[4] + off) * LOG2E; o1.y = -(v[5] + off) * LOG2E; o1.z = -(v[6] + off) * LOG2E; o1.w = -(v[7] + off) * LOG2E;
                *(f32x4*)(cb + tid * 8) = o0; *(f32x4*)(cb + tid * 8 + 4) = o1;
                } else if (idx < 64) {
                const int bh = idx - 32, b = bh >> 3, h = bh & 7, rsub = lane >> 3, part = lane & 7;
                const bf16* Qp = (const bf16*)(ws + WS_QO) + ((size_t)b * SEQ + wave * 512 + rsub) * 512 + h * 64 + part * 8; const bf16* Kp = (const bf16*)(ws + WS_KB) + ((size_t)b * SEQ + wave * 512 + rsub) * 512 + h * 64 + part * 8;
                float qm = 0.f, km = 0.f;
#pragma unroll 8
                for (int it = 0; it < 64; ++it) { const u32x4 qv = *(const u32x4*)(Qp + (size_t)it * 8 * 512), kv = *(const u32x4*)(Kp + (size_t)it * 8 * 512); float sq = 0.f, sk = 0.f;
#pragma unroll
                    for (int e = 0; e < 4; ++e) { const float a0 = bflo(qv[e]), a1 = bfhi(qv[e]), c0 = bflo(kv[e]), c1 = bfhi(kv[e]); sq += a0 * a0 + a1 * a1; sk += c0 * c0 + c1 * c1; }
                    sq += __shfl_xor(sq, 1); sq += __shfl_xor(sq, 2); sq += __shfl_xor(sq, 4); sk += __shfl_xor(sk, 1); sk += __shfl_xor(sk, 2); sk += __shfl_xor(sk, 4);
                    qm = fmaxf(qm, sq); km = fmaxf(km, sk); }
#pragma unroll
                for (int o = 8; o < 64; o <<= 1) { qm = fmaxf(qm, __shfl_xor(qm, o)); km = fmaxf(km, __shfl_xor(km, o)); }
                if (lane == 0) { ldsf[wave * 2] = qm; ldsf[wave * 2 + 1] = km; }
                __syncthreads();
                if (tid == 0) { float a = 0.f, c = 0.f; for (int w = 0; w < NWAVES; ++w) { a = fmaxf(a, ldsf[2 * w]); c = fmaxf(c, ldsf[2 * w + 1]); } ((float*)(ws + WS_NRM))[bh] = sqrtf(a) * sqrtf(c) * 1.0001f; }
                }
            }
        }
        GSYNC();
        TSTAMP(3);
        {
            PHASE_VARS;
            if (wave < 4) ret_out_unit(args, l, wave * 256 + bx, lane);
            else {
                const int t = (wave - 4) * 256 + bx, tm = t >> 2, tn = t & 3;
                WEpiGlu E{(const bf16*)(ws + WS_YS5), (bf16*)(ws + WS_GATE), tm * 64, tn * 64};
                wave_gemm64<8, 4, WEpiGlu>((const bf16*)(ws + WS_YS5) + (size_t)(tm * 64) * 256, 256, (const bf16*)(ws + WS_WGLU) + (size_t)l * 65536 + (size_t)(tn * 64) * 256, 256, lane, E);
            }
            __syncthreads();
            const attn_body::AttnTensors AT{(const attn_body::bf16*)(ws + WS_QO), (const attn_body::bf16*)(ws + WS_KB), (const attn_body::bf16*)(ws + WS_VB), (attn_body::bf16*)(ws + WS_GATE), (const float*)(ws + WS_CB), (const float*)(ws + WS_NRM)};
            { const unsigned x0 = xb_xcc_id() & 7u; volatile LAS unsigned* slot = (volatile LAS unsigned*)(ldsl + RING_BYTES + 352) + 3;
              for (unsigned xi = 0; xi < 8u; ++xi) { const unsigned x = (x0 + xi) & 7u; unsigned* cnt = (unsigned*)ws + 8192 + (l * 8 + (int)x) * 64;
                for (;;) {
                  if (tid == 0) *slot = __hip_atomic_fetch_add(cnt, 1u, __ATOMIC_RELAXED, __HIP_MEMORY_SCOPE_AGENT);
                  __syncthreads();
                  const unsigned j = *slot;
                  __syncthreads();
                  if (j >= 64u) break;
                  const int qb = 15 - (int)(j >> 2), b = (int)(j & 3u), h = (int)((x + 2u * (j & 3u)) & 7u);
                  attn_body::attn_unit<8>(b, h, qb, AT.Q, AT.K, AT.V, AT.O, AT.CB, AT.NRM, (char*)lds);
                } } }
        }
        GSYNC();
        TSTAMP(4);
        {
            PHASE_VARS;
            pg8::Gemm g{(const bf16*)(ws + WS_GATE), (const bf16*)(ws + WS_WO) + (size_t)l * DM * DM, M, DM, DM, DM, DM, 0, 0};
            pg8::StaticOrder S; S.init(M, DM, G, bx);
            if (l + 1 < DEPTH) {
                EpiOutX<false> E{l == 0 ? args.in[0] : X, X, args.in[1] + (size_t)(l + 1) * DM, (float*)(ws + WS_XBUF), (unsigned*)ws + 4096, (bf16*)(ws + WS_XN), 32u * (unsigned)(l + 1)};
                pg8::gemm_phase<EpiOutX<false>, pg8::StaticOrder, false, true>(ldsl, g, S, E);
            } else {
                EpiOutX<true> E{X, X, args.in[15], (float*)(ws + WS_XBUF), (unsigned*)ws + 4096, nullptr, 32u * (unsigned)(l + 1)};
                pg8::gemm_phase<EpiOutX<true>, pg8::StaticOrder, false, true>(ldsl, g, S, E);
            }
        }
        if (l + 1 < DEPTH) GSYNC();
        TSTAMP(6);
    }
}

extern "C" void kernel_launch(void* const* d_in, const int* in_sizes, int n_in, void* d_out, int out_size, void* d_ws, size_t ws_size, hipStream_t stream) {
    static int grid = 0;
    if (grid == 0) {
        if (n_in != 16 || ws_size < WS_END) { fprintf(stderr, "kernel_launch: unexpected n_in %d / ws %zu\n", n_in, ws_size); grid = -1; return; }
        int dev = 0, cus = 0, per_cu = 0;
        hipGetDevice(&dev); hipDeviceGetAttribute(&cus, hipDeviceAttributeMultiprocessorCount, dev);
        if (hipFuncSetAttribute((const void*)mega_fwd, hipFuncAttributeMaxDynamicSharedMemorySize, LDS_BYTES) != hipSuccess) { fprintf(stderr, "kernel_launch: hipFuncSetAttribute failed\n"); grid = -1; return; }
        if (hipOccupancyMaxActiveBlocksPerMultiprocessor(&per_cu, (const void*)mega_fwd, NTHR, LDS_BYTES) != hipSuccess || per_cu < 1) { fprintf(stderr, "kernel_launch: occupancy query failed (%d)\n", per_cu); grid = -1; return; }
        grid = cus;
        if (grid != 256) fprintf(stderr, "kernel_launch: note: %d CUs\n", grid);
    }
    if (grid < 0) return;
    if (hipMemsetAsync(d_ws, 0, 65536, stream) != hipSuccess) { fprintf(stderr, "kernel_launch: hipMemsetAsync failed\n"); return; }
    Args a{};
    for (int i = 0; i < 16; ++i) a.in[i] = (const float*)d_in[i];
    a.out = (float*)d_out; a.ws = (unsigned char*)d_ws;
    void* kargs[] = {&a};
    hipError_t e = hipLaunchCooperativeKernel((const void*)mega_fwd, dim3(grid), dim3(NTHR), kargs, LDS_BYTES, stream);
    if (e != hipSuccess) fprintf(stderr, "kernel_launch: cooperative launch failed: %s\n", hipGetErrorString(e));
}
```

```cpp
#include <hip/hip_runtime.h>
#include <cstdio>
#include <cstdint>
namespace pg8 {
#define PG8_LAS __attribute__((address_space(3)))
typedef unsigned short bf16_t;
typedef short bf16x8 __attribute__((ext_vector_type(8)));
typedef float f32x4 __attribute__((ext_vector_type(4)));
typedef unsigned u32x4 __attribute__((ext_vector_type(4)));
constexpr int BM = 256, BK = 64, HALF = 128, HTB = HALF * BK * 2  , STAGE_BYTES = 8 * HTB, NXCD = 8, WGM = 4;

__host__ __device__ __forceinline__ int lds_byte(int r, int c) { const int st = (r >> 4) * 2 + (c >> 5), rr = r & 15, cc = c & 31, ob = rr * 64 + cc * 2; return st * 1024 + (ob ^ (((ob >> 9) & 1) << 5)); }
__host__ __device__ __forceinline__ void stage_rc(int b, int& R, int& C) { const int st = b / 1024, sb = b % 1024, swz = sb ^ (((sb >> 9) & 1) << 5); R = (st >> 1) * 16 + swz / 64; C = (st & 1) * 32 + (swz % 64) / 2; }
__host__ __device__ __forceinline__ int perm32(int rho) { const int n = rho >> 4, i = rho & 15; return 8 * (i >> 2) + 4 * n + (i & 3); }

struct Unit { int pm, pn, gz; };
struct Gemm { const bf16_t* A; const bf16_t* Bt; int M, N, K; int lda, ldb; size_t gsA, gsB; };

struct StaticOrder {
    int nM, nN, nwg, G, c;
    __host__ __device__ void init(int M, int N, int G_, int c_) { nM = M / BM; nN = N / BM; nwg = nM * nN; G = G_; c = c_; }
    __host__ __device__ bool next(int i, Unit& u) const {
        const long L = (long)i * G + c; if (L >= nwg) return false;
        int wgid = (int)L; { const int q = nwg / NXCD, r = nwg % NXCD, xcd = wgid % NXCD, off = wgid / NXCD; wgid = (xcd < r ? xcd * (q + 1) : r * (q + 1) + (xcd - r) * q) + off; }
        const int nig = WGM * nN, gid = wgid / nig, fm = gid * WGM, gsz = (nM - fm) < WGM ? (nM - fm) : WGM;
        u.pm = fm + ((wgid % nig) % gsz); u.pn = (wgid % nig) / gsz; u.gz = 0; return true;
    }
    __device__ __forceinline__ void a_ready(const Unit&) const {}
    __device__ __forceinline__ void done(const Unit&) const {}
};

__device__ __forceinline__ unsigned cvt_pk_bf16(float lo, float hi) { unsigned r; asm volatile("v_cvt_pk_bf16_f32 %0, %1, %2" : "=v"(r) : "v"(lo), "v"(hi)); return r; }
typedef float f32x2 __attribute__((ext_vector_type(2)));
__device__ __forceinline__ f32x2 gelu_pk(f32x2 v) {
    const f32x2 av = __builtin_elementwise_abs(v), d = av * 0.2316418882f + 1.0f;
    f32x2 t; t.x = __builtin_amdgcn_rcpf(d.x); t.y = __builtin_amdgcn_rcpf(d.y);
    f32x2 q = t * 0.5307027145f + (-0.7265760135f); q = q * t + 0.7107068705f; q = q * t + (-0.142248368f); q = q * t + 0.127414796f; q = q * t;
    const f32x2 s = (v * v) * (-0.72134752044f);
    f32x2 e; e.x = __builtin_amdgcn_exp2f(s.x); e.y = __builtin_amdgcn_exp2f(s.y);
    const f32x2 m = v * (q * e), r = v - m;
    f32x2 o; o.x = v.x < 0.f ? m.x : r.x; o.y = v.y < 0.f ? m.y : r.y; return o;
}

template <class Epi, class Sched, bool ALIGN_EPI = false, bool SP2 = false>
__device__ __forceinline__ void gemm_phase(PG8_LAS unsigned char* lds, const Gemm g, const Sched& S, const Epi& E) {
    int tid_ = threadIdx.x; asm volatile("" : "+v"(tid_));
    const int tid = tid_, wid = __builtin_amdgcn_readfirstlane(tid >> 6), lane = tid & 63, wr = wid >> 2, wc = wid & 3, fr = lane & 15, fq = lane >> 4;
    const int K = g.K, nt = K / BK;
    unsigned voffA[2], voffB[2];
#pragma unroll
    for (int i = 0; i < 2; ++i) { int R, C; stage_rc(tid * 16 + i * 8192, R, C); const int Rb = Epi::PERM ? ((R & ~31) + perm32(R & 31)) : R;
        voffA[i] = (unsigned)(R * g.lda + C) * 2u; voffB[i] = (unsigned)(Rb * g.ldb + C) * 2u; }
    const size_t kstep = (size_t)(BK * 2);
    const size_t hstepA = (size_t)HALF * g.lda * 2, hstepB = (size_t)HALF * g.ldb * 2;
    const size_t tstepA = 2 * hstepA, tstepB = 2 * hstepB;
    const unsigned ldsw = (unsigned)wid * 1024u;
    const int aoff = lds_byte(wr * 64 + fr, fq * 8), boff = lds_byte(wc * 32 + fr, fq * 8);
#define PG8_SA(b, h) (((b) * 2 + (h)) * HTB)
#define PG8_SB(b, h) ((4 + (b) * 2 + (h)) * HTB)
#define PG8_STAGE(bufoff, gbase, voff) do { _Pragma("unroll") for (int _i = 0; _i < 2; ++_i) \
        __builtin_amdgcn_global_load_lds((const unsigned*)((const char*)(gbase) + (voff)[_i]), (PG8_LAS unsigned*)(lds + (bufoff) + ldsw + _i * 8192), 16, 0, 0); } while (0)
#define PG8_LDA(dst, b, h) do { _Pragma("unroll") for (int m = 0; m < 4; ++m) _Pragma("unroll") for (int k = 0; k < 2; ++k) dst[m][k] = *(const PG8_LAS bf16x8*)(lds + PG8_SA(b, h) + aoff + m * 2048 + k * 1024); } while (0)
#define PG8_LDB(dst, b, h) do { _Pragma("unroll") for (int n = 0; n < 2; ++n) _Pragma("unroll") for (int k = 0; k < 2; ++k) dst[n][k] = *(const PG8_LAS bf16x8*)(lds + PG8_SB(b, h) + boff + n * 2048 + k * 1024); } while (0)
#define PG8_MMA(ai, bj, At, Bt) do { __builtin_amdgcn_s_setprio(1); _Pragma("unroll") for (int m = 0; m < 4; ++m) _Pragma("unroll") for (int n = 0; n < 2; ++n) _Pragma("unroll") for (int k = 0; k < 2; ++k) \
        acc[ai][bj][m][n] = __builtin_amdgcn_mfma_f32_16x16x32_bf16(Bt[n][k], At[m][k], acc[ai][bj][m][n], 0, 0, 0); __builtin_amdgcn_s_setprio(0); } while (0)
#define PG8_WAIT_V(n) asm volatile("s_waitcnt vmcnt(" #n ")" ::: "memory")
#define PG8_WAIT_L(n) asm volatile("s_waitcnt lgkmcnt(" #n ")" ::: "memory")
#define PG8_BAR __builtin_amdgcn_s_barrier()
#define PG8_SCHED __builtin_amdgcn_sched_barrier(0)
    Unit cur, nxt; int ui = 0;
    if (!S.next(0, cur)) return;
    f32x4 acc[2][2][4][2];
#pragma unroll
    for (int a = 0; a < 2; ++a)
#pragma unroll
        for (int b = 0; b < 2; ++b)
#pragma unroll
            for (int m = 0; m < 4; ++m)
#pragma unroll
                for (int n = 0; n < 2; ++n) acc[a][b][m][n] = (f32x4){0.f, 0.f, 0.f, 0.f};
    bf16x8 At[4][2], B0[2][2], B1[2][2];
    const char* cA = (const char*)g.A + (size_t)cur.gz * g.gsA * 2 + (size_t)cur.pm * tstepA; const char* cB = (const char*)g.Bt + (size_t)cur.gz * g.gsB * 2 + (size_t)cur.pn * tstepB;
    S.a_ready(cur);
    if constexpr (SP2) {
        PG8_STAGE(PG8_SB(0, 0), cB, voffB); PG8_STAGE(PG8_SB(0, 1), cB + hstepB, voffB); PG8_STAGE(PG8_SA(0, 0), cA, voffA); PG8_STAGE(PG8_SA(0, 1), cA + hstepA, voffA);
        if (wr == 1) PG8_BAR;
        PG8_WAIT_V(2); PG8_BAR;
        PG8_STAGE(PG8_SB(1, 0), cB + kstep, voffB); PG8_STAGE(PG8_SA(1, 0), cA + kstep, voffA); PG8_STAGE(PG8_SB(1, 1), cB + hstepB + kstep, voffB);
        PG8_WAIT_V(6); PG8_BAR;
    } else {
        PG8_STAGE(PG8_SB(0, 0), cB, voffB); PG8_STAGE(PG8_SA(0, 0), cA, voffA); PG8_STAGE(PG8_SB(0, 1), cB + hstepB, voffB); PG8_STAGE(PG8_SA(0, 1), cA + hstepA, voffA);
        if (wr == 1) PG8_BAR;
        PG8_WAIT_V(4); PG8_BAR;
        PG8_STAGE(PG8_SB(1, 0), cB + kstep, voffB); PG8_STAGE(PG8_SA(1, 0), cA + kstep, voffA); PG8_STAGE(PG8_SB(1, 1), cB + hstepB + kstep, voffB);
        PG8_WAIT_V(6); PG8_BAR;
    }
    for (;;) {
        const bool has_next = S.next(ui + 1, nxt);
        const char* nA = has_next ? (const char*)g.A + (size_t)nxt.gz * g.gsA * 2 + (size_t)nxt.pm * tstepA : cA; const char* nB = has_next ? (const char*)g.Bt + (size_t)nxt.gz * g.gsB * 2 + (size_t)nxt.pn * tstepB : cB;
        for (int t = 0; t < nt; t += 2) {
            const bool last = (t == nt - 2);
            const char* a1 = cA + (size_t)(t + 1) * kstep;
            const char* a2 = last ? nA : cA + (size_t)(t + 2) * kstep; const char* b2 = last ? nB : cB + (size_t)(t + 2) * kstep;
            const char* a3 = a2 + kstep; const char* b3 = b2 + kstep;
            if (last && has_next) S.a_ready(nxt);
            if constexpr (SP2) {
            PG8_LDB(B0, 0, 0); PG8_LDB(B1, 0, 1); PG8_SCHED; PG8_LDA(At, 0, 0); PG8_STAGE(PG8_SA(1, 1), a1 + hstepA, voffA);
            PG8_WAIT_V(8); PG8_WAIT_L(0); PG8_BAR; PG8_MMA(0, 0, At, B0); PG8_MMA(0, 1, At, B1); PG8_BAR; PG8_SCHED;
            PG8_LDA(At, 0, 1); PG8_STAGE(PG8_SB(0, 0), b2, voffB); PG8_STAGE(PG8_SB(0, 1), b2 + hstepB, voffB); PG8_STAGE(PG8_SA(0, 0), a2, voffA);
            PG8_WAIT_V(8); PG8_WAIT_L(0); PG8_BAR; PG8_MMA(1, 0, At, B0); PG8_MMA(1, 1, At, B1); PG8_BAR; PG8_SCHED;
            PG8_LDB(B0, 1, 0); PG8_LDB(B1, 1, 1); PG8_SCHED; PG8_LDA(At, 1, 0); PG8_STAGE(PG8_SA(0, 1), a2 + hstepA, voffA);
            PG8_WAIT_V(8); PG8_WAIT_L(0); PG8_BAR; PG8_MMA(0, 0, At, B0); PG8_MMA(0, 1, At, B1); PG8_BAR; PG8_SCHED;
            PG8_LDA(At, 1, 1); PG8_STAGE(PG8_SB(1, 0), b3, voffB); PG8_STAGE(PG8_SB(1, 1), b3 + hstepB, voffB); PG8_STAGE(PG8_SA(1, 0), a3, voffA);
            PG8_WAIT_V(8); PG8_WAIT_L(0); PG8_BAR; PG8_MMA(1, 0, At, B0); PG8_MMA(1, 1, At, B1); PG8_BAR; PG8_SCHED;
            } else {
            PG8_LDB(B0, 0, 0); PG8_SCHED; PG8_LDA(At, 0, 0); PG8_STAGE(PG8_SA(1, 1), a1 + hstepA, voffA);
            PG8_WAIT_L(8); PG8_BAR; PG8_WAIT_L(0); PG8_MMA(0, 0, At, B0); PG8_BAR; PG8_SCHED;
            PG8_LDB(B1, 0, 1); PG8_STAGE(PG8_SB(0, 0), b2, voffB);
            PG8_BAR; PG8_WAIT_L(0); PG8_MMA(0, 1, At, B1); PG8_BAR;
            PG8_LDA(At, 0, 1); PG8_STAGE(PG8_SA(0, 0), a2, voffA);
            PG8_BAR; PG8_WAIT_L(0); PG8_MMA(1, 0, At, B0); PG8_BAR; PG8_SCHED;
            PG8_STAGE(PG8_SB(0, 1), b2 + hstepB, voffB);
            PG8_WAIT_V(6); PG8_BAR; PG8_MMA(1, 1, At, B1); PG8_BAR;
            PG8_LDB(B0, 1, 0); PG8_SCHED; PG8_LDA(At, 1, 0); PG8_STAGE(PG8_SA(0, 1), a2 + hstepA, voffA);
            PG8_WAIT_L(8); PG8_BAR; PG8_WAIT_L(0); PG8_MMA(0, 0, At, B0); PG8_BAR; PG8_SCHED;
            PG8_LDB(B1, 1, 1); PG8_STAGE(PG8_SB(1, 0), b3, voffB);
            PG8_BAR; PG8_WAIT_L(0); PG8_MMA(0, 1, At, B1); PG8_BAR;
            PG8_LDA(At, 1, 1); PG8_STAGE(PG8_SA(1, 0), a3, voffA);
            PG8_BAR; PG8_WAIT_L(0); PG8_MMA(1, 0, At, B0); PG8_BAR; PG8_SCHED;
            PG8_STAGE(PG8_SB(1, 1), b3 + hstepB, voffB);
            PG8_WAIT_V(6); PG8_BAR; PG8_MMA(1, 1, At, B1); PG8_BAR;
            }
        }
        if constexpr (ALIGN_EPI) { if (wr == 0) PG8_BAR; }
        if constexpr (!Epi::AFTER_DRAIN) { E(acc, cur, wr, wc, fr, fq); S.done(cur); }
        if (!has_next) break;
#pragma unroll
        for (int a = 0; a < 2; ++a)
#pragma unroll
            for (int b = 0; b < 2; ++b)
#pragma unroll
                for (int m = 0; m < 4; ++m)
#pragma unroll
                    for (int n = 0; n < 2; ++n) acc[a][b][m][n] = (f32x4){0.f, 0.f, 0.f, 0.f};
        cur = nxt; cA = nA; cB = nB; ++ui;
        if constexpr (ALIGN_EPI) { if (wr == 1) PG8_BAR; }
    }
    PG8_WAIT_V(0);
    if constexpr (!ALIGN_EPI) { if (wr == 0) PG8_BAR; }
    PG8_BAR;
    if constexpr (Epi::AFTER_DRAIN) { E.fused(acc, cur, wr, wc, fr, fq, lds, wid, lane); S.done(cur); }
#undef PG8_SA
#undef PG8_SB
#undef PG8_STAGE
#undef PG8_LDA
#undef PG8_LDB
#undef PG8_MMA
#undef PG8_WAIT_V
#undef PG8_WAIT_L
#undef PG8_BAR
#undef PG8_SCHED
}
}
#include <hip/hip_bf16.h>
#include <cmath>
namespace attn_body {
using bf16=__hip_bfloat16;
using bf16x8=__attribute__((ext_vector_type(8)))short;
using s16x4=__attribute__((ext_vector_type(4)))short;
using f32x16=__attribute__((ext_vector_type(16)))float;
using u32x4=__attribute__((ext_vector_type(4)))unsigned;
using f32x4=__attribute__((ext_vector_type(4)))float;
constexpr int BATCH=4,NHEAD=8,SEQ=4096,D=64,DM=NHEAD*D,OPITCH=1024;
constexpr int NW=8,QBLK=32,QB=QBLK*NW,KVBLK=64,NQB=SEQ/QB;
constexpr int ATTN_PITCH=DM, ATTN_UNIT_ROWS=QB;
__device__ __forceinline__ int crow(int r,int hi){return (r&3)+8*(r>>2)+4*hi;}
#define SBAR() __builtin_amdgcn_sched_barrier(0)
__device__ __forceinline__ void cmask(f32x16&p0,f32x16&p1,int jb,int qrel,int hi){
  const float NEG=-INFINITY; int kb=64*jb+4*hi;
  #pragma unroll
  for(int r=0;r<16;++r){int kv=kb+(r&3)+8*(r>>2); if(kv>qrel)p0[r]=NEG; if(kv+32>qrel)p1[r]=NEG;}
}

constexpr int NSLOT=3, SLOTB=8192;
constexpr int LDS_K=0, LDS_V=NSLOT*SLOTB, LDS_WS=2*NSLOT*SLOTB, LDS_OST=LDS_WS+NW*64*4, LDS_CB=LDS_OST+NW*4096, LDS_BYTES=LDS_CB+SEQ*4;
constexpr float C2=0.125f*1.4426950408889634f;
__device__ __forceinline__ void glds16(const void*gsrc,unsigned lds_dst){unsigned keep;
  asm volatile("s_mov_b32 %0, m0\n\ts_mov_b32 m0, %2\n\ts_nop 0\n\tglobal_load_lds_dwordx4 %1, off\n\ts_mov_b32 m0, %0":"=&s"(keep):"v"(gsrc),"s"(lds_dst):"memory");}
__device__ __forceinline__ float max3f(float a,float b,float c){float r;asm("v_max3_f32 %0, %1, %2, %3":"=v"(r):"v"(a),"v"(b),"v"(c));return r;}
__device__ __forceinline__ float max2f(float a,float b){float r;asm("v_max_f32_e32 %0, %1, %2":"=v"(r):"v"(a),"v"(b));return r;}
__device__ __forceinline__ float fadd_s(float a,float b){float r;asm("v_add_f32_e32 %0, %1, %2":"=v"(r):"v"(a),"v"(b));return r;}
__device__ __forceinline__ float fsub_s(float a,float b){float r;asm("v_sub_f32_e32 %0, %1, %2":"=v"(r):"v"(a),"v"(b));return r;}
typedef float f32x2_t __attribute__((ext_vector_type(2))); typedef __bf16 bf16x2_t __attribute__((ext_vector_type(2)));
__device__ __forceinline__ unsigned cvtpk_s(float lo,float hi){f32x2_t v={lo,hi};bf16x2_t b=__builtin_convertvector(v,bf16x2_t);return __builtin_bit_cast(unsigned,b);}
#define WAIT_BAR(N) asm volatile("s_waitcnt vmcnt(" #N ") lgkmcnt(0)\n\ts_barrier":::"memory")

__device__ __forceinline__ void qkt(f32x16&p0,f32x16&p1,const char*Kslot,const bf16x8*qr,const char*cbt,int r32,int hi){
  const char*kb=Kslot+hi*1024+r32*16;
  #pragma unroll
  for(int a=0;a<4;++a){ const f32x4 u0=*reinterpret_cast<const f32x4*>(cbt+hi*16+a*32), u1=*reinterpret_cast<const f32x4*>(cbt+128+hi*16+a*32);
    p0[4*a]=u0[0];p0[4*a+1]=u0[1];p0[4*a+2]=u0[2];p0[4*a+3]=u0[3]; p1[4*a]=u1[0];p1[4*a+1]=u1[1];p1[4*a+2]=u1[2];p1[4*a+3]=u1[3]; }
  #pragma unroll
  for(int d0=0;d0<4;++d0){
    const bf16x8 b0=*reinterpret_cast<const bf16x8*>(kb+d0*2048);
    const bf16x8 b1=*reinterpret_cast<const bf16x8*>(kb+d0*2048+512);
    p0=__builtin_amdgcn_mfma_f32_32x32x16_bf16(b0,qr[d0],p0,0,0,0);p1=__builtin_amdgcn_mfma_f32_32x32x16_bf16(b1,qr[d0],p1,0,0,0);}
}
typedef __attribute__((address_space(3))) const char* lds_cptr;
typedef short v4i16_t __attribute__((ext_vector_type(4)));
__device__ __forceinline__ void kload8(bf16x8*kf,lds_cptr kp){
  kf[0]=*(const __attribute__((address_space(3))) bf16x8*)(kp);      kf[1]=*(const __attribute__((address_space(3))) bf16x8*)(kp+512);
  kf[2]=*(const __attribute__((address_space(3))) bf16x8*)(kp+2048); kf[3]=*(const __attribute__((address_space(3))) bf16x8*)(kp+2560);
  kf[4]=*(const __attribute__((address_space(3))) bf16x8*)(kp+4096); kf[5]=*(const __attribute__((address_space(3))) bf16x8*)(kp+4608);
  kf[6]=*(const __attribute__((address_space(3))) bf16x8*)(kp+6144); kf[7]=*(const __attribute__((address_space(3))) bf16x8*)(kp+6656);
}
__device__ __forceinline__ void kload2(bf16x8*kf,lds_cptr kp,int j){ kf[2*j]=*(const __attribute__((address_space(3))) bf16x8*)(kp+j*2048); kf[2*j+1]=*(const __attribute__((address_space(3))) bf16x8*)(kp+j*2048+512); }
__device__ __forceinline__ s16x4 vtr(lds_cptr p){ return __builtin_bit_cast(s16x4,__builtin_amdgcn_ds_read_tr16_b64_v4i16((__attribute__((address_space(3))) v4i16_t*)p)); }
__device__ __forceinline__ float rowmax(const f32x16&p0,const f32x16&p1){
  float a=max3f(p0[0],p0[1],p1[0]),b=max3f(p0[2],p0[3],p1[1]);a=max3f(a,p1[2],p1[3]);
  #pragma unroll
  for(int r=4;r<16;r+=4){a=max3f(a,p0[r],p0[r+1]);b=max3f(b,p0[r+2],p0[r+3]);a=max3f(a,p1[r],p1[r+1]);b=max3f(b,p1[r+2],p1[r+3]);}
  const float m=max2f(a,b);
  auto rr=__builtin_amdgcn_permlane32_swap(__float_as_uint(m),__float_as_uint(m),false,false);
  return max2f(__uint_as_float(rr[0]),__uint_as_float(rr[1]));
}
__device__ __forceinline__ void pv(f32x16*o,int vb,bf16x8 pa0,bf16x8 pa1,bf16x8 pa2,bf16x8 pa3){
  #pragma unroll
  for(int d0=0;d0<2;++d0){s16x4 lo[4],hi[4];
    #pragma unroll
    for(int ks=0;ks<4;++ks){
      asm volatile("ds_read_b64_tr_b16 %0,%1 offset:%c2":"=&v"(lo[ks]):"v"(vb),"i"(d0*4096+ks*1024):"memory");
      asm volatile("ds_read_b64_tr_b16 %0,%1 offset:%c2":"=&v"(hi[ks]):"v"(vb),"i"(d0*4096+ks*1024+512):"memory");}
    asm volatile("s_waitcnt lgkmcnt(0)":::"memory");SBAR();
    #define PK(k) (bf16x8){lo[k][0],lo[k][1],lo[k][2],lo[k][3],hi[k][0],hi[k][1],hi[k][2],hi[k][3]}
    o[d0]=__builtin_amdgcn_mfma_f32_32x32x16_bf16(pa0,PK(0),o[d0],0,0,0);
    o[d0]=__builtin_amdgcn_mfma_f32_32x32x16_bf16(pa1,PK(1),o[d0],0,0,0);
    o[d0]=__builtin_amdgcn_mfma_f32_32x32x16_bf16(pa2,PK(2),o[d0],0,0,0);
    o[d0]=__builtin_amdgcn_mfma_f32_32x32x16_bf16(pa3,PK(3),o[d0],0,0,0);
    #undef PK
  }
}

#ifndef ATTN_STORE16
#define ATTN_STORE16(p,v) (*(u32x4*)(p)=(v))
#endif
template<int THRL> __device__ __forceinline__ void attn_unit(int b,int h,int qb,const bf16*Q,const bf16*__restrict__ K,const bf16*__restrict__ V,bf16*O,const float*__restrict__ CB,const float*__restrict__ NRM,char*shm,bool dry=false){
  int tid_=threadIdx.x; asm volatile("":"+v"(tid_)); const int tid=tid_,lane=tid&63,r32=lane&31,hi=lane>>5; const int wid=__builtin_amdgcn_readfirstlane(tid>>6);
  const long rowbase=(long)b*SEQ; const int q0=qb*QB;
  int t0;
  { const f32x4* cbg=reinterpret_cast<const f32x4*>(CB+(long)(b*NHEAD+h)*SEQ); f32x4* cbl=reinterpret_cast<f32x4*>(shm+LDS_CB); const int nv=(q0+QB)/4;
    for(int i=tid;i<nv;i+=NW*64) cbl[i]=cbg[i];
    const float bnd=NRM[b*NHEAD+h]+36.f;
    asm volatile("s_waitcnt vmcnt(0) lgkmcnt(0)\n\ts_barrier":::"memory");
    const float*cbf=reinterpret_cast<const float*>(shm+LDS_CB); const int tc=2*lane; const int NT0=(q0+QB)/KVBLK;
    const bool ok=(tc<=NT0-4)&&(tc==0||cbf[64*tc-1]+bnd<=cbf[q0]);
    const unsigned long long mk=__ballot(ok); t0=2*(__popcll(mk)-1); t0=__builtin_amdgcn_readfirstlane(t0); }
  const bf16*Qw=Q+(rowbase+q0+wid*QBLK)*DM+h*D;
  const bf16*Kh=K+(rowbase+(long)t0*KVBLK)*DM+h*D,*Vh=V+(rowbase+(long)t0*KVBLK)*DM+h*D;
  const unsigned lds0=(unsigned)(uintptr_t)shm;
  float*wsf=(float*)(shm+LDS_WS)+wid*64;
  const bf16*ksrc=Kh+(long)lane*DM+wid*8;
  const bf16*vsrc=Vh+(long)(16*(wid&3)+(lane>>2))*DM+(wid>>2)*32+(lane&3)*8;
  const unsigned kdst=lds0+LDS_K+wid*1024, vdst=lds0+LDS_V+wid*1024;
  #define DMA_K(t,slot) glds16(ksrc+(long)(t)*KVBLK*DM,(unsigned)__builtin_amdgcn_readfirstlane(kdst+(slot)))
  #define DMA_V(t,slot) glds16(vsrc+(long)(t)*KVBLK*DM,(unsigned)__builtin_amdgcn_readfirstlane(vdst+(slot)))
  const int vb0=(int)(lds0+LDS_V)+((lane>>4)&1)*32+(lane&3)*8+(4*hi+((lane&15)>>2))*64;
  const char*Kbase=shm+LDS_K; bf16x8 kf[8];
  const lds_cptr shm3=(lds_cptr)shm; const lds_cptr kp0=shm3+LDS_K+hi*1024+r32*16; const lds_cptr vp0=shm3+LDS_V+((lane>>4)&1)*32+(lane&3)*8+(4*hi+((lane&15)>>2))*64;
  const int NT=(q0+QB)/KVBLK-t0;
  const lds_cptr cb3=(lds_cptr)shm+LDS_CB+t0*256;
  const float cb_own=*(const __attribute__((address_space(3))) float*)((lds_cptr)shm+LDS_CB+(q0+wid*QBLK+r32)*4);
  DMA_K(0,0);DMA_V(0,0);DMA_K(1,SLOTB);
  bf16x8 qr[4];
  #pragma unroll
  for(int d0=0;d0<4;++d0)qr[d0]=*reinterpret_cast<const bf16x8*>(&Qw[(long)r32*DM+d0*16+hi*8]);
  float mhat=0.f,l_reg=0.f;f32x16 o[2];o[0]=f32x16{};o[1]=f32x16{};
  const int qrel=wid*QBLK+r32;
  #define CMASK(P0,P1,t) do{int jb_=(t)-(NT-4); if(jb_>=0)cmask(P0,P1,jb_,qrel,hi);}while(0)
  bool resc=false;
  #define START(P0,P1) do{ const float rm=max2f(rowmax(P0,P1),cb_own); resc=false; \
    { const float dl=rm; mhat=fadd_s(mhat,dl); \
      _Pragma("unroll") for(int r=0;r<16;++r){P0[r]=fsub_s(P0[r],dl);P1[r]=fsub_s(P1[r],dl);} } \
    _Pragma("unroll") for(int r=0;r<16;++r)P0[r]=__builtin_amdgcn_exp2f(P0[r]); }while(0)
  #define RESC() do{ if(resc){ asm volatile("s_waitcnt lgkmcnt(0)":::"memory"); \
      _Pragma("unroll") for(int d_=0;d_<2;++d_) _Pragma("unroll") for(int r=0;r<16;++r)o[d_][r]*=wsf[crow(r,hi)]; } }while(0)
  f32x16 pA0,pA1,pB0,pB1;
  int sl_prev=0,sl_cur=0,sl_next=SLOTB;
  #define ROT() do{sl_prev=sl_cur;sl_cur=sl_next;sl_next=(sl_next==(NSLOT-1)*SLOTB)?0:sl_next+SLOTB;}while(0)
  DMA_K(2,2*SLOTB);
  WAIT_BAR(3);
  qkt(pA0,pA1,Kbase,qr,shm+LDS_CB+t0*256,r32,hi);asm volatile("s_nop 15\n\ts_nop 7":"+v"(pA0),"+v"(pA1));CMASK(pA0,pA1,0);
  START(pA0,pA1);
  _Pragma("unroll") for(int r=0;r<16;++r)pA1[r]=__builtin_amdgcn_exp2f(pA1[r]);
  WAIT_BAR(0);
  DMA_K(3,0);DMA_V(1,SLOTB);
  ROT();
  kload8(kf,kp0+sl_cur);
  WAIT_BAR(2);
  s16x4 vlo[8],vhi[8]; u32x4 pw0,pw1,pw2,pw3;
  #define PKW(P,B) cvtpk_s(P[B],P[B+1])
  #define PAF(k) __builtin_bit_cast(bf16x8,pw##k)
  #define VFR(i) (bf16x8){vlo[i][0],vlo[i][1],vlo[i][2],vlo[i][3],vhi[i][0],vhi[i][1],vhi[i][2],vhi[i][3]}
  #define PIN(x) asm volatile("":"+v"(x))
  #define MX3(a,b,c) __builtin_fmaxf(__builtin_fmaxf((a),(b)),(c))
  #define GAPA(MF,A0,A1,A2,A3,W0,W1,PW) do{ MF; sacc+=A0; sacc+=A1; sacc+=A2; sacc+=A3; PIN(sacc); W0; W1; PIN(PW); SBAR(); }while(0)
  #define EX(v) __builtin_amdgcn_exp2f(v)
  #define GAPB(MF,X,B) do{ MF; X[B]=EX(X[B]); X[B+1]=EX(X[B+1]); X[B+2]=EX(X[B+2]); X[B+3]=EX(X[B+3]); PIN(X); SBAR(); }while(0)
  #define VRD(i) do{ vlo[i]=vtr(vp_+(((i)>>2)*4096+((i)&3)*1024)); vhi[i]=vtr(vp_+(((i)>>2)*4096+((i)&3)*1024+512)); }while(0)
  #define KRD(G,j) do{ if(G){ kload2(kf,kp0+sl_next,j); SBAR(); } }while(0)
  #define STEP(C0,C1,P0,P1,t,GK,GV,GL) do{ SBAR(); \
    const lds_cptr vp_=vp0+sl_prev; \
    VRD(0); SBAR(); float sacc=(P0[0]+P0[1]); \
    GAPA(C0=__builtin_amdgcn_mfma_f32_32x32x16_bf16(kf[0],qr[0],C0,0,0,0), P0[2],P0[3],P0[4],P0[5],     pw0[0]=PKW(P0,0), pw0[1]=PKW(P0,2), pw0); \
    VRD(4); SBAR(); GAPA(C1=__builtin_amdgcn_mfma_f32_32x32x16_bf16(kf[1],qr[0],C1,0,0,0), P0[6],P0[7],P0[8],P0[9],     pw0[2]=PKW(P0,4), pw0[3]=PKW(P0,6), pw0); \
    VRD(1); SBAR(); GAPA(C0=__builtin_amdgcn_mfma_f32_32x32x16_bf16(kf[2],qr[1],C0,0,0,0),   P0[10],P0[11],P0[12],P0[13], pw1[0]=PKW(P0,8), pw1[1]=PKW(P0,10), pw1); \
    VRD(5); SBAR(); GAPA(C1=__builtin_amdgcn_mfma_f32_32x32x16_bf16(kf[3],qr[1],C1,0,0,0),   P0[14],P0[15],P1[0],P1[1],   pw1[2]=PKW(P0,12),pw1[3]=PKW(P0,14), pw1); \
    VRD(2); SBAR(); GAPA(C0=__builtin_amdgcn_mfma_f32_32x32x16_bf16(kf[4],qr[2],C0,0,0,0),   P1[2],P1[3],P1[4],P1[5],     pw2[0]=PKW(P1,0), pw2[1]=PKW(P1,2), pw2); \
    VRD(6); SBAR(); GAPA(C1=__builtin_amdgcn_mfma_f32_32x32x16_bf16(kf[5],qr[2],C1,0,0,0),   P1[6],P1[7],P1[8],P1[9],     pw2[2]=PKW(P1,4), pw2[3]=PKW(P1,6), pw2); \
    VRD(3); SBAR(); GAPA(C0=__builtin_amdgcn_mfma_f32_32x32x16_bf16(kf[6],qr[3],C0,0,0,0),   P1[10],P1[11],P1[12],P1[13], pw3[0]=PKW(P1,8), pw3[1]=PKW(P1,10), pw3); \
    VRD(7); SBAR(); GAPA(C1=__builtin_amdgcn_mfma_f32_32x32x16_bf16(kf[7],qr[3],C1,0,0,0),   P1[14],P1[15],0.f,0.f,       pw3[2]=PKW(P1,12),pw3[3]=PKW(P1,14), pw3); \
    l_reg+=sacc; \
    if(GK){DMA_K((t)+3,sl_cur);} if(GV){DMA_V((t)+1,sl_next);} \
    CMASK(C0,C1,t); \
    { float a=MX3(C0[0],C0[1],C1[0]),b=MX3(C0[2],C0[3],C1[1]); a=MX3(a,C1[2],C1[3]); \
      _Pragma("unroll") for(int r=4;r<16;r+=4){a=MX3(a,C0[r],C0[r+1]);b=MX3(b,C0[r+2],C0[r+3]);a=MX3(a,C1[r],C1[r+1]);b=MX3(b,C1[r+2],C1[r+3]);} \
      float rm=__builtin_fmaxf(a,b); { auto rr=__builtin_amdgcn_permlane32_swap(__float_as_uint(rm),__float_as_uint(rm),false,false); rm=__builtin_fmaxf(__uint_as_float(rr[0]),__uint_as_float(rr[1])); } \
      resc=false; \
      if(__builtin_expect(__any(rm>(float)THRL),0)){ const float dl=__builtin_fmaxf(rm,0.f); mhat+=dl; \
        _Pragma("unroll") for(int r=0;r<16;++r){C0[r]-=dl;C1[r]-=dl;} \
        const float f=__builtin_amdgcn_exp2f(-dl); l_reg*=f; if(hi==0)wsf[r32]=f; resc=true; } } \
    SBAR(); \
    { const __attribute__((address_space(3))) f32x4* cbp_=(const __attribute__((address_space(3))) f32x4*)(cb3+((t)+1)*256+hi*16); \
      _Pragma("unroll") for(int a_=0;a_<4;++a_){ const f32x4 u0_=cbp_[2*a_], u1_=cbp_[8+2*a_]; \
        P0[4*a_]=u0_[0];P0[4*a_+1]=u0_[1];P0[4*a_+2]=u0_[2];P0[4*a_+3]=u0_[3]; P1[4*a_]=u1_[0];P1[4*a_+1]=u1_[1];P1[4*a_+2]=u1_[2];P1[4*a_+3]=u1_[3]; } } SBAR(); \
    GAPB(o[0]=__builtin_amdgcn_mfma_f32_32x32x16_bf16(PAF(0),VFR(0),o[0],0,0,0), C0,0); \
    GAPB(o[1]=__builtin_amdgcn_mfma_f32_32x32x16_bf16(PAF(0),VFR(4),o[1],0,0,0), C0,4); \
    KRD(GL,0); GAPB(o[0]=__builtin_amdgcn_mfma_f32_32x32x16_bf16(PAF(1),VFR(1),o[0],0,0,0), C0,8); \
    KRD(GL,1); GAPB(o[1]=__builtin_amdgcn_mfma_f32_32x32x16_bf16(PAF(1),VFR(5),o[1],0,0,0), C0,12); \
    KRD(GL,2); GAPB(o[0]=__builtin_amdgcn_mfma_f32_32x32x16_bf16(PAF(2),VFR(2),o[0],0,0,0), C1,0); \
    KRD(GL,3); GAPB(o[1]=__builtin_amdgcn_mfma_f32_32x32x16_bf16(PAF(2),VFR(6),o[1],0,0,0), C1,4); \
    GAPB(o[0]=__builtin_amdgcn_mfma_f32_32x32x16_bf16(PAF(3),VFR(3),o[0],0,0,0), C1,8); \
    GAPB(o[1]=__builtin_amdgcn_mfma_f32_32x32x16_bf16(PAF(3),VFR(7),o[1],0,0,0), C1,12); \
    _Pragma("unroll") for(int r_=0;r_<16;++r_){P0[r_]-=mhat;P1[r_]-=mhat;} \
    }while(0)
  { const __attribute__((address_space(3))) f32x4* cbp_=(const __attribute__((address_space(3))) f32x4*)(cb3+256+hi*16);
    #pragma unroll
    for(int a_=0;a_<4;++a_){ const f32x4 u0_=cbp_[2*a_], u1_=cbp_[8+2*a_];
      pB0[4*a_]=u0_[0]-mhat;pB0[4*a_+1]=u0_[1]-mhat;pB0[4*a_+2]=u0_[2]-mhat;pB0[4*a_+3]=u0_[3]-mhat;
      pB1[4*a_]=u1_[0]-mhat;pB1[4*a_+1]=u1_[1]-mhat;pB1[4*a_+2]=u1_[2]-mhat;pB1[4*a_+3]=u1_[3]-mhat; } }
  int t=1;
  #undef CMASK
  #define CMASK(P0,P1,t) do{}while(0)
  for(;t+5<NT;t+=2){
    STEP(pB0,pB1,pA0,pA1,t,true,true,true);     WAIT_BAR(2); RESC(); ROT();
    STEP(pA0,pA1,pB0,pB1,t+1,true,true,true);   WAIT_BAR(2); RESC(); ROT();
  }
  #undef CMASK
  #define CMASK(P0,P1,t) do{int jb_=(t)-(NT-4); if(jb_>=0)cmask(P0,P1,jb_,qrel,hi);}while(0)
  #define ENDW(tt) do{ if((tt)+3<NT){WAIT_BAR(2);} else if((tt)+2<NT){WAIT_BAR(1);} else {WAIT_BAR(0);} }while(0)
  for(;t+1<NT;t+=2){
    STEP(pB0,pB1,pA0,pA1,t,(t+3<NT),(t+1<NT),(t+1<NT));       ENDW(t);   RESC(); ROT();
    STEP(pA0,pA1,pB0,pB1,t+1,(t+4<NT),(t+2<NT),(t+2<NT));     ENDW(t+1); RESC(); ROT();
  }
  STEP(pB0,pB1,pA0,pA1,NT-1,false,false,false); RESC();
  { float sacc=pB0[0]+pB0[1]; _Pragma("unroll") for(int r=2;r<16;++r)sacc+=pB0[r]; _Pragma("unroll") for(int r=0;r<16;++r)sacc+=pB1[r]; l_reg+=sacc;
    pw0=(u32x4){PKW(pB0,0),PKW(pB0,2),PKW(pB0,4),PKW(pB0,6)};pw1=(u32x4){PKW(pB0,8),PKW(pB0,10),PKW(pB0,12),PKW(pB0,14)};pw2=(u32x4){PKW(pB1,0),PKW(pB1,2),PKW(pB1,4),PKW(pB1,6)};pw3=(u32x4){PKW(pB1,8),PKW(pB1,10),PKW(pB1,12),PKW(pB1,14)};
    SBAR(); pv(o,vb0+sl_cur,PAF(0),PAF(1),PAF(2),PAF(3)); }
  #undef PKW
  #undef PAF
  #undef VFR
  #undef PIN
  #undef MX3
  #undef GAPA
  #undef GAPB
  #undef EX
  #undef VRD
  #undef KRD
  #undef STEP
  #undef ENDW
  {auto rr=__builtin_amdgcn_permlane32_swap(__float_as_uint(l_reg),__float_as_uint(l_reg),false,false);l_reg=__uint_as_float(rr[0])+__uint_as_float(rr[1]);}
  if(hi==0)wsf[32+r32]=l_reg;asm volatile("s_waitcnt lgkmcnt(0)":::"memory");
  float rli[16];
  #pragma unroll
  for(int r=0;r<16;++r)rli[r]=__builtin_amdgcn_rcpf(wsf[32+crow(r,hi)]);
  bf16*Ow=O+(rowbase+q0+wid*QBLK)*OPITCH+h*D;
  { bf16*stg=(bf16*)(shm+LDS_OST)+wid*2048;
    #pragma unroll
    for(int r=0;r<16;++r){const int orow=crow(r,hi);
      #pragma unroll
      for(int d0=0;d0<2;++d0)stg[orow*64+d0*32+r32]=__float2bfloat16(o[d0][r]*rli[r]);}
    asm volatile("s_waitcnt lgkmcnt(0)":::"memory");
    #pragma unroll
    for(int i=0;i<4;++i){const int row=i*8+(lane>>3),ch=lane&7; const u32x4 v=*(const u32x4*)(stg+row*64+ch*8); bf16*dst=Ow+(long)row*OPITCH+ch*8; const u32x4 gv=*(const u32x4*)dst; u32x4 w;
      #pragma unroll
      for(int j=0;j<4;++j){ const float a0=__uint_as_float(v[j]<<16)*__uint_as_float(gv[j]<<16), a1=__uint_as_float(v[j]&0xffff0000u)*__uint_as_float(gv[j]&0xffff0000u); w[j]=cvtpk_s(a0,a1); }
      if(!dry)*(u32x4*)dst=w;} }
  asm volatile("s_waitcnt lgkmcnt(0)\n\ts_barrier":::"memory");
  #undef DMA_K
  #undef DMA_V
  #undef CMASK
  #undef START
  #undef RESC
  #undef ROT
}
constexpr int ATTN_LDS_BYTES=LDS_BYTES;
struct AttnTensors { const bf16* Q; const bf16* K; const bf16* V; bf16* O; const float* CB; const float* NRM; };
struct AttnUnit { int bh; int qb; };
struct StaticOrder {
  int vcu;
  __device__ __forceinline__ explicit StaticOrder(int grid,int block):vcu((block%8)*(grid/8)+block/8){}
  __device__ __forceinline__ bool next(int i,AttnUnit&u)const{ if(i>=2)return false; const int s=vcu&7; u.bh=vcu>>3; u.qb=(i==0)?15-s:s; return true; }
  __device__ __forceinline__ void a_ready(const AttnUnit&)const{}
  __device__ __forceinline__ void done(const AttnUnit&)const{}
};
template<class Sched,int THRL=8> __device__ __forceinline__ void attn_phase(char*lds,const AttnTensors&T,const Sched&S,bool dry=false){
  AttnUnit u;
  for(int i=0;S.next(i,u);++i){ S.a_ready(u); attn_unit<THRL>(u.bh/NHEAD,u.bh%NHEAD,u.qb,T.Q,T.K,T.V,T.O,T.CB,T.NRM,lds,dry); S.done(u); }
}
#undef SBAR
#undef WAIT_BAR
}
#include <hip/hip_cooperative_groups.h>
namespace cg = cooperative_groups;
#define LAS __attribute__((address_space(3)))
typedef unsigned short bf16;
typedef float f32x4 __attribute__((ext_vector_type(4)));
typedef float f32x2 __attribute__((ext_vector_type(2)));
typedef unsigned u32x4 __attribute__((ext_vector_type(4)));
typedef unsigned u32x2 __attribute__((ext_vector_type(2)));
typedef short bf16x8 __attribute__((ext_vector_type(8)));
typedef short bf16x4 __attribute__((ext_vector_type(4)));

constexpr int NWAVES = 8, NTHR = 512;
constexpr int BATCH = 4, SEQ = 4096, DM = 1024, DEPTH = 4, M = BATCH * SEQ;
constexpr int NIN = 3592, NF = 3584;
constexpr int T5 = 32, NCH5 = M / T5, KA5 = 640, NG5 = 16;
constexpr float EPS = 1e-6f;
constexpr float LOG2E = 1.4426950408889634f;

constexpr size_t MiB = 1u << 20;
constexpr size_t WS_WIN = 1 * MiB, WS_WO = 31 * MiB, WS_WGLU = 39 * MiB, WS_ROPE = 40 * MiB, WS_MF = 41 * MiB, WS_WB = 81 * MiB;
constexpr size_t WS_LAM = 90 * MiB, WS_LOGF = 90 * MiB + 65536, WS_CB = WS_LOGF + 524288, WS_SS = WS_CB + 524288, WS_NRM = WS_SS + 131072, WS_XBUF = WS_NRM + 4096;
constexpr size_t WS_XN = 92 * MiB, WS_E = WS_XN, WS_UPD = WS_XN + 4 * MiB, WS_STATE = WS_XN + 20 * MiB;
constexpr size_t WS_QO = 124 * MiB, WS_KB = 140 * MiB, WS_VB = 156 * MiB, WS_SUA = 172 * MiB, WS_RQ = 182 * MiB, WS_RK = 190 * MiB, WS_RKT = 198 * MiB, WS_YS5 = WS_XN + 4 * MiB;
constexpr size_t WS_RVT = 206 * MiB, WS_GATE = 214 * MiB, WS_END = 246 * MiB;

constexpr int RING_BYTES = 131072, LDS_BYTES = 147456;

struct Args { const float* in[16]; float* out; unsigned char* ws; };

__device__ __forceinline__ float bf2f(unsigned short b) { return __uint_as_float((unsigned)b << 16); }
__device__ __forceinline__ float bflo(unsigned w) { return __uint_as_float(w << 16); }
__device__ __forceinline__ float bfhi(unsigned w) { return __uint_as_float(w & 0xffff0000u); }
__device__ __forceinline__ unsigned pk2(float lo, float hi) { return pg8::cvt_pk_bf16(lo, hi); }
__device__ __forceinline__ unsigned short f2bf(float f) { return (unsigned short)(pg8::cvt_pk_bf16(f, 0.f) & 0xffffu); }
__device__ __forceinline__ float wave_sum(float v) {
#pragma unroll
    for (int o = 1; o < 64; o <<= 1) v += __shfl_xor(v, o);
    return v;
}
__device__ __forceinline__ float lg2_gamma(int hh) { return __builtin_amdgcn_logf(1.0f - __builtin_amdgcn_exp2f(-5.0f - (float)hh)); }

__device__ __forceinline__ int win_col(int n) {
    if (n < 1536) return n;
    if (n < 1792) return n + 8;
    if (n < 2304) { const bool q = n < 2048; const int base = q ? 1792 : 2048; const int hh = (n - base) >> 6, pos = (n - base) & 63; const int d = (pos & 1) ? 32 + (pos >> 1) : (pos >> 1); return (q ? 1800 : 2056) + hh * 64 + d; }
    return n + 8;
}
template <bool MAP> __device__ __forceinline__ void p0_transpose_item(const float* W, int K, int Nsrc, int Ndst, bf16* WT, LAS float* scr, int item, int lane) {
    const int nblk = Ndst / 32, kb = item / nblk, nb = item % nblk, k0 = 64 * kb, n0 = 32 * nb;
    const int sc = MAP ? win_col(n0 + (lane & 31)) : n0 + (lane & 31);
    float wv[32];
#pragma unroll
    for (int i = 0; i < 32; ++i) { const int kk = 2 * i + (lane >> 5); wv[i] = (MAP && sc < 0) ? 0.f : W[(size_t)(k0 + kk) * Nsrc + (sc < 0 ? 0 : sc)]; }
#pragma unroll
    for (int i = 0; i < 32; ++i) { const int kk = 2 * i + (lane >> 5); scr[kk * 33 + (lane & 31)] = wv[i]; }
    asm volatile("s_waitcnt lgkmcnt(0)" ::: "memory");
    const int c = lane & 7;
#pragma unroll
    for (int j = 0; j < 4; ++j) { const int n = (lane >> 3) + 8 * j; const LAS float* s = scr + (8 * c) * 33 + n;
        u32x4 o; o.x = pk2(s[0 * 33], s[1 * 33]); o.y = pk2(s[2 * 33], s[3 * 33]); o.z = pk2(s[4 * 33], s[5 * 33]); o.w = pk2(s[6 * 33], s[7 * 33]);
        *(u32x4*)(WT + (size_t)(n0 + n) * K + k0 + 8 * c) = o; }
    asm volatile("s_waitcnt lgkmcnt(0)" ::: "memory");
}

__device__ __forceinline__ void s5_prep(const Args& a, int l, int g, LAS float* L, int tid) {
    LAS float* LPr = L;
    LAS float* LPi = L + 33 * 64;
    LAS float* Bbr = L + 66 * 64;
    LAS float* Bbi = Bbr + 1024;
    LAS float* Cr = Bbi + 1024;
    LAS float* Ci = Cr + 1024;
    LAS float* KT = Ci + 1024;
    const float* a_re = a.in[4] + (size_t)(l * 16 + g) * 64; const float* a_im = a.in[5] + (size_t)(l * 16 + g) * 64;
    const float* b_re = a.in[6] + (size_t)(l * 16 + g) * 1024; const float* b_im = a.in[7] + (size_t)(l * 16 + g) * 1024;
    const float* c_re = a.in[8] + (size_t)(l * 16 + g) * 1024; const float* c_im = a.in[9] + (size_t)(l * 16 + g) * 1024;
    const float log_dt = a.in[11][l * 16 + g];
    bf16* MF = (bf16*)(a.ws + WS_MF) + (size_t)(l * 16 + g) * 512 * KA5;
    bf16* WB = (bf16*)(a.ws + WS_WB) + (size_t)(l * 16 + g) * 128 * 512;
    float* LAM = (float*)(a.ws + WS_LAM) + (size_t)(l * 16 + g) * 128;
    if (tid < 64) {
        const int p = tid;
        const double dt = exp((double)log_dt), ar = (double)a_re[p], ai = (double)a_im[p];
        const double mag = exp(ar * dt); double sn, cs; sincos(ai * dt, &sn, &cs);
        const double lr = mag * cs, li = mag * sn, den = ar * ar + ai * ai;
        const double fr = ((lr - 1.0) * ar + li * ai) / den, fi = (li * ar - (lr - 1.0) * ai) / den;
#pragma unroll 4
        for (int h = 0; h < 16; ++h) { const double br = (double)b_re[p * 16 + h], bi = (double)b_im[p * 16 + h]; Bbr[p * 16 + h] = (float)(fr * br - fi * bi); Bbi[p * 16 + h] = (float)(fr * bi + fi * br); }
        double pr = 1.0, pi = 0.0;
        for (int j = 0; j <= 32; ++j) { LPr[j * 64 + p] = (float)pr; LPi[j * 64 + p] = (float)pi; const double nr = pr * lr - pi * li, ni = pr * li + pi * lr; pr = nr; pi = ni; }
        LAM[p] = LPr[32 * 64 + p]; LAM[64 + p] = LPi[32 * 64 + p];
    }
    for (int i = tid; i < 1024; i += NTHR) { const int h = i >> 6, p = i & 63; Cr[p * 16 + h] = c_re[i]; Ci[p * 16 + h] = c_im[i]; }
    __syncthreads();
    { const int j = tid >> 4, h = tid & 15; float acc[16];
#pragma unroll
      for (int e = 0; e < 16; ++e) acc[e] = 0.f;
      for (int p = 0; p < 64; ++p) { const float cr = Cr[p * 16 + h], ci = Ci[p * 16 + h], lr = LPr[j * 64 + p], li = LPi[j * 64 + p]; const float clr = cr * lr - ci * li, cli = cr * li + ci * lr;
#pragma unroll
          for (int q = 0; q < 4; ++q) { const f32x4 br = *(const LAS f32x4*)(Bbr + p * 16 + 4 * q), bi = *(const LAS f32x4*)(Bbi + p * 16 + 4 * q);
              acc[4 * q] += clr * br.x - cli * bi.x; acc[4 * q + 1] += clr * br.y - cli * bi.y; acc[4 * q + 2] += clr * br.z - cli * bi.z; acc[4 * q + 3] += clr * br.w - cli * bi.w; } }
#pragma unroll
      for (int e = 0; e < 16; ++e) KT[tid * 16 + e] = acc[e]; }
    __syncthreads();
    for (int q = tid; q < 512 * 64; q += NTHR) {
        const int row = q >> 6, cp = q & 63, s = cp >> 1, h0 = (cp & 1) * 8, t = row >> 4, h = row & 15;
        u32x4 o = (u32x4){0u, 0u, 0u, 0u};
        if (s <= t) { const LAS float* k = KT + ((t - s) * 16 + h) * 16 + h0; o.x = pk2(k[0], k[1]); o.y = pk2(k[2], k[3]); o.z = pk2(k[4], k[5]); o.w = pk2(k[6], k[7]); }
        *(u32x4*)(MF + (size_t)row * KA5 + cp * 8) = o;
    }
    for (int q = tid; q < 512 * 16; q += NTHR) {
        const int row = q >> 4, cp = q & 15, t = row >> 4, h = row & 15; float v[8];
#pragma unroll
        for (int e = 0; e < 8; ++e) { const int jj = cp * 8 + e, p = jj & 63; const float cr = Cr[p * 16 + h], ci = Ci[p * 16 + h], lr = LPr[(t + 1) * 64 + p], li = LPi[(t + 1) * 64 + p];
            v[e] = (jj < 64) ? (cr * lr - ci * li) : -(cr * li + ci * lr); }
        u32x4 o; o.x = pk2(v[0], v[1]); o.y = pk2(v[2], v[3]); o.z = pk2(v[4], v[5]); o.w = pk2(v[6], v[7]);
        *(u32x4*)(MF + (size_t)row * KA5 + 512 + cp * 8) = o;
    }
    for (int q = tid; q < 128 * 64; q += NTHR) {
        const int j = q >> 6, cp = q & 63, s = cp >> 1, h0 = (cp & 1) * 8, p = j & 63; const float lr = LPr[(31 - s) * 64 + p], li = LPi[(31 - s) * 64 + p]; float v[8];
#pragma unroll
        for (int e = 0; e < 8; ++e) { const float br = Bbr[p * 16 + h0 + e], bi = Bbi[p * 16 + h0 + e]; v[e] = (j < 64) ? (lr * br - li * bi) : (lr * bi + li * br); }
        u32x4 o; o.x = pk2(v[0], v[1]); o.y = pk2(v[2], v[3]); o.z = pk2(v[4], v[5]); o.w = pk2(v[6], v[7]);
        *(u32x4*)(WB + (size_t)j * 512 + cp * 8) = o;
    }
    __syncthreads();
}

__device__ __forceinline__ void norm0_phase(const Args& a, int lane, int gw, int NGW) {
    const float* X = a.in[0]; f32x4 gv[4];
#pragma unroll
    for (int j = 0; j < 4; ++j) gv[j] = *((const f32x4*)a.in[1] + lane + 64 * j);
    bf16* XN = (bf16*)(a.ws + WS_XN); float* SS = (float*)(a.ws + WS_SS);
    for (int m = gw; m < M; m += 2 * NGW) {
        const int m2 = m + NGW; const bool has2 = m2 < M;
        const f32x4* xr = (const f32x4*)(X + (size_t)m * DM) + lane; const f32x4* xr2 = (const f32x4*)(X + (size_t)(has2 ? m2 : m) * DM) + lane; f32x4 v[4], w[4];
#pragma unroll
        for (int j = 0; j < 4; ++j) { v[j] = xr[64 * j]; w[j] = xr2[64 * j]; }
        float ss = 0.f, ss2 = 0.f;
#pragma unroll
        for (int j = 0; j < 4; ++j) { ss += (v[j].x * v[j].x + v[j].y * v[j].y) + (v[j].z * v[j].z + v[j].w * v[j].w); ss2 += (w[j].x * w[j].x + w[j].y * w[j].y) + (w[j].z * w[j].z + w[j].w * w[j].w); }
        ss = wave_sum(ss); ss2 = wave_sum(ss2);
        unsigned long long* o8 = (unsigned long long*)(XN + (size_t)m * DM) + lane; unsigned long long* o82 = (unsigned long long*)(XN + (size_t)m2 * DM) + lane;
        const float r1_ = rsqrtf(ss * (1.f / DM) + EPS), r2_ = rsqrtf(ss2 * (1.f / DM) + EPS);
#pragma unroll
        for (int j = 0; j < 4; ++j) { v[j] = v[j] * gv[j] * r1_; o8[64 * j] = (unsigned long long)pk2(v[j].x, v[j].y) | ((unsigned long long)pk2(v[j].z, v[j].w) << 32);
            if (has2) { w[j] = w[j] * gv[j] * r2_; o82[64 * j] = (unsigned long long)pk2(w[j].x, w[j].y) | ((unsigned long long)pk2(w[j].z, w[j].w) << 32); } }
        if (lane == 0) { SS[m] = ss; if (has2) SS[m2] = ss2; }
    }
}
__device__ __forceinline__ void final_norm(const Args& a, float* X, const float* SS, int lane, int gw, int NGW) {
    f32x4 gv[4];
#pragma unroll
    for (int j = 0; j < 4; ++j) gv[j] = *((const f32x4*)a.in[15] + lane + 64 * j);
    for (int m = gw; m < M; m += 2 * NGW) {
        const int m2 = m + NGW; const bool has2 = m2 < M;
        f32x4* xr = (f32x4*)(X + (size_t)m * DM) + lane; f32x4* xr2 = (f32x4*)(X + (size_t)(has2 ? m2 : m) * DM) + lane; f32x4 v[4], w[4];
#pragma unroll
        for (int j = 0; j < 4; ++j) { v[j] = xr[64 * j]; w[j] = xr2[64 * j]; }
        const float r1 = rsqrtf(SS[m] * (1.f / DM) + EPS), r2 = rsqrtf(SS[has2 ? m2 : m] * (1.f / DM) + EPS);
#pragma unroll
        for (int j = 0; j < 4; ++j) { xr[64 * j] = v[j] * r1 * gv[j]; if (has2) xr2[64 * j] = w[j] * r2 * gv[j]; }
    }
}

__device__ __forceinline__ void flog_phase(const Args& a, int l, const float* SS, LAS float* WF, int tid, int lane, int wave, int blk, int nblk) {
    const float* win = a.in[2] + (size_t)l * DM * NIN;
    for (int i = tid; i < 2048; i += NTHR) { const int k = i >> 1, hf = i & 1; *(LAS f32x4*)(WF + k * 8 + hf * 4) = *(const f32x4*)(win + (size_t)k * NIN + 1536 + hf * 4); }
    __syncthreads();
    const bf16* XN = (const bf16*)(a.ws + WS_XN); float* LOGF = (float*)(a.ws + WS_LOGF);
    const float bfj = (lane < 8) ? a.in[3][l * 8 + lane] : 0.f;
    const int rows_per = M / nblk;
    for (int i = wave; i < rows_per; i += 2 * NWAVES) {
        const int m = blk * rows_per + i, m2 = m + NWAVES; const bool has2 = (i + NWAVES) < rows_per;
        const u32x4 x0 = *((const u32x4*)(XN + (size_t)m * DM) + lane), x1 = *((const u32x4*)(XN + (size_t)m * DM + 512) + lane);
        const u32x4 y0 = *((const u32x4*)(XN + (size_t)(has2 ? m2 : m) * DM) + lane), y1 = *((const u32x4*)(XN + (size_t)(has2 ? m2 : m) * DM + 512) + lane);
        float acc[8], acc2[8];
#pragma unroll
        for (int e = 0; e < 8; ++e) { acc[e] = 0.f; acc2[e] = 0.f; }
#pragma unroll
        for (int hf = 0; hf < 2; ++hf)
#pragma unroll
            for (int q = 0; q < 8; ++q) { const int k = 512 * hf + 8 * lane + q; const f32x4 w0 = *(const LAS f32x4*)(WF + k * 8), w1 = *(const LAS f32x4*)(WF + k * 8 + 4);
                const unsigned xw = hf ? x1[q >> 1] : x0[q >> 1], yw = hf ? y1[q >> 1] : y0[q >> 1]; const float hv = (q & 1) ? bfhi(xw) : bflo(xw), hv2 = (q & 1) ? bfhi(yw) : bflo(yw);
                acc[0] += hv * w0.x; acc[1] += hv * w0.y; acc[2] += hv * w0.z; acc[3] += hv * w0.w; acc[4] += hv * w1.x; acc[5] += hv * w1.y; acc[6] += hv * w1.z; acc[7] += hv * w1.w;
                acc2[0] += hv2 * w0.x; acc2[1] += hv2 * w0.y; acc2[2] += hv2 * w0.z; acc2[3] += hv2 * w0.w; acc2[4] += hv2 * w1.x; acc2[5] += hv2 * w1.y; acc2[6] += hv2 * w1.z; acc2[7] += hv2 * w1.w; }
        float mine = 0.f, mine2 = 0.f;
#pragma unroll
        for (int e = 0; e < 8; ++e) { const float s = wave_sum(acc[e]), s2 = wave_sum(acc2[e]); if (lane == e) { mine = s; mine2 = s2; } }
        if (lane < 8) { const float z = mine + bfj; LOGF[(size_t)((m >> 12) * 8 + lane) * SEQ + (m & 4095)] = fminf(z, 0.f) - log1pf(expf(-fabsf(z)));
            if (has2) { const float z2 = mine2 + bfj; LOGF[(size_t)((m2 >> 12) * 8 + lane) * SEQ + (m2 & 4095)] = fminf(z2, 0.f) - log1pf(expf(-fabsf(z2))); } }
    }
}

__device__ __forceinline__ bool opaque_true() { int d = 1; asm volatile("" : "+s"(d)); return d != 0; }
struct RangeOrder {
    pg8::StaticOrder S; int lo, hi;
    __device__ bool next(int i, pg8::Unit& u) const { return (lo + i < hi) ? S.next(lo + i, u) : false; }
    __device__ __forceinline__ void a_ready(const pg8::Unit&) const {}
    __device__ __forceinline__ void done(const pg8::Unit&) const {}
};
struct FlatOrder {
    int nM, nN, nG, G, c;
    __device__ bool next(int i, pg8::Unit& u) const { const int L = i * G + c; if (L >= nG * nM * nN) return false; u.gz = L / (nM * nN); const int r = L % (nM * nN); u.pm = r % nM; u.pn = r / nM; return true; }
    __device__ __forceinline__ void a_ready(const pg8::Unit&) const {}
    __device__ __forceinline__ void done(const pg8::Unit&) const {}
};
__device__ __forceinline__ float silu_f(float v) { return v * __builtin_amdgcn_rcpf(1.f + __expf(-v)); }
__device__ __forceinline__ float gelu_tanh(float v) { const float u = 0.7978845608028654f * (v + 0.044715f * v * v * v); const float e = __expf(2.f * u); const float th = 1.f - 2.f * __builtin_amdgcn_rcpf(e + 1.f); return 0.5f * v * (1.f + th); }

struct EpiInProj {
    static constexpr bool PERM = true, AFTER_DRAIN = false;
    unsigned char* ws; const float* SS; const float* bfl;
    __device__ __forceinline__ void operator()(const pg8::f32x4 (&acc)[2][2][4][2], const pg8::Unit& u, int wr, int wc, int fr, int fq) const {
        const int pn = u.pn; const int row0 = u.pm * 256 + wr * 64 + fr, cl0 = wc * 32 + 8 * fq;
        float rs[2][4];
#pragma unroll
        for (int ai = 0; ai < 2; ++ai)
#pragma unroll
            for (int m = 0; m < 4; ++m) rs[ai][m] = 1.f;
        if (pn == 14) {
            if (wc == 0 && fq == 0) { float* LOGF = (float*)(ws + WS_LOGF); const f32x4 b0 = *(const f32x4*)bfl, b1 = *(const f32x4*)(bfl + 4);
#pragma unroll
                for (int ai = 0; ai < 2; ++ai)
#pragma unroll
                    for (int m = 0; m < 4; ++m) { const int row = row0 + ai * 128 + m * 16; const float r = rs[ai][m]; const pg8::f32x4 v0 = acc[ai][0][m][0], v1 = acc[ai][0][m][1];
                        float z[8] = {v0[0] * r + b0.x, v0[1] * r + b0.y, v0[2] * r + b0.z, v0[3] * r + b0.w, v1[0] * r + b1.x, v1[1] * r + b1.y, v1[2] * r + b1.z, v1[3] * r + b1.w};
#pragma unroll
                        for (int e = 0; e < 8; ++e) LOGF[(size_t)((row >> 12) * 8 + e) * SEQ + (row & 4095)] = fminf(z[e], 0.f) - log1pf(__expf(-fabsf(z[e]))); } }
            return;
        }
        if (pn < 6) {
            bf16* base = (bf16*)(ws + (pn < 2 ? WS_QO : pn < 4 ? WS_KB : WS_VB)); const float sc = pn < 2 ? 0.125f * LOG2E : 1.f; const int cb = (pn & 1) * 256 + cl0;
#pragma unroll
            for (int ai = 0; ai < 2; ++ai)
#pragma unroll
                for (int m = 0; m < 4; ++m) { bf16* rp = base + (size_t)(row0 + ai * 128 + m * 16) * 512 + cb;
#pragma unroll
                    for (int bj = 0; bj < 2; ++bj) { const float sr = sc * rs[ai][m]; const pg8::f32x4 v0 = acc[ai][bj][m][0] * sr, v1 = acc[ai][bj][m][1] * sr; u32x4 w; w.x = pk2(v0[0], v0[1]); w.y = pk2(v0[2], v0[3]); w.z = pk2(v1[0], v1[1]); w.w = pk2(v1[2], v1[3]); *(u32x4*)(rp + bj * 128) = w; } }
        } else if (pn == 6) {
            bf16* base = (bf16*)(ws + WS_SUA);
#pragma unroll
            for (int ai = 0; ai < 2; ++ai)
#pragma unroll
                for (int m = 0; m < 4; ++m) { const int row = row0 + ai * 128 + m * 16, chunk = row >> 5, t = row & 31;
#pragma unroll
                    for (int bj = 0; bj < 2; ++bj) { const int c = cl0 + bj * 128, g = c >> 4, h0 = c & 15; const pg8::f32x4 v0 = acc[ai][bj][m][0] * rs[ai][m], v1 = acc[ai][bj][m][1] * rs[ai][m]; u32x4 w; w.x = pk2(v0[0], v0[1]); w.y = pk2(v0[2], v0[3]); w.z = pk2(v1[0], v1[1]); w.w = pk2(v1[2], v1[3]);
                        *(u32x4*)(base + ((size_t)(g * 512 + chunk) * KA5 + t * 16 + h0)) = w; } }
        } else if (pn == 7 || pn == 8) {
            const f32x4* rope = (const f32x4*)(ws + WS_ROPE); bf16* base = (bf16*)(ws + (pn == 7 ? WS_RQ : WS_RK)); bf16* RKT = (bf16*)(ws + WS_RKT);
#pragma unroll
            for (int ai = 0; ai < 2; ++ai)
#pragma unroll
                for (int m = 0; m < 4; ++m) { const int row = row0 + ai * 128 + m * 16, b = row >> 12, t = row & 4095;
#pragma unroll
                    for (int bj = 0; bj < 2; ++bj) { const int c = cl0 + bj * 128, hh = c >> 6, pos0 = c & 63; const pg8::f32x4 v0 = acc[ai][bj][m][0] * rs[ai][m], v1 = acc[ai][bj][m][1] * rs[ai][m];
                        const f32x4 r0 = rope[(t * 32 + (pos0 >> 1)) >> 1], r1 = rope[((t * 32 + (pos0 >> 1)) >> 1) + 1];
                        float o[8];
                        o[0] = v0[0] * r0.x - v0[1] * r0.y; o[1] = v0[0] * r0.y + v0[1] * r0.x; o[2] = v0[2] * r0.z - v0[3] * r0.w; o[3] = v0[2] * r0.w + v0[3] * r0.z;
                        o[4] = v1[0] * r1.x - v1[1] * r1.y; o[5] = v1[0] * r1.y + v1[1] * r1.x; o[6] = v1[2] * r1.z - v1[3] * r1.w; o[7] = v1[2] * r1.w + v1[3] * r1.z;
                        u32x4 w; w.x = pk2(o[0], o[1]); w.y = pk2(o[2], o[3]); w.z = pk2(o[4], o[5]); w.w = pk2(o[6], o[7]);
                        *(u32x4*)(base + (size_t)row * 256 + c) = w;
                        if (pn == 8) { const float wk = __builtin_amdgcn_exp2f(lg2_gamma(hh) * (float)(63 - (t & 63))); bf16* tp = RKT + ((size_t)((b * 4 + hh) * 64 + pos0)) * SEQ + t;
#pragma unroll
                            for (int e = 0; e < 8; ++e) tp[(size_t)e * SEQ] = f2bf(o[e] * wk); } } }
        } else if (pn == 9) {
            bf16* RVT = (bf16*)(ws + WS_RVT);
#pragma unroll
            for (int ai = 0; ai < 2; ++ai)
#pragma unroll
                for (int m = 0; m < 4; ++m) { const int row = row0 + ai * 128 + m * 16, b = row >> 12, t = row & 4095;
#pragma unroll
                    for (int bj = 0; bj < 2; ++bj) { const int c = cl0 + bj * 128, hh = c >> 6, d0 = c & 63; const pg8::f32x4 v0 = acc[ai][bj][m][0] * rs[ai][m], v1 = acc[ai][bj][m][1] * rs[ai][m]; bf16* tp = RVT + ((size_t)((b * 4 + hh) * 64 + d0)) * SEQ + t;
#pragma unroll
                        for (int e = 0; e < 4; ++e) { tp[(size_t)e * SEQ] = f2bf(v0[e]); tp[(size_t)(4 + e) * SEQ] = f2bf(v1[e]); } } }
        } else {
            bf16* base = (bf16*)(ws + WS_GATE); const int cb = (pn - 10) * 256 + cl0;
#pragma unroll
            for (int ai = 0; ai < 2; ++ai)
#pragma unroll
                for (int m = 0; m < 4; ++m) { bf16* rp = base + (size_t)(row0 + ai * 128 + m * 16) * 1024 + cb;
#pragma unroll
                    for (int bj = 0; bj < 2; ++bj) { const pg8::f32x4 v0 = acc[ai][bj][m][0] * rs[ai][m], v1 = acc[ai][bj][m][1] * rs[ai][m]; u32x4 w; w.x = pk2(silu_f(v0[0]), silu_f(v0[1])); w.y = pk2(silu_f(v0[2]), silu_f(v0[3])); w.z = pk2(silu_f(v1[0]), silu_f(v1[1])); w.w = pk2(silu_f(v1[2]), silu_f(v1[3])); *(u32x4*)(rp + bj * 128) = w; } }
        }
    }
};
struct EpiS5E {
    static constexpr bool PERM = false, AFTER_DRAIN = false;
    float* E;
    __device__ __forceinline__ void operator()(const pg8::f32x4 (&acc)[2][2][4][2], const pg8::Unit& u, int wr, int wc, int fr, int fq) const {
        const int row0 = u.pm * 256 + wr * 64 + fr, col0 = wc * 32 + 4 * fq;
#pragma unroll
        for (int ai = 0; ai < 2; ++ai)
#pragma unroll
            for (int m = 0; m < 4; ++m) { float* rp = E + ((size_t)u.gz * NCH5 + row0 + ai * 128 + m * 16) * 128 + col0;
#pragma unroll
                for (int n = 0; n < 2; ++n) *(pg8::f32x4*)(rp + n * 16) = acc[ai][0][m][n]; }
    }
};
struct EpiS5Y {
    static constexpr bool PERM = true, AFTER_DRAIN = false;
    const bf16* SUA; bf16* YS5; const float* dvec;
    __device__ __forceinline__ void operator()(const pg8::f32x4 (&acc)[2][2][4][2], const pg8::Unit& u, int wr, int wc, int fr, int fq) const {
        const int row0 = u.pm * 256 + wr * 64 + fr, cl0 = u.pn * 256 + wc * 32 + 8 * fq; const int g = u.gz;
#pragma unroll
        for (int bj = 0; bj < 2; ++bj) { const int c = cl0 + bj * 128, tt = c >> 4, h0 = c & 15; const f32x4 d0 = *(const f32x4*)(dvec + g * 16 + h0), d1 = *(const f32x4*)(dvec + g * 16 + h0 + 4);
#pragma unroll
            for (int ai = 0; ai < 2; ++ai)
#pragma unroll
                for (int m = 0; m < 4; ++m) { const int chunk = row0 + ai * 128 + m * 16; const u32x4 uu = *(const u32x4*)(SUA + ((size_t)(g * 512 + chunk) * KA5 + c)); const pg8::f32x4 v0 = acc[ai][bj][m][0], v1 = acc[ai][bj][m][1];
                    float y[8]; y[0] = v0[0] + d0.x * bflo(uu.x); y[1] = v0[1] + d0.y * bfhi(uu.x); y[2] = v0[2] + d0.z * bflo(uu.y); y[3] = v0[3] + d0.w * bfhi(uu.y);
                    y[4] = v1[0] + d1.x * bflo(uu.z); y[5] = v1[1] + d1.y * bfhi(uu.z); y[6] = v1[2] + d1.z * bflo(uu.w); y[7] = v1[3] + d1.w * bfhi(uu.w);
#pragma unroll
                    for (int e = 0; e < 8; ++e) y[e] = gelu_tanh(y[e]);
                    u32x4 w; w.x = pk2(y[0], y[1]); w.y = pk2(y[2], y[3]); w.z = pk2(y[4], y[5]); w.w = pk2(y[6], y[7]);
                    *(u32x4*)(YS5 + (size_t)(chunk * 32 + tt) * 256 + g * 16 + h0) = w; } }
    }
};
struct EpiGlu {
    static constexpr bool PERM = true, AFTER_DRAIN = false;
    const bf16* YS5; bf16* G; bool dry;
    __device__ __forceinline__ void operator()(const pg8::f32x4 (&acc)[2][2][4][2], const pg8::Unit& u, int wr, int wc, int fr, int fq) const {
        const int row0 = u.pm * 256 + wr * 64 + fr, cl0 = wc * 32 + 8 * fq;
#pragma unroll
        for (int ai = 0; ai < 2; ++ai)
#pragma unroll
            for (int m = 0; m < 4; ++m) { const int row = row0 + ai * 128 + m * 16;
#pragma unroll
                for (int bj = 0; bj < 2; ++bj) { const int c = cl0 + bj * 128; const u32x4 yy = *(const u32x4*)(YS5 + (size_t)row * 256 + c); bf16* gp = G + (size_t)row * 1024 + 512 + c; const u32x4 gg = *(const u32x4*)gp;
                    const pg8::f32x4 v0 = acc[ai][bj][m][0], v1 = acc[ai][bj][m][1]; float s[8];
#pragma unroll
                    for (int e = 0; e < 4; ++e) { s[e] = 1.f / (1.f + __expf(-v0[e])); s[4 + e] = 1.f / (1.f + __expf(-v1[e])); }
                    u32x4 w; w.x = pk2(bflo(yy.x) * s[0] * bflo(gg.x), bfhi(yy.x) * s[1] * bfhi(gg.x)); w.y = pk2(bflo(yy.y) * s[2] * bflo(gg.y), bfhi(yy.y) * s[3] * bfhi(gg.y));
                    w.z = pk2(bflo(yy.z) * s[4] * bflo(gg.z), bfhi(yy.z) * s[5] * bfhi(gg.z)); w.w = pk2(bflo(yy.w) * s[6] * bflo(gg.w), bfhi(yy.w) * s[7] * bfhi(gg.w));
                    if (!dry) *(u32x4*)gp = w; } }
    }
};
struct EpiOut {
    static constexpr bool PERM = false, AFTER_DRAIN = false;
    const float* base; float* out; float* SSn; bf16* XN; const float* gnext; bool dry;
    __device__ __forceinline__ void operator()(const pg8::f32x4 (&acc)[2][2][4][2], const pg8::Unit& u, int wr, int wc, int fr, int fq) const {
        const int row0 = u.pm * 256 + wr * 64 + fr, col0 = u.pn * 256 + wc * 32 + 4 * fq;
        f32x4 gq[2][2];
#pragma unroll
        for (int bj = 0; bj < 2; ++bj)
#pragma unroll
            for (int n = 0; n < 2; ++n) gq[bj][n] = gnext ? *(const f32x4*)(gnext + col0 + bj * 128 + n * 16) : (f32x4){0.f, 0.f, 0.f, 0.f};
#pragma unroll
        for (int ai = 0; ai < 2; ++ai)
#pragma unroll
            for (int m = 0; m < 4; ++m) { const int row = row0 + ai * 128 + m * 16; const size_t off = (size_t)row * DM + col0; float sq = 0.f;
#pragma unroll
                for (int bj = 0; bj < 2; ++bj)
#pragma unroll
                    for (int n = 0; n < 2; ++n) { const f32x4 bs = *(const f32x4*)(base + off + bj * 128 + n * 16); const pg8::f32x4 v = acc[ai][bj][m][n]; const f32x4 x = (f32x4){bs.x + v[0], bs.y + v[1], bs.z + v[2], bs.w + v[3]};
                        sq += (x.x * x.x + x.y * x.y) + (x.z * x.z + x.w * x.w);
                        if (!dry) { *(f32x4*)(out + off + bj * 128 + n * 16) = x;
                            if (gnext) { const f32x4 g = gq[bj][n]; u32x2 w; w.x = pk2(x.x * g.x, x.y * g.y); w.y = pk2(x.z * g.z, x.w * g.w); *(u32x2*)(XN + off + bj * 128 + n * 16) = w; } } }
                sq += __shfl_xor(sq, 16); sq += __shfl_xor(sq, 32);
                if (fq == 0 && !dry) __hip_atomic_fetch_add(SSn + row, sq, __ATOMIC_RELAXED, __HIP_MEMORY_SCOPE_AGENT); }
    }
};

template <bool FINAL> struct EpiOutX {
    static constexpr bool PERM = false, AFTER_DRAIN = true;
    const float* base; float* out; const float* wfin; float* xbuf; unsigned* cnt; bf16* XN; unsigned target;
    __device__ __forceinline__ void fused(pg8::f32x4 (&acc)[2][2][4][2], const pg8::Unit& u, int wr, int wc, int fr, int fq, PG8_LAS unsigned char* lds, int wid, int lane) const {
        PG8_LAS float* P = (PG8_LAS float*)lds;
        PG8_LAS float* S = (PG8_LAS float*)(lds + 4096);
        const int col0 = u.pn * 256 + wc * 32 + 4 * fq;
#pragma unroll
        for (int ai = 0; ai < 2; ++ai)
#pragma unroll
            for (int m = 0; m < 4; ++m) { const int r = ai * 128 + wr * 64 + m * 16 + fr; const size_t off = (size_t)(u.pm * 256 + r) * DM + col0; float sq = 0.f;
#pragma unroll
                for (int bj = 0; bj < 2; ++bj)
#pragma unroll
                    for (int n = 0; n < 2; ++n) { const f32x4 bs = *(const f32x4*)(base + off + bj * 128 + n * 16); pg8::f32x4 x = acc[ai][bj][m][n]; x[0] += bs.x; x[1] += bs.y; x[2] += bs.z; x[3] += bs.w; acc[ai][bj][m][n] = x;
                        sq += (x[0] * x[0] + x[1] * x[1]) + (x[2] * x[2] + x[3] * x[3]); }
                sq += __shfl_xor(sq, 16); sq += __shfl_xor(sq, 32);
                if (fq == 0) P[r * 4 + wc] = sq;
                asm volatile("" : "+v"(acc[ai][0][m][0]), "+v"(acc[ai][0][m][1]), "+v"(acc[ai][1][m][0]), "+v"(acc[ai][1][m][1]));
                if (m & 1) asm volatile("" ::: "memory"); }
        asm volatile("s_waitcnt lgkmcnt(0)" ::: "memory"); __builtin_amdgcn_s_barrier(); asm volatile("" ::: "memory");
        const int row = wid * 32 + (lane & 31);
        if (lane < 32) { const float tot = (P[row * 4 + 0] + P[row * 4 + 1]) + (P[row * 4 + 2] + P[row * 4 + 3]);
            __hip_atomic_store(xbuf + (size_t)(u.pm * 256 + row) * 4 + u.pn, tot, __ATOMIC_RELAXED, __HIP_MEMORY_SCOPE_AGENT); }
        asm volatile("s_waitcnt vmcnt(0)" ::: "memory");
        if (lane == 0) __hip_atomic_fetch_add(cnt + 64 * u.pm, 1u, __ATOMIC_RELAXED, __HIP_MEMORY_SCOPE_AGENT);
        if (wid == 0) {
            unsigned sp = 0u;
            while ((unsigned)__builtin_amdgcn_readfirstlane(__hip_atomic_load(cnt + 64 * u.pm, __ATOMIC_RELAXED, __HIP_MEMORY_SCOPE_AGENT)) < target) { __builtin_amdgcn_s_sleep(2); if (++sp > (1u << 20)) break; }
            __builtin_amdgcn_fence(__ATOMIC_ACQUIRE, "agent");
        }
        asm volatile("s_waitcnt vmcnt(0) lgkmcnt(0)" ::: "memory"); __builtin_amdgcn_s_barrier(); asm volatile("" ::: "memory");
        if (lane < 32) { const float* sl = xbuf + (size_t)(u.pm * 256 + row) * 4; float t = 0.f;
#pragma unroll
            for (int k = 0; k < 4; ++k) t += __hip_atomic_load(sl + k, __ATOMIC_RELAXED, __HIP_MEMORY_SCOPE_AGENT);
            S[row] = rsqrtf(t * (1.f / DM) + EPS); }
        asm volatile("s_waitcnt lgkmcnt(0)" ::: "memory"); __builtin_amdgcn_s_barrier(); asm volatile("" ::: "memory");
        f32x4 wq[2][2];
#pragma unroll
        for (int bj = 0; bj < 2; ++bj)
#pragma unroll
            for (int n = 0; n < 2; ++n) wq[bj][n] = *(const f32x4*)(wfin + col0 + bj * 128 + n * 16);
#pragma unroll
        for (int ai = 0; ai < 2; ++ai)
#pragma unroll
            for (int m = 0; m < 4; ++m) { const int r = ai * 128 + wr * 64 + m * 16 + fr; const float sr = S[r]; const size_t off = (size_t)(u.pm * 256 + r) * DM + col0;
#pragma unroll
                for (int bj = 0; bj < 2; ++bj)
#pragma unroll
                    for (int n = 0; n < 2; ++n) { const pg8::f32x4 x = acc[ai][bj][m][n]; const f32x4 g = wq[bj][n]; const f32x4 y = (f32x4){x[0] * sr * g.x, x[1] * sr * g.y, x[2] * sr * g.z, x[3] * sr * g.w};
                        if (FINAL) *(f32x4*)(out + off + bj * 128 + n * 16) = y;
                        else { *(f32x4*)(out + off + bj * 128 + n * 16) = (f32x4){x[0], x[1], x[2], x[3]}; u32x2 w; w.x = pk2(y.x, y.y); w.y = pk2(y.z, y.w); *(u32x2*)(XN + off + bj * 128 + n * 16) = w; } } }
    }
};

template <int KS, int UNR, class Epi> __device__ __forceinline__ void wave_gemm64(const bf16* A, int lda, const bf16* B, int ldb, int lane, const Epi& epi) {
    const int fr = lane & 15, fq = lane >> 4;
    pg8::f32x4 acc[4][4];
#pragma unroll
    for (int jb = 0; jb < 4; ++jb)
#pragma unroll
        for (int ib = 0; ib < 4; ++ib) acc[jb][ib] = (pg8::f32x4){0.f, 0.f, 0.f, 0.f};
    const bf16* ap = A + (size_t)fr * lda + 8 * fq; const bf16* bp = B + (size_t)fr * ldb + 8 * fq;
#pragma unroll UNR
    for (int ks = 0; ks < KS; ++ks) {
        bf16x8 af[4], bv[4];
#pragma unroll
        for (int ib = 0; ib < 4; ++ib) { af[ib] = *(const bf16x8*)(ap + (size_t)(16 * ib) * lda + 32 * ks); bv[ib] = *(const bf16x8*)(bp + (size_t)(16 * ib) * ldb + 32 * ks); }
#pragma unroll
        for (int jb = 0; jb < 4; ++jb)
#pragma unroll
            for (int ib = 0; ib < 4; ++ib) acc[jb][ib] = __builtin_amdgcn_mfma_f32_16x16x32_bf16(bv[jb], af[ib], acc[jb][ib], 0, 0, 0);
    }
    epi(acc, fr, fq);
}
struct WEpiE {
    float* E;
    __device__ __forceinline__ void operator()(const pg8::f32x4 (&acc)[4][4], int fr, int fq) const {
#pragma unroll
        for (int jb = 0; jb < 4; ++jb)
#pragma unroll
            for (int ib = 0; ib < 4; ++ib) *(pg8::f32x4*)(E + (size_t)(16 * ib + fr) * 128 + 16 * jb + 4 * fq) = acc[jb][ib];
    }
};
struct WEpiS5Y {
    const bf16* SUAg; bf16* YS5; const float* dg; int chunk0, col0, g;
    __device__ __forceinline__ void operator()(const pg8::f32x4 (&acc)[4][4], int fr, int fq) const {
#pragma unroll
        for (int jb = 0; jb < 4; ++jb) { const int col = col0 + 16 * jb + 4 * fq, tt = col >> 4, h0 = col & 15; const f32x4 d4 = *(const f32x4*)(dg + h0);
#pragma unroll
            for (int ib = 0; ib < 4; ++ib) { const int chunk = chunk0 + 16 * ib + fr; const u32x2 uu = *(const u32x2*)(SUAg + (size_t)chunk * KA5 + col); const pg8::f32x4 v = acc[jb][ib];
                const float y0 = gelu_tanh(v[0] + d4.x * bflo(uu.x)), y1 = gelu_tanh(v[1] + d4.y * bfhi(uu.x)), y2 = gelu_tanh(v[2] + d4.z * bflo(uu.y)), y3 = gelu_tanh(v[3] + d4.w * bfhi(uu.y));
                u32x2 w; w.x = pk2(y0, y1); w.y = pk2(y2, y3); *(u32x2*)(YS5 + (size_t)(chunk * 32 + tt) * 256 + g * 16 + h0) = w; } }
    }
};
struct WEpiGlu {
    const bf16* YS5; bf16* G; int row0, col0;
    __device__ __forceinline__ void operator()(const pg8::f32x4 (&acc)[4][4], int fr, int fq) const {
#pragma unroll
        for (int jb = 0; jb < 4; ++jb)
#pragma unroll
            for (int ib = 0; ib < 4; ++ib) { const int row = row0 + 16 * ib + fr, col = col0 + 16 * jb + 4 * fq; const u32x2 yy = *(const u32x2*)(YS5 + (size_t)row * 256 + col); bf16* gp = G + (size_t)row * 1024 + 512 + col; const u32x2 gg = *(const u32x2*)gp; const pg8::f32x4 v = acc[jb][ib];
                const float s0 = __builtin_amdgcn_rcpf(1.f + __expf(-v[0])), s1 = __builtin_amdgcn_rcpf(1.f + __expf(-v[1])), s2 = __builtin_amdgcn_rcpf(1.f + __expf(-v[2])), s3 = __builtin_amdgcn_rcpf(1.f + __expf(-v[3]));
                u32x2 w; w.x = pk2(bflo(yy.x) * s0 * bflo(gg.x), bfhi(yy.x) * s1 * bfhi(gg.x)); w.y = pk2(bflo(yy.y) * s2 * bflo(gg.y), bfhi(yy.y) * s3 * bfhi(gg.y)); *(u32x2*)gp = w; }
    }
};

__device__ __forceinline__ void ret_upd_unit(unsigned char* ws, int unit, int lane) {
    const int c = unit & 63, bh = unit >> 6; const int i16 = lane & 15, kq = lane >> 4;
    const bf16* KT = (const bf16*)(ws + WS_RKT) + (size_t)bh * 64 * SEQ + c * 64; const bf16* VT = (const bf16*)(ws + WS_RVT) + (size_t)bh * 64 * SEQ + c * 64;
    float* UPD = (float*)(ws + WS_UPD) + (size_t)unit * 4096;
    bf16x8 af[4][2], bfv[4][2];
#pragma unroll
    for (int ib = 0; ib < 4; ++ib)
#pragma unroll
        for (int ks = 0; ks < 2; ++ks) { af[ib][ks] = *(const bf16x8*)(KT + (size_t)(16 * ib + i16) * SEQ + 32 * ks + 8 * kq); bfv[ib][ks] = *(const bf16x8*)(VT + (size_t)(16 * ib + i16) * SEQ + 32 * ks + 8 * kq); }
#pragma unroll
    for (int ib = 0; ib < 4; ++ib)
#pragma unroll
        for (int jb = 0; jb < 4; ++jb) { pg8::f32x4 d = (pg8::f32x4){0.f, 0.f, 0.f, 0.f};
            d = __builtin_amdgcn_mfma_f32_16x16x32_bf16(af[ib][0], bfv[jb][0], d, 0, 0, 0); d = __builtin_amdgcn_mfma_f32_16x16x32_bf16(af[ib][1], bfv[jb][1], d, 0, 0, 0);
            *(pg8::f32x4*)(UPD + (size_t)(16 * jb + i16) * 64 + 16 * ib + 4 * kq) = d; }
}
__device__ __forceinline__ void ret_out_unit(const Args& a, int l, int unit, int lane, bool dry = false) {
    unsigned char* ws = a.ws;
    const int c = unit & 63, bh = unit >> 6, hh = bh & 3, b = bh >> 2; const int fr = lane & 15, fq = lane >> 4;
    const size_t t0 = (size_t)b * SEQ + c * 64;
    const bf16* RQ = (const bf16*)(ws + WS_RQ) + t0 * 256 + hh * 64; const bf16* RK = (const bf16*)(ws + WS_RK) + t0 * 256 + hh * 64;
    const bf16* VT = (const bf16*)(ws + WS_RVT) + (size_t)bh * 64 * SEQ + c * 64; const bf16* ST = (const bf16*)(ws + WS_STATE) + (size_t)unit * 4096;
    const float lg = lg2_gamma(hh);
    bf16x8 qf[4][2]; pg8::f32x4 st[4][4];
#pragma unroll
    for (int nb = 0; nb < 4; ++nb)
#pragma unroll
        for (int ks = 0; ks < 2; ++ks) qf[nb][ks] = *(const bf16x8*)(RQ + (size_t)(16 * nb + fr) * 256 + 32 * ks + 8 * fq);
#pragma unroll
    for (int mb = 0; mb < 4; ++mb) { bf16x8 k0 = *(const bf16x8*)(RK + (size_t)(16 * mb + fr) * 256 + 8 * fq), k1 = *(const bf16x8*)(RK + (size_t)(16 * mb + fr) * 256 + 32 + 8 * fq);
#pragma unroll
        for (int nb = 0; nb < 4; ++nb) { pg8::f32x4 d = (pg8::f32x4){0.f, 0.f, 0.f, 0.f};
            d = __builtin_amdgcn_mfma_f32_16x16x32_bf16(k0, qf[nb][0], d, 0, 0, 0); d = __builtin_amdgcn_mfma_f32_16x16x32_bf16(k1, qf[nb][1], d, 0, 0, 0);
#pragma unroll
            for (int r = 0; r < 4; ++r) { const int mm = 16 * mb + 4 * fq + r, nn = 16 * nb + fr; const int df = mm > nn ? mm - nn : nn - mm; d[r] *= 0.125f * __builtin_amdgcn_exp2f(lg * (float)df); }
            st[mb][nb] = d; } }
    bf16* Y = (bf16*)(ws + WS_GATE) + t0 * 1024 + 768 + hh * 64;
    u32x2 gt[4][4];
#pragma unroll
    for (int nb = 0; nb < 4; ++nb)
#pragma unroll
        for (int dvb = 0; dvb < 4; ++dvb) gt[nb][dvb] = *(const u32x2*)(Y + (size_t)(16 * nb + fr) * 1024 + 16 * dvb + 4 * fq);
    pg8::f32x4 oT[4][4];
#pragma unroll
    for (int dvb = 0; dvb < 4; ++dvb)
#pragma unroll
        for (int nb = 0; nb < 4; ++nb) oT[dvb][nb] = (pg8::f32x4){0.f, 0.f, 0.f, 0.f};
#pragma unroll
    for (int dvb = 0; dvb < 4; ++dvb) { const bf16x8 s0 = *(const bf16x8*)(ST + (size_t)(16 * dvb + fr) * 64 + 8 * fq), s1 = *(const bf16x8*)(ST + (size_t)(16 * dvb + fr) * 64 + 32 + 8 * fq);
#pragma unroll
        for (int nb = 0; nb < 4; ++nb) { oT[dvb][nb] = __builtin_amdgcn_mfma_f32_16x16x32_bf16(s0, qf[nb][0], oT[dvb][nb], 0, 0, 0); oT[dvb][nb] = __builtin_amdgcn_mfma_f32_16x16x32_bf16(s1, qf[nb][1], oT[dvb][nb], 0, 0, 0); } }
#pragma unroll
    for (int nb = 0; nb < 4; ++nb) { const float wq = 0.125f * __builtin_amdgcn_exp2f(lg * (float)(16 * nb + fr + 1));
#pragma unroll
        for (int dvb = 0; dvb < 4; ++dvb) oT[dvb][nb] = oT[dvb][nb] * wq; }
#pragma unroll
    for (int s = 0; s < 2; ++s) {
        bf16x8 pa[4];
#pragma unroll
        for (int nb = 0; nb < 4; ++nb) { u32x4 w; w.x = pk2(st[2 * s][nb][0], st[2 * s][nb][1]); w.y = pk2(st[2 * s][nb][2], st[2 * s][nb][3]); w.z = pk2(st[2 * s + 1][nb][0], st[2 * s + 1][nb][1]); w.w = pk2(st[2 * s + 1][nb][2], st[2 * s + 1][nb][3]); pa[nb] = __builtin_bit_cast(bf16x8, w); }
#pragma unroll
        for (int dvb = 0; dvb < 4; ++dvb) { const u32x2 v0 = *(const u32x2*)(VT + (size_t)(16 * dvb + fr) * SEQ + 32 * s + 4 * fq), v1 = *(const u32x2*)(VT + (size_t)(16 * dvb + fr) * SEQ + 32 * s + 16 + 4 * fq);
            const bf16x8 vf = __builtin_bit_cast(bf16x8, (u32x4){v0.x, v0.y, v1.x, v1.y});
#pragma unroll
            for (int nb = 0; nb < 4; ++nb) oT[dvb][nb] = __builtin_amdgcn_mfma_f32_16x16x32_bf16(vf, pa[nb], oT[dvb][nb], 0, 0, 0); }
    }
    const float* gn = a.in[13] + (size_t)l * 256 + hh * 64; f32x4 gnw[4];
#pragma unroll
    for (int dvb = 0; dvb < 4; ++dvb) gnw[dvb] = *(const f32x4*)(gn + 16 * dvb + 4 * fq);
#pragma unroll
    for (int nb = 0; nb < 4; ++nb) { float sm = 0.f;
#pragma unroll
        for (int dvb = 0; dvb < 4; ++dvb) sm += (oT[dvb][nb][0] + oT[dvb][nb][1]) + (oT[dvb][nb][2] + oT[dvb][nb][3]);
        sm += __shfl_xor(sm, 16); sm += __shfl_xor(sm, 32);
        const float mu = sm * (1.f / 64.f); float q = 0.f;
#pragma unroll
        for (int dvb = 0; dvb < 4; ++dvb)
#pragma unroll
            for (int r = 0; r < 4; ++r) { const float d = oT[dvb][nb][r] - mu; q += d * d; }
        q += __shfl_xor(q, 16); q += __shfl_xor(q, 32);
        const float rstd = rsqrtf(q * (1.f / 64.f) + EPS);
#pragma unroll
        for (int dvb = 0; dvb < 4; ++dvb) { const u32x2 g2 = gt[nb][dvb]; const pg8::f32x4 v = oT[dvb][nb]; const f32x4 w4 = gnw[dvb]; u32x2 w;
            w.x = pk2((v[0] - mu) * rstd * w4.x * bflo(g2.x), (v[1] - mu) * rstd * w4.y * bfhi(g2.x)); w.y = pk2((v[2] - mu) * rstd * w4.z * bflo(g2.y), (v[3] - mu) * rstd * w4.w * bfhi(g2.y));
            if (!dry) *(u32x2*)(Y + (size_t)(16 * nb + fr) * 1024 + 16 * dvb + 4 * fq) = w; } }
}


#define XB_TMO      128
#define XB_XCNT(j)  (256  + 64 * (j))
#define XB_XSUB(j)  (1280 + 64 * (j))
#define XB_XGEN(j)  (2304 + 64 * (j))
#define XB_TOP      3328
#define XB_TOPGEN   3392
#define XCD_BAR_WORDS 3456
#define XB_SPIN_CAP (1u << 18)

__device__ __forceinline__ unsigned xb_ld(unsigned* p)              { return __hip_atomic_load(p, __ATOMIC_RELAXED, __HIP_MEMORY_SCOPE_AGENT); }
__device__ __forceinline__ unsigned xb_add(unsigned* p, unsigned v) { return __hip_atomic_fetch_add(p, v, __ATOMIC_RELAXED, __HIP_MEMORY_SCOPE_AGENT); }
__device__ __forceinline__ unsigned xb_xcc_id() { return (unsigned)__builtin_amdgcn_s_getreg((3 << 11) | 20) & 0xFu; }
#define XB_SPIN(cond, bar) do { unsigned _sp = 0; while (cond) { __builtin_amdgcn_s_sleep(1); \
    if ((++_sp & 255u) == 0u) { if (xb_ld(&(bar)[XB_TMO])) break; if (_sp > XB_SPIN_CAP) { atomicAdd(&(bar)[XB_TMO], 1u); break; } } } } while (0)

struct XcdBarrier {
    unsigned* bar; unsigned x;
    volatile LAS unsigned* st;
};

__device__ __forceinline__ XcdBarrier xcd_barrier_post(unsigned* bar, volatile LAS unsigned* st) {
    XcdBarrier b; b.bar = bar; b.x = xb_xcc_id(); b.st = st;
    if (threadIdx.x == 0) (void)xb_add(&bar[XB_XCNT(b.x)], 1u);
    return b;
}
__device__ __forceinline__ void xcd_barrier_complete(unsigned* bar, unsigned x, unsigned& nloc, unsigned& nx) {
    const unsigned G = gridDim.x * gridDim.y * gridDim.z;
    unsigned sum, cnt, mine, sp = 0u;
    for (;;) {
        sum = 0u; cnt = 0u; mine = 0u;
#pragma unroll
        for (unsigned j = 0; j < 16; ++j) { const unsigned c = xb_ld(&bar[XB_XCNT(j)]); sum += c; cnt += (c > 0u) ? 1u : 0u; mine = (j == x) ? c : mine; }
        if (sum == G) break;
        __builtin_amdgcn_s_sleep(1);
        if ((++sp & 255u) == 0u) { if (xb_ld(&bar[XB_TMO])) break; if (sp > XB_SPIN_CAP) { atomicAdd(&bar[XB_TMO], 1u); break; } }
    }
    nloc = mine > 0u ? mine : 1u; nx = cnt > 0u ? cnt : 1u;
}

__device__ __forceinline__ void xcd_barrier(const XcdBarrier& b) {
    asm volatile("s_waitcnt vmcnt(0)" ::: "memory");
    __syncthreads();
    if (threadIdx.x == 0) {
        unsigned* bar = b.bar;
        __builtin_amdgcn_s_waitcnt(0);
        unsigned nloc = b.st[0], nx = b.st[1];
        if (nloc == 0u) { xcd_barrier_complete(bar, b.x, nloc, nx); b.st[0] = nloc; b.st[1] = nx; }
        const unsigned old = xb_add(&bar[XB_XSUB(b.x)], 1u);
        const unsigned gen = old / nloc;
        if (old + 1u == (gen + 1u) * nloc) {
            __builtin_amdgcn_fence(__ATOMIC_RELEASE, "agent");
            asm volatile("s_waitcnt vmcnt(0)" ::: "memory");
            const unsigned og = xb_add(&bar[XB_TOP], 1u);
            const unsigned tg = og / nx;
            if (og + 1u == (tg + 1u) * nx) xb_add(&bar[XB_TOPGEN], 1u);
            else XB_SPIN(xb_ld(&bar[XB_TOPGEN]) == tg, bar);
            __builtin_amdgcn_fence(__ATOMIC_ACQUIRE, "agent");
            xb_add(&bar[XB_XGEN(b.x)], 1u);
            asm volatile("s_waitcnt vmcnt(0)" ::: "memory");
        } else {
            XB_SPIN(xb_ld(&bar[XB_XGEN(b.x)]) == gen, bar);
            __builtin_amdgcn_fence(__ATOMIC_ACQUIRE, "agent");
            asm volatile("s_waitcnt vmcnt(0)" ::: "memory");
        }
    }
    __syncthreads();
}

#define XBAR_MAKE XcdBarrier xb_; xb_.bar = (unsigned*)args.ws; xb_.st = (volatile LAS unsigned*)((LAS unsigned char*)lds + RING_BYTES + 352); xb_.x = xb_.st[2]
#ifdef REP_SYNC
#define GSYNC() do { XBAR_MAKE; xcd_barrier(xb_); xcd_barrier(xb_); } while (0)
#else
#define GSYNC() do { XBAR_MAKE; xcd_barrier(xb_); } while (0)
#endif
#ifndef REP_P0
#define REP_P0 1
#endif
#ifndef REP_P1
#define REP_P1 1
#endif
#ifndef REP_P23
#define REP_P23 1
#endif
#ifndef REP_NORM
#define REP_NORM 1
#endif
__global__ void __launch_bounds__(NTHR, 2) mega_fwd(Args args) {
    extern __shared__ __attribute__((aligned(16))) unsigned char lds[];
    cg::grid_group grid = cg::this_grid();
    const int tid = threadIdx.x, lane = tid & 63, wave = __builtin_amdgcn_readfirstlane(tid >> 6);
    const int G = gridDim.x, bx = blockIdx.x; const int vcu = (G % 8 == 0) ? (bx % 8) * (G / 8) + bx / 8 : bx;
    const int gw = bx * NWAVES + wave, NGW = G * NWAVES;
    unsigned char* ws = args.ws;
    LAS unsigned char* ldsl = (LAS unsigned char*)lds;
    LAS float* ldsf = (LAS float*)lds;
    float* X = args.out;
    if (ws == nullptr) grid.sync();
    if (tid < 2) ((volatile LAS unsigned*)(ldsl + RING_BYTES + 352))[tid] = 0u;
    __syncthreads();
    { const XcdBarrier xb0 = xcd_barrier_post((unsigned*)ws, (volatile LAS unsigned*)(ldsl + RING_BYTES + 352)); if (tid == 0) ((volatile LAS unsigned*)(ldsl + RING_BYTES + 352))[2] = xb0.x; }
    __syncthreads();

#ifdef PROBE_T
    unsigned long long tacc_ = 0ull, tprev_ = __builtin_amdgcn_s_memrealtime();
#define TSTAMP(id) do { const unsigned long long tn_ = __builtin_amdgcn_s_memrealtime(); if ((id) == PROBE_T || ((PROBE_T) == 23 && ((id) == 2 || (id) == 3 || (id) == 5))) tacc_ += tn_ - tprev_; tprev_ = tn_; } while (0)
#else
#define TSTAMP(id) do {} while (0)
#endif
    for (int rep_ = 0; rep_ < REP_P0; ++rep_) {
        if (rep_) { __syncthreads(); }
#ifdef REP_S5P
        if (bx < 64) { s5_prep(args, bx >> 4, bx & 15, ldsf, tid); }
#endif
        if (bx < 64) { s5_prep(args, bx >> 4, bx & 15, ldsf, tid); }
        LAS float* scr = ldsf + wave * 4096;
        constexpr int I_IN = (DM / 64) * (NF / 32), I_O = (DM / 64) * (DM / 32), I_G = (256 / 64) * (256 / 32), I_L = I_IN + I_O + I_G;
#ifndef REP_TR
#define REP_TR 1
#endif
        for (int rt_ = 0; rt_ < REP_TR; ++rt_)
        for (int it = (bx < 64 ? DEPTH * I_L : (bx - 64) * NWAVES + wave); it < DEPTH * I_L; it += (G - 64) * NWAVES) {
            const int l = it / I_L; int r = it % I_L;
            if (r < I_IN) { p0_transpose_item<true>(args.in[2] + (size_t)l * DM * NIN, DM, NIN, NF, (bf16*)(ws + WS_WIN) + (size_t)l * NF * DM, scr, r, lane); continue; } r -= I_IN;
            if (r < I_O) { p0_transpose_item<false>(args.in[14] + (size_t)l * DM * DM, DM, DM, DM, (bf16*)(ws + WS_WO) + (size_t)l * DM * DM, scr, r, lane); continue; } r -= I_O;
            p0_transpose_item<false>(args.in[12] + (size_t)l * 65536, 256, 256, 256, (bf16*)(ws + WS_WGLU) + (size_t)l * 65536, scr, r, lane);
        }
        f32x2* rope = (f32x2*)(ws + WS_ROPE);
        for (int i = bx * NTHR + tid; i < SEQ * 32; i += G * NTHR) { const int pos = i >> 5, fi = i & 31; const float freq = powf(10000.f, -(float)fi / 32.f); const float ang = (float)pos * freq; float sn, cs; sincosf(ang, &sn, &cs); rope[i] = (f32x2){cs, sn}; }
        __syncthreads();
        { const int NW = (64 + 2 * (G - 64)) * NWAVES;
          if (bx < 64) norm0_phase(args, lane, bx * NWAVES + wave, NW);
          else { const int sl = 64 * NWAVES + ((bx - 64) * NWAVES + wave) * 2; norm0_phase(args, lane, sl, NW); norm0_phase(args, lane, sl + 1, NW); } }
    }
    GSYNC();
    TSTAMP(0);

#define PHASE_VARS int tid = threadIdx.x; asm volatile("" : "+v"(tid)); int bxl_ = blockIdx.x; asm volatile("" : "+s"(bxl_)); const int bx = bxl_; const int lane = tid & 63, wave = __builtin_amdgcn_readfirstlane(tid >> 6), gw = bx * NWAVES + wave; __attribute__((address_space(1))) unsigned char* wsg_ = (__attribute__((address_space(1))) unsigned char*)args.ws; asm volatile("" : "+s"(wsg_)); unsigned char* ws = (unsigned char*)wsg_; LAS unsigned char* ldsl = (LAS unsigned char*)lds; LAS float* ldsf = (LAS float*)lds; (void)lane; (void)wave; (void)gw; (void)ldsl; (void)ldsf
    for (int l = 0; l < DEPTH; ++l) {
        for (int rep_ = 0; rep_ < REP_P1; ++rep_) {
            PHASE_VARS;
            pg8::Gemm g{(const bf16*)(ws + WS_XN), (const bf16*)(ws + WS_WIN) + (size_t)l * NF * DM, M, NF, DM, DM, DM, 0, 0};
            pg8::StaticOrder S; S.init(M, NF, G, bx);
            EpiInProj E{ws, (const float*)(ws + WS_SS) + (size_t)(l & 1) * M, args.in[3] + (size_t)l * 8};
#ifdef PROBE_SPLIT
            { RangeOrder R0{S, 0, 2}, R1{S, 2, 4}; pg8::gemm_phase<EpiInProj, RangeOrder, true, true>(ldsl, g, R0, E); GSYNC(); pg8::gemm_phase<EpiInProj, RangeOrder, true, true>(ldsl, g, R1, E); }
#else
            pg8::gemm_phase<EpiInProj, pg8::StaticOrder, true, true>(ldsl, g, S, E);
#endif
            if (bx >= G / 2) flog_phase(args, l, (const float*)(ws + WS_SS) + (size_t)(l & 1) * M, ldsf, tid, lane, wave, bx - G / 2, G / 2);
        }
        GSYNC();
        TSTAMP(1);
        for (int rep_ = 0; rep_ < REP_P23; ++rep_) {
            if (rep_) __syncthreads();
            PHASE_VARS;
            if (bx < 128) {
                const int half = bx & 1, bg_ = bx >> 1, b = bg_ >> 4, g = bg_ & 15, tmL = wave & 1, tn = (wave >> 1) & 1, kh = wave >> 2;
                { const int fr = lane & 15, fq = lane >> 4;
                  const bf16* Ap = (const bf16*)(ws + WS_SUA) + ((size_t)g * NCH5 + b * 128 + tmL * 64) * KA5 + 256 * kh; const bf16* Bp = (const bf16*)(ws + WS_WB) + ((size_t)(l * 16 + g) * 128 + tn * 64) * 512 + 256 * kh;
                  struct WEpiLds { LAS float* EL; __device__ __forceinline__ void operator()(const pg8::f32x4 (&acc)[4][4], int fr_, int fq_) const {
#pragma unroll
                      for (int jb = 0; jb < 4; ++jb)
#pragma unroll
                          for (int ib = 0; ib < 4; ++ib) *(LAS pg8::f32x4*)(EL + (16 * ib + fr_) * 128 + 16 * jb + 4 * fq_) = acc[jb][ib]; } };
                  WEpiLds E{ldsf + (size_t)(kh * 128 + tmL * 64) * 128 + tn * 64}; (void)fr; (void)fq;
                  wave_gemm64<8, 4, WEpiLds>(Ap, KA5, Bp, 512, lane, E); }
                __syncthreads();
                const int p = tid & 63, seg = tid >> 6;
                const float* LAM = (const float*)(ws + WS_LAM) + (size_t)(l * 16 + g) * 128; const float lr = LAM[p], li = LAM[64 + p];
                bf16* SA = (bf16*)(ws + WS_SUA) + ((size_t)g * NCH5 + b * 128 + seg * 16) * KA5 + 512 + p;
                float er[16], ei[16];
#pragma unroll
                for (int i = 0; i < 16; ++i) { const int r = (seg * 16 + i) * 128; er[i] = ldsf[r + p] + ldsf[16384 + r + p]; ei[i] = ldsf[r + 64 + p] + ldsf[16384 + r + 64 + p]; }
                float sr = 0.f, si = 0.f;
#pragma unroll
                for (int i = 0; i < 16; ++i) { const float nr = lr * sr - li * si + er[i], ni = lr * si + li * sr + ei[i]; sr = nr; si = ni; }
                LAS float* ends = ldsf + (RING_BYTES + 1024) / 4;
                ends[(seg * 64 + p) * 2] = sr; ends[(seg * 64 + p) * 2 + 1] = si;
                float pr = lr, pi = li;
#pragma unroll
                for (int i = 0; i < 4; ++i) { const float nr = pr * pr - pi * pi, ni = 2.f * pr * pi; pr = nr; pi = ni; }
                __syncthreads();
                float cr = 0.f, ci = 0.f;
                for (int s2 = 0; s2 < seg; ++s2) { const float xr = ends[(s2 * 64 + p) * 2], xi = ends[(s2 * 64 + p) * 2 + 1]; const float nr = pr * cr - pi * ci + xr, ni = pr * ci + pi * cr + xi; cr = nr; ci = ni; }
#pragma unroll
                for (int i = 0; i < 16; ++i) { SA[(size_t)i * KA5] = f2bf(cr); SA[(size_t)i * KA5 + 64] = f2bf(ci); const float nr = lr * cr - li * ci + er[i], ni = lr * ci + li * cr + ei[i]; cr = nr; ci = ni; }
                asm volatile("s_waitcnt vmcnt(0)" ::: "memory"); __syncthreads();
                { const int tmL2 = wave & 1, tn2 = half * 4 + (wave >> 1);
                  const bf16* SUAg = (const bf16*)(ws + WS_SUA) + (size_t)g * NCH5 * KA5;
                  WEpiS5Y E{SUAg, (bf16*)(ws + WS_YS5), args.in[10] + (size_t)l * 256 + g * 16, b * 128 + tmL2 * 64, tn2 * 64, g};
                  wave_gemm64<20, 4, WEpiS5Y>(SUAg + (size_t)(b * 128 + tmL2 * 64) * KA5, KA5, (const bf16*)(ws + WS_MF) + ((size_t)(l * 16 + g) * 512 + tn2 * 64) * KA5, KA5, lane, E); }
            } else {
                const int idx = bx - 128, bh = idx >> 3, dvs = (idx >> 1) & 3, dkh = idx & 1, fr = lane & 15, fq = lane >> 4; const float g64 = exp2f(lg2_gamma(bh & 3) * 64.f);
                const bf16* KT = (const bf16*)(ws + WS_RKT) + ((size_t)bh * 64 + 32 * dkh + fr) * SEQ + 8 * fq; const bf16* VT = (const bf16*)(ws + WS_RVT) + ((size_t)bh * 64 + 16 * dvs + fr) * SEQ + 8 * fq;
                pg8::f32x4 u[8][2];
#pragma unroll
                for (int i2 = 0; i2 < 2; ++i2) {
                    bf16x8 vf[4][2], kf[4][2][2];
#pragma unroll
                    for (int i1 = 0; i1 < 4; ++i1) { const int c = 8 * wave + 4 * i2 + i1; vf[i1][0] = *(const bf16x8*)(VT + c * 64); vf[i1][1] = *(const bf16x8*)(VT + c * 64 + 32);
#pragma unroll
                        for (int ib = 0; ib < 2; ++ib) { kf[i1][ib][0] = *(const bf16x8*)(KT + (size_t)(16 * ib) * SEQ + c * 64); kf[i1][ib][1] = *(const bf16x8*)(KT + (size_t)(16 * ib) * SEQ + c * 64 + 32); } }
#pragma unroll
                    for (int i1 = 0; i1 < 4; ++i1)
#pragma unroll
                        for (int ib = 0; ib < 2; ++ib) { pg8::f32x4 d = (pg8::f32x4){0.f, 0.f, 0.f, 0.f}; d = __builtin_amdgcn_mfma_f32_16x16x32_bf16(kf[i1][ib][0], vf[i1][0], d, 0, 0, 0); d = __builtin_amdgcn_mfma_f32_16x16x32_bf16(kf[i1][ib][1], vf[i1][1], d, 0, 0, 0); u[4 * i2 + i1][ib] = d; }
                }
                pg8::f32x4 e4[2];
#pragma unroll
                for (int ib = 0; ib < 2; ++ib) e4[ib] = (pg8::f32x4){0.f, 0.f, 0.f, 0.f};
#pragma unroll
                for (int i = 0; i < 8; ++i)
#pragma unroll
                    for (int ib = 0; ib < 2; ++ib) e4[ib] = e4[ib] * g64 + u[i][ib];
                LAS pg8::f32x4* ends = (LAS pg8::f32x4*)ldsf;
#pragma unroll
                for (int ib = 0; ib < 2; ++ib) ends[(wave * 2 + ib) * 64 + lane] = e4[ib];
                float g8 = g64; g8 = g8 * g8; g8 = g8 * g8; g8 = g8 * g8;
                __syncthreads();
                pg8::f32x4 st[2];
#pragma unroll
                for (int ib = 0; ib < 2; ++ib) st[ib] = (pg8::f32x4){0.f, 0.f, 0.f, 0.f};
                for (int w2 = 0; w2 < wave; ++w2)
#pragma unroll
                    for (int ib = 0; ib < 2; ++ib) st[ib] = st[ib] * g8 + ends[(w2 * 2 + ib) * 64 + lane];
                bf16* ST = (bf16*)(ws + WS_STATE) + (size_t)(bh * 64 + 8 * wave) * 4096 + (size_t)(16 * dvs + fr) * 64 + 32 * dkh + 4 * fq;
#pragma unroll
                for (int i = 0; i < 8; ++i)
#pragma unroll
                    for (int ib = 0; ib < 2; ++ib) { u32x2 w; w.x = pk2(st[ib][0], st[ib][1]); w.y = pk2(st[ib][2], st[ib][3]); *(u32x2*)(ST + (size_t)i * 4096 + 16 * ib) = w; st[ib] = st[ib] * g64 + u[i][ib]; }
                __syncthreads();
                if (idx < 32) {
                const int bh = idx; const float* lf = (const float*)(ws + WS_LOGF) + (size_t)bh * SEQ; float* cb = (float*)(ws + WS_CB) + (size_t)bh * SEQ;
                const f32x4 a0 = *(const f32x4*)(lf + tid * 8), a1 = *(const f32x4*)(lf + tid * 8 + 4); float v[8] = {a0.x, a0.y, a0.z, a0.w, a1.x, a1.y, a1.z, a1.w};
#pragma unroll
                for (int e = 1; e < 8; ++e) v[e] += v[e - 1];
                float tot = v[7];
#pragma unroll
                for (int o = 1; o < 64; o <<= 1) { const float t = __shfl_up(tot, o); if (lane >= o) tot += t; }
                if (lane == 63) ldsf[wave] = tot;
                __syncthreads();
                float off = tot - v[7];
                for (int w = 0; w < wave; ++w) off += ldsf[w];
                f32x4 o0, o1; o0.x = -(v[0] + off) * LOG2E; o0.y = -(v[1] + off) * LOG2E; o0.z = -(v[2] + off) * LOG2E; o0.w = -(v[3] + off) * LOG2E; o1.x = -(v[4] + off) * LOG2E; o1.y = -(v[5] + off) * LOG2E; o1.z = -(v[6] + off) * LOG2E; o1.w = -(v[7] + off) * LOG2E;
                *(f32x4*)(cb + tid * 8) = o0; *(f32x4*)(cb + tid * 8 + 4) = o1;
                } else if (idx < 64) {
                const int bh = idx - 32, b = bh >> 3, h = bh & 7, rsub = lane >> 3, part = lane & 7;
                const bf16* Qp = (const bf16*)(ws + WS_QO) + ((size_t)b * SEQ + wave * 512 + rsub) * 512 + h * 64 + part * 8; const bf16* Kp = (const bf16*)(ws + WS_KB) + ((size_t)b * SEQ + wave * 512 + rsub) * 512 + h * 64 + part * 8;
                float qm = 0.f, km = 0.f;
#pragma unroll 8
                for (int it = 0; it < 64; ++it) { const u32x4 qv = *(const u32x4*)(Qp + (size_t)it * 8 * 512), kv = *(const u32x4*)(Kp + (size_t)it * 8 * 512); float sq = 0.f, sk = 0.f;
#pragma unroll
                    for (int e = 0; e < 4; ++e) { const float a0 = bflo(qv[e]), a1 = bfhi(qv[e]), c0 = bflo(kv[e]), c1 = bfhi(kv[e]); sq += a0 * a0 + a1 * a1; sk += c0 * c0 + c1 * c1; }
                    sq += __shfl_xor(sq, 1); sq += __shfl_xor(sq, 2); sq += __shfl_xor(sq, 4); sk += __shfl_xor(sk, 1); sk += __shfl_xor(sk, 2); sk += __shfl_xor(sk, 4);
                    qm = fmaxf(qm, sq); km = fmaxf(km, sk); }
#pragma unroll
                for (int o = 8; o < 64; o <<= 1) { qm = fmaxf(qm, __shfl_xor(qm, o)); km = fmaxf(km, __shfl_xor(km, o)); }
                if (lane == 0) { ldsf[wave * 2] = qm; ldsf[wave * 2 + 1] = km; }
                __syncthreads();
                if (tid == 0) { float a = 0.f, c = 0.f; for (int w = 0; w < NWAVES; ++w) { a = fmaxf(a, ldsf[2 * w]); c = fmaxf(c, ldsf[2 * w + 1]); } ((float*)(ws + WS_NRM))[bh] = sqrtf(a) * sqrtf(c) * 1.0001f; }
                }
            }
        }
        GSYNC();
        TSTAMP(3);
        {
            PHASE_VARS;
            const attn_body::AttnTensors AT{(const attn_body::bf16*)(ws + WS_QO), (const attn_body::bf16*)(ws + WS_KB), (const attn_body::bf16*)(ws + WS_VB), (attn_body::bf16*)(ws + WS_GATE), (const float*)(ws + WS_CB), (const float*)(ws + WS_NRM)};
            { const unsigned x0 = xb_xcc_id() & 7u; volatile LAS unsigned* slot = (volatile LAS unsigned*)(ldsl + RING_BYTES + 352) + 3;
              for (unsigned xi = 0; xi < 8u; ++xi) { const unsigned x = (x0 + xi) & 7u; unsigned* cnt = (unsigned*)ws + 8192 + (l * 8 + (int)x) * 64;
                for (;;) {
                  if (tid == 0) *slot = __hip_atomic_fetch_add(cnt, 1u, __ATOMIC_RELAXED, __HIP_MEMORY_SCOPE_AGENT);
                  __syncthreads();
                  const unsigned j = *slot;
                  __syncthreads();
                  if (j >= 64u) break;
                  const int qb = 15 - (int)(j >> 2), b = (int)(j & 3u), h = (int)((x + 2u * (j & 3u)) & 7u);
                  attn_body::attn_unit<8>(b, h, qb, AT.Q, AT.K, AT.V, AT.O, AT.CB, AT.NRM, (char*)lds);
                } } }
            if (wave < 4) ret_out_unit(args, l, wave * 256 + bx, lane);
            else {
                const int t = (wave - 4) * 256 + bx, tm = t >> 2, tn = t & 3;
                WEpiGlu E{(const bf16*)(ws + WS_YS5), (bf16*)(ws + WS_GATE), tm * 64, tn * 64};
                wave_gemm64<8, 4, WEpiGlu>((const bf16*)(ws + WS_YS5) + (size_t)(tm * 64) * 256, 256, (const bf16*)(ws + WS_WGLU) + (size_t)l * 65536 + (size_t)(tn * 64) * 256, 256, lane, E);
            }
        }
        GSYNC();
        TSTAMP(4);
        {
            PHASE_VARS;
            pg8::Gemm g{(const bf16*)(ws + WS_GATE), (const bf16*)(ws + WS_WO) + (size_t)l * DM * DM, M, DM, DM, DM, DM, 0, 0};
            pg8::StaticOrder S; S.init(M, DM, G, bx);
            if (l + 1 < DEPTH) {
                EpiOutX<false> E{l == 0 ? args.in[0] : X, X, args.in[1] + (size_t)(l + 1) * DM, (float*)(ws + WS_XBUF), (unsigned*)ws + 4096, (bf16*)(ws + WS_XN), 32u * (unsigned)(l + 1)};
                pg8::gemm_phase<EpiOutX<false>, pg8::StaticOrder, false, true>(ldsl, g, S, E);
            } else {
                EpiOutX<true> E{X, X, args.in[15], (float*)(ws + WS_XBUF), (unsigned*)ws + 4096, nullptr, 32u * (unsigned)(l + 1)};
                pg8::gemm_phase<EpiOutX<true>, pg8::StaticOrder, false, true>(ldsl, g, S, E);
            }
        }
        if (l + 1 < DEPTH) GSYNC();
        TSTAMP(6);
    }
}

extern "C" void kernel_launch(void* const* d_in, const int* in_sizes, int n_in, void* d_out, int out_size, void* d_ws, size_t ws_size, hipStream_t stream) {
    static int grid = 0;
    if (grid == 0) {
        if (n_in != 16 || ws_size < WS_END) { fprintf(stderr, "kernel_launch: unexpected n_in %d / ws %zu\n", n_in, ws_size); grid = -1; return; }
        int dev = 0, cus = 0, per_cu = 0;
        hipGetDevice(&dev); hipDeviceGetAttribute(&cus, hipDeviceAttributeMultiprocessorCount, dev);
        if (hipFuncSetAttribute((const void*)mega_fwd, hipFuncAttributeMaxDynamicSharedMemorySize, LDS_BYTES) != hipSuccess) { fprintf(stderr, "kernel_launch: hipFuncSetAttribute failed\n"); grid = -1; return; }
        if (hipOccupancyMaxActiveBlocksPerMultiprocessor(&per_cu, (const void*)mega_fwd, NTHR, LDS_BYTES) != hipSuccess || per_cu < 1) { fprintf(stderr, "kernel_launch: occupancy query failed (%d)\n", per_cu); grid = -1; return; }
        grid = cus;
        if (grid != 256) fprintf(stderr, "kernel_launch: note: %d CUs\n", grid);
    }
    if (grid < 0) return;
    if (hipMemsetAsync(d_ws, 0, 65536, stream) != hipSuccess) { fprintf(stderr, "kernel_launch: hipMemsetAsync failed\n"); return; }
    Args a{};
    for (int i = 0; i < 16; ++i) a.in[i] = (const float*)d_in[i];
    a.out = (float*)d_out; a.ws = (unsigned char*)d_ws;
    void* kargs[] = {&a};
    hipError_t e = hipLaunchCooperativeKernel((const void*)mega_fwd, dim3(grid), dim3(NTHR), kargs, LDS_BYTES, stream);
    if (e != hipSuccess) fprintf(stderr, "kernel_launch: cooperative launch failed: %s\n", hipGetErrorString(e));
}
```
